# Optimizing an MI355X kernel written in HIP

```python
import numpy as np
import jax
import jax.numpy as jnp
from jax import lax

D_MODEL = 1024
BATCH = 8
SEQ = 4096
DEPTH = 2

GRID_W = 64
CTX_LEN = 256
MLA_HEADS = 8
MLA_Q_LORA = 384
MLA_KV_LORA = 256
MLA_NOPE = 64
MLA_ROPE = 32
MLA_V = 64
MLA_SCALE = (MLA_NOPE + MLA_ROPE) ** -0.5
ROPE_BASE = 10000.0
Q_BLOCK = 128
HG_HEADS = 4
HG_DK = 128
HG_DV = 128
HG_CHUNK = 32
HG_K = HG_HEADS * HG_DK
HG_V = HG_HEADS * HG_DV
IN_SPLITS = (MLA_Q_LORA, MLA_KV_LORA, MLA_ROPE, HG_K, HG_K, HG_K, HG_V, HG_V)
IN_COLS = sum(IN_SPLITS)
MIX_WIDTH = MLA_HEADS * MLA_V + HG_V
CONV_WIDTH = 31
CONF_DIM = D_MODEL
N_EXPERTS = 32
TOP_K = 4
D_EXPERT = D_MODEL
SWIGLU_LIMIT = 7.0
SWIGLU_ALPHA = 1.702
MOE_BLOCK = 128
LN_EPS = 1e-5
RMS_EPS = 1e-6
DEEPNORM_ALPHA = (2.0 * DEPTH) ** 0.25
DEEPNORM_BETA = (8.0 * DEPTH) ** -0.25
N_EVEN = (DEPTH + 1) // 2
N_ODD = DEPTH // 2

kernel_name = 'hybrid_mla_hgrn2_conformer_moe'


def _rmsnorm(x, g):
    xf = x.astype(jnp.float32)
    y = xf * lax.rsqrt(jnp.mean(xf * xf, axis=-1, keepdims=True) + RMS_EPS)
    return (y * g.astype(jnp.float32)).astype(x.dtype)


def _layernorm(x, g, b):
    xf = x.astype(jnp.float32)
    xc = xf - jnp.mean(xf, axis=-1, keepdims=True)
    var = jnp.mean(xc * xc, axis=-1, keepdims=True)
    return (xc * lax.rsqrt(var + LN_EPS) * g.astype(jnp.float32) + b.astype(jnp.float32)).astype(x.dtype)


def _axial_rope(rows):
    pos_r = jnp.repeat(jnp.arange(rows, dtype=jnp.float32), GRID_W)
    pos_c = jnp.tile(jnp.arange(GRID_W, dtype=jnp.float32), rows)
    half = MLA_ROPE // 2
    inv = jnp.power(ROPE_BASE, -jnp.arange(0, half, 2, dtype=jnp.float32) / half)
    ang = jnp.concatenate([pos_r[:, None] * inv, pos_c[:, None] * inv], axis=-1)
    return jnp.cos(ang), jnp.sin(ang)


def _rope(x, cos, sin):
    x1, x2 = x[..., 0::2], x[..., 1::2]
    cs, sn = cos.astype(x.dtype), sin.astype(x.dtype)
    return jnp.stack([x1 * cs - x2 * sn, x1 * sn + x2 * cs], axis=-1).reshape(x.shape)


def _mla_heads(cq, ckv, kr, q_norm, kv_norm, w_uq, w_uk, w_uv):
    B, T, _ = cq.shape
    q = (_rmsnorm(cq, q_norm) @ w_uq).reshape(B, T, MLA_HEADS, MLA_NOPE + MLA_ROPE)
    ckv = _rmsnorm(ckv, kv_norm)
    k_nope = (ckv @ w_uk).reshape(B, T, MLA_HEADS, MLA_NOPE)
    v = (ckv @ w_uv).reshape(B, T, MLA_HEADS, MLA_V)
    return q[..., :MLA_NOPE], q[..., MLA_NOPE:], k_nope, kr, v


def _mla_attend(qn, qr, kn, kr, v):
    s = jnp.einsum('bqhd,bkhd->bhqk', qn, kn) + jnp.einsum('bqhr,bkr->bhqk', qr, kr)
    p = jax.nn.softmax(s.astype(jnp.float32) * MLA_SCALE, axis=-1).astype(v.dtype)
    return jnp.einsum('bhqk,bkhd->bqhd', p, v)


def _mla_latent(qn, qr, kn, kr, v):
    B, n, H, _ = qn.shape
    nb = n // Q_BLOCK

    def blocks(a):
        return jnp.moveaxis(a.reshape(B, nb, Q_BLOCK, *a.shape[2:]), 1, 0)

    o = lax.map(lambda qs: _mla_attend(qs[0], qs[1], kn, kr, v), (blocks(qn), blocks(qr)))
    return jnp.moveaxis(o, 0, 1).reshape(B, n, H * MLA_V)


def _hgrn_chunk_scan(q, k, v, log_f, s0):
    B, T, H, _ = q.shape
    nc = T // HG_CHUNK

    def chunks(a):
        return a.reshape(B, nc, HG_CHUNK, H, a.shape[-1]).transpose(1, 0, 3, 2, 4)

    tri = jnp.tril(jnp.ones((HG_CHUNK, HG_CHUNK), dtype=bool))

    def step(S, xs):
        qc, kc, vc, gc = xs
        b = jnp.cumsum(gc, axis=2)
        b_end = b[:, :, -1:, :]
        q_in = qc * jnp.exp(b)
        a = jnp.einsum('bhtk,bhsk->bhts', q_in, kc * jnp.exp(-b))
        a = jnp.where(tri, a, 0.0)
        o = jnp.einsum('bhts,bhsv->bhtv', a, vc) + jnp.einsum('bhtk,bhkv->bhtv', q_in, S)
        S = jnp.exp(b_end[:, :, 0, :])[..., None] * S + jnp.einsum('bhsk,bhsv->bhkv', kc * jnp.exp(b_end - b), vc)
        return S, o

    S, o = lax.scan(step, s0, (chunks(q), chunks(k), chunks(v), chunks(log_f)))
    return o.transpose(1, 0, 3, 2, 4).reshape(B, T, H, v.shape[-1]), S


def _hgrn_bidir(parts_c, parts_l, lb, hg_norm, need_ctx):
    lbh = lb.reshape(HG_HEADS, HG_DK)

    def heads(a, d):
        B, T, _ = a.shape
        return a.reshape(B, T, HG_HEADS, d).astype(jnp.float32)

    def gate(hf):
        f = lbh + (1.0 - lbh) * jax.nn.sigmoid(heads(hf, HG_DK))
        return 1.0 - f, jnp.log(f)

    q_c, v_c = heads(parts_c[0], HG_DK), heads(parts_c[3], HG_DV)
    q_l, v_l = heads(parts_l[0], HG_DK), heads(parts_l[3], HG_DV)
    B = q_l.shape[0]
    o_c = jnp.zeros_like(v_c)
    o_l = jnp.zeros_like(v_l)
    for fi, reverse in ((1, False), (2, True)):
        k_c, g_c = gate(parts_c[fi])
        k_l, g_l = gate(parts_l[fi])
        seq_c, seq_l = (q_c, k_c, v_c, g_c), (q_l, k_l, v_l, g_l)
        if reverse:
            seq_c = tuple(jnp.flip(a, 1) for a in seq_c)
            seq_l = tuple(jnp.flip(a, 1) for a in seq_l)
        s0 = jnp.zeros((B, HG_HEADS, HG_DK, HG_DV), jnp.float32)
        oc, s_ctx = _hgrn_chunk_scan(*seq_c, s0)
        ol, _ = _hgrn_chunk_scan(*seq_l, s_ctx)
        if reverse:
            oc, ol = jnp.flip(oc, 1), jnp.flip(ol, 1)
        o_c = o_c + oc
        o_l = o_l + ol

    def readout(o, g):
        B2, T = o.shape[:2]
        y = _rmsnorm(o, hg_norm) * jax.nn.silu(heads(g, HG_DV))
        return y.reshape(B2, T, HG_V).astype(g.dtype)

    y_c = readout(o_c, parts_c[4]) if need_ctx else None
    return y_c, readout(o_l, parts_l[4])


def _mla_hgrn_mixer(a_ctx, a_lat, w_in, q_norm, kv_norm, w_uq, w_uk, w_uv, lb, hg_norm, w_out, cos, sin, need_ctx):
    splits = np.cumsum(IN_SPLITS)[:-1].tolist()
    zc = jnp.split(a_ctx @ w_in, splits, axis=-1)
    zl = jnp.split(a_lat @ w_in, splits, axis=-1)
    qn_c, qr_c, kn_c, kr_c, v_c = _mla_heads(zc[0], zc[1], zc[2], q_norm, kv_norm, w_uq, w_uk, w_uv)
    qn_l, qr_l, kn_l, kr_l, v_l = _mla_heads(zl[0], zl[1], zl[2], q_norm, kv_norm, w_uq, w_uk, w_uv)
    qr_l = _rope(qr_l, cos[:, None, :], sin[:, None, :])
    kr_l = _rope(kr_l, cos, sin)
    att_l = _mla_latent(qn_l, qr_l,
                        jnp.concatenate([kn_c, kn_l], axis=1),
                        jnp.concatenate([kr_c, kr_l], axis=1),
                        jnp.concatenate([v_c, v_l], axis=1))
    hg_c, hg_l = _hgrn_bidir(zc[3:], zl[3:], lb, hg_norm, need_ctx)
    y_lat = jnp.concatenate([att_l, hg_l], axis=-1) @ w_out
    y_ctx = None
    if need_ctx:
        B, Tc = a_ctx.shape[:2]
        att_c = _mla_attend(qn_c, qr_c, kn_c, kr_c, v_c).reshape(B, Tc, MLA_HEADS * MLA_V)
        y_ctx = jnp.concatenate([att_c, hg_c], axis=-1) @ w_out
    return y_ctx, y_lat


def _conformer_conv(h, pw1_w, pw1_b, dw_w, dw_b, ln_g, ln_b, pw2_w, pw2_b):
    a = h @ pw1_w + pw1_b
    u = a[..., :CONF_DIM] * jax.nn.sigmoid(a[..., CONF_DIM:])
    u = lax.conv_general_dilated(u, dw_w[:, None, :].astype(u.dtype), window_strides=(1,),
                                 padding=[(CONV_WIDTH // 2, CONV_WIDTH // 2)],
                                 dimension_numbers=('NWC', 'WIO', 'NWC'),
                                 feature_group_count=CONF_DIM) + dw_b
    u = jax.nn.silu(_layernorm(u, ln_g, ln_b))
    return u @ pw2_w + pw2_b


def _clamped_swiglu(gu):
    gate = jnp.minimum(gu[..., 0::2], SWIGLU_LIMIT)
    up = jnp.clip(gu[..., 1::2], -SWIGLU_LIMIT, SWIGLU_LIMIT)
    return (up + 1.0) * gate * jax.nn.sigmoid(SWIGLU_ALPHA * gate)


def _moe(h, router_w, router_b, w_gu, b_gu, w_down, b_down):
    N, D = h.shape
    logits = (h @ router_w + router_b).astype(jnp.float32)
    top_v, top_i = lax.top_k(logits, TOP_K)
    gates = jax.nn.softmax(top_v, axis=-1).astype(h.dtype)
    nk = N * TOP_K
    flat_e = top_i.reshape(-1)
    flat_w = gates.reshape(-1)
    flat_tok = jnp.arange(nk, dtype=jnp.int32) // TOP_K
    order = jnp.argsort(flat_e)
    se = flat_e[order]
    counts = jnp.zeros((N_EXPERTS,), jnp.int32).at[flat_e].add(1)
    starts = jnp.cumsum(counts) - counts
    pcounts = (counts + MOE_BLOCK - 1) // MOE_BLOCK * MOE_BLOCK
    pends = jnp.cumsum(pcounts)
    pstarts = pends - pcounts
    dest = pstarts[se] + jnp.arange(nk, dtype=jnp.int32) - starts[se]
    n_blocks = -(-(nk + N_EXPERTS * (MOE_BLOCK - 1)) // MOE_BLOCK)
    P = n_blocks * MOE_BLOCK
    row_tok = jnp.zeros((P,), jnp.int32).at[dest].set(flat_tok[order])
    row_w = jnp.zeros((P,), h.dtype).at[dest].set(flat_w[order])
    block_e = jnp.minimum(jnp.searchsorted(pends, jnp.arange(n_blocks, dtype=jnp.int32) * MOE_BLOCK, side='right'),
                          N_EXPERTS - 1)

    def step(out, xs):
        tok, wt, e = xs
        gu = h[tok] @ w_gu[e] + b_gu[e]
        y = _clamped_swiglu(gu) @ w_down[e] + b_down[e]
        return out.at[tok].add((y * wt[:, None]).astype(jnp.float32)), None

    out, _ = lax.scan(step, jnp.zeros((N, D), jnp.float32),
                      (row_tok.reshape(n_blocks, MOE_BLOCK), row_w.reshape(n_blocks, MOE_BLOCK), block_e))
    return out.astype(h.dtype)


def setup_inputs(seed: int = 0) -> dict:
    key = jax.random.key(seed)
    ks = iter(jax.random.split(key, 40))
    D = D_MODEL

    def nrm(shape, scale):
        return jax.random.normal(next(ks), shape, jnp.float32) * scale

    def gain(shape):
        return 1.0 + nrm(shape, 0.02)

    return {
        'x': nrm((BATCH, SEQ, D), 1.0),
        'c': nrm((BATCH, D), 1.0),
        'ctx': nrm((BATCH, CTX_LEN, D), 1.0),
        'c_ctx': nrm((D,), 1.0),
        'mod_w': nrm((DEPTH, D, 6 * D), 0.5 * D ** -0.5),
        'mod_b': nrm((DEPTH, 6 * D), 0.02),
        'ln1_g': gain((DEPTH, D)),
        'ln1_b': nrm((DEPTH, D), 0.02),
        'ln2_g': gain((DEPTH, D)),
        'ln2_b': nrm((DEPTH, D), 0.02),
        'mix_w_in': nrm((N_EVEN, D, IN_COLS), D ** -0.5),
        'mla_q_norm': gain((N_EVEN, MLA_Q_LORA)),
        'mla_kv_norm': gain((N_EVEN, MLA_KV_LORA)),
        'mla_w_uq': nrm((N_EVEN, MLA_Q_LORA, MLA_HEADS * (MLA_NOPE + MLA_ROPE)), MLA_Q_LORA ** -0.5),
        'mla_w_uk': nrm((N_EVEN, MLA_KV_LORA, MLA_HEADS * MLA_NOPE), MLA_KV_LORA ** -0.5),
        'mla_w_uv': nrm((N_EVEN, MLA_KV_LORA, MLA_HEADS * MLA_V), MLA_KV_LORA ** -0.5),
        'hg_lb_logits': nrm((DEPTH + 1, HG_K), 0.1),
        'hg_norm': gain((N_EVEN, HG_DV)),
        'mix_w_out': nrm((N_EVEN, MIX_WIDTH, D), DEEPNORM_BETA * MIX_WIDTH ** -0.5),
        'conv_pw1_w': nrm((N_ODD, D, 2 * CONF_DIM), D ** -0.5),
        'conv_pw1_b': nrm((N_ODD, 2 * CONF_DIM), 0.02),
        'conv_dw_w': nrm((N_ODD, CONV_WIDTH, CONF_DIM), CONV_WIDTH ** -0.5),
        'conv_dw_b': nrm((N_ODD, CONF_DIM), 0.02),
        'conv_ln_g': gain((N_ODD, CONF_DIM)),
        'conv_ln_b': nrm((N_ODD, CONF_DIM), 0.02),
        'conv_pw2_w': nrm((N_ODD, CONF_DIM, D), DEEPNORM_BETA * CONF_DIM ** -0.5),
        'conv_pw2_b': nrm((N_ODD, D), 0.02),
        'router_w': nrm((DEPTH, D, N_EXPERTS), D ** -0.5),
        'router_b': nrm((DEPTH, N_EXPERTS), 0.01),
        'exp_w_gu': nrm((DEPTH, N_EXPERTS, D, 2 * D_EXPERT), D ** -0.5),
        'exp_b_gu': nrm((DEPTH, N_EXPERTS, 2 * D_EXPERT), 0.02),
        'exp_w_down': nrm((DEPTH, N_EXPERTS, D_EXPERT, D), DEEPNORM_BETA * D_EXPERT ** -0.5),
        'exp_b_down': nrm((DEPTH, N_EXPERTS, D), 0.02),
    }


def reference(x, c, ctx, c_ctx, mod_w, mod_b, ln1_g, ln1_b, ln2_g, ln2_b,
              mix_w_in, mla_q_norm, mla_kv_norm, mla_w_uq, mla_w_uk, mla_w_uv,
              hg_lb_logits, hg_norm, mix_w_out,
              conv_pw1_w, conv_pw1_b, conv_dw_w, conv_dw_b, conv_ln_g, conv_ln_b,
              conv_pw2_w, conv_pw2_b,
              router_w, router_b, exp_w_gu, exp_b_gu, exp_w_down, exp_b_down):
    B, n, D = x.shape
    rows = n // GRID_W
    cos, sin = _axial_rope(rows)
    lb_all = jnp.cumsum(jax.nn.softmax(hg_lb_logits.astype(jnp.float32), axis=0), axis=0)
    h_lat, h_ctx = x, ctx
    for l in range(DEPTH):
        last = l == DEPTH - 1
        j = l // 2
        m_lat = jnp.split((jax.nn.silu(c) @ mod_w[l] + mod_b[l])[:, None, :], 6, axis=-1)
        m_ctx = jnp.split(jax.nn.silu(c_ctx) @ mod_w[l] + mod_b[l], 6, axis=-1)
        a_lat = h_lat * (1.0 + m_lat[1]) + m_lat[0]
        a_ctx = h_ctx * (1.0 + m_ctx[1]) + m_ctx[0]
        if l % 2 == 0:
            y_ctx, y_lat = _mla_hgrn_mixer(a_ctx, a_lat, mix_w_in[j], mla_q_norm[j], mla_kv_norm[j],
                                           mla_w_uq[j], mla_w_uk[j], mla_w_uv[j], lb_all[l], hg_norm[j],
                                           mix_w_out[j], cos, sin, not last)
        else:
            conv_p = (conv_pw1_w[j], conv_pw1_b[j], conv_dw_w[j], conv_dw_b[j],
                      conv_ln_g[j], conv_ln_b[j], conv_pw2_w[j], conv_pw2_b[j])
            y_lat = _conformer_conv(a_lat, *conv_p)
            y_ctx = None if last else _conformer_conv(a_ctx, *conv_p)
        h_lat = _layernorm(DEEPNORM_ALPHA * h_lat + m_lat[2] * y_lat, ln1_g[l], ln1_b[l])
        moe_p = (router_w[l], router_b[l], exp_w_gu[l], exp_b_gu[l], exp_w_down[l], exp_b_down[l])
        b_lat = h_lat * (1.0 + m_lat[4]) + m_lat[3]
        if last:
            f_lat = _moe(b_lat.reshape(B * n, D), *moe_p).reshape(B, n, D)
        else:
            h_ctx = _layernorm(DEEPNORM_ALPHA * h_ctx + m_ctx[2] * y_ctx, ln1_g[l], ln1_b[l])
            b_ctx = h_ctx * (1.0 + m_ctx[4]) + m_ctx[3]
            Tc = h_ctx.shape[1]
            f_all = _moe(jnp.concatenate([b_ctx.reshape(B * Tc, D), b_lat.reshape(B * n, D)], axis=0), *moe_p)
            f_ctx = f_all[:B * Tc].reshape(B, Tc, D)
            f_lat = f_all[B * Tc:].reshape(B, n, D)
            h_ctx = _layernorm(DEEPNORM_ALPHA * h_ctx + m_ctx[5] * f_ctx, ln2_g[l], ln2_b[l])
        h_lat = _layernorm(DEEPNORM_ALPHA * h_lat + m_lat[5] * f_lat, ln2_g[l], ln2_b[l])
    return h_lat
```

```cpp
#include <hip/hip_runtime.h>
#include <cstdio>
#include <cstdint>

#ifndef MK_ONE_LAUNCH
#define MK_ONE_LAUNCH 1
#endif

namespace pg8 {
#define PG8_LAS __attribute__((address_space(3)))
typedef unsigned short bf16_t;
typedef short bf16x8 __attribute__((ext_vector_type(8)));
typedef float f32x4 __attribute__((ext_vector_type(4)));
typedef unsigned u32x4 __attribute__((ext_vector_type(4)));
constexpr int BM = 256, BK = 64, HALF = 128, HTB = HALF * BK * 2  , STAGE_BYTES = 8 * HTB, NXCD = 8, WGM = 8;

__host__ __device__ __forceinline__ int lds_byte(int r, int c) { const int st = (r >> 4) * 2 + (c >> 5), rr = r & 15, cc = c & 31, ob = rr * 64 + cc * 2; return st * 1024 + (ob ^ (((ob >> 9) & 1) << 5)); }
__host__ __device__ __forceinline__ void stage_rc(int b, int& R, int& C) { const int st = b / 1024, sb = b % 1024, swz = sb ^ (((sb >> 9) & 1) << 5); R = (st >> 1) * 16 + swz / 64; C = (st & 1) * 32 + (swz % 64) / 2; }
__host__ __device__ __forceinline__ int perm32(int rho) { const int n = rho >> 4, i = rho & 15; return 8 * (i >> 2) + 4 * n + (i & 3); }

struct Unit { int pm, pn; };
struct Gemm { const bf16_t* A; const bf16_t* Bt; int M, N, K; };

struct StaticOrder {
    int nM, nN, nwg, G, c;
    __host__ __device__ void init(int M, int N, int G_, int c_) { nM = M / BM; nN = N / BM; nwg = nM * nN; G = G_; c = c_; }
    __host__ __device__ bool next(int i, Unit& u) const {
        const long L = (long)i * G + c; if (L >= nwg) return false;
        int wgid = (int)L; { const int q = nwg / NXCD, r = nwg % NXCD, xcd = wgid % NXCD, off = wgid / NXCD; wgid = (xcd < r ? xcd * (q + 1) : r * (q + 1) + (xcd - r) * q) + off; }
        const int nig = WGM * nN, gid = wgid / nig, fm = gid * WGM, gsz = (nM - fm) < WGM ? (nM - fm) : WGM;
        u.pm = fm + ((wgid % nig) % gsz); u.pn = (wgid % nig) / gsz; return true;
    }
    __device__ __forceinline__ void a_ready(const Unit&) const {}
    __device__ __forceinline__ void done(const Unit&) const {}
};

__device__ __forceinline__ unsigned cvt_pk_bf16(float lo, float hi) { unsigned r; asm volatile("v_cvt_pk_bf16_f32 %0, %1, %2" : "=v"(r) : "v"(lo), "v"(hi)); return r; }
typedef float f32x2 __attribute__((ext_vector_type(2)));
__device__ __forceinline__ f32x2 gelu_pk(f32x2 v) {
    const f32x2 av = __builtin_elementwise_abs(v), d = av * 0.2316418882f + 1.0f;
    f32x2 t; t.x = __builtin_amdgcn_rcpf(d.x); t.y = __builtin_amdgcn_rcpf(d.y);
    f32x2 q = t * 0.5307027145f + (-0.7265760135f); q = q * t + 0.7107068705f; q = q * t + (-0.142248368f); q = q * t + 0.127414796f; q = q * t;
    const f32x2 s = (v * v) * (-0.72134752044f);
    f32x2 e; e.x = __builtin_amdgcn_exp2f(s.x); e.y = __builtin_amdgcn_exp2f(s.y);
    const f32x2 m = v * (q * e), r = v - m;
    f32x2 o; o.x = v.x < 0.f ? m.x : r.x; o.y = v.y < 0.f ? m.y : r.y; return o;
}

template <int ACT  > struct EpiBf16 {
    static constexpr bool PERM = true, AFTER_DRAIN = false; static_assert(ACT == 0 || ACT == 1, "EpiBf16: ACT is 0 (none) or 1 (gelu_pk)");
    bf16_t* O; int ldc; const float* bias; int split_cols; size_t split_stride; float scale0;
    __device__ __forceinline__ void operator()(const f32x4 (&acc)[2][2][4][2], const Unit& u, int wr, int wc, int fr, int fq) const {
        const int row0 = u.pm * BM + wr * 64 + fr; int colt = u.pn * BM; bf16_t* base = O;
        float sc = 1.f; if (split_cols) { const int t = colt / split_cols; base += (size_t)t * split_stride; colt -= t * split_cols; if (t == 0) sc = scale0; }
        const int col0 = colt + wc * 32 + 8 * fq, bcol0 = u.pn * BM + wc * 32 + 8 * fq;
        f32x4 bv[2][2];
#pragma unroll
        for (int bj = 0; bj < 2; ++bj)
#pragma unroll
            for (int n = 0; n < 2; ++n) bv[bj][n] = bias ? *(const f32x4*)(bias + bcol0 + bj * HALF + 4 * n) : (f32x4){0.f, 0.f, 0.f, 0.f};
#pragma unroll
        for (int ai = 0; ai < 2; ++ai)
#pragma unroll
            for (int m = 0; m < 4; ++m) { bf16_t* rowp = base + (size_t)(row0 + ai * HALF + m * 16) * ldc + col0;
#pragma unroll
                for (int bj = 0; bj < 2; ++bj) { f32x4 v0 = acc[ai][bj][m][0] + bv[bj][0], v1 = acc[ai][bj][m][1] + bv[bj][1];
                    if (ACT == 1) { f32x2 a = gelu_pk((f32x2){v0[0], v0[1]}), b = gelu_pk((f32x2){v0[2], v0[3]}), c = gelu_pk((f32x2){v1[0], v1[1]}), d = gelu_pk((f32x2){v1[2], v1[3]});
                        v0 = (f32x4){a.x, a.y, b.x, b.y}; v1 = (f32x4){c.x, c.y, d.x, d.y}; }
                    v0 = v0 * sc; v1 = v1 * sc; u32x4 w; w.x = cvt_pk_bf16(v0[0], v0[1]); w.y = cvt_pk_bf16(v0[2], v0[3]); w.z = cvt_pk_bf16(v1[0], v1[1]); w.w = cvt_pk_bf16(v1[2], v1[3]);
                    *(u32x4*)(rowp + bj * HALF) = w; } }
    }
};
template <class Epi, class Sched, bool ALIGN_EPI = false, bool SP2 = false>
__device__ __forceinline__ void gemm_phase(PG8_LAS unsigned char* lds, const Gemm g, const Sched& S, const Epi& E) {
    int tid_l = threadIdx.x; asm volatile("" : "+v"(tid_l));
    const int tid = tid_l, wid = __builtin_amdgcn_readfirstlane(tid >> 6), lane = tid & 63, wr = wid >> 2, wc = wid & 3, fr = lane & 15, fq = lane >> 4;
    const int K = g.K, nt = K / BK;
    unsigned voffA[2], voffB[2];
#pragma unroll
    for (int i = 0; i < 2; ++i) { int R, C; stage_rc(tid * 16 + i * 8192, R, C); const int Rb = Epi::PERM ? ((R & ~31) + perm32(R & 31)) : R;
        voffA[i] = (unsigned)(R * K + C) * 2u; voffB[i] = (unsigned)(Rb * K + C) * 2u; }
    const size_t kstep = (size_t)(BK * 2);
    const size_t hstep = (size_t)HALF * K * 2;
    const size_t tstep = 2 * hstep;
    const unsigned ldsw = (unsigned)wid * 1024u;
    const int aoff = lds_byte(wr * 64 + fr, fq * 8), boff = lds_byte(wc * 32 + fr, fq * 8);
#define PG8_SA(b, h) (((b) * 2 + (h)) * HTB)
#define PG8_SB(b, h) ((4 + (b) * 2 + (h)) * HTB)
#define PG8_STAGE(bufoff, gbase, voff) do { _Pragma("unroll") for (int _i = 0; _i < 2; ++_i) \
        __builtin_amdgcn_global_load_lds((const unsigned*)((const char*)(gbase) + (voff)[_i]), (PG8_LAS unsigned*)(lds + (bufoff) + ldsw + _i * 8192), 16, 0, 0); } while (0)
#define PG8_LDA(dst, b, h) do { _Pragma("unroll") for (int m = 0; m < 4; ++m) _Pragma("unroll") for (int k = 0; k < 2; ++k) dst[m][k] = *(const PG8_LAS bf16x8*)(lds + PG8_SA(b, h) + aoff + m * 2048 + k * 1024); } while (0)
#define PG8_LDB(dst, b, h) do { _Pragma("unroll") for (int n = 0; n < 2; ++n) _Pragma("unroll") for (int k = 0; k < 2; ++k) dst[n][k] = *(const PG8_LAS bf16x8*)(lds + PG8_SB(b, h) + boff + n * 2048 + k * 1024); } while (0)
#define PG8_MMA(ai, bj, At, Bt) do { __builtin_amdgcn_s_setprio(1); _Pragma("unroll") for (int m = 0; m < 4; ++m) _Pragma("unroll") for (int n = 0; n < 2; ++n) _Pragma("unroll") for (int k = 0; k < 2; ++k) \
        acc[ai][bj][m][n] = __builtin_amdgcn_mfma_f32_16x16x32_bf16(Bt[n][k], At[m][k], acc[ai][bj][m][n], 0, 0, 0); __builtin_amdgcn_s_setprio(0); } while (0)
#define PG8_WAIT_V(n) asm volatile("s_waitcnt vmcnt(" #n ")" ::: "memory")
#define PG8_WAIT_L(n) asm volatile("s_waitcnt lgkmcnt(" #n ")" ::: "memory")
#define PG8_BAR __builtin_amdgcn_s_barrier()
#define PG8_SCHED __builtin_amdgcn_sched_barrier(0)
    Unit cur, nxt; int ui = 0;
    if (!S.next(0, cur)) return;
    f32x4 acc[2][2][4][2];
#pragma unroll
    for (int a = 0; a < 2; ++a)
#pragma unroll
        for (int b = 0; b < 2; ++b)
#pragma unroll
            for (int m = 0; m < 4; ++m)
#pragma unroll
                for (int n = 0; n < 2; ++n) acc[a][b][m][n] = (f32x4){0.f, 0.f, 0.f, 0.f};
    bf16x8 At[4][2], B0[2][2], B1[2][2];
    const char* cA = (const char*)g.A + (size_t)cur.pm * tstep; const char* cB = (const char*)g.Bt + (size_t)cur.pn * tstep;
    S.a_ready(cur);
    if constexpr (SP2) {
        PG8_STAGE(PG8_SB(0, 0), cB, voffB); PG8_STAGE(PG8_SB(0, 1), cB + hstep, voffB); PG8_STAGE(PG8_SA(0, 0), cA, voffA); PG8_STAGE(PG8_SA(0, 1), cA + hstep, voffA);
        if (wr == 1) PG8_BAR;
        PG8_WAIT_V(2); PG8_BAR;
        PG8_STAGE(PG8_SB(1, 0), cB + kstep, voffB); PG8_STAGE(PG8_SA(1, 0), cA + kstep, voffA); PG8_STAGE(PG8_SB(1, 1), cB + hstep + kstep, voffB);
        PG8_WAIT_V(6); PG8_BAR;
    } else {
        PG8_STAGE(PG8_SB(0, 0), cB, voffB); PG8_STAGE(PG8_SA(0, 0), cA, voffA); PG8_STAGE(PG8_SB(0, 1), cB + hstep, voffB); PG8_STAGE(PG8_SA(0, 1), cA + hstep, voffA);
        if (wr == 1) PG8_BAR;
        PG8_WAIT_V(4); PG8_BAR;
        PG8_STAGE(PG8_SB(1, 0), cB + kstep, voffB); PG8_STAGE(PG8_SA(1, 0), cA + kstep, voffA); PG8_STAGE(PG8_SB(1, 1), cB + hstep + kstep, voffB);
        PG8_WAIT_V(6); PG8_BAR;
    }
    for (;;) {
        const bool has_next = S.next(ui + 1, nxt);
        const char* nA = has_next ? (const char*)g.A + (size_t)nxt.pm * tstep : cA; const char* nB = has_next ? (const char*)g.Bt + (size_t)nxt.pn * tstep : cB;
#pragma nounroll
        for (int t = 0; t < nt; t += 2) {
            const bool last = (t == nt - 2);
            const char* a1 = cA + (size_t)(t + 1) * kstep;
            const char* a2 = last ? nA : cA + (size_t)(t + 2) * kstep; const char* b2 = last ? nB : cB + (size_t)(t + 2) * kstep;
            const char* a3 = a2 + kstep; const char* b3 = b2 + kstep;
            if (last && has_next) S.a_ready(nxt);
            if constexpr (SP2) {
            PG8_LDB(B0, 0, 0); PG8_LDB(B1, 0, 1); PG8_SCHED; PG8_LDA(At, 0, 0); PG8_STAGE(PG8_SA(1, 1), a1 + hstep, voffA);
            PG8_WAIT_V(8); PG8_WAIT_L(0); PG8_BAR; PG8_MMA(0, 0, At, B0); PG8_MMA(0, 1, At, B1); PG8_BAR; PG8_SCHED;
            PG8_LDA(At, 0, 1); PG8_STAGE(PG8_SB(0, 0), b2, voffB); PG8_STAGE(PG8_SB(0, 1), b2 + hstep, voffB); PG8_STAGE(PG8_SA(0, 0), a2, voffA);
            PG8_WAIT_V(8); PG8_WAIT_L(0); PG8_BAR; PG8_MMA(1, 0, At, B0); PG8_MMA(1, 1, At, B1); PG8_BAR; PG8_SCHED;
            PG8_LDB(B0, 1, 0); PG8_LDB(B1, 1, 1); PG8_SCHED; PG8_LDA(At, 1, 0); PG8_STAGE(PG8_SA(0, 1), a2 + hstep, voffA);
            PG8_WAIT_V(8); PG8_WAIT_L(0); PG8_BAR; PG8_MMA(0, 0, At, B0); PG8_MMA(0, 1, At, B1); PG8_BAR; PG8_SCHED;
            PG8_LDA(At, 1, 1); PG8_STAGE(PG8_SB(1, 0), b3, voffB); PG8_STAGE(PG8_SB(1, 1), b3 + hstep, voffB); PG8_STAGE(PG8_SA(1, 0), a3, voffA);
            PG8_WAIT_V(8); PG8_WAIT_L(0); PG8_BAR; PG8_MMA(1, 0, At, B0); PG8_MMA(1, 1, At, B1); PG8_BAR; PG8_SCHED;
            } else {
            PG8_LDB(B0, 0, 0); PG8_SCHED; PG8_LDA(At, 0, 0); PG8_STAGE(PG8_SA(1, 1), a1 + hstep, voffA);
            PG8_WAIT_L(8); PG8_BAR; PG8_WAIT_L(0); PG8_MMA(0, 0, At, B0); PG8_BAR; PG8_SCHED;
            PG8_LDB(B1, 0, 1); PG8_STAGE(PG8_SB(0, 0), b2, voffB);
            PG8_BAR; PG8_WAIT_L(0); PG8_MMA(0, 1, At, B1); PG8_BAR;
            PG8_LDA(At, 0, 1); PG8_STAGE(PG8_SA(0, 0), a2, voffA);
            PG8_BAR; PG8_WAIT_L(0); PG8_MMA(1, 0, At, B0); PG8_BAR; PG8_SCHED;
            PG8_STAGE(PG8_SB(0, 1), b2 + hstep, voffB);
            PG8_WAIT_V(6); PG8_BAR; PG8_MMA(1, 1, At, B1); PG8_BAR;
            PG8_LDB(B0, 1, 0); PG8_SCHED; PG8_LDA(At, 1, 0); PG8_STAGE(PG8_SA(0, 1), a2 + hstep, voffA);
            PG8_WAIT_L(8); PG8_BAR; PG8_WAIT_L(0); PG8_MMA(0, 0, At, B0); PG8_BAR; PG8_SCHED;
            PG8_LDB(B1, 1, 1); PG8_STAGE(PG8_SB(1, 0), b3, voffB);
            PG8_BAR; PG8_WAIT_L(0); PG8_MMA(0, 1, At, B1); PG8_BAR;
            PG8_LDA(At, 1, 1); PG8_STAGE(PG8_SA(1, 0), a3, voffA);
            PG8_BAR; PG8_WAIT_L(0); PG8_MMA(1, 0, At, B0); PG8_BAR; PG8_SCHED;
            PG8_STAGE(PG8_SB(1, 1), b3 + hstep, voffB);
            PG8_WAIT_V(6); PG8_BAR; PG8_MMA(1, 1, At, B1); PG8_BAR;
            }
        }
        if constexpr (ALIGN_EPI) { if (wr == 0) PG8_BAR; }
        if constexpr (!Epi::AFTER_DRAIN) { E(acc, cur, wr, wc, fr, fq); S.done(cur); }
        if (!has_next) break;
#pragma unroll
        for (int a = 0; a < 2; ++a)
#pragma unroll
            for (int b = 0; b < 2; ++b)
#pragma unroll
                for (int m = 0; m < 4; ++m)
#pragma unroll
                    for (int n = 0; n < 2; ++n) acc[a][b][m][n] = (f32x4){0.f, 0.f, 0.f, 0.f};
        cur = nxt; cA = nA; cB = nB; ++ui;
        if constexpr (ALIGN_EPI) { if (wr == 1) PG8_BAR; }
    }
    PG8_WAIT_V(0);
    if constexpr (!ALIGN_EPI) { if (wr == 0) PG8_BAR; }
    PG8_BAR;
    if constexpr (Epi::AFTER_DRAIN) { E.fused(acc, cur, wr, wc, fr, fq, lds, wid, lane); S.done(cur); }
#undef PG8_SA
#undef PG8_SB
#undef PG8_STAGE
#undef PG8_LDA
#undef PG8_LDB
#undef PG8_MMA
#undef PG8_WAIT_V
#undef PG8_WAIT_L
#undef PG8_BAR
#undef PG8_SCHED
}
}

#ifndef PG8_SP2
#define PG8_SP2 true
#endif
#ifndef PG8_ALIGN
#define PG8_ALIGN true
#endif

#define GAS __attribute__((address_space(1)))
#define LAS __attribute__((address_space(3)))
typedef unsigned short bf16;
typedef unsigned v4u __attribute__((ext_vector_type(4)));
typedef unsigned v2u __attribute__((ext_vector_type(2)));
typedef float f32x4 __attribute__((ext_vector_type(4)));
typedef short bf16x8 __attribute__((ext_vector_type(8)));

constexpr int D = 1024, NB = 8, SEQ = 4096, CTXL = 256, TPB = SEQ + CTXL, NTOK = NB * TPB, NLAT = NB * SEQ;
constexpr int ZC = 3328;
constexpr int ZQ = 0, ZKV = 384, ZKR = 640, ZHQ = 672, ZHF = 1184, ZHB = 1696, ZHI = 2208, ZHG = 2720;
constexpr int NEXP = 32;
constexpr float ALPHA = 1.4142135623730951f;
constexpr float LN_EPS = 1e-5f, RMS_EPS = 1e-6f;
constexpr int NWAVES = 8, NTHR = 512;
constexpr int LDS_BYTES = 147456;
constexpr int LDS_BAR_OFF = LDS_BYTES - 64;
constexpr int LDS_TILE_E = 131072;
constexpr int MAXTILES = 576;

constexpr size_t MiB = 1u << 20;
constexpr size_t WS_CTL = 0, CTL_ZERO_BYTES = 16384;
constexpr size_t WS_MODV = 1 * MiB;
constexpr size_t WS_ROPE = 1 * MiB + 512 * 1024;
constexpr size_t WS_BGU = 2 * MiB;
constexpr size_t WS_PW1B = 2 * MiB + 512 * 1024;
constexpr size_t WS_BCNT = WS_PW1B + 64 * 1024;
constexpr size_t WS_TILEE = WS_BCNT + 64 * 1024;
constexpr size_t WS_META = WS_TILEE + 4096;
constexpr size_t WS_TOPI = 3 * MiB, WS_TOPW = 4 * MiB, WS_ROWW = 5 * MiB, WS_ROWD = 6 * MiB;
constexpr size_t WS_WIN = 8 * MiB, WS_WUQ = 15 * MiB, WS_WUKV = 16 * MiB, WS_WOUT = 17 * MiB, WS_WPW1 = 19 * MiB, WS_WPW2 = 23 * MiB;
constexpr size_t WS_WGU = 32 * MiB, WS_WDN = 288 * MiB;
constexpr size_t WS_H = 416 * MiB;
constexpr size_t WS_X = 552 * MiB, WS_Y = 620 * MiB;
constexpr size_t WS_BIG = 688 * MiB;
constexpr size_t WS_Z = WS_BIG, WS_CQN = WS_BIG + 221 * MiB, WS_CKVN = WS_BIG + 247 * MiB, WS_KRR = WS_BIG + 264 * MiB,
                 WS_Q = WS_BIG + 267 * MiB, WS_KV = WS_BIG + 318 * MiB, WS_OF = WS_BIG + 386 * MiB, WS_OB = WS_BIG + 454 * MiB;
constexpr size_t WS_XS = WS_BIG, WS_ACT = WS_BIG + 288 * MiB, WS_YB = WS_BIG + 576 * MiB;
constexpr size_t WS_END = WS_BIG + 848 * MiB;
static_assert((size_t)NTOK * ZC * 2 <= 221 * MiB && (size_t)NTOK * 384 * 2 <= 26 * MiB && (size_t)NTOK * 256 * 2 <= 17 * MiB && (size_t)NTOK * 32 * 2 <= 3 * MiB, "ws map 1");
static_assert((size_t)NTOK * 768 * 2 <= 51 * MiB && (size_t)NTOK * 1024 * 2 <= 68 * MiB && (size_t)NTOK * 512 * 4 <= 68 * MiB, "ws map 2");
static_assert((size_t)MAXTILES * 256 * 2048 <= 288 * MiB && (size_t)NLAT * 4 * 2048 <= 272 * MiB && (size_t)NTOK * 1024 * 4 <= 136 * MiB, "ws map 3");

#define LDS_WAIT() asm volatile("s_waitcnt lgkmcnt(0)" ::: "memory")
#define VM_WAIT() asm volatile("s_waitcnt vmcnt(0)" ::: "memory")
__device__ __forceinline__ float bf2f(unsigned short b) { return __uint_as_float(((unsigned)b) << 16); }
__device__ __forceinline__ unsigned pk2(float lo, float hi) { return pg8::cvt_pk_bf16(lo, hi); }
__device__ __forceinline__ float sigm(float x) { return 1.f / (1.f + __expf(-x)); }
__device__ __forceinline__ float wave_sum(float v) {
#pragma unroll
    for (int o = 1; o < 64; o <<= 1) v += __shfl_xor(v, o);
    return v;
}
__device__ __forceinline__ int ld_ctl(const int* p) { return (int)__hip_atomic_load((const unsigned*)p, __ATOMIC_RELAXED, __HIP_MEMORY_SCOPE_AGENT); }
__device__ __forceinline__ int grow_of(int lr) { return (lr >> 12) * TPB + CTXL + (lr & 4095); }

#define XB_TMO      128
#define XB_XCNT(j)  (256  + 64 * (j))
#define XB_XSUB(j)  (1280 + 64 * (j))
#define XB_XGEN(j)  (2304 + 64 * (j))
#define XB_TOP      3328
#define XB_TOPGEN   3392
#define XCD_BAR_WORDS 3456
#define XB_SPIN_CAP (1u << 21)

__device__ __forceinline__ unsigned xb_ld(unsigned* p)              { return __hip_atomic_load(p, __ATOMIC_RELAXED, __HIP_MEMORY_SCOPE_AGENT); }
__device__ __forceinline__ unsigned xb_add(unsigned* p, unsigned v) { return __hip_atomic_fetch_add(p, v, __ATOMIC_RELAXED, __HIP_MEMORY_SCOPE_AGENT); }
__device__ __forceinline__ unsigned xb_xcc_id() { return (unsigned)__builtin_amdgcn_s_getreg((3 << 11) | 20) & 0xFu; }
#define XB_SPIN(cond, bar) do { unsigned _sp = 0; while (cond) { __builtin_amdgcn_s_sleep(1); \
    if ((++_sp & 255u) == 0u) { if (xb_ld(&(bar)[XB_TMO])) break; if (_sp > XB_SPIN_CAP) { atomicAdd(&(bar)[XB_TMO], 1u); break; } } } } while (0)

struct XcdBarrier { unsigned* bar; unsigned x; volatile LAS unsigned* st; };

__device__ __forceinline__ XcdBarrier xcd_barrier_post(unsigned* bar, volatile LAS unsigned* st) {
    XcdBarrier b; b.bar = bar; b.x = xb_xcc_id(); b.st = st;
    if (threadIdx.x == 0) (void)xb_add(&bar[XB_XCNT(b.x)], 1u);
    return b;
}
__device__ __forceinline__ void xcd_barrier_complete(unsigned* bar, unsigned x, unsigned& nloc, unsigned& nx) {
    const unsigned G = gridDim.x * gridDim.y * gridDim.z;
    unsigned sum, cnt, mine, sp = 0u;
    for (;;) {
        sum = 0u; cnt = 0u; mine = 0u;
#pragma unroll
        for (unsigned j = 0; j < 16; ++j) { const unsigned c = xb_ld(&bar[XB_XCNT(j)]); sum += c; cnt += (c > 0u) ? 1u : 0u; mine = (j == x) ? c : mine; }
        if (sum == G) break;
        __builtin_amdgcn_s_sleep(1);
        if ((++sp & 255u) == 0u) { if (xb_ld(&bar[XB_TMO])) break; if (sp > XB_SPIN_CAP) { atomicAdd(&bar[XB_TMO], 1u); break; } }
    }
    nloc = mine > 0u ? mine : 1u; nx = cnt > 0u ? cnt : 1u;
}
__device__ __forceinline__ void xcd_barrier(const XcdBarrier& b) {
    asm volatile("s_waitcnt vmcnt(0)" ::: "memory");
    __syncthreads();
    if (threadIdx.x == 0) {
        unsigned* bar = b.bar;
        __builtin_amdgcn_s_waitcnt(0);
        unsigned nloc = b.st[0], nx = b.st[1];
        if (nloc == 0u) { xcd_barrier_complete(bar, b.x, nloc, nx); b.st[0] = nloc; b.st[1] = nx; }
        const unsigned old = xb_add(&bar[XB_XSUB(b.x)], 1u);
        const unsigned gen = old / nloc;
        if (old + 1u == (gen + 1u) * nloc) {
            __builtin_amdgcn_fence(__ATOMIC_RELEASE, "agent");
            asm volatile("s_waitcnt vmcnt(0)" ::: "memory");
            const unsigned og = xb_add(&bar[XB_TOP], 1u);
            const unsigned tg = og / nx;
            if (og + 1u == (tg + 1u) * nx) xb_add(&bar[XB_TOPGEN], 1u);
            else XB_SPIN(xb_ld(&bar[XB_TOPGEN]) == tg, bar);
            __builtin_amdgcn_fence(__ATOMIC_ACQUIRE, "agent");
            xb_add(&bar[XB_XGEN(b.x)], 1u);
            asm volatile("s_waitcnt vmcnt(0)" ::: "memory");
        } else {
            XB_SPIN(xb_ld(&bar[XB_XGEN(b.x)]) == gen, bar);
            __builtin_amdgcn_fence(__ATOMIC_ACQUIRE, "agent");
            asm volatile("s_waitcnt vmcnt(0)" ::: "memory");
        }
    }
    __syncthreads();
}

namespace pg8 {
struct TileOrder {
    int nM, nN, nwg, G, c;
    __device__ __forceinline__ void init(int nM_, int nN_, int G_, int c_) { nM = nM_; nN = nN_; nwg = nM * nN; G = G_; c = c_; }
    __device__ __forceinline__ bool logical(int i, int& im, int& in) const {
        const long L = (long)i * G + c; if (L >= nwg) return false;
        int wgid = (int)L; { const int q = nwg / NXCD, r = nwg % NXCD, xcd = wgid % NXCD, off = wgid / NXCD; wgid = (xcd < r ? xcd * (q + 1) : r * (q + 1) + (xcd - r) * q) + off; }
        const int nig = WGM * nN, gid = wgid / nig, fm = gid * WGM, gsz = (nM - fm) < WGM ? (nM - fm) : WGM;
        im = fm + ((wgid % nig) % gsz); in = (wgid % nig) / gsz; return true;
    }
    __device__ __forceinline__ void a_ready(const Unit&) const {}
    __device__ __forceinline__ void done(const Unit&) const {}
};
struct AllOrder : TileOrder { __device__ __forceinline__ bool next(int i, Unit& u) const { int im, in; if (!logical(i, im, in)) return false; u.pm = im; u.pn = in; return true; } };
struct LatOrder : TileOrder {
    __device__ __forceinline__ bool next(int i, Unit& u) const { int im, in; if (!logical(i, im, in)) return false; u.pm = (im >> 4) * 17 + 1 + (im & 15); u.pn = in; return true; } };
struct MoeOrder : TileOrder {
    const PG8_LAS int* tile_e; int nper;
    __device__ __forceinline__ bool next(int i, Unit& u) const { int im, in; if (!logical(i, im, in)) return false; u.pm = im; u.pn = tile_e[im] * nper + in; return true; } };

struct EpiRes {
    static constexpr bool PERM = false, AFTER_DRAIN = false;
    const float* xin; float* h; const float* modv; const float* bias;
    __device__ __forceinline__ void operator()(const f32x4 (&acc)[2][2][4][2], const Unit& u, int wr, int wc, int fr, int fq) const {
        const int b = u.pm / 17, j = u.pm % 17;
        const int rl0 = wr * 64 + fr, col0 = u.pn * BM + wc * 32 + 4 * fq;
        const float* gate = modv + (size_t)b * 6144 + 2048;
        f32x4 gv[2][2], bv[2][2];
#pragma unroll
        for (int bj = 0; bj < 2; ++bj)
#pragma unroll
            for (int n = 0; n < 2; ++n) { gv[bj][n] = *(const f32x4*)(gate + col0 + bj * HALF + n * 16); bv[bj][n] = bias ? *(const f32x4*)(bias + col0 + bj * HALF + n * 16) : (f32x4){0.f, 0.f, 0.f, 0.f}; }
#pragma unroll
        for (int ai = 0; ai < 2; ++ai)
#pragma unroll
            for (int m = 0; m < 4; ++m) { const int rl = rl0 + ai * HALF + m * 16; const size_t grow = (size_t)u.pm * BM + rl;
                const float* hin = xin ? xin + ((size_t)b * 4096 + (size_t)(j - 1) * 256 + rl) * 1024 + col0 : h + grow * 1024 + col0;
                float* ho = h + grow * 1024 + col0;
#pragma unroll
                for (int bj = 0; bj < 2; ++bj)
#pragma unroll
                    for (int n = 0; n < 2; ++n) { const f32x4 hv = *(const f32x4*)(hin + bj * HALF + n * 16);
                        *(f32x4*)(ho + bj * HALF + n * 16) = hv * 1.4142135623730951f + gv[bj][n] * (acc[ai][bj][m][n] + bv[bj][n]); } }
    }
};
template <int MODE> struct EpiGate {
    static constexpr bool PERM = true, AFTER_DRAIN = false;
    bf16_t* O; const float* bias; int nper;
    __device__ __forceinline__ void operator()(const f32x4 (&acc)[2][2][4][2], const Unit& u, int wr, int wc, int fr, int fq) const {
        const int row0 = u.pm * BM + wr * 64 + fr, pnl = u.pn % nper, ocol0 = pnl * HALF + wc * 32 + 8 * fq, bcol0 = u.pn * BM + wc * 32 + 8 * fq;
        f32x4 bv[2][2];
#pragma unroll
        for (int bj = 0; bj < 2; ++bj)
#pragma unroll
            for (int n = 0; n < 2; ++n) bv[bj][n] = *(const f32x4*)(bias + bcol0 + bj * HALF + 4 * n);
#pragma unroll
        for (int ai = 0; ai < 2; ++ai)
#pragma unroll
            for (int m = 0; m < 4; ++m) { bf16_t* rowp = O + (size_t)(row0 + ai * HALF + m * 16) * 1024 + ocol0;
                float o[8];
#pragma unroll
                for (int n = 0; n < 2; ++n) { const f32x4 a = acc[ai][0][m][n] + bv[0][n], g = acc[ai][1][m][n] + bv[1][n];
#pragma unroll
                    for (int e = 0; e < 4; ++e) {
                        if (MODE == 0) { o[4 * n + e] = a[e] * (1.f / (1.f + __expf(-g[e]))); }
                        else { const float gt = fminf(a[e], 7.0f), up = fminf(fmaxf(g[e], -7.0f), 7.0f); o[4 * n + e] = (up + 1.0f) * gt * (1.f / (1.f + __expf(-1.702f * gt))); } } }
                u32x4 w; w.x = cvt_pk_bf16(o[0], o[1]); w.y = cvt_pk_bf16(o[2], o[3]); w.z = cvt_pk_bf16(o[4], o[5]); w.w = cvt_pk_bf16(o[6], o[7]);
                *(u32x4*)rowp = w; }
    }
};
struct EpiDown {
    static constexpr bool PERM = true, AFTER_DRAIN = false;
    bf16_t* Y; const float* bias; const float* row_w; const int* row_dst;
    __device__ __forceinline__ void operator()(const f32x4 (&acc)[2][2][4][2], const Unit& u, int wr, int wc, int fr, int fq) const {
        const int row0 = u.pm * BM + wr * 64 + fr, pnl = u.pn & 3, ocol0 = pnl * BM + wc * 32 + 8 * fq, bcol0 = u.pn * BM + wc * 32 + 8 * fq;
        f32x4 bv[2][2];
#pragma unroll
        for (int bj = 0; bj < 2; ++bj)
#pragma unroll
            for (int n = 0; n < 2; ++n) bv[bj][n] = *(const f32x4*)(bias + bcol0 + bj * HALF + 4 * n);
#pragma unroll
        for (int ai = 0; ai < 2; ++ai)
#pragma unroll
            for (int m = 0; m < 4; ++m) { const int r = row0 + ai * HALF + m * 16; const int dst = row_dst[r]; const float w8 = row_w[r];
                if (dst >= 0) { bf16_t* rowp = Y + (size_t)dst * 1024 + ocol0;
#pragma unroll
                    for (int bj = 0; bj < 2; ++bj) { const f32x4 v0 = (acc[ai][bj][m][0] + bv[bj][0]) * w8, v1 = (acc[ai][bj][m][1] + bv[bj][1]) * w8;
                        u32x4 w; w.x = cvt_pk_bf16(v0[0], v0[1]); w.y = cvt_pk_bf16(v0[2], v0[3]); w.z = cvt_pk_bf16(v1[0], v1[1]); w.w = cvt_pk_bf16(v1[2], v1[3]);
                        *(u32x4*)(rowp + bj * HALF) = w; } } }
    }
};
}

namespace att {
using bf16x8 = __attribute__((ext_vector_type(8))) short;
using s16x4  = __attribute__((ext_vector_type(4))) short;
using f32x16 = __attribute__((ext_vector_type(16))) float;
using u32x4  = __attribute__((ext_vector_type(4))) unsigned;
constexpr int NW = 8, QBLK = 32, KVBLK = 64;
constexpr float SCALE = 0.10206207261596575f;
constexpr float THR = 8.f;
constexpr int SHM_V = 16384, SHM_K = 16384, SHM_ATTN = 2 * SHM_V + 2 * SHM_K + NW * 64 * 4;
#define KSWZ(row, colB) ((row) * 256 + ((colB) ^ (((row) & 7) << 4)))
#define SBAR() __builtin_amdgcn_sched_barrier(0)
__device__ __forceinline__ int crow(int r, int hi) { return (r & 3) + 8 * (r >> 2) + 4 * hi; }
__device__ __forceinline__ unsigned cvtpk(float lo, float hi) { unsigned r; asm volatile("v_cvt_pk_bf16_f32 %0, %1, %2" : "=v"(r) : "v"(lo), "v"(hi)); return r; }

__device__ __forceinline__ void partialSM(f32x16& p0, f32x16& p1, float& m_reg, float& mn, float& alpha) {
  constexpr float C = SCALE * 1.4426950408889634f;
  float pmax = p0[0];
#pragma unroll
  for (int r = 1; r < 16; ++r) pmax = fmaxf(pmax, p0[r]);
#pragma unroll
  for (int r = 0; r < 16; ++r) pmax = fmaxf(pmax, p1[r]);
  { auto rr = __builtin_amdgcn_permlane32_swap(__float_as_uint(pmax), __float_as_uint(pmax), false, false);
    pmax = fmaxf(__uint_as_float(rr[0]), __uint_as_float(rr[1])); }
  if (__builtin_expect(__all(pmax - m_reg <= THR / SCALE), 1)) { mn = m_reg; alpha = 1.f; }
  else { mn = fmaxf(m_reg, pmax); alpha = __builtin_amdgcn_exp2f((m_reg - mn) * C); m_reg = mn; }
  float mnC = -mn * C;
#pragma unroll
  for (int r = 0; r < 16; ++r) p0[r] = fmaf(p0[r], C, mnC);
#pragma unroll
  for (int r = 0; r < 16; ++r) p1[r] = fmaf(p1[r], C, mnC);
#pragma unroll
  for (int r = 0; r < 16; ++r) p0[r] = __builtin_amdgcn_exp2f(p0[r]);
}
__device__ __forceinline__ void finishSM(f32x16& p0, f32x16& p1, float alpha, float& l_reg, bf16x8& pa0, bf16x8& pa1, bf16x8& pa2, bf16x8& pa3) {
#pragma unroll
  for (int r = 0; r < 16; ++r) p1[r] = __builtin_amdgcn_exp2f(p1[r]);
  float ps = 0;
#pragma unroll
  for (int r = 0; r < 16; ++r) ps += p0[r];
#pragma unroll
  for (int r = 0; r < 16; ++r) ps += p1[r];
  { auto rr = __builtin_amdgcn_permlane32_swap(__float_as_uint(ps), __float_as_uint(ps), false, false);
    ps = __uint_as_float(rr[0]) + __uint_as_float(rr[1]); }
  l_reg = l_reg * alpha + ps;
#define PK4(P, BASE, OUT) do { unsigned a0 = cvtpk(P[BASE + 0], P[BASE + 1]), a1 = cvtpk(P[BASE + 2], P[BASE + 3]);   \
    unsigned b0 = cvtpk(P[BASE + 4], P[BASE + 5]), b1 = cvtpk(P[BASE + 6], P[BASE + 7]);                              \
    auto r0 = __builtin_amdgcn_permlane32_swap(a0, b0, false, false); auto r1 = __builtin_amdgcn_permlane32_swap(a1, b1, false, false); \
    u32x4 w = {r0[0], r1[0], r0[1], r1[1]}; OUT = *reinterpret_cast<bf16x8*>(&w); } while (0)
  PK4(p0, 0, pa0); PK4(p0, 8, pa1); PK4(p1, 0, pa2); PK4(p1, 8, pa3);
#undef PK4
}
__device__ __forceinline__ void qkt(f32x16& p0, f32x16& p1, const bf16* Ks, const bf16x8* qr, int r32, int hi) {
  p0 = f32x16{}; p1 = f32x16{};
#pragma unroll
  for (int d0 = 0; d0 < 6; ++d0) { int cb = (d0 * 16 + hi * 8) * 2;
    bf16x8 b0 = *reinterpret_cast<const bf16x8*>((const char*)Ks + KSWZ(r32, cb));
    bf16x8 b1 = *reinterpret_cast<const bf16x8*>((const char*)Ks + KSWZ(32 + r32, cb));
    p0 = __builtin_amdgcn_mfma_f32_32x32x16_bf16(b0, qr[d0], p0, 0, 0, 0);
    p1 = __builtin_amdgcn_mfma_f32_32x32x16_bf16(b1, qr[d0], p1, 0, 0, 0); }
}
__device__ __forceinline__ int v_st(int k, int c) { const int kk = (k & ~0xC) | ((k & 4) << 1) | ((k & 8) >> 1); return ((kk >> 3) * 4 + (c >> 5)) * 512 + ((kk & 7) * 32 + (c & 31)) * 2; }
__device__ __forceinline__ int v_rd_base(int lane) { return ((lane & 3) << 3) | (((lane >> 2) & 3) << 6) | (((lane >> 4) & 1) << 5) | (((lane >> 5) & 1) << 8); }
constexpr int v_rd_off(int d0, int ks, int half) { return d0 * 512 + ks * 4096 + half * 2048; }
template <int OFF> __device__ __forceinline__ s16x4 tr_read(int vb) {
  s16x4 r; asm volatile("ds_read_b64_tr_b16 %0, %1 offset:%2" : "=&v"(r) : "v"(vb), "i"(OFF) : "memory"); return r;
}
template <int D0> __device__ __forceinline__ void pv_one(f32x16& od, int vb, bf16x8 pa0, bf16x8 pa1, bf16x8 pa2, bf16x8 pa3) {
  const s16x4 l0 = tr_read<v_rd_off(D0, 0, 0)>(vb), h0 = tr_read<v_rd_off(D0, 0, 1)>(vb), l1 = tr_read<v_rd_off(D0, 1, 0)>(vb), h1 = tr_read<v_rd_off(D0, 1, 1)>(vb);
  const s16x4 l2 = tr_read<v_rd_off(D0, 2, 0)>(vb), h2 = tr_read<v_rd_off(D0, 2, 1)>(vb), l3 = tr_read<v_rd_off(D0, 3, 0)>(vb), h3 = tr_read<v_rd_off(D0, 3, 1)>(vb);
  asm volatile("s_waitcnt lgkmcnt(0)" ::: "memory"); SBAR();
#define PK(L, H) (bf16x8){L[0], L[1], L[2], L[3], H[0], H[1], H[2], H[3]}
  od = __builtin_amdgcn_mfma_f32_32x32x16_bf16(pa0, PK(l0, h0), od, 0, 0, 0);
  od = __builtin_amdgcn_mfma_f32_32x32x16_bf16(pa1, PK(l1, h1), od, 0, 0, 0);
  od = __builtin_amdgcn_mfma_f32_32x32x16_bf16(pa2, PK(l2, h2), od, 0, 0, 0);
  od = __builtin_amdgcn_mfma_f32_32x32x16_bf16(pa3, PK(l3, h3), od, 0, 0, 0);
#undef PK
}
__device__ __forceinline__ void pv_d0(f32x16* o, int vb, bf16x8 pa0, bf16x8 pa1, bf16x8 pa2, bf16x8 pa3) {
  pv_one<0>(o[0], vb, pa0, pa1, pa2, pa3); pv_one<1>(o[1], vb, pa0, pa1, pa2, pa3);
}
__device__ __forceinline__ bf16x8 rope8(bf16x8 x, const float* tab, int pbase) {
  u32x4 w;
#pragma unroll
  for (int i = 0; i < 4; ++i) { const float x1 = __uint_as_float(((unsigned)(unsigned short)x[2 * i]) << 16), x2 = __uint_as_float(((unsigned)(unsigned short)x[2 * i + 1]) << 16);
    const float cs = tab[pbase + i], sn = tab[16 + pbase + i]; w[i] = cvtpk(x1 * cs - x2 * sn, x1 * sn + x2 * cs); }
  return *reinterpret_cast<bf16x8*>(&w);
}
__device__ __forceinline__ void attn_unit(const bf16* __restrict__ Qb, const bf16* __restrict__ KVb, const bf16* __restrict__ KRb, bf16* __restrict__ Ob,
                                          const float* __restrict__ rope, int seq, char* lds) {
  int tid_l = threadIdx.x; asm volatile("" : "+v"(tid_l));
  const int tid = tid_l, wid = tid >> 6, lane = tid & 63, r32 = lane & 31, hi = lane >> 5;
  bf16* V_lds = (bf16*)lds; bf16* K_lds = (bf16*)(lds + 2 * SHM_V);
  float* ws = (float*)(lds + 2 * SHM_V + 2 * SHM_K) + wid * 64; float* li_l = ws; float* al_l = ws + 32;
  float m_reg = -1e30f, l_reg = 0; f32x16 o[2] = {}; bf16x8 qr[6];
  const bf16* Qw = Qb + (long)(wid * QBLK + r32) * 768 + hi * 8;
#pragma unroll
  for (int d0 = 0; d0 < 6; ++d0) qr[d0] = *reinterpret_cast<const bf16x8*>(Qw + d0 * 16);
  if (rope) { const float* tab = rope + (long)(wid * QBLK + r32) * 32; qr[4] = rope8(qr[4], tab, 4 * hi); qr[5] = rope8(qr[5], tab, 8 + 4 * hi); }
  const int sr = tid >> 4, ch = tid & 15;
  const bf16* kbase = ch < 8 ? KVb + ch * 8 : KRb + ((ch - 8) & 3) * 8; const long kstr = ch < 8 ? 1024 : 32;
  const int vkey = tid >> 3, vc8 = (tid & 7) * 8, vst0 = v_st(vkey, vc8);
  const bf16* vbase = KVb + 512 + vc8;
  const int vb0 = (int)(uintptr_t)V_lds + v_rd_base(lane);
  struct { bf16x8 vs0, ks0, ks1; } sr_[2];
#define SLOAD(i, k0) do { sr_[i].vs0 = *reinterpret_cast<const bf16x8*>(vbase + (long)((k0) + vkey) * 1024); \
    sr_[i].ks0 = *reinterpret_cast<const bf16x8*>(kbase + (long)((k0) + sr) * kstr); sr_[i].ks1 = *reinterpret_cast<const bf16x8*>(kbase + (long)((k0) + 32 + sr) * kstr); } while (0)
#define SWRITE(b, i) do { *(bf16x8*)((char*)V_lds + (b) * SHM_V + vst0) = sr_[i].vs0; int kc = ch * 16;               \
    *(bf16x8*)((char*)K_lds + (b) * SHM_K + KSWZ(sr, kc)) = sr_[i].ks0;                       \
    *(bf16x8*)((char*)K_lds + (b) * SHM_K + KSWZ(32 + sr, kc)) = sr_[i].ks1; } while (0)
#define SWAIT() asm volatile("s_waitcnt vmcnt(3)" ::: "memory")
#define RESC(a) do { if (__any((a) < 1.f)) { if (hi == 0) al_l[r32] = (a); asm volatile("s_waitcnt lgkmcnt(0)" ::: "memory"); \
    _Pragma("unroll") for (int d = 0; d < 2; ++d) _Pragma("unroll") for (int r = 0; r < 16; ++r) o[d][r] *= al_l[crow(r, hi)]; } } while (0)
  f32x16 pA0, pA1, pB0, pB1; float mnA, mnB, alA, alB; bf16x8 pa0, pa1, pa2, pa3; const int NT = seq / KVBLK;
  constexpr int SE = 0, SO = 1;
  SLOAD(SE, 0); asm volatile("s_waitcnt vmcnt(0)" ::: "memory"); SWRITE(0, SE); __syncthreads();
  qkt(pA0, pA1, K_lds, qr, r32, hi); partialSM(pA0, pA1, m_reg, mnA, alA);
  SLOAD(SO, KVBLK); if (2 < NT) SLOAD(SE, 2 * KVBLK);
  SWAIT(); SWRITE(1, SO); __syncthreads();
  for (int j = 1; j + 1 < NT; j += 2) {
    SBAR(); qkt(pB0, pB1, (bf16*)((char*)K_lds + SHM_K), qr, r32, hi);
    finishSM(pA0, pA1, alA, l_reg, pa0, pa1, pa2, pa3); SBAR();
    SLOAD(SO, (j + 2) * KVBLK); SBAR();
    pv_d0(o, vb0, pa0, pa1, pa2, pa3); partialSM(pB0, pB1, m_reg, mnB, alB);
    __syncthreads(); SWAIT(); SWRITE(0, SE);
    RESC(alB); __syncthreads();
    SBAR(); qkt(pA0, pA1, K_lds, qr, r32, hi);
    finishSM(pB0, pB1, alB, l_reg, pa0, pa1, pa2, pa3); SBAR();
    if (j + 3 < NT) SLOAD(SE, (j + 3) * KVBLK); SBAR();
    pv_d0(o, vb0 + (int)SHM_V, pa0, pa1, pa2, pa3); partialSM(pA0, pA1, m_reg, mnA, alA);
    __syncthreads(); SWAIT(); SWRITE(1, SO);
    RESC(alA); __syncthreads();
  }
  SBAR(); qkt(pB0, pB1, (bf16*)((char*)K_lds + SHM_K), qr, r32, hi);
  finishSM(pA0, pA1, alA, l_reg, pa0, pa1, pa2, pa3); SBAR();
  pv_d0(o, vb0, pa0, pa1, pa2, pa3); partialSM(pB0, pB1, m_reg, mnB, alB);
  __syncthreads(); RESC(alB);
  finishSM(pB0, pB1, alB, l_reg, pa0, pa1, pa2, pa3); SBAR();
  pv_d0(o, vb0 + (int)SHM_V, pa0, pa1, pa2, pa3);
  if (hi == 0) li_l[r32] = l_reg; asm volatile("s_waitcnt lgkmcnt(0)" ::: "memory");
  float rli[16];
#pragma unroll
  for (int r = 0; r < 16; ++r) rli[r] = __builtin_amdgcn_rcpf(li_l[crow(r, hi)]);
  bf16* Ow = Ob + (long)(wid * QBLK) * 1024;
#pragma unroll
  for (int r = 0; r < 16; ++r) { int orow = crow(r, hi);
#pragma unroll
    for (int d0 = 0; d0 < 2; ++d0) { const float v = o[d0][r] * rli[r]; Ow[(long)orow * 1024 + d0 * 32 + r32] = (bf16)(cvtpk(v, v) & 0xffffu); } }
#undef SLOAD
#undef SWRITE
#undef SWAIT
#undef RESC
}
}

struct Args { const float* in[33]; float* out; unsigned char* ws; int ph_lo, ph_hi; };
enum { I_X = 0, I_C, I_CTX, I_CCTX, I_MODW, I_MODB, I_LN1G, I_LN1B, I_LN2G, I_LN2B, I_WIN, I_QNORM, I_KVNORM, I_WUQ, I_WUK, I_WUV, I_LBL, I_HGNORM, I_WOUT,
       I_PW1W, I_PW1B, I_DWW, I_DWB, I_CLNG, I_CLNB, I_PW2W, I_PW2B, I_RW, I_RB, I_WGU, I_BGU, I_WDN, I_BDN };

__device__ __forceinline__ int dst_row(int n, int mode, int row_off) {
    if (mode == 0) return row_off + n;
    int f, g; if (mode == 1) { f = n >> 1; g = n & 1; } else { g = n >> 10; f = n & 1023; }
    return row_off + 256 * (f >> 7) + 128 * g + (f & 127);
}
__device__ __forceinline__ void tr_item(const float* __restrict__ W, int K, int N, bf16* __restrict__ WT, int mode, int row_off, LAS float* scr, int item, int lane) {
    const int nblk = (N + 63) >> 6, kb = item / nblk, nb = item - kb * nblk, k0 = 64 * kb, n0 = 64 * nb;
    const int nc = n0 + 4 * (lane & 15), kr = lane >> 4;
    f32x4 v[16];
#pragma unroll
    for (int i = 0; i < 16; ++i) v[i] = (nc < N) ? *(const f32x4*)(W + (size_t)(k0 + 4 * i + kr) * N + nc) : (f32x4){0.f, 0.f, 0.f, 0.f};
#pragma unroll
    for (int i = 0; i < 16; ++i) { LAS float* s = scr + (4 * i + kr) * 65 + 4 * (lane & 15); s[0] = v[i][0]; s[1] = v[i][1]; s[2] = v[i][2]; s[3] = v[i][3]; }
    LDS_WAIT();
    const int c = lane & 7;
#pragma unroll
    for (int j = 0; j < 8; ++j) { const int nl = (lane >> 3) + 8 * j, n = n0 + nl; const LAS float* s = scr + (8 * c) * 65 + nl;
        v4u o; o.x = pk2(s[0 * 65], s[1 * 65]); o.y = pk2(s[2 * 65], s[3 * 65]); o.z = pk2(s[4 * 65], s[5 * 65]); o.w = pk2(s[6 * 65], s[7 * 65]);
        if (n < N) *(v4u*)(WT + (size_t)dst_row(n, mode, row_off) * K + k0 + 8 * c) = o; }
    LDS_WAIT();
}
__device__ __forceinline__ void phase_prologue(const Args& a, LAS unsigned char* lds, int tid, int lane, int wave) {
    unsigned char* ws = a.ws;
    const int G = gridDim.x, B = blockIdx.x;
    {
        LAS float* sc = (LAS float*)lds;
        LAS float* red = (LAS float*)(lds + 36864);
        float* modv = (float*)(ws + WS_MODV);
        bool have = false;
        for (int it = B; it < 192; it += G) {
            if (!have) { for (int i = tid; i < 9 * 1024; i += NTHR) { const int r = i >> 10, k = i & 1023; const float x = r < 8 ? a.in[I_C][r * 1024 + k] : a.in[I_CCTX][k]; sc[i] = x * sigm(x); } __syncthreads(); have = true; }
            const int l = it / 96, jc = it % 96, kg = tid >> 6, jj = tid & 63, j = jc * 64 + jj;
            float acc[9];
#pragma unroll
            for (int r = 0; r < 9; ++r) acc[r] = 0.f;
            const float* wp = a.in[I_MODW] + ((size_t)l * 1024 + kg * 128) * 6144 + j;
            for (int k = 0; k < 128; ++k) { const float w = wp[(size_t)k * 6144];
#pragma unroll
                for (int r = 0; r < 9; ++r) acc[r] += sc[r * 1024 + kg * 128 + k] * w; }
#pragma unroll
            for (int r = 0; r < 9; ++r) red[(kg * 9 + r) * 64 + jj] = acc[r];
            __syncthreads();
            for (int i = tid; i < 576; i += NTHR) { const int r = i >> 6, j2 = i & 63; float s = a.in[I_MODB][l * 6144 + jc * 64 + j2];
#pragma unroll
                for (int g = 0; g < 8; ++g) s += red[(g * 9 + r) * 64 + j2];
                modv[((size_t)l * 9 + r) * 6144 + jc * 64 + j2] = s; }
            __syncthreads();
        }
        __syncthreads();
    }
    const int gw = B * NWAVES + wave, NGW = G * NWAVES, gt = B * NTHR + tid, NGT = G * NTHR;
    { float* rope = (float*)(ws + WS_ROPE);
      for (int i = gt; i < 4096 * 16; i += NGT) { const int t = i >> 4, p = i & 15; const float pos = (float)(p < 8 ? (t >> 6) : (t & 63));
          const float inv = __powf(10000.0f, -(float)(p & 7) * 0.125f); const float ang = pos * inv; rope[t * 32 + p] = cosf(ang); rope[t * 32 + 16 + p] = sinf(ang); }
      float* bgu = (float*)(ws + WS_BGU);
      for (int i = gt; i < 2 * 32 * 2048; i += NGT) { const int le = i >> 11, np = i & 2047, q = np >> 8, g = (np >> 7) & 1, r = np & 127, f = 128 * q + r; bgu[i] = a.in[I_BGU][(size_t)le * 2048 + 2 * f + g]; }
      float* pb = (float*)(ws + WS_PW1B);
      for (int i = gt; i < 2048; i += NGT) { const int q = i >> 8, g = (i >> 7) & 1, r = i & 127, f = 128 * q + r; pb[i] = a.in[I_PW1B][g * 1024 + f]; }
      v4u* zp = (v4u*)(ws + WS_WIN + (size_t)3232 * 1024 * 2);
      for (int i = gt; i < 96 * 1024 * 2 / 16; i += NGT) zp[i] = (v4u){0u, 0u, 0u, 0u};
    }
    LAS float* scr = (LAS float*)(lds + wave * 16640);
    constexpr int I0 = 16 * 51, I1 = 6 * 12, I2 = 4 * 8, I3 = 4 * 8, I4 = 256, I5 = 512, I6 = 256, SMALL = I0 + I1 + I2 + I3 + I4 + I5 + I6;
    constexpr int NGU = 64 * 512, NDN = 64 * 256, NITEMS = SMALL + NGU + NDN;
    for (int it = gw; it < NITEMS; it += NGW) {
        int r = it;
        if (r < NGU) { const int mi = r >> 9; tr_item(a.in[I_WGU] + (size_t)mi * 1024 * 2048, 1024, 2048, (bf16*)(ws + WS_WGU) + (size_t)mi * 2048 * 1024, 1, 0, scr, r & 511, lane); continue; } r -= NGU;
        if (r < NDN) { const int mi = r >> 8; tr_item(a.in[I_WDN] + (size_t)mi * 1024 * 1024, 1024, 1024, (bf16*)(ws + WS_WDN) + (size_t)mi * 1024 * 1024, 0, 0, scr, r & 255, lane); continue; } r -= NDN;
        if (r < I0) { tr_item(a.in[I_WIN], 1024, 3232, (bf16*)(ws + WS_WIN), 0, 0, scr, r, lane); continue; } r -= I0;
        if (r < I1) { tr_item(a.in[I_WUQ], 384, 768, (bf16*)(ws + WS_WUQ), 0, 0, scr, r, lane); continue; } r -= I1;
        if (r < I2) { tr_item(a.in[I_WUK], 256, 512, (bf16*)(ws + WS_WUKV), 0, 0, scr, r, lane); continue; } r -= I2;
        if (r < I3) { tr_item(a.in[I_WUV], 256, 512, (bf16*)(ws + WS_WUKV), 0, 512, scr, r, lane); continue; } r -= I3;
        if (r < I4) { tr_item(a.in[I_WOUT], 1024, 1024, (bf16*)(ws + WS_WOUT), 0, 0, scr, r, lane); continue; } r -= I4;
        if (r < I5) { tr_item(a.in[I_PW1W], 1024, 2048, (bf16*)(ws + WS_WPW1), 2, 0, scr, r, lane); continue; } r -= I5;
        tr_item(a.in[I_PW2W], 1024, 1024, (bf16*)(ws + WS_WPW2), 0, 0, scr, r, lane);
    }
}

__device__ __forceinline__ void phase_mod0(const Args& a, int lane, int wave) {
    const int gw = blockIdx.x * NWAVES + wave, NGW = gridDim.x * NWAVES;
    const float* modv = (const float*)(a.ws + WS_MODV);
    bf16* X = (bf16*)(a.ws + WS_X);
    for (int r = gw; r < NTOK; r += NGW) {
        const int b = r / TPB, p = r - b * TPB;
        const float* src = p < CTXL ? a.in[I_CTX] + ((size_t)b * CTXL + p) * 1024 : a.in[I_X] + ((size_t)b * SEQ + (p - CTXL)) * 1024;
        const float* mv = modv + (size_t)(p < CTXL ? 8 : b) * 6144;
#pragma unroll
        for (int j = 0; j < 4; ++j) { const int c = 4 * (lane + 64 * j); const f32x4 xv = *(const f32x4*)(src + c), sh = *(const f32x4*)(mv + c), sc = *(const f32x4*)(mv + 1024 + c);
            const f32x4 y = xv * (sc + 1.0f) + sh; v2u o; o.x = pk2(y[0], y[1]); o.y = pk2(y[2], y[3]); *(v2u*)(X + (size_t)r * 1024 + c) = o; }
    }
}

__device__ __forceinline__ void phase_norm0(const Args& a, int lane, int wave) {
    const int gw = blockIdx.x * NWAVES + wave, NGW = gridDim.x * NWAVES;
    const bf16* Z = (const bf16*)(a.ws + WS_Z); bf16* CQN = (bf16*)(a.ws + WS_CQN); bf16* CKVN = (bf16*)(a.ws + WS_CKVN); bf16* KRR = (bf16*)(a.ws + WS_KRR);
    const float* rope = (const float*)(a.ws + WS_ROPE);
    float gq[8], gk[8];
#pragma unroll
    for (int i = 0; i < 8; ++i) { gq[i] = lane < 48 ? a.in[I_QNORM][8 * lane + i] : 0.f; gk[i] = lane < 32 ? a.in[I_KVNORM][8 * lane + i] : 0.f; }
    for (int r = gw; r < NTOK; r += NGW) {
        const bf16* z = Z + (size_t)r * ZC; const int p = r % TPB;
        bf16x8 q8 = {}, k8 = {}, r8 = {};
        if (lane < 48) q8 = *(const bf16x8*)(z + ZQ + 8 * lane);
        if (lane < 32) k8 = *(const bf16x8*)(z + ZKV + 8 * lane);
        if (lane < 4) r8 = *(const bf16x8*)(z + ZKR + 8 * lane);
        float qf[8], kf[8], sq = 0.f, sk = 0.f;
#pragma unroll
        for (int i = 0; i < 8; ++i) { qf[i] = bf2f((unsigned short)q8[i]); kf[i] = bf2f((unsigned short)k8[i]); sq += qf[i] * qf[i]; sk += kf[i] * kf[i]; }
        sq = wave_sum(sq); sk = wave_sum(sk);
        const float rq = rsqrtf(sq * (1.f / 384.f) + RMS_EPS), rk = rsqrtf(sk * (1.f / 256.f) + RMS_EPS);
        if (lane < 48) { v4u o; o.x = pk2(qf[0] * rq * gq[0], qf[1] * rq * gq[1]); o.y = pk2(qf[2] * rq * gq[2], qf[3] * rq * gq[3]); o.z = pk2(qf[4] * rq * gq[4], qf[5] * rq * gq[5]); o.w = pk2(qf[6] * rq * gq[6], qf[7] * rq * gq[7]);
            *(v4u*)(CQN + (size_t)r * 384 + 8 * lane) = o; }
        if (lane < 32) { v4u o; o.x = pk2(kf[0] * rk * gk[0], kf[1] * rk * gk[1]); o.y = pk2(kf[2] * rk * gk[2], kf[3] * rk * gk[3]); o.z = pk2(kf[4] * rk * gk[4], kf[5] * rk * gk[5]); o.w = pk2(kf[6] * rk * gk[6], kf[7] * rk * gk[7]);
            *(v4u*)(CKVN + (size_t)r * 256 + 8 * lane) = o; }
        if (lane < 4) { bf16x8 o8 = r8; if (p >= CTXL) o8 = att::rope8(r8, rope + (size_t)(p - CTXL) * 32, 4 * lane); *(bf16x8*)(KRR + (size_t)r * 32 + 8 * lane) = o8; }
    }
}

__device__ __forceinline__ void hgrn_unit(const Args& a, int unit, LAS unsigned char* lds, int tid) {
    const int b = unit >> 5, head = (unit >> 3) & 3, dir = (unit >> 2) & 1, sl = unit & 3;
    const bf16* Z = (const bf16*)(a.ws + WS_Z);
    float* Od = (float*)(a.ws + (dir ? WS_OB : WS_OF));
    LAS float* lbv = (LAS float*)lds;
    constexpr int BUF0 = 1024, BUFSZ = 28672, OFF_Q = 16384, OFF_V = 24576;
    if (tid < 128) { const int c = head * 128 + tid; const float l0 = a.in[I_LBL][c], l1 = a.in[I_LBL][512 + c], l2 = a.in[I_LBL][1024 + c]; const float m = fmaxf(l0, fmaxf(l1, l2));
        const float e0 = __expf(l0 - m), e1 = __expf(l1 - m), e2 = __expf(l2 - m); lbv[tid] = e0 / (e0 + e1 + e2); }
    __syncthreads();
    const int lt = tid >> 4, lcg = tid & 15;
    float lb8[8];
#pragma unroll
    for (int i = 0; i < 8; ++i) lb8[i] = lbv[8 * lcg + i];
    const int fcol = (dir ? ZHB : ZHF) + head * 128 + 8 * lcg, qcol = ZHQ + head * 128 + 8 * lcg;
    const int vt = tid >> 2, vcol = ZHI + head * 128 + sl * 32 + (tid & 3) * 8;
    const int wave = tid >> 6, lane = tid & 63, vv = lane >> 4, cg = lane & 15, vloc = wave * 4 + vv;
    const size_t zb = (size_t)b * TPB;
    bf16x8 rq, rf, rv;
#define TOKP(n) (dir ? ((n) < CTXL ? (CTXL - 1 - (n)) : (TPB + CTXL - 1 - (n))) : (n))
#define HG_LOAD(i) do { const int n_ = 32 * (i) + lt; const bf16* zr_ = Z + (zb + TOKP(n_)) * ZC; rq = *(const bf16x8*)(zr_ + qcol); rf = *(const bf16x8*)(zr_ + fcol); \
        if (tid < 128) { const int n2_ = 32 * (i) + vt; rv = *(const bf16x8*)(Z + (zb + TOKP(n2_)) * ZC + vcol); } } while (0)
#define HG_WRITE(bufi) do { LAS unsigned char* bp_ = lds + BUF0 + (bufi) * BUFSZ; float f_[8]; \
        _Pragma("unroll") for (int i_ = 0; i_ < 8; ++i_) f_[i_] = lb8[i_] + (1.f - lb8[i_]) * sigm(bf2f((unsigned short)rf[i_])); \
        *(LAS f32x4*)(bp_ + ((lt * 128 + lcg * 4) * 4)) = (f32x4){f_[0], f_[1], f_[2], f_[3]}; *(LAS f32x4*)(bp_ + ((lt * 128 + 64 + lcg * 4) * 4)) = (f32x4){f_[4], f_[5], f_[6], f_[7]}; \
        *(LAS bf16x8*)(bp_ + OFF_Q + (lt * 128 + lcg * 8) * 2) = rq; \
        if (tid < 128) { float v_[8]; _Pragma("unroll") for (int i_ = 0; i_ < 8; ++i_) v_[i_] = bf2f((unsigned short)rv[i_]); \
            *(LAS f32x4*)(bp_ + OFF_V + (vt * 32 + (tid & 3) * 8) * 4) = (f32x4){v_[0], v_[1], v_[2], v_[3]}; *(LAS f32x4*)(bp_ + OFF_V + (vt * 32 + (tid & 3) * 8 + 4) * 4) = (f32x4){v_[4], v_[5], v_[6], v_[7]}; } } while (0)
    float S[8];
#pragma unroll
    for (int j = 0; j < 8; ++j) S[j] = 0.f;
    HG_LOAD(0); HG_WRITE(0); __syncthreads();
    const bool b3 = (cg & 8) != 0, b2 = (cg & 4) != 0, b1 = (cg & 2) != 0, b0 = (cg & 1) != 0;
    for (int i = 0; i < TPB / 32; ++i) {
        if (i + 1 < TPB / 32) HG_LOAD(i + 1);
        const LAS unsigned char* bp = lds + BUF0 + (i & 1) * BUFSZ;
#pragma unroll 1
        for (int g = 0; g < 4; ++g) {
            const LAS unsigned char* gp = bp + g * 8 * 512;
            float ot[8];
#pragma unroll
            for (int t = 0; t < 8; ++t) {
                const f32x4 f0 = *(const LAS f32x4*)(gp + ((t * 128 + cg * 4) * 4)), f1 = *(const LAS f32x4*)(gp + ((t * 128 + 64 + cg * 4) * 4));
                const bf16x8 q8 = *(const LAS bf16x8*)(bp + OFF_Q + ((g * 8 + t) * 128 + cg * 8) * 2);
                const float v = *(const LAS float*)(bp + OFF_V + ((g * 8 + t) * 32 + vloc) * 4);
                float acc = 0.f;
#pragma unroll
                for (int j = 0; j < 8; ++j) { const float fj = j < 4 ? f0[j] : f1[j - 4]; const float qj = bf2f((unsigned short)q8[j]);
                    const float kv = fmaf(-fj, v, v); S[j] = fmaf(fj, S[j], kv); acc = fmaf(S[j], qj, acc); }
                ot[t] = acc;
            }
#pragma unroll
            for (int k = 0; k < 4; ++k) { const float snd = b3 ? ot[k] : ot[k + 4]; const float rcv = __shfl_xor(snd, 8); ot[k] = (b3 ? ot[k + 4] : ot[k]) + rcv; }
#pragma unroll
            for (int k = 0; k < 2; ++k) { const float snd = b2 ? ot[k] : ot[k + 2]; const float rcv = __shfl_xor(snd, 4); ot[k] = (b2 ? ot[k + 2] : ot[k]) + rcv; }
            { const float snd = b1 ? ot[0] : ot[1]; const float rcv = __shfl_xor(snd, 2); ot[0] = (b1 ? ot[1] : ot[0]) + rcv; }
            ot[0] += __shfl_xor(ot[0], 1);
            if (!b0) { const int n = 32 * i + 8 * g + (cg >> 1); const int p = TOKP(n); if (p >= CTXL) Od[(zb + p) * 512 + head * 128 + sl * 32 + vloc] = ot[0]; }
        }
        if (i + 1 < TPB / 32) HG_WRITE((i + 1) & 1);
        __syncthreads();
    }
#undef TOKP
#undef HG_LOAD
#undef HG_WRITE
}

__device__ __forceinline__ void phase_readout(const Args& a, int lane, int wave) {
    const int gw = blockIdx.x * NWAVES + wave, NGW = gridDim.x * NWAVES;
    const float* OF = (const float*)(a.ws + WS_OF); const float* OB = (const float*)(a.ws + WS_OB);
    const bf16* Z = (const bf16*)(a.ws + WS_Z); bf16* MIX = (bf16*)(a.ws + WS_Y);
    float hn[8];
#pragma unroll
    for (int i = 0; i < 8; ++i) hn[i] = a.in[I_HGNORM][((8 * lane) & 127) + i];
    for (int lr = gw; lr < NLAT; lr += NGW) {
        const size_t r = (size_t)grow_of(lr);
        const f32x4 a0 = *(const f32x4*)(OF + r * 512 + 8 * lane), a1 = *(const f32x4*)(OF + r * 512 + 8 * lane + 4);
        const f32x4 c0 = *(const f32x4*)(OB + r * 512 + 8 * lane), c1 = *(const f32x4*)(OB + r * 512 + 8 * lane + 4);
        const bf16x8 g8 = *(const bf16x8*)(Z + r * ZC + ZHG + 8 * lane);
        float o[8]; float ss = 0.f;
#pragma unroll
        for (int i = 0; i < 4; ++i) { o[i] = a0[i] + c0[i]; o[4 + i] = a1[i] + c1[i]; }
#pragma unroll
        for (int i = 0; i < 8; ++i) ss += o[i] * o[i];
        ss += __shfl_xor(ss, 1); ss += __shfl_xor(ss, 2); ss += __shfl_xor(ss, 4); ss += __shfl_xor(ss, 8);
        const float rs = rsqrtf(ss * (1.f / 128.f) + RMS_EPS);
        float y[8];
#pragma unroll
        for (int i = 0; i < 8; ++i) { const float g = bf2f((unsigned short)g8[i]); y[i] = o[i] * rs * hn[i] * (g * sigm(g)); }
        v4u w; w.x = pk2(y[0], y[1]); w.y = pk2(y[2], y[3]); w.z = pk2(y[4], y[5]); w.w = pk2(y[6], y[7]);
        *(v4u*)(MIX + r * 1024 + 512 + 8 * lane) = w;
    }
}

__device__ __forceinline__ int rows_per_block() { const int G = gridDim.x; return (((NLAT + G - 1) / G) + 15) & ~15; }
__device__ __forceinline__ void phase_ln1(const Args& a, int l, LAS unsigned char* lds, int tid, int lane, int wave) {
    const int RB = rows_per_block(), lr_base = blockIdx.x * RB;
    float* H = (float*)(a.ws + WS_H); bf16* XB = (bf16*)(a.ws + WS_X);
    const float* modv = (const float*)(a.ws + WS_MODV) + (size_t)l * 9 * 6144;
    const float* lng = a.in[I_LN1G] + l * 1024; const float* lnb = a.in[I_LN1B] + l * 1024;
    const float* rw = a.in[I_RW] + (size_t)l * 1024 * 32; const float* rb = a.in[I_RB] + l * 32;
    int* topi = (int*)(a.ws + WS_TOPI); float* topw = (float*)(a.ws + WS_TOPW);
    LAS float* rwl = (LAS float*)lds;
    LAS float* lgs = (LAS float*)(lds + 131072) + wave * 64;
    LAS int* hist = (LAS int*)(lds + 131072 + 2048);
    for (int i = tid; i < 8192; i += NTHR) { const int k = i >> 3, q = i & 7; *(LAS f32x4*)(rwl + k * 32 + 4 * (q ^ ((k >> 2) & 7))) = *(const f32x4*)(rw + k * 32 + 4 * q); }
    if (tid < 32) hist[tid] = 0;
    __syncthreads();
    const int sw = lane & 7;
    for (int i = 2 * wave; i < RB; i += 16) {
        const int lr0 = lr_base + i; if (lr0 >= NLAT) break;
        float vv[2][16];
#pragma unroll
        for (int rr = 0; rr < 2; ++rr) {
            const int lr = lr0 + rr; const size_t r = (size_t)grow_of(lr); const int b = lr >> 12;
            const float* mv = modv + (size_t)b * 6144;
            f32x4 x[4]; float s = 0.f;
#pragma unroll
            for (int j = 0; j < 4; ++j) { x[j] = *(const f32x4*)(H + r * 1024 + 4 * (lane + 64 * j)); s += (x[j][0] + x[j][1]) + (x[j][2] + x[j][3]); }
            const float mean = wave_sum(s) * (1.f / 1024.f); float s2 = 0.f;
#pragma unroll
            for (int j = 0; j < 4; ++j) { x[j] = x[j] - mean; s2 += (x[j][0] * x[j][0] + x[j][1] * x[j][1]) + (x[j][2] * x[j][2] + x[j][3] * x[j][3]); }
            const float rstd = rsqrtf(wave_sum(s2) * (1.f / 1024.f) + LN_EPS);
#pragma unroll
            for (int j = 0; j < 4; ++j) { const int c = 4 * (lane + 64 * j); const f32x4 g = *(const f32x4*)(lng + c), bb = *(const f32x4*)(lnb + c);
                const f32x4 hv = x[j] * rstd * g + bb; *(f32x4*)(H + r * 1024 + c) = hv;
                const f32x4 sh = *(const f32x4*)(mv + 3 * 1024 + c), sc = *(const f32x4*)(mv + 4 * 1024 + c);
                const f32x4 bm = hv * (sc + 1.0f) + sh; v2u o; o.x = pk2(bm[0], bm[1]); o.y = pk2(bm[2], bm[3]); *(v2u*)(XB + r * 1024 + c) = o;
                vv[rr][4 * j + 0] = bm[0]; vv[rr][4 * j + 1] = bm[1]; vv[rr][4 * j + 2] = bm[2]; vv[rr][4 * j + 3] = bm[3]; }
        }
        float p0[32], p1[32];
#pragma unroll
        for (int e = 0; e < 32; ++e) { p0[e] = 0.f; p1[e] = 0.f; }
#pragma unroll
        for (int j = 0; j < 4; ++j)
#pragma unroll
            for (int e4 = 0; e4 < 4; ++e4) { const int k = 4 * (lane + 64 * j) + e4; const float x0 = vv[0][4 * j + e4], x1 = vv[1][4 * j + e4];
#pragma unroll
                for (int q = 0; q < 8; ++q) { const f32x4 w = *(const LAS f32x4*)(rwl + k * 32 + 4 * (q ^ sw));
#pragma unroll
                    for (int c = 0; c < 4; ++c) { p0[4 * q + c] = fmaf(x0, w[c], p0[4 * q + c]); p1[4 * q + c] = fmaf(x1, w[c], p1[4 * q + c]); } } }
#define RS_STEP(P, NKEEP, BITV, XORV) _Pragma("unroll") for (int k_ = 0; k_ < NKEEP; ++k_) { const float snd_ = (BITV) ? P[k_] : P[k_ + NKEEP]; const float rcv_ = __shfl_xor(snd_, XORV); P[k_] = ((BITV) ? P[k_ + NKEEP] : P[k_]) + rcv_; }
        { const bool c5 = (lane & 32) != 0, c4 = (lane & 16) != 0, c3 = (lane & 8) != 0, c2 = (lane & 4) != 0, c1 = (lane & 2) != 0;
          RS_STEP(p0, 16, c5, 32) RS_STEP(p0, 8, c4, 16) RS_STEP(p0, 4, c3, 8) RS_STEP(p0, 2, c2, 4) RS_STEP(p0, 1, c1, 2)
          RS_STEP(p1, 16, c5, 32) RS_STEP(p1, 8, c4, 16) RS_STEP(p1, 4, c3, 8) RS_STEP(p1, 2, c2, 4) RS_STEP(p1, 1, c1, 2)
          p0[0] += __shfl_xor(p0[0], 1); p1[0] += __shfl_xor(p1[0], 1); }
#undef RS_STEP
        if ((lane & 1) == 0) { lgs[lane >> 1] = p0[0]; lgs[32 + (lane >> 1)] = p1[0]; }
        LDS_WAIT();
#pragma unroll
        for (int rr = 0; rr < 2; ++rr) {
            float lg[32];
#pragma unroll
            for (int q = 0; q < 8; ++q) { const f32x4 t4 = *(const LAS f32x4*)(lgs + rr * 32 + 4 * q); const f32x4 b4 = *(const f32x4*)(rb + 4 * q); lg[4 * q] = t4[0] + b4[0]; lg[4 * q + 1] = t4[1] + b4[1]; lg[4 * q + 2] = t4[2] + b4[2]; lg[4 * q + 3] = t4[3] + b4[3]; }
            unsigned taken = 0u; float tv[4]; int ti[4];
#pragma unroll
            for (int kk = 0; kk < 4; ++kk) { float best = -3.0e38f; int bi = 0;
#pragma unroll
                for (int e = 0; e < 32; ++e) { const bool ok = (lg[e] > best) && !((taken >> e) & 1u); best = ok ? lg[e] : best; bi = ok ? e : bi; }
                taken |= 1u << bi; tv[kk] = best; ti[kk] = bi; }
            const float e1 = __expf(tv[1] - tv[0]), e2 = __expf(tv[2] - tv[0]), e3 = __expf(tv[3] - tv[0]); const float inv = 1.f / (1.f + e1 + e2 + e3);
            if (lane == 0) { const int lr = lr0 + rr;
                *(int4*)(topi + (size_t)lr * 4) = make_int4(ti[0], ti[1], ti[2], ti[3]); *(f32x4*)(topw + (size_t)lr * 4) = (f32x4){inv, e1 * inv, e2 * inv, e3 * inv};
                __hip_atomic_fetch_add(hist + ti[0], 1, __ATOMIC_RELAXED, __HIP_MEMORY_SCOPE_WORKGROUP); __hip_atomic_fetch_add(hist + ti[1], 1, __ATOMIC_RELAXED, __HIP_MEMORY_SCOPE_WORKGROUP);
                __hip_atomic_fetch_add(hist + ti[2], 1, __ATOMIC_RELAXED, __HIP_MEMORY_SCOPE_WORKGROUP); __hip_atomic_fetch_add(hist + ti[3], 1, __ATOMIC_RELAXED, __HIP_MEMORY_SCOPE_WORKGROUP); }
        }
        LDS_WAIT();
    }
    __syncthreads();
    if (tid < 32) ((int*)(a.ws + WS_BCNT))[blockIdx.x * 32 + tid] = hist[tid];
}

__device__ __forceinline__ void phase_place(const Args& a, LAS unsigned char* lds, int tid, int lane, int wave) {
    const int G = gridDim.x, B = blockIdx.x, RB = rows_per_block(), lr_base = B * RB;
    LAS int* tot = (LAS int*)lds; LAS int* pre = tot + 32; LAS int* pstart = tot + 64; LAS int* basee = tot + 128; LAS int* til = tot + 256; LAS int* posl = til + 4096;
    const int* bcnt = (const int*)(a.ws + WS_BCNT);
    int* tile_e = (int*)(a.ws + WS_TILEE); int* meta = (int*)(a.ws + WS_META);
    const int* topi = (const int*)(a.ws + WS_TOPI); const float* topw = (const float*)(a.ws + WS_TOPW);
    float* roww = (float*)(a.ws + WS_ROWW); int* rowd = (int*)(a.ws + WS_ROWD);
    const bf16* XB = (const bf16*)(a.ws + WS_X); bf16* XS = (bf16*)(a.ws + WS_XS);
    if (tid < 32) { int t = 0, p = 0; for (int bb = 0; bb < G; ++bb) { const int c = ld_ctl(bcnt + bb * 32 + tid); if (bb < B) p += c; t += c; } tot[tid] = t; pre[tid] = p; }
    __syncthreads();
    if (tid == 0) { int ps = 0; for (int e = 0; e < 32; ++e) { pstart[e] = ps; ps += ((tot[e] + 255) >> 8) << 8; } pstart[32] = ps; }
    __syncthreads();
    if (tid < 32) basee[tid] = pstart[tid] + pre[tid];
    const int ntiles = pstart[32] >> 8;
    if (B == 0) { for (int t = tid; t < ntiles; t += NTHR) { int e = 0; while (e < 31 && pstart[e + 1] <= t * 256) ++e; tile_e[t] = e; } if (tid == 0) meta[0] = ntiles; }
    for (int e = B; e < 32; e += G) for (int i = pstart[e] + tot[e] + tid; i < pstart[e + 1]; i += NTHR) rowd[i] = -1;
    int nrows = NLAT - lr_base; nrows = nrows > RB ? RB : nrows; if (nrows < 0) nrows = 0;
    const int nas = nrows * 4;
    for (int i = tid; i < nas; i += NTHR) til[i] = topi[(size_t)lr_base * 4 + i];
    __syncthreads();
    if (tid < 32) { int n = basee[tid]; for (int i = 0; i < nas; ++i) if (til[i] == tid) posl[i] = n++; }
    __syncthreads();
    for (int i = wave; i < nas; i += NWAVES) { const int lr = lr_base + (i >> 2); const size_t r = (size_t)grow_of(lr); const int pos = posl[i];
        const v4u* src = (const v4u*)(XB + r * 1024); v4u* dst = (v4u*)(XS + (size_t)pos * 1024);
        dst[lane] = src[lane]; dst[64 + lane] = src[64 + lane];
        if (lane == 0) { roww[pos] = topw[(size_t)lr * 4 + (i & 3)]; rowd[pos] = lr * 4 + (i & 3); } }
}

__device__ __forceinline__ void phase_ln2(const Args& a, int l, int lane, int wave) {
    const int gw = blockIdx.x * NWAVES + wave, NGW = gridDim.x * NWAVES;
    float* H = (float*)(a.ws + WS_H); const bf16* YB = (const bf16*)(a.ws + WS_YB); bf16* A1 = (bf16*)(a.ws + WS_Y);
    const float* modv = (const float*)(a.ws + WS_MODV);
    const float* lng = a.in[I_LN2G] + l * 1024; const float* lnb = a.in[I_LN2B] + l * 1024;
    for (int lr = gw; lr < NLAT; lr += NGW) {
        const size_t r = (size_t)grow_of(lr); const int b = lr >> 12;
        const float* mv = modv + ((size_t)l * 9 + b) * 6144; const float* mv1 = modv + ((size_t)9 + b) * 6144;
        f32x4 x[4]; float s = 0.f;
#pragma unroll
        for (int j = 0; j < 4; ++j) { const int c = 4 * (lane + 64 * j); const f32x4 hv = *(const f32x4*)(H + r * 1024 + c); f32x4 f = {0.f, 0.f, 0.f, 0.f};
#pragma unroll
            for (int k = 0; k < 4; ++k) { const v2u y = *(const v2u*)(YB + ((size_t)lr * 4 + k) * 1024 + c);
                f[0] += __uint_as_float(y.x << 16); f[1] += __uint_as_float(y.x & 0xffff0000u); f[2] += __uint_as_float(y.y << 16); f[3] += __uint_as_float(y.y & 0xffff0000u); }
            const f32x4 gt = *(const f32x4*)(mv + 5 * 1024 + c);
            x[j] = hv * ALPHA + gt * f; s += (x[j][0] + x[j][1]) + (x[j][2] + x[j][3]); }
        const float mean = wave_sum(s) * (1.f / 1024.f); float s2 = 0.f;
#pragma unroll
        for (int j = 0; j < 4; ++j) { x[j] = x[j] - mean; s2 += (x[j][0] * x[j][0] + x[j][1] * x[j][1]) + (x[j][2] * x[j][2] + x[j][3] * x[j][3]); }
        const float rstd = rsqrtf(wave_sum(s2) * (1.f / 1024.f) + LN_EPS);
#pragma unroll
        for (int j = 0; j < 4; ++j) { const int c = 4 * (lane + 64 * j); const f32x4 g = *(const f32x4*)(lng + c), bb = *(const f32x4*)(lnb + c);
            const f32x4 hv = x[j] * rstd * g + bb;
            if (l == 0) { *(f32x4*)(H + r * 1024 + c) = hv; const f32x4 sh = *(const f32x4*)(mv1 + c), sc = *(const f32x4*)(mv1 + 1024 + c);
                const f32x4 am = hv * (sc + 1.0f) + sh; v2u o; o.x = pk2(am[0], am[1]); o.y = pk2(am[2], am[3]); *(v2u*)(A1 + r * 1024 + c) = o; }
            else *(f32x4*)(a.out + (size_t)lr * 1024 + c) = hv; }
    }
}

__device__ __forceinline__ void phase_conv(const Args& a, LAS unsigned char* lds, int tid, int lane, int wave) {
    const bf16* U = (const bf16*)(a.ws + WS_X); bf16* V = (bf16*)(a.ws + WS_Y);
    LAS float* part = (LAS float*)(lds + 126976);
    LAS float* st = part + 512;
    const int c0 = 2 * tid;
    const float db0 = a.in[I_DWB][c0], db1 = a.in[I_DWB][c0 + 1], g0 = a.in[I_CLNG][c0], g1 = a.in[I_CLNG][c0 + 1], be0 = a.in[I_CLNB][c0], be1 = a.in[I_CLNB][c0 + 1];
    for (int tile = blockIdx.x; tile < NLAT / 32; tile += gridDim.x) {
        const int b = tile >> 7, t0 = (tile & 127) * 32;
        const size_t rb0 = (size_t)b * TPB + CTXL;
        __syncthreads();
        for (int i = tid; i < 62 * 128; i += NTHR) { const int row = i >> 7, chk = i & 127, t = t0 - 15 + row;
            v4u val = {0u, 0u, 0u, 0u}; if (t >= 0 && t < SEQ) val = *(const v4u*)(U + (rb0 + t) * 1024 + chk * 8);
            *(LAS v4u*)(lds + row * 2048 + chk * 16) = val; }
        __syncthreads();
        float w0[31], w1[31];
#pragma unroll
        for (int j = 0; j < 31; ++j) { const float2 wv = *(const float2*)(a.in[I_DWW] + j * 1024 + c0); w0[j] = wv.x; w1[j] = wv.y; }
#pragma unroll 1
        for (int hh = 0; hh < 2; ++hh) {
            const LAS unsigned char* hp = lds + hh * 16 * 2048;
            float acc0[16], acc1[16];
#pragma unroll
            for (int t = 0; t < 16; ++t) { acc0[t] = db0; acc1[t] = db1; }
#pragma unroll
            for (int s = 0; s < 46; ++s) { const unsigned pr = *(const LAS unsigned*)(hp + s * 2048 + tid * 4); const float x0 = __uint_as_float(pr << 16), x1 = __uint_as_float(pr & 0xffff0000u);
#pragma unroll
                for (int t = (s > 30 ? s - 30 : 0); t <= (s < 15 ? s : 15); ++t) { acc0[t] = fmaf(x0, w0[s - t], acc0[t]); acc1[t] = fmaf(x1, w1[s - t], acc1[t]); } }
            float rs[32];
#pragma unroll
            for (int t = 0; t < 16; ++t) { rs[2 * t] = acc0[t] + acc1[t]; rs[2 * t + 1] = acc0[t] * acc0[t] + acc1[t] * acc1[t]; }
#define RS_STEP(NKEEP, XORV) { const bool bit_ = (lane & XORV) != 0; _Pragma("unroll") for (int k_ = 0; k_ < NKEEP; ++k_) { const float snd_ = bit_ ? rs[k_] : rs[k_ + NKEEP]; const float rcv_ = __shfl_xor(snd_, XORV); rs[k_] = (bit_ ? rs[k_ + NKEEP] : rs[k_]) + rcv_; } }
            RS_STEP(16, 32) RS_STEP(8, 16) RS_STEP(4, 8) RS_STEP(2, 4) RS_STEP(1, 2)
#undef RS_STEP
            rs[0] += __shfl_xor(rs[0], 1);
            __syncthreads();
            if ((lane & 1) == 0) part[wave * 32 + (lane >> 1)] = rs[0];
            __syncthreads();
            if (tid < 16) { float s1 = 0.f, s2 = 0.f;
#pragma unroll
                for (int w = 0; w < 8; ++w) { s1 += part[w * 32 + 2 * tid]; s2 += part[w * 32 + 2 * tid + 1]; }
                const float mean = s1 * (1.f / 1024.f); const float var = fmaxf(s2 * (1.f / 1024.f) - mean * mean, 0.f); st[2 * tid] = mean; st[2 * tid + 1] = rsqrtf(var + LN_EPS); }
            __syncthreads();
#pragma unroll
            for (int t = 0; t < 16; ++t) { const float mean = st[2 * t], rstd = st[2 * t + 1];
                const float y0 = (acc0[t] - mean) * rstd * g0 + be0, y1 = (acc1[t] - mean) * rstd * g1 + be1;
                *(unsigned*)(V + (rb0 + t0 + hh * 16 + t) * 1024 + c0) = pk2(y0 * sigm(y0), y1 * sigm(y1)); }
        }
    }
}

constexpr int NPHASES = 21;
__global__ void __launch_bounds__(NTHR, 2) fwd_kernel(Args args) {
    extern __shared__ __attribute__((aligned(16))) unsigned char lds_raw[];
    LAS unsigned char* lds = (LAS unsigned char*)lds_raw;
    const int G = gridDim.x;
#define FRESH() int tid = threadIdx.x; asm volatile("" : "+v"(tid)); const int lane = tid & 63, wave = __builtin_amdgcn_readfirstlane(tid >> 6); (void)lane; (void)wave
    unsigned char* ws = args.ws;
    if (threadIdx.x < 16) ((LAS unsigned*)(lds + LDS_BAR_OFF))[threadIdx.x] = 0u;
    __syncthreads();
    XcdBarrier bar = xcd_barrier_post((unsigned*)(ws + WS_CTL), (volatile LAS unsigned*)(lds + LDS_BAR_OFF));
    const int lo = args.ph_lo, hi = args.ph_hi;
#define IN(k) (lo <= (k) && (k) < hi)
#define SEAM(k) do { if (IN(k) && IN((k) + 1)) xcd_barrier(bar); } while (0)
    bf16* const BX = (bf16*)(ws + WS_X); bf16* const BY = (bf16*)(ws + WS_Y);
    const float* const MODV = (const float*)(ws + WS_MODV);

    if (IN(0)) { FRESH(); phase_prologue(args, lds, tid, lane, wave); } SEAM(0);
    if (IN(1)) { FRESH(); phase_mod0(args, lane, wave); } SEAM(1);
    if (IN(2)) {
        pg8::Gemm g{BX, (const bf16*)(ws + WS_WIN), NTOK, ZC, 1024}; pg8::AllOrder S; S.init(NTOK / 256, ZC / 256, G, (int)blockIdx.x);
        pg8::EpiBf16<0> E{(bf16*)(ws + WS_Z), ZC, nullptr, 0, 0, 1.f};
        pg8::gemm_phase<pg8::EpiBf16<0>, pg8::AllOrder, PG8_ALIGN, PG8_SP2>(lds, g, S, E);
    } SEAM(2);
    if (IN(3)) { FRESH(); phase_norm0(args, lane, wave); } SEAM(3);
    if (IN(4)) {
        { pg8::Gemm g{(const bf16*)(ws + WS_CQN), (const bf16*)(ws + WS_WUQ), NTOK, 768, 384}; pg8::LatOrder S; S.init(128, 3, G, (int)blockIdx.x);
          pg8::EpiBf16<0> E{(bf16*)(ws + WS_Q), 768, nullptr, 0, 0, 1.f};
          pg8::gemm_phase<pg8::EpiBf16<0>, pg8::LatOrder, PG8_ALIGN, PG8_SP2>(lds, g, S, E); }
        __syncthreads();
        { pg8::Gemm g{(const bf16*)(ws + WS_CKVN), (const bf16*)(ws + WS_WUKV), NTOK, 1024, 256}; pg8::AllOrder S; S.init(NTOK / 256, 4, G, (int)blockIdx.x);
          pg8::EpiBf16<0> E{(bf16*)(ws + WS_KV), 1024, nullptr, 0, 0, 1.f};
          pg8::gemm_phase<pg8::EpiBf16<0>, pg8::AllOrder, PG8_ALIGN, PG8_SP2>(lds, g, S, E); }
    } SEAM(4);
    if (IN(5)) {
        { FRESH();
        for (int u = blockIdx.x; u < 256; u += G) { __syncthreads(); hgrn_unit(args, u, lds, tid); } }
        const bf16* Q = (const bf16*)(ws + WS_Q); const bf16* KV = (const bf16*)(ws + WS_KV); const bf16* KRR = (const bf16*)(ws + WS_KRR);
        const float* rope = (const float*)(ws + WS_ROPE);
        for (int u = blockIdx.x; u < 1024; u += G) {
            const int b = u >> 7, h = (u >> 4) & 7, qb = u & 15;
            const size_t kb = (size_t)b * TPB, q0 = kb + CTXL + (size_t)qb * 256;
            __syncthreads();
            att::attn_unit(Q + q0 * 768 + h * 96, KV + kb * 1024 + h * 64, KRR + kb * 32, BY + q0 * 1024 + h * 64, rope + (size_t)qb * 256 * 32, TPB, (char*)lds_raw);
        }
    } SEAM(5);
    if (IN(6)) { FRESH(); phase_readout(args, lane, wave); } SEAM(6);
    if (IN(7)) {
        pg8::Gemm g{BY, (const bf16*)(ws + WS_WOUT), NTOK, 1024, 1024}; pg8::LatOrder S; S.init(128, 4, G, (int)blockIdx.x);
        pg8::EpiRes E{args.in[I_X], (float*)(ws + WS_H), MODV, nullptr};
        pg8::gemm_phase<pg8::EpiRes, pg8::LatOrder, PG8_ALIGN, PG8_SP2>(lds, g, S, E);
    } SEAM(7);
    for (int l = 0; l < 2; ++l) {
        if (l == 1) {
            if (IN(13)) {
                pg8::Gemm g{BY, (const bf16*)(ws + WS_WPW1), NTOK, 2048, 1024}; pg8::LatOrder S; S.init(128, 8, G, (int)blockIdx.x);
                pg8::EpiGate<0> E{BX, (const float*)(ws + WS_PW1B), 8};
                pg8::gemm_phase<pg8::EpiGate<0>, pg8::LatOrder, PG8_ALIGN, PG8_SP2>(lds, g, S, E);
            } SEAM(13);
            if (IN(14)) { FRESH(); phase_conv(args, lds, tid, lane, wave); } SEAM(14);
            if (IN(15)) {
                pg8::Gemm g{BY, (const bf16*)(ws + WS_WPW2), NTOK, 1024, 1024}; pg8::LatOrder S; S.init(128, 4, G, (int)blockIdx.x);
                pg8::EpiRes E{nullptr, (float*)(ws + WS_H), MODV + 9 * 6144, args.in[I_PW2B]};
                pg8::gemm_phase<pg8::EpiRes, pg8::LatOrder, PG8_ALIGN, PG8_SP2>(lds, g, S, E);
            } SEAM(15);
        }
        const int pb = l ? 16 : 8;
        if (IN(pb)) { FRESH(); phase_ln1(args, l, lds, tid, lane, wave); } SEAM(pb);
        if (IN(pb + 1)) { FRESH(); phase_place(args, lds, tid, lane, wave); } SEAM(pb + 1);
        if (IN(pb + 2) || IN(pb + 3)) {
            LAS int* tl = (LAS int*)(lds + LDS_TILE_E);
            FRESH();
            __syncthreads();
            const int ntiles = ld_ctl((const int*)(ws + WS_META));
            for (int t = tid; t < ntiles && t < MAXTILES; t += NTHR) tl[t] = ld_ctl((const int*)(ws + WS_TILEE) + t);
            __syncthreads();
            if (IN(pb + 2)) {
                pg8::Gemm g{(const bf16*)(ws + WS_XS), (const bf16*)(ws + WS_WGU) + (size_t)l * 32 * 2048 * 1024, 0, 0, 1024};
                pg8::MoeOrder S; S.init(ntiles, 8, G, (int)blockIdx.x); S.tile_e = tl; S.nper = 8;
                pg8::EpiGate<1> E{(bf16*)(ws + WS_ACT), (const float*)(ws + WS_BGU) + (size_t)l * 32 * 2048, 8};
                pg8::gemm_phase<pg8::EpiGate<1>, pg8::MoeOrder, PG8_ALIGN, PG8_SP2>(lds, g, S, E);
            } SEAM(pb + 2);
            if (IN(pb + 3)) {
                pg8::Gemm g{(const bf16*)(ws + WS_ACT), (const bf16*)(ws + WS_WDN) + (size_t)l * 32 * 1024 * 1024, 0, 0, 1024};
                pg8::MoeOrder S; S.init(ntiles, 4, G, (int)blockIdx.x); S.tile_e = tl; S.nper = 4;
                pg8::EpiDown E{(bf16*)(ws + WS_YB), args.in[I_BDN] + (size_t)l * 32 * 1024, (const float*)(ws + WS_ROWW), (const int*)(ws + WS_ROWD)};
                pg8::gemm_phase<pg8::EpiDown, pg8::MoeOrder, PG8_ALIGN, PG8_SP2>(lds, g, S, E);
            } SEAM(pb + 3);
        }
        if (IN(pb + 4)) { FRESH(); phase_ln2(args, l, lane, wave); }
        if (l == 0) SEAM(12);
    }
#undef IN
#undef SEAM
}

extern "C" void kernel_launch(void* const* d_in, const int* in_sizes, int n_in, void* d_out, int out_size, void* d_ws, size_t ws_size, hipStream_t stream) {
    static int grid = 0;
    if (grid == 0) {
        if (n_in != 33 || in_sizes[0] != NB * SEQ * D || out_size != NB * SEQ * D || ws_size < WS_END) {
            fprintf(stderr, "kernel_launch: unexpected shapes: n_in %d in0 %d out %d ws %zu (need %zu)\n", n_in, n_in > 0 ? in_sizes[0] : -1, out_size, ws_size, (size_t)WS_END); grid = -1; return; }
        int dev = 0, cus = 0;
        if (hipGetDevice(&dev) != hipSuccess || hipDeviceGetAttribute(&cus, hipDeviceAttributeMultiprocessorCount, dev) != hipSuccess) { grid = -1; return; }
        if (hipFuncSetAttribute((const void*)fwd_kernel, hipFuncAttributeMaxDynamicSharedMemorySize, LDS_BYTES) != hipSuccess) { fprintf(stderr, "kernel_launch: hipFuncSetAttribute failed\n"); grid = -1; return; }
        int per_cu = 0;
        if (hipOccupancyMaxActiveBlocksPerMultiprocessor(&per_cu, (const void*)fwd_kernel, NTHR, LDS_BYTES) != hipSuccess || per_cu < 1) fprintf(stderr, "kernel_launch: occupancy query reports %d\n", per_cu);
        (void)hipGetLastError();
        grid = cus;
    }
    if (grid < 0) return;
    if (hipMemsetAsync((char*)d_ws + WS_CTL, 0, CTL_ZERO_BYTES, stream) != hipSuccess) return;
    Args a{};
    for (int i = 0; i < 33; ++i) a.in[i] = (const float*)d_in[i];
    a.out = (float*)d_out; a.ws = (unsigned char*)d_ws;
#if MK_ONE_LAUNCH
    a.ph_lo = 0; a.ph_hi = NPHASES;
    hipLaunchKernelGGL(fwd_kernel, dim3(grid), dim3(NTHR), LDS_BYTES, stream, a);
#else
    for (int ph = 0; ph < NPHASES; ++ph) { a.ph_lo = ph; a.ph_hi = ph + 1; hipLaunchKernelGGL(fwd_kernel, dim3(grid), dim3(NTHR), LDS_BYTES, stream, a); }
#endif
    const hipError_t le = hipPeekAtLastError();
    if (le != hipSuccess) fprintf(stderr, "kernel_launch: launch failed: %s\n", hipGetErrorName(le));
}
```

```cpp
#include <hip/hip_runtime.h>
#include <cstdio>
#include <cstdint>

#ifndef PROBE_MASK
#define PROBE_MASK 0u
#endif
#ifndef MK_ONE_LAUNCH
#define MK_ONE_LAUNCH 1
#endif

namespace pg8 {
#define PG8_LAS __attribute__((address_space(3)))
typedef unsigned short bf16_t;
typedef short bf16x8 __attribute__((ext_vector_type(8)));
typedef float f32x4 __attribute__((ext_vector_type(4)));
typedef unsigned u32x4 __attribute__((ext_vector_type(4)));
constexpr int BM = 256, BK = 64, HALF = 128, HTB = HALF * BK * 2  , STAGE_BYTES = 8 * HTB, NXCD = 8, WGM = 8;

__host__ __device__ __forceinline__ int lds_byte(int r, int c) { const int st = (r >> 4) * 2 + (c >> 5), rr = r & 15, cc = c & 31, ob = rr * 64 + cc * 2; return st * 1024 + (ob ^ (((ob >> 9) & 1) << 5)); }
__host__ __device__ __forceinline__ void stage_rc(int b, int& R, int& C) { const int st = b / 1024, sb = b % 1024, swz = sb ^ (((sb >> 9) & 1) << 5); R = (st >> 1) * 16 + swz / 64; C = (st & 1) * 32 + (swz % 64) / 2; }
__host__ __device__ __forceinline__ int perm32(int rho) { const int n = rho >> 4, i = rho & 15; return 8 * (i >> 2) + 4 * n + (i & 3); }

struct Unit { int pm, pn; };
struct Gemm { const bf16_t* A; const bf16_t* Bt; int M, N, K; };

struct StaticOrder {
    int nM, nN, nwg, G, c;
    __host__ __device__ void init(int M, int N, int G_, int c_) { nM = M / BM; nN = N / BM; nwg = nM * nN; G = G_; c = c_; }
    __host__ __device__ bool next(int i, Unit& u) const {
        const long L = (long)i * G + c; if (L >= nwg) return false;
        int wgid = (int)L; { const int q = nwg / NXCD, r = nwg % NXCD, xcd = wgid % NXCD, off = wgid / NXCD; wgid = (xcd < r ? xcd * (q + 1) : r * (q + 1) + (xcd - r) * q) + off; }
        const int nig = WGM * nN, gid = wgid / nig, fm = gid * WGM, gsz = (nM - fm) < WGM ? (nM - fm) : WGM;
        u.pm = fm + ((wgid % nig) % gsz); u.pn = (wgid % nig) / gsz; return true;
    }
    __device__ __forceinline__ void a_ready(const Unit&) const {}
    __device__ __forceinline__ void done(const Unit&) const {}
};

__device__ __forceinline__ unsigned cvt_pk_bf16(float lo, float hi) { unsigned r; asm volatile("v_cvt_pk_bf16_f32 %0, %1, %2" : "=v"(r) : "v"(lo), "v"(hi)); return r; }
typedef float f32x2 __attribute__((ext_vector_type(2)));
__device__ __forceinline__ f32x2 gelu_pk(f32x2 v) {
    const f32x2 av = __builtin_elementwise_abs(v), d = av * 0.2316418882f + 1.0f;
    f32x2 t; t.x = __builtin_amdgcn_rcpf(d.x); t.y = __builtin_amdgcn_rcpf(d.y);
    f32x2 q = t * 0.5307027145f + (-0.7265760135f); q = q * t + 0.7107068705f; q = q * t + (-0.142248368f); q = q * t + 0.127414796f; q = q * t;
    const f32x2 s = (v * v) * (-0.72134752044f);
    f32x2 e; e.x = __builtin_amdgcn_exp2f(s.x); e.y = __builtin_amdgcn_exp2f(s.y);
    const f32x2 m = v * (q * e), r = v - m;
    f32x2 o; o.x = v.x < 0.f ? m.x : r.x; o.y = v.y < 0.f ? m.y : r.y; return o;
}

template <int ACT  > struct EpiBf16 {
    static constexpr bool PERM = true, AFTER_DRAIN = false; static_assert(ACT == 0 || ACT == 1, "EpiBf16: ACT is 0 (none) or 1 (gelu_pk)");
    bf16_t* O; int ldc; const float* bias; int split_cols; size_t split_stride; float scale0;
    __device__ __forceinline__ void operator()(const f32x4 (&acc)[2][2][4][2], const Unit& u, int wr, int wc, int fr, int fq) const {
        const int row0 = u.pm * BM + wr * 64 + fr; int colt = u.pn * BM; bf16_t* base = O;
        float sc = 1.f; if (split_cols) { const int t = colt / split_cols; base += (size_t)t * split_stride; colt -= t * split_cols; if (t == 0) sc = scale0; }
        const int col0 = colt + wc * 32 + 8 * fq, bcol0 = u.pn * BM + wc * 32 + 8 * fq;
        f32x4 bv[2][2];
#pragma unroll
        for (int bj = 0; bj < 2; ++bj)
#pragma unroll
            for (int n = 0; n < 2; ++n) bv[bj][n] = bias ? *(const f32x4*)(bias + bcol0 + bj * HALF + 4 * n) : (f32x4){0.f, 0.f, 0.f, 0.f};
#pragma unroll
        for (int ai = 0; ai < 2; ++ai)
#pragma unroll
            for (int m = 0; m < 4; ++m) { bf16_t* rowp = base + (size_t)(row0 + ai * HALF + m * 16) * ldc + col0;
#pragma unroll
                for (int bj = 0; bj < 2; ++bj) { f32x4 v0 = acc[ai][bj][m][0] + bv[bj][0], v1 = acc[ai][bj][m][1] + bv[bj][1];
                    if (ACT == 1) { f32x2 a = gelu_pk((f32x2){v0[0], v0[1]}), b = gelu_pk((f32x2){v0[2], v0[3]}), c = gelu_pk((f32x2){v1[0], v1[1]}), d = gelu_pk((f32x2){v1[2], v1[3]});
                        v0 = (f32x4){a.x, a.y, b.x, b.y}; v1 = (f32x4){c.x, c.y, d.x, d.y}; }
                    v0 = v0 * sc; v1 = v1 * sc; u32x4 w; w.x = cvt_pk_bf16(v0[0], v0[1]); w.y = cvt_pk_bf16(v0[2], v0[3]); w.z = cvt_pk_bf16(v1[0], v1[1]); w.w = cvt_pk_bf16(v1[2], v1[3]);
                    *(u32x4*)(rowp + bj * HALF) = w; } }
    }
};
template <class Epi, class Sched, bool ALIGN_EPI = false, bool SP2 = false, bool GATHER = false>
__device__ __forceinline__ void gemm_phase(PG8_LAS unsigned char* lds, const Gemm g, const Sched& S, const Epi& E, const int* rowsrc = nullptr) {
    static_assert(!GATHER || SP2, "GATHER is implemented on the SP2 loop only");
    int tid_l = threadIdx.x; asm volatile("" : "+v"(tid_l));
    const int tid = tid_l, wid = __builtin_amdgcn_readfirstlane(tid >> 6), lane = tid & 63, wr = wid >> 2, wc = wid & 3, fr = lane & 15, fq = lane >> 4;
    const int K = g.K, nt = K / BK;
    unsigned voffA[2], voffB[2];
#pragma unroll
    for (int i = 0; i < 2; ++i) { int R, C; stage_rc(tid * 16 + i * 8192, R, C); const int Rb = Epi::PERM ? ((R & ~31) + perm32(R & 31)) : R;
        voffA[i] = (unsigned)(R * K + C) * 2u; voffB[i] = (unsigned)(Rb * K + C) * 2u; }
    unsigned gAc[2][2], gAn[2][2]; int gR[2]; unsigned gC[2];
#pragma unroll
    for (int i = 0; i < 2; ++i) { int R, C; stage_rc(tid * 16 + i * 8192, R, C); gR[i] = R; gC[i] = (unsigned)C * 2u; gAc[0][i] = gAc[1][i] = gAn[0][i] = gAn[1][i] = 0u; }
#define PG8_GATHER(u_, o_) do { _Pragma("unroll") for (int h_ = 0; h_ < 2; ++h_) _Pragma("unroll") for (int i_ = 0; i_ < 2; ++i_) \
        o_[h_][i_] = (unsigned)rowsrc[(u_).pm * BM + h_ * HALF + gR[i_]] * (unsigned)(K * 2) + gC[i_]; } while (0)
#define PG8_STAGE_A(bufoff, orig_gbase, NEXTSEL, H, KOFF) do { if constexpr (GATHER) { unsigned vo_[2]; vo_[0] = (NEXTSEL) ? gAn[H][0] : gAc[H][0]; vo_[1] = (NEXTSEL) ? gAn[H][1] : gAc[H][1]; \
        PG8_STAGE(bufoff, (const char*)g.A + (KOFF), vo_); } else { PG8_STAGE(bufoff, orig_gbase, voffA); } } while (0)
    const size_t kstep = (size_t)(BK * 2);
    const size_t hstep = (size_t)HALF * K * 2;
    const size_t tstep = 2 * hstep;
    const unsigned ldsw = (unsigned)wid * 1024u;
    const int aoff = lds_byte(wr * 64 + fr, fq * 8), boff = lds_byte(wc * 32 + fr, fq * 8);
#define PG8_SA(b, h) (((b) * 2 + (h)) * HTB)
#define PG8_SB(b, h) ((4 + (b) * 2 + (h)) * HTB)
#define PG8_STAGE(bufoff, gbase, voff) do { _Pragma("unroll") for (int _i = 0; _i < 2; ++_i) \
        __builtin_amdgcn_global_load_lds((const unsigned*)((const char*)(gbase) + (voff)[_i]), (PG8_LAS unsigned*)(lds + (bufoff) + ldsw + _i * 8192), 16, 0, 0); } while (0)
#define PG8_LDA(dst, b, h) do { _Pragma("unroll") for (int m = 0; m < 4; ++m) _Pragma("unroll") for (int k = 0; k < 2; ++k) dst[m][k] = *(const PG8_LAS bf16x8*)(lds + PG8_SA(b, h) + aoff + m * 2048 + k * 1024); } while (0)
#define PG8_LDB(dst, b, h) do { _Pragma("unroll") for (int n = 0; n < 2; ++n) _Pragma("unroll") for (int k = 0; k < 2; ++k) dst[n][k] = *(const PG8_LAS bf16x8*)(lds + PG8_SB(b, h) + boff + n * 2048 + k * 1024); } while (0)
#define PG8_MMA(ai, bj, At, Bt) do { __builtin_amdgcn_s_setprio(1); _Pragma("unroll") for (int m = 0; m < 4; ++m) _Pragma("unroll") for (int n = 0; n < 2; ++n) _Pragma("unroll") for (int k = 0; k < 2; ++k) \
        acc[ai][bj][m][n] = __builtin_amdgcn_mfma_f32_16x16x32_bf16(Bt[n][k], At[m][k], acc[ai][bj][m][n], 0, 0, 0); __builtin_amdgcn_s_setprio(0); } while (0)
#define PG8_WAIT_V(n) asm volatile("s_waitcnt vmcnt(" #n ")" ::: "memory")
#define PG8_WAIT_L(n) asm volatile("s_waitcnt lgkmcnt(" #n ")" ::: "memory")
#define PG8_BAR __builtin_amdgcn_s_barrier()
#define PG8_SCHED __builtin_amdgcn_sched_barrier(0)
    Unit cur, nxt; int ui = 0;
    if (!S.next(0, cur)) return;
    f32x4 acc[2][2][4][2];
#pragma unroll
    for (int a = 0; a < 2; ++a)
#pragma unroll
        for (int b = 0; b < 2; ++b)
#pragma unroll
            for (int m = 0; m < 4; ++m)
#pragma unroll
                for (int n = 0; n < 2; ++n) acc[a][b][m][n] = (f32x4){0.f, 0.f, 0.f, 0.f};
    bf16x8 At[4][2], B0[2][2], B1[2][2];
    const char* cA = (const char*)g.A + (size_t)cur.pm * tstep; const char* cB = (const char*)g.Bt + (size_t)cur.pn * tstep;
    S.a_ready(cur);
    if constexpr (GATHER) { PG8_GATHER(cur, gAc); }
    if constexpr (SP2) {
        PG8_STAGE(PG8_SB(0, 0), cB, voffB); PG8_STAGE(PG8_SB(0, 1), cB + hstep, voffB); PG8_STAGE_A(PG8_SA(0, 0), cA, false, 0, (size_t)0); PG8_STAGE_A(PG8_SA(0, 1), cA + hstep, false, 1, (size_t)0);
        if (wr == 1) PG8_BAR;
        PG8_WAIT_V(2); PG8_BAR;
        PG8_STAGE(PG8_SB(1, 0), cB + kstep, voffB); PG8_STAGE_A(PG8_SA(1, 0), cA + kstep, false, 0, kstep); PG8_STAGE(PG8_SB(1, 1), cB + hstep + kstep, voffB);
        PG8_WAIT_V(6); PG8_BAR;
    } else {
        PG8_STAGE(PG8_SB(0, 0), cB, voffB); PG8_STAGE(PG8_SA(0, 0), cA, voffA); PG8_STAGE(PG8_SB(0, 1), cB + hstep, voffB); PG8_STAGE(PG8_SA(0, 1), cA + hstep, voffA);
        if (wr == 1) PG8_BAR;
        PG8_WAIT_V(4); PG8_BAR;
        PG8_STAGE(PG8_SB(1, 0), cB + kstep, voffB); PG8_STAGE(PG8_SA(1, 0), cA + kstep, voffA); PG8_STAGE(PG8_SB(1, 1), cB + hstep + kstep, voffB);
        PG8_WAIT_V(6); PG8_BAR;
    }
    for (;;) {
        const bool has_next = S.next(ui + 1, nxt);
        if constexpr (GATHER) { if (has_next) { PG8_GATHER(nxt, gAn); } else { _Pragma("unroll") for (int h_ = 0; h_ < 2; ++h_) _Pragma("unroll") for (int i_ = 0; i_ < 2; ++i_) gAn[h_][i_] = gAc[h_][i_]; } }
        const char* nA = has_next ? (const char*)g.A + (size_t)nxt.pm * tstep : cA; const char* nB = has_next ? (const char*)g.Bt + (size_t)nxt.pn * tstep : cB;
#pragma nounroll
        for (int t = 0; t < nt; t += 2) {
            const bool last = (t == nt - 2);
            const char* a1 = cA + (size_t)(t + 1) * kstep;
            const char* a2 = last ? nA : cA + (size_t)(t + 2) * kstep; const char* b2 = last ? nB : cB + (size_t)(t + 2) * kstep;
            const char* a3 = a2 + kstep; const char* b3 = b2 + kstep;
            const size_t k1 = (size_t)(t + 1) * kstep, k2 = last ? (size_t)0 : (size_t)(t + 2) * kstep, k3 = k2 + kstep; (void)k1; (void)k2; (void)k3;
            if (last && has_next) S.a_ready(nxt);
            if constexpr (SP2) {
            PG8_LDB(B0, 0, 0); PG8_LDB(B1, 0, 1); PG8_SCHED; PG8_LDA(At, 0, 0); PG8_STAGE_A(PG8_SA(1, 1), a1 + hstep, false, 1, k1);
            PG8_WAIT_V(8); PG8_WAIT_L(0); PG8_BAR; PG8_MMA(0, 0, At, B0); PG8_MMA(0, 1, At, B1); PG8_BAR; PG8_SCHED;
            PG8_LDA(At, 0, 1); PG8_STAGE(PG8_SB(0, 0), b2, voffB); PG8_STAGE(PG8_SB(0, 1), b2 + hstep, voffB); PG8_STAGE_A(PG8_SA(0, 0), a2, last, 0, k2);
            PG8_WAIT_V(8); PG8_WAIT_L(0); PG8_BAR; PG8_MMA(1, 0, At, B0); PG8_MMA(1, 1, At, B1); PG8_BAR; PG8_SCHED;
            PG8_LDB(B0, 1, 0); PG8_LDB(B1, 1, 1); PG8_SCHED; PG8_LDA(At, 1, 0); PG8_STAGE_A(PG8_SA(0, 1), a2 + hstep, last, 1, k2);
            PG8_WAIT_V(8); PG8_WAIT_L(0); PG8_BAR; PG8_MMA(0, 0, At, B0); PG8_MMA(0, 1, At, B1); PG8_BAR; PG8_SCHED;
            PG8_LDA(At, 1, 1); PG8_STAGE(PG8_SB(1, 0), b3, voffB); PG8_STAGE(PG8_SB(1, 1), b3 + hstep, voffB); PG8_STAGE_A(PG8_SA(1, 0), a3, last, 0, k3);
            PG8_WAIT_V(8); PG8_WAIT_L(0); PG8_BAR; PG8_MMA(1, 0, At, B0); PG8_MMA(1, 1, At, B1); PG8_BAR; PG8_SCHED;
            } else {
            PG8_LDB(B0, 0, 0); PG8_SCHED; PG8_LDA(At, 0, 0); PG8_STAGE(PG8_SA(1, 1), a1 + hstep, voffA);
            PG8_WAIT_L(8); PG8_BAR; PG8_WAIT_L(0); PG8_MMA(0, 0, At, B0); PG8_BAR; PG8_SCHED;
            PG8_LDB(B1, 0, 1); PG8_STAGE(PG8_SB(0, 0), b2, voffB);
            PG8_BAR; PG8_WAIT_L(0); PG8_MMA(0, 1, At, B1); PG8_BAR;
            PG8_LDA(At, 0, 1); PG8_STAGE(PG8_SA(0, 0), a2, voffA);
            PG8_BAR; PG8_WAIT_L(0); PG8_MMA(1, 0, At, B0); PG8_BAR; PG8_SCHED;
            PG8_STAGE(PG8_SB(0, 1), b2 + hstep, voffB);
            PG8_WAIT_V(6); PG8_BAR; PG8_MMA(1, 1, At, B1); PG8_BAR;
            PG8_LDB(B0, 1, 0); PG8_SCHED; PG8_LDA(At, 1, 0); PG8_STAGE(PG8_SA(0, 1), a2 + hstep, voffA);
            PG8_WAIT_L(8); PG8_BAR; PG8_WAIT_L(0); PG8_MMA(0, 0, At, B0); PG8_BAR; PG8_SCHED;
            PG8_LDB(B1, 1, 1); PG8_STAGE(PG8_SB(1, 0), b3, voffB);
            PG8_BAR; PG8_WAIT_L(0); PG8_MMA(0, 1, At, B1); PG8_BAR;
            PG8_LDA(At, 1, 1); PG8_STAGE(PG8_SA(1, 0), a3, voffA);
            PG8_BAR; PG8_WAIT_L(0); PG8_MMA(1, 0, At, B0); PG8_BAR; PG8_SCHED;
            PG8_STAGE(PG8_SB(1, 1), b3 + hstep, voffB);
            PG8_WAIT_V(6); PG8_BAR; PG8_MMA(1, 1, At, B1); PG8_BAR;
            }
        }
        if constexpr (ALIGN_EPI) { if (wr == 0) PG8_BAR; }
        if constexpr (!Epi::AFTER_DRAIN) { E(acc, cur, wr, wc, fr, fq); S.done(cur); }
        if (!has_next) break;
#pragma unroll
        for (int a = 0; a < 2; ++a)
#pragma unroll
            for (int b = 0; b < 2; ++b)
#pragma unroll
                for (int m = 0; m < 4; ++m)
#pragma unroll
                    for (int n = 0; n < 2; ++n) acc[a][b][m][n] = (f32x4){0.f, 0.f, 0.f, 0.f};
        cur = nxt; cA = nA; cB = nB; ++ui;
        if constexpr (GATHER) { _Pragma("unroll") for (int h_ = 0; h_ < 2; ++h_) _Pragma("unroll") for (int i_ = 0; i_ < 2; ++i_) gAc[h_][i_] = gAn[h_][i_]; }
        if constexpr (ALIGN_EPI) { if (wr == 1) PG8_BAR; }
    }
    PG8_WAIT_V(0);
    if constexpr (!ALIGN_EPI) { if (wr == 0) PG8_BAR; }
    PG8_BAR;
    if constexpr (Epi::AFTER_DRAIN) { E.fused(acc, cur, wr, wc, fr, fq, lds, wid, lane); S.done(cur); }
#undef PG8_SA
#undef PG8_SB
#undef PG8_STAGE
#undef PG8_STAGE_A
#undef PG8_GATHER
#undef PG8_LDA
#undef PG8_LDB
#undef PG8_MMA
#undef PG8_WAIT_V
#undef PG8_WAIT_L
#undef PG8_BAR
#undef PG8_SCHED
}
}

#ifndef PG8_SP2
#define PG8_SP2 true
#endif
#ifndef PG8_ALIGN
#define PG8_ALIGN true
#endif

#define GAS __attribute__((address_space(1)))
#define LAS __attribute__((address_space(3)))
typedef unsigned short bf16;
typedef unsigned v4u __attribute__((ext_vector_type(4)));
typedef unsigned v2u __attribute__((ext_vector_type(2)));
typedef float f32x4 __attribute__((ext_vector_type(4)));
typedef short bf16x8 __attribute__((ext_vector_type(8)));

constexpr int D = 1024, NB = 8, SEQ = 4096, CTXL = 256, TPB = SEQ + CTXL, NTOK = NB * TPB, NLAT = NB * SEQ;
constexpr int ZC = 3328;
constexpr int ZQ = 0, ZKV = 384, ZKR = 640, ZHQ = 672, ZHF = 1184, ZHB = 1696, ZHI = 2208, ZHG = 2720;
constexpr int NEXP = 32;
constexpr float ALPHA = 1.4142135623730951f;
constexpr float LN_EPS = 1e-5f, RMS_EPS = 1e-6f;
constexpr int NWAVES = 8, NTHR = 512;
constexpr int LDS_BYTES = 147456;
constexpr int LDS_BAR_OFF = LDS_BYTES - 64;
constexpr int LDS_TILE_E = 131072;
constexpr int MAXTILES = 576;

constexpr size_t MiB = 1u << 20;
constexpr size_t WS_CTL = 0, CTL_ZERO_BYTES = 16384;
constexpr size_t WS_MODV = 1 * MiB;
constexpr size_t WS_ROPE = 1 * MiB + 512 * 1024;
constexpr size_t WS_BGU = 2 * MiB;
constexpr size_t WS_PW1B = 2 * MiB + 512 * 1024;
constexpr size_t WS_BCNT = WS_PW1B + 64 * 1024;
constexpr size_t WS_TILEE = WS_BCNT + 64 * 1024;
constexpr size_t WS_META = WS_TILEE + 4096;
constexpr size_t WS_TOPI = 3 * MiB, WS_TOPW = 4 * MiB, WS_ROWW = 5 * MiB, WS_ROWD = 6 * MiB, WS_ROWS = 7 * MiB;
constexpr size_t WS_WIN = 8 * MiB, WS_WUQ = 15 * MiB, WS_WUKV = 16 * MiB, WS_WOUT = 17 * MiB, WS_WPW1 = 19 * MiB, WS_WPW2 = 23 * MiB;
constexpr size_t WS_WGU = 32 * MiB, WS_WDN = 288 * MiB;
constexpr size_t WS_H = 416 * MiB;
constexpr size_t WS_X = 552 * MiB, WS_Y = 620 * MiB;
constexpr size_t WS_BIG = 688 * MiB;
constexpr size_t WS_Z = WS_BIG, WS_CQN = WS_BIG + 221 * MiB, WS_CKVN = WS_BIG + 247 * MiB, WS_KRR = WS_BIG + 264 * MiB,
                 WS_Q = WS_BIG + 267 * MiB, WS_KV = WS_BIG + 318 * MiB, WS_OF = WS_BIG + 386 * MiB, WS_OB = WS_BIG + 454 * MiB;
constexpr size_t WS_XS = WS_BIG, WS_ACT = WS_BIG + 288 * MiB, WS_YB = WS_BIG + 576 * MiB;
constexpr size_t WS_END = WS_BIG + 848 * MiB;
static_assert((size_t)NTOK * ZC * 2 <= 221 * MiB && (size_t)NTOK * 384 * 2 <= 26 * MiB && (size_t)NTOK * 256 * 2 <= 17 * MiB && (size_t)NTOK * 32 * 2 <= 3 * MiB, "ws map 1");
static_assert((size_t)NTOK * 768 * 2 <= 51 * MiB && (size_t)NTOK * 1024 * 2 <= 68 * MiB && (size_t)NTOK * 512 * 4 <= 68 * MiB, "ws map 2");
static_assert((size_t)MAXTILES * 256 * 2048 <= 288 * MiB && (size_t)NLAT * 4 * 2048 <= 272 * MiB && (size_t)NTOK * 1024 * 4 <= 136 * MiB, "ws map 3");

#define LDS_WAIT() asm volatile("s_waitcnt lgkmcnt(0)" ::: "memory")
#define VM_WAIT() asm volatile("s_waitcnt vmcnt(0)" ::: "memory")
__device__ __forceinline__ float bf2f(unsigned short b) { return __uint_as_float(((unsigned)b) << 16); }
__device__ __forceinline__ unsigned pk2(float lo, float hi) { return pg8::cvt_pk_bf16(lo, hi); }
__device__ __forceinline__ float sigm(float x) { return 1.f / (1.f + __expf(-x)); }
__device__ __forceinline__ float wave_sum(float v) {
#pragma unroll
    for (int o = 1; o < 64; o <<= 1) v += __shfl_xor(v, o);
    return v;
}
__device__ __forceinline__ int ld_ctl(const int* p) { return (int)__hip_atomic_load((const unsigned*)p, __ATOMIC_RELAXED, __HIP_MEMORY_SCOPE_AGENT); }
__device__ __forceinline__ int grow_of(int lr) { return (lr >> 12) * TPB + CTXL + (lr & 4095); }

#define XB_TMO      128
#define XB_XCNT(j)  (256  + 64 * (j))
#define XB_XSUB(j)  (1280 + 64 * (j))
#define XB_XGEN(j)  (2304 + 64 * (j))
#define XB_TOP      3328
#define XB_TOPGEN   3392
#define XCD_BAR_WORDS 3456
#define XB_SPIN_CAP (1u << 21)

__device__ __forceinline__ unsigned xb_ld(unsigned* p)              { return __hip_atomic_load(p, __ATOMIC_RELAXED, __HIP_MEMORY_SCOPE_AGENT); }
__device__ __forceinline__ unsigned xb_add(unsigned* p, unsigned v) { return __hip_atomic_fetch_add(p, v, __ATOMIC_RELAXED, __HIP_MEMORY_SCOPE_AGENT); }
__device__ __forceinline__ unsigned xb_xcc_id() { return (unsigned)__builtin_amdgcn_s_getreg((3 << 11) | 20) & 0xFu; }
#define XB_SPIN(cond, bar) do { unsigned _sp = 0; while (cond) { __builtin_amdgcn_s_sleep(1); \
    if ((++_sp & 255u) == 0u) { if (xb_ld(&(bar)[XB_TMO])) break; if (_sp > XB_SPIN_CAP) { atomicAdd(&(bar)[XB_TMO], 1u); break; } } } } while (0)

struct XcdBarrier { unsigned* bar; unsigned x; volatile LAS unsigned* st; };

__device__ __forceinline__ XcdBarrier xcd_barrier_post(unsigned* bar, volatile LAS unsigned* st) {
    XcdBarrier b; b.bar = bar; b.x = xb_xcc_id(); b.st = st;
    if (threadIdx.x == 0) (void)xb_add(&bar[XB_XCNT(b.x)], 1u);
    return b;
}
__device__ __forceinline__ void xcd_barrier_complete(unsigned* bar, unsigned x, unsigned& nloc, unsigned& nx) {
    const unsigned G = gridDim.x * gridDim.y * gridDim.z;
    unsigned sum, cnt, mine, sp = 0u;
    for (;;) {
        sum = 0u; cnt = 0u; mine = 0u;
#pragma unroll
        for (unsigned j = 0; j < 16; ++j) { const unsigned c = xb_ld(&bar[XB_XCNT(j)]); sum += c; cnt += (c > 0u) ? 1u : 0u; mine = (j == x) ? c : mine; }
        if (sum == G) break;
        __builtin_amdgcn_s_sleep(1);
        if ((++sp & 255u) == 0u) { if (xb_ld(&bar[XB_TMO])) break; if (sp > XB_SPIN_CAP) { atomicAdd(&bar[XB_TMO], 1u); break; } }
    }
    nloc = mine > 0u ? mine : 1u; nx = cnt > 0u ? cnt : 1u;
}
__device__ __forceinline__ void xcd_barrier(const XcdBarrier& b) {
    asm volatile("s_waitcnt vmcnt(0)" ::: "memory");
    __syncthreads();
    if (threadIdx.x == 0) {
        unsigned* bar = b.bar;
        __builtin_amdgcn_s_waitcnt(0);
        unsigned nloc = b.st[0], nx = b.st[1];
        if (nloc == 0u) { xcd_barrier_complete(bar, b.x, nloc, nx); b.st[0] = nloc; b.st[1] = nx; }
        const unsigned old = xb_add(&bar[XB_XSUB(b.x)], 1u);
        const unsigned gen = old / nloc;
        if (old + 1u == (gen + 1u) * nloc) {
            __builtin_amdgcn_fence(__ATOMIC_RELEASE, "agent");
            asm volatile("s_waitcnt vmcnt(0)" ::: "memory");
            const unsigned og = xb_add(&bar[XB_TOP], 1u);
            const unsigned tg = og / nx;
            if (og + 1u == (tg + 1u) * nx) xb_add(&bar[XB_TOPGEN], 1u);
            else XB_SPIN(xb_ld(&bar[XB_TOPGEN]) == tg, bar);
            __builtin_amdgcn_fence(__ATOMIC_ACQUIRE, "agent");
            xb_add(&bar[XB_XGEN(b.x)], 1u);
            asm volatile("s_waitcnt vmcnt(0)" ::: "memory");
        } else {
            XB_SPIN(xb_ld(&bar[XB_XGEN(b.x)]) == gen, bar);
            __builtin_amdgcn_fence(__ATOMIC_ACQUIRE, "agent");
            asm volatile("s_waitcnt vmcnt(0)" ::: "memory");
        }
    }
    __syncthreads();
}

namespace pg8 {
struct TileOrder {
    int nM, nN, nwg, G, c;
    __device__ __forceinline__ void init(int nM_, int nN_, int G_, int c_) { nM = nM_; nN = nN_; nwg = nM * nN; G = G_; c = c_; }
    __device__ __forceinline__ bool logical(int i, int& im, int& in) const {
        const long L = (long)i * G + c; if (L >= nwg) return false;
        int wgid = (int)L; { const int q = nwg / NXCD, r = nwg % NXCD, xcd = wgid % NXCD, off = wgid / NXCD; wgid = (xcd < r ? xcd * (q + 1) : r * (q + 1) + (xcd - r) * q) + off; }
        const int nig = WGM * nN, gid = wgid / nig, fm = gid * WGM, gsz = (nM - fm) < WGM ? (nM - fm) : WGM;
        im = fm + ((wgid % nig) % gsz); in = (wgid % nig) / gsz; return true;
    }
    __device__ __forceinline__ void a_ready(const Unit&) const {}
    __device__ __forceinline__ void done(const Unit&) const {}
};
struct AllOrder : TileOrder { __device__ __forceinline__ bool next(int i, Unit& u) const { int im, in; if (!logical(i, im, in)) return false; u.pm = im; u.pn = in; return true; } };
struct LatOrder : TileOrder {
    __device__ __forceinline__ bool next(int i, Unit& u) const { int im, in; if (!logical(i, im, in)) return false; u.pm = (im >> 4) * 17 + 1 + (im & 15); u.pn = in; return true; } };
struct MoeOrder : TileOrder {
    const PG8_LAS int* tile_e; int nper;
    __device__ __forceinline__ bool next(int i, Unit& u) const { int im, in; if (!logical(i, im, in)) return false; u.pm = im; u.pn = tile_e[im] * nper + in; return true; } };

struct EpiRes {
    static constexpr bool PERM = false, AFTER_DRAIN = false;
    const float* xin; float* h; const float* modv; const float* bias;
    __device__ __forceinline__ void operator()(const f32x4 (&acc)[2][2][4][2], const Unit& u, int wr, int wc, int fr, int fq) const {
        const int b = u.pm / 17, j = u.pm % 17;
        const int rl0 = wr * 64 + fr, col0 = u.pn * BM + wc * 32 + 4 * fq;
        const float* gate = modv + (size_t)b * 6144 + 2048;
        f32x4 gv[2][2], bv[2][2];
#pragma unroll
        for (int bj = 0; bj < 2; ++bj)
#pragma unroll
            for (int n = 0; n < 2; ++n) { gv[bj][n] = *(const f32x4*)(gate + col0 + bj * HALF + n * 16); bv[bj][n] = bias ? *(const f32x4*)(bias + col0 + bj * HALF + n * 16) : (f32x4){0.f, 0.f, 0.f, 0.f}; }
#pragma unroll
        for (int ai = 0; ai < 2; ++ai)
#pragma unroll
            for (int m = 0; m < 4; ++m) { const int rl = rl0 + ai * HALF + m * 16; const size_t grow = (size_t)u.pm * BM + rl;
                const float* hin = xin ? xin + ((size_t)b * 4096 + (size_t)(j - 1) * 256 + rl) * 1024 + col0 : h + grow * 1024 + col0;
                float* ho = h + grow * 1024 + col0;
#pragma unroll
                for (int bj = 0; bj < 2; ++bj)
#pragma unroll
                    for (int n = 0; n < 2; ++n) { const f32x4 hv = *(const f32x4*)(hin + bj * HALF + n * 16);
                        *(f32x4*)(ho + bj * HALF + n * 16) = hv * 1.4142135623730951f + gv[bj][n] * (acc[ai][bj][m][n] + bv[bj][n]); } }
    }
};
template <int MODE> struct EpiGate {
    static constexpr bool PERM = true, AFTER_DRAIN = false;
    bf16_t* O; const float* bias; int nper;
    __device__ __forceinline__ void operator()(const f32x4 (&acc)[2][2][4][2], const Unit& u, int wr, int wc, int fr, int fq) const {
        const int row0 = u.pm * BM + wr * 64 + fr, pnl = u.pn % nper, ocol0 = pnl * HALF + wc * 32 + 8 * fq, bcol0 = u.pn * BM + wc * 32 + 8 * fq;
        f32x4 bv[2][2];
#pragma unroll
        for (int bj = 0; bj < 2; ++bj)
#pragma unroll
            for (int n = 0; n < 2; ++n) bv[bj][n] = *(const f32x4*)(bias + bcol0 + bj * HALF + 4 * n);
#pragma unroll
        for (int ai = 0; ai < 2; ++ai)
#pragma unroll
            for (int m = 0; m < 4; ++m) { bf16_t* rowp = O + (size_t)(row0 + ai * HALF + m * 16) * 1024 + ocol0;
                float o[8];
#pragma unroll
                for (int n = 0; n < 2; ++n) { const f32x4 a = acc[ai][0][m][n] + bv[0][n], g = acc[ai][1][m][n] + bv[1][n];
#pragma unroll
                    for (int e = 0; e < 4; ++e) {
                        if (MODE == 0) { o[4 * n + e] = a[e] * (1.f / (1.f + __expf(-g[e]))); }
                        else { const float gt = fminf(a[e], 7.0f), up = fminf(fmaxf(g[e], -7.0f), 7.0f); o[4 * n + e] = (up + 1.0f) * gt * (1.f / (1.f + __expf(-1.702f * gt))); } } }
                u32x4 w; w.x = cvt_pk_bf16(o[0], o[1]); w.y = cvt_pk_bf16(o[2], o[3]); w.z = cvt_pk_bf16(o[4], o[5]); w.w = cvt_pk_bf16(o[6], o[7]);
                *(u32x4*)rowp = w; }
    }
};
struct EpiDown {
    static constexpr bool PERM = true, AFTER_DRAIN = false;
    bf16_t* Y; const float* bias; const float* row_w; const int* row_dst;
    __device__ __forceinline__ void operator()(const f32x4 (&acc)[2][2][4][2], const Unit& u, int wr, int wc, int fr, int fq) const {
        const int row0 = u.pm * BM + wr * 64 + fr, pnl = u.pn & 3, ocol0 = pnl * BM + wc * 32 + 8 * fq, bcol0 = u.pn * BM + wc * 32 + 8 * fq;
        f32x4 bv[2][2];
#pragma unroll
        for (int bj = 0; bj < 2; ++bj)
#pragma unroll
            for (int n = 0; n < 2; ++n) bv[bj][n] = *(const f32x4*)(bias + bcol0 + bj * HALF + 4 * n);
#pragma unroll
        for (int ai = 0; ai < 2; ++ai)
#pragma unroll
            for (int m = 0; m < 4; ++m) { const int r = row0 + ai * HALF + m * 16; const int dst = row_dst[r]; const float w8 = row_w[r];
                if (dst >= 0) { bf16_t* rowp = Y + (size_t)dst * 1024 + ocol0;
#pragma unroll
                    for (int bj = 0; bj < 2; ++bj) { const f32x4 v0 = (acc[ai][bj][m][0] + bv[bj][0]) * w8, v1 = (acc[ai][bj][m][1] + bv[bj][1]) * w8;
                        u32x4 w; w.x = cvt_pk_bf16(v0[0], v0[1]); w.y = cvt_pk_bf16(v0[2], v0[3]); w.z = cvt_pk_bf16(v1[0], v1[1]); w.w = cvt_pk_bf16(v1[2], v1[3]);
                        *(u32x4*)(rowp + bj * HALF) = w; } } }
    }
};
}

namespace att {
using bf16x8 = __attribute__((ext_vector_type(8))) short;
using s16x4  = __attribute__((ext_vector_type(4))) short;
using f32x16 = __attribute__((ext_vector_type(16))) float;
using u32x4  = __attribute__((ext_vector_type(4))) unsigned;
constexpr int NW = 8, QBLK = 32, KVBLK = 64;
constexpr float SCALE = 0.10206207261596575f;
constexpr float THR = 8.f;
constexpr int SHM_V = 16384, SHM_K = 16384, SHM_ATTN = 2 * SHM_V + 2 * SHM_K + NW * 64 * 4;
#define KSWZ(row, colB) ((row) * 256 + ((colB) ^ (((row) & 7) << 4)))
#define SBAR() __builtin_amdgcn_sched_barrier(0)
__device__ __forceinline__ int crow(int r, int hi) { return (r & 3) + 8 * (r >> 2) + 4 * hi; }
__device__ __forceinline__ unsigned cvtpk(float lo, float hi) { unsigned r; asm volatile("v_cvt_pk_bf16_f32 %0, %1, %2" : "=v"(r) : "v"(lo), "v"(hi)); return r; }

__device__ __forceinline__ void partialSM(f32x16& p0, f32x16& p1, float& m_reg, float& mn, float& alpha) {
  constexpr float C = SCALE * 1.4426950408889634f;
  float pmax = p0[0];
#pragma unroll
  for (int r = 1; r < 16; ++r) pmax = fmaxf(pmax, p0[r]);
#pragma unroll
  for (int r = 0; r < 16; ++r) pmax = fmaxf(pmax, p1[r]);
  { auto rr = __builtin_amdgcn_permlane32_swap(__float_as_uint(pmax), __float_as_uint(pmax), false, false);
    pmax = fmaxf(__uint_as_float(rr[0]), __uint_as_float(rr[1])); }
  if (__builtin_expect(__all(pmax - m_reg <= THR / SCALE), 1)) { mn = m_reg; alpha = 1.f; }
  else { mn = fmaxf(m_reg, pmax); alpha = __builtin_amdgcn_exp2f((m_reg - mn) * C); m_reg = mn; }
  float mnC = -mn * C;
#pragma unroll
  for (int r = 0; r < 16; ++r) p0[r] = fmaf(p0[r], C, mnC);
#pragma unroll
  for (int r = 0; r < 16; ++r) p1[r] = fmaf(p1[r], C, mnC);
#pragma unroll
  for (int r = 0; r < 16; ++r) p0[r] = __builtin_amdgcn_exp2f(p0[r]);
}
__device__ __forceinline__ void finishSM(f32x16& p0, f32x16& p1, float alpha, float& l_reg, bf16x8& pa0, bf16x8& pa1, bf16x8& pa2, bf16x8& pa3) {
#pragma unroll
  for (int r = 0; r < 16; ++r) p1[r] = __builtin_amdgcn_exp2f(p1[r]);
  float ps = 0;
#pragma unroll
  for (int r = 0; r < 16; ++r) ps += p0[r];
#pragma unroll
  for (int r = 0; r < 16; ++r) ps += p1[r];
  { auto rr = __builtin_amdgcn_permlane32_swap(__float_as_uint(ps), __float_as_uint(ps), false, false);
    ps = __uint_as_float(rr[0]) + __uint_as_float(rr[1]); }
  l_reg = l_reg * alpha + ps;
#define PK4(P, BASE, OUT) do { unsigned a0 = cvtpk(P[BASE + 0], P[BASE + 1]), a1 = cvtpk(P[BASE + 2], P[BASE + 3]);   \
    unsigned b0 = cvtpk(P[BASE + 4], P[BASE + 5]), b1 = cvtpk(P[BASE + 6], P[BASE + 7]);                              \
    auto r0 = __builtin_amdgcn_permlane32_swap(a0, b0, false, false); auto r1 = __builtin_amdgcn_permlane32_swap(a1, b1, false, false); \
    u32x4 w = {r0[0], r1[0], r0[1], r1[1]}; OUT = *reinterpret_cast<bf16x8*>(&w); } while (0)
  PK4(p0, 0, pa0); PK4(p0, 8, pa1); PK4(p1, 0, pa2); PK4(p1, 8, pa3);
#undef PK4
}
__device__ __forceinline__ void qkt(f32x16& p0, f32x16& p1, const bf16* Ks, const bf16x8* qr, int r32, int hi) {
  p0 = f32x16{}; p1 = f32x16{};
#pragma unroll
  for (int d0 = 0; d0 < 6; ++d0) { int cb = (d0 * 16 + hi * 8) * 2;
    bf16x8 b0 = *reinterpret_cast<const bf16x8*>((const char*)Ks + KSWZ(r32, cb));
    bf16x8 b1 = *reinterpret_cast<const bf16x8*>((const char*)Ks + KSWZ(32 + r32, cb));
    p0 = __builtin_amdgcn_mfma_f32_32x32x16_bf16(b0, qr[d0], p0, 0, 0, 0);
    p1 = __builtin_amdgcn_mfma_f32_32x32x16_bf16(b1, qr[d0], p1, 0, 0, 0); }
}
__device__ __forceinline__ int v_st(int k, int c) { const int kk = (k & ~0xC) | ((k & 4) << 1) | ((k & 8) >> 1); return ((kk >> 3) * 4 + (c >> 5)) * 512 + ((kk & 7) * 32 + (c & 31)) * 2; }
__device__ __forceinline__ int v_rd_base(int lane) { return ((lane & 3) << 3) | (((lane >> 2) & 3) << 6) | (((lane >> 4) & 1) << 5) | (((lane >> 5) & 1) << 8); }
constexpr int v_rd_off(int d0, int ks, int half) { return d0 * 512 + ks * 4096 + half * 2048; }
template <int OFF> __device__ __forceinline__ s16x4 tr_read(int vb) {
  s16x4 r; asm volatile("ds_read_b64_tr_b16 %0, %1 offset:%2" : "=&v"(r) : "v"(vb), "i"(OFF) : "memory"); return r;
}
template <int D0> __device__ __forceinline__ void pv_one(f32x16& od, int vb, bf16x8 pa0, bf16x8 pa1, bf16x8 pa2, bf16x8 pa3) {
  const s16x4 l0 = tr_read<v_rd_off(D0, 0, 0)>(vb), h0 = tr_read<v_rd_off(D0, 0, 1)>(vb), l1 = tr_read<v_rd_off(D0, 1, 0)>(vb), h1 = tr_read<v_rd_off(D0, 1, 1)>(vb);
  const s16x4 l2 = tr_read<v_rd_off(D0, 2, 0)>(vb), h2 = tr_read<v_rd_off(D0, 2, 1)>(vb), l3 = tr_read<v_rd_off(D0, 3, 0)>(vb), h3 = tr_read<v_rd_off(D0, 3, 1)>(vb);
  asm volatile("s_waitcnt lgkmcnt(0)" ::: "memory"); SBAR();
#define PK(L, H) (bf16x8){L[0], L[1], L[2], L[3], H[0], H[1], H[2], H[3]}
  od = __builtin_amdgcn_mfma_f32_32x32x16_bf16(pa0, PK(l0, h0), od, 0, 0, 0);
  od = __builtin_amdgcn_mfma_f32_32x32x16_bf16(pa1, PK(l1, h1), od, 0, 0, 0);
  od = __builtin_amdgcn_mfma_f32_32x32x16_bf16(pa2, PK(l2, h2), od, 0, 0, 0);
  od = __builtin_amdgcn_mfma_f32_32x32x16_bf16(pa3, PK(l3, h3), od, 0, 0, 0);
#undef PK
}
__device__ __forceinline__ void pv_d0(f32x16* o, int vb, bf16x8 pa0, bf16x8 pa1, bf16x8 pa2, bf16x8 pa3) {
  pv_one<0>(o[0], vb, pa0, pa1, pa2, pa3); pv_one<1>(o[1], vb, pa0, pa1, pa2, pa3);
}
__device__ __forceinline__ bf16x8 rope8(bf16x8 x, const float* tab, int pbase) {
  u32x4 w;
#pragma unroll
  for (int i = 0; i < 4; ++i) { const float x1 = __uint_as_float(((unsigned)(unsigned short)x[2 * i]) << 16), x2 = __uint_as_float(((unsigned)(unsigned short)x[2 * i + 1]) << 16);
    const float cs = tab[pbase + i], sn = tab[16 + pbase + i]; w[i] = cvtpk(x1 * cs - x2 * sn, x1 * sn + x2 * cs); }
  return *reinterpret_cast<bf16x8*>(&w);
}
__device__ __forceinline__ void attn_unit(const bf16* __restrict__ Qb, const bf16* __restrict__ KVb, const bf16* __restrict__ KRb, bf16* __restrict__ Ob,
                                          const float* __restrict__ rope, int seq, char* lds) {
  int tid_l = threadIdx.x; asm volatile("" : "+v"(tid_l));
  const int tid = tid_l, wid = tid >> 6, lane = tid & 63, r32 = lane & 31, hi = lane >> 5;
  bf16* V_lds = (bf16*)lds; bf16* K_lds = (bf16*)(lds + 2 * SHM_V);
  float* ws = (float*)(lds + 2 * SHM_V + 2 * SHM_K) + wid * 64; float* li_l = ws; float* al_l = ws + 32;
  float m_reg = -1e30f, l_reg = 0; f32x16 o[2] = {}; bf16x8 qr[6];
  const bf16* Qw = Qb + (long)(wid * QBLK + r32) * 768 + hi * 8;
#pragma unroll
  for (int d0 = 0; d0 < 6; ++d0) qr[d0] = *reinterpret_cast<const bf16x8*>(Qw + d0 * 16);
  if (rope) { const float* tab = rope + (long)(wid * QBLK + r32) * 32; qr[4] = rope8(qr[4], tab, 4 * hi); qr[5] = rope8(qr[5], tab, 8 + 4 * hi); }
  const int sr = tid >> 4, ch = tid & 15;
  const bf16* kbase = ch < 8 ? KVb + ch * 8 : KRb + ((ch - 8) & 3) * 8; const long kstr = ch < 8 ? 1024 : 32;
  const int vkey = tid >> 3, vc8 = (tid & 7) * 8, vst0 = v_st(vkey, vc8);
  const bf16* vbase = KVb + 512 + vc8;
  const int vb0 = (int)(uintptr_t)V_lds + v_rd_base(lane);
  struct { bf16x8 vs0, ks0, ks1; } sr_[2];
#define SLOAD(i, k0) do { sr_[i].vs0 = *reinterpret_cast<const bf16x8*>(vbase + (long)((k0) + vkey) * 1024); \
    sr_[i].ks0 = *reinterpret_cast<const bf16x8*>(kbase + (long)((k0) + sr) * kstr); sr_[i].ks1 = *reinterpret_cast<const bf16x8*>(kbase + (long)((k0) + 32 + sr) * kstr); } while (0)
#define SWRITE(b, i) do { *(bf16x8*)((char*)V_lds + (b) * SHM_V + vst0) = sr_[i].vs0; int kc = ch * 16;               \
    *(bf16x8*)((char*)K_lds + (b) * SHM_K + KSWZ(sr, kc)) = sr_[i].ks0;                       \
    *(bf16x8*)((char*)K_lds + (b) * SHM_K + KSWZ(32 + sr, kc)) = sr_[i].ks1; } while (0)
#define SWAIT() asm volatile("s_waitcnt vmcnt(3)" ::: "memory")
#define RESC(a) do { if (__any((a) < 1.f)) { if (hi == 0) al_l[r32] = (a); asm volatile("s_waitcnt lgkmcnt(0)" ::: "memory"); \
    _Pragma("unroll") for (int d = 0; d < 2; ++d) _Pragma("unroll") for (int r = 0; r < 16; ++r) o[d][r] *= al_l[crow(r, hi)]; } } while (0)
  f32x16 pA0, pA1, pB0, pB1; float mnA, mnB, alA, alB; bf16x8 pa0, pa1, pa2, pa3; const int NT = seq / KVBLK;
  constexpr int SE = 0, SO = 1;
  SLOAD(SE, 0); asm volatile("s_waitcnt vmcnt(0)" ::: "memory"); SWRITE(0, SE); __syncthreads();
  qkt(pA0, pA1, K_lds, qr, r32, hi); partialSM(pA0, pA1, m_reg, mnA, alA);
  SLOAD(SO, KVBLK); if (2 < NT) SLOAD(SE, 2 * KVBLK);
  SWAIT(); SWRITE(1, SO); __syncthreads();
  for (int j = 1; j + 1 < NT; j += 2) {
    SBAR(); qkt(pB0, pB1, (bf16*)((char*)K_lds + SHM_K), qr, r32, hi);
    finishSM(pA0, pA1, alA, l_reg, pa0, pa1, pa2, pa3); SBAR();
    SLOAD(SO, (j + 2) * KVBLK); SBAR();
    pv_d0(o, vb0, pa0, pa1, pa2, pa3); partialSM(pB0, pB1, m_reg, mnB, alB);
    __syncthreads(); SWAIT(); SWRITE(0, SE);
    RESC(alB); __syncthreads();
    SBAR(); qkt(pA0, pA1, K_lds, qr, r32, hi);
    finishSM(pB0, pB1, alB, l_reg, pa0, pa1, pa2, pa3); SBAR();
    if (j + 3 < NT) SLOAD(SE, (j + 3) * KVBLK); SBAR();
    pv_d0(o, vb0 + (int)SHM_V, pa0, pa1, pa2, pa3); partialSM(pA0, pA1, m_reg, mnA, alA);
    __syncthreads(); SWAIT(); SWRITE(1, SO);
    RESC(alA); __syncthreads();
  }
  SBAR(); qkt(pB0, pB1, (bf16*)((char*)K_lds + SHM_K), qr, r32, hi);
  finishSM(pA0, pA1, alA, l_reg, pa0, pa1, pa2, pa3); SBAR();
  pv_d0(o, vb0, pa0, pa1, pa2, pa3); partialSM(pB0, pB1, m_reg, mnB, alB);
  __syncthreads(); RESC(alB);
  finishSM(pB0, pB1, alB, l_reg, pa0, pa1, pa2, pa3); SBAR();
  pv_d0(o, vb0 + (int)SHM_V, pa0, pa1, pa2, pa3);
  if (hi == 0) li_l[r32] = l_reg; asm volatile("s_waitcnt lgkmcnt(0)" ::: "memory");
  float rli[16];
#pragma unroll
  for (int r = 0; r < 16; ++r) rli[r] = __builtin_amdgcn_rcpf(li_l[crow(r, hi)]);
  bf16* Ow = Ob + (long)(wid * QBLK) * 1024;
#pragma unroll
  for (int r = 0; r < 16; ++r) { int orow = crow(r, hi);
#pragma unroll
    for (int d0 = 0; d0 < 2; ++d0) { const float v = o[d0][r] * rli[r]; Ow[(long)orow * 1024 + d0 * 32 + r32] = (bf16)(cvtpk(v, v) & 0xffffu); } }
#undef SLOAD
#undef SWRITE
#undef SWAIT
#undef RESC
}
}

struct Args { const float* in[33]; float* out; unsigned char* ws; int ph_lo, ph_hi; };
enum { I_X = 0, I_C, I_CTX, I_CCTX, I_MODW, I_MODB, I_LN1G, I_LN1B, I_LN2G, I_LN2B, I_WIN, I_QNORM, I_KVNORM, I_WUQ, I_WUK, I_WUV, I_LBL, I_HGNORM, I_WOUT,
       I_PW1W, I_PW1B, I_DWW, I_DWB, I_CLNG, I_CLNB, I_PW2W, I_PW2B, I_RW, I_RB, I_WGU, I_BGU, I_WDN, I_BDN };

__device__ __forceinline__ int dst_row(int n, int mode, int row_off) {
    if (mode == 0) return row_off + n;
    int f, g; if (mode == 1) { f = n >> 1; g = n & 1; } else { g = n >> 10; f = n & 1023; }
    return row_off + 256 * (f >> 7) + 128 * g + (f & 127);
}
__device__ __forceinline__ void tr_item(const float* __restrict__ W, int K, int N, bf16* __restrict__ WT, int mode, int row_off, LAS float* scr, int item, int lane) {
    const int nblk = (N + 63) >> 6, kb = item / nblk, nb = item - kb * nblk, k0 = 64 * kb, n0 = 64 * nb;
    const int nc = n0 + 4 * (lane & 15), kr = lane >> 4;
    f32x4 v[16];
#pragma unroll
    for (int i = 0; i < 16; ++i) v[i] = (nc < N) ? *(const f32x4*)(W + (size_t)(k0 + 4 * i + kr) * N + nc) : (f32x4){0.f, 0.f, 0.f, 0.f};
#pragma unroll
    for (int i = 0; i < 16; ++i) { LAS float* s = scr + (4 * i + kr) * 65 + 4 * (lane & 15); s[0] = v[i][0]; s[1] = v[i][1]; s[2] = v[i][2]; s[3] = v[i][3]; }
    LDS_WAIT();
    const int c = lane & 7;
#pragma unroll
    for (int j = 0; j < 8; ++j) { const int nl = (lane >> 3) + 8 * j, n = n0 + nl; const LAS float* s = scr + (8 * c) * 65 + nl;
        v4u o; o.x = pk2(s[0 * 65], s[1 * 65]); o.y = pk2(s[2 * 65], s[3 * 65]); o.z = pk2(s[4 * 65], s[5 * 65]); o.w = pk2(s[6 * 65], s[7 * 65]);
        if (n < N) *(v4u*)(WT + (size_t)dst_row(n, mode, row_off) * K + k0 + 8 * c) = o; }
    LDS_WAIT();
}
__device__ __forceinline__ void phase_prologue(const Args& a, LAS unsigned char* lds, int tid, int lane, int wave) {
    unsigned char* ws = a.ws;
    const int G = gridDim.x, B = blockIdx.x;
    {
        LAS float* sc = (LAS float*)lds;
        LAS float* red = (LAS float*)(lds + 36864);
        float* modv = (float*)(ws + WS_MODV);
        bool have = false;
        for (int it = B; it < 192; it += G) {
            if (!have) { for (int i = tid; i < 9 * 1024; i += NTHR) { const int r = i >> 10, k = i & 1023; const float x = r < 8 ? a.in[I_C][r * 1024 + k] : a.in[I_CCTX][k]; sc[i] = x * sigm(x); } __syncthreads(); have = true; }
            const int l = it / 96, jc = it % 96, kg = tid >> 6, jj = tid & 63, j = jc * 64 + jj;
            float acc[9];
#pragma unroll
            for (int r = 0; r < 9; ++r) acc[r] = 0.f;
            const float* wp = a.in[I_MODW] + ((size_t)l * 1024 + kg * 128) * 6144 + j;
            for (int k0 = 0; k0 < 128; k0 += 16) { float w[16];
#pragma unroll
                for (int kk = 0; kk < 16; ++kk) w[kk] = wp[(size_t)(k0 + kk) * 6144];
#pragma unroll
                for (int kk = 0; kk < 16; ++kk)
#pragma unroll
                    for (int r = 0; r < 9; ++r) acc[r] += sc[r * 1024 + kg * 128 + k0 + kk] * w[kk]; }
#pragma unroll
            for (int r = 0; r < 9; ++r) red[(kg * 9 + r) * 64 + jj] = acc[r];
            __syncthreads();
            for (int i = tid; i < 576; i += NTHR) { const int r = i >> 6, j2 = i & 63; float s = a.in[I_MODB][l * 6144 + jc * 64 + j2];
#pragma unroll
                for (int g = 0; g < 8; ++g) s += red[(g * 9 + r) * 64 + j2];
                modv[((size_t)l * 9 + r) * 6144 + jc * 64 + j2] = s; }
            __syncthreads();
        }
        __syncthreads();
    }
    const int gw = B * NWAVES + wave, NGW = G * NWAVES, gt = B * NTHR + tid, NGT = G * NTHR;
    { float* rope = (float*)(ws + WS_ROPE);
      for (int i = gt; i < 4096 * 16; i += NGT) { const int t = i >> 4, p = i & 15; const float pos = (float)(p < 8 ? (t >> 6) : (t & 63));
          const float inv = __powf(10000.0f, -(float)(p & 7) * 0.125f); const float ang = pos * inv; rope[t * 32 + p] = cosf(ang); rope[t * 32 + 16 + p] = sinf(ang); }
      float* bgu = (float*)(ws + WS_BGU);
      for (int i = gt; i < 2 * 32 * 2048; i += NGT) { const int le = i >> 11, np = i & 2047, q = np >> 8, g = (np >> 7) & 1, r = np & 127, f = 128 * q + r; bgu[i] = a.in[I_BGU][(size_t)le * 2048 + 2 * f + g]; }
      float* pb = (float*)(ws + WS_PW1B);
      for (int i = gt; i < 2048; i += NGT) { const int q = i >> 8, g = (i >> 7) & 1, r = i & 127, f = 128 * q + r; pb[i] = a.in[I_PW1B][g * 1024 + f]; }
      v4u* zp = (v4u*)(ws + WS_WIN + (size_t)3232 * 1024 * 2);
      for (int i = gt; i < 96 * 1024 * 2 / 16; i += NGT) zp[i] = (v4u){0u, 0u, 0u, 0u};
    }
    LAS float* scr = (LAS float*)(lds + wave * 16640);
    constexpr int I0 = 16 * 51, I1 = 6 * 12, I2 = 4 * 8, I3 = 4 * 8, I4 = 256, I5 = 512, I6 = 256, SMALL = I0 + I1 + I2 + I3 + I4 + I5 + I6;
    constexpr int NGU = 64 * 512, NDN = 64 * 256, NITEMS = SMALL + NGU + NDN;
    for (int it = gw; it < NITEMS; it += NGW) {
        int r = it;
        if (r < NGU) { const int mi = r >> 9; tr_item(a.in[I_WGU] + (size_t)mi * 1024 * 2048, 1024, 2048, (bf16*)(ws + WS_WGU) + (size_t)mi * 2048 * 1024, 1, 0, scr, r & 511, lane); continue; } r -= NGU;
        if (r < NDN) { const int mi = r >> 8; tr_item(a.in[I_WDN] + (size_t)mi * 1024 * 1024, 1024, 1024, (bf16*)(ws + WS_WDN) + (size_t)mi * 1024 * 1024, 0, 0, scr, r & 255, lane); continue; } r -= NDN;
        if (r < I0) { tr_item(a.in[I_WIN], 1024, 3232, (bf16*)(ws + WS_WIN), 0, 0, scr, r, lane); continue; } r -= I0;
        if (r < I1) { tr_item(a.in[I_WUQ], 384, 768, (bf16*)(ws + WS_WUQ), 0, 0, scr, r, lane); continue; } r -= I1;
        if (r < I2) { tr_item(a.in[I_WUK], 256, 512, (bf16*)(ws + WS_WUKV), 0, 0, scr, r, lane); continue; } r -= I2;
        if (r < I3) { tr_item(a.in[I_WUV], 256, 512, (bf16*)(ws + WS_WUKV), 0, 512, scr, r, lane); continue; } r -= I3;
        if (r < I4) { tr_item(a.in[I_WOUT], 1024, 1024, (bf16*)(ws + WS_WOUT), 0, 0, scr, r, lane); continue; } r -= I4;
        if (r < I5) { tr_item(a.in[I_PW1W], 1024, 2048, (bf16*)(ws + WS_WPW1), 2, 0, scr, r, lane); continue; } r -= I5;
        tr_item(a.in[I_PW2W], 1024, 1024, (bf16*)(ws + WS_WPW2), 0, 0, scr, r, lane);
    }
}

__device__ __forceinline__ void phase_mod0(const Args& a, int lane, int wave) {
    const int gw = blockIdx.x * NWAVES + wave, NGW = gridDim.x * NWAVES;
    const float* modv = (const float*)(a.ws + WS_MODV);
    bf16* X = (bf16*)(a.ws + WS_X);
    for (int r = gw; r < NTOK; r += NGW) {
        const int b = r / TPB, p = r - b * TPB;
        const float* src = p < CTXL ? a.in[I_CTX] + ((size_t)b * CTXL + p) * 1024 : a.in[I_X] + ((size_t)b * SEQ + (p - CTXL)) * 1024;
        const float* mv = modv + (size_t)(p < CTXL ? 8 : b) * 6144;
#pragma unroll
        for (int j = 0; j < 4; ++j) { const int c = 4 * (lane + 64 * j); const f32x4 xv = *(const f32x4*)(src + c), sh = *(const f32x4*)(mv + c), sc = *(const f32x4*)(mv + 1024 + c);
            const f32x4 y = xv * (sc + 1.0f) + sh; v2u o; o.x = pk2(y[0], y[1]); o.y = pk2(y[2], y[3]); *(v2u*)(X + (size_t)r * 1024 + c) = o; }
    }
}

__device__ __forceinline__ void phase_norm0(const Args& a, int lane, int wave) {
    const int gw = blockIdx.x * NWAVES + wave, NGW = gridDim.x * NWAVES;
    const bf16* Z = (const bf16*)(a.ws + WS_Z); bf16* CQN = (bf16*)(a.ws + WS_CQN); bf16* CKVN = (bf16*)(a.ws + WS_CKVN); bf16* KRR = (bf16*)(a.ws + WS_KRR);
    const float* rope = (const float*)(a.ws + WS_ROPE);
    float gq[8], gk[8];
#pragma unroll
    for (int i = 0; i < 8; ++i) { gq[i] = lane < 48 ? a.in[I_QNORM][8 * lane + i] : 0.f; gk[i] = lane < 32 ? a.in[I_KVNORM][8 * lane + i] : 0.f; }
    for (int r = gw; r < NTOK; r += NGW) {
        const bf16* z = Z + (size_t)r * ZC; const int p = r % TPB;
        bf16x8 q8 = {}, k8 = {}, r8 = {};
        if (lane < 48) q8 = *(const bf16x8*)(z + ZQ + 8 * lane);
        if (lane < 32) k8 = *(const bf16x8*)(z + ZKV + 8 * lane);
        if (lane < 4) r8 = *(const bf16x8*)(z + ZKR + 8 * lane);
        float qf[8], kf[8], sq = 0.f, sk = 0.f;
#pragma unroll
        for (int i = 0; i < 8; ++i) { qf[i] = bf2f((unsigned short)q8[i]); kf[i] = bf2f((unsigned short)k8[i]); sq += qf[i] * qf[i]; sk += kf[i] * kf[i]; }
        sq = wave_sum(sq); sk = wave_sum(sk);
        const float rq = rsqrtf(sq * (1.f / 384.f) + RMS_EPS), rk = rsqrtf(sk * (1.f / 256.f) + RMS_EPS);
        if (lane < 48) { v4u o; o.x = pk2(qf[0] * rq * gq[0], qf[1] * rq * gq[1]); o.y = pk2(qf[2] * rq * gq[2], qf[3] * rq * gq[3]); o.z = pk2(qf[4] * rq * gq[4], qf[5] * rq * gq[5]); o.w = pk2(qf[6] * rq * gq[6], qf[7] * rq * gq[7]);
            *(v4u*)(CQN + (size_t)r * 384 + 8 * lane) = o; }
        if (lane < 32) { v4u o; o.x = pk2(kf[0] * rk * gk[0], kf[1] * rk * gk[1]); o.y = pk2(kf[2] * rk * gk[2], kf[3] * rk * gk[3]); o.z = pk2(kf[4] * rk * gk[4], kf[5] * rk * gk[5]); o.w = pk2(kf[6] * rk * gk[6], kf[7] * rk * gk[7]);
            *(v4u*)(CKVN + (size_t)r * 256 + 8 * lane) = o; }
        if (lane < 4) { bf16x8 o8 = r8; if (p >= CTXL) o8 = att::rope8(r8, rope + (size_t)(p - CTXL) * 32, 4 * lane); *(bf16x8*)(KRR + (size_t)r * 32 + 8 * lane) = o8; }
    }
}

__device__ __forceinline__ void hgrn_unit(const Args& a, int unit, LAS unsigned char* lds, int tid) {
    const int b = unit >> 5, head = (unit >> 3) & 3, dir = (unit >> 2) & 1, sl = unit & 3;
    const bf16* Z = (const bf16*)(a.ws + WS_Z);
    float* Od = (float*)(a.ws + (dir ? WS_OB : WS_OF));
    LAS float* lbv = (LAS float*)lds;
    constexpr int BUF0 = 1024, BUFSZ = 28672, OFF_Q = 16384, OFF_V = 24576;
    if (tid < 128) { const int c = head * 128 + tid; const float l0 = a.in[I_LBL][c], l1 = a.in[I_LBL][512 + c], l2 = a.in[I_LBL][1024 + c]; const float m = fmaxf(l0, fmaxf(l1, l2));
        const float e0 = __expf(l0 - m), e1 = __expf(l1 - m), e2 = __expf(l2 - m); lbv[tid] = e0 / (e0 + e1 + e2); }
    __syncthreads();
    const int lt = tid >> 4, lcg = tid & 15;
    float lb8[8];
#pragma unroll
    for (int i = 0; i < 8; ++i) lb8[i] = lbv[8 * lcg + i];
    const int fcol = (dir ? ZHB : ZHF) + head * 128 + 8 * lcg, qcol = ZHQ + head * 128 + 8 * lcg;
    const int vt = tid >> 2, vcol = ZHI + head * 128 + sl * 32 + (tid & 3) * 8;
    const int wave = tid >> 6, lane = tid & 63, vv = lane >> 4, cg = lane & 15, vloc = wave * 4 + vv;
    const size_t zb = (size_t)b * TPB;
    bf16x8 rq, rf, rv;
#define TOKP(n) (dir ? ((n) < CTXL ? (CTXL - 1 - (n)) : (TPB + CTXL - 1 - (n))) : (n))
#define HG_LOAD(i) do { const int n_ = 32 * (i) + lt; const bf16* zr_ = Z + (zb + TOKP(n_)) * ZC; rq = *(const bf16x8*)(zr_ + qcol); rf = *(const bf16x8*)(zr_ + fcol); \
        if (tid < 128) { const int n2_ = 32 * (i) + vt; rv = *(const bf16x8*)(Z + (zb + TOKP(n2_)) * ZC + vcol); } } while (0)
#define HG_WRITE(bufi) do { LAS unsigned char* bp_ = lds + BUF0 + (bufi) * BUFSZ; float f_[8]; \
        _Pragma("unroll") for (int i_ = 0; i_ < 8; ++i_) f_[i_] = lb8[i_] + (1.f - lb8[i_]) * sigm(bf2f((unsigned short)rf[i_])); \
        *(LAS f32x4*)(bp_ + ((lt * 128 + lcg * 4) * 4)) = (f32x4){f_[0], f_[1], f_[2], f_[3]}; *(LAS f32x4*)(bp_ + ((lt * 128 + 64 + lcg * 4) * 4)) = (f32x4){f_[4], f_[5], f_[6], f_[7]}; \
        *(LAS bf16x8*)(bp_ + OFF_Q + (lt * 128 + lcg * 8) * 2) = rq; \
        if (tid < 128) { float v_[8]; _Pragma("unroll") for (int i_ = 0; i_ < 8; ++i_) v_[i_] = bf2f((unsigned short)rv[i_]); \
            *(LAS f32x4*)(bp_ + OFF_V + (vt * 32 + (tid & 3) * 8) * 4) = (f32x4){v_[0], v_[1], v_[2], v_[3]}; *(LAS f32x4*)(bp_ + OFF_V + (vt * 32 + (tid & 3) * 8 + 4) * 4) = (f32x4){v_[4], v_[5], v_[6], v_[7]}; } } while (0)
    float S[8];
#pragma unroll
    for (int j = 0; j < 8; ++j) S[j] = 0.f;
    HG_LOAD(0); HG_WRITE(0); __syncthreads();
    const bool b3 = (cg & 8) != 0, b2 = (cg & 4) != 0, b1 = (cg & 2) != 0, b0 = (cg & 1) != 0;
    for (int i = 0; i < TPB / 32; ++i) {
        if (i + 1 < TPB / 32) HG_LOAD(i + 1);
        const LAS unsigned char* bp = lds + BUF0 + (i & 1) * BUFSZ;
#pragma unroll 1
        for (int g = 0; g < 4; ++g) {
            const LAS unsigned char* gp = bp + g * 8 * 512;
            float ot[8];
#pragma unroll
            for (int t = 0; t < 8; ++t) {
                const f32x4 f0 = *(const LAS f32x4*)(gp + ((t * 128 + cg * 4) * 4)), f1 = *(const LAS f32x4*)(gp + ((t * 128 + 64 + cg * 4) * 4));
                const bf16x8 q8 = *(const LAS bf16x8*)(bp + OFF_Q + ((g * 8 + t) * 128 + cg * 8) * 2);
                const float v = *(const LAS float*)(bp + OFF_V + ((g * 8 + t) * 32 + vloc) * 4);
                float acc = 0.f;
#pragma unroll
                for (int j = 0; j < 8; ++j) { const float fj = j < 4 ? f0[j] : f1[j - 4]; const float qj = bf2f((unsigned short)q8[j]);
                    const float kv = fmaf(-fj, v, v); S[j] = fmaf(fj, S[j], kv); acc = fmaf(S[j], qj, acc); }
                ot[t] = acc;
            }
#pragma unroll
            for (int k = 0; k < 4; ++k) { const float snd = b3 ? ot[k] : ot[k + 4]; const float rcv = __shfl_xor(snd, 8); ot[k] = (b3 ? ot[k + 4] : ot[k]) + rcv; }
#pragma unroll
            for (int k = 0; k < 2; ++k) { const float snd = b2 ? ot[k] : ot[k + 2]; const float rcv = __shfl_xor(snd, 4); ot[k] = (b2 ? ot[k + 2] : ot[k]) + rcv; }
            { const float snd = b1 ? ot[0] : ot[1]; const float rcv = __shfl_xor(snd, 2); ot[0] = (b1 ? ot[1] : ot[0]) + rcv; }
            ot[0] += __shfl_xor(ot[0], 1);
            if (!b0) { const int n = 32 * i + 8 * g + (cg >> 1); const int p = TOKP(n); if (p >= CTXL) Od[(zb + p) * 512 + head * 128 + sl * 32 + vloc] = ot[0]; }
        }
        if (i + 1 < TPB / 32) HG_WRITE((i + 1) & 1);
        __syncthreads();
    }
#undef TOKP
#undef HG_LOAD
#undef HG_WRITE
}

__device__ __forceinline__ void phase_readout(const Args& a, int lane, int wave) {
    const int gw = blockIdx.x * NWAVES + wave, NGW = gridDim.x * NWAVES;
    const float* OF = (const float*)(a.ws + WS_OF); const float* OB = (const float*)(a.ws + WS_OB);
    const bf16* Z = (const bf16*)(a.ws + WS_Z); bf16* MIX = (bf16*)(a.ws + WS_Y);
    float hn[8];
#pragma unroll
    for (int i = 0; i < 8; ++i) hn[i] = a.in[I_HGNORM][((8 * lane) & 127) + i];
    for (int lr = gw; lr < NLAT; lr += NGW) {
        const size_t r = (size_t)grow_of(lr);
        const f32x4 a0 = *(const f32x4*)(OF + r * 512 + 8 * lane), a1 = *(const f32x4*)(OF + r * 512 + 8 * lane + 4);
        const f32x4 c0 = *(const f32x4*)(OB + r * 512 + 8 * lane), c1 = *(const f32x4*)(OB + r * 512 + 8 * lane + 4);
        const bf16x8 g8 = *(const bf16x8*)(Z + r * ZC + ZHG + 8 * lane);
        float o[8]; float ss = 0.f;
#pragma unroll
        for (int i = 0; i < 4; ++i) { o[i] = a0[i] + c0[i]; o[4 + i] = a1[i] + c1[i]; }
#pragma unroll
        for (int i = 0; i < 8; ++i) ss += o[i] * o[i];
        ss += __shfl_xor(ss, 1); ss += __shfl_xor(ss, 2); ss += __shfl_xor(ss, 4); ss += __shfl_xor(ss, 8);
        const float rs = rsqrtf(ss * (1.f / 128.f) + RMS_EPS);
        float y[8];
#pragma unroll
        for (int i = 0; i < 8; ++i) { const float g = bf2f((unsigned short)g8[i]); y[i] = o[i] * rs * hn[i] * (g * sigm(g)); }
        v4u w; w.x = pk2(y[0], y[1]); w.y = pk2(y[2], y[3]); w.z = pk2(y[4], y[5]); w.w = pk2(y[6], y[7]);
        *(v4u*)(MIX + r * 1024 + 512 + 8 * lane) = w;
    }
}

__device__ __forceinline__ int rows_per_block() { const int G = gridDim.x; return (((NLAT + G - 1) / G) + 15) & ~15; }
__device__ __forceinline__ void phase_ln1(const Args& a, int l, LAS unsigned char* lds, int tid, int lane, int wave) {
    const int RB = rows_per_block(), lr_base = blockIdx.x * RB;
    float* H = (float*)(a.ws + WS_H); bf16* XB = (bf16*)(a.ws + WS_X);
    const float* modv = (const float*)(a.ws + WS_MODV) + (size_t)l * 9 * 6144;
    const float* lng = a.in[I_LN1G] + l * 1024; const float* lnb = a.in[I_LN1B] + l * 1024;
    const float* rw = a.in[I_RW] + (size_t)l * 1024 * 32; const float* rb = a.in[I_RB] + l * 32;
    int* topi = (int*)(a.ws + WS_TOPI); float* topw = (float*)(a.ws + WS_TOPW);
    LAS float* rwl = (LAS float*)lds;
    LAS float* lgs = (LAS float*)(lds + 131072) + wave * 64;
    LAS int* hist = (LAS int*)(lds + 131072 + 2048);
    for (int i = tid; i < 8192; i += NTHR) { const int k = i >> 3, q = i & 7; *(LAS f32x4*)(rwl + k * 32 + 4 * (q ^ ((k >> 2) & 7))) = *(const f32x4*)(rw + k * 32 + 4 * q); }
    if (tid < 32) hist[tid] = 0;
    __syncthreads();
    const int sw = lane & 7;
    for (int i = 2 * wave; i < RB; i += 16) {
        const int lr0 = lr_base + i; if (lr0 >= NLAT) break;
        float vv[2][16];
#pragma unroll
        for (int rr = 0; rr < 2; ++rr) {
            const int lr = lr0 + rr; const size_t r = (size_t)grow_of(lr); const int b = lr >> 12;
            const float* mv = modv + (size_t)b * 6144;
            f32x4 x[4]; float s = 0.f;
#pragma unroll
            for (int j = 0; j < 4; ++j) { x[j] = *(const f32x4*)(H + r * 1024 + 4 * (lane + 64 * j)); s += (x[j][0] + x[j][1]) + (x[j][2] + x[j][3]); }
            const float mean = wave_sum(s) * (1.f / 1024.f); float s2 = 0.f;
#pragma unroll
            for (int j = 0; j < 4; ++j) { x[j] = x[j] - mean; s2 += (x[j][0] * x[j][0] + x[j][1] * x[j][1]) + (x[j][2] * x[j][2] + x[j][3] * x[j][3]); }
            const float rstd = rsqrtf(wave_sum(s2) * (1.f / 1024.f) + LN_EPS);
#pragma unroll
            for (int j = 0; j < 4; ++j) { const int c = 4 * (lane + 64 * j); const f32x4 g = *(const f32x4*)(lng + c), bb = *(const f32x4*)(lnb + c);
                const f32x4 hv = x[j] * rstd * g + bb; *(f32x4*)(H + r * 1024 + c) = hv;
                const f32x4 sh = *(const f32x4*)(mv + 3 * 1024 + c), sc = *(const f32x4*)(mv + 4 * 1024 + c);
                const f32x4 bm = hv * (sc + 1.0f) + sh; v2u o; o.x = pk2(bm[0], bm[1]); o.y = pk2(bm[2], bm[3]); *(v2u*)(XB + r * 1024 + c) = o;
                vv[rr][4 * j + 0] = bm[0]; vv[rr][4 * j + 1] = bm[1]; vv[rr][4 * j + 2] = bm[2]; vv[rr][4 * j + 3] = bm[3]; }
        }
        float p0[32], p1[32];
#pragma unroll
        for (int e = 0; e < 32; ++e) { p0[e] = 0.f; p1[e] = 0.f; }
#pragma unroll
        for (int j = 0; j < 4; ++j)
#pragma unroll
            for (int e4 = 0; e4 < 4; ++e4) { const int k = 4 * (lane + 64 * j) + e4; const float x0 = vv[0][4 * j + e4], x1 = vv[1][4 * j + e4];
#pragma unroll
                for (int q = 0; q < 8; ++q) { const f32x4 w = *(const LAS f32x4*)(rwl + k * 32 + 4 * (q ^ sw));
#pragma unroll
                    for (int c = 0; c < 4; ++c) { p0[4 * q + c] = fmaf(x0, w[c], p0[4 * q + c]); p1[4 * q + c] = fmaf(x1, w[c], p1[4 * q + c]); } } }
#define RS_STEP(P, NKEEP, BITV, XORV) _Pragma("unroll") for (int k_ = 0; k_ < NKEEP; ++k_) { const float snd_ = (BITV) ? P[k_] : P[k_ + NKEEP]; const float rcv_ = __shfl_xor(snd_, XORV); P[k_] = ((BITV) ? P[k_ + NKEEP] : P[k_]) + rcv_; }
        { const bool c5 = (lane & 32) != 0, c4 = (lane & 16) != 0, c3 = (lane & 8) != 0, c2 = (lane & 4) != 0, c1 = (lane & 2) != 0;
          RS_STEP(p0, 16, c5, 32) RS_STEP(p0, 8, c4, 16) RS_STEP(p0, 4, c3, 8) RS_STEP(p0, 2, c2, 4) RS_STEP(p0, 1, c1, 2)
          RS_STEP(p1, 16, c5, 32) RS_STEP(p1, 8, c4, 16) RS_STEP(p1, 4, c3, 8) RS_STEP(p1, 2, c2, 4) RS_STEP(p1, 1, c1, 2)
          p0[0] += __shfl_xor(p0[0], 1); p1[0] += __shfl_xor(p1[0], 1); }
#undef RS_STEP
        if ((lane & 1) == 0) { lgs[lane >> 1] = p0[0]; lgs[32 + (lane >> 1)] = p1[0]; }
        LDS_WAIT();
#pragma unroll
        for (int rr = 0; rr < 2; ++rr) {
            float lg[32];
#pragma unroll
            for (int q = 0; q < 8; ++q) { const f32x4 t4 = *(const LAS f32x4*)(lgs + rr * 32 + 4 * q); const f32x4 b4 = *(const f32x4*)(rb + 4 * q); lg[4 * q] = t4[0] + b4[0]; lg[4 * q + 1] = t4[1] + b4[1]; lg[4 * q + 2] = t4[2] + b4[2]; lg[4 * q + 3] = t4[3] + b4[3]; }
            unsigned taken = 0u; float tv[4]; int ti[4];
#pragma unroll
            for (int kk = 0; kk < 4; ++kk) { float best = -3.0e38f; int bi = 0;
#pragma unroll
                for (int e = 0; e < 32; ++e) { const bool ok = (lg[e] > best) && !((taken >> e) & 1u); best = ok ? lg[e] : best; bi = ok ? e : bi; }
                taken |= 1u << bi; tv[kk] = best; ti[kk] = bi; }
            const float e1 = __expf(tv[1] - tv[0]), e2 = __expf(tv[2] - tv[0]), e3 = __expf(tv[3] - tv[0]); const float inv = 1.f / (1.f + e1 + e2 + e3);
            if (lane == 0) { const int lr = lr0 + rr;
                *(int4*)(topi + (size_t)lr * 4) = make_int4(ti[0], ti[1], ti[2], ti[3]); *(f32x4*)(topw + (size_t)lr * 4) = (f32x4){inv, e1 * inv, e2 * inv, e3 * inv};
                __hip_atomic_fetch_add(hist + ti[0], 1, __ATOMIC_RELAXED, __HIP_MEMORY_SCOPE_WORKGROUP); __hip_atomic_fetch_add(hist + ti[1], 1, __ATOMIC_RELAXED, __HIP_MEMORY_SCOPE_WORKGROUP);
                __hip_atomic_fetch_add(hist + ti[2], 1, __ATOMIC_RELAXED, __HIP_MEMORY_SCOPE_WORKGROUP); __hip_atomic_fetch_add(hist + ti[3], 1, __ATOMIC_RELAXED, __HIP_MEMORY_SCOPE_WORKGROUP); }
        }
        LDS_WAIT();
    }
    __syncthreads();
    if (tid < 32) ((int*)(a.ws + WS_BCNT))[blockIdx.x * 32 + tid] = hist[tid];
}

__device__ __forceinline__ void phase_place(const Args& a, LAS unsigned char* lds, int tid, int lane, int wave) {
    const int G = gridDim.x, B = blockIdx.x, RB = rows_per_block(), lr_base = B * RB;
    LAS int* tot = (LAS int*)lds; LAS int* pre = tot + 32; LAS int* pstart = tot + 64; LAS int* basee = tot + 128; LAS int* til = tot + 256; LAS int* posl = til + 4096;
    const int* bcnt = (const int*)(a.ws + WS_BCNT);
    int* tile_e = (int*)(a.ws + WS_TILEE); int* meta = (int*)(a.ws + WS_META);
    const int* topi = (const int*)(a.ws + WS_TOPI); const float* topw = (const float*)(a.ws + WS_TOPW);
    float* roww = (float*)(a.ws + WS_ROWW); int* rowd = (int*)(a.ws + WS_ROWD);
    int* rows = (int*)(a.ws + WS_ROWS);
    { const int e = tid & 31, chn = tid >> 5; int t = 0, p = 0;
      for (int bb0 = chn; bb0 < G; bb0 += 64) { int c[4];
#pragma unroll
          for (int q = 0; q < 4; ++q) { const int bb = bb0 + 16 * q; c[q] = bb < G ? ld_ctl(bcnt + bb * 32 + e) : 0; }
#pragma unroll
          for (int q = 0; q < 4; ++q) { const int bb = bb0 + 16 * q; if (bb < B) p += c[q]; t += c[q]; } }
      posl[tid] = t; posl[512 + tid] = p; }
    __syncthreads();
    if (tid < 32) { int t = 0, p = 0;
#pragma unroll
        for (int q = 0; q < 16; ++q) { t += posl[q * 32 + tid]; p += posl[512 + q * 32 + tid]; }
        tot[tid] = t; pre[tid] = p; }
    __syncthreads();
    if (tid == 0) { int ps = 0; for (int e = 0; e < 32; ++e) { pstart[e] = ps; ps += ((tot[e] + 255) >> 8) << 8; } pstart[32] = ps; }
    __syncthreads();
    if (tid < 32) basee[tid] = pstart[tid] + pre[tid];
    const int ntiles = pstart[32] >> 8;
    if (B == 0) { for (int t = tid; t < ntiles; t += NTHR) { int e = 0; while (e < 31 && pstart[e + 1] <= t * 256) ++e; tile_e[t] = e; } if (tid == 0) meta[0] = ntiles; }
    for (int e = B; e < 32; e += G) for (int i = pstart[e] + tot[e] + tid; i < pstart[e + 1]; i += NTHR) { rowd[i] = -1; rows[i] = 0; }
    int nrows = NLAT - lr_base; nrows = nrows > RB ? RB : nrows; if (nrows < 0) nrows = 0;
    const int nas = nrows * 4;
    for (int i = tid; i < nas; i += NTHR) til[i] = topi[(size_t)lr_base * 4 + i];
    __syncthreads();
    if (tid < 32) { int n = basee[tid]; for (int i = 0; i < nas; ++i) if (til[i] == tid) posl[i] = n++; }
    __syncthreads();
    for (int i = tid; i < nas; i += NTHR) { const int lr = lr_base + (i >> 2); const int pos = posl[i]; rows[pos] = grow_of(lr); roww[pos] = topw[(size_t)lr * 4 + (i & 3)]; rowd[pos] = lr * 4 + (i & 3); }
}

__device__ __forceinline__ void phase_ln2(const Args& a, int l, int lane, int wave) {
    const int gw = blockIdx.x * NWAVES + wave, NGW = gridDim.x * NWAVES;
    float* H = (float*)(a.ws + WS_H); const bf16* YB = (const bf16*)(a.ws + WS_YB); bf16* A1 = (bf16*)(a.ws + WS_Y);
    const float* modv = (const float*)(a.ws + WS_MODV);
    const float* lng = a.in[I_LN2G] + l * 1024; const float* lnb = a.in[I_LN2B] + l * 1024;
    for (int lr0 = 2 * gw; lr0 < NLAT; lr0 += 2 * NGW) {
        f32x4 hv[2][4]; v2u yv[2][4][4];
#pragma unroll
        for (int q = 0; q < 2; ++q) { const int lr = lr0 + q; const size_t r = (size_t)grow_of(lr);
#pragma unroll
            for (int j = 0; j < 4; ++j) { const int c = 4 * (lane + 64 * j); hv[q][j] = *(const f32x4*)(H + r * 1024 + c);
#pragma unroll
                for (int k = 0; k < 4; ++k) yv[q][j][k] = *(const v2u*)(YB + ((size_t)lr * 4 + k) * 1024 + c); } }
#pragma unroll
        for (int q = 0; q < 2; ++q) {
            const int lr = lr0 + q; const size_t r = (size_t)grow_of(lr); const int b = lr >> 12;
            const float* mv = modv + ((size_t)l * 9 + b) * 6144; const float* mv1 = modv + ((size_t)9 + b) * 6144;
            f32x4 x[4]; float s = 0.f;
#pragma unroll
            for (int j = 0; j < 4; ++j) { const int c = 4 * (lane + 64 * j); f32x4 f = {0.f, 0.f, 0.f, 0.f};
#pragma unroll
                for (int k = 0; k < 4; ++k) { const v2u y = yv[q][j][k];
                    f[0] += __uint_as_float(y.x << 16); f[1] += __uint_as_float(y.x & 0xffff0000u); f[2] += __uint_as_float(y.y << 16); f[3] += __uint_as_float(y.y & 0xffff0000u); }
                const f32x4 gt = *(const f32x4*)(mv + 5 * 1024 + c);
                x[j] = hv[q][j] * ALPHA + gt * f; s += (x[j][0] + x[j][1]) + (x[j][2] + x[j][3]); }
            const float mean = wave_sum(s) * (1.f / 1024.f); float s2 = 0.f;
#pragma unroll
            for (int j = 0; j < 4; ++j) { x[j] = x[j] - mean; s2 += (x[j][0] * x[j][0] + x[j][1] * x[j][1]) + (x[j][2] * x[j][2] + x[j][3] * x[j][3]); }
            const float rstd = rsqrtf(wave_sum(s2) * (1.f / 1024.f) + LN_EPS);
#pragma unroll
            for (int j = 0; j < 4; ++j) { const int c = 4 * (lane + 64 * j); const f32x4 g = *(const f32x4*)(lng + c), bb = *(const f32x4*)(lnb + c);
                const f32x4 o = x[j] * rstd * g + bb;
                if (l == 0) { *(f32x4*)(H + r * 1024 + c) = o; const f32x4 sh = *(const f32x4*)(mv1 + c), sc = *(const f32x4*)(mv1 + 1024 + c);
                    const f32x4 am = o * (sc + 1.0f) + sh; v2u w; w.x = pk2(am[0], am[1]); w.y = pk2(am[2], am[3]); *(v2u*)(A1 + r * 1024 + c) = w; }
                else *(f32x4*)(a.out + (size_t)lr * 1024 + c) = o; }
        }
    }
}

__device__ __forceinline__ void phase_conv(const Args& a, LAS unsigned char* lds, int tid, int lane, int wave) {
    const bf16* U = (const bf16*)(a.ws + WS_X); bf16* V = (bf16*)(a.ws + WS_Y);
    LAS float* part = (LAS float*)(lds + 126976);
    LAS float* st = part + 512;
    const int c0 = 2 * tid;
    const float db0 = a.in[I_DWB][c0], db1 = a.in[I_DWB][c0 + 1], g0 = a.in[I_CLNG][c0], g1 = a.in[I_CLNG][c0 + 1], be0 = a.in[I_CLNB][c0], be1 = a.in[I_CLNB][c0 + 1];
    for (int tile = blockIdx.x; tile < NLAT / 32; tile += gridDim.x) {
        const int b = tile >> 7, t0 = (tile & 127) * 32;
        const size_t rb0 = (size_t)b * TPB + CTXL;
        __syncthreads();
        for (int i = tid; i < 62 * 128; i += NTHR) { const int row = i >> 7, chk = i & 127, t = t0 - 15 + row;
            v4u val = {0u, 0u, 0u, 0u}; if (t >= 0 && t < SEQ) val = *(const v4u*)(U + (rb0 + t) * 1024 + chk * 8);
            *(LAS v4u*)(lds + row * 2048 + chk * 16) = val; }
        __syncthreads();
        float w0[31], w1[31];
#pragma unroll
        for (int j = 0; j < 31; ++j) { const float2 wv = *(const float2*)(a.in[I_DWW] + j * 1024 + c0); w0[j] = wv.x; w1[j] = wv.y; }
#pragma unroll 1
        for (int hh = 0; hh < 2; ++hh) {
            const LAS unsigned char* hp = lds + hh * 16 * 2048;
            float acc0[16], acc1[16];
#pragma unroll
            for (int t = 0; t < 16; ++t) { acc0[t] = db0; acc1[t] = db1; }
#pragma unroll
            for (int s = 0; s < 46; ++s) { const unsigned pr = *(const LAS unsigned*)(hp + s * 2048 + tid * 4); const float x0 = __uint_as_float(pr << 16), x1 = __uint_as_float(pr & 0xffff0000u);
#pragma unroll
                for (int t = (s > 30 ? s - 30 : 0); t <= (s < 15 ? s : 15); ++t) { acc0[t] = fmaf(x0, w0[s - t], acc0[t]); acc1[t] = fmaf(x1, w1[s - t], acc1[t]); } }
            float rs[32];
#pragma unroll
            for (int t = 0; t < 16; ++t) { rs[2 * t] = acc0[t] + acc1[t]; rs[2 * t + 1] = acc0[t] * acc0[t] + acc1[t] * acc1[t]; }
#define RS_STEP(NKEEP, XORV) { const bool bit_ = (lane & XORV) != 0; _Pragma("unroll") for (int k_ = 0; k_ < NKEEP; ++k_) { const float snd_ = bit_ ? rs[k_] : rs[k_ + NKEEP]; const float rcv_ = __shfl_xor(snd_, XORV); rs[k_] = (bit_ ? rs[k_ + NKEEP] : rs[k_]) + rcv_; } }
            RS_STEP(16, 32) RS_STEP(8, 16) RS_STEP(4, 8) RS_STEP(2, 4) RS_STEP(1, 2)
#undef RS_STEP
            rs[0] += __shfl_xor(rs[0], 1);
            __syncthreads();
            if ((lane & 1) == 0) part[wave * 32 + (lane >> 1)] = rs[0];
            __syncthreads();
            if (tid < 16) { float s1 = 0.f, s2 = 0.f;
#pragma unroll
                for (int w = 0; w < 8; ++w) { s1 += part[w * 32 + 2 * tid]; s2 += part[w * 32 + 2 * tid + 1]; }
                const float mean = s1 * (1.f / 1024.f); const float var = fmaxf(s2 * (1.f / 1024.f) - mean * mean, 0.f); st[2 * tid] = mean; st[2 * tid + 1] = rsqrtf(var + LN_EPS); }
            __syncthreads();
#pragma unroll
            for (int t = 0; t < 16; ++t) { const float mean = st[2 * t], rstd = st[2 * t + 1];
                const float y0 = (acc0[t] - mean) * rstd * g0 + be0, y1 = (acc1[t] - mean) * rstd * g1 + be1;
                *(unsigned*)(V + (rb0 + t0 + hh * 16 + t) * 1024 + c0) = pk2(y0 * sigm(y0), y1 * sigm(y1)); }
        }
    }
}

namespace hg {
using bf16x8 = __attribute__((ext_vector_type(8))) short;
using s16x4  = __attribute__((ext_vector_type(4))) short;
using f32x16 = __attribute__((ext_vector_type(16))) float;
using u32x4  = __attribute__((ext_vector_type(4))) unsigned;
constexpr int RS = 272;
constexpr int VS = 80;
constexpr int T_Q = 0, T_KO = 32 * RS, T_KE = 64 * RS, T_V = 96 * RS, T_D = T_V + 32 * VS, TILE_BYTES = T_D + 512;
constexpr int OFF_TILES = 1024, OFF_OPART = OFF_TILES + 2 * TILE_BYTES, OPART_BYTES = 4 * 4096;
constexpr int OFF_RAW = OFF_OPART + 2 * OPART_BYTES, R_Q = 0, R_F = 32 * RS, R_V = 64 * RS, RAW_BYTES = R_V + 32 * VS;
static_assert(OFF_RAW + 2 * RAW_BYTES <= 147456 - 64, "hgrn lds");
__device__ __forceinline__ int crow(int r, int hi) { return (r & 3) + 8 * (r >> 2) + 4 * hi; }
__device__ __forceinline__ s16x4 tr_read(unsigned addr) { s16x4 r; asm volatile("ds_read_b64_tr_b16 %0, %1" : "=&v"(r) : "v"(addr) : "memory"); return r; }
__device__ __forceinline__ bf16x8 cat8(s16x4 l, s16x4 h) { return (bf16x8){l[0], l[1], l[2], l[3], h[0], h[1], h[2], h[3]}; }
__device__ __forceinline__ bf16x8 pack8(const f32x16& x, int base) {
    u32x4 w; w[0] = pk2(x[base + 0], x[base + 1]); w[1] = pk2(x[base + 2], x[base + 3]); w[2] = pk2(x[base + 4], x[base + 5]); w[3] = pk2(x[base + 6], x[base + 7]);
    return *reinterpret_cast<bf16x8*>(&w);
}
}

__device__ __forceinline__ void hgrn_unit_mfma(const Args& a, int unit, LAS unsigned char* lds, int tid) {
    using namespace hg;
    const int b = unit >> 5, head = (unit >> 3) & 3, dir = (unit >> 2) & 1, sl = unit & 3;
    const bf16* Z = (const bf16*)(a.ws + WS_Z);
    float* Od = (float*)(a.ws + (dir ? WS_OB : WS_OF));
    const int wave = __builtin_amdgcn_readfirstlane(tid >> 6), lane = tid & 63, t = lane & 31, half = lane >> 5;
    const int c0 = 16 * wave + 8 * half;
    float lb8[8];
#pragma unroll
    for (int i = 0; i < 8; ++i) { const int c = head * 128 + c0 + i; const float l0 = a.in[I_LBL][c], l1 = a.in[I_LBL][512 + c], l2 = a.in[I_LBL][1024 + c]; const float m = fmaxf(l0, fmaxf(l1, l2));
        const float e0 = __expf(l0 - m), e1 = __expf(l1 - m), e2 = __expf(l2 - m); lb8[i] = e0 / (e0 + e1 + e2); }
    const int fcol = (dir ? ZHB : ZHF) + head * 128 + c0, qcol = ZHQ + head * 128 + c0;
    const int vcol = ZHI + head * 128 + sl * 32 + c0;
    const size_t zb = (size_t)b * TPB;
    constexpr int NCH = TPB / 32;
#define TOKP(n) (dir ? ((n) < CTXL ? (CTXL - 1 - (n)) : (TPB + CTXL - 1 - (n))) : (n))
    const int lr = tid >> 4, lch = tid & 15, vr = (tid >> 2) & 31, vp = tid & 3;
    const int lqcol = ZHQ + head * 128 + lch * 8, lfcol = (dir ? ZHB : ZHF) + head * 128 + lch * 8, lvcol = ZHI + head * 128 + sl * 32 + vp * 8;
    bf16x8 gqA, gfA, gvA;
#define HG_LOAD(gq, gf, gv, ch) do { const int c_ = (ch) < NCH ? (ch) : NCH - 1; gq = *(const bf16x8*)(Z + (zb + TOKP(32 * c_ + lr)) * ZC + lqcol); gf = *(const bf16x8*)(Z + (zb + TOKP(32 * c_ + lr)) * ZC + lfcol); \
        gv = *(const bf16x8*)(Z + (zb + TOKP(32 * c_ + vr)) * ZC + lvcol); } while (0)
#define HG_STASH(gq, gf, gv, bufi) do { LAS unsigned char* rb_ = lds + OFF_RAW + (bufi) * RAW_BYTES; *(LAS bf16x8*)(rb_ + R_Q + lr * RS + lch * 16) = gq; *(LAS bf16x8*)(rb_ + R_F + lr * RS + lch * 16) = gf; \
        if (tid < 128) *(LAS bf16x8*)(rb_ + R_V + vr * VS + vp * 16) = gv; } while (0)
#define HG_DPP(x, ctrl, rmask) __int_as_float(__builtin_amdgcn_update_dpp(0, __float_as_int(x), ctrl, rmask, 0xf, false))
#define HG_PREP(bufi) do { LAS unsigned char* tb_ = lds + OFF_TILES + (bufi) * TILE_BYTES; const LAS unsigned char* rb_ = lds + OFF_RAW + (bufi) * RAW_BYTES; \
        const bf16x8 RQ = *(const LAS bf16x8*)(rb_ + R_Q + t * RS + c0 * 2), RF = *(const LAS bf16x8*)(rb_ + R_F + t * RS + c0 * 2); \
        float bb_[8], kk_[8]; \
        _Pragma("unroll") for (int i_ = 0; i_ < 8; ++i_) { const float f_ = lb8[i_] + (1.f - lb8[i_]) * __builtin_amdgcn_rcpf(1.f + __expf(-bf2f((unsigned short)RF[i_]))); kk_[i_] = 1.f - f_; bb_[i_] = __logf(f_); } \
        _Pragma("unroll") for (int i_ = 0; i_ < 8; ++i_) { float x_ = bb_[i_]; x_ += HG_DPP(x_, 0x111, 0xf); x_ += HG_DPP(x_, 0x112, 0xf); x_ += HG_DPP(x_, 0x114, 0xf); x_ += HG_DPP(x_, 0x118, 0xf); \
            x_ += HG_DPP(x_, 0x142, 0xa); bb_[i_] = x_; }     \
        float qi_[8], ko_[8], ke_[8], dd_[8]; \
        _Pragma("unroll") for (int i_ = 0; i_ < 8; ++i_) { const int bi_ = __float_as_int(bb_[i_]); const float be_ = __int_as_float(half ? __builtin_amdgcn_readlane(bi_, 63) : __builtin_amdgcn_readlane(bi_, 31)); \
            const float e_ = __expf(bb_[i_]); const float ei_ = __builtin_amdgcn_rcpf(e_); dd_[i_] = __expf(be_); \
            qi_[i_] = bf2f((unsigned short)RQ[i_]) * e_; ko_[i_] = kk_[i_] * ei_; ke_[i_] = kk_[i_] * (dd_[i_] * ei_); } \
        *(LAS v4u*)(tb_ + T_Q + t * RS + c0 * 2) = (v4u){pk2(qi_[0], qi_[1]), pk2(qi_[2], qi_[3]), pk2(qi_[4], qi_[5]), pk2(qi_[6], qi_[7])}; \
        *(LAS v4u*)(tb_ + T_KO + t * RS + c0 * 2) = (v4u){pk2(ko_[0], ko_[1]), pk2(ko_[2], ko_[3]), pk2(ko_[4], ko_[5]), pk2(ko_[6], ko_[7])}; \
        *(LAS v4u*)(tb_ + T_KE + t * RS + c0 * 2) = (v4u){pk2(ke_[0], ke_[1]), pk2(ke_[2], ke_[3]), pk2(ke_[4], ke_[5]), pk2(ke_[6], ke_[7])}; \
        if (wave < 2) *(LAS bf16x8*)(tb_ + T_V + t * VS + c0 * 2) = *(const LAS bf16x8*)(rb_ + R_V + t * VS + c0 * 2); \
        if (t == 31) { *(LAS f32x4*)(tb_ + T_D + c0 * 4) = (f32x4){dd_[0], dd_[1], dd_[2], dd_[3]}; *(LAS f32x4*)(tb_ + T_D + c0 * 4 + 16) = (f32x4){dd_[4], dd_[5], dd_[6], dd_[7]}; } } while (0)
    const int r32 = lane & 31, hi = lane >> 5, g1 = (lane >> 4) & 1, q4 = (lane & 15) >> 2, p4 = lane & 3, cb = 32 * wave;
    const unsigned lbase = (unsigned)(uintptr_t)lds;
    f32x16 S = {};
    HG_LOAD(gqA, gfA, gvA, 0); HG_STASH(gqA, gfA, gvA, 0); HG_LOAD(gqA, gfA, gvA, 1); HG_STASH(gqA, gfA, gvA, 1);
    __syncthreads();
    HG_PREP(0);
    __syncthreads();
#define HG_RD64(dst, addr, OFFS) asm volatile("ds_read_b64 %0, %1 offset:" #OFFS : "=&v"(dst) : "v"(addr) : "memory")
#define HG_MFMA_STAGE(n) do { \
            const unsigned tb = lbase + OFF_TILES + ((n) & 1) * TILE_BYTES; const LAS unsigned char* tl_ = lds + OFF_TILES + ((n) & 1) * TILE_BYTES; \
            bf16x8 ko[2], qi[2]; s16x4 pvl[2], pvh[2], pql[2], pqh[2], kl[2], kh[2], nvl[2], nvh[2]; f32x4 dsc[4]; \
            _Pragma("unroll") for (int kk = 0; kk < 2; ++kk) { ko[kk] = *(const LAS bf16x8*)(tl_ + T_KO + r32 * RS + (cb + 16 * kk + 8 * hi) * 2); qi[kk] = *(const LAS bf16x8*)(tl_ + T_Q + r32 * RS + (cb + 16 * kk + 8 * hi) * 2); } \
            _Pragma("unroll") for (int sp = 0; sp < 2; ++sp) { \
                const unsigned va = tb + T_V + (16 * sp + 4 * hi + q4) * VS + (16 * g1 + 4 * p4) * 2; pvl[sp] = tr_read(va); pvh[sp] = tr_read(va + 8 * VS);              \
                const unsigned qa = tb + T_Q + r32 * RS + (cb + 16 * sp + 4 * hi) * 2; HG_RD64(pql[sp], qa, 0); HG_RD64(pqh[sp], qa, 16);                                  \
                const unsigned ka = tb + T_KE + (16 * sp + 8 * hi + q4) * RS + (cb + 16 * g1 + 4 * p4) * 2; kl[sp] = tr_read(ka); kh[sp] = tr_read(ka + 4 * RS);        \
                const unsigned vb = tb + T_V + (16 * sp + 8 * hi + q4) * VS + (16 * g1 + 4 * p4) * 2; nvl[sp] = tr_read(vb); nvh[sp] = tr_read(vb + 4 * VS); }            \
            _Pragma("unroll") for (int g = 0; g < 4; ++g) dsc[g] = *(const LAS f32x4*)(tl_ + T_D + (cb + 8 * g + 4 * hi) * 4); \
            asm volatile("s_waitcnt lgkmcnt(0)" ::: "memory"); __builtin_amdgcn_sched_barrier(0); \
            f32x16 X = {}; \
            X = __builtin_amdgcn_mfma_f32_32x32x16_bf16(ko[0], qi[0], X, 0, 0, 0); X = __builtin_amdgcn_mfma_f32_32x32x16_bf16(ko[1], qi[1], X, 0, 0, 0); \
            f32x16 O = {}; \
            O = __builtin_amdgcn_mfma_f32_32x32x16_bf16(cat8(pql[0], pqh[0]), pack8(S, 0), O, 0, 0, 0); O = __builtin_amdgcn_mfma_f32_32x32x16_bf16(cat8(pql[1], pqh[1]), pack8(S, 8), O, 0, 0, 0); \
            _Pragma("unroll") for (int i = 0; i < 16; ++i) S[i] *= dsc[i >> 2][i & 3]; \
            S = __builtin_amdgcn_mfma_f32_32x32x16_bf16(cat8(kl[0], kh[0]), cat8(nvl[0], nvh[0]), S, 0, 0, 0); S = __builtin_amdgcn_mfma_f32_32x32x16_bf16(cat8(kl[1], kh[1]), cat8(nvl[1], nvh[1]), S, 0, 0, 0); \
            _Pragma("unroll") for (int i = 0; i < 16; ++i) X[i] = (crow(i, hi) <= r32) ? X[i] : 0.f; \
            O = __builtin_amdgcn_mfma_f32_32x32x16_bf16(pack8(X, 0), cat8(pvl[0], pvh[0]), O, 0, 0, 0); O = __builtin_amdgcn_mfma_f32_32x32x16_bf16(pack8(X, 8), cat8(pvl[1], pvh[1]), O, 0, 0, 0); \
            LAS float* op = (LAS float*)(lds + OFF_OPART + ((n) & 1) * OPART_BYTES + wave * 4096); \
            _Pragma("unroll") for (int i = 0; i < 16; ++i) op[crow(i, hi) * 32 + r32] = O[i]; } while (0)
#define HG_OUT_STAGE(n) do { \
            const int l2 = tid - 256, tt = l2 >> 3, vq = l2 & 7; \
            const LAS float* op = (const LAS float*)(lds + OFF_OPART + (((n) - 1) & 1) * OPART_BYTES) + tt * 32 + vq * 4; \
            const f32x4 s = (*(const LAS f32x4*)op + *(const LAS f32x4*)(op + 1024)) + (*(const LAS f32x4*)(op + 2048) + *(const LAS f32x4*)(op + 3072)); \
            const int p = TOKP(32 * ((n) - 1) + tt); \
            if (p >= CTXL) *(f32x4*)(Od + (zb + p) * 512 + head * 128 + sl * 32 + vq * 4) = s; } while (0)
    for (int n = 0; n < NCH; ++n) {
        HG_LOAD(gqA, gfA, gvA, n + 2);
        if (wave < 4) { HG_MFMA_STAGE(n); } else if (n > 0) { HG_OUT_STAGE(n); }
        if (n + 1 < NCH) { HG_PREP((n + 1) & 1); }
        HG_STASH(gqA, gfA, gvA, n & 1);
        __syncthreads();
    }
    if (wave >= 4) { HG_OUT_STAGE(NCH); }
    __syncthreads();
#undef HG_MFMA_STAGE
#undef HG_OUT_STAGE
#undef HG_STASH
#undef HG_RD64
#undef HG_DPP
#undef TOKP
#undef HG_LOAD
#undef HG_PREP
}

__device__ __forceinline__ bool in_range(int lo, int hi, int k) { asm volatile("" : "+s"(lo), "+s"(hi)); return lo <= k && k < hi; }
constexpr int NPHASES = 21;
__global__ void __launch_bounds__(NTHR, 2) fwd_kernel(Args args) {
    extern __shared__ __attribute__((aligned(16))) unsigned char lds_raw[];
    LAS unsigned char* lds = (LAS unsigned char*)lds_raw;
    const int G = gridDim.x;
#define FRESH() int tid = threadIdx.x; asm volatile("" : "+v"(tid)); const int lane = tid & 63, wave = __builtin_amdgcn_readfirstlane(tid >> 6); (void)lane; (void)wave
    unsigned char* ws = args.ws;
    if (threadIdx.x < 16) ((LAS unsigned*)(lds + LDS_BAR_OFF))[threadIdx.x] = 0u;
    __syncthreads();
    XcdBarrier bar = xcd_barrier_post((unsigned*)(ws + WS_CTL), (volatile LAS unsigned*)(lds + LDS_BAR_OFF));
    const int lo = args.ph_lo, hi = args.ph_hi;
#define IN(k) in_range(lo, hi, (k))
#define NREP(k) (((PROBE_MASK >> (k)) & 1u) ? 2 : 1)
#define REPEAT(k) for (int rep_ = 0; rep_ < NREP(k); ++rep_) if (rep_ == 0 || (xcd_barrier(bar), true))
#define SEAM(k) do { if (IN(k) && IN((k) + 1)) xcd_barrier(bar); } while (0)
    bf16* const BX = (bf16*)(ws + WS_X); bf16* const BY = (bf16*)(ws + WS_Y);
    const float* const MODV = (const float*)(ws + WS_MODV);

    if (IN(0)) REPEAT(0) { FRESH(); phase_prologue(args, lds, tid, lane, wave); } SEAM(0);
    if (IN(1)) REPEAT(1) { FRESH(); phase_mod0(args, lane, wave); } SEAM(1);
    if (IN(2)) REPEAT(2) {
        pg8::Gemm g{BX, (const bf16*)(ws + WS_WIN), NTOK, ZC, 1024}; pg8::AllOrder S; S.init(NTOK / 256, ZC / 256, G, (int)blockIdx.x);
        pg8::EpiBf16<0> E{(bf16*)(ws + WS_Z), ZC, nullptr, 0, 0, 1.f};
        pg8::gemm_phase<pg8::EpiBf16<0>, pg8::AllOrder, PG8_ALIGN, PG8_SP2>(lds, g, S, E);
    } SEAM(2);
    if (IN(3)) REPEAT(3) { FRESH(); phase_norm0(args, lane, wave); } SEAM(3);
    if (IN(4)) REPEAT(4) {
        { pg8::Gemm g{(const bf16*)(ws + WS_CQN), (const bf16*)(ws + WS_WUQ), NTOK, 768, 384}; pg8::LatOrder S; S.init(128, 3, G, (int)blockIdx.x);
          pg8::EpiBf16<0> E{(bf16*)(ws + WS_Q), 768, nullptr, 0, 0, 1.f};
          pg8::gemm_phase<pg8::EpiBf16<0>, pg8::LatOrder, PG8_ALIGN, PG8_SP2>(lds, g, S, E); }
        __syncthreads();
        { pg8::Gemm g{(const bf16*)(ws + WS_CKVN), (const bf16*)(ws + WS_WUKV), NTOK, 1024, 256}; pg8::AllOrder S; S.init(NTOK / 256, 4, G, (int)blockIdx.x);
          pg8::EpiBf16<0> E{(bf16*)(ws + WS_KV), 1024, nullptr, 0, 0, 1.f};
          pg8::gemm_phase<pg8::EpiBf16<0>, pg8::AllOrder, PG8_ALIGN, PG8_SP2>(lds, g, S, E); }
    } SEAM(4);
    if (IN(5)) {
        REPEAT(21) { FRESH();
        for (int u = blockIdx.x; u < 256; u += G) { __syncthreads(); hgrn_unit_mfma(args, u, lds, tid); } }
        const bf16* Q = (const bf16*)(ws + WS_Q); const bf16* KV = (const bf16*)(ws + WS_KV); const bf16* KRR = (const bf16*)(ws + WS_KRR);
        const float* rope = (const float*)(ws + WS_ROPE);
        REPEAT(22) for (int u = blockIdx.x; u < 1024; u += G) {
            const int b = u >> 7, h = (u >> 4) & 7, qb = u & 15;
            const size_t kb = (size_t)b * TPB, q0 = kb + CTXL + (size_t)qb * 256;
            __syncthreads();
            att::attn_unit(Q + q0 * 768 + h * 96, KV + kb * 1024 + h * 64, KRR + kb * 32, BY + q0 * 1024 + h * 64, rope + (size_t)qb * 256 * 32, TPB, (char*)lds_raw);
        }
    } SEAM(5);
    if (IN(6)) REPEAT(6) { FRESH(); phase_readout(args, lane, wave); } SEAM(6);
    if (IN(7)) REPEAT(7) {
        pg8::Gemm g{BY, (const bf16*)(ws + WS_WOUT), NTOK, 1024, 1024}; pg8::LatOrder S; S.init(128, 4, G, (int)blockIdx.x);
        pg8::EpiRes E{args.in[I_X], (float*)(ws + WS_H), MODV, nullptr};
        pg8::gemm_phase<pg8::EpiRes, pg8::LatOrder, PG8_ALIGN, PG8_SP2>(lds, g, S, E);
    } SEAM(7);
    for (int l = 0; l < 2; ++l) {
        if (l == 1) {
            if (IN(13)) REPEAT(13) {
                pg8::Gemm g{BY, (const bf16*)(ws + WS_WPW1), NTOK, 2048, 1024}; pg8::LatOrder S; S.init(128, 8, G, (int)blockIdx.x);
                pg8::EpiGate<0> E{BX, (const float*)(ws + WS_PW1B), 8};
                pg8::gemm_phase<pg8::EpiGate<0>, pg8::LatOrder, PG8_ALIGN, PG8_SP2>(lds, g, S, E);
            } SEAM(13);
            if (IN(14)) REPEAT(14) { FRESH(); phase_conv(args, lds, tid, lane, wave); } SEAM(14);
            if (IN(15)) REPEAT(15) {
                pg8::Gemm g{BY, (const bf16*)(ws + WS_WPW2), NTOK, 1024, 1024}; pg8::LatOrder S; S.init(128, 4, G, (int)blockIdx.x);
                pg8::EpiRes E{nullptr, (float*)(ws + WS_H), MODV + 9 * 6144, args.in[I_PW2B]};
                pg8::gemm_phase<pg8::EpiRes, pg8::LatOrder, PG8_ALIGN, PG8_SP2>(lds, g, S, E);
            } SEAM(15);
        }
        const int pb = l ? 16 : 8;
        if (IN(pb)) REPEAT(pb) { FRESH(); phase_ln1(args, l, lds, tid, lane, wave); } SEAM(pb);
        if (IN(pb + 1)) REPEAT(pb + 1) { FRESH(); phase_place(args, lds, tid, lane, wave); } SEAM(pb + 1);
        if (IN(pb + 2) || IN(pb + 3)) {
            LAS int* tl = (LAS int*)(lds + LDS_TILE_E);
            FRESH();
            __syncthreads();
            const int ntiles = ld_ctl((const int*)(ws + WS_META));
            for (int t = tid; t < ntiles && t < MAXTILES; t += NTHR) tl[t] = ld_ctl((const int*)(ws + WS_TILEE) + t);
            __syncthreads();
            if (IN(pb + 2)) REPEAT(pb + 2) {
                pg8::Gemm g{BX, (const bf16*)(ws + WS_WGU) + (size_t)l * 32 * 2048 * 1024, 0, 0, 1024};
                pg8::MoeOrder S; S.init(ntiles, 8, G, (int)blockIdx.x); S.tile_e = tl; S.nper = 8;
                pg8::EpiGate<1> E{(bf16*)(ws + WS_ACT), (const float*)(ws + WS_BGU) + (size_t)l * 32 * 2048, 8};
                pg8::gemm_phase<pg8::EpiGate<1>, pg8::MoeOrder, PG8_ALIGN, true, true>(lds, g, S, E, (const int*)(ws + WS_ROWS));
            } SEAM(pb + 2);
            if (IN(pb + 3)) REPEAT(pb + 3) {
                pg8::Gemm g{(const bf16*)(ws + WS_ACT), (const bf16*)(ws + WS_WDN) + (size_t)l * 32 * 1024 * 1024, 0, 0, 1024};
                pg8::MoeOrder S; S.init(ntiles, 4, G, (int)blockIdx.x); S.tile_e = tl; S.nper = 4;
                pg8::EpiDown E{(bf16*)(ws + WS_YB), args.in[I_BDN] + (size_t)l * 32 * 1024, (const float*)(ws + WS_ROWW), (const int*)(ws + WS_ROWD)};
                pg8::gemm_phase<pg8::EpiDown, pg8::MoeOrder, PG8_ALIGN, PG8_SP2>(lds, g, S, E);
            } SEAM(pb + 3);
        }
        if (IN(pb + 4)) REPEAT(pb + 4) { FRESH(); phase_ln2(args, l, lane, wave); }
        if (l == 0) SEAM(12);
    }
#undef IN
#undef SEAM
}

extern "C" void kernel_launch(void* const* d_in, const int* in_sizes, int n_in, void* d_out, int out_size, void* d_ws, size_t ws_size, hipStream_t stream) {
    static int grid = 0;
    if (grid == 0) {
        if (n_in != 33 || in_sizes[0] != NB * SEQ * D || out_size != NB * SEQ * D || ws_size < WS_END) {
            fprintf(stderr, "kernel_launch: unexpected shapes: n_in %d in0 %d out %d ws %zu (need %zu)\n", n_in, n_in > 0 ? in_sizes[0] : -1, out_size, ws_size, (size_t)WS_END); grid = -1; return; }
        int dev = 0, cus = 0;
        if (hipGetDevice(&dev) != hipSuccess || hipDeviceGetAttribute(&cus, hipDeviceAttributeMultiprocessorCount, dev) != hipSuccess) { grid = -1; return; }
        if (hipFuncSetAttribute((const void*)fwd_kernel, hipFuncAttributeMaxDynamicSharedMemorySize, LDS_BYTES) != hipSuccess) { fprintf(stderr, "kernel_launch: hipFuncSetAttribute failed\n"); grid = -1; return; }
        int per_cu = 0;
        if (hipOccupancyMaxActiveBlocksPerMultiprocessor(&per_cu, (const void*)fwd_kernel, NTHR, LDS_BYTES) != hipSuccess || per_cu < 1) fprintf(stderr, "kernel_launch: occupancy query reports %d\n", per_cu);
        (void)hipGetLastError();
        grid = cus;
    }
    if (grid < 0) return;
    if (hipMemsetAsync((char*)d_ws + WS_CTL, 0, CTL_ZERO_BYTES, stream) != hipSuccess) return;
    Args a{};
    for (int i = 0; i < 33; ++i) a.in[i] = (const float*)d_in[i];
    a.out = (float*)d_out; a.ws = (unsigned char*)d_ws;
#if MK_ONE_LAUNCH
    a.ph_lo = 0; a.ph_hi = NPHASES;
    hipLaunchKernelGGL(fwd_kernel, dim3(grid), dim3(NTHR), LDS_BYTES, stream, a);
#else
    for (int ph = 0; ph < NPHASES; ++ph) { a.ph_lo = ph; a.ph_hi = ph + 1; hipLaunchKernelGGL(fwd_kernel, dim3(grid), dim3(NTHR), LDS_BYTES, stream, a); }
#endif
    const hipError_t le = hipPeekAtLastError();
    if (le != hipSuccess) fprintf(stderr, "kernel_launch: launch failed: %s\n", hipGetErrorName(le));
}
```

```cpp
#include <hip/hip_runtime.h>
#include <cstdio>
#include <cstdint>

#ifndef PROBE_MASK
#define PROBE_MASK 0u
#endif
#ifndef MK_ONE_LAUNCH
#define MK_ONE_LAUNCH 1
#endif

namespace pg8 {
#define PG8_LAS __attribute__((address_space(3)))
typedef unsigned short bf16_t;
typedef short bf16x8 __attribute__((ext_vector_type(8)));
typedef float f32x4 __attribute__((ext_vector_type(4)));
typedef unsigned u32x4 __attribute__((ext_vector_type(4)));
constexpr int BM = 256, BK = 64, HALF = 128, HTB = HALF * BK * 2  , STAGE_BYTES = 8 * HTB, NXCD = 8, WGM = 8;

__host__ __device__ __forceinline__ int lds_byte(int r, int c) { const int st = (r >> 4) * 2 + (c >> 5), rr = r & 15, cc = c & 31, ob = rr * 64 + cc * 2; return st * 1024 + (ob ^ (((ob >> 9) & 1) << 5)); }
__host__ __device__ __forceinline__ void stage_rc(int b, int& R, int& C) { const int st = b / 1024, sb = b % 1024, swz = sb ^ (((sb >> 9) & 1) << 5); R = (st >> 1) * 16 + swz / 64; C = (st & 1) * 32 + (swz % 64) / 2; }
__host__ __device__ __forceinline__ int perm32(int rho) { const int n = rho >> 4, i = rho & 15; return 8 * (i >> 2) + 4 * n + (i & 3); }

struct Unit { int pm, pn; };
struct Gemm { const bf16_t* A; const bf16_t* Bt; int M, N, K; };

struct StaticOrder {
    int nM, nN, nwg, G, c;
    __host__ __device__ void init(int M, int N, int G_, int c_) { nM = M / BM; nN = N / BM; nwg = nM * nN; G = G_; c = c_; }
    __host__ __device__ bool next(int i, Unit& u) const {
        const long L = (long)i * G + c; if (L >= nwg) return false;
        int wgid = (int)L; { const int q = nwg / NXCD, r = nwg % NXCD, xcd = wgid % NXCD, off = wgid / NXCD; wgid = (xcd < r ? xcd * (q + 1) : r * (q + 1) + (xcd - r) * q) + off; }
        const int nig = WGM * nN, gid = wgid / nig, fm = gid * WGM, gsz = (nM - fm) < WGM ? (nM - fm) : WGM;
        u.pm = fm + ((wgid % nig) % gsz); u.pn = (wgid % nig) / gsz; return true;
    }
    __device__ __forceinline__ void a_ready(const Unit&) const {}
    __device__ __forceinline__ void done(const Unit&) const {}
};

__device__ __forceinline__ unsigned cvt_pk_bf16(float lo, float hi) { unsigned r; asm volatile("v_cvt_pk_bf16_f32 %0, %1, %2" : "=v"(r) : "v"(lo), "v"(hi)); return r; }
typedef float f32x2 __attribute__((ext_vector_type(2)));
__device__ __forceinline__ f32x2 gelu_pk(f32x2 v) {
    const f32x2 av = __builtin_elementwise_abs(v), d = av * 0.2316418882f + 1.0f;
    f32x2 t; t.x = __builtin_amdgcn_rcpf(d.x); t.y = __builtin_amdgcn_rcpf(d.y);
    f32x2 q = t * 0.5307027145f + (-0.7265760135f); q = q * t + 0.7107068705f; q = q * t + (-0.142248368f); q = q * t + 0.127414796f; q = q * t;
    const f32x2 s = (v * v) * (-0.72134752044f);
    f32x2 e; e.x = __builtin_amdgcn_exp2f(s.x); e.y = __builtin_amdgcn_exp2f(s.y);
    const f32x2 m = v * (q * e), r = v - m;
    f32x2 o; o.x = v.x < 0.f ? m.x : r.x; o.y = v.y < 0.f ? m.y : r.y; return o;
}

template <int ACT  > struct EpiBf16 {
    static constexpr bool PERM = true, AFTER_DRAIN = false; static_assert(ACT == 0 || ACT == 1, "EpiBf16: ACT is 0 (none) or 1 (gelu_pk)");
    bf16_t* O; int ldc; const float* bias; int split_cols; size_t split_stride; float scale0;
    __device__ __forceinline__ void operator()(const f32x4 (&acc)[2][2][4][2], const Unit& u, int wr, int wc, int fr, int fq) const {
        const int row0 = u.pm * BM + wr * 64 + fr; int colt = u.pn * BM; bf16_t* base = O;
        float sc = 1.f; if (split_cols) { const int t = colt / split_cols; base += (size_t)t * split_stride; colt -= t * split_cols; if (t == 0) sc = scale0; }
        const int col0 = colt + wc * 32 + 8 * fq, bcol0 = u.pn * BM + wc * 32 + 8 * fq;
        f32x4 bv[2][2];
#pragma unroll
        for (int bj = 0; bj < 2; ++bj)
#pragma unroll
            for (int n = 0; n < 2; ++n) bv[bj][n] = bias ? *(const f32x4*)(bias + bcol0 + bj * HALF + 4 * n) : (f32x4){0.f, 0.f, 0.f, 0.f};
#pragma unroll
        for (int ai = 0; ai < 2; ++ai)
#pragma unroll
            for (int m = 0; m < 4; ++m) { bf16_t* rowp = base + (size_t)(row0 + ai * HALF + m * 16) * ldc + col0;
#pragma unroll
                for (int bj = 0; bj < 2; ++bj) { f32x4 v0 = acc[ai][bj][m][0] + bv[bj][0], v1 = acc[ai][bj][m][1] + bv[bj][1];
                    if (ACT == 1) { f32x2 a = gelu_pk((f32x2){v0[0], v0[1]}), b = gelu_pk((f32x2){v0[2], v0[3]}), c = gelu_pk((f32x2){v1[0], v1[1]}), d = gelu_pk((f32x2){v1[2], v1[3]});
                        v0 = (f32x4){a.x, a.y, b.x, b.y}; v1 = (f32x4){c.x, c.y, d.x, d.y}; }
                    v0 = v0 * sc; v1 = v1 * sc; u32x4 w; w.x = cvt_pk_bf16(v0[0], v0[1]); w.y = cvt_pk_bf16(v0[2], v0[3]); w.z = cvt_pk_bf16(v1[0], v1[1]); w.w = cvt_pk_bf16(v1[2], v1[3]);
                    *(u32x4*)(rowp + bj * HALF) = w; } }
    }
};
template <class Epi, class Sched, bool ALIGN_EPI = false, bool SP2 = false, bool GATHER = false>
__device__ __forceinline__ void gemm_phase(PG8_LAS unsigned char* lds, const Gemm g, const Sched& S, const Epi& E, const int* rowsrc = nullptr) {
    static_assert(!GATHER || SP2, "GATHER is implemented on the SP2 loop only");
    int tid_l = threadIdx.x; asm volatile("" : "+v"(tid_l));
    const int tid = tid_l, wid = __builtin_amdgcn_readfirstlane(tid >> 6), lane = tid & 63, wr = wid >> 2, wc = wid & 3, fr = lane & 15, fq = lane >> 4;
    const int K = g.K, nt = K / BK;
    unsigned voffA[2], voffB[2];
#pragma unroll
    for (int i = 0; i < 2; ++i) { int R, C; stage_rc(tid * 16 + i * 8192, R, C); const int Rb = Epi::PERM ? ((R & ~31) + perm32(R & 31)) : R;
        voffA[i] = (unsigned)(R * K + C) * 2u; voffB[i] = (unsigned)(Rb * K + C) * 2u; }
    unsigned gAc[2][2], gAn[2][2]; int gR[2]; unsigned gC[2];
#pragma unroll
    for (int i = 0; i < 2; ++i) { int R, C; stage_rc(tid * 16 + i * 8192, R, C); gR[i] = R; gC[i] = (unsigned)C * 2u; gAc[0][i] = gAc[1][i] = gAn[0][i] = gAn[1][i] = 0u; }
#define PG8_GATHER(u_, o_) do { _Pragma("unroll") for (int h_ = 0; h_ < 2; ++h_) _Pragma("unroll") for (int i_ = 0; i_ < 2; ++i_) \
        o_[h_][i_] = (unsigned)rowsrc[(u_).pm * BM + h_ * HALF + gR[i_]] * (unsigned)(K * 2) + gC[i_]; } while (0)
#define PG8_STAGE_A(bufoff, orig_gbase, NEXTSEL, H, KOFF) do { if constexpr (GATHER) { unsigned vo_[2]; vo_[0] = (NEXTSEL) ? gAn[H][0] : gAc[H][0]; vo_[1] = (NEXTSEL) ? gAn[H][1] : gAc[H][1]; \
        PG8_STAGE(bufoff, (const char*)g.A + (KOFF), vo_); } else { PG8_STAGE(bufoff, orig_gbase, voffA); } } while (0)
    const size_t kstep = (size_t)(BK * 2);
    const size_t hstep = (size_t)HALF * K * 2;
    const size_t tstep = 2 * hstep;
    const unsigned ldsw = (unsigned)wid * 1024u;
    const int aoff = lds_byte(wr * 64 + fr, fq * 8), boff = lds_byte(wc * 32 + fr, fq * 8);
#define PG8_SA(b, h) (((b) * 2 + (h)) * HTB)
#define PG8_SB(b, h) ((4 + (b) * 2 + (h)) * HTB)
#define PG8_STAGE(bufoff, gbase, voff) do { _Pragma("unroll") for (int _i = 0; _i < 2; ++_i) \
        __builtin_amdgcn_global_load_lds((const unsigned*)((const char*)(gbase) + (voff)[_i]), (PG8_LAS unsigned*)(lds + (bufoff) + ldsw + _i * 8192), 16, 0, 0); } while (0)
#define PG8_LDA(dst, b, h) do { _Pragma("unroll") for (int m = 0; m < 4; ++m) _Pragma("unroll") for (int k = 0; k < 2; ++k) dst[m][k] = *(const PG8_LAS bf16x8*)(lds + PG8_SA(b, h) + aoff + m * 2048 + k * 1024); } while (0)
#define PG8_LDB(dst, b, h) do { _Pragma("unroll") for (int n = 0; n < 2; ++n) _Pragma("unroll") for (int k = 0; k < 2; ++k) dst[n][k] = *(const PG8_LAS bf16x8*)(lds + PG8_SB(b, h) + boff + n * 2048 + k * 1024); } while (0)
#define PG8_MMA(ai, bj, At, Bt) do { __builtin_amdgcn_s_setprio(1); _Pragma("unroll") for (int m = 0; m < 4; ++m) _Pragma("unroll") for (int n = 0; n < 2; ++n) _Pragma("unroll") for (int k = 0; k < 2; ++k) \
        acc[ai][bj][m][n] = __builtin_amdgcn_mfma_f32_16x16x32_bf16(Bt[n][k], At[m][k], acc[ai][bj][m][n], 0, 0, 0); __builtin_amdgcn_s_setprio(0); } while (0)
#define PG8_WAIT_V(n) asm volatile("s_waitcnt vmcnt(" #n ")" ::: "memory")
#define PG8_WAIT_L(n) asm volatile("s_waitcnt lgkmcnt(" #n ")" ::: "memory")
#define PG8_BAR __builtin_amdgcn_s_barrier()
#define PG8_SCHED __builtin_amdgcn_sched_barrier(0)
    Unit cur, nxt; int ui = 0;
    if (!S.next(0, cur)) return;
    f32x4 acc[2][2][4][2];
#pragma unroll
    for (int a = 0; a < 2; ++a)
#pragma unroll
        for (int b = 0; b < 2; ++b)
#pragma unroll
            for (int m = 0; m < 4; ++m)
#pragma unroll
                for (int n = 0; n < 2; ++n) acc[a][b][m][n] = (f32x4){0.f, 0.f, 0.f, 0.f};
    bf16x8 At[4][2], B0[2][2], B1[2][2];
    const char* cA = (const char*)g.A + (size_t)cur.pm * tstep; const char* cB = (const char*)g.Bt + (size_t)cur.pn * tstep;
    S.a_ready(cur);
    if constexpr (GATHER) { PG8_GATHER(cur, gAc); }
    if constexpr (SP2) {
        PG8_STAGE(PG8_SB(0, 0), cB, voffB); PG8_STAGE(PG8_SB(0, 1), cB + hstep, voffB); PG8_STAGE_A(PG8_SA(0, 0), cA, false, 0, (size_t)0); PG8_STAGE_A(PG8_SA(0, 1), cA + hstep, false, 1, (size_t)0);
        if (wr == 1) PG8_BAR;
        PG8_WAIT_V(2); PG8_BAR;
        PG8_STAGE(PG8_SB(1, 0), cB + kstep, voffB); PG8_STAGE_A(PG8_SA(1, 0), cA + kstep, false, 0, kstep); PG8_STAGE(PG8_SB(1, 1), cB + hstep + kstep, voffB);
        PG8_WAIT_V(6); PG8_BAR;
    } else {
        PG8_STAGE(PG8_SB(0, 0), cB, voffB); PG8_STAGE(PG8_SA(0, 0), cA, voffA); PG8_STAGE(PG8_SB(0, 1), cB + hstep, voffB); PG8_STAGE(PG8_SA(0, 1), cA + hstep, voffA);
        if (wr == 1) PG8_BAR;
        PG8_WAIT_V(4); PG8_BAR;
        PG8_STAGE(PG8_SB(1, 0), cB + kstep, voffB); PG8_STAGE(PG8_SA(1, 0), cA + kstep, voffA); PG8_STAGE(PG8_SB(1, 1), cB + hstep + kstep, voffB);
        PG8_WAIT_V(6); PG8_BAR;
    }
    for (;;) {
        const bool has_next = S.next(ui + 1, nxt);
        if constexpr (GATHER) { if (has_next) { PG8_GATHER(nxt, gAn); } else { _Pragma("unroll") for (int h_ = 0; h_ < 2; ++h_) _Pragma("unroll") for (int i_ = 0; i_ < 2; ++i_) gAn[h_][i_] = gAc[h_][i_]; } }
        const char* nA = has_next ? (const char*)g.A + (size_t)nxt.pm * tstep : cA; const char* nB = has_next ? (const char*)g.Bt + (size_t)nxt.pn * tstep : cB;
#pragma nounroll
        for (int t = 0; t < nt; t += 2) {
            const bool last = (t == nt - 2);
            const char* a1 = cA + (size_t)(t + 1) * kstep;
            const char* a2 = last ? nA : cA + (size_t)(t + 2) * kstep; const char* b2 = last ? nB : cB + (size_t)(t + 2) * kstep;
            const char* a3 = a2 + kstep; const char* b3 = b2 + kstep;
            const size_t k1 = (size_t)(t + 1) * kstep, k2 = last ? (size_t)0 : (size_t)(t + 2) * kstep, k3 = k2 + kstep; (void)k1; (void)k2; (void)k3;
            if (last && has_next) S.a_ready(nxt);
            if constexpr (SP2) {
            PG8_LDB(B0, 0, 0); PG8_LDB(B1, 0, 1); PG8_SCHED; PG8_LDA(At, 0, 0); PG8_STAGE_A(PG8_SA(1, 1), a1 + hstep, false, 1, k1);
            PG8_WAIT_V(8); PG8_WAIT_L(0); PG8_BAR; PG8_MMA(0, 0, At, B0); PG8_MMA(0, 1, At, B1); PG8_BAR; PG8_SCHED;
            PG8_LDA(At, 0, 1); PG8_STAGE(PG8_SB(0, 0), b2, voffB); PG8_STAGE(PG8_SB(0, 1), b2 + hstep, voffB); PG8_STAGE_A(PG8_SA(0, 0), a2, last, 0, k2);
            PG8_WAIT_V(8); PG8_WAIT_L(0); PG8_BAR; PG8_MMA(1, 0, At, B0); PG8_MMA(1, 1, At, B1); PG8_BAR; PG8_SCHED;
            PG8_LDB(B0, 1, 0); PG8_LDB(B1, 1, 1); PG8_SCHED; PG8_LDA(At, 1, 0); PG8_STAGE_A(PG8_SA(0, 1), a2 + hstep, last, 1, k2);
            PG8_WAIT_V(8); PG8_WAIT_L(0); PG8_BAR; PG8_MMA(0, 0, At, B0); PG8_MMA(0, 1, At, B1); PG8_BAR; PG8_SCHED;
            PG8_LDA(At, 1, 1); PG8_STAGE(PG8_SB(1, 0), b3, voffB); PG8_STAGE(PG8_SB(1, 1), b3 + hstep, voffB); PG8_STAGE_A(PG8_SA(1, 0), a3, last, 0, k3);
            PG8_WAIT_V(8); PG8_WAIT_L(0); PG8_BAR; PG8_MMA(1, 0, At, B0); PG8_MMA(1, 1, At, B1); PG8_BAR; PG8_SCHED;
            } else {
            PG8_LDB(B0, 0, 0); PG8_SCHED; PG8_LDA(At, 0, 0); PG8_STAGE(PG8_SA(1, 1), a1 + hstep, voffA);
            PG8_WAIT_L(8); PG8_BAR; PG8_WAIT_L(0); PG8_MMA(0, 0, At, B0); PG8_BAR; PG8_SCHED;
            PG8_LDB(B1, 0, 1); PG8_STAGE(PG8_SB(0, 0), b2, voffB);
            PG8_BAR; PG8_WAIT_L(0); PG8_MMA(0, 1, At, B1); PG8_BAR;
            PG8_LDA(At, 0, 1); PG8_STAGE(PG8_SA(0, 0), a2, voffA);
            PG8_BAR; PG8_WAIT_L(0); PG8_MMA(1, 0, At, B0); PG8_BAR; PG8_SCHED;
            PG8_STAGE(PG8_SB(0, 1), b2 + hstep, voffB);
            PG8_WAIT_V(6); PG8_BAR; PG8_MMA(1, 1, At, B1); PG8_BAR;
            PG8_LDB(B0, 1, 0); PG8_SCHED; PG8_LDA(At, 1, 0); PG8_STAGE(PG8_SA(0, 1), a2 + hstep, voffA);
            PG8_WAIT_L(8); PG8_BAR; PG8_WAIT_L(0); PG8_MMA(0, 0, At, B0); PG8_BAR; PG8_SCHED;
            PG8_LDB(B1, 1, 1); PG8_STAGE(PG8_SB(1, 0), b3, voffB);
            PG8_BAR; PG8_WAIT_L(0); PG8_MMA(0, 1, At, B1); PG8_BAR;
            PG8_LDA(At, 1, 1); PG8_STAGE(PG8_SA(1, 0), a3, voffA);
            PG8_BAR; PG8_WAIT_L(0); PG8_MMA(1, 0, At, B0); PG8_BAR; PG8_SCHED;
            PG8_STAGE(PG8_SB(1, 1), b3 + hstep, voffB);
            PG8_WAIT_V(6); PG8_BAR; PG8_MMA(1, 1, At, B1); PG8_BAR;
            }
        }
        if constexpr (ALIGN_EPI) { if (wr == 0) PG8_BAR; }
        if constexpr (!Epi::AFTER_DRAIN) { E(acc, cur, wr, wc, fr, fq); S.done(cur); }
        if (!has_next) break;
#pragma unroll
        for (int a = 0; a < 2; ++a)
#pragma unroll
            for (int b = 0; b < 2; ++b)
#pragma unroll
                for (int m = 0; m < 4; ++m)
#pragma unroll
                    for (int n = 0; n < 2; ++n) acc[a][b][m][n] = (f32x4){0.f, 0.f, 0.f, 0.f};
        cur = nxt; cA = nA; cB = nB; ++ui;
        if constexpr (GATHER) { _Pragma("unroll") for (int h_ = 0; h_ < 2; ++h_) _Pragma("unroll") for (int i_ = 0; i_ < 2; ++i_) gAc[h_][i_] = gAn[h_][i_]; }
        if constexpr (ALIGN_EPI) { if (wr == 1) PG8_BAR; }
    }
    PG8_WAIT_V(0);
    if constexpr (!ALIGN_EPI) { if (wr == 0) PG8_BAR; }
    PG8_BAR;
    if constexpr (Epi::AFTER_DRAIN) { E.fused(acc, cur, wr, wc, fr, fq, lds, wid, lane); S.done(cur); }
#undef PG8_SA
#undef PG8_SB
#undef PG8_STAGE
#undef PG8_STAGE_A
#undef PG8_GATHER
#undef PG8_LDA
#undef PG8_LDB
#undef PG8_MMA
#undef PG8_WAIT_V
#undef PG8_WAIT_L
#undef PG8_BAR
#undef PG8_SCHED
}
}

#ifndef PG8_SP2
#define PG8_SP2 true
#endif
#ifndef PG8_ALIGN
#define PG8_ALIGN true
#endif

#define GAS __attribute__((address_space(1)))
#define LAS __attribute__((address_space(3)))
typedef unsigned short bf16;
typedef unsigned v4u __attribute__((ext_vector_type(4)));
typedef unsigned v2u __attribute__((ext_vector_type(2)));
typedef float f32x4 __attribute__((ext_vector_type(4)));
typedef short bf16x8 __attribute__((ext_vector_type(8)));

constexpr int D = 1024, NB = 8, SEQ = 4096, CTXL = 256, TPB = SEQ + CTXL, NTOK = NB * TPB, NLAT = NB * SEQ;
constexpr int ZC = 3328;
constexpr int ZQ = 0, ZKV = 384, ZKR = 640, ZHQ = 672, ZHF = 1184, ZHB = 1696, ZHI = 2208, ZHG = 2720;
constexpr int NEXP = 32;
constexpr float ALPHA = 1.4142135623730951f;
constexpr float LN_EPS = 1e-5f, RMS_EPS = 1e-6f;
constexpr int NWAVES = 8, NTHR = 512;
constexpr int LDS_BYTES = 147456;
constexpr int LDS_BAR_OFF = LDS_BYTES - 64;
constexpr int LDS_TILE_E = 131072;
constexpr int MAXTILES = 576;

constexpr size_t MiB = 1u << 20;
constexpr size_t WS_CTL = 0, CTL_ZERO_BYTES = 16384;
constexpr size_t WS_MODV = 1 * MiB;
constexpr size_t WS_ROPE = 1 * MiB + 512 * 1024;
constexpr size_t WS_BGU = 2 * MiB;
constexpr size_t WS_PW1B = 2 * MiB + 512 * 1024;
constexpr size_t WS_BCNT = WS_PW1B + 64 * 1024;
constexpr size_t WS_TILEE = WS_BCNT + 64 * 1024;
constexpr size_t WS_META = WS_TILEE + 4096;
constexpr size_t WS_TOPI = 3 * MiB, WS_TOPW = 4 * MiB, WS_ROWW = 5 * MiB, WS_ROWD = 6 * MiB, WS_ROWS = 7 * MiB;
constexpr size_t WS_WIN = 8 * MiB, WS_WUQ = 15 * MiB, WS_WUKV = 16 * MiB, WS_WOUT = 17 * MiB, WS_WPW1 = 19 * MiB, WS_WPW2 = 23 * MiB;
constexpr size_t WS_WGU = 32 * MiB, WS_WDN = 288 * MiB;
constexpr size_t WS_H = 416 * MiB;
constexpr size_t WS_X = 552 * MiB, WS_Y = 620 * MiB;
constexpr size_t WS_BIG = 688 * MiB;
constexpr size_t WS_Z = WS_BIG, WS_CQN = WS_BIG + 221 * MiB, WS_CKVN = WS_BIG + 247 * MiB, WS_KRR = WS_BIG + 264 * MiB,
                 WS_Q = WS_BIG + 267 * MiB, WS_KV = WS_BIG + 318 * MiB, WS_OF = WS_BIG + 386 * MiB, WS_OB = WS_BIG + 454 * MiB;
constexpr size_t WS_HT = WS_BIG + 528 * MiB;
constexpr size_t WS_XS = WS_BIG, WS_ACT = WS_BIG + 288 * MiB, WS_YB = WS_BIG + 576 * MiB;
constexpr size_t WS_END = WS_BIG + 848 * MiB;
static_assert((size_t)NTOK * ZC * 2 <= 221 * MiB && (size_t)NTOK * 384 * 2 <= 26 * MiB && (size_t)NTOK * 256 * 2 <= 17 * MiB && (size_t)NTOK * 32 * 2 <= 3 * MiB, "ws map 1");
static_assert((size_t)NTOK * 768 * 2 <= 51 * MiB && (size_t)NTOK * 1024 * 2 <= 68 * MiB && (size_t)NTOK * 512 * 4 <= 68 * MiB, "ws map 2");
static_assert((size_t)64 * 136 * 26624 <= 320 * MiB && (size_t)MAXTILES * 256 * 2048 <= 288 * MiB && (size_t)NLAT * 4 * 2048 <= 272 * MiB && (size_t)NTOK * 1024 * 4 <= 136 * MiB, "ws map 3");

#define LDS_WAIT() asm volatile("s_waitcnt lgkmcnt(0)" ::: "memory")
#define VM_WAIT() asm volatile("s_waitcnt vmcnt(0)" ::: "memory")
__device__ __forceinline__ float bf2f(unsigned short b) { return __uint_as_float(((unsigned)b) << 16); }
__device__ __forceinline__ unsigned pk2(float lo, float hi) { return pg8::cvt_pk_bf16(lo, hi); }
__device__ __forceinline__ float sigm(float x) { return 1.f / (1.f + __expf(-x)); }
__device__ __forceinline__ float wave_sum(float v) {
#pragma unroll
    for (int o = 1; o < 64; o <<= 1) v += __shfl_xor(v, o);
    return v;
}
__device__ __forceinline__ int ld_ctl(const int* p) { return (int)__hip_atomic_load((const unsigned*)p, __ATOMIC_RELAXED, __HIP_MEMORY_SCOPE_AGENT); }
__device__ __forceinline__ int grow_of(int lr) { return (lr >> 12) * TPB + CTXL + (lr & 4095); }

#define XB_TMO      128
#define XB_XCNT(j)  (256  + 64 * (j))
#define XB_XSUB(j)  (1280 + 64 * (j))
#define XB_XGEN(j)  (2304 + 64 * (j))
#define XB_TOP      3328
#define XB_TOPGEN   3392
#define XCD_BAR_WORDS 3456
#define XB_SPIN_CAP (1u << 21)

__device__ __forceinline__ unsigned xb_ld(unsigned* p)              { return __hip_atomic_load(p, __ATOMIC_RELAXED, __HIP_MEMORY_SCOPE_AGENT); }
__device__ __forceinline__ unsigned xb_add(unsigned* p, unsigned v) { return __hip_atomic_fetch_add(p, v, __ATOMIC_RELAXED, __HIP_MEMORY_SCOPE_AGENT); }
__device__ __forceinline__ unsigned xb_xcc_id() { return (unsigned)__builtin_amdgcn_s_getreg((3 << 11) | 20) & 0xFu; }
#define XB_SPIN(cond, bar) do { unsigned _sp = 0; while (cond) { __builtin_amdgcn_s_sleep(1); \
    if ((++_sp & 255u) == 0u) { if (xb_ld(&(bar)[XB_TMO])) break; if (_sp > XB_SPIN_CAP) { atomicAdd(&(bar)[XB_TMO], 1u); break; } } } } while (0)

struct XcdBarrier { unsigned* bar; unsigned x; volatile LAS unsigned* st; };

__device__ __forceinline__ XcdBarrier xcd_barrier_post(unsigned* bar, volatile LAS unsigned* st) {
    XcdBarrier b; b.bar = bar; b.x = xb_xcc_id(); b.st = st;
    if (threadIdx.x == 0) (void)xb_add(&bar[XB_XCNT(b.x)], 1u);
    return b;
}
__device__ __forceinline__ void xcd_barrier_complete(unsigned* bar, unsigned x, unsigned& nloc, unsigned& nx) {
    const unsigned G = gridDim.x * gridDim.y * gridDim.z;
    unsigned sum, cnt, mine, sp = 0u;
    for (;;) {
        sum = 0u; cnt = 0u; mine = 0u;
#pragma unroll
        for (unsigned j = 0; j < 16; ++j) { const unsigned c = xb_ld(&bar[XB_XCNT(j)]); sum += c; cnt += (c > 0u) ? 1u : 0u; mine = (j == x) ? c : mine; }
        if (sum == G) break;
        __builtin_amdgcn_s_sleep(1);
        if ((++sp & 255u) == 0u) { if (xb_ld(&bar[XB_TMO])) break; if (sp > XB_SPIN_CAP) { atomicAdd(&bar[XB_TMO], 1u); break; } }
    }
    nloc = mine > 0u ? mine : 1u; nx = cnt > 0u ? cnt : 1u;
}
__device__ __forceinline__ void xcd_barrier(const XcdBarrier& b) {
    asm volatile("s_waitcnt vmcnt(0)" ::: "memory");
    __syncthreads();
    if (threadIdx.x == 0) {
        unsigned* bar = b.bar;
        __builtin_amdgcn_s_waitcnt(0);
        unsigned nloc = b.st[0], nx = b.st[1];
        if (nloc == 0u) { xcd_barrier_complete(bar, b.x, nloc, nx); b.st[0] = nloc; b.st[1] = nx; }
        const unsigned old = xb_add(&bar[XB_XSUB(b.x)], 1u);
        const unsigned gen = old / nloc;
        if (old + 1u == (gen + 1u) * nloc) {
            __builtin_amdgcn_fence(__ATOMIC_RELEASE, "agent");
            asm volatile("s_waitcnt vmcnt(0)" ::: "memory");
            const unsigned og = xb_add(&bar[XB_TOP], 1u);
            const unsigned tg = og / nx;
            if (og + 1u == (tg + 1u) * nx) xb_add(&bar[XB_TOPGEN], 1u);
            else XB_SPIN(xb_ld(&bar[XB_TOPGEN]) == tg, bar);
            __builtin_amdgcn_fence(__ATOMIC_ACQUIRE, "agent");
            xb_add(&bar[XB_XGEN(b.x)], 1u);
            asm volatile("s_waitcnt vmcnt(0)" ::: "memory");
        } else {
            XB_SPIN(xb_ld(&bar[XB_XGEN(b.x)]) == gen, bar);
            __builtin_amdgcn_fence(__ATOMIC_ACQUIRE, "agent");
            asm volatile("s_waitcnt vmcnt(0)" ::: "memory");
        }
    }
    __syncthreads();
}

namespace pg8 {
struct TileOrder {
    int nM, nN, nwg, G, c;
    __device__ __forceinline__ void init(int nM_, int nN_, int G_, int c_) { nM = nM_; nN = nN_; nwg = nM * nN; G = G_; c = c_; }
    __device__ __forceinline__ bool logical(int i, int& im, int& in) const {
        const long L = (long)i * G + c; if (L >= nwg) return false;
        int wgid = (int)L; { const int q = nwg / NXCD, r = nwg % NXCD, xcd = wgid % NXCD, off = wgid / NXCD; wgid = (xcd < r ? xcd * (q + 1) : r * (q + 1) + (xcd - r) * q) + off; }
        const int nig = WGM * nN, gid = wgid / nig, fm = gid * WGM, gsz = (nM - fm) < WGM ? (nM - fm) : WGM;
        im = fm + ((wgid % nig) % gsz); in = (wgid % nig) / gsz; return true;
    }
    __device__ __forceinline__ void a_ready(const Unit&) const {}
    __device__ __forceinline__ void done(const Unit&) const {}
};
struct AllOrder : TileOrder { __device__ __forceinline__ bool next(int i, Unit& u) const { int im, in; if (!logical(i, im, in)) return false; u.pm = im; u.pn = in; return true; } };
struct LatOrder : TileOrder {
    __device__ __forceinline__ bool next(int i, Unit& u) const { int im, in; if (!logical(i, im, in)) return false; u.pm = (im >> 4) * 17 + 1 + (im & 15); u.pn = in; return true; } };
struct MoeOrder : TileOrder {
    const PG8_LAS int* tile_e; int nper;
    __device__ __forceinline__ bool next(int i, Unit& u) const { int im, in; if (!logical(i, im, in)) return false; u.pm = im; u.pn = tile_e[im] * nper + in; return true; } };

struct EpiRes {
    static constexpr bool PERM = false, AFTER_DRAIN = false;
    const float* xin; float* h; const float* modv; const float* bias;
    __device__ __forceinline__ void operator()(const f32x4 (&acc)[2][2][4][2], const Unit& u, int wr, int wc, int fr, int fq) const {
        const int b = u.pm / 17, j = u.pm % 17;
        const int rl0 = wr * 64 + fr, col0 = u.pn * BM + wc * 32 + 4 * fq;
        const float* gate = modv + (size_t)b * 6144 + 2048;
        f32x4 gv[2][2], bv[2][2];
#pragma unroll
        for (int bj = 0; bj < 2; ++bj)
#pragma unroll
            for (int n = 0; n < 2; ++n) { gv[bj][n] = *(const f32x4*)(gate + col0 + bj * HALF + n * 16); bv[bj][n] = bias ? *(const f32x4*)(bias + col0 + bj * HALF + n * 16) : (f32x4){0.f, 0.f, 0.f, 0.f}; }
#pragma unroll
        for (int ai = 0; ai < 2; ++ai)
#pragma unroll
            for (int m = 0; m < 4; ++m) { const int rl = rl0 + ai * HALF + m * 16; const size_t grow = (size_t)u.pm * BM + rl;
                const float* hin = xin ? xin + ((size_t)b * 4096 + (size_t)(j - 1) * 256 + rl) * 1024 + col0 : h + grow * 1024 + col0;
                float* ho = h + grow * 1024 + col0;
#pragma unroll
                for (int bj = 0; bj < 2; ++bj)
#pragma unroll
                    for (int n = 0; n < 2; ++n) { const f32x4 hv = *(const f32x4*)(hin + bj * HALF + n * 16);
                        *(f32x4*)(ho + bj * HALF + n * 16) = hv * 1.4142135623730951f + gv[bj][n] * (acc[ai][bj][m][n] + bv[bj][n]); } }
    }
};
template <int MODE> struct EpiGate {
    static constexpr bool PERM = true, AFTER_DRAIN = false;
    bf16_t* O; const float* bias; int nper;
    __device__ __forceinline__ void operator()(const f32x4 (&acc)[2][2][4][2], const Unit& u, int wr, int wc, int fr, int fq) const {
        const int row0 = u.pm * BM + wr * 64 + fr, pnl = u.pn % nper, ocol0 = pnl * HALF + wc * 32 + 8 * fq, bcol0 = u.pn * BM + wc * 32 + 8 * fq;
        f32x4 bv[2][2];
#pragma unroll
        for (int bj = 0; bj < 2; ++bj)
#pragma unroll
            for (int n = 0; n < 2; ++n) bv[bj][n] = *(const f32x4*)(bias + bcol0 + bj * HALF + 4 * n);
#pragma unroll
        for (int ai = 0; ai < 2; ++ai)
#pragma unroll
            for (int m = 0; m < 4; ++m) { bf16_t* rowp = O + (size_t)(row0 + ai * HALF + m * 16) * 1024 + ocol0;
                float o[8];
#pragma unroll
                for (int n = 0; n < 2; ++n) { const f32x4 a = acc[ai][0][m][n] + bv[0][n], g = acc[ai][1][m][n] + bv[1][n];
#pragma unroll
                    for (int e = 0; e < 4; ++e) {
                        if (MODE == 0) { o[4 * n + e] = a[e] * (1.f / (1.f + __expf(-g[e]))); }
                        else { const float gt = fminf(a[e], 7.0f), up = fminf(fmaxf(g[e], -7.0f), 7.0f); o[4 * n + e] = (up + 1.0f) * gt * (1.f / (1.f + __expf(-1.702f * gt))); } } }
                u32x4 w; w.x = cvt_pk_bf16(o[0], o[1]); w.y = cvt_pk_bf16(o[2], o[3]); w.z = cvt_pk_bf16(o[4], o[5]); w.w = cvt_pk_bf16(o[6], o[7]);
                *(u32x4*)rowp = w; }
    }
};
struct EpiDown {
    static constexpr bool PERM = true, AFTER_DRAIN = false;
    bf16_t* Y; const float* bias; const float* row_w; const int* row_dst;
    __device__ __forceinline__ void operator()(const f32x4 (&acc)[2][2][4][2], const Unit& u, int wr, int wc, int fr, int fq) const {
        const int row0 = u.pm * BM + wr * 64 + fr, pnl = u.pn & 3, ocol0 = pnl * BM + wc * 32 + 8 * fq, bcol0 = u.pn * BM + wc * 32 + 8 * fq;
        f32x4 bv[2][2];
#pragma unroll
        for (int bj = 0; bj < 2; ++bj)
#pragma unroll
            for (int n = 0; n < 2; ++n) bv[bj][n] = *(const f32x4*)(bias + bcol0 + bj * HALF + 4 * n);
#pragma unroll
        for (int ai = 0; ai < 2; ++ai)
#pragma unroll
            for (int m = 0; m < 4; ++m) { const int r = row0 + ai * HALF + m * 16; const int dst = row_dst[r]; const float w8 = row_w[r];
                if (dst >= 0) { bf16_t* rowp = Y + (size_t)dst * 1024 + ocol0;
#pragma unroll
                    for (int bj = 0; bj < 2; ++bj) { const f32x4 v0 = (acc[ai][bj][m][0] + bv[bj][0]) * w8, v1 = (acc[ai][bj][m][1] + bv[bj][1]) * w8;
                        u32x4 w; w.x = cvt_pk_bf16(v0[0], v0[1]); w.y = cvt_pk_bf16(v0[2], v0[3]); w.z = cvt_pk_bf16(v1[0], v1[1]); w.w = cvt_pk_bf16(v1[2], v1[3]);
                        *(u32x4*)(rowp + bj * HALF) = w; } } }
    }
};
}

namespace att {
using bf16x8 = __attribute__((ext_vector_type(8))) short;
using s16x4  = __attribute__((ext_vector_type(4))) short;
using f32x16 = __attribute__((ext_vector_type(16))) float;
using u32x4  = __attribute__((ext_vector_type(4))) unsigned;
constexpr int NW = 8, QBLK = 32, KVBLK = 64;
constexpr float SCALE = 0.10206207261596575f;
constexpr float THR = 8.f;
constexpr int SHM_V = 16384, SHM_K = 16384, SHM_ATTN = 2 * SHM_V + 2 * SHM_K + NW * 64 * 4;
#define KSWZ(row, colB) ((row) * 256 + ((colB) ^ (((row) & 7) << 4)))
#define SBAR() __builtin_amdgcn_sched_barrier(0)
__device__ __forceinline__ int crow(int r, int hi) { return (r & 3) + 8 * (r >> 2) + 4 * hi; }
__device__ __forceinline__ unsigned cvtpk(float lo, float hi) { unsigned r; asm volatile("v_cvt_pk_bf16_f32 %0, %1, %2" : "=v"(r) : "v"(lo), "v"(hi)); return r; }

__device__ __forceinline__ void partialSM(f32x16& p0, f32x16& p1, float& m_reg, float& mn, float& alpha) {
  constexpr float C = SCALE * 1.4426950408889634f;
  float pmax = p0[0];
#pragma unroll
  for (int r = 1; r < 16; ++r) pmax = fmaxf(pmax, p0[r]);
#pragma unroll
  for (int r = 0; r < 16; ++r) pmax = fmaxf(pmax, p1[r]);
  { auto rr = __builtin_amdgcn_permlane32_swap(__float_as_uint(pmax), __float_as_uint(pmax), false, false);
    pmax = fmaxf(__uint_as_float(rr[0]), __uint_as_float(rr[1])); }
  if (__builtin_expect(__all(pmax - m_reg <= THR / SCALE), 1)) { mn = m_reg; alpha = 1.f; }
  else { mn = fmaxf(m_reg, pmax); alpha = __builtin_amdgcn_exp2f((m_reg - mn) * C); m_reg = mn; }
  float mnC = -mn * C;
#pragma unroll
  for (int r = 0; r < 16; ++r) p0[r] = fmaf(p0[r], C, mnC);
#pragma unroll
  for (int r = 0; r < 16; ++r) p1[r] = fmaf(p1[r], C, mnC);
#pragma unroll
  for (int r = 0; r < 16; ++r) p0[r] = __builtin_amdgcn_exp2f(p0[r]);
}
__device__ __forceinline__ void finishSM(f32x16& p0, f32x16& p1, float alpha, float& l_reg, bf16x8& pa0, bf16x8& pa1, bf16x8& pa2, bf16x8& pa3) {
#pragma unroll
  for (int r = 0; r < 16; ++r) p1[r] = __builtin_amdgcn_exp2f(p1[r]);
  float ps = 0;
#pragma unroll
  for (int r = 0; r < 16; ++r) ps += p0[r];
#pragma unroll
  for (int r = 0; r < 16; ++r) ps += p1[r];
  { auto rr = __builtin_amdgcn_permlane32_swap(__float_as_uint(ps), __float_as_uint(ps), false, false);
    ps = __uint_as_float(rr[0]) + __uint_as_float(rr[1]); }
  l_reg = l_reg * alpha + ps;
#define PK4(P, BASE, OUT) do { unsigned a0 = cvtpk(P[BASE + 0], P[BASE + 1]), a1 = cvtpk(P[BASE + 2], P[BASE + 3]);   \
    unsigned b0 = cvtpk(P[BASE + 4], P[BASE + 5]), b1 = cvtpk(P[BASE + 6], P[BASE + 7]);                              \
    auto r0 = __builtin_amdgcn_permlane32_swap(a0, b0, false, false); auto r1 = __builtin_amdgcn_permlane32_swap(a1, b1, false, false); \
    u32x4 w = {r0[0], r1[0], r0[1], r1[1]}; OUT = *reinterpret_cast<bf16x8*>(&w); } while (0)
  PK4(p0, 0, pa0); PK4(p0, 8, pa1); PK4(p1, 0, pa2); PK4(p1, 8, pa3);
#undef PK4
}
__device__ __forceinline__ void qkt(f32x16& p0, f32x16& p1, const bf16* Ks, const bf16x8* qr, int r32, int hi) {
  p0 = f32x16{}; p1 = f32x16{};
#pragma unroll
  for (int d0 = 0; d0 < 6; ++d0) { int cb = (d0 * 16 + hi * 8) * 2;
    bf16x8 b0 = *reinterpret_cast<const bf16x8*>((const char*)Ks + KSWZ(r32, cb));
    bf16x8 b1 = *reinterpret_cast<const bf16x8*>((const char*)Ks + KSWZ(32 + r32, cb));
    p0 = __builtin_amdgcn_mfma_f32_32x32x16_bf16(b0, qr[d0], p0, 0, 0, 0);
    p1 = __builtin_amdgcn_mfma_f32_32x32x16_bf16(b1, qr[d0], p1, 0, 0, 0); }
}
__device__ __forceinline__ int v_st(int k, int c) { const int kk = (k & ~0xC) | ((k & 4) << 1) | ((k & 8) >> 1); return ((kk >> 3) * 4 + (c >> 5)) * 512 + ((kk & 7) * 32 + (c & 31)) * 2; }
__device__ __forceinline__ int v_rd_base(int lane) { return ((lane & 3) << 3) | (((lane >> 2) & 3) << 6) | (((lane >> 4) & 1) << 5) | (((lane >> 5) & 1) << 8); }
constexpr int v_rd_off(int d0, int ks, int half) { return d0 * 512 + ks * 4096 + half * 2048; }
template <int OFF> __device__ __forceinline__ s16x4 tr_read(int vb) {
  s16x4 r; asm volatile("ds_read_b64_tr_b16 %0, %1 offset:%2" : "=&v"(r) : "v"(vb), "i"(OFF) : "memory"); return r;
}
template <int D0> __device__ __forceinline__ void pv_one(f32x16& od, int vb, bf16x8 pa0, bf16x8 pa1, bf16x8 pa2, bf16x8 pa3) {
  const s16x4 l0 = tr_read<v_rd_off(D0, 0, 0)>(vb), h0 = tr_read<v_rd_off(D0, 0, 1)>(vb), l1 = tr_read<v_rd_off(D0, 1, 0)>(vb), h1 = tr_read<v_rd_off(D0, 1, 1)>(vb);
  const s16x4 l2 = tr_read<v_rd_off(D0, 2, 0)>(vb), h2 = tr_read<v_rd_off(D0, 2, 1)>(vb), l3 = tr_read<v_rd_off(D0, 3, 0)>(vb), h3 = tr_read<v_rd_off(D0, 3, 1)>(vb);
  asm volatile("s_waitcnt lgkmcnt(0)" ::: "memory"); SBAR();
#define PK(L, H) (bf16x8){L[0], L[1], L[2], L[3], H[0], H[1], H[2], H[3]}
  od = __builtin_amdgcn_mfma_f32_32x32x16_bf16(pa0, PK(l0, h0), od, 0, 0, 0);
  od = __builtin_amdgcn_mfma_f32_32x32x16_bf16(pa1, PK(l1, h1), od, 0, 0, 0);
  od = __builtin_amdgcn_mfma_f32_32x32x16_bf16(pa2, PK(l2, h2), od, 0, 0, 0);
  od = __builtin_amdgcn_mfma_f32_32x32x16_bf16(pa3, PK(l3, h3), od, 0, 0, 0);
#undef PK
}
__device__ __forceinline__ void pv_d0(f32x16* o, int vb, bf16x8 pa0, bf16x8 pa1, bf16x8 pa2, bf16x8 pa3) {
  pv_one<0>(o[0], vb, pa0, pa1, pa2, pa3); pv_one<1>(o[1], vb, pa0, pa1, pa2, pa3);
}
__device__ __forceinline__ bf16x8 rope8(bf16x8 x, const float* tab, int pbase) {
  u32x4 w;
#pragma unroll
  for (int i = 0; i < 4; ++i) { const float x1 = __uint_as_float(((unsigned)(unsigned short)x[2 * i]) << 16), x2 = __uint_as_float(((unsigned)(unsigned short)x[2 * i + 1]) << 16);
    const float cs = tab[pbase + i], sn = tab[16 + pbase + i]; w[i] = cvtpk(x1 * cs - x2 * sn, x1 * sn + x2 * cs); }
  return *reinterpret_cast<bf16x8*>(&w);
}
__device__ __forceinline__ void attn_unit(const bf16* __restrict__ Qb, const bf16* __restrict__ KVb, const bf16* __restrict__ KRb, bf16* __restrict__ Ob,
                                          const float* __restrict__ rope, int seq, char* lds) {
  int tid_l = threadIdx.x; asm volatile("" : "+v"(tid_l));
  const int tid = tid_l, wid = tid >> 6, lane = tid & 63, r32 = lane & 31, hi = lane >> 5;
  bf16* V_lds = (bf16*)lds; bf16* K_lds = (bf16*)(lds + 2 * SHM_V);
  float* ws = (float*)(lds + 2 * SHM_V + 2 * SHM_K) + wid * 64; float* li_l = ws; float* al_l = ws + 32;
  float m_reg = -1e30f, l_reg = 0; f32x16 o[2] = {}; bf16x8 qr[6];
  const bf16* Qw = Qb + (long)(wid * QBLK + r32) * 768 + hi * 8;
#pragma unroll
  for (int d0 = 0; d0 < 6; ++d0) qr[d0] = *reinterpret_cast<const bf16x8*>(Qw + d0 * 16);
  if (rope) { const float* tab = rope + (long)(wid * QBLK + r32) * 32; qr[4] = rope8(qr[4], tab, 4 * hi); qr[5] = rope8(qr[5], tab, 8 + 4 * hi); }
  const int sr = tid >> 4, ch = tid & 15;
  const bf16* kbase = ch < 8 ? KVb + ch * 8 : KRb + ((ch - 8) & 3) * 8; const long kstr = ch < 8 ? 1024 : 32;
  const int vkey = tid >> 3, vc8 = (tid & 7) * 8, vst0 = v_st(vkey, vc8);
  const bf16* vbase = KVb + 512 + vc8;
  const int vb0 = (int)(uintptr_t)V_lds + v_rd_base(lane);
  struct { bf16x8 vs0, ks0, ks1; } sr_[2];
#define SLOAD(i, k0) do { sr_[i].vs0 = *reinterpret_cast<const bf16x8*>(vbase + (long)((k0) + vkey) * 1024); \
    sr_[i].ks0 = *reinterpret_cast<const bf16x8*>(kbase + (long)((k0) + sr) * kstr); sr_[i].ks1 = *reinterpret_cast<const bf16x8*>(kbase + (long)((k0) + 32 + sr) * kstr); } while (0)
#define SWRITE(b, i) do { *(bf16x8*)((char*)V_lds + (b) * SHM_V + vst0) = sr_[i].vs0; int kc = ch * 16;               \
    *(bf16x8*)((char*)K_lds + (b) * SHM_K + KSWZ(sr, kc)) = sr_[i].ks0;                       \
    *(bf16x8*)((char*)K_lds + (b) * SHM_K + KSWZ(32 + sr, kc)) = sr_[i].ks1; } while (0)
#define SWAIT() asm volatile("s_waitcnt vmcnt(3)" ::: "memory")
#define RESC(a) do { if (__any((a) < 1.f)) { if (hi == 0) al_l[r32] = (a); asm volatile("s_waitcnt lgkmcnt(0)" ::: "memory"); \
    _Pragma("unroll") for (int d = 0; d < 2; ++d) _Pragma("unroll") for (int r = 0; r < 16; ++r) o[d][r] *= al_l[crow(r, hi)]; } } while (0)
  f32x16 pA0, pA1, pB0, pB1; float mnA, mnB, alA, alB; bf16x8 pa0, pa1, pa2, pa3; const int NT = seq / KVBLK;
  constexpr int SE = 0, SO = 1;
  SLOAD(SE, 0); asm volatile("s_waitcnt vmcnt(0)" ::: "memory"); SWRITE(0, SE); __syncthreads();
  qkt(pA0, pA1, K_lds, qr, r32, hi); partialSM(pA0, pA1, m_reg, mnA, alA);
  SLOAD(SO, KVBLK); if (2 < NT) SLOAD(SE, 2 * KVBLK);
  SWAIT(); SWRITE(1, SO); __syncthreads();
  for (int j = 1; j + 1 < NT; j += 2) {
    SBAR(); qkt(pB0, pB1, (bf16*)((char*)K_lds + SHM_K), qr, r32, hi);
    finishSM(pA0, pA1, alA, l_reg, pa0, pa1, pa2, pa3); SBAR();
    SLOAD(SO, (j + 2) * KVBLK); SBAR();
    pv_d0(o, vb0, pa0, pa1, pa2, pa3); partialSM(pB0, pB1, m_reg, mnB, alB);
    __syncthreads(); SWAIT(); SWRITE(0, SE);
    RESC(alB); __syncthreads();
    SBAR(); qkt(pA0, pA1, K_lds, qr, r32, hi);
    finishSM(pB0, pB1, alB, l_reg, pa0, pa1, pa2, pa3); SBAR();
    if (j + 3 < NT) SLOAD(SE, (j + 3) * KVBLK); SBAR();
    pv_d0(o, vb0 + (int)SHM_V, pa0, pa1, pa2, pa3); partialSM(pA0, pA1, m_reg, mnA, alA);
    __syncthreads(); SWAIT(); SWRITE(1, SO);
    RESC(alA); __syncthreads();
  }
  SBAR(); qkt(pB0, pB1, (bf16*)((char*)K_lds + SHM_K), qr, r32, hi);
  finishSM(pA0, pA1, alA, l_reg, pa0, pa1, pa2, pa3); SBAR();
  pv_d0(o, vb0, pa0, pa1, pa2, pa3); partialSM(pB0, pB1, m_reg, mnB, alB);
  __syncthreads(); RESC(alB);
  finishSM(pB0, pB1, alB, l_reg, pa0, pa1, pa2, pa3); SBAR();
  pv_d0(o, vb0 + (int)SHM_V, pa0, pa1, pa2, pa3);
  if (hi == 0) li_l[r32] = l_reg; asm volatile("s_waitcnt lgkmcnt(0)" ::: "memory");
  float rli[16];
#pragma unroll
  for (int r = 0; r < 16; ++r) rli[r] = __builtin_amdgcn_rcpf(li_l[crow(r, hi)]);
  bf16* Ow = Ob + (long)(wid * QBLK) * 1024;
#pragma unroll
  for (int r = 0; r < 16; ++r) { int orow = crow(r, hi);
#pragma unroll
    for (int d0 = 0; d0 < 2; ++d0) { const float v = o[d0][r] * rli[r]; Ow[(long)orow * 1024 + d0 * 32 + r32] = (bf16)(cvtpk(v, v) & 0xffffu); } }
#undef SLOAD
#undef SWRITE
#undef SWAIT
#undef RESC
}
}

struct Args { const float* in[33]; float* out; unsigned char* ws; int ph_lo, ph_hi; };
enum { I_X = 0, I_C, I_CTX, I_CCTX, I_MODW, I_MODB, I_LN1G, I_LN1B, I_LN2G, I_LN2B, I_WIN, I_QNORM, I_KVNORM, I_WUQ, I_WUK, I_WUV, I_LBL, I_HGNORM, I_WOUT,
       I_PW1W, I_PW1B, I_DWW, I_DWB, I_CLNG, I_CLNB, I_PW2W, I_PW2B, I_RW, I_RB, I_WGU, I_BGU, I_WDN, I_BDN };

__device__ __forceinline__ int dst_row(int n, int mode, int row_off) {
    if (mode == 0) return row_off + n;
    int f, g; if (mode == 1) { f = n >> 1; g = n & 1; } else { g = n >> 10; f = n & 1023; }
    return row_off + 256 * (f >> 7) + 128 * g + (f & 127);
}
__device__ __forceinline__ void tr_item(const float* __restrict__ W, int K, int N, bf16* __restrict__ WT, int mode, int row_off, LAS float* scr, int item, int lane) {
    const int nblk = (N + 63) >> 6, kb = item / nblk, nb = item - kb * nblk, k0 = 64 * kb, n0 = 64 * nb;
    const int nc = n0 + 4 * (lane & 15), kr = lane >> 4;
    f32x4 v[16];
#pragma unroll
    for (int i = 0; i < 16; ++i) v[i] = (nc < N) ? *(const f32x4*)(W + (size_t)(k0 + 4 * i + kr) * N + nc) : (f32x4){0.f, 0.f, 0.f, 0.f};
#pragma unroll
    for (int i = 0; i < 16; ++i) { LAS float* s = scr + (4 * i + kr) * 65 + 4 * (lane & 15); s[0] = v[i][0]; s[1] = v[i][1]; s[2] = v[i][2]; s[3] = v[i][3]; }
    LDS_WAIT();
    const int c = lane & 7;
#pragma unroll
    for (int j = 0; j < 8; ++j) { const int nl = (lane >> 3) + 8 * j, n = n0 + nl; const LAS float* s = scr + (8 * c) * 65 + nl;
        v4u o; o.x = pk2(s[0 * 65], s[1 * 65]); o.y = pk2(s[2 * 65], s[3 * 65]); o.z = pk2(s[4 * 65], s[5 * 65]); o.w = pk2(s[6 * 65], s[7 * 65]);
        if (n < N) *(v4u*)(WT + (size_t)dst_row(n, mode, row_off) * K + k0 + 8 * c) = o; }
    LDS_WAIT();
}
__device__ __forceinline__ void phase_prologue(const Args& a, LAS unsigned char* lds, int tid, int lane, int wave) {
    unsigned char* ws = a.ws;
    const int G = gridDim.x, B = blockIdx.x;
    {
        LAS float* sc = (LAS float*)lds;
        LAS float* red = (LAS float*)(lds + 36864);
        float* modv = (float*)(ws + WS_MODV);
        bool have = false;
        for (int it = B; it < 192; it += G) {
            if (!have) { for (int i = tid; i < 9 * 1024; i += NTHR) { const int r = i >> 10, k = i & 1023; const float x = r < 8 ? a.in[I_C][r * 1024 + k] : a.in[I_CCTX][k]; sc[i] = x * sigm(x); } __syncthreads(); have = true; }
            const int l = it / 96, jc = it % 96, kg = tid >> 6, jj = tid & 63, j = jc * 64 + jj;
            float acc[9];
#pragma unroll
            for (int r = 0; r < 9; ++r) acc[r] = 0.f;
            const float* wp = a.in[I_MODW] + ((size_t)l * 1024 + kg * 128) * 6144 + j;
            for (int k0 = 0; k0 < 128; k0 += 16) { float w[16];
#pragma unroll
                for (int kk = 0; kk < 16; ++kk) w[kk] = wp[(size_t)(k0 + kk) * 6144];
#pragma unroll
                for (int kk = 0; kk < 16; ++kk)
#pragma unroll
                    for (int r = 0; r < 9; ++r) acc[r] += sc[r * 1024 + kg * 128 + k0 + kk] * w[kk]; }
#pragma unroll
            for (int r = 0; r < 9; ++r) red[(kg * 9 + r) * 64 + jj] = acc[r];
            __syncthreads();
            for (int i = tid; i < 576; i += NTHR) { const int r = i >> 6, j2 = i & 63; float s = a.in[I_MODB][l * 6144 + jc * 64 + j2];
#pragma unroll
                for (int g = 0; g < 8; ++g) s += red[(g * 9 + r) * 64 + j2];
                modv[((size_t)l * 9 + r) * 6144 + jc * 64 + j2] = s; }
            __syncthreads();
        }
        __syncthreads();
    }
    const int gw = B * NWAVES + wave, NGW = G * NWAVES, gt = B * NTHR + tid, NGT = G * NTHR;
    { float* rope = (float*)(ws + WS_ROPE);
      for (int i = gt; i < 4096 * 16; i += NGT) { const int t = i >> 4, p = i & 15; const float pos = (float)(p < 8 ? (t >> 6) : (t & 63));
          const float inv = __powf(10000.0f, -(float)(p & 7) * 0.125f); const float ang = pos * inv; rope[t * 32 + p] = cosf(ang); rope[t * 32 + 16 + p] = sinf(ang); }
      float* bgu = (float*)(ws + WS_BGU);
      for (int i = gt; i < 2 * 32 * 2048; i += NGT) { const int le = i >> 11, np = i & 2047, q = np >> 8, g = (np >> 7) & 1, r = np & 127, f = 128 * q + r; bgu[i] = a.in[I_BGU][(size_t)le * 2048 + 2 * f + g]; }
      float* pb = (float*)(ws + WS_PW1B);
      for (int i = gt; i < 2048; i += NGT) { const int q = i >> 8, g = (i >> 7) & 1, r = i & 127, f = 128 * q + r; pb[i] = a.in[I_PW1B][g * 1024 + f]; }
      v4u* zp = (v4u*)(ws + WS_WIN + (size_t)3232 * 1024 * 2);
      for (int i = gt; i < 96 * 1024 * 2 / 16; i += NGT) zp[i] = (v4u){0u, 0u, 0u, 0u};
    }
    LAS float* scr = (LAS float*)(lds + wave * 16640);
    constexpr int I0 = 16 * 51, I1 = 6 * 12, I2 = 4 * 8, I3 = 4 * 8, I4 = 256, I5 = 512, I6 = 256, SMALL = I0 + I1 + I2 + I3 + I4 + I5 + I6;
    constexpr int NGU = 64 * 512, NDN = 64 * 256, NITEMS = SMALL + NGU + NDN;
    for (int it = gw; it < NITEMS; it += NGW) {
        int r = it;
        if (r < NGU) { const int mi = r >> 9; tr_item(a.in[I_WGU] + (size_t)mi * 1024 * 2048, 1024, 2048, (bf16*)(ws + WS_WGU) + (size_t)mi * 2048 * 1024, 1, 0, scr, r & 511, lane); continue; } r -= NGU;
        if (r < NDN) { const int mi = r >> 8; tr_item(a.in[I_WDN] + (size_t)mi * 1024 * 1024, 1024, 1024, (bf16*)(ws + WS_WDN) + (size_t)mi * 1024 * 1024, 0, 0, scr, r & 255, lane); continue; } r -= NDN;
        if (r < I0) { tr_item(a.in[I_WIN], 1024, 3232, (bf16*)(ws + WS_WIN), 0, 0, scr, r, lane); continue; } r -= I0;
        if (r < I1) { tr_item(a.in[I_WUQ], 384, 768, (bf16*)(ws + WS_WUQ), 0, 0, scr, r, lane); continue; } r -= I1;
        if (r < I2) { tr_item(a.in[I_WUK], 256, 512, (bf16*)(ws + WS_WUKV), 0, 0, scr, r, lane); continue; } r -= I2;
        if (r < I3) { tr_item(a.in[I_WUV], 256, 512, (bf16*)(ws + WS_WUKV), 0, 512, scr, r, lane); continue; } r -= I3;
        if (r < I4) { tr_item(a.in[I_WOUT], 1024, 1024, (bf16*)(ws + WS_WOUT), 0, 0, scr, r, lane); continue; } r -= I4;
        if (r < I5) { tr_item(a.in[I_PW1W], 1024, 2048, (bf16*)(ws + WS_WPW1), 2, 0, scr, r, lane); continue; } r -= I5;
        tr_item(a.in[I_PW2W], 1024, 1024, (bf16*)(ws + WS_WPW2), 0, 0, scr, r, lane);
    }
}

__device__ __forceinline__ void phase_mod0(const Args& a, int lane, int wave) {
    const int gw = blockIdx.x * NWAVES + wave, NGW = gridDim.x * NWAVES;
    const float* modv = (const float*)(a.ws + WS_MODV);
    bf16* X = (bf16*)(a.ws + WS_X);
    for (int r = gw; r < NTOK; r += NGW) {
        const int b = r / TPB, p = r - b * TPB;
        const float* src = p < CTXL ? a.in[I_CTX] + ((size_t)b * CTXL + p) * 1024 : a.in[I_X] + ((size_t)b * SEQ + (p - CTXL)) * 1024;
        const float* mv = modv + (size_t)(p < CTXL ? 8 : b) * 6144;
#pragma unroll
        for (int j = 0; j < 4; ++j) { const int c = 4 * (lane + 64 * j); const f32x4 xv = *(const f32x4*)(src + c), sh = *(const f32x4*)(mv + c), sc = *(const f32x4*)(mv + 1024 + c);
            const f32x4 y = xv * (sc + 1.0f) + sh; v2u o; o.x = pk2(y[0], y[1]); o.y = pk2(y[2], y[3]); *(v2u*)(X + (size_t)r * 1024 + c) = o; }
    }
}

__device__ __forceinline__ void phase_norm0(const Args& a, int lane, int wave) {
    const int gw = blockIdx.x * NWAVES + wave, NGW = gridDim.x * NWAVES;
    const bf16* Z = (const bf16*)(a.ws + WS_Z); bf16* CQN = (bf16*)(a.ws + WS_CQN); bf16* CKVN = (bf16*)(a.ws + WS_CKVN); bf16* KRR = (bf16*)(a.ws + WS_KRR);
    const float* rope = (const float*)(a.ws + WS_ROPE);
    float gq[8], gk[8];
#pragma unroll
    for (int i = 0; i < 8; ++i) { gq[i] = lane < 48 ? a.in[I_QNORM][8 * lane + i] : 0.f; gk[i] = lane < 32 ? a.in[I_KVNORM][8 * lane + i] : 0.f; }
    for (int r = gw; r < NTOK; r += NGW) {
        const bf16* z = Z + (size_t)r * ZC; const int p = r % TPB;
        bf16x8 q8 = {}, k8 = {}, r8 = {};
        if (lane < 48) q8 = *(const bf16x8*)(z + ZQ + 8 * lane);
        if (lane < 32) k8 = *(const bf16x8*)(z + ZKV + 8 * lane);
        if (lane < 4) r8 = *(const bf16x8*)(z + ZKR + 8 * lane);
        float qf[8], kf[8], sq = 0.f, sk = 0.f;
#pragma unroll
        for (int i = 0; i < 8; ++i) { qf[i] = bf2f((unsigned short)q8[i]); kf[i] = bf2f((unsigned short)k8[i]); sq += qf[i] * qf[i]; sk += kf[i] * kf[i]; }
        sq = wave_sum(sq); sk = wave_sum(sk);
        const float rq = rsqrtf(sq * (1.f / 384.f) + RMS_EPS), rk = rsqrtf(sk * (1.f / 256.f) + RMS_EPS);
        if (lane < 48) { v4u o; o.x = pk2(qf[0] * rq * gq[0], qf[1] * rq * gq[1]); o.y = pk2(qf[2] * rq * gq[2], qf[3] * rq * gq[3]); o.z = pk2(qf[4] * rq * gq[4], qf[5] * rq * gq[5]); o.w = pk2(qf[6] * rq * gq[6], qf[7] * rq * gq[7]);
            *(v4u*)(CQN + (size_t)r * 384 + 8 * lane) = o; }
        if (lane < 32) { v4u o; o.x = pk2(kf[0] * rk * gk[0], kf[1] * rk * gk[1]); o.y = pk2(kf[2] * rk * gk[2], kf[3] * rk * gk[3]); o.z = pk2(kf[4] * rk * gk[4], kf[5] * rk * gk[5]); o.w = pk2(kf[6] * rk * gk[6], kf[7] * rk * gk[7]);
            *(v4u*)(CKVN + (size_t)r * 256 + 8 * lane) = o; }
        if (lane < 4) { bf16x8 o8 = r8; if (p >= CTXL) o8 = att::rope8(r8, rope + (size_t)(p - CTXL) * 32, 4 * lane); *(bf16x8*)(KRR + (size_t)r * 32 + 8 * lane) = o8; }
    }
}

__device__ __forceinline__ void hgrn_unit(const Args& a, int unit, LAS unsigned char* lds, int tid) {
    const int b = unit >> 5, head = (unit >> 3) & 3, dir = (unit >> 2) & 1, sl = unit & 3;
    const bf16* Z = (const bf16*)(a.ws + WS_Z);
    float* Od = (float*)(a.ws + (dir ? WS_OB : WS_OF));
    LAS float* lbv = (LAS float*)lds;
    constexpr int BUF0 = 1024, BUFSZ = 28672, OFF_Q = 16384, OFF_V = 24576;
    if (tid < 128) { const int c = head * 128 + tid; const float l0 = a.in[I_LBL][c], l1 = a.in[I_LBL][512 + c], l2 = a.in[I_LBL][1024 + c]; const float m = fmaxf(l0, fmaxf(l1, l2));
        const float e0 = __expf(l0 - m), e1 = __expf(l1 - m), e2 = __expf(l2 - m); lbv[tid] = e0 / (e0 + e1 + e2); }
    __syncthreads();
    const int lt = tid >> 4, lcg = tid & 15;
    float lb8[8];
#pragma unroll
    for (int i = 0; i < 8; ++i) lb8[i] = lbv[8 * lcg + i];
    const int fcol = (dir ? ZHB : ZHF) + head * 128 + 8 * lcg, qcol = ZHQ + head * 128 + 8 * lcg;
    const int vt = tid >> 2, vcol = ZHI + head * 128 + sl * 32 + (tid & 3) * 8;
    const int wave = tid >> 6, lane = tid & 63, vv = lane >> 4, cg = lane & 15, vloc = wave * 4 + vv;
    const size_t zb = (size_t)b * TPB;
    bf16x8 rq, rf, rv;
#define TOKP(n) (dir ? ((n) < CTXL ? (CTXL - 1 - (n)) : (TPB + CTXL - 1 - (n))) : (n))
#define HG_LOAD(i) do { const int n_ = 32 * (i) + lt; const bf16* zr_ = Z + (zb + TOKP(n_)) * ZC; rq = *(const bf16x8*)(zr_ + qcol); rf = *(const bf16x8*)(zr_ + fcol); \
        if (tid < 128) { const int n2_ = 32 * (i) + vt; rv = *(const bf16x8*)(Z + (zb + TOKP(n2_)) * ZC + vcol); } } while (0)
#define HG_WRITE(bufi) do { LAS unsigned char* bp_ = lds + BUF0 + (bufi) * BUFSZ; float f_[8]; \
        _Pragma("unroll") for (int i_ = 0; i_ < 8; ++i_) f_[i_] = lb8[i_] + (1.f - lb8[i_]) * sigm(bf2f((unsigned short)rf[i_])); \
        *(LAS f32x4*)(bp_ + ((lt * 128 + lcg * 4) * 4)) = (f32x4){f_[0], f_[1], f_[2], f_[3]}; *(LAS f32x4*)(bp_ + ((lt * 128 + 64 + lcg * 4) * 4)) = (f32x4){f_[4], f_[5], f_[6], f_[7]}; \
        *(LAS bf16x8*)(bp_ + OFF_Q + (lt * 128 + lcg * 8) * 2) = rq; \
        if (tid < 128) { float v_[8]; _Pragma("unroll") for (int i_ = 0; i_ < 8; ++i_) v_[i_] = bf2f((unsigned short)rv[i_]); \
            *(LAS f32x4*)(bp_ + OFF_V + (vt * 32 + (tid & 3) * 8) * 4) = (f32x4){v_[0], v_[1], v_[2], v_[3]}; *(LAS f32x4*)(bp_ + OFF_V + (vt * 32 + (tid & 3) * 8 + 4) * 4) = (f32x4){v_[4], v_[5], v_[6], v_[7]}; } } while (0)
    float S[8];
#pragma unroll
    for (int j = 0; j < 8; ++j) S[j] = 0.f;
    HG_LOAD(0); HG_WRITE(0); __syncthreads();
    const bool b3 = (cg & 8) != 0, b2 = (cg & 4) != 0, b1 = (cg & 2) != 0, b0 = (cg & 1) != 0;
    for (int i = 0; i < TPB / 32; ++i) {
        if (i + 1 < TPB / 32) HG_LOAD(i + 1);
        const LAS unsigned char* bp = lds + BUF0 + (i & 1) * BUFSZ;
#pragma unroll 1
        for (int g = 0; g < 4; ++g) {
            const LAS unsigned char* gp = bp + g * 8 * 512;
            float ot[8];
#pragma unroll
            for (int t = 0; t < 8; ++t) {
                const f32x4 f0 = *(const LAS f32x4*)(gp + ((t * 128 + cg * 4) * 4)), f1 = *(const LAS f32x4*)(gp + ((t * 128 + 64 + cg * 4) * 4));
                const bf16x8 q8 = *(const LAS bf16x8*)(bp + OFF_Q + ((g * 8 + t) * 128 + cg * 8) * 2);
                const float v = *(const LAS float*)(bp + OFF_V + ((g * 8 + t) * 32 + vloc) * 4);
                float acc = 0.f;
#pragma unroll
                for (int j = 0; j < 8; ++j) { const float fj = j < 4 ? f0[j] : f1[j - 4]; const float qj = bf2f((unsigned short)q8[j]);
                    const float kv = fmaf(-fj, v, v); S[j] = fmaf(fj, S[j], kv); acc = fmaf(S[j], qj, acc); }
                ot[t] = acc;
            }
#pragma unroll
            for (int k = 0; k < 4; ++k) { const float snd = b3 ? ot[k] : ot[k + 4]; const float rcv = __shfl_xor(snd, 8); ot[k] = (b3 ? ot[k + 4] : ot[k]) + rcv; }
#pragma unroll
            for (int k = 0; k < 2; ++k) { const float snd = b2 ? ot[k] : ot[k + 2]; const float rcv = __shfl_xor(snd, 4); ot[k] = (b2 ? ot[k + 2] : ot[k]) + rcv; }
            { const float snd = b1 ? ot[0] : ot[1]; const float rcv = __shfl_xor(snd, 2); ot[0] = (b1 ? ot[1] : ot[0]) + rcv; }
            ot[0] += __shfl_xor(ot[0], 1);
            if (!b0) { const int n = 32 * i + 8 * g + (cg >> 1); const int p = TOKP(n); if (p >= CTXL) Od[(zb + p) * 512 + head * 128 + sl * 32 + vloc] = ot[0]; }
        }
        if (i + 1 < TPB / 32) HG_WRITE((i + 1) & 1);
        __syncthreads();
    }
#undef TOKP
#undef HG_LOAD
#undef HG_WRITE
}

__device__ __forceinline__ void phase_readout(const Args& a, int lane, int wave) {
    const int gw = blockIdx.x * NWAVES + wave, NGW = gridDim.x * NWAVES;
    const float* OF = (const float*)(a.ws + WS_OF); const float* OB = (const float*)(a.ws + WS_OB);
    const bf16* Z = (const bf16*)(a.ws + WS_Z); bf16* MIX = (bf16*)(a.ws + WS_Y);
    float hn[8];
#pragma unroll
    for (int i = 0; i < 8; ++i) hn[i] = a.in[I_HGNORM][((8 * lane) & 127) + i];
    for (int lr = gw; lr < NLAT; lr += NGW) {
        const size_t r = (size_t)grow_of(lr);
        const f32x4 a0 = *(const f32x4*)(OF + r * 512 + 8 * lane), a1 = *(const f32x4*)(OF + r * 512 + 8 * lane + 4);
        const f32x4 c0 = *(const f32x4*)(OB + r * 512 + 8 * lane), c1 = *(const f32x4*)(OB + r * 512 + 8 * lane + 4);
        const bf16x8 g8 = *(const bf16x8*)(Z + r * ZC + ZHG + 8 * lane);
        float o[8]; float ss = 0.f;
#pragma unroll
        for (int i = 0; i < 4; ++i) { o[i] = a0[i] + c0[i]; o[4 + i] = a1[i] + c1[i]; }
#pragma unroll
        for (int i = 0; i < 8; ++i) ss += o[i] * o[i];
        ss += __shfl_xor(ss, 1); ss += __shfl_xor(ss, 2); ss += __shfl_xor(ss, 4); ss += __shfl_xor(ss, 8);
        const float rs = rsqrtf(ss * (1.f / 128.f) + RMS_EPS);
        float y[8];
#pragma unroll
        for (int i = 0; i < 8; ++i) { const float g = bf2f((unsigned short)g8[i]); y[i] = o[i] * rs * hn[i] * (g * sigm(g)); }
        v4u w; w.x = pk2(y[0], y[1]); w.y = pk2(y[2], y[3]); w.z = pk2(y[4], y[5]); w.w = pk2(y[6], y[7]);
        *(v4u*)(MIX + r * 1024 + 512 + 8 * lane) = w;
    }
}

__device__ __forceinline__ int rows_per_block() { const int G = gridDim.x; return (((NLAT + G - 1) / G) + 15) & ~15; }
__device__ __forceinline__ void phase_ln1(const Args& a, int l, LAS unsigned char* lds, int tid, int lane, int wave) {
    const int RB = rows_per_block(), lr_base = blockIdx.x * RB;
    float* H = (float*)(a.ws + WS_H); bf16* XB = (bf16*)(a.ws + WS_X);
    const float* modv = (const float*)(a.ws + WS_MODV) + (size_t)l * 9 * 6144;
    const float* lng = a.in[I_LN1G] + l * 1024; const float* lnb = a.in[I_LN1B] + l * 1024;
    const float* rw = a.in[I_RW] + (size_t)l * 1024 * 32; const float* rb = a.in[I_RB] + l * 32;
    int* topi = (int*)(a.ws + WS_TOPI); float* topw = (float*)(a.ws + WS_TOPW);
    LAS float* rwl = (LAS float*)lds;
    LAS float* lgs = (LAS float*)(lds + 131072) + wave * 64;
    LAS int* hist = (LAS int*)(lds + 131072 + 2048);
    for (int i = tid; i < 8192; i += NTHR) { const int k = i >> 3, q = i & 7; *(LAS f32x4*)(rwl + k * 32 + 4 * (q ^ ((k >> 2) & 7))) = *(const f32x4*)(rw + k * 32 + 4 * q); }
    if (tid < 32) hist[tid] = 0;
    __syncthreads();
    const int sw = lane & 7;
    for (int i = 2 * wave; i < RB; i += 16) {
        const int lr0 = lr_base + i; if (lr0 >= NLAT) break;
        float vv[2][16];
#pragma unroll
        for (int rr = 0; rr < 2; ++rr) {
            const int lr = lr0 + rr; const size_t r = (size_t)grow_of(lr); const int b = lr >> 12;
            const float* mv = modv + (size_t)b * 6144;
            f32x4 x[4]; float s = 0.f;
#pragma unroll
            for (int j = 0; j < 4; ++j) { x[j] = *(const f32x4*)(H + r * 1024 + 4 * (lane + 64 * j)); s += (x[j][0] + x[j][1]) + (x[j][2] + x[j][3]); }
            const float mean = wave_sum(s) * (1.f / 1024.f); float s2 = 0.f;
#pragma unroll
            for (int j = 0; j < 4; ++j) { x[j] = x[j] - mean; s2 += (x[j][0] * x[j][0] + x[j][1] * x[j][1]) + (x[j][2] * x[j][2] + x[j][3] * x[j][3]); }
            const float rstd = rsqrtf(wave_sum(s2) * (1.f / 1024.f) + LN_EPS);
#pragma unroll
            for (int j = 0; j < 4; ++j) { const int c = 4 * (lane + 64 * j); const f32x4 g = *(const f32x4*)(lng + c), bb = *(const f32x4*)(lnb + c);
                const f32x4 hv = x[j] * rstd * g + bb; *(f32x4*)(H + r * 1024 + c) = hv;
                const f32x4 sh = *(const f32x4*)(mv + 3 * 1024 + c), sc = *(const f32x4*)(mv + 4 * 1024 + c);
                const f32x4 bm = hv * (sc + 1.0f) + sh; v2u o; o.x = pk2(bm[0], bm[1]); o.y = pk2(bm[2], bm[3]); *(v2u*)(XB + r * 1024 + c) = o;
                vv[rr][4 * j + 0] = bm[0]; vv[rr][4 * j + 1] = bm[1]; vv[rr][4 * j + 2] = bm[2]; vv[rr][4 * j + 3] = bm[3]; }
        }
        float p0[32], p1[32];
#pragma unroll
        for (int e = 0; e < 32; ++e) { p0[e] = 0.f; p1[e] = 0.f; }
#pragma unroll
        for (int j = 0; j < 4; ++j)
#pragma unroll
            for (int e4 = 0; e4 < 4; ++e4) { const int k = 4 * (lane + 64 * j) + e4; const float x0 = vv[0][4 * j + e4], x1 = vv[1][4 * j + e4];
#pragma unroll
                for (int q = 0; q < 8; ++q) { const f32x4 w = *(const LAS f32x4*)(rwl + k * 32 + 4 * (q ^ sw));
#pragma unroll
                    for (int c = 0; c < 4; ++c) { p0[4 * q + c] = fmaf(x0, w[c], p0[4 * q + c]); p1[4 * q + c] = fmaf(x1, w[c], p1[4 * q + c]); } } }
#define RS_STEP(P, NKEEP, BITV, XORV) _Pragma("unroll") for (int k_ = 0; k_ < NKEEP; ++k_) { const float snd_ = (BITV) ? P[k_] : P[k_ + NKEEP]; const float rcv_ = __shfl_xor(snd_, XORV); P[k_] = ((BITV) ? P[k_ + NKEEP] : P[k_]) + rcv_; }
        { const bool c5 = (lane & 32) != 0, c4 = (lane & 16) != 0, c3 = (lane & 8) != 0, c2 = (lane & 4) != 0, c1 = (lane & 2) != 0;
          RS_STEP(p0, 16, c5, 32) RS_STEP(p0, 8, c4, 16) RS_STEP(p0, 4, c3, 8) RS_STEP(p0, 2, c2, 4) RS_STEP(p0, 1, c1, 2)
          RS_STEP(p1, 16, c5, 32) RS_STEP(p1, 8, c4, 16) RS_STEP(p1, 4, c3, 8) RS_STEP(p1, 2, c2, 4) RS_STEP(p1, 1, c1, 2)
          p0[0] += __shfl_xor(p0[0], 1); p1[0] += __shfl_xor(p1[0], 1); }
#undef RS_STEP
        if ((lane & 1) == 0) { lgs[lane >> 1] = p0[0]; lgs[32 + (lane >> 1)] = p1[0]; }
        LDS_WAIT();
#pragma unroll
        for (int rr = 0; rr < 2; ++rr) {
            float lg[32];
#pragma unroll
            for (int q = 0; q < 8; ++q) { const f32x4 t4 = *(const LAS f32x4*)(lgs + rr * 32 + 4 * q); const f32x4 b4 = *(const f32x4*)(rb + 4 * q); lg[4 * q] = t4[0] + b4[0]; lg[4 * q + 1] = t4[1] + b4[1]; lg[4 * q + 2] = t4[2] + b4[2]; lg[4 * q + 3] = t4[3] + b4[3]; }
            unsigned taken = 0u; float tv[4]; int ti[4];
#pragma unroll
            for (int kk = 0; kk < 4; ++kk) { float best = -3.0e38f; int bi = 0;
#pragma unroll
                for (int e = 0; e < 32; ++e) { const bool ok = (lg[e] > best) && !((taken >> e) & 1u); best = ok ? lg[e] : best; bi = ok ? e : bi; }
                taken |= 1u << bi; tv[kk] = best; ti[kk] = bi; }
            const float e1 = __expf(tv[1] - tv[0]), e2 = __expf(tv[2] - tv[0]), e3 = __expf(tv[3] - tv[0]); const float inv = 1.f / (1.f + e1 + e2 + e3);
            if (lane == 0) { const int lr = lr0 + rr;
                *(int4*)(topi + (size_t)lr * 4) = make_int4(ti[0], ti[1], ti[2], ti[3]); *(f32x4*)(topw + (size_t)lr * 4) = (f32x4){inv, e1 * inv, e2 * inv, e3 * inv};
                __hip_atomic_fetch_add(hist + ti[0], 1, __ATOMIC_RELAXED, __HIP_MEMORY_SCOPE_WORKGROUP); __hip_atomic_fetch_add(hist + ti[1], 1, __ATOMIC_RELAXED, __HIP_MEMORY_SCOPE_WORKGROUP);
                __hip_atomic_fetch_add(hist + ti[2], 1, __ATOMIC_RELAXED, __HIP_MEMORY_SCOPE_WORKGROUP); __hip_atomic_fetch_add(hist + ti[3], 1, __ATOMIC_RELAXED, __HIP_MEMORY_SCOPE_WORKGROUP); }
        }
        LDS_WAIT();
    }
    __syncthreads();
    if (tid < 32) ((int*)(a.ws + WS_BCNT))[blockIdx.x * 32 + tid] = hist[tid];
}

__device__ __forceinline__ void phase_place(const Args& a, LAS unsigned char* lds, int tid, int lane, int wave) {
    const int G = gridDim.x, B = blockIdx.x, RB = rows_per_block(), lr_base = B * RB;
    LAS int* tot = (LAS int*)lds; LAS int* pre = tot + 32; LAS int* pstart = tot + 64; LAS int* basee = tot + 128; LAS int* til = tot + 256; LAS int* posl = til + 4096;
    const int* bcnt = (const int*)(a.ws + WS_BCNT);
    int* tile_e = (int*)(a.ws + WS_TILEE); int* meta = (int*)(a.ws + WS_META);
    const int* topi = (const int*)(a.ws + WS_TOPI); const float* topw = (const float*)(a.ws + WS_TOPW);
    float* roww = (float*)(a.ws + WS_ROWW); int* rowd = (int*)(a.ws + WS_ROWD);
    int* rows = (int*)(a.ws + WS_ROWS);
    { const int e = tid & 31, chn = tid >> 5; int t = 0, p = 0;
      for (int bb0 = chn; bb0 < G; bb0 += 64) { int c[4];
#pragma unroll
          for (int q = 0; q < 4; ++q) { const int bb = bb0 + 16 * q; c[q] = bb < G ? ld_ctl(bcnt + bb * 32 + e) : 0; }
#pragma unroll
          for (int q = 0; q < 4; ++q) { const int bb = bb0 + 16 * q; if (bb < B) p += c[q]; t += c[q]; } }
      posl[tid] = t; posl[512 + tid] = p; }
    __syncthreads();
    if (tid < 32) { int t = 0, p = 0;
#pragma unroll
        for (int q = 0; q < 16; ++q) { t += posl[q * 32 + tid]; p += posl[512 + q * 32 + tid]; }
        tot[tid] = t; pre[tid] = p; }
    __syncthreads();
    if (tid == 0) { int ps = 0; for (int e = 0; e < 32; ++e) { pstart[e] = ps; ps += ((tot[e] + 255) >> 8) << 8; } pstart[32] = ps; }
    __syncthreads();
    if (tid < 32) basee[tid] = pstart[tid] + pre[tid];
    const int ntiles = pstart[32] >> 8;
    if (B == 0) { for (int t = tid; t < ntiles; t += NTHR) { int e = 0; while (e < 31 && pstart[e + 1] <= t * 256) ++e; tile_e[t] = e; } if (tid == 0) meta[0] = ntiles; }
    for (int e = B; e < 32; e += G) for (int i = pstart[e] + tot[e] + tid; i < pstart[e + 1]; i += NTHR) { rowd[i] = -1; rows[i] = 0; }
    int nrows = NLAT - lr_base; nrows = nrows > RB ? RB : nrows; if (nrows < 0) nrows = 0;
    const int nas = nrows * 4;
    for (int i = tid; i < nas; i += NTHR) til[i] = topi[(size_t)lr_base * 4 + i];
    __syncthreads();
    if (tid < 32) { int n = basee[tid]; for (int i = 0; i < nas; ++i) if (til[i] == tid) posl[i] = n++; }
    __syncthreads();
    for (int i = tid; i < nas; i += NTHR) { const int lr = lr_base + (i >> 2); const int pos = posl[i]; rows[pos] = grow_of(lr); roww[pos] = topw[(size_t)lr * 4 + (i & 3)]; rowd[pos] = lr * 4 + (i & 3); }
}

__device__ __forceinline__ void phase_ln2(const Args& a, int l, int lane, int wave) {
    const int gw = blockIdx.x * NWAVES + wave, NGW = gridDim.x * NWAVES;
    float* H = (float*)(a.ws + WS_H); const bf16* YB = (const bf16*)(a.ws + WS_YB); bf16* A1 = (bf16*)(a.ws + WS_Y);
    const float* modv = (const float*)(a.ws + WS_MODV);
    const float* lng = a.in[I_LN2G] + l * 1024; const float* lnb = a.in[I_LN2B] + l * 1024;
    for (int lr0 = 2 * gw; lr0 < NLAT; lr0 += 2 * NGW) {
        f32x4 hv[2][4]; v2u yv[2][4][4];
#pragma unroll
        for (int q = 0; q < 2; ++q) { const int lr = lr0 + q; const size_t r = (size_t)grow_of(lr);
#pragma unroll
            for (int j = 0; j < 4; ++j) { const int c = 4 * (lane + 64 * j); hv[q][j] = *(const f32x4*)(H + r * 1024 + c);
#pragma unroll
                for (int k = 0; k < 4; ++k) yv[q][j][k] = *(const v2u*)(YB + ((size_t)lr * 4 + k) * 1024 + c); } }
#pragma unroll
        for (int q = 0; q < 2; ++q) {
            const int lr = lr0 + q; const size_t r = (size_t)grow_of(lr); const int b = lr >> 12;
            const float* mv = modv + ((size_t)l * 9 + b) * 6144; const float* mv1 = modv + ((size_t)9 + b) * 6144;
            f32x4 x[4]; float s = 0.f;
#pragma unroll
            for (int j = 0; j < 4; ++j) { const int c = 4 * (lane + 64 * j); f32x4 f = {0.f, 0.f, 0.f, 0.f};
#pragma unroll
                for (int k = 0; k < 4; ++k) { const v2u y = yv[q][j][k];
                    f[0] += __uint_as_float(y.x << 16); f[1] += __uint_as_float(y.x & 0xffff0000u); f[2] += __uint_as_float(y.y << 16); f[3] += __uint_as_float(y.y & 0xffff0000u); }
                const f32x4 gt = *(const f32x4*)(mv + 5 * 1024 + c);
                x[j] = hv[q][j] * ALPHA + gt * f; s += (x[j][0] + x[j][1]) + (x[j][2] + x[j][3]); }
            const float mean = wave_sum(s) * (1.f / 1024.f); float s2 = 0.f;
#pragma unroll
            for (int j = 0; j < 4; ++j) { x[j] = x[j] - mean; s2 += (x[j][0] * x[j][0] + x[j][1] * x[j][1]) + (x[j][2] * x[j][2] + x[j][3] * x[j][3]); }
            const float rstd = rsqrtf(wave_sum(s2) * (1.f / 1024.f) + LN_EPS);
#pragma unroll
            for (int j = 0; j < 4; ++j) { const int c = 4 * (lane + 64 * j); const f32x4 g = *(const f32x4*)(lng + c), bb = *(const f32x4*)(lnb + c);
                const f32x4 o = x[j] * rstd * g + bb;
                if (l == 0) { *(f32x4*)(H + r * 1024 + c) = o; const f32x4 sh = *(const f32x4*)(mv1 + c), sc = *(const f32x4*)(mv1 + 1024 + c);
                    const f32x4 am = o * (sc + 1.0f) + sh; v2u w; w.x = pk2(am[0], am[1]); w.y = pk2(am[2], am[3]); *(v2u*)(A1 + r * 1024 + c) = w; }
                else *(f32x4*)(a.out + (size_t)lr * 1024 + c) = o; }
        }
    }
}

__device__ __forceinline__ void phase_conv(const Args& a, LAS unsigned char* lds, int tid, int lane, int wave) {
    const bf16* U = (const bf16*)(a.ws + WS_X); bf16* V = (bf16*)(a.ws + WS_Y);
    LAS float* part = (LAS float*)(lds + 126976);
    LAS float* st = part + 512;
    const int c0 = 2 * tid;
    const float db0 = a.in[I_DWB][c0], db1 = a.in[I_DWB][c0 + 1], g0 = a.in[I_CLNG][c0], g1 = a.in[I_CLNG][c0 + 1], be0 = a.in[I_CLNB][c0], be1 = a.in[I_CLNB][c0 + 1];
    for (int tile = blockIdx.x; tile < NLAT / 32; tile += gridDim.x) {
        const int b = tile >> 7, t0 = (tile & 127) * 32;
        const size_t rb0 = (size_t)b * TPB + CTXL;
        __syncthreads();
        for (int i = tid; i < 62 * 128; i += NTHR) { const int row = i >> 7, chk = i & 127, t = t0 - 15 + row;
            v4u val = {0u, 0u, 0u, 0u}; if (t >= 0 && t < SEQ) val = *(const v4u*)(U + (rb0 + t) * 1024 + chk * 8);
            *(LAS v4u*)(lds + row * 2048 + chk * 16) = val; }
        __syncthreads();
        float w0[31], w1[31];
#pragma unroll
        for (int j = 0; j < 31; ++j) { const float2 wv = *(const float2*)(a.in[I_DWW] + j * 1024 + c0); w0[j] = wv.x; w1[j] = wv.y; }
#pragma unroll 1
        for (int hh = 0; hh < 2; ++hh) {
            const LAS unsigned char* hp = lds + hh * 16 * 2048;
            float acc0[16], acc1[16];
#pragma unroll
            for (int t = 0; t < 16; ++t) { acc0[t] = db0; acc1[t] = db1; }
#pragma unroll
            for (int s = 0; s < 46; ++s) { const unsigned pr = *(const LAS unsigned*)(hp + s * 2048 + tid * 4); const float x0 = __uint_as_float(pr << 16), x1 = __uint_as_float(pr & 0xffff0000u);
#pragma unroll
                for (int t = (s > 30 ? s - 30 : 0); t <= (s < 15 ? s : 15); ++t) { acc0[t] = fmaf(x0, w0[s - t], acc0[t]); acc1[t] = fmaf(x1, w1[s - t], acc1[t]); } }
            float rs[32];
#pragma unroll
            for (int t = 0; t < 16; ++t) { rs[2 * t] = acc0[t] + acc1[t]; rs[2 * t + 1] = acc0[t] * acc0[t] + acc1[t] * acc1[t]; }
#define RS_STEP(NKEEP, XORV) { const bool bit_ = (lane & XORV) != 0; _Pragma("unroll") for (int k_ = 0; k_ < NKEEP; ++k_) { const float snd_ = bit_ ? rs[k_] : rs[k_ + NKEEP]; const float rcv_ = __shfl_xor(snd_, XORV); rs[k_] = (bit_ ? rs[k_ + NKEEP] : rs[k_]) + rcv_; } }
            RS_STEP(16, 32) RS_STEP(8, 16) RS_STEP(4, 8) RS_STEP(2, 4) RS_STEP(1, 2)
#undef RS_STEP
            rs[0] += __shfl_xor(rs[0], 1);
            __syncthreads();
            if ((lane & 1) == 0) part[wave * 32 + (lane >> 1)] = rs[0];
            __syncthreads();
            if (tid < 16) { float s1 = 0.f, s2 = 0.f;
#pragma unroll
                for (int w = 0; w < 8; ++w) { s1 += part[w * 32 + 2 * tid]; s2 += part[w * 32 + 2 * tid + 1]; }
                const float mean = s1 * (1.f / 1024.f); const float var = fmaxf(s2 * (1.f / 1024.f) - mean * mean, 0.f); st[2 * tid] = mean; st[2 * tid + 1] = rsqrtf(var + LN_EPS); }
            __syncthreads();
#pragma unroll
            for (int t = 0; t < 16; ++t) { const float mean = st[2 * t], rstd = st[2 * t + 1];
                const float y0 = (acc0[t] - mean) * rstd * g0 + be0, y1 = (acc1[t] - mean) * rstd * g1 + be1;
                *(unsigned*)(V + (rb0 + t0 + hh * 16 + t) * 1024 + c0) = pk2(y0 * sigm(y0), y1 * sigm(y1)); }
        }
    }
}

namespace hg {
using bf16x8 = __attribute__((ext_vector_type(8))) short;
using s16x4  = __attribute__((ext_vector_type(4))) short;
using f32x16 = __attribute__((ext_vector_type(16))) float;
using u32x4  = __attribute__((ext_vector_type(4))) unsigned;
constexpr int RS = 272;
constexpr int VS = 80;
constexpr int T_Q = 0, T_KO = 32 * RS, T_KE = 64 * RS, T_D = 96 * RS, IMG_BYTES = T_D + 512, T_V = IMG_BYTES, TILE_BYTES = T_V + 32 * VS;
constexpr int OFF_TILES = 1024, NTB = 3, OFF_OPART = OFF_TILES + NTB * TILE_BYTES, OPART_BYTES = 4 * 4096;
static_assert(OFF_OPART + 2 * OPART_BYTES <= 131072 && IMG_BYTES % 16 == 0 && IMG_BYTES / 16 == 1664, "hgrn lds");
constexpr int P_RAW = 1024, R_Q = 0, R_F = 32 * RS, RAW_BYTES = 64 * RS, P_IMG = P_RAW + RAW_BYTES;
constexpr int NCHUNK = TPB / 32, NCHAIN = NB * 4 * 2, NITEM = NCHAIN * NCHUNK;
__device__ __forceinline__ int crow(int r, int hi) { return (r & 3) + 8 * (r >> 2) + 4 * hi; }
__device__ __forceinline__ s16x4 tr_read(unsigned addr) { s16x4 r; asm volatile("ds_read_b64_tr_b16 %0, %1" : "=&v"(r) : "v"(addr) : "memory"); return r; }
__device__ __forceinline__ bf16x8 cat8(s16x4 l, s16x4 h) { return (bf16x8){l[0], l[1], l[2], l[3], h[0], h[1], h[2], h[3]}; }
__device__ __forceinline__ bf16x8 pack8(const f32x16& x, int base) {
    u32x4 w; w[0] = pk2(x[base + 0], x[base + 1]); w[1] = pk2(x[base + 2], x[base + 3]); w[2] = pk2(x[base + 4], x[base + 5]); w[3] = pk2(x[base + 6], x[base + 7]);
    return *reinterpret_cast<bf16x8*>(&w);
}
}


#define HG_TOKP(dir, n) ((dir) ? ((n) < CTXL ? (CTXL - 1 - (n)) : (TPB + CTXL - 1 - (n))) : (n))
#define HG_DPP(x, ctrl, rmask) __int_as_float(__builtin_amdgcn_update_dpp(0, __float_as_int(x), ctrl, rmask, 0xf, false))
__device__ __forceinline__ void hgrn_prep_items(const Args& a, LAS unsigned char* lds, int tid) {
    using namespace hg;
    const bf16* Z = (const bf16*)(a.ws + WS_Z);
    unsigned char* HT = a.ws + WS_HT;
    const int wave = __builtin_amdgcn_readfirstlane(tid >> 6), lane = tid & 63, t = lane & 31, half = lane >> 5;
    const int c0 = 16 * wave + 8 * half;
    const int lr = tid >> 4, lch = tid & 15;
    LAS float* lbt = (LAS float*)lds;
    constexpr int P_RAW2 = 2048, P_IMG2 = P_RAW2 + 2 * RAW_BYTES;
    static_assert(P_IMG2 + 2 * IMG_BYTES <= 131072, "prep lds");
    __syncthreads();
    { const float l0 = a.in[I_LBL][tid], l1 = a.in[I_LBL][512 + tid], l2 = a.in[I_LBL][1024 + tid]; const float m = fmaxf(l0, fmaxf(l1, l2));
      const float e0 = __expf(l0 - m), e1 = __expf(l1 - m), e2 = __expf(l2 - m); lbt[tid] = e0 / (e0 + e1 + e2); }
    bf16x8 gq, gf;
#define HP_LOAD(it) do { const int ch_ = (it) % NCHUNK, cn_ = (it) / NCHUNK, dir_ = cn_ & 1, hd_ = (cn_ >> 1) & 3, b_ = cn_ >> 3; \
        const bf16* zr_ = Z + ((size_t)b_ * TPB + HG_TOKP(dir_, 32 * ch_ + lr)) * ZC; gq = *(const bf16x8*)(zr_ + ZHQ + hd_ * 128 + lch * 8); gf = *(const bf16x8*)(zr_ + (dir_ ? ZHB : ZHF) + hd_ * 128 + lch * 8); } while (0)
#define HP_STASH(bufi) do { LAS unsigned char* rb_ = lds + P_RAW2 + (bufi) * RAW_BYTES; *(LAS bf16x8*)(rb_ + R_Q + lr * RS + lch * 16) = gq; *(LAS bf16x8*)(rb_ + R_F + lr * RS + lch * 16) = gf; } while (0)
#define HP_COPYOUT(item, bufi) do { v4u* dst_ = (v4u*)(HT + (size_t)(item) * IMG_BYTES); const LAS v4u* src_ = (const LAS v4u*)(lds + P_IMG2 + (bufi) * IMG_BYTES); \
        dst_[tid] = src_[tid]; dst_[tid + 512] = src_[tid + 512]; dst_[tid + 1024] = src_[tid + 1024]; if (tid < 128) dst_[tid + 1536] = src_[tid + 1536]; } while (0)
    const int G = gridDim.x;
    int it = blockIdx.x, par = 0;
    if (it < NITEM) { HP_LOAD(it); HP_STASH(0); }
    if (it + G < NITEM) HP_LOAD(it + G);
    __syncthreads();
    for (; it < NITEM; it += G, par ^= 1) {
        if (it + G < NITEM) HP_STASH(par ^ 1);
        if (it != (int)blockIdx.x) HP_COPYOUT(it - G, par ^ 1);
        if (it + 2 * G < NITEM) HP_LOAD(it + 2 * G);
        const int hd = ((it / NCHUNK) >> 1) & 3;
        {
            const LAS unsigned char* rb_ = lds + P_RAW2 + par * RAW_BYTES;
            const bf16x8 RQ = *(const LAS bf16x8*)(rb_ + R_Q + t * RS + c0 * 2), RF = *(const LAS bf16x8*)(rb_ + R_F + t * RS + c0 * 2);
            const f32x4 lbA = *(const LAS f32x4*)(lbt + hd * 128 + c0), lbB = *(const LAS f32x4*)(lbt + hd * 128 + c0 + 4);
            LAS unsigned char* tb_ = lds + P_IMG2 + par * IMG_BYTES;
            float bb_[8], kk_[8];
#pragma unroll
            for (int i_ = 0; i_ < 8; ++i_) { const float lb_ = i_ < 4 ? lbA[i_] : lbB[i_ - 4]; const float f_ = lb_ + (1.f - lb_) * __builtin_amdgcn_rcpf(1.f + __expf(-bf2f((unsigned short)RF[i_]))); kk_[i_] = 1.f - f_; bb_[i_] = __logf(f_); }
#pragma unroll
            for (int i_ = 0; i_ < 8; ++i_) { float x_ = bb_[i_]; x_ += HG_DPP(x_, 0x111, 0xf); x_ += HG_DPP(x_, 0x112, 0xf); x_ += HG_DPP(x_, 0x114, 0xf); x_ += HG_DPP(x_, 0x118, 0xf);
                x_ += HG_DPP(x_, 0x142, 0xa); bb_[i_] = x_; }
            float qi_[8], ko_[8], ke_[8], dd_[8];
#pragma unroll
            for (int i_ = 0; i_ < 8; ++i_) { const int bi_ = __float_as_int(bb_[i_]); const float be_ = __int_as_float(half ? __builtin_amdgcn_readlane(bi_, 63) : __builtin_amdgcn_readlane(bi_, 31));
                const float e_ = __expf(bb_[i_]); const float ei_ = __builtin_amdgcn_rcpf(e_); dd_[i_] = __expf(be_);
                qi_[i_] = bf2f((unsigned short)RQ[i_]) * e_; ko_[i_] = kk_[i_] * ei_; ke_[i_] = kk_[i_] * (dd_[i_] * ei_); }
            *(LAS v4u*)(tb_ + T_Q + t * RS + c0 * 2) = (v4u){pk2(qi_[0], qi_[1]), pk2(qi_[2], qi_[3]), pk2(qi_[4], qi_[5]), pk2(qi_[6], qi_[7])};
            *(LAS v4u*)(tb_ + T_KO + t * RS + c0 * 2) = (v4u){pk2(ko_[0], ko_[1]), pk2(ko_[2], ko_[3]), pk2(ko_[4], ko_[5]), pk2(ko_[6], ko_[7])};
            *(LAS v4u*)(tb_ + T_KE + t * RS + c0 * 2) = (v4u){pk2(ke_[0], ke_[1]), pk2(ke_[2], ke_[3]), pk2(ke_[4], ke_[5]), pk2(ke_[6], ke_[7])};
            if (t == 31) { *(LAS f32x4*)(tb_ + T_D + c0 * 4) = (f32x4){dd_[0], dd_[1], dd_[2], dd_[3]}; *(LAS f32x4*)(tb_ + T_D + c0 * 4 + 16) = (f32x4){dd_[4], dd_[5], dd_[6], dd_[7]}; }
            if (tid < 32) *(LAS v4u*)(tb_ + T_Q + tid * RS + 256) = (v4u){0u, 0u, 0u, 0u};
            else if (tid < 64) *(LAS v4u*)(tb_ + T_KO + (tid - 32) * RS + 256) = (v4u){0u, 0u, 0u, 0u};
            else if (tid < 96) *(LAS v4u*)(tb_ + T_KE + (tid - 64) * RS + 256) = (v4u){0u, 0u, 0u, 0u};
        }
        __syncthreads();
    }
    if (it - G >= (int)blockIdx.x && it - G < NITEM) HP_COPYOUT(it - G, par ^ 1);
    __syncthreads();
#undef HP_COPYOUT
#undef HP_LOAD
#undef HP_STASH
}

__device__ __forceinline__ void hgrn_unit_mfma(const Args& a, int unit, LAS unsigned char* lds, int tid) {
    using namespace hg;
    const int b = unit >> 5, head = (unit >> 3) & 3, dir = (unit >> 2) & 1, sl = unit & 3;
    const bf16* Z = (const bf16*)(a.ws + WS_Z);
    const unsigned char* HT = a.ws + WS_HT + (size_t)((b * 4 + head) * 2 + dir) * NCHUNK * IMG_BYTES;
    float* Od = (float*)(a.ws + (dir ? WS_OB : WS_OF));
    const int wave = __builtin_amdgcn_readfirstlane(tid >> 6), lane = tid & 63;
    const size_t zb = (size_t)b * TPB;
    constexpr int NCH = NCHUNK;
    const int vr = (tid >> 2) & 31, vp = tid & 3, lvcol = ZHI + head * 128 + sl * 32 + vp * 8, i3 = 1536 + (tid & 127);
    v4u gA0, gA1, gA2, gA3, gB0, gB1, gB2, gB3; bf16x8 gAv, gBv;
#define HG_LOAD(g0, g1, g2, g3, gv, ch) do { const int c_ = (ch) < NCH ? (ch) : NCH - 1; const v4u* src_ = (const v4u*)(HT + (size_t)c_ * IMG_BYTES); \
        g0 = src_[tid]; g1 = src_[tid + 512]; g2 = src_[tid + 1024]; g3 = src_[i3]; gv = *(const bf16x8*)(Z + (zb + HG_TOKP(dir, 32 * c_ + vr)) * ZC + lvcol); } while (0)
#define HG_STASH(g0, g1, g2, g3, gv, bufi) do { LAS unsigned char* tb_ = lds + OFF_TILES + (bufi) * TILE_BYTES; LAS v4u* d_ = (LAS v4u*)tb_; \
        d_[tid] = g0; d_[tid + 512] = g1; d_[tid + 1024] = g2; if (tid < 128) { d_[tid + 1536] = g3; *(LAS bf16x8*)(tb_ + T_V + vr * VS + vp * 16) = gv; } } while (0)
    const int r32 = lane & 31, hi = lane >> 5, g1 = (lane >> 4) & 1, q4 = (lane & 15) >> 2, p4 = lane & 3, cb = 32 * wave;
    const unsigned lbase = (unsigned)(uintptr_t)lds;
    f32x16 S = {};
    HG_LOAD(gA0, gA1, gA2, gA3, gAv, 0); HG_STASH(gA0, gA1, gA2, gA3, gAv, 0); HG_LOAD(gA0, gA1, gA2, gA3, gAv, 1); HG_STASH(gA0, gA1, gA2, gA3, gAv, 1);
    HG_LOAD(gA0, gA1, gA2, gA3, gAv, 2);
    __syncthreads();
#define HG_RD64(dst, addr, OFFS) asm volatile("ds_read_b64 %0, %1 offset:" #OFFS : "=&v"(dst) : "v"(addr) : "memory")
#define HG_MFMA_STAGE(n, bufi) do { \
            const unsigned tb = lbase + OFF_TILES + (bufi) * TILE_BYTES; const LAS unsigned char* tl_ = lds + OFF_TILES + (bufi) * TILE_BYTES; \
            bf16x8 ko[2], qi[2]; s16x4 pvl[2], pvh[2], pql[2], pqh[2], kl[2], kh[2], nvl[2], nvh[2]; f32x4 dsc[4]; \
            _Pragma("unroll") for (int kk = 0; kk < 2; ++kk) { ko[kk] = *(const LAS bf16x8*)(tl_ + T_KO + r32 * RS + (cb + 16 * kk + 8 * hi) * 2); qi[kk] = *(const LAS bf16x8*)(tl_ + T_Q + r32 * RS + (cb + 16 * kk + 8 * hi) * 2); } \
            _Pragma("unroll") for (int sp = 0; sp < 2; ++sp) { \
                const unsigned va = tb + T_V + (16 * sp + 4 * hi + q4) * VS + (16 * g1 + 4 * p4) * 2; pvl[sp] = tr_read(va); pvh[sp] = tr_read(va + 8 * VS);              \
                const unsigned qa = tb + T_Q + r32 * RS + (cb + 16 * sp + 4 * hi) * 2; HG_RD64(pql[sp], qa, 0); HG_RD64(pqh[sp], qa, 16);                                  \
                const unsigned ka = tb + T_KE + (16 * sp + 8 * hi + q4) * RS + (cb + 16 * g1 + 4 * p4) * 2; kl[sp] = tr_read(ka); kh[sp] = tr_read(ka + 4 * RS);        \
                const unsigned vb = tb + T_V + (16 * sp + 8 * hi + q4) * VS + (16 * g1 + 4 * p4) * 2; nvl[sp] = tr_read(vb); nvh[sp] = tr_read(vb + 4 * VS); }            \
            _Pragma("unroll") for (int g = 0; g < 4; ++g) dsc[g] = *(const LAS f32x4*)(tl_ + T_D + (cb + 8 * g + 4 * hi) * 4); \
            asm volatile("s_waitcnt lgkmcnt(0)" ::: "memory"); __builtin_amdgcn_sched_barrier(0); \
            f32x16 X = {}; \
            X = __builtin_amdgcn_mfma_f32_32x32x16_bf16(ko[0], qi[0], X, 0, 0, 0); X = __builtin_amdgcn_mfma_f32_32x32x16_bf16(ko[1], qi[1], X, 0, 0, 0); \
            f32x16 O = {}; \
            O = __builtin_amdgcn_mfma_f32_32x32x16_bf16(cat8(pql[0], pqh[0]), pack8(S, 0), O, 0, 0, 0); O = __builtin_amdgcn_mfma_f32_32x32x16_bf16(cat8(pql[1], pqh[1]), pack8(S, 8), O, 0, 0, 0); \
            _Pragma("unroll") for (int i = 0; i < 16; ++i) S[i] *= dsc[i >> 2][i & 3]; \
            S = __builtin_amdgcn_mfma_f32_32x32x16_bf16(cat8(kl[0], kh[0]), cat8(nvl[0], nvh[0]), S, 0, 0, 0); S = __builtin_amdgcn_mfma_f32_32x32x16_bf16(cat8(kl[1], kh[1]), cat8(nvl[1], nvh[1]), S, 0, 0, 0); \
            _Pragma("unroll") for (int i = 0; i < 16; ++i) X[i] = (crow(i, hi) <= r32) ? X[i] : 0.f; \
            O = __builtin_amdgcn_mfma_f32_32x32x16_bf16(pack8(X, 0), cat8(pvl[0], pvh[0]), O, 0, 0, 0); O = __builtin_amdgcn_mfma_f32_32x32x16_bf16(pack8(X, 8), cat8(pvl[1], pvh[1]), O, 0, 0, 0); \
            LAS float* op = (LAS float*)(lds + OFF_OPART + ((n) & 1) * OPART_BYTES + wave * 4096); \
            _Pragma("unroll") for (int i = 0; i < 16; ++i) op[crow(i, hi) * 32 + r32] = O[i]; } while (0)
#define HG_OUT_STAGE(n) do { \
            const int l2 = tid - 256, tt = l2 >> 3, vq = l2 & 7; \
            const LAS float* op = (const LAS float*)(lds + OFF_OPART + (((n) - 1) & 1) * OPART_BYTES) + tt * 32 + vq * 4; \
            const f32x4 s = (*(const LAS f32x4*)op + *(const LAS f32x4*)(op + 1024)) + (*(const LAS f32x4*)(op + 2048) + *(const LAS f32x4*)(op + 3072)); \
            const int p = HG_TOKP(dir, 32 * ((n) - 1) + tt); \
            if (p >= CTXL) *(f32x4*)(Od + (zb + p) * 512 + head * 128 + sl * 32 + vq * 4) = s; } while (0)
#define HG_ITER(n, L0, L1, L2, L3, LV, S0, S1, S2, S3, SV) do { \
        HG_LOAD(L0, L1, L2, L3, LV, (n) + 3); \
        if (wave < 4) { HG_MFMA_STAGE(n, bcur); } else if ((n) > 0) { HG_OUT_STAGE(n); } \
        { const int bst_ = bcur == 0 ? 2 : bcur - 1; HG_STASH(S0, S1, S2, S3, SV, bst_); } \
        bcur = bcur == 2 ? 0 : bcur + 1; \
        __syncthreads(); } while (0)
    int bcur = 0;
    for (int n = 0; n < NCH; n += 2) {
        HG_ITER(n, gB0, gB1, gB2, gB3, gBv, gA0, gA1, gA2, gA3, gAv);
        HG_ITER(n + 1, gA0, gA1, gA2, gA3, gAv, gB0, gB1, gB2, gB3, gBv);
    }
    if (wave >= 4) { HG_OUT_STAGE(NCH); }
    __syncthreads();
#undef HG_MFMA_STAGE
#undef HG_OUT_STAGE
#undef HG_ITER
#undef HG_LOAD
#undef HG_STASH
#undef HG_RD64
}

__device__ __forceinline__ bool in_range(int lo, int hi, int k) { asm volatile("" : "+s"(lo), "+s"(hi)); return lo <= k && k < hi; }
constexpr int NPHASES = 21;
__global__ void __launch_bounds__(NTHR, 2) fwd_kernel(Args args) {
    extern __shared__ __attribute__((aligned(16))) unsigned char lds_raw[];
    LAS unsigned char* lds = (LAS unsigned char*)lds_raw;
    const int G = gridDim.x;
#define FRESH() int tid = threadIdx.x; asm volatile("" : "+v"(tid)); const int lane = tid & 63, wave = __builtin_amdgcn_readfirstlane(tid >> 6); (void)lane; (void)wave
    unsigned char* ws = args.ws;
    if (threadIdx.x < 16) ((LAS unsigned*)(lds + LDS_BAR_OFF))[threadIdx.x] = 0u;
    __syncthreads();
    XcdBarrier bar = xcd_barrier_post((unsigned*)(ws + WS_CTL), (volatile LAS unsigned*)(lds + LDS_BAR_OFF));
    const int lo = args.ph_lo, hi = args.ph_hi;
#define IN(k) in_range(lo, hi, (k))
#define NREP(k) (((PROBE_MASK >> (k)) & 1u) ? 2 : 1)
#define REPEAT(k) for (int rep_ = 0; rep_ < NREP(k); ++rep_) if (rep_ == 0 || (xcd_barrier(bar), true))
#define SEAM(k) do { if (IN(k) && IN((k) + 1)) xcd_barrier(bar); } while (0)
    bf16* const BX = (bf16*)(ws + WS_X); bf16* const BY = (bf16*)(ws + WS_Y);
    const float* const MODV = (const float*)(ws + WS_MODV);

    if (IN(0)) REPEAT(0) { FRESH(); phase_prologue(args, lds, tid, lane, wave); } SEAM(0);
    if (IN(1)) REPEAT(1) { FRESH(); phase_mod0(args, lane, wave); } SEAM(1);
    if (IN(2)) REPEAT(2) {
        pg8::Gemm g{BX, (const bf16*)(ws + WS_WIN), NTOK, ZC, 1024}; pg8::AllOrder S; S.init(NTOK / 256, ZC / 256, G, (int)blockIdx.x);
        pg8::EpiBf16<0> E{(bf16*)(ws + WS_Z), ZC, nullptr, 0, 0, 1.f};
        pg8::gemm_phase<pg8::EpiBf16<0>, pg8::AllOrder, PG8_ALIGN, PG8_SP2>(lds, g, S, E);
    } SEAM(2);
    if (IN(3)) REPEAT(3) { FRESH(); phase_norm0(args, lane, wave); hgrn_prep_items(args, lds, tid); } SEAM(3);
    if (IN(4)) REPEAT(4) {
        { pg8::Gemm g{(const bf16*)(ws + WS_CQN), (const bf16*)(ws + WS_WUQ), NTOK, 768, 384}; pg8::LatOrder S; S.init(128, 3, G, (int)blockIdx.x);
          pg8::EpiBf16<0> E{(bf16*)(ws + WS_Q), 768, nullptr, 0, 0, 1.f};
          pg8::gemm_phase<pg8::EpiBf16<0>, pg8::LatOrder, PG8_ALIGN, PG8_SP2>(lds, g, S, E); }
        __syncthreads();
        { pg8::Gemm g{(const bf16*)(ws + WS_CKVN), (const bf16*)(ws + WS_WUKV), NTOK, 1024, 256}; pg8::AllOrder S; S.init(NTOK / 256, 4, G, (int)blockIdx.x);
          pg8::EpiBf16<0> E{(bf16*)(ws + WS_KV), 1024, nullptr, 0, 0, 1.f};
          pg8::gemm_phase<pg8::EpiBf16<0>, pg8::AllOrder, PG8_ALIGN, PG8_SP2>(lds, g, S, E); }
    } SEAM(4);
    if (IN(5)) {
        REPEAT(21) { FRESH();
        for (int u = blockIdx.x; u < 256; u += G) { __syncthreads(); hgrn_unit_mfma(args, (G == 256) ? ((u & 7) * 32 + (u >> 3)) : u, lds, tid); } }
        const bf16* Q = (const bf16*)(ws + WS_Q); const bf16* KV = (const bf16*)(ws + WS_KV); const bf16* KRR = (const bf16*)(ws + WS_KRR);
        const float* rope = (const float*)(ws + WS_ROPE);
        REPEAT(22) for (int u = blockIdx.x; u < 1024; u += G) {
            const int b = u >> 7, h = (u >> 4) & 7, qb = u & 15;
            const size_t kb = (size_t)b * TPB, q0 = kb + CTXL + (size_t)qb * 256;
            __syncthreads();
            att::attn_unit(Q + q0 * 768 + h * 96, KV + kb * 1024 + h * 64, KRR + kb * 32, BY + q0 * 1024 + h * 64, rope + (size_t)qb * 256 * 32, TPB, (char*)lds_raw);
        }
    } SEAM(5);
    if (IN(6)) REPEAT(6) { FRESH(); phase_readout(args, lane, wave); } SEAM(6);
    if (IN(7)) REPEAT(7) {
        pg8::Gemm g{BY, (const bf16*)(ws + WS_WOUT), NTOK, 1024, 1024}; pg8::LatOrder S; S.init(128, 4, G, (int)blockIdx.x);
        pg8::EpiRes E{args.in[I_X], (float*)(ws + WS_H), MODV, nullptr};
        pg8::gemm_phase<pg8::EpiRes, pg8::LatOrder, PG8_ALIGN, PG8_SP2>(lds, g, S, E);
    } SEAM(7);
    for (int l = 0; l < 2; ++l) {
        if (l == 1) {
            if (IN(13)) REPEAT(13) {
                pg8::Gemm g{BY, (const bf16*)(ws + WS_WPW1), NTOK, 2048, 1024}; pg8::LatOrder S; S.init(128, 8, G, (int)blockIdx.x);
                pg8::EpiGate<0> E{BX, (const float*)(ws + WS_PW1B), 8};
                pg8::gemm_phase<pg8::EpiGate<0>, pg8::LatOrder, PG8_ALIGN, PG8_SP2>(lds, g, S, E);
            } SEAM(13);
            if (IN(14)) REPEAT(14) { FRESH(); phase_conv(args, lds, tid, lane, wave); } SEAM(14);
            if (IN(15)) REPEAT(15) {
                pg8::Gemm g{BY, (const bf16*)(ws + WS_WPW2), NTOK, 1024, 1024}; pg8::LatOrder S; S.init(128, 4, G, (int)blockIdx.x);
                pg8::EpiRes E{nullptr, (float*)(ws + WS_H), MODV + 9 * 6144, args.in[I_PW2B]};
                pg8::gemm_phase<pg8::EpiRes, pg8::LatOrder, PG8_ALIGN, PG8_SP2>(lds, g, S, E);
            } SEAM(15);
        }
        const int pb = l ? 16 : 8;
        if (IN(pb)) REPEAT(pb) { FRESH(); phase_ln1(args, l, lds, tid, lane, wave); } SEAM(pb);
        if (IN(pb + 1)) REPEAT(pb + 1) { FRESH(); phase_place(args, lds, tid, lane, wave); } SEAM(pb + 1);
        if (IN(pb + 2) || IN(pb + 3)) {
            LAS int* tl = (LAS int*)(lds + LDS_TILE_E);
            FRESH();
            __syncthreads();
            const int ntiles = ld_ctl((const int*)(ws + WS_META));
            for (int t = tid; t < ntiles && t < MAXTILES; t += NTHR) tl[t] = ld_ctl((const int*)(ws + WS_TILEE) + t);
            __syncthreads();
            if (IN(pb + 2)) REPEAT(pb + 2) {
                pg8::Gemm g{BX, (const bf16*)(ws + WS_WGU) + (size_t)l * 32 * 2048 * 1024, 0, 0, 1024};
                pg8::MoeOrder S; S.init(ntiles, 8, G, (int)blockIdx.x); S.tile_e = tl; S.nper = 8;
                pg8::EpiGate<1> E{(bf16*)(ws + WS_ACT), (const float*)(ws + WS_BGU) + (size_t)l * 32 * 2048, 8};
                pg8::gemm_phase<pg8::EpiGate<1>, pg8::MoeOrder, PG8_ALIGN, true, true>(lds, g, S, E, (const int*)(ws + WS_ROWS));
            } SEAM(pb + 2);
            if (IN(pb + 3)) REPEAT(pb + 3) {
                pg8::Gemm g{(const bf16*)(ws + WS_ACT), (const bf16*)(ws + WS_WDN) + (size_t)l * 32 * 1024 * 1024, 0, 0, 1024};
                pg8::MoeOrder S; S.init(ntiles, 4, G, (int)blockIdx.x); S.tile_e = tl; S.nper = 4;
                pg8::EpiDown E{(bf16*)(ws + WS_YB), args.in[I_BDN] + (size_t)l * 32 * 1024, (const float*)(ws + WS_ROWW), (const int*)(ws + WS_ROWD)};
                pg8::gemm_phase<pg8::EpiDown, pg8::MoeOrder, PG8_ALIGN, PG8_SP2>(lds, g, S, E);
            } SEAM(pb + 3);
        }
        if (IN(pb + 4)) REPEAT(pb + 4) { FRESH(); phase_ln2(args, l, lane, wave); }
        if (l == 0) SEAM(12);
    }
#undef IN
#undef SEAM
}

extern "C" void kernel_launch(void* const* d_in, const int* in_sizes, int n_in, void* d_out, int out_size, void* d_ws, size_t ws_size, hipStream_t stream) {
    static int grid = 0;
    if (grid == 0) {
        if (n_in != 33 || in_sizes[0] != NB * SEQ * D || out_size != NB * SEQ * D || ws_size < WS_END) {
            fprintf(stderr, "kernel_launch: unexpected shapes: n_in %d in0 %d out %d ws %zu (need %zu)\n", n_in, n_in > 0 ? in_sizes[0] : -1, out_size, ws_size, (size_t)WS_END); grid = -1; return; }
        int dev = 0, cus = 0;
        if (hipGetDevice(&dev) != hipSuccess || hipDeviceGetAttribute(&cus, hipDeviceAttributeMultiprocessorCount, dev) != hipSuccess) { grid = -1; return; }
        if (hipFuncSetAttribute((const void*)fwd_kernel, hipFuncAttributeMaxDynamicSharedMemorySize, LDS_BYTES) != hipSuccess) { fprintf(stderr, "kernel_launch: hipFuncSetAttribute failed\n"); grid = -1; return; }
        int per_cu = 0;
        if (hipOccupancyMaxActiveBlocksPerMultiprocessor(&per_cu, (const void*)fwd_kernel, NTHR, LDS_BYTES) != hipSuccess || per_cu < 1) fprintf(stderr, "kernel_launch: occupancy query reports %d\n", per_cu);
        (void)hipGetLastError();
        grid = cus;
    }
    if (grid < 0) return;
    if (hipMemsetAsync((char*)d_ws + WS_CTL, 0, CTL_ZERO_BYTES, stream) != hipSuccess) return;
    Args a{};
    for (int i = 0; i < 33; ++i) a.in[i] = (const float*)d_in[i];
    a.out = (float*)d_out; a.ws = (unsigned char*)d_ws;
#if MK_ONE_LAUNCH
    a.ph_lo = 0; a.ph_hi = NPHASES;
    hipLaunchKernelGGL(fwd_kernel, dim3(grid), dim3(NTHR), LDS_BYTES, stream, a);
#else
    for (int ph = 0; ph < NPHASES; ++ph) { a.ph_lo = ph; a.ph_hi = ph + 1; hipLaunchKernelGGL(fwd_kernel, dim3(grid), dim3(NTHR), LDS_BYTES, stream, a); }
#endif
    const hipError_t le = hipPeekAtLastError();
    if (le != hipSuccess) fprintf(stderr, "kernel_launch: launch failed: %s\n", hipGetErrorName(le));
}
```

```cpp
#include <hip/hip_runtime.h>
#include <cstdio>
#include <cstdint>

#ifndef PROBE_MASK
#define PROBE_MASK 0u
#endif
#ifndef MK_ONE_LAUNCH
#define MK_ONE_LAUNCH 1
#endif

namespace pg8 {
#define PG8_LAS __attribute__((address_space(3)))
typedef unsigned short bf16_t;
typedef short bf16x8 __attribute__((ext_vector_type(8)));
typedef float f32x4 __attribute__((ext_vector_type(4)));
typedef unsigned u32x4 __attribute__((ext_vector_type(4)));
constexpr int BM = 256, BK = 64, HALF = 128, HTB = HALF * BK * 2  , STAGE_BYTES = 8 * HTB, NXCD = 8, WGM = 8;

__host__ __device__ __forceinline__ int lds_byte(int r, int c) { const int st = (r >> 4) * 2 + (c >> 5), rr = r & 15, cc = c & 31, ob = rr * 64 + cc * 2; return st * 1024 + (ob ^ (((ob >> 9) & 1) << 5)); }
__host__ __device__ __forceinline__ void stage_rc(int b, int& R, int& C) { const int st = b / 1024, sb = b % 1024, swz = sb ^ (((sb >> 9) & 1) << 5); R = (st >> 1) * 16 + swz / 64; C = (st & 1) * 32 + (swz % 64) / 2; }
__host__ __device__ __forceinline__ int perm32(int rho) { const int n = rho >> 4, i = rho & 15; return 8 * (i >> 2) + 4 * n + (i & 3); }

struct Unit { int pm, pn; };
struct Gemm { const bf16_t* A; const bf16_t* Bt; int M, N, K; };

struct StaticOrder {
    int nM, nN, nwg, G, c;
    __host__ __device__ void init(int M, int N, int G_, int c_) { nM = M / BM; nN = N / BM; nwg = nM * nN; G = G_; c = c_; }
    __host__ __device__ bool next(int i, Unit& u) const {
        const long L = (long)i * G + c; if (L >= nwg) return false;
        int wgid = (int)L; { const int q = nwg / NXCD, r = nwg % NXCD, xcd = wgid % NXCD, off = wgid / NXCD; wgid = (xcd < r ? xcd * (q + 1) : r * (q + 1) + (xcd - r) * q) + off; }
        const int nig = WGM * nN, gid = wgid / nig, fm = gid * WGM, gsz = (nM - fm) < WGM ? (nM - fm) : WGM;
        u.pm = fm + ((wgid % nig) % gsz); u.pn = (wgid % nig) / gsz; return true;
    }
    __device__ __forceinline__ void a_ready(const Unit&) const {}
    __device__ __forceinline__ void done(const Unit&) const {}
};

__device__ __forceinline__ unsigned cvt_pk_bf16(float lo, float hi) { unsigned r; asm volatile("v_cvt_pk_bf16_f32 %0, %1, %2" : "=v"(r) : "v"(lo), "v"(hi)); return r; }
typedef float f32x2 __attribute__((ext_vector_type(2)));
__device__ __forceinline__ f32x2 gelu_pk(f32x2 v) {
    const f32x2 av = __builtin_elementwise_abs(v), d = av * 0.2316418882f + 1.0f;
    f32x2 t; t.x = __builtin_amdgcn_rcpf(d.x); t.y = __builtin_amdgcn_rcpf(d.y);
    f32x2 q = t * 0.5307027145f + (-0.7265760135f); q = q * t + 0.7107068705f; q = q * t + (-0.142248368f); q = q * t + 0.127414796f; q = q * t;
    const f32x2 s = (v * v) * (-0.72134752044f);
    f32x2 e; e.x = __builtin_amdgcn_exp2f(s.x); e.y = __builtin_amdgcn_exp2f(s.y);
    const f32x2 m = v * (q * e), r = v - m;
    f32x2 o; o.x = v.x < 0.f ? m.x : r.x; o.y = v.y < 0.f ? m.y : r.y; return o;
}

template <int ACT  > struct EpiBf16 {
    static constexpr bool PERM = true, AFTER_DRAIN = false; static_assert(ACT == 0 || ACT == 1, "EpiBf16: ACT is 0 (none) or 1 (gelu_pk)");
    bf16_t* O; int ldc; const float* bias; int split_cols; size_t split_stride; float scale0;
    __device__ __forceinline__ void operator()(const f32x4 (&acc)[2][2][4][2], const Unit& u, int wr, int wc, int fr, int fq) const {
        const int row0 = u.pm * BM + wr * 64 + fr; int colt = u.pn * BM; bf16_t* base = O;
        float sc = 1.f; if (split_cols) { const int t = colt / split_cols; base += (size_t)t * split_stride; colt -= t * split_cols; if (t == 0) sc = scale0; }
        const int col0 = colt + wc * 32 + 8 * fq, bcol0 = u.pn * BM + wc * 32 + 8 * fq;
        f32x4 bv[2][2];
#pragma unroll
        for (int bj = 0; bj < 2; ++bj)
#pragma unroll
            for (int n = 0; n < 2; ++n) bv[bj][n] = bias ? *(const f32x4*)(bias + bcol0 + bj * HALF + 4 * n) : (f32x4){0.f, 0.f, 0.f, 0.f};
#pragma unroll
        for (int ai = 0; ai < 2; ++ai)
#pragma unroll
            for (int m = 0; m < 4; ++m) { bf16_t* rowp = base + (size_t)(row0 + ai * HALF + m * 16) * ldc + col0;
#pragma unroll
                for (int bj = 0; bj < 2; ++bj) { f32x4 v0 = acc[ai][bj][m][0] + bv[bj][0], v1 = acc[ai][bj][m][1] + bv[bj][1];
                    if (ACT == 1) { f32x2 a = gelu_pk((f32x2){v0[0], v0[1]}), b = gelu_pk((f32x2){v0[2], v0[3]}), c = gelu_pk((f32x2){v1[0], v1[1]}), d = gelu_pk((f32x2){v1[2], v1[3]});
                        v0 = (f32x4){a.x, a.y, b.x, b.y}; v1 = (f32x4){c.x, c.y, d.x, d.y}; }
                    v0 = v0 * sc; v1 = v1 * sc; u32x4 w; w.x = cvt_pk_bf16(v0[0], v0[1]); w.y = cvt_pk_bf16(v0[2], v0[3]); w.z = cvt_pk_bf16(v1[0], v1[1]); w.w = cvt_pk_bf16(v1[2], v1[3]);
                    *(u32x4*)(rowp + bj * HALF) = w; } }
    }
};
typedef int v4i_t __attribute__((ext_vector_type(4)));
typedef int v8i_t __attribute__((ext_vector_type(8)));
__device__ __forceinline__ v8i_t cat32(bf16x8 a, bf16x8 b) { const v4i_t x = __builtin_bit_cast(v4i_t, a), y = __builtin_bit_cast(v4i_t, b); return __builtin_shufflevector(x, y, 0, 1, 2, 3, 4, 5, 6, 7); }
template <class Epi, class Sched, bool ALIGN_EPI = false, bool SP2 = false, bool GATHER = false, bool FP8 = false>
__device__ __forceinline__ void gemm_phase(PG8_LAS unsigned char* lds, const Gemm g, const Sched& S, const Epi& E, const int* rowsrc = nullptr) {
    static_assert(!GATHER || SP2, "GATHER is implemented on the SP2 loop only");
    int tid_l = threadIdx.x; asm volatile("" : "+v"(tid_l));
    const int tid = tid_l, wid = __builtin_amdgcn_readfirstlane(tid >> 6), lane = tid & 63, wr = wid >> 2, wc = wid & 3, fr = lane & 15, fq = lane >> 4;
    const int K = g.K, nt = K / BK;
    unsigned voffA[2], voffB[2];
#pragma unroll
    for (int i = 0; i < 2; ++i) { int R, C; stage_rc(tid * 16 + i * 8192, R, C); const int Rb = Epi::PERM ? ((R & ~31) + perm32(R & 31)) : R;
        voffA[i] = (unsigned)(R * K + C) * 2u; voffB[i] = (unsigned)(Rb * K + C) * 2u; }
    unsigned gAc[2][2], gAn[2][2]; int gR[2]; unsigned gC[2];
#pragma unroll
    for (int i = 0; i < 2; ++i) { int R, C; stage_rc(tid * 16 + i * 8192, R, C); gR[i] = R; gC[i] = (unsigned)C * 2u; gAc[0][i] = gAc[1][i] = gAn[0][i] = gAn[1][i] = 0u; }
#define PG8_GATHER(u_, o_) do { _Pragma("unroll") for (int h_ = 0; h_ < 2; ++h_) _Pragma("unroll") for (int i_ = 0; i_ < 2; ++i_) \
        o_[h_][i_] = (unsigned)rowsrc[(u_).pm * BM + h_ * HALF + gR[i_]] * (unsigned)(K * 2) + gC[i_]; } while (0)
#define PG8_STAGE_A(bufoff, orig_gbase, NEXTSEL, H, KOFF) do { if constexpr (GATHER) { unsigned vo_[2]; vo_[0] = (NEXTSEL) ? gAn[H][0] : gAc[H][0]; vo_[1] = (NEXTSEL) ? gAn[H][1] : gAc[H][1]; \
        PG8_STAGE(bufoff, (const char*)g.A + (KOFF), vo_); } else { PG8_STAGE(bufoff, orig_gbase, voffA); } } while (0)
    const size_t kstep = (size_t)(BK * 2);
    const size_t hstep = (size_t)HALF * K * 2;
    const size_t tstep = 2 * hstep;
    const unsigned ldsw = (unsigned)wid * 1024u;
    const int aoff = lds_byte(wr * 64 + fr, fq * (FP8 ? 16 : 8)), boff = lds_byte(wc * 32 + fr, fq * (FP8 ? 16 : 8));
#define PG8_SA(b, h) (((b) * 2 + (h)) * HTB)
#define PG8_SB(b, h) ((4 + (b) * 2 + (h)) * HTB)
#define PG8_STAGE(bufoff, gbase, voff) do { _Pragma("unroll") for (int _i = 0; _i < 2; ++_i) \
        __builtin_amdgcn_global_load_lds((const unsigned*)((const char*)(gbase) + (voff)[_i]), (PG8_LAS unsigned*)(lds + (bufoff) + ldsw + _i * 8192), 16, 0, 0); } while (0)
#define PG8_LD32(var, addr) do { var = *(const PG8_LAS v8i_t*)(addr); } while (0)
#define PG8_LDA(dst, b, h) do { if constexpr (FP8) { _Pragma("unroll") for (int m = 0; m < 4; ++m) PG8_LD32(dst##8[m], lds + PG8_SA(b, h) + aoff + m * 2048); } \
        else { _Pragma("unroll") for (int m = 0; m < 4; ++m) _Pragma("unroll") for (int k = 0; k < 2; ++k) dst[m][k] = *(const PG8_LAS bf16x8*)(lds + PG8_SA(b, h) + aoff + m * 2048 + k * 1024); } } while (0)
#define PG8_LDB(dst, b, h) do { if constexpr (FP8) { _Pragma("unroll") for (int n = 0; n < 2; ++n) PG8_LD32(dst##8[n], lds + PG8_SB(b, h) + boff + n * 2048); } \
        else { _Pragma("unroll") for (int n = 0; n < 2; ++n) _Pragma("unroll") for (int k = 0; k < 2; ++k) dst[n][k] = *(const PG8_LAS bf16x8*)(lds + PG8_SB(b, h) + boff + n * 2048 + k * 1024); } } while (0)
#define PG8_MMA(ai, bj, At, Bt) do { __builtin_amdgcn_s_setprio(1); \
        if constexpr (FP8) { _Pragma("unroll") for (int m = 0; m < 4; ++m) _Pragma("unroll") for (int n = 0; n < 2; ++n) \
            asm volatile("v_mfma_scale_f32_16x16x128_f8f6f4 %0, %1, %2, %0, %3, %3 op_sel_hi:[0,0,0]" : "+v"(acc[ai][bj][m][n]) : "v"(Bt##8[n]), "v"(At##8[m]), "v"(sc127)); } \
        else { _Pragma("unroll") for (int m = 0; m < 4; ++m) _Pragma("unroll") for (int n = 0; n < 2; ++n) _Pragma("unroll") for (int k = 0; k < 2; ++k) \
            acc[ai][bj][m][n] = __builtin_amdgcn_mfma_f32_16x16x32_bf16(Bt[n][k], At[m][k], acc[ai][bj][m][n], 0, 0, 0); } \
        __builtin_amdgcn_s_setprio(0); } while (0)
#define PG8_WAIT_V(n) asm volatile("s_waitcnt vmcnt(" #n ")" ::: "memory")
#define PG8_WAIT_L(n) asm volatile("s_waitcnt lgkmcnt(" #n ")" ::: "memory")
#define PG8_BAR __builtin_amdgcn_s_barrier()
#define PG8_SCHED __builtin_amdgcn_sched_barrier(0)
    Unit cur, nxt; int ui = 0;
    if (!S.next(0, cur)) return;
    f32x4 acc[2][2][4][2];
#pragma unroll
    for (int a = 0; a < 2; ++a)
#pragma unroll
        for (int b = 0; b < 2; ++b)
#pragma unroll
            for (int m = 0; m < 4; ++m)
#pragma unroll
                for (int n = 0; n < 2; ++n) acc[a][b][m][n] = (f32x4){0.f, 0.f, 0.f, 0.f};
    int sc127 = 0x7f7f7f7f; asm volatile("" : "+v"(sc127));
    bf16x8 At[4][2], B0[2][2], B1[2][2]; v8i_t At8[4], B08[2], B18[2]; (void)At; (void)B0; (void)B1; (void)At8; (void)B08; (void)B18;
    const char* cA = (const char*)g.A + (size_t)cur.pm * tstep; const char* cB = (const char*)g.Bt + (size_t)cur.pn * tstep;
    S.a_ready(cur);
    if constexpr (GATHER) { PG8_GATHER(cur, gAc); }
    if constexpr (SP2) {
        PG8_STAGE(PG8_SB(0, 0), cB, voffB); PG8_STAGE(PG8_SB(0, 1), cB + hstep, voffB); PG8_STAGE_A(PG8_SA(0, 0), cA, false, 0, (size_t)0); PG8_STAGE_A(PG8_SA(0, 1), cA + hstep, false, 1, (size_t)0);
        if (wr == 1) PG8_BAR;
        PG8_WAIT_V(2); PG8_BAR;
        PG8_STAGE(PG8_SB(1, 0), cB + kstep, voffB); PG8_STAGE_A(PG8_SA(1, 0), cA + kstep, false, 0, kstep); PG8_STAGE(PG8_SB(1, 1), cB + hstep + kstep, voffB);
        PG8_WAIT_V(6); PG8_BAR;
    } else {
        PG8_STAGE(PG8_SB(0, 0), cB, voffB); PG8_STAGE(PG8_SA(0, 0), cA, voffA); PG8_STAGE(PG8_SB(0, 1), cB + hstep, voffB); PG8_STAGE(PG8_SA(0, 1), cA + hstep, voffA);
        if (wr == 1) PG8_BAR;
        PG8_WAIT_V(4); PG8_BAR;
        PG8_STAGE(PG8_SB(1, 0), cB + kstep, voffB); PG8_STAGE(PG8_SA(1, 0), cA + kstep, voffA); PG8_STAGE(PG8_SB(1, 1), cB + hstep + kstep, voffB);
        PG8_WAIT_V(6); PG8_BAR;
    }
    for (;;) {
        const bool has_next = S.next(ui + 1, nxt);
        if constexpr (GATHER) { if (has_next) { PG8_GATHER(nxt, gAn); } else { _Pragma("unroll") for (int h_ = 0; h_ < 2; ++h_) _Pragma("unroll") for (int i_ = 0; i_ < 2; ++i_) gAn[h_][i_] = gAc[h_][i_]; } }
        const char* nA = has_next ? (const char*)g.A + (size_t)nxt.pm * tstep : cA; const char* nB = has_next ? (const char*)g.Bt + (size_t)nxt.pn * tstep : cB;
#pragma nounroll
        for (int t = 0; t < nt; t += 2) {
            const bool last = (t == nt - 2);
            const char* a1 = cA + (size_t)(t + 1) * kstep;
            const char* a2 = last ? nA : cA + (size_t)(t + 2) * kstep; const char* b2 = last ? nB : cB + (size_t)(t + 2) * kstep;
            const char* a3 = a2 + kstep; const char* b3 = b2 + kstep;
            const size_t k1 = (size_t)(t + 1) * kstep, k2 = last ? (size_t)0 : (size_t)(t + 2) * kstep, k3 = k2 + kstep; (void)k1; (void)k2; (void)k3;
            if (last && has_next) S.a_ready(nxt);
            if constexpr (SP2) {
            PG8_LDB(B0, 0, 0); PG8_LDB(B1, 0, 1); PG8_SCHED; PG8_LDA(At, 0, 0); PG8_STAGE_A(PG8_SA(1, 1), a1 + hstep, false, 1, k1);
            PG8_WAIT_V(8); PG8_WAIT_L(0); PG8_BAR; PG8_MMA(0, 0, At, B0); PG8_MMA(0, 1, At, B1); PG8_BAR; PG8_SCHED;
            PG8_LDA(At, 0, 1); PG8_STAGE(PG8_SB(0, 0), b2, voffB); PG8_STAGE(PG8_SB(0, 1), b2 + hstep, voffB); PG8_STAGE_A(PG8_SA(0, 0), a2, last, 0, k2);
            PG8_WAIT_V(8); PG8_WAIT_L(0); PG8_BAR; PG8_MMA(1, 0, At, B0); PG8_MMA(1, 1, At, B1); PG8_BAR; PG8_SCHED;
            PG8_LDB(B0, 1, 0); PG8_LDB(B1, 1, 1); PG8_SCHED; PG8_LDA(At, 1, 0); PG8_STAGE_A(PG8_SA(0, 1), a2 + hstep, last, 1, k2);
            PG8_WAIT_V(8); PG8_WAIT_L(0); PG8_BAR; PG8_MMA(0, 0, At, B0); PG8_MMA(0, 1, At, B1); PG8_BAR; PG8_SCHED;
            PG8_LDA(At, 1, 1); PG8_STAGE(PG8_SB(1, 0), b3, voffB); PG8_STAGE(PG8_SB(1, 1), b3 + hstep, voffB); PG8_STAGE_A(PG8_SA(1, 0), a3, last, 0, k3);
            PG8_WAIT_V(8); PG8_WAIT_L(0); PG8_BAR; PG8_MMA(1, 0, At, B0); PG8_MMA(1, 1, At, B1); PG8_BAR; PG8_SCHED;
            } else {
            PG8_LDB(B0, 0, 0); PG8_SCHED; PG8_LDA(At, 0, 0); PG8_STAGE(PG8_SA(1, 1), a1 + hstep, voffA);
            PG8_WAIT_L(8); PG8_BAR; PG8_WAIT_L(0); PG8_MMA(0, 0, At, B0); PG8_BAR; PG8_SCHED;
            PG8_LDB(B1, 0, 1); PG8_STAGE(PG8_SB(0, 0), b2, voffB);
            PG8_BAR; PG8_WAIT_L(0); PG8_MMA(0, 1, At, B1); PG8_BAR;
            PG8_LDA(At, 0, 1); PG8_STAGE(PG8_SA(0, 0), a2, voffA);
            PG8_BAR; PG8_WAIT_L(0); PG8_MMA(1, 0, At, B0); PG8_BAR; PG8_SCHED;
            PG8_STAGE(PG8_SB(0, 1), b2 + hstep, voffB);
            PG8_WAIT_V(6); PG8_BAR; PG8_MMA(1, 1, At, B1); PG8_BAR;
            PG8_LDB(B0, 1, 0); PG8_SCHED; PG8_LDA(At, 1, 0); PG8_STAGE(PG8_SA(0, 1), a2 + hstep, voffA);
            PG8_WAIT_L(8); PG8_BAR; PG8_WAIT_L(0); PG8_MMA(0, 0, At, B0); PG8_BAR; PG8_SCHED;
            PG8_LDB(B1, 1, 1); PG8_STAGE(PG8_SB(1, 0), b3, voffB);
            PG8_BAR; PG8_WAIT_L(0); PG8_MMA(0, 1, At, B1); PG8_BAR;
            PG8_LDA(At, 1, 1); PG8_STAGE(PG8_SA(1, 0), a3, voffA);
            PG8_BAR; PG8_WAIT_L(0); PG8_MMA(1, 0, At, B0); PG8_BAR; PG8_SCHED;
            PG8_STAGE(PG8_SB(1, 1), b3 + hstep, voffB);
            PG8_WAIT_V(6); PG8_BAR; PG8_MMA(1, 1, At, B1); PG8_BAR;
            }
        }
        if constexpr (ALIGN_EPI) { if (wr == 0) PG8_BAR; }
        if constexpr (FP8) { asm volatile("s_nop 15\n\ts_nop 15" ::: "memory"); }
        if constexpr (!Epi::AFTER_DRAIN) { E(acc, cur, wr, wc, fr, fq); S.done(cur); }
        if (!has_next) break;
#pragma unroll
        for (int a = 0; a < 2; ++a)
#pragma unroll
            for (int b = 0; b < 2; ++b)
#pragma unroll
                for (int m = 0; m < 4; ++m)
#pragma unroll
                    for (int n = 0; n < 2; ++n) acc[a][b][m][n] = (f32x4){0.f, 0.f, 0.f, 0.f};
        cur = nxt; cA = nA; cB = nB; ++ui;
        if constexpr (GATHER) { _Pragma("unroll") for (int h_ = 0; h_ < 2; ++h_) _Pragma("unroll") for (int i_ = 0; i_ < 2; ++i_) gAc[h_][i_] = gAn[h_][i_]; }
        if constexpr (ALIGN_EPI) { if (wr == 1) PG8_BAR; }
    }
    PG8_WAIT_V(0);
    if constexpr (!ALIGN_EPI) { if (wr == 0) PG8_BAR; }
    PG8_BAR;
    if constexpr (Epi::AFTER_DRAIN) { E.fused(acc, cur, wr, wc, fr, fq, lds, wid, lane); S.done(cur); }
#undef PG8_SA
#undef PG8_SB
#undef PG8_STAGE
#undef PG8_STAGE_A
#undef PG8_GATHER
#undef PG8_LDA
#undef PG8_LD32
#undef PG8_LDB
#undef PG8_MMA
#undef PG8_WAIT_V
#undef PG8_WAIT_L
#undef PG8_BAR
#undef PG8_SCHED
}
}

#ifndef PG8_SP2
#define PG8_SP2 true
#endif
#ifndef PG8_ALIGN
#define PG8_ALIGN true
#endif

#define GAS __attribute__((address_space(1)))
#define LAS __attribute__((address_space(3)))
typedef unsigned short bf16;
typedef unsigned v4u __attribute__((ext_vector_type(4)));
typedef unsigned v2u __attribute__((ext_vector_type(2)));
typedef float f32x4 __attribute__((ext_vector_type(4)));
typedef short bf16x8 __attribute__((ext_vector_type(8)));

constexpr int D = 1024, NB = 8, SEQ = 4096, CTXL = 256, TPB = SEQ + CTXL, NTOK = NB * TPB, NLAT = NB * SEQ;
constexpr int ZC = 3328;
constexpr int ZQ = 0, ZKV = 384, ZKR = 640, ZHQ = 672, ZHF = 1184, ZHB = 1696, ZHI = 2208, ZHG = 2720;
constexpr int NEXP = 32;
constexpr float ALPHA = 1.4142135623730951f;
constexpr float LN_EPS = 1e-5f, RMS_EPS = 1e-6f;
constexpr int NWAVES = 8, NTHR = 512;
constexpr float SC_X8 = 16.f, SC_WGU = 64.f, SC_ACT = 8.f, SC_WDN = 128.f;
constexpr int LDS_BYTES = 147456;
constexpr int LDS_BAR_OFF = LDS_BYTES - 64;
constexpr int LDS_TILE_E = 131072;
constexpr int MAXTILES = 576;

constexpr size_t MiB = 1u << 20;
constexpr size_t WS_CTL = 0, CTL_ZERO_BYTES = 16384;
constexpr size_t WS_MODV = 1 * MiB;
constexpr size_t WS_ROPE = 1 * MiB + 512 * 1024;
constexpr size_t WS_BGU = 2 * MiB;
constexpr size_t WS_PW1B = 2 * MiB + 512 * 1024;
constexpr size_t WS_BCNT = WS_PW1B + 64 * 1024;
constexpr size_t WS_TILEE = WS_BCNT + 64 * 1024;
constexpr size_t WS_META = WS_TILEE + 4096;
constexpr size_t WS_TOPI = 3 * MiB, WS_TOPW = 4 * MiB, WS_ROWW = 5 * MiB, WS_ROWD = 6 * MiB, WS_ROWS = 7 * MiB;
constexpr size_t WS_WIN = 8 * MiB, WS_WUQ = 15 * MiB, WS_WUKV = 16 * MiB, WS_WOUT = 17 * MiB, WS_WPW1 = 19 * MiB, WS_WPW2 = 23 * MiB;
constexpr size_t WS_WGU = 32 * MiB, WS_WDN = 288 * MiB;
constexpr size_t WS_H = 416 * MiB;
constexpr size_t WS_X = 552 * MiB, WS_Y = 620 * MiB;
constexpr size_t WS_BIG = 688 * MiB;
constexpr size_t WS_Z = WS_BIG, WS_CQN = WS_BIG + 221 * MiB, WS_CKVN = WS_BIG + 247 * MiB, WS_KRR = WS_BIG + 264 * MiB,
                 WS_Q = WS_BIG + 267 * MiB, WS_KV = WS_BIG + 318 * MiB, WS_OF = WS_BIG + 386 * MiB, WS_OB = WS_BIG + 454 * MiB;
constexpr size_t WS_HT = WS_BIG + 528 * MiB;
constexpr size_t WS_XS = WS_BIG, WS_ACT = WS_BIG + 288 * MiB, WS_YB = WS_BIG + 576 * MiB;
constexpr size_t WS_END = WS_BIG + 848 * MiB;
static_assert((size_t)NTOK * ZC * 2 <= 221 * MiB && (size_t)NTOK * 384 * 2 <= 26 * MiB && (size_t)NTOK * 256 * 2 <= 17 * MiB && (size_t)NTOK * 32 * 2 <= 3 * MiB, "ws map 1");
static_assert((size_t)NTOK * 768 * 2 <= 51 * MiB && (size_t)NTOK * 1024 * 2 <= 68 * MiB && (size_t)NTOK * 512 * 4 <= 68 * MiB, "ws map 2");
static_assert((size_t)64 * 136 * 26624 <= 320 * MiB && (size_t)MAXTILES * 256 * 2048 <= 288 * MiB && (size_t)NLAT * 4 * 2048 <= 272 * MiB && (size_t)NTOK * 1024 * 4 <= 136 * MiB, "ws map 3");

#define LDS_WAIT() asm volatile("s_waitcnt lgkmcnt(0)" ::: "memory")
#define VM_WAIT() asm volatile("s_waitcnt vmcnt(0)" ::: "memory")
__device__ __forceinline__ float bf2f(unsigned short b) { return __uint_as_float(((unsigned)b) << 16); }
__device__ __forceinline__ unsigned pk2(float lo, float hi) { return pg8::cvt_pk_bf16(lo, hi); }
__device__ __forceinline__ float sigm(float x) { return 1.f / (1.f + __expf(-x)); }
__device__ __forceinline__ float wave_sum(float v) {
#pragma unroll
    for (int o = 1; o < 64; o <<= 1) v += __shfl_xor(v, o);
    return v;
}
__device__ __forceinline__ int ld_ctl(const int* p) { return (int)__hip_atomic_load((const unsigned*)p, __ATOMIC_RELAXED, __HIP_MEMORY_SCOPE_AGENT); }
__device__ __forceinline__ int grow_of(int lr) { return (lr >> 12) * TPB + CTXL + (lr & 4095); }

#define XB_TMO      128
#define XB_XCNT(j)  (256  + 64 * (j))
#define XB_XSUB(j)  (1280 + 64 * (j))
#define XB_XGEN(j)  (2304 + 64 * (j))
#define XB_TOP      3328
#define XB_TOPGEN   3392
#define XCD_BAR_WORDS 3456
#define XB_SPIN_CAP (1u << 21)

__device__ __forceinline__ unsigned xb_ld(unsigned* p)              { return __hip_atomic_load(p, __ATOMIC_RELAXED, __HIP_MEMORY_SCOPE_AGENT); }
__device__ __forceinline__ unsigned xb_add(unsigned* p, unsigned v) { return __hip_atomic_fetch_add(p, v, __ATOMIC_RELAXED, __HIP_MEMORY_SCOPE_AGENT); }
__device__ __forceinline__ unsigned xb_xcc_id() { return (unsigned)__builtin_amdgcn_s_getreg((3 << 11) | 20) & 0xFu; }
#define XB_SPIN(cond, bar) do { unsigned _sp = 0; while (cond) { __builtin_amdgcn_s_sleep(1); \
    if ((++_sp & 255u) == 0u) { if (xb_ld(&(bar)[XB_TMO])) break; if (_sp > XB_SPIN_CAP) { atomicAdd(&(bar)[XB_TMO], 1u); break; } } } } while (0)

struct XcdBarrier { unsigned* bar; unsigned x; volatile LAS unsigned* st; };

__device__ __forceinline__ XcdBarrier xcd_barrier_post(unsigned* bar, volatile LAS unsigned* st) {
    XcdBarrier b; b.bar = bar; b.x = xb_xcc_id(); b.st = st;
    if (threadIdx.x == 0) (void)xb_add(&bar[XB_XCNT(b.x)], 1u);
    return b;
}
__device__ __forceinline__ void xcd_barrier_complete(unsigned* bar, unsigned x, unsigned& nloc, unsigned& nx) {
    const unsigned G = gridDim.x * gridDim.y * gridDim.z;
    unsigned sum, cnt, mine, sp = 0u;
    for (;;) {
        sum = 0u; cnt = 0u; mine = 0u;
#pragma unroll
        for (unsigned j = 0; j < 16; ++j) { const unsigned c = xb_ld(&bar[XB_XCNT(j)]); sum += c; cnt += (c > 0u) ? 1u : 0u; mine = (j == x) ? c : mine; }
        if (sum == G) break;
        __builtin_amdgcn_s_sleep(1);
        if ((++sp & 255u) == 0u) { if (xb_ld(&bar[XB_TMO])) break; if (sp > XB_SPIN_CAP) { atomicAdd(&bar[XB_TMO], 1u); break; } }
    }
    nloc = mine > 0u ? mine : 1u; nx = cnt > 0u ? cnt : 1u;
}
__device__ __forceinline__ void xcd_barrier(const XcdBarrier& b) {
    asm volatile("s_waitcnt vmcnt(0)" ::: "memory");
    __syncthreads();
    if (threadIdx.x == 0) {
        unsigned* bar = b.bar;
        __builtin_amdgcn_s_waitcnt(0);
        unsigned nloc = b.st[0], nx = b.st[1];
        if (nloc == 0u) { xcd_barrier_complete(bar, b.x, nloc, nx); b.st[0] = nloc; b.st[1] = nx; }
        const unsigned old = xb_add(&bar[XB_XSUB(b.x)], 1u);
        const unsigned gen = old / nloc;
        if (old + 1u == (gen + 1u) * nloc) {
            __builtin_amdgcn_fence(__ATOMIC_RELEASE, "agent");
            asm volatile("s_waitcnt vmcnt(0)" ::: "memory");
            const unsigned og = xb_add(&bar[XB_TOP], 1u);
            const unsigned tg = og / nx;
            if (og + 1u == (tg + 1u) * nx) xb_add(&bar[XB_TOPGEN], 1u);
            else XB_SPIN(xb_ld(&bar[XB_TOPGEN]) == tg, bar);
            __builtin_amdgcn_fence(__ATOMIC_ACQUIRE, "agent");
            xb_add(&bar[XB_XGEN(b.x)], 1u);
            asm volatile("s_waitcnt vmcnt(0)" ::: "memory");
        } else {
            XB_SPIN(xb_ld(&bar[XB_XGEN(b.x)]) == gen, bar);
            __builtin_amdgcn_fence(__ATOMIC_ACQUIRE, "agent");
            asm volatile("s_waitcnt vmcnt(0)" ::: "memory");
        }
    }
    __syncthreads();
}

namespace pg8 {
struct TileOrder {
    int nM, nN, nwg, G, c;
    __device__ __forceinline__ void init(int nM_, int nN_, int G_, int c_) { nM = nM_; nN = nN_; nwg = nM * nN; G = G_; c = c_; }
    __device__ __forceinline__ bool logical(int i, int& im, int& in) const {
        const long L = (long)i * G + c; if (L >= nwg) return false;
        int wgid = (int)L; { const int q = nwg / NXCD, r = nwg % NXCD, xcd = wgid % NXCD, off = wgid / NXCD; wgid = (xcd < r ? xcd * (q + 1) : r * (q + 1) + (xcd - r) * q) + off; }
        const int nig = WGM * nN, gid = wgid / nig, fm = gid * WGM, gsz = (nM - fm) < WGM ? (nM - fm) : WGM;
        im = fm + ((wgid % nig) % gsz); in = (wgid % nig) / gsz; return true;
    }
    __device__ __forceinline__ void a_ready(const Unit&) const {}
    __device__ __forceinline__ void done(const Unit&) const {}
};
struct AllOrder : TileOrder { __device__ __forceinline__ bool next(int i, Unit& u) const { int im, in; if (!logical(i, im, in)) return false; u.pm = im; u.pn = in; return true; } };
struct LatOrder : TileOrder {
    __device__ __forceinline__ bool next(int i, Unit& u) const { int im, in; if (!logical(i, im, in)) return false; u.pm = (im >> 4) * 17 + 1 + (im & 15); u.pn = in; return true; } };
struct MoeOrder : TileOrder {
    const PG8_LAS int* tile_e; int nper;
    __device__ __forceinline__ bool next(int i, Unit& u) const { int im, in; if (!logical(i, im, in)) return false; u.pm = im; u.pn = tile_e[im] * nper + in; return true; } };

struct EpiRes {
    static constexpr bool PERM = false, AFTER_DRAIN = false;
    const float* xin; float* h; const float* modv; const float* bias;
    __device__ __forceinline__ void operator()(const f32x4 (&acc)[2][2][4][2], const Unit& u, int wr, int wc, int fr, int fq) const {
        asm volatile("" : "+v"(fr), "+v"(fq));
        const int b = u.pm / 17, j = u.pm % 17;
        const int rl0 = wr * 64 + fr, col0 = u.pn * BM + wc * 32 + 4 * fq;
        const float* gate = modv + (size_t)b * 6144 + 2048;
        f32x4 gv[2][2], bv[2][2];
#pragma unroll
        for (int bj = 0; bj < 2; ++bj)
#pragma unroll
            for (int n = 0; n < 2; ++n) { gv[bj][n] = *(const f32x4*)(gate + col0 + bj * HALF + n * 16); bv[bj][n] = bias ? *(const f32x4*)(bias + col0 + bj * HALF + n * 16) : (f32x4){0.f, 0.f, 0.f, 0.f}; }
#pragma unroll
        for (int ai = 0; ai < 2; ++ai)
#pragma unroll
            for (int m = 0; m < 4; ++m) { const int rl = rl0 + ai * HALF + m * 16; const size_t grow = (size_t)u.pm * BM + rl;
                const float* hin = xin ? xin + ((size_t)b * 4096 + (size_t)(j - 1) * 256 + rl) * 1024 + col0 : h + grow * 1024 + col0;
                float* ho = h + grow * 1024 + col0;
#pragma unroll
                for (int bj = 0; bj < 2; ++bj)
#pragma unroll
                    for (int n = 0; n < 2; ++n) { const f32x4 hv = *(const f32x4*)(hin + bj * HALF + n * 16);
                        *(f32x4*)(ho + bj * HALF + n * 16) = hv * 1.4142135623730951f + gv[bj][n] * (acc[ai][bj][m][n] + bv[bj][n]); } }
    }
};
template <int MODE, bool OUT8 = false> struct EpiGate {
    static constexpr bool PERM = true, AFTER_DRAIN = false;
    bf16_t* O; const float* bias; int nper; float ascale, oscale;
    __device__ __forceinline__ void operator()(const f32x4 (&acc)[2][2][4][2], const Unit& u, int wr, int wc, int fr, int fq) const {
        asm volatile("" : "+v"(fr), "+v"(fq));
        const int row0 = u.pm * BM + wr * 64 + fr, pnl = u.pn % nper, ocol0 = pnl * HALF + wc * 32 + 8 * fq, bcol0 = u.pn * BM + wc * 32 + 8 * fq;
        f32x4 bv[2][2];
#pragma unroll
        for (int bj = 0; bj < 2; ++bj)
#pragma unroll
            for (int n = 0; n < 2; ++n) bv[bj][n] = *(const f32x4*)(bias + bcol0 + bj * HALF + 4 * n);
#pragma unroll
        for (int ai = 0; ai < 2; ++ai)
#pragma unroll
            for (int m = 0; m < 4; ++m) { bf16_t* rowp = O + (size_t)(row0 + ai * HALF + m * 16) * 1024 + ocol0;
                unsigned char* rowp8 = (unsigned char*)O + (size_t)(row0 + ai * HALF + m * 16) * 1024 + ocol0;
                float o[8];
#pragma unroll
                for (int n = 0; n < 2; ++n) { const f32x4 a = acc[ai][0][m][n] * ascale + bv[0][n], g = acc[ai][1][m][n] * ascale + bv[1][n];
#pragma unroll
                    for (int e = 0; e < 4; ++e) {
                        if (MODE == 0) { o[4 * n + e] = a[e] * (1.f / (1.f + __expf(-g[e]))); }
                        else { const float gt = fminf(a[e], 7.0f), up = fminf(fmaxf(g[e], -7.0f), 7.0f); o[4 * n + e] = (up + 1.0f) * gt * (1.f / (1.f + __expf(-1.702f * gt))); } } }
                if constexpr (OUT8) {
#pragma unroll
                    for (int e = 0; e < 8; ++e) o[e] = fminf(fmaxf(o[e] * oscale, -448.f), 448.f);
                    int w0 = 0, w1 = 0; w0 = __builtin_amdgcn_cvt_pk_fp8_f32(o[0], o[1], w0, false); w0 = __builtin_amdgcn_cvt_pk_fp8_f32(o[2], o[3], w0, true);
                    w1 = __builtin_amdgcn_cvt_pk_fp8_f32(o[4], o[5], w1, false); w1 = __builtin_amdgcn_cvt_pk_fp8_f32(o[6], o[7], w1, true);
                    typedef unsigned u32x2 __attribute__((ext_vector_type(2))); *(u32x2*)rowp8 = (u32x2){(unsigned)w0, (unsigned)w1}; (void)rowp;
                } else { (void)rowp8;
                u32x4 w; w.x = cvt_pk_bf16(o[0], o[1]); w.y = cvt_pk_bf16(o[2], o[3]); w.z = cvt_pk_bf16(o[4], o[5]); w.w = cvt_pk_bf16(o[6], o[7]);
                *(u32x4*)rowp = w; } }
    }
};
struct EpiDown {
    static constexpr bool PERM = true, AFTER_DRAIN = false;
    bf16_t* Y; const float* bias; const float* row_w; const int* row_dst; float ascale;
    __device__ __forceinline__ void operator()(const f32x4 (&acc)[2][2][4][2], const Unit& u, int wr, int wc, int fr, int fq) const {
        asm volatile("" : "+v"(fr), "+v"(fq));
        const int row0 = u.pm * BM + wr * 64 + fr, pnl = u.pn & 3, ocol0 = pnl * BM + wc * 32 + 8 * fq, bcol0 = u.pn * BM + wc * 32 + 8 * fq;
        f32x4 bv[2][2];
#pragma unroll
        for (int bj = 0; bj < 2; ++bj)
#pragma unroll
            for (int n = 0; n < 2; ++n) bv[bj][n] = *(const f32x4*)(bias + bcol0 + bj * HALF + 4 * n);
#pragma unroll
        for (int ai = 0; ai < 2; ++ai)
#pragma unroll
            for (int m = 0; m < 4; ++m) { const int r = row0 + ai * HALF + m * 16; const int dst = row_dst[r]; const float w8 = row_w[r];
                if (dst >= 0) { bf16_t* rowp = Y + (size_t)dst * 1024 + ocol0;
#pragma unroll
                    for (int bj = 0; bj < 2; ++bj) { const f32x4 v0 = (acc[ai][bj][m][0] * ascale + bv[bj][0]) * w8, v1 = (acc[ai][bj][m][1] * ascale + bv[bj][1]) * w8;
                        u32x4 w; w.x = cvt_pk_bf16(v0[0], v0[1]); w.y = cvt_pk_bf16(v0[2], v0[3]); w.z = cvt_pk_bf16(v1[0], v1[1]); w.w = cvt_pk_bf16(v1[2], v1[3]);
                        *(u32x4*)(rowp + bj * HALF) = w; } } }
    }
};
}

namespace att {
using bf16x8 = __attribute__((ext_vector_type(8))) short;
using s16x4  = __attribute__((ext_vector_type(4))) short;
using f32x16 = __attribute__((ext_vector_type(16))) float;
using u32x4  = __attribute__((ext_vector_type(4))) unsigned;
constexpr int NW = 8, QBLK = 32, KVBLK = 64;
constexpr float SCALE = 0.10206207261596575f;
constexpr float THR = 8.f;
constexpr int SHM_V = 16384, SHM_K = 16384, SHM_ATTN = 2 * SHM_V + 2 * SHM_K + NW * 64 * 4;
#define KSWZ(row, colB) ((row) * 256 + ((colB) ^ (((row) & 7) << 4)))
#define SBAR() __builtin_amdgcn_sched_barrier(0)
__device__ __forceinline__ int crow(int r, int hi) { return (r & 3) + 8 * (r >> 2) + 4 * hi; }
__device__ __forceinline__ unsigned cvtpk(float lo, float hi) { unsigned r; asm volatile("v_cvt_pk_bf16_f32 %0, %1, %2" : "=v"(r) : "v"(lo), "v"(hi)); return r; }

__device__ __forceinline__ void partialSM(f32x16& p0, f32x16& p1, float& m_reg, float& mn, float& alpha) {
  constexpr float C = SCALE * 1.4426950408889634f;
  float pmax = p0[0];
#pragma unroll
  for (int r = 1; r < 16; ++r) pmax = fmaxf(pmax, p0[r]);
#pragma unroll
  for (int r = 0; r < 16; ++r) pmax = fmaxf(pmax, p1[r]);
  { auto rr = __builtin_amdgcn_permlane32_swap(__float_as_uint(pmax), __float_as_uint(pmax), false, false);
    pmax = fmaxf(__uint_as_float(rr[0]), __uint_as_float(rr[1])); }
  if (__builtin_expect(__all(pmax - m_reg <= THR / SCALE), 1)) { mn = m_reg; alpha = 1.f; }
  else { mn = fmaxf(m_reg, pmax); alpha = __builtin_amdgcn_exp2f((m_reg - mn) * C); m_reg = mn; }
  float mnC = -mn * C;
#pragma unroll
  for (int r = 0; r < 16; ++r) p0[r] = fmaf(p0[r], C, mnC);
#pragma unroll
  for (int r = 0; r < 16; ++r) p1[r] = fmaf(p1[r], C, mnC);
#pragma unroll
  for (int r = 0; r < 16; ++r) p0[r] = __builtin_amdgcn_exp2f(p0[r]);
}
__device__ __forceinline__ void finishSM(f32x16& p0, f32x16& p1, float alpha, float& l_reg, bf16x8& pa0, bf16x8& pa1, bf16x8& pa2, bf16x8& pa3) {
#pragma unroll
  for (int r = 0; r < 16; ++r) p1[r] = __builtin_amdgcn_exp2f(p1[r]);
  float ps = 0;
#pragma unroll
  for (int r = 0; r < 16; ++r) ps += p0[r];
#pragma unroll
  for (int r = 0; r < 16; ++r) ps += p1[r];
  { auto rr = __builtin_amdgcn_permlane32_swap(__float_as_uint(ps), __float_as_uint(ps), false, false);
    ps = __uint_as_float(rr[0]) + __uint_as_float(rr[1]); }
  l_reg = l_reg * alpha + ps;
#define PK4(P, BASE, OUT) do { unsigned a0 = cvtpk(P[BASE + 0], P[BASE + 1]), a1 = cvtpk(P[BASE + 2], P[BASE + 3]);   \
    unsigned b0 = cvtpk(P[BASE + 4], P[BASE + 5]), b1 = cvtpk(P[BASE + 6], P[BASE + 7]);                              \
    auto r0 = __builtin_amdgcn_permlane32_swap(a0, b0, false, false); auto r1 = __builtin_amdgcn_permlane32_swap(a1, b1, false, false); \
    u32x4 w = {r0[0], r1[0], r0[1], r1[1]}; OUT = *reinterpret_cast<bf16x8*>(&w); } while (0)
  PK4(p0, 0, pa0); PK4(p0, 8, pa1); PK4(p1, 0, pa2); PK4(p1, 8, pa3);
#undef PK4
}
__device__ __forceinline__ void qkt(f32x16& p0, f32x16& p1, const bf16* Ks, const bf16x8* qr, int r32, int hi) {
  p0 = f32x16{}; p1 = f32x16{};
#pragma unroll
  for (int d0 = 0; d0 < 6; ++d0) { int cb = (d0 * 16 + hi * 8) * 2;
    bf16x8 b0 = *reinterpret_cast<const bf16x8*>((const char*)Ks + KSWZ(r32, cb));
    bf16x8 b1 = *reinterpret_cast<const bf16x8*>((const char*)Ks + KSWZ(32 + r32, cb));
    p0 = __builtin_amdgcn_mfma_f32_32x32x16_bf16(b0, qr[d0], p0, 0, 0, 0);
    p1 = __builtin_amdgcn_mfma_f32_32x32x16_bf16(b1, qr[d0], p1, 0, 0, 0); }
}
__device__ __forceinline__ int v_st(int k, int c) { const int kk = (k & ~0xC) | ((k & 4) << 1) | ((k & 8) >> 1); return ((kk >> 3) * 4 + (c >> 5)) * 512 + ((kk & 7) * 32 + (c & 31)) * 2; }
__device__ __forceinline__ int v_rd_base(int lane) { return ((lane & 3) << 3) | (((lane >> 2) & 3) << 6) | (((lane >> 4) & 1) << 5) | (((lane >> 5) & 1) << 8); }
constexpr int v_rd_off(int d0, int ks, int half) { return d0 * 512 + ks * 4096 + half * 2048; }
template <int OFF> __device__ __forceinline__ s16x4 tr_read(int vb) {
  s16x4 r; asm volatile("ds_read_b64_tr_b16 %0, %1 offset:%2" : "=&v"(r) : "v"(vb), "i"(OFF) : "memory"); return r;
}
template <int D0> __device__ __forceinline__ void pv_one(f32x16& od, int vb, bf16x8 pa0, bf16x8 pa1, bf16x8 pa2, bf16x8 pa3) {
  const s16x4 l0 = tr_read<v_rd_off(D0, 0, 0)>(vb), h0 = tr_read<v_rd_off(D0, 0, 1)>(vb), l1 = tr_read<v_rd_off(D0, 1, 0)>(vb), h1 = tr_read<v_rd_off(D0, 1, 1)>(vb);
  const s16x4 l2 = tr_read<v_rd_off(D0, 2, 0)>(vb), h2 = tr_read<v_rd_off(D0, 2, 1)>(vb), l3 = tr_read<v_rd_off(D0, 3, 0)>(vb), h3 = tr_read<v_rd_off(D0, 3, 1)>(vb);
  asm volatile("s_waitcnt lgkmcnt(0)" ::: "memory"); SBAR();
#define PK(L, H) (bf16x8){L[0], L[1], L[2], L[3], H[0], H[1], H[2], H[3]}
  od = __builtin_amdgcn_mfma_f32_32x32x16_bf16(pa0, PK(l0, h0), od, 0, 0, 0);
  od = __builtin_amdgcn_mfma_f32_32x32x16_bf16(pa1, PK(l1, h1), od, 0, 0, 0);
  od = __builtin_amdgcn_mfma_f32_32x32x16_bf16(pa2, PK(l2, h2), od, 0, 0, 0);
  od = __builtin_amdgcn_mfma_f32_32x32x16_bf16(pa3, PK(l3, h3), od, 0, 0, 0);
#undef PK
}
__device__ __forceinline__ void pv_d0(f32x16* o, int vb, bf16x8 pa0, bf16x8 pa1, bf16x8 pa2, bf16x8 pa3) {
  pv_one<0>(o[0], vb, pa0, pa1, pa2, pa3); pv_one<1>(o[1], vb, pa0, pa1, pa2, pa3);
}
__device__ __forceinline__ bf16x8 rope8(bf16x8 x, const float* tab, int pbase) {
  u32x4 w;
#pragma unroll
  for (int i = 0; i < 4; ++i) { const float x1 = __uint_as_float(((unsigned)(unsigned short)x[2 * i]) << 16), x2 = __uint_as_float(((unsigned)(unsigned short)x[2 * i + 1]) << 16);
    const float cs = tab[pbase + i], sn = tab[16 + pbase + i]; w[i] = cvtpk(x1 * cs - x2 * sn, x1 * sn + x2 * cs); }
  return *reinterpret_cast<bf16x8*>(&w);
}
__device__ __forceinline__ void attn_unit(const bf16* __restrict__ Qb, const bf16* __restrict__ KVb, const bf16* __restrict__ KRb, bf16* __restrict__ Ob,
                                          const float* __restrict__ rope, int seq, char* lds) {
  int tid_l = threadIdx.x; asm volatile("" : "+v"(tid_l));
  const int tid = tid_l, wid = tid >> 6, lane = tid & 63, r32 = lane & 31, hi = lane >> 5;
  bf16* V_lds = (bf16*)lds; bf16* K_lds = (bf16*)(lds + 2 * SHM_V);
  float* ws = (float*)(lds + 2 * SHM_V + 2 * SHM_K) + wid * 64; float* li_l = ws; float* al_l = ws + 32;
  float m_reg = -1e30f, l_reg = 0; f32x16 o[2] = {}; bf16x8 qr[6];
  const bf16* Qw = Qb + (long)(wid * QBLK + r32) * 768 + hi * 8;
#pragma unroll
  for (int d0 = 0; d0 < 6; ++d0) qr[d0] = *reinterpret_cast<const bf16x8*>(Qw + d0 * 16);
  if (rope) { const float* tab = rope + (long)(wid * QBLK + r32) * 32; qr[4] = rope8(qr[4], tab, 4 * hi); qr[5] = rope8(qr[5], tab, 8 + 4 * hi); }
  const int sr = tid >> 4, ch = tid & 15;
  const bf16* kbase = ch < 8 ? KVb + ch * 8 : KRb + ((ch - 8) & 3) * 8; const long kstr = ch < 8 ? 1024 : 32;
  const int vkey = tid >> 3, vc8 = (tid & 7) * 8, vst0 = v_st(vkey, vc8);
  const bf16* vbase = KVb + 512 + vc8;
  const int vb0 = (int)(uintptr_t)V_lds + v_rd_base(lane);
  struct { bf16x8 vs0, ks0, ks1; } sr_[2];
#define SLOAD(i, k0) do { sr_[i].vs0 = *reinterpret_cast<const bf16x8*>(vbase + (long)((k0) + vkey) * 1024); \
    sr_[i].ks0 = *reinterpret_cast<const bf16x8*>(kbase + (long)((k0) + sr) * kstr); sr_[i].ks1 = *reinterpret_cast<const bf16x8*>(kbase + (long)((k0) + 32 + sr) * kstr); } while (0)
#define SWRITE(b, i) do { *(bf16x8*)((char*)V_lds + (b) * SHM_V + vst0) = sr_[i].vs0; int kc = ch * 16;               \
    *(bf16x8*)((char*)K_lds + (b) * SHM_K + KSWZ(sr, kc)) = sr_[i].ks0;                       \
    *(bf16x8*)((char*)K_lds + (b) * SHM_K + KSWZ(32 + sr, kc)) = sr_[i].ks1; } while (0)
#define SWAIT() asm volatile("s_waitcnt vmcnt(3)" ::: "memory")
#define RESC(a) do { if (__any((a) < 1.f)) { if (hi == 0) al_l[r32] = (a); asm volatile("s_waitcnt lgkmcnt(0)" ::: "memory"); \
    _Pragma("unroll") for (int d = 0; d < 2; ++d) _Pragma("unroll") for (int r = 0; r < 16; ++r) o[d][r] *= al_l[crow(r, hi)]; } } while (0)
  f32x16 pA0, pA1, pB0, pB1; float mnA, mnB, alA, alB; bf16x8 pa0, pa1, pa2, pa3; const int NT = seq / KVBLK;
  constexpr int SE = 0, SO = 1;
  SLOAD(SE, 0); asm volatile("s_waitcnt vmcnt(0)" ::: "memory"); SWRITE(0, SE); __syncthreads();
  qkt(pA0, pA1, K_lds, qr, r32, hi); partialSM(pA0, pA1, m_reg, mnA, alA);
  SLOAD(SO, KVBLK); if (2 < NT) SLOAD(SE, 2 * KVBLK);
  SWAIT(); SWRITE(1, SO); __syncthreads();
  for (int j = 1; j + 1 < NT; j += 2) {
    SBAR(); qkt(pB0, pB1, (bf16*)((char*)K_lds + SHM_K), qr, r32, hi);
    finishSM(pA0, pA1, alA, l_reg, pa0, pa1, pa2, pa3); SBAR();
    SLOAD(SO, (j + 2) * KVBLK); SBAR();
    pv_d0(o, vb0, pa0, pa1, pa2, pa3); partialSM(pB0, pB1, m_reg, mnB, alB);
    __syncthreads(); SWAIT(); SWRITE(0, SE);
    RESC(alB); __syncthreads();
    SBAR(); qkt(pA0, pA1, K_lds, qr, r32, hi);
    finishSM(pB0, pB1, alB, l_reg, pa0, pa1, pa2, pa3); SBAR();
    if (j + 3 < NT) SLOAD(SE, (j + 3) * KVBLK); SBAR();
    pv_d0(o, vb0 + (int)SHM_V, pa0, pa1, pa2, pa3); partialSM(pA0, pA1, m_reg, mnA, alA);
    __syncthreads(); SWAIT(); SWRITE(1, SO);
    RESC(alA); __syncthreads();
  }
  SBAR(); qkt(pB0, pB1, (bf16*)((char*)K_lds + SHM_K), qr, r32, hi);
  finishSM(pA0, pA1, alA, l_reg, pa0, pa1, pa2, pa3); SBAR();
  pv_d0(o, vb0, pa0, pa1, pa2, pa3); partialSM(pB0, pB1, m_reg, mnB, alB);
  __syncthreads(); RESC(alB);
  finishSM(pB0, pB1, alB, l_reg, pa0, pa1, pa2, pa3); SBAR();
  pv_d0(o, vb0 + (int)SHM_V, pa0, pa1, pa2, pa3);
  if (hi == 0) li_l[r32] = l_reg; asm volatile("s_waitcnt lgkmcnt(0)" ::: "memory");
  float rli[16];
#pragma unroll
  for (int r = 0; r < 16; ++r) rli[r] = __builtin_amdgcn_rcpf(li_l[crow(r, hi)]);
  bf16* Ow = Ob + (long)(wid * QBLK) * 1024;
#pragma unroll
  for (int r = 0; r < 16; ++r) { int orow = crow(r, hi);
#pragma unroll
    for (int d0 = 0; d0 < 2; ++d0) { const float v = o[d0][r] * rli[r]; Ow[(long)orow * 1024 + d0 * 32 + r32] = (bf16)(cvtpk(v, v) & 0xffffu); } }
#undef SLOAD
#undef SWRITE
#undef SWAIT
#undef RESC
}
}

struct Args { const float* in[33]; float* out; unsigned char* ws; int ph_lo, ph_hi; };
enum { I_X = 0, I_C, I_CTX, I_CCTX, I_MODW, I_MODB, I_LN1G, I_LN1B, I_LN2G, I_LN2B, I_WIN, I_QNORM, I_KVNORM, I_WUQ, I_WUK, I_WUV, I_LBL, I_HGNORM, I_WOUT,
       I_PW1W, I_PW1B, I_DWW, I_DWB, I_CLNG, I_CLNB, I_PW2W, I_PW2B, I_RW, I_RB, I_WGU, I_BGU, I_WDN, I_BDN };

__device__ __forceinline__ int dst_row(int n, int mode, int row_off) {
    if (mode == 0) return row_off + n;
    int f, g; if (mode == 1) { f = n >> 1; g = n & 1; } else { g = n >> 10; f = n & 1023; }
    return row_off + 256 * (f >> 7) + 128 * g + (f & 127);
}
__device__ __forceinline__ unsigned pack_fp8x4(float a, float b, float c, float d) { int w = 0; w = __builtin_amdgcn_cvt_pk_fp8_f32(fminf(fmaxf(a, -448.f), 448.f), fminf(fmaxf(b, -448.f), 448.f), w, false);
    w = __builtin_amdgcn_cvt_pk_fp8_f32(fminf(fmaxf(c, -448.f), 448.f), fminf(fmaxf(d, -448.f), 448.f), w, true); return (unsigned)w; }
__device__ __forceinline__ void tr_item(const float* __restrict__ W, int K, int N, bf16* __restrict__ WT, int mode, int row_off, LAS float* scr, int item, int lane, float f8scale = 0.f) {
    const int nblk = (N + 63) >> 6, kb = item / nblk, nb = item - kb * nblk, k0 = 64 * kb, n0 = 64 * nb;
    const int nc = n0 + 4 * (lane & 15), kr = lane >> 4;
    f32x4 v[16];
#pragma unroll
    for (int i = 0; i < 16; ++i) v[i] = (nc < N) ? *(const f32x4*)(W + (size_t)(k0 + 4 * i + kr) * N + nc) : (f32x4){0.f, 0.f, 0.f, 0.f};
#pragma unroll
    for (int i = 0; i < 16; ++i) { LAS float* s = scr + (4 * i + kr) * 65 + 4 * (lane & 15); s[0] = v[i][0]; s[1] = v[i][1]; s[2] = v[i][2]; s[3] = v[i][3]; }
    LDS_WAIT();
    const int c = lane & 7;
#pragma unroll
    for (int j = 0; j < 8; ++j) { const int nl = (lane >> 3) + 8 * j, n = n0 + nl; const LAS float* s = scr + (8 * c) * 65 + nl;
        v4u o; o.x = pk2(s[0 * 65], s[1 * 65]); o.y = pk2(s[2 * 65], s[3 * 65]); o.z = pk2(s[4 * 65], s[5 * 65]); o.w = pk2(s[6 * 65], s[7 * 65]);
        if (n < N) { if (f8scale > 0.f) { v2u o8; o8.x = pack_fp8x4(s[0 * 65] * f8scale, s[1 * 65] * f8scale, s[2 * 65] * f8scale, s[3 * 65] * f8scale); o8.y = pack_fp8x4(s[4 * 65] * f8scale, s[5 * 65] * f8scale, s[6 * 65] * f8scale, s[7 * 65] * f8scale);
                *(v2u*)((unsigned char*)WT + (size_t)dst_row(n, mode, row_off) * K + k0 + 8 * c) = o8; }
            else *(v4u*)(WT + (size_t)dst_row(n, mode, row_off) * K + k0 + 8 * c) = o; } }
    LDS_WAIT();
}
__device__ __forceinline__ void phase_prologue(const Args& a, LAS unsigned char* lds, int tid, int lane, int wave) {
    unsigned char* ws = a.ws;
    const int G = gridDim.x, B = blockIdx.x;
    {
        LAS float* sc = (LAS float*)lds;
        LAS float* red = (LAS float*)(lds + 36864);
        float* modv = (float*)(ws + WS_MODV);
        bool have = false;
        for (int it = B; it < 192; it += G) {
            if (!have) { for (int i = tid; i < 9 * 1024; i += NTHR) { const int r = i >> 10, k = i & 1023; const float x = r < 8 ? a.in[I_C][r * 1024 + k] : a.in[I_CCTX][k]; sc[i] = x * sigm(x); } __syncthreads(); have = true; }
            const int l = it / 96, jc = it % 96, kg = tid >> 6, jj = tid & 63, j = jc * 64 + jj;
            float acc[9];
#pragma unroll
            for (int r = 0; r < 9; ++r) acc[r] = 0.f;
            const float* wp = a.in[I_MODW] + ((size_t)l * 1024 + kg * 128) * 6144 + j;
            for (int k0 = 0; k0 < 128; k0 += 16) { float w[16];
#pragma unroll
                for (int kk = 0; kk < 16; ++kk) w[kk] = wp[(size_t)(k0 + kk) * 6144];
#pragma unroll
                for (int kk = 0; kk < 16; ++kk)
#pragma unroll
                    for (int r = 0; r < 9; ++r) acc[r] += sc[r * 1024 + kg * 128 + k0 + kk] * w[kk]; }
#pragma unroll
            for (int r = 0; r < 9; ++r) red[(kg * 9 + r) * 64 + jj] = acc[r];
            __syncthreads();
            for (int i = tid; i < 576; i += NTHR) { const int r = i >> 6, j2 = i & 63; float s = a.in[I_MODB][l * 6144 + jc * 64 + j2];
#pragma unroll
                for (int g = 0; g < 8; ++g) s += red[(g * 9 + r) * 64 + j2];
                modv[((size_t)l * 9 + r) * 6144 + jc * 64 + j2] = s; }
            __syncthreads();
        }
        __syncthreads();
    }
    const int gw = B * NWAVES + wave, NGW = G * NWAVES, gt = B * NTHR + tid, NGT = G * NTHR;
    { float* rope = (float*)(ws + WS_ROPE);
      for (int i = gt; i < 4096 * 16; i += NGT) { const int t = i >> 4, p = i & 15; const float pos = (float)(p < 8 ? (t >> 6) : (t & 63));
          const float inv = __powf(10000.0f, -(float)(p & 7) * 0.125f); const float ang = pos * inv; rope[t * 32 + p] = cosf(ang); rope[t * 32 + 16 + p] = sinf(ang); }
      float* bgu = (float*)(ws + WS_BGU);
      for (int i = gt; i < 2 * 32 * 2048; i += NGT) { const int le = i >> 11, np = i & 2047, q = np >> 8, g = (np >> 7) & 1, r = np & 127, f = 128 * q + r; bgu[i] = a.in[I_BGU][(size_t)le * 2048 + 2 * f + g]; }
      float* pb = (float*)(ws + WS_PW1B);
      for (int i = gt; i < 2048; i += NGT) { const int q = i >> 8, g = (i >> 7) & 1, r = i & 127, f = 128 * q + r; pb[i] = a.in[I_PW1B][g * 1024 + f]; }
      v4u* zp = (v4u*)(ws + WS_WIN + (size_t)3232 * 1024 * 2);
      for (int i = gt; i < 96 * 1024 * 2 / 16; i += NGT) zp[i] = (v4u){0u, 0u, 0u, 0u};
    }
    LAS float* scr = (LAS float*)(lds + wave * 16640);
    constexpr int I0 = 16 * 51, I1 = 6 * 12, I2 = 4 * 8, I3 = 4 * 8, I4 = 256, I5 = 512, I6 = 256, SMALL = I0 + I1 + I2 + I3 + I4 + I5 + I6;
    constexpr int NGU = 64 * 512, NDN = 64 * 256, NITEMS = SMALL + NGU + NDN;
    for (int it = gw; it < NITEMS; it += NGW) {
        int r = it;
        if (r < NGU) { const int mi = r >> 9; tr_item(a.in[I_WGU] + (size_t)mi * 1024 * 2048, 1024, 2048, (bf16*)(ws + WS_WGU + (size_t)mi * 2048 * 1024), 1, 0, scr, r & 511, lane, SC_WGU); continue; } r -= NGU;
        if (r < NDN) { const int mi = r >> 8; tr_item(a.in[I_WDN] + (size_t)mi * 1024 * 1024, 1024, 1024, (bf16*)(ws + WS_WDN + (size_t)mi * 1024 * 1024), 0, 0, scr, r & 255, lane, SC_WDN); continue; } r -= NDN;
        if (r < I0) { tr_item(a.in[I_WIN], 1024, 3232, (bf16*)(ws + WS_WIN), 0, 0, scr, r, lane); continue; } r -= I0;
        if (r < I1) { tr_item(a.in[I_WUQ], 384, 768, (bf16*)(ws + WS_WUQ), 0, 0, scr, r, lane); continue; } r -= I1;
        if (r < I2) { tr_item(a.in[I_WUK], 256, 512, (bf16*)(ws + WS_WUKV), 0, 0, scr, r, lane); continue; } r -= I2;
        if (r < I3) { tr_item(a.in[I_WUV], 256, 512, (bf16*)(ws + WS_WUKV), 0, 512, scr, r, lane); continue; } r -= I3;
        if (r < I4) { tr_item(a.in[I_WOUT], 1024, 1024, (bf16*)(ws + WS_WOUT), 0, 0, scr, r, lane); continue; } r -= I4;
        if (r < I5) { tr_item(a.in[I_PW1W], 1024, 2048, (bf16*)(ws + WS_WPW1), 2, 0, scr, r, lane); continue; } r -= I5;
        tr_item(a.in[I_PW2W], 1024, 1024, (bf16*)(ws + WS_WPW2), 0, 0, scr, r, lane);
    }
}

__device__ __forceinline__ void phase_mod0(const Args& a, int lane, int wave) {
    const int gw = blockIdx.x * NWAVES + wave, NGW = gridDim.x * NWAVES;
    const float* modv = (const float*)(a.ws + WS_MODV);
    bf16* X = (bf16*)(a.ws + WS_X);
    for (int r = gw; r < NTOK; r += NGW) {
        const int b = r / TPB, p = r - b * TPB;
        const float* src = p < CTXL ? a.in[I_CTX] + ((size_t)b * CTXL + p) * 1024 : a.in[I_X] + ((size_t)b * SEQ + (p - CTXL)) * 1024;
        const float* mv = modv + (size_t)(p < CTXL ? 8 : b) * 6144;
#pragma unroll
        for (int j = 0; j < 4; ++j) { const int c = 4 * (lane + 64 * j); const f32x4 xv = *(const f32x4*)(src + c), sh = *(const f32x4*)(mv + c), sc = *(const f32x4*)(mv + 1024 + c);
            const f32x4 y = xv * (sc + 1.0f) + sh; v2u o; o.x = pk2(y[0], y[1]); o.y = pk2(y[2], y[3]); *(v2u*)(X + (size_t)r * 1024 + c) = o; }
    }
}

__device__ __forceinline__ void phase_norm0(const Args& a, int lane, int wave) {
    const int gw = blockIdx.x * NWAVES + wave, NGW = gridDim.x * NWAVES;
    const bf16* Z = (const bf16*)(a.ws + WS_Z); bf16* CQN = (bf16*)(a.ws + WS_CQN); bf16* CKVN = (bf16*)(a.ws + WS_CKVN); bf16* KRR = (bf16*)(a.ws + WS_KRR);
    const float* rope = (const float*)(a.ws + WS_ROPE);
    float gq[8], gk[8];
#pragma unroll
    for (int i = 0; i < 8; ++i) { gq[i] = lane < 48 ? a.in[I_QNORM][8 * lane + i] : 0.f; gk[i] = lane < 32 ? a.in[I_KVNORM][8 * lane + i] : 0.f; }
    for (int r = gw; r < NTOK; r += NGW) {
        const bf16* z = Z + (size_t)r * ZC; const int p = r % TPB;
        bf16x8 q8 = {}, k8 = {}, r8 = {};
        if (lane < 48) q8 = *(const bf16x8*)(z + ZQ + 8 * lane);
        if (lane < 32) k8 = *(const bf16x8*)(z + ZKV + 8 * lane);
        if (lane < 4) r8 = *(const bf16x8*)(z + ZKR + 8 * lane);
        float qf[8], kf[8], sq = 0.f, sk = 0.f;
#pragma unroll
        for (int i = 0; i < 8; ++i) { qf[i] = bf2f((unsigned short)q8[i]); kf[i] = bf2f((unsigned short)k8[i]); sq += qf[i] * qf[i]; sk += kf[i] * kf[i]; }
        sq = wave_sum(sq); sk = wave_sum(sk);
        const float rq = rsqrtf(sq * (1.f / 384.f) + RMS_EPS), rk = rsqrtf(sk * (1.f / 256.f) + RMS_EPS);
        if (lane < 48) { v4u o; o.x = pk2(qf[0] * rq * gq[0], qf[1] * rq * gq[1]); o.y = pk2(qf[2] * rq * gq[2], qf[3] * rq * gq[3]); o.z = pk2(qf[4] * rq * gq[4], qf[5] * rq * gq[5]); o.w = pk2(qf[6] * rq * gq[6], qf[7] * rq * gq[7]);
            *(v4u*)(CQN + (size_t)r * 384 + 8 * lane) = o; }
        if (lane < 32) { v4u o; o.x = pk2(kf[0] * rk * gk[0], kf[1] * rk * gk[1]); o.y = pk2(kf[2] * rk * gk[2], kf[3] * rk * gk[3]); o.z = pk2(kf[4] * rk * gk[4], kf[5] * rk * gk[5]); o.w = pk2(kf[6] * rk * gk[6], kf[7] * rk * gk[7]);
            *(v4u*)(CKVN + (size_t)r * 256 + 8 * lane) = o; }
        if (lane < 4) { bf16x8 o8 = r8; if (p >= CTXL) o8 = att::rope8(r8, rope + (size_t)(p - CTXL) * 32, 4 * lane); *(bf16x8*)(KRR + (size_t)r * 32 + 8 * lane) = o8; }
    }
}

__device__ __forceinline__ void hgrn_unit(const Args& a, int unit, LAS unsigned char* lds, int tid) {
    const int b = unit >> 5, head = (unit >> 3) & 3, dir = (unit >> 2) & 1, sl = unit & 3;
    const bf16* Z = (const bf16*)(a.ws + WS_Z);
    float* Od = (float*)(a.ws + (dir ? WS_OB : WS_OF));
    LAS float* lbv = (LAS float*)lds;
    constexpr int BUF0 = 1024, BUFSZ = 28672, OFF_Q = 16384, OFF_V = 24576;
    if (tid < 128) { const int c = head * 128 + tid; const float l0 = a.in[I_LBL][c], l1 = a.in[I_LBL][512 + c], l2 = a.in[I_LBL][1024 + c]; const float m = fmaxf(l0, fmaxf(l1, l2));
        const float e0 = __expf(l0 - m), e1 = __expf(l1 - m), e2 = __expf(l2 - m); lbv[tid] = e0 / (e0 + e1 + e2); }
    __syncthreads();
    const int lt = tid >> 4, lcg = tid & 15;
    float lb8[8];
#pragma unroll
    for (int i = 0; i < 8; ++i) lb8[i] = lbv[8 * lcg + i];
    const int fcol = (dir ? ZHB : ZHF) + head * 128 + 8 * lcg, qcol = ZHQ + head * 128 + 8 * lcg;
    const int vt = tid >> 2, vcol = ZHI + head * 128 + sl * 32 + (tid & 3) * 8;
    const int wave = tid >> 6, lane = tid & 63, vv = lane >> 4, cg = lane & 15, vloc = wave * 4 + vv;
    const size_t zb = (size_t)b * TPB;
    bf16x8 rq, rf, rv;
#define TOKP(n) (dir ? ((n) < CTXL ? (CTXL - 1 - (n)) : (TPB + CTXL - 1 - (n))) : (n))
#define HG_LOAD(i) do { const int n_ = 32 * (i) + lt; const bf16* zr_ = Z + (zb + TOKP(n_)) * ZC; rq = *(const bf16x8*)(zr_ + qcol); rf = *(const bf16x8*)(zr_ + fcol); \
        if (tid < 128) { const int n2_ = 32 * (i) + vt; rv = *(const bf16x8*)(Z + (zb + TOKP(n2_)) * ZC + vcol); } } while (0)
#define HG_WRITE(bufi) do { LAS unsigned char* bp_ = lds + BUF0 + (bufi) * BUFSZ; float f_[8]; \
        _Pragma("unroll") for (int i_ = 0; i_ < 8; ++i_) f_[i_] = lb8[i_] + (1.f - lb8[i_]) * sigm(bf2f((unsigned short)rf[i_])); \
        *(LAS f32x4*)(bp_ + ((lt * 128 + lcg * 4) * 4)) = (f32x4){f_[0], f_[1], f_[2], f_[3]}; *(LAS f32x4*)(bp_ + ((lt * 128 + 64 + lcg * 4) * 4)) = (f32x4){f_[4], f_[5], f_[6], f_[7]}; \
        *(LAS bf16x8*)(bp_ + OFF_Q + (lt * 128 + lcg * 8) * 2) = rq; \
        if (tid < 128) { float v_[8]; _Pragma("unroll") for (int i_ = 0; i_ < 8; ++i_) v_[i_] = bf2f((unsigned short)rv[i_]); \
            *(LAS f32x4*)(bp_ + OFF_V + (vt * 32 + (tid & 3) * 8) * 4) = (f32x4){v_[0], v_[1], v_[2], v_[3]}; *(LAS f32x4*)(bp_ + OFF_V + (vt * 32 + (tid & 3) * 8 + 4) * 4) = (f32x4){v_[4], v_[5], v_[6], v_[7]}; } } while (0)
    float S[8];
#pragma unroll
    for (int j = 0; j < 8; ++j) S[j] = 0.f;
    HG_LOAD(0); HG_WRITE(0); __syncthreads();
    const bool b3 = (cg & 8) != 0, b2 = (cg & 4) != 0, b1 = (cg & 2) != 0, b0 = (cg & 1) != 0;
    for (int i = 0; i < TPB / 32; ++i) {
        if (i + 1 < TPB / 32) HG_LOAD(i + 1);
        const LAS unsigned char* bp = lds + BUF0 + (i & 1) * BUFSZ;
#pragma unroll 1
        for (int g = 0; g < 4; ++g) {
            const LAS unsigned char* gp = bp + g * 8 * 512;
            float ot[8];
#pragma unroll
            for (int t = 0; t < 8; ++t) {
                const f32x4 f0 = *(const LAS f32x4*)(gp + ((t * 128 + cg * 4) * 4)), f1 = *(const LAS f32x4*)(gp + ((t * 128 + 64 + cg * 4) * 4));
                const bf16x8 q8 = *(const LAS bf16x8*)(bp + OFF_Q + ((g * 8 + t) * 128 + cg * 8) * 2);
                const float v = *(const LAS float*)(bp + OFF_V + ((g * 8 + t) * 32 + vloc) * 4);
                float acc = 0.f;
#pragma unroll
                for (int j = 0; j < 8; ++j) { const float fj = j < 4 ? f0[j] : f1[j - 4]; const float qj = bf2f((unsigned short)q8[j]);
                    const float kv = fmaf(-fj, v, v); S[j] = fmaf(fj, S[j], kv); acc = fmaf(S[j], qj, acc); }
                ot[t] = acc;
            }
#pragma unroll
            for (int k = 0; k < 4; ++k) { const float snd = b3 ? ot[k] : ot[k + 4]; const float rcv = __shfl_xor(snd, 8); ot[k] = (b3 ? ot[k + 4] : ot[k]) + rcv; }
#pragma unroll
            for (int k = 0; k < 2; ++k) { const float snd = b2 ? ot[k] : ot[k + 2]; const float rcv = __shfl_xor(snd, 4); ot[k] = (b2 ? ot[k + 2] : ot[k]) + rcv; }
            { const float snd = b1 ? ot[0] : ot[1]; const float rcv = __shfl_xor(snd, 2); ot[0] = (b1 ? ot[1] : ot[0]) + rcv; }
            ot[0] += __shfl_xor(ot[0], 1);
            if (!b0) { const int n = 32 * i + 8 * g + (cg >> 1); const int p = TOKP(n); if (p >= CTXL) Od[(zb + p) * 512 + head * 128 + sl * 32 + vloc] = ot[0]; }
        }
        if (i + 1 < TPB / 32) HG_WRITE((i + 1) & 1);
        __syncthreads();
    }
#undef TOKP
#undef HG_LOAD
#undef HG_WRITE
}

__device__ __forceinline__ void phase_readout(const Args& a, int lane, int wave) {
    const int gw = blockIdx.x * NWAVES + wave, NGW = gridDim.x * NWAVES;
    const float* OF = (const float*)(a.ws + WS_OF); const float* OB = (const float*)(a.ws + WS_OB);
    const bf16* Z = (const bf16*)(a.ws + WS_Z); bf16* MIX = (bf16*)(a.ws + WS_Y);
    float hn[8];
#pragma unroll
    for (int i = 0; i < 8; ++i) hn[i] = a.in[I_HGNORM][((8 * lane) & 127) + i];
    for (int lr = gw; lr < NLAT; lr += NGW) {
        const size_t r = (size_t)grow_of(lr);
        const f32x4 a0 = *(const f32x4*)(OF + r * 512 + 8 * lane), a1 = *(const f32x4*)(OF + r * 512 + 8 * lane + 4);
        const f32x4 c0 = *(const f32x4*)(OB + r * 512 + 8 * lane), c1 = *(const f32x4*)(OB + r * 512 + 8 * lane + 4);
        const bf16x8 g8 = *(const bf16x8*)(Z + r * ZC + ZHG + 8 * lane);
        float o[8]; float ss = 0.f;
#pragma unroll
        for (int i = 0; i < 4; ++i) { o[i] = a0[i] + c0[i]; o[4 + i] = a1[i] + c1[i]; }
#pragma unroll
        for (int i = 0; i < 8; ++i) ss += o[i] * o[i];
        ss += __shfl_xor(ss, 1); ss += __shfl_xor(ss, 2); ss += __shfl_xor(ss, 4); ss += __shfl_xor(ss, 8);
        const float rs = rsqrtf(ss * (1.f / 128.f) + RMS_EPS);
        float y[8];
#pragma unroll
        for (int i = 0; i < 8; ++i) { const float g = bf2f((unsigned short)g8[i]); y[i] = o[i] * rs * hn[i] * (g * sigm(g)); }
        v4u w; w.x = pk2(y[0], y[1]); w.y = pk2(y[2], y[3]); w.z = pk2(y[4], y[5]); w.w = pk2(y[6], y[7]);
        *(v4u*)(MIX + r * 1024 + 512 + 8 * lane) = w;
    }
}

__device__ __forceinline__ int rows_per_block() { const int G = gridDim.x; return (((NLAT + G - 1) / G) + 15) & ~15; }
__device__ __forceinline__ void phase_ln1(const Args& a, int l, LAS unsigned char* lds, int tid, int lane, int wave) {
    const int RB = rows_per_block(), lr_base = blockIdx.x * RB;
    float* H = (float*)(a.ws + WS_H); bf16* XB = (bf16*)(a.ws + WS_X);
    const float* modv = (const float*)(a.ws + WS_MODV) + (size_t)l * 9 * 6144;
    const float* lng = a.in[I_LN1G] + l * 1024; const float* lnb = a.in[I_LN1B] + l * 1024;
    const float* rw = a.in[I_RW] + (size_t)l * 1024 * 32; const float* rb = a.in[I_RB] + l * 32;
    int* topi = (int*)(a.ws + WS_TOPI); float* topw = (float*)(a.ws + WS_TOPW);
    LAS float* rwl = (LAS float*)lds;
    LAS float* lgs = (LAS float*)(lds + 131072) + wave * 64;
    LAS int* hist = (LAS int*)(lds + 131072 + 2048);
    for (int i = tid; i < 8192; i += NTHR) { const int k = i >> 3, q = i & 7; *(LAS f32x4*)(rwl + k * 32 + 4 * (q ^ ((k >> 2) & 7))) = *(const f32x4*)(rw + k * 32 + 4 * q); }
    if (tid < 32) hist[tid] = 0;
    __syncthreads();
    const int sw = lane & 7;
    for (int i = 2 * wave; i < RB; i += 16) {
        const int lr0 = lr_base + i; if (lr0 >= NLAT) break;
        float vv[2][16];
#pragma unroll
        for (int rr = 0; rr < 2; ++rr) {
            const int lr = lr0 + rr; const size_t r = (size_t)grow_of(lr); const int b = lr >> 12;
            const float* mv = modv + (size_t)b * 6144;
            f32x4 x[4]; float s = 0.f;
#pragma unroll
            for (int j = 0; j < 4; ++j) { x[j] = *(const f32x4*)(H + r * 1024 + 4 * (lane + 64 * j)); s += (x[j][0] + x[j][1]) + (x[j][2] + x[j][3]); }
            const float mean = wave_sum(s) * (1.f / 1024.f); float s2 = 0.f;
#pragma unroll
            for (int j = 0; j < 4; ++j) { x[j] = x[j] - mean; s2 += (x[j][0] * x[j][0] + x[j][1] * x[j][1]) + (x[j][2] * x[j][2] + x[j][3] * x[j][3]); }
            const float rstd = rsqrtf(wave_sum(s2) * (1.f / 1024.f) + LN_EPS);
#pragma unroll
            for (int j = 0; j < 4; ++j) { const int c = 4 * (lane + 64 * j); const f32x4 g = *(const f32x4*)(lng + c), bb = *(const f32x4*)(lnb + c);
                const f32x4 hv = x[j] * rstd * g + bb; *(f32x4*)(H + r * 1024 + c) = hv;
                const f32x4 sh = *(const f32x4*)(mv + 3 * 1024 + c), sc = *(const f32x4*)(mv + 4 * 1024 + c);
                const f32x4 bm = hv * (sc + 1.0f) + sh; *(unsigned*)((unsigned char*)XB + r * 1024 + c) = pack_fp8x4(bm[0] * SC_X8, bm[1] * SC_X8, bm[2] * SC_X8, bm[3] * SC_X8);
                vv[rr][4 * j + 0] = bm[0]; vv[rr][4 * j + 1] = bm[1]; vv[rr][4 * j + 2] = bm[2]; vv[rr][4 * j + 3] = bm[3]; }
        }
        float p0[32], p1[32];
#pragma unroll
        for (int e = 0; e < 32; ++e) { p0[e] = 0.f; p1[e] = 0.f; }
#pragma unroll
        for (int j = 0; j < 4; ++j)
#pragma unroll
            for (int e4 = 0; e4 < 4; ++e4) { const int k = 4 * (lane + 64 * j) + e4; const float x0 = vv[0][4 * j + e4], x1 = vv[1][4 * j + e4];
#pragma unroll
                for (int q = 0; q < 8; ++q) { const f32x4 w = *(const LAS f32x4*)(rwl + k * 32 + 4 * (q ^ sw));
#pragma unroll
                    for (int c = 0; c < 4; ++c) { p0[4 * q + c] = fmaf(x0, w[c], p0[4 * q + c]); p1[4 * q + c] = fmaf(x1, w[c], p1[4 * q + c]); } } }
#define RS_STEP(P, NKEEP, BITV, XORV) _Pragma("unroll") for (int k_ = 0; k_ < NKEEP; ++k_) { const float snd_ = (BITV) ? P[k_] : P[k_ + NKEEP]; const float rcv_ = __shfl_xor(snd_, XORV); P[k_] = ((BITV) ? P[k_ + NKEEP] : P[k_]) + rcv_; }
        { const bool c5 = (lane & 32) != 0, c4 = (lane & 16) != 0, c3 = (lane & 8) != 0, c2 = (lane & 4) != 0, c1 = (lane & 2) != 0;
          RS_STEP(p0, 16, c5, 32) RS_STEP(p0, 8, c4, 16) RS_STEP(p0, 4, c3, 8) RS_STEP(p0, 2, c2, 4) RS_STEP(p0, 1, c1, 2)
          RS_STEP(p1, 16, c5, 32) RS_STEP(p1, 8, c4, 16) RS_STEP(p1, 4, c3, 8) RS_STEP(p1, 2, c2, 4) RS_STEP(p1, 1, c1, 2)
          p0[0] += __shfl_xor(p0[0], 1); p1[0] += __shfl_xor(p1[0], 1); }
#undef RS_STEP
        if ((lane & 1) == 0) { lgs[lane >> 1] = p0[0]; lgs[32 + (lane >> 1)] = p1[0]; }
        LDS_WAIT();
#pragma unroll
        for (int rr = 0; rr < 2; ++rr) {
            float lg[32];
#pragma unroll
            for (int q = 0; q < 8; ++q) { const f32x4 t4 = *(const LAS f32x4*)(lgs + rr * 32 + 4 * q); const f32x4 b4 = *(const f32x4*)(rb + 4 * q); lg[4 * q] = t4[0] + b4[0]; lg[4 * q + 1] = t4[1] + b4[1]; lg[4 * q + 2] = t4[2] + b4[2]; lg[4 * q + 3] = t4[3] + b4[3]; }
            unsigned taken = 0u; float tv[4]; int ti[4];
#pragma unroll
            for (int kk = 0; kk < 4; ++kk) { float best = -3.0e38f; int bi = 0;
#pragma unroll
                for (int e = 0; e < 32; ++e) { const bool ok = (lg[e] > best) && !((taken >> e) & 1u); best = ok ? lg[e] : best; bi = ok ? e : bi; }
                taken |= 1u << bi; tv[kk] = best; ti[kk] = bi; }
            const float e1 = __expf(tv[1] - tv[0]), e2 = __expf(tv[2] - tv[0]), e3 = __expf(tv[3] - tv[0]); const float inv = 1.f / (1.f + e1 + e2 + e3);
            if (lane == 0) { const int lr = lr0 + rr;
                *(int4*)(topi + (size_t)lr * 4) = make_int4(ti[0], ti[1], ti[2], ti[3]); *(f32x4*)(topw + (size_t)lr * 4) = (f32x4){inv, e1 * inv, e2 * inv, e3 * inv};
                __hip_atomic_fetch_add(hist + ti[0], 1, __ATOMIC_RELAXED, __HIP_MEMORY_SCOPE_WORKGROUP); __hip_atomic_fetch_add(hist + ti[1], 1, __ATOMIC_RELAXED, __HIP_MEMORY_SCOPE_WORKGROUP);
                __hip_atomic_fetch_add(hist + ti[2], 1, __ATOMIC_RELAXED, __HIP_MEMORY_SCOPE_WORKGROUP); __hip_atomic_fetch_add(hist + ti[3], 1, __ATOMIC_RELAXED, __HIP_MEMORY_SCOPE_WORKGROUP); }
        }
        LDS_WAIT();
    }
    __syncthreads();
    if (tid < 32) ((int*)(a.ws + WS_BCNT))[blockIdx.x * 32 + tid] = hist[tid];
}

__device__ __forceinline__ void phase_place(const Args& a, LAS unsigned char* lds, int tid, int lane, int wave) {
    const int G = gridDim.x, B = blockIdx.x, RB = rows_per_block(), lr_base = B * RB;
    LAS int* tot = (LAS int*)lds; LAS int* pre = tot + 32; LAS int* pstart = tot + 64; LAS int* basee = tot + 128; LAS int* til = tot + 256; LAS int* posl = til + 4096;
    const int* bcnt = (const int*)(a.ws + WS_BCNT);
    int* tile_e = (int*)(a.ws + WS_TILEE); int* meta = (int*)(a.ws + WS_META);
    const int* topi = (const int*)(a.ws + WS_TOPI); const float* topw = (const float*)(a.ws + WS_TOPW);
    float* roww = (float*)(a.ws + WS_ROWW); int* rowd = (int*)(a.ws + WS_ROWD);
    int* rows = (int*)(a.ws + WS_ROWS);
    { const int e = tid & 31, chn = tid >> 5; int t = 0, p = 0;
      for (int bb0 = chn; bb0 < G; bb0 += 64) { int c[4];
#pragma unroll
          for (int q = 0; q < 4; ++q) { const int bb = bb0 + 16 * q; c[q] = bb < G ? ld_ctl(bcnt + bb * 32 + e) : 0; }
#pragma unroll
          for (int q = 0; q < 4; ++q) { const int bb = bb0 + 16 * q; if (bb < B) p += c[q]; t += c[q]; } }
      posl[tid] = t; posl[512 + tid] = p; }
    __syncthreads();
    if (tid < 32) { int t = 0, p = 0;
#pragma unroll
        for (int q = 0; q < 16; ++q) { t += posl[q * 32 + tid]; p += posl[512 + q * 32 + tid]; }
        tot[tid] = t; pre[tid] = p; }
    __syncthreads();
    if (tid == 0) { int ps = 0; for (int e = 0; e < 32; ++e) { pstart[e] = ps; ps += ((tot[e] + 255) >> 8) << 8; } pstart[32] = ps; }
    __syncthreads();
    if (tid < 32) basee[tid] = pstart[tid] + pre[tid];
    const int ntiles = pstart[32] >> 8;
    if (B == 0) { for (int t = tid; t < ntiles; t += NTHR) { int e = 0; while (e < 31 && pstart[e + 1] <= t * 256) ++e; tile_e[t] = e; } if (tid == 0) meta[0] = ntiles; }
    for (int e = B; e < 32; e += G) for (int i = pstart[e] + tot[e] + tid; i < pstart[e + 1]; i += NTHR) { rowd[i] = -1; rows[i] = 0; }
    int nrows = NLAT - lr_base; nrows = nrows > RB ? RB : nrows; if (nrows < 0) nrows = 0;
    const int nas = nrows * 4;
    for (int i = tid; i < nas; i += NTHR) til[i] = topi[(size_t)lr_base * 4 + i];
    __syncthreads();
    if (tid < 32) { int n = basee[tid]; for (int i = 0; i < nas; ++i) if (til[i] == tid) posl[i] = n++; }
    __syncthreads();
    for (int i = tid; i < nas; i += NTHR) { const int lr = lr_base + (i >> 2); const int pos = posl[i]; rows[pos] = grow_of(lr); roww[pos] = topw[(size_t)lr * 4 + (i & 3)]; rowd[pos] = lr * 4 + (i & 3); }
}

__device__ __forceinline__ void phase_ln2(const Args& a, int l, int lane, int wave) {
    const int gw = blockIdx.x * NWAVES + wave, NGW = gridDim.x * NWAVES;
    float* H = (float*)(a.ws + WS_H); const bf16* YB = (const bf16*)(a.ws + WS_YB); bf16* A1 = (bf16*)(a.ws + WS_Y);
    const float* modv = (const float*)(a.ws + WS_MODV);
    const float* lng = a.in[I_LN2G] + l * 1024; const float* lnb = a.in[I_LN2B] + l * 1024;
    for (int lr0 = 2 * gw; lr0 < NLAT; lr0 += 2 * NGW) {
        f32x4 hv[2][4]; v2u yv[2][4][4];
#pragma unroll
        for (int q = 0; q < 2; ++q) { const int lr = lr0 + q; const size_t r = (size_t)grow_of(lr);
#pragma unroll
            for (int j = 0; j < 4; ++j) { const int c = 4 * (lane + 64 * j); hv[q][j] = *(const f32x4*)(H + r * 1024 + c);
#pragma unroll
                for (int k = 0; k < 4; ++k) yv[q][j][k] = *(const v2u*)(YB + ((size_t)lr * 4 + k) * 1024 + c); } }
#pragma unroll
        for (int q = 0; q < 2; ++q) {
            const int lr = lr0 + q; const size_t r = (size_t)grow_of(lr); const int b = lr >> 12;
            const float* mv = modv + ((size_t)l * 9 + b) * 6144; const float* mv1 = modv + ((size_t)9 + b) * 6144;
            f32x4 x[4]; float s = 0.f;
#pragma unroll
            for (int j = 0; j < 4; ++j) { const int c = 4 * (lane + 64 * j); f32x4 f = {0.f, 0.f, 0.f, 0.f};
#pragma unroll
                for (int k = 0; k < 4; ++k) { const v2u y = yv[q][j][k];
                    f[0] += __uint_as_float(y.x << 16); f[1] += __uint_as_float(y.x & 0xffff0000u); f[2] += __uint_as_float(y.y << 16); f[3] += __uint_as_float(y.y & 0xffff0000u); }
                const f32x4 gt = *(const f32x4*)(mv + 5 * 1024 + c);
                x[j] = hv[q][j] * ALPHA + gt * f; s += (x[j][0] + x[j][1]) + (x[j][2] + x[j][3]); }
            const float mean = wave_sum(s) * (1.f / 1024.f); float s2 = 0.f;
#pragma unroll
            for (int j = 0; j < 4; ++j) { x[j] = x[j] - mean; s2 += (x[j][0] * x[j][0] + x[j][1] * x[j][1]) + (x[j][2] * x[j][2] + x[j][3] * x[j][3]); }
            const float rstd = rsqrtf(wave_sum(s2) * (1.f / 1024.f) + LN_EPS);
#pragma unroll
            for (int j = 0; j < 4; ++j) { const int c = 4 * (lane + 64 * j); const f32x4 g = *(const f32x4*)(lng + c), bb = *(const f32x4*)(lnb + c);
                const f32x4 o = x[j] * rstd * g + bb;
                if (l == 0) { *(f32x4*)(H + r * 1024 + c) = o; const f32x4 sh = *(const f32x4*)(mv1 + c), sc = *(const f32x4*)(mv1 + 1024 + c);
                    const f32x4 am = o * (sc + 1.0f) + sh; v2u w; w.x = pk2(am[0], am[1]); w.y = pk2(am[2], am[3]); *(v2u*)(A1 + r * 1024 + c) = w; }
                else *(f32x4*)(a.out + (size_t)lr * 1024 + c) = o; }
        }
    }
}

__device__ __forceinline__ void phase_conv(const Args& a, LAS unsigned char* lds, int tid, int lane, int wave) {
    const bf16* U = (const bf16*)(a.ws + WS_X); bf16* V = (bf16*)(a.ws + WS_Y);
    LAS float* part = (LAS float*)(lds + 126976);
    LAS float* st = part + 512;
    const int c0 = 2 * tid;
    const float db0 = a.in[I_DWB][c0], db1 = a.in[I_DWB][c0 + 1], g0 = a.in[I_CLNG][c0], g1 = a.in[I_CLNG][c0 + 1], be0 = a.in[I_CLNB][c0], be1 = a.in[I_CLNB][c0 + 1];
    for (int tile = blockIdx.x; tile < NLAT / 32; tile += gridDim.x) {
        const int b = tile >> 7, t0 = (tile & 127) * 32;
        const size_t rb0 = (size_t)b * TPB + CTXL;
        __syncthreads();
        for (int i = tid; i < 62 * 128; i += NTHR) { const int row = i >> 7, chk = i & 127, t = t0 - 15 + row;
            v4u val = {0u, 0u, 0u, 0u}; if (t >= 0 && t < SEQ) val = *(const v4u*)(U + (rb0 + t) * 1024 + chk * 8);
            *(LAS v4u*)(lds + row * 2048 + chk * 16) = val; }
        __syncthreads();
        float w0[31], w1[31];
#pragma unroll
        for (int j = 0; j < 31; ++j) { const float2 wv = *(const float2*)(a.in[I_DWW] + j * 1024 + c0); w0[j] = wv.x; w1[j] = wv.y; }
#pragma unroll 1
        for (int hh = 0; hh < 2; ++hh) {
            const LAS unsigned char* hp = lds + hh * 16 * 2048;
            float acc0[16], acc1[16];
#pragma unroll
            for (int t = 0; t < 16; ++t) { acc0[t] = db0; acc1[t] = db1; }
#pragma unroll
            for (int s = 0; s < 46; ++s) { const unsigned pr = *(const LAS unsigned*)(hp + s * 2048 + tid * 4); const float x0 = __uint_as_float(pr << 16), x1 = __uint_as_float(pr & 0xffff0000u);
#pragma unroll
                for (int t = (s > 30 ? s - 30 : 0); t <= (s < 15 ? s : 15); ++t) { acc0[t] = fmaf(x0, w0[s - t], acc0[t]); acc1[t] = fmaf(x1, w1[s - t], acc1[t]); } }
            float rs[32];
#pragma unroll
            for (int t = 0; t < 16; ++t) { rs[2 * t] = acc0[t] + acc1[t]; rs[2 * t + 1] = acc0[t] * acc0[t] + acc1[t] * acc1[t]; }
#define RS_STEP(NKEEP, XORV) { const bool bit_ = (lane & XORV) != 0; _Pragma("unroll") for (int k_ = 0; k_ < NKEEP; ++k_) { const float snd_ = bit_ ? rs[k_] : rs[k_ + NKEEP]; const float rcv_ = __shfl_xor(snd_, XORV); rs[k_] = (bit_ ? rs[k_ + NKEEP] : rs[k_]) + rcv_; } }
            RS_STEP(16, 32) RS_STEP(8, 16) RS_STEP(4, 8) RS_STEP(2, 4) RS_STEP(1, 2)
#undef RS_STEP
            rs[0] += __shfl_xor(rs[0], 1);
            __syncthreads();
            if ((lane & 1) == 0) part[wave * 32 + (lane >> 1)] = rs[0];
            __syncthreads();
            if (tid < 16) { float s1 = 0.f, s2 = 0.f;
#pragma unroll
                for (int w = 0; w < 8; ++w) { s1 += part[w * 32 + 2 * tid]; s2 += part[w * 32 + 2 * tid + 1]; }
                const float mean = s1 * (1.f / 1024.f); const float var = fmaxf(s2 * (1.f / 1024.f) - mean * mean, 0.f); st[2 * tid] = mean; st[2 * tid + 1] = rsqrtf(var + LN_EPS); }
            __syncthreads();
#pragma unroll
            for (int t = 0; t < 16; ++t) { const float mean = st[2 * t], rstd = st[2 * t + 1];
                const float y0 = (acc0[t] - mean) * rstd * g0 + be0, y1 = (acc1[t] - mean) * rstd * g1 + be1;
                *(unsigned*)(V + (rb0 + t0 + hh * 16 + t) * 1024 + c0) = pk2(y0 * sigm(y0), y1 * sigm(y1)); }
        }
    }
}

namespace hg {
using bf16x8 = __attribute__((ext_vector_type(8))) short;
using s16x4  = __attribute__((ext_vector_type(4))) short;
using f32x16 = __attribute__((ext_vector_type(16))) float;
using u32x4  = __attribute__((ext_vector_type(4))) unsigned;
constexpr int RS = 272;
constexpr int VS = 80;
constexpr int T_Q = 0, T_KO = 32 * RS, T_KE = 64 * RS, T_D = 96 * RS, IMG_BYTES = T_D + 512, T_V = IMG_BYTES, TILE_BYTES = T_V + 32 * VS;
constexpr int OFF_TILES = 1024, NTB = 3, OFF_OPART = OFF_TILES + NTB * TILE_BYTES, OPART_BYTES = 4 * 4096;
static_assert(OFF_OPART + 2 * OPART_BYTES <= 131072 && IMG_BYTES % 16 == 0 && IMG_BYTES / 16 == 1664, "hgrn lds");
constexpr int P_RAW = 1024, R_Q = 0, R_F = 32 * RS, RAW_BYTES = 64 * RS, P_IMG = P_RAW + RAW_BYTES;
constexpr int NCHUNK = TPB / 32, NCHAIN = NB * 4 * 2, NITEM = NCHAIN * NCHUNK;
__device__ __forceinline__ int crow(int r, int hi) { return (r & 3) + 8 * (r >> 2) + 4 * hi; }
__device__ __forceinline__ s16x4 tr_read(unsigned addr) { s16x4 r; asm volatile("ds_read_b64_tr_b16 %0, %1" : "=&v"(r) : "v"(addr) : "memory"); return r; }
__device__ __forceinline__ bf16x8 cat8(s16x4 l, s16x4 h) { return (bf16x8){l[0], l[1], l[2], l[3], h[0], h[1], h[2], h[3]}; }
__device__ __forceinline__ bf16x8 pack8(const f32x16& x, int base) {
    u32x4 w; w[0] = pk2(x[base + 0], x[base + 1]); w[1] = pk2(x[base + 2], x[base + 3]); w[2] = pk2(x[base + 4], x[base + 5]); w[3] = pk2(x[base + 6], x[base + 7]);
    return *reinterpret_cast<bf16x8*>(&w);
}
}


#define HG_TOKP(dir, n) ((dir) ? ((n) < CTXL ? (CTXL - 1 - (n)) : (TPB + CTXL - 1 - (n))) : (n))
#define HG_DPP(x, ctrl, rmask) __int_as_float(__builtin_amdgcn_update_dpp(0, __float_as_int(x), ctrl, rmask, 0xf, false))
__device__ __forceinline__ void hgrn_prep_items(const Args& a, LAS unsigned char* lds, int tid) {
    using namespace hg;
    const bf16* Z = (const bf16*)(a.ws + WS_Z);
    unsigned char* HT = a.ws + WS_HT;
    const int wave = __builtin_amdgcn_readfirstlane(tid >> 6), lane = tid & 63, t = lane & 31, half = lane >> 5;
    const int c0 = 16 * wave + 8 * half;
    const int lr = tid >> 4, lch = tid & 15;
    LAS float* lbt = (LAS float*)lds;
    constexpr int P_RAW2 = 2048, P_IMG2 = P_RAW2 + 2 * RAW_BYTES;
    static_assert(P_IMG2 + 2 * IMG_BYTES <= 131072, "prep lds");
    __syncthreads();
    { const float l0 = a.in[I_LBL][tid], l1 = a.in[I_LBL][512 + tid], l2 = a.in[I_LBL][1024 + tid]; const float m = fmaxf(l0, fmaxf(l1, l2));
      const float e0 = __expf(l0 - m), e1 = __expf(l1 - m), e2 = __expf(l2 - m); lbt[tid] = e0 / (e0 + e1 + e2); }
    bf16x8 gq, gf;
#define HP_LOAD(it) do { const int ch_ = (it) % NCHUNK, cn_ = (it) / NCHUNK, dir_ = cn_ & 1, hd_ = (cn_ >> 1) & 3, b_ = cn_ >> 3; \
        const bf16* zr_ = Z + ((size_t)b_ * TPB + HG_TOKP(dir_, 32 * ch_ + lr)) * ZC; gq = *(const bf16x8*)(zr_ + ZHQ + hd_ * 128 + lch * 8); gf = *(const bf16x8*)(zr_ + (dir_ ? ZHB : ZHF) + hd_ * 128 + lch * 8); } while (0)
#define HP_STASH(bufi) do { LAS unsigned char* rb_ = lds + P_RAW2 + (bufi) * RAW_BYTES; *(LAS bf16x8*)(rb_ + R_Q + lr * RS + lch * 16) = gq; *(LAS bf16x8*)(rb_ + R_F + lr * RS + lch * 16) = gf; } while (0)
#define HP_COPYOUT(item, bufi) do { v4u* dst_ = (v4u*)(HT + (size_t)(item) * IMG_BYTES); const LAS v4u* src_ = (const LAS v4u*)(lds + P_IMG2 + (bufi) * IMG_BYTES); \
        dst_[tid] = src_[tid]; dst_[tid + 512] = src_[tid + 512]; dst_[tid + 1024] = src_[tid + 1024]; if (tid < 128) dst_[tid + 1536] = src_[tid + 1536]; } while (0)
    const int G = gridDim.x;
    int it = blockIdx.x, par = 0;
    if (it < NITEM) { HP_LOAD(it); HP_STASH(0); }
    if (it + G < NITEM) HP_LOAD(it + G);
    __syncthreads();
    for (; it < NITEM; it += G, par ^= 1) {
        if (it + G < NITEM) HP_STASH(par ^ 1);
        if (it != (int)blockIdx.x) HP_COPYOUT(it - G, par ^ 1);
        if (it + 2 * G < NITEM) HP_LOAD(it + 2 * G);
        const int hd = ((it / NCHUNK) >> 1) & 3;
        {
            const LAS unsigned char* rb_ = lds + P_RAW2 + par * RAW_BYTES;
            const bf16x8 RQ = *(const LAS bf16x8*)(rb_ + R_Q + t * RS + c0 * 2), RF = *(const LAS bf16x8*)(rb_ + R_F + t * RS + c0 * 2);
            const f32x4 lbA = *(const LAS f32x4*)(lbt + hd * 128 + c0), lbB = *(const LAS f32x4*)(lbt + hd * 128 + c0 + 4);
            LAS unsigned char* tb_ = lds + P_IMG2 + par * IMG_BYTES;
            float bb_[8], kk_[8];
#pragma unroll
            for (int i_ = 0; i_ < 8; ++i_) { const float lb_ = i_ < 4 ? lbA[i_] : lbB[i_ - 4]; const float f_ = lb_ + (1.f - lb_) * __builtin_amdgcn_rcpf(1.f + __expf(-bf2f((unsigned short)RF[i_]))); kk_[i_] = 1.f - f_; bb_[i_] = __logf(f_); }
#pragma unroll
            for (int i_ = 0; i_ < 8; ++i_) { float x_ = bb_[i_]; x_ += HG_DPP(x_, 0x111, 0xf); x_ += HG_DPP(x_, 0x112, 0xf); x_ += HG_DPP(x_, 0x114, 0xf); x_ += HG_DPP(x_, 0x118, 0xf);
                x_ += HG_DPP(x_, 0x142, 0xa); bb_[i_] = x_; }
            float qi_[8], ko_[8], ke_[8], dd_[8];
#pragma unroll
            for (int i_ = 0; i_ < 8; ++i_) { const int bi_ = __float_as_int(bb_[i_]); const float be_ = __int_as_float(half ? __builtin_amdgcn_readlane(bi_, 63) : __builtin_amdgcn_readlane(bi_, 31));
                const float e_ = __expf(bb_[i_]); const float ei_ = __builtin_amdgcn_rcpf(e_); dd_[i_] = __expf(be_);
                qi_[i_] = bf2f((unsigned short)RQ[i_]) * e_; ko_[i_] = kk_[i_] * ei_; ke_[i_] = kk_[i_] * (dd_[i_] * ei_); }
            *(LAS v4u*)(tb_ + T_Q + t * RS + c0 * 2) = (v4u){pk2(qi_[0], qi_[1]), pk2(qi_[2], qi_[3]), pk2(qi_[4], qi_[5]), pk2(qi_[6], qi_[7])};
            *(LAS v4u*)(tb_ + T_KO + t * RS + c0 * 2) = (v4u){pk2(ko_[0], ko_[1]), pk2(ko_[2], ko_[3]), pk2(ko_[4], ko_[5]), pk2(ko_[6], ko_[7])};
            *(LAS v4u*)(tb_ + T_KE + t * RS + c0 * 2) = (v4u){pk2(ke_[0], ke_[1]), pk2(ke_[2], ke_[3]), pk2(ke_[4], ke_[5]), pk2(ke_[6], ke_[7])};
            if (t == 31) { *(LAS f32x4*)(tb_ + T_D + c0 * 4) = (f32x4){dd_[0], dd_[1], dd_[2], dd_[3]}; *(LAS f32x4*)(tb_ + T_D + c0 * 4 + 16) = (f32x4){dd_[4], dd_[5], dd_[6], dd_[7]}; }
            if (tid < 32) *(LAS v4u*)(tb_ + T_Q + tid * RS + 256) = (v4u){0u, 0u, 0u, 0u};
            else if (tid < 64) *(LAS v4u*)(tb_ + T_KO + (tid - 32) * RS + 256) = (v4u){0u, 0u, 0u, 0u};
            else if (tid < 96) *(LAS v4u*)(tb_ + T_KE + (tid - 64) * RS + 256) = (v4u){0u, 0u, 0u, 0u};
        }
        __syncthreads();
    }
    if (it - G >= (int)blockIdx.x && it - G < NITEM) HP_COPYOUT(it - G, par ^ 1);
    __syncthreads();
#undef HP_COPYOUT
#undef HP_LOAD
#undef HP_STASH
}

__device__ __forceinline__ void hgrn_unit_mfma(const Args& a, int unit, LAS unsigned char* lds, int tid) {
    using namespace hg;
    const int b = unit >> 5, head = (unit >> 3) & 3, dir = (unit >> 2) & 1, sl = unit & 3;
    const bf16* Z = (const bf16*)(a.ws + WS_Z);
    const unsigned char* HT = a.ws + WS_HT + (size_t)((b * 4 + head) * 2 + dir) * NCHUNK * IMG_BYTES;
    float* Od = (float*)(a.ws + (dir ? WS_OB : WS_OF));
    const int wave = __builtin_amdgcn_readfirstlane(tid >> 6), lane = tid & 63;
    const size_t zb = (size_t)b * TPB;
    constexpr int NCH = NCHUNK;
    const int vr = (tid >> 2) & 31, vp = tid & 3, lvcol = ZHI + head * 128 + sl * 32 + vp * 8, i3 = 1536 + (tid & 127);
    v4u gA0, gA1, gA2, gA3, gB0, gB1, gB2, gB3; bf16x8 gAv, gBv;
#define HG_LOAD(g0, g1, g2, g3, gv, ch) do { const int c_ = (ch) < NCH ? (ch) : NCH - 1; const v4u* src_ = (const v4u*)(HT + (size_t)c_ * IMG_BYTES); \
        g0 = src_[tid]; g1 = src_[tid + 512]; g2 = src_[tid + 1024]; g3 = src_[i3]; gv = *(const bf16x8*)(Z + (zb + HG_TOKP(dir, 32 * c_ + vr)) * ZC + lvcol); } while (0)
#define HG_STASH(g0, g1, g2, g3, gv, bufi) do { LAS unsigned char* tb_ = lds + OFF_TILES + (bufi) * TILE_BYTES; LAS v4u* d_ = (LAS v4u*)tb_; \
        d_[tid] = g0; d_[tid + 512] = g1; d_[tid + 1024] = g2; if (tid < 128) { d_[tid + 1536] = g3; *(LAS bf16x8*)(tb_ + T_V + vr * VS + vp * 16) = gv; } } while (0)
    const int r32 = lane & 31, hi = lane >> 5, g1 = (lane >> 4) & 1, q4 = (lane & 15) >> 2, p4 = lane & 3, cb = 32 * wave;
    const unsigned lbase = (unsigned)(uintptr_t)lds;
    f32x16 S = {};
    HG_LOAD(gA0, gA1, gA2, gA3, gAv, 0); HG_STASH(gA0, gA1, gA2, gA3, gAv, 0); HG_LOAD(gA0, gA1, gA2, gA3, gAv, 1); HG_STASH(gA0, gA1, gA2, gA3, gAv, 1);
    HG_LOAD(gA0, gA1, gA2, gA3, gAv, 2);
    __syncthreads();
#define HG_RD64(dst, addr, OFFS) asm volatile("ds_read_b64 %0, %1 offset:" #OFFS : "=&v"(dst) : "v"(addr) : "memory")
#define HG_MFMA_STAGE(n, bufi) do { \
            const unsigned tb = lbase + OFF_TILES + (bufi) * TILE_BYTES; const LAS unsigned char* tl_ = lds + OFF_TILES + (bufi) * TILE_BYTES; \
            bf16x8 ko[2], qi[2]; s16x4 pvl[2], pvh[2], pql[2], pqh[2], kl[2], kh[2], nvl[2], nvh[2]; f32x4 dsc[4]; \
            _Pragma("unroll") for (int kk = 0; kk < 2; ++kk) { ko[kk] = *(const LAS bf16x8*)(tl_ + T_KO + r32 * RS + (cb + 16 * kk + 8 * hi) * 2); qi[kk] = *(const LAS bf16x8*)(tl_ + T_Q + r32 * RS + (cb + 16 * kk + 8 * hi) * 2); } \
            _Pragma("unroll") for (int sp = 0; sp < 2; ++sp) { \
                const unsigned va = tb + T_V + (16 * sp + 4 * hi + q4) * VS + (16 * g1 + 4 * p4) * 2; pvl[sp] = tr_read(va); pvh[sp] = tr_read(va + 8 * VS);              \
                const unsigned qa = tb + T_Q + r32 * RS + (cb + 16 * sp + 4 * hi) * 2; HG_RD64(pql[sp], qa, 0); HG_RD64(pqh[sp], qa, 16);                                  \
                const unsigned ka = tb + T_KE + (16 * sp + 8 * hi + q4) * RS + (cb + 16 * g1 + 4 * p4) * 2; kl[sp] = tr_read(ka); kh[sp] = tr_read(ka + 4 * RS);        \
                const unsigned vb = tb + T_V + (16 * sp + 8 * hi + q4) * VS + (16 * g1 + 4 * p4) * 2; nvl[sp] = tr_read(vb); nvh[sp] = tr_read(vb + 4 * VS); }            \
            _Pragma("unroll") for (int g = 0; g < 4; ++g) dsc[g] = *(const LAS f32x4*)(tl_ + T_D + (cb + 8 * g + 4 * hi) * 4); \
            asm volatile("s_waitcnt lgkmcnt(0)" ::: "memory"); __builtin_amdgcn_sched_barrier(0); \
            f32x16 X = {}; \
            X = __builtin_amdgcn_mfma_f32_32x32x16_bf16(ko[0], qi[0], X, 0, 0, 0); X = __builtin_amdgcn_mfma_f32_32x32x16_bf16(ko[1], qi[1], X, 0, 0, 0); \
            f32x16 O = {}; \
            O = __builtin_amdgcn_mfma_f32_32x32x16_bf16(cat8(pql[0], pqh[0]), pack8(S, 0), O, 0, 0, 0); O = __builtin_amdgcn_mfma_f32_32x32x16_bf16(cat8(pql[1], pqh[1]), pack8(S, 8), O, 0, 0, 0); \
            _Pragma("unroll") for (int i = 0; i < 16; ++i) S[i] *= dsc[i >> 2][i & 3]; \
            S = __builtin_amdgcn_mfma_f32_32x32x16_bf16(cat8(kl[0], kh[0]), cat8(nvl[0], nvh[0]), S, 0, 0, 0); S = __builtin_amdgcn_mfma_f32_32x32x16_bf16(cat8(kl[1], kh[1]), cat8(nvl[1], nvh[1]), S, 0, 0, 0); \
            _Pragma("unroll") for (int i = 0; i < 16; ++i) X[i] = (crow(i, hi) <= r32) ? X[i] : 0.f; \
            O = __builtin_amdgcn_mfma_f32_32x32x16_bf16(pack8(X, 0), cat8(pvl[0], pvh[0]), O, 0, 0, 0); O = __builtin_amdgcn_mfma_f32_32x32x16_bf16(pack8(X, 8), cat8(pvl[1], pvh[1]), O, 0, 0, 0); \
            LAS float* op = (LAS float*)(lds + OFF_OPART + ((n) & 1) * OPART_BYTES + wave * 4096); \
            _Pragma("unroll") for (int i = 0; i < 16; ++i) op[crow(i, hi) * 32 + r32] = O[i]; } while (0)
#define HG_OUT_STAGE(n) do { \
            const int l2 = tid - 256, tt = l2 >> 3, vq = l2 & 7; \
            const LAS float* op = (const LAS float*)(lds + OFF_OPART + (((n) - 1) & 1) * OPART_BYTES) + tt * 32 + vq * 4; \
            const f32x4 s = (*(const LAS f32x4*)op + *(const LAS f32x4*)(op + 1024)) + (*(const LAS f32x4*)(op + 2048) + *(const LAS f32x4*)(op + 3072)); \
            const int p = HG_TOKP(dir, 32 * ((n) - 1) + tt); \
            if (p >= CTXL) *(f32x4*)(Od + (zb + p) * 512 + head * 128 + sl * 32 + vq * 4) = s; } while (0)
#define HG_ITER(n, L0, L1, L2, L3, LV, S0, S1, S2, S3, SV) do { \
        HG_LOAD(L0, L1, L2, L3, LV, (n) + 3); \
        if (wave < 4) { HG_MFMA_STAGE(n, bcur); } else if ((n) > 0) { HG_OUT_STAGE(n); } \
        { const int bst_ = bcur == 0 ? 2 : bcur - 1; HG_STASH(S0, S1, S2, S3, SV, bst_); } \
        bcur = bcur == 2 ? 0 : bcur + 1; \
        __syncthreads(); } while (0)
    int bcur = 0;
    for (int n = 0; n < NCH; n += 2) {
        HG_ITER(n, gB0, gB1, gB2, gB3, gBv, gA0, gA1, gA2, gA3, gAv);
        HG_ITER(n + 1, gA0, gA1, gA2, gA3, gAv, gB0, gB1, gB2, gB3, gBv);
    }
    if (wave >= 4) { HG_OUT_STAGE(NCH); }
    __syncthreads();
#undef HG_MFMA_STAGE
#undef HG_OUT_STAGE
#undef HG_ITER
#undef HG_LOAD
#undef HG_STASH
#undef HG_RD64
}

__device__ __forceinline__ bool in_range(int lo, int hi, int k) { asm volatile("" : "+s"(lo), "+s"(hi)); return lo <= k && k < hi; }
constexpr int NPHASES = 21;
__global__ void __launch_bounds__(NTHR, 2) fwd_kernel(Args args) {
    extern __shared__ __attribute__((aligned(16))) unsigned char lds_raw[];
    LAS unsigned char* lds = (LAS unsigned char*)lds_raw;
    const int G = gridDim.x;
#define FRESH() int tid = threadIdx.x; asm volatile("" : "+v"(tid)); const int lane = tid & 63, wave = __builtin_amdgcn_readfirstlane(tid >> 6); (void)lane; (void)wave
    unsigned char* ws = args.ws;
    if (threadIdx.x < 16) ((LAS unsigned*)(lds + LDS_BAR_OFF))[threadIdx.x] = 0u;
    __syncthreads();
    XcdBarrier bar = xcd_barrier_post((unsigned*)(ws + WS_CTL), (volatile LAS unsigned*)(lds + LDS_BAR_OFF));
    const int lo = args.ph_lo, hi = args.ph_hi;
#define IN(k) in_range(lo, hi, (k))
#define NREP(k) (((PROBE_MASK >> (k)) & 1u) ? 2 : 1)
#define REPEAT(k) for (int rep_ = 0; rep_ < NREP(k); ++rep_) if (rep_ == 0 || (xcd_barrier(bar), true))
#define SEAM(k) do { if (IN(k) && IN((k) + 1)) xcd_barrier(bar); } while (0)
    bf16* const BX = (bf16*)(ws + WS_X); bf16* const BY = (bf16*)(ws + WS_Y);
    const float* const MODV = (const float*)(ws + WS_MODV);

    if (IN(0)) REPEAT(0) { FRESH(); phase_prologue(args, lds, tid, lane, wave); } SEAM(0);
    if (IN(1)) REPEAT(1) { FRESH(); phase_mod0(args, lane, wave); } SEAM(1);
    if (IN(2)) REPEAT(2) {
        pg8::Gemm g{BX, (const bf16*)(ws + WS_WIN), NTOK, ZC, 1024}; pg8::AllOrder S; S.init(NTOK / 256, ZC / 256, G, (int)blockIdx.x);
        pg8::EpiBf16<0> E{(bf16*)(ws + WS_Z), ZC, nullptr, 0, 0, 1.f};
        pg8::gemm_phase<pg8::EpiBf16<0>, pg8::AllOrder, PG8_ALIGN, PG8_SP2>(lds, g, S, E);
    } SEAM(2);
    if (IN(3)) REPEAT(3) { FRESH(); phase_norm0(args, lane, wave); hgrn_prep_items(args, lds, tid); } SEAM(3);
    if (IN(4)) REPEAT(4) {
        { pg8::Gemm g{(const bf16*)(ws + WS_CQN), (const bf16*)(ws + WS_WUQ), NTOK, 768, 384}; pg8::LatOrder S; S.init(128, 3, G, (int)blockIdx.x);
          pg8::EpiBf16<0> E{(bf16*)(ws + WS_Q), 768, nullptr, 0, 0, 1.f};
          pg8::gemm_phase<pg8::EpiBf16<0>, pg8::LatOrder, PG8_ALIGN, PG8_SP2>(lds, g, S, E); }
        __syncthreads();
        { pg8::Gemm g{(const bf16*)(ws + WS_CKVN), (const bf16*)(ws + WS_WUKV), NTOK, 1024, 256}; pg8::AllOrder S; S.init(NTOK / 256, 4, G, (int)blockIdx.x);
          pg8::EpiBf16<0> E{(bf16*)(ws + WS_KV), 1024, nullptr, 0, 0, 1.f};
          pg8::gemm_phase<pg8::EpiBf16<0>, pg8::AllOrder, PG8_ALIGN, PG8_SP2>(lds, g, S, E); }
    } SEAM(4);
    if (IN(5)) {
        REPEAT(21) { FRESH();
        for (int u = blockIdx.x; u < 256; u += G) { __syncthreads(); hgrn_unit_mfma(args, (G == 256) ? ((u & 7) * 32 + (u >> 3)) : u, lds, tid); } }
        const bf16* Q = (const bf16*)(ws + WS_Q); const bf16* KV = (const bf16*)(ws + WS_KV); const bf16* KRR = (const bf16*)(ws + WS_KRR);
        const float* rope = (const float*)(ws + WS_ROPE);
        REPEAT(22) for (int u = blockIdx.x; u < 1024; u += G) {
            const int b = u >> 7, h = (u >> 4) & 7, qb = u & 15;
            const size_t kb = (size_t)b * TPB, q0 = kb + CTXL + (size_t)qb * 256;
            __syncthreads();
            att::attn_unit(Q + q0 * 768 + h * 96, KV + kb * 1024 + h * 64, KRR + kb * 32, BY + q0 * 1024 + h * 64, rope + (size_t)qb * 256 * 32, TPB, (char*)lds_raw);
        }
    } SEAM(5);
    if (IN(6)) REPEAT(6) { FRESH(); phase_readout(args, lane, wave); } SEAM(6);
    if (IN(7)) REPEAT(7) {
        pg8::Gemm g{BY, (const bf16*)(ws + WS_WOUT), NTOK, 1024, 1024}; pg8::LatOrder S; S.init(128, 4, G, (int)blockIdx.x);
        pg8::EpiRes E{args.in[I_X], (float*)(ws + WS_H), MODV, nullptr};
        pg8::gemm_phase<pg8::EpiRes, pg8::LatOrder, PG8_ALIGN, PG8_SP2>(lds, g, S, E);
    } SEAM(7);
    for (int l = 0; l < 2; ++l) {
        if (l == 1) {
            if (IN(13)) REPEAT(13) {
                pg8::Gemm g{BY, (const bf16*)(ws + WS_WPW1), NTOK, 2048, 1024}; pg8::LatOrder S; S.init(128, 8, G, (int)blockIdx.x);
                pg8::EpiGate<0> E{BX, (const float*)(ws + WS_PW1B), 8, 1.f, 1.f};
                pg8::gemm_phase<pg8::EpiGate<0>, pg8::LatOrder, PG8_ALIGN, PG8_SP2>(lds, g, S, E);
            } SEAM(13);
            if (IN(14)) REPEAT(14) { FRESH(); phase_conv(args, lds, tid, lane, wave); } SEAM(14);
            if (IN(15)) REPEAT(15) {
                pg8::Gemm g{BY, (const bf16*)(ws + WS_WPW2), NTOK, 1024, 1024}; pg8::LatOrder S; S.init(128, 4, G, (int)blockIdx.x);
                pg8::EpiRes E{nullptr, (float*)(ws + WS_H), MODV + 9 * 6144, args.in[I_PW2B]};
                pg8::gemm_phase<pg8::EpiRes, pg8::LatOrder, PG8_ALIGN, PG8_SP2>(lds, g, S, E);
            } SEAM(15);
        }
        const int pb = l ? 16 : 8;
        if (IN(pb)) REPEAT(pb) { FRESH(); phase_ln1(args, l, lds, tid, lane, wave); } SEAM(pb);
        if (IN(pb + 1)) REPEAT(pb + 1) { FRESH(); phase_place(args, lds, tid, lane, wave); } SEAM(pb + 1);
        if (IN(pb + 2) || IN(pb + 3)) {
            LAS int* tl = (LAS int*)(lds + LDS_TILE_E);
            FRESH();
            __syncthreads();
            const int ntiles = ld_ctl((const int*)(ws + WS_META));
            for (int t = tid; t < ntiles && t < MAXTILES; t += NTHR) tl[t] = ld_ctl((const int*)(ws + WS_TILEE) + t);
            __syncthreads();
            if (IN(pb + 2)) REPEAT(pb + 2) {
                pg8::Gemm g{BX, (const bf16*)(ws + WS_WGU + (size_t)l * 32 * 2048 * 1024), 0, 0, 512};
                pg8::MoeOrder S; S.init(ntiles, 8, G, (int)blockIdx.x); S.tile_e = tl; S.nper = 8;
                pg8::EpiGate<1, true> E{(bf16*)(ws + WS_ACT), (const float*)(ws + WS_BGU) + (size_t)l * 32 * 2048, 8, 1.f / (SC_X8 * SC_WGU), SC_ACT};
                pg8::gemm_phase<pg8::EpiGate<1, true>, pg8::MoeOrder, PG8_ALIGN, true, true, true>(lds, g, S, E, (const int*)(ws + WS_ROWS));
            } SEAM(pb + 2);
            if (IN(pb + 3)) REPEAT(pb + 3) {
                pg8::Gemm g{(const bf16*)(ws + WS_ACT), (const bf16*)(ws + WS_WDN + (size_t)l * 32 * 1024 * 1024), 0, 0, 512};
                pg8::MoeOrder S; S.init(ntiles, 4, G, (int)blockIdx.x); S.tile_e = tl; S.nper = 4;
                pg8::EpiDown E{(bf16*)(ws + WS_YB), args.in[I_BDN] + (size_t)l * 32 * 1024, (const float*)(ws + WS_ROWW), (const int*)(ws + WS_ROWD), 1.f / (SC_ACT * SC_WDN)};
                pg8::gemm_phase<pg8::EpiDown, pg8::MoeOrder, PG8_ALIGN, true, false, true>(lds, g, S, E);
            } SEAM(pb + 3);
        }
        if (IN(pb + 4)) REPEAT(pb + 4) { FRESH(); phase_ln2(args, l, lane, wave); }
        if (l == 0) SEAM(12);
    }
#undef IN
#undef SEAM
}

extern "C" void kernel_launch(void* const* d_in, const int* in_sizes, int n_in, void* d_out, int out_size, void* d_ws, size_t ws_size, hipStream_t stream) {
    static int grid = 0;
    if (grid == 0) {
        if (n_in != 33 || in_sizes[0] != NB * SEQ * D || out_size != NB * SEQ * D || ws_size < WS_END) {
            fprintf(stderr, "kernel_launch: unexpected shapes: n_in %d in0 %d out %d ws %zu (need %zu)\n", n_in, n_in > 0 ? in_sizes[0] : -1, out_size, ws_size, (size_t)WS_END); grid = -1; return; }
        int dev = 0, cus = 0;
        if (hipGetDevice(&dev) != hipSuccess || hipDeviceGetAttribute(&cus, hipDeviceAttributeMultiprocessorCount, dev) != hipSuccess) { grid = -1; return; }
        if (hipFuncSetAttribute((const void*)fwd_kernel, hipFuncAttributeMaxDynamicSharedMemorySize, LDS_BYTES) != hipSuccess) { fprintf(stderr, "kernel_launch: hipFuncSetAttribute failed\n"); grid = -1; return; }
        int per_cu = 0;
        if (hipOccupancyMaxActiveBlocksPerMultiprocessor(&per_cu, (const void*)fwd_kernel, NTHR, LDS_BYTES) != hipSuccess || per_cu < 1) fprintf(stderr, "kernel_launch: occupancy query reports %d\n", per_cu);
        (void)hipGetLastError();
        grid = cus;
    }
    if (grid < 0) return;
    if (hipMemsetAsync((char*)d_ws + WS_CTL, 0, CTL_ZERO_BYTES, stream) != hipSuccess) return;
    Args a{};
    for (int i = 0; i < 33; ++i) a.in[i] = (const float*)d_in[i];
    a.out = (float*)d_out; a.ws = (unsigned char*)d_ws;
#if MK_ONE_LAUNCH
    a.ph_lo = 0; a.ph_hi = NPHASES;
    hipLaunchKernelGGL(fwd_kernel, dim3(grid), dim3(NTHR), LDS_BYTES, stream, a);
#else
    for (int ph = 0; ph < NPHASES; ++ph) { a.ph_lo = ph; a.ph_hi = ph + 1; hipLaunchKernelGGL(fwd_kernel, dim3(grid), dim3(NTHR), LDS_BYTES, stream, a); }
#endif
    const hipError_t le = hipPeekAtLastError();
    if (le != hipSuccess) fprintf(stderr, "kernel_launch: launch failed: %s\n", hipGetErrorName(le));
}
```

```cpp
#include <hip/hip_runtime.h>
#include <cstdio>
#include <cstdint>

#ifndef PROBE_MASK
#define PROBE_MASK 0u
#endif
#ifndef MK_ONE_LAUNCH
#define MK_ONE_LAUNCH 1
#endif

namespace pg8 {
#define PG8_LAS __attribute__((address_space(3)))
typedef unsigned short bf16_t;
typedef short bf16x8 __attribute__((ext_vector_type(8)));
typedef float f32x4 __attribute__((ext_vector_type(4)));
typedef unsigned u32x4 __attribute__((ext_vector_type(4)));
constexpr int BM = 256, BK = 64, HALF = 128, HTB = HALF * BK * 2  , STAGE_BYTES = 8 * HTB, NXCD = 8, WGM = 8;

__host__ __device__ __forceinline__ int lds_byte(int r, int c) { const int st = (r >> 4) * 2 + (c >> 5), rr = r & 15, cc = c & 31, ob = rr * 64 + cc * 2; return st * 1024 + (ob ^ (((ob >> 9) & 1) << 5)); }
__host__ __device__ __forceinline__ void stage_rc(int b, int& R, int& C) { const int st = b / 1024, sb = b % 1024, swz = sb ^ (((sb >> 9) & 1) << 5); R = (st >> 1) * 16 + swz / 64; C = (st & 1) * 32 + (swz % 64) / 2; }
__host__ __device__ __forceinline__ int perm32(int rho) { const int n = rho >> 4, i = rho & 15; return 8 * (i >> 2) + 4 * n + (i & 3); }

struct Unit { int pm, pn; };
struct Gemm { const bf16_t* A; const bf16_t* Bt; int M, N, K; };

struct StaticOrder {
    int nM, nN, nwg, G, c;
    __host__ __device__ void init(int M, int N, int G_, int c_) { nM = M / BM; nN = N / BM; nwg = nM * nN; G = G_; c = c_; }
    __host__ __device__ bool next(int i, Unit& u) const {
        const long L = (long)i * G + c; if (L >= nwg) return false;
        int wgid = (int)L; { const int q = nwg / NXCD, r = nwg % NXCD, xcd = wgid % NXCD, off = wgid / NXCD; wgid = (xcd < r ? xcd * (q + 1) : r * (q + 1) + (xcd - r) * q) + off; }
        const int nig = WGM * nN, gid = wgid / nig, fm = gid * WGM, gsz = (nM - fm) < WGM ? (nM - fm) : WGM;
        u.pm = fm + ((wgid % nig) % gsz); u.pn = (wgid % nig) / gsz; return true;
    }
    __device__ __forceinline__ void a_ready(const Unit&) const {}
    __device__ __forceinline__ void done(const Unit&) const {}
};

__device__ __forceinline__ unsigned cvt_pk_bf16(float lo, float hi) { unsigned r; asm volatile("v_cvt_pk_bf16_f32 %0, %1, %2" : "=v"(r) : "v"(lo), "v"(hi)); return r; }
typedef float f32x2 __attribute__((ext_vector_type(2)));
__device__ __forceinline__ f32x2 gelu_pk(f32x2 v) {
    const f32x2 av = __builtin_elementwise_abs(v), d = av * 0.2316418882f + 1.0f;
    f32x2 t; t.x = __builtin_amdgcn_rcpf(d.x); t.y = __builtin_amdgcn_rcpf(d.y);
    f32x2 q = t * 0.5307027145f + (-0.7265760135f); q = q * t + 0.7107068705f; q = q * t + (-0.142248368f); q = q * t + 0.127414796f; q = q * t;
    const f32x2 s = (v * v) * (-0.72134752044f);
    f32x2 e; e.x = __builtin_amdgcn_exp2f(s.x); e.y = __builtin_amdgcn_exp2f(s.y);
    const f32x2 m = v * (q * e), r = v - m;
    f32x2 o; o.x = v.x < 0.f ? m.x : r.x; o.y = v.y < 0.f ? m.y : r.y; return o;
}

template <int ACT  > struct EpiBf16 {
    static constexpr bool PERM = true, AFTER_DRAIN = false; static_assert(ACT == 0 || ACT == 1, "EpiBf16: ACT is 0 (none) or 1 (gelu_pk)");
    bf16_t* O; int ldc; const float* bias; int split_cols; size_t split_stride; float scale0;
    __device__ __forceinline__ void operator()(const f32x4 (&acc)[2][2][4][2], const Unit& u, int wr, int wc, int fr, int fq) const {
        const int row0 = u.pm * BM + wr * 64 + fr; int colt = u.pn * BM; bf16_t* base = O;
        float sc = 1.f; if (split_cols) { const int t = colt / split_cols; base += (size_t)t * split_stride; colt -= t * split_cols; if (t == 0) sc = scale0; }
        const int col0 = colt + wc * 32 + 8 * fq, bcol0 = u.pn * BM + wc * 32 + 8 * fq;
        f32x4 bv[2][2];
#pragma unroll
        for (int bj = 0; bj < 2; ++bj)
#pragma unroll
            for (int n = 0; n < 2; ++n) bv[bj][n] = bias ? *(const f32x4*)(bias + bcol0 + bj * HALF + 4 * n) : (f32x4){0.f, 0.f, 0.f, 0.f};
#pragma unroll
        for (int ai = 0; ai < 2; ++ai)
#pragma unroll
            for (int m = 0; m < 4; ++m) { bf16_t* rowp = base + (size_t)(row0 + ai * HALF + m * 16) * ldc + col0;
#pragma unroll
                for (int bj = 0; bj < 2; ++bj) { f32x4 v0 = acc[ai][bj][m][0] + bv[bj][0], v1 = acc[ai][bj][m][1] + bv[bj][1];
                    if (ACT == 1) { f32x2 a = gelu_pk((f32x2){v0[0], v0[1]}), b = gelu_pk((f32x2){v0[2], v0[3]}), c = gelu_pk((f32x2){v1[0], v1[1]}), d = gelu_pk((f32x2){v1[2], v1[3]});
                        v0 = (f32x4){a.x, a.y, b.x, b.y}; v1 = (f32x4){c.x, c.y, d.x, d.y}; }
                    v0 = v0 * sc; v1 = v1 * sc; u32x4 w; w.x = cvt_pk_bf16(v0[0], v0[1]); w.y = cvt_pk_bf16(v0[2], v0[3]); w.z = cvt_pk_bf16(v1[0], v1[1]); w.w = cvt_pk_bf16(v1[2], v1[3]);
                    *(u32x4*)(rowp + bj * HALF) = w; } }
    }
};
typedef int v4i_t __attribute__((ext_vector_type(4)));
typedef int v8i_t __attribute__((ext_vector_type(8)));
__device__ __forceinline__ v8i_t cat32(bf16x8 a, bf16x8 b) { const v4i_t x = __builtin_bit_cast(v4i_t, a), y = __builtin_bit_cast(v4i_t, b); return __builtin_shufflevector(x, y, 0, 1, 2, 3, 4, 5, 6, 7); }
template <class Epi, class Sched, bool ALIGN_EPI = false, bool SP2 = false, bool GATHER = false, bool FP8 = false>
__device__ __forceinline__ void gemm_phase(PG8_LAS unsigned char* lds, const Gemm g, const Sched& S, const Epi& E, const int* rowsrc = nullptr, const PG8_LAS int* gtab = nullptr) {
    static_assert(!GATHER || SP2, "GATHER is implemented on the SP2 loop only");
    int tid_l = threadIdx.x; asm volatile("" : "+v"(tid_l));
    const int tid = tid_l, wid = __builtin_amdgcn_readfirstlane(tid >> 6), lane = tid & 63, wr = wid >> 2, wc = wid & 3, fr = lane & 15, fq = lane >> 4;
    const int K = g.K, nt = K / BK;
    unsigned voffA[2], voffB[2];
#pragma unroll
    for (int i = 0; i < 2; ++i) { int R, C; stage_rc(tid * 16 + i * 8192, R, C); const int Rb = Epi::PERM ? ((R & ~31) + perm32(R & 31)) : R;
        voffA[i] = (unsigned)(R * K + C) * 2u; voffB[i] = (unsigned)(Rb * K + C) * 2u; }
    unsigned gAc[2][2], gAn[2][2]; int gR[2]; unsigned gC[2];
#pragma unroll
    for (int i = 0; i < 2; ++i) { int R, C; stage_rc(tid * 16 + i * 8192, R, C); gR[i] = R; gC[i] = (unsigned)C * 2u; gAc[0][i] = gAc[1][i] = gAn[0][i] = gAn[1][i] = 0u; }
#define PG8_GATHER(u_, o_) do { const int gtb_ = gtab[(u_).pm], gtc_ = gtab[576 + (u_).pm];     \
        _Pragma("unroll") for (int h_ = 0; h_ < 2; ++h_) _Pragma("unroll") for (int i_ = 0; i_ < 2; ++i_) \
        { const int rl_ = h_ * HALF + gR[i_]; const int src_ = rl_ < gtc_ ? rowsrc[gtb_ + rl_] : 0; o_[h_][i_] = (unsigned)src_ * (unsigned)(K * 2) + gC[i_]; } } while (0)
#define PG8_STAGE_A(bufoff, orig_gbase, NEXTSEL, H, KOFF) do { if constexpr (GATHER) { unsigned vo_[2]; vo_[0] = (NEXTSEL) ? gAn[H][0] : gAc[H][0]; vo_[1] = (NEXTSEL) ? gAn[H][1] : gAc[H][1]; \
        PG8_STAGE(bufoff, (const char*)g.A + (KOFF), vo_); } else { PG8_STAGE(bufoff, orig_gbase, voffA); } } while (0)
    const size_t kstep = (size_t)(BK * 2);
    const size_t hstep = (size_t)HALF * K * 2;
    const size_t tstep = 2 * hstep;
    const unsigned ldsw = (unsigned)wid * 1024u;
    const int aoff = lds_byte(wr * 64 + fr, fq * (FP8 ? 16 : 8)), boff = lds_byte(wc * 32 + fr, fq * (FP8 ? 16 : 8));
#define PG8_SA(b, h) (((b) * 2 + (h)) * HTB)
#define PG8_SB(b, h) ((4 + (b) * 2 + (h)) * HTB)
#define PG8_STAGE(bufoff, gbase, voff) do { _Pragma("unroll") for (int _i = 0; _i < 2; ++_i) \
        __builtin_amdgcn_global_load_lds((const unsigned*)((const char*)(gbase) + (voff)[_i]), (PG8_LAS unsigned*)(lds + (bufoff) + ldsw + _i * 8192), 16, 0, 0); } while (0)
#define PG8_LD32(var, addr) do { var = *(const PG8_LAS v8i_t*)(addr); } while (0)
#define PG8_LDA(dst, b, h) do { if constexpr (FP8) { _Pragma("unroll") for (int m = 0; m < 4; ++m) PG8_LD32(dst##8[m], lds + PG8_SA(b, h) + aoff + m * 2048); } \
        else { _Pragma("unroll") for (int m = 0; m < 4; ++m) _Pragma("unroll") for (int k = 0; k < 2; ++k) dst[m][k] = *(const PG8_LAS bf16x8*)(lds + PG8_SA(b, h) + aoff + m * 2048 + k * 1024); } } while (0)
#define PG8_LDB(dst, b, h) do { if constexpr (FP8) { _Pragma("unroll") for (int n = 0; n < 2; ++n) PG8_LD32(dst##8[n], lds + PG8_SB(b, h) + boff + n * 2048); } \
        else { _Pragma("unroll") for (int n = 0; n < 2; ++n) _Pragma("unroll") for (int k = 0; k < 2; ++k) dst[n][k] = *(const PG8_LAS bf16x8*)(lds + PG8_SB(b, h) + boff + n * 2048 + k * 1024); } } while (0)
#define PG8_MMA(ai, bj, At, Bt) do { __builtin_amdgcn_s_setprio(1); \
        if constexpr (FP8) { _Pragma("unroll") for (int m = 0; m < 4; ++m) _Pragma("unroll") for (int n = 0; n < 2; ++n) \
            asm volatile("v_mfma_scale_f32_16x16x128_f8f6f4 %0, %1, %2, %0, %3, %3 op_sel_hi:[0,0,0]" : "+v"(acc[ai][bj][m][n]) : "v"(Bt##8[n]), "v"(At##8[m]), "v"(sc127)); } \
        else { _Pragma("unroll") for (int m = 0; m < 4; ++m) _Pragma("unroll") for (int n = 0; n < 2; ++n) _Pragma("unroll") for (int k = 0; k < 2; ++k) \
            acc[ai][bj][m][n] = __builtin_amdgcn_mfma_f32_16x16x32_bf16(Bt[n][k], At[m][k], acc[ai][bj][m][n], 0, 0, 0); } \
        __builtin_amdgcn_s_setprio(0); } while (0)
#define PG8_WAIT_V(n) asm volatile("s_waitcnt vmcnt(" #n ")" ::: "memory")
#define PG8_WAIT_L(n) asm volatile("s_waitcnt lgkmcnt(" #n ")" ::: "memory")
#define PG8_BAR __builtin_amdgcn_s_barrier()
#define PG8_SCHED __builtin_amdgcn_sched_barrier(0)
    Unit cur, nxt; int ui = 0;
    if (!S.next(0, cur)) return;
    f32x4 acc[2][2][4][2];
#pragma unroll
    for (int a = 0; a < 2; ++a)
#pragma unroll
        for (int b = 0; b < 2; ++b)
#pragma unroll
            for (int m = 0; m < 4; ++m)
#pragma unroll
                for (int n = 0; n < 2; ++n) acc[a][b][m][n] = (f32x4){0.f, 0.f, 0.f, 0.f};
    int sc127 = 0x7f7f7f7f; asm volatile("" : "+v"(sc127));
    bf16x8 At[4][2], B0[2][2], B1[2][2]; v8i_t At8[4], B08[2], B18[2]; (void)At; (void)B0; (void)B1; (void)At8; (void)B08; (void)B18;
    const char* cA = (const char*)g.A + (size_t)cur.pm * tstep; const char* cB = (const char*)g.Bt + (size_t)cur.pn * tstep;
    S.a_ready(cur);
    if constexpr (GATHER) { PG8_GATHER(cur, gAc); }
    if constexpr (SP2) {
        PG8_STAGE(PG8_SB(0, 0), cB, voffB); PG8_STAGE(PG8_SB(0, 1), cB + hstep, voffB); PG8_STAGE_A(PG8_SA(0, 0), cA, false, 0, (size_t)0); PG8_STAGE_A(PG8_SA(0, 1), cA + hstep, false, 1, (size_t)0);
        if (wr == 1) PG8_BAR;
        PG8_WAIT_V(2); PG8_BAR;
        PG8_STAGE(PG8_SB(1, 0), cB + kstep, voffB); PG8_STAGE_A(PG8_SA(1, 0), cA + kstep, false, 0, kstep); PG8_STAGE(PG8_SB(1, 1), cB + hstep + kstep, voffB);
        PG8_WAIT_V(6); PG8_BAR;
    } else {
        PG8_STAGE(PG8_SB(0, 0), cB, voffB); PG8_STAGE(PG8_SA(0, 0), cA, voffA); PG8_STAGE(PG8_SB(0, 1), cB + hstep, voffB); PG8_STAGE(PG8_SA(0, 1), cA + hstep, voffA);
        if (wr == 1) PG8_BAR;
        PG8_WAIT_V(4); PG8_BAR;
        PG8_STAGE(PG8_SB(1, 0), cB + kstep, voffB); PG8_STAGE(PG8_SA(1, 0), cA + kstep, voffA); PG8_STAGE(PG8_SB(1, 1), cB + hstep + kstep, voffB);
        PG8_WAIT_V(6); PG8_BAR;
    }
    for (;;) {
        const bool has_next = S.next(ui + 1, nxt);
        if constexpr (GATHER) { if (has_next) { PG8_GATHER(nxt, gAn); } else { _Pragma("unroll") for (int h_ = 0; h_ < 2; ++h_) _Pragma("unroll") for (int i_ = 0; i_ < 2; ++i_) gAn[h_][i_] = gAc[h_][i_]; } }
        const char* nA = has_next ? (const char*)g.A + (size_t)nxt.pm * tstep : cA; const char* nB = has_next ? (const char*)g.Bt + (size_t)nxt.pn * tstep : cB;
#pragma nounroll
        for (int t = 0; t < nt; t += 2) {
            const bool last = (t == nt - 2);
            const char* a1 = cA + (size_t)(t + 1) * kstep;
            const char* a2 = last ? nA : cA + (size_t)(t + 2) * kstep; const char* b2 = last ? nB : cB + (size_t)(t + 2) * kstep;
            const char* a3 = a2 + kstep; const char* b3 = b2 + kstep;
            const size_t k1 = (size_t)(t + 1) * kstep, k2 = last ? (size_t)0 : (size_t)(t + 2) * kstep, k3 = k2 + kstep; (void)k1; (void)k2; (void)k3;
            if (last && has_next) S.a_ready(nxt);
            if constexpr (SP2) {
            PG8_LDB(B0, 0, 0); PG8_LDB(B1, 0, 1); PG8_SCHED; PG8_LDA(At, 0, 0); PG8_STAGE_A(PG8_SA(1, 1), a1 + hstep, false, 1, k1);
            PG8_WAIT_V(8); PG8_WAIT_L(0); PG8_BAR; PG8_MMA(0, 0, At, B0); PG8_MMA(0, 1, At, B1); PG8_BAR; PG8_SCHED;
            PG8_LDA(At, 0, 1); PG8_STAGE(PG8_SB(0, 0), b2, voffB); PG8_STAGE(PG8_SB(0, 1), b2 + hstep, voffB); PG8_STAGE_A(PG8_SA(0, 0), a2, last, 0, k2);
            PG8_WAIT_V(8); PG8_WAIT_L(0); PG8_BAR; PG8_MMA(1, 0, At, B0); PG8_MMA(1, 1, At, B1); PG8_BAR; PG8_SCHED;
            PG8_LDB(B0, 1, 0); PG8_LDB(B1, 1, 1); PG8_SCHED; PG8_LDA(At, 1, 0); PG8_STAGE_A(PG8_SA(0, 1), a2 + hstep, last, 1, k2);
            PG8_WAIT_V(8); PG8_WAIT_L(0); PG8_BAR; PG8_MMA(0, 0, At, B0); PG8_MMA(0, 1, At, B1); PG8_BAR; PG8_SCHED;
            PG8_LDA(At, 1, 1); PG8_STAGE(PG8_SB(1, 0), b3, voffB); PG8_STAGE(PG8_SB(1, 1), b3 + hstep, voffB); PG8_STAGE_A(PG8_SA(1, 0), a3, last, 0, k3);
            PG8_WAIT_V(8); PG8_WAIT_L(0); PG8_BAR; PG8_MMA(1, 0, At, B0); PG8_MMA(1, 1, At, B1); PG8_BAR; PG8_SCHED;
            } else {
            PG8_LDB(B0, 0, 0); PG8_SCHED; PG8_LDA(At, 0, 0); PG8_STAGE(PG8_SA(1, 1), a1 + hstep, voffA);
            PG8_WAIT_L(8); PG8_BAR; PG8_WAIT_L(0); PG8_MMA(0, 0, At, B0); PG8_BAR; PG8_SCHED;
            PG8_LDB(B1, 0, 1); PG8_STAGE(PG8_SB(0, 0), b2, voffB);
            PG8_BAR; PG8_WAIT_L(0); PG8_MMA(0, 1, At, B1); PG8_BAR;
            PG8_LDA(At, 0, 1); PG8_STAGE(PG8_SA(0, 0), a2, voffA);
            PG8_BAR; PG8_WAIT_L(0); PG8_MMA(1, 0, At, B0); PG8_BAR; PG8_SCHED;
            PG8_STAGE(PG8_SB(0, 1), b2 + hstep, voffB);
            PG8_WAIT_V(6); PG8_BAR; PG8_MMA(1, 1, At, B1); PG8_BAR;
            PG8_LDB(B0, 1, 0); PG8_SCHED; PG8_LDA(At, 1, 0); PG8_STAGE(PG8_SA(0, 1), a2 + hstep, voffA);
            PG8_WAIT_L(8); PG8_BAR; PG8_WAIT_L(0); PG8_MMA(0, 0, At, B0); PG8_BAR; PG8_SCHED;
            PG8_LDB(B1, 1, 1); PG8_STAGE(PG8_SB(1, 0), b3, voffB);
            PG8_BAR; PG8_WAIT_L(0); PG8_MMA(0, 1, At, B1); PG8_BAR;
            PG8_LDA(At, 1, 1); PG8_STAGE(PG8_SA(1, 0), a3, voffA);
            PG8_BAR; PG8_WAIT_L(0); PG8_MMA(1, 0, At, B0); PG8_BAR; PG8_SCHED;
            PG8_STAGE(PG8_SB(1, 1), b3 + hstep, voffB);
            PG8_WAIT_V(6); PG8_BAR; PG8_MMA(1, 1, At, B1); PG8_BAR;
            }
        }
        if constexpr (ALIGN_EPI) { if (wr == 0) PG8_BAR; }
        if constexpr (FP8) { asm volatile("s_nop 15\n\ts_nop 15" ::: "memory"); }
        if constexpr (!Epi::AFTER_DRAIN) { E(acc, cur, wr, wc, fr, fq); S.done(cur); }
        if (!has_next) break;
#pragma unroll
        for (int a = 0; a < 2; ++a)
#pragma unroll
            for (int b = 0; b < 2; ++b)
#pragma unroll
                for (int m = 0; m < 4; ++m)
#pragma unroll
                    for (int n = 0; n < 2; ++n) acc[a][b][m][n] = (f32x4){0.f, 0.f, 0.f, 0.f};
        cur = nxt; cA = nA; cB = nB; ++ui;
        if constexpr (GATHER) { _Pragma("unroll") for (int h_ = 0; h_ < 2; ++h_) _Pragma("unroll") for (int i_ = 0; i_ < 2; ++i_) gAc[h_][i_] = gAn[h_][i_]; }
        if constexpr (ALIGN_EPI) { if (wr == 1) PG8_BAR; }
    }
    PG8_WAIT_V(0);
    if constexpr (!ALIGN_EPI) { if (wr == 0) PG8_BAR; }
    PG8_BAR;
    if constexpr (Epi::AFTER_DRAIN) { E.fused(acc, cur, wr, wc, fr, fq, lds, wid, lane); S.done(cur); }
#undef PG8_SA
#undef PG8_SB
#undef PG8_STAGE
#undef PG8_STAGE_A
#undef PG8_GATHER
#undef PG8_LDA
#undef PG8_LD32
#undef PG8_LDB
#undef PG8_MMA
#undef PG8_WAIT_V
#undef PG8_WAIT_L
#undef PG8_BAR
#undef PG8_SCHED
}
}

#ifndef PG8_SP2
#define PG8_SP2 true
#endif
#ifndef PG8_ALIGN
#define PG8_ALIGN true
#endif

#define GAS __attribute__((address_space(1)))
#define LAS __attribute__((address_space(3)))
typedef unsigned short bf16;
typedef unsigned v4u __attribute__((ext_vector_type(4)));
typedef unsigned v2u __attribute__((ext_vector_type(2)));
typedef float f32x4 __attribute__((ext_vector_type(4)));
typedef short bf16x8 __attribute__((ext_vector_type(8)));

constexpr int D = 1024, NB = 8, SEQ = 4096, CTXL = 256, TPB = SEQ + CTXL, NTOK = NB * TPB, NLAT = NB * SEQ;
constexpr int ZC = 3328;
constexpr int ZQ = 0, ZKV = 384, ZKR = 640, ZHQ = 672, ZHF = 1184, ZHB = 1696, ZHI = 2208, ZHG = 2720;
constexpr int NEXP = 32;
constexpr float ALPHA = 1.4142135623730951f;
constexpr float LN_EPS = 1e-5f, RMS_EPS = 1e-6f;
constexpr int NWAVES = 8, NTHR = 512;
constexpr float SC_X8 = 16.f, SC_WGU = 64.f, SC_ACT = 8.f, SC_WDN = 128.f;
constexpr int LDS_BYTES = 147456;
constexpr int LDS_BAR_OFF = LDS_BYTES - 64;
constexpr int LDS_TILE_E = 131072;
constexpr int MAXTILES = 576;

constexpr size_t MiB = 1u << 20;
constexpr size_t WS_CTL = 0, CTL_ZERO_BYTES = 16384;
constexpr size_t WS_MODV = 1 * MiB;
constexpr size_t WS_ROPE = 1 * MiB + 512 * 1024;
constexpr size_t WS_BGU = 2 * MiB;
constexpr size_t WS_PW1B = 2 * MiB + 512 * 1024;
constexpr size_t WS_BCNT = WS_PW1B + 64 * 1024;
constexpr size_t WS_TILEE = WS_BCNT + 64 * 1024;
constexpr size_t WS_META = WS_TILEE + 4096;
constexpr size_t WS_TOPI = 3 * MiB, WS_TOPW = 4 * MiB;
constexpr int ECAP = 32768;
constexpr size_t WS_ROWS = 160 * MiB, WS_ROWW = 164 * MiB, WS_ROWD = 168 * MiB;
constexpr size_t WS_CURSOR = 14336;
constexpr size_t WS_WIN = 8 * MiB, WS_WUQ = 15 * MiB, WS_WUKV = 16 * MiB, WS_WOUT = 17 * MiB, WS_WPW1 = 19 * MiB, WS_WPW2 = 23 * MiB;
constexpr size_t WS_WGU = 32 * MiB, WS_WDN = 288 * MiB;
constexpr size_t WS_H = 416 * MiB;
constexpr size_t WS_X = 552 * MiB, WS_Y = 620 * MiB;
constexpr size_t WS_BIG = 688 * MiB;
constexpr size_t WS_Z = WS_BIG, WS_CQN = WS_BIG + 221 * MiB, WS_CKVN = WS_BIG + 247 * MiB, WS_KRR = WS_BIG + 264 * MiB,
                 WS_Q = WS_BIG + 267 * MiB, WS_KV = WS_BIG + 318 * MiB, WS_OF = WS_BIG + 386 * MiB, WS_OB = WS_BIG + 454 * MiB;
constexpr size_t WS_HT = WS_BIG + 528 * MiB;
constexpr size_t WS_XS = WS_BIG, WS_ACT = WS_BIG + 288 * MiB, WS_YB = WS_BIG + 576 * MiB;
constexpr size_t WS_END = WS_BIG + 848 * MiB;
static_assert((size_t)NTOK * ZC * 2 <= 221 * MiB && (size_t)NTOK * 384 * 2 <= 26 * MiB && (size_t)NTOK * 256 * 2 <= 17 * MiB && (size_t)NTOK * 32 * 2 <= 3 * MiB, "ws map 1");
static_assert((size_t)NTOK * 768 * 2 <= 51 * MiB && (size_t)NTOK * 1024 * 2 <= 68 * MiB && (size_t)NTOK * 512 * 4 <= 68 * MiB, "ws map 2");
static_assert((size_t)64 * 136 * 26624 <= 320 * MiB && (size_t)MAXTILES * 256 * 2048 <= 288 * MiB && (size_t)NLAT * 4 * 2048 <= 272 * MiB && (size_t)NTOK * 1024 * 4 <= 136 * MiB, "ws map 3");

#define LDS_WAIT() asm volatile("s_waitcnt lgkmcnt(0)" ::: "memory")
#define VM_WAIT() asm volatile("s_waitcnt vmcnt(0)" ::: "memory")
__device__ __forceinline__ float bf2f(unsigned short b) { return __uint_as_float(((unsigned)b) << 16); }
__device__ __forceinline__ unsigned pk2(float lo, float hi) { return pg8::cvt_pk_bf16(lo, hi); }
__device__ __forceinline__ float sigm(float x) { return 1.f / (1.f + __expf(-x)); }
__device__ __forceinline__ float wave_sum(float v) {
#pragma unroll
    for (int o = 1; o < 64; o <<= 1) v += __shfl_xor(v, o);
    return v;
}
__device__ __forceinline__ int ld_ctl(const int* p) { return (int)__hip_atomic_load((const unsigned*)p, __ATOMIC_RELAXED, __HIP_MEMORY_SCOPE_AGENT); }
__device__ __forceinline__ int grow_of(int lr) { return (lr >> 12) * TPB + CTXL + (lr & 4095); }

#define XB_TMO      128
#define XB_XCNT(j)  (256  + 64 * (j))
#define XB_XSUB(j)  (1280 + 64 * (j))
#define XB_XGEN(j)  (2304 + 64 * (j))
#define XB_TOP      3328
#define XB_TOPGEN   3392
#define XCD_BAR_WORDS 3456
#define XB_SPIN_CAP (1u << 21)

__device__ __forceinline__ unsigned xb_ld(unsigned* p)              { return __hip_atomic_load(p, __ATOMIC_RELAXED, __HIP_MEMORY_SCOPE_AGENT); }
__device__ __forceinline__ unsigned xb_add(unsigned* p, unsigned v) { return __hip_atomic_fetch_add(p, v, __ATOMIC_RELAXED, __HIP_MEMORY_SCOPE_AGENT); }
__device__ __forceinline__ unsigned xb_xcc_id() { return (unsigned)__builtin_amdgcn_s_getreg((3 << 11) | 20) & 0xFu; }
#define XB_SPIN(cond, bar) do { unsigned _sp = 0; while (cond) { __builtin_amdgcn_s_sleep(1); \
    if ((++_sp & 255u) == 0u) { if (xb_ld(&(bar)[XB_TMO])) break; if (_sp > XB_SPIN_CAP) { atomicAdd(&(bar)[XB_TMO], 1u); break; } } } } while (0)

struct XcdBarrier { unsigned* bar; unsigned x; volatile LAS unsigned* st; };

__device__ __forceinline__ XcdBarrier xcd_barrier_post(unsigned* bar, volatile LAS unsigned* st) {
    XcdBarrier b; b.bar = bar; b.x = xb_xcc_id(); b.st = st;
    if (threadIdx.x == 0) (void)xb_add(&bar[XB_XCNT(b.x)], 1u);
    return b;
}
__device__ __forceinline__ void xcd_barrier_complete(unsigned* bar, unsigned x, unsigned& nloc, unsigned& nx) {
    const unsigned G = gridDim.x * gridDim.y * gridDim.z;
    unsigned sum, cnt, mine, sp = 0u;
    for (;;) {
        sum = 0u; cnt = 0u; mine = 0u;
#pragma unroll
        for (unsigned j = 0; j < 16; ++j) { const unsigned c = xb_ld(&bar[XB_XCNT(j)]); sum += c; cnt += (c > 0u) ? 1u : 0u; mine = (j == x) ? c : mine; }
        if (sum == G) break;
        __builtin_amdgcn_s_sleep(1);
        if ((++sp & 255u) == 0u) { if (xb_ld(&bar[XB_TMO])) break; if (sp > XB_SPIN_CAP) { atomicAdd(&bar[XB_TMO], 1u); break; } }
    }
    nloc = mine > 0u ? mine : 1u; nx = cnt > 0u ? cnt : 1u;
}
__device__ __forceinline__ void xcd_barrier(const XcdBarrier& b) {
    asm volatile("s_waitcnt vmcnt(0)" ::: "memory");
    __syncthreads();
    if (threadIdx.x == 0) {
        unsigned* bar = b.bar;
        __builtin_amdgcn_s_waitcnt(0);
        unsigned nloc = b.st[0], nx = b.st[1];
        if (nloc == 0u) { xcd_barrier_complete(bar, b.x, nloc, nx); b.st[0] = nloc; b.st[1] = nx; }
        const unsigned old = xb_add(&bar[XB_XSUB(b.x)], 1u);
        const unsigned gen = old / nloc;
        if (old + 1u == (gen + 1u) * nloc) {
            __builtin_amdgcn_fence(__ATOMIC_RELEASE, "agent");
            asm volatile("s_waitcnt vmcnt(0)" ::: "memory");
            const unsigned og = xb_add(&bar[XB_TOP], 1u);
            const unsigned tg = og / nx;
            if (og + 1u == (tg + 1u) * nx) xb_add(&bar[XB_TOPGEN], 1u);
            else XB_SPIN(xb_ld(&bar[XB_TOPGEN]) == tg, bar);
            __builtin_amdgcn_fence(__ATOMIC_ACQUIRE, "agent");
            xb_add(&bar[XB_XGEN(b.x)], 1u);
            asm volatile("s_waitcnt vmcnt(0)" ::: "memory");
        } else {
            XB_SPIN(xb_ld(&bar[XB_XGEN(b.x)]) == gen, bar);
            __builtin_amdgcn_fence(__ATOMIC_ACQUIRE, "agent");
            asm volatile("s_waitcnt vmcnt(0)" ::: "memory");
        }
    }
    __syncthreads();
}

namespace pg8 {
struct TileOrder {
    int nM, nN, nwg, G, c;
    __device__ __forceinline__ void init(int nM_, int nN_, int G_, int c_) { nM = nM_; nN = nN_; nwg = nM * nN; G = G_; c = c_; }
    __device__ __forceinline__ bool logical(int i, int& im, int& in) const {
        const long L = (long)i * G + c; if (L >= nwg) return false;
        int wgid = (int)L; { const int q = nwg / NXCD, r = nwg % NXCD, xcd = wgid % NXCD, off = wgid / NXCD; wgid = (xcd < r ? xcd * (q + 1) : r * (q + 1) + (xcd - r) * q) + off; }
        const int nig = WGM * nN, gid = wgid / nig, fm = gid * WGM, gsz = (nM - fm) < WGM ? (nM - fm) : WGM;
        im = fm + ((wgid % nig) % gsz); in = (wgid % nig) / gsz; return true;
    }
    __device__ __forceinline__ void a_ready(const Unit&) const {}
    __device__ __forceinline__ void done(const Unit&) const {}
};
struct AllOrder : TileOrder { __device__ __forceinline__ bool next(int i, Unit& u) const { int im, in; if (!logical(i, im, in)) return false; u.pm = im; u.pn = in; return true; } };
struct LatOrder : TileOrder {
    __device__ __forceinline__ bool next(int i, Unit& u) const { int im, in; if (!logical(i, im, in)) return false; u.pm = (im >> 4) * 17 + 1 + (im & 15); u.pn = in; return true; } };
struct MoeOrder : TileOrder {
    const PG8_LAS int* tile_e; int nper;
    __device__ __forceinline__ bool next(int i, Unit& u) const { int im, in; if (!logical(i, im, in)) return false; u.pm = im; u.pn = tile_e[im] * nper + in; return true; } };

struct EpiRes {
    static constexpr bool PERM = false, AFTER_DRAIN = false;
    const float* xin; float* h; const float* modv; const float* bias;
    __device__ __forceinline__ void operator()(const f32x4 (&acc)[2][2][4][2], const Unit& u, int wr, int wc, int fr, int fq) const {
        asm volatile("" : "+v"(fr), "+v"(fq));
        const int b = u.pm / 17, j = u.pm % 17;
        const int rl0 = wr * 64 + fr, col0 = u.pn * BM + wc * 32 + 4 * fq;
        const float* gate = modv + (size_t)b * 6144 + 2048;
        f32x4 gv[2][2], bv[2][2];
#pragma unroll
        for (int bj = 0; bj < 2; ++bj)
#pragma unroll
            for (int n = 0; n < 2; ++n) { gv[bj][n] = *(const f32x4*)(gate + col0 + bj * HALF + n * 16); bv[bj][n] = bias ? *(const f32x4*)(bias + col0 + bj * HALF + n * 16) : (f32x4){0.f, 0.f, 0.f, 0.f}; }
#pragma unroll
        for (int ai = 0; ai < 2; ++ai)
#pragma unroll
            for (int m = 0; m < 4; ++m) { const int rl = rl0 + ai * HALF + m * 16; const size_t grow = (size_t)u.pm * BM + rl;
                const float* hin = xin ? xin + ((size_t)b * 4096 + (size_t)(j - 1) * 256 + rl) * 1024 + col0 : h + grow * 1024 + col0;
                float* ho = h + grow * 1024 + col0;
#pragma unroll
                for (int bj = 0; bj < 2; ++bj)
#pragma unroll
                    for (int n = 0; n < 2; ++n) { const f32x4 hv = *(const f32x4*)(hin + bj * HALF + n * 16);
                        *(f32x4*)(ho + bj * HALF + n * 16) = hv * 1.4142135623730951f + gv[bj][n] * (acc[ai][bj][m][n] + bv[bj][n]); } }
    }
};
template <int MODE, bool OUT8 = false> struct EpiGate {
    static constexpr bool PERM = true, AFTER_DRAIN = false;
    bf16_t* O; const float* bias; int nper; float ascale, oscale;
    __device__ __forceinline__ void operator()(const f32x4 (&acc)[2][2][4][2], const Unit& u, int wr, int wc, int fr, int fq) const {
        asm volatile("" : "+v"(fr), "+v"(fq));
        const int row0 = u.pm * BM + wr * 64 + fr, pnl = u.pn % nper, ocol0 = pnl * HALF + wc * 32 + 8 * fq, bcol0 = u.pn * BM + wc * 32 + 8 * fq;
        f32x4 bv[2][2];
#pragma unroll
        for (int bj = 0; bj < 2; ++bj)
#pragma unroll
            for (int n = 0; n < 2; ++n) bv[bj][n] = *(const f32x4*)(bias + bcol0 + bj * HALF + 4 * n);
#pragma unroll
        for (int ai = 0; ai < 2; ++ai)
#pragma unroll
            for (int m = 0; m < 4; ++m) { bf16_t* rowp = O + (size_t)(row0 + ai * HALF + m * 16) * 1024 + ocol0;
                unsigned char* rowp8 = (unsigned char*)O + (size_t)(row0 + ai * HALF + m * 16) * 1024 + ocol0;
                float o[8];
#pragma unroll
                for (int n = 0; n < 2; ++n) { const f32x4 a = acc[ai][0][m][n] * ascale + bv[0][n], g = acc[ai][1][m][n] * ascale + bv[1][n];
#pragma unroll
                    for (int e = 0; e < 4; ++e) {
                        if (MODE == 0) { o[4 * n + e] = a[e] * (1.f / (1.f + __expf(-g[e]))); }
                        else { const float gt = fminf(a[e], 7.0f), up = fminf(fmaxf(g[e], -7.0f), 7.0f); o[4 * n + e] = (up + 1.0f) * gt * (1.f / (1.f + __expf(-1.702f * gt))); } } }
                if constexpr (OUT8) {
#pragma unroll
                    for (int e = 0; e < 8; ++e) o[e] = fminf(fmaxf(o[e] * oscale, -448.f), 448.f);
                    int w0 = 0, w1 = 0; w0 = __builtin_amdgcn_cvt_pk_fp8_f32(o[0], o[1], w0, false); w0 = __builtin_amdgcn_cvt_pk_fp8_f32(o[2], o[3], w0, true);
                    w1 = __builtin_amdgcn_cvt_pk_fp8_f32(o[4], o[5], w1, false); w1 = __builtin_amdgcn_cvt_pk_fp8_f32(o[6], o[7], w1, true);
                    typedef unsigned u32x2 __attribute__((ext_vector_type(2))); *(u32x2*)rowp8 = (u32x2){(unsigned)w0, (unsigned)w1}; (void)rowp;
                } else { (void)rowp8;
                u32x4 w; w.x = cvt_pk_bf16(o[0], o[1]); w.y = cvt_pk_bf16(o[2], o[3]); w.z = cvt_pk_bf16(o[4], o[5]); w.w = cvt_pk_bf16(o[6], o[7]);
                *(u32x4*)rowp = w; } }
    }
};
struct EpiDown {
    static constexpr bool PERM = true, AFTER_DRAIN = false;
    bf16_t* Y; const float* bias; const float* row_w; const int* row_dst; float ascale; const PG8_LAS int* gtab;
    __device__ __forceinline__ void operator()(const f32x4 (&acc)[2][2][4][2], const Unit& u, int wr, int wc, int fr, int fq) const {
        asm volatile("" : "+v"(fr), "+v"(fq));
        const int pnl = u.pn & 3, ocol0 = pnl * BM + wc * 32 + 8 * fq, bcol0 = u.pn * BM + wc * 32 + 8 * fq; const int tbase = gtab[u.pm], tcnt = gtab[576 + u.pm];
        f32x4 bv[2][2];
#pragma unroll
        for (int bj = 0; bj < 2; ++bj)
#pragma unroll
            for (int n = 0; n < 2; ++n) bv[bj][n] = *(const f32x4*)(bias + bcol0 + bj * HALF + 4 * n);
#pragma unroll
        for (int ai = 0; ai < 2; ++ai)
#pragma unroll
            for (int m = 0; m < 4; ++m) { const int rl = wr * 64 + fr + ai * HALF + m * 16;
                if (rl < tcnt) { const int dst = row_dst[tbase + rl]; const float w8 = row_w[tbase + rl]; bf16_t* rowp = Y + (size_t)dst * 1024 + ocol0;
#pragma unroll
                    for (int bj = 0; bj < 2; ++bj) { const f32x4 v0 = (acc[ai][bj][m][0] * ascale + bv[bj][0]) * w8, v1 = (acc[ai][bj][m][1] * ascale + bv[bj][1]) * w8;
                        u32x4 w; w.x = cvt_pk_bf16(v0[0], v0[1]); w.y = cvt_pk_bf16(v0[2], v0[3]); w.z = cvt_pk_bf16(v1[0], v1[1]); w.w = cvt_pk_bf16(v1[2], v1[3]);
                        *(u32x4*)(rowp + bj * HALF) = w; } } }
    }
};
}

namespace att {
using bf16x8 = __attribute__((ext_vector_type(8))) short;
using s16x4  = __attribute__((ext_vector_type(4))) short;
using f32x16 = __attribute__((ext_vector_type(16))) float;
using u32x4  = __attribute__((ext_vector_type(4))) unsigned;
constexpr int NW = 8, QBLK = 32, KVBLK = 64;
constexpr float SCALE = 0.10206207261596575f;
constexpr float THR = 8.f;
constexpr int SHM_V = 16384, SHM_K = 16384, SHM_ATTN = 2 * SHM_V + 2 * SHM_K + NW * 64 * 4;
#define KSWZ(row, colB) ((row) * 256 + ((colB) ^ (((row) & 7) << 4)))
#define SBAR() __builtin_amdgcn_sched_barrier(0)
__device__ __forceinline__ int crow(int r, int hi) { return (r & 3) + 8 * (r >> 2) + 4 * hi; }
__device__ __forceinline__ unsigned cvtpk(float lo, float hi) { unsigned r; asm volatile("v_cvt_pk_bf16_f32 %0, %1, %2" : "=v"(r) : "v"(lo), "v"(hi)); return r; }

__device__ __forceinline__ void partialSM(f32x16& p0, f32x16& p1, float& m_reg, float& mn, float& alpha) {
  constexpr float C = SCALE * 1.4426950408889634f;
  float pmax = p0[0];
#pragma unroll
  for (int r = 1; r < 16; ++r) pmax = fmaxf(pmax, p0[r]);
#pragma unroll
  for (int r = 0; r < 16; ++r) pmax = fmaxf(pmax, p1[r]);
  { auto rr = __builtin_amdgcn_permlane32_swap(__float_as_uint(pmax), __float_as_uint(pmax), false, false);
    pmax = fmaxf(__uint_as_float(rr[0]), __uint_as_float(rr[1])); }
  if (__builtin_expect(__all(pmax - m_reg <= THR / SCALE), 1)) { mn = m_reg; alpha = 1.f; }
  else { mn = fmaxf(m_reg, pmax); alpha = __builtin_amdgcn_exp2f((m_reg - mn) * C); m_reg = mn; }
  float mnC = -mn * C;
#pragma unroll
  for (int r = 0; r < 16; ++r) p0[r] = fmaf(p0[r], C, mnC);
#pragma unroll
  for (int r = 0; r < 16; ++r) p1[r] = fmaf(p1[r], C, mnC);
#pragma unroll
  for (int r = 0; r < 16; ++r) p0[r] = __builtin_amdgcn_exp2f(p0[r]);
}
__device__ __forceinline__ void finishSM(f32x16& p0, f32x16& p1, float alpha, float& l_reg, bf16x8& pa0, bf16x8& pa1, bf16x8& pa2, bf16x8& pa3) {
#pragma unroll
  for (int r = 0; r < 16; ++r) p1[r] = __builtin_amdgcn_exp2f(p1[r]);
  float ps = 0;
#pragma unroll
  for (int r = 0; r < 16; ++r) ps += p0[r];
#pragma unroll
  for (int r = 0; r < 16; ++r) ps += p1[r];
  { auto rr = __builtin_amdgcn_permlane32_swap(__float_as_uint(ps), __float_as_uint(ps), false, false);
    ps = __uint_as_float(rr[0]) + __uint_as_float(rr[1]); }
  l_reg = l_reg * alpha + ps;
#define PK4(P, BASE, OUT) do { unsigned a0 = cvtpk(P[BASE + 0], P[BASE + 1]), a1 = cvtpk(P[BASE + 2], P[BASE + 3]);   \
    unsigned b0 = cvtpk(P[BASE + 4], P[BASE + 5]), b1 = cvtpk(P[BASE + 6], P[BASE + 7]);                              \
    auto r0 = __builtin_amdgcn_permlane32_swap(a0, b0, false, false); auto r1 = __builtin_amdgcn_permlane32_swap(a1, b1, false, false); \
    u32x4 w = {r0[0], r1[0], r0[1], r1[1]}; OUT = *reinterpret_cast<bf16x8*>(&w); } while (0)
  PK4(p0, 0, pa0); PK4(p0, 8, pa1); PK4(p1, 0, pa2); PK4(p1, 8, pa3);
#undef PK4
}
__device__ __forceinline__ void qkt(f32x16& p0, f32x16& p1, const bf16* Ks, const bf16x8* qr, int r32, int hi) {
  p0 = f32x16{}; p1 = f32x16{};
#pragma unroll
  for (int d0 = 0; d0 < 6; ++d0) { int cb = (d0 * 16 + hi * 8) * 2;
    bf16x8 b0 = *reinterpret_cast<const bf16x8*>((const char*)Ks + KSWZ(r32, cb));
    bf16x8 b1 = *reinterpret_cast<const bf16x8*>((const char*)Ks + KSWZ(32 + r32, cb));
    p0 = __builtin_amdgcn_mfma_f32_32x32x16_bf16(b0, qr[d0], p0, 0, 0, 0);
    p1 = __builtin_amdgcn_mfma_f32_32x32x16_bf16(b1, qr[d0], p1, 0, 0, 0); }
}
__device__ __forceinline__ int v_st(int k, int c) { const int kk = (k & ~0xC) | ((k & 4) << 1) | ((k & 8) >> 1); return ((kk >> 3) * 4 + (c >> 5)) * 512 + ((kk & 7) * 32 + (c & 31)) * 2; }
__device__ __forceinline__ int v_rd_base(int lane) { return ((lane & 3) << 3) | (((lane >> 2) & 3) << 6) | (((lane >> 4) & 1) << 5) | (((lane >> 5) & 1) << 8); }
constexpr int v_rd_off(int d0, int ks, int half) { return d0 * 512 + ks * 4096 + half * 2048; }
template <int OFF> __device__ __forceinline__ s16x4 tr_read(int vb) {
  s16x4 r; asm volatile("ds_read_b64_tr_b16 %0, %1 offset:%2" : "=&v"(r) : "v"(vb), "i"(OFF) : "memory"); return r;
}
template <int D0> __device__ __forceinline__ void pv_one(f32x16& od, int vb, bf16x8 pa0, bf16x8 pa1, bf16x8 pa2, bf16x8 pa3) {
  const s16x4 l0 = tr_read<v_rd_off(D0, 0, 0)>(vb), h0 = tr_read<v_rd_off(D0, 0, 1)>(vb), l1 = tr_read<v_rd_off(D0, 1, 0)>(vb), h1 = tr_read<v_rd_off(D0, 1, 1)>(vb);
  const s16x4 l2 = tr_read<v_rd_off(D0, 2, 0)>(vb), h2 = tr_read<v_rd_off(D0, 2, 1)>(vb), l3 = tr_read<v_rd_off(D0, 3, 0)>(vb), h3 = tr_read<v_rd_off(D0, 3, 1)>(vb);
  asm volatile("s_waitcnt lgkmcnt(0)" ::: "memory"); SBAR();
#define PK(L, H) (bf16x8){L[0], L[1], L[2], L[3], H[0], H[1], H[2], H[3]}
  od = __builtin_amdgcn_mfma_f32_32x32x16_bf16(pa0, PK(l0, h0), od, 0, 0, 0);
  od = __builtin_amdgcn_mfma_f32_32x32x16_bf16(pa1, PK(l1, h1), od, 0, 0, 0);
  od = __builtin_amdgcn_mfma_f32_32x32x16_bf16(pa2, PK(l2, h2), od, 0, 0, 0);
  od = __builtin_amdgcn_mfma_f32_32x32x16_bf16(pa3, PK(l3, h3), od, 0, 0, 0);
#undef PK
}
__device__ __forceinline__ void pv_d0(f32x16* o, int vb, bf16x8 pa0, bf16x8 pa1, bf16x8 pa2, bf16x8 pa3) {
  pv_one<0>(o[0], vb, pa0, pa1, pa2, pa3); pv_one<1>(o[1], vb, pa0, pa1, pa2, pa3);
}
__device__ __forceinline__ bf16x8 rope8(bf16x8 x, const float* tab, int pbase) {
  u32x4 w;
#pragma unroll
  for (int i = 0; i < 4; ++i) { const float x1 = __uint_as_float(((unsigned)(unsigned short)x[2 * i]) << 16), x2 = __uint_as_float(((unsigned)(unsigned short)x[2 * i + 1]) << 16);
    const float cs = tab[pbase + i], sn = tab[16 + pbase + i]; w[i] = cvtpk(x1 * cs - x2 * sn, x1 * sn + x2 * cs); }
  return *reinterpret_cast<bf16x8*>(&w);
}
__device__ __forceinline__ void attn_unit(const bf16* __restrict__ Qb, const bf16* __restrict__ KVb, const bf16* __restrict__ KRb, bf16* __restrict__ Ob,
                                          const float* __restrict__ rope, int seq, char* lds) {
  int tid_l = threadIdx.x; asm volatile("" : "+v"(tid_l));
  const int tid = tid_l, wid = tid >> 6, lane = tid & 63, r32 = lane & 31, hi = lane >> 5;
  bf16* V_lds = (bf16*)lds; bf16* K_lds = (bf16*)(lds + 2 * SHM_V);
  float* ws = (float*)(lds + 2 * SHM_V + 2 * SHM_K) + wid * 64; float* li_l = ws; float* al_l = ws + 32;
  float m_reg = -1e30f, l_reg = 0; f32x16 o[2] = {}; bf16x8 qr[6];
  const bf16* Qw = Qb + (long)(wid * QBLK + r32) * 768 + hi * 8;
#pragma unroll
  for (int d0 = 0; d0 < 6; ++d0) qr[d0] = *reinterpret_cast<const bf16x8*>(Qw + d0 * 16);
  if (rope) { const float* tab = rope + (long)(wid * QBLK + r32) * 32; qr[4] = rope8(qr[4], tab, 4 * hi); qr[5] = rope8(qr[5], tab, 8 + 4 * hi); }
  const int sr = tid >> 4, ch = tid & 15;
  const bf16* kbase = ch < 8 ? KVb + ch * 8 : KRb + ((ch - 8) & 3) * 8; const long kstr = ch < 8 ? 1024 : 32;
  const int vkey = tid >> 3, vc8 = (tid & 7) * 8, vst0 = v_st(vkey, vc8);
  const bf16* vbase = KVb + 512 + vc8;
  const int vb0 = (int)(uintptr_t)V_lds + v_rd_base(lane);
  struct { bf16x8 vs0, ks0, ks1; } sr_[2];
#define SLOAD(i, k0) do { sr_[i].vs0 = *reinterpret_cast<const bf16x8*>(vbase + (long)((k0) + vkey) * 1024); \
    sr_[i].ks0 = *reinterpret_cast<const bf16x8*>(kbase + (long)((k0) + sr) * kstr); sr_[i].ks1 = *reinterpret_cast<const bf16x8*>(kbase + (long)((k0) + 32 + sr) * kstr); } while (0)
#define SWRITE(b, i) do { *(bf16x8*)((char*)V_lds + (b) * SHM_V + vst0) = sr_[i].vs0; int kc = ch * 16;               \
    *(bf16x8*)((char*)K_lds + (b) * SHM_K + KSWZ(sr, kc)) = sr_[i].ks0;                       \
    *(bf16x8*)((char*)K_lds + (b) * SHM_K + KSWZ(32 + sr, kc)) = sr_[i].ks1; } while (0)
#define SWAIT() asm volatile("s_waitcnt vmcnt(3)" ::: "memory")
#define RESC(a) do { if (__any((a) < 1.f)) { if (hi == 0) al_l[r32] = (a); asm volatile("s_waitcnt lgkmcnt(0)" ::: "memory"); \
    _Pragma("unroll") for (int d = 0; d < 2; ++d) _Pragma("unroll") for (int r = 0; r < 16; ++r) o[d][r] *= al_l[crow(r, hi)]; } } while (0)
  f32x16 pA0, pA1, pB0, pB1; float mnA, mnB, alA, alB; bf16x8 pa0, pa1, pa2, pa3; const int NT = seq / KVBLK;
  constexpr int SE = 0, SO = 1;
  SLOAD(SE, 0); asm volatile("s_waitcnt vmcnt(0)" ::: "memory"); SWRITE(0, SE); __syncthreads();
  qkt(pA0, pA1, K_lds, qr, r32, hi); partialSM(pA0, pA1, m_reg, mnA, alA);
  SLOAD(SO, KVBLK); if (2 < NT) SLOAD(SE, 2 * KVBLK);
  SWAIT(); SWRITE(1, SO); __syncthreads();
  for (int j = 1; j + 1 < NT; j += 2) {
    SBAR(); qkt(pB0, pB1, (bf16*)((char*)K_lds + SHM_K), qr, r32, hi);
    finishSM(pA0, pA1, alA, l_reg, pa0, pa1, pa2, pa3); SBAR();
    SLOAD(SO, (j + 2) * KVBLK); SBAR();
    pv_d0(o, vb0, pa0, pa1, pa2, pa3); partialSM(pB0, pB1, m_reg, mnB, alB);
    __syncthreads(); SWAIT(); SWRITE(0, SE);
    RESC(alB); __syncthreads();
    SBAR(); qkt(pA0, pA1, K_lds, qr, r32, hi);
    finishSM(pB0, pB1, alB, l_reg, pa0, pa1, pa2, pa3); SBAR();
    if (j + 3 < NT) SLOAD(SE, (j + 3) * KVBLK); SBAR();
    pv_d0(o, vb0 + (int)SHM_V, pa0, pa1, pa2, pa3); partialSM(pA0, pA1, m_reg, mnA, alA);
    __syncthreads(); SWAIT(); SWRITE(1, SO);
    RESC(alA); __syncthreads();
  }
  SBAR(); qkt(pB0, pB1, (bf16*)((char*)K_lds + SHM_K), qr, r32, hi);
  finishSM(pA0, pA1, alA, l_reg, pa0, pa1, pa2, pa3); SBAR();
  pv_d0(o, vb0, pa0, pa1, pa2, pa3); partialSM(pB0, pB1, m_reg, mnB, alB);
  __syncthreads(); RESC(alB);
  finishSM(pB0, pB1, alB, l_reg, pa0, pa1, pa2, pa3); SBAR();
  pv_d0(o, vb0 + (int)SHM_V, pa0, pa1, pa2, pa3);
  if (hi == 0) li_l[r32] = l_reg; asm volatile("s_waitcnt lgkmcnt(0)" ::: "memory");
  float rli[16];
#pragma unroll
  for (int r = 0; r < 16; ++r) rli[r] = __builtin_amdgcn_rcpf(li_l[crow(r, hi)]);
  bf16* Ow = Ob + (long)(wid * QBLK) * 1024;
#pragma unroll
  for (int r = 0; r < 16; ++r) { int orow = crow(r, hi);
#pragma unroll
    for (int d0 = 0; d0 < 2; ++d0) { const float v = o[d0][r] * rli[r]; Ow[(long)orow * 1024 + d0 * 32 + r32] = (bf16)(cvtpk(v, v) & 0xffffu); } }
#undef SLOAD
#undef SWRITE
#undef SWAIT
#undef RESC
}
}

struct Args { const float* in[33]; float* out; unsigned char* ws; int ph_lo, ph_hi; };
enum { I_X = 0, I_C, I_CTX, I_CCTX, I_MODW, I_MODB, I_LN1G, I_LN1B, I_LN2G, I_LN2B, I_WIN, I_QNORM, I_KVNORM, I_WUQ, I_WUK, I_WUV, I_LBL, I_HGNORM, I_WOUT,
       I_PW1W, I_PW1B, I_DWW, I_DWB, I_CLNG, I_CLNB, I_PW2W, I_PW2B, I_RW, I_RB, I_WGU, I_BGU, I_WDN, I_BDN };

__device__ __forceinline__ int dst_row(int n, int mode, int row_off) {
    if (mode == 0) return row_off + n;
    int f, g; if (mode == 1) { f = n >> 1; g = n & 1; } else { g = n >> 10; f = n & 1023; }
    return row_off + 256 * (f >> 7) + 128 * g + (f & 127);
}
__device__ __forceinline__ unsigned pack_fp8x4(float a, float b, float c, float d) { int w = 0; w = __builtin_amdgcn_cvt_pk_fp8_f32(fminf(fmaxf(a, -448.f), 448.f), fminf(fmaxf(b, -448.f), 448.f), w, false);
    w = __builtin_amdgcn_cvt_pk_fp8_f32(fminf(fmaxf(c, -448.f), 448.f), fminf(fmaxf(d, -448.f), 448.f), w, true); return (unsigned)w; }
__device__ __forceinline__ void tr_item(const float* __restrict__ W, int K, int N, bf16* __restrict__ WT, int mode, int row_off, LAS float* scr, int item, int lane, float f8scale = 0.f) {
    const int nblk = (N + 63) >> 6, kb = item / nblk, nb = item - kb * nblk, k0 = 64 * kb, n0 = 64 * nb;
    const int nc = n0 + 4 * (lane & 15), kr = lane >> 4;
    f32x4 v[16];
#pragma unroll
    for (int i = 0; i < 16; ++i) v[i] = (nc < N) ? *(const f32x4*)(W + (size_t)(k0 + 4 * i + kr) * N + nc) : (f32x4){0.f, 0.f, 0.f, 0.f};
#pragma unroll
    for (int i = 0; i < 16; ++i) { LAS float* s = scr + (4 * i + kr) * 65 + 4 * (lane & 15); s[0] = v[i][0]; s[1] = v[i][1]; s[2] = v[i][2]; s[3] = v[i][3]; }
    LDS_WAIT();
    const int c = lane & 7;
#pragma unroll
    for (int j = 0; j < 8; ++j) { const int nl = (lane >> 3) + 8 * j, n = n0 + nl; const LAS float* s = scr + (8 * c) * 65 + nl;
        v4u o; o.x = pk2(s[0 * 65], s[1 * 65]); o.y = pk2(s[2 * 65], s[3 * 65]); o.z = pk2(s[4 * 65], s[5 * 65]); o.w = pk2(s[6 * 65], s[7 * 65]);
        if (n < N) { if (f8scale > 0.f) { v2u o8; o8.x = pack_fp8x4(s[0 * 65] * f8scale, s[1 * 65] * f8scale, s[2 * 65] * f8scale, s[3 * 65] * f8scale); o8.y = pack_fp8x4(s[4 * 65] * f8scale, s[5 * 65] * f8scale, s[6 * 65] * f8scale, s[7 * 65] * f8scale);
                *(v2u*)((unsigned char*)WT + (size_t)dst_row(n, mode, row_off) * K + k0 + 8 * c) = o8; }
            else *(v4u*)(WT + (size_t)dst_row(n, mode, row_off) * K + k0 + 8 * c) = o; } }
    LDS_WAIT();
}
__device__ __forceinline__ void phase_prologue(const Args& a, LAS unsigned char* lds, int tid, int lane, int wave) {
    unsigned char* ws = a.ws;
    const int G = gridDim.x, B = blockIdx.x;
    {
        LAS float* sc = (LAS float*)lds;
        LAS float* red = (LAS float*)(lds + 36864);
        float* modv = (float*)(ws + WS_MODV);
        bool have = false;
        for (int it = B; it < 192; it += G) {
            if (!have) { for (int i = tid; i < 9 * 1024; i += NTHR) { const int r = i >> 10, k = i & 1023; const float x = r < 8 ? a.in[I_C][r * 1024 + k] : a.in[I_CCTX][k]; sc[i] = x * sigm(x); } __syncthreads(); have = true; }
            const int l = it / 96, jc = it % 96, kg = tid >> 6, jj = tid & 63, j = jc * 64 + jj;
            float acc[9];
#pragma unroll
            for (int r = 0; r < 9; ++r) acc[r] = 0.f;
            const float* wp = a.in[I_MODW] + ((size_t)l * 1024 + kg * 128) * 6144 + j;
            for (int k0 = 0; k0 < 128; k0 += 16) { float w[16];
#pragma unroll
                for (int kk = 0; kk < 16; ++kk) w[kk] = wp[(size_t)(k0 + kk) * 6144];
#pragma unroll
                for (int kk = 0; kk < 16; ++kk)
#pragma unroll
                    for (int r = 0; r < 9; ++r) acc[r] += sc[r * 1024 + kg * 128 + k0 + kk] * w[kk]; }
#pragma unroll
            for (int r = 0; r < 9; ++r) red[(kg * 9 + r) * 64 + jj] = acc[r];
            __syncthreads();
            for (int i = tid; i < 576; i += NTHR) { const int r = i >> 6, j2 = i & 63; float s = a.in[I_MODB][l * 6144 + jc * 64 + j2];
#pragma unroll
                for (int g = 0; g < 8; ++g) s += red[(g * 9 + r) * 64 + j2];
                modv[((size_t)l * 9 + r) * 6144 + jc * 64 + j2] = s; }
            __syncthreads();
        }
        __syncthreads();
    }
    const int gw = B * NWAVES + wave, NGW = G * NWAVES, gt = B * NTHR + tid, NGT = G * NTHR;
    { float* rope = (float*)(ws + WS_ROPE);
      for (int i = gt; i < 4096 * 16; i += NGT) { const int t = i >> 4, p = i & 15; const float pos = (float)(p < 8 ? (t >> 6) : (t & 63));
          const float inv = __powf(10000.0f, -(float)(p & 7) * 0.125f); const float ang = pos * inv; rope[t * 32 + p] = cosf(ang); rope[t * 32 + 16 + p] = sinf(ang); }
      float* bgu = (float*)(ws + WS_BGU);
      for (int i = gt; i < 2 * 32 * 2048; i += NGT) { const int le = i >> 11, np = i & 2047, q = np >> 8, g = (np >> 7) & 1, r = np & 127, f = 128 * q + r; bgu[i] = a.in[I_BGU][(size_t)le * 2048 + 2 * f + g]; }
      float* pb = (float*)(ws + WS_PW1B);
      for (int i = gt; i < 2048; i += NGT) { const int q = i >> 8, g = (i >> 7) & 1, r = i & 127, f = 128 * q + r; pb[i] = a.in[I_PW1B][g * 1024 + f]; }
      v4u* zp = (v4u*)(ws + WS_WIN + (size_t)3232 * 1024 * 2);
      for (int i = gt; i < 96 * 1024 * 2 / 16; i += NGT) zp[i] = (v4u){0u, 0u, 0u, 0u};
    }
    LAS float* scr = (LAS float*)(lds + wave * 16640);
    constexpr int I0 = 16 * 51, I1 = 6 * 12, I2 = 4 * 8, I3 = 4 * 8, I4 = 256, I5 = 512, I6 = 256, SMALL = I0 + I1 + I2 + I3 + I4 + I5 + I6;
    constexpr int NGU = 64 * 512, NDN = 64 * 256, NITEMS = SMALL + NGU + NDN;
    for (int it = gw; it < NITEMS; it += NGW) {
        int r = it;
        if (r < NGU) { const int mi = r >> 9; tr_item(a.in[I_WGU] + (size_t)mi * 1024 * 2048, 1024, 2048, (bf16*)(ws + WS_WGU + (size_t)mi * 2048 * 1024), 1, 0, scr, r & 511, lane, SC_WGU); continue; } r -= NGU;
        if (r < NDN) { const int mi = r >> 8; tr_item(a.in[I_WDN] + (size_t)mi * 1024 * 1024, 1024, 1024, (bf16*)(ws + WS_WDN + (size_t)mi * 1024 * 1024), 0, 0, scr, r & 255, lane, SC_WDN); continue; } r -= NDN;
        if (r < I0) { tr_item(a.in[I_WIN], 1024, 3232, (bf16*)(ws + WS_WIN), 0, 0, scr, r, lane); continue; } r -= I0;
        if (r < I1) { tr_item(a.in[I_WUQ], 384, 768, (bf16*)(ws + WS_WUQ), 0, 0, scr, r, lane); continue; } r -= I1;
        if (r < I2) { tr_item(a.in[I_WUK], 256, 512, (bf16*)(ws + WS_WUKV), 0, 0, scr, r, lane); continue; } r -= I2;
        if (r < I3) { tr_item(a.in[I_WUV], 256, 512, (bf16*)(ws + WS_WUKV), 0, 512, scr, r, lane); continue; } r -= I3;
        if (r < I4) { tr_item(a.in[I_WOUT], 1024, 1024, (bf16*)(ws + WS_WOUT), 0, 0, scr, r, lane); continue; } r -= I4;
        if (r < I5) { tr_item(a.in[I_PW1W], 1024, 2048, (bf16*)(ws + WS_WPW1), 2, 0, scr, r, lane); continue; } r -= I5;
        tr_item(a.in[I_PW2W], 1024, 1024, (bf16*)(ws + WS_WPW2), 0, 0, scr, r, lane);
    }
}

__device__ __forceinline__ void phase_mod0(const Args& a, int lane, int wave) {
    const int gw = blockIdx.x * NWAVES + wave, NGW = gridDim.x * NWAVES;
    const float* modv = (const float*)(a.ws + WS_MODV);
    bf16* X = (bf16*)(a.ws + WS_X);
    for (int r = gw; r < NTOK; r += NGW) {
        const int b = r / TPB, p = r - b * TPB;
        const float* src = p < CTXL ? a.in[I_CTX] + ((size_t)b * CTXL + p) * 1024 : a.in[I_X] + ((size_t)b * SEQ + (p - CTXL)) * 1024;
        const float* mv = modv + (size_t)(p < CTXL ? 8 : b) * 6144;
#pragma unroll
        for (int j = 0; j < 4; ++j) { const int c = 4 * (lane + 64 * j); const f32x4 xv = *(const f32x4*)(src + c), sh = *(const f32x4*)(mv + c), sc = *(const f32x4*)(mv + 1024 + c);
            const f32x4 y = xv * (sc + 1.0f) + sh; v2u o; o.x = pk2(y[0], y[1]); o.y = pk2(y[2], y[3]); *(v2u*)(X + (size_t)r * 1024 + c) = o; }
    }
}

__device__ __forceinline__ void phase_norm0(const Args& a, int lane, int wave) {
    const int gw = blockIdx.x * NWAVES + wave, NGW = gridDim.x * NWAVES;
    const bf16* Z = (const bf16*)(a.ws + WS_Z); bf16* CQN = (bf16*)(a.ws + WS_CQN); bf16* CKVN = (bf16*)(a.ws + WS_CKVN); bf16* KRR = (bf16*)(a.ws + WS_KRR);
    const float* rope = (const float*)(a.ws + WS_ROPE);
    float gq[8], gk[8];
#pragma unroll
    for (int i = 0; i < 8; ++i) { gq[i] = lane < 48 ? a.in[I_QNORM][8 * lane + i] : 0.f; gk[i] = lane < 32 ? a.in[I_KVNORM][8 * lane + i] : 0.f; }
    for (int r = gw; r < NTOK; r += NGW) {
        const bf16* z = Z + (size_t)r * ZC; const int p = r % TPB;
        bf16x8 q8 = {}, k8 = {}, r8 = {};
        if (lane < 48) q8 = *(const bf16x8*)(z + ZQ + 8 * lane);
        if (lane < 32) k8 = *(const bf16x8*)(z + ZKV + 8 * lane);
        if (lane < 4) r8 = *(const bf16x8*)(z + ZKR + 8 * lane);
        float qf[8], kf[8], sq = 0.f, sk = 0.f;
#pragma unroll
        for (int i = 0; i < 8; ++i) { qf[i] = bf2f((unsigned short)q8[i]); kf[i] = bf2f((unsigned short)k8[i]); sq += qf[i] * qf[i]; sk += kf[i] * kf[i]; }
        sq = wave_sum(sq); sk = wave_sum(sk);
        const float rq = rsqrtf(sq * (1.f / 384.f) + RMS_EPS), rk = rsqrtf(sk * (1.f / 256.f) + RMS_EPS);
        if (lane < 48) { v4u o; o.x = pk2(qf[0] * rq * gq[0], qf[1] * rq * gq[1]); o.y = pk2(qf[2] * rq * gq[2], qf[3] * rq * gq[3]); o.z = pk2(qf[4] * rq * gq[4], qf[5] * rq * gq[5]); o.w = pk2(qf[6] * rq * gq[6], qf[7] * rq * gq[7]);
            *(v4u*)(CQN + (size_t)r * 384 + 8 * lane) = o; }
        if (lane < 32) { v4u o; o.x = pk2(kf[0] * rk * gk[0], kf[1] * rk * gk[1]); o.y = pk2(kf[2] * rk * gk[2], kf[3] * rk * gk[3]); o.z = pk2(kf[4] * rk * gk[4], kf[5] * rk * gk[5]); o.w = pk2(kf[6] * rk * gk[6], kf[7] * rk * gk[7]);
            *(v4u*)(CKVN + (size_t)r * 256 + 8 * lane) = o; }
        if (lane < 4) { bf16x8 o8 = r8; if (p >= CTXL) o8 = att::rope8(r8, rope + (size_t)(p - CTXL) * 32, 4 * lane); *(bf16x8*)(KRR + (size_t)r * 32 + 8 * lane) = o8; }
    }
}

__device__ __forceinline__ void hgrn_unit(const Args& a, int unit, LAS unsigned char* lds, int tid) {
    const int b = unit >> 5, head = (unit >> 3) & 3, dir = (unit >> 2) & 1, sl = unit & 3;
    const bf16* Z = (const bf16*)(a.ws + WS_Z);
    float* Od = (float*)(a.ws + (dir ? WS_OB : WS_OF));
    LAS float* lbv = (LAS float*)lds;
    constexpr int BUF0 = 1024, BUFSZ = 28672, OFF_Q = 16384, OFF_V = 24576;
    if (tid < 128) { const int c = head * 128 + tid; const float l0 = a.in[I_LBL][c], l1 = a.in[I_LBL][512 + c], l2 = a.in[I_LBL][1024 + c]; const float m = fmaxf(l0, fmaxf(l1, l2));
        const float e0 = __expf(l0 - m), e1 = __expf(l1 - m), e2 = __expf(l2 - m); lbv[tid] = e0 / (e0 + e1 + e2); }
    __syncthreads();
    const int lt = tid >> 4, lcg = tid & 15;
    float lb8[8];
#pragma unroll
    for (int i = 0; i < 8; ++i) lb8[i] = lbv[8 * lcg + i];
    const int fcol = (dir ? ZHB : ZHF) + head * 128 + 8 * lcg, qcol = ZHQ + head * 128 + 8 * lcg;
    const int vt = tid >> 2, vcol = ZHI + head * 128 + sl * 32 + (tid & 3) * 8;
    const int wave = tid >> 6, lane = tid & 63, vv = lane >> 4, cg = lane & 15, vloc = wave * 4 + vv;
    const size_t zb = (size_t)b * TPB;
    bf16x8 rq, rf, rv;
#define TOKP(n) (dir ? ((n) < CTXL ? (CTXL - 1 - (n)) : (TPB + CTXL - 1 - (n))) : (n))
#define HG_LOAD(i) do { const int n_ = 32 * (i) + lt; const bf16* zr_ = Z + (zb + TOKP(n_)) * ZC; rq = *(const bf16x8*)(zr_ + qcol); rf = *(const bf16x8*)(zr_ + fcol); \
        if (tid < 128) { const int n2_ = 32 * (i) + vt; rv = *(const bf16x8*)(Z + (zb + TOKP(n2_)) * ZC + vcol); } } while (0)
#define HG_WRITE(bufi) do { LAS unsigned char* bp_ = lds + BUF0 + (bufi) * BUFSZ; float f_[8]; \
        _Pragma("unroll") for (int i_ = 0; i_ < 8; ++i_) f_[i_] = lb8[i_] + (1.f - lb8[i_]) * sigm(bf2f((unsigned short)rf[i_])); \
        *(LAS f32x4*)(bp_ + ((lt * 128 + lcg * 4) * 4)) = (f32x4){f_[0], f_[1], f_[2], f_[3]}; *(LAS f32x4*)(bp_ + ((lt * 128 + 64 + lcg * 4) * 4)) = (f32x4){f_[4], f_[5], f_[6], f_[7]}; \
        *(LAS bf16x8*)(bp_ + OFF_Q + (lt * 128 + lcg * 8) * 2) = rq; \
        if (tid < 128) { float v_[8]; _Pragma("unroll") for (int i_ = 0; i_ < 8; ++i_) v_[i_] = bf2f((unsigned short)rv[i_]); \
            *(LAS f32x4*)(bp_ + OFF_V + (vt * 32 + (tid & 3) * 8) * 4) = (f32x4){v_[0], v_[1], v_[2], v_[3]}; *(LAS f32x4*)(bp_ + OFF_V + (vt * 32 + (tid & 3) * 8 + 4) * 4) = (f32x4){v_[4], v_[5], v_[6], v_[7]}; } } while (0)
    float S[8];
#pragma unroll
    for (int j = 0; j < 8; ++j) S[j] = 0.f;
    HG_LOAD(0); HG_WRITE(0); __syncthreads();
    const bool b3 = (cg & 8) != 0, b2 = (cg & 4) != 0, b1 = (cg & 2) != 0, b0 = (cg & 1) != 0;
    for (int i = 0; i < TPB / 32; ++i) {
        if (i + 1 < TPB / 32) HG_LOAD(i + 1);
        const LAS unsigned char* bp = lds + BUF0 + (i & 1) * BUFSZ;
#pragma unroll 1
        for (int g = 0; g < 4; ++g) {
            const LAS unsigned char* gp = bp + g * 8 * 512;
            float ot[8];
#pragma unroll
            for (int t = 0; t < 8; ++t) {
                const f32x4 f0 = *(const LAS f32x4*)(gp + ((t * 128 + cg * 4) * 4)), f1 = *(const LAS f32x4*)(gp + ((t * 128 + 64 + cg * 4) * 4));
                const bf16x8 q8 = *(const LAS bf16x8*)(bp + OFF_Q + ((g * 8 + t) * 128 + cg * 8) * 2);
                const float v = *(const LAS float*)(bp + OFF_V + ((g * 8 + t) * 32 + vloc) * 4);
                float acc = 0.f;
#pragma unroll
                for (int j = 0; j < 8; ++j) { const float fj = j < 4 ? f0[j] : f1[j - 4]; const float qj = bf2f((unsigned short)q8[j]);
                    const float kv = fmaf(-fj, v, v); S[j] = fmaf(fj, S[j], kv); acc = fmaf(S[j], qj, acc); }
                ot[t] = acc;
            }
#pragma unroll
            for (int k = 0; k < 4; ++k) { const float snd = b3 ? ot[k] : ot[k + 4]; const float rcv = __shfl_xor(snd, 8); ot[k] = (b3 ? ot[k + 4] : ot[k]) + rcv; }
#pragma unroll
            for (int k = 0; k < 2; ++k) { const float snd = b2 ? ot[k] : ot[k + 2]; const float rcv = __shfl_xor(snd, 4); ot[k] = (b2 ? ot[k + 2] : ot[k]) + rcv; }
            { const float snd = b1 ? ot[0] : ot[1]; const float rcv = __shfl_xor(snd, 2); ot[0] = (b1 ? ot[1] : ot[0]) + rcv; }
            ot[0] += __shfl_xor(ot[0], 1);
            if (!b0) { const int n = 32 * i + 8 * g + (cg >> 1); const int p = TOKP(n); if (p >= CTXL) Od[(zb + p) * 512 + head * 128 + sl * 32 + vloc] = ot[0]; }
        }
        if (i + 1 < TPB / 32) HG_WRITE((i + 1) & 1);
        __syncthreads();
    }
#undef TOKP
#undef HG_LOAD
#undef HG_WRITE
}

__device__ __forceinline__ void phase_readout(const Args& a, int lane, int wave) {
    const int gw = blockIdx.x * NWAVES + wave, NGW = gridDim.x * NWAVES;
    const float* OF = (const float*)(a.ws + WS_OF); const float* OB = (const float*)(a.ws + WS_OB);
    const bf16* Z = (const bf16*)(a.ws + WS_Z); bf16* MIX = (bf16*)(a.ws + WS_Y);
    float hn[8];
#pragma unroll
    for (int i = 0; i < 8; ++i) hn[i] = a.in[I_HGNORM][((8 * lane) & 127) + i];
    for (int lr = gw; lr < NLAT; lr += NGW) {
        const size_t r = (size_t)grow_of(lr);
        const f32x4 a0 = *(const f32x4*)(OF + r * 512 + 8 * lane), a1 = *(const f32x4*)(OF + r * 512 + 8 * lane + 4);
        const f32x4 c0 = *(const f32x4*)(OB + r * 512 + 8 * lane), c1 = *(const f32x4*)(OB + r * 512 + 8 * lane + 4);
        const bf16x8 g8 = *(const bf16x8*)(Z + r * ZC + ZHG + 8 * lane);
        float o[8]; float ss = 0.f;
#pragma unroll
        for (int i = 0; i < 4; ++i) { o[i] = a0[i] + c0[i]; o[4 + i] = a1[i] + c1[i]; }
#pragma unroll
        for (int i = 0; i < 8; ++i) ss += o[i] * o[i];
        ss += __shfl_xor(ss, 1); ss += __shfl_xor(ss, 2); ss += __shfl_xor(ss, 4); ss += __shfl_xor(ss, 8);
        const float rs = rsqrtf(ss * (1.f / 128.f) + RMS_EPS);
        float y[8];
#pragma unroll
        for (int i = 0; i < 8; ++i) { const float g = bf2f((unsigned short)g8[i]); y[i] = o[i] * rs * hn[i] * (g * sigm(g)); }
        v4u w; w.x = pk2(y[0], y[1]); w.y = pk2(y[2], y[3]); w.z = pk2(y[4], y[5]); w.w = pk2(y[6], y[7]);
        *(v4u*)(MIX + r * 1024 + 512 + 8 * lane) = w;
    }
}

__device__ __forceinline__ int rows_per_block() { const int G = gridDim.x; return (((NLAT + G - 1) / G) + 15) & ~15; }
__device__ __forceinline__ void phase_ln1(const Args& a, int l, LAS unsigned char* lds, int tid, int lane, int wave) {
    const int RB = rows_per_block(), lr_base = blockIdx.x * RB;
    float* H = (float*)(a.ws + WS_H); bf16* XB = (bf16*)(a.ws + WS_X);
    const float* modv = (const float*)(a.ws + WS_MODV) + (size_t)l * 9 * 6144;
    const float* lng = a.in[I_LN1G] + l * 1024; const float* lnb = a.in[I_LN1B] + l * 1024;
    const float* rw = a.in[I_RW] + (size_t)l * 1024 * 32; const float* rb = a.in[I_RB] + l * 32;
    int* topi = (int*)(a.ws + WS_TOPI); float* topw = (float*)(a.ws + WS_TOPW);
    LAS float* rwl = (LAS float*)lds;
    LAS float* lgs = (LAS float*)(lds + 131072) + wave * 64;
    LAS int* hist = (LAS int*)(lds + 131072 + 2048);
    LAS int* til = (LAS int*)(lds + 131072 + 6144);
    LAS float* twl = (LAS float*)(lds + 131072 + 6144 + 4096);
    LAS int* ccnt = (LAS int*)(lds + 131072 + 2048 + 512);
    for (int i = tid; i < 8192; i += NTHR) { const int k = i >> 3, q = i & 7; *(LAS f32x4*)(rwl + k * 32 + 4 * (q ^ ((k >> 2) & 7))) = *(const f32x4*)(rw + k * 32 + 4 * q); }
    if (tid < 32) hist[tid] = 0;
    __syncthreads();
    const int sw = lane & 7;
    for (int i = 2 * wave; i < RB; i += 16) {
        const int lr0 = lr_base + i; if (lr0 >= NLAT) break;
        float vv[2][16];
#pragma unroll
        for (int rr = 0; rr < 2; ++rr) {
            const int lr = lr0 + rr; const size_t r = (size_t)grow_of(lr); const int b = lr >> 12;
            const float* mv = modv + (size_t)b * 6144;
            f32x4 x[4]; float s = 0.f;
#pragma unroll
            for (int j = 0; j < 4; ++j) { x[j] = *(const f32x4*)(H + r * 1024 + 4 * (lane + 64 * j)); s += (x[j][0] + x[j][1]) + (x[j][2] + x[j][3]); }
            const float mean = wave_sum(s) * (1.f / 1024.f); float s2 = 0.f;
#pragma unroll
            for (int j = 0; j < 4; ++j) { x[j] = x[j] - mean; s2 += (x[j][0] * x[j][0] + x[j][1] * x[j][1]) + (x[j][2] * x[j][2] + x[j][3] * x[j][3]); }
            const float rstd = rsqrtf(wave_sum(s2) * (1.f / 1024.f) + LN_EPS);
#pragma unroll
            for (int j = 0; j < 4; ++j) { const int c = 4 * (lane + 64 * j); const f32x4 g = *(const f32x4*)(lng + c), bb = *(const f32x4*)(lnb + c);
                const f32x4 hv = x[j] * rstd * g + bb; *(f32x4*)(H + r * 1024 + c) = hv;
                const f32x4 sh = *(const f32x4*)(mv + 3 * 1024 + c), sc = *(const f32x4*)(mv + 4 * 1024 + c);
                const f32x4 bm = hv * (sc + 1.0f) + sh; *(unsigned*)((unsigned char*)XB + r * 1024 + c) = pack_fp8x4(bm[0] * SC_X8, bm[1] * SC_X8, bm[2] * SC_X8, bm[3] * SC_X8);
                vv[rr][4 * j + 0] = bm[0]; vv[rr][4 * j + 1] = bm[1]; vv[rr][4 * j + 2] = bm[2]; vv[rr][4 * j + 3] = bm[3]; }
        }
        float p0[32], p1[32];
#pragma unroll
        for (int e = 0; e < 32; ++e) { p0[e] = 0.f; p1[e] = 0.f; }
#pragma unroll
        for (int j = 0; j < 4; ++j)
#pragma unroll
            for (int e4 = 0; e4 < 4; ++e4) { const int k = 4 * (lane + 64 * j) + e4; const float x0 = vv[0][4 * j + e4], x1 = vv[1][4 * j + e4];
#pragma unroll
                for (int q = 0; q < 8; ++q) { const f32x4 w = *(const LAS f32x4*)(rwl + k * 32 + 4 * (q ^ sw));
#pragma unroll
                    for (int c = 0; c < 4; ++c) { p0[4 * q + c] = fmaf(x0, w[c], p0[4 * q + c]); p1[4 * q + c] = fmaf(x1, w[c], p1[4 * q + c]); } } }
#define RS_STEP(P, NKEEP, BITV, XORV) _Pragma("unroll") for (int k_ = 0; k_ < NKEEP; ++k_) { const float snd_ = (BITV) ? P[k_] : P[k_ + NKEEP]; const float rcv_ = __shfl_xor(snd_, XORV); P[k_] = ((BITV) ? P[k_ + NKEEP] : P[k_]) + rcv_; }
        { const bool c5 = (lane & 32) != 0, c4 = (lane & 16) != 0, c3 = (lane & 8) != 0, c2 = (lane & 4) != 0, c1 = (lane & 2) != 0;
          RS_STEP(p0, 16, c5, 32) RS_STEP(p0, 8, c4, 16) RS_STEP(p0, 4, c3, 8) RS_STEP(p0, 2, c2, 4) RS_STEP(p0, 1, c1, 2)
          RS_STEP(p1, 16, c5, 32) RS_STEP(p1, 8, c4, 16) RS_STEP(p1, 4, c3, 8) RS_STEP(p1, 2, c2, 4) RS_STEP(p1, 1, c1, 2)
          p0[0] += __shfl_xor(p0[0], 1); p1[0] += __shfl_xor(p1[0], 1); }
#undef RS_STEP
        if ((lane & 1) == 0) { lgs[lane >> 1] = p0[0]; lgs[32 + (lane >> 1)] = p1[0]; }
        LDS_WAIT();
#pragma unroll
        for (int rr = 0; rr < 2; ++rr) {
            float lg[32];
#pragma unroll
            for (int q = 0; q < 8; ++q) { const f32x4 t4 = *(const LAS f32x4*)(lgs + rr * 32 + 4 * q); const f32x4 b4 = *(const f32x4*)(rb + 4 * q); lg[4 * q] = t4[0] + b4[0]; lg[4 * q + 1] = t4[1] + b4[1]; lg[4 * q + 2] = t4[2] + b4[2]; lg[4 * q + 3] = t4[3] + b4[3]; }
            unsigned taken = 0u; float tv[4]; int ti[4];
#pragma unroll
            for (int kk = 0; kk < 4; ++kk) { float best = -3.0e38f; int bi = 0;
#pragma unroll
                for (int e = 0; e < 32; ++e) { const bool ok = (lg[e] > best) && !((taken >> e) & 1u); best = ok ? lg[e] : best; bi = ok ? e : bi; }
                taken |= 1u << bi; tv[kk] = best; ti[kk] = bi; }
            const float e1 = __expf(tv[1] - tv[0]), e2 = __expf(tv[2] - tv[0]), e3 = __expf(tv[3] - tv[0]); const float inv = 1.f / (1.f + e1 + e2 + e3);
            if (lane == 0) { const int lr = lr0 + rr;
                const int li = (lr - lr_base) * 4; til[li] = ti[0]; til[li + 1] = ti[1]; til[li + 2] = ti[2]; til[li + 3] = ti[3]; twl[li] = inv; twl[li + 1] = e1 * inv; twl[li + 2] = e2 * inv; twl[li + 3] = e3 * inv;
                __hip_atomic_fetch_add(hist + ti[0], 1, __ATOMIC_RELAXED, __HIP_MEMORY_SCOPE_WORKGROUP); __hip_atomic_fetch_add(hist + ti[1], 1, __ATOMIC_RELAXED, __HIP_MEMORY_SCOPE_WORKGROUP);
                __hip_atomic_fetch_add(hist + ti[2], 1, __ATOMIC_RELAXED, __HIP_MEMORY_SCOPE_WORKGROUP); __hip_atomic_fetch_add(hist + ti[3], 1, __ATOMIC_RELAXED, __HIP_MEMORY_SCOPE_WORKGROUP); }
        }
        LDS_WAIT();
    }
    __syncthreads();
    int* cursor = (int*)(a.ws + WS_CURSOR) + l * 32;
    int* rows = (int*)(a.ws + WS_ROWS); float* roww = (float*)(a.ws + WS_ROWW); int* rowd = (int*)(a.ws + WS_ROWD);
    int nrows = NLAT - lr_base; nrows = nrows > RB ? RB : nrows; if (nrows < 0) nrows = 0;
    const int nas = nrows * 4, nchunks = (nas + 63) >> 6;
    int basev = 0; if (tid < 32) basev = (int)__hip_atomic_fetch_add((unsigned*)cursor + tid, (unsigned)hist[tid], __ATOMIC_RELAXED, __HIP_MEMORY_SCOPE_AGENT);
    int myrank[2] = {0, 0}, mye[2] = {-1, -1};
#pragma unroll
    for (int cc = 0; cc < 2; ++cc) { const int c = wave + 8 * cc; if (c < nchunks) { const int idx = c * 64 + lane; const int e = idx < nas ? til[idx] : -1; mye[cc] = e;
        for (int x = 0; x < 32; ++x) { const unsigned long long m = __ballot(e == x); if (e == x) myrank[cc] = __popcll(m & ((1ull << lane) - 1ull)); if (lane == 0) ccnt[c * 32 + x] = __popcll(m); } } }
    __syncthreads();
    if (tid < 32) hist[32 + tid] = basev;
    __syncthreads();
#pragma unroll
    for (int cc = 0; cc < 2; ++cc) { const int c = wave + 8 * cc; const int idx = c * 64 + lane; if (c < nchunks && idx < nas) { const int e = mye[cc]; int pos = hist[32 + e] + myrank[cc]; for (int c2 = 0; c2 < c; ++c2) pos += ccnt[c2 * 32 + e];
        const int lr = lr_base + (idx >> 2); const size_t pi = (size_t)e * ECAP + pos; rows[pi] = grow_of(lr); roww[pi] = twl[idx]; rowd[pi] = lr * 4 + (idx & 3); } }
}

__device__ __forceinline__ void phase_ln2(const Args& a, int l, int lane, int wave) {
    const int gw = blockIdx.x * NWAVES + wave, NGW = gridDim.x * NWAVES;
    float* H = (float*)(a.ws + WS_H); const bf16* YB = (const bf16*)(a.ws + WS_YB); bf16* A1 = (bf16*)(a.ws + WS_Y);
    const float* modv = (const float*)(a.ws + WS_MODV);
    const float* lng = a.in[I_LN2G] + l * 1024; const float* lnb = a.in[I_LN2B] + l * 1024;
    for (int lr0 = 2 * gw; lr0 < NLAT; lr0 += 2 * NGW) {
        f32x4 hv[2][4]; v2u yv[2][4][4];
#pragma unroll
        for (int q = 0; q < 2; ++q) { const int lr = lr0 + q; const size_t r = (size_t)grow_of(lr);
#pragma unroll
            for (int j = 0; j < 4; ++j) { const int c = 4 * (lane + 64 * j); hv[q][j] = *(const f32x4*)(H + r * 1024 + c);
#pragma unroll
                for (int k = 0; k < 4; ++k) yv[q][j][k] = *(const v2u*)(YB + ((size_t)lr * 4 + k) * 1024 + c); } }
#pragma unroll
        for (int q = 0; q < 2; ++q) {
            const int lr = lr0 + q; const size_t r = (size_t)grow_of(lr); const int b = lr >> 12;
            const float* mv = modv + ((size_t)l * 9 + b) * 6144; const float* mv1 = modv + ((size_t)9 + b) * 6144;
            f32x4 x[4]; float s = 0.f;
#pragma unroll
            for (int j = 0; j < 4; ++j) { const int c = 4 * (lane + 64 * j); f32x4 f = {0.f, 0.f, 0.f, 0.f};
#pragma unroll
                for (int k = 0; k < 4; ++k) { const v2u y = yv[q][j][k];
                    f[0] += __uint_as_float(y.x << 16); f[1] += __uint_as_float(y.x & 0xffff0000u); f[2] += __uint_as_float(y.y << 16); f[3] += __uint_as_float(y.y & 0xffff0000u); }
                const f32x4 gt = *(const f32x4*)(mv + 5 * 1024 + c);
                x[j] = hv[q][j] * ALPHA + gt * f; s += (x[j][0] + x[j][1]) + (x[j][2] + x[j][3]); }
            const float mean = wave_sum(s) * (1.f / 1024.f); float s2 = 0.f;
#pragma unroll
            for (int j = 0; j < 4; ++j) { x[j] = x[j] - mean; s2 += (x[j][0] * x[j][0] + x[j][1] * x[j][1]) + (x[j][2] * x[j][2] + x[j][3] * x[j][3]); }
            const float rstd = rsqrtf(wave_sum(s2) * (1.f / 1024.f) + LN_EPS);
#pragma unroll
            for (int j = 0; j < 4; ++j) { const int c = 4 * (lane + 64 * j); const f32x4 g = *(const f32x4*)(lng + c), bb = *(const f32x4*)(lnb + c);
                const f32x4 o = x[j] * rstd * g + bb;
                if (l == 0) { *(f32x4*)(H + r * 1024 + c) = o; const f32x4 sh = *(const f32x4*)(mv1 + c), sc = *(const f32x4*)(mv1 + 1024 + c);
                    const f32x4 am = o * (sc + 1.0f) + sh; v2u w; w.x = pk2(am[0], am[1]); w.y = pk2(am[2], am[3]); *(v2u*)(A1 + r * 1024 + c) = w; }
                else *(f32x4*)(a.out + (size_t)lr * 1024 + c) = o; }
        }
    }
}

__device__ __forceinline__ void phase_conv(const Args& a, LAS unsigned char* lds, int tid, int lane, int wave) {
    const bf16* U = (const bf16*)(a.ws + WS_X); bf16* V = (bf16*)(a.ws + WS_Y);
    LAS float* part = (LAS float*)(lds + 126976);
    LAS float* st = part + 512;
    const int c0 = 2 * tid;
    const float db0 = a.in[I_DWB][c0], db1 = a.in[I_DWB][c0 + 1], g0 = a.in[I_CLNG][c0], g1 = a.in[I_CLNG][c0 + 1], be0 = a.in[I_CLNB][c0], be1 = a.in[I_CLNB][c0 + 1];
    for (int tile = blockIdx.x; tile < NLAT / 32; tile += gridDim.x) {
        const int b = tile >> 7, t0 = (tile & 127) * 32;
        const size_t rb0 = (size_t)b * TPB + CTXL;
        __syncthreads();
        for (int i = tid; i < 62 * 128; i += NTHR) { const int row = i >> 7, chk = i & 127, t = t0 - 15 + row;
            v4u val = {0u, 0u, 0u, 0u}; if (t >= 0 && t < SEQ) val = *(const v4u*)(U + (rb0 + t) * 1024 + chk * 8);
            *(LAS v4u*)(lds + row * 2048 + chk * 16) = val; }
        __syncthreads();
        float w0[31], w1[31];
#pragma unroll
        for (int j = 0; j < 31; ++j) { const float2 wv = *(const float2*)(a.in[I_DWW] + j * 1024 + c0); w0[j] = wv.x; w1[j] = wv.y; }
#pragma unroll 1
        for (int hh = 0; hh < 2; ++hh) {
            const LAS unsigned char* hp = lds + hh * 16 * 2048;
            float acc0[16], acc1[16];
#pragma unroll
            for (int t = 0; t < 16; ++t) { acc0[t] = db0; acc1[t] = db1; }
#pragma unroll
            for (int s = 0; s < 46; ++s) { const unsigned pr = *(const LAS unsigned*)(hp + s * 2048 + tid * 4); const float x0 = __uint_as_float(pr << 16), x1 = __uint_as_float(pr & 0xffff0000u);
#pragma unroll
                for (int t = (s > 30 ? s - 30 : 0); t <= (s < 15 ? s : 15); ++t) { acc0[t] = fmaf(x0, w0[s - t], acc0[t]); acc1[t] = fmaf(x1, w1[s - t], acc1[t]); } }
            float rs[32];
#pragma unroll
            for (int t = 0; t < 16; ++t) { rs[2 * t] = acc0[t] + acc1[t]; rs[2 * t + 1] = acc0[t] * acc0[t] + acc1[t] * acc1[t]; }
#define RS_STEP(NKEEP, XORV) { const bool bit_ = (lane & XORV) != 0; _Pragma("unroll") for (int k_ = 0; k_ < NKEEP; ++k_) { const float snd_ = bit_ ? rs[k_] : rs[k_ + NKEEP]; const float rcv_ = __shfl_xor(snd_, XORV); rs[k_] = (bit_ ? rs[k_ + NKEEP] : rs[k_]) + rcv_; } }
            RS_STEP(16, 32) RS_STEP(8, 16) RS_STEP(4, 8) RS_STEP(2, 4) RS_STEP(1, 2)
#undef RS_STEP
            rs[0] += __shfl_xor(rs[0], 1);
            __syncthreads();
            if ((lane & 1) == 0) part[wave * 32 + (lane >> 1)] = rs[0];
            __syncthreads();
            if (tid < 16) { float s1 = 0.f, s2 = 0.f;
#pragma unroll
                for (int w = 0; w < 8; ++w) { s1 += part[w * 32 + 2 * tid]; s2 += part[w * 32 + 2 * tid + 1]; }
                const float mean = s1 * (1.f / 1024.f); const float var = fmaxf(s2 * (1.f / 1024.f) - mean * mean, 0.f); st[2 * tid] = mean; st[2 * tid + 1] = rsqrtf(var + LN_EPS); }
            __syncthreads();
#pragma unroll
            for (int t = 0; t < 16; ++t) { const float mean = st[2 * t], rstd = st[2 * t + 1];
                const float y0 = (acc0[t] - mean) * rstd * g0 + be0, y1 = (acc1[t] - mean) * rstd * g1 + be1;
                *(unsigned*)(V + (rb0 + t0 + hh * 16 + t) * 1024 + c0) = pk2(y0 * sigm(y0), y1 * sigm(y1)); }
        }
    }
}

namespace hg {
using bf16x8 = __attribute__((ext_vector_type(8))) short;
using s16x4  = __attribute__((ext_vector_type(4))) short;
using f32x16 = __attribute__((ext_vector_type(16))) float;
using u32x4  = __attribute__((ext_vector_type(4))) unsigned;
constexpr int RS = 272;
constexpr int VS = 80;
constexpr int T_Q = 0, T_KO = 32 * RS, T_KE = 64 * RS, T_D = 96 * RS, IMG_BYTES = T_D + 512, T_V = IMG_BYTES, TILE_BYTES = T_V + 32 * VS;
constexpr int OFF_TILES = 1024, NTB = 3, OFF_OPART = OFF_TILES + NTB * TILE_BYTES, OPART_BYTES = 4 * 4096;
static_assert(OFF_OPART + 2 * OPART_BYTES <= 131072 && IMG_BYTES % 16 == 0 && IMG_BYTES / 16 == 1664, "hgrn lds");
constexpr int P_RAW = 1024, R_Q = 0, R_F = 32 * RS, RAW_BYTES = 64 * RS, P_IMG = P_RAW + RAW_BYTES;
constexpr int NCHUNK = TPB / 32, NCHAIN = NB * 4 * 2, NITEM = NCHAIN * NCHUNK;
__device__ __forceinline__ int crow(int r, int hi) { return (r & 3) + 8 * (r >> 2) + 4 * hi; }
__device__ __forceinline__ s16x4 tr_read(unsigned addr) { s16x4 r; asm volatile("ds_read_b64_tr_b16 %0, %1" : "=&v"(r) : "v"(addr) : "memory"); return r; }
__device__ __forceinline__ bf16x8 cat8(s16x4 l, s16x4 h) { return (bf16x8){l[0], l[1], l[2], l[3], h[0], h[1], h[2], h[3]}; }
__device__ __forceinline__ bf16x8 pack8(const f32x16& x, int base) {
    u32x4 w; w[0] = pk2(x[base + 0], x[base + 1]); w[1] = pk2(x[base + 2], x[base + 3]); w[2] = pk2(x[base + 4], x[base + 5]); w[3] = pk2(x[base + 6], x[base + 7]);
    return *reinterpret_cast<bf16x8*>(&w);
}
}


#define HG_TOKP(dir, n) ((dir) ? ((n) < CTXL ? (CTXL - 1 - (n)) : (TPB + CTXL - 1 - (n))) : (n))
#define HG_DPP1(x, ctrl, rmask) __int_as_float(__builtin_amdgcn_update_dpp(0x3f800000, __float_as_int(x), ctrl, rmask, 0xf, false))
#define HG_DPP(x, ctrl, rmask) __int_as_float(__builtin_amdgcn_update_dpp(0, __float_as_int(x), ctrl, rmask, 0xf, false))
__device__ __forceinline__ void hgrn_prep_items(const Args& a, LAS unsigned char* lds, int tid) {
    using namespace hg;
    const bf16* Z = (const bf16*)(a.ws + WS_Z);
    unsigned char* HT = a.ws + WS_HT;
    const int wave = __builtin_amdgcn_readfirstlane(tid >> 6), lane = tid & 63, t = lane & 31, half = lane >> 5;
    const int c0 = 16 * wave + 8 * half;
    const int lr = tid >> 4, lch = tid & 15;
    LAS float* lbt = (LAS float*)lds;
    constexpr int P_RAW2 = 2048, P_IMG2 = P_RAW2 + 2 * RAW_BYTES;
    static_assert(P_IMG2 + 2 * IMG_BYTES <= 131072, "prep lds");
    __syncthreads();
    { const float l0 = a.in[I_LBL][tid], l1 = a.in[I_LBL][512 + tid], l2 = a.in[I_LBL][1024 + tid]; const float m = fmaxf(l0, fmaxf(l1, l2));
      const float e0 = __expf(l0 - m), e1 = __expf(l1 - m), e2 = __expf(l2 - m); lbt[tid] = e0 / (e0 + e1 + e2); }
    bf16x8 gq, gf;
#define HP_LOAD(it) do { const int ch_ = (it) % NCHUNK, cn_ = (it) / NCHUNK, dir_ = cn_ & 1, hd_ = (cn_ >> 1) & 3, b_ = cn_ >> 3; \
        const bf16* zr_ = Z + ((size_t)b_ * TPB + HG_TOKP(dir_, 32 * ch_ + lr)) * ZC; gq = *(const bf16x8*)(zr_ + ZHQ + hd_ * 128 + lch * 8); gf = *(const bf16x8*)(zr_ + (dir_ ? ZHB : ZHF) + hd_ * 128 + lch * 8); } while (0)
#define HP_STASH(bufi) do { LAS unsigned char* rb_ = lds + P_RAW2 + (bufi) * RAW_BYTES; *(LAS bf16x8*)(rb_ + R_Q + lr * RS + lch * 16) = gq; *(LAS bf16x8*)(rb_ + R_F + lr * RS + lch * 16) = gf; } while (0)
#define HP_COPYOUT(item, bufi) do { v4u* dst_ = (v4u*)(HT + (size_t)(item) * IMG_BYTES); const LAS v4u* src_ = (const LAS v4u*)(lds + P_IMG2 + (bufi) * IMG_BYTES); \
        dst_[tid] = src_[tid]; dst_[tid + 512] = src_[tid + 512]; dst_[tid + 1024] = src_[tid + 1024]; if (tid < 128) dst_[tid + 1536] = src_[tid + 1536]; } while (0)
    const int G = gridDim.x;
    int it = blockIdx.x, par = 0;
    if (it < NITEM) { HP_LOAD(it); HP_STASH(0); }
    if (it + G < NITEM) HP_LOAD(it + G);
    __syncthreads();
    for (; it < NITEM; it += G, par ^= 1) {
        if (it + G < NITEM) HP_STASH(par ^ 1);
        if (it != (int)blockIdx.x) HP_COPYOUT(it - G, par ^ 1);
        if (it + 2 * G < NITEM) HP_LOAD(it + 2 * G);
        const int hd = ((it / NCHUNK) >> 1) & 3;
        {
            const LAS unsigned char* rb_ = lds + P_RAW2 + par * RAW_BYTES;
            const bf16x8 RQ = *(const LAS bf16x8*)(rb_ + R_Q + t * RS + c0 * 2), RF = *(const LAS bf16x8*)(rb_ + R_F + t * RS + c0 * 2);
            const f32x4 lbA = *(const LAS f32x4*)(lbt + hd * 128 + c0), lbB = *(const LAS f32x4*)(lbt + hd * 128 + c0 + 4);
            LAS unsigned char* tb_ = lds + P_IMG2 + par * IMG_BYTES;
            float bb_[8], kk_[8];
#pragma unroll
            for (int i_ = 0; i_ < 8; ++i_) { const float lb_ = i_ < 4 ? lbA[i_] : lbB[i_ - 4]; const float f_ = lb_ + (1.f - lb_) * __builtin_amdgcn_rcpf(1.f + __expf(-bf2f((unsigned short)RF[i_]))); kk_[i_] = 1.f - f_; bb_[i_] = f_; }
#pragma unroll
            for (int i_ = 0; i_ < 8; ++i_) { float x_ = bb_[i_]; x_ *= HG_DPP1(x_, 0x111, 0xf); x_ *= HG_DPP1(x_, 0x112, 0xf); x_ *= HG_DPP1(x_, 0x114, 0xf); x_ *= HG_DPP1(x_, 0x118, 0xf);
                x_ *= HG_DPP1(x_, 0x142, 0xa); bb_[i_] = x_; }
            float qi_[8], ko_[8], ke_[8], dd_[8];
#pragma unroll
            for (int i_ = 0; i_ < 8; ++i_) { const int bi_ = __float_as_int(bb_[i_]); dd_[i_] = __int_as_float(half ? __builtin_amdgcn_readlane(bi_, 63) : __builtin_amdgcn_readlane(bi_, 31));
                const float e_ = bb_[i_]; const float ei_ = __builtin_amdgcn_rcpf(e_);
                qi_[i_] = bf2f((unsigned short)RQ[i_]) * e_; ko_[i_] = kk_[i_] * ei_; ke_[i_] = kk_[i_] * (dd_[i_] * ei_); }
            *(LAS v4u*)(tb_ + T_Q + t * RS + c0 * 2) = (v4u){pk2(qi_[0], qi_[1]), pk2(qi_[2], qi_[3]), pk2(qi_[4], qi_[5]), pk2(qi_[6], qi_[7])};
            *(LAS v4u*)(tb_ + T_KO + t * RS + c0 * 2) = (v4u){pk2(ko_[0], ko_[1]), pk2(ko_[2], ko_[3]), pk2(ko_[4], ko_[5]), pk2(ko_[6], ko_[7])};
            *(LAS v4u*)(tb_ + T_KE + t * RS + c0 * 2) = (v4u){pk2(ke_[0], ke_[1]), pk2(ke_[2], ke_[3]), pk2(ke_[4], ke_[5]), pk2(ke_[6], ke_[7])};
            if (t == 31) { *(LAS f32x4*)(tb_ + T_D + c0 * 4) = (f32x4){dd_[0], dd_[1], dd_[2], dd_[3]}; *(LAS f32x4*)(tb_ + T_D + c0 * 4 + 16) = (f32x4){dd_[4], dd_[5], dd_[6], dd_[7]}; }
            if (tid < 32) *(LAS v4u*)(tb_ + T_Q + tid * RS + 256) = (v4u){0u, 0u, 0u, 0u};
            else if (tid < 64) *(LAS v4u*)(tb_ + T_KO + (tid - 32) * RS + 256) = (v4u){0u, 0u, 0u, 0u};
            else if (tid < 96) *(LAS v4u*)(tb_ + T_KE + (tid - 64) * RS + 256) = (v4u){0u, 0u, 0u, 0u};
        }
        __syncthreads();
    }
    if (it - G >= (int)blockIdx.x && it - G < NITEM) HP_COPYOUT(it - G, par ^ 1);
    __syncthreads();
#undef HP_COPYOUT
#undef HP_LOAD
#undef HP_STASH
}

__device__ __forceinline__ void hgrn_unit_mfma(const Args& a, int unit, LAS unsigned char* lds, int tid) {
    using namespace hg;
    const int b = unit >> 5, head = (unit >> 3) & 3, dir = (unit >> 2) & 1, sl = unit & 3;
    const bf16* Z = (const bf16*)(a.ws + WS_Z);
    const unsigned char* HT = a.ws + WS_HT + (size_t)((b * 4 + head) * 2 + dir) * NCHUNK * IMG_BYTES;
    float* Od = (float*)(a.ws + (dir ? WS_OB : WS_OF));
    const int wave = __builtin_amdgcn_readfirstlane(tid >> 6), lane = tid & 63;
    const size_t zb = (size_t)b * TPB;
    constexpr int NCH = NCHUNK;
    const int vr = (tid >> 2) & 31, vp = tid & 3, lvcol = ZHI + head * 128 + sl * 32 + vp * 8, i3 = 1536 + (tid & 127);
    v4u gA0, gA1, gA2, gA3, gB0, gB1, gB2, gB3; bf16x8 gAv, gBv;
#define HG_LOAD(g0, g1, g2, g3, gv, ch) do { const int c_ = (ch) < NCH ? (ch) : NCH - 1; const v4u* src_ = (const v4u*)(HT + (size_t)c_ * IMG_BYTES); \
        g0 = src_[tid]; g1 = src_[tid + 512]; g2 = src_[tid + 1024]; g3 = src_[i3]; gv = *(const bf16x8*)(Z + (zb + HG_TOKP(dir, 32 * c_ + vr)) * ZC + lvcol); } while (0)
#define HG_STASH(g0, g1, g2, g3, gv, bufi) do { LAS unsigned char* tb_ = lds + OFF_TILES + (bufi) * TILE_BYTES; LAS v4u* d_ = (LAS v4u*)tb_; \
        d_[tid] = g0; d_[tid + 512] = g1; d_[tid + 1024] = g2; if (tid < 128) { d_[tid + 1536] = g3; *(LAS bf16x8*)(tb_ + T_V + vr * VS + vp * 16) = gv; } } while (0)
    const int r32 = lane & 31, hi = lane >> 5, g1 = (lane >> 4) & 1, q4 = (lane & 15) >> 2, p4 = lane & 3, cb = 32 * wave;
    const unsigned lbase = (unsigned)(uintptr_t)lds;
    f32x16 S = {};
    HG_LOAD(gA0, gA1, gA2, gA3, gAv, 0); HG_STASH(gA0, gA1, gA2, gA3, gAv, 0); HG_LOAD(gA0, gA1, gA2, gA3, gAv, 1); HG_STASH(gA0, gA1, gA2, gA3, gAv, 1);
    HG_LOAD(gA0, gA1, gA2, gA3, gAv, 2);
    __syncthreads();
#define HG_RD64(dst, addr, OFFS) asm volatile("ds_read_b64 %0, %1 offset:" #OFFS : "=&v"(dst) : "v"(addr) : "memory")
#define HG_MFMA_STAGE(n, bufi) do { \
            const unsigned tb = lbase + OFF_TILES + (bufi) * TILE_BYTES; const LAS unsigned char* tl_ = lds + OFF_TILES + (bufi) * TILE_BYTES; \
            bf16x8 ko[2], qi[2]; s16x4 pvl[2], pvh[2], pql[2], pqh[2], kl[2], kh[2], nvl[2], nvh[2]; f32x4 dsc[4]; \
            _Pragma("unroll") for (int kk = 0; kk < 2; ++kk) { ko[kk] = *(const LAS bf16x8*)(tl_ + T_KO + r32 * RS + (cb + 16 * kk + 8 * hi) * 2); qi[kk] = *(const LAS bf16x8*)(tl_ + T_Q + r32 * RS + (cb + 16 * kk + 8 * hi) * 2); } \
            _Pragma("unroll") for (int sp = 0; sp < 2; ++sp) { \
                const unsigned va = tb + T_V + (16 * sp + 4 * hi + q4) * VS + (16 * g1 + 4 * p4) * 2; pvl[sp] = tr_read(va); pvh[sp] = tr_read(va + 8 * VS);              \
                const unsigned qa = tb + T_Q + r32 * RS + (cb + 16 * sp + 4 * hi) * 2; HG_RD64(pql[sp], qa, 0); HG_RD64(pqh[sp], qa, 16);                                  \
                const unsigned ka = tb + T_KE + (16 * sp + 8 * hi + q4) * RS + (cb + 16 * g1 + 4 * p4) * 2; kl[sp] = tr_read(ka); kh[sp] = tr_read(ka + 4 * RS);        \
                const unsigned vb = tb + T_V + (16 * sp + 8 * hi + q4) * VS + (16 * g1 + 4 * p4) * 2; nvl[sp] = tr_read(vb); nvh[sp] = tr_read(vb + 4 * VS); }            \
            _Pragma("unroll") for (int g = 0; g < 4; ++g) dsc[g] = *(const LAS f32x4*)(tl_ + T_D + (cb + 8 * g + 4 * hi) * 4); \
            asm volatile("s_waitcnt lgkmcnt(0)" ::: "memory"); __builtin_amdgcn_sched_barrier(0); \
            f32x16 X = {}; \
            X = __builtin_amdgcn_mfma_f32_32x32x16_bf16(ko[0], qi[0], X, 0, 0, 0); X = __builtin_amdgcn_mfma_f32_32x32x16_bf16(ko[1], qi[1], X, 0, 0, 0); \
            f32x16 O = {}; \
            O = __builtin_amdgcn_mfma_f32_32x32x16_bf16(cat8(pql[0], pqh[0]), pack8(S, 0), O, 0, 0, 0); O = __builtin_amdgcn_mfma_f32_32x32x16_bf16(cat8(pql[1], pqh[1]), pack8(S, 8), O, 0, 0, 0); \
            _Pragma("unroll") for (int i = 0; i < 16; ++i) S[i] *= dsc[i >> 2][i & 3]; \
            S = __builtin_amdgcn_mfma_f32_32x32x16_bf16(cat8(kl[0], kh[0]), cat8(nvl[0], nvh[0]), S, 0, 0, 0); S = __builtin_amdgcn_mfma_f32_32x32x16_bf16(cat8(kl[1], kh[1]), cat8(nvl[1], nvh[1]), S, 0, 0, 0); \
            _Pragma("unroll") for (int i = 0; i < 16; ++i) X[i] = (crow(i, hi) <= r32) ? X[i] : 0.f; \
            O = __builtin_amdgcn_mfma_f32_32x32x16_bf16(pack8(X, 0), cat8(pvl[0], pvh[0]), O, 0, 0, 0); O = __builtin_amdgcn_mfma_f32_32x32x16_bf16(pack8(X, 8), cat8(pvl[1], pvh[1]), O, 0, 0, 0); \
            LAS float* op = (LAS float*)(lds + OFF_OPART + ((n) & 1) * OPART_BYTES + wave * 4096); \
            _Pragma("unroll") for (int i = 0; i < 16; ++i) op[crow(i, hi) * 32 + r32] = O[i]; } while (0)
#define HG_OUT_STAGE(n) do { \
            const int l2 = tid - 256, tt = l2 >> 3, vq = l2 & 7; \
            const LAS float* op = (const LAS float*)(lds + OFF_OPART + (((n) - 1) & 1) * OPART_BYTES) + tt * 32 + vq * 4; \
            const f32x4 s = (*(const LAS f32x4*)op + *(const LAS f32x4*)(op + 1024)) + (*(const LAS f32x4*)(op + 2048) + *(const LAS f32x4*)(op + 3072)); \
            const int p = HG_TOKP(dir, 32 * ((n) - 1) + tt); \
            if (p >= CTXL) *(f32x4*)(Od + (zb + p) * 512 + head * 128 + sl * 32 + vq * 4) = s; } while (0)
#define HG_ITER(n, L0, L1, L2, L3, LV, S0, S1, S2, S3, SV) do { \
        HG_LOAD(L0, L1, L2, L3, LV, (n) + 3); \
        if (wave < 4) { HG_MFMA_STAGE(n, bcur); } else if ((n) > 0) { HG_OUT_STAGE(n); } \
        { const int bst_ = bcur == 0 ? 2 : bcur - 1; HG_STASH(S0, S1, S2, S3, SV, bst_); } \
        bcur = bcur == 2 ? 0 : bcur + 1; \
        __syncthreads(); } while (0)
    int bcur = 0;
    for (int n = 0; n < NCH; n += 2) {
        HG_ITER(n, gB0, gB1, gB2, gB3, gBv, gA0, gA1, gA2, gA3, gAv);
        HG_ITER(n + 1, gA0, gA1, gA2, gA3, gAv, gB0, gB1, gB2, gB3, gBv);
    }
    if (wave >= 4) { HG_OUT_STAGE(NCH); }
    __syncthreads();
#undef HG_MFMA_STAGE
#undef HG_OUT_STAGE
#undef HG_ITER
#undef HG_LOAD
#undef HG_STASH
#undef HG_RD64
}

__device__ __forceinline__ bool in_range(int lo, int hi, int k) { asm volatile("" : "+s"(lo), "+s"(hi)); return lo <= k && k < hi; }
constexpr int NPHASES = 21;
__global__ void __launch_bounds__(NTHR, 2) fwd_kernel(Args args) {
    extern __shared__ __attribute__((aligned(16))) unsigned char lds_raw[];
    LAS unsigned char* lds = (LAS unsigned char*)lds_raw;
    const int G = gridDim.x;
#define FRESH() int tid = threadIdx.x; asm volatile("" : "+v"(tid)); const int lane = tid & 63, wave = __builtin_amdgcn_readfirstlane(tid >> 6); (void)lane; (void)wave
    unsigned char* ws = args.ws;
    if (threadIdx.x < 16) ((LAS unsigned*)(lds + LDS_BAR_OFF))[threadIdx.x] = 0u;
    __syncthreads();
    XcdBarrier bar = xcd_barrier_post((unsigned*)(ws + WS_CTL), (volatile LAS unsigned*)(lds + LDS_BAR_OFF));
    const int lo = args.ph_lo, hi = args.ph_hi;
#define IN(k) in_range(lo, hi, (k))
#define NREP(k) (((PROBE_MASK >> (k)) & 1u) ? 2 : 1)
#define REPEAT(k) for (int rep_ = 0; rep_ < NREP(k); ++rep_) if (rep_ == 0 || (xcd_barrier(bar), true))
#define SEAM(k) do { if (IN(k) && IN((k) + 1)) xcd_barrier(bar); } while (0)
    bf16* const BX = (bf16*)(ws + WS_X); bf16* const BY = (bf16*)(ws + WS_Y);
    const float* const MODV = (const float*)(ws + WS_MODV);

    if (IN(0)) REPEAT(0) { FRESH(); phase_prologue(args, lds, tid, lane, wave); } SEAM(0);
    if (IN(1)) REPEAT(1) { FRESH(); phase_mod0(args, lane, wave); } SEAM(1);
    if (IN(2)) REPEAT(2) {
        pg8::Gemm g{BX, (const bf16*)(ws + WS_WIN), NTOK, ZC, 1024}; pg8::AllOrder S; S.init(NTOK / 256, ZC / 256, G, (int)blockIdx.x);
        pg8::EpiBf16<0> E{(bf16*)(ws + WS_Z), ZC, nullptr, 0, 0, 1.f};
        pg8::gemm_phase<pg8::EpiBf16<0>, pg8::AllOrder, PG8_ALIGN, PG8_SP2>(lds, g, S, E);
    } SEAM(2);
    if (IN(3)) REPEAT(3) { FRESH(); phase_norm0(args, lane, wave); hgrn_prep_items(args, lds, tid); } SEAM(3);
    if (IN(4)) REPEAT(4) {
        { pg8::Gemm g{(const bf16*)(ws + WS_CQN), (const bf16*)(ws + WS_WUQ), NTOK, 768, 384}; pg8::LatOrder S; S.init(128, 3, G, (int)blockIdx.x);
          pg8::EpiBf16<0> E{(bf16*)(ws + WS_Q), 768, nullptr, 0, 0, 1.f};
          pg8::gemm_phase<pg8::EpiBf16<0>, pg8::LatOrder, PG8_ALIGN, PG8_SP2>(lds, g, S, E); }
        __syncthreads();
        { pg8::Gemm g{(const bf16*)(ws + WS_CKVN), (const bf16*)(ws + WS_WUKV), NTOK, 1024, 256}; pg8::AllOrder S; S.init(NTOK / 256, 4, G, (int)blockIdx.x);
          pg8::EpiBf16<0> E{(bf16*)(ws + WS_KV), 1024, nullptr, 0, 0, 1.f};
          pg8::gemm_phase<pg8::EpiBf16<0>, pg8::AllOrder, PG8_ALIGN, PG8_SP2>(lds, g, S, E); }
    } SEAM(4);
    if (IN(5)) {
        REPEAT(21) { FRESH();
        for (int u = blockIdx.x; u < 256; u += G) { __syncthreads(); hgrn_unit_mfma(args, (G == 256) ? ((u & 7) * 32 + (u >> 3)) : u, lds, tid); } }
        const bf16* Q = (const bf16*)(ws + WS_Q); const bf16* KV = (const bf16*)(ws + WS_KV); const bf16* KRR = (const bf16*)(ws + WS_KRR);
        const float* rope = (const float*)(ws + WS_ROPE);
        REPEAT(22) for (int u = blockIdx.x; u < 1024; u += G) {
            const int b = u >> 7, h = (u >> 4) & 7, qb = u & 15;
            const size_t kb = (size_t)b * TPB, q0 = kb + CTXL + (size_t)qb * 256;
            __syncthreads();
            att::attn_unit(Q + q0 * 768 + h * 96, KV + kb * 1024 + h * 64, KRR + kb * 32, BY + q0 * 1024 + h * 64, rope + (size_t)qb * 256 * 32, TPB, (char*)lds_raw);
        }
    } SEAM(5);
    if (IN(6)) REPEAT(6) { FRESH(); phase_readout(args, lane, wave); } SEAM(6);
    if (IN(7)) REPEAT(7) {
        pg8::Gemm g{BY, (const bf16*)(ws + WS_WOUT), NTOK, 1024, 1024}; pg8::LatOrder S; S.init(128, 4, G, (int)blockIdx.x);
        pg8::EpiRes E{args.in[I_X], (float*)(ws + WS_H), MODV, nullptr};
        pg8::gemm_phase<pg8::EpiRes, pg8::LatOrder, PG8_ALIGN, PG8_SP2>(lds, g, S, E);
    } SEAM(7);
    for (int l = 0; l < 2; ++l) {
        if (l == 1) {
            if (IN(13)) REPEAT(13) {
                pg8::Gemm g{BY, (const bf16*)(ws + WS_WPW1), NTOK, 2048, 1024}; pg8::LatOrder S; S.init(128, 8, G, (int)blockIdx.x);
                pg8::EpiGate<0> E{BX, (const float*)(ws + WS_PW1B), 8, 1.f, 1.f};
                pg8::gemm_phase<pg8::EpiGate<0>, pg8::LatOrder, PG8_ALIGN, PG8_SP2>(lds, g, S, E);
            } SEAM(13);
            if (IN(14)) REPEAT(14) { FRESH(); phase_conv(args, lds, tid, lane, wave); } SEAM(14);
            if (IN(15)) REPEAT(15) {
                pg8::Gemm g{BY, (const bf16*)(ws + WS_WPW2), NTOK, 1024, 1024}; pg8::LatOrder S; S.init(128, 4, G, (int)blockIdx.x);
                pg8::EpiRes E{nullptr, (float*)(ws + WS_H), MODV + 9 * 6144, args.in[I_PW2B]};
                pg8::gemm_phase<pg8::EpiRes, pg8::LatOrder, PG8_ALIGN, PG8_SP2>(lds, g, S, E);
            } SEAM(15);
        }
        const int pb = l ? 16 : 8;
        if (IN(pb)) REPEAT(pb) { FRESH(); phase_ln1(args, l, lds, tid, lane, wave); } SEAM(pb);
        if (IN(pb + 2) || IN(pb + 3)) {
            LAS int* tl = (LAS int*)(lds + LDS_TILE_E);
            FRESH();
            __syncthreads();
            if (tid < 32) tl[3 * MAXTILES + 64 + tid] = ld_ctl((const int*)(ws + WS_CURSOR) + l * 32 + tid);
            __syncthreads();
            if (tid == 0) { int ts = 0; for (int e = 0; e < 32; ++e) { tl[3 * MAXTILES + e] = ts; ts += (tl[3 * MAXTILES + 64 + e] + 255) >> 8; } tl[3 * MAXTILES + 32] = ts; }
            __syncthreads();
            const int ntiles = tl[3 * MAXTILES + 32];
            for (int t = tid; t < ntiles && t < MAXTILES; t += NTHR) { int e = 0; while (e < 31 && tl[3 * MAXTILES + e + 1] <= t) ++e; const int j = t - tl[3 * MAXTILES + e], rem = tl[3 * MAXTILES + 64 + e] - 256 * j;
                tl[t] = e; tl[MAXTILES + t] = e * ECAP + 256 * j; tl[2 * MAXTILES + t] = rem < 256 ? rem : 256; }
            __syncthreads();
            if (IN(pb + 2)) REPEAT(pb + 2) {
                pg8::Gemm g{BX, (const bf16*)(ws + WS_WGU + (size_t)l * 32 * 2048 * 1024), 0, 0, 512};
                pg8::MoeOrder S; S.init(ntiles, 8, G, (int)blockIdx.x); S.tile_e = tl; S.nper = 8;
                pg8::EpiGate<1, true> E{(bf16*)(ws + WS_ACT), (const float*)(ws + WS_BGU) + (size_t)l * 32 * 2048, 8, 1.f / (SC_X8 * SC_WGU), SC_ACT};
                pg8::gemm_phase<pg8::EpiGate<1, true>, pg8::MoeOrder, PG8_ALIGN, true, true, true>(lds, g, S, E, (const int*)(ws + WS_ROWS), tl + MAXTILES);
            } SEAM(pb + 2);
            if (IN(pb + 3)) REPEAT(pb + 3) {
                pg8::Gemm g{(const bf16*)(ws + WS_ACT), (const bf16*)(ws + WS_WDN + (size_t)l * 32 * 1024 * 1024), 0, 0, 512};
                pg8::MoeOrder S; S.init(ntiles, 4, G, (int)blockIdx.x); S.tile_e = tl; S.nper = 4;
                pg8::EpiDown E{(bf16*)(ws + WS_YB), args.in[I_BDN] + (size_t)l * 32 * 1024, (const float*)(ws + WS_ROWW), (const int*)(ws + WS_ROWD), 1.f / (SC_ACT * SC_WDN), tl + MAXTILES};
                pg8::gemm_phase<pg8::EpiDown, pg8::MoeOrder, PG8_ALIGN, true, false, true>(lds, g, S, E);
            } SEAM(pb + 3);
        }
        if (IN(pb + 4)) REPEAT(pb + 4) { FRESH(); phase_ln2(args, l, lane, wave); }
        if (l == 0) SEAM(12);
    }
#undef IN
#undef SEAM
}

extern "C" void kernel_launch(void* const* d_in, const int* in_sizes, int n_in, void* d_out, int out_size, void* d_ws, size_t ws_size, hipStream_t stream) {
    static int grid = 0;
    if (grid == 0) {
        if (n_in != 33 || in_sizes[0] != NB * SEQ * D || out_size != NB * SEQ * D || ws_size < WS_END) {
            fprintf(stderr, "kernel_launch: unexpected shapes: n_in %d in0 %d out %d ws %zu (need %zu)\n", n_in, n_in > 0 ? in_sizes[0] : -1, out_size, ws_size, (size_t)WS_END); grid = -1; return; }
        int dev = 0, cus = 0;
        if (hipGetDevice(&dev) != hipSuccess || hipDeviceGetAttribute(&cus, hipDeviceAttributeMultiprocessorCount, dev) != hipSuccess) { grid = -1; return; }
        if (hipFuncSetAttribute((const void*)fwd_kernel, hipFuncAttributeMaxDynamicSharedMemorySize, LDS_BYTES) != hipSuccess) { fprintf(stderr, "kernel_launch: hipFuncSetAttribute failed\n"); grid = -1; return; }
        int per_cu = 0;
        if (hipOccupancyMaxActiveBlocksPerMultiprocessor(&per_cu, (const void*)fwd_kernel, NTHR, LDS_BYTES) != hipSuccess || per_cu < 1) fprintf(stderr, "kernel_launch: occupancy query reports %d\n", per_cu);
        (void)hipGetLastError();
        grid = cus;
    }
    if (grid < 0) return;
    if (hipMemsetAsync((char*)d_ws + WS_CTL, 0, CTL_ZERO_BYTES, stream) != hipSuccess) return;
    Args a{};
    for (int i = 0; i < 33; ++i) a.in[i] = (const float*)d_in[i];
    a.out = (float*)d_out; a.ws = (unsigned char*)d_ws;
#if MK_ONE_LAUNCH
    a.ph_lo = 0; a.ph_hi = NPHASES;
    hipLaunchKernelGGL(fwd_kernel, dim3(grid), dim3(NTHR), LDS_BYTES, stream, a);
#else
    for (int ph = 0; ph < NPHASES; ++ph) { a.ph_lo = ph; a.ph_hi = ph + 1; hipLaunchKernelGGL(fwd_kernel, dim3(grid), dim3(NTHR), LDS_BYTES, stream, a); }
#endif
    const hipError_t le = hipPeekAtLastError();
    if (le != hipSuccess) fprintf(stderr, "kernel_launch: launch failed: %s\n", hipGetErrorName(le));
}
```

```cpp
#include <hip/hip_runtime.h>
#include <cstdio>
#include <cstdint>

#ifndef PROBE_MASK
#define PROBE_MASK 0u
#endif
#ifndef MK_ONE_LAUNCH
#define MK_ONE_LAUNCH 1
#endif

namespace pg8 {
#define PG8_LAS __attribute__((address_space(3)))
typedef unsigned short bf16_t;
typedef short bf16x8 __attribute__((ext_vector_type(8)));
typedef float f32x4 __attribute__((ext_vector_type(4)));
typedef unsigned u32x4 __attribute__((ext_vector_type(4)));
constexpr int BM = 256, BK = 64, HALF = 128, HTB = HALF * BK * 2  , STAGE_BYTES = 8 * HTB, NXCD = 8, WGM = 8;

__host__ __device__ __forceinline__ int lds_byte(int r, int c) { const int st = (r >> 4) * 2 + (c >> 5), rr = r & 15, cc = c & 31, ob = rr * 64 + cc * 2; return st * 1024 + (ob ^ (((ob >> 9) & 1) << 5)); }
__host__ __device__ __forceinline__ void stage_rc(int b, int& R, int& C) { const int st = b / 1024, sb = b % 1024, swz = sb ^ (((sb >> 9) & 1) << 5); R = (st >> 1) * 16 + swz / 64; C = (st & 1) * 32 + (swz % 64) / 2; }
__host__ __device__ __forceinline__ int perm32(int rho) { const int n = rho >> 4, i = rho & 15; return 8 * (i >> 2) + 4 * n + (i & 3); }

struct Unit { int pm, pn; };
struct Gemm { const bf16_t* A; const bf16_t* Bt; int M, N, K; };

struct StaticOrder {
    int nM, nN, nwg, G, c;
    __host__ __device__ void init(int M, int N, int G_, int c_) { nM = M / BM; nN = N / BM; nwg = nM * nN; G = G_; c = c_; }
    __host__ __device__ bool next(int i, Unit& u) const {
        const long L = (long)i * G + c; if (L >= nwg) return false;
        int wgid = (int)L; { const int q = nwg / NXCD, r = nwg % NXCD, xcd = wgid % NXCD, off = wgid / NXCD; wgid = (xcd < r ? xcd * (q + 1) : r * (q + 1) + (xcd - r) * q) + off; }
        const int nig = WGM * nN, gid = wgid / nig, fm = gid * WGM, gsz = (nM - fm) < WGM ? (nM - fm) : WGM;
        u.pm = fm + ((wgid % nig) % gsz); u.pn = (wgid % nig) / gsz; return true;
    }
    __device__ __forceinline__ void a_ready(const Unit&) const {}
    __device__ __forceinline__ void done(const Unit&) const {}
};

__device__ __forceinline__ unsigned cvt_pk_bf16(float lo, float hi) { unsigned r; asm volatile("v_cvt_pk_bf16_f32 %0, %1, %2" : "=v"(r) : "v"(lo), "v"(hi)); return r; }
typedef float f32x2 __attribute__((ext_vector_type(2)));
__device__ __forceinline__ f32x2 gelu_pk(f32x2 v) {
    const f32x2 av = __builtin_elementwise_abs(v), d = av * 0.2316418882f + 1.0f;
    f32x2 t; t.x = __builtin_amdgcn_rcpf(d.x); t.y = __builtin_amdgcn_rcpf(d.y);
    f32x2 q = t * 0.5307027145f + (-0.7265760135f); q = q * t + 0.7107068705f; q = q * t + (-0.142248368f); q = q * t + 0.127414796f; q = q * t;
    const f32x2 s = (v * v) * (-0.72134752044f);
    f32x2 e; e.x = __builtin_amdgcn_exp2f(s.x); e.y = __builtin_amdgcn_exp2f(s.y);
    const f32x2 m = v * (q * e), r = v - m;
    f32x2 o; o.x = v.x < 0.f ? m.x : r.x; o.y = v.y < 0.f ? m.y : r.y; return o;
}

template <int ACT  > struct EpiBf16 {
    static constexpr bool PERM = true, AFTER_DRAIN = false; static_assert(ACT == 0 || ACT == 1, "EpiBf16: ACT is 0 (none) or 1 (gelu_pk)");
    bf16_t* O; int ldc; const float* bias; int split_cols; size_t split_stride; float scale0;
    __device__ __forceinline__ void operator()(const f32x4 (&acc)[2][2][4][2], const Unit& u, int wr, int wc, int fr, int fq) const {
        const int row0 = u.pm * BM + wr * 64 + fr; int colt = u.pn * BM; bf16_t* base = O;
        float sc = 1.f; if (split_cols) { const int t = colt / split_cols; base += (size_t)t * split_stride; colt -= t * split_cols; if (t == 0) sc = scale0; }
        const int col0 = colt + wc * 32 + 8 * fq, bcol0 = u.pn * BM + wc * 32 + 8 * fq;
        f32x4 bv[2][2];
#pragma unroll
        for (int bj = 0; bj < 2; ++bj)
#pragma unroll
            for (int n = 0; n < 2; ++n) bv[bj][n] = bias ? *(const f32x4*)(bias + bcol0 + bj * HALF + 4 * n) : (f32x4){0.f, 0.f, 0.f, 0.f};
#pragma unroll
        for (int ai = 0; ai < 2; ++ai)
#pragma unroll
            for (int m = 0; m < 4; ++m) { bf16_t* rowp = base + (size_t)(row0 + ai * HALF + m * 16) * ldc + col0;
#pragma unroll
                for (int bj = 0; bj < 2; ++bj) { f32x4 v0 = acc[ai][bj][m][0] + bv[bj][0], v1 = acc[ai][bj][m][1] + bv[bj][1];
                    if (ACT == 1) { f32x2 a = gelu_pk((f32x2){v0[0], v0[1]}), b = gelu_pk((f32x2){v0[2], v0[3]}), c = gelu_pk((f32x2){v1[0], v1[1]}), d = gelu_pk((f32x2){v1[2], v1[3]});
                        v0 = (f32x4){a.x, a.y, b.x, b.y}; v1 = (f32x4){c.x, c.y, d.x, d.y}; }
                    v0 = v0 * sc; v1 = v1 * sc; u32x4 w; w.x = cvt_pk_bf16(v0[0], v0[1]); w.y = cvt_pk_bf16(v0[2], v0[3]); w.z = cvt_pk_bf16(v1[0], v1[1]); w.w = cvt_pk_bf16(v1[2], v1[3]);
                    *(u32x4*)(rowp + bj * HALF) = w; } }
    }
};
typedef int v4i_t __attribute__((ext_vector_type(4)));
typedef int v8i_t __attribute__((ext_vector_type(8)));
__device__ __forceinline__ v8i_t cat32(bf16x8 a, bf16x8 b) { const v4i_t x = __builtin_bit_cast(v4i_t, a), y = __builtin_bit_cast(v4i_t, b); return __builtin_shufflevector(x, y, 0, 1, 2, 3, 4, 5, 6, 7); }
template <class Epi, class Sched, bool ALIGN_EPI = false, bool SP2 = false, bool GATHER = false, bool FP8 = false>
__device__ __forceinline__ void gemm_phase(PG8_LAS unsigned char* lds, const Gemm g, const Sched& S, const Epi& E, const int* rowsrc = nullptr, const PG8_LAS int* gtab = nullptr) {
    static_assert(!GATHER || SP2, "GATHER is implemented on the SP2 loop only");
    int tid_l = threadIdx.x; asm volatile("" : "+v"(tid_l));
    const int tid = tid_l, wid = __builtin_amdgcn_readfirstlane(tid >> 6), lane = tid & 63, wr = wid >> 2, wc = wid & 3, fr = lane & 15, fq = lane >> 4;
    const int K = g.K, nt = K / BK;
    unsigned voffA[2], voffB[2];
#pragma unroll
    for (int i = 0; i < 2; ++i) { int R, C; stage_rc(tid * 16 + i * 8192, R, C); const int Rb = Epi::PERM ? ((R & ~31) + perm32(R & 31)) : R;
        voffA[i] = (unsigned)(R * K + C) * 2u; voffB[i] = (unsigned)(Rb * K + C) * 2u; }
    unsigned gAc[2][2], gAn[2][2]; int gR[2]; unsigned gC[2];
#pragma unroll
    for (int i = 0; i < 2; ++i) { int R, C; stage_rc(tid * 16 + i * 8192, R, C); gR[i] = R; gC[i] = (unsigned)C * 2u; gAc[0][i] = gAc[1][i] = gAn[0][i] = gAn[1][i] = 0u; }
#define PG8_GATHER(u_, o_) do { const int gtb_ = gtab[(u_).pm], gtc_ = gtab[576 + (u_).pm];     \
        _Pragma("unroll") for (int h_ = 0; h_ < 2; ++h_) _Pragma("unroll") for (int i_ = 0; i_ < 2; ++i_) \
        { const int rl_ = h_ * HALF + gR[i_]; const int src_ = rl_ < gtc_ ? rowsrc[gtb_ + rl_] : 0; o_[h_][i_] = (unsigned)src_ * (unsigned)(K * 2) + gC[i_]; } } while (0)
#define PG8_STAGE_A(bufoff, orig_gbase, NEXTSEL, H, KOFF) do { if constexpr (GATHER) { unsigned vo_[2]; vo_[0] = (NEXTSEL) ? gAn[H][0] : gAc[H][0]; vo_[1] = (NEXTSEL) ? gAn[H][1] : gAc[H][1]; \
        PG8_STAGE(bufoff, (const char*)g.A + (KOFF), vo_); } else { PG8_STAGE(bufoff, orig_gbase, voffA); } } while (0)
    const size_t kstep = (size_t)(BK * 2);
    const size_t hstep = (size_t)HALF * K * 2;
    const size_t tstep = 2 * hstep;
    const unsigned ldsw = (unsigned)wid * 1024u;
    const int aoff = lds_byte(wr * 64 + fr, fq * (FP8 ? 16 : 8)), boff = lds_byte(wc * 32 + fr, fq * (FP8 ? 16 : 8));
#define PG8_SA(b, h) (((b) * 2 + (h)) * HTB)
#define PG8_SB(b, h) ((4 + (b) * 2 + (h)) * HTB)
#define PG8_STAGE(bufoff, gbase, voff) do { _Pragma("unroll") for (int _i = 0; _i < 2; ++_i) \
        __builtin_amdgcn_global_load_lds((const unsigned*)((const char*)(gbase) + (voff)[_i]), (PG8_LAS unsigned*)(lds + (bufoff) + ldsw + _i * 8192), 16, 0, 0); } while (0)
#define PG8_LD32(var, addr) do { const bf16x8 lo_ = *(const PG8_LAS bf16x8*)(addr); const bf16x8 hi_ = *(const PG8_LAS bf16x8*)((addr) + 16); var = cat32(lo_, hi_); } while (0)
#define PG8_LDA(dst, b, h) do { if constexpr (FP8) { _Pragma("unroll") for (int m = 0; m < 4; ++m) PG8_LD32(dst##8[m], lds + PG8_SA(b, h) + aoff + m * 2048); } \
        else { _Pragma("unroll") for (int m = 0; m < 4; ++m) _Pragma("unroll") for (int k = 0; k < 2; ++k) dst[m][k] = *(const PG8_LAS bf16x8*)(lds + PG8_SA(b, h) + aoff + m * 2048 + k * 1024); } } while (0)
#define PG8_LDB(dst, b, h) do { if constexpr (FP8) { _Pragma("unroll") for (int n = 0; n < 2; ++n) PG8_LD32(dst##8[n], lds + PG8_SB(b, h) + boff + n * 2048); } \
        else { _Pragma("unroll") for (int n = 0; n < 2; ++n) _Pragma("unroll") for (int k = 0; k < 2; ++k) dst[n][k] = *(const PG8_LAS bf16x8*)(lds + PG8_SB(b, h) + boff + n * 2048 + k * 1024); } } while (0)
#define PG8_MMA(ai, bj, At, Bt) do { __builtin_amdgcn_s_setprio(1); \
        if constexpr (FP8) { _Pragma("unroll") for (int m = 0; m < 4; ++m) _Pragma("unroll") for (int n = 0; n < 2; ++n) \
            asm volatile("v_mfma_scale_f32_16x16x128_f8f6f4 %0, %1, %2, %0, %3, %3 op_sel_hi:[0,0,0]" : "+v"(acc[ai][bj][m][n]) : "v"(Bt##8[n]), "v"(At##8[m]), "v"(sc127)); } \
        else { _Pragma("unroll") for (int m = 0; m < 4; ++m) _Pragma("unroll") for (int n = 0; n < 2; ++n) _Pragma("unroll") for (int k = 0; k < 2; ++k) \
            acc[ai][bj][m][n] = __builtin_amdgcn_mfma_f32_16x16x32_bf16(Bt[n][k], At[m][k], acc[ai][bj][m][n], 0, 0, 0); } \
        __builtin_amdgcn_s_setprio(0); } while (0)
#define PG8_WAIT_V(n) asm volatile("s_waitcnt vmcnt(" #n ")" ::: "memory")
#define PG8_WAIT_L(n) asm volatile("s_waitcnt lgkmcnt(" #n ")" ::: "memory")
#define PG8_BAR __builtin_amdgcn_s_barrier()
#define PG8_SCHED __builtin_amdgcn_sched_barrier(0)
    Unit cur, nxt; int ui = 0;
    if (!S.next(0, cur)) return;
    f32x4 acc[2][2][4][2];
#pragma unroll
    for (int a = 0; a < 2; ++a)
#pragma unroll
        for (int b = 0; b < 2; ++b)
#pragma unroll
            for (int m = 0; m < 4; ++m)
#pragma unroll
                for (int n = 0; n < 2; ++n) acc[a][b][m][n] = (f32x4){0.f, 0.f, 0.f, 0.f};
    int sc127 = 0x7f7f7f7f; asm volatile("" : "+v"(sc127));
    bf16x8 At[4][2], B0[2][2], B1[2][2]; v8i_t At8[4], B08[2], B18[2]; (void)At; (void)B0; (void)B1; (void)At8; (void)B08; (void)B18;
    const char* cA = (const char*)g.A + (size_t)cur.pm * tstep; const char* cB = (const char*)g.Bt + (size_t)cur.pn * tstep;
    S.a_ready(cur);
    if constexpr (GATHER) { PG8_GATHER(cur, gAc); }
    if constexpr (SP2) {
        PG8_STAGE(PG8_SB(0, 0), cB, voffB); PG8_STAGE(PG8_SB(0, 1), cB + hstep, voffB); PG8_STAGE_A(PG8_SA(0, 0), cA, false, 0, (size_t)0); PG8_STAGE_A(PG8_SA(0, 1), cA + hstep, false, 1, (size_t)0);
        if (wr == 1) PG8_BAR;
        PG8_WAIT_V(2); PG8_BAR;
        PG8_STAGE(PG8_SB(1, 0), cB + kstep, voffB); PG8_STAGE_A(PG8_SA(1, 0), cA + kstep, false, 0, kstep); PG8_STAGE(PG8_SB(1, 1), cB + hstep + kstep, voffB);
        PG8_WAIT_V(6); PG8_BAR;
    } else {
        PG8_STAGE(PG8_SB(0, 0), cB, voffB); PG8_STAGE(PG8_SA(0, 0), cA, voffA); PG8_STAGE(PG8_SB(0, 1), cB + hstep, voffB); PG8_STAGE(PG8_SA(0, 1), cA + hstep, voffA);
        if (wr == 1) PG8_BAR;
        PG8_WAIT_V(4); PG8_BAR;
        PG8_STAGE(PG8_SB(1, 0), cB + kstep, voffB); PG8_STAGE(PG8_SA(1, 0), cA + kstep, voffA); PG8_STAGE(PG8_SB(1, 1), cB + hstep + kstep, voffB);
        PG8_WAIT_V(6); PG8_BAR;
    }
    for (;;) {
        const bool has_next = S.next(ui + 1, nxt);
        if constexpr (GATHER) { if (has_next) { PG8_GATHER(nxt, gAn); } else { _Pragma("unroll") for (int h_ = 0; h_ < 2; ++h_) _Pragma("unroll") for (int i_ = 0; i_ < 2; ++i_) gAn[h_][i_] = gAc[h_][i_]; } }
        const char* nA = has_next ? (const char*)g.A + (size_t)nxt.pm * tstep : cA; const char* nB = has_next ? (const char*)g.Bt + (size_t)nxt.pn * tstep : cB;
#pragma nounroll
        for (int t = 0; t < nt; t += 2) {
            const bool last = (t == nt - 2);
            const char* a1 = cA + (size_t)(t + 1) * kstep;
            const char* a2 = last ? nA : cA + (size_t)(t + 2) * kstep; const char* b2 = last ? nB : cB + (size_t)(t + 2) * kstep;
            const char* a3 = a2 + kstep; const char* b3 = b2 + kstep;
            const size_t k1 = (size_t)(t + 1) * kstep, k2 = last ? (size_t)0 : (size_t)(t + 2) * kstep, k3 = k2 + kstep; (void)k1; (void)k2; (void)k3;
            if (last && has_next) S.a_ready(nxt);
            if constexpr (SP2) {
            PG8_LDB(B0, 0, 0); PG8_LDB(B1, 0, 1); PG8_SCHED; PG8_LDA(At, 0, 0); PG8_STAGE_A(PG8_SA(1, 1), a1 + hstep, false, 1, k1);
            PG8_WAIT_V(8); PG8_WAIT_L(0); PG8_BAR; PG8_MMA(0, 0, At, B0); PG8_MMA(0, 1, At, B1); PG8_BAR; PG8_SCHED;
            PG8_LDA(At, 0, 1); PG8_STAGE(PG8_SB(0, 0), b2, voffB); PG8_STAGE(PG8_SB(0, 1), b2 + hstep, voffB); PG8_STAGE_A(PG8_SA(0, 0), a2, last, 0, k2);
            PG8_WAIT_V(8); PG8_WAIT_L(0); PG8_BAR; PG8_MMA(1, 0, At, B0); PG8_MMA(1, 1, At, B1); PG8_BAR; PG8_SCHED;
            PG8_LDB(B0, 1, 0); PG8_LDB(B1, 1, 1); PG8_SCHED; PG8_LDA(At, 1, 0); PG8_STAGE_A(PG8_SA(0, 1), a2 + hstep, last, 1, k2);
            PG8_WAIT_V(8); PG8_WAIT_L(0); PG8_BAR; PG8_MMA(0, 0, At, B0); PG8_MMA(0, 1, At, B1); PG8_BAR; PG8_SCHED;
            PG8_LDA(At, 1, 1); PG8_STAGE(PG8_SB(1, 0), b3, voffB); PG8_STAGE(PG8_SB(1, 1), b3 + hstep, voffB); PG8_STAGE_A(PG8_SA(1, 0), a3, last, 0, k3);
            PG8_WAIT_V(8); PG8_WAIT_L(0); PG8_BAR; PG8_MMA(1, 0, At, B0); PG8_MMA(1, 1, At, B1); PG8_BAR; PG8_SCHED;
            } else {
            PG8_LDB(B0, 0, 0); PG8_SCHED; PG8_LDA(At, 0, 0); PG8_STAGE(PG8_SA(1, 1), a1 + hstep, voffA);
            PG8_WAIT_L(8); PG8_BAR; PG8_WAIT_L(0); PG8_MMA(0, 0, At, B0); PG8_BAR; PG8_SCHED;
            PG8_LDB(B1, 0, 1); PG8_STAGE(PG8_SB(0, 0), b2, voffB);
            PG8_BAR; PG8_WAIT_L(0); PG8_MMA(0, 1, At, B1); PG8_BAR;
            PG8_LDA(At, 0, 1); PG8_STAGE(PG8_SA(0, 0), a2, voffA);
            PG8_BAR; PG8_WAIT_L(0); PG8_MMA(1, 0, At, B0); PG8_BAR; PG8_SCHED;
            PG8_STAGE(PG8_SB(0, 1), b2 + hstep, voffB);
            PG8_WAIT_V(6); PG8_BAR; PG8_MMA(1, 1, At, B1); PG8_BAR;
            PG8_LDB(B0, 1, 0); PG8_SCHED; PG8_LDA(At, 1, 0); PG8_STAGE(PG8_SA(0, 1), a2 + hstep, voffA);
            PG8_WAIT_L(8); PG8_BAR; PG8_WAIT_L(0); PG8_MMA(0, 0, At, B0); PG8_BAR; PG8_SCHED;
            PG8_LDB(B1, 1, 1); PG8_STAGE(PG8_SB(1, 0), b3, voffB);
            PG8_BAR; PG8_WAIT_L(0); PG8_MMA(0, 1, At, B1); PG8_BAR;
            PG8_LDA(At, 1, 1); PG8_STAGE(PG8_SA(1, 0), a3, voffA);
            PG8_BAR; PG8_WAIT_L(0); PG8_MMA(1, 0, At, B0); PG8_BAR; PG8_SCHED;
            PG8_STAGE(PG8_SB(1, 1), b3 + hstep, voffB);
            PG8_WAIT_V(6); PG8_BAR; PG8_MMA(1, 1, At, B1); PG8_BAR;
            }
        }
        if constexpr (ALIGN_EPI) { if (wr == 0) PG8_BAR; }
        if constexpr (FP8) { asm volatile("s_nop 15\n\ts_nop 15" ::: "memory"); }
        if constexpr (!Epi::AFTER_DRAIN) { E(acc, cur, wr, wc, fr, fq);
#if defined(PROBE_EPI2)
            if constexpr (FP8) { E(acc, cur, wr, wc, fr, fq); }
#endif
            S.done(cur); }
        if (!has_next) break;
#pragma unroll
        for (int a = 0; a < 2; ++a)
#pragma unroll
            for (int b = 0; b < 2; ++b)
#pragma unroll
                for (int m = 0; m < 4; ++m)
#pragma unroll
                    for (int n = 0; n < 2; ++n) acc[a][b][m][n] = (f32x4){0.f, 0.f, 0.f, 0.f};
        cur = nxt; cA = nA; cB = nB; ++ui;
        if constexpr (GATHER) { _Pragma("unroll") for (int h_ = 0; h_ < 2; ++h_) _Pragma("unroll") for (int i_ = 0; i_ < 2; ++i_) gAc[h_][i_] = gAn[h_][i_]; }
        if constexpr (ALIGN_EPI) { if (wr == 1) PG8_BAR; }
    }
    PG8_WAIT_V(0);
    if constexpr (!ALIGN_EPI) { if (wr == 0) PG8_BAR; }
    PG8_BAR;
    if constexpr (Epi::AFTER_DRAIN) { E.fused(acc, cur, wr, wc, fr, fq, lds, wid, lane); S.done(cur); }
#undef PG8_SA
#undef PG8_SB
#undef PG8_STAGE
#undef PG8_STAGE_A
#undef PG8_GATHER
#undef PG8_LDA
#undef PG8_LD32
#undef PG8_LDB
#undef PG8_MMA
#undef PG8_WAIT_V
#undef PG8_WAIT_L
#undef PG8_BAR
#undef PG8_SCHED
}
}

#ifndef PG8_SP2
#define PG8_SP2 true
#endif
#ifndef PG8_ALIGN
#define PG8_ALIGN true
#endif

#define GAS __attribute__((address_space(1)))
#define LAS __attribute__((address_space(3)))
typedef unsigned short bf16;
typedef unsigned v4u __attribute__((ext_vector_type(4)));
typedef unsigned v2u __attribute__((ext_vector_type(2)));
typedef float f32x4 __attribute__((ext_vector_type(4)));
typedef short bf16x8 __attribute__((ext_vector_type(8)));

constexpr int D = 1024, NB = 8, SEQ = 4096, CTXL = 256, TPB = SEQ + CTXL, NTOK = NB * TPB, NLAT = NB * SEQ;
constexpr int ZC = 3328;
constexpr int ZQ = 0, ZKV = 384, ZKR = 640, ZHQ = 672, ZHF = 1184, ZHB = 1696, ZHI = 2208, ZHG = 2720;
constexpr int NEXP = 32;
constexpr float ALPHA = 1.4142135623730951f;
constexpr float LN_EPS = 1e-5f, RMS_EPS = 1e-6f;
constexpr int NWAVES = 8, NTHR = 512;
constexpr float SC_X8 = 16.f, SC_WGU = 64.f, SC_ACT = 8.f, SC_WDN = 128.f, SC_Y = 64.f;
constexpr int LDS_BYTES = 147456;
constexpr int LDS_BAR_OFF = LDS_BYTES - 64;
constexpr int LDS_TILE_E = 131072;
constexpr int MAXTILES = 576;

constexpr size_t MiB = 1u << 20;
constexpr size_t WS_CTL = 0, CTL_ZERO_BYTES = 16384;
constexpr size_t WS_MODV = 1 * MiB;
constexpr size_t WS_ROPE = 1 * MiB + 512 * 1024;
constexpr size_t WS_BGU = 2 * MiB;
constexpr size_t WS_PW1B = 2 * MiB + 512 * 1024;
constexpr size_t WS_BCNT = WS_PW1B + 64 * 1024;
constexpr size_t WS_TILEE = WS_BCNT + 64 * 1024;
constexpr size_t WS_META = WS_TILEE + 4096;
constexpr size_t WS_TOPI = 3 * MiB, WS_TOPW = 4 * MiB;
constexpr int ECAP = 32768;
constexpr size_t WS_ROWS = 160 * MiB, WS_ROWW = 164 * MiB, WS_ROWD = 168 * MiB;
constexpr size_t WS_CURSOR = 14336;
constexpr size_t WS_WIN = 8 * MiB, WS_WUQ = 15 * MiB, WS_WUKV = 16 * MiB, WS_WOUT = 17 * MiB, WS_WPW1 = 19 * MiB, WS_WPW2 = 23 * MiB;
constexpr size_t WS_WGU = 32 * MiB, WS_WDN = 288 * MiB;
constexpr size_t WS_H = 416 * MiB;
constexpr size_t WS_X = 552 * MiB, WS_Y = 620 * MiB;
constexpr size_t WS_BIG = 688 * MiB;
constexpr size_t WS_Z = WS_BIG, WS_CQN = WS_BIG + 221 * MiB, WS_CKVN = WS_BIG + 247 * MiB, WS_KRR = WS_BIG + 264 * MiB,
                 WS_Q = WS_BIG + 267 * MiB, WS_KV = WS_BIG + 318 * MiB, WS_OF = WS_BIG + 386 * MiB, WS_OB = WS_BIG + 454 * MiB;
constexpr size_t WS_HT = WS_BIG + 528 * MiB;
constexpr size_t WS_XS = WS_BIG, WS_ACT = WS_BIG + 288 * MiB, WS_YB = WS_BIG + 576 * MiB;
constexpr size_t WS_END = WS_BIG + 848 * MiB;
static_assert((size_t)NTOK * ZC * 2 <= 221 * MiB && (size_t)NTOK * 384 * 2 <= 26 * MiB && (size_t)NTOK * 256 * 2 <= 17 * MiB && (size_t)NTOK * 32 * 2 <= 3 * MiB, "ws map 1");
static_assert((size_t)NTOK * 768 * 2 <= 51 * MiB && (size_t)NTOK * 1024 * 2 <= 68 * MiB && (size_t)NTOK * 512 * 4 <= 68 * MiB, "ws map 2");
static_assert((size_t)64 * 136 * 26624 <= 320 * MiB && (size_t)MAXTILES * 256 * 2048 <= 288 * MiB && (size_t)NLAT * 4 * 2048 <= 272 * MiB && (size_t)NTOK * 1024 * 4 <= 136 * MiB, "ws map 3");

#define LDS_WAIT() asm volatile("s_waitcnt lgkmcnt(0)" ::: "memory")
#define VM_WAIT() asm volatile("s_waitcnt vmcnt(0)" ::: "memory")
__device__ __forceinline__ float bf2f(unsigned short b) { return __uint_as_float(((unsigned)b) << 16); }
__device__ __forceinline__ unsigned pk2(float lo, float hi) { return pg8::cvt_pk_bf16(lo, hi); }
__device__ __forceinline__ float sigm(float x) { return __builtin_amdgcn_rcpf(1.f + __expf(-x)); }
__device__ __forceinline__ float wave_sum(float v) {
#pragma unroll
    for (int o = 1; o < 64; o <<= 1) v += __shfl_xor(v, o);
    return v;
}
__device__ __forceinline__ int ld_ctl(const int* p) { return (int)__hip_atomic_load((const unsigned*)p, __ATOMIC_RELAXED, __HIP_MEMORY_SCOPE_AGENT); }
__device__ __forceinline__ int grow_of(int lr) { return (lr >> 12) * TPB + CTXL + (lr & 4095); }

#define XB_TMO      128
#define XB_XCNT(j)  (256  + 64 * (j))
#define XB_XSUB(j)  (1280 + 64 * (j))
#define XB_XGEN(j)  (2304 + 64 * (j))
#define XB_TOP      3328
#define XB_TOPGEN   3392
#define XCD_BAR_WORDS 3456
#define XB_SPIN_CAP (1u << 21)

__device__ __forceinline__ unsigned xb_ld(unsigned* p)              { return __hip_atomic_load(p, __ATOMIC_RELAXED, __HIP_MEMORY_SCOPE_AGENT); }
__device__ __forceinline__ unsigned xb_add(unsigned* p, unsigned v) { return __hip_atomic_fetch_add(p, v, __ATOMIC_RELAXED, __HIP_MEMORY_SCOPE_AGENT); }
__device__ __forceinline__ unsigned xb_xcc_id() { return (unsigned)__builtin_amdgcn_s_getreg((3 << 11) | 20) & 0xFu; }
#define XB_SPIN(cond, bar) do { unsigned _sp = 0; while (cond) { __builtin_amdgcn_s_sleep(1); \
    if ((++_sp & 255u) == 0u) { if (xb_ld(&(bar)[XB_TMO])) break; if (_sp > XB_SPIN_CAP) { atomicAdd(&(bar)[XB_TMO], 1u); break; } } } } while (0)

struct XcdBarrier { unsigned* bar; unsigned x; volatile LAS unsigned* st; };

__device__ __forceinline__ XcdBarrier xcd_barrier_post(unsigned* bar, volatile LAS unsigned* st) {
    XcdBarrier b; b.bar = bar; b.x = xb_xcc_id(); b.st = st;
    if (threadIdx.x == 0) (void)xb_add(&bar[XB_XCNT(b.x)], 1u);
    return b;
}
__device__ __forceinline__ void xcd_barrier_complete(unsigned* bar, unsigned x, unsigned& nloc, unsigned& nx) {
    const unsigned G = gridDim.x * gridDim.y * gridDim.z;
    unsigned sum, cnt, mine, sp = 0u;
    for (;;) {
        sum = 0u; cnt = 0u; mine = 0u;
#pragma unroll
        for (unsigned j = 0; j < 16; ++j) { const unsigned c = xb_ld(&bar[XB_XCNT(j)]); sum += c; cnt += (c > 0u) ? 1u : 0u; mine = (j == x) ? c : mine; }
        if (sum == G) break;
        __builtin_amdgcn_s_sleep(1);
        if ((++sp & 255u) == 0u) { if (xb_ld(&bar[XB_TMO])) break; if (sp > XB_SPIN_CAP) { atomicAdd(&bar[XB_TMO], 1u); break; } }
    }
    nloc = mine > 0u ? mine : 1u; nx = cnt > 0u ? cnt : 1u;
}
__device__ __forceinline__ void xcd_barrier(const XcdBarrier& b) {
    asm volatile("s_waitcnt vmcnt(0)" ::: "memory");
    __syncthreads();
    if (threadIdx.x == 0) {
        unsigned* bar = b.bar;
        __builtin_amdgcn_s_waitcnt(0);
        unsigned nloc = b.st[0], nx = b.st[1];
        if (nloc == 0u) { xcd_barrier_complete(bar, b.x, nloc, nx); b.st[0] = nloc; b.st[1] = nx; }
        const unsigned old = xb_add(&bar[XB_XSUB(b.x)], 1u);
        const unsigned gen = old / nloc;
        if (old + 1u == (gen + 1u) * nloc) {
            __builtin_amdgcn_fence(__ATOMIC_RELEASE, "agent");
            asm volatile("s_waitcnt vmcnt(0)" ::: "memory");
            const unsigned og = xb_add(&bar[XB_TOP], 1u);
            const unsigned tg = og / nx;
            if (og + 1u == (tg + 1u) * nx) xb_add(&bar[XB_TOPGEN], 1u);
            else XB_SPIN(xb_ld(&bar[XB_TOPGEN]) == tg, bar);
            __builtin_amdgcn_fence(__ATOMIC_ACQUIRE, "agent");
            xb_add(&bar[XB_XGEN(b.x)], 1u);
            asm volatile("s_waitcnt vmcnt(0)" ::: "memory");
        } else {
            XB_SPIN(xb_ld(&bar[XB_XGEN(b.x)]) == gen, bar);
            __builtin_amdgcn_fence(__ATOMIC_ACQUIRE, "agent");
            asm volatile("s_waitcnt vmcnt(0)" ::: "memory");
        }
    }
    __syncthreads();
}

namespace pg8 {
struct TileOrder {
    int nM, nN, nwg, G, c;
    __device__ __forceinline__ void init(int nM_, int nN_, int G_, int c_) { nM = nM_; nN = nN_; nwg = nM * nN; G = G_; c = c_; }
    __device__ __forceinline__ bool logical(int i, int& im, int& in) const {
        const long L = (long)i * G + c; if (L >= nwg) return false;
        int wgid = (int)L; { const int q = nwg / NXCD, r = nwg % NXCD, xcd = wgid % NXCD, off = wgid / NXCD; wgid = (xcd < r ? xcd * (q + 1) : r * (q + 1) + (xcd - r) * q) + off; }
        const int nig = WGM * nN, gid = wgid / nig, fm = gid * WGM, gsz = (nM - fm) < WGM ? (nM - fm) : WGM;
        im = fm + ((wgid % nig) % gsz); in = (wgid % nig) / gsz; return true;
    }
    __device__ __forceinline__ void a_ready(const Unit&) const {}
    __device__ __forceinline__ void done(const Unit&) const {}
};
struct AllOrder : TileOrder { __device__ __forceinline__ bool next(int i, Unit& u) const { int im, in; if (!logical(i, im, in)) return false; u.pm = im; u.pn = in; return true; } };
struct LatOrder : TileOrder {
    __device__ __forceinline__ bool next(int i, Unit& u) const { int im, in; if (!logical(i, im, in)) return false; u.pm = (im >> 4) * 17 + 1 + (im & 15); u.pn = in; return true; } };
struct MoeOrder : TileOrder {
    const PG8_LAS int* tile_e; int nper;
    __device__ __forceinline__ bool next(int i, Unit& u) const { int im, in; if (!logical(i, im, in)) return false; u.pm = im; u.pn = tile_e[im] * nper + in; return true; } };

struct EpiRes {
    static constexpr bool PERM = false, AFTER_DRAIN = false;
    const float* xin; float* h; const float* modv; const float* bias;
    __device__ __forceinline__ void operator()(const f32x4 (&acc)[2][2][4][2], const Unit& u, int wr, int wc, int fr, int fq) const {
        asm volatile("" : "+v"(fr), "+v"(fq));
        const int b = u.pm / 17, j = u.pm % 17;
        const int rl0 = wr * 64 + fr, col0 = u.pn * BM + wc * 32 + 4 * fq;
        const float* gate = modv + (size_t)b * 6144 + 2048;
        f32x4 gv[2][2], bv[2][2];
#pragma unroll
        for (int bj = 0; bj < 2; ++bj)
#pragma unroll
            for (int n = 0; n < 2; ++n) { gv[bj][n] = *(const f32x4*)(gate + col0 + bj * HALF + n * 16); bv[bj][n] = bias ? *(const f32x4*)(bias + col0 + bj * HALF + n * 16) : (f32x4){0.f, 0.f, 0.f, 0.f}; }
#pragma unroll
        for (int ai = 0; ai < 2; ++ai)
#pragma unroll
            for (int m = 0; m < 4; ++m) { const int rl = rl0 + ai * HALF + m * 16; const size_t grow = (size_t)u.pm * BM + rl;
                const float* hin = xin ? xin + ((size_t)b * 4096 + (size_t)(j - 1) * 256 + rl) * 1024 + col0 : h + grow * 1024 + col0;
                float* ho = h + grow * 1024 + col0;
#pragma unroll
                for (int bj = 0; bj < 2; ++bj)
#pragma unroll
                    for (int n = 0; n < 2; ++n) { const f32x4 hv = *(const f32x4*)(hin + bj * HALF + n * 16);
                        *(f32x4*)(ho + bj * HALF + n * 16) = hv * 1.4142135623730951f + gv[bj][n] * (acc[ai][bj][m][n] + bv[bj][n]); } }
    }
};
template <int MODE, bool OUT8 = false> struct EpiGate {
    static constexpr bool PERM = true, AFTER_DRAIN = false;
    bf16_t* O; const float* bias; int nper; float ascale, oscale;
    __device__ __forceinline__ void operator()(const f32x4 (&acc)[2][2][4][2], const Unit& u, int wr, int wc, int fr, int fq) const {
        asm volatile("" : "+v"(fr), "+v"(fq));
        const int row0 = u.pm * BM + wr * 64 + fr, pnl = u.pn % nper, ocol0 = pnl * HALF + wc * 32 + 8 * fq, bcol0 = u.pn * BM + wc * 32 + 8 * fq;
        const float s0 = ascale, s1 = MODE == 1 ? ascale * oscale : ascale;
        f32x4 bv[2][2];
#pragma unroll
        for (int n = 0; n < 2; ++n) { bv[0][n] = *(const f32x4*)(bias + bcol0 + 4 * n); const f32x4 t = *(const f32x4*)(bias + bcol0 + HALF + 4 * n); bv[1][n] = MODE == 1 ? (t + 1.0f) * oscale : t; }
#pragma unroll
        for (int ai = 0; ai < 2; ++ai)
#pragma unroll
            for (int m = 0; m < 4; ++m) { bf16_t* rowp = O + (size_t)(row0 + ai * HALF + m * 16) * 1024 + ocol0;
                unsigned char* rowp8 = (unsigned char*)O + (size_t)(row0 + ai * HALF + m * 16) * 1024 + ocol0;
                float o[8];
#pragma unroll
                for (int n = 0; n < 2; ++n) { const f32x4 a = acc[ai][0][m][n] * s0 + bv[0][n], g = acc[ai][1][m][n] * s1 + bv[1][n];
#pragma unroll
                    for (int e = 0; e < 4; ++e) {
                        if (MODE == 0) { o[4 * n + e] = a[e] * __builtin_amdgcn_rcpf(1.f + __builtin_amdgcn_exp2f(g[e] * -1.4426950408889634f)); }
                        else { const float gt = fminf(a[e], 7.0f), up1 = __builtin_amdgcn_fmed3f(g[e], -6.0f * oscale, 8.0f * oscale);
                            o[4 * n + e] = up1 * (gt * __builtin_amdgcn_rcpf(1.f + __builtin_amdgcn_exp2f(gt * (-1.702f * 1.4426950408889634f)))); } } }
                if constexpr (OUT8) {
                    int w0 = 0, w1 = 0; w0 = __builtin_amdgcn_cvt_pk_fp8_f32(o[0], o[1], w0, false); w0 = __builtin_amdgcn_cvt_pk_fp8_f32(o[2], o[3], w0, true);
                    w1 = __builtin_amdgcn_cvt_pk_fp8_f32(o[4], o[5], w1, false); w1 = __builtin_amdgcn_cvt_pk_fp8_f32(o[6], o[7], w1, true);
                    typedef unsigned u32x2 __attribute__((ext_vector_type(2))); *(u32x2*)rowp8 = (u32x2){(unsigned)w0, (unsigned)w1}; (void)rowp;
                } else { (void)rowp8;
                u32x4 w; w.x = cvt_pk_bf16(o[0], o[1]); w.y = cvt_pk_bf16(o[2], o[3]); w.z = cvt_pk_bf16(o[4], o[5]); w.w = cvt_pk_bf16(o[6], o[7]);
                *(u32x4*)rowp = w; } }
    }
};
struct EpiDown {
    static constexpr bool PERM = true, AFTER_DRAIN = false;
    bf16_t* Y; const float* bias; const float* row_w; const int* row_dst; float ascale; const PG8_LAS int* gtab; float oscale;
    __device__ __forceinline__ void operator()(const f32x4 (&acc)[2][2][4][2], const Unit& u, int wr, int wc, int fr, int fq) const {
        asm volatile("" : "+v"(fr), "+v"(fq));
        const int pnl = u.pn & 3, ocol0 = pnl * BM + wc * 32 + 8 * fq, bcol0 = u.pn * BM + wc * 32 + 8 * fq; const int tbase = gtab[u.pm], tcnt = gtab[576 + u.pm];
        f32x4 bv[2][2];
#pragma unroll
        for (int bj = 0; bj < 2; ++bj)
#pragma unroll
            for (int n = 0; n < 2; ++n) bv[bj][n] = *(const f32x4*)(bias + bcol0 + bj * HALF + 4 * n);
#pragma unroll
        for (int ai = 0; ai < 2; ++ai)
#pragma unroll
            for (int m = 0; m < 4; ++m) { const int rl = wr * 64 + fr + ai * HALF + m * 16;
                if (rl < tcnt) { const int dst = row_dst[tbase + rl]; const float w8 = row_w[tbase + rl] * oscale; unsigned char* rowp = (unsigned char*)Y + (size_t)dst * 1024 + ocol0;
#pragma unroll
                    for (int bj = 0; bj < 2; ++bj) { const f32x4 v0 = (acc[ai][bj][m][0] * ascale + bv[bj][0]) * w8, v1 = (acc[ai][bj][m][1] * ascale + bv[bj][1]) * w8;
                        int w0 = 0, w1 = 0; w0 = __builtin_amdgcn_cvt_pk_fp8_f32(fminf(fmaxf(v0[0], -448.f), 448.f), fminf(fmaxf(v0[1], -448.f), 448.f), w0, false); w0 = __builtin_amdgcn_cvt_pk_fp8_f32(fminf(fmaxf(v0[2], -448.f), 448.f), fminf(fmaxf(v0[3], -448.f), 448.f), w0, true);
                        w1 = __builtin_amdgcn_cvt_pk_fp8_f32(fminf(fmaxf(v1[0], -448.f), 448.f), fminf(fmaxf(v1[1], -448.f), 448.f), w1, false); w1 = __builtin_amdgcn_cvt_pk_fp8_f32(fminf(fmaxf(v1[2], -448.f), 448.f), fminf(fmaxf(v1[3], -448.f), 448.f), w1, true);
                        typedef unsigned u32x2 __attribute__((ext_vector_type(2))); *(u32x2*)(rowp + bj * HALF) = (u32x2){(unsigned)w0, (unsigned)w1}; } } }
    }
};
}

namespace att {
using bf16x8 = __attribute__((ext_vector_type(8))) short;
using s16x4  = __attribute__((ext_vector_type(4))) short;
using f32x16 = __attribute__((ext_vector_type(16))) float;
using u32x4  = __attribute__((ext_vector_type(4))) unsigned;
constexpr int NW = 8, QBLK = 32, KVBLK = 64;
constexpr float SCALE = 0.10206207261596575f;
constexpr float THR = 8.f;
constexpr int SHM_V = 16384, SHM_K = 16384, SHM_ATTN = 2 * SHM_V + 2 * SHM_K + NW * 64 * 4;
#define KSWZ(row, colB) ((row) * 256 + ((colB) ^ (((row) & 7) << 4)))
#define SBAR() __builtin_amdgcn_sched_barrier(0)
__device__ __forceinline__ int crow(int r, int hi) { return (r & 3) + 8 * (r >> 2) + 4 * hi; }
__device__ __forceinline__ unsigned cvtpk(float lo, float hi) { unsigned r; asm volatile("v_cvt_pk_bf16_f32 %0, %1, %2" : "=v"(r) : "v"(lo), "v"(hi)); return r; }

__device__ __forceinline__ void partialSM(f32x16& p0, f32x16& p1, float& m_reg, float& mn, float& alpha) {
  constexpr float C = SCALE * 1.4426950408889634f;
  float pmax = p0[0];
#pragma unroll
  for (int r = 1; r < 16; ++r) pmax = fmaxf(pmax, p0[r]);
#pragma unroll
  for (int r = 0; r < 16; ++r) pmax = fmaxf(pmax, p1[r]);
  { auto rr = __builtin_amdgcn_permlane32_swap(__float_as_uint(pmax), __float_as_uint(pmax), false, false);
    pmax = fmaxf(__uint_as_float(rr[0]), __uint_as_float(rr[1])); }
  if (__builtin_expect(__all(pmax - m_reg <= THR / SCALE), 1)) { mn = m_reg; alpha = 1.f; }
  else { mn = fmaxf(m_reg, pmax); alpha = __builtin_amdgcn_exp2f((m_reg - mn) * C); m_reg = mn; }
  float mnC = -mn * C;
#pragma unroll
  for (int r = 0; r < 16; ++r) p0[r] = fmaf(p0[r], C, mnC);
#pragma unroll
  for (int r = 0; r < 16; ++r) p1[r] = fmaf(p1[r], C, mnC);
#pragma unroll
  for (int r = 0; r < 16; ++r) p0[r] = __builtin_amdgcn_exp2f(p0[r]);
}
__device__ __forceinline__ void finishSM(f32x16& p0, f32x16& p1, float alpha, float& l_reg, bf16x8& pa0, bf16x8& pa1, bf16x8& pa2, bf16x8& pa3) {
#pragma unroll
  for (int r = 0; r < 16; ++r) p1[r] = __builtin_amdgcn_exp2f(p1[r]);
  float ps = 0;
#pragma unroll
  for (int r = 0; r < 16; ++r) ps += p0[r];
#pragma unroll
  for (int r = 0; r < 16; ++r) ps += p1[r];
  { auto rr = __builtin_amdgcn_permlane32_swap(__float_as_uint(ps), __float_as_uint(ps), false, false);
    ps = __uint_as_float(rr[0]) + __uint_as_float(rr[1]); }
  l_reg = l_reg * alpha + ps;
#define PK4(P, BASE, OUT) do { unsigned a0 = cvtpk(P[BASE + 0], P[BASE + 1]), a1 = cvtpk(P[BASE + 2], P[BASE + 3]);   \
    unsigned b0 = cvtpk(P[BASE + 4], P[BASE + 5]), b1 = cvtpk(P[BASE + 6], P[BASE + 7]);                              \
    auto r0 = __builtin_amdgcn_permlane32_swap(a0, b0, false, false); auto r1 = __builtin_amdgcn_permlane32_swap(a1, b1, false, false); \
    u32x4 w = {r0[0], r1[0], r0[1], r1[1]}; OUT = *reinterpret_cast<bf16x8*>(&w); } while (0)
  PK4(p0, 0, pa0); PK4(p0, 8, pa1); PK4(p1, 0, pa2); PK4(p1, 8, pa3);
#undef PK4
}
__device__ __forceinline__ void qkt(f32x16& p0, f32x16& p1, const bf16* Ks, const bf16x8* qr, int r32, int hi) {
  p0 = f32x16{}; p1 = f32x16{};
#pragma unroll
  for (int d0 = 0; d0 < 6; ++d0) { int cb = (d0 * 16 + hi * 8) * 2;
    bf16x8 b0 = *reinterpret_cast<const bf16x8*>((const char*)Ks + KSWZ(r32, cb));
    bf16x8 b1 = *reinterpret_cast<const bf16x8*>((const char*)Ks + KSWZ(32 + r32, cb));
    p0 = __builtin_amdgcn_mfma_f32_32x32x16_bf16(b0, qr[d0], p0, 0, 0, 0);
    p1 = __builtin_amdgcn_mfma_f32_32x32x16_bf16(b1, qr[d0], p1, 0, 0, 0); }
}
__device__ __forceinline__ int v_st(int k, int c) { const int kk = (k & ~0xC) | ((k & 4) << 1) | ((k & 8) >> 1); return ((kk >> 3) * 4 + (c >> 5)) * 512 + ((kk & 7) * 32 + (c & 31)) * 2; }
__device__ __forceinline__ int v_rd_base(int lane) { return ((lane & 3) << 3) | (((lane >> 2) & 3) << 6) | (((lane >> 4) & 1) << 5) | (((lane >> 5) & 1) << 8); }
constexpr int v_rd_off(int d0, int ks, int half) { return d0 * 512 + ks * 4096 + half * 2048; }
template <int OFF> __device__ __forceinline__ s16x4 tr_read(int vb) {
  s16x4 r; asm volatile("ds_read_b64_tr_b16 %0, %1 offset:%2" : "=&v"(r) : "v"(vb), "i"(OFF) : "memory"); return r;
}
template <int D0> __device__ __forceinline__ void pv_one(f32x16& od, int vb, bf16x8 pa0, bf16x8 pa1, bf16x8 pa2, bf16x8 pa3) {
  const s16x4 l0 = tr_read<v_rd_off(D0, 0, 0)>(vb), h0 = tr_read<v_rd_off(D0, 0, 1)>(vb), l1 = tr_read<v_rd_off(D0, 1, 0)>(vb), h1 = tr_read<v_rd_off(D0, 1, 1)>(vb);
  const s16x4 l2 = tr_read<v_rd_off(D0, 2, 0)>(vb), h2 = tr_read<v_rd_off(D0, 2, 1)>(vb), l3 = tr_read<v_rd_off(D0, 3, 0)>(vb), h3 = tr_read<v_rd_off(D0, 3, 1)>(vb);
  asm volatile("s_waitcnt lgkmcnt(0)" ::: "memory"); SBAR();
#define PK(L, H) (bf16x8){L[0], L[1], L[2], L[3], H[0], H[1], H[2], H[3]}
  od = __builtin_amdgcn_mfma_f32_32x32x16_bf16(pa0, PK(l0, h0), od, 0, 0, 0);
  od = __builtin_amdgcn_mfma_f32_32x32x16_bf16(pa1, PK(l1, h1), od, 0, 0, 0);
  od = __builtin_amdgcn_mfma_f32_32x32x16_bf16(pa2, PK(l2, h2), od, 0, 0, 0);
  od = __builtin_amdgcn_mfma_f32_32x32x16_bf16(pa3, PK(l3, h3), od, 0, 0, 0);
#undef PK
}
__device__ __forceinline__ void pv_d0(f32x16* o, int vb, bf16x8 pa0, bf16x8 pa1, bf16x8 pa2, bf16x8 pa3) {
  pv_one<0>(o[0], vb, pa0, pa1, pa2, pa3); pv_one<1>(o[1], vb, pa0, pa1, pa2, pa3);
}
__device__ __forceinline__ bf16x8 rope8(bf16x8 x, const float* tab, int pbase) {
  u32x4 w;
#pragma unroll
  for (int i = 0; i < 4; ++i) { const float x1 = __uint_as_float(((unsigned)(unsigned short)x[2 * i]) << 16), x2 = __uint_as_float(((unsigned)(unsigned short)x[2 * i + 1]) << 16);
    const float cs = tab[pbase + i], sn = tab[16 + pbase + i]; w[i] = cvtpk(x1 * cs - x2 * sn, x1 * sn + x2 * cs); }
  return *reinterpret_cast<bf16x8*>(&w);
}
__device__ __forceinline__ void attn_unit(const bf16* __restrict__ Qb, const bf16* __restrict__ KVb, const bf16* __restrict__ KRb, bf16* __restrict__ Ob,
                                          const float* __restrict__ rope, int seq, char* lds) {
  int tid_l = threadIdx.x; asm volatile("" : "+v"(tid_l));
  const int tid = tid_l, wid = tid >> 6, lane = tid & 63, r32 = lane & 31, hi = lane >> 5;
  bf16* V_lds = (bf16*)lds; bf16* K_lds = (bf16*)(lds + 2 * SHM_V);
  float* ws = (float*)(lds + 2 * SHM_V + 2 * SHM_K) + wid * 64; float* li_l = ws; float* al_l = ws + 32;
  float m_reg = -1e30f, l_reg = 0; f32x16 o[2] = {}; bf16x8 qr[6];
  const bf16* Qw = Qb + (long)(wid * QBLK + r32) * 768 + hi * 8;
#pragma unroll
  for (int d0 = 0; d0 < 6; ++d0) qr[d0] = *reinterpret_cast<const bf16x8*>(Qw + d0 * 16);
  if (rope) { const float* tab = rope + (long)(wid * QBLK + r32) * 32; qr[4] = rope8(qr[4], tab, 4 * hi); qr[5] = rope8(qr[5], tab, 8 + 4 * hi); }
  const int sr = tid >> 4, ch = tid & 15;
  const bf16* kbase = ch < 8 ? KVb + ch * 8 : KRb + ((ch - 8) & 3) * 8; const long kstr = ch < 8 ? 1024 : 32;
  const int vkey = tid >> 3, vc8 = (tid & 7) * 8, vst0 = v_st(vkey, vc8);
  const bf16* vbase = KVb + 512 + vc8;
  const int vb0 = (int)(uintptr_t)V_lds + v_rd_base(lane);
  struct { bf16x8 vs0, ks0, ks1; } sr_[2];
#define SLOAD(i, k0) do { sr_[i].vs0 = *reinterpret_cast<const bf16x8*>(vbase + (long)((k0) + vkey) * 1024); \
    sr_[i].ks0 = *reinterpret_cast<const bf16x8*>(kbase + (long)((k0) + sr) * kstr); sr_[i].ks1 = *reinterpret_cast<const bf16x8*>(kbase + (long)((k0) + 32 + sr) * kstr); } while (0)
#define SWRITE(b, i) do { *(bf16x8*)((char*)V_lds + (b) * SHM_V + vst0) = sr_[i].vs0; int kc = ch * 16;               \
    *(bf16x8*)((char*)K_lds + (b) * SHM_K + KSWZ(sr, kc)) = sr_[i].ks0;                       \
    *(bf16x8*)((char*)K_lds + (b) * SHM_K + KSWZ(32 + sr, kc)) = sr_[i].ks1; } while (0)
#define SWAIT() asm volatile("s_waitcnt vmcnt(3)" ::: "memory")
#define RESC(a) do { if (__any((a) < 1.f)) { if (hi == 0) al_l[r32] = (a); asm volatile("s_waitcnt lgkmcnt(0)" ::: "memory"); \
    _Pragma("unroll") for (int d = 0; d < 2; ++d) _Pragma("unroll") for (int r = 0; r < 16; ++r) o[d][r] *= al_l[crow(r, hi)]; } } while (0)
  f32x16 pA0, pA1, pB0, pB1; float mnA, mnB, alA, alB; bf16x8 pa0, pa1, pa2, pa3; const int NT = seq / KVBLK;
  constexpr int SE = 0, SO = 1;
  SLOAD(SE, 0); asm volatile("s_waitcnt vmcnt(0)" ::: "memory"); SWRITE(0, SE); __syncthreads();
  qkt(pA0, pA1, K_lds, qr, r32, hi); partialSM(pA0, pA1, m_reg, mnA, alA);
  SLOAD(SO, KVBLK); if (2 < NT) SLOAD(SE, 2 * KVBLK);
  SWAIT(); SWRITE(1, SO); __syncthreads();
  for (int j = 1; j + 1 < NT; j += 2) {
    SBAR(); qkt(pB0, pB1, (bf16*)((char*)K_lds + SHM_K), qr, r32, hi);
    finishSM(pA0, pA1, alA, l_reg, pa0, pa1, pa2, pa3); SBAR();
    SLOAD(SO, (j + 2) * KVBLK); SBAR();
    pv_d0(o, vb0, pa0, pa1, pa2, pa3); partialSM(pB0, pB1, m_reg, mnB, alB);
    __syncthreads(); SWAIT(); SWRITE(0, SE);
    RESC(alB); __syncthreads();
    SBAR(); qkt(pA0, pA1, K_lds, qr, r32, hi);
    finishSM(pB0, pB1, alB, l_reg, pa0, pa1, pa2, pa3); SBAR();
    if (j + 3 < NT) SLOAD(SE, (j + 3) * KVBLK); SBAR();
    pv_d0(o, vb0 + (int)SHM_V, pa0, pa1, pa2, pa3); partialSM(pA0, pA1, m_reg, mnA, alA);
    __syncthreads(); SWAIT(); SWRITE(1, SO);
    RESC(alA); __syncthreads();
  }
  SBAR(); qkt(pB0, pB1, (bf16*)((char*)K_lds + SHM_K), qr, r32, hi);
  finishSM(pA0, pA1, alA, l_reg, pa0, pa1, pa2, pa3); SBAR();
  pv_d0(o, vb0, pa0, pa1, pa2, pa3); partialSM(pB0, pB1, m_reg, mnB, alB);
  __syncthreads(); RESC(alB);
  finishSM(pB0, pB1, alB, l_reg, pa0, pa1, pa2, pa3); SBAR();
  pv_d0(o, vb0 + (int)SHM_V, pa0, pa1, pa2, pa3);
  if (hi == 0) li_l[r32] = l_reg; asm volatile("s_waitcnt lgkmcnt(0)" ::: "memory");
  float rli[16];
#pragma unroll
  for (int r = 0; r < 16; ++r) rli[r] = __builtin_amdgcn_rcpf(li_l[crow(r, hi)]);
  bf16* Ow = Ob + (long)(wid * QBLK) * 1024;
#pragma unroll
  for (int r = 0; r < 16; ++r) { int orow = crow(r, hi);
#pragma unroll
    for (int d0 = 0; d0 < 2; ++d0) { const float v = o[d0][r] * rli[r]; Ow[(long)orow * 1024 + d0 * 32 + r32] = (bf16)(cvtpk(v, v) & 0xffffu); } }
#undef SLOAD
#undef SWRITE
#undef SWAIT
#undef RESC
}
}

struct Args { const float* in[33]; float* out; unsigned char* ws; int ph_lo, ph_hi; };
enum { I_X = 0, I_C, I_CTX, I_CCTX, I_MODW, I_MODB, I_LN1G, I_LN1B, I_LN2G, I_LN2B, I_WIN, I_QNORM, I_KVNORM, I_WUQ, I_WUK, I_WUV, I_LBL, I_HGNORM, I_WOUT,
       I_PW1W, I_PW1B, I_DWW, I_DWB, I_CLNG, I_CLNB, I_PW2W, I_PW2B, I_RW, I_RB, I_WGU, I_BGU, I_WDN, I_BDN };

__device__ __forceinline__ int dst_row(int n, int mode, int row_off) {
    if (mode == 0) return row_off + n;
    int f, g; if (mode == 1) { f = n >> 1; g = n & 1; } else { g = n >> 10; f = n & 1023; }
    return row_off + 256 * (f >> 7) + 128 * g + (f & 127);
}
__device__ __forceinline__ unsigned pack_fp8x4(float a, float b, float c, float d) { int w = 0; w = __builtin_amdgcn_cvt_pk_fp8_f32(fminf(fmaxf(a, -448.f), 448.f), fminf(fmaxf(b, -448.f), 448.f), w, false);
    w = __builtin_amdgcn_cvt_pk_fp8_f32(fminf(fmaxf(c, -448.f), 448.f), fminf(fmaxf(d, -448.f), 448.f), w, true); return (unsigned)w; }
struct TrItem { const float* W; bf16* WT; int K, N, mode, row_off, item; float f8scale; };
__device__ __forceinline__ void tr_load(const TrItem& d, f32x4 (&v)[16], int lane) {
    const int nblk = (d.N + 63) >> 6, kb = d.item / nblk, nb = d.item - kb * nblk, k0 = 64 * kb, n0 = 64 * nb;
    const int nc = n0 + 4 * (lane & 15), kr = lane >> 4;
#pragma unroll
    for (int i = 0; i < 16; ++i) v[i] = (nc < d.N) ? __builtin_nontemporal_load((const f32x4*)(d.W + (size_t)(k0 + 4 * i + kr) * d.N + nc)) : (f32x4){0.f, 0.f, 0.f, 0.f};
}
__device__ __forceinline__ void tr_lds_write(const f32x4 (&v)[16], LAS float* scr, int lane) {
    const int kr = lane >> 4;
#pragma unroll
    for (int i = 0; i < 16; ++i) { LAS float* s = scr + (4 * i + kr) * 65 + 4 * (lane & 15); s[0] = v[i][0]; s[1] = v[i][1]; s[2] = v[i][2]; s[3] = v[i][3]; }
}
__device__ __forceinline__ void tr_store(const TrItem& d, LAS float* scr, int lane) {
    const int nblk = (d.N + 63) >> 6, kb = d.item / nblk, nb = d.item - kb * nblk, k0 = 64 * kb, n0 = 64 * nb;
    const int c = lane & 7; const int K = d.K;
#pragma unroll
    for (int j = 0; j < 8; ++j) { const int nl = (lane >> 3) + 8 * j, n = n0 + nl; const LAS float* s = scr + (8 * c) * 65 + nl;
        if (n < d.N) { if (d.f8scale > 0.f) { const float f8 = d.f8scale; v2u o8; o8.x = pack_fp8x4(s[0 * 65] * f8, s[1 * 65] * f8, s[2 * 65] * f8, s[3 * 65] * f8); o8.y = pack_fp8x4(s[4 * 65] * f8, s[5 * 65] * f8, s[6 * 65] * f8, s[7 * 65] * f8);
                *(v2u*)((unsigned char*)d.WT + (size_t)dst_row(n, d.mode, d.row_off) * K + k0 + 8 * c) = o8; }
            else { v4u o; o.x = pk2(s[0 * 65], s[1 * 65]); o.y = pk2(s[2 * 65], s[3 * 65]); o.z = pk2(s[4 * 65], s[5 * 65]); o.w = pk2(s[6 * 65], s[7 * 65]);
                *(v4u*)(d.WT + (size_t)dst_row(n, d.mode, d.row_off) * K + k0 + 8 * c) = o; } } }
}
__device__ __forceinline__ void phase_prologue(const Args& a, LAS unsigned char* lds, int tid, int lane, int wave) {
    unsigned char* ws = a.ws;
    const int G = gridDim.x, B = blockIdx.x;
    {
        LAS float* sc = (LAS float*)lds;
        LAS float* red = (LAS float*)(lds + 36864);
        float* modv = (float*)(ws + WS_MODV);
        bool have = false;
        for (int it = B; it < 192; it += G) {
            if (!have) { for (int i = tid; i < 9 * 1024; i += NTHR) { const int r = i >> 10, k = i & 1023; const float x = r < 8 ? a.in[I_C][r * 1024 + k] : a.in[I_CCTX][k]; sc[i] = x * sigm(x); } __syncthreads(); have = true; }
            const int l = it / 96, jc = it % 96, kg = tid >> 6, jj = tid & 63, j = jc * 64 + jj;
            float acc[9];
#pragma unroll
            for (int r = 0; r < 9; ++r) acc[r] = 0.f;
            const float* wp = a.in[I_MODW] + ((size_t)l * 1024 + kg * 128) * 6144 + j;
            for (int k0 = 0; k0 < 128; k0 += 16) { float w[16];
#pragma unroll
                for (int kk = 0; kk < 16; ++kk) w[kk] = wp[(size_t)(k0 + kk) * 6144];
#pragma unroll
                for (int kk = 0; kk < 16; ++kk)
#pragma unroll
                    for (int r = 0; r < 9; ++r) acc[r] += sc[r * 1024 + kg * 128 + k0 + kk] * w[kk]; }
#pragma unroll
            for (int r = 0; r < 9; ++r) red[(kg * 9 + r) * 64 + jj] = acc[r];
            __syncthreads();
            for (int i = tid; i < 576; i += NTHR) { const int r = i >> 6, j2 = i & 63; float s = a.in[I_MODB][l * 6144 + jc * 64 + j2];
#pragma unroll
                for (int g = 0; g < 8; ++g) s += red[(g * 9 + r) * 64 + j2];
                modv[((size_t)l * 9 + r) * 6144 + jc * 64 + j2] = s; }
            __syncthreads();
        }
        __syncthreads();
    }
    const int gw = B * NWAVES + wave, NGW = G * NWAVES, gt = B * NTHR + tid, NGT = G * NTHR;
    { float* rope = (float*)(ws + WS_ROPE);
      for (int i = gt; i < 4096 * 16; i += NGT) { const int t = i >> 4, p = i & 15; const float pos = (float)(p < 8 ? (t >> 6) : (t & 63));
          const float inv = __powf(10000.0f, -(float)(p & 7) * 0.125f); const float ang = pos * inv; rope[t * 32 + p] = cosf(ang); rope[t * 32 + 16 + p] = sinf(ang); }
      float* bgu = (float*)(ws + WS_BGU);
      for (int i = gt; i < 2 * 32 * 2048; i += NGT) { const int le = i >> 11, np = i & 2047, q = np >> 8, g = (np >> 7) & 1, r = np & 127, f = 128 * q + r; bgu[i] = a.in[I_BGU][(size_t)le * 2048 + 2 * f + g]; }
      float* pb = (float*)(ws + WS_PW1B);
      for (int i = gt; i < 2048; i += NGT) { const int q = i >> 8, g = (i >> 7) & 1, r = i & 127, f = 128 * q + r; pb[i] = a.in[I_PW1B][g * 1024 + f]; }
      v4u* zp = (v4u*)(ws + WS_WIN + (size_t)3232 * 1024 * 2);
      for (int i = gt; i < 96 * 1024 * 2 / 16; i += NGT) zp[i] = (v4u){0u, 0u, 0u, 0u};
    }
    LAS float* scr = (LAS float*)(lds + wave * 16640);
    constexpr int I0 = 16 * 51, I1 = 6 * 12, I2 = 4 * 8, I3 = 4 * 8, I4 = 256, I5 = 512, I6 = 256, SMALL = I0 + I1 + I2 + I3 + I4 + I5 + I6;
    constexpr int NGU = 64 * 512, NDN = 64 * 256, NITEMS = SMALL + NGU + NDN;
    auto decode = [&](int it) -> TrItem {
        TrItem d; int r = it; d.f8scale = 0.f; d.mode = 0; d.row_off = 0;
        if (r < NGU) { const int mi = r >> 9; d.W = a.in[I_WGU] + (size_t)mi * 1024 * 2048; d.K = 1024; d.N = 2048; d.WT = (bf16*)(ws + WS_WGU + (size_t)mi * 2048 * 1024); d.mode = 1; d.item = r & 511; d.f8scale = SC_WGU; return d; } r -= NGU;
        if (r < NDN) { const int mi = r >> 8; d.W = a.in[I_WDN] + (size_t)mi * 1024 * 1024; d.K = 1024; d.N = 1024; d.WT = (bf16*)(ws + WS_WDN + (size_t)mi * 1024 * 1024); d.item = r & 255; d.f8scale = SC_WDN; return d; } r -= NDN;
        if (r < I0) { d.W = a.in[I_WIN]; d.K = 1024; d.N = 3232; d.WT = (bf16*)(ws + WS_WIN); d.item = r; return d; } r -= I0;
        if (r < I1) { d.W = a.in[I_WUQ]; d.K = 384; d.N = 768; d.WT = (bf16*)(ws + WS_WUQ); d.item = r; return d; } r -= I1;
        if (r < I2) { d.W = a.in[I_WUK]; d.K = 256; d.N = 512; d.WT = (bf16*)(ws + WS_WUKV); d.item = r; return d; } r -= I2;
        if (r < I3) { d.W = a.in[I_WUV]; d.K = 256; d.N = 512; d.WT = (bf16*)(ws + WS_WUKV); d.row_off = 512; d.item = r; return d; } r -= I3;
        if (r < I4) { d.W = a.in[I_WOUT]; d.K = 1024; d.N = 1024; d.WT = (bf16*)(ws + WS_WOUT); d.item = r; return d; } r -= I4;
        if (r < I5) { d.W = a.in[I_PW1W]; d.K = 1024; d.N = 2048; d.WT = (bf16*)(ws + WS_WPW1); d.mode = 2; d.item = r; return d; } r -= I5;
        d.W = a.in[I_PW2W]; d.K = 1024; d.N = 1024; d.WT = (bf16*)(ws + WS_WPW2); d.item = r; return d; };
    f32x4 tv[16];
    int it = gw;
    if (it < NITEMS) { const TrItem d0 = decode(it); tr_load(d0, tv, lane); }
    for (; it < NITEMS; it += NGW) {
        const TrItem d = decode(it);
        tr_lds_write(tv, scr, lane);
        if (it + NGW < NITEMS) { const TrItem dn = decode(it + NGW); tr_load(dn, tv, lane); }
        LDS_WAIT();
        tr_store(d, scr, lane);
        LDS_WAIT();
    }
}

__device__ __forceinline__ void phase_mod0(const Args& a, int lane, int wave) {
    const int gw = blockIdx.x * NWAVES + wave, NGW = gridDim.x * NWAVES;
    const float* modv = (const float*)(a.ws + WS_MODV);
    bf16* X = (bf16*)(a.ws + WS_X);
    for (int r = gw; r < NTOK; r += NGW) {
        const int b = r / TPB, p = r - b * TPB;
        const float* src = p < CTXL ? a.in[I_CTX] + ((size_t)b * CTXL + p) * 1024 : a.in[I_X] + ((size_t)b * SEQ + (p - CTXL)) * 1024;
        const float* mv = modv + (size_t)(p < CTXL ? 8 : b) * 6144;
#pragma unroll
        for (int j = 0; j < 4; ++j) { const int c = 4 * (lane + 64 * j); const f32x4 xv = *(const f32x4*)(src + c), sh = *(const f32x4*)(mv + c), sc = *(const f32x4*)(mv + 1024 + c);
            const f32x4 y = xv * (sc + 1.0f) + sh; v2u o; o.x = pk2(y[0], y[1]); o.y = pk2(y[2], y[3]); *(v2u*)(X + (size_t)r * 1024 + c) = o; }
    }
}

__device__ __forceinline__ void phase_norm0(const Args& a, int lane, int wave) {
    const int gw = blockIdx.x * NWAVES + wave, NGW = gridDim.x * NWAVES;
    const bf16* Z = (const bf16*)(a.ws + WS_Z); bf16* CQN = (bf16*)(a.ws + WS_CQN); bf16* CKVN = (bf16*)(a.ws + WS_CKVN); bf16* KRR = (bf16*)(a.ws + WS_KRR);
    const float* rope = (const float*)(a.ws + WS_ROPE);
    float gq[8], gk[8];
#pragma unroll
    for (int i = 0; i < 8; ++i) { gq[i] = lane < 48 ? a.in[I_QNORM][8 * lane + i] : 0.f; gk[i] = lane < 32 ? a.in[I_KVNORM][8 * lane + i] : 0.f; }
    for (int r = gw; r < NTOK; r += NGW) {
        const bf16* z = Z + (size_t)r * ZC; const int p = r % TPB;
        bf16x8 q8 = {}, k8 = {}, r8 = {};
        if (lane < 48) q8 = *(const bf16x8*)(z + ZQ + 8 * lane);
        if (lane < 32) k8 = *(const bf16x8*)(z + ZKV + 8 * lane);
        if (lane < 4) r8 = *(const bf16x8*)(z + ZKR + 8 * lane);
        float qf[8], kf[8], sq = 0.f, sk = 0.f;
#pragma unroll
        for (int i = 0; i < 8; ++i) { qf[i] = bf2f((unsigned short)q8[i]); kf[i] = bf2f((unsigned short)k8[i]); sq += qf[i] * qf[i]; sk += kf[i] * kf[i]; }
        sq = wave_sum(sq); sk = wave_sum(sk);
        const float rq = rsqrtf(sq * (1.f / 384.f) + RMS_EPS), rk = rsqrtf(sk * (1.f / 256.f) + RMS_EPS);
        if (lane < 48) { v4u o; o.x = pk2(qf[0] * rq * gq[0], qf[1] * rq * gq[1]); o.y = pk2(qf[2] * rq * gq[2], qf[3] * rq * gq[3]); o.z = pk2(qf[4] * rq * gq[4], qf[5] * rq * gq[5]); o.w = pk2(qf[6] * rq * gq[6], qf[7] * rq * gq[7]);
            *(v4u*)(CQN + (size_t)r * 384 + 8 * lane) = o; }
        if (lane < 32) { v4u o; o.x = pk2(kf[0] * rk * gk[0], kf[1] * rk * gk[1]); o.y = pk2(kf[2] * rk * gk[2], kf[3] * rk * gk[3]); o.z = pk2(kf[4] * rk * gk[4], kf[5] * rk * gk[5]); o.w = pk2(kf[6] * rk * gk[6], kf[7] * rk * gk[7]);
            *(v4u*)(CKVN + (size_t)r * 256 + 8 * lane) = o; }
        if (lane < 4) { bf16x8 o8 = r8; if (p >= CTXL) o8 = att::rope8(r8, rope + (size_t)(p - CTXL) * 32, 4 * lane); *(bf16x8*)(KRR + (size_t)r * 32 + 8 * lane) = o8; }
    }
}

__device__ __forceinline__ void hgrn_unit(const Args& a, int unit, LAS unsigned char* lds, int tid) {
    const int b = unit >> 5, head = (unit >> 3) & 3, dir = (unit >> 2) & 1, sl = unit & 3;
    const bf16* Z = (const bf16*)(a.ws + WS_Z);
    float* Od = (float*)(a.ws + (dir ? WS_OB : WS_OF));
    LAS float* lbv = (LAS float*)lds;
    constexpr int BUF0 = 1024, BUFSZ = 28672, OFF_Q = 16384, OFF_V = 24576;
    if (tid < 128) { const int c = head * 128 + tid; const float l0 = a.in[I_LBL][c], l1 = a.in[I_LBL][512 + c], l2 = a.in[I_LBL][1024 + c]; const float m = fmaxf(l0, fmaxf(l1, l2));
        const float e0 = __expf(l0 - m), e1 = __expf(l1 - m), e2 = __expf(l2 - m); lbv[tid] = e0 / (e0 + e1 + e2); }
    __syncthreads();
    const int lt = tid >> 4, lcg = tid & 15;
    float lb8[8];
#pragma unroll
    for (int i = 0; i < 8; ++i) lb8[i] = lbv[8 * lcg + i];
    const int fcol = (dir ? ZHB : ZHF) + head * 128 + 8 * lcg, qcol = ZHQ + head * 128 + 8 * lcg;
    const int vt = tid >> 2, vcol = ZHI + head * 128 + sl * 32 + (tid & 3) * 8;
    const int wave = tid >> 6, lane = tid & 63, vv = lane >> 4, cg = lane & 15, vloc = wave * 4 + vv;
    const size_t zb = (size_t)b * TPB;
    bf16x8 rq, rf, rv;
#define TOKP(n) (dir ? ((n) < CTXL ? (CTXL - 1 - (n)) : (TPB + CTXL - 1 - (n))) : (n))
#define HG_LOAD(i) do { const int n_ = 32 * (i) + lt; const bf16* zr_ = Z + (zb + TOKP(n_)) * ZC; rq = *(const bf16x8*)(zr_ + qcol); rf = *(const bf16x8*)(zr_ + fcol); \
        if (tid < 128) { const int n2_ = 32 * (i) + vt; rv = *(const bf16x8*)(Z + (zb + TOKP(n2_)) * ZC + vcol); } } while (0)
#define HG_WRITE(bufi) do { LAS unsigned char* bp_ = lds + BUF0 + (bufi) * BUFSZ; float f_[8]; \
        _Pragma("unroll") for (int i_ = 0; i_ < 8; ++i_) f_[i_] = lb8[i_] + (1.f - lb8[i_]) * sigm(bf2f((unsigned short)rf[i_])); \
        *(LAS f32x4*)(bp_ + ((lt * 128 + lcg * 4) * 4)) = (f32x4){f_[0], f_[1], f_[2], f_[3]}; *(LAS f32x4*)(bp_ + ((lt * 128 + 64 + lcg * 4) * 4)) = (f32x4){f_[4], f_[5], f_[6], f_[7]}; \
        *(LAS bf16x8*)(bp_ + OFF_Q + (lt * 128 + lcg * 8) * 2) = rq; \
        if (tid < 128) { float v_[8]; _Pragma("unroll") for (int i_ = 0; i_ < 8; ++i_) v_[i_] = bf2f((unsigned short)rv[i_]); \
            *(LAS f32x4*)(bp_ + OFF_V + (vt * 32 + (tid & 3) * 8) * 4) = (f32x4){v_[0], v_[1], v_[2], v_[3]}; *(LAS f32x4*)(bp_ + OFF_V + (vt * 32 + (tid & 3) * 8 + 4) * 4) = (f32x4){v_[4], v_[5], v_[6], v_[7]}; } } while (0)
    float S[8];
#pragma unroll
    for (int j = 0; j < 8; ++j) S[j] = 0.f;
    HG_LOAD(0); HG_WRITE(0); __syncthreads();
    const bool b3 = (cg & 8) != 0, b2 = (cg & 4) != 0, b1 = (cg & 2) != 0, b0 = (cg & 1) != 0;
    for (int i = 0; i < TPB / 32; ++i) {
        if (i + 1 < TPB / 32) HG_LOAD(i + 1);
        const LAS unsigned char* bp = lds + BUF0 + (i & 1) * BUFSZ;
#pragma unroll 1
        for (int g = 0; g < 4; ++g) {
            const LAS unsigned char* gp = bp + g * 8 * 512;
            float ot[8];
#pragma unroll
            for (int t = 0; t < 8; ++t) {
                const f32x4 f0 = *(const LAS f32x4*)(gp + ((t * 128 + cg * 4) * 4)), f1 = *(const LAS f32x4*)(gp + ((t * 128 + 64 + cg * 4) * 4));
                const bf16x8 q8 = *(const LAS bf16x8*)(bp + OFF_Q + ((g * 8 + t) * 128 + cg * 8) * 2);
                const float v = *(const LAS float*)(bp + OFF_V + ((g * 8 + t) * 32 + vloc) * 4);
                float acc = 0.f;
#pragma unroll
                for (int j = 0; j < 8; ++j) { const float fj = j < 4 ? f0[j] : f1[j - 4]; const float qj = bf2f((unsigned short)q8[j]);
                    const float kv = fmaf(-fj, v, v); S[j] = fmaf(fj, S[j], kv); acc = fmaf(S[j], qj, acc); }
                ot[t] = acc;
            }
#pragma unroll
            for (int k = 0; k < 4; ++k) { const float snd = b3 ? ot[k] : ot[k + 4]; const float rcv = __shfl_xor(snd, 8); ot[k] = (b3 ? ot[k + 4] : ot[k]) + rcv; }
#pragma unroll
            for (int k = 0; k < 2; ++k) { const float snd = b2 ? ot[k] : ot[k + 2]; const float rcv = __shfl_xor(snd, 4); ot[k] = (b2 ? ot[k + 2] : ot[k]) + rcv; }
            { const float snd = b1 ? ot[0] : ot[1]; const float rcv = __shfl_xor(snd, 2); ot[0] = (b1 ? ot[1] : ot[0]) + rcv; }
            ot[0] += __shfl_xor(ot[0], 1);
            if (!b0) { const int n = 32 * i + 8 * g + (cg >> 1); const int p = TOKP(n); if (p >= CTXL) Od[(zb + p) * 512 + head * 128 + sl * 32 + vloc] = ot[0]; }
        }
        if (i + 1 < TPB / 32) HG_WRITE((i + 1) & 1);
        __syncthreads();
    }
#undef TOKP
#undef HG_LOAD
#undef HG_WRITE
}

__device__ __forceinline__ void phase_readout(const Args& a, int lane, int wave) {
    const int gw = blockIdx.x * NWAVES + wave, NGW = gridDim.x * NWAVES;
    const bf16* OF = (const bf16*)(a.ws + WS_OF); const bf16* OB = (const bf16*)(a.ws + WS_OB);
    const bf16* Z = (const bf16*)(a.ws + WS_Z); bf16* MIX = (bf16*)(a.ws + WS_Y);
    float hn[8];
#pragma unroll
    for (int i = 0; i < 8; ++i) hn[i] = a.in[I_HGNORM][((8 * lane) & 127) + i];
    for (int lr = gw; lr < NLAT; lr += NGW) {
        const size_t r = (size_t)grow_of(lr);
        const bf16x8 a8 = *(const bf16x8*)(OF + r * 512 + 8 * lane), c8 = *(const bf16x8*)(OB + r * 512 + 8 * lane);
        const bf16x8 g8 = *(const bf16x8*)(Z + r * ZC + ZHG + 8 * lane);
        float o[8]; float ss = 0.f;
#pragma unroll
        for (int i = 0; i < 8; ++i) o[i] = bf2f((unsigned short)a8[i]) + bf2f((unsigned short)c8[i]);
#pragma unroll
        for (int i = 0; i < 8; ++i) ss += o[i] * o[i];
        ss += __shfl_xor(ss, 1); ss += __shfl_xor(ss, 2); ss += __shfl_xor(ss, 4); ss += __shfl_xor(ss, 8);
        const float rs = rsqrtf(ss * (1.f / 128.f) + RMS_EPS);
        float y[8];
#pragma unroll
        for (int i = 0; i < 8; ++i) { const float g = bf2f((unsigned short)g8[i]); y[i] = o[i] * rs * hn[i] * (g * sigm(g)); }
        v4u w; w.x = pk2(y[0], y[1]); w.y = pk2(y[2], y[3]); w.z = pk2(y[4], y[5]); w.w = pk2(y[6], y[7]);
        *(v4u*)(MIX + r * 1024 + 512 + 8 * lane) = w;
    }
}

__device__ __forceinline__ int rows_per_block() { const int G = gridDim.x; return (((NLAT + G - 1) / G) + 15) & ~15; }
__device__ __forceinline__ void phase_ln1(const Args& a, int l, LAS unsigned char* lds, int tid, int lane, int wave) {
    const int RB = rows_per_block(), lr_base = blockIdx.x * RB;
    float* H = (float*)(a.ws + WS_H); bf16* XB = (bf16*)(a.ws + WS_X);
    const float* modv = (const float*)(a.ws + WS_MODV) + (size_t)l * 9 * 6144;
    const float* lng = a.in[I_LN1G] + l * 1024; const float* lnb = a.in[I_LN1B] + l * 1024;
    const float* rw = a.in[I_RW] + (size_t)l * 1024 * 32; const float* rb = a.in[I_RB] + l * 32;
    int* topi = (int*)(a.ws + WS_TOPI); float* topw = (float*)(a.ws + WS_TOPW);
    LAS float* rwl = (LAS float*)lds;
    LAS float* lgs = (LAS float*)(lds + 131072) + wave * 64;
    LAS int* hist = (LAS int*)(lds + 131072 + 2048);
    LAS int* til = (LAS int*)(lds + 131072 + 6144);
    LAS float* twl = (LAS float*)(lds + 131072 + 6144 + 4096);
    LAS int* ccnt = (LAS int*)(lds + 131072 + 2048 + 512);
    for (int i = tid; i < 8192; i += NTHR) { const int k = i >> 3, q = i & 7; *(LAS f32x4*)(rwl + k * 32 + 4 * (q ^ ((k >> 2) & 7))) = *(const f32x4*)(rw + k * 32 + 4 * q); }
    if (tid < 32) hist[tid] = 0;
    __syncthreads();
    const int sw = lane & 7;
    for (int i = 2 * wave; i < RB; i += 16) {
        const int lr0 = lr_base + i; if (lr0 >= NLAT) break;
        float vv[2][16];
#pragma unroll
        for (int rr = 0; rr < 2; ++rr) {
            const int lr = lr0 + rr; const size_t r = (size_t)grow_of(lr); const int b = lr >> 12;
            const float* mv = modv + (size_t)b * 6144;
            f32x4 x[4]; float s = 0.f;
#pragma unroll
            for (int j = 0; j < 4; ++j) { x[j] = *(const f32x4*)(H + r * 1024 + 4 * (lane + 64 * j)); s += (x[j][0] + x[j][1]) + (x[j][2] + x[j][3]); }
            const float mean = wave_sum(s) * (1.f / 1024.f); float s2 = 0.f;
#pragma unroll
            for (int j = 0; j < 4; ++j) { x[j] = x[j] - mean; s2 += (x[j][0] * x[j][0] + x[j][1] * x[j][1]) + (x[j][2] * x[j][2] + x[j][3] * x[j][3]); }
            const float rstd = rsqrtf(wave_sum(s2) * (1.f / 1024.f) + LN_EPS);
#pragma unroll
            for (int j = 0; j < 4; ++j) { const int c = 4 * (lane + 64 * j); const f32x4 g = *(const f32x4*)(lng + c), bb = *(const f32x4*)(lnb + c);
                const f32x4 hv = x[j] * rstd * g + bb;
                const f32x4 sh = *(const f32x4*)(mv + 3 * 1024 + c), sc = *(const f32x4*)(mv + 4 * 1024 + c);
                const f32x4 bm = hv * (sc + 1.0f) + sh; *(unsigned*)((unsigned char*)XB + r * 1024 + c) = pack_fp8x4(bm[0] * SC_X8, bm[1] * SC_X8, bm[2] * SC_X8, bm[3] * SC_X8);
                vv[rr][4 * j + 0] = bm[0]; vv[rr][4 * j + 1] = bm[1]; vv[rr][4 * j + 2] = bm[2]; vv[rr][4 * j + 3] = bm[3]; }
        }
        float p0[32], p1[32];
#pragma unroll
        for (int e = 0; e < 32; ++e) { p0[e] = 0.f; p1[e] = 0.f; }
#pragma unroll
        for (int j = 0; j < 4; ++j)
#pragma unroll
            for (int e4 = 0; e4 < 4; ++e4) { const int k = 4 * (lane + 64 * j) + e4; const float x0 = vv[0][4 * j + e4], x1 = vv[1][4 * j + e4];
#pragma unroll
                for (int q = 0; q < 8; ++q) { const f32x4 w = *(const LAS f32x4*)(rwl + k * 32 + 4 * (q ^ sw));
#pragma unroll
                    for (int c = 0; c < 4; ++c) { p0[4 * q + c] = fmaf(x0, w[c], p0[4 * q + c]); p1[4 * q + c] = fmaf(x1, w[c], p1[4 * q + c]); } } }
#define RS_STEP(P, NKEEP, BITV, XORV) _Pragma("unroll") for (int k_ = 0; k_ < NKEEP; ++k_) { const float snd_ = (BITV) ? P[k_] : P[k_ + NKEEP]; const float rcv_ = __shfl_xor(snd_, XORV); P[k_] = ((BITV) ? P[k_ + NKEEP] : P[k_]) + rcv_; }
        { const bool c5 = (lane & 32) != 0, c4 = (lane & 16) != 0, c3 = (lane & 8) != 0, c2 = (lane & 4) != 0, c1 = (lane & 2) != 0;
          RS_STEP(p0, 16, c5, 32) RS_STEP(p0, 8, c4, 16) RS_STEP(p0, 4, c3, 8) RS_STEP(p0, 2, c2, 4) RS_STEP(p0, 1, c1, 2)
          RS_STEP(p1, 16, c5, 32) RS_STEP(p1, 8, c4, 16) RS_STEP(p1, 4, c3, 8) RS_STEP(p1, 2, c2, 4) RS_STEP(p1, 1, c1, 2)
          p0[0] += __shfl_xor(p0[0], 1); p1[0] += __shfl_xor(p1[0], 1); }
#undef RS_STEP
        if ((lane & 1) == 0) { lgs[lane >> 1] = p0[0]; lgs[32 + (lane >> 1)] = p1[0]; }
        LDS_WAIT();
#pragma unroll
        for (int rr = 0; rr < 2; ++rr) {
            float lg[32];
#pragma unroll
            for (int q = 0; q < 8; ++q) { const f32x4 t4 = *(const LAS f32x4*)(lgs + rr * 32 + 4 * q); const f32x4 b4 = *(const f32x4*)(rb + 4 * q); lg[4 * q] = t4[0] + b4[0]; lg[4 * q + 1] = t4[1] + b4[1]; lg[4 * q + 2] = t4[2] + b4[2]; lg[4 * q + 3] = t4[3] + b4[3]; }
            unsigned taken = 0u; float tv[4]; int ti[4];
#pragma unroll
            for (int kk = 0; kk < 4; ++kk) { float best = -3.0e38f; int bi = 0;
#pragma unroll
                for (int e = 0; e < 32; ++e) { const bool ok = (lg[e] > best) && !((taken >> e) & 1u); best = ok ? lg[e] : best; bi = ok ? e : bi; }
                taken |= 1u << bi; tv[kk] = best; ti[kk] = bi; }
            const float e1 = __expf(tv[1] - tv[0]), e2 = __expf(tv[2] - tv[0]), e3 = __expf(tv[3] - tv[0]); const float inv = 1.f / (1.f + e1 + e2 + e3);
            if (lane == 0) { const int lr = lr0 + rr;
                const int li = (lr - lr_base) * 4; til[li] = ti[0]; til[li + 1] = ti[1]; til[li + 2] = ti[2]; til[li + 3] = ti[3]; twl[li] = inv; twl[li + 1] = e1 * inv; twl[li + 2] = e2 * inv; twl[li + 3] = e3 * inv;
                __hip_atomic_fetch_add(hist + ti[0], 1, __ATOMIC_RELAXED, __HIP_MEMORY_SCOPE_WORKGROUP); __hip_atomic_fetch_add(hist + ti[1], 1, __ATOMIC_RELAXED, __HIP_MEMORY_SCOPE_WORKGROUP);
                __hip_atomic_fetch_add(hist + ti[2], 1, __ATOMIC_RELAXED, __HIP_MEMORY_SCOPE_WORKGROUP); __hip_atomic_fetch_add(hist + ti[3], 1, __ATOMIC_RELAXED, __HIP_MEMORY_SCOPE_WORKGROUP); }
        }
        LDS_WAIT();
    }
    __syncthreads();
    int* cursor = (int*)(a.ws + WS_CURSOR) + l * 32;
    int* rows = (int*)(a.ws + WS_ROWS); float* roww = (float*)(a.ws + WS_ROWW); int* rowd = (int*)(a.ws + WS_ROWD);
    int nrows = NLAT - lr_base; nrows = nrows > RB ? RB : nrows; if (nrows < 0) nrows = 0;
    const int nas = nrows * 4, nchunks = (nas + 63) >> 6;
    int basev = 0; if (tid < 32) basev = (int)__hip_atomic_fetch_add((unsigned*)cursor + tid, (unsigned)hist[tid], __ATOMIC_RELAXED, __HIP_MEMORY_SCOPE_AGENT);
    int myrank[2] = {0, 0}, mye[2] = {-1, -1};
#pragma unroll
    for (int cc = 0; cc < 2; ++cc) { const int c = wave + 8 * cc; if (c < nchunks) { const int idx = c * 64 + lane; const int e = idx < nas ? til[idx] : -1; mye[cc] = e;
        for (int x = 0; x < 32; ++x) { const unsigned long long m = __ballot(e == x); if (e == x) myrank[cc] = __popcll(m & ((1ull << lane) - 1ull)); if (lane == 0) ccnt[c * 32 + x] = __popcll(m); } } }
    __syncthreads();
    if (tid < 32) hist[32 + tid] = basev;
    __syncthreads();
#pragma unroll
    for (int cc = 0; cc < 2; ++cc) { const int c = wave + 8 * cc; const int idx = c * 64 + lane; if (c < nchunks && idx < nas) { const int e = mye[cc]; int pos = hist[32 + e] + myrank[cc]; for (int c2 = 0; c2 < c; ++c2) pos += ccnt[c2 * 32 + e];
        const int lr = lr_base + (idx >> 2); const size_t pi = (size_t)e * ECAP + pos; rows[pi] = grow_of(lr); roww[pi] = twl[idx]; rowd[pi] = lr * 4 + (idx & 3); } }
}

__device__ __forceinline__ void phase_ln2(const Args& a, int l, int lane, int wave) {
    const int gw = blockIdx.x * NWAVES + wave, NGW = gridDim.x * NWAVES;
    float* H = (float*)(a.ws + WS_H); const unsigned char* YB = (const unsigned char*)(a.ws + WS_YB); bf16* A1 = (bf16*)(a.ws + WS_Y);
    const float* modv = (const float*)(a.ws + WS_MODV);
    const float* ln1g = a.in[I_LN1G] + l * 1024; const float* ln1b = a.in[I_LN1B] + l * 1024;
    const float* lng = a.in[I_LN2G] + l * 1024; const float* lnb = a.in[I_LN2B] + l * 1024;
    for (int lr0 = 2 * gw; lr0 < NLAT; lr0 += 2 * NGW) {
        f32x4 hv[2][4]; unsigned yv[2][4][4];
#pragma unroll
        for (int q = 0; q < 2; ++q) { const int lr = lr0 + q; const size_t r = (size_t)grow_of(lr);
#pragma unroll
            for (int j = 0; j < 4; ++j) { const int c = 4 * (lane + 64 * j); hv[q][j] = *(const f32x4*)(H + r * 1024 + c);
#pragma unroll
                for (int k = 0; k < 4; ++k) yv[q][j][k] = *(const unsigned*)(YB + ((size_t)lr * 4 + k) * 1024 + c); } }
#pragma unroll
        for (int q = 0; q < 2; ++q) {
            const int lr = lr0 + q; const size_t r = (size_t)grow_of(lr); const int b = lr >> 12;
            const float* mv = modv + ((size_t)l * 9 + b) * 6144; const float* mv1 = modv + ((size_t)9 + b) * 6144;
            f32x4 x[4]; float s = 0.f;
#pragma unroll
            for (int j = 0; j < 4; ++j) { x[j] = hv[q][j]; s += (x[j][0] + x[j][1]) + (x[j][2] + x[j][3]); }
            float mean = wave_sum(s) * (1.f / 1024.f), s2 = 0.f;
#pragma unroll
            for (int j = 0; j < 4; ++j) { x[j] = x[j] - mean; s2 += (x[j][0] * x[j][0] + x[j][1] * x[j][1]) + (x[j][2] * x[j][2] + x[j][3] * x[j][3]); }
            float rstd = rsqrtf(wave_sum(s2) * (1.f / 1024.f) + LN_EPS);
            s = 0.f;
#pragma unroll
            for (int j = 0; j < 4; ++j) { const int c = 4 * (lane + 64 * j); const f32x4 g = *(const f32x4*)(ln1g + c), bb = *(const f32x4*)(ln1b + c);
                const f32x4 h1 = x[j] * rstd * g + bb; f32x4 f = {0.f, 0.f, 0.f, 0.f};
#pragma unroll
                for (int k = 0; k < 4; ++k) { const unsigned y = yv[q][j][k]; const auto lo = __builtin_amdgcn_cvt_pk_f32_fp8((int)y, false), hi = __builtin_amdgcn_cvt_pk_f32_fp8((int)y, true);
                    f[0] += lo[0]; f[1] += lo[1]; f[2] += hi[0]; f[3] += hi[1]; }
                const f32x4 gt = *(const f32x4*)(mv + 5 * 1024 + c);
                x[j] = h1 * ALPHA + gt * (f * (1.f / SC_Y)); s += (x[j][0] + x[j][1]) + (x[j][2] + x[j][3]); }
            mean = wave_sum(s) * (1.f / 1024.f); s2 = 0.f;
#pragma unroll
            for (int j = 0; j < 4; ++j) { x[j] = x[j] - mean; s2 += (x[j][0] * x[j][0] + x[j][1] * x[j][1]) + (x[j][2] * x[j][2] + x[j][3] * x[j][3]); }
            rstd = rsqrtf(wave_sum(s2) * (1.f / 1024.f) + LN_EPS);
#pragma unroll
            for (int j = 0; j < 4; ++j) { const int c = 4 * (lane + 64 * j); const f32x4 g = *(const f32x4*)(lng + c), bb = *(const f32x4*)(lnb + c);
                const f32x4 o = x[j] * rstd * g + bb;
                if (l == 0) { *(f32x4*)(H + r * 1024 + c) = o; const f32x4 sh = *(const f32x4*)(mv1 + c), sc = *(const f32x4*)(mv1 + 1024 + c);
                    const f32x4 am = o * (sc + 1.0f) + sh; v2u w; w.x = pk2(am[0], am[1]); w.y = pk2(am[2], am[3]); *(v2u*)(A1 + r * 1024 + c) = w; }
                else *(f32x4*)(a.out + (size_t)lr * 1024 + c) = o; }
        }
    }
}

__device__ __forceinline__ void phase_conv(const Args& a, LAS unsigned char* lds, int tid, int lane, int wave) {
    const bf16* U = (const bf16*)(a.ws + WS_X); bf16* V = (bf16*)(a.ws + WS_Y);
    LAS float* part = (LAS float*)(lds + 126976);
    LAS float* st = part + 512;
    const int c0 = 2 * tid;
    const float db0 = a.in[I_DWB][c0], db1 = a.in[I_DWB][c0 + 1], g0 = a.in[I_CLNG][c0], g1 = a.in[I_CLNG][c0 + 1], be0 = a.in[I_CLNB][c0], be1 = a.in[I_CLNB][c0 + 1];
    for (int tile = blockIdx.x; tile < NLAT / 32; tile += gridDim.x) {
        const int b = tile >> 7, t0 = (tile & 127) * 32;
        const size_t rb0 = (size_t)b * TPB + CTXL;
        __syncthreads();
        for (int i = tid; i < 62 * 128; i += NTHR) { const int row = i >> 7, chk = i & 127, t = t0 - 15 + row;
            v4u val = {0u, 0u, 0u, 0u}; if (t >= 0 && t < SEQ) val = *(const v4u*)(U + (rb0 + t) * 1024 + chk * 8);
            *(LAS v4u*)(lds + row * 2048 + chk * 16) = val; }
        __syncthreads();
        float w0[31], w1[31];
#pragma unroll
        for (int j = 0; j < 31; ++j) { const float2 wv = *(const float2*)(a.in[I_DWW] + j * 1024 + c0); w0[j] = wv.x; w1[j] = wv.y; }
#pragma unroll 1
        for (int hh = 0; hh < 2; ++hh) {
            const LAS unsigned char* hp = lds + hh * 16 * 2048;
            float acc0[16], acc1[16];
#pragma unroll
            for (int t = 0; t < 16; ++t) { acc0[t] = db0; acc1[t] = db1; }
#pragma unroll
            for (int s = 0; s < 46; ++s) { const unsigned pr = *(const LAS unsigned*)(hp + s * 2048 + tid * 4); const float x0 = __uint_as_float(pr << 16), x1 = __uint_as_float(pr & 0xffff0000u);
#pragma unroll
                for (int t = (s > 30 ? s - 30 : 0); t <= (s < 15 ? s : 15); ++t) { acc0[t] = fmaf(x0, w0[s - t], acc0[t]); acc1[t] = fmaf(x1, w1[s - t], acc1[t]); } }
            float rs[32];
#pragma unroll
            for (int t = 0; t < 16; ++t) { rs[2 * t] = acc0[t] + acc1[t]; rs[2 * t + 1] = acc0[t] * acc0[t] + acc1[t] * acc1[t]; }
#define RS_STEP(NKEEP, XORV) { const bool bit_ = (lane & XORV) != 0; _Pragma("unroll") for (int k_ = 0; k_ < NKEEP; ++k_) { const float snd_ = bit_ ? rs[k_] : rs[k_ + NKEEP]; const float rcv_ = __shfl_xor(snd_, XORV); rs[k_] = (bit_ ? rs[k_ + NKEEP] : rs[k_]) + rcv_; } }
            RS_STEP(16, 32) RS_STEP(8, 16) RS_STEP(4, 8) RS_STEP(2, 4) RS_STEP(1, 2)
#undef RS_STEP
            rs[0] += __shfl_xor(rs[0], 1);
            __syncthreads();
            if ((lane & 1) == 0) part[wave * 32 + (lane >> 1)] = rs[0];
            __syncthreads();
            if (tid < 16) { float s1 = 0.f, s2 = 0.f;
#pragma unroll
                for (int w = 0; w < 8; ++w) { s1 += part[w * 32 + 2 * tid]; s2 += part[w * 32 + 2 * tid + 1]; }
                const float mean = s1 * (1.f / 1024.f); const float var = fmaxf(s2 * (1.f / 1024.f) - mean * mean, 0.f); st[2 * tid] = mean; st[2 * tid + 1] = rsqrtf(var + LN_EPS); }
            __syncthreads();
#pragma unroll
            for (int t = 0; t < 16; ++t) { const float mean = st[2 * t], rstd = st[2 * t + 1];
                const float y0 = (acc0[t] - mean) * rstd * g0 + be0, y1 = (acc1[t] - mean) * rstd * g1 + be1;
                *(unsigned*)(V + (rb0 + t0 + hh * 16 + t) * 1024 + c0) = pk2(y0 * sigm(y0), y1 * sigm(y1)); }
        }
    }
}

namespace hg {
using bf16x8 = __attribute__((ext_vector_type(8))) short;
using s16x4  = __attribute__((ext_vector_type(4))) short;
using f32x16 = __attribute__((ext_vector_type(16))) float;
using u32x4  = __attribute__((ext_vector_type(4))) unsigned;
constexpr int RS = 272;
constexpr int VS = 80;
constexpr int T_Q = 0, T_KO = 32 * RS, T_KE = 64 * RS, T_D = 96 * RS, IMG_BYTES = T_D + 512, T_V = IMG_BYTES, TILE_BYTES = T_V + 32 * VS;
constexpr int OFF_TILES = 1024, NTB = 3, OFF_OPART = OFF_TILES + NTB * TILE_BYTES, OPART_BYTES = 4 * 4096;
static_assert(OFF_OPART + 2 * OPART_BYTES <= 131072 && IMG_BYTES % 16 == 0 && IMG_BYTES / 16 == 1664, "hgrn lds");
constexpr int P_RAW = 1024, R_Q = 0, R_F = 32 * RS, RAW_BYTES = 64 * RS, P_IMG = P_RAW + RAW_BYTES;
constexpr int NCHUNK = TPB / 32, NCHAIN = NB * 4 * 2, NITEM = NCHAIN * NCHUNK;
__device__ __forceinline__ int crow(int r, int hi) { return (r & 3) + 8 * (r >> 2) + 4 * hi; }
__device__ __forceinline__ s16x4 tr_read(unsigned addr) { s16x4 r; asm volatile("ds_read_b64_tr_b16 %0, %1" : "=&v"(r) : "v"(addr) : "memory"); return r; }
__device__ __forceinline__ bf16x8 cat8(s16x4 l, s16x4 h) { return (bf16x8){l[0], l[1], l[2], l[3], h[0], h[1], h[2], h[3]}; }
__device__ __forceinline__ bf16x8 pack8(const f32x16& x, int base) {
    u32x4 w; w[0] = pk2(x[base + 0], x[base + 1]); w[1] = pk2(x[base + 2], x[base + 3]); w[2] = pk2(x[base + 4], x[base + 5]); w[3] = pk2(x[base + 6], x[base + 7]);
    return *reinterpret_cast<bf16x8*>(&w);
}
}


#define HG_TOKP(dir, n) ((dir) ? ((n) < CTXL ? (CTXL - 1 - (n)) : (TPB + CTXL - 1 - (n))) : (n))
#define HG_DPP1(x, ctrl, rmask) __int_as_float(__builtin_amdgcn_update_dpp(0x3f800000, __float_as_int(x), ctrl, rmask, 0xf, false))
#define HG_DPP(x, ctrl, rmask) __int_as_float(__builtin_amdgcn_update_dpp(0, __float_as_int(x), ctrl, rmask, 0xf, false))
__device__ __forceinline__ void hgrn_prep_items(const Args& a, LAS unsigned char* lds, int tid) {
    using namespace hg;
    const bf16* Z = (const bf16*)(a.ws + WS_Z);
    unsigned char* HT = a.ws + WS_HT;
    const int wave = __builtin_amdgcn_readfirstlane(tid >> 6), lane = tid & 63, t = lane & 31, half = lane >> 5;
    const int c0 = 16 * wave + 8 * half;
    const int lr = tid >> 4, lch = tid & 15;
    LAS float* lbt = (LAS float*)lds;
    constexpr int P_RAW2 = 2048, P_IMG2 = P_RAW2 + 2 * RAW_BYTES;
    static_assert(P_IMG2 + 2 * IMG_BYTES <= 131072, "prep lds");
    __syncthreads();
    { const float l0 = a.in[I_LBL][tid], l1 = a.in[I_LBL][512 + tid], l2 = a.in[I_LBL][1024 + tid]; const float m = fmaxf(l0, fmaxf(l1, l2));
      const float e0 = __expf(l0 - m), e1 = __expf(l1 - m), e2 = __expf(l2 - m); lbt[tid] = e0 / (e0 + e1 + e2); }
    bf16x8 gq, gf;
#define HP_LOAD(it) do { const int ch_ = (it) % NCHUNK, cn_ = (it) / NCHUNK, dir_ = cn_ & 1, hd_ = (cn_ >> 1) & 3, b_ = cn_ >> 3; \
        const bf16* zr_ = Z + ((size_t)b_ * TPB + HG_TOKP(dir_, 32 * ch_ + lr)) * ZC; gq = *(const bf16x8*)(zr_ + ZHQ + hd_ * 128 + lch * 8); gf = *(const bf16x8*)(zr_ + (dir_ ? ZHB : ZHF) + hd_ * 128 + lch * 8); } while (0)
#define HP_STASH(bufi) do { LAS unsigned char* rb_ = lds + P_RAW2 + (bufi) * RAW_BYTES; *(LAS bf16x8*)(rb_ + R_Q + lr * RS + lch * 16) = gq; *(LAS bf16x8*)(rb_ + R_F + lr * RS + lch * 16) = gf; } while (0)
#define HP_COPYOUT(item, bufi) do { v4u* dst_ = (v4u*)(HT + (size_t)(item) * IMG_BYTES); const LAS v4u* src_ = (const LAS v4u*)(lds + P_IMG2 + (bufi) * IMG_BYTES); \
        dst_[tid] = src_[tid]; dst_[tid + 512] = src_[tid + 512]; dst_[tid + 1024] = src_[tid + 1024]; if (tid < 128) dst_[tid + 1536] = src_[tid + 1536]; } while (0)
    const int G = gridDim.x;
    int it = blockIdx.x, par = 0;
    if (it < NITEM) { HP_LOAD(it); HP_STASH(0); }
    if (it + G < NITEM) HP_LOAD(it + G);
    __syncthreads();
    for (; it < NITEM; it += G, par ^= 1) {
        if (it + G < NITEM) HP_STASH(par ^ 1);
        if (it != (int)blockIdx.x) HP_COPYOUT(it - G, par ^ 1);
        if (it + 2 * G < NITEM) HP_LOAD(it + 2 * G);
        const int hd = ((it / NCHUNK) >> 1) & 3;
        {
            const LAS unsigned char* rb_ = lds + P_RAW2 + par * RAW_BYTES;
            const bf16x8 RQ = *(const LAS bf16x8*)(rb_ + R_Q + t * RS + c0 * 2), RF = *(const LAS bf16x8*)(rb_ + R_F + t * RS + c0 * 2);
            const f32x4 lbA = *(const LAS f32x4*)(lbt + hd * 128 + c0), lbB = *(const LAS f32x4*)(lbt + hd * 128 + c0 + 4);
            LAS unsigned char* tb_ = lds + P_IMG2 + par * IMG_BYTES;
            float bb_[8], kk_[8];
#pragma unroll
            for (int i_ = 0; i_ < 8; ++i_) { const float lb_ = i_ < 4 ? lbA[i_] : lbB[i_ - 4]; const float f_ = lb_ + (1.f - lb_) * __builtin_amdgcn_rcpf(1.f + __expf(-bf2f((unsigned short)RF[i_]))); kk_[i_] = 1.f - f_; bb_[i_] = f_; }
#pragma unroll
            for (int i_ = 0; i_ < 8; ++i_) { float x_ = bb_[i_]; x_ *= HG_DPP1(x_, 0x111, 0xf); x_ *= HG_DPP1(x_, 0x112, 0xf); x_ *= HG_DPP1(x_, 0x114, 0xf); x_ *= HG_DPP1(x_, 0x118, 0xf);
                x_ *= HG_DPP1(x_, 0x142, 0xa); bb_[i_] = x_; }
            float qi_[8], ko_[8], ke_[8], dd_[8];
#pragma unroll
            for (int i_ = 0; i_ < 8; ++i_) { const int bi_ = __float_as_int(bb_[i_]); dd_[i_] = __int_as_float(half ? __builtin_amdgcn_readlane(bi_, 63) : __builtin_amdgcn_readlane(bi_, 31));
                const float e_ = bb_[i_]; const float ei_ = __builtin_amdgcn_rcpf(e_);
                qi_[i_] = bf2f((unsigned short)RQ[i_]) * e_; ko_[i_] = kk_[i_] * ei_; ke_[i_] = kk_[i_] * (dd_[i_] * ei_); }
            *(LAS v4u*)(tb_ + T_Q + t * RS + c0 * 2) = (v4u){pk2(qi_[0], qi_[1]), pk2(qi_[2], qi_[3]), pk2(qi_[4], qi_[5]), pk2(qi_[6], qi_[7])};
            *(LAS v4u*)(tb_ + T_KO + t * RS + c0 * 2) = (v4u){pk2(ko_[0], ko_[1]), pk2(ko_[2], ko_[3]), pk2(ko_[4], ko_[5]), pk2(ko_[6], ko_[7])};
            *(LAS v4u*)(tb_ + T_KE + t * RS + c0 * 2) = (v4u){pk2(ke_[0], ke_[1]), pk2(ke_[2], ke_[3]), pk2(ke_[4], ke_[5]), pk2(ke_[6], ke_[7])};
            if (t == 31) { *(LAS f32x4*)(tb_ + T_D + c0 * 4) = (f32x4){dd_[0], dd_[1], dd_[2], dd_[3]}; *(LAS f32x4*)(tb_ + T_D + c0 * 4 + 16) = (f32x4){dd_[4], dd_[5], dd_[6], dd_[7]}; }
            if (tid < 32) *(LAS v4u*)(tb_ + T_Q + tid * RS + 256) = (v4u){0u, 0u, 0u, 0u};
            else if (tid < 64) *(LAS v4u*)(tb_ + T_KO + (tid - 32) * RS + 256) = (v4u){0u, 0u, 0u, 0u};
            else if (tid < 96) *(LAS v4u*)(tb_ + T_KE + (tid - 64) * RS + 256) = (v4u){0u, 0u, 0u, 0u};
        }
        __syncthreads();
    }
    if (it - G >= (int)blockIdx.x && it - G < NITEM) HP_COPYOUT(it - G, par ^ 1);
    __syncthreads();
#undef HP_COPYOUT
#undef HP_LOAD
#undef HP_STASH
}

__device__ __forceinline__ void hgrn_unit_mfma(const Args& a, int unit, LAS unsigned char* lds, int tid) {
    using namespace hg;
    const int b = unit >> 5, head = (unit >> 3) & 3, dir = (unit >> 2) & 1, sl = unit & 3;
    const bf16* Z = (const bf16*)(a.ws + WS_Z);
    const unsigned char* HT = a.ws + WS_HT + (size_t)((b * 4 + head) * 2 + dir) * NCHUNK * IMG_BYTES;
    bf16* Od = (bf16*)(a.ws + (dir ? WS_OB : WS_OF));
    const int wave = __builtin_amdgcn_readfirstlane(tid >> 6), lane = tid & 63;
    const size_t zb = (size_t)b * TPB;
    constexpr int NCH = NCHUNK;
    const int vr = (tid >> 2) & 31, vp = tid & 3, lvcol = ZHI + head * 128 + sl * 32 + vp * 8, i3 = 1536 + (tid & 127);
    v4u gA0, gA1, gA2, gA3, gB0, gB1, gB2, gB3; bf16x8 gAv, gBv;
#define HG_LOAD(g0, g1, g2, g3, gv, ch) do { const int c_ = (ch) < NCH ? (ch) : NCH - 1; const v4u* src_ = (const v4u*)(HT + (size_t)c_ * IMG_BYTES); \
        g0 = src_[tid]; g1 = src_[tid + 512]; g2 = src_[tid + 1024]; g3 = src_[i3]; gv = *(const bf16x8*)(Z + (zb + HG_TOKP(dir, 32 * c_ + vr)) * ZC + lvcol); } while (0)
#define HG_STASH(g0, g1, g2, g3, gv, bufi) do { LAS unsigned char* tb_ = lds + OFF_TILES + (bufi) * TILE_BYTES; LAS v4u* d_ = (LAS v4u*)tb_; \
        d_[tid] = g0; d_[tid + 512] = g1; d_[tid + 1024] = g2; if (tid < 128) { d_[tid + 1536] = g3; *(LAS bf16x8*)(tb_ + T_V + vr * VS + vp * 16) = gv; } } while (0)
    const int r32 = lane & 31, hi = lane >> 5, g1 = (lane >> 4) & 1, q4 = (lane & 15) >> 2, p4 = lane & 3, cb = 32 * wave;
    const unsigned lbase = (unsigned)(uintptr_t)lds;
    f32x16 S = {};
    HG_LOAD(gA0, gA1, gA2, gA3, gAv, 0); HG_STASH(gA0, gA1, gA2, gA3, gAv, 0); HG_LOAD(gA0, gA1, gA2, gA3, gAv, 1); HG_STASH(gA0, gA1, gA2, gA3, gAv, 1);
    HG_LOAD(gA0, gA1, gA2, gA3, gAv, 2);
    __syncthreads();
#define HG_RD64(dst, addr, OFFS) asm volatile("ds_read_b64 %0, %1 offset:" #OFFS : "=&v"(dst) : "v"(addr) : "memory")
#define HG_MFMA_STAGE(n, bufi) do { \
            const unsigned tb = lbase + OFF_TILES + (bufi) * TILE_BYTES; const LAS unsigned char* tl_ = lds + OFF_TILES + (bufi) * TILE_BYTES; \
            bf16x8 ko[2], qi[2]; s16x4 pvl[2], pvh[2], pql[2], pqh[2], kl[2], kh[2], nvl[2], nvh[2]; f32x4 dsc[4]; \
            _Pragma("unroll") for (int kk = 0; kk < 2; ++kk) { ko[kk] = *(const LAS bf16x8*)(tl_ + T_KO + r32 * RS + (cb + 16 * kk + 8 * hi) * 2); qi[kk] = *(const LAS bf16x8*)(tl_ + T_Q + r32 * RS + (cb + 16 * kk + 8 * hi) * 2); } \
            _Pragma("unroll") for (int sp = 0; sp < 2; ++sp) { \
                const unsigned va = tb + T_V + (16 * sp + 4 * hi + q4) * VS + (16 * g1 + 4 * p4) * 2; pvl[sp] = tr_read(va); pvh[sp] = tr_read(va + 8 * VS);              \
                const unsigned qa = tb + T_Q + r32 * RS + (cb + 16 * sp + 4 * hi) * 2; HG_RD64(pql[sp], qa, 0); HG_RD64(pqh[sp], qa, 16);                                  \
                const unsigned ka = tb + T_KE + (16 * sp + 8 * hi + q4) * RS + (cb + 16 * g1 + 4 * p4) * 2; kl[sp] = tr_read(ka); kh[sp] = tr_read(ka + 4 * RS);        \
                const unsigned vb = tb + T_V + (16 * sp + 8 * hi + q4) * VS + (16 * g1 + 4 * p4) * 2; nvl[sp] = tr_read(vb); nvh[sp] = tr_read(vb + 4 * VS); }            \
            _Pragma("unroll") for (int g = 0; g < 4; ++g) dsc[g] = *(const LAS f32x4*)(tl_ + T_D + (cb + 8 * g + 4 * hi) * 4); \
            asm volatile("s_waitcnt lgkmcnt(0)" ::: "memory"); __builtin_amdgcn_sched_barrier(0); \
            f32x16 X = {}; \
            X = __builtin_amdgcn_mfma_f32_32x32x16_bf16(ko[0], qi[0], X, 0, 0, 0); X = __builtin_amdgcn_mfma_f32_32x32x16_bf16(ko[1], qi[1], X, 0, 0, 0); \
            f32x16 O = {}; \
            O = __builtin_amdgcn_mfma_f32_32x32x16_bf16(cat8(pql[0], pqh[0]), pack8(S, 0), O, 0, 0, 0); O = __builtin_amdgcn_mfma_f32_32x32x16_bf16(cat8(pql[1], pqh[1]), pack8(S, 8), O, 0, 0, 0); \
            _Pragma("unroll") for (int i = 0; i < 16; ++i) S[i] *= dsc[i >> 2][i & 3]; \
            S = __builtin_amdgcn_mfma_f32_32x32x16_bf16(cat8(kl[0], kh[0]), cat8(nvl[0], nvh[0]), S, 0, 0, 0); S = __builtin_amdgcn_mfma_f32_32x32x16_bf16(cat8(kl[1], kh[1]), cat8(nvl[1], nvh[1]), S, 0, 0, 0); \
            _Pragma("unroll") for (int i = 0; i < 16; ++i) X[i] = (crow(i, hi) <= r32) ? X[i] : 0.f; \
            O = __builtin_amdgcn_mfma_f32_32x32x16_bf16(pack8(X, 0), cat8(pvl[0], pvh[0]), O, 0, 0, 0); O = __builtin_amdgcn_mfma_f32_32x32x16_bf16(pack8(X, 8), cat8(pvl[1], pvh[1]), O, 0, 0, 0); \
            LAS float* op = (LAS float*)(lds + OFF_OPART + ((n) & 1) * OPART_BYTES + wave * 4096); \
            _Pragma("unroll") for (int i = 0; i < 16; ++i) op[crow(i, hi) * 32 + r32] = O[i]; } while (0)
#define HG_OUT_STAGE(n) do { \
            const int l2 = tid - 256, tt = l2 >> 3, vq = l2 & 7; \
            const LAS float* op = (const LAS float*)(lds + OFF_OPART + (((n) - 1) & 1) * OPART_BYTES) + tt * 32 + vq * 4; \
            const f32x4 s = (*(const LAS f32x4*)op + *(const LAS f32x4*)(op + 1024)) + (*(const LAS f32x4*)(op + 2048) + *(const LAS f32x4*)(op + 3072)); \
            const int p = HG_TOKP(dir, 32 * ((n) - 1) + tt); \
            if (p >= CTXL) *(v2u*)(Od + (zb + p) * 512 + head * 128 + sl * 32 + vq * 4) = (v2u){pk2(s[0], s[1]), pk2(s[2], s[3])}; } while (0)
#define HG_ITER(n, L0, L1, L2, L3, LV, S0, S1, S2, S3, SV) do { \
        HG_LOAD(L0, L1, L2, L3, LV, (n) + 3); \
        if (wave < 4) { HG_MFMA_STAGE(n, bcur); } else if ((n) > 0) { HG_OUT_STAGE(n); } \
        { const int bst_ = bcur == 0 ? 2 : bcur - 1; HG_STASH(S0, S1, S2, S3, SV, bst_); } \
        bcur = bcur == 2 ? 0 : bcur + 1; \
        __syncthreads(); } while (0)
    int bcur = 0;
    for (int n = 0; n < NCH; n += 2) {
        HG_ITER(n, gB0, gB1, gB2, gB3, gBv, gA0, gA1, gA2, gA3, gAv);
        HG_ITER(n + 1, gA0, gA1, gA2, gA3, gAv, gB0, gB1, gB2, gB3, gBv);
    }
    if (wave >= 4) { HG_OUT_STAGE(NCH); }
    __syncthreads();
#undef HG_MFMA_STAGE
#undef HG_OUT_STAGE
#undef HG_ITER
#undef HG_LOAD
#undef HG_STASH
#undef HG_RD64
}

__device__ __forceinline__ bool in_range(int lo, int hi, int k) { asm volatile("" : "+s"(lo), "+s"(hi)); return lo <= k && k < hi; }
constexpr int NPHASES = 21;
__global__ void __launch_bounds__(NTHR, 2) fwd_kernel(Args args) {
    extern __shared__ __attribute__((aligned(16))) unsigned char lds_raw[];
    LAS unsigned char* lds = (LAS unsigned char*)lds_raw;
    const int G = gridDim.x;
#define FRESH() int tid = threadIdx.x; asm volatile("" : "+v"(tid)); const int lane = tid & 63, wave = __builtin_amdgcn_readfirstlane(tid >> 6); (void)lane; (void)wave
    unsigned char* ws = args.ws;
    if (threadIdx.x < 16) ((LAS unsigned*)(lds + LDS_BAR_OFF))[threadIdx.x] = 0u;
    __syncthreads();
    XcdBarrier bar = xcd_barrier_post((unsigned*)(ws + WS_CTL), (volatile LAS unsigned*)(lds + LDS_BAR_OFF));
    const int lo = args.ph_lo, hi = args.ph_hi;
#define IN(k) in_range(lo, hi, (k))
#define NREP(k) (((PROBE_MASK >> (k)) & 1u) ? 2 : 1)
#define REPEAT(k) for (int rep_ = 0; rep_ < NREP(k); ++rep_) if (rep_ == 0 || (xcd_barrier(bar), true))
#define SEAM(k) do { if (IN(k) && IN((k) + 1)) xcd_barrier(bar); } while (0)
    bf16* const BX = (bf16*)(ws + WS_X); bf16* const BY = (bf16*)(ws + WS_Y);
    const float* const MODV = (const float*)(ws + WS_MODV);

    if (IN(0)) REPEAT(0) { FRESH(); phase_prologue(args, lds, tid, lane, wave); } SEAM(0);
    if (IN(1)) REPEAT(1) { FRESH(); phase_mod0(args, lane, wave); } SEAM(1);
    if (IN(2)) REPEAT(2) {
        pg8::Gemm g{BX, (const bf16*)(ws + WS_WIN), NTOK, ZC, 1024}; pg8::AllOrder S; S.init(NTOK / 256, ZC / 256, G, (int)blockIdx.x);
        pg8::EpiBf16<0> E{(bf16*)(ws + WS_Z), ZC, nullptr, 0, 0, 1.f};
        pg8::gemm_phase<pg8::EpiBf16<0>, pg8::AllOrder, PG8_ALIGN, PG8_SP2>(lds, g, S, E);
    } SEAM(2);
    if (IN(3)) REPEAT(3) { FRESH(); phase_norm0(args, lane, wave); hgrn_prep_items(args, lds, tid); } SEAM(3);
    if (IN(4)) REPEAT(4) {
        { pg8::Gemm g{(const bf16*)(ws + WS_CQN), (const bf16*)(ws + WS_WUQ), NTOK, 768, 384}; pg8::LatOrder S; S.init(128, 3, G, (int)blockIdx.x);
          pg8::EpiBf16<0> E{(bf16*)(ws + WS_Q), 768, nullptr, 0, 0, 1.f};
          pg8::gemm_phase<pg8::EpiBf16<0>, pg8::LatOrder, PG8_ALIGN, PG8_SP2>(lds, g, S, E); }
        __syncthreads();
        { pg8::Gemm g{(const bf16*)(ws + WS_CKVN), (const bf16*)(ws + WS_WUKV), NTOK, 1024, 256}; pg8::AllOrder S; S.init(NTOK / 256, 4, G, (int)blockIdx.x);
          pg8::EpiBf16<0> E{(bf16*)(ws + WS_KV), 1024, nullptr, 0, 0, 1.f};
          pg8::gemm_phase<pg8::EpiBf16<0>, pg8::AllOrder, PG8_ALIGN, PG8_SP2>(lds, g, S, E); }
    } SEAM(4);
    if (IN(5)) {
        REPEAT(21) { FRESH();
        for (int u = blockIdx.x; u < 256; u += G) { __syncthreads(); hgrn_unit_mfma(args, (G == 256) ? ((u & 7) * 32 + (u >> 3)) : u, lds, tid); } }
        const bf16* Q = (const bf16*)(ws + WS_Q); const bf16* KV = (const bf16*)(ws + WS_KV); const bf16* KRR = (const bf16*)(ws + WS_KRR);
        const float* rope = (const float*)(ws + WS_ROPE);
        REPEAT(22) for (int u = blockIdx.x; u < 1024; u += G) {
            int b, h, qb; if (G == 256) { const int x = (int)blockIdx.x & 7, j = (int)blockIdx.x >> 3, pr = (u >> 8) * 16 + 2 * x + (j >> 4); b = pr >> 3; h = pr & 7; qb = j & 15; } else { b = u >> 7; h = (u >> 4) & 7; qb = u & 15; }
            const size_t kb = (size_t)b * TPB, q0 = kb + CTXL + (size_t)qb * 256;
            __syncthreads();
            att::attn_unit(Q + q0 * 768 + h * 96, KV + kb * 1024 + h * 64, KRR + kb * 32, BY + q0 * 1024 + h * 64, rope + (size_t)qb * 256 * 32, TPB, (char*)lds_raw);
        }
    } SEAM(5);
    if (IN(6)) REPEAT(6) { FRESH(); phase_readout(args, lane, wave); } SEAM(6);
    if (IN(7)) REPEAT(7) {
        pg8::Gemm g{BY, (const bf16*)(ws + WS_WOUT), NTOK, 1024, 1024}; pg8::LatOrder S; S.init(128, 4, G, (int)blockIdx.x);
        pg8::EpiRes E{args.in[I_X], (float*)(ws + WS_H), MODV, nullptr};
        pg8::gemm_phase<pg8::EpiRes, pg8::LatOrder, PG8_ALIGN, PG8_SP2>(lds, g, S, E);
    } SEAM(7);
    for (int l = 0; l < 2; ++l) {
        if (l == 1) {
            if (IN(13)) REPEAT(13) {
                pg8::Gemm g{BY, (const bf16*)(ws + WS_WPW1), NTOK, 2048, 1024}; pg8::LatOrder S; S.init(128, 8, G, (int)blockIdx.x);
                pg8::EpiGate<0> E{BX, (const float*)(ws + WS_PW1B), 8, 1.f, 1.f};
                pg8::gemm_phase<pg8::EpiGate<0>, pg8::LatOrder, PG8_ALIGN, PG8_SP2>(lds, g, S, E);
            } SEAM(13);
            if (IN(14)) REPEAT(14) { FRESH(); phase_conv(args, lds, tid, lane, wave); } SEAM(14);
            if (IN(15)) REPEAT(15) {
                pg8::Gemm g{BY, (const bf16*)(ws + WS_WPW2), NTOK, 1024, 1024}; pg8::LatOrder S; S.init(128, 4, G, (int)blockIdx.x);
                pg8::EpiRes E{nullptr, (float*)(ws + WS_H), MODV + 9 * 6144, args.in[I_PW2B]};
                pg8::gemm_phase<pg8::EpiRes, pg8::LatOrder, PG8_ALIGN, PG8_SP2>(lds, g, S, E);
            } SEAM(15);
        }
        const int pb = l ? 16 : 8;
        if (IN(pb)) REPEAT(pb) { FRESH(); phase_ln1(args, l, lds, tid, lane, wave); } SEAM(pb);
        if (IN(pb + 2) || IN(pb + 3)) {
            LAS int* tl = (LAS int*)(lds + LDS_TILE_E);
            FRESH();
            __syncthreads();
            if (tid < 32) tl[3 * MAXTILES + 64 + tid] = ld_ctl((const int*)(ws + WS_CURSOR) + l * 32 + tid);
            __syncthreads();
            if (tid == 0) { int ts = 0; for (int e = 0; e < 32; ++e) { tl[3 * MAXTILES + e] = ts; ts += (tl[3 * MAXTILES + 64 + e] + 255) >> 8; } tl[3 * MAXTILES + 32] = ts; }
            __syncthreads();
            const int ntiles = tl[3 * MAXTILES + 32];
            for (int t = tid; t < ntiles && t < MAXTILES; t += NTHR) { int e = 0; while (e < 31 && tl[3 * MAXTILES + e + 1] <= t) ++e; const int j = t - tl[3 * MAXTILES + e], rem = tl[3 * MAXTILES + 64 + e] - 256 * j;
                tl[t] = e; tl[MAXTILES + t] = e * ECAP + 256 * j; tl[2 * MAXTILES + t] = rem < 256 ? rem : 256; }
            __syncthreads();
            if (IN(pb + 2)) REPEAT(pb + 2) {
                pg8::Gemm g{BX, (const bf16*)(ws + WS_WGU + (size_t)l * 32 * 2048 * 1024), 0, 0, 512};
                pg8::MoeOrder S; S.init(ntiles, 8, G, (int)blockIdx.x); S.tile_e = tl; S.nper = 8;
                pg8::EpiGate<1, true> E{(bf16*)(ws + WS_ACT), (const float*)(ws + WS_BGU) + (size_t)l * 32 * 2048, 8, 1.f / (SC_X8 * SC_WGU), SC_ACT};
                pg8::gemm_phase<pg8::EpiGate<1, true>, pg8::MoeOrder, PG8_ALIGN, true, true, true>(lds, g, S, E, (const int*)(ws + WS_ROWS), tl + MAXTILES);
            } SEAM(pb + 2);
            if (IN(pb + 3)) REPEAT(pb + 3) {
                pg8::Gemm g{(const bf16*)(ws + WS_ACT), (const bf16*)(ws + WS_WDN + (size_t)l * 32 * 1024 * 1024), 0, 0, 512};
                pg8::MoeOrder S; S.init(ntiles, 4, G, (int)blockIdx.x); S.tile_e = tl; S.nper = 4;
                pg8::EpiDown E{(bf16*)(ws + WS_YB), args.in[I_BDN] + (size_t)l * 32 * 1024, (const float*)(ws + WS_ROWW), (const int*)(ws + WS_ROWD), 1.f / (SC_ACT * SC_WDN), tl + MAXTILES, SC_Y};
                pg8::gemm_phase<pg8::EpiDown, pg8::MoeOrder, PG8_ALIGN, true, false, true>(lds, g, S, E);
            } SEAM(pb + 3);
        }
        if (IN(pb + 4)) REPEAT(pb + 4) { FRESH(); phase_ln2(args, l, lane, wave); }
        if (l == 0) SEAM(12);
    }
#undef IN
#undef SEAM
}

extern "C" void kernel_launch(void* const* d_in, const int* in_sizes, int n_in, void* d_out, int out_size, void* d_ws, size_t ws_size, hipStream_t stream) {
    static int grid = 0;
    if (grid == 0) {
        if (n_in != 33 || in_sizes[0] != NB * SEQ * D || out_size != NB * SEQ * D || ws_size < WS_END) {
            fprintf(stderr, "kernel_launch: unexpected shapes: n_in %d in0 %d out %d ws %zu (need %zu)\n", n_in, n_in > 0 ? in_sizes[0] : -1, out_size, ws_size, (size_t)WS_END); grid = -1; return; }
        int dev = 0, cus = 0;
        if (hipGetDevice(&dev) != hipSuccess || hipDeviceGetAttribute(&cus, hipDeviceAttributeMultiprocessorCount, dev) != hipSuccess) { grid = -1; return; }
        if (hipFuncSetAttribute((const void*)fwd_kernel, hipFuncAttributeMaxDynamicSharedMemorySize, LDS_BYTES) != hipSuccess) { fprintf(stderr, "kernel_launch: hipFuncSetAttribute failed\n"); grid = -1; return; }
        int per_cu = 0;
        if (hipOccupancyMaxActiveBlocksPerMultiprocessor(&per_cu, (const void*)fwd_kernel, NTHR, LDS_BYTES) != hipSuccess || per_cu < 1) fprintf(stderr, "kernel_launch: occupancy query reports %d\n", per_cu);
        (void)hipGetLastError();
        grid = cus;
    }
    if (grid < 0) return;
    if (hipMemsetAsync((char*)d_ws + WS_CTL, 0, CTL_ZERO_BYTES, stream) != hipSuccess) return;
    Args a{};
    for (int i = 0; i < 33; ++i) a.in[i] = (const float*)d_in[i];
    a.out = (float*)d_out; a.ws = (unsigned char*)d_ws;
#if MK_ONE_LAUNCH
    a.ph_lo = 0; a.ph_hi = NPHASES;
    hipLaunchKernelGGL(fwd_kernel, dim3(grid), dim3(NTHR), LDS_BYTES, stream, a);
#else
    for (int ph = 0; ph < NPHASES; ++ph) { a.ph_lo = ph; a.ph_hi = ph + 1; hipLaunchKernelGGL(fwd_kernel, dim3(grid), dim3(NTHR), LDS_BYTES, stream, a); }
#endif
    const hipError_t le = hipPeekAtLastError();
    if (le != hipSuccess) fprintf(stderr, "kernel_launch: launch failed: %s\n", hipGetErrorName(le));
}
```

```cpp
#include <hip/hip_runtime.h>
#include <cstdio>
#include <cstdint>

#ifndef PROBE_MASK
#define PROBE_MASK 0u
#endif
#if defined(PROBE_K2)
#define PROBE_KSC 0.5f
#else
#define PROBE_KSC 1.0f
#endif
#ifndef MK_ONE_LAUNCH
#define MK_ONE_LAUNCH 1
#endif

namespace pg8 {
#define PG8_LAS __attribute__((address_space(3)))
typedef unsigned short bf16_t;
typedef short bf16x8 __attribute__((ext_vector_type(8)));
typedef float f32x4 __attribute__((ext_vector_type(4)));
typedef unsigned u32x4 __attribute__((ext_vector_type(4)));
constexpr int BM = 256, BK = 64, HALF = 128, HTB = HALF * BK * 2  , STAGE_BYTES = 8 * HTB, NXCD = 8, WGM = 8;

__host__ __device__ __forceinline__ int lds_byte(int r, int c) { const int st = (r >> 4) * 2 + (c >> 5), rr = r & 15, cc = c & 31, ob = rr * 64 + cc * 2; return st * 1024 + (ob ^ (((ob >> 9) & 1) << 5)); }
__host__ __device__ __forceinline__ void stage_rc(int b, int& R, int& C) { const int st = b / 1024, sb = b % 1024, swz = sb ^ (((sb >> 9) & 1) << 5); R = (st >> 1) * 16 + swz / 64; C = (st & 1) * 32 + (swz % 64) / 2; }
__host__ __device__ __forceinline__ int perm32(int rho) { const int n = rho >> 4, i = rho & 15; return 8 * (i >> 2) + 4 * n + (i & 3); }

struct Unit { int pm, pn; };
struct Gemm { const bf16_t* A; const bf16_t* Bt; int M, N, K; };

struct StaticOrder {
    int nM, nN, nwg, G, c;
    __host__ __device__ void init(int M, int N, int G_, int c_) { nM = M / BM; nN = N / BM; nwg = nM * nN; G = G_; c = c_; }
    __host__ __device__ bool next(int i, Unit& u) const {
        const long L = (long)i * G + c; if (L >= nwg) return false;
        int wgid = (int)L; { const int q = nwg / NXCD, r = nwg % NXCD, xcd = wgid % NXCD, off = wgid / NXCD; wgid = (xcd < r ? xcd * (q + 1) : r * (q + 1) + (xcd - r) * q) + off; }
        const int nig = WGM * nN, gid = wgid / nig, fm = gid * WGM, gsz = (nM - fm) < WGM ? (nM - fm) : WGM;
        u.pm = fm + ((wgid % nig) % gsz); u.pn = (wgid % nig) / gsz; return true;
    }
    __device__ __forceinline__ void a_ready(const Unit&) const {}
    __device__ __forceinline__ void done(const Unit&) const {}
};

__device__ __forceinline__ unsigned cvt_pk_bf16(float lo, float hi) { unsigned r; asm volatile("v_cvt_pk_bf16_f32 %0, %1, %2" : "=v"(r) : "v"(lo), "v"(hi)); return r; }
typedef float f32x2 __attribute__((ext_vector_type(2)));
__device__ __forceinline__ f32x2 gelu_pk(f32x2 v) {
    const f32x2 av = __builtin_elementwise_abs(v), d = av * 0.2316418882f + 1.0f;
    f32x2 t; t.x = __builtin_amdgcn_rcpf(d.x); t.y = __builtin_amdgcn_rcpf(d.y);
    f32x2 q = t * 0.5307027145f + (-0.7265760135f); q = q * t + 0.7107068705f; q = q * t + (-0.142248368f); q = q * t + 0.127414796f; q = q * t;
    const f32x2 s = (v * v) * (-0.72134752044f);
    f32x2 e; e.x = __builtin_amdgcn_exp2f(s.x); e.y = __builtin_amdgcn_exp2f(s.y);
    const f32x2 m = v * (q * e), r = v - m;
    f32x2 o; o.x = v.x < 0.f ? m.x : r.x; o.y = v.y < 0.f ? m.y : r.y; return o;
}

template <int ACT  > struct EpiBf16 {
    static constexpr bool PERM = true, AFTER_DRAIN = false; static_assert(ACT == 0 || ACT == 1, "EpiBf16: ACT is 0 (none) or 1 (gelu_pk)");
    bf16_t* O; int ldc; const float* bias; int split_cols; size_t split_stride; float scale0;
    __device__ __forceinline__ void operator()(const f32x4 (&acc)[2][2][4][2], const Unit& u, int wr, int wc, int fr, int fq) const {
        const int row0 = u.pm * BM + wr * 64 + fr; int colt = u.pn * BM; bf16_t* base = O;
        float sc = 1.f; if (split_cols) { const int t = colt / split_cols; base += (size_t)t * split_stride; colt -= t * split_cols; if (t == 0) sc = scale0; }
        const int col0 = colt + wc * 32 + 8 * fq, bcol0 = u.pn * BM + wc * 32 + 8 * fq;
        f32x4 bv[2][2];
#pragma unroll
        for (int bj = 0; bj < 2; ++bj)
#pragma unroll
            for (int n = 0; n < 2; ++n) bv[bj][n] = bias ? *(const f32x4*)(bias + bcol0 + bj * HALF + 4 * n) : (f32x4){0.f, 0.f, 0.f, 0.f};
#pragma unroll
        for (int ai = 0; ai < 2; ++ai)
#pragma unroll
            for (int m = 0; m < 4; ++m) { bf16_t* rowp = base + (size_t)(row0 + ai * HALF + m * 16) * ldc + col0;
#pragma unroll
                for (int bj = 0; bj < 2; ++bj) { f32x4 v0 = acc[ai][bj][m][0] + bv[bj][0], v1 = acc[ai][bj][m][1] + bv[bj][1];
                    if (ACT == 1) { f32x2 a = gelu_pk((f32x2){v0[0], v0[1]}), b = gelu_pk((f32x2){v0[2], v0[3]}), c = gelu_pk((f32x2){v1[0], v1[1]}), d = gelu_pk((f32x2){v1[2], v1[3]});
                        v0 = (f32x4){a.x, a.y, b.x, b.y}; v1 = (f32x4){c.x, c.y, d.x, d.y}; }
                    v0 = v0 * sc; v1 = v1 * sc; u32x4 w; w.x = cvt_pk_bf16(v0[0], v0[1]); w.y = cvt_pk_bf16(v0[2], v0[3]); w.z = cvt_pk_bf16(v1[0], v1[1]); w.w = cvt_pk_bf16(v1[2], v1[3]);
                    *(u32x4*)(rowp + bj * HALF) = w; } }
    }
};
typedef int v4i_t __attribute__((ext_vector_type(4)));
typedef int v8i_t __attribute__((ext_vector_type(8)));
__device__ __forceinline__ v8i_t cat32(bf16x8 a, bf16x8 b) { const v4i_t x = __builtin_bit_cast(v4i_t, a), y = __builtin_bit_cast(v4i_t, b); return __builtin_shufflevector(x, y, 0, 1, 2, 3, 4, 5, 6, 7); }
template <class Epi, class Sched, bool ALIGN_EPI = false, bool SP2 = false, bool GATHER = false, bool FP8 = false>
__device__ __forceinline__ void gemm_phase(PG8_LAS unsigned char* lds, const Gemm g, const Sched& S, const Epi& E, const int* rowsrc = nullptr, const PG8_LAS int* gtab = nullptr) {
    static_assert(!GATHER || SP2, "GATHER is implemented on the SP2 loop only");
    int tid_l = threadIdx.x; asm volatile("" : "+v"(tid_l));
    const int tid = tid_l, wid = __builtin_amdgcn_readfirstlane(tid >> 6), lane = tid & 63, wr = wid >> 2, wc = wid & 3, fr = lane & 15, fq = lane >> 4;
#if defined(PROBE_K2)
    const int K = g.K, nt0 = K / BK, nt = FP8 ? 2 * nt0 : nt0;
#define PG8_KT(x) (FP8 ? ((x) & (nt0 - 1)) : (x))
#else
    const int K = g.K, nt = K / BK;
#define PG8_KT(x) (x)
#endif
    unsigned voffA[2], voffB[2];
#pragma unroll
    for (int i = 0; i < 2; ++i) { int R, C; stage_rc(tid * 16 + i * 8192, R, C); const int Rb = Epi::PERM ? ((R & ~31) + perm32(R & 31)) : R;
        voffA[i] = (unsigned)(R * K + C) * 2u; voffB[i] = (unsigned)(Rb * K + C) * 2u; }
    unsigned gAc[2][2], gAn[2][2]; int gR[2]; unsigned gC[2];
#pragma unroll
    for (int i = 0; i < 2; ++i) { int R, C; stage_rc(tid * 16 + i * 8192, R, C); gR[i] = R; gC[i] = (unsigned)C * 2u; gAc[0][i] = gAc[1][i] = gAn[0][i] = gAn[1][i] = 0u; }
#define PG8_GATHER(u_, o_) do { const int gtb_ = gtab[(u_).pm], gtc_ = gtab[576 + (u_).pm];     \
        _Pragma("unroll") for (int h_ = 0; h_ < 2; ++h_) _Pragma("unroll") for (int i_ = 0; i_ < 2; ++i_) \
        { const int rl_ = h_ * HALF + gR[i_]; const int src_ = rl_ < gtc_ ? rowsrc[gtb_ + rl_] : 0; o_[h_][i_] = (unsigned)src_ * (unsigned)(K * 2) + gC[i_]; } } while (0)
#define PG8_STAGE_A(bufoff, orig_gbase, NEXTSEL, H, KOFF) do { if constexpr (GATHER) { unsigned vo_[2]; vo_[0] = (NEXTSEL) ? gAn[H][0] : gAc[H][0]; vo_[1] = (NEXTSEL) ? gAn[H][1] : gAc[H][1]; \
        PG8_STAGE(bufoff, (const char*)g.A + (KOFF), vo_); } else { PG8_STAGE(bufoff, orig_gbase, voffA); } } while (0)
    const size_t kstep = (size_t)(BK * 2);
    const size_t hstep = (size_t)HALF * K * 2;
    const size_t tstep = 2 * hstep;
    const unsigned ldsw = (unsigned)wid * 1024u;
    const int aoff = lds_byte(wr * 64 + fr, fq * (FP8 ? 16 : 8)), boff = lds_byte(wc * 32 + fr, fq * (FP8 ? 16 : 8));
#define PG8_SA(b, h) (((b) * 2 + (h)) * HTB)
#define PG8_SB(b, h) ((4 + (b) * 2 + (h)) * HTB)
#define PG8_STAGE(bufoff, gbase, voff) do { _Pragma("unroll") for (int _i = 0; _i < 2; ++_i) \
        __builtin_amdgcn_global_load_lds((const unsigned*)((const char*)(gbase) + (voff)[_i]), (PG8_LAS unsigned*)(lds + (bufoff) + ldsw + _i * 8192), 16, 0, 0); } while (0)
#define PG8_LD32(var, addr) do { const bf16x8 lo_ = *(const PG8_LAS bf16x8*)(addr); const bf16x8 hi_ = *(const PG8_LAS bf16x8*)((addr) + 16); var = cat32(lo_, hi_); } while (0)
#define PG8_LDA(dst, b, h) do { if constexpr (FP8) { _Pragma("unroll") for (int m = 0; m < 4; ++m) PG8_LD32(dst##8[m], lds + PG8_SA(b, h) + aoff + m * 2048); } \
        else { _Pragma("unroll") for (int m = 0; m < 4; ++m) _Pragma("unroll") for (int k = 0; k < 2; ++k) dst[m][k] = *(const PG8_LAS bf16x8*)(lds + PG8_SA(b, h) + aoff + m * 2048 + k * 1024); } } while (0)
#define PG8_LDB(dst, b, h) do { if constexpr (FP8) { _Pragma("unroll") for (int n = 0; n < 2; ++n) PG8_LD32(dst##8[n], lds + PG8_SB(b, h) + boff + n * 2048); } \
        else { _Pragma("unroll") for (int n = 0; n < 2; ++n) _Pragma("unroll") for (int k = 0; k < 2; ++k) dst[n][k] = *(const PG8_LAS bf16x8*)(lds + PG8_SB(b, h) + boff + n * 2048 + k * 1024); } } while (0)
#define PG8_MMA(ai, bj, At, Bt) do { __builtin_amdgcn_s_setprio(1); \
        if constexpr (FP8) { _Pragma("unroll") for (int m = 0; m < 4; ++m) _Pragma("unroll") for (int n = 0; n < 2; ++n) \
            asm volatile("v_mfma_scale_f32_16x16x128_f8f6f4 %0, %1, %2, %0, %3, %3 op_sel_hi:[0,0,0]" : "+v"(acc[ai][bj][m][n]) : "v"(Bt##8[n]), "v"(At##8[m]), "v"(sc127)); } \
        else { _Pragma("unroll") for (int m = 0; m < 4; ++m) _Pragma("unroll") for (int n = 0; n < 2; ++n) _Pragma("unroll") for (int k = 0; k < 2; ++k) \
            acc[ai][bj][m][n] = __builtin_amdgcn_mfma_f32_16x16x32_bf16(Bt[n][k], At[m][k], acc[ai][bj][m][n], 0, 0, 0); } \
        __builtin_amdgcn_s_setprio(0); } while (0)
#define PG8_WAIT_V(n) asm volatile("s_waitcnt vmcnt(" #n ")" ::: "memory")
#define PG8_WAIT_L(n) asm volatile("s_waitcnt lgkmcnt(" #n ")" ::: "memory")
#define PG8_BAR __builtin_amdgcn_s_barrier()
#define PG8_SCHED __builtin_amdgcn_sched_barrier(0)
    Unit cur, nxt; int ui = 0;
    if (!S.next(0, cur)) return;
    f32x4 acc[2][2][4][2];
#pragma unroll
    for (int a = 0; a < 2; ++a)
#pragma unroll
        for (int b = 0; b < 2; ++b)
#pragma unroll
            for (int m = 0; m < 4; ++m)
#pragma unroll
                for (int n = 0; n < 2; ++n) acc[a][b][m][n] = (f32x4){0.f, 0.f, 0.f, 0.f};
    int sc127 = 0x7f7f7f7f; asm volatile("" : "+v"(sc127));
    bf16x8 At[4][2], B0[2][2], B1[2][2]; v8i_t At8[4], B08[2], B18[2]; (void)At; (void)B0; (void)B1; (void)At8; (void)B08; (void)B18;
    const char* cA = (const char*)g.A + (size_t)cur.pm * tstep; const char* cB = (const char*)g.Bt + (size_t)cur.pn * tstep;
    S.a_ready(cur);
    if constexpr (GATHER) { PG8_GATHER(cur, gAc); }
    if constexpr (SP2) {
        PG8_STAGE(PG8_SB(0, 0), cB, voffB); PG8_STAGE(PG8_SB(0, 1), cB + hstep, voffB); PG8_STAGE_A(PG8_SA(0, 0), cA, false, 0, (size_t)0); PG8_STAGE_A(PG8_SA(0, 1), cA + hstep, false, 1, (size_t)0);
        if (wr == 1) PG8_BAR;
        PG8_WAIT_V(2); PG8_BAR;
        PG8_STAGE(PG8_SB(1, 0), cB + kstep, voffB); PG8_STAGE_A(PG8_SA(1, 0), cA + kstep, false, 0, kstep); PG8_STAGE(PG8_SB(1, 1), cB + hstep + kstep, voffB);
        PG8_WAIT_V(6); PG8_BAR;
    } else {
        PG8_STAGE(PG8_SB(0, 0), cB, voffB); PG8_STAGE(PG8_SA(0, 0), cA, voffA); PG8_STAGE(PG8_SB(0, 1), cB + hstep, voffB); PG8_STAGE(PG8_SA(0, 1), cA + hstep, voffA);
        if (wr == 1) PG8_BAR;
        PG8_WAIT_V(4); PG8_BAR;
        PG8_STAGE(PG8_SB(1, 0), cB + kstep, voffB); PG8_STAGE(PG8_SA(1, 0), cA + kstep, voffA); PG8_STAGE(PG8_SB(1, 1), cB + hstep + kstep, voffB);
        PG8_WAIT_V(6); PG8_BAR;
    }
    for (;;) {
        const bool has_next = S.next(ui + 1, nxt);
        if constexpr (GATHER) { if (has_next) { PG8_GATHER(nxt, gAn); } else { _Pragma("unroll") for (int h_ = 0; h_ < 2; ++h_) _Pragma("unroll") for (int i_ = 0; i_ < 2; ++i_) gAn[h_][i_] = gAc[h_][i_]; } }
        const char* nA = has_next ? (const char*)g.A + (size_t)nxt.pm * tstep : cA; const char* nB = has_next ? (const char*)g.Bt + (size_t)nxt.pn * tstep : cB;
#pragma nounroll
        for (int t = 0; t < nt; t += 2) {
            const bool last = (t == nt - 2);
            const char* a1 = cA + (size_t)PG8_KT(t + 1) * kstep;
            const char* a2 = last ? nA : cA + (size_t)PG8_KT(t + 2) * kstep; const char* b2 = last ? nB : cB + (size_t)PG8_KT(t + 2) * kstep;
            const char* a3 = a2 + kstep; const char* b3 = b2 + kstep;
            const size_t k1 = (size_t)PG8_KT(t + 1) * kstep, k2 = last ? (size_t)0 : (size_t)PG8_KT(t + 2) * kstep, k3 = k2 + kstep; (void)k1; (void)k2; (void)k3;
            if (last && has_next) S.a_ready(nxt);
            if constexpr (SP2) {
            PG8_LDB(B0, 0, 0); PG8_LDB(B1, 0, 1); PG8_SCHED; PG8_LDA(At, 0, 0); PG8_STAGE_A(PG8_SA(1, 1), a1 + hstep, false, 1, k1);
            PG8_WAIT_V(8); PG8_WAIT_L(0); PG8_BAR; PG8_MMA(0, 0, At, B0); PG8_MMA(0, 1, At, B1); PG8_BAR; PG8_SCHED;
            PG8_LDA(At, 0, 1); PG8_STAGE(PG8_SB(0, 0), b2, voffB); PG8_STAGE(PG8_SB(0, 1), b2 + hstep, voffB); PG8_STAGE_A(PG8_SA(0, 0), a2, last, 0, k2);
            PG8_WAIT_V(8); PG8_WAIT_L(0); PG8_BAR; PG8_MMA(1, 0, At, B0); PG8_MMA(1, 1, At, B1); PG8_BAR; PG8_SCHED;
            PG8_LDB(B0, 1, 0); PG8_LDB(B1, 1, 1); PG8_SCHED; PG8_LDA(At, 1, 0); PG8_STAGE_A(PG8_SA(0, 1), a2 + hstep, last, 1, k2);
            PG8_WAIT_V(8); PG8_WAIT_L(0); PG8_BAR; PG8_MMA(0, 0, At, B0); PG8_MMA(0, 1, At, B1); PG8_BAR; PG8_SCHED;
            PG8_LDA(At, 1, 1); PG8_STAGE(PG8_SB(1, 0), b3, voffB); PG8_STAGE(PG8_SB(1, 1), b3 + hstep, voffB); PG8_STAGE_A(PG8_SA(1, 0), a3, last, 0, k3);
            PG8_WAIT_V(8); PG8_WAIT_L(0); PG8_BAR; PG8_MMA(1, 0, At, B0); PG8_MMA(1, 1, At, B1); PG8_BAR; PG8_SCHED;
            } else {
            PG8_LDB(B0, 0, 0); PG8_SCHED; PG8_LDA(At, 0, 0); PG8_STAGE(PG8_SA(1, 1), a1 + hstep, voffA);
            PG8_WAIT_L(8); PG8_BAR; PG8_WAIT_L(0); PG8_MMA(0, 0, At, B0); PG8_BAR; PG8_SCHED;
            PG8_LDB(B1, 0, 1); PG8_STAGE(PG8_SB(0, 0), b2, voffB);
            PG8_BAR; PG8_WAIT_L(0); PG8_MMA(0, 1, At, B1); PG8_BAR;
            PG8_LDA(At, 0, 1); PG8_STAGE(PG8_SA(0, 0), a2, voffA);
            PG8_BAR; PG8_WAIT_L(0); PG8_MMA(1, 0, At, B0); PG8_BAR; PG8_SCHED;
            PG8_STAGE(PG8_SB(0, 1), b2 + hstep, voffB);
            PG8_WAIT_V(6); PG8_BAR; PG8_MMA(1, 1, At, B1); PG8_BAR;
            PG8_LDB(B0, 1, 0); PG8_SCHED; PG8_LDA(At, 1, 0); PG8_STAGE(PG8_SA(0, 1), a2 + hstep, voffA);
            PG8_WAIT_L(8); PG8_BAR; PG8_WAIT_L(0); PG8_MMA(0, 0, At, B0); PG8_BAR; PG8_SCHED;
            PG8_LDB(B1, 1, 1); PG8_STAGE(PG8_SB(1, 0), b3, voffB);
            PG8_BAR; PG8_WAIT_L(0); PG8_MMA(0, 1, At, B1); PG8_BAR;
            PG8_LDA(At, 1, 1); PG8_STAGE(PG8_SA(1, 0), a3, voffA);
            PG8_BAR; PG8_WAIT_L(0); PG8_MMA(1, 0, At, B0); PG8_BAR; PG8_SCHED;
            PG8_STAGE(PG8_SB(1, 1), b3 + hstep, voffB);
            PG8_WAIT_V(6); PG8_BAR; PG8_MMA(1, 1, At, B1); PG8_BAR;
            }
        }
        if constexpr (ALIGN_EPI) { if (wr == 0) PG8_BAR; }
        if constexpr (FP8) { asm volatile("s_nop 15\n\ts_nop 15" ::: "memory"); }
        if constexpr (!Epi::AFTER_DRAIN) { E(acc, cur, wr, wc, fr, fq);
#if defined(PROBE_EPI2)
            if constexpr (FP8) { E(acc, cur, wr, wc, fr, fq); }
#endif
            S.done(cur); }
        if (!has_next) break;
#pragma unroll
        for (int a = 0; a < 2; ++a)
#pragma unroll
            for (int b = 0; b < 2; ++b)
#pragma unroll
                for (int m = 0; m < 4; ++m)
#pragma unroll
                    for (int n = 0; n < 2; ++n) acc[a][b][m][n] = (f32x4){0.f, 0.f, 0.f, 0.f};
        cur = nxt; cA = nA; cB = nB; ++ui;
        if constexpr (GATHER) { _Pragma("unroll") for (int h_ = 0; h_ < 2; ++h_) _Pragma("unroll") for (int i_ = 0; i_ < 2; ++i_) gAc[h_][i_] = gAn[h_][i_]; }
        if constexpr (ALIGN_EPI) { if (wr == 1) PG8_BAR; }
    }
    PG8_WAIT_V(0);
    if constexpr (!ALIGN_EPI) { if (wr == 0) PG8_BAR; }
    PG8_BAR;
    if constexpr (Epi::AFTER_DRAIN) { E.fused(acc, cur, wr, wc, fr, fq, lds, wid, lane); S.done(cur); }
#undef PG8_SA
#undef PG8_SB
#undef PG8_STAGE
#undef PG8_STAGE_A
#undef PG8_GATHER
#undef PG8_LDA
#undef PG8_LD32
#undef PG8_LDB
#undef PG8_MMA
#undef PG8_WAIT_V
#undef PG8_WAIT_L
#undef PG8_BAR
#undef PG8_SCHED
}
}

#ifndef PG8_SP2
#define PG8_SP2 true
#endif
#ifndef PG8_ALIGN
#define PG8_ALIGN true
#endif

#define GAS __attribute__((address_space(1)))
#define LAS __attribute__((address_space(3)))
typedef unsigned short bf16;
typedef unsigned v4u __attribute__((ext_vector_type(4)));
typedef unsigned v2u __attribute__((ext_vector_type(2)));
typedef float f32x4 __attribute__((ext_vector_type(4)));
typedef short bf16x8 __attribute__((ext_vector_type(8)));

constexpr int D = 1024, NB = 8, SEQ = 4096, CTXL = 256, TPB = SEQ + CTXL, NTOK = NB * TPB, NLAT = NB * SEQ;
constexpr int ZC = 3328;
constexpr int ZQ = 0, ZKV = 384, ZKR = 640, ZHQ = 672, ZHF = 1184, ZHB = 1696, ZHI = 2208, ZHG = 2720;
constexpr int NEXP = 32;
constexpr float ALPHA = 1.4142135623730951f;
constexpr float LN_EPS = 1e-5f, RMS_EPS = 1e-6f;
constexpr int NWAVES = 8, NTHR = 512;
constexpr float SC_X8 = 16.f, SC_WGU = 64.f, SC_ACT = 8.f, SC_WDN = 128.f, SC_Y = 64.f;
constexpr int LDS_BYTES = 147456;
constexpr int LDS_BAR_OFF = LDS_BYTES - 64;
constexpr int LDS_TILE_E = 131072;
constexpr int MAXTILES = 576;

constexpr size_t MiB = 1u << 20;
constexpr size_t WS_CTL = 0, CTL_ZERO_BYTES = 16384;
constexpr size_t WS_MODV = 1 * MiB;
constexpr size_t WS_ROPE = 1 * MiB + 512 * 1024;
constexpr size_t WS_BGU = 2 * MiB;
constexpr size_t WS_PW1B = 2 * MiB + 512 * 1024;
constexpr size_t WS_BCNT = WS_PW1B + 64 * 1024;
constexpr size_t WS_TILEE = WS_BCNT + 64 * 1024;
constexpr size_t WS_META = WS_TILEE + 4096;
constexpr size_t WS_TOPI = 3 * MiB, WS_TOPW = 4 * MiB;
constexpr int ECAP = 32768;
constexpr size_t WS_ROWS = 160 * MiB, WS_ROWW = 164 * MiB, WS_ROWD = 168 * MiB;
constexpr size_t WS_CURSOR = 14336;
constexpr size_t WS_WIN = 8 * MiB, WS_WUQ = 15 * MiB, WS_WUKV = 16 * MiB, WS_WOUT = 17 * MiB, WS_WPW1 = 19 * MiB, WS_WPW2 = 23 * MiB;
constexpr size_t WS_WGU = 32 * MiB, WS_WDN = 288 * MiB;
constexpr size_t WS_H = 416 * MiB;
constexpr size_t WS_X = 552 * MiB, WS_Y = 620 * MiB;
constexpr size_t WS_BIG = 688 * MiB;
constexpr size_t WS_Z = WS_BIG, WS_CQN = WS_BIG + 221 * MiB, WS_CKVN = WS_BIG + 247 * MiB, WS_KRR = WS_BIG + 264 * MiB,
                 WS_Q = WS_BIG + 267 * MiB, WS_KV = WS_BIG + 318 * MiB, WS_OF = WS_BIG + 386 * MiB, WS_OB = WS_BIG + 454 * MiB;
constexpr size_t WS_HT = WS_BIG + 528 * MiB;
constexpr size_t WS_XS = WS_BIG, WS_ACT = WS_BIG + 288 * MiB, WS_YB = WS_BIG + 576 * MiB;
constexpr size_t WS_END = WS_BIG + 848 * MiB;
static_assert((size_t)NTOK * ZC * 2 <= 221 * MiB && (size_t)NTOK * 384 * 2 <= 26 * MiB && (size_t)NTOK * 256 * 2 <= 17 * MiB && (size_t)NTOK * 32 * 2 <= 3 * MiB, "ws map 1");
static_assert((size_t)NTOK * 768 * 2 <= 51 * MiB && (size_t)NTOK * 1024 * 2 <= 68 * MiB && (size_t)NTOK * 512 * 4 <= 68 * MiB, "ws map 2");
static_assert((size_t)64 * 136 * 26624 <= 320 * MiB && (size_t)MAXTILES * 256 * 2048 <= 288 * MiB && (size_t)NLAT * 4 * 2048 <= 272 * MiB && (size_t)NTOK * 1024 * 4 <= 136 * MiB, "ws map 3");

#define LDS_WAIT() asm volatile("s_waitcnt lgkmcnt(0)" ::: "memory")
#define VM_WAIT() asm volatile("s_waitcnt vmcnt(0)" ::: "memory")
__device__ __forceinline__ float bf2f(unsigned short b) { return __uint_as_float(((unsigned)b) << 16); }
__device__ __forceinline__ unsigned pk2(float lo, float hi) { return pg8::cvt_pk_bf16(lo, hi); }
__device__ __forceinline__ float sigm(float x) { return __builtin_amdgcn_rcpf(1.f + __expf(-x)); }
__device__ __forceinline__ float wave_sum(float v) {
#pragma unroll
    for (int o = 1; o < 64; o <<= 1) v += __shfl_xor(v, o);
    return v;
}
__device__ __forceinline__ int ld_ctl(const int* p) { return (int)__hip_atomic_load((const unsigned*)p, __ATOMIC_RELAXED, __HIP_MEMORY_SCOPE_AGENT); }
__device__ __forceinline__ int grow_of(int lr) { return (lr >> 12) * TPB + CTXL + (lr & 4095); }

#define XB_TMO      128
#define XB_XCNT(j)  (256  + 64 * (j))
#define XB_XSUB(j)  (1280 + 64 * (j))
#define XB_XGEN(j)  (2304 + 64 * (j))
#define XB_TOP      3328
#define XB_TOPGEN   3392
#define XCD_BAR_WORDS 3456
#define XB_SPIN_CAP (1u << 21)

__device__ __forceinline__ unsigned xb_ld(unsigned* p)              { return __hip_atomic_load(p, __ATOMIC_RELAXED, __HIP_MEMORY_SCOPE_AGENT); }
__device__ __forceinline__ unsigned xb_add(unsigned* p, unsigned v) { return __hip_atomic_fetch_add(p, v, __ATOMIC_RELAXED, __HIP_MEMORY_SCOPE_AGENT); }
__device__ __forceinline__ unsigned xb_xcc_id() { return (unsigned)__builtin_amdgcn_s_getreg((3 << 11) | 20) & 0xFu; }
#define XB_SPIN(cond, bar) do { unsigned _sp = 0; while (cond) { __builtin_amdgcn_s_sleep(1); \
    if ((++_sp & 255u) == 0u) { if (xb_ld(&(bar)[XB_TMO])) break; if (_sp > XB_SPIN_CAP) { atomicAdd(&(bar)[XB_TMO], 1u); break; } } } } while (0)

struct XcdBarrier { unsigned* bar; unsigned x; volatile LAS unsigned* st; };

__device__ __forceinline__ XcdBarrier xcd_barrier_post(unsigned* bar, volatile LAS unsigned* st) {
    XcdBarrier b; b.bar = bar; b.x = xb_xcc_id(); b.st = st;
    if (threadIdx.x == 0) (void)xb_add(&bar[XB_XCNT(b.x)], 1u);
    return b;
}
__device__ __forceinline__ void xcd_barrier_complete(unsigned* bar, unsigned x, unsigned& nloc, unsigned& nx) {
    const unsigned G = gridDim.x * gridDim.y * gridDim.z;
    unsigned sum, cnt, mine, sp = 0u;
    for (;;) {
        sum = 0u; cnt = 0u; mine = 0u;
#pragma unroll
        for (unsigned j = 0; j < 16; ++j) { const unsigned c = xb_ld(&bar[XB_XCNT(j)]); sum += c; cnt += (c > 0u) ? 1u : 0u; mine = (j == x) ? c : mine; }
        if (sum == G) break;
        __builtin_amdgcn_s_sleep(1);
        if ((++sp & 255u) == 0u) { if (xb_ld(&bar[XB_TMO])) break; if (sp > XB_SPIN_CAP) { atomicAdd(&bar[XB_TMO], 1u); break; } }
    }
    nloc = mine > 0u ? mine : 1u; nx = cnt > 0u ? cnt : 1u;
}
__device__ __forceinline__ void xcd_barrier(const XcdBarrier& b) {
    asm volatile("s_waitcnt vmcnt(0)" ::: "memory");
    __syncthreads();
    if (threadIdx.x == 0) {
        unsigned* bar = b.bar;
        __builtin_amdgcn_s_waitcnt(0);
        unsigned nloc = b.st[0], nx = b.st[1];
        if (nloc == 0u) { xcd_barrier_complete(bar, b.x, nloc, nx); b.st[0] = nloc; b.st[1] = nx; }
        const unsigned old = xb_add(&bar[XB_XSUB(b.x)], 1u);
        const unsigned gen = old / nloc;
        if (old + 1u == (gen + 1u) * nloc) {
            __builtin_amdgcn_fence(__ATOMIC_RELEASE, "agent");
            asm volatile("s_waitcnt vmcnt(0)" ::: "memory");
            const unsigned og = xb_add(&bar[XB_TOP], 1u);
            const unsigned tg = og / nx;
            if (og + 1u == (tg + 1u) * nx) xb_add(&bar[XB_TOPGEN], 1u);
            else XB_SPIN(xb_ld(&bar[XB_TOPGEN]) == tg, bar);
            __builtin_amdgcn_fence(__ATOMIC_ACQUIRE, "agent");
            xb_add(&bar[XB_XGEN(b.x)], 1u);
            asm volatile("s_waitcnt vmcnt(0)" ::: "memory");
        } else {
            XB_SPIN(xb_ld(&bar[XB_XGEN(b.x)]) == gen, bar);
            __builtin_amdgcn_fence(__ATOMIC_ACQUIRE, "agent");
            asm volatile("s_waitcnt vmcnt(0)" ::: "memory");
        }
    }
    __syncthreads();
}

namespace pg8 {
struct TileOrder {
    int nM, nN, nwg, G, c;
    __device__ __forceinline__ void init(int nM_, int nN_, int G_, int c_) { nM = nM_; nN = nN_; nwg = nM * nN; G = G_; c = c_; }
    __device__ __forceinline__ bool logical(int i, int& im, int& in) const {
        const long L = (long)i * G + c; if (L >= nwg) return false;
        int wgid = (int)L; { const int q = nwg / NXCD, r = nwg % NXCD, xcd = wgid % NXCD, off = wgid / NXCD; wgid = (xcd < r ? xcd * (q + 1) : r * (q + 1) + (xcd - r) * q) + off; }
        const int nig = WGM * nN, gid = wgid / nig, fm = gid * WGM, gsz = (nM - fm) < WGM ? (nM - fm) : WGM;
        im = fm + ((wgid % nig) % gsz); in = (wgid % nig) / gsz; return true;
    }
    __device__ __forceinline__ void a_ready(const Unit&) const {}
    __device__ __forceinline__ void done(const Unit&) const {}
};
struct AllOrder : TileOrder { __device__ __forceinline__ bool next(int i, Unit& u) const { int im, in; if (!logical(i, im, in)) return false; u.pm = im; u.pn = in; return true; } };
struct LatOrder : TileOrder {
    __device__ __forceinline__ bool next(int i, Unit& u) const { int im, in; if (!logical(i, im, in)) return false; u.pm = (im >> 4) * 17 + 1 + (im & 15); u.pn = in; return true; } };
struct MoeOrder : TileOrder {
    const PG8_LAS int* tile_e; int nper;
    __device__ __forceinline__ bool next(int i, Unit& u) const { int im, in; if (!logical(i, im, in)) return false; u.pm = im; u.pn = tile_e[im] * nper + in; return true; } };

struct EpiRes {
    static constexpr bool PERM = false, AFTER_DRAIN = false;
    const float* xin; float* h; const float* modv; const float* bias;
    __device__ __forceinline__ void operator()(const f32x4 (&acc)[2][2][4][2], const Unit& u, int wr, int wc, int fr, int fq) const {
        asm volatile("" : "+v"(fr), "+v"(fq));
        const int b = u.pm / 17, j = u.pm % 17;
        const int rl0 = wr * 64 + fr, col0 = u.pn * BM + wc * 32 + 4 * fq;
        const float* gate = modv + (size_t)b * 6144 + 2048;
        f32x4 gv[2][2], bv[2][2];
#pragma unroll
        for (int bj = 0; bj < 2; ++bj)
#pragma unroll
            for (int n = 0; n < 2; ++n) { gv[bj][n] = *(const f32x4*)(gate + col0 + bj * HALF + n * 16); bv[bj][n] = bias ? *(const f32x4*)(bias + col0 + bj * HALF + n * 16) : (f32x4){0.f, 0.f, 0.f, 0.f}; }
#pragma unroll
        for (int ai = 0; ai < 2; ++ai)
#pragma unroll
            for (int m = 0; m < 4; ++m) { const int rl = rl0 + ai * HALF + m * 16; const size_t grow = (size_t)u.pm * BM + rl;
                const float* hin = xin ? xin + ((size_t)b * 4096 + (size_t)(j - 1) * 256 + rl) * 1024 + col0 : h + grow * 1024 + col0;
                float* ho = h + grow * 1024 + col0;
#pragma unroll
                for (int bj = 0; bj < 2; ++bj)
#pragma unroll
                    for (int n = 0; n < 2; ++n) { const f32x4 hv = *(const f32x4*)(hin + bj * HALF + n * 16);
                        *(f32x4*)(ho + bj * HALF + n * 16) = hv * 1.4142135623730951f + gv[bj][n] * (acc[ai][bj][m][n] + bv[bj][n]); } }
    }
};
template <int MODE, bool OUT8 = false> struct EpiGate {
    static constexpr bool PERM = true, AFTER_DRAIN = false;
    bf16_t* O; const float* bias; int nper; float ascale, oscale;
    __device__ __forceinline__ void operator()(const f32x4 (&acc)[2][2][4][2], const Unit& u, int wr, int wc, int fr, int fq) const {
        asm volatile("" : "+v"(fr), "+v"(fq));
        const int row0 = u.pm * BM + wr * 64 + fr, pnl = u.pn % nper, ocol0 = pnl * HALF + wc * 32 + 8 * fq, bcol0 = u.pn * BM + wc * 32 + 8 * fq;
        const float s0 = ascale, s1 = MODE == 1 ? ascale * oscale : ascale;
        f32x4 bv[2][2];
#pragma unroll
        for (int n = 0; n < 2; ++n) { bv[0][n] = *(const f32x4*)(bias + bcol0 + 4 * n); const f32x4 t = *(const f32x4*)(bias + bcol0 + HALF + 4 * n); bv[1][n] = MODE == 1 ? (t + 1.0f) * oscale : t; }
#pragma unroll
        for (int ai = 0; ai < 2; ++ai)
#pragma unroll
            for (int m = 0; m < 4; ++m) { bf16_t* rowp = O + (size_t)(row0 + ai * HALF + m * 16) * 1024 + ocol0;
                unsigned char* rowp8 = (unsigned char*)O + (size_t)(row0 + ai * HALF + m * 16) * 1024 + ocol0;
                float o[8];
#pragma unroll
                for (int n = 0; n < 2; ++n) { const f32x4 a = acc[ai][0][m][n] * s0 + bv[0][n], g = acc[ai][1][m][n] * s1 + bv[1][n];
#pragma unroll
                    for (int e = 0; e < 4; ++e) {
                        if (MODE == 0) { o[4 * n + e] = a[e] * __builtin_amdgcn_rcpf(1.f + __builtin_amdgcn_exp2f(g[e] * -1.4426950408889634f)); }
                        else { const float gt = fminf(a[e], 7.0f), up1 = __builtin_amdgcn_fmed3f(g[e], -6.0f * oscale, 8.0f * oscale);
                            o[4 * n + e] = up1 * (gt * __builtin_amdgcn_rcpf(1.f + __builtin_amdgcn_exp2f(gt * (-1.702f * 1.4426950408889634f)))); } } }
                if constexpr (OUT8) {
                    int w0 = 0, w1 = 0; w0 = __builtin_amdgcn_cvt_pk_fp8_f32(o[0], o[1], w0, false); w0 = __builtin_amdgcn_cvt_pk_fp8_f32(o[2], o[3], w0, true);
                    w1 = __builtin_amdgcn_cvt_pk_fp8_f32(o[4], o[5], w1, false); w1 = __builtin_amdgcn_cvt_pk_fp8_f32(o[6], o[7], w1, true);
                    typedef unsigned u32x2 __attribute__((ext_vector_type(2))); *(u32x2*)rowp8 = (u32x2){(unsigned)w0, (unsigned)w1}; (void)rowp;
                } else { (void)rowp8;
                u32x4 w; w.x = cvt_pk_bf16(o[0], o[1]); w.y = cvt_pk_bf16(o[2], o[3]); w.z = cvt_pk_bf16(o[4], o[5]); w.w = cvt_pk_bf16(o[6], o[7]);
                *(u32x4*)rowp = w; } }
    }
};
struct EpiDown {
    static constexpr bool PERM = true, AFTER_DRAIN = false;
    bf16_t* Y; const float* bias; const float* row_w; const int* row_dst; float ascale; const PG8_LAS int* gtab; float oscale;
    __device__ __forceinline__ void operator()(const f32x4 (&acc)[2][2][4][2], const Unit& u, int wr, int wc, int fr, int fq) const {
        asm volatile("" : "+v"(fr), "+v"(fq));
        const int pnl = u.pn & 3, ocol0 = pnl * BM + wc * 32 + 8 * fq, bcol0 = u.pn * BM + wc * 32 + 8 * fq; const int tbase = gtab[u.pm], tcnt = gtab[576 + u.pm];
        f32x4 bv[2][2];
#pragma unroll
        for (int bj = 0; bj < 2; ++bj)
#pragma unroll
            for (int n = 0; n < 2; ++n) bv[bj][n] = *(const f32x4*)(bias + bcol0 + bj * HALF + 4 * n);
#pragma unroll
        for (int ai = 0; ai < 2; ++ai)
#pragma unroll
            for (int m = 0; m < 4; ++m) { const int rl = wr * 64 + fr + ai * HALF + m * 16;
                if (rl < tcnt) { const int dst = row_dst[tbase + rl]; const float w8 = row_w[tbase + rl] * oscale; unsigned char* rowp = (unsigned char*)Y + (size_t)dst * 1024 + ocol0;
#pragma unroll
                    for (int bj = 0; bj < 2; ++bj) { const f32x4 v0 = (acc[ai][bj][m][0] * ascale + bv[bj][0]) * w8, v1 = (acc[ai][bj][m][1] * ascale + bv[bj][1]) * w8;
                        int w0 = 0, w1 = 0; w0 = __builtin_amdgcn_cvt_pk_fp8_f32(fminf(fmaxf(v0[0], -448.f), 448.f), fminf(fmaxf(v0[1], -448.f), 448.f), w0, false); w0 = __builtin_amdgcn_cvt_pk_fp8_f32(fminf(fmaxf(v0[2], -448.f), 448.f), fminf(fmaxf(v0[3], -448.f), 448.f), w0, true);
                        w1 = __builtin_amdgcn_cvt_pk_fp8_f32(fminf(fmaxf(v1[0], -448.f), 448.f), fminf(fmaxf(v1[1], -448.f), 448.f), w1, false); w1 = __builtin_amdgcn_cvt_pk_fp8_f32(fminf(fmaxf(v1[2], -448.f), 448.f), fminf(fmaxf(v1[3], -448.f), 448.f), w1, true);
                        typedef unsigned u32x2 __attribute__((ext_vector_type(2))); *(u32x2*)(rowp + bj * HALF) = (u32x2){(unsigned)w0, (unsigned)w1}; } } }
    }
};
}

namespace att {
using bf16x8 = __attribute__((ext_vector_type(8))) short;
using s16x4  = __attribute__((ext_vector_type(4))) short;
using f32x16 = __attribute__((ext_vector_type(16))) float;
using u32x4  = __attribute__((ext_vector_type(4))) unsigned;
constexpr int NW = 8, QBLK = 32, KVBLK = 64;
constexpr float SCALE = 0.10206207261596575f;
constexpr float THR = 8.f;
constexpr int SHM_V = 16384, SHM_K = 16384, SHM_ATTN = 2 * SHM_V + 2 * SHM_K + NW * 64 * 4;
#define KSWZ(row, colB) ((row) * 256 + ((colB) ^ (((row) & 7) << 4)))
#define SBAR() __builtin_amdgcn_sched_barrier(0)
__device__ __forceinline__ int crow(int r, int hi) { return (r & 3) + 8 * (r >> 2) + 4 * hi; }
__device__ __forceinline__ unsigned cvtpk(float lo, float hi) { unsigned r; asm volatile("v_cvt_pk_bf16_f32 %0, %1, %2" : "=v"(r) : "v"(lo), "v"(hi)); return r; }

__device__ __forceinline__ void partialSM(f32x16& p0, f32x16& p1, float& m_reg, float& mn, float& alpha) {
  constexpr float C = SCALE * 1.4426950408889634f;
  float pmax = p0[0];
#pragma unroll
  for (int r = 1; r < 16; ++r) pmax = fmaxf(pmax, p0[r]);
#pragma unroll
  for (int r = 0; r < 16; ++r) pmax = fmaxf(pmax, p1[r]);
  { auto rr = __builtin_amdgcn_permlane32_swap(__float_as_uint(pmax), __float_as_uint(pmax), false, false);
    pmax = fmaxf(__uint_as_float(rr[0]), __uint_as_float(rr[1])); }
  if (__builtin_expect(__all(pmax - m_reg <= THR / SCALE), 1)) { mn = m_reg; alpha = 1.f; }
  else { mn = fmaxf(m_reg, pmax); alpha = __builtin_amdgcn_exp2f((m_reg - mn) * C); m_reg = mn; }
  float mnC = -mn * C;
#pragma unroll
  for (int r = 0; r < 16; ++r) p0[r] = fmaf(p0[r], C, mnC);
#pragma unroll
  for (int r = 0; r < 16; ++r) p1[r] = fmaf(p1[r], C, mnC);
#pragma unroll
  for (int r = 0; r < 16; ++r) p0[r] = __builtin_amdgcn_exp2f(p0[r]);
}
__device__ __forceinline__ void finishSM(f32x16& p0, f32x16& p1, float alpha, float& l_reg, bf16x8& pa0, bf16x8& pa1, bf16x8& pa2, bf16x8& pa3) {
#pragma unroll
  for (int r = 0; r < 16; ++r) p1[r] = __builtin_amdgcn_exp2f(p1[r]);
  float ps = 0;
#pragma unroll
  for (int r = 0; r < 16; ++r) ps += p0[r];
#pragma unroll
  for (int r = 0; r < 16; ++r) ps += p1[r];
  { auto rr = __builtin_amdgcn_permlane32_swap(__float_as_uint(ps), __float_as_uint(ps), false, false);
    ps = __uint_as_float(rr[0]) + __uint_as_float(rr[1]); }
  l_reg = l_reg * alpha + ps;
#define PK4(P, BASE, OUT) do { unsigned a0 = cvtpk(P[BASE + 0], P[BASE + 1]), a1 = cvtpk(P[BASE + 2], P[BASE + 3]);   \
    unsigned b0 = cvtpk(P[BASE + 4], P[BASE + 5]), b1 = cvtpk(P[BASE + 6], P[BASE + 7]);                              \
    auto r0 = __builtin_amdgcn_permlane32_swap(a0, b0, false, false); auto r1 = __builtin_amdgcn_permlane32_swap(a1, b1, false, false); \
    u32x4 w = {r0[0], r1[0], r0[1], r1[1]}; OUT = *reinterpret_cast<bf16x8*>(&w); } while (0)
  PK4(p0, 0, pa0); PK4(p0, 8, pa1); PK4(p1, 0, pa2); PK4(p1, 8, pa3);
#undef PK4
}
__device__ __forceinline__ void qkt(f32x16& p0, f32x16& p1, const bf16* Ks, const bf16x8* qr, int r32, int hi) {
  p0 = f32x16{}; p1 = f32x16{};
#pragma unroll
  for (int d0 = 0; d0 < 6; ++d0) { int cb = (d0 * 16 + hi * 8) * 2;
    bf16x8 b0 = *reinterpret_cast<const bf16x8*>((const char*)Ks + KSWZ(r32, cb));
    bf16x8 b1 = *reinterpret_cast<const bf16x8*>((const char*)Ks + KSWZ(32 + r32, cb));
    p0 = __builtin_amdgcn_mfma_f32_32x32x16_bf16(b0, qr[d0], p0, 0, 0, 0);
    p1 = __builtin_amdgcn_mfma_f32_32x32x16_bf16(b1, qr[d0], p1, 0, 0, 0); }
}
__device__ __forceinline__ int v_st(int k, int c) { const int kk = (k & ~0xC) | ((k & 4) << 1) | ((k & 8) >> 1); return ((kk >> 3) * 4 + (c >> 5)) * 512 + ((kk & 7) * 32 + (c & 31)) * 2; }
__device__ __forceinline__ int v_rd_base(int lane) { return ((lane & 3) << 3) | (((lane >> 2) & 3) << 6) | (((lane >> 4) & 1) << 5) | (((lane >> 5) & 1) << 8); }
constexpr int v_rd_off(int d0, int ks, int half) { return d0 * 512 + ks * 4096 + half * 2048; }
template <int OFF> __device__ __forceinline__ s16x4 tr_read(int vb) {
  s16x4 r; asm volatile("ds_read_b64_tr_b16 %0, %1 offset:%2" : "=&v"(r) : "v"(vb), "i"(OFF) : "memory"); return r;
}
template <int D0> __device__ __forceinline__ void pv_one(f32x16& od, int vb, bf16x8 pa0, bf16x8 pa1, bf16x8 pa2, bf16x8 pa3) {
  const s16x4 l0 = tr_read<v_rd_off(D0, 0, 0)>(vb), h0 = tr_read<v_rd_off(D0, 0, 1)>(vb), l1 = tr_read<v_rd_off(D0, 1, 0)>(vb), h1 = tr_read<v_rd_off(D0, 1, 1)>(vb);
  const s16x4 l2 = tr_read<v_rd_off(D0, 2, 0)>(vb), h2 = tr_read<v_rd_off(D0, 2, 1)>(vb), l3 = tr_read<v_rd_off(D0, 3, 0)>(vb), h3 = tr_read<v_rd_off(D0, 3, 1)>(vb);
  asm volatile("s_waitcnt lgkmcnt(0)" ::: "memory"); SBAR();
#define PK(L, H) (bf16x8){L[0], L[1], L[2], L[3], H[0], H[1], H[2], H[3]}
  od = __builtin_amdgcn_mfma_f32_32x32x16_bf16(pa0, PK(l0, h0), od, 0, 0, 0);
  od = __builtin_amdgcn_mfma_f32_32x32x16_bf16(pa1, PK(l1, h1), od, 0, 0, 0);
  od = __builtin_amdgcn_mfma_f32_32x32x16_bf16(pa2, PK(l2, h2), od, 0, 0, 0);
  od = __builtin_amdgcn_mfma_f32_32x32x16_bf16(pa3, PK(l3, h3), od, 0, 0, 0);
#undef PK
}
__device__ __forceinline__ void pv_d0(f32x16* o, int vb, bf16x8 pa0, bf16x8 pa1, bf16x8 pa2, bf16x8 pa3) {
  pv_one<0>(o[0], vb, pa0, pa1, pa2, pa3); pv_one<1>(o[1], vb, pa0, pa1, pa2, pa3);
}
__device__ __forceinline__ bf16x8 rope8(bf16x8 x, const float* tab, int pbase) {
  u32x4 w;
#pragma unroll
  for (int i = 0; i < 4; ++i) { const float x1 = __uint_as_float(((unsigned)(unsigned short)x[2 * i]) << 16), x2 = __uint_as_float(((unsigned)(unsigned short)x[2 * i + 1]) << 16);
    const float cs = tab[pbase + i], sn = tab[16 + pbase + i]; w[i] = cvtpk(x1 * cs - x2 * sn, x1 * sn + x2 * cs); }
  return *reinterpret_cast<bf16x8*>(&w);
}
__device__ __forceinline__ void attn_unit(const bf16* __restrict__ Qb, const bf16* __restrict__ KVb, const bf16* __restrict__ KRb, bf16* __restrict__ Ob,
                                          const float* __restrict__ rope, int seq, char* lds) {
  int tid_l = threadIdx.x; asm volatile("" : "+v"(tid_l));
  const int tid = tid_l, wid = tid >> 6, lane = tid & 63, r32 = lane & 31, hi = lane >> 5;
  bf16* V_lds = (bf16*)lds; bf16* K_lds = (bf16*)(lds + 2 * SHM_V);
  float* ws = (float*)(lds + 2 * SHM_V + 2 * SHM_K) + wid * 64; float* li_l = ws; float* al_l = ws + 32;
  float m_reg = -1e30f, l_reg = 0; f32x16 o[2] = {}; bf16x8 qr[6];
  const bf16* Qw = Qb + (long)(wid * QBLK + r32) * 768 + hi * 8;
#pragma unroll
  for (int d0 = 0; d0 < 6; ++d0) qr[d0] = *reinterpret_cast<const bf16x8*>(Qw + d0 * 16);
  if (rope) { const float* tab = rope + (long)(wid * QBLK + r32) * 32; qr[4] = rope8(qr[4], tab, 4 * hi); qr[5] = rope8(qr[5], tab, 8 + 4 * hi); }
  const int sr = tid >> 4, ch = tid & 15;
  const bf16* kbase = ch < 8 ? KVb + ch * 8 : KRb + ((ch - 8) & 3) * 8; const long kstr = ch < 8 ? 1024 : 32;
  const int vkey = tid >> 3, vc8 = (tid & 7) * 8, vst0 = v_st(vkey, vc8);
  const bf16* vbase = KVb + 512 + vc8;
  const int vb0 = (int)(uintptr_t)V_lds + v_rd_base(lane);
  struct { bf16x8 vs0, ks0, ks1; } sr_[2];
#define SLOAD(i, k0) do { sr_[i].vs0 = *reinterpret_cast<const bf16x8*>(vbase + (long)((k0) + vkey) * 1024); \
    sr_[i].ks0 = *reinterpret_cast<const bf16x8*>(kbase + (long)((k0) + sr) * kstr); sr_[i].ks1 = *reinterpret_cast<const bf16x8*>(kbase + (long)((k0) + 32 + sr) * kstr); } while (0)
#define SWRITE(b, i) do { *(bf16x8*)((char*)V_lds + (b) * SHM_V + vst0) = sr_[i].vs0; int kc = ch * 16;               \
    *(bf16x8*)((char*)K_lds + (b) * SHM_K + KSWZ(sr, kc)) = sr_[i].ks0;                       \
    *(bf16x8*)((char*)K_lds + (b) * SHM_K + KSWZ(32 + sr, kc)) = sr_[i].ks1; } while (0)
#define SWAIT() asm volatile("s_waitcnt vmcnt(3)" ::: "memory")
#define RESC(a) do { if (__any((a) < 1.f)) { if (hi == 0) al_l[r32] = (a); asm volatile("s_waitcnt lgkmcnt(0)" ::: "memory"); \
    _Pragma("unroll") for (int d = 0; d < 2; ++d) _Pragma("unroll") for (int r = 0; r < 16; ++r) o[d][r] *= al_l[crow(r, hi)]; } } while (0)
  f32x16 pA0, pA1, pB0, pB1; float mnA, mnB, alA, alB; bf16x8 pa0, pa1, pa2, pa3; const int NT = seq / KVBLK;
  constexpr int SE = 0, SO = 1;
  SLOAD(SE, 0); asm volatile("s_waitcnt vmcnt(0)" ::: "memory"); SWRITE(0, SE); __syncthreads();
  qkt(pA0, pA1, K_lds, qr, r32, hi); partialSM(pA0, pA1, m_reg, mnA, alA);
  SLOAD(SO, KVBLK); if (2 < NT) SLOAD(SE, 2 * KVBLK);
  SWAIT(); SWRITE(1, SO); __syncthreads();
  for (int j = 1; j + 1 < NT; j += 2) {
    SBAR(); qkt(pB0, pB1, (bf16*)((char*)K_lds + SHM_K), qr, r32, hi);
    finishSM(pA0, pA1, alA, l_reg, pa0, pa1, pa2, pa3); SBAR();
    SLOAD(SO, (j + 2) * KVBLK); SBAR();
    pv_d0(o, vb0, pa0, pa1, pa2, pa3); partialSM(pB0, pB1, m_reg, mnB, alB);
    __syncthreads(); SWAIT(); SWRITE(0, SE);
    RESC(alB); __syncthreads();
    SBAR(); qkt(pA0, pA1, K_lds, qr, r32, hi);
    finishSM(pB0, pB1, alB, l_reg, pa0, pa1, pa2, pa3); SBAR();
    if (j + 3 < NT) SLOAD(SE, (j + 3) * KVBLK); SBAR();
    pv_d0(o, vb0 + (int)SHM_V, pa0, pa1, pa2, pa3); partialSM(pA0, pA1, m_reg, mnA, alA);
    __syncthreads(); SWAIT(); SWRITE(1, SO);
    RESC(alA); __syncthreads();
  }
  SBAR(); qkt(pB0, pB1, (bf16*)((char*)K_lds + SHM_K), qr, r32, hi);
  finishSM(pA0, pA1, alA, l_reg, pa0, pa1, pa2, pa3); SBAR();
  pv_d0(o, vb0, pa0, pa1, pa2, pa3); partialSM(pB0, pB1, m_reg, mnB, alB);
  __syncthreads(); RESC(alB);
  finishSM(pB0, pB1, alB, l_reg, pa0, pa1, pa2, pa3); SBAR();
  pv_d0(o, vb0 + (int)SHM_V, pa0, pa1, pa2, pa3);
  if (hi == 0) li_l[r32] = l_reg; asm volatile("s_waitcnt lgkmcnt(0)" ::: "memory");
  float rli[16];
#pragma unroll
  for (int r = 0; r < 16; ++r) rli[r] = __builtin_amdgcn_rcpf(li_l[crow(r, hi)]);
  bf16* Ow = Ob + (long)(wid * QBLK) * 1024;
#pragma unroll
  for (int r = 0; r < 16; ++r) { int orow = crow(r, hi);
#pragma unroll
    for (int d0 = 0; d0 < 2; ++d0) { const float v = o[d0][r] * rli[r]; Ow[(long)orow * 1024 + d0 * 32 + r32] = (bf16)(cvtpk(v, v) & 0xffffu); } }
#undef SLOAD
#undef SWRITE
#undef SWAIT
#undef RESC
}
}

struct Args { const float* in[33]; float* out; unsigned char* ws; int ph_lo, ph_hi; };
enum { I_X = 0, I_C, I_CTX, I_CCTX, I_MODW, I_MODB, I_LN1G, I_LN1B, I_LN2G, I_LN2B, I_WIN, I_QNORM, I_KVNORM, I_WUQ, I_WUK, I_WUV, I_LBL, I_HGNORM, I_WOUT,
       I_PW1W, I_PW1B, I_DWW, I_DWB, I_CLNG, I_CLNB, I_PW2W, I_PW2B, I_RW, I_RB, I_WGU, I_BGU, I_WDN, I_BDN };

__device__ __forceinline__ int dst_row(int n, int mode, int row_off) {
    if (mode == 0) return row_off + n;
    int f, g; if (mode == 1) { f = n >> 1; g = n & 1; } else { g = n >> 10; f = n & 1023; }
    return row_off + 256 * (f >> 7) + 128 * g + (f & 127);
}
__device__ __forceinline__ unsigned pack_fp8x4(float a, float b, float c, float d) { int w = 0; w = __builtin_amdgcn_cvt_pk_fp8_f32(fminf(fmaxf(a, -448.f), 448.f), fminf(fmaxf(b, -448.f), 448.f), w, false);
    w = __builtin_amdgcn_cvt_pk_fp8_f32(fminf(fmaxf(c, -448.f), 448.f), fminf(fmaxf(d, -448.f), 448.f), w, true); return (unsigned)w; }
struct TrItem { const float* W; bf16* WT; int K, N, mode, row_off, item; float f8scale; };
__device__ __forceinline__ void tr_load(const TrItem& d, f32x4 (&v)[16], int lane) {
    const int nblk = (d.N + 63) >> 6, kb = d.item / nblk, nb = d.item - kb * nblk, k0 = 64 * kb, n0 = 64 * nb;
    const int nc = n0 + 4 * (lane & 15), kr = lane >> 4;
#pragma unroll
    for (int i = 0; i < 16; ++i) v[i] = (nc < d.N) ? __builtin_nontemporal_load((const f32x4*)(d.W + (size_t)(k0 + 4 * i + kr) * d.N + nc)) : (f32x4){0.f, 0.f, 0.f, 0.f};
}
__device__ __forceinline__ void tr_lds_write(const f32x4 (&v)[16], LAS float* scr, int lane) {
    const int kr = lane >> 4;
#pragma unroll
    for (int i = 0; i < 16; ++i) { LAS float* s = scr + (4 * i + kr) * 65 + 4 * (lane & 15); s[0] = v[i][0]; s[1] = v[i][1]; s[2] = v[i][2]; s[3] = v[i][3]; }
}
__device__ __forceinline__ void tr_store(const TrItem& d, LAS float* scr, int lane) {
    const int nblk = (d.N + 63) >> 6, kb = d.item / nblk, nb = d.item - kb * nblk, k0 = 64 * kb, n0 = 64 * nb;
    const int c = lane & 7; const int K = d.K;
#pragma unroll
    for (int j = 0; j < 8; ++j) { const int nl = (lane >> 3) + 8 * j, n = n0 + nl; const LAS float* s = scr + (8 * c) * 65 + nl;
        if (n < d.N) { if (d.f8scale > 0.f) { const float f8 = d.f8scale; v2u o8; o8.x = pack_fp8x4(s[0 * 65] * f8, s[1 * 65] * f8, s[2 * 65] * f8, s[3 * 65] * f8); o8.y = pack_fp8x4(s[4 * 65] * f8, s[5 * 65] * f8, s[6 * 65] * f8, s[7 * 65] * f8);
                *(v2u*)((unsigned char*)d.WT + (size_t)dst_row(n, d.mode, d.row_off) * K + k0 + 8 * c) = o8; }
            else { v4u o; o.x = pk2(s[0 * 65], s[1 * 65]); o.y = pk2(s[2 * 65], s[3 * 65]); o.z = pk2(s[4 * 65], s[5 * 65]); o.w = pk2(s[6 * 65], s[7 * 65]);
                *(v4u*)(d.WT + (size_t)dst_row(n, d.mode, d.row_off) * K + k0 + 8 * c) = o; } } }
}
__device__ __forceinline__ void phase_prologue(const Args& a, LAS unsigned char* lds, int tid, int lane, int wave) {
    unsigned char* ws = a.ws;
    const int G = gridDim.x, B = blockIdx.x;
    {
        LAS float* sc = (LAS float*)lds;
        LAS float* red = (LAS float*)(lds + 36864);
        float* modv = (float*)(ws + WS_MODV);
        bool have = false;
        for (int it = B; it < 192; it += G) {
            if (!have) { for (int i = tid; i < 9 * 1024; i += NTHR) { const int r = i >> 10, k = i & 1023; const float x = r < 8 ? a.in[I_C][r * 1024 + k] : a.in[I_CCTX][k]; sc[i] = x * sigm(x); } __syncthreads(); have = true; }
            const int l = it / 96, jc = it % 96, kg = tid >> 6, jj = tid & 63, j = jc * 64 + jj;
            float acc[9];
#pragma unroll
            for (int r = 0; r < 9; ++r) acc[r] = 0.f;
            const float* wp = a.in[I_MODW] + ((size_t)l * 1024 + kg * 128) * 6144 + j;
            for (int k0 = 0; k0 < 128; k0 += 16) { float w[16];
#pragma unroll
                for (int kk = 0; kk < 16; ++kk) w[kk] = wp[(size_t)(k0 + kk) * 6144];
#pragma unroll
                for (int kk = 0; kk < 16; ++kk)
#pragma unroll
                    for (int r = 0; r < 9; ++r) acc[r] += sc[r * 1024 + kg * 128 + k0 + kk] * w[kk]; }
#pragma unroll
            for (int r = 0; r < 9; ++r) red[(kg * 9 + r) * 64 + jj] = acc[r];
            __syncthreads();
            for (int i = tid; i < 576; i += NTHR) { const int r = i >> 6, j2 = i & 63; float s = a.in[I_MODB][l * 6144 + jc * 64 + j2];
#pragma unroll
                for (int g = 0; g < 8; ++g) s += red[(g * 9 + r) * 64 + j2];
                modv[((size_t)l * 9 + r) * 6144 + jc * 64 + j2] = s; }
            __syncthreads();
        }
        __syncthreads();
    }
    const int gw = B * NWAVES + wave, NGW = G * NWAVES, gt = B * NTHR + tid, NGT = G * NTHR;
    { float* rope = (float*)(ws + WS_ROPE);
      for (int i = gt; i < 4096 * 16; i += NGT) { const int t = i >> 4, p = i & 15; const float pos = (float)(p < 8 ? (t >> 6) : (t & 63));
          const float inv = __powf(10000.0f, -(float)(p & 7) * 0.125f); const float ang = pos * inv; rope[t * 32 + p] = cosf(ang); rope[t * 32 + 16 + p] = sinf(ang); }
      float* bgu = (float*)(ws + WS_BGU);
      for (int i = gt; i < 2 * 32 * 2048; i += NGT) { const int le = i >> 11, np = i & 2047, q = np >> 8, g = (np >> 7) & 1, r = np & 127, f = 128 * q + r; bgu[i] = a.in[I_BGU][(size_t)le * 2048 + 2 * f + g]; }
      float* pb = (float*)(ws + WS_PW1B);
      for (int i = gt; i < 2048; i += NGT) { const int q = i >> 8, g = (i >> 7) & 1, r = i & 127, f = 128 * q + r; pb[i] = a.in[I_PW1B][g * 1024 + f]; }
      v4u* zp = (v4u*)(ws + WS_WIN + (size_t)3232 * 1024 * 2);
      for (int i = gt; i < 96 * 1024 * 2 / 16; i += NGT) zp[i] = (v4u){0u, 0u, 0u, 0u};
    }
    LAS float* scr = (LAS float*)(lds + wave * 16640);
    constexpr int I0 = 16 * 51, I1 = 6 * 12, I2 = 4 * 8, I3 = 4 * 8, I4 = 256, I5 = 512, I6 = 256, SMALL = I0 + I1 + I2 + I3 + I4 + I5 + I6;
    constexpr int NGU = 64 * 512, NDN = 64 * 256, NITEMS = SMALL + NGU + NDN;
    auto decode = [&](int it) -> TrItem {
        TrItem d; int r = it; d.f8scale = 0.f; d.mode = 0; d.row_off = 0;
        if (r < NGU) { const int mi = r >> 9; d.W = a.in[I_WGU] + (size_t)mi * 1024 * 2048; d.K = 1024; d.N = 2048; d.WT = (bf16*)(ws + WS_WGU + (size_t)mi * 2048 * 1024); d.mode = 1; d.item = r & 511; d.f8scale = SC_WGU; return d; } r -= NGU;
        if (r < NDN) { const int mi = r >> 8; d.W = a.in[I_WDN] + (size_t)mi * 1024 * 1024; d.K = 1024; d.N = 1024; d.WT = (bf16*)(ws + WS_WDN + (size_t)mi * 1024 * 1024); d.item = r & 255; d.f8scale = SC_WDN; return d; } r -= NDN;
        if (r < I0) { d.W = a.in[I_WIN]; d.K = 1024; d.N = 3232; d.WT = (bf16*)(ws + WS_WIN); d.item = r; return d; } r -= I0;
        if (r < I1) { d.W = a.in[I_WUQ]; d.K = 384; d.N = 768; d.WT = (bf16*)(ws + WS_WUQ); d.item = r; return d; } r -= I1;
        if (r < I2) { d.W = a.in[I_WUK]; d.K = 256; d.N = 512; d.WT = (bf16*)(ws + WS_WUKV); d.item = r; return d; } r -= I2;
        if (r < I3) { d.W = a.in[I_WUV]; d.K = 256; d.N = 512; d.WT = (bf16*)(ws + WS_WUKV); d.row_off = 512; d.item = r; return d; } r -= I3;
        if (r < I4) { d.W = a.in[I_WOUT]; d.K = 1024; d.N = 1024; d.WT = (bf16*)(ws + WS_WOUT); d.item = r; return d; } r -= I4;
        if (r < I5) { d.W = a.in[I_PW1W]; d.K = 1024; d.N = 2048; d.WT = (bf16*)(ws + WS_WPW1); d.mode = 2; d.item = r; return d; } r -= I5;
        d.W = a.in[I_PW2W]; d.K = 1024; d.N = 1024; d.WT = (bf16*)(ws + WS_WPW2); d.item = r; return d; };
    f32x4 tv[16];
    int it = gw;
    if (it < NITEMS) { const TrItem d0 = decode(it); tr_load(d0, tv, lane); }
    for (; it < NITEMS; it += NGW) {
        const TrItem d = decode(it);
        tr_lds_write(tv, scr, lane);
        if (it + NGW < NITEMS) { const TrItem dn = decode(it + NGW); tr_load(dn, tv, lane); }
        LDS_WAIT();
        tr_store(d, scr, lane);
        LDS_WAIT();
    }
}

__device__ __forceinline__ void phase_mod0(const Args& a, int lane, int wave) {
    const int gw = blockIdx.x * NWAVES + wave, NGW = gridDim.x * NWAVES;
    const float* modv = (const float*)(a.ws + WS_MODV);
    bf16* X = (bf16*)(a.ws + WS_X);
    for (int r = gw; r < NTOK; r += NGW) {
        const int b = r / TPB, p = r - b * TPB;
        const float* src = p < CTXL ? a.in[I_CTX] + ((size_t)b * CTXL + p) * 1024 : a.in[I_X] + ((size_t)b * SEQ + (p - CTXL)) * 1024;
        const float* mv = modv + (size_t)(p < CTXL ? 8 : b) * 6144;
#pragma unroll
        for (int j = 0; j < 4; ++j) { const int c = 4 * (lane + 64 * j); const f32x4 xv = *(const f32x4*)(src + c), sh = *(const f32x4*)(mv + c), sc = *(const f32x4*)(mv + 1024 + c);
            const f32x4 y = xv * (sc + 1.0f) + sh; v2u o; o.x = pk2(y[0], y[1]); o.y = pk2(y[2], y[3]); *(v2u*)(X + (size_t)r * 1024 + c) = o; }
    }
}

__device__ __forceinline__ void phase_norm0(const Args& a, int lane, int wave) {
    const int gw = blockIdx.x * NWAVES + wave, NGW = gridDim.x * NWAVES;
    const bf16* Z = (const bf16*)(a.ws + WS_Z); bf16* CQN = (bf16*)(a.ws + WS_CQN); bf16* CKVN = (bf16*)(a.ws + WS_CKVN); bf16* KRR = (bf16*)(a.ws + WS_KRR);
    const float* rope = (const float*)(a.ws + WS_ROPE);
    float gq[8], gk[8];
#pragma unroll
    for (int i = 0; i < 8; ++i) { gq[i] = lane < 48 ? a.in[I_QNORM][8 * lane + i] : 0.f; gk[i] = lane < 32 ? a.in[I_KVNORM][8 * lane + i] : 0.f; }
    for (int r = gw; r < NTOK; r += NGW) {
        const bf16* z = Z + (size_t)r * ZC; const int p = r % TPB;
        bf16x8 q8 = {}, k8 = {}, r8 = {};
        if (lane < 48) q8 = *(const bf16x8*)(z + ZQ + 8 * lane);
        if (lane < 32) k8 = *(const bf16x8*)(z + ZKV + 8 * lane);
        if (lane < 4) r8 = *(const bf16x8*)(z + ZKR + 8 * lane);
        float qf[8], kf[8], sq = 0.f, sk = 0.f;
#pragma unroll
        for (int i = 0; i < 8; ++i) { qf[i] = bf2f((unsigned short)q8[i]); kf[i] = bf2f((unsigned short)k8[i]); sq += qf[i] * qf[i]; sk += kf[i] * kf[i]; }
        sq = wave_sum(sq); sk = wave_sum(sk);
        const float rq = rsqrtf(sq * (1.f / 384.f) + RMS_EPS), rk = rsqrtf(sk * (1.f / 256.f) + RMS_EPS);
        if (lane < 48) { v4u o; o.x = pk2(qf[0] * rq * gq[0], qf[1] * rq * gq[1]); o.y = pk2(qf[2] * rq * gq[2], qf[3] * rq * gq[3]); o.z = pk2(qf[4] * rq * gq[4], qf[5] * rq * gq[5]); o.w = pk2(qf[6] * rq * gq[6], qf[7] * rq * gq[7]);
            *(v4u*)(CQN + (size_t)r * 384 + 8 * lane) = o; }
        if (lane < 32) { v4u o; o.x = pk2(kf[0] * rk * gk[0], kf[1] * rk * gk[1]); o.y = pk2(kf[2] * rk * gk[2], kf[3] * rk * gk[3]); o.z = pk2(kf[4] * rk * gk[4], kf[5] * rk * gk[5]); o.w = pk2(kf[6] * rk * gk[6], kf[7] * rk * gk[7]);
            *(v4u*)(CKVN + (size_t)r * 256 + 8 * lane) = o; }
        if (lane < 4) { bf16x8 o8 = r8; if (p >= CTXL) o8 = att::rope8(r8, rope + (size_t)(p - CTXL) * 32, 4 * lane); *(bf16x8*)(KRR + (size_t)r * 32 + 8 * lane) = o8; }
    }
}

__device__ __forceinline__ void hgrn_unit(const Args& a, int unit, LAS unsigned char* lds, int tid) {
    const int b = unit >> 5, head = (unit >> 3) & 3, dir = (unit >> 2) & 1, sl = unit & 3;
    const bf16* Z = (const bf16*)(a.ws + WS_Z);
    float* Od = (float*)(a.ws + (dir ? WS_OB : WS_OF));
    LAS float* lbv = (LAS float*)lds;
    constexpr int BUF0 = 1024, BUFSZ = 28672, OFF_Q = 16384, OFF_V = 24576;
    if (tid < 128) { const int c = head * 128 + tid; const float l0 = a.in[I_LBL][c], l1 = a.in[I_LBL][512 + c], l2 = a.in[I_LBL][1024 + c]; const float m = fmaxf(l0, fmaxf(l1, l2));
        const float e0 = __expf(l0 - m), e1 = __expf(l1 - m), e2 = __expf(l2 - m); lbv[tid] = e0 / (e0 + e1 + e2); }
    __syncthreads();
    const int lt = tid >> 4, lcg = tid & 15;
    float lb8[8];
#pragma unroll
    for (int i = 0; i < 8; ++i) lb8[i] = lbv[8 * lcg + i];
    const int fcol = (dir ? ZHB : ZHF) + head * 128 + 8 * lcg, qcol = ZHQ + head * 128 + 8 * lcg;
    const int vt = tid >> 2, vcol = ZHI + head * 128 + sl * 32 + (tid & 3) * 8;
    const int wave = tid >> 6, lane = tid & 63, vv = lane >> 4, cg = lane & 15, vloc = wave * 4 + vv;
    const size_t zb = (size_t)b * TPB;
    bf16x8 rq, rf, rv;
#define TOKP(n) (dir ? ((n) < CTXL ? (CTXL - 1 - (n)) : (TPB + CTXL - 1 - (n))) : (n))
#define HG_LOAD(i) do { const int n_ = 32 * (i) + lt; const bf16* zr_ = Z + (zb + TOKP(n_)) * ZC; rq = *(const bf16x8*)(zr_ + qcol); rf = *(const bf16x8*)(zr_ + fcol); \
        if (tid < 128) { const int n2_ = 32 * (i) + vt; rv = *(const bf16x8*)(Z + (zb + TOKP(n2_)) * ZC + vcol); } } while (0)
#define HG_WRITE(bufi) do { LAS unsigned char* bp_ = lds + BUF0 + (bufi) * BUFSZ; float f_[8]; \
        _Pragma("unroll") for (int i_ = 0; i_ < 8; ++i_) f_[i_] = lb8[i_] + (1.f - lb8[i_]) * sigm(bf2f((unsigned short)rf[i_])); \
        *(LAS f32x4*)(bp_ + ((lt * 128 + lcg * 4) * 4)) = (f32x4){f_[0], f_[1], f_[2], f_[3]}; *(LAS f32x4*)(bp_ + ((lt * 128 + 64 + lcg * 4) * 4)) = (f32x4){f_[4], f_[5], f_[6], f_[7]}; \
        *(LAS bf16x8*)(bp_ + OFF_Q + (lt * 128 + lcg * 8) * 2) = rq; \
        if (tid < 128) { float v_[8]; _Pragma("unroll") for (int i_ = 0; i_ < 8; ++i_) v_[i_] = bf2f((unsigned short)rv[i_]); \
            *(LAS f32x4*)(bp_ + OFF_V + (vt * 32 + (tid & 3) * 8) * 4) = (f32x4){v_[0], v_[1], v_[2], v_[3]}; *(LAS f32x4*)(bp_ + OFF_V + (vt * 32 + (tid & 3) * 8 + 4) * 4) = (f32x4){v_[4], v_[5], v_[6], v_[7]}; } } while (0)
    float S[8];
#pragma unroll
    for (int j = 0; j < 8; ++j) S[j] = 0.f;
    HG_LOAD(0); HG_WRITE(0); __syncthreads();
    const bool b3 = (cg & 8) != 0, b2 = (cg & 4) != 0, b1 = (cg & 2) != 0, b0 = (cg & 1) != 0;
    for (int i = 0; i < TPB / 32; ++i) {
        if (i + 1 < TPB / 32) HG_LOAD(i + 1);
        const LAS unsigned char* bp = lds + BUF0 + (i & 1) * BUFSZ;
#pragma unroll 1
        for (int g = 0; g < 4; ++g) {
            const LAS unsigned char* gp = bp + g * 8 * 512;
            float ot[8];
#pragma unroll
            for (int t = 0; t < 8; ++t) {
                const f32x4 f0 = *(const LAS f32x4*)(gp + ((t * 128 + cg * 4) * 4)), f1 = *(const LAS f32x4*)(gp + ((t * 128 + 64 + cg * 4) * 4));
                const bf16x8 q8 = *(const LAS bf16x8*)(bp + OFF_Q + ((g * 8 + t) * 128 + cg * 8) * 2);
                const float v = *(const LAS float*)(bp + OFF_V + ((g * 8 + t) * 32 + vloc) * 4);
                float acc = 0.f;
#pragma unroll
                for (int j = 0; j < 8; ++j) { const float fj = j < 4 ? f0[j] : f1[j - 4]; const float qj = bf2f((unsigned short)q8[j]);
                    const float kv = fmaf(-fj, v, v); S[j] = fmaf(fj, S[j], kv); acc = fmaf(S[j], qj, acc); }
                ot[t] = acc;
            }
#pragma unroll
            for (int k = 0; k < 4; ++k) { const float snd = b3 ? ot[k] : ot[k + 4]; const float rcv = __shfl_xor(snd, 8); ot[k] = (b3 ? ot[k + 4] : ot[k]) + rcv; }
#pragma unroll
            for (int k = 0; k < 2; ++k) { const float snd = b2 ? ot[k] : ot[k + 2]; const float rcv = __shfl_xor(snd, 4); ot[k] = (b2 ? ot[k + 2] : ot[k]) + rcv; }
            { const float snd = b1 ? ot[0] : ot[1]; const float rcv = __shfl_xor(snd, 2); ot[0] = (b1 ? ot[1] : ot[0]) + rcv; }
            ot[0] += __shfl_xor(ot[0], 1);
            if (!b0) { const int n = 32 * i + 8 * g + (cg >> 1); const int p = TOKP(n); if (p >= CTXL) Od[(zb + p) * 512 + head * 128 + sl * 32 + vloc] = ot[0]; }
        }
        if (i + 1 < TPB / 32) HG_WRITE((i + 1) & 1);
        __syncthreads();
    }
#undef TOKP
#undef HG_LOAD
#undef HG_WRITE
}

__device__ __forceinline__ void phase_readout(const Args& a, int lane, int wave) {
    const int gw = blockIdx.x * NWAVES + wave, NGW = gridDim.x * NWAVES;
    const bf16* OF = (const bf16*)(a.ws + WS_OF); const bf16* OB = (const bf16*)(a.ws + WS_OB);
    const bf16* Z = (const bf16*)(a.ws + WS_Z); bf16* MIX = (bf16*)(a.ws + WS_Y);
    float hn[8];
#pragma unroll
    for (int i = 0; i < 8; ++i) hn[i] = a.in[I_HGNORM][((8 * lane) & 127) + i];
    for (int lr = gw; lr < NLAT; lr += NGW) {
        const size_t r = (size_t)grow_of(lr);
        const bf16x8 a8 = *(const bf16x8*)(OF + r * 512 + 8 * lane), c8 = *(const bf16x8*)(OB + r * 512 + 8 * lane);
        const bf16x8 g8 = *(const bf16x8*)(Z + r * ZC + ZHG + 8 * lane);
        float o[8]; float ss = 0.f;
#pragma unroll
        for (int i = 0; i < 8; ++i) o[i] = bf2f((unsigned short)a8[i]) + bf2f((unsigned short)c8[i]);
#pragma unroll
        for (int i = 0; i < 8; ++i) ss += o[i] * o[i];
        ss += __shfl_xor(ss, 1); ss += __shfl_xor(ss, 2); ss += __shfl_xor(ss, 4); ss += __shfl_xor(ss, 8);
        const float rs = rsqrtf(ss * (1.f / 128.f) + RMS_EPS);
        float y[8];
#pragma unroll
        for (int i = 0; i < 8; ++i) { const float g = bf2f((unsigned short)g8[i]); y[i] = o[i] * rs * hn[i] * (g * sigm(g)); }
        v4u w; w.x = pk2(y[0], y[1]); w.y = pk2(y[2], y[3]); w.z = pk2(y[4], y[5]); w.w = pk2(y[6], y[7]);
        *(v4u*)(MIX + r * 1024 + 512 + 8 * lane) = w;
    }
}

__device__ __forceinline__ int rows_per_block() { const int G = gridDim.x; return (((NLAT + G - 1) / G) + 15) & ~15; }
__device__ __forceinline__ void phase_ln1(const Args& a, int l, LAS unsigned char* lds, int tid, int lane, int wave) {
    typedef short bf16x8s __attribute__((ext_vector_type(8)));
    const int RB = rows_per_block(), lr_base = blockIdx.x * RB;
    float* H = (float*)(a.ws + WS_H); bf16* XB = (bf16*)(a.ws + WS_X);
    const float* modv = (const float*)(a.ws + WS_MODV) + (size_t)l * 9 * 6144;
    const float* lng = a.in[I_LN1G] + l * 1024; const float* lnb = a.in[I_LN1B] + l * 1024;
    const float* rw = a.in[I_RW] + (size_t)l * 1024 * 32; const float* rb = a.in[I_RB] + l * 32;
    constexpr int XT_LD = 1028, O_PART = 16 * XT_LD * 4, O_LG = O_PART + 8 * 32 * 16 * 4, O_HIST = O_LG + 16 * 33 * 4 + 64, O_CCNT = O_HIST + 256, O_TIL = O_CCNT + 2048, O_TWL = O_TIL + 4096;
    LAS float* XT = (LAS float*)lds; LAS float* PART = (LAS float*)(lds + O_PART); LAS float* LG = (LAS float*)(lds + O_LG);
    LAS int* hist = (LAS int*)(lds + O_HIST);
    LAS int* ccnt = (LAS int*)(lds + O_CCNT);
    LAS int* til = (LAS int*)(lds + O_TIL);
    LAS float* twl = (LAS float*)(lds + O_TWL);
    __syncthreads();
    if (tid < 32) hist[tid] = 0;
    bf16x8s whi[2][4], wlo[2][4];
    { const int e15 = lane & 15, kq = lane >> 4;
#pragma unroll
      for (int t = 0; t < 2; ++t)
#pragma unroll
          for (int sI = 0; sI < 4; ++sI) { float wv[8];
#pragma unroll
              for (int j = 0; j < 8; ++j) wv[j] = rw[(size_t)(128 * wave + 32 * sI + 8 * kq + j) * 32 + 16 * t + e15];
              v4u ph, pl;
#pragma unroll
              for (int j = 0; j < 4; ++j) { const unsigned p = pk2(wv[2 * j], wv[2 * j + 1]); const float h0 = __uint_as_float(p << 16), h1 = __uint_as_float(p & 0xffff0000u); ph[j] = p; pl[j] = pk2(wv[2 * j] - h0, wv[2 * j + 1] - h1); }
              whi[t][sI] = __builtin_bit_cast(bf16x8s, ph); wlo[t][sI] = __builtin_bit_cast(bf16x8s, pl); } }
    const int ngroups = RB / 16;
    f32x4 xr[2][4];
#define LN1_LOAD(g) do { _Pragma("unroll") for (int rr_ = 0; rr_ < 2; ++rr_) { const int lr_ = lr_base + 16 * (g) + 2 * wave + rr_; const size_t r_ = (size_t)grow_of(lr_ < NLAT ? lr_ : NLAT - 1); \
        _Pragma("unroll") for (int j_ = 0; j_ < 4; ++j_) xr[rr_][j_] = *(const f32x4*)(H + r_ * 1024 + 4 * (lane + 64 * j_)); } } while (0)
    LN1_LOAD(0);
    for (int g = 0; g < ngroups; ++g) {
#pragma unroll
        for (int rr = 0; rr < 2; ++rr) {
            const int lr = lr_base + 16 * g + 2 * wave + rr; const bool ok = lr < NLAT; const size_t r = (size_t)grow_of(ok ? lr : NLAT - 1); const int b = (ok ? lr : NLAT - 1) >> 12;
            const float* mv = modv + (size_t)b * 6144;
            f32x4 x[4]; float s = 0.f;
#pragma unroll
            for (int j = 0; j < 4; ++j) { x[j] = xr[rr][j]; s += (x[j][0] + x[j][1]) + (x[j][2] + x[j][3]); }
            const float mean = wave_sum(s) * (1.f / 1024.f); float s2 = 0.f;
#pragma unroll
            for (int j = 0; j < 4; ++j) { x[j] = x[j] - mean; s2 += (x[j][0] * x[j][0] + x[j][1] * x[j][1]) + (x[j][2] * x[j][2] + x[j][3] * x[j][3]); }
            const float rstd = rsqrtf(wave_sum(s2) * (1.f / 1024.f) + LN_EPS);
#pragma unroll
            for (int j = 0; j < 4; ++j) { const int c = 4 * (lane + 64 * j); const f32x4 gg = *(const f32x4*)(lng + c), bb = *(const f32x4*)(lnb + c);
                const f32x4 hv = x[j] * rstd * gg + bb;
                const f32x4 sh = *(const f32x4*)(mv + 3 * 1024 + c), sc = *(const f32x4*)(mv + 4 * 1024 + c);
                const f32x4 bm = hv * (sc + 1.0f) + sh;
                if (ok) *(unsigned*)((unsigned char*)XB + r * 1024 + c) = pack_fp8x4(bm[0] * SC_X8, bm[1] * SC_X8, bm[2] * SC_X8, bm[3] * SC_X8);
                *(LAS f32x4*)(XT + (2 * wave + rr) * XT_LD + c) = bm; }
        }
        if (g + 1 < ngroups) LN1_LOAD(g + 1);
        __syncthreads();
        { const int rr = lane & 15, kq = lane >> 4;
          f32x4 acc0 = {0.f, 0.f, 0.f, 0.f}, acc1 = {0.f, 0.f, 0.f, 0.f};
#pragma unroll
          for (int sI = 0; sI < 4; ++sI) { const LAS float* xp = XT + rr * XT_LD + 128 * wave + 32 * sI + 8 * kq; const f32x4 v0 = *(const LAS f32x4*)xp, v1 = *(const LAS f32x4*)(xp + 4);
              const float bv[8] = {v0[0], v0[1], v0[2], v0[3], v1[0], v1[1], v1[2], v1[3]}; v4u ph, pl;
#pragma unroll
              for (int j = 0; j < 4; ++j) { const unsigned p = pk2(bv[2 * j], bv[2 * j + 1]); const float h0 = __uint_as_float(p << 16), h1 = __uint_as_float(p & 0xffff0000u); ph[j] = p; pl[j] = pk2(bv[2 * j] - h0, bv[2 * j + 1] - h1); }
              const bf16x8s bh = __builtin_bit_cast(bf16x8s, ph), bl = __builtin_bit_cast(bf16x8s, pl);
              acc0 = __builtin_amdgcn_mfma_f32_16x16x32_bf16(whi[0][sI], bh, acc0, 0, 0, 0); acc0 = __builtin_amdgcn_mfma_f32_16x16x32_bf16(whi[0][sI], bl, acc0, 0, 0, 0); acc0 = __builtin_amdgcn_mfma_f32_16x16x32_bf16(wlo[0][sI], bh, acc0, 0, 0, 0);
              acc1 = __builtin_amdgcn_mfma_f32_16x16x32_bf16(whi[1][sI], bh, acc1, 0, 0, 0); acc1 = __builtin_amdgcn_mfma_f32_16x16x32_bf16(whi[1][sI], bl, acc1, 0, 0, 0); acc1 = __builtin_amdgcn_mfma_f32_16x16x32_bf16(wlo[1][sI], bh, acc1, 0, 0, 0); }
#pragma unroll
          for (int q = 0; q < 4; ++q) { PART[(wave * 32 + 4 * kq + q) * 16 + rr] = acc0[q]; PART[(wave * 32 + 16 + 4 * kq + q) * 16 + rr] = acc1[q]; } }
        __syncthreads();
        { const int e = tid >> 4, rr = tid & 15; float sacc = rb[e];
#pragma unroll
          for (int w = 0; w < 8; ++w) sacc += PART[(w * 32 + e) * 16 + rr];
          LG[rr * 33 + e] = sacc; }
        __syncthreads();
        if (wave == (g & 7) && lane < 16) { const int lr = lr_base + 16 * g + lane;
            if (lr < NLAT) { float lg[32];
#pragma unroll
                for (int e = 0; e < 32; ++e) lg[e] = LG[lane * 33 + e];
                unsigned taken = 0u; float tv[4]; int ti[4];
#pragma unroll
                for (int kk = 0; kk < 4; ++kk) { float best = -3.0e38f; int bi = 0;
#pragma unroll
                    for (int e = 0; e < 32; ++e) { const bool okk = (lg[e] > best) && !((taken >> e) & 1u); best = okk ? lg[e] : best; bi = okk ? e : bi; }
                    taken |= 1u << bi; tv[kk] = best; ti[kk] = bi; }
                const float e1 = __expf(tv[1] - tv[0]), e2 = __expf(tv[2] - tv[0]), e3 = __expf(tv[3] - tv[0]); const float inv = 1.f / (1.f + e1 + e2 + e3);
                const int li = (16 * g + lane) * 4; til[li] = ti[0]; til[li + 1] = ti[1]; til[li + 2] = ti[2]; til[li + 3] = ti[3]; twl[li] = inv; twl[li + 1] = e1 * inv; twl[li + 2] = e2 * inv; twl[li + 3] = e3 * inv;
                __hip_atomic_fetch_add(hist + ti[0], 1, __ATOMIC_RELAXED, __HIP_MEMORY_SCOPE_WORKGROUP); __hip_atomic_fetch_add(hist + ti[1], 1, __ATOMIC_RELAXED, __HIP_MEMORY_SCOPE_WORKGROUP);
                __hip_atomic_fetch_add(hist + ti[2], 1, __ATOMIC_RELAXED, __HIP_MEMORY_SCOPE_WORKGROUP); __hip_atomic_fetch_add(hist + ti[3], 1, __ATOMIC_RELAXED, __HIP_MEMORY_SCOPE_WORKGROUP); } }
    }
#undef LN1_LOAD
    __syncthreads();
    int* cursor = (int*)(a.ws + WS_CURSOR) + l * 32;
    int* rows = (int*)(a.ws + WS_ROWS); float* roww = (float*)(a.ws + WS_ROWW); int* rowd = (int*)(a.ws + WS_ROWD);
    int nrows = NLAT - lr_base; nrows = nrows > RB ? RB : nrows; if (nrows < 0) nrows = 0;
    const int nas = nrows * 4, nchunks = (nas + 63) >> 6;
    int basev = 0; if (tid < 32) basev = (int)__hip_atomic_fetch_add((unsigned*)cursor + tid, (unsigned)hist[tid], __ATOMIC_RELAXED, __HIP_MEMORY_SCOPE_AGENT);
    int myrank[2] = {0, 0}, mye[2] = {-1, -1};
#pragma unroll
    for (int cc = 0; cc < 2; ++cc) { const int c = wave + 8 * cc; if (c < nchunks) { const int idx = c * 64 + lane; const int e = idx < nas ? til[idx] : -1; mye[cc] = e;
        for (int x = 0; x < 32; ++x) { const unsigned long long m = __ballot(e == x); if (e == x) myrank[cc] = __popcll(m & ((1ull << lane) - 1ull)); if (lane == 0) ccnt[c * 32 + x] = __popcll(m); } } }
    __syncthreads();
    if (tid < 32) hist[32 + tid] = basev;
    __syncthreads();
#pragma unroll
    for (int cc = 0; cc < 2; ++cc) { const int c = wave + 8 * cc; const int idx = c * 64 + lane; if (c < nchunks && idx < nas) { const int e = mye[cc]; int pos = hist[32 + e] + myrank[cc]; for (int c2 = 0; c2 < c; ++c2) pos += ccnt[c2 * 32 + e];
        const int lr = lr_base + (idx >> 2); const size_t pi = (size_t)e * ECAP + pos; rows[pi] = grow_of(lr); roww[pi] = twl[idx]; rowd[pi] = lr * 4 + (idx & 3); } }
}

__device__ __forceinline__ void phase_ln2(const Args& a, int l, int lane, int wave) {
    const int gw = blockIdx.x * NWAVES + wave, NGW = gridDim.x * NWAVES;
    float* H = (float*)(a.ws + WS_H); const unsigned char* YB = (const unsigned char*)(a.ws + WS_YB); bf16* A1 = (bf16*)(a.ws + WS_Y);
    const float* modv = (const float*)(a.ws + WS_MODV);
    const float* ln1g = a.in[I_LN1G] + l * 1024; const float* ln1b = a.in[I_LN1B] + l * 1024;
    const float* lng = a.in[I_LN2G] + l * 1024; const float* lnb = a.in[I_LN2B] + l * 1024;
    for (int lr0 = 2 * gw; lr0 < NLAT; lr0 += 2 * NGW) {
        f32x4 hv[2][4]; unsigned yv[2][4][4];
#pragma unroll
        for (int q = 0; q < 2; ++q) { const int lr = lr0 + q; const size_t r = (size_t)grow_of(lr);
#pragma unroll
            for (int j = 0; j < 4; ++j) { const int c = 4 * (lane + 64 * j); hv[q][j] = *(const f32x4*)(H + r * 1024 + c);
#pragma unroll
                for (int k = 0; k < 4; ++k) yv[q][j][k] = *(const unsigned*)(YB + ((size_t)lr * 4 + k) * 1024 + c); } }
#pragma unroll
        for (int q = 0; q < 2; ++q) {
            const int lr = lr0 + q; const size_t r = (size_t)grow_of(lr); const int b = lr >> 12;
            const float* mv = modv + ((size_t)l * 9 + b) * 6144; const float* mv1 = modv + ((size_t)9 + b) * 6144;
            f32x4 x[4]; float s = 0.f;
#pragma unroll
            for (int j = 0; j < 4; ++j) { x[j] = hv[q][j]; s += (x[j][0] + x[j][1]) + (x[j][2] + x[j][3]); }
            float mean = wave_sum(s) * (1.f / 1024.f), s2 = 0.f;
#pragma unroll
            for (int j = 0; j < 4; ++j) { x[j] = x[j] - mean; s2 += (x[j][0] * x[j][0] + x[j][1] * x[j][1]) + (x[j][2] * x[j][2] + x[j][3] * x[j][3]); }
            float rstd = rsqrtf(wave_sum(s2) * (1.f / 1024.f) + LN_EPS);
            s = 0.f;
#pragma unroll
            for (int j = 0; j < 4; ++j) { const int c = 4 * (lane + 64 * j); const f32x4 g = *(const f32x4*)(ln1g + c), bb = *(const f32x4*)(ln1b + c);
                const f32x4 h1 = x[j] * rstd * g + bb; f32x4 f = {0.f, 0.f, 0.f, 0.f};
#pragma unroll
                for (int k = 0; k < 4; ++k) { const unsigned y = yv[q][j][k]; const auto lo = __builtin_amdgcn_cvt_pk_f32_fp8((int)y, false), hi = __builtin_amdgcn_cvt_pk_f32_fp8((int)y, true);
                    f[0] += lo[0]; f[1] += lo[1]; f[2] += hi[0]; f[3] += hi[1]; }
                const f32x4 gt = *(const f32x4*)(mv + 5 * 1024 + c);
                x[j] = h1 * ALPHA + gt * (f * (1.f / SC_Y)); s += (x[j][0] + x[j][1]) + (x[j][2] + x[j][3]); }
            mean = wave_sum(s) * (1.f / 1024.f); s2 = 0.f;
#pragma unroll
            for (int j = 0; j < 4; ++j) { x[j] = x[j] - mean; s2 += (x[j][0] * x[j][0] + x[j][1] * x[j][1]) + (x[j][2] * x[j][2] + x[j][3] * x[j][3]); }
            rstd = rsqrtf(wave_sum(s2) * (1.f / 1024.f) + LN_EPS);
#pragma unroll
            for (int j = 0; j < 4; ++j) { const int c = 4 * (lane + 64 * j); const f32x4 g = *(const f32x4*)(lng + c), bb = *(const f32x4*)(lnb + c);
                const f32x4 o = x[j] * rstd * g + bb;
                if (l == 0) { *(f32x4*)(H + r * 1024 + c) = o; const f32x4 sh = *(const f32x4*)(mv1 + c), sc = *(const f32x4*)(mv1 + 1024 + c);
                    const f32x4 am = o * (sc + 1.0f) + sh; v2u w; w.x = pk2(am[0], am[1]); w.y = pk2(am[2], am[3]); *(v2u*)(A1 + r * 1024 + c) = w; }
                else *(f32x4*)(a.out + (size_t)lr * 1024 + c) = o; }
        }
    }
}

__device__ __forceinline__ void phase_conv(const Args& a, LAS unsigned char* lds, int tid, int lane, int wave) {
    const bf16* U = (const bf16*)(a.ws + WS_X); bf16* V = (bf16*)(a.ws + WS_Y);
    LAS float* part = (LAS float*)(lds + 126976);
    LAS float* st = part + 512;
    const int c0 = 2 * tid;
    const float db0 = a.in[I_DWB][c0], db1 = a.in[I_DWB][c0 + 1], g0 = a.in[I_CLNG][c0], g1 = a.in[I_CLNG][c0 + 1], be0 = a.in[I_CLNB][c0], be1 = a.in[I_CLNB][c0 + 1];
    for (int tile = blockIdx.x; tile < NLAT / 32; tile += gridDim.x) {
        const int b = tile >> 7, t0 = (tile & 127) * 32;
        const size_t rb0 = (size_t)b * TPB + CTXL;
        __syncthreads();
        for (int i = tid; i < 62 * 128; i += NTHR) { const int row = i >> 7, chk = i & 127, t = t0 - 15 + row;
            v4u val = {0u, 0u, 0u, 0u}; if (t >= 0 && t < SEQ) val = *(const v4u*)(U + (rb0 + t) * 1024 + chk * 8);
            *(LAS v4u*)(lds + row * 2048 + chk * 16) = val; }
        __syncthreads();
        float w0[31], w1[31];
#pragma unroll
        for (int j = 0; j < 31; ++j) { const float2 wv = *(const float2*)(a.in[I_DWW] + j * 1024 + c0); w0[j] = wv.x; w1[j] = wv.y; }
#pragma unroll 1
        for (int hh = 0; hh < 2; ++hh) {
            const LAS unsigned char* hp = lds + hh * 16 * 2048;
            float acc0[16], acc1[16];
#pragma unroll
            for (int t = 0; t < 16; ++t) { acc0[t] = db0; acc1[t] = db1; }
#pragma unroll
            for (int s = 0; s < 46; ++s) { const unsigned pr = *(const LAS unsigned*)(hp + s * 2048 + tid * 4); const float x0 = __uint_as_float(pr << 16), x1 = __uint_as_float(pr & 0xffff0000u);
#pragma unroll
                for (int t = (s > 30 ? s - 30 : 0); t <= (s < 15 ? s : 15); ++t) { acc0[t] = fmaf(x0, w0[s - t], acc0[t]); acc1[t] = fmaf(x1, w1[s - t], acc1[t]); } }
            float rs[32];
#pragma unroll
            for (int t = 0; t < 16; ++t) { rs[2 * t] = acc0[t] + acc1[t]; rs[2 * t + 1] = acc0[t] * acc0[t] + acc1[t] * acc1[t]; }
#define RS_STEP(NKEEP, XORV) { const bool bit_ = (lane & XORV) != 0; _Pragma("unroll") for (int k_ = 0; k_ < NKEEP; ++k_) { const float snd_ = bit_ ? rs[k_] : rs[k_ + NKEEP]; const float rcv_ = __shfl_xor(snd_, XORV); rs[k_] = (bit_ ? rs[k_ + NKEEP] : rs[k_]) + rcv_; } }
            RS_STEP(16, 32) RS_STEP(8, 16) RS_STEP(4, 8) RS_STEP(2, 4) RS_STEP(1, 2)
#undef RS_STEP
            rs[0] += __shfl_xor(rs[0], 1);
            __syncthreads();
            if ((lane & 1) == 0) part[wave * 32 + (lane >> 1)] = rs[0];
            __syncthreads();
            if (tid < 16) { float s1 = 0.f, s2 = 0.f;
#pragma unroll
                for (int w = 0; w < 8; ++w) { s1 += part[w * 32 + 2 * tid]; s2 += part[w * 32 + 2 * tid + 1]; }
                const float mean = s1 * (1.f / 1024.f); const float var = fmaxf(s2 * (1.f / 1024.f) - mean * mean, 0.f); st[2 * tid] = mean; st[2 * tid + 1] = rsqrtf(var + LN_EPS); }
            __syncthreads();
#pragma unroll
            for (int t = 0; t < 16; ++t) { const float mean = st[2 * t], rstd = st[2 * t + 1];
                const float y0 = (acc0[t] - mean) * rstd * g0 + be0, y1 = (acc1[t] - mean) * rstd * g1 + be1;
                *(unsigned*)(V + (rb0 + t0 + hh * 16 + t) * 1024 + c0) = pk2(y0 * sigm(y0), y1 * sigm(y1)); }
        }
    }
}

namespace hg {
using bf16x8 = __attribute__((ext_vector_type(8))) short;
using s16x4  = __attribute__((ext_vector_type(4))) short;
using f32x16 = __attribute__((ext_vector_type(16))) float;
using u32x4  = __attribute__((ext_vector_type(4))) unsigned;
constexpr int RS = 272;
constexpr int VS = 80;
constexpr int T_Q = 0, T_KO = 32 * RS, T_KE = 64 * RS, T_D = 96 * RS, IMG_BYTES = T_D + 512, T_V = IMG_BYTES, TILE_BYTES = T_V + 32 * VS;
constexpr int OFF_TILES = 1024, NTB = 3, OFF_OPART = OFF_TILES + NTB * TILE_BYTES, OPART_BYTES = 4 * 4096;
static_assert(OFF_OPART + 2 * OPART_BYTES <= 131072 && IMG_BYTES % 16 == 0 && IMG_BYTES / 16 == 1664, "hgrn lds");
constexpr int P_RAW = 1024, R_Q = 0, R_F = 32 * RS, RAW_BYTES = 64 * RS, P_IMG = P_RAW + RAW_BYTES;
constexpr int NCHUNK = TPB / 32, NCHAIN = NB * 4 * 2, NITEM = NCHAIN * NCHUNK;
__device__ __forceinline__ int crow(int r, int hi) { return (r & 3) + 8 * (r >> 2) + 4 * hi; }
__device__ __forceinline__ s16x4 tr_read(unsigned addr) { s16x4 r; asm volatile("ds_read_b64_tr_b16 %0, %1" : "=&v"(r) : "v"(addr) : "memory"); return r; }
__device__ __forceinline__ bf16x8 cat8(s16x4 l, s16x4 h) { return (bf16x8){l[0], l[1], l[2], l[3], h[0], h[1], h[2], h[3]}; }
__device__ __forceinline__ bf16x8 pack8(const f32x16& x, int base) {
    u32x4 w; w[0] = pk2(x[base + 0], x[base + 1]); w[1] = pk2(x[base + 2], x[base + 3]); w[2] = pk2(x[base + 4], x[base + 5]); w[3] = pk2(x[base + 6], x[base + 7]);
    return *reinterpret_cast<bf16x8*>(&w);
}
}


#define HG_TOKP(dir, n) ((dir) ? ((n) < CTXL ? (CTXL - 1 - (n)) : (TPB + CTXL - 1 - (n))) : (n))
#define HG_DPP1(x, ctrl, rmask) __int_as_float(__builtin_amdgcn_update_dpp(0x3f800000, __float_as_int(x), ctrl, rmask, 0xf, false))
#define HG_DPP(x, ctrl, rmask) __int_as_float(__builtin_amdgcn_update_dpp(0, __float_as_int(x), ctrl, rmask, 0xf, false))
__device__ __forceinline__ void hgrn_prep_items(const Args& a, LAS unsigned char* lds, int tid) {
    using namespace hg;
    const bf16* Z = (const bf16*)(a.ws + WS_Z);
    unsigned char* HT = a.ws + WS_HT;
    const int wave = __builtin_amdgcn_readfirstlane(tid >> 6), lane = tid & 63, t = lane & 31, half = lane >> 5;
    const int c0 = 16 * wave + 8 * half;
    const int lr = tid >> 4, lch = tid & 15;
    LAS float* lbt = (LAS float*)lds;
    constexpr int P_RAW2 = 2048, P_IMG2 = P_RAW2 + 2 * RAW_BYTES;
    static_assert(P_IMG2 + 2 * IMG_BYTES <= 131072, "prep lds");
    __syncthreads();
    { const float l0 = a.in[I_LBL][tid], l1 = a.in[I_LBL][512 + tid], l2 = a.in[I_LBL][1024 + tid]; const float m = fmaxf(l0, fmaxf(l1, l2));
      const float e0 = __expf(l0 - m), e1 = __expf(l1 - m), e2 = __expf(l2 - m); lbt[tid] = e0 / (e0 + e1 + e2); }
    bf16x8 gq, gf;
#define HP_LOAD(it) do { const int ch_ = (it) % NCHUNK, cn_ = (it) / NCHUNK, dir_ = cn_ & 1, hd_ = (cn_ >> 1) & 3, b_ = cn_ >> 3; \
        const bf16* zr_ = Z + ((size_t)b_ * TPB + HG_TOKP(dir_, 32 * ch_ + lr)) * ZC; gq = *(const bf16x8*)(zr_ + ZHQ + hd_ * 128 + lch * 8); gf = *(const bf16x8*)(zr_ + (dir_ ? ZHB : ZHF) + hd_ * 128 + lch * 8); } while (0)
#define HP_STASH(bufi) do { LAS unsigned char* rb_ = lds + P_RAW2 + (bufi) * RAW_BYTES; *(LAS bf16x8*)(rb_ + R_Q + lr * RS + lch * 16) = gq; *(LAS bf16x8*)(rb_ + R_F + lr * RS + lch * 16) = gf; } while (0)
#define HP_COPYOUT(item, bufi) do { v4u* dst_ = (v4u*)(HT + (size_t)(item) * IMG_BYTES); const LAS v4u* src_ = (const LAS v4u*)(lds + P_IMG2 + (bufi) * IMG_BYTES); \
        dst_[tid] = src_[tid]; dst_[tid + 512] = src_[tid + 512]; dst_[tid + 1024] = src_[tid + 1024]; if (tid < 128) dst_[tid + 1536] = src_[tid + 1536]; } while (0)
    const int G = gridDim.x;
    int it = blockIdx.x, par = 0;
    if (it < NITEM) { HP_LOAD(it); HP_STASH(0); }
    if (it + G < NITEM) HP_LOAD(it + G);
    __syncthreads();
    for (; it < NITEM; it += G, par ^= 1) {
        if (it + G < NITEM) HP_STASH(par ^ 1);
        if (it != (int)blockIdx.x) HP_COPYOUT(it - G, par ^ 1);
        if (it + 2 * G < NITEM) HP_LOAD(it + 2 * G);
        const int hd = ((it / NCHUNK) >> 1) & 3;
        {
            const LAS unsigned char* rb_ = lds + P_RAW2 + par * RAW_BYTES;
            const bf16x8 RQ = *(const LAS bf16x8*)(rb_ + R_Q + t * RS + c0 * 2), RF = *(const LAS bf16x8*)(rb_ + R_F + t * RS + c0 * 2);
            const f32x4 lbA = *(const LAS f32x4*)(lbt + hd * 128 + c0), lbB = *(const LAS f32x4*)(lbt + hd * 128 + c0 + 4);
            LAS unsigned char* tb_ = lds + P_IMG2 + par * IMG_BYTES;
            float bb_[8], kk_[8];
#pragma unroll
            for (int i_ = 0; i_ < 8; ++i_) { const float lb_ = i_ < 4 ? lbA[i_] : lbB[i_ - 4]; const float f_ = lb_ + (1.f - lb_) * __builtin_amdgcn_rcpf(1.f + __expf(-bf2f((unsigned short)RF[i_]))); kk_[i_] = 1.f - f_; bb_[i_] = f_; }
#pragma unroll
            for (int i_ = 0; i_ < 8; ++i_) { float x_ = bb_[i_]; x_ *= HG_DPP1(x_, 0x111, 0xf); x_ *= HG_DPP1(x_, 0x112, 0xf); x_ *= HG_DPP1(x_, 0x114, 0xf); x_ *= HG_DPP1(x_, 0x118, 0xf);
                x_ *= HG_DPP1(x_, 0x142, 0xa); bb_[i_] = x_; }
            float qi_[8], ko_[8], ke_[8], dd_[8];
#pragma unroll
            for (int i_ = 0; i_ < 8; ++i_) { const int bi_ = __float_as_int(bb_[i_]); dd_[i_] = __int_as_float(half ? __builtin_amdgcn_readlane(bi_, 63) : __builtin_amdgcn_readlane(bi_, 31));
                const float e_ = bb_[i_]; const float ei_ = __builtin_amdgcn_rcpf(e_);
                qi_[i_] = bf2f((unsigned short)RQ[i_]) * e_; ko_[i_] = kk_[i_] * ei_; ke_[i_] = kk_[i_] * (dd_[i_] * ei_); }
            *(LAS v4u*)(tb_ + T_Q + t * RS + c0 * 2) = (v4u){pk2(qi_[0], qi_[1]), pk2(qi_[2], qi_[3]), pk2(qi_[4], qi_[5]), pk2(qi_[6], qi_[7])};
            *(LAS v4u*)(tb_ + T_KO + t * RS + c0 * 2) = (v4u){pk2(ko_[0], ko_[1]), pk2(ko_[2], ko_[3]), pk2(ko_[4], ko_[5]), pk2(ko_[6], ko_[7])};
            *(LAS v4u*)(tb_ + T_KE + t * RS + c0 * 2) = (v4u){pk2(ke_[0], ke_[1]), pk2(ke_[2], ke_[3]), pk2(ke_[4], ke_[5]), pk2(ke_[6], ke_[7])};
            if (t == 31) { *(LAS f32x4*)(tb_ + T_D + c0 * 4) = (f32x4){dd_[0], dd_[1], dd_[2], dd_[3]}; *(LAS f32x4*)(tb_ + T_D + c0 * 4 + 16) = (f32x4){dd_[4], dd_[5], dd_[6], dd_[7]}; }
            if (tid < 32) *(LAS v4u*)(tb_ + T_Q + tid * RS + 256) = (v4u){0u, 0u, 0u, 0u};
            else if (tid < 64) *(LAS v4u*)(tb_ + T_KO + (tid - 32) * RS + 256) = (v4u){0u, 0u, 0u, 0u};
            else if (tid < 96) *(LAS v4u*)(tb_ + T_KE + (tid - 64) * RS + 256) = (v4u){0u, 0u, 0u, 0u};
        }
        __syncthreads();
    }
    if (it - G >= (int)blockIdx.x && it - G < NITEM) HP_COPYOUT(it - G, par ^ 1);
    __syncthreads();
#undef HP_COPYOUT
#undef HP_LOAD
#undef HP_STASH
}

__device__ __forceinline__ void hgrn_unit_mfma(const Args& a, int unit, LAS unsigned char* lds, int tid) {
    using namespace hg;
    const int b = unit >> 5, head = (unit >> 3) & 3, dir = (unit >> 2) & 1, sl = unit & 3;
    const bf16* Z = (const bf16*)(a.ws + WS_Z);
    const unsigned char* HT = a.ws + WS_HT + (size_t)((b * 4 + head) * 2 + dir) * NCHUNK * IMG_BYTES;
    bf16* Od = (bf16*)(a.ws + (dir ? WS_OB : WS_OF));
    const int wave = __builtin_amdgcn_readfirstlane(tid >> 6), lane = tid & 63;
    const size_t zb = (size_t)b * TPB;
    constexpr int NCH = NCHUNK;
    const int vr = (tid >> 2) & 31, vp = tid & 3, lvcol = ZHI + head * 128 + sl * 32 + vp * 8, i3 = 1536 + (tid & 127);
    v4u gA0, gA1, gA2, gA3, gB0, gB1, gB2, gB3; bf16x8 gAv, gBv;
#define HG_LOAD(g0, g1, g2, g3, gv, ch) do { const int c_ = (ch) < NCH ? (ch) : NCH - 1; const v4u* src_ = (const v4u*)(HT + (size_t)c_ * IMG_BYTES); \
        g0 = src_[tid]; g1 = src_[tid + 512]; g2 = src_[tid + 1024]; g3 = src_[i3]; gv = *(const bf16x8*)(Z + (zb + HG_TOKP(dir, 32 * c_ + vr)) * ZC + lvcol); } while (0)
#define HG_STASH(g0, g1, g2, g3, gv, bufi) do { LAS unsigned char* tb_ = lds + OFF_TILES + (bufi) * TILE_BYTES; LAS v4u* d_ = (LAS v4u*)tb_; \
        d_[tid] = g0; d_[tid + 512] = g1; d_[tid + 1024] = g2; if (tid < 128) { d_[tid + 1536] = g3; *(LAS bf16x8*)(tb_ + T_V + vr * VS + vp * 16) = gv; } } while (0)
    const int r32 = lane & 31, hi = lane >> 5, g1 = (lane >> 4) & 1, q4 = (lane & 15) >> 2, p4 = lane & 3, cb = 32 * wave;
    const unsigned lbase = (unsigned)(uintptr_t)lds;
    f32x16 S = {};
    HG_LOAD(gA0, gA1, gA2, gA3, gAv, 0); HG_STASH(gA0, gA1, gA2, gA3, gAv, 0); HG_LOAD(gA0, gA1, gA2, gA3, gAv, 1); HG_STASH(gA0, gA1, gA2, gA3, gAv, 1);
    HG_LOAD(gA0, gA1, gA2, gA3, gAv, 2);
    __syncthreads();
#define HG_RD64(dst, addr, OFFS) asm volatile("ds_read_b64 %0, %1 offset:" #OFFS : "=&v"(dst) : "v"(addr) : "memory")
#define HG_MFMA_STAGE(n, bufi) do { \
            const unsigned tb = lbase + OFF_TILES + (bufi) * TILE_BYTES; const LAS unsigned char* tl_ = lds + OFF_TILES + (bufi) * TILE_BYTES; \
            bf16x8 ko[2], qi[2]; s16x4 pvl[2], pvh[2], pql[2], pqh[2], kl[2], kh[2], nvl[2], nvh[2]; f32x4 dsc[4]; \
            _Pragma("unroll") for (int kk = 0; kk < 2; ++kk) { ko[kk] = *(const LAS bf16x8*)(tl_ + T_KO + r32 * RS + (cb + 16 * kk + 8 * hi) * 2); qi[kk] = *(const LAS bf16x8*)(tl_ + T_Q + r32 * RS + (cb + 16 * kk + 8 * hi) * 2); } \
            _Pragma("unroll") for (int sp = 0; sp < 2; ++sp) { \
                const unsigned va = tb + T_V + (16 * sp + 4 * hi + q4) * VS + (16 * g1 + 4 * p4) * 2; pvl[sp] = tr_read(va); pvh[sp] = tr_read(va + 8 * VS);              \
                const unsigned qa = tb + T_Q + r32 * RS + (cb + 16 * sp + 4 * hi) * 2; HG_RD64(pql[sp], qa, 0); HG_RD64(pqh[sp], qa, 16);                                  \
                const unsigned ka = tb + T_KE + (16 * sp + 8 * hi + q4) * RS + (cb + 16 * g1 + 4 * p4) * 2; kl[sp] = tr_read(ka); kh[sp] = tr_read(ka + 4 * RS);        \
                const unsigned vb = tb + T_V + (16 * sp + 8 * hi + q4) * VS + (16 * g1 + 4 * p4) * 2; nvl[sp] = tr_read(vb); nvh[sp] = tr_read(vb + 4 * VS); }            \
            _Pragma("unroll") for (int g = 0; g < 4; ++g) dsc[g] = *(const LAS f32x4*)(tl_ + T_D + (cb + 8 * g + 4 * hi) * 4); \
            asm volatile("s_waitcnt lgkmcnt(0)" ::: "memory"); __builtin_amdgcn_sched_barrier(0); \
            f32x16 X = {}; \
            X = __builtin_amdgcn_mfma_f32_32x32x16_bf16(ko[0], qi[0], X, 0, 0, 0); X = __builtin_amdgcn_mfma_f32_32x32x16_bf16(ko[1], qi[1], X, 0, 0, 0); \
            f32x16 O = {}; \
            O = __builtin_amdgcn_mfma_f32_32x32x16_bf16(cat8(pql[0], pqh[0]), pack8(S, 0), O, 0, 0, 0); O = __builtin_amdgcn_mfma_f32_32x32x16_bf16(cat8(pql[1], pqh[1]), pack8(S, 8), O, 0, 0, 0); \
            _Pragma("unroll") for (int i = 0; i < 16; ++i) S[i] *= dsc[i >> 2][i & 3]; \
            S = __builtin_amdgcn_mfma_f32_32x32x16_bf16(cat8(kl[0], kh[0]), cat8(nvl[0], nvh[0]), S, 0, 0, 0); S = __builtin_amdgcn_mfma_f32_32x32x16_bf16(cat8(kl[1], kh[1]), cat8(nvl[1], nvh[1]), S, 0, 0, 0); \
            _Pragma("unroll") for (int i = 0; i < 16; ++i) X[i] = (crow(i, hi) <= r32) ? X[i] : 0.f; \
            O = __builtin_amdgcn_mfma_f32_32x32x16_bf16(pack8(X, 0), cat8(pvl[0], pvh[0]), O, 0, 0, 0); O = __builtin_amdgcn_mfma_f32_32x32x16_bf16(pack8(X, 8), cat8(pvl[1], pvh[1]), O, 0, 0, 0); \
            LAS float* op = (LAS float*)(lds + OFF_OPART + ((n) & 1) * OPART_BYTES + wave * 4096); \
            _Pragma("unroll") for (int i = 0; i < 16; ++i) op[crow(i, hi) * 32 + r32] = O[i]; } while (0)
#define HG_OUT_STAGE(n) do { \
            const int l2 = tid - 256, tt = l2 >> 3, vq = l2 & 7; \
            const LAS float* op = (const LAS float*)(lds + OFF_OPART + (((n) - 1) & 1) * OPART_BYTES) + tt * 32 + vq * 4; \
            const f32x4 s = (*(const LAS f32x4*)op + *(const LAS f32x4*)(op + 1024)) + (*(const LAS f32x4*)(op + 2048) + *(const LAS f32x4*)(op + 3072)); \
            const int p = HG_TOKP(dir, 32 * ((n) - 1) + tt); \
            if (p >= CTXL) *(v2u*)(Od + (zb + p) * 512 + head * 128 + sl * 32 + vq * 4) = (v2u){pk2(s[0], s[1]), pk2(s[2], s[3])}; } while (0)
#define HG_ITER(n, L0, L1, L2, L3, LV, S0, S1, S2, S3, SV) do { \
        HG_LOAD(L0, L1, L2, L3, LV, (n) + 3); \
        if (wave < 4) { HG_MFMA_STAGE(n, bcur); } else if ((n) > 0) { HG_OUT_STAGE(n); } \
        { const int bst_ = bcur == 0 ? 2 : bcur - 1; HG_STASH(S0, S1, S2, S3, SV, bst_); } \
        bcur = bcur == 2 ? 0 : bcur + 1; \
        __syncthreads(); } while (0)
    int bcur = 0;
    for (int n = 0; n < NCH; n += 2) {
        HG_ITER(n, gB0, gB1, gB2, gB3, gBv, gA0, gA1, gA2, gA3, gAv);
        HG_ITER(n + 1, gA0, gA1, gA2, gA3, gAv, gB0, gB1, gB2, gB3, gBv);
    }
    if (wave >= 4) { HG_OUT_STAGE(NCH); }
    __syncthreads();
#undef HG_MFMA_STAGE
#undef HG_OUT_STAGE
#undef HG_ITER
#undef HG_LOAD
#undef HG_STASH
#undef HG_RD64
}

__device__ __forceinline__ bool in_range(int lo, int hi, int k) { asm volatile("" : "+s"(lo), "+s"(hi)); return lo <= k && k < hi; }
constexpr int NPHASES = 21;
__global__ void __launch_bounds__(NTHR, 2) fwd_kernel(Args args) {
    extern __shared__ __attribute__((aligned(16))) unsigned char lds_raw[];
    LAS unsigned char* lds = (LAS unsigned char*)lds_raw;
    const int G = gridDim.x;
#define FRESH() int tid = threadIdx.x; asm volatile("" : "+v"(tid)); const int lane = tid & 63, wave = __builtin_amdgcn_readfirstlane(tid >> 6); (void)lane; (void)wave
    unsigned char* ws = args.ws;
    if (threadIdx.x < 16) ((LAS unsigned*)(lds + LDS_BAR_OFF))[threadIdx.x] = 0u;
    __syncthreads();
    XcdBarrier bar = xcd_barrier_post((unsigned*)(ws + WS_CTL), (volatile LAS unsigned*)(lds + LDS_BAR_OFF));
    const int lo = args.ph_lo, hi = args.ph_hi;
#define IN(k) in_range(lo, hi, (k))
#define NREP(k) (((PROBE_MASK >> (k)) & 1u) ? 2 : 1)
#define REPEAT(k) for (int rep_ = 0; rep_ < NREP(k); ++rep_) if (rep_ == 0 || (xcd_barrier(bar), true))
#define SEAM(k) do { if (IN(k) && IN((k) + 1)) xcd_barrier(bar); } while (0)
    bf16* const BX = (bf16*)(ws + WS_X); bf16* const BY = (bf16*)(ws + WS_Y);
    const float* const MODV = (const float*)(ws + WS_MODV);

#if defined(PROBE_BARS)
    for (int pbi = 0; pbi < PROBE_BARS; ++pbi) xcd_barrier(bar);
#endif
    if (IN(0)) REPEAT(0) { FRESH(); phase_prologue(args, lds, tid, lane, wave); } SEAM(0);
    if (IN(1)) REPEAT(1) { FRESH(); phase_mod0(args, lane, wave); } SEAM(1);
    if (IN(2)) REPEAT(2) {
        pg8::Gemm g{BX, (const bf16*)(ws + WS_WIN), NTOK, ZC, 1024}; pg8::AllOrder S; S.init(NTOK / 256, ZC / 256, G, (int)blockIdx.x);
        pg8::EpiBf16<0> E{(bf16*)(ws + WS_Z), ZC, nullptr, 0, 0, 1.f};
        pg8::gemm_phase<pg8::EpiBf16<0>, pg8::AllOrder, PG8_ALIGN, PG8_SP2>(lds, g, S, E);
    } SEAM(2);
    if (IN(3)) REPEAT(3) { FRESH(); phase_norm0(args, lane, wave); hgrn_prep_items(args, lds, tid); } SEAM(3);
    if (IN(4)) REPEAT(4) {
        { pg8::Gemm g{(const bf16*)(ws + WS_CQN), (const bf16*)(ws + WS_WUQ), NTOK, 768, 384}; pg8::LatOrder S; S.init(128, 3, G, (int)blockIdx.x);
          pg8::EpiBf16<0> E{(bf16*)(ws + WS_Q), 768, nullptr, 0, 0, 1.f};
          pg8::gemm_phase<pg8::EpiBf16<0>, pg8::LatOrder, PG8_ALIGN, PG8_SP2>(lds, g, S, E); }
        __syncthreads();
        { pg8::Gemm g{(const bf16*)(ws + WS_CKVN), (const bf16*)(ws + WS_WUKV), NTOK, 1024, 256}; pg8::AllOrder S; S.init(NTOK / 256, 4, G, (int)blockIdx.x);
          pg8::EpiBf16<0> E{(bf16*)(ws + WS_KV), 1024, nullptr, 0, 0, 1.f};
          pg8::gemm_phase<pg8::EpiBf16<0>, pg8::AllOrder, PG8_ALIGN, PG8_SP2>(lds, g, S, E); }
    } SEAM(4);
    if (IN(5)) {
        REPEAT(21) { FRESH();
        for (int u = blockIdx.x; u < 256; u += G) { __syncthreads(); hgrn_unit_mfma(args, (G == 256) ? ((u & 7) * 32 + (u >> 3)) : u, lds, tid); } }
        const bf16* Q = (const bf16*)(ws + WS_Q); const bf16* KV = (const bf16*)(ws + WS_KV); const bf16* KRR = (const bf16*)(ws + WS_KRR);
        const float* rope = (const float*)(ws + WS_ROPE);
        REPEAT(22) for (int u = blockIdx.x; u < 1024; u += G) {
            int b, h, qb; if (G == 256) { const int x = (int)blockIdx.x & 7, j = (int)blockIdx.x >> 3, pr = (u >> 8) * 16 + 2 * x + (j >> 4); b = pr >> 3; h = pr & 7; qb = j & 15; } else { b = u >> 7; h = (u >> 4) & 7; qb = u & 15; }
            const size_t kb = (size_t)b * TPB, q0 = kb + CTXL + (size_t)qb * 256;
            __syncthreads();
            att::attn_unit(Q + q0 * 768 + h * 96, KV + kb * 1024 + h * 64, KRR + kb * 32, BY + q0 * 1024 + h * 64, rope + (size_t)qb * 256 * 32, TPB, (char*)lds_raw);
        }
    } SEAM(5);
    if (IN(6)) REPEAT(6) { FRESH(); phase_readout(args, lane, wave); } SEAM(6);
    if (IN(7)) REPEAT(7) {
        pg8::Gemm g{BY, (const bf16*)(ws + WS_WOUT), NTOK, 1024, 1024}; pg8::LatOrder S; S.init(128, 4, G, (int)blockIdx.x);
        pg8::EpiRes E{args.in[I_X], (float*)(ws + WS_H), MODV, nullptr};
        pg8::gemm_phase<pg8::EpiRes, pg8::LatOrder, PG8_ALIGN, PG8_SP2>(lds, g, S, E);
    } SEAM(7);
    for (int l = 0; l < 2; ++l) {
        if (l == 1) {
            if (IN(13)) REPEAT(13) {
                pg8::Gemm g{BY, (const bf16*)(ws + WS_WPW1), NTOK, 2048, 1024}; pg8::LatOrder S; S.init(128, 8, G, (int)blockIdx.x);
                pg8::EpiGate<0> E{BX, (const float*)(ws + WS_PW1B), 8, 1.f, 1.f};
                pg8::gemm_phase<pg8::EpiGate<0>, pg8::LatOrder, PG8_ALIGN, PG8_SP2>(lds, g, S, E);
            } SEAM(13);
            if (IN(14)) REPEAT(14) { FRESH(); phase_conv(args, lds, tid, lane, wave); } SEAM(14);
            if (IN(15)) REPEAT(15) {
                pg8::Gemm g{BY, (const bf16*)(ws + WS_WPW2), NTOK, 1024, 1024}; pg8::LatOrder S; S.init(128, 4, G, (int)blockIdx.x);
                pg8::EpiRes E{nullptr, (float*)(ws + WS_H), MODV + 9 * 6144, args.in[I_PW2B]};
                pg8::gemm_phase<pg8::EpiRes, pg8::LatOrder, PG8_ALIGN, PG8_SP2>(lds, g, S, E);
            } SEAM(15);
        }
        const int pb = l ? 16 : 8;
        if (IN(pb)) REPEAT(pb) { FRESH(); phase_ln1(args, l, lds, tid, lane, wave); } SEAM(pb);
        if (IN(pb + 2) || IN(pb + 3)) {
            LAS int* tl = (LAS int*)(lds + LDS_TILE_E);
            FRESH();
            __syncthreads();
            if (tid < 32) tl[3 * MAXTILES + 64 + tid] = ld_ctl((const int*)(ws + WS_CURSOR) + l * 32 + tid);
            __syncthreads();
            if (tid == 0) { int ts = 0; for (int e = 0; e < 32; ++e) { tl[3 * MAXTILES + e] = ts; ts += (tl[3 * MAXTILES + 64 + e] + 255) >> 8; } tl[3 * MAXTILES + 32] = ts; }
            __syncthreads();
            const int ntiles = tl[3 * MAXTILES + 32];
            for (int t = tid; t < ntiles && t < MAXTILES; t += NTHR) { int e = 0; while (e < 31 && tl[3 * MAXTILES + e + 1] <= t) ++e; const int j = t - tl[3 * MAXTILES + e], rem = tl[3 * MAXTILES + 64 + e] - 256 * j;
                tl[t] = e; tl[MAXTILES + t] = e * ECAP + 256 * j; tl[2 * MAXTILES + t] = rem < 256 ? rem : 256; }
            __syncthreads();
            if (IN(pb + 2)) REPEAT(pb + 2) {
#if defined(PROBE_STAGGER)
                if (blockIdx.x & 1) { const unsigned long long t0 = __builtin_amdgcn_s_memrealtime(); while (__builtin_amdgcn_s_memrealtime() - t0 < PROBE_STAGGER) __builtin_amdgcn_s_sleep(8); }
#endif
                pg8::Gemm g{BX, (const bf16*)(ws + WS_WGU + (size_t)l * 32 * 2048 * 1024), 0, 0, 512};
                pg8::MoeOrder S; S.init(ntiles, 8, G, (int)blockIdx.x); S.tile_e = tl; S.nper = 8;
                pg8::EpiGate<1, true> E{(bf16*)(ws + WS_ACT), (const float*)(ws + WS_BGU) + (size_t)l * 32 * 2048, 8, 1.f / (SC_X8 * SC_WGU) * PROBE_KSC, SC_ACT};
                pg8::gemm_phase<pg8::EpiGate<1, true>, pg8::MoeOrder, PG8_ALIGN, true, true, true>(lds, g, S, E, (const int*)(ws + WS_ROWS), tl + MAXTILES);
            } SEAM(pb + 2);
            if (IN(pb + 3)) REPEAT(pb + 3) {
                pg8::Gemm g{(const bf16*)(ws + WS_ACT), (const bf16*)(ws + WS_WDN + (size_t)l * 32 * 1024 * 1024), 0, 0, 512};
                pg8::MoeOrder S; S.init(ntiles, 4, G, (int)blockIdx.x); S.tile_e = tl; S.nper = 4;
                pg8::EpiDown E{(bf16*)(ws + WS_YB), args.in[I_BDN] + (size_t)l * 32 * 1024, (const float*)(ws + WS_ROWW), (const int*)(ws + WS_ROWD), 1.f / (SC_ACT * SC_WDN) * PROBE_KSC, tl + MAXTILES, SC_Y};
                pg8::gemm_phase<pg8::EpiDown, pg8::MoeOrder, PG8_ALIGN, true, false, true>(lds, g, S, E);
            } SEAM(pb + 3);
        }
        if (IN(pb + 4)) REPEAT(pb + 4) { FRESH(); phase_ln2(args, l, lane, wave); }
        if (l == 0) SEAM(12);
    }
#undef IN
#undef SEAM
}

extern "C" void kernel_launch(void* const* d_in, const int* in_sizes, int n_in, void* d_out, int out_size, void* d_ws, size_t ws_size, hipStream_t stream) {
    static int grid = 0;
    if (grid == 0) {
        if (n_in != 33 || in_sizes[0] != NB * SEQ * D || out_size != NB * SEQ * D || ws_size < WS_END) {
            fprintf(stderr, "kernel_launch: unexpected shapes: n_in %d in0 %d out %d ws %zu (need %zu)\n", n_in, n_in > 0 ? in_sizes[0] : -1, out_size, ws_size, (size_t)WS_END); grid = -1; return; }
        int dev = 0, cus = 0;
        if (hipGetDevice(&dev) != hipSuccess || hipDeviceGetAttribute(&cus, hipDeviceAttributeMultiprocessorCount, dev) != hipSuccess) { grid = -1; return; }
        if (hipFuncSetAttribute((const void*)fwd_kernel, hipFuncAttributeMaxDynamicSharedMemorySize, LDS_BYTES) != hipSuccess) { fprintf(stderr, "kernel_launch: hipFuncSetAttribute failed\n"); grid = -1; return; }
        int per_cu = 0;
        if (hipOccupancyMaxActiveBlocksPerMultiprocessor(&per_cu, (const void*)fwd_kernel, NTHR, LDS_BYTES) != hipSuccess || per_cu < 1) fprintf(stderr, "kernel_launch: occupancy query reports %d\n", per_cu);
        (void)hipGetLastError();
        grid = cus;
    }
    if (grid < 0) return;
    if (hipMemsetAsync((char*)d_ws + WS_CTL, 0, CTL_ZERO_BYTES, stream) != hipSuccess) return;
    Args a{};
    for (int i = 0; i < 33; ++i) a.in[i] = (const float*)d_in[i];
    a.out = (float*)d_out; a.ws = (unsigned char*)d_ws;
#if MK_ONE_LAUNCH
    a.ph_lo = 0; a.ph_hi = NPHASES;
    hipLaunchKernelGGL(fwd_kernel, dim3(grid), dim3(NTHR), LDS_BYTES, stream, a);
#else
    for (int ph = 0; ph < NPHASES; ++ph) { a.ph_lo = ph; a.ph_hi = ph + 1; hipLaunchKernelGGL(fwd_kernel, dim3(grid), dim3(NTHR), LDS_BYTES, stream, a); }
#endif
    const hipError_t le = hipPeekAtLastError();
    if (le != hipSuccess) fprintf(stderr, "kernel_launch: launch failed: %s\n", hipGetErrorName(le));
}
```

```cpp
#include <hip/hip_runtime.h>
#include <cstdio>
#include <cstdint>

#ifndef PROBE_MASK
#define PROBE_MASK 0u
#endif
#if defined(PROBE_K2)
#define PROBE_KSC 0.5f
#else
#define PROBE_KSC 1.0f
#endif
#ifndef MK_ONE_LAUNCH
#define MK_ONE_LAUNCH 1
#endif

namespace pg8 {
#define PG8_LAS __attribute__((address_space(3)))
typedef unsigned short bf16_t;
typedef short bf16x8 __attribute__((ext_vector_type(8)));
typedef float f32x4 __attribute__((ext_vector_type(4)));
typedef unsigned u32x4 __attribute__((ext_vector_type(4)));
constexpr int BM = 256, BK = 64, HALF = 128, HTB = HALF * BK * 2  , STAGE_BYTES = 8 * HTB, NXCD = 8, WGM = 8;

__host__ __device__ __forceinline__ int lds_byte(int r, int c) { const int st = (r >> 4) * 2 + (c >> 5), rr = r & 15, cc = c & 31, ob = rr * 64 + cc * 2; return st * 1024 + (ob ^ (((ob >> 9) & 1) << 5)); }
__host__ __device__ __forceinline__ void stage_rc(int b, int& R, int& C) { const int st = b / 1024, sb = b % 1024, swz = sb ^ (((sb >> 9) & 1) << 5); R = (st >> 1) * 16 + swz / 64; C = (st & 1) * 32 + (swz % 64) / 2; }
__host__ __device__ __forceinline__ int perm32(int rho) { const int n = rho >> 4, i = rho & 15; return 8 * (i >> 2) + 4 * n + (i & 3); }

struct Unit { int pm, pn; };
struct Gemm { const bf16_t* A; const bf16_t* Bt; int M, N, K; };

struct StaticOrder {
    int nM, nN, nwg, G, c;
    __host__ __device__ void init(int M, int N, int G_, int c_) { nM = M / BM; nN = N / BM; nwg = nM * nN; G = G_; c = c_; }
    __host__ __device__ bool next(int i, Unit& u) const {
        const long L = (long)i * G + c; if (L >= nwg) return false;
        int wgid = (int)L; { const int q = nwg / NXCD, r = nwg % NXCD, xcd = wgid % NXCD, off = wgid / NXCD; wgid = (xcd < r ? xcd * (q + 1) : r * (q + 1) + (xcd - r) * q) + off; }
        const int nig = WGM * nN, gid = wgid / nig, fm = gid * WGM, gsz = (nM - fm) < WGM ? (nM - fm) : WGM;
        u.pm = fm + ((wgid % nig) % gsz); u.pn = (wgid % nig) / gsz; return true;
    }
    __device__ __forceinline__ void a_ready(const Unit&) const {}
    __device__ __forceinline__ void done(const Unit&) const {}
};

__device__ __forceinline__ unsigned cvt_pk_bf16(float lo, float hi) { unsigned r; asm volatile("v_cvt_pk_bf16_f32 %0, %1, %2" : "=v"(r) : "v"(lo), "v"(hi)); return r; }
typedef float f32x2 __attribute__((ext_vector_type(2)));
__device__ __forceinline__ f32x2 gelu_pk(f32x2 v) {
    const f32x2 av = __builtin_elementwise_abs(v), d = av * 0.2316418882f + 1.0f;
    f32x2 t; t.x = __builtin_amdgcn_rcpf(d.x); t.y = __builtin_amdgcn_rcpf(d.y);
    f32x2 q = t * 0.5307027145f + (-0.7265760135f); q = q * t + 0.7107068705f; q = q * t + (-0.142248368f); q = q * t + 0.127414796f; q = q * t;
    const f32x2 s = (v * v) * (-0.72134752044f);
    f32x2 e; e.x = __builtin_amdgcn_exp2f(s.x); e.y = __builtin_amdgcn_exp2f(s.y);
    const f32x2 m = v * (q * e), r = v - m;
    f32x2 o; o.x = v.x < 0.f ? m.x : r.x; o.y = v.y < 0.f ? m.y : r.y; return o;
}

template <int ACT  > struct EpiBf16 {
    static constexpr bool PERM = true, AFTER_DRAIN = false; static_assert(ACT == 0 || ACT == 1, "EpiBf16: ACT is 0 (none) or 1 (gelu_pk)");
    bf16_t* O; int ldc; const float* bias; int split_cols; size_t split_stride; float scale0;
    __device__ __forceinline__ void operator()(const f32x4 (&acc)[2][2][4][2], const Unit& u, int wr, int wc, int fr, int fq) const {
        const int row0 = u.pm * BM + wr * 64 + fr; int colt = u.pn * BM; bf16_t* base = O;
        float sc = 1.f; if (split_cols) { const int t = colt / split_cols; base += (size_t)t * split_stride; colt -= t * split_cols; if (t == 0) sc = scale0; }
        const int col0 = colt + wc * 32 + 8 * fq, bcol0 = u.pn * BM + wc * 32 + 8 * fq;
        f32x4 bv[2][2];
#pragma unroll
        for (int bj = 0; bj < 2; ++bj)
#pragma unroll
            for (int n = 0; n < 2; ++n) bv[bj][n] = bias ? *(const f32x4*)(bias + bcol0 + bj * HALF + 4 * n) : (f32x4){0.f, 0.f, 0.f, 0.f};
#pragma unroll
        for (int ai = 0; ai < 2; ++ai)
#pragma unroll
            for (int m = 0; m < 4; ++m) { bf16_t* rowp = base + (size_t)(row0 + ai * HALF + m * 16) * ldc + col0;
#pragma unroll
                for (int bj = 0; bj < 2; ++bj) { f32x4 v0 = acc[ai][bj][m][0] + bv[bj][0], v1 = acc[ai][bj][m][1] + bv[bj][1];
                    if (ACT == 1) { f32x2 a = gelu_pk((f32x2){v0[0], v0[1]}), b = gelu_pk((f32x2){v0[2], v0[3]}), c = gelu_pk((f32x2){v1[0], v1[1]}), d = gelu_pk((f32x2){v1[2], v1[3]});
                        v0 = (f32x4){a.x, a.y, b.x, b.y}; v1 = (f32x4){c.x, c.y, d.x, d.y}; }
                    v0 = v0 * sc; v1 = v1 * sc; u32x4 w; w.x = cvt_pk_bf16(v0[0], v0[1]); w.y = cvt_pk_bf16(v0[2], v0[3]); w.z = cvt_pk_bf16(v1[0], v1[1]); w.w = cvt_pk_bf16(v1[2], v1[3]);
                    *(u32x4*)(rowp + bj * HALF) = w; } }
    }
};
typedef int v4i_t __attribute__((ext_vector_type(4)));
typedef int v8i_t __attribute__((ext_vector_type(8)));
__device__ __forceinline__ v8i_t cat32(bf16x8 a, bf16x8 b) { const v4i_t x = __builtin_bit_cast(v4i_t, a), y = __builtin_bit_cast(v4i_t, b); return __builtin_shufflevector(x, y, 0, 1, 2, 3, 4, 5, 6, 7); }
template <class Epi, class Sched, bool ALIGN_EPI = false, bool SP2 = false, bool GATHER = false, bool FP8 = false>
__device__ __forceinline__ void gemm_phase(PG8_LAS unsigned char* lds, const Gemm g, const Sched& S, const Epi& E, const int* rowsrc = nullptr, const PG8_LAS int* gtab = nullptr) {
    static_assert(!GATHER || SP2, "GATHER is implemented on the SP2 loop only");
    int tid_l = threadIdx.x; asm volatile("" : "+v"(tid_l));
    const int tid = tid_l, wid = __builtin_amdgcn_readfirstlane(tid >> 6), lane = tid & 63, wr = wid >> 2, wc = wid & 3, fr = lane & 15, fq = lane >> 4;
#if defined(PROBE_K2)
    const int K = g.K, nt0 = K / BK, nt = FP8 ? 2 * nt0 : nt0;
#define PG8_KT(x) (FP8 ? ((x) & (nt0 - 1)) : (x))
#else
    const int K = g.K, nt = K / BK;
#define PG8_KT(x) (x)
#endif
    unsigned voffA[2], voffB[2];
#pragma unroll
    for (int i = 0; i < 2; ++i) { int R, C; stage_rc(tid * 16 + i * 8192, R, C); const int Rb = Epi::PERM ? ((R & ~31) + perm32(R & 31)) : R;
        voffA[i] = (unsigned)(R * K + C) * 2u; voffB[i] = (unsigned)(Rb * K + C) * 2u; }
    unsigned gAc[2][2], gAn[2][2]; int gR[2]; unsigned gC[2];
#pragma unroll
    for (int i = 0; i < 2; ++i) { int R, C; stage_rc(tid * 16 + i * 8192, R, C); gR[i] = R; gC[i] = (unsigned)C * 2u; gAc[0][i] = gAc[1][i] = gAn[0][i] = gAn[1][i] = 0u; }
#define PG8_GATHER(u_, o_) do { const int gtb_ = gtab[(u_).pm], gtc_ = gtab[576 + (u_).pm];     \
        _Pragma("unroll") for (int h_ = 0; h_ < 2; ++h_) _Pragma("unroll") for (int i_ = 0; i_ < 2; ++i_) \
        { const int rl_ = h_ * HALF + gR[i_]; const int src_ = rl_ < gtc_ ? rowsrc[gtb_ + rl_] : 0; o_[h_][i_] = (unsigned)src_ * (unsigned)(K * 2) + gC[i_]; } } while (0)
#define PG8_STAGE_A(bufoff, orig_gbase, NEXTSEL, H, KOFF) do { if constexpr (GATHER) { unsigned vo_[2]; vo_[0] = (NEXTSEL) ? gAn[H][0] : gAc[H][0]; vo_[1] = (NEXTSEL) ? gAn[H][1] : gAc[H][1]; \
        PG8_STAGE(bufoff, (const char*)g.A + (KOFF), vo_); } else { PG8_STAGE(bufoff, orig_gbase, voffA); } } while (0)
    const size_t kstep = (size_t)(BK * 2);
    const size_t hstep = (size_t)HALF * K * 2;
    const size_t tstep = 2 * hstep;
    const unsigned ldsw = (unsigned)wid * 1024u;
    const int aoff = lds_byte(wr * 64 + fr, fq * (FP8 ? 16 : 8)), boff = lds_byte(wc * 32 + fr, fq * (FP8 ? 16 : 8));
#define PG8_SA(b, h) (((b) * 2 + (h)) * HTB)
#define PG8_SB(b, h) ((4 + (b) * 2 + (h)) * HTB)
#define PG8_STAGE(bufoff, gbase, voff) do { _Pragma("unroll") for (int _i = 0; _i < 2; ++_i) \
        __builtin_amdgcn_global_load_lds((const unsigned*)((const char*)(gbase) + (voff)[_i]), (PG8_LAS unsigned*)(lds + (bufoff) + ldsw + _i * 8192), 16, 0, 0); } while (0)
#define PG8_LD32(var, addr) do { const bf16x8 lo_ = *(const PG8_LAS bf16x8*)(addr); const bf16x8 hi_ = *(const PG8_LAS bf16x8*)((addr) + 16); var = cat32(lo_, hi_); } while (0)
#define PG8_LDA(dst, b, h) do { if constexpr (FP8) { _Pragma("unroll") for (int m = 0; m < 4; ++m) PG8_LD32(dst##8[m], lds + PG8_SA(b, h) + aoff + m * 2048); } \
        else { _Pragma("unroll") for (int m = 0; m < 4; ++m) _Pragma("unroll") for (int k = 0; k < 2; ++k) dst[m][k] = *(const PG8_LAS bf16x8*)(lds + PG8_SA(b, h) + aoff + m * 2048 + k * 1024); } } while (0)
#define PG8_LDB(dst, b, h) do { if constexpr (FP8) { _Pragma("unroll") for (int n = 0; n < 2; ++n) PG8_LD32(dst##8[n], lds + PG8_SB(b, h) + boff + n * 2048); } \
        else { _Pragma("unroll") for (int n = 0; n < 2; ++n) _Pragma("unroll") for (int k = 0; k < 2; ++k) dst[n][k] = *(const PG8_LAS bf16x8*)(lds + PG8_SB(b, h) + boff + n * 2048 + k * 1024); } } while (0)
#define PG8_MMA(ai, bj, At, Bt) do { __builtin_amdgcn_s_setprio(1); \
        if constexpr (FP8) { _Pragma("unroll") for (int m = 0; m < 4; ++m) _Pragma("unroll") for (int n = 0; n < 2; ++n) \
            asm volatile("v_mfma_scale_f32_16x16x128_f8f6f4 %0, %1, %2, %0, %3, %3 op_sel_hi:[0,0,0]" : "+v"(acc[ai][bj][m][n]) : "v"(Bt##8[n]), "v"(At##8[m]), "v"(sc127)); } \
        else { _Pragma("unroll") for (int m = 0; m < 4; ++m) _Pragma("unroll") for (int n = 0; n < 2; ++n) _Pragma("unroll") for (int k = 0; k < 2; ++k) \
            acc[ai][bj][m][n] = __builtin_amdgcn_mfma_f32_16x16x32_bf16(Bt[n][k], At[m][k], acc[ai][bj][m][n], 0, 0, 0); } \
        __builtin_amdgcn_s_setprio(0); } while (0)
#define PG8_WAIT_V(n) asm volatile("s_waitcnt vmcnt(" #n ")" ::: "memory")
#define PG8_WAIT_L(n) asm volatile("s_waitcnt lgkmcnt(" #n ")" ::: "memory")
#define PG8_BAR __builtin_amdgcn_s_barrier()
#define PG8_SCHED __builtin_amdgcn_sched_barrier(0)
    Unit cur, nxt; int ui = 0;
    if (!S.next(0, cur)) return;
    f32x4 acc[2][2][4][2];
#pragma unroll
    for (int a = 0; a < 2; ++a)
#pragma unroll
        for (int b = 0; b < 2; ++b)
#pragma unroll
            for (int m = 0; m < 4; ++m)
#pragma unroll
                for (int n = 0; n < 2; ++n) acc[a][b][m][n] = (f32x4){0.f, 0.f, 0.f, 0.f};
    int sc127 = 0x7f7f7f7f; asm volatile("" : "+v"(sc127));
    bf16x8 At[4][2], B0[2][2], B1[2][2]; v8i_t At8[4], B08[2], B18[2]; (void)At; (void)B0; (void)B1; (void)At8; (void)B08; (void)B18;
    const char* cA = (const char*)g.A + (size_t)cur.pm * tstep; const char* cB = (const char*)g.Bt + (size_t)cur.pn * tstep;
    S.a_ready(cur);
    if constexpr (GATHER) { PG8_GATHER(cur, gAc); }
    if constexpr (SP2) {
        PG8_STAGE(PG8_SB(0, 0), cB, voffB); PG8_STAGE(PG8_SB(0, 1), cB + hstep, voffB); PG8_STAGE_A(PG8_SA(0, 0), cA, false, 0, (size_t)0); PG8_STAGE_A(PG8_SA(0, 1), cA + hstep, false, 1, (size_t)0);
        if (wr == 1) PG8_BAR;
        PG8_WAIT_V(2); PG8_BAR;
        PG8_STAGE(PG8_SB(1, 0), cB + kstep, voffB); PG8_STAGE_A(PG8_SA(1, 0), cA + kstep, false, 0, kstep); PG8_STAGE(PG8_SB(1, 1), cB + hstep + kstep, voffB);
        PG8_WAIT_V(6); PG8_BAR;
    } else {
        PG8_STAGE(PG8_SB(0, 0), cB, voffB); PG8_STAGE(PG8_SA(0, 0), cA, voffA); PG8_STAGE(PG8_SB(0, 1), cB + hstep, voffB); PG8_STAGE(PG8_SA(0, 1), cA + hstep, voffA);
        if (wr == 1) PG8_BAR;
        PG8_WAIT_V(4); PG8_BAR;
        PG8_STAGE(PG8_SB(1, 0), cB + kstep, voffB); PG8_STAGE(PG8_SA(1, 0), cA + kstep, voffA); PG8_STAGE(PG8_SB(1, 1), cB + hstep + kstep, voffB);
        PG8_WAIT_V(6); PG8_BAR;
    }
    for (;;) {
        const bool has_next = S.next(ui + 1, nxt);
        if constexpr (GATHER) { if (has_next) { PG8_GATHER(nxt, gAn); } else { _Pragma("unroll") for (int h_ = 0; h_ < 2; ++h_) _Pragma("unroll") for (int i_ = 0; i_ < 2; ++i_) gAn[h_][i_] = gAc[h_][i_]; } }
        const char* nA = has_next ? (const char*)g.A + (size_t)nxt.pm * tstep : cA; const char* nB = has_next ? (const char*)g.Bt + (size_t)nxt.pn * tstep : cB;
#pragma nounroll
        for (int t = 0; t < nt; t += 2) {
            const bool last = (t == nt - 2);
            const char* a1 = cA + (size_t)PG8_KT(t + 1) * kstep;
            const char* a2 = last ? nA : cA + (size_t)PG8_KT(t + 2) * kstep; const char* b2 = last ? nB : cB + (size_t)PG8_KT(t + 2) * kstep;
            const char* a3 = a2 + kstep; const char* b3 = b2 + kstep;
            const size_t k1 = (size_t)PG8_KT(t + 1) * kstep, k2 = last ? (size_t)0 : (size_t)PG8_KT(t + 2) * kstep, k3 = k2 + kstep; (void)k1; (void)k2; (void)k3;
            if (last && has_next) S.a_ready(nxt);
            if constexpr (SP2) {
            PG8_LDB(B0, 0, 0); PG8_LDB(B1, 0, 1); PG8_SCHED; PG8_LDA(At, 0, 0); PG8_STAGE_A(PG8_SA(1, 1), a1 + hstep, false, 1, k1);
            PG8_WAIT_V(8); PG8_WAIT_L(0); PG8_BAR; PG8_MMA(0, 0, At, B0); PG8_MMA(0, 1, At, B1); PG8_BAR; PG8_SCHED;
            PG8_LDA(At, 0, 1); PG8_STAGE(PG8_SB(0, 0), b2, voffB); PG8_STAGE(PG8_SB(0, 1), b2 + hstep, voffB); PG8_STAGE_A(PG8_SA(0, 0), a2, last, 0, k2);
            PG8_WAIT_V(8); PG8_WAIT_L(0); PG8_BAR; PG8_MMA(1, 0, At, B0); PG8_MMA(1, 1, At, B1); PG8_BAR; PG8_SCHED;
            PG8_LDB(B0, 1, 0); PG8_LDB(B1, 1, 1); PG8_SCHED; PG8_LDA(At, 1, 0); PG8_STAGE_A(PG8_SA(0, 1), a2 + hstep, last, 1, k2);
            PG8_WAIT_V(8); PG8_WAIT_L(0); PG8_BAR; PG8_MMA(0, 0, At, B0); PG8_MMA(0, 1, At, B1); PG8_BAR; PG8_SCHED;
            PG8_LDA(At, 1, 1); PG8_STAGE(PG8_SB(1, 0), b3, voffB); PG8_STAGE(PG8_SB(1, 1), b3 + hstep, voffB); PG8_STAGE_A(PG8_SA(1, 0), a3, last, 0, k3);
            PG8_WAIT_V(8); PG8_WAIT_L(0); PG8_BAR; PG8_MMA(1, 0, At, B0); PG8_MMA(1, 1, At, B1); PG8_BAR; PG8_SCHED;
            } else {
            PG8_LDB(B0, 0, 0); PG8_SCHED; PG8_LDA(At, 0, 0); PG8_STAGE(PG8_SA(1, 1), a1 + hstep, voffA);
            PG8_WAIT_L(8); PG8_BAR; PG8_WAIT_L(0); PG8_MMA(0, 0, At, B0); PG8_BAR; PG8_SCHED;
            PG8_LDB(B1, 0, 1); PG8_STAGE(PG8_SB(0, 0), b2, voffB);
            PG8_BAR; PG8_WAIT_L(0); PG8_MMA(0, 1, At, B1); PG8_BAR;
            PG8_LDA(At, 0, 1); PG8_STAGE(PG8_SA(0, 0), a2, voffA);
            PG8_BAR; PG8_WAIT_L(0); PG8_MMA(1, 0, At, B0); PG8_BAR; PG8_SCHED;
            PG8_STAGE(PG8_SB(0, 1), b2 + hstep, voffB);
            PG8_WAIT_V(6); PG8_BAR; PG8_MMA(1, 1, At, B1); PG8_BAR;
            PG8_LDB(B0, 1, 0); PG8_SCHED; PG8_LDA(At, 1, 0); PG8_STAGE(PG8_SA(0, 1), a2 + hstep, voffA);
            PG8_WAIT_L(8); PG8_BAR; PG8_WAIT_L(0); PG8_MMA(0, 0, At, B0); PG8_BAR; PG8_SCHED;
            PG8_LDB(B1, 1, 1); PG8_STAGE(PG8_SB(1, 0), b3, voffB);
            PG8_BAR; PG8_WAIT_L(0); PG8_MMA(0, 1, At, B1); PG8_BAR;
            PG8_LDA(At, 1, 1); PG8_STAGE(PG8_SA(1, 0), a3, voffA);
            PG8_BAR; PG8_WAIT_L(0); PG8_MMA(1, 0, At, B0); PG8_BAR; PG8_SCHED;
            PG8_STAGE(PG8_SB(1, 1), b3 + hstep, voffB);
            PG8_WAIT_V(6); PG8_BAR; PG8_MMA(1, 1, At, B1); PG8_BAR;
            }
        }
        if constexpr (ALIGN_EPI) { if (wr == 0) PG8_BAR; }
        if constexpr (FP8) { asm volatile("s_nop 15\n\ts_nop 15" ::: "memory"); }
        if constexpr (!Epi::AFTER_DRAIN) { E(acc, cur, wr, wc, fr, fq);
#if defined(PROBE_EPI2)
            if constexpr (FP8) { E(acc, cur, wr, wc, fr, fq); }
#endif
            S.done(cur); }
        if (!has_next) break;
#pragma unroll
        for (int a = 0; a < 2; ++a)
#pragma unroll
            for (int b = 0; b < 2; ++b)
#pragma unroll
                for (int m = 0; m < 4; ++m)
#pragma unroll
                    for (int n = 0; n < 2; ++n) acc[a][b][m][n] = (f32x4){0.f, 0.f, 0.f, 0.f};
        cur = nxt; cA = nA; cB = nB; ++ui;
        if constexpr (GATHER) { _Pragma("unroll") for (int h_ = 0; h_ < 2; ++h_) _Pragma("unroll") for (int i_ = 0; i_ < 2; ++i_) gAc[h_][i_] = gAn[h_][i_]; }
        if constexpr (ALIGN_EPI) { if (wr == 1) PG8_BAR; }
    }
    PG8_WAIT_V(0);
    if constexpr (!ALIGN_EPI) { if (wr == 0) PG8_BAR; }
    PG8_BAR;
    if constexpr (Epi::AFTER_DRAIN) { E.fused(acc, cur, wr, wc, fr, fq, lds, wid, lane); S.done(cur); }
#undef PG8_SA
#undef PG8_SB
#undef PG8_STAGE
#undef PG8_STAGE_A
#undef PG8_GATHER
#undef PG8_LDA
#undef PG8_LD32
#undef PG8_LDB
#undef PG8_MMA
#undef PG8_WAIT_V
#undef PG8_WAIT_L
#undef PG8_BAR
#undef PG8_SCHED
}
}

#ifndef PG8_SP2
#define PG8_SP2 true
#endif
#ifndef PG8_ALIGN
#define PG8_ALIGN true
#endif

#define GAS __attribute__((address_space(1)))
#define LAS __attribute__((address_space(3)))
typedef unsigned short bf16;
typedef unsigned v4u __attribute__((ext_vector_type(4)));
typedef unsigned v2u __attribute__((ext_vector_type(2)));
typedef float f32x4 __attribute__((ext_vector_type(4)));
typedef short bf16x8 __attribute__((ext_vector_type(8)));

constexpr int D = 1024, NB = 8, SEQ = 4096, CTXL = 256, TPB = SEQ + CTXL, NTOK = NB * TPB, NLAT = NB * SEQ;
constexpr int ZC = 3328;
constexpr int ZQ = 0, ZKV = 384, ZKR = 640, ZHQ = 672, ZHF = 1184, ZHB = 1696, ZHI = 2208, ZHG = 2720;
constexpr int NEXP = 32;
constexpr float ALPHA = 1.4142135623730951f;
constexpr float LN_EPS = 1e-5f, RMS_EPS = 1e-6f;
constexpr int NWAVES = 8, NTHR = 512;
constexpr float SC_X8 = 16.f, SC_WGU = 64.f, SC_ACT = 8.f, SC_WDN = 128.f, SC_Y = 64.f;
constexpr int LDS_BYTES = 147456;
constexpr int LDS_BAR_OFF = LDS_BYTES - 64;
constexpr int LDS_TILE_E = 131072;
constexpr int MAXTILES = 576;

constexpr size_t MiB = 1u << 20;
constexpr size_t WS_CTL = 0, CTL_ZERO_BYTES = 16384;
constexpr size_t WS_MODV = 1 * MiB;
constexpr size_t WS_ROPE = 1 * MiB + 512 * 1024;
constexpr size_t WS_BGU = 2 * MiB;
constexpr size_t WS_PW1B = 2 * MiB + 512 * 1024;
constexpr size_t WS_BCNT = WS_PW1B + 64 * 1024;
constexpr size_t WS_TILEE = WS_BCNT + 64 * 1024;
constexpr size_t WS_META = WS_TILEE + 4096;
constexpr size_t WS_TOPI = 3 * MiB, WS_TOPW = 4 * MiB;
constexpr int ECAP = 32768;
constexpr size_t WS_ROWS = 160 * MiB, WS_ROWW = 164 * MiB, WS_ROWD = 168 * MiB;
constexpr size_t WS_CURSOR = 14336;
constexpr size_t WS_WIN = 8 * MiB, WS_WUQ = 15 * MiB, WS_WUKV = 16 * MiB, WS_WOUT = 17 * MiB, WS_WPW1 = 19 * MiB, WS_WPW2 = 23 * MiB;
constexpr size_t WS_WGU = 32 * MiB, WS_WDN = 288 * MiB;
constexpr size_t WS_H = 416 * MiB;
constexpr size_t WS_X = 552 * MiB, WS_Y = 620 * MiB;
constexpr size_t WS_BIG = 688 * MiB;
constexpr size_t WS_Z = WS_BIG, WS_CQN = WS_BIG + 221 * MiB, WS_CKVN = WS_BIG + 247 * MiB, WS_KRR = WS_BIG + 264 * MiB,
                 WS_Q = WS_BIG + 267 * MiB, WS_KV = WS_BIG + 318 * MiB, WS_OF = WS_BIG + 386 * MiB, WS_OB = WS_BIG + 454 * MiB;
constexpr size_t WS_HT = WS_BIG + 528 * MiB;
constexpr size_t WS_XS = WS_BIG, WS_ACT = WS_BIG + 288 * MiB, WS_YB = WS_BIG + 576 * MiB;
constexpr size_t WS_END = WS_BIG + 848 * MiB;
static_assert((size_t)NTOK * ZC * 2 <= 221 * MiB && (size_t)NTOK * 384 * 2 <= 26 * MiB && (size_t)NTOK * 256 * 2 <= 17 * MiB && (size_t)NTOK * 32 * 2 <= 3 * MiB, "ws map 1");
static_assert((size_t)NTOK * 768 * 2 <= 51 * MiB && (size_t)NTOK * 1024 * 2 <= 68 * MiB && (size_t)NTOK * 512 * 4 <= 68 * MiB, "ws map 2");
static_assert((size_t)64 * 136 * 26624 <= 320 * MiB && (size_t)MAXTILES * 256 * 2048 <= 288 * MiB && (size_t)NLAT * 4 * 2048 <= 272 * MiB && (size_t)NTOK * 1024 * 4 <= 136 * MiB, "ws map 3");

#define LDS_WAIT() asm volatile("s_waitcnt lgkmcnt(0)" ::: "memory")
#define VM_WAIT() asm volatile("s_waitcnt vmcnt(0)" ::: "memory")
__device__ __forceinline__ float bf2f(unsigned short b) { return __uint_as_float(((unsigned)b) << 16); }
__device__ __forceinline__ unsigned pk2(float lo, float hi) { return pg8::cvt_pk_bf16(lo, hi); }
__device__ __forceinline__ float sigm(float x) { return __builtin_amdgcn_rcpf(1.f + __expf(-x)); }
__device__ __forceinline__ float wave_sum(float v) {
#pragma unroll
    for (int o = 1; o < 64; o <<= 1) v += __shfl_xor(v, o);
    return v;
}
__device__ __forceinline__ int ld_ctl(const int* p) { return (int)__hip_atomic_load((const unsigned*)p, __ATOMIC_RELAXED, __HIP_MEMORY_SCOPE_AGENT); }
__device__ __forceinline__ int grow_of(int lr) { return (lr >> 12) * TPB + CTXL + (lr & 4095); }

#define XB_TMO      128
#define XB_XCNT(j)  (256  + 64 * (j))
#define XB_XSUB(j)  (1280 + 64 * (j))
#define XB_XGEN(j)  (2304 + 64 * (j))
#define XB_TOP      3328
#define XB_TOPGEN   3392
#define XCD_BAR_WORDS 3456
#define XB_SPIN_CAP (1u << 21)

__device__ __forceinline__ unsigned xb_ld(unsigned* p)              { return __hip_atomic_load(p, __ATOMIC_RELAXED, __HIP_MEMORY_SCOPE_AGENT); }
__device__ __forceinline__ unsigned xb_add(unsigned* p, unsigned v) { return __hip_atomic_fetch_add(p, v, __ATOMIC_RELAXED, __HIP_MEMORY_SCOPE_AGENT); }
__device__ __forceinline__ unsigned xb_xcc_id() { return (unsigned)__builtin_amdgcn_s_getreg((3 << 11) | 20) & 0xFu; }
#define XB_SPIN(cond, bar) do { unsigned _sp = 0; while (cond) { __builtin_amdgcn_s_sleep(1); \
    if ((++_sp & 255u) == 0u) { if (xb_ld(&(bar)[XB_TMO])) break; if (_sp > XB_SPIN_CAP) { atomicAdd(&(bar)[XB_TMO], 1u); break; } } } } while (0)

struct XcdBarrier { unsigned* bar; unsigned x; volatile LAS unsigned* st; };

__device__ __forceinline__ XcdBarrier xcd_barrier_post(unsigned* bar, volatile LAS unsigned* st) {
    XcdBarrier b; b.bar = bar; b.x = xb_xcc_id(); b.st = st;
    if (threadIdx.x == 0) (void)xb_add(&bar[XB_XCNT(b.x)], 1u);
    return b;
}
__device__ __forceinline__ void xcd_barrier_complete(unsigned* bar, unsigned x, unsigned& nloc, unsigned& nx) {
    const unsigned G = gridDim.x * gridDim.y * gridDim.z;
    unsigned sum, cnt, mine, sp = 0u;
    for (;;) {
        sum = 0u; cnt = 0u; mine = 0u;
#pragma unroll
        for (unsigned j = 0; j < 16; ++j) { const unsigned c = xb_ld(&bar[XB_XCNT(j)]); sum += c; cnt += (c > 0u) ? 1u : 0u; mine = (j == x) ? c : mine; }
        if (sum == G) break;
        __builtin_amdgcn_s_sleep(1);
        if ((++sp & 255u) == 0u) { if (xb_ld(&bar[XB_TMO])) break; if (sp > XB_SPIN_CAP) { atomicAdd(&bar[XB_TMO], 1u); break; } }
    }
    nloc = mine > 0u ? mine : 1u; nx = cnt > 0u ? cnt : 1u;
}
__device__ __forceinline__ void xcd_barrier(const XcdBarrier& b) {
    asm volatile("s_waitcnt vmcnt(0)" ::: "memory");
    __syncthreads();
    if (threadIdx.x == 0) {
        unsigned* bar = b.bar;
        __builtin_amdgcn_s_waitcnt(0);
        unsigned nloc = b.st[0], nx = b.st[1];
        if (nloc == 0u) { xcd_barrier_complete(bar, b.x, nloc, nx); b.st[0] = nloc; b.st[1] = nx; }
        const unsigned old = xb_add(&bar[XB_XSUB(b.x)], 1u);
        const unsigned gen = old / nloc;
        if (old + 1u == (gen + 1u) * nloc) {
            __builtin_amdgcn_fence(__ATOMIC_RELEASE, "agent");
            asm volatile("s_waitcnt vmcnt(0)" ::: "memory");
            const unsigned og = xb_add(&bar[XB_TOP], 1u);
            const unsigned tg = og / nx;
            if (og + 1u == (tg + 1u) * nx) xb_add(&bar[XB_TOPGEN], 1u);
            else XB_SPIN(xb_ld(&bar[XB_TOPGEN]) == tg, bar);
            __builtin_amdgcn_fence(__ATOMIC_ACQUIRE, "agent");
            xb_add(&bar[XB_XGEN(b.x)], 1u);
            asm volatile("s_waitcnt vmcnt(0)" ::: "memory");
        } else {
            XB_SPIN(xb_ld(&bar[XB_XGEN(b.x)]) == gen, bar);
            __builtin_amdgcn_fence(__ATOMIC_ACQUIRE, "agent");
            asm volatile("s_waitcnt vmcnt(0)" ::: "memory");
        }
    }
    __syncthreads();
}

namespace pg8 {
struct TileOrder {
    int nM, nN, nwg, G, c;
    __device__ __forceinline__ void init(int nM_, int nN_, int G_, int c_) { nM = nM_; nN = nN_; nwg = nM * nN; G = G_; c = c_; }
    __device__ __forceinline__ bool logical(int i, int& im, int& in) const {
        const long L = (long)i * G + c; if (L >= nwg) return false;
        int wgid = (int)L; { const int q = nwg / NXCD, r = nwg % NXCD, xcd = wgid % NXCD, off = wgid / NXCD; wgid = (xcd < r ? xcd * (q + 1) : r * (q + 1) + (xcd - r) * q) + off; }
        const int nig = WGM * nN, gid = wgid / nig, fm = gid * WGM, gsz = (nM - fm) < WGM ? (nM - fm) : WGM;
        im = fm + ((wgid % nig) % gsz); in = (wgid % nig) / gsz; return true;
    }
    __device__ __forceinline__ void a_ready(const Unit&) const {}
    __device__ __forceinline__ void done(const Unit&) const {}
};
struct AllOrder : TileOrder { __device__ __forceinline__ bool next(int i, Unit& u) const { int im, in; if (!logical(i, im, in)) return false; u.pm = im; u.pn = in; return true; } };
struct LatOrder : TileOrder {
    __device__ __forceinline__ bool next(int i, Unit& u) const { int im, in; if (!logical(i, im, in)) return false; u.pm = (im >> 4) * 17 + 1 + (im & 15); u.pn = in; return true; } };
struct MoeOrder : TileOrder {
    const PG8_LAS int* tile_e; int nper;
    __device__ __forceinline__ bool next(int i, Unit& u) const { int im, in; if (!logical(i, im, in)) return false; u.pm = im; u.pn = tile_e[im] * nper + in; return true; } };

struct EpiRes {
    static constexpr bool PERM = false, AFTER_DRAIN = false;
    const float* xin; float* h; const float* modv; const float* bias;
    __device__ __forceinline__ void operator()(const f32x4 (&acc)[2][2][4][2], const Unit& u, int wr, int wc, int fr, int fq) const {
        asm volatile("" : "+v"(fr), "+v"(fq));
        const int b = u.pm / 17, j = u.pm % 17;
        const int rl0 = wr * 64 + fr, col0 = u.pn * BM + wc * 32 + 4 * fq;
        const float* gate = modv + (size_t)b * 6144 + 2048;
        f32x4 gv[2][2], bv[2][2];
#pragma unroll
        for (int bj = 0; bj < 2; ++bj)
#pragma unroll
            for (int n = 0; n < 2; ++n) { gv[bj][n] = *(const f32x4*)(gate + col0 + bj * HALF + n * 16); bv[bj][n] = bias ? *(const f32x4*)(bias + col0 + bj * HALF + n * 16) : (f32x4){0.f, 0.f, 0.f, 0.f}; }
#pragma unroll
        for (int ai = 0; ai < 2; ++ai)
#pragma unroll
            for (int m = 0; m < 4; ++m) { const int rl = rl0 + ai * HALF + m * 16; const size_t grow = (size_t)u.pm * BM + rl;
                const float* hin = xin ? xin + ((size_t)b * 4096 + (size_t)(j - 1) * 256 + rl) * 1024 + col0 : h + grow * 1024 + col0;
                float* ho = h + grow * 1024 + col0;
#pragma unroll
                for (int bj = 0; bj < 2; ++bj)
#pragma unroll
                    for (int n = 0; n < 2; ++n) { const f32x4 hv = *(const f32x4*)(hin + bj * HALF + n * 16);
                        *(f32x4*)(ho + bj * HALF + n * 16) = hv * 1.4142135623730951f + gv[bj][n] * (acc[ai][bj][m][n] + bv[bj][n]); } }
    }
};
template <int MODE, bool OUT8 = false> struct EpiGate {
    static constexpr bool PERM = true, AFTER_DRAIN = false;
    bf16_t* O; const float* bias; int nper; float ascale, oscale;
    __device__ __forceinline__ void operator()(const f32x4 (&acc)[2][2][4][2], const Unit& u, int wr, int wc, int fr, int fq) const {
        asm volatile("" : "+v"(fr), "+v"(fq));
        const int row0 = u.pm * BM + wr * 64 + fr, pnl = u.pn % nper, ocol0 = pnl * HALF + wc * 32 + 8 * fq, bcol0 = u.pn * BM + wc * 32 + 8 * fq;
        const float s0 = ascale, s1 = MODE == 1 ? ascale * oscale : ascale;
        f32x4 bv[2][2];
#pragma unroll
        for (int n = 0; n < 2; ++n) { bv[0][n] = *(const f32x4*)(bias + bcol0 + 4 * n); const f32x4 t = *(const f32x4*)(bias + bcol0 + HALF + 4 * n); bv[1][n] = MODE == 1 ? (t + 1.0f) * oscale : t; }
#pragma unroll
        for (int ai = 0; ai < 2; ++ai)
#pragma unroll
            for (int m = 0; m < 4; ++m) { bf16_t* rowp = O + (size_t)(row0 + ai * HALF + m * 16) * 1024 + ocol0;
                unsigned char* rowp8 = (unsigned char*)O + (size_t)(row0 + ai * HALF + m * 16) * 1024 + ocol0;
                float o[8];
#pragma unroll
                for (int n = 0; n < 2; ++n) { const f32x4 a = acc[ai][0][m][n] * s0 + bv[0][n], g = acc[ai][1][m][n] * s1 + bv[1][n];
#pragma unroll
                    for (int e = 0; e < 4; ++e) {
                        if (MODE == 0) { o[4 * n + e] = a[e] * __builtin_amdgcn_rcpf(1.f + __builtin_amdgcn_exp2f(g[e] * -1.4426950408889634f)); }
                        else { const float gt = fminf(a[e], 7.0f), up1 = __builtin_amdgcn_fmed3f(g[e], -6.0f * oscale, 8.0f * oscale);
                            o[4 * n + e] = up1 * (gt * __builtin_amdgcn_rcpf(1.f + __builtin_amdgcn_exp2f(gt * (-1.702f * 1.4426950408889634f)))); } } }
                if constexpr (OUT8) {
                    int w0 = 0, w1 = 0; w0 = __builtin_amdgcn_cvt_pk_fp8_f32(o[0], o[1], w0, false); w0 = __builtin_amdgcn_cvt_pk_fp8_f32(o[2], o[3], w0, true);
                    w1 = __builtin_amdgcn_cvt_pk_fp8_f32(o[4], o[5], w1, false); w1 = __builtin_amdgcn_cvt_pk_fp8_f32(o[6], o[7], w1, true);
                    typedef unsigned u32x2 __attribute__((ext_vector_type(2))); *(u32x2*)rowp8 = (u32x2){(unsigned)w0, (unsigned)w1}; (void)rowp;
                } else { (void)rowp8;
                u32x4 w; w.x = cvt_pk_bf16(o[0], o[1]); w.y = cvt_pk_bf16(o[2], o[3]); w.z = cvt_pk_bf16(o[4], o[5]); w.w = cvt_pk_bf16(o[6], o[7]);
                *(u32x4*)rowp = w; } }
    }
};
struct EpiDown {
    static constexpr bool PERM = true, AFTER_DRAIN = false;
    bf16_t* Y; const float* bias; const float* row_w; const int* row_dst; float ascale; const PG8_LAS int* gtab; float oscale;
    __device__ __forceinline__ void operator()(const f32x4 (&acc)[2][2][4][2], const Unit& u, int wr, int wc, int fr, int fq) const {
        asm volatile("" : "+v"(fr), "+v"(fq));
        const int pnl = u.pn & 3, ocol0 = pnl * BM + wc * 32 + 8 * fq, bcol0 = u.pn * BM + wc * 32 + 8 * fq; const int tbase = gtab[u.pm], tcnt = gtab[576 + u.pm];
        f32x4 bv[2][2];
#pragma unroll
        for (int bj = 0; bj < 2; ++bj)
#pragma unroll
            for (int n = 0; n < 2; ++n) bv[bj][n] = *(const f32x4*)(bias + bcol0 + bj * HALF + 4 * n);
#pragma unroll
        for (int ai = 0; ai < 2; ++ai)
#pragma unroll
            for (int m = 0; m < 4; ++m) { const int rl = wr * 64 + fr + ai * HALF + m * 16;
                if (rl < tcnt) { const int dst = row_dst[tbase + rl]; const float w8 = row_w[tbase + rl] * oscale; unsigned char* rowp = (unsigned char*)Y + (size_t)dst * 1024 + ocol0;
#pragma unroll
                    for (int bj = 0; bj < 2; ++bj) { const f32x4 v0 = (acc[ai][bj][m][0] * ascale + bv[bj][0]) * w8, v1 = (acc[ai][bj][m][1] * ascale + bv[bj][1]) * w8;
                        int w0 = 0, w1 = 0; w0 = __builtin_amdgcn_cvt_pk_fp8_f32(fminf(fmaxf(v0[0], -448.f), 448.f), fminf(fmaxf(v0[1], -448.f), 448.f), w0, false); w0 = __builtin_amdgcn_cvt_pk_fp8_f32(fminf(fmaxf(v0[2], -448.f), 448.f), fminf(fmaxf(v0[3], -448.f), 448.f), w0, true);
                        w1 = __builtin_amdgcn_cvt_pk_fp8_f32(fminf(fmaxf(v1[0], -448.f), 448.f), fminf(fmaxf(v1[1], -448.f), 448.f), w1, false); w1 = __builtin_amdgcn_cvt_pk_fp8_f32(fminf(fmaxf(v1[2], -448.f), 448.f), fminf(fmaxf(v1[3], -448.f), 448.f), w1, true);
                        typedef unsigned u32x2 __attribute__((ext_vector_type(2))); *(u32x2*)(rowp + bj * HALF) = (u32x2){(unsigned)w0, (unsigned)w1}; } } }
    }
};
}

namespace att {
using bf16x8 = __attribute__((ext_vector_type(8))) short;
using s16x4  = __attribute__((ext_vector_type(4))) short;
using f32x16 = __attribute__((ext_vector_type(16))) float;
using u32x4  = __attribute__((ext_vector_type(4))) unsigned;
constexpr int NW = 8, QBLK = 32, KVBLK = 64;
constexpr float SCALE = 0.10206207261596575f;
constexpr float THR = 8.f;
constexpr int SHM_V = 16384, SHM_K = 16384, NBUF = 3, SHM_ATTN = NBUF * SHM_V + NBUF * SHM_K + NW * 64 * 4;
#define KSWZ(row, colB) ((row) * 256 + ((colB) ^ (((row) & 7) << 4)))
#define SBAR() __builtin_amdgcn_sched_barrier(0)
__device__ __forceinline__ int crow(int r, int hi) { return (r & 3) + 8 * (r >> 2) + 4 * hi; }
__device__ __forceinline__ unsigned cvtpk(float lo, float hi) { unsigned r; asm volatile("v_cvt_pk_bf16_f32 %0, %1, %2" : "=v"(r) : "v"(lo), "v"(hi)); return r; }

__device__ __forceinline__ void partialSM(f32x16& p0, f32x16& p1, float& m_reg, float& mn, float& alpha) {
  constexpr float C = SCALE * 1.4426950408889634f;
  float pmax = p0[0];
#pragma unroll
  for (int r = 1; r < 16; ++r) pmax = fmaxf(pmax, p0[r]);
#pragma unroll
  for (int r = 0; r < 16; ++r) pmax = fmaxf(pmax, p1[r]);
  { auto rr = __builtin_amdgcn_permlane32_swap(__float_as_uint(pmax), __float_as_uint(pmax), false, false);
    pmax = fmaxf(__uint_as_float(rr[0]), __uint_as_float(rr[1])); }
  if (__builtin_expect(__all(pmax - m_reg <= THR / SCALE), 1)) { mn = m_reg; alpha = 1.f; }
  else { mn = fmaxf(m_reg, pmax); alpha = __builtin_amdgcn_exp2f((m_reg - mn) * C); m_reg = mn; }
  float mnC = -mn * C;
#pragma unroll
  for (int r = 0; r < 16; ++r) p0[r] = fmaf(p0[r], C, mnC);
#pragma unroll
  for (int r = 0; r < 16; ++r) p1[r] = fmaf(p1[r], C, mnC);
#pragma unroll
  for (int r = 0; r < 16; ++r) p0[r] = __builtin_amdgcn_exp2f(p0[r]);
}
__device__ __forceinline__ void finishSM(f32x16& p0, f32x16& p1, float alpha, float& l_reg, bf16x8& pa0, bf16x8& pa1, bf16x8& pa2, bf16x8& pa3) {
#pragma unroll
  for (int r = 0; r < 16; ++r) p1[r] = __builtin_amdgcn_exp2f(p1[r]);
  float ps = 0;
#pragma unroll
  for (int r = 0; r < 16; ++r) ps += p0[r];
#pragma unroll
  for (int r = 0; r < 16; ++r) ps += p1[r];
  { auto rr = __builtin_amdgcn_permlane32_swap(__float_as_uint(ps), __float_as_uint(ps), false, false);
    ps = __uint_as_float(rr[0]) + __uint_as_float(rr[1]); }
  l_reg = l_reg * alpha + ps;
#define PK4(P, BASE, OUT) do { unsigned a0 = cvtpk(P[BASE + 0], P[BASE + 1]), a1 = cvtpk(P[BASE + 2], P[BASE + 3]);   \
    unsigned b0 = cvtpk(P[BASE + 4], P[BASE + 5]), b1 = cvtpk(P[BASE + 6], P[BASE + 7]);                              \
    auto r0 = __builtin_amdgcn_permlane32_swap(a0, b0, false, false); auto r1 = __builtin_amdgcn_permlane32_swap(a1, b1, false, false); \
    u32x4 w = {r0[0], r1[0], r0[1], r1[1]}; OUT = *reinterpret_cast<bf16x8*>(&w); } while (0)
  PK4(p0, 0, pa0); PK4(p0, 8, pa1); PK4(p1, 0, pa2); PK4(p1, 8, pa3);
#undef PK4
}
__device__ __forceinline__ void qkt(f32x16& p0, f32x16& p1, const bf16* Ks, const bf16x8* qr, int r32, int hi) {
  p0 = f32x16{}; p1 = f32x16{};
#pragma unroll
  for (int d0 = 0; d0 < 6; ++d0) { int cb = (d0 * 16 + hi * 8) * 2;
    bf16x8 b0 = *reinterpret_cast<const bf16x8*>((const char*)Ks + KSWZ(r32, cb));
    bf16x8 b1 = *reinterpret_cast<const bf16x8*>((const char*)Ks + KSWZ(32 + r32, cb));
    p0 = __builtin_amdgcn_mfma_f32_32x32x16_bf16(b0, qr[d0], p0, 0, 0, 0);
    p1 = __builtin_amdgcn_mfma_f32_32x32x16_bf16(b1, qr[d0], p1, 0, 0, 0); }
}
__device__ __forceinline__ int v_st(int k, int c) { const int kk = (k & ~0xC) | ((k & 4) << 1) | ((k & 8) >> 1); return ((kk >> 3) * 4 + (c >> 5)) * 512 + ((kk & 7) * 32 + (c & 31)) * 2; }
__device__ __forceinline__ int v_rd_base(int lane) { return ((lane & 3) << 3) | (((lane >> 2) & 3) << 6) | (((lane >> 4) & 1) << 5) | (((lane >> 5) & 1) << 8); }
constexpr int v_rd_off(int d0, int ks, int half) { return d0 * 512 + ks * 4096 + half * 2048; }
template <int OFF> __device__ __forceinline__ s16x4 tr_read(int vb) {
  s16x4 r; asm volatile("ds_read_b64_tr_b16 %0, %1 offset:%2" : "=&v"(r) : "v"(vb), "i"(OFF) : "memory"); return r;
}
template <int D0> __device__ __forceinline__ void pv_one(f32x16& od, int vb, bf16x8 pa0, bf16x8 pa1, bf16x8 pa2, bf16x8 pa3) {
  const s16x4 l0 = tr_read<v_rd_off(D0, 0, 0)>(vb), h0 = tr_read<v_rd_off(D0, 0, 1)>(vb), l1 = tr_read<v_rd_off(D0, 1, 0)>(vb), h1 = tr_read<v_rd_off(D0, 1, 1)>(vb);
  const s16x4 l2 = tr_read<v_rd_off(D0, 2, 0)>(vb), h2 = tr_read<v_rd_off(D0, 2, 1)>(vb), l3 = tr_read<v_rd_off(D0, 3, 0)>(vb), h3 = tr_read<v_rd_off(D0, 3, 1)>(vb);
  asm volatile("s_waitcnt lgkmcnt(0)" ::: "memory"); SBAR();
#define PK(L, H) (bf16x8){L[0], L[1], L[2], L[3], H[0], H[1], H[2], H[3]}
  od = __builtin_amdgcn_mfma_f32_32x32x16_bf16(pa0, PK(l0, h0), od, 0, 0, 0);
  od = __builtin_amdgcn_mfma_f32_32x32x16_bf16(pa1, PK(l1, h1), od, 0, 0, 0);
  od = __builtin_amdgcn_mfma_f32_32x32x16_bf16(pa2, PK(l2, h2), od, 0, 0, 0);
  od = __builtin_amdgcn_mfma_f32_32x32x16_bf16(pa3, PK(l3, h3), od, 0, 0, 0);
#undef PK
}
__device__ __forceinline__ void pv_d0(f32x16* o, int vb, bf16x8 pa0, bf16x8 pa1, bf16x8 pa2, bf16x8 pa3) {
  pv_one<0>(o[0], vb, pa0, pa1, pa2, pa3); pv_one<1>(o[1], vb, pa0, pa1, pa2, pa3);
}
__device__ __forceinline__ bf16x8 rope8(bf16x8 x, const float* tab, int pbase) {
  u32x4 w;
#pragma unroll
  for (int i = 0; i < 4; ++i) { const float x1 = __uint_as_float(((unsigned)(unsigned short)x[2 * i]) << 16), x2 = __uint_as_float(((unsigned)(unsigned short)x[2 * i + 1]) << 16);
    const float cs = tab[pbase + i], sn = tab[16 + pbase + i]; w[i] = cvtpk(x1 * cs - x2 * sn, x1 * sn + x2 * cs); }
  return *reinterpret_cast<bf16x8*>(&w);
}
__device__ __forceinline__ void attn_unit(const bf16* __restrict__ Qb, const bf16* __restrict__ KVb, const bf16* __restrict__ KRb, bf16* __restrict__ Ob,
                                          const float* __restrict__ rope, int seq, char* lds) {
  int tid_l = threadIdx.x; asm volatile("" : "+v"(tid_l));
  const int tid = tid_l, wid = tid >> 6, lane = tid & 63, r32 = lane & 31, hi = lane >> 5;
  bf16* V_lds = (bf16*)lds; bf16* K_lds = (bf16*)(lds + NBUF * SHM_V);
  float* ws = (float*)(lds + NBUF * SHM_V + NBUF * SHM_K) + wid * 64; float* li_l = ws; float* al_l = ws + 32;
  float m_reg = -1e30f, l_reg = 0; f32x16 o[2] = {}; bf16x8 qr[6];
  const bf16* Qw = Qb + (long)(wid * QBLK + r32) * 768 + hi * 8;
#pragma unroll
  for (int d0 = 0; d0 < 6; ++d0) qr[d0] = *reinterpret_cast<const bf16x8*>(Qw + d0 * 16);
  if (rope) { const float* tab = rope + (long)(wid * QBLK + r32) * 32; qr[4] = rope8(qr[4], tab, 4 * hi); qr[5] = rope8(qr[5], tab, 8 + 4 * hi); }
  const int sr = tid >> 4, ch = tid & 15;
  const bf16* kbase = ch < 8 ? KVb + ch * 8 : KRb + ((ch - 8) & 3) * 8; const long kstr = ch < 8 ? 1024 : 32;
  const int vkey = tid >> 3, vc8 = (tid & 7) * 8, vst0 = v_st(vkey, vc8);
  const bf16* vbase = KVb + 512 + vc8;
  const int vb0 = (int)(uintptr_t)V_lds + v_rd_base(lane);
  struct { bf16x8 vs0, ks0, ks1; } sr_[2];
#define SLOAD(i, k0) do { sr_[i].vs0 = *reinterpret_cast<const bf16x8*>(vbase + (long)((k0) + vkey) * 1024); \
    sr_[i].ks0 = *reinterpret_cast<const bf16x8*>(kbase + (long)((k0) + sr) * kstr); sr_[i].ks1 = *reinterpret_cast<const bf16x8*>(kbase + (long)((k0) + 32 + sr) * kstr); } while (0)
#define SWRITE(b, i) do { *(bf16x8*)((char*)V_lds + (b) * SHM_V + vst0) = sr_[i].vs0; int kc = ch * 16;               \
    *(bf16x8*)((char*)K_lds + (b) * SHM_K + KSWZ(sr, kc)) = sr_[i].ks0;                       \
    *(bf16x8*)((char*)K_lds + (b) * SHM_K + KSWZ(32 + sr, kc)) = sr_[i].ks1; } while (0)
#define SWAIT() asm volatile("s_waitcnt vmcnt(3)" ::: "memory")
#define RESC(a) do { if (__any((a) < 1.f)) { if (hi == 0) al_l[r32] = (a); asm volatile("s_waitcnt lgkmcnt(0)" ::: "memory"); \
    _Pragma("unroll") for (int d = 0; d < 2; ++d) _Pragma("unroll") for (int r = 0; r < 16; ++r) o[d][r] *= al_l[crow(r, hi)]; } } while (0)
  f32x16 pA0, pA1, pB0, pB1; float mnA, mnB, alA, alB; bf16x8 pa0, pa1, pa2, pa3; const int NT = seq / KVBLK;
  constexpr int SE = 0, SO = 1;
  SLOAD(SE, 0); asm volatile("s_waitcnt vmcnt(0)" ::: "memory"); SWRITE(0, SE); __syncthreads();
  qkt(pA0, pA1, K_lds, qr, r32, hi); partialSM(pA0, pA1, m_reg, mnA, alA);
  SLOAD(SO, KVBLK); if (2 < NT) SLOAD(SE, 2 * KVBLK);
  SWAIT(); SWRITE(1, SO); __syncthreads();
  int bprev = 0, bcur = 1, bnext = 2;
#define ATT_STEP(PN0, PN1, MNN, ALN, PO0, PO1, ALO, SL_LOAD, SL_WRITE, t) do { \
    SBAR(); qkt(PN0, PN1, (bf16*)((char*)K_lds + bcur * SHM_K), qr, r32, hi); \
    finishSM(PO0, PO1, ALO, l_reg, pa0, pa1, pa2, pa3); SBAR(); \
    if ((t) + 2 < NT) SLOAD(SL_LOAD, ((t) + 2) * KVBLK); SBAR(); \
    pv_d0(o, vb0 + bprev * (int)SHM_V, pa0, pa1, pa2, pa3); partialSM(PN0, PN1, m_reg, MNN, ALN); \
    SWAIT(); SWRITE(bnext, SL_WRITE); \
    RESC(ALN); __syncthreads(); \
    bprev = bcur; bcur = bnext; bnext = (bnext == 2) ? 0 : bnext + 1; } while (0)
  for (int j = 1; j + 1 < NT; j += 2) {
    ATT_STEP(pB0, pB1, mnB, alB, pA0, pA1, alA, SO, SE, j);
    ATT_STEP(pA0, pA1, mnA, alA, pB0, pB1, alB, SE, SO, j + 1);
  }
#undef ATT_STEP
  SBAR(); qkt(pB0, pB1, (bf16*)((char*)K_lds + bcur * SHM_K), qr, r32, hi);
  finishSM(pA0, pA1, alA, l_reg, pa0, pa1, pa2, pa3); SBAR();
  pv_d0(o, vb0 + bprev * (int)SHM_V, pa0, pa1, pa2, pa3); partialSM(pB0, pB1, m_reg, mnB, alB);
  RESC(alB);
  finishSM(pB0, pB1, alB, l_reg, pa0, pa1, pa2, pa3); SBAR();
  pv_d0(o, vb0 + bcur * (int)SHM_V, pa0, pa1, pa2, pa3);
  if (hi == 0) li_l[r32] = l_reg; asm volatile("s_waitcnt lgkmcnt(0)" ::: "memory");
  float rli[16];
#pragma unroll
  for (int r = 0; r < 16; ++r) rli[r] = __builtin_amdgcn_rcpf(li_l[crow(r, hi)]);
  bf16* Ow = Ob + (long)(wid * QBLK) * 1024;
#pragma unroll
  for (int r = 0; r < 16; ++r) { int orow = crow(r, hi);
#pragma unroll
    for (int d0 = 0; d0 < 2; ++d0) { const float v = o[d0][r] * rli[r]; Ow[(long)orow * 1024 + d0 * 32 + r32] = (bf16)(cvtpk(v, v) & 0xffffu); } }
#undef SLOAD
#undef SWRITE
#undef SWAIT
#undef RESC
}
}

struct Args { const float* in[33]; float* out; unsigned char* ws; int ph_lo, ph_hi; };
enum { I_X = 0, I_C, I_CTX, I_CCTX, I_MODW, I_MODB, I_LN1G, I_LN1B, I_LN2G, I_LN2B, I_WIN, I_QNORM, I_KVNORM, I_WUQ, I_WUK, I_WUV, I_LBL, I_HGNORM, I_WOUT,
       I_PW1W, I_PW1B, I_DWW, I_DWB, I_CLNG, I_CLNB, I_PW2W, I_PW2B, I_RW, I_RB, I_WGU, I_BGU, I_WDN, I_BDN };

__device__ __forceinline__ int dst_row(int n, int mode, int row_off) {
    if (mode == 0) return row_off + n;
    int f, g; if (mode == 1) { f = n >> 1; g = n & 1; } else { g = n >> 10; f = n & 1023; }
    return row_off + 256 * (f >> 7) + 128 * g + (f & 127);
}
__device__ __forceinline__ unsigned pack_fp8x4(float a, float b, float c, float d) { int w = 0; w = __builtin_amdgcn_cvt_pk_fp8_f32(fminf(fmaxf(a, -448.f), 448.f), fminf(fmaxf(b, -448.f), 448.f), w, false);
    w = __builtin_amdgcn_cvt_pk_fp8_f32(fminf(fmaxf(c, -448.f), 448.f), fminf(fmaxf(d, -448.f), 448.f), w, true); return (unsigned)w; }
struct TrItem { const float* W; bf16* WT; int K, N, mode, row_off, item; float f8scale; };
__device__ __forceinline__ void tr_load(const TrItem& d, f32x4 (&v)[16], int lane) {
    const int nblk = (d.N + 63) >> 6, kb = d.item / nblk, nb = d.item - kb * nblk, k0 = 64 * kb, n0 = 64 * nb;
    const int nc = n0 + 4 * (lane & 15), kr = lane >> 4;
#pragma unroll
    for (int i = 0; i < 16; ++i) v[i] = (nc < d.N) ? __builtin_nontemporal_load((const f32x4*)(d.W + (size_t)(k0 + 4 * i + kr) * d.N + nc)) : (f32x4){0.f, 0.f, 0.f, 0.f};
}
__device__ __forceinline__ void tr_lds_write(const f32x4 (&v)[16], LAS float* scr, int lane) {
    const int kr = lane >> 4;
#pragma unroll
    for (int i = 0; i < 16; ++i) { LAS float* s = scr + (4 * i + kr) * 65 + 4 * (lane & 15); s[0] = v[i][0]; s[1] = v[i][1]; s[2] = v[i][2]; s[3] = v[i][3]; }
}
__device__ __forceinline__ void tr_store(const TrItem& d, LAS float* scr, int lane) {
    const int nblk = (d.N + 63) >> 6, kb = d.item / nblk, nb = d.item - kb * nblk, k0 = 64 * kb, n0 = 64 * nb;
    const int c = lane & 7; const int K = d.K;
#pragma unroll
    for (int j = 0; j < 8; ++j) { const int nl = (lane >> 3) + 8 * j, n = n0 + nl; const LAS float* s = scr + (8 * c) * 65 + nl;
        if (n < d.N) { if (d.f8scale > 0.f) { const float f8 = d.f8scale; v2u o8; o8.x = pack_fp8x4(s[0 * 65] * f8, s[1 * 65] * f8, s[2 * 65] * f8, s[3 * 65] * f8); o8.y = pack_fp8x4(s[4 * 65] * f8, s[5 * 65] * f8, s[6 * 65] * f8, s[7 * 65] * f8);
                *(v2u*)((unsigned char*)d.WT + (size_t)dst_row(n, d.mode, d.row_off) * K + k0 + 8 * c) = o8; }
            else { v4u o; o.x = pk2(s[0 * 65], s[1 * 65]); o.y = pk2(s[2 * 65], s[3 * 65]); o.z = pk2(s[4 * 65], s[5 * 65]); o.w = pk2(s[6 * 65], s[7 * 65]);
                *(v4u*)(d.WT + (size_t)dst_row(n, d.mode, d.row_off) * K + k0 + 8 * c) = o; } } }
}
__device__ __forceinline__ void convert_items(const Args& a, unsigned char* ws, LAS float* scr, int lane, int gw, int NGW, int it_lo, int it_hi) {
    constexpr int I0 = 16 * 51, I1 = 6 * 12, I2 = 4 * 8, I3 = 4 * 8, I4 = 256, I5 = 512;
    constexpr int NGU = 64 * 512, NDN = 64 * 256;
    auto decode = [&](int it) -> TrItem {
        TrItem d; int r = it; d.f8scale = 0.f; d.mode = 0; d.row_off = 0;
        if (r < NGU) { const int mi = r >> 9; d.W = a.in[I_WGU] + (size_t)mi * 1024 * 2048; d.K = 1024; d.N = 2048; d.WT = (bf16*)(ws + WS_WGU + (size_t)mi * 2048 * 1024); d.mode = 1; d.item = r & 511; d.f8scale = SC_WGU; return d; } r -= NGU;
        if (r < NDN) { const int mi = r >> 8; d.W = a.in[I_WDN] + (size_t)mi * 1024 * 1024; d.K = 1024; d.N = 1024; d.WT = (bf16*)(ws + WS_WDN + (size_t)mi * 1024 * 1024); d.item = r & 255; d.f8scale = SC_WDN; return d; } r -= NDN;
        if (r < I0) { d.W = a.in[I_WIN]; d.K = 1024; d.N = 3232; d.WT = (bf16*)(ws + WS_WIN); d.item = r; return d; } r -= I0;
        if (r < I1) { d.W = a.in[I_WUQ]; d.K = 384; d.N = 768; d.WT = (bf16*)(ws + WS_WUQ); d.item = r; return d; } r -= I1;
        if (r < I2) { d.W = a.in[I_WUK]; d.K = 256; d.N = 512; d.WT = (bf16*)(ws + WS_WUKV); d.item = r; return d; } r -= I2;
        if (r < I3) { d.W = a.in[I_WUV]; d.K = 256; d.N = 512; d.WT = (bf16*)(ws + WS_WUKV); d.row_off = 512; d.item = r; return d; } r -= I3;
        if (r < I4) { d.W = a.in[I_WOUT]; d.K = 1024; d.N = 1024; d.WT = (bf16*)(ws + WS_WOUT); d.item = r; return d; } r -= I4;
        if (r < I5) { d.W = a.in[I_PW1W]; d.K = 1024; d.N = 2048; d.WT = (bf16*)(ws + WS_WPW1); d.mode = 2; d.item = r; return d; } r -= I5;
        d.W = a.in[I_PW2W]; d.K = 1024; d.N = 1024; d.WT = (bf16*)(ws + WS_WPW2); d.item = r; return d; };
    f32x4 tv[16];
    int it = it_lo + gw;
    if (it < it_hi) { const TrItem d0 = decode(it); tr_load(d0, tv, lane); }
    for (; it < it_hi; it += NGW) {
        const TrItem d = decode(it);
        tr_lds_write(tv, scr, lane);
        if (it + NGW < it_hi) { const TrItem dn = decode(it + NGW); tr_load(dn, tv, lane); }
        LDS_WAIT();
        tr_store(d, scr, lane);
        LDS_WAIT();
    }
}
__device__ __forceinline__ void phase_prologue(const Args& a, LAS unsigned char* lds, int tid, int lane, int wave) {
    unsigned char* ws = a.ws;
    const int G = gridDim.x, B = blockIdx.x;
    {
        LAS float* sc = (LAS float*)lds;
        LAS float* red = (LAS float*)(lds + 36864);
        float* modv = (float*)(ws + WS_MODV);
        bool have = false;
        for (int it = B; it < 192; it += G) {
            if (!have) { for (int i = tid; i < 9 * 1024; i += NTHR) { const int r = i >> 10, k = i & 1023; const float x = r < 8 ? a.in[I_C][r * 1024 + k] : a.in[I_CCTX][k]; sc[i] = x * sigm(x); } __syncthreads(); have = true; }
            const int l = it / 96, jc = it % 96, kg = tid >> 6, jj = tid & 63, j = jc * 64 + jj;
            float acc[9];
#pragma unroll
            for (int r = 0; r < 9; ++r) acc[r] = 0.f;
            const float* wp = a.in[I_MODW] + ((size_t)l * 1024 + kg * 128) * 6144 + j;
            for (int k0 = 0; k0 < 128; k0 += 16) { float w[16];
#pragma unroll
                for (int kk = 0; kk < 16; ++kk) w[kk] = wp[(size_t)(k0 + kk) * 6144];
#pragma unroll
                for (int kk = 0; kk < 16; ++kk)
#pragma unroll
                    for (int r = 0; r < 9; ++r) acc[r] += sc[r * 1024 + kg * 128 + k0 + kk] * w[kk]; }
#pragma unroll
            for (int r = 0; r < 9; ++r) red[(kg * 9 + r) * 64 + jj] = acc[r];
            __syncthreads();
            for (int i = tid; i < 576; i += NTHR) { const int r = i >> 6, j2 = i & 63; float s = a.in[I_MODB][l * 6144 + jc * 64 + j2];
#pragma unroll
                for (int g = 0; g < 8; ++g) s += red[(g * 9 + r) * 64 + j2];
                modv[((size_t)l * 9 + r) * 6144 + jc * 64 + j2] = s; }
            __syncthreads();
        }
        __syncthreads();
    }
    const int gw = B * NWAVES + wave, NGW = G * NWAVES, gt = B * NTHR + tid, NGT = G * NTHR;
    { float* rope = (float*)(ws + WS_ROPE);
      for (int i = gt; i < 4096 * 16; i += NGT) { const int t = i >> 4, p = i & 15; const float pos = (float)(p < 8 ? (t >> 6) : (t & 63));
          const float inv = __powf(10000.0f, -(float)(p & 7) * 0.125f); const float ang = pos * inv; rope[t * 32 + p] = cosf(ang); rope[t * 32 + 16 + p] = sinf(ang); }
      float* bgu = (float*)(ws + WS_BGU);
      for (int i = gt; i < 2 * 32 * 2048; i += NGT) { const int le = i >> 11, np = i & 2047, q = np >> 8, g = (np >> 7) & 1, r = np & 127, f = 128 * q + r; bgu[i] = a.in[I_BGU][(size_t)le * 2048 + 2 * f + g]; }
      float* pb = (float*)(ws + WS_PW1B);
      for (int i = gt; i < 2048; i += NGT) { const int q = i >> 8, g = (i >> 7) & 1, r = i & 127, f = 128 * q + r; pb[i] = a.in[I_PW1B][g * 1024 + f]; }
      v4u* zp = (v4u*)(ws + WS_WIN + (size_t)3232 * 1024 * 2);
      for (int i = gt; i < 96 * 1024 * 2 / 16; i += NGT) zp[i] = (v4u){0u, 0u, 0u, 0u};
    }
    LAS float* scr = (LAS float*)(lds + wave * 16640);
    constexpr int I0 = 16 * 51, I1 = 6 * 12, I2 = 4 * 8, I3 = 4 * 8, I4 = 256, I5 = 512, I6 = 256, SMALL = I0 + I1 + I2 + I3 + I4 + I5 + I6;
    constexpr int NGU = 64 * 512, NDN = 64 * 256, NITEMS = SMALL + NGU + NDN;
    convert_items(a, ws, scr, lane, B * NWAVES + wave, G * NWAVES, NGU + NDN, NITEMS);
}
__device__ __forceinline__ void convert_moe_share(const Args& a, LAS unsigned char* lds, int lane, int wave) {
    LAS float* scr = (LAS float*)(lds + wave * 16640);
    constexpr int NGU = 64 * 512, NDN = 64 * 256;
    convert_items(a, a.ws, scr, lane, blockIdx.x * NWAVES + wave, gridDim.x * NWAVES, 0, NGU + NDN);
}

__device__ __forceinline__ void phase_mod0(const Args& a, int lane, int wave) {
    const int gw = blockIdx.x * NWAVES + wave, NGW = gridDim.x * NWAVES;
    const float* modv = (const float*)(a.ws + WS_MODV);
    bf16* X = (bf16*)(a.ws + WS_X);
    for (int r = gw; r < NTOK; r += NGW) {
        const int b = r / TPB, p = r - b * TPB;
        const float* src = p < CTXL ? a.in[I_CTX] + ((size_t)b * CTXL + p) * 1024 : a.in[I_X] + ((size_t)b * SEQ + (p - CTXL)) * 1024;
        const float* mv = modv + (size_t)(p < CTXL ? 8 : b) * 6144;
#pragma unroll
        for (int j = 0; j < 4; ++j) { const int c = 4 * (lane + 64 * j); const f32x4 xv = *(const f32x4*)(src + c), sh = *(const f32x4*)(mv + c), sc = *(const f32x4*)(mv + 1024 + c);
            const f32x4 y = xv * (sc + 1.0f) + sh; v2u o; o.x = pk2(y[0], y[1]); o.y = pk2(y[2], y[3]); *(v2u*)(X + (size_t)r * 1024 + c) = o; }
    }
}

__device__ __forceinline__ void phase_norm0(const Args& a, int lane, int wave) {
    const int gw = blockIdx.x * NWAVES + wave, NGW = gridDim.x * NWAVES;
    const bf16* Z = (const bf16*)(a.ws + WS_Z); bf16* CQN = (bf16*)(a.ws + WS_CQN); bf16* CKVN = (bf16*)(a.ws + WS_CKVN); bf16* KRR = (bf16*)(a.ws + WS_KRR);
    const float* rope = (const float*)(a.ws + WS_ROPE);
    float gq[8], gk[8];
#pragma unroll
    for (int i = 0; i < 8; ++i) { gq[i] = lane < 48 ? a.in[I_QNORM][8 * lane + i] : 0.f; gk[i] = lane < 32 ? a.in[I_KVNORM][8 * lane + i] : 0.f; }
    for (int r = gw; r < NTOK; r += NGW) {
        const bf16* z = Z + (size_t)r * ZC; const int p = r % TPB;
        bf16x8 q8 = {}, k8 = {}, r8 = {};
        if (lane < 48) q8 = *(const bf16x8*)(z + ZQ + 8 * lane);
        if (lane < 32) k8 = *(const bf16x8*)(z + ZKV + 8 * lane);
        if (lane < 4) r8 = *(const bf16x8*)(z + ZKR + 8 * lane);
        float qf[8], kf[8], sq = 0.f, sk = 0.f;
#pragma unroll
        for (int i = 0; i < 8; ++i) { qf[i] = bf2f((unsigned short)q8[i]); kf[i] = bf2f((unsigned short)k8[i]); sq += qf[i] * qf[i]; sk += kf[i] * kf[i]; }
        sq = wave_sum(sq); sk = wave_sum(sk);
        const float rq = rsqrtf(sq * (1.f / 384.f) + RMS_EPS), rk = rsqrtf(sk * (1.f / 256.f) + RMS_EPS);
        if (lane < 48) { v4u o; o.x = pk2(qf[0] * rq * gq[0], qf[1] * rq * gq[1]); o.y = pk2(qf[2] * rq * gq[2], qf[3] * rq * gq[3]); o.z = pk2(qf[4] * rq * gq[4], qf[5] * rq * gq[5]); o.w = pk2(qf[6] * rq * gq[6], qf[7] * rq * gq[7]);
            *(v4u*)(CQN + (size_t)r * 384 + 8 * lane) = o; }
        if (lane < 32) { v4u o; o.x = pk2(kf[0] * rk * gk[0], kf[1] * rk * gk[1]); o.y = pk2(kf[2] * rk * gk[2], kf[3] * rk * gk[3]); o.z = pk2(kf[4] * rk * gk[4], kf[5] * rk * gk[5]); o.w = pk2(kf[6] * rk * gk[6], kf[7] * rk * gk[7]);
            *(v4u*)(CKVN + (size_t)r * 256 + 8 * lane) = o; }
        if (lane < 4) { bf16x8 o8 = r8; if (p >= CTXL) o8 = att::rope8(r8, rope + (size_t)(p - CTXL) * 32, 4 * lane); *(bf16x8*)(KRR + (size_t)r * 32 + 8 * lane) = o8; }
    }
}

__device__ __forceinline__ void hgrn_unit(const Args& a, int unit, LAS unsigned char* lds, int tid) {
    const int b = unit >> 5, head = (unit >> 3) & 3, dir = (unit >> 2) & 1, sl = unit & 3;
    const bf16* Z = (const bf16*)(a.ws + WS_Z);
    float* Od = (float*)(a.ws + (dir ? WS_OB : WS_OF));
    LAS float* lbv = (LAS float*)lds;
    constexpr int BUF0 = 1024, BUFSZ = 28672, OFF_Q = 16384, OFF_V = 24576;
    if (tid < 128) { const int c = head * 128 + tid; const float l0 = a.in[I_LBL][c], l1 = a.in[I_LBL][512 + c], l2 = a.in[I_LBL][1024 + c]; const float m = fmaxf(l0, fmaxf(l1, l2));
        const float e0 = __expf(l0 - m), e1 = __expf(l1 - m), e2 = __expf(l2 - m); lbv[tid] = e0 / (e0 + e1 + e2); }
    __syncthreads();
    const int lt = tid >> 4, lcg = tid & 15;
    float lb8[8];
#pragma unroll
    for (int i = 0; i < 8; ++i) lb8[i] = lbv[8 * lcg + i];
    const int fcol = (dir ? ZHB : ZHF) + head * 128 + 8 * lcg, qcol = ZHQ + head * 128 + 8 * lcg;
    const int vt = tid >> 2, vcol = ZHI + head * 128 + sl * 32 + (tid & 3) * 8;
    const int wave = tid >> 6, lane = tid & 63, vv = lane >> 4, cg = lane & 15, vloc = wave * 4 + vv;
    const size_t zb = (size_t)b * TPB;
    bf16x8 rq, rf, rv;
#define TOKP(n) (dir ? ((n) < CTXL ? (CTXL - 1 - (n)) : (TPB + CTXL - 1 - (n))) : (n))
#define HG_LOAD(i) do { const int n_ = 32 * (i) + lt; const bf16* zr_ = Z + (zb + TOKP(n_)) * ZC; rq = *(const bf16x8*)(zr_ + qcol); rf = *(const bf16x8*)(zr_ + fcol); \
        if (tid < 128) { const int n2_ = 32 * (i) + vt; rv = *(const bf16x8*)(Z + (zb + TOKP(n2_)) * ZC + vcol); } } while (0)
#define HG_WRITE(bufi) do { LAS unsigned char* bp_ = lds + BUF0 + (bufi) * BUFSZ; float f_[8]; \
        _Pragma("unroll") for (int i_ = 0; i_ < 8; ++i_) f_[i_] = lb8[i_] + (1.f - lb8[i_]) * sigm(bf2f((unsigned short)rf[i_])); \
        *(LAS f32x4*)(bp_ + ((lt * 128 + lcg * 4) * 4)) = (f32x4){f_[0], f_[1], f_[2], f_[3]}; *(LAS f32x4*)(bp_ + ((lt * 128 + 64 + lcg * 4) * 4)) = (f32x4){f_[4], f_[5], f_[6], f_[7]}; \
        *(LAS bf16x8*)(bp_ + OFF_Q + (lt * 128 + lcg * 8) * 2) = rq; \
        if (tid < 128) { float v_[8]; _Pragma("unroll") for (int i_ = 0; i_ < 8; ++i_) v_[i_] = bf2f((unsigned short)rv[i_]); \
            *(LAS f32x4*)(bp_ + OFF_V + (vt * 32 + (tid & 3) * 8) * 4) = (f32x4){v_[0], v_[1], v_[2], v_[3]}; *(LAS f32x4*)(bp_ + OFF_V + (vt * 32 + (tid & 3) * 8 + 4) * 4) = (f32x4){v_[4], v_[5], v_[6], v_[7]}; } } while (0)
    float S[8];
#pragma unroll
    for (int j = 0; j < 8; ++j) S[j] = 0.f;
    HG_LOAD(0); HG_WRITE(0); __syncthreads();
    const bool b3 = (cg & 8) != 0, b2 = (cg & 4) != 0, b1 = (cg & 2) != 0, b0 = (cg & 1) != 0;
    for (int i = 0; i < TPB / 32; ++i) {
        if (i + 1 < TPB / 32) HG_LOAD(i + 1);
        const LAS unsigned char* bp = lds + BUF0 + (i & 1) * BUFSZ;
#pragma unroll 1
        for (int g = 0; g < 4; ++g) {
            const LAS unsigned char* gp = bp + g * 8 * 512;
            float ot[8];
#pragma unroll
            for (int t = 0; t < 8; ++t) {
                const f32x4 f0 = *(const LAS f32x4*)(gp + ((t * 128 + cg * 4) * 4)), f1 = *(const LAS f32x4*)(gp + ((t * 128 + 64 + cg * 4) * 4));
                const bf16x8 q8 = *(const LAS bf16x8*)(bp + OFF_Q + ((g * 8 + t) * 128 + cg * 8) * 2);
                const float v = *(const LAS float*)(bp + OFF_V + ((g * 8 + t) * 32 + vloc) * 4);
                float acc = 0.f;
#pragma unroll
                for (int j = 0; j < 8; ++j) { const float fj = j < 4 ? f0[j] : f1[j - 4]; const float qj = bf2f((unsigned short)q8[j]);
                    const float kv = fmaf(-fj, v, v); S[j] = fmaf(fj, S[j], kv); acc = fmaf(S[j], qj, acc); }
                ot[t] = acc;
            }
#pragma unroll
            for (int k = 0; k < 4; ++k) { const float snd = b3 ? ot[k] : ot[k + 4]; const float rcv = __shfl_xor(snd, 8); ot[k] = (b3 ? ot[k + 4] : ot[k]) + rcv; }
#pragma unroll
            for (int k = 0; k < 2; ++k) { const float snd = b2 ? ot[k] : ot[k + 2]; const float rcv = __shfl_xor(snd, 4); ot[k] = (b2 ? ot[k + 2] : ot[k]) + rcv; }
            { const float snd = b1 ? ot[0] : ot[1]; const float rcv = __shfl_xor(snd, 2); ot[0] = (b1 ? ot[1] : ot[0]) + rcv; }
            ot[0] += __shfl_xor(ot[0], 1);
            if (!b0) { const int n = 32 * i + 8 * g + (cg >> 1); const int p = TOKP(n); if (p >= CTXL) Od[(zb + p) * 512 + head * 128 + sl * 32 + vloc] = ot[0]; }
        }
        if (i + 1 < TPB / 32) HG_WRITE((i + 1) & 1);
        __syncthreads();
    }
#undef TOKP
#undef HG_LOAD
#undef HG_WRITE
}

__device__ __forceinline__ void phase_readout(const Args& a, int lane, int wave) {
    const int gw = blockIdx.x * NWAVES + wave, NGW = gridDim.x * NWAVES;
    const bf16* OF = (const bf16*)(a.ws + WS_OF); const bf16* OB = (const bf16*)(a.ws + WS_OB);
    const bf16* Z = (const bf16*)(a.ws + WS_Z); bf16* MIX = (bf16*)(a.ws + WS_Y);
    float hn[8];
#pragma unroll
    for (int i = 0; i < 8; ++i) hn[i] = a.in[I_HGNORM][((8 * lane) & 127) + i];
    for (int lr = gw; lr < NLAT; lr += NGW) {
        const size_t r = (size_t)grow_of(lr);
        const bf16x8 a8 = *(const bf16x8*)(OF + r * 512 + 8 * lane), c8 = *(const bf16x8*)(OB + r * 512 + 8 * lane);
        const bf16x8 g8 = *(const bf16x8*)(Z + r * ZC + ZHG + 8 * lane);
        float o[8]; float ss = 0.f;
#pragma unroll
        for (int i = 0; i < 8; ++i) o[i] = bf2f((unsigned short)a8[i]) + bf2f((unsigned short)c8[i]);
#pragma unroll
        for (int i = 0; i < 8; ++i) ss += o[i] * o[i];
        ss += __shfl_xor(ss, 1); ss += __shfl_xor(ss, 2); ss += __shfl_xor(ss, 4); ss += __shfl_xor(ss, 8);
        const float rs = rsqrtf(ss * (1.f / 128.f) + RMS_EPS);
        float y[8];
#pragma unroll
        for (int i = 0; i < 8; ++i) { const float g = bf2f((unsigned short)g8[i]); y[i] = o[i] * rs * hn[i] * (g * sigm(g)); }
        v4u w; w.x = pk2(y[0], y[1]); w.y = pk2(y[2], y[3]); w.z = pk2(y[4], y[5]); w.w = pk2(y[6], y[7]);
        *(v4u*)(MIX + r * 1024 + 512 + 8 * lane) = w;
    }
}

__device__ __forceinline__ int rows_per_block() { const int G = gridDim.x; return (((NLAT + G - 1) / G) + 15) & ~15; }
__device__ __forceinline__ void phase_ln1(const Args& a, int l, LAS unsigned char* lds, int tid, int lane, int wave) {
    typedef short bf16x8s __attribute__((ext_vector_type(8)));
    const int RB = rows_per_block(), lr_base = blockIdx.x * RB;
    float* H = (float*)(a.ws + WS_H); bf16* XB = (bf16*)(a.ws + WS_X);
    const float* modv = (const float*)(a.ws + WS_MODV) + (size_t)l * 9 * 6144;
    const float* lng = a.in[I_LN1G] + l * 1024; const float* lnb = a.in[I_LN1B] + l * 1024;
    const float* rw = a.in[I_RW] + (size_t)l * 1024 * 32; const float* rb = a.in[I_RB] + l * 32;
    constexpr int XT_LD = 1028, O_PART = 16 * XT_LD * 4, O_LG = O_PART + 8 * 32 * 16 * 4, O_HIST = O_LG + 16 * 33 * 4 + 64, O_CCNT = O_HIST + 256, O_TIL = O_CCNT + 2048, O_TWL = O_TIL + 4096;
    LAS float* XT = (LAS float*)lds; LAS float* PART = (LAS float*)(lds + O_PART); LAS float* LG = (LAS float*)(lds + O_LG);
    LAS int* hist = (LAS int*)(lds + O_HIST);
    LAS int* ccnt = (LAS int*)(lds + O_CCNT);
    LAS int* til = (LAS int*)(lds + O_TIL);
    LAS float* twl = (LAS float*)(lds + O_TWL);
    __syncthreads();
    if (tid < 32) hist[tid] = 0;
    bf16x8s whi[2][4], wlo[2][4];
    { const int e15 = lane & 15, kq = lane >> 4;
#pragma unroll
      for (int t = 0; t < 2; ++t)
#pragma unroll
          for (int sI = 0; sI < 4; ++sI) { float wv[8];
#pragma unroll
              for (int j = 0; j < 8; ++j) wv[j] = rw[(size_t)(128 * wave + 32 * sI + 8 * kq + j) * 32 + 16 * t + e15];
              v4u ph, pl;
#pragma unroll
              for (int j = 0; j < 4; ++j) { const unsigned p = pk2(wv[2 * j], wv[2 * j + 1]); const float h0 = __uint_as_float(p << 16), h1 = __uint_as_float(p & 0xffff0000u); ph[j] = p; pl[j] = pk2(wv[2 * j] - h0, wv[2 * j + 1] - h1); }
              whi[t][sI] = __builtin_bit_cast(bf16x8s, ph); wlo[t][sI] = __builtin_bit_cast(bf16x8s, pl); } }
    const int ngroups = RB / 16;
    f32x4 xr[2][4];
#define LN1_LOAD(g) do { _Pragma("unroll") for (int rr_ = 0; rr_ < 2; ++rr_) { const int lr_ = lr_base + 16 * (g) + 2 * wave + rr_; const size_t r_ = (size_t)grow_of(lr_ < NLAT ? lr_ : NLAT - 1); \
        _Pragma("unroll") for (int j_ = 0; j_ < 4; ++j_) xr[rr_][j_] = *(const f32x4*)(H + r_ * 1024 + 4 * (lane + 64 * j_)); } } while (0)
    LN1_LOAD(0);
    for (int g = 0; g < ngroups; ++g) {
#pragma unroll
        for (int rr = 0; rr < 2; ++rr) {
            const int lr = lr_base + 16 * g + 2 * wave + rr; const bool ok = lr < NLAT; const size_t r = (size_t)grow_of(ok ? lr : NLAT - 1); const int b = (ok ? lr : NLAT - 1) >> 12;
            const float* mv = modv + (size_t)b * 6144;
            f32x4 x[4]; float s = 0.f;
#pragma unroll
            for (int j = 0; j < 4; ++j) { x[j] = xr[rr][j]; s += (x[j][0] + x[j][1]) + (x[j][2] + x[j][3]); }
            const float mean = wave_sum(s) * (1.f / 1024.f); float s2 = 0.f;
#pragma unroll
            for (int j = 0; j < 4; ++j) { x[j] = x[j] - mean; s2 += (x[j][0] * x[j][0] + x[j][1] * x[j][1]) + (x[j][2] * x[j][2] + x[j][3] * x[j][3]); }
            const float rstd = rsqrtf(wave_sum(s2) * (1.f / 1024.f) + LN_EPS);
#pragma unroll
            for (int j = 0; j < 4; ++j) { const int c = 4 * (lane + 64 * j); const f32x4 gg = *(const f32x4*)(lng + c), bb = *(const f32x4*)(lnb + c);
                const f32x4 hv = x[j] * rstd * gg + bb;
                const f32x4 sh = *(const f32x4*)(mv + 3 * 1024 + c), sc = *(const f32x4*)(mv + 4 * 1024 + c);
                const f32x4 bm = hv * (sc + 1.0f) + sh;
                if (ok) *(unsigned*)((unsigned char*)XB + r * 1024 + c) = pack_fp8x4(bm[0] * SC_X8, bm[1] * SC_X8, bm[2] * SC_X8, bm[3] * SC_X8);
                *(LAS f32x4*)(XT + (2 * wave + rr) * XT_LD + c) = bm; }
        }
        if (g + 1 < ngroups) LN1_LOAD(g + 1);
        __syncthreads();
        { const int rr = lane & 15, kq = lane >> 4;
          f32x4 acc0 = {0.f, 0.f, 0.f, 0.f}, acc1 = {0.f, 0.f, 0.f, 0.f};
#pragma unroll
          for (int sI = 0; sI < 4; ++sI) { const LAS float* xp = XT + rr * XT_LD + 128 * wave + 32 * sI + 8 * kq; const f32x4 v0 = *(const LAS f32x4*)xp, v1 = *(const LAS f32x4*)(xp + 4);
              const float bv[8] = {v0[0], v0[1], v0[2], v0[3], v1[0], v1[1], v1[2], v1[3]}; v4u ph, pl;
#pragma unroll
              for (int j = 0; j < 4; ++j) { const unsigned p = pk2(bv[2 * j], bv[2 * j + 1]); const float h0 = __uint_as_float(p << 16), h1 = __uint_as_float(p & 0xffff0000u); ph[j] = p; pl[j] = pk2(bv[2 * j] - h0, bv[2 * j + 1] - h1); }
              const bf16x8s bh = __builtin_bit_cast(bf16x8s, ph), bl = __builtin_bit_cast(bf16x8s, pl);
              acc0 = __builtin_amdgcn_mfma_f32_16x16x32_bf16(whi[0][sI], bh, acc0, 0, 0, 0); acc0 = __builtin_amdgcn_mfma_f32_16x16x32_bf16(whi[0][sI], bl, acc0, 0, 0, 0); acc0 = __builtin_amdgcn_mfma_f32_16x16x32_bf16(wlo[0][sI], bh, acc0, 0, 0, 0);
              acc1 = __builtin_amdgcn_mfma_f32_16x16x32_bf16(whi[1][sI], bh, acc1, 0, 0, 0); acc1 = __builtin_amdgcn_mfma_f32_16x16x32_bf16(whi[1][sI], bl, acc1, 0, 0, 0); acc1 = __builtin_amdgcn_mfma_f32_16x16x32_bf16(wlo[1][sI], bh, acc1, 0, 0, 0); }
#pragma unroll
          for (int q = 0; q < 4; ++q) { PART[(wave * 32 + 4 * kq + q) * 16 + rr] = acc0[q]; PART[(wave * 32 + 16 + 4 * kq + q) * 16 + rr] = acc1[q]; } }
        __syncthreads();
        { const int e = tid >> 4, rr = tid & 15; float sacc = rb[e];
#pragma unroll
          for (int w = 0; w < 8; ++w) sacc += PART[(w * 32 + e) * 16 + rr];
          LG[rr * 33 + e] = sacc; }
        __syncthreads();
        if (wave == (g & 7) && lane < 16) { const int lr = lr_base + 16 * g + lane;
            if (lr < NLAT) { float lg[32];
#pragma unroll
                for (int e = 0; e < 32; ++e) lg[e] = LG[lane * 33 + e];
                unsigned taken = 0u; float tv[4]; int ti[4];
#pragma unroll
                for (int kk = 0; kk < 4; ++kk) { float best = -3.0e38f; int bi = 0;
#pragma unroll
                    for (int e = 0; e < 32; ++e) { const bool okk = (lg[e] > best) && !((taken >> e) & 1u); best = okk ? lg[e] : best; bi = okk ? e : bi; }
                    taken |= 1u << bi; tv[kk] = best; ti[kk] = bi; }
                const float e1 = __expf(tv[1] - tv[0]), e2 = __expf(tv[2] - tv[0]), e3 = __expf(tv[3] - tv[0]); const float inv = 1.f / (1.f + e1 + e2 + e3);
                const int li = (16 * g + lane) * 4; til[li] = ti[0]; til[li + 1] = ti[1]; til[li + 2] = ti[2]; til[li + 3] = ti[3]; twl[li] = inv; twl[li + 1] = e1 * inv; twl[li + 2] = e2 * inv; twl[li + 3] = e3 * inv;
                __hip_atomic_fetch_add(hist + ti[0], 1, __ATOMIC_RELAXED, __HIP_MEMORY_SCOPE_WORKGROUP); __hip_atomic_fetch_add(hist + ti[1], 1, __ATOMIC_RELAXED, __HIP_MEMORY_SCOPE_WORKGROUP);
                __hip_atomic_fetch_add(hist + ti[2], 1, __ATOMIC_RELAXED, __HIP_MEMORY_SCOPE_WORKGROUP); __hip_atomic_fetch_add(hist + ti[3], 1, __ATOMIC_RELAXED, __HIP_MEMORY_SCOPE_WORKGROUP); } }
    }
#undef LN1_LOAD
    __syncthreads();
    int* cursor = (int*)(a.ws + WS_CURSOR) + l * 32;
    int* rows = (int*)(a.ws + WS_ROWS); float* roww = (float*)(a.ws + WS_ROWW); int* rowd = (int*)(a.ws + WS_ROWD);
    int nrows = NLAT - lr_base; nrows = nrows > RB ? RB : nrows; if (nrows < 0) nrows = 0;
    const int nas = nrows * 4, nchunks = (nas + 63) >> 6;
    int basev = 0; if (tid < 32) basev = (int)__hip_atomic_fetch_add((unsigned*)cursor + tid, (unsigned)hist[tid], __ATOMIC_RELAXED, __HIP_MEMORY_SCOPE_AGENT);
    int myrank[2] = {0, 0}, mye[2] = {-1, -1};
#pragma unroll
    for (int cc = 0; cc < 2; ++cc) { const int c = wave + 8 * cc; if (c < nchunks) { const int idx = c * 64 + lane; const int e = idx < nas ? til[idx] : -1; mye[cc] = e;
        for (int x = 0; x < 32; ++x) { const unsigned long long m = __ballot(e == x); if (e == x) myrank[cc] = __popcll(m & ((1ull << lane) - 1ull)); if (lane == 0) ccnt[c * 32 + x] = __popcll(m); } } }
    __syncthreads();
    if (tid < 32) hist[32 + tid] = basev;
    __syncthreads();
#pragma unroll
    for (int cc = 0; cc < 2; ++cc) { const int c = wave + 8 * cc; const int idx = c * 64 + lane; if (c < nchunks && idx < nas) { const int e = mye[cc]; int pos = hist[32 + e] + myrank[cc]; for (int c2 = 0; c2 < c; ++c2) pos += ccnt[c2 * 32 + e];
        const int lr = lr_base + (idx >> 2); const size_t pi = (size_t)e * ECAP + pos; rows[pi] = grow_of(lr); roww[pi] = twl[idx]; rowd[pi] = lr * 4 + (idx & 3); } }
}

__device__ __forceinline__ void phase_ln2(const Args& a, int l, int lane, int wave) {
    const int gw = blockIdx.x * NWAVES + wave, NGW = gridDim.x * NWAVES;
    float* H = (float*)(a.ws + WS_H); const unsigned char* YB = (const unsigned char*)(a.ws + WS_YB); bf16* A1 = (bf16*)(a.ws + WS_Y);
    const float* modv = (const float*)(a.ws + WS_MODV);
    const float* ln1g = a.in[I_LN1G] + l * 1024; const float* ln1b = a.in[I_LN1B] + l * 1024;
    const float* lng = a.in[I_LN2G] + l * 1024; const float* lnb = a.in[I_LN2B] + l * 1024;
    for (int lr0 = 2 * gw; lr0 < NLAT; lr0 += 2 * NGW) {
        f32x4 hv[2][4]; unsigned yv[2][4][4];
#pragma unroll
        for (int q = 0; q < 2; ++q) { const int lr = lr0 + q; const size_t r = (size_t)grow_of(lr);
#pragma unroll
            for (int j = 0; j < 4; ++j) { const int c = 4 * (lane + 64 * j); hv[q][j] = *(const f32x4*)(H + r * 1024 + c);
#pragma unroll
                for (int k = 0; k < 4; ++k) yv[q][j][k] = *(const unsigned*)(YB + ((size_t)lr * 4 + k) * 1024 + c); } }
#pragma unroll
        for (int q = 0; q < 2; ++q) {
            const int lr = lr0 + q; const size_t r = (size_t)grow_of(lr); const int b = lr >> 12;
            const float* mv = modv + ((size_t)l * 9 + b) * 6144; const float* mv1 = modv + ((size_t)9 + b) * 6144;
            f32x4 x[4]; float s = 0.f;
#pragma unroll
            for (int j = 0; j < 4; ++j) { x[j] = hv[q][j]; s += (x[j][0] + x[j][1]) + (x[j][2] + x[j][3]); }
            float mean = wave_sum(s) * (1.f / 1024.f), s2 = 0.f;
#pragma unroll
            for (int j = 0; j < 4; ++j) { x[j] = x[j] - mean; s2 += (x[j][0] * x[j][0] + x[j][1] * x[j][1]) + (x[j][2] * x[j][2] + x[j][3] * x[j][3]); }
            float rstd = rsqrtf(wave_sum(s2) * (1.f / 1024.f) + LN_EPS);
            s = 0.f;
#pragma unroll
            for (int j = 0; j < 4; ++j) { const int c = 4 * (lane + 64 * j); const f32x4 g = *(const f32x4*)(ln1g + c), bb = *(const f32x4*)(ln1b + c);
                const f32x4 h1 = x[j] * rstd * g + bb; f32x4 f = {0.f, 0.f, 0.f, 0.f};
#pragma unroll
                for (int k = 0; k < 4; ++k) { const unsigned y = yv[q][j][k]; const auto lo = __builtin_amdgcn_cvt_pk_f32_fp8((int)y, false), hi = __builtin_amdgcn_cvt_pk_f32_fp8((int)y, true);
                    f[0] += lo[0]; f[1] += lo[1]; f[2] += hi[0]; f[3] += hi[1]; }
                const f32x4 gt = *(const f32x4*)(mv + 5 * 1024 + c);
                x[j] = h1 * ALPHA + gt * (f * (1.f / SC_Y)); s += (x[j][0] + x[j][1]) + (x[j][2] + x[j][3]); }
            mean = wave_sum(s) * (1.f / 1024.f); s2 = 0.f;
#pragma unroll
            for (int j = 0; j < 4; ++j) { x[j] = x[j] - mean; s2 += (x[j][0] * x[j][0] + x[j][1] * x[j][1]) + (x[j][2] * x[j][2] + x[j][3] * x[j][3]); }
            rstd = rsqrtf(wave_sum(s2) * (1.f / 1024.f) + LN_EPS);
#pragma unroll
            for (int j = 0; j < 4; ++j) { const int c = 4 * (lane + 64 * j); const f32x4 g = *(const f32x4*)(lng + c), bb = *(const f32x4*)(lnb + c);
                const f32x4 o = x[j] * rstd * g + bb;
                if (l == 0) { *(f32x4*)(H + r * 1024 + c) = o; const f32x4 sh = *(const f32x4*)(mv1 + c), sc = *(const f32x4*)(mv1 + 1024 + c);
                    const f32x4 am = o * (sc + 1.0f) + sh; v2u w; w.x = pk2(am[0], am[1]); w.y = pk2(am[2], am[3]); *(v2u*)(A1 + r * 1024 + c) = w; }
                else *(f32x4*)(a.out + (size_t)lr * 1024 + c) = o; }
        }
    }
}

__device__ __forceinline__ void phase_conv(const Args& a, LAS unsigned char* lds, int tid, int lane, int wave) {
    const bf16* U = (const bf16*)(a.ws + WS_X); bf16* V = (bf16*)(a.ws + WS_Y);
    LAS float* part = (LAS float*)(lds + 126976);
    LAS float* st = part + 512;
    const int c0 = 2 * tid;
    const float db0 = a.in[I_DWB][c0], db1 = a.in[I_DWB][c0 + 1], g0 = a.in[I_CLNG][c0], g1 = a.in[I_CLNG][c0 + 1], be0 = a.in[I_CLNB][c0], be1 = a.in[I_CLNB][c0 + 1];
    for (int tile = blockIdx.x; tile < NLAT / 32; tile += gridDim.x) {
        const int b = tile >> 7, t0 = (tile & 127) * 32;
        const size_t rb0 = (size_t)b * TPB + CTXL;
        __syncthreads();
        for (int i = tid; i < 62 * 128; i += NTHR) { const int row = i >> 7, chk = i & 127, t = t0 - 15 + row;
            v4u val = {0u, 0u, 0u, 0u}; if (t >= 0 && t < SEQ) val = *(const v4u*)(U + (rb0 + t) * 1024 + chk * 8);
            *(LAS v4u*)(lds + row * 2048 + chk * 16) = val; }
        __syncthreads();
        float w0[31], w1[31];
#pragma unroll
        for (int j = 0; j < 31; ++j) { const float2 wv = *(const float2*)(a.in[I_DWW] + j * 1024 + c0); w0[j] = wv.x; w1[j] = wv.y; }
#pragma unroll 1
        for (int hh = 0; hh < 2; ++hh) {
            const LAS unsigned char* hp = lds + hh * 16 * 2048;
            float acc0[16], acc1[16];
#pragma unroll
            for (int t = 0; t < 16; ++t) { acc0[t] = db0; acc1[t] = db1; }
#pragma unroll
            for (int s = 0; s < 46; ++s) { const unsigned pr = *(const LAS unsigned*)(hp + s * 2048 + tid * 4); const float x0 = __uint_as_float(pr << 16), x1 = __uint_as_float(pr & 0xffff0000u);
#pragma unroll
                for (int t = (s > 30 ? s - 30 : 0); t <= (s < 15 ? s : 15); ++t) { acc0[t] = fmaf(x0, w0[s - t], acc0[t]); acc1[t] = fmaf(x1, w1[s - t], acc1[t]); } }
            float rs[32];
#pragma unroll
            for (int t = 0; t < 16; ++t) { rs[2 * t] = acc0[t] + acc1[t]; rs[2 * t + 1] = acc0[t] * acc0[t] + acc1[t] * acc1[t]; }
#define RS_STEP(NKEEP, XORV) { const bool bit_ = (lane & XORV) != 0; _Pragma("unroll") for (int k_ = 0; k_ < NKEEP; ++k_) { const float snd_ = bit_ ? rs[k_] : rs[k_ + NKEEP]; const float rcv_ = __shfl_xor(snd_, XORV); rs[k_] = (bit_ ? rs[k_ + NKEEP] : rs[k_]) + rcv_; } }
            RS_STEP(16, 32) RS_STEP(8, 16) RS_STEP(4, 8) RS_STEP(2, 4) RS_STEP(1, 2)
#undef RS_STEP
            rs[0] += __shfl_xor(rs[0], 1);
            __syncthreads();
            if ((lane & 1) == 0) part[wave * 32 + (lane >> 1)] = rs[0];
            __syncthreads();
            if (tid < 16) { float s1 = 0.f, s2 = 0.f;
#pragma unroll
                for (int w = 0; w < 8; ++w) { s1 += part[w * 32 + 2 * tid]; s2 += part[w * 32 + 2 * tid + 1]; }
                const float mean = s1 * (1.f / 1024.f); const float var = fmaxf(s2 * (1.f / 1024.f) - mean * mean, 0.f); st[2 * tid] = mean; st[2 * tid + 1] = rsqrtf(var + LN_EPS); }
            __syncthreads();
#pragma unroll
            for (int t = 0; t < 16; ++t) { const float mean = st[2 * t], rstd = st[2 * t + 1];
                const float y0 = (acc0[t] - mean) * rstd * g0 + be0, y1 = (acc1[t] - mean) * rstd * g1 + be1;
                *(unsigned*)(V + (rb0 + t0 + hh * 16 + t) * 1024 + c0) = pk2(y0 * sigm(y0), y1 * sigm(y1)); }
        }
    }
}

namespace hg {
using bf16x8 = __attribute__((ext_vector_type(8))) short;
using s16x4  = __attribute__((ext_vector_type(4))) short;
using f32x16 = __attribute__((ext_vector_type(16))) float;
using u32x4  = __attribute__((ext_vector_type(4))) unsigned;
constexpr int RS = 272;
constexpr int VS = 80;
constexpr int T_Q = 0, T_KO = 32 * RS, T_KE = 64 * RS, T_D = 96 * RS, IMG_BYTES = T_D + 512, T_V = IMG_BYTES, TILE_BYTES = T_V + 32 * VS;
constexpr int OFF_TILES = 1024, NTB = 3, OFF_OPART = OFF_TILES + NTB * TILE_BYTES, OPART_BYTES = 4 * 4096;
static_assert(OFF_OPART + 2 * OPART_BYTES <= 131072 && IMG_BYTES % 16 == 0 && IMG_BYTES / 16 == 1664, "hgrn lds");
constexpr int P_RAW = 1024, R_Q = 0, R_F = 32 * RS, RAW_BYTES = 64 * RS, P_IMG = P_RAW + RAW_BYTES;
constexpr int NCHUNK = TPB / 32, NCHAIN = NB * 4 * 2, NITEM = NCHAIN * NCHUNK;
__device__ __forceinline__ int crow(int r, int hi) { return (r & 3) + 8 * (r >> 2) + 4 * hi; }
__device__ __forceinline__ s16x4 tr_read(unsigned addr) { s16x4 r; asm volatile("ds_read_b64_tr_b16 %0, %1" : "=&v"(r) : "v"(addr) : "memory"); return r; }
__device__ __forceinline__ bf16x8 cat8(s16x4 l, s16x4 h) { return (bf16x8){l[0], l[1], l[2], l[3], h[0], h[1], h[2], h[3]}; }
__device__ __forceinline__ bf16x8 pack8(const f32x16& x, int base) {
    u32x4 w; w[0] = pk2(x[base + 0], x[base + 1]); w[1] = pk2(x[base + 2], x[base + 3]); w[2] = pk2(x[base + 4], x[base + 5]); w[3] = pk2(x[base + 6], x[base + 7]);
    return *reinterpret_cast<bf16x8*>(&w);
}
}


#define HG_TOKP(dir, n) ((dir) ? ((n) < CTXL ? (CTXL - 1 - (n)) : (TPB + CTXL - 1 - (n))) : (n))
#define HG_DPP1(x, ctrl, rmask) __int_as_float(__builtin_amdgcn_update_dpp(0x3f800000, __float_as_int(x), ctrl, rmask, 0xf, false))
#define HG_DPP(x, ctrl, rmask) __int_as_float(__builtin_amdgcn_update_dpp(0, __float_as_int(x), ctrl, rmask, 0xf, false))
__device__ __forceinline__ void hgrn_prep_items(const Args& a, LAS unsigned char* lds, int tid) {
    using namespace hg;
    const bf16* Z = (const bf16*)(a.ws + WS_Z);
    unsigned char* HT = a.ws + WS_HT;
    const int wave = __builtin_amdgcn_readfirstlane(tid >> 6), lane = tid & 63, t = lane & 31, half = lane >> 5;
    const int c0 = 16 * wave + 8 * half;
    const int lr = tid >> 4, lch = tid & 15;
    LAS float* lbt = (LAS float*)lds;
    constexpr int P_RAW2 = 2048, P_IMG2 = P_RAW2 + 2 * RAW_BYTES;
    static_assert(P_IMG2 + 2 * IMG_BYTES <= 131072, "prep lds");
    __syncthreads();
    { const float l0 = a.in[I_LBL][tid], l1 = a.in[I_LBL][512 + tid], l2 = a.in[I_LBL][1024 + tid]; const float m = fmaxf(l0, fmaxf(l1, l2));
      const float e0 = __expf(l0 - m), e1 = __expf(l1 - m), e2 = __expf(l2 - m); lbt[tid] = e0 / (e0 + e1 + e2); }
    bf16x8 gq, gf;
#define HP_LOAD(it) do { const int ch_ = (it) % NCHUNK, cn_ = (it) / NCHUNK, dir_ = cn_ & 1, hd_ = (cn_ >> 1) & 3, b_ = cn_ >> 3; \
        const bf16* zr_ = Z + ((size_t)b_ * TPB + HG_TOKP(dir_, 32 * ch_ + lr)) * ZC; gq = *(const bf16x8*)(zr_ + ZHQ + hd_ * 128 + lch * 8); gf = *(const bf16x8*)(zr_ + (dir_ ? ZHB : ZHF) + hd_ * 128 + lch * 8); } while (0)
#define HP_STASH(bufi) do { LAS unsigned char* rb_ = lds + P_RAW2 + (bufi) * RAW_BYTES; *(LAS bf16x8*)(rb_ + R_Q + lr * RS + lch * 16) = gq; *(LAS bf16x8*)(rb_ + R_F + lr * RS + lch * 16) = gf; } while (0)
#define HP_COPYOUT(item, bufi) do { v4u* dst_ = (v4u*)(HT + (size_t)(item) * IMG_BYTES); const LAS v4u* src_ = (const LAS v4u*)(lds + P_IMG2 + (bufi) * IMG_BYTES); \
        dst_[tid] = src_[tid]; dst_[tid + 512] = src_[tid + 512]; dst_[tid + 1024] = src_[tid + 1024]; if (tid < 128) dst_[tid + 1536] = src_[tid + 1536]; } while (0)
    const int G = gridDim.x;
    int it = blockIdx.x, par = 0;
    if (it < NITEM) { HP_LOAD(it); HP_STASH(0); }
    if (it + G < NITEM) HP_LOAD(it + G);
    __syncthreads();
    for (; it < NITEM; it += G, par ^= 1) {
        if (it + G < NITEM) HP_STASH(par ^ 1);
        if (it != (int)blockIdx.x) HP_COPYOUT(it - G, par ^ 1);
        if (it + 2 * G < NITEM) HP_LOAD(it + 2 * G);
        const int hd = ((it / NCHUNK) >> 1) & 3;
        {
            const LAS unsigned char* rb_ = lds + P_RAW2 + par * RAW_BYTES;
            const bf16x8 RQ = *(const LAS bf16x8*)(rb_ + R_Q + t * RS + c0 * 2), RF = *(const LAS bf16x8*)(rb_ + R_F + t * RS + c0 * 2);
            const f32x4 lbA = *(const LAS f32x4*)(lbt + hd * 128 + c0), lbB = *(const LAS f32x4*)(lbt + hd * 128 + c0 + 4);
            LAS unsigned char* tb_ = lds + P_IMG2 + par * IMG_BYTES;
            float bb_[8], kk_[8];
#pragma unroll
            for (int i_ = 0; i_ < 8; ++i_) { const float lb_ = i_ < 4 ? lbA[i_] : lbB[i_ - 4]; const float f_ = lb_ + (1.f - lb_) * __builtin_amdgcn_rcpf(1.f + __expf(-bf2f((unsigned short)RF[i_]))); kk_[i_] = 1.f - f_; bb_[i_] = f_; }
#pragma unroll
            for (int i_ = 0; i_ < 8; ++i_) { float x_ = bb_[i_]; x_ *= HG_DPP1(x_, 0x111, 0xf); x_ *= HG_DPP1(x_, 0x112, 0xf); x_ *= HG_DPP1(x_, 0x114, 0xf); x_ *= HG_DPP1(x_, 0x118, 0xf);
                x_ *= HG_DPP1(x_, 0x142, 0xa); bb_[i_] = x_; }
            float qi_[8], ko_[8], ke_[8], dd_[8];
#pragma unroll
            for (int i_ = 0; i_ < 8; ++i_) { const int bi_ = __float_as_int(bb_[i_]); dd_[i_] = __int_as_float(half ? __builtin_amdgcn_readlane(bi_, 63) : __builtin_amdgcn_readlane(bi_, 31));
                const float e_ = bb_[i_]; const float ei_ = __builtin_amdgcn_rcpf(e_);
                qi_[i_] = bf2f((unsigned short)RQ[i_]) * e_; ko_[i_] = kk_[i_] * ei_; ke_[i_] = kk_[i_] * (dd_[i_] * ei_); }
            *(LAS v4u*)(tb_ + T_Q + t * RS + c0 * 2) = (v4u){pk2(qi_[0], qi_[1]), pk2(qi_[2], qi_[3]), pk2(qi_[4], qi_[5]), pk2(qi_[6], qi_[7])};
            *(LAS v4u*)(tb_ + T_KO + t * RS + c0 * 2) = (v4u){pk2(ko_[0], ko_[1]), pk2(ko_[2], ko_[3]), pk2(ko_[4], ko_[5]), pk2(ko_[6], ko_[7])};
            *(LAS v4u*)(tb_ + T_KE + t * RS + c0 * 2) = (v4u){pk2(ke_[0], ke_[1]), pk2(ke_[2], ke_[3]), pk2(ke_[4], ke_[5]), pk2(ke_[6], ke_[7])};
            if (t == 31) { *(LAS f32x4*)(tb_ + T_D + c0 * 4) = (f32x4){dd_[0], dd_[1], dd_[2], dd_[3]}; *(LAS f32x4*)(tb_ + T_D + c0 * 4 + 16) = (f32x4){dd_[4], dd_[5], dd_[6], dd_[7]}; }
            if (tid < 32) *(LAS v4u*)(tb_ + T_Q + tid * RS + 256) = (v4u){0u, 0u, 0u, 0u};
            else if (tid < 64) *(LAS v4u*)(tb_ + T_KO + (tid - 32) * RS + 256) = (v4u){0u, 0u, 0u, 0u};
            else if (tid < 96) *(LAS v4u*)(tb_ + T_KE + (tid - 64) * RS + 256) = (v4u){0u, 0u, 0u, 0u};
        }
        __syncthreads();
    }
    if (it - G >= (int)blockIdx.x && it - G < NITEM) HP_COPYOUT(it - G, par ^ 1);
    __syncthreads();
#undef HP_COPYOUT
#undef HP_LOAD
#undef HP_STASH
}

__device__ __forceinline__ void hgrn_unit_mfma(const Args& a, int unit, LAS unsigned char* lds, int tid) {
    using namespace hg;
    const int b = unit >> 5, head = (unit >> 3) & 3, dir = (unit >> 2) & 1, sl = unit & 3;
    const bf16* Z = (const bf16*)(a.ws + WS_Z);
    const unsigned char* HT = a.ws + WS_HT + (size_t)((b * 4 + head) * 2 + dir) * NCHUNK * IMG_BYTES;
    bf16* Od = (bf16*)(a.ws + (dir ? WS_OB : WS_OF));
    const int wave = __builtin_amdgcn_readfirstlane(tid >> 6), lane = tid & 63;
    const size_t zb = (size_t)b * TPB;
    constexpr int NCH = NCHUNK;
    const int vr = (tid >> 2) & 31, vp = tid & 3, lvcol = ZHI + head * 128 + sl * 32 + vp * 8, i3 = 1536 + (tid & 127);
    v4u gA0, gA1, gA2, gA3, gB0, gB1, gB2, gB3; bf16x8 gAv, gBv;
#define HG_LOAD(g0, g1, g2, g3, gv, ch) do { const int c_ = (ch) < NCH ? (ch) : NCH - 1; const v4u* src_ = (const v4u*)(HT + (size_t)c_ * IMG_BYTES); \
        g0 = src_[tid]; g1 = src_[tid + 512]; g2 = src_[tid + 1024]; g3 = src_[i3]; gv = *(const bf16x8*)(Z + (zb + HG_TOKP(dir, 32 * c_ + vr)) * ZC + lvcol); } while (0)
#define HG_STASH(g0, g1, g2, g3, gv, bufi) do { LAS unsigned char* tb_ = lds + OFF_TILES + (bufi) * TILE_BYTES; LAS v4u* d_ = (LAS v4u*)tb_; \
        d_[tid] = g0; d_[tid + 512] = g1; d_[tid + 1024] = g2; if (tid < 128) { d_[tid + 1536] = g3; *(LAS bf16x8*)(tb_ + T_V + vr * VS + vp * 16) = gv; } } while (0)
    const int r32 = lane & 31, hi = lane >> 5, g1 = (lane >> 4) & 1, q4 = (lane & 15) >> 2, p4 = lane & 3, cb = 32 * wave;
    const unsigned lbase = (unsigned)(uintptr_t)lds;
    f32x16 S = {};
    HG_LOAD(gA0, gA1, gA2, gA3, gAv, 0); HG_STASH(gA0, gA1, gA2, gA3, gAv, 0); HG_LOAD(gA0, gA1, gA2, gA3, gAv, 1); HG_STASH(gA0, gA1, gA2, gA3, gAv, 1);
    HG_LOAD(gA0, gA1, gA2, gA3, gAv, 2);
    __syncthreads();
#define HG_RD64(dst, addr, OFFS) asm volatile("ds_read_b64 %0, %1 offset:" #OFFS : "=&v"(dst) : "v"(addr) : "memory")
#define HG_MFMA_STAGE(n, bufi) do { \
            const unsigned tb = lbase + OFF_TILES + (bufi) * TILE_BYTES; const LAS unsigned char* tl_ = lds + OFF_TILES + (bufi) * TILE_BYTES; \
            bf16x8 ko[2], qi[2]; s16x4 pvl[2], pvh[2], pql[2], pqh[2], kl[2], kh[2], nvl[2], nvh[2]; f32x4 dsc[4]; \
            _Pragma("unroll") for (int kk = 0; kk < 2; ++kk) { ko[kk] = *(const LAS bf16x8*)(tl_ + T_KO + r32 * RS + (cb + 16 * kk + 8 * hi) * 2); qi[kk] = *(const LAS bf16x8*)(tl_ + T_Q + r32 * RS + (cb + 16 * kk + 8 * hi) * 2); } \
            _Pragma("unroll") for (int sp = 0; sp < 2; ++sp) { \
                const unsigned va = tb + T_V + (16 * sp + 4 * hi + q4) * VS + (16 * g1 + 4 * p4) * 2; pvl[sp] = tr_read(va); pvh[sp] = tr_read(va + 8 * VS);              \
                const unsigned qa = tb + T_Q + r32 * RS + (cb + 16 * sp + 4 * hi) * 2; HG_RD64(pql[sp], qa, 0); HG_RD64(pqh[sp], qa, 16);                                  \
                const unsigned ka = tb + T_KE + (16 * sp + 8 * hi + q4) * RS + (cb + 16 * g1 + 4 * p4) * 2; kl[sp] = tr_read(ka); kh[sp] = tr_read(ka + 4 * RS);        \
                const unsigned vb = tb + T_V + (16 * sp + 8 * hi + q4) * VS + (16 * g1 + 4 * p4) * 2; nvl[sp] = tr_read(vb); nvh[sp] = tr_read(vb + 4 * VS); }            \
            _Pragma("unroll") for (int g = 0; g < 4; ++g) dsc[g] = *(const LAS f32x4*)(tl_ + T_D + (cb + 8 * g + 4 * hi) * 4); \
            asm volatile("s_waitcnt lgkmcnt(0)" ::: "memory"); __builtin_amdgcn_sched_barrier(0); \
            f32x16 X = {}; \
            X = __builtin_amdgcn_mfma_f32_32x32x16_bf16(ko[0], qi[0], X, 0, 0, 0); X = __builtin_amdgcn_mfma_f32_32x32x16_bf16(ko[1], qi[1], X, 0, 0, 0); \
            f32x16 O = {}; \
            O = __builtin_amdgcn_mfma_f32_32x32x16_bf16(cat8(pql[0], pqh[0]), pack8(S, 0), O, 0, 0, 0); O = __builtin_amdgcn_mfma_f32_32x32x16_bf16(cat8(pql[1], pqh[1]), pack8(S, 8), O, 0, 0, 0); \
            _Pragma("unroll") for (int i = 0; i < 16; ++i) S[i] *= dsc[i >> 2][i & 3]; \
            S = __builtin_amdgcn_mfma_f32_32x32x16_bf16(cat8(kl[0], kh[0]), cat8(nvl[0], nvh[0]), S, 0, 0, 0); S = __builtin_amdgcn_mfma_f32_32x32x16_bf16(cat8(kl[1], kh[1]), cat8(nvl[1], nvh[1]), S, 0, 0, 0); \
            _Pragma("unroll") for (int i = 0; i < 16; ++i) X[i] = (crow(i, hi) <= r32) ? X[i] : 0.f; \
            O = __builtin_amdgcn_mfma_f32_32x32x16_bf16(pack8(X, 0), cat8(pvl[0], pvh[0]), O, 0, 0, 0); O = __builtin_amdgcn_mfma_f32_32x32x16_bf16(pack8(X, 8), cat8(pvl[1], pvh[1]), O, 0, 0, 0); \
            LAS float* op = (LAS float*)(lds + OFF_OPART + ((n) & 1) * OPART_BYTES + wave * 4096); \
            _Pragma("unroll") for (int i = 0; i < 16; ++i) op[crow(i, hi) * 32 + r32] = O[i]; } while (0)
#define HG_OUT_STAGE(n) do { \
            const int l2 = tid - 256, tt = l2 >> 3, vq = l2 & 7; \
            const LAS float* op = (const LAS float*)(lds + OFF_OPART + (((n) - 1) & 1) * OPART_BYTES) + tt * 32 + vq * 4; \
            const f32x4 s = (*(const LAS f32x4*)op + *(const LAS f32x4*)(op + 1024)) + (*(const LAS f32x4*)(op + 2048) + *(const LAS f32x4*)(op + 3072)); \
            const int p = HG_TOKP(dir, 32 * ((n) - 1) + tt); \
            if (p >= CTXL) *(v2u*)(Od + (zb + p) * 512 + head * 128 + sl * 32 + vq * 4) = (v2u){pk2(s[0], s[1]), pk2(s[2], s[3])}; } while (0)
#define HG_ITER(n, L0, L1, L2, L3, LV, S0, S1, S2, S3, SV) do { \
        HG_LOAD(L0, L1, L2, L3, LV, (n) + 3); \
        if (wave < 4) { HG_MFMA_STAGE(n, bcur); } else if ((n) > 0) { HG_OUT_STAGE(n); } \
        { const int bst_ = bcur == 0 ? 2 : bcur - 1; HG_STASH(S0, S1, S2, S3, SV, bst_); } \
        bcur = bcur == 2 ? 0 : bcur + 1; \
        __syncthreads(); } while (0)
    int bcur = 0;
    for (int n = 0; n < NCH; n += 2) {
        HG_ITER(n, gB0, gB1, gB2, gB3, gBv, gA0, gA1, gA2, gA3, gAv);
        HG_ITER(n + 1, gA0, gA1, gA2, gA3, gAv, gB0, gB1, gB2, gB3, gBv);
    }
    if (wave >= 4) { HG_OUT_STAGE(NCH); }
    __syncthreads();
#undef HG_MFMA_STAGE
#undef HG_OUT_STAGE
#undef HG_ITER
#undef HG_LOAD
#undef HG_STASH
#undef HG_RD64
}

__device__ __forceinline__ bool in_range(int lo, int hi, int k) { asm volatile("" : "+s"(lo), "+s"(hi)); return lo <= k && k < hi; }
constexpr int NPHASES = 21;
__global__ void __launch_bounds__(NTHR, 2) fwd_kernel(Args args) {
    extern __shared__ __attribute__((aligned(16))) unsigned char lds_raw[];
    LAS unsigned char* lds = (LAS unsigned char*)lds_raw;
    const int G = gridDim.x;
#define FRESH() int tid = threadIdx.x; asm volatile("" : "+v"(tid)); const int lane = tid & 63, wave = __builtin_amdgcn_readfirstlane(tid >> 6); (void)lane; (void)wave
    unsigned char* ws = args.ws;
    if (threadIdx.x < 16) ((LAS unsigned*)(lds + LDS_BAR_OFF))[threadIdx.x] = 0u;
    __syncthreads();
    XcdBarrier bar = xcd_barrier_post((unsigned*)(ws + WS_CTL), (volatile LAS unsigned*)(lds + LDS_BAR_OFF));
    const int lo = args.ph_lo, hi = args.ph_hi;
#define IN(k) in_range(lo, hi, (k))
#define NREP(k) (((PROBE_MASK >> (k)) & 1u) ? 2 : 1)
#define REPEAT(k) for (int rep_ = 0; rep_ < NREP(k); ++rep_) if (rep_ == 0 || (xcd_barrier(bar), true))
#define SEAM(k) do { if (IN(k) && IN((k) + 1)) xcd_barrier(bar); } while (0)
    bf16* const BX = (bf16*)(ws + WS_X); bf16* const BY = (bf16*)(ws + WS_Y);
    const float* const MODV = (const float*)(ws + WS_MODV);

#if defined(PROBE_BARS)
    for (int pbi = 0; pbi < PROBE_BARS; ++pbi) xcd_barrier(bar);
#endif
    if (IN(0)) REPEAT(0) { FRESH(); phase_prologue(args, lds, tid, lane, wave); } SEAM(0);
    if (IN(1)) REPEAT(1) { FRESH(); phase_mod0(args, lane, wave); } SEAM(1);
    if (IN(2)) REPEAT(2) {
        pg8::Gemm g{BX, (const bf16*)(ws + WS_WIN), NTOK, ZC, 1024}; pg8::AllOrder S; S.init(NTOK / 256, ZC / 256, G, (int)blockIdx.x);
        pg8::EpiBf16<0> E{(bf16*)(ws + WS_Z), ZC, nullptr, 0, 0, 1.f};
        pg8::gemm_phase<pg8::EpiBf16<0>, pg8::AllOrder, PG8_ALIGN, PG8_SP2>(lds, g, S, E);
    } SEAM(2);
    if (IN(3)) REPEAT(3) { FRESH(); phase_norm0(args, lane, wave); hgrn_prep_items(args, lds, tid); } SEAM(3);
    if (IN(4)) REPEAT(4) {
        { pg8::Gemm g{(const bf16*)(ws + WS_CQN), (const bf16*)(ws + WS_WUQ), NTOK, 768, 384}; pg8::LatOrder S; S.init(128, 3, G, (int)blockIdx.x);
          pg8::EpiBf16<0> E{(bf16*)(ws + WS_Q), 768, nullptr, 0, 0, 1.f};
          pg8::gemm_phase<pg8::EpiBf16<0>, pg8::LatOrder, PG8_ALIGN, PG8_SP2>(lds, g, S, E); }
        __syncthreads();
        { pg8::Gemm g{(const bf16*)(ws + WS_CKVN), (const bf16*)(ws + WS_WUKV), NTOK, 1024, 256}; pg8::AllOrder S; S.init(NTOK / 256, 4, G, (int)blockIdx.x);
          pg8::EpiBf16<0> E{(bf16*)(ws + WS_KV), 1024, nullptr, 0, 0, 1.f};
          pg8::gemm_phase<pg8::EpiBf16<0>, pg8::AllOrder, PG8_ALIGN, PG8_SP2>(lds, g, S, E); }
    } SEAM(4);
    if (IN(5)) {
        REPEAT(21) { FRESH();
        for (int u = blockIdx.x; u < 256; u += G) { __syncthreads(); hgrn_unit_mfma(args, (G == 256) ? ((u & 7) * 32 + (u >> 3)) : u, lds, tid); } }
        const bf16* Q = (const bf16*)(ws + WS_Q); const bf16* KV = (const bf16*)(ws + WS_KV); const bf16* KRR = (const bf16*)(ws + WS_KRR);
        const float* rope = (const float*)(ws + WS_ROPE);
        const int cslot = (G == 256) ? ((((int)blockIdx.x & 7) * 2 + (((int)blockIdx.x >> 3) >> 4)) % 5) : 0;
        REPEAT(22) {
        int ai = 0;
        for (int slot = 0; slot < 5; ++slot) {
            if (slot == cslot) { if (rep_ == 0) { FRESH(); __syncthreads(); convert_moe_share(args, lds, lane, wave); } continue; }
            for (int u = (G == 256) ? (int)blockIdx.x + ai * 256 : (int)blockIdx.x; u < ((G == 256) ? (int)blockIdx.x + ai * 256 + 1 : (ai == 0 ? 1024 : 0)); u += G) {
                int b, h, qb; if (G == 256) { const int x = (int)blockIdx.x & 7, j = (int)blockIdx.x >> 3, pr = (u >> 8) * 16 + 2 * x + (j >> 4); b = pr >> 3; h = pr & 7; qb = j & 15; } else { b = u >> 7; h = (u >> 4) & 7; qb = u & 15; }
                const size_t kb = (size_t)b * TPB, q0 = kb + CTXL + (size_t)qb * 256;
                __syncthreads();
                att::attn_unit(Q + q0 * 768 + h * 96, KV + kb * 1024 + h * 64, KRR + kb * 32, BY + q0 * 1024 + h * 64, rope + (size_t)qb * 256 * 32, TPB, (char*)lds_raw);
            }
            ++ai;
        }
        }
    } SEAM(5);
    if (IN(6)) REPEAT(6) { FRESH(); phase_readout(args, lane, wave); } SEAM(6);
    if (IN(7)) REPEAT(7) {
        pg8::Gemm g{BY, (const bf16*)(ws + WS_WOUT), NTOK, 1024, 1024}; pg8::LatOrder S; S.init(128, 4, G, (int)blockIdx.x);
        pg8::EpiRes E{args.in[I_X], (float*)(ws + WS_H), MODV, nullptr};
        pg8::gemm_phase<pg8::EpiRes, pg8::LatOrder, PG8_ALIGN, PG8_SP2>(lds, g, S, E);
    } SEAM(7);
    for (int l = 0; l < 2; ++l) {
        if (l == 1) {
            if (IN(13)) REPEAT(13) {
                pg8::Gemm g{BY, (const bf16*)(ws + WS_WPW1), NTOK, 2048, 1024}; pg8::LatOrder S; S.init(128, 8, G, (int)blockIdx.x);
                pg8::EpiGate<0> E{BX, (const float*)(ws + WS_PW1B), 8, 1.f, 1.f};
                pg8::gemm_phase<pg8::EpiGate<0>, pg8::LatOrder, PG8_ALIGN, PG8_SP2>(lds, g, S, E);
            } SEAM(13);
            if (IN(14)) REPEAT(14) { FRESH(); phase_conv(args, lds, tid, lane, wave); } SEAM(14);
            if (IN(15)) REPEAT(15) {
                pg8::Gemm g{BY, (const bf16*)(ws + WS_WPW2), NTOK, 1024, 1024}; pg8::LatOrder S; S.init(128, 4, G, (int)blockIdx.x);
                pg8::EpiRes E{nullptr, (float*)(ws + WS_H), MODV + 9 * 6144, args.in[I_PW2B]};
                pg8::gemm_phase<pg8::EpiRes, pg8::LatOrder, PG8_ALIGN, PG8_SP2>(lds, g, S, E);
            } SEAM(15);
        }
        const int pb = l ? 16 : 8;
        if (IN(pb)) REPEAT(pb) { FRESH(); phase_ln1(args, l, lds, tid, lane, wave); } SEAM(pb);
        if (IN(pb + 2) || IN(pb + 3)) {
            LAS int* tl = (LAS int*)(lds + LDS_TILE_E);
            FRESH();
            __syncthreads();
            if (tid < 32) tl[3 * MAXTILES + 64 + tid] = ld_ctl((const int*)(ws + WS_CURSOR) + l * 32 + tid);
            __syncthreads();
            if (tid == 0) { int ts = 0; for (int e = 0; e < 32; ++e) { tl[3 * MAXTILES + e] = ts; ts += (tl[3 * MAXTILES + 64 + e] + 255) >> 8; } tl[3 * MAXTILES + 32] = ts; }
            __syncthreads();
            const int ntiles = tl[3 * MAXTILES + 32];
            for (int t = tid; t < ntiles && t < MAXTILES; t += NTHR) { int e = 0; while (e < 31 && tl[3 * MAXTILES + e + 1] <= t) ++e; const int j = t - tl[3 * MAXTILES + e], rem = tl[3 * MAXTILES + 64 + e] - 256 * j;
                tl[t] = e; tl[MAXTILES + t] = e * ECAP + 256 * j; tl[2 * MAXTILES + t] = rem < 256 ? rem : 256; }
            __syncthreads();
            if (IN(pb + 2)) REPEAT(pb + 2) {
#if defined(PROBE_STAGGER)
                if (blockIdx.x & 1) { const unsigned long long t0 = __builtin_amdgcn_s_memrealtime(); while (__builtin_amdgcn_s_memrealtime() - t0 < PROBE_STAGGER) __builtin_amdgcn_s_sleep(8); }
#endif
                pg8::Gemm g{BX, (const bf16*)(ws + WS_WGU + (size_t)l * 32 * 2048 * 1024), 0, 0, 512};
                pg8::MoeOrder S; S.init(ntiles, 8, G, (int)blockIdx.x); S.tile_e = tl; S.nper = 8;
                pg8::EpiGate<1, true> E{(bf16*)(ws + WS_ACT), (const float*)(ws + WS_BGU) + (size_t)l * 32 * 2048, 8, 1.f / (SC_X8 * SC_WGU) * PROBE_KSC, SC_ACT};
                pg8::gemm_phase<pg8::EpiGate<1, true>, pg8::MoeOrder, PG8_ALIGN, true, true, true>(lds, g, S, E, (const int*)(ws + WS_ROWS), tl + MAXTILES);
            } SEAM(pb + 2);
            if (IN(pb + 3)) REPEAT(pb + 3) {
                pg8::Gemm g{(const bf16*)(ws + WS_ACT), (const bf16*)(ws + WS_WDN + (size_t)l * 32 * 1024 * 1024), 0, 0, 512};
                pg8::MoeOrder S; S.init(ntiles, 4, G, (int)blockIdx.x); S.tile_e = tl; S.nper = 4;
                pg8::EpiDown E{(bf16*)(ws + WS_YB), args.in[I_BDN] + (size_t)l * 32 * 1024, (const float*)(ws + WS_ROWW), (const int*)(ws + WS_ROWD), 1.f / (SC_ACT * SC_WDN) * PROBE_KSC, tl + MAXTILES, SC_Y};
                pg8::gemm_phase<pg8::EpiDown, pg8::MoeOrder, PG8_ALIGN, true, false, true>(lds, g, S, E);
            } SEAM(pb + 3);
        }
        if (IN(pb + 4)) REPEAT(pb + 4) { FRESH(); phase_ln2(args, l, lane, wave); }
        if (l == 0) SEAM(12);
    }
#undef IN
#undef SEAM
}

extern "C" void kernel_launch(void* const* d_in, const int* in_sizes, int n_in, void* d_out, int out_size, void* d_ws, size_t ws_size, hipStream_t stream) {
    static int grid = 0;
    if (grid == 0) {
        if (n_in != 33 || in_sizes[0] != NB * SEQ * D || out_size != NB * SEQ * D || ws_size < WS_END) {
            fprintf(stderr, "kernel_launch: unexpected shapes: n_in %d in0 %d out %d ws %zu (need %zu)\n", n_in, n_in > 0 ? in_sizes[0] : -1, out_size, ws_size, (size_t)WS_END); grid = -1; return; }
        int dev = 0, cus = 0;
        if (hipGetDevice(&dev) != hipSuccess || hipDeviceGetAttribute(&cus, hipDeviceAttributeMultiprocessorCount, dev) != hipSuccess) { grid = -1; return; }
        if (hipFuncSetAttribute((const void*)fwd_kernel, hipFuncAttributeMaxDynamicSharedMemorySize, LDS_BYTES) != hipSuccess) { fprintf(stderr, "kernel_launch: hipFuncSetAttribute failed\n"); grid = -1; return; }
        int per_cu = 0;
        if (hipOccupancyMaxActiveBlocksPerMultiprocessor(&per_cu, (const void*)fwd_kernel, NTHR, LDS_BYTES) != hipSuccess || per_cu < 1) fprintf(stderr, "kernel_launch: occupancy query reports %d\n", per_cu);
        (void)hipGetLastError();
        grid = cus;
    }
    if (grid < 0) return;
    if (hipMemsetAsync((char*)d_ws + WS_CTL, 0, CTL_ZERO_BYTES, stream) != hipSuccess) return;
    Args a{};
    for (int i = 0; i < 33; ++i) a.in[i] = (const float*)d_in[i];
    a.out = (float*)d_out; a.ws = (unsigned char*)d_ws;
#if MK_ONE_LAUNCH
    a.ph_lo = 0; a.ph_hi = NPHASES;
    hipLaunchKernelGGL(fwd_kernel, dim3(grid), dim3(NTHR), LDS_BYTES, stream, a);
#else
    for (int ph = 0; ph < NPHASES; ++ph) { a.ph_lo = ph; a.ph_hi = ph + 1; hipLaunchKernelGGL(fwd_kernel, dim3(grid), dim3(NTHR), LDS_BYTES, stream, a); }
#endif
    const hipError_t le = hipPeekAtLastError();
    if (le != hipSuccess) fprintf(stderr, "kernel_launch: launch failed: %s\n", hipGetErrorName(le));
}
```

```cpp
#include <hip/hip_runtime.h>
#include <cstdio>
#include <cstdint>

#ifndef PROBE_MASK
#define PROBE_MASK 0u
#endif
#if defined(PROBE_K2)
#define PROBE_KSC 0.5f
#else
#define PROBE_KSC 1.0f
#endif
#ifndef MK_ONE_LAUNCH
#define MK_ONE_LAUNCH 1
#endif

namespace pg8 {
#define PG8_LAS __attribute__((address_space(3)))
typedef unsigned short bf16_t;
typedef short bf16x8 __attribute__((ext_vector_type(8)));
typedef float f32x4 __attribute__((ext_vector_type(4)));
typedef unsigned u32x4 __attribute__((ext_vector_type(4)));
constexpr int BM = 256, BK = 64, HALF = 128, HTB = HALF * BK * 2  , STAGE_BYTES = 8 * HTB, NXCD = 8, WGM = 8;

__host__ __device__ __forceinline__ int lds_byte(int r, int c) { const int st = (r >> 4) * 2 + (c >> 5), rr = r & 15, cc = c & 31, ob = rr * 64 + cc * 2; return st * 1024 + (ob ^ (((ob >> 9) & 1) << 5)); }
__host__ __device__ __forceinline__ void stage_rc(int b, int& R, int& C) { const int st = b / 1024, sb = b % 1024, swz = sb ^ (((sb >> 9) & 1) << 5); R = (st >> 1) * 16 + swz / 64; C = (st & 1) * 32 + (swz % 64) / 2; }
__host__ __device__ __forceinline__ int perm32(int rho) { const int n = rho >> 4, i = rho & 15; return 8 * (i >> 2) + 4 * n + (i & 3); }

struct Unit { int pm, pn; };
struct Gemm { const bf16_t* A; const bf16_t* Bt; int M, N, K; };

struct StaticOrder {
    int nM, nN, nwg, G, c;
    __host__ __device__ void init(int M, int N, int G_, int c_) { nM = M / BM; nN = N / BM; nwg = nM * nN; G = G_; c = c_; }
    __host__ __device__ bool next(int i, Unit& u) const {
        const long L = (long)i * G + c; if (L >= nwg) return false;
        int wgid = (int)L; { const int q = nwg / NXCD, r = nwg % NXCD, xcd = wgid % NXCD, off = wgid / NXCD; wgid = (xcd < r ? xcd * (q + 1) : r * (q + 1) + (xcd - r) * q) + off; }
        const int nig = WGM * nN, gid = wgid / nig, fm = gid * WGM, gsz = (nM - fm) < WGM ? (nM - fm) : WGM;
        u.pm = fm + ((wgid % nig) % gsz); u.pn = (wgid % nig) / gsz; return true;
    }
    __device__ __forceinline__ void a_ready(const Unit&) const {}
    __device__ __forceinline__ void done(const Unit&) const {}
};

__device__ __forceinline__ unsigned cvt_pk_bf16(float lo, float hi) { unsigned r; asm volatile("v_cvt_pk_bf16_f32 %0, %1, %2" : "=v"(r) : "v"(lo), "v"(hi)); return r; }
typedef float f32x2 __attribute__((ext_vector_type(2)));
__device__ __forceinline__ f32x2 gelu_pk(f32x2 v) {
    const f32x2 av = __builtin_elementwise_abs(v), d = av * 0.2316418882f + 1.0f;
    f32x2 t; t.x = __builtin_amdgcn_rcpf(d.x); t.y = __builtin_amdgcn_rcpf(d.y);
    f32x2 q = t * 0.5307027145f + (-0.7265760135f); q = q * t + 0.7107068705f; q = q * t + (-0.142248368f); q = q * t + 0.127414796f; q = q * t;
    const f32x2 s = (v * v) * (-0.72134752044f);
    f32x2 e; e.x = __builtin_amdgcn_exp2f(s.x); e.y = __builtin_amdgcn_exp2f(s.y);
    const f32x2 m = v * (q * e), r = v - m;
    f32x2 o; o.x = v.x < 0.f ? m.x : r.x; o.y = v.y < 0.f ? m.y : r.y; return o;
}

template <int ACT  > struct EpiBf16 {
    static constexpr bool PERM = true, AFTER_DRAIN = false; static_assert(ACT == 0 || ACT == 1, "EpiBf16: ACT is 0 (none) or 1 (gelu_pk)");
    bf16_t* O; int ldc; const float* bias; int split_cols; size_t split_stride; float scale0;
    __device__ __forceinline__ void operator()(const f32x4 (&acc)[2][2][4][2], const Unit& u, int wr, int wc, int fr, int fq) const {
        const int row0 = u.pm * BM + wr * 64 + fr; int colt = u.pn * BM; bf16_t* base = O;
        float sc = 1.f; if (split_cols) { const int t = colt / split_cols; base += (size_t)t * split_stride; colt -= t * split_cols; if (t == 0) sc = scale0; }
        const int col0 = colt + wc * 32 + 8 * fq, bcol0 = u.pn * BM + wc * 32 + 8 * fq;
        f32x4 bv[2][2];
#pragma unroll
        for (int bj = 0; bj < 2; ++bj)
#pragma unroll
            for (int n = 0; n < 2; ++n) bv[bj][n] = bias ? *(const f32x4*)(bias + bcol0 + bj * HALF + 4 * n) : (f32x4){0.f, 0.f, 0.f, 0.f};
#pragma unroll
        for (int ai = 0; ai < 2; ++ai)
#pragma unroll
            for (int m = 0; m < 4; ++m) { bf16_t* rowp = base + (size_t)(row0 + ai * HALF + m * 16) * ldc + col0;
#pragma unroll
                for (int bj = 0; bj < 2; ++bj) { f32x4 v0 = acc[ai][bj][m][0] + bv[bj][0], v1 = acc[ai][bj][m][1] + bv[bj][1];
                    if (ACT == 1) { f32x2 a = gelu_pk((f32x2){v0[0], v0[1]}), b = gelu_pk((f32x2){v0[2], v0[3]}), c = gelu_pk((f32x2){v1[0], v1[1]}), d = gelu_pk((f32x2){v1[2], v1[3]});
                        v0 = (f32x4){a.x, a.y, b.x, b.y}; v1 = (f32x4){c.x, c.y, d.x, d.y}; }
                    v0 = v0 * sc; v1 = v1 * sc; u32x4 w; w.x = cvt_pk_bf16(v0[0], v0[1]); w.y = cvt_pk_bf16(v0[2], v0[3]); w.z = cvt_pk_bf16(v1[0], v1[1]); w.w = cvt_pk_bf16(v1[2], v1[3]);
                    *(u32x4*)(rowp + bj * HALF) = w; } }
    }
};
typedef int v4i_t __attribute__((ext_vector_type(4)));
typedef int v8i_t __attribute__((ext_vector_type(8)));
__device__ __forceinline__ v8i_t cat32(bf16x8 a, bf16x8 b) { const v4i_t x = __builtin_bit_cast(v4i_t, a), y = __builtin_bit_cast(v4i_t, b); return __builtin_shufflevector(x, y, 0, 1, 2, 3, 4, 5, 6, 7); }
template <class Epi, class Sched, bool ALIGN_EPI = false, bool SP2 = false, bool GATHER = false, bool FP8 = false>
__device__ __forceinline__ void gemm_phase(PG8_LAS unsigned char* lds, const Gemm g, const Sched& S, const Epi& E, const int* rowsrc = nullptr, const PG8_LAS int* gtab = nullptr) {
    static_assert(!GATHER || SP2, "GATHER is implemented on the SP2 loop only");
    int tid_l = threadIdx.x; asm volatile("" : "+v"(tid_l));
    const int tid = tid_l, wid = __builtin_amdgcn_readfirstlane(tid >> 6), lane = tid & 63, wr = wid >> 2, wc = wid & 3, fr = lane & 15, fq = lane >> 4;
#if defined(PROBE_K2)
    const int K = g.K, nt0 = K / BK, nt = FP8 ? 2 * nt0 : nt0;
#define PG8_KT(x) (FP8 ? ((x) & (nt0 - 1)) : (x))
#else
    const int K = g.K, nt = K / BK;
#define PG8_KT(x) (x)
#endif
    unsigned voffA[2], voffB[2];
#pragma unroll
    for (int i = 0; i < 2; ++i) { int R, C; stage_rc(tid * 16 + i * 8192, R, C); const int Rb = Epi::PERM ? ((R & ~31) + perm32(R & 31)) : R;
        voffA[i] = (unsigned)(R * K + C) * 2u; voffB[i] = (unsigned)(Rb * K + C) * 2u; }
    unsigned gAc[2][2], gAn[2][2]; int gR[2]; unsigned gC[2];
#pragma unroll
    for (int i = 0; i < 2; ++i) { int R, C; stage_rc(tid * 16 + i * 8192, R, C); gR[i] = R; gC[i] = (unsigned)C * 2u; gAc[0][i] = gAc[1][i] = gAn[0][i] = gAn[1][i] = 0u; }
#define PG8_GATHER(u_, o_) do { const int gtb_ = gtab[(u_).pm], gtc_ = gtab[576 + (u_).pm];     \
        _Pragma("unroll") for (int h_ = 0; h_ < 2; ++h_) _Pragma("unroll") for (int i_ = 0; i_ < 2; ++i_) \
        { const int rl_ = h_ * HALF + gR[i_]; const int src_ = rl_ < gtc_ ? rowsrc[gtb_ + rl_] : 0; o_[h_][i_] = (unsigned)src_ * (unsigned)(K * 2) + gC[i_]; } } while (0)
#define PG8_STAGE_A(bufoff, orig_gbase, NEXTSEL, H, KOFF) do { if constexpr (GATHER) { unsigned vo_[2]; vo_[0] = (NEXTSEL) ? gAn[H][0] : gAc[H][0]; vo_[1] = (NEXTSEL) ? gAn[H][1] : gAc[H][1]; \
        PG8_STAGE(bufoff, (const char*)g.A + (KOFF), vo_); } else { PG8_STAGE(bufoff, orig_gbase, voffA); } } while (0)
    const size_t kstep = (size_t)(BK * 2);
    const size_t hstep = (size_t)HALF * K * 2;
    const size_t tstep = 2 * hstep;
    const unsigned ldsw = (unsigned)wid * 1024u;
    const int aoff = lds_byte(wr * 64 + fr, fq * (FP8 ? 16 : 8)), boff = lds_byte(wc * 32 + fr, fq * (FP8 ? 16 : 8));
#define PG8_SA(b, h) (((b) * 2 + (h)) * HTB)
#define PG8_SB(b, h) ((4 + (b) * 2 + (h)) * HTB)
#define PG8_STAGE(bufoff, gbase, voff) do { _Pragma("unroll") for (int _i = 0; _i < 2; ++_i) \
        __builtin_amdgcn_global_load_lds((const unsigned*)((const char*)(gbase) + (voff)[_i]), (PG8_LAS unsigned*)(lds + (bufoff) + ldsw + _i * 8192), 16, 0, 0); } while (0)
#define PG8_LD32(var, addr) do { const bf16x8 lo_ = *(const PG8_LAS bf16x8*)(addr); const bf16x8 hi_ = *(const PG8_LAS bf16x8*)((addr) + 16); var = cat32(lo_, hi_); } while (0)
#define PG8_LDA(dst, b, h) do { if constexpr (FP8) { _Pragma("unroll") for (int m = 0; m < 4; ++m) PG8_LD32(dst##8[m], lds + PG8_SA(b, h) + aoff + m * 2048); } \
        else { _Pragma("unroll") for (int m = 0; m < 4; ++m) _Pragma("unroll") for (int k = 0; k < 2; ++k) dst[m][k] = *(const PG8_LAS bf16x8*)(lds + PG8_SA(b, h) + aoff + m * 2048 + k * 1024); } } while (0)
#define PG8_LDB(dst, b, h) do { if constexpr (FP8) { _Pragma("unroll") for (int n = 0; n < 2; ++n) PG8_LD32(dst##8[n], lds + PG8_SB(b, h) + boff + n * 2048); } \
        else { _Pragma("unroll") for (int n = 0; n < 2; ++n) _Pragma("unroll") for (int k = 0; k < 2; ++k) dst[n][k] = *(const PG8_LAS bf16x8*)(lds + PG8_SB(b, h) + boff + n * 2048 + k * 1024); } } while (0)
#define PG8_MMA(ai, bj, At, Bt) do { __builtin_amdgcn_s_setprio(1); \
        if constexpr (FP8) { _Pragma("unroll") for (int m = 0; m < 4; ++m) _Pragma("unroll") for (int n = 0; n < 2; ++n) \
            asm volatile("v_mfma_scale_f32_16x16x128_f8f6f4 %0, %1, %2, %0, %3, %3 op_sel_hi:[0,0,0]" : "+v"(acc[ai][bj][m][n]) : "v"(Bt##8[n]), "v"(At##8[m]), "v"(sc127)); } \
        else { _Pragma("unroll") for (int m = 0; m < 4; ++m) _Pragma("unroll") for (int n = 0; n < 2; ++n) _Pragma("unroll") for (int k = 0; k < 2; ++k) \
            acc[ai][bj][m][n] = __builtin_amdgcn_mfma_f32_16x16x32_bf16(Bt[n][k], At[m][k], acc[ai][bj][m][n], 0, 0, 0); } \
        __builtin_amdgcn_s_setprio(0); } while (0)
#define PG8_WAIT_V(n) asm volatile("s_waitcnt vmcnt(" #n ")" ::: "memory")
#define PG8_WAIT_L(n) asm volatile("s_waitcnt lgkmcnt(" #n ")" ::: "memory")
#define PG8_BAR __builtin_amdgcn_s_barrier()
#define PG8_SCHED __builtin_amdgcn_sched_barrier(0)
    Unit cur, nxt; int ui = 0;
    if (!S.next(0, cur)) return;
    f32x4 acc[2][2][4][2];
#pragma unroll
    for (int a = 0; a < 2; ++a)
#pragma unroll
        for (int b = 0; b < 2; ++b)
#pragma unroll
            for (int m = 0; m < 4; ++m)
#pragma unroll
                for (int n = 0; n < 2; ++n) acc[a][b][m][n] = (f32x4){0.f, 0.f, 0.f, 0.f};
    int sc127 = 0x7f7f7f7f; asm volatile("" : "+v"(sc127));
    bf16x8 At[4][2], B0[2][2], B1[2][2]; v8i_t At8[4], B08[2], B18[2]; (void)At; (void)B0; (void)B1; (void)At8; (void)B08; (void)B18;
    const char* cA = (const char*)g.A + (size_t)cur.pm * tstep; const char* cB = (const char*)g.Bt + (size_t)cur.pn * tstep;
    S.a_ready(cur);
    if constexpr (GATHER) { PG8_GATHER(cur, gAc); }
    if constexpr (SP2) {
        PG8_STAGE(PG8_SB(0, 0), cB, voffB); PG8_STAGE(PG8_SB(0, 1), cB + hstep, voffB); PG8_STAGE_A(PG8_SA(0, 0), cA, false, 0, (size_t)0); PG8_STAGE_A(PG8_SA(0, 1), cA + hstep, false, 1, (size_t)0);
        if (wr == 1) PG8_BAR;
        PG8_WAIT_V(2); PG8_BAR;
        PG8_STAGE(PG8_SB(1, 0), cB + kstep, voffB); PG8_STAGE_A(PG8_SA(1, 0), cA + kstep, false, 0, kstep); PG8_STAGE(PG8_SB(1, 1), cB + hstep + kstep, voffB);
        PG8_WAIT_V(6); PG8_BAR;
    } else {
        PG8_STAGE(PG8_SB(0, 0), cB, voffB); PG8_STAGE(PG8_SA(0, 0), cA, voffA); PG8_STAGE(PG8_SB(0, 1), cB + hstep, voffB); PG8_STAGE(PG8_SA(0, 1), cA + hstep, voffA);
        if (wr == 1) PG8_BAR;
        PG8_WAIT_V(4); PG8_BAR;
        PG8_STAGE(PG8_SB(1, 0), cB + kstep, voffB); PG8_STAGE(PG8_SA(1, 0), cA + kstep, voffA); PG8_STAGE(PG8_SB(1, 1), cB + hstep + kstep, voffB);
        PG8_WAIT_V(6); PG8_BAR;
    }
    for (;;) {
        const bool has_next = S.next(ui + 1, nxt);
        if constexpr (GATHER) { if (has_next) { PG8_GATHER(nxt, gAn); } else { _Pragma("unroll") for (int h_ = 0; h_ < 2; ++h_) _Pragma("unroll") for (int i_ = 0; i_ < 2; ++i_) gAn[h_][i_] = gAc[h_][i_]; } }
        const char* nA = has_next ? (const char*)g.A + (size_t)nxt.pm * tstep : cA; const char* nB = has_next ? (const char*)g.Bt + (size_t)nxt.pn * tstep : cB;
#pragma nounroll
        for (int t = 0; t < nt; t += 2) {
            const bool last = (t == nt - 2);
            const char* a1 = cA + (size_t)PG8_KT(t + 1) * kstep;
            const char* a2 = last ? nA : cA + (size_t)PG8_KT(t + 2) * kstep; const char* b2 = last ? nB : cB + (size_t)PG8_KT(t + 2) * kstep;
            const char* a3 = a2 + kstep; const char* b3 = b2 + kstep;
            const size_t k1 = (size_t)PG8_KT(t + 1) * kstep, k2 = last ? (size_t)0 : (size_t)PG8_KT(t + 2) * kstep, k3 = k2 + kstep; (void)k1; (void)k2; (void)k3;
            if (last && has_next) S.a_ready(nxt);
            if constexpr (SP2) {
            PG8_LDB(B0, 0, 0); PG8_LDB(B1, 0, 1); PG8_SCHED; PG8_LDA(At, 0, 0); PG8_STAGE_A(PG8_SA(1, 1), a1 + hstep, false, 1, k1);
            PG8_WAIT_V(8); PG8_WAIT_L(0); PG8_BAR; PG8_MMA(0, 0, At, B0); PG8_MMA(0, 1, At, B1); PG8_BAR; PG8_SCHED;
            PG8_LDA(At, 0, 1); PG8_STAGE(PG8_SB(0, 0), b2, voffB); PG8_STAGE(PG8_SB(0, 1), b2 + hstep, voffB); PG8_STAGE_A(PG8_SA(0, 0), a2, last, 0, k2);
            PG8_WAIT_V(8); PG8_WAIT_L(0); PG8_BAR; PG8_MMA(1, 0, At, B0); PG8_MMA(1, 1, At, B1); PG8_BAR; PG8_SCHED;
            PG8_LDB(B0, 1, 0); PG8_LDB(B1, 1, 1); PG8_SCHED; PG8_LDA(At, 1, 0); PG8_STAGE_A(PG8_SA(0, 1), a2 + hstep, last, 1, k2);
            PG8_WAIT_V(8); PG8_WAIT_L(0); PG8_BAR; PG8_MMA(0, 0, At, B0); PG8_MMA(0, 1, At, B1); PG8_BAR; PG8_SCHED;
            PG8_LDA(At, 1, 1); PG8_STAGE(PG8_SB(1, 0), b3, voffB); PG8_STAGE(PG8_SB(1, 1), b3 + hstep, voffB); PG8_STAGE_A(PG8_SA(1, 0), a3, last, 0, k3);
            PG8_WAIT_V(8); PG8_WAIT_L(0); PG8_BAR; PG8_MMA(1, 0, At, B0); PG8_MMA(1, 1, At, B1); PG8_BAR; PG8_SCHED;
            } else {
            PG8_LDB(B0, 0, 0); PG8_SCHED; PG8_LDA(At, 0, 0); PG8_STAGE(PG8_SA(1, 1), a1 + hstep, voffA);
            PG8_WAIT_L(8); PG8_BAR; PG8_WAIT_L(0); PG8_MMA(0, 0, At, B0); PG8_BAR; PG8_SCHED;
            PG8_LDB(B1, 0, 1); PG8_STAGE(PG8_SB(0, 0), b2, voffB);
            PG8_BAR; PG8_WAIT_L(0); PG8_MMA(0, 1, At, B1); PG8_BAR;
            PG8_LDA(At, 0, 1); PG8_STAGE(PG8_SA(0, 0), a2, voffA);
            PG8_BAR; PG8_WAIT_L(0); PG8_MMA(1, 0, At, B0); PG8_BAR; PG8_SCHED;
            PG8_STAGE(PG8_SB(0, 1), b2 + hstep, voffB);
            PG8_WAIT_V(6); PG8_BAR; PG8_MMA(1, 1, At, B1); PG8_BAR;
            PG8_LDB(B0, 1, 0); PG8_SCHED; PG8_LDA(At, 1, 0); PG8_STAGE(PG8_SA(0, 1), a2 + hstep, voffA);
            PG8_WAIT_L(8); PG8_BAR; PG8_WAIT_L(0); PG8_MMA(0, 0, At, B0); PG8_BAR; PG8_SCHED;
            PG8_LDB(B1, 1, 1); PG8_STAGE(PG8_SB(1, 0), b3, voffB);
            PG8_BAR; PG8_WAIT_L(0); PG8_MMA(0, 1, At, B1); PG8_BAR;
            PG8_LDA(At, 1, 1); PG8_STAGE(PG8_SA(1, 0), a3, voffA);
            PG8_BAR; PG8_WAIT_L(0); PG8_MMA(1, 0, At, B0); PG8_BAR; PG8_SCHED;
            PG8_STAGE(PG8_SB(1, 1), b3 + hstep, voffB);
            PG8_WAIT_V(6); PG8_BAR; PG8_MMA(1, 1, At, B1); PG8_BAR;
            }
        }
        if constexpr (ALIGN_EPI) { if (wr == 0) PG8_BAR; }
        if constexpr (FP8) { asm volatile("s_nop 15\n\ts_nop 15" ::: "memory"); }
        if constexpr (!Epi::AFTER_DRAIN) { E(acc, cur, wr, wc, fr, fq);
#if defined(PROBE_EPI2)
            if constexpr (FP8 == (PROBE_EPI2 == 1)) { E(acc, cur, wr, wc, fr, fq); }
#endif
            S.done(cur); }
        if (!has_next) break;
#pragma unroll
        for (int a = 0; a < 2; ++a)
#pragma unroll
            for (int b = 0; b < 2; ++b)
#pragma unroll
                for (int m = 0; m < 4; ++m)
#pragma unroll
                    for (int n = 0; n < 2; ++n) acc[a][b][m][n] = (f32x4){0.f, 0.f, 0.f, 0.f};
        cur = nxt; cA = nA; cB = nB; ++ui;
        if constexpr (GATHER) { _Pragma("unroll") for (int h_ = 0; h_ < 2; ++h_) _Pragma("unroll") for (int i_ = 0; i_ < 2; ++i_) gAc[h_][i_] = gAn[h_][i_]; }
        if constexpr (ALIGN_EPI) { if (wr == 1) PG8_BAR; }
    }
    PG8_WAIT_V(0);
    if constexpr (!ALIGN_EPI) { if (wr == 0) PG8_BAR; }
    PG8_BAR;
    if constexpr (Epi::AFTER_DRAIN) { E.fused(acc, cur, wr, wc, fr, fq, lds, wid, lane); S.done(cur); }
#undef PG8_SA
#undef PG8_SB
#undef PG8_STAGE
#undef PG8_STAGE_A
#undef PG8_GATHER
#undef PG8_LDA
#undef PG8_LD32
#undef PG8_LDB
#undef PG8_MMA
#undef PG8_WAIT_V
#undef PG8_WAIT_L
#undef PG8_BAR
#undef PG8_SCHED
}
}

#ifndef PG8_SP2
#define PG8_SP2 true
#endif
#ifndef PG8_ALIGN
#define PG8_ALIGN true
#endif

#define GAS __attribute__((address_space(1)))
#define LAS __attribute__((address_space(3)))
typedef unsigned short bf16;
typedef unsigned v4u __attribute__((ext_vector_type(4)));
typedef unsigned v2u __attribute__((ext_vector_type(2)));
typedef float f32x4 __attribute__((ext_vector_type(4)));
typedef short bf16x8 __attribute__((ext_vector_type(8)));

constexpr int D = 1024, NB = 8, SEQ = 4096, CTXL = 256, TPB = SEQ + CTXL, NTOK = NB * TPB, NLAT = NB * SEQ;
constexpr int ZC = 3328;
constexpr int ZQ = 0, ZKV = 384, ZKR = 640, ZHQ = 672, ZHF = 1184, ZHB = 1696, ZHI = 2208, ZHG = 2720;
constexpr int NEXP = 32;
constexpr float ALPHA = 1.4142135623730951f;
constexpr float LN_EPS = 1e-5f, RMS_EPS = 1e-6f;
constexpr int NWAVES = 8, NTHR = 512;
constexpr float SC_X8 = 16.f, SC_WGU = 64.f, SC_ACT = 8.f, SC_WDN = 128.f, SC_Y = 64.f;
constexpr int LDS_BYTES = 147456;
constexpr int LDS_BAR_OFF = LDS_BYTES - 64;
constexpr int LDS_TILE_E = 131072;
constexpr int MAXTILES = 576;

constexpr size_t MiB = 1u << 20;
constexpr size_t WS_CTL = 0, CTL_ZERO_BYTES = 16384;
constexpr size_t WS_MODV = 1 * MiB;
constexpr size_t WS_ROPE = 1 * MiB + 512 * 1024;
constexpr size_t WS_BGU = 2 * MiB;
constexpr size_t WS_PW1B = 2 * MiB + 512 * 1024;
constexpr size_t WS_BCNT = WS_PW1B + 64 * 1024;
constexpr size_t WS_TILEE = WS_BCNT + 64 * 1024;
constexpr size_t WS_META = WS_TILEE + 4096;
constexpr size_t WS_TOPI = 3 * MiB, WS_TOPW = 4 * MiB;
constexpr int ECAP = 32768;
constexpr size_t WS_ROWS = 160 * MiB, WS_ROWW = 164 * MiB, WS_ROWD = 168 * MiB;
constexpr size_t WS_CURSOR = 14336;
constexpr size_t WS_WIN = 8 * MiB, WS_WUQ = 15 * MiB, WS_WUKV = 16 * MiB, WS_WOUT = 17 * MiB, WS_WPW1 = 19 * MiB, WS_WPW2 = 23 * MiB;
constexpr size_t WS_WGU = 32 * MiB, WS_WDN = 288 * MiB;
constexpr size_t WS_H = 416 * MiB;
constexpr size_t WS_X = 552 * MiB, WS_Y = 620 * MiB;
constexpr size_t WS_BIG = 688 * MiB;
constexpr size_t WS_Z = WS_BIG, WS_CQN = WS_BIG + 221 * MiB, WS_CKVN = WS_BIG + 247 * MiB, WS_KRR = WS_BIG + 264 * MiB,
                 WS_Q = WS_BIG + 267 * MiB, WS_KV = WS_BIG + 318 * MiB, WS_OF = WS_BIG + 386 * MiB, WS_OB = WS_BIG + 454 * MiB;
constexpr size_t WS_HT = WS_BIG + 528 * MiB;
constexpr size_t WS_PRE = WS_BIG;
constexpr size_t WS_XS = WS_BIG, WS_ACT = WS_BIG + 288 * MiB, WS_YB = WS_BIG + 576 * MiB;
constexpr size_t WS_END = WS_BIG + 848 * MiB;
static_assert((size_t)NTOK * ZC * 2 <= 221 * MiB && (size_t)NTOK * 384 * 2 <= 26 * MiB && (size_t)NTOK * 256 * 2 <= 17 * MiB && (size_t)NTOK * 32 * 2 <= 3 * MiB, "ws map 1");
static_assert((size_t)NTOK * 768 * 2 <= 51 * MiB && (size_t)NTOK * 1024 * 2 <= 68 * MiB && (size_t)NTOK * 512 * 4 <= 68 * MiB, "ws map 2");
static_assert((size_t)64 * 136 * 26624 <= 320 * MiB && (size_t)MAXTILES * 256 * 2048 <= 288 * MiB && (size_t)NLAT * 4 * 2048 <= 272 * MiB && (size_t)NTOK * 1024 * 4 <= 136 * MiB, "ws map 3");

#define LDS_WAIT() asm volatile("s_waitcnt lgkmcnt(0)" ::: "memory")
#define VM_WAIT() asm volatile("s_waitcnt vmcnt(0)" ::: "memory")
__device__ __forceinline__ float bf2f(unsigned short b) { return __uint_as_float(((unsigned)b) << 16); }
__device__ __forceinline__ unsigned pk2(float lo, float hi) { return pg8::cvt_pk_bf16(lo, hi); }
__device__ __forceinline__ float sigm(float x) { return __builtin_amdgcn_rcpf(1.f + __expf(-x)); }
__device__ __forceinline__ float wave_sum(float v) {
#pragma unroll
    for (int o = 1; o < 64; o <<= 1) v += __shfl_xor(v, o);
    return v;
}
__device__ __forceinline__ int ld_ctl(const int* p) { return (int)__hip_atomic_load((const unsigned*)p, __ATOMIC_RELAXED, __HIP_MEMORY_SCOPE_AGENT); }
__device__ __forceinline__ int grow_of(int lr) { return (lr >> 12) * TPB + CTXL + (lr & 4095); }

#define XB_TMO      128
#define XB_XCNT(j)  (256  + 64 * (j))
#define XB_XSUB(j)  (1280 + 64 * (j))
#define XB_XGEN(j)  (2304 + 64 * (j))
#define XB_TOP      3328
#define XB_TOPGEN   3392
#define XCD_BAR_WORDS 3456
#define XB_SPIN_CAP (1u << 21)

__device__ __forceinline__ unsigned xb_ld(unsigned* p)              { return __hip_atomic_load(p, __ATOMIC_RELAXED, __HIP_MEMORY_SCOPE_AGENT); }
__device__ __forceinline__ unsigned xb_add(unsigned* p, unsigned v) { return __hip_atomic_fetch_add(p, v, __ATOMIC_RELAXED, __HIP_MEMORY_SCOPE_AGENT); }
__device__ __forceinline__ unsigned xb_xcc_id() { return (unsigned)__builtin_amdgcn_s_getreg((3 << 11) | 20) & 0xFu; }
#define XB_SPIN(cond, bar) do { unsigned _sp = 0; while (cond) { __builtin_amdgcn_s_sleep(1); \
    if ((++_sp & 255u) == 0u) { if (xb_ld(&(bar)[XB_TMO])) break; if (_sp > XB_SPIN_CAP) { atomicAdd(&(bar)[XB_TMO], 1u); break; } } } } while (0)

struct XcdBarrier { unsigned* bar; unsigned x; volatile LAS unsigned* st; };

__device__ __forceinline__ XcdBarrier xcd_barrier_post(unsigned* bar, volatile LAS unsigned* st) {
    XcdBarrier b; b.bar = bar; b.x = xb_xcc_id(); b.st = st;
    if (threadIdx.x == 0) (void)xb_add(&bar[XB_XCNT(b.x)], 1u);
    return b;
}
__device__ __forceinline__ void xcd_barrier_complete(unsigned* bar, unsigned x, unsigned& nloc, unsigned& nx) {
    const unsigned G = gridDim.x * gridDim.y * gridDim.z;
    unsigned sum, cnt, mine, sp = 0u;
    for (;;) {
        sum = 0u; cnt = 0u; mine = 0u;
#pragma unroll
        for (unsigned j = 0; j < 16; ++j) { const unsigned c = xb_ld(&bar[XB_XCNT(j)]); sum += c; cnt += (c > 0u) ? 1u : 0u; mine = (j == x) ? c : mine; }
        if (sum == G) break;
        __builtin_amdgcn_s_sleep(1);
        if ((++sp & 255u) == 0u) { if (xb_ld(&bar[XB_TMO])) break; if (sp > XB_SPIN_CAP) { atomicAdd(&bar[XB_TMO], 1u); break; } }
    }
    nloc = mine > 0u ? mine : 1u; nx = cnt > 0u ? cnt : 1u;
}
__device__ __forceinline__ void xcd_barrier(const XcdBarrier& b) {
    asm volatile("s_waitcnt vmcnt(0)" ::: "memory");
    __syncthreads();
    if (threadIdx.x == 0) {
        unsigned* bar = b.bar;
        __builtin_amdgcn_s_waitcnt(0);
        unsigned nloc = b.st[0], nx = b.st[1];
        if (nloc == 0u) { xcd_barrier_complete(bar, b.x, nloc, nx); b.st[0] = nloc; b.st[1] = nx; }
        const unsigned old = xb_add(&bar[XB_XSUB(b.x)], 1u);
        const unsigned gen = old / nloc;
        if (old + 1u == (gen + 1u) * nloc) {
            __builtin_amdgcn_fence(__ATOMIC_RELEASE, "agent");
            asm volatile("s_waitcnt vmcnt(0)" ::: "memory");
            const unsigned og = xb_add(&bar[XB_TOP], 1u);
            const unsigned tg = og / nx;
            if (og + 1u == (tg + 1u) * nx) xb_add(&bar[XB_TOPGEN], 1u);
            else XB_SPIN(xb_ld(&bar[XB_TOPGEN]) == tg, bar);
            __builtin_amdgcn_fence(__ATOMIC_ACQUIRE, "agent");
            xb_add(&bar[XB_XGEN(b.x)], 1u);
            asm volatile("s_waitcnt vmcnt(0)" ::: "memory");
        } else {
            XB_SPIN(xb_ld(&bar[XB_XGEN(b.x)]) == gen, bar);
            __builtin_amdgcn_fence(__ATOMIC_ACQUIRE, "agent");
            asm volatile("s_waitcnt vmcnt(0)" ::: "memory");
        }
    }
    __syncthreads();
}

namespace pg8 {
struct TileOrder {
    int nM, nN, nwg, G, c;
    __device__ __forceinline__ void init(int nM_, int nN_, int G_, int c_) { nM = nM_; nN = nN_; nwg = nM * nN; G = G_; c = c_; }
    __device__ __forceinline__ bool logical(int i, int& im, int& in) const {
        const long L = (long)i * G + c; if (L >= nwg) return false;
        int wgid = (int)L; { const int q = nwg / NXCD, r = nwg % NXCD, xcd = wgid % NXCD, off = wgid / NXCD; wgid = (xcd < r ? xcd * (q + 1) : r * (q + 1) + (xcd - r) * q) + off; }
        const int nig = WGM * nN, gid = wgid / nig, fm = gid * WGM, gsz = (nM - fm) < WGM ? (nM - fm) : WGM;
        im = fm + ((wgid % nig) % gsz); in = (wgid % nig) / gsz; return true;
    }
    __device__ __forceinline__ void a_ready(const Unit&) const {}
    __device__ __forceinline__ void done(const Unit&) const {}
};
struct AllOrder : TileOrder { __device__ __forceinline__ bool next(int i, Unit& u) const { int im, in; if (!logical(i, im, in)) return false; u.pm = im; u.pn = in; return true; } };
struct LatOrder : TileOrder {
    __device__ __forceinline__ bool next(int i, Unit& u) const { int im, in; if (!logical(i, im, in)) return false; u.pm = (im >> 4) * 17 + 1 + (im & 15); u.pn = in; return true; } };
struct MoeOrder : TileOrder {
    const PG8_LAS int* tile_e; int nper;
    __device__ __forceinline__ bool next(int i, Unit& u) const { int im, in; if (!logical(i, im, in)) return false; u.pm = im; u.pn = tile_e[im] * nper + in; return true; } };

struct EpiRes {
    static constexpr bool PERM = true, AFTER_DRAIN = false;
    const float* xin; const float* h; bf16_t* pre; const float* modv; const float* bias;
    __device__ __forceinline__ void operator()(const f32x4 (&acc)[2][2][4][2], const Unit& u, int wr, int wc, int fr, int fq) const {
        asm volatile("" : "+v"(fr), "+v"(fq));
        const int b = u.pm / 17, j = u.pm % 17;
        const int rl0 = wr * 64 + fr, col0 = u.pn * BM + wc * 32 + 8 * fq;
        const float* gate = modv + (size_t)b * 6144 + 2048;
        f32x4 gv[2][2], bv[2][2];
#pragma unroll
        for (int bj = 0; bj < 2; ++bj)
#pragma unroll
            for (int n = 0; n < 2; ++n) { gv[bj][n] = *(const f32x4*)(gate + col0 + bj * HALF + 4 * n); bv[bj][n] = bias ? *(const f32x4*)(bias + col0 + bj * HALF + 4 * n) : (f32x4){0.f, 0.f, 0.f, 0.f}; }
#pragma unroll
        for (int ai = 0; ai < 2; ++ai)
#pragma unroll
            for (int m = 0; m < 4; ++m) { const int rl = rl0 + ai * HALF + m * 16; const size_t grow = (size_t)u.pm * BM + rl;
                const float* hin = xin ? xin + ((size_t)b * 4096 + (size_t)(j - 1) * 256 + rl) * 1024 + col0 : h + grow * 1024 + col0;
                bf16_t* po = pre + grow * 1024 + col0;
#pragma unroll
                for (int bj = 0; bj < 2; ++bj) { const f32x4 h0 = *(const f32x4*)(hin + bj * HALF), h1 = *(const f32x4*)(hin + bj * HALF + 4);
                    const f32x4 v0 = h0 * 1.4142135623730951f + gv[bj][0] * (acc[ai][bj][m][0] + bv[bj][0]), v1 = h1 * 1.4142135623730951f + gv[bj][1] * (acc[ai][bj][m][1] + bv[bj][1]);
                    u32x4 w; w.x = cvt_pk_bf16(v0[0], v0[1]); w.y = cvt_pk_bf16(v0[2], v0[3]); w.z = cvt_pk_bf16(v1[0], v1[1]); w.w = cvt_pk_bf16(v1[2], v1[3]);
                    *(u32x4*)(po + bj * HALF) = w; } }
    }
};
template <int MODE, bool OUT8 = false> struct EpiGate {
    static constexpr bool PERM = true, AFTER_DRAIN = false;
    bf16_t* O; const float* bias; int nper; float ascale, oscale;
    __device__ __forceinline__ void operator()(const f32x4 (&acc)[2][2][4][2], const Unit& u, int wr, int wc, int fr, int fq) const {
        asm volatile("" : "+v"(fr), "+v"(fq));
        const int row0 = u.pm * BM + wr * 64 + fr, pnl = u.pn % nper, ocol0 = pnl * HALF + wc * 32 + 8 * fq, bcol0 = u.pn * BM + wc * 32 + 8 * fq;
        const float s0 = ascale, s1 = MODE == 1 ? ascale * oscale : ascale;
        f32x4 bv[2][2];
#pragma unroll
        for (int n = 0; n < 2; ++n) { bv[0][n] = *(const f32x4*)(bias + bcol0 + 4 * n); const f32x4 t = *(const f32x4*)(bias + bcol0 + HALF + 4 * n); bv[1][n] = MODE == 1 ? (t + 1.0f) * oscale : t; }
#pragma unroll
        for (int ai = 0; ai < 2; ++ai)
#pragma unroll
            for (int m = 0; m < 4; ++m) { bf16_t* rowp = O + (size_t)(row0 + ai * HALF + m * 16) * 1024 + ocol0;
                unsigned char* rowp8 = (unsigned char*)O + (size_t)(row0 + ai * HALF + m * 16) * 1024 + ocol0;
                float o[8];
#pragma unroll
                for (int n = 0; n < 2; ++n) { const f32x4 a = acc[ai][0][m][n] * s0 + bv[0][n], g = acc[ai][1][m][n] * s1 + bv[1][n];
#pragma unroll
                    for (int e = 0; e < 4; ++e) {
                        if (MODE == 0) { o[4 * n + e] = a[e] * __builtin_amdgcn_rcpf(1.f + __builtin_amdgcn_exp2f(g[e] * -1.4426950408889634f)); }
                        else { const float gt = fminf(a[e], 7.0f), up1 = __builtin_amdgcn_fmed3f(g[e], -6.0f * oscale, 8.0f * oscale);
                            o[4 * n + e] = up1 * (gt * __builtin_amdgcn_rcpf(1.f + __builtin_amdgcn_exp2f(gt * (-1.702f * 1.4426950408889634f)))); } } }
                if constexpr (OUT8) {
                    int w0 = 0, w1 = 0; w0 = __builtin_amdgcn_cvt_pk_fp8_f32(o[0], o[1], w0, false); w0 = __builtin_amdgcn_cvt_pk_fp8_f32(o[2], o[3], w0, true);
                    w1 = __builtin_amdgcn_cvt_pk_fp8_f32(o[4], o[5], w1, false); w1 = __builtin_amdgcn_cvt_pk_fp8_f32(o[6], o[7], w1, true);
                    typedef unsigned u32x2 __attribute__((ext_vector_type(2))); *(u32x2*)rowp8 = (u32x2){(unsigned)w0, (unsigned)w1}; (void)rowp;
                } else { (void)rowp8;
                u32x4 w; w.x = cvt_pk_bf16(o[0], o[1]); w.y = cvt_pk_bf16(o[2], o[3]); w.z = cvt_pk_bf16(o[4], o[5]); w.w = cvt_pk_bf16(o[6], o[7]);
                *(u32x4*)rowp = w; } }
    }
};
struct EpiDown {
    static constexpr bool PERM = true, AFTER_DRAIN = false;
    bf16_t* Y; const float* bias; const float* row_w; const int* row_dst; float ascale; const PG8_LAS int* gtab; float oscale;
    __device__ __forceinline__ void operator()(const f32x4 (&acc)[2][2][4][2], const Unit& u, int wr, int wc, int fr, int fq) const {
        asm volatile("" : "+v"(fr), "+v"(fq));
        const int pnl = u.pn & 3, ocol0 = pnl * BM + wc * 32 + 8 * fq, bcol0 = u.pn * BM + wc * 32 + 8 * fq; const int tbase = gtab[u.pm], tcnt = gtab[576 + u.pm];
        f32x4 bv[2][2];
#pragma unroll
        for (int bj = 0; bj < 2; ++bj)
#pragma unroll
            for (int n = 0; n < 2; ++n) bv[bj][n] = *(const f32x4*)(bias + bcol0 + bj * HALF + 4 * n);
#pragma unroll
        for (int ai = 0; ai < 2; ++ai)
#pragma unroll
            for (int m = 0; m < 4; ++m) { const int rl = wr * 64 + fr + ai * HALF + m * 16;
                if (rl < tcnt) { const int dst = row_dst[tbase + rl]; const float w8 = row_w[tbase + rl] * oscale; unsigned char* rowp = (unsigned char*)Y + (size_t)dst * 1024 + ocol0;
#pragma unroll
                    for (int bj = 0; bj < 2; ++bj) { const f32x4 v0 = (acc[ai][bj][m][0] * ascale + bv[bj][0]) * w8, v1 = (acc[ai][bj][m][1] * ascale + bv[bj][1]) * w8;
                        int w0 = 0, w1 = 0; w0 = __builtin_amdgcn_cvt_pk_fp8_f32(fminf(fmaxf(v0[0], -448.f), 448.f), fminf(fmaxf(v0[1], -448.f), 448.f), w0, false); w0 = __builtin_amdgcn_cvt_pk_fp8_f32(fminf(fmaxf(v0[2], -448.f), 448.f), fminf(fmaxf(v0[3], -448.f), 448.f), w0, true);
                        w1 = __builtin_amdgcn_cvt_pk_fp8_f32(fminf(fmaxf(v1[0], -448.f), 448.f), fminf(fmaxf(v1[1], -448.f), 448.f), w1, false); w1 = __builtin_amdgcn_cvt_pk_fp8_f32(fminf(fmaxf(v1[2], -448.f), 448.f), fminf(fmaxf(v1[3], -448.f), 448.f), w1, true);
                        typedef unsigned u32x2 __attribute__((ext_vector_type(2))); *(u32x2*)(rowp + bj * HALF) = (u32x2){(unsigned)w0, (unsigned)w1}; } } }
    }
};
}

namespace att {
using bf16x8 = __attribute__((ext_vector_type(8))) short;
using s16x4  = __attribute__((ext_vector_type(4))) short;
using f32x16 = __attribute__((ext_vector_type(16))) float;
using u32x4  = __attribute__((ext_vector_type(4))) unsigned;
constexpr int NW = 8, QBLK = 32, KVBLK = 64;
constexpr float SCALE = 0.10206207261596575f;
constexpr float THR = 8.f;
constexpr int SHM_V = 16384, SHM_K = 16384, NBUF = 3, SHM_ATTN = NBUF * SHM_V + NBUF * SHM_K + NW * 64 * 4;
#define KSWZ(row, colB) ((row) * 256 + ((colB) ^ (((row) & 7) << 4)))
#define SBAR() __builtin_amdgcn_sched_barrier(0)
__device__ __forceinline__ int crow(int r, int hi) { return (r & 3) + 8 * (r >> 2) + 4 * hi; }
__device__ __forceinline__ unsigned cvtpk(float lo, float hi) { unsigned r; asm volatile("v_cvt_pk_bf16_f32 %0, %1, %2" : "=v"(r) : "v"(lo), "v"(hi)); return r; }

__device__ __forceinline__ void partialSM(f32x16& p0, f32x16& p1, float& m_reg, float& mn, float& alpha) {
  constexpr float C = SCALE * 1.4426950408889634f;
  float pmax = p0[0];
#pragma unroll
  for (int r = 1; r < 16; ++r) pmax = fmaxf(pmax, p0[r]);
#pragma unroll
  for (int r = 0; r < 16; ++r) pmax = fmaxf(pmax, p1[r]);
  { auto rr = __builtin_amdgcn_permlane32_swap(__float_as_uint(pmax), __float_as_uint(pmax), false, false);
    pmax = fmaxf(__uint_as_float(rr[0]), __uint_as_float(rr[1])); }
  if (__builtin_expect(__all(pmax - m_reg <= THR / SCALE), 1)) { mn = m_reg; alpha = 1.f; }
  else { mn = fmaxf(m_reg, pmax); alpha = __builtin_amdgcn_exp2f((m_reg - mn) * C); m_reg = mn; }
  float mnC = -mn * C;
#pragma unroll
  for (int r = 0; r < 16; ++r) p0[r] = fmaf(p0[r], C, mnC);
#pragma unroll
  for (int r = 0; r < 16; ++r) p1[r] = fmaf(p1[r], C, mnC);
#pragma unroll
  for (int r = 0; r < 16; ++r) p0[r] = __builtin_amdgcn_exp2f(p0[r]);
}
__device__ __forceinline__ void finishSM(f32x16& p0, f32x16& p1, float alpha, float& l_reg, bf16x8& pa0, bf16x8& pa1, bf16x8& pa2, bf16x8& pa3) {
#pragma unroll
  for (int r = 0; r < 16; ++r) p1[r] = __builtin_amdgcn_exp2f(p1[r]);
  float ps = 0;
#pragma unroll
  for (int r = 0; r < 16; ++r) ps += p0[r];
#pragma unroll
  for (int r = 0; r < 16; ++r) ps += p1[r];
  { auto rr = __builtin_amdgcn_permlane32_swap(__float_as_uint(ps), __float_as_uint(ps), false, false);
    ps = __uint_as_float(rr[0]) + __uint_as_float(rr[1]); }
  l_reg = l_reg * alpha + ps;
#define PK4(P, BASE, OUT) do { unsigned a0 = cvtpk(P[BASE + 0], P[BASE + 1]), a1 = cvtpk(P[BASE + 2], P[BASE + 3]);   \
    unsigned b0 = cvtpk(P[BASE + 4], P[BASE + 5]), b1 = cvtpk(P[BASE + 6], P[BASE + 7]);                              \
    auto r0 = __builtin_amdgcn_permlane32_swap(a0, b0, false, false); auto r1 = __builtin_amdgcn_permlane32_swap(a1, b1, false, false); \
    u32x4 w = {r0[0], r1[0], r0[1], r1[1]}; OUT = *reinterpret_cast<bf16x8*>(&w); } while (0)
  PK4(p0, 0, pa0); PK4(p0, 8, pa1); PK4(p1, 0, pa2); PK4(p1, 8, pa3);
#undef PK4
}
__device__ __forceinline__ void qkt(f32x16& p0, f32x16& p1, const bf16* Ks, const bf16x8* qr, int r32, int hi) {
  p0 = f32x16{}; p1 = f32x16{};
#pragma unroll
  for (int d0 = 0; d0 < 6; ++d0) { int cb = (d0 * 16 + hi * 8) * 2;
    bf16x8 b0 = *reinterpret_cast<const bf16x8*>((const char*)Ks + KSWZ(r32, cb));
    bf16x8 b1 = *reinterpret_cast<const bf16x8*>((const char*)Ks + KSWZ(32 + r32, cb));
    p0 = __builtin_amdgcn_mfma_f32_32x32x16_bf16(b0, qr[d0], p0, 0, 0, 0);
    p1 = __builtin_amdgcn_mfma_f32_32x32x16_bf16(b1, qr[d0], p1, 0, 0, 0); }
}
__device__ __forceinline__ int v_st(int k, int c) { const int kk = (k & ~0xC) | ((k & 4) << 1) | ((k & 8) >> 1); return ((kk >> 3) * 4 + (c >> 5)) * 512 + ((kk & 7) * 32 + (c & 31)) * 2; }
__device__ __forceinline__ int v_rd_base(int lane) { return ((lane & 3) << 3) | (((lane >> 2) & 3) << 6) | (((lane >> 4) & 1) << 5) | (((lane >> 5) & 1) << 8); }
constexpr int v_rd_off(int d0, int ks, int half) { return d0 * 512 + ks * 4096 + half * 2048; }
template <int OFF> __device__ __forceinline__ s16x4 tr_read(int vb) {
  s16x4 r; asm volatile("ds_read_b64_tr_b16 %0, %1 offset:%2" : "=&v"(r) : "v"(vb), "i"(OFF) : "memory"); return r;
}
template <int D0> __device__ __forceinline__ void pv_one(f32x16& od, int vb, bf16x8 pa0, bf16x8 pa1, bf16x8 pa2, bf16x8 pa3) {
  const s16x4 l0 = tr_read<v_rd_off(D0, 0, 0)>(vb), h0 = tr_read<v_rd_off(D0, 0, 1)>(vb), l1 = tr_read<v_rd_off(D0, 1, 0)>(vb), h1 = tr_read<v_rd_off(D0, 1, 1)>(vb);
  const s16x4 l2 = tr_read<v_rd_off(D0, 2, 0)>(vb), h2 = tr_read<v_rd_off(D0, 2, 1)>(vb), l3 = tr_read<v_rd_off(D0, 3, 0)>(vb), h3 = tr_read<v_rd_off(D0, 3, 1)>(vb);
  asm volatile("s_waitcnt lgkmcnt(0)" ::: "memory"); SBAR();
#define PK(L, H) (bf16x8){L[0], L[1], L[2], L[3], H[0], H[1], H[2], H[3]}
  od = __builtin_amdgcn_mfma_f32_32x32x16_bf16(pa0, PK(l0, h0), od, 0, 0, 0);
  od = __builtin_amdgcn_mfma_f32_32x32x16_bf16(pa1, PK(l1, h1), od, 0, 0, 0);
  od = __builtin_amdgcn_mfma_f32_32x32x16_bf16(pa2, PK(l2, h2), od, 0, 0, 0);
  od = __builtin_amdgcn_mfma_f32_32x32x16_bf16(pa3, PK(l3, h3), od, 0, 0, 0);
#undef PK
}
__device__ __forceinline__ void pv_d0(f32x16* o, int vb, bf16x8 pa0, bf16x8 pa1, bf16x8 pa2, bf16x8 pa3) {
  pv_one<0>(o[0], vb, pa0, pa1, pa2, pa3); pv_one<1>(o[1], vb, pa0, pa1, pa2, pa3);
}
__device__ __forceinline__ bf16x8 rope8(bf16x8 x, const float* tab, int pbase) {
  u32x4 w;
#pragma unroll
  for (int i = 0; i < 4; ++i) { const float x1 = __uint_as_float(((unsigned)(unsigned short)x[2 * i]) << 16), x2 = __uint_as_float(((unsigned)(unsigned short)x[2 * i + 1]) << 16);
    const float cs = tab[pbase + i], sn = tab[16 + pbase + i]; w[i] = cvtpk(x1 * cs - x2 * sn, x1 * sn + x2 * cs); }
  return *reinterpret_cast<bf16x8*>(&w);
}
__device__ __forceinline__ void attn_unit(const bf16* __restrict__ Qb, const bf16* __restrict__ KVb, const bf16* __restrict__ KRb, bf16* __restrict__ Ob,
                                          const float* __restrict__ rope, int seq, char* lds) {
  int tid_l = threadIdx.x; asm volatile("" : "+v"(tid_l));
  const int tid = tid_l, wid = tid >> 6, lane = tid & 63, r32 = lane & 31, hi = lane >> 5;
  bf16* V_lds = (bf16*)lds; bf16* K_lds = (bf16*)(lds + NBUF * SHM_V);
  float* ws = (float*)(lds + NBUF * SHM_V + NBUF * SHM_K) + wid * 64; float* li_l = ws; float* al_l = ws + 32;
  float m_reg = -1e30f, l_reg = 0; f32x16 o[2] = {}; bf16x8 qr[6];
  const bf16* Qw = Qb + (long)(wid * QBLK + r32) * 768 + hi * 8;
#pragma unroll
  for (int d0 = 0; d0 < 6; ++d0) qr[d0] = *reinterpret_cast<const bf16x8*>(Qw + d0 * 16);
  if (rope) { const float* tab = rope + (long)(wid * QBLK + r32) * 32; qr[4] = rope8(qr[4], tab, 4 * hi); qr[5] = rope8(qr[5], tab, 8 + 4 * hi); }
  const int sr = tid >> 4, ch = tid & 15;
  const bf16* kbase = ch < 8 ? KVb + ch * 8 : KRb + ((ch - 8) & 3) * 8; const long kstr = ch < 8 ? 1024 : 32;
  const int vkey = tid >> 3, vc8 = (tid & 7) * 8, vst0 = v_st(vkey, vc8);
  const bf16* vbase = KVb + 512 + vc8;
  const int vb0 = (int)(uintptr_t)V_lds + v_rd_base(lane);
  struct { bf16x8 vs0, ks0, ks1; } sr_[2];
#define SLOAD(i, k0) do { sr_[i].vs0 = *reinterpret_cast<const bf16x8*>(vbase + (long)((k0) + vkey) * 1024); \
    sr_[i].ks0 = *reinterpret_cast<const bf16x8*>(kbase + (long)((k0) + sr) * kstr); sr_[i].ks1 = *reinterpret_cast<const bf16x8*>(kbase + (long)((k0) + 32 + sr) * kstr); } while (0)
#define SWRITE(b, i) do { *(bf16x8*)((char*)V_lds + (b) * SHM_V + vst0) = sr_[i].vs0; int kc = ch * 16;               \
    *(bf16x8*)((char*)K_lds + (b) * SHM_K + KSWZ(sr, kc)) = sr_[i].ks0;                       \
    *(bf16x8*)((char*)K_lds + (b) * SHM_K + KSWZ(32 + sr, kc)) = sr_[i].ks1; } while (0)
#define SWAIT() asm volatile("s_waitcnt vmcnt(3)" ::: "memory")
#define RESC(a) do { if (__any((a) < 1.f)) { if (hi == 0) al_l[r32] = (a); asm volatile("s_waitcnt lgkmcnt(0)" ::: "memory"); \
    _Pragma("unroll") for (int d = 0; d < 2; ++d) _Pragma("unroll") for (int r = 0; r < 16; ++r) o[d][r] *= al_l[crow(r, hi)]; } } while (0)
  f32x16 pA0, pA1, pB0, pB1; float mnA, mnB, alA, alB; bf16x8 pa0, pa1, pa2, pa3; const int NT = seq / KVBLK;
  constexpr int SE = 0, SO = 1;
  SLOAD(SE, 0); asm volatile("s_waitcnt vmcnt(0)" ::: "memory"); SWRITE(0, SE); __syncthreads();
  qkt(pA0, pA1, K_lds, qr, r32, hi); partialSM(pA0, pA1, m_reg, mnA, alA);
  SLOAD(SO, KVBLK); if (2 < NT) SLOAD(SE, 2 * KVBLK);
  SWAIT(); SWRITE(1, SO); __syncthreads();
  int bprev = 0, bcur = 1, bnext = 2;
#define ATT_STEP(PN0, PN1, MNN, ALN, PO0, PO1, ALO, SL_LOAD, SL_WRITE, t) do { \
    SBAR(); qkt(PN0, PN1, (bf16*)((char*)K_lds + bcur * SHM_K), qr, r32, hi); \
    finishSM(PO0, PO1, ALO, l_reg, pa0, pa1, pa2, pa3); SBAR(); \
    if ((t) + 2 < NT) SLOAD(SL_LOAD, ((t) + 2) * KVBLK); SBAR(); \
    pv_d0(o, vb0 + bprev * (int)SHM_V, pa0, pa1, pa2, pa3); partialSM(PN0, PN1, m_reg, MNN, ALN); \
    SWAIT(); SWRITE(bnext, SL_WRITE); \
    RESC(ALN); __syncthreads(); \
    bprev = bcur; bcur = bnext; bnext = (bnext == 2) ? 0 : bnext + 1; } while (0)
  for (int j = 1; j + 1 < NT; j += 2) {
    ATT_STEP(pB0, pB1, mnB, alB, pA0, pA1, alA, SO, SE, j);
    ATT_STEP(pA0, pA1, mnA, alA, pB0, pB1, alB, SE, SO, j + 1);
  }
#undef ATT_STEP
  SBAR(); qkt(pB0, pB1, (bf16*)((char*)K_lds + bcur * SHM_K), qr, r32, hi);
  finishSM(pA0, pA1, alA, l_reg, pa0, pa1, pa2, pa3); SBAR();
  pv_d0(o, vb0 + bprev * (int)SHM_V, pa0, pa1, pa2, pa3); partialSM(pB0, pB1, m_reg, mnB, alB);
  RESC(alB);
  finishSM(pB0, pB1, alB, l_reg, pa0, pa1, pa2, pa3); SBAR();
  pv_d0(o, vb0 + bcur * (int)SHM_V, pa0, pa1, pa2, pa3);
  if (hi == 0) li_l[r32] = l_reg; asm volatile("s_waitcnt lgkmcnt(0)" ::: "memory");
  float rli[16];
#pragma unroll
  for (int r = 0; r < 16; ++r) rli[r] = __builtin_amdgcn_rcpf(li_l[crow(r, hi)]);
  bf16* Ow = Ob + (long)(wid * QBLK) * 1024;
#pragma unroll
  for (int r = 0; r < 16; ++r) { int orow = crow(r, hi);
#pragma unroll
    for (int d0 = 0; d0 < 2; ++d0) { const float v = o[d0][r] * rli[r]; Ow[(long)orow * 1024 + d0 * 32 + r32] = (bf16)(cvtpk(v, v) & 0xffffu); } }
#undef SLOAD
#undef SWRITE
#undef SWAIT
#undef RESC
}
}

struct Args { const float* in[33]; float* out; unsigned char* ws; int ph_lo, ph_hi; };
enum { I_X = 0, I_C, I_CTX, I_CCTX, I_MODW, I_MODB, I_LN1G, I_LN1B, I_LN2G, I_LN2B, I_WIN, I_QNORM, I_KVNORM, I_WUQ, I_WUK, I_WUV, I_LBL, I_HGNORM, I_WOUT,
       I_PW1W, I_PW1B, I_DWW, I_DWB, I_CLNG, I_CLNB, I_PW2W, I_PW2B, I_RW, I_RB, I_WGU, I_BGU, I_WDN, I_BDN };

__device__ __forceinline__ int dst_row(int n, int mode, int row_off) {
    if (mode == 0) return row_off + n;
    int f, g; if (mode == 1) { f = n >> 1; g = n & 1; } else { g = n >> 10; f = n & 1023; }
    return row_off + 256 * (f >> 7) + 128 * g + (f & 127);
}
__device__ __forceinline__ unsigned pack_fp8x4(float a, float b, float c, float d) { int w = 0; w = __builtin_amdgcn_cvt_pk_fp8_f32(fminf(fmaxf(a, -448.f), 448.f), fminf(fmaxf(b, -448.f), 448.f), w, false);
    w = __builtin_amdgcn_cvt_pk_fp8_f32(fminf(fmaxf(c, -448.f), 448.f), fminf(fmaxf(d, -448.f), 448.f), w, true); return (unsigned)w; }
struct TrItem { const float* W; bf16* WT; int K, N, mode, row_off, item; float f8scale; };
__device__ __forceinline__ void tr_load(const TrItem& d, f32x4 (&v)[16], int lane) {
    const int nblk = (d.N + 63) >> 6, kb = d.item / nblk, nb = d.item - kb * nblk, k0 = 64 * kb, n0 = 64 * nb;
    const int nc = n0 + 4 * (lane & 15), kr = lane >> 4;
#pragma unroll
    for (int i = 0; i < 16; ++i) v[i] = (nc < d.N) ? __builtin_nontemporal_load((const f32x4*)(d.W + (size_t)(k0 + 4 * i + kr) * d.N + nc)) : (f32x4){0.f, 0.f, 0.f, 0.f};
}
__device__ __forceinline__ void tr_lds_write(const f32x4 (&v)[16], LAS float* scr, int lane) {
    const int kr = lane >> 4;
#pragma unroll
    for (int i = 0; i < 16; ++i) { LAS float* s = scr + (4 * i + kr) * 65 + 4 * (lane & 15); s[0] = v[i][0]; s[1] = v[i][1]; s[2] = v[i][2]; s[3] = v[i][3]; }
}
__device__ __forceinline__ void tr_store(const TrItem& d, LAS float* scr, int lane) {
    const int nblk = (d.N + 63) >> 6, kb = d.item / nblk, nb = d.item - kb * nblk, k0 = 64 * kb, n0 = 64 * nb;
    const int c = lane & 7; const int K = d.K;
#pragma unroll
    for (int j = 0; j < 8; ++j) { const int nl = (lane >> 3) + 8 * j, n = n0 + nl; const LAS float* s = scr + (8 * c) * 65 + nl;
        if (n < d.N) { if (d.f8scale > 0.f) { const float f8 = d.f8scale; v2u o8; o8.x = pack_fp8x4(s[0 * 65] * f8, s[1 * 65] * f8, s[2 * 65] * f8, s[3 * 65] * f8); o8.y = pack_fp8x4(s[4 * 65] * f8, s[5 * 65] * f8, s[6 * 65] * f8, s[7 * 65] * f8);
                *(v2u*)((unsigned char*)d.WT + (size_t)dst_row(n, d.mode, d.row_off) * K + k0 + 8 * c) = o8; }
            else { v4u o; o.x = pk2(s[0 * 65], s[1 * 65]); o.y = pk2(s[2 * 65], s[3 * 65]); o.z = pk2(s[4 * 65], s[5 * 65]); o.w = pk2(s[6 * 65], s[7 * 65]);
                *(v4u*)(d.WT + (size_t)dst_row(n, d.mode, d.row_off) * K + k0 + 8 * c) = o; } } }
}
__device__ __forceinline__ void convert_items(const Args& a, unsigned char* ws, LAS float* scr, int lane, int gw, int NGW, int it_lo, int it_hi) {
    constexpr int I0 = 16 * 51, I1 = 6 * 12, I2 = 4 * 8, I3 = 4 * 8, I4 = 256, I5 = 512;
    constexpr int NGU = 64 * 512, NDN = 64 * 256;
    auto decode = [&](int it) -> TrItem {
        TrItem d; int r = it; d.f8scale = 0.f; d.mode = 0; d.row_off = 0;
        if (r < NGU) { const int mi = r >> 9; d.W = a.in[I_WGU] + (size_t)mi * 1024 * 2048; d.K = 1024; d.N = 2048; d.WT = (bf16*)(ws + WS_WGU + (size_t)mi * 2048 * 1024); d.mode = 1; d.item = r & 511; d.f8scale = SC_WGU; return d; } r -= NGU;
        if (r < NDN) { const int mi = r >> 8; d.W = a.in[I_WDN] + (size_t)mi * 1024 * 1024; d.K = 1024; d.N = 1024; d.WT = (bf16*)(ws + WS_WDN + (size_t)mi * 1024 * 1024); d.item = r & 255; d.f8scale = SC_WDN; return d; } r -= NDN;
        if (r < I0) { d.W = a.in[I_WIN]; d.K = 1024; d.N = 3232; d.WT = (bf16*)(ws + WS_WIN); d.item = r; return d; } r -= I0;
        if (r < I1) { d.W = a.in[I_WUQ]; d.K = 384; d.N = 768; d.WT = (bf16*)(ws + WS_WUQ); d.item = r; return d; } r -= I1;
        if (r < I2) { d.W = a.in[I_WUK]; d.K = 256; d.N = 512; d.WT = (bf16*)(ws + WS_WUKV); d.item = r; return d; } r -= I2;
        if (r < I3) { d.W = a.in[I_WUV]; d.K = 256; d.N = 512; d.WT = (bf16*)(ws + WS_WUKV); d.row_off = 512; d.item = r; return d; } r -= I3;
        if (r < I4) { d.W = a.in[I_WOUT]; d.K = 1024; d.N = 1024; d.WT = (bf16*)(ws + WS_WOUT); d.item = r; return d; } r -= I4;
        if (r < I5) { d.W = a.in[I_PW1W]; d.K = 1024; d.N = 2048; d.WT = (bf16*)(ws + WS_WPW1); d.mode = 2; d.item = r; return d; } r -= I5;
        d.W = a.in[I_PW2W]; d.K = 1024; d.N = 1024; d.WT = (bf16*)(ws + WS_WPW2); d.item = r; return d; };
    f32x4 tv[16];
    int it = it_lo + gw;
    if (it < it_hi) { const TrItem d0 = decode(it); tr_load(d0, tv, lane); }
    for (; it < it_hi; it += NGW) {
        const TrItem d = decode(it);
        tr_lds_write(tv, scr, lane);
        if (it + NGW < it_hi) { const TrItem dn = decode(it + NGW); tr_load(dn, tv, lane); }
        LDS_WAIT();
        tr_store(d, scr, lane);
        LDS_WAIT();
    }
}
__device__ __forceinline__ void phase_prologue(const Args& a, LAS unsigned char* lds, int tid, int lane, int wave) {
    unsigned char* ws = a.ws;
    const int G = gridDim.x, B = blockIdx.x;
    {
        LAS float* sc = (LAS float*)lds;
        LAS float* red = (LAS float*)(lds + 36864);
        float* modv = (float*)(ws + WS_MODV);
        bool have = false;
        for (int it = B; it < 192; it += G) {
            if (!have) { for (int i = tid; i < 9 * 1024; i += NTHR) { const int r = i >> 10, k = i & 1023; const float x = r < 8 ? a.in[I_C][r * 1024 + k] : a.in[I_CCTX][k]; sc[i] = x * sigm(x); } __syncthreads(); have = true; }
            const int l = it / 96, jc = it % 96, kg = tid >> 6, jj = tid & 63, j = jc * 64 + jj;
            float acc[9];
#pragma unroll
            for (int r = 0; r < 9; ++r) acc[r] = 0.f;
            const float* wp = a.in[I_MODW] + ((size_t)l * 1024 + kg * 128) * 6144 + j;
            for (int k0 = 0; k0 < 128; k0 += 16) { float w[16];
#pragma unroll
                for (int kk = 0; kk < 16; ++kk) w[kk] = wp[(size_t)(k0 + kk) * 6144];
#pragma unroll
                for (int kk = 0; kk < 16; ++kk)
#pragma unroll
                    for (int r = 0; r < 9; ++r) acc[r] += sc[r * 1024 + kg * 128 + k0 + kk] * w[kk]; }
#pragma unroll
            for (int r = 0; r < 9; ++r) red[(kg * 9 + r) * 64 + jj] = acc[r];
            __syncthreads();
            for (int i = tid; i < 576; i += NTHR) { const int r = i >> 6, j2 = i & 63; float s = a.in[I_MODB][l * 6144 + jc * 64 + j2];
#pragma unroll
                for (int g = 0; g < 8; ++g) s += red[(g * 9 + r) * 64 + j2];
                modv[((size_t)l * 9 + r) * 6144 + jc * 64 + j2] = s; }
            __syncthreads();
        }
        __syncthreads();
    }
    const int gw = B * NWAVES + wave, NGW = G * NWAVES, gt = B * NTHR + tid, NGT = G * NTHR;
    { float* rope = (float*)(ws + WS_ROPE);
      for (int i = gt; i < 4096 * 16; i += NGT) { const int t = i >> 4, p = i & 15; const float pos = (float)(p < 8 ? (t >> 6) : (t & 63));
          const float inv = __powf(10000.0f, -(float)(p & 7) * 0.125f); const float ang = pos * inv; rope[t * 32 + p] = cosf(ang); rope[t * 32 + 16 + p] = sinf(ang); }
      float* bgu = (float*)(ws + WS_BGU);
      for (int i = gt; i < 2 * 32 * 2048; i += NGT) { const int le = i >> 11, np = i & 2047, q = np >> 8, g = (np >> 7) & 1, r = np & 127, f = 128 * q + r; bgu[i] = a.in[I_BGU][(size_t)le * 2048 + 2 * f + g]; }
      float* pb = (float*)(ws + WS_PW1B);
      for (int i = gt; i < 2048; i += NGT) { const int q = i >> 8, g = (i >> 7) & 1, r = i & 127, f = 128 * q + r; pb[i] = a.in[I_PW1B][g * 1024 + f]; }
      v4u* zp = (v4u*)(ws + WS_WIN + (size_t)3232 * 1024 * 2);
      for (int i = gt; i < 96 * 1024 * 2 / 16; i += NGT) zp[i] = (v4u){0u, 0u, 0u, 0u};
    }
    LAS float* scr = (LAS float*)(lds + wave * 16640);
    constexpr int I0 = 16 * 51, I1 = 6 * 12, I2 = 4 * 8, I3 = 4 * 8, I4 = 256, I5 = 512, I6 = 256, SMALL = I0 + I1 + I2 + I3 + I4 + I5 + I6;
    constexpr int NGU = 64 * 512, NDN = 64 * 256, NITEMS = SMALL + NGU + NDN;
    convert_items(a, ws, scr, lane, B * NWAVES + wave, G * NWAVES, NGU + NDN, NITEMS);
}
__device__ __forceinline__ void convert_moe_share(const Args& a, LAS unsigned char* lds, int lane, int wave) {
    LAS float* scr = (LAS float*)(lds + wave * 16640);
    constexpr int NGU = 64 * 512, NDN = 64 * 256;
    convert_items(a, a.ws, scr, lane, blockIdx.x * NWAVES + wave, gridDim.x * NWAVES, 0, NGU + NDN);
}

__device__ __forceinline__ void phase_mod0(const Args& a, int lane, int wave) {
    const int gw = blockIdx.x * NWAVES + wave, NGW = gridDim.x * NWAVES;
    const float* modv = (const float*)(a.ws + WS_MODV);
    bf16* X = (bf16*)(a.ws + WS_X);
    for (int r = gw; r < NTOK; r += NGW) {
        const int b = r / TPB, p = r - b * TPB;
        const float* src = p < CTXL ? a.in[I_CTX] + ((size_t)b * CTXL + p) * 1024 : a.in[I_X] + ((size_t)b * SEQ + (p - CTXL)) * 1024;
        const float* mv = modv + (size_t)(p < CTXL ? 8 : b) * 6144;
#pragma unroll
        for (int j = 0; j < 4; ++j) { const int c = 4 * (lane + 64 * j); const f32x4 xv = *(const f32x4*)(src + c), sh = *(const f32x4*)(mv + c), sc = *(const f32x4*)(mv + 1024 + c);
            const f32x4 y = xv * (sc + 1.0f) + sh; v2u o; o.x = pk2(y[0], y[1]); o.y = pk2(y[2], y[3]); *(v2u*)(X + (size_t)r * 1024 + c) = o; }
    }
}

__device__ __forceinline__ void phase_norm0(const Args& a, int lane, int wave) {
    const int gw = blockIdx.x * NWAVES + wave, NGW = gridDim.x * NWAVES;
    const bf16* Z = (const bf16*)(a.ws + WS_Z); bf16* CQN = (bf16*)(a.ws + WS_CQN); bf16* CKVN = (bf16*)(a.ws + WS_CKVN); bf16* KRR = (bf16*)(a.ws + WS_KRR);
    const float* rope = (const float*)(a.ws + WS_ROPE);
    float gq[8], gk[8];
#pragma unroll
    for (int i = 0; i < 8; ++i) { gq[i] = lane < 48 ? a.in[I_QNORM][8 * lane + i] : 0.f; gk[i] = lane < 32 ? a.in[I_KVNORM][8 * lane + i] : 0.f; }
    for (int r = gw; r < NTOK; r += NGW) {
        const bf16* z = Z + (size_t)r * ZC; const int p = r % TPB;
        bf16x8 q8 = {}, k8 = {}, r8 = {};
        if (lane < 48) q8 = *(const bf16x8*)(z + ZQ + 8 * lane);
        if (lane < 32) k8 = *(const bf16x8*)(z + ZKV + 8 * lane);
        if (lane < 4) r8 = *(const bf16x8*)(z + ZKR + 8 * lane);
        float qf[8], kf[8], sq = 0.f, sk = 0.f;
#pragma unroll
        for (int i = 0; i < 8; ++i) { qf[i] = bf2f((unsigned short)q8[i]); kf[i] = bf2f((unsigned short)k8[i]); sq += qf[i] * qf[i]; sk += kf[i] * kf[i]; }
        sq = wave_sum(sq); sk = wave_sum(sk);
        const float rq = rsqrtf(sq * (1.f / 384.f) + RMS_EPS), rk = rsqrtf(sk * (1.f / 256.f) + RMS_EPS);
        if (lane < 48) { v4u o; o.x = pk2(qf[0] * rq * gq[0], qf[1] * rq * gq[1]); o.y = pk2(qf[2] * rq * gq[2], qf[3] * rq * gq[3]); o.z = pk2(qf[4] * rq * gq[4], qf[5] * rq * gq[5]); o.w = pk2(qf[6] * rq * gq[6], qf[7] * rq * gq[7]);
            *(v4u*)(CQN + (size_t)r * 384 + 8 * lane) = o; }
        if (lane < 32) { v4u o; o.x = pk2(kf[0] * rk * gk[0], kf[1] * rk * gk[1]); o.y = pk2(kf[2] * rk * gk[2], kf[3] * rk * gk[3]); o.z = pk2(kf[4] * rk * gk[4], kf[5] * rk * gk[5]); o.w = pk2(kf[6] * rk * gk[6], kf[7] * rk * gk[7]);
            *(v4u*)(CKVN + (size_t)r * 256 + 8 * lane) = o; }
        if (lane < 4) { bf16x8 o8 = r8; if (p >= CTXL) o8 = att::rope8(r8, rope + (size_t)(p - CTXL) * 32, 4 * lane); *(bf16x8*)(KRR + (size_t)r * 32 + 8 * lane) = o8; }
    }
}

__device__ __forceinline__ void hgrn_unit(const Args& a, int unit, LAS unsigned char* lds, int tid) {
    const int b = unit >> 5, head = (unit >> 3) & 3, dir = (unit >> 2) & 1, sl = unit & 3;
    const bf16* Z = (const bf16*)(a.ws + WS_Z);
    float* Od = (float*)(a.ws + (dir ? WS_OB : WS_OF));
    LAS float* lbv = (LAS float*)lds;
    constexpr int BUF0 = 1024, BUFSZ = 28672, OFF_Q = 16384, OFF_V = 24576;
    if (tid < 128) { const int c = head * 128 + tid; const float l0 = a.in[I_LBL][c], l1 = a.in[I_LBL][512 + c], l2 = a.in[I_LBL][1024 + c]; const float m = fmaxf(l0, fmaxf(l1, l2));
        const float e0 = __expf(l0 - m), e1 = __expf(l1 - m), e2 = __expf(l2 - m); lbv[tid] = e0 / (e0 + e1 + e2); }
    __syncthreads();
    const int lt = tid >> 4, lcg = tid & 15;
    float lb8[8];
#pragma unroll
    for (int i = 0; i < 8; ++i) lb8[i] = lbv[8 * lcg + i];
    const int fcol = (dir ? ZHB : ZHF) + head * 128 + 8 * lcg, qcol = ZHQ + head * 128 + 8 * lcg;
    const int vt = tid >> 2, vcol = ZHI + head * 128 + sl * 32 + (tid & 3) * 8;
    const int wave = tid >> 6, lane = tid & 63, vv = lane >> 4, cg = lane & 15, vloc = wave * 4 + vv;
    const size_t zb = (size_t)b * TPB;
    bf16x8 rq, rf, rv;
#define TOKP(n) (dir ? ((n) < CTXL ? (CTXL - 1 - (n)) : (TPB + CTXL - 1 - (n))) : (n))
#define HG_LOAD(i) do { const int n_ = 32 * (i) + lt; const bf16* zr_ = Z + (zb + TOKP(n_)) * ZC; rq = *(const bf16x8*)(zr_ + qcol); rf = *(const bf16x8*)(zr_ + fcol); \
        if (tid < 128) { const int n2_ = 32 * (i) + vt; rv = *(const bf16x8*)(Z + (zb + TOKP(n2_)) * ZC + vcol); } } while (0)
#define HG_WRITE(bufi) do { LAS unsigned char* bp_ = lds + BUF0 + (bufi) * BUFSZ; float f_[8]; \
        _Pragma("unroll") for (int i_ = 0; i_ < 8; ++i_) f_[i_] = lb8[i_] + (1.f - lb8[i_]) * sigm(bf2f((unsigned short)rf[i_])); \
        *(LAS f32x4*)(bp_ + ((lt * 128 + lcg * 4) * 4)) = (f32x4){f_[0], f_[1], f_[2], f_[3]}; *(LAS f32x4*)(bp_ + ((lt * 128 + 64 + lcg * 4) * 4)) = (f32x4){f_[4], f_[5], f_[6], f_[7]}; \
        *(LAS bf16x8*)(bp_ + OFF_Q + (lt * 128 + lcg * 8) * 2) = rq; \
        if (tid < 128) { float v_[8]; _Pragma("unroll") for (int i_ = 0; i_ < 8; ++i_) v_[i_] = bf2f((unsigned short)rv[i_]); \
            *(LAS f32x4*)(bp_ + OFF_V + (vt * 32 + (tid & 3) * 8) * 4) = (f32x4){v_[0], v_[1], v_[2], v_[3]}; *(LAS f32x4*)(bp_ + OFF_V + (vt * 32 + (tid & 3) * 8 + 4) * 4) = (f32x4){v_[4], v_[5], v_[6], v_[7]}; } } while (0)
    float S[8];
#pragma unroll
    for (int j = 0; j < 8; ++j) S[j] = 0.f;
    HG_LOAD(0); HG_WRITE(0); __syncthreads();
    const bool b3 = (cg & 8) != 0, b2 = (cg & 4) != 0, b1 = (cg & 2) != 0, b0 = (cg & 1) != 0;
    for (int i = 0; i < TPB / 32; ++i) {
        if (i + 1 < TPB / 32) HG_LOAD(i + 1);
        const LAS unsigned char* bp = lds + BUF0 + (i & 1) * BUFSZ;
#pragma unroll 1
        for (int g = 0; g < 4; ++g) {
            const LAS unsigned char* gp = bp + g * 8 * 512;
            float ot[8];
#pragma unroll
            for (int t = 0; t < 8; ++t) {
                const f32x4 f0 = *(const LAS f32x4*)(gp + ((t * 128 + cg * 4) * 4)), f1 = *(const LAS f32x4*)(gp + ((t * 128 + 64 + cg * 4) * 4));
                const bf16x8 q8 = *(const LAS bf16x8*)(bp + OFF_Q + ((g * 8 + t) * 128 + cg * 8) * 2);
                const float v = *(const LAS float*)(bp + OFF_V + ((g * 8 + t) * 32 + vloc) * 4);
                float acc = 0.f;
#pragma unroll
                for (int j = 0; j < 8; ++j) { const float fj = j < 4 ? f0[j] : f1[j - 4]; const float qj = bf2f((unsigned short)q8[j]);
                    const float kv = fmaf(-fj, v, v); S[j] = fmaf(fj, S[j], kv); acc = fmaf(S[j], qj, acc); }
                ot[t] = acc;
            }
#pragma unroll
            for (int k = 0; k < 4; ++k) { const float snd = b3 ? ot[k] : ot[k + 4]; const float rcv = __shfl_xor(snd, 8); ot[k] = (b3 ? ot[k + 4] : ot[k]) + rcv; }
#pragma unroll
            for (int k = 0; k < 2; ++k) { const float snd = b2 ? ot[k] : ot[k + 2]; const float rcv = __shfl_xor(snd, 4); ot[k] = (b2 ? ot[k + 2] : ot[k]) + rcv; }
            { const float snd = b1 ? ot[0] : ot[1]; const float rcv = __shfl_xor(snd, 2); ot[0] = (b1 ? ot[1] : ot[0]) + rcv; }
            ot[0] += __shfl_xor(ot[0], 1);
            if (!b0) { const int n = 32 * i + 8 * g + (cg >> 1); const int p = TOKP(n); if (p >= CTXL) Od[(zb + p) * 512 + head * 128 + sl * 32 + vloc] = ot[0]; }
        }
        if (i + 1 < TPB / 32) HG_WRITE((i + 1) & 1);
        __syncthreads();
    }
#undef TOKP
#undef HG_LOAD
#undef HG_WRITE
}

__device__ __forceinline__ void phase_readout(const Args& a, int lane, int wave) {
    const int gw = blockIdx.x * NWAVES + wave, NGW = gridDim.x * NWAVES;
    const bf16* OF = (const bf16*)(a.ws + WS_OF); const bf16* OB = (const bf16*)(a.ws + WS_OB);
    const bf16* Z = (const bf16*)(a.ws + WS_Z); bf16* MIX = (bf16*)(a.ws + WS_Y);
    float hn[8];
#pragma unroll
    for (int i = 0; i < 8; ++i) hn[i] = a.in[I_HGNORM][((8 * lane) & 127) + i];
    for (int lr = gw; lr < NLAT; lr += NGW) {
        const size_t r = (size_t)grow_of(lr);
        const bf16x8 a8 = *(const bf16x8*)(OF + r * 512 + 8 * lane), c8 = *(const bf16x8*)(OB + r * 512 + 8 * lane);
        const bf16x8 g8 = *(const bf16x8*)(Z + r * ZC + ZHG + 8 * lane);
        float o[8]; float ss = 0.f;
#pragma unroll
        for (int i = 0; i < 8; ++i) o[i] = bf2f((unsigned short)a8[i]) + bf2f((unsigned short)c8[i]);
#pragma unroll
        for (int i = 0; i < 8; ++i) ss += o[i] * o[i];
        ss += __shfl_xor(ss, 1); ss += __shfl_xor(ss, 2); ss += __shfl_xor(ss, 4); ss += __shfl_xor(ss, 8);
        const float rs = rsqrtf(ss * (1.f / 128.f) + RMS_EPS);
        float y[8];
#pragma unroll
        for (int i = 0; i < 8; ++i) { const float g = bf2f((unsigned short)g8[i]); y[i] = o[i] * rs * hn[i] * (g * sigm(g)); }
        v4u w; w.x = pk2(y[0], y[1]); w.y = pk2(y[2], y[3]); w.z = pk2(y[4], y[5]); w.w = pk2(y[6], y[7]);
        *(v4u*)(MIX + r * 1024 + 512 + 8 * lane) = w;
    }
}

__device__ __forceinline__ int rows_per_block() { const int G = gridDim.x; return (((NLAT + G - 1) / G) + 15) & ~15; }
__device__ __forceinline__ void phase_ln1(const Args& a, int l, LAS unsigned char* lds, int tid, int lane, int wave) {
    typedef short bf16x8s __attribute__((ext_vector_type(8)));
    const int RB = rows_per_block(), lr_base = blockIdx.x * RB;
    const bf16* PRE = (const bf16*)(a.ws + WS_PRE); bf16* XB = (bf16*)(a.ws + WS_X);
    const float* modv = (const float*)(a.ws + WS_MODV) + (size_t)l * 9 * 6144;
    const float* lng = a.in[I_LN1G] + l * 1024; const float* lnb = a.in[I_LN1B] + l * 1024;
    const float* rw = a.in[I_RW] + (size_t)l * 1024 * 32; const float* rb = a.in[I_RB] + l * 32;
    constexpr int XT_LD = 1028, O_PART = 16 * XT_LD * 4, O_LG = O_PART + 8 * 32 * 16 * 4, O_HIST = O_LG + 16 * 33 * 4 + 64, O_CCNT = O_HIST + 256, O_TIL = O_CCNT + 2048, O_TWL = O_TIL + 4096;
    LAS float* XT = (LAS float*)lds; LAS float* PART = (LAS float*)(lds + O_PART); LAS float* LG = (LAS float*)(lds + O_LG);
    LAS int* hist = (LAS int*)(lds + O_HIST);
    LAS int* ccnt = (LAS int*)(lds + O_CCNT);
    LAS int* til = (LAS int*)(lds + O_TIL);
    LAS float* twl = (LAS float*)(lds + O_TWL);
    __syncthreads();
    if (tid < 32) hist[tid] = 0;
    bf16x8s whi[2][4], wlo[2][4];
    { const int e15 = lane & 15, kq = lane >> 4;
#pragma unroll
      for (int t = 0; t < 2; ++t)
#pragma unroll
          for (int sI = 0; sI < 4; ++sI) { float wv[8];
#pragma unroll
              for (int j = 0; j < 8; ++j) wv[j] = rw[(size_t)(128 * wave + 32 * sI + 8 * kq + j) * 32 + 16 * t + e15];
              v4u ph, pl;
#pragma unroll
              for (int j = 0; j < 4; ++j) { const unsigned p = pk2(wv[2 * j], wv[2 * j + 1]); const float h0 = __uint_as_float(p << 16), h1 = __uint_as_float(p & 0xffff0000u); ph[j] = p; pl[j] = pk2(wv[2 * j] - h0, wv[2 * j + 1] - h1); }
              whi[t][sI] = __builtin_bit_cast(bf16x8s, ph); wlo[t][sI] = __builtin_bit_cast(bf16x8s, pl); } }
    const int ngroups = RB / 16;
    v2u xr[2][4];
#define LN1_LOAD(g) do { _Pragma("unroll") for (int rr_ = 0; rr_ < 2; ++rr_) { const int lr_ = lr_base + 16 * (g) + 2 * wave + rr_; const size_t r_ = (size_t)grow_of(lr_ < NLAT ? lr_ : NLAT - 1); \
        _Pragma("unroll") for (int j_ = 0; j_ < 4; ++j_) xr[rr_][j_] = *(const v2u*)(PRE + r_ * 1024 + 4 * (lane + 64 * j_)); } } while (0)
#if defined(PROBE_LN1X2)
    for (int rep_ = 0; rep_ < 2; ++rep_) { __syncthreads(); if (tid < 32) hist[tid] = 0; __syncthreads();
#endif
    LN1_LOAD(0);
    for (int g = 0; g < ngroups; ++g) {
#pragma unroll
        for (int rr = 0; rr < 2; ++rr) {
            const int lr = lr_base + 16 * g + 2 * wave + rr; const bool ok = lr < NLAT; const size_t r = (size_t)grow_of(ok ? lr : NLAT - 1); const int b = (ok ? lr : NLAT - 1) >> 12;
            const float* mv = modv + (size_t)b * 6144;
            f32x4 x[4]; float s = 0.f;
#pragma unroll
            for (int j = 0; j < 4; ++j) { const v2u p = xr[rr][j]; x[j] = (f32x4){__uint_as_float(p.x << 16), __uint_as_float(p.x & 0xffff0000u), __uint_as_float(p.y << 16), __uint_as_float(p.y & 0xffff0000u)}; s += (x[j][0] + x[j][1]) + (x[j][2] + x[j][3]); }
            const float mean = wave_sum(s) * (1.f / 1024.f); float s2 = 0.f;
#pragma unroll
            for (int j = 0; j < 4; ++j) { x[j] = x[j] - mean; s2 += (x[j][0] * x[j][0] + x[j][1] * x[j][1]) + (x[j][2] * x[j][2] + x[j][3] * x[j][3]); }
            const float rstd = rsqrtf(wave_sum(s2) * (1.f / 1024.f) + LN_EPS);
#pragma unroll
            for (int j = 0; j < 4; ++j) { const int c = 4 * (lane + 64 * j); const f32x4 gg = *(const f32x4*)(lng + c), bb = *(const f32x4*)(lnb + c);
                const f32x4 hv = x[j] * rstd * gg + bb;
                const f32x4 sh = *(const f32x4*)(mv + 3 * 1024 + c), sc = *(const f32x4*)(mv + 4 * 1024 + c);
                const f32x4 bm = hv * (sc + 1.0f) + sh;
                if (ok) *(unsigned*)((unsigned char*)XB + r * 1024 + c) = pack_fp8x4(bm[0] * SC_X8, bm[1] * SC_X8, bm[2] * SC_X8, bm[3] * SC_X8);
                *(LAS f32x4*)(XT + (2 * wave + rr) * XT_LD + c) = bm; }
        }
        if (g + 1 < ngroups) LN1_LOAD(g + 1);
        __syncthreads();
        { const int rr = lane & 15, kq = lane >> 4;
          f32x4 acc0 = {0.f, 0.f, 0.f, 0.f}, acc1 = {0.f, 0.f, 0.f, 0.f};
#pragma unroll
          for (int sI = 0; sI < 4; ++sI) { const LAS float* xp = XT + rr * XT_LD + 128 * wave + 32 * sI + 8 * kq; const f32x4 v0 = *(const LAS f32x4*)xp, v1 = *(const LAS f32x4*)(xp + 4);
              const float bv[8] = {v0[0], v0[1], v0[2], v0[3], v1[0], v1[1], v1[2], v1[3]}; v4u ph, pl;
#pragma unroll
              for (int j = 0; j < 4; ++j) { const unsigned p = pk2(bv[2 * j], bv[2 * j + 1]); const float h0 = __uint_as_float(p << 16), h1 = __uint_as_float(p & 0xffff0000u); ph[j] = p; pl[j] = pk2(bv[2 * j] - h0, bv[2 * j + 1] - h1); }
              const bf16x8s bh = __builtin_bit_cast(bf16x8s, ph), bl = __builtin_bit_cast(bf16x8s, pl);
              acc0 = __builtin_amdgcn_mfma_f32_16x16x32_bf16(whi[0][sI], bh, acc0, 0, 0, 0); acc0 = __builtin_amdgcn_mfma_f32_16x16x32_bf16(whi[0][sI], bl, acc0, 0, 0, 0); acc0 = __builtin_amdgcn_mfma_f32_16x16x32_bf16(wlo[0][sI], bh, acc0, 0, 0, 0);
              acc1 = __builtin_amdgcn_mfma_f32_16x16x32_bf16(whi[1][sI], bh, acc1, 0, 0, 0); acc1 = __builtin_amdgcn_mfma_f32_16x16x32_bf16(whi[1][sI], bl, acc1, 0, 0, 0); acc1 = __builtin_amdgcn_mfma_f32_16x16x32_bf16(wlo[1][sI], bh, acc1, 0, 0, 0); }
#pragma unroll
          for (int q = 0; q < 4; ++q) { PART[(wave * 32 + 4 * kq + q) * 16 + rr] = acc0[q]; PART[(wave * 32 + 16 + 4 * kq + q) * 16 + rr] = acc1[q]; } }
        __syncthreads();
        { const int e = tid >> 4, rr = tid & 15; float sacc = rb[e];
#pragma unroll
          for (int w = 0; w < 8; ++w) sacc += PART[(w * 32 + e) * 16 + rr];
          LG[rr * 33 + e] = sacc; }
        __syncthreads();
        if (wave == (g & 7) && lane < 16) { const int lr = lr_base + 16 * g + lane;
            if (lr < NLAT) { float lg[32];
#pragma unroll
                for (int e = 0; e < 32; ++e) lg[e] = LG[lane * 33 + e];
                unsigned taken = 0u; float tv[4]; int ti[4];
#pragma unroll
                for (int kk = 0; kk < 4; ++kk) { float best = -3.0e38f; int bi = 0;
#pragma unroll
                    for (int e = 0; e < 32; ++e) { const bool okk = (lg[e] > best) && !((taken >> e) & 1u); best = okk ? lg[e] : best; bi = okk ? e : bi; }
                    taken |= 1u << bi; tv[kk] = best; ti[kk] = bi; }
                const float e1 = __expf(tv[1] - tv[0]), e2 = __expf(tv[2] - tv[0]), e3 = __expf(tv[3] - tv[0]); const float inv = 1.f / (1.f + e1 + e2 + e3);
                const int li = (16 * g + lane) * 4; til[li] = ti[0]; til[li + 1] = ti[1]; til[li + 2] = ti[2]; til[li + 3] = ti[3]; twl[li] = inv; twl[li + 1] = e1 * inv; twl[li + 2] = e2 * inv; twl[li + 3] = e3 * inv;
                __hip_atomic_fetch_add(hist + ti[0], 1, __ATOMIC_RELAXED, __HIP_MEMORY_SCOPE_WORKGROUP); __hip_atomic_fetch_add(hist + ti[1], 1, __ATOMIC_RELAXED, __HIP_MEMORY_SCOPE_WORKGROUP);
                __hip_atomic_fetch_add(hist + ti[2], 1, __ATOMIC_RELAXED, __HIP_MEMORY_SCOPE_WORKGROUP); __hip_atomic_fetch_add(hist + ti[3], 1, __ATOMIC_RELAXED, __HIP_MEMORY_SCOPE_WORKGROUP); } }
    }
#if defined(PROBE_LN1X2)
    }
#endif
#undef LN1_LOAD
    __syncthreads();
    int* cursor = (int*)(a.ws + WS_CURSOR) + l * 32;
    int* rows = (int*)(a.ws + WS_ROWS); float* roww = (float*)(a.ws + WS_ROWW); int* rowd = (int*)(a.ws + WS_ROWD);
    int nrows = NLAT - lr_base; nrows = nrows > RB ? RB : nrows; if (nrows < 0) nrows = 0;
    const int nas = nrows * 4, nchunks = (nas + 63) >> 6;
    int basev = 0; if (tid < 32) basev = (int)__hip_atomic_fetch_add((unsigned*)cursor + tid, (unsigned)hist[tid], __ATOMIC_RELAXED, __HIP_MEMORY_SCOPE_AGENT);
    int myrank[2] = {0, 0}, mye[2] = {-1, -1};
#pragma unroll
    for (int cc = 0; cc < 2; ++cc) { const int c = wave + 8 * cc; if (c < nchunks) { const int idx = c * 64 + lane; const int e = idx < nas ? til[idx] : -1; mye[cc] = e;
        for (int x = 0; x < 32; ++x) { const unsigned long long m = __ballot(e == x); if (e == x) myrank[cc] = __popcll(m & ((1ull << lane) - 1ull)); if (lane == 0) ccnt[c * 32 + x] = __popcll(m); } } }
    __syncthreads();
    if (tid < 32) hist[32 + tid] = basev;
    __syncthreads();
#pragma unroll
    for (int cc = 0; cc < 2; ++cc) { const int c = wave + 8 * cc; const int idx = c * 64 + lane; if (c < nchunks && idx < nas) { const int e = mye[cc]; int pos = hist[32 + e] + myrank[cc]; for (int c2 = 0; c2 < c; ++c2) pos += ccnt[c2 * 32 + e];
        const int lr = lr_base + (idx >> 2); const size_t pi = (size_t)e * ECAP + pos; rows[pi] = grow_of(lr); roww[pi] = twl[idx]; rowd[pi] = lr * 4 + (idx & 3); } }
}

__device__ __forceinline__ void phase_ln2(const Args& a, int l, int lane, int wave) {
    const int gw = blockIdx.x * NWAVES + wave, NGW = gridDim.x * NWAVES;
    float* H = (float*)(a.ws + WS_H); const bf16* PRE = (const bf16*)(a.ws + WS_PRE); const unsigned char* YB = (const unsigned char*)(a.ws + WS_YB); bf16* A1 = (bf16*)(a.ws + WS_Y);
    const float* modv = (const float*)(a.ws + WS_MODV);
    const float* ln1g = a.in[I_LN1G] + l * 1024; const float* ln1b = a.in[I_LN1B] + l * 1024;
    const float* lng = a.in[I_LN2G] + l * 1024; const float* lnb = a.in[I_LN2B] + l * 1024;
    for (int lr0 = 2 * gw; lr0 < NLAT; lr0 += 2 * NGW) {
        v2u hv[2][4]; unsigned yv[2][4][4];
#pragma unroll
        for (int q = 0; q < 2; ++q) { const int lr = lr0 + q; const size_t r = (size_t)grow_of(lr);
#pragma unroll
            for (int j = 0; j < 4; ++j) { const int c = 4 * (lane + 64 * j); hv[q][j] = *(const v2u*)(PRE + r * 1024 + c);
#pragma unroll
                for (int k = 0; k < 4; ++k) yv[q][j][k] = *(const unsigned*)(YB + ((size_t)lr * 4 + k) * 1024 + c); } }
#pragma unroll
        for (int q = 0; q < 2; ++q) {
            const int lr = lr0 + q; const size_t r = (size_t)grow_of(lr); const int b = lr >> 12;
            const float* mv = modv + ((size_t)l * 9 + b) * 6144; const float* mv1 = modv + ((size_t)9 + b) * 6144;
            f32x4 x[4]; float s = 0.f;
#pragma unroll
            for (int j = 0; j < 4; ++j) { const v2u p = hv[q][j]; x[j] = (f32x4){__uint_as_float(p.x << 16), __uint_as_float(p.x & 0xffff0000u), __uint_as_float(p.y << 16), __uint_as_float(p.y & 0xffff0000u)}; s += (x[j][0] + x[j][1]) + (x[j][2] + x[j][3]); }
            float mean = wave_sum(s) * (1.f / 1024.f), s2 = 0.f;
#pragma unroll
            for (int j = 0; j < 4; ++j) { x[j] = x[j] - mean; s2 += (x[j][0] * x[j][0] + x[j][1] * x[j][1]) + (x[j][2] * x[j][2] + x[j][3] * x[j][3]); }
            float rstd = rsqrtf(wave_sum(s2) * (1.f / 1024.f) + LN_EPS);
            s = 0.f;
#pragma unroll
            for (int j = 0; j < 4; ++j) { const int c = 4 * (lane + 64 * j); const f32x4 g = *(const f32x4*)(ln1g + c), bb = *(const f32x4*)(ln1b + c);
                const f32x4 h1 = x[j] * rstd * g + bb; f32x4 f = {0.f, 0.f, 0.f, 0.f};
#pragma unroll
                for (int k = 0; k < 4; ++k) { const unsigned y = yv[q][j][k]; const auto lo = __builtin_amdgcn_cvt_pk_f32_fp8((int)y, false), hi = __builtin_amdgcn_cvt_pk_f32_fp8((int)y, true);
                    f[0] += lo[0]; f[1] += lo[1]; f[2] += hi[0]; f[3] += hi[1]; }
                const f32x4 gt = *(const f32x4*)(mv + 5 * 1024 + c);
                x[j] = h1 * ALPHA + gt * (f * (1.f / SC_Y)); s += (x[j][0] + x[j][1]) + (x[j][2] + x[j][3]); }
            mean = wave_sum(s) * (1.f / 1024.f); s2 = 0.f;
#pragma unroll
            for (int j = 0; j < 4; ++j) { x[j] = x[j] - mean; s2 += (x[j][0] * x[j][0] + x[j][1] * x[j][1]) + (x[j][2] * x[j][2] + x[j][3] * x[j][3]); }
            rstd = rsqrtf(wave_sum(s2) * (1.f / 1024.f) + LN_EPS);
#pragma unroll
            for (int j = 0; j < 4; ++j) { const int c = 4 * (lane + 64 * j); const f32x4 g = *(const f32x4*)(lng + c), bb = *(const f32x4*)(lnb + c);
                const f32x4 o = x[j] * rstd * g + bb;
                if (l == 0) { *(f32x4*)(H + r * 1024 + c) = o; const f32x4 sh = *(const f32x4*)(mv1 + c), sc = *(const f32x4*)(mv1 + 1024 + c);
                    const f32x4 am = o * (sc + 1.0f) + sh; v2u w; w.x = pk2(am[0], am[1]); w.y = pk2(am[2], am[3]); *(v2u*)(A1 + r * 1024 + c) = w; }
                else *(f32x4*)(a.out + (size_t)lr * 1024 + c) = o; }
        }
    }
}

__device__ __forceinline__ void phase_conv(const Args& a, LAS unsigned char* lds, int tid, int lane, int wave) {
    const bf16* U = (const bf16*)(a.ws + WS_X); bf16* V = (bf16*)(a.ws + WS_Y);
    LAS float* part = (LAS float*)(lds + 126976);
    LAS float* st = part + 512;
    const int c0 = 2 * tid;
    const float db0 = a.in[I_DWB][c0], db1 = a.in[I_DWB][c0 + 1], g0 = a.in[I_CLNG][c0], g1 = a.in[I_CLNG][c0 + 1], be0 = a.in[I_CLNB][c0], be1 = a.in[I_CLNB][c0 + 1];
    for (int tile = blockIdx.x; tile < NLAT / 32; tile += gridDim.x) {
        const int b = tile >> 7, t0 = (tile & 127) * 32;
        const size_t rb0 = (size_t)b * TPB + CTXL;
        __syncthreads();
        for (int i = tid; i < 62 * 128; i += NTHR) { const int row = i >> 7, chk = i & 127, t = t0 - 15 + row;
            v4u val = {0u, 0u, 0u, 0u}; if (t >= 0 && t < SEQ) val = *(const v4u*)(U + (rb0 + t) * 1024 + chk * 8);
            *(LAS v4u*)(lds + row * 2048 + chk * 16) = val; }
        __syncthreads();
        float w0[31], w1[31];
#pragma unroll
        for (int j = 0; j < 31; ++j) { const float2 wv = *(const float2*)(a.in[I_DWW] + j * 1024 + c0); w0[j] = wv.x; w1[j] = wv.y; }
#pragma unroll 1
        for (int hh = 0; hh < 2; ++hh) {
            const LAS unsigned char* hp = lds + hh * 16 * 2048;
            float acc0[16], acc1[16];
#pragma unroll
            for (int t = 0; t < 16; ++t) { acc0[t] = db0; acc1[t] = db1; }
#pragma unroll
            for (int s = 0; s < 46; ++s) { const unsigned pr = *(const LAS unsigned*)(hp + s * 2048 + tid * 4); const float x0 = __uint_as_float(pr << 16), x1 = __uint_as_float(pr & 0xffff0000u);
#pragma unroll
                for (int t = (s > 30 ? s - 30 : 0); t <= (s < 15 ? s : 15); ++t) { acc0[t] = fmaf(x0, w0[s - t], acc0[t]); acc1[t] = fmaf(x1, w1[s - t], acc1[t]); } }
            float rs[32];
#pragma unroll
            for (int t = 0; t < 16; ++t) { rs[2 * t] = acc0[t] + acc1[t]; rs[2 * t + 1] = acc0[t] * acc0[t] + acc1[t] * acc1[t]; }
#define RS_STEP(NKEEP, XORV) { const bool bit_ = (lane & XORV) != 0; _Pragma("unroll") for (int k_ = 0; k_ < NKEEP; ++k_) { const float snd_ = bit_ ? rs[k_] : rs[k_ + NKEEP]; const float rcv_ = __shfl_xor(snd_, XORV); rs[k_] = (bit_ ? rs[k_ + NKEEP] : rs[k_]) + rcv_; } }
            RS_STEP(16, 32) RS_STEP(8, 16) RS_STEP(4, 8) RS_STEP(2, 4) RS_STEP(1, 2)
#undef RS_STEP
            rs[0] += __shfl_xor(rs[0], 1);
            __syncthreads();
            if ((lane & 1) == 0) part[wave * 32 + (lane >> 1)] = rs[0];
            __syncthreads();
            if (tid < 16) { float s1 = 0.f, s2 = 0.f;
#pragma unroll
                for (int w = 0; w < 8; ++w) { s1 += part[w * 32 + 2 * tid]; s2 += part[w * 32 + 2 * tid + 1]; }
                const float mean = s1 * (1.f / 1024.f); const float var = fmaxf(s2 * (1.f / 1024.f) - mean * mean, 0.f); st[2 * tid] = mean; st[2 * tid + 1] = rsqrtf(var + LN_EPS); }
            __syncthreads();
#pragma unroll
            for (int t = 0; t < 16; ++t) { const float mean = st[2 * t], rstd = st[2 * t + 1];
                const float y0 = (acc0[t] - mean) * rstd * g0 + be0, y1 = (acc1[t] - mean) * rstd * g1 + be1;
                *(unsigned*)(V + (rb0 + t0 + hh * 16 + t) * 1024 + c0) = pk2(y0 * sigm(y0), y1 * sigm(y1)); }
        }
    }
}

namespace hg {
using bf16x8 = __attribute__((ext_vector_type(8))) short;
using s16x4  = __attribute__((ext_vector_type(4))) short;
using f32x16 = __attribute__((ext_vector_type(16))) float;
using u32x4  = __attribute__((ext_vector_type(4))) unsigned;
constexpr int RS = 272;
constexpr int VS = 80;
constexpr int T_Q = 0, T_KO = 32 * RS, T_KE = 64 * RS, T_D = 96 * RS, IMG_BYTES = T_D + 512, T_V = IMG_BYTES, TILE_BYTES = T_V + 32 * VS;
constexpr int OFF_TILES = 1024, NTB = 3, OFF_OPART = OFF_TILES + NTB * TILE_BYTES, OPART_BYTES = 4 * 4096;
static_assert(OFF_OPART + 2 * OPART_BYTES <= 131072 && IMG_BYTES % 16 == 0 && IMG_BYTES / 16 == 1664, "hgrn lds");
constexpr int P_RAW = 1024, R_Q = 0, R_F = 32 * RS, RAW_BYTES = 64 * RS, P_IMG = P_RAW + RAW_BYTES;
constexpr int NCHUNK = TPB / 32, NCHAIN = NB * 4 * 2, NITEM = NCHAIN * NCHUNK;
__device__ __forceinline__ int crow(int r, int hi) { return (r & 3) + 8 * (r >> 2) + 4 * hi; }
__device__ __forceinline__ s16x4 tr_read(unsigned addr) { s16x4 r; asm volatile("ds_read_b64_tr_b16 %0, %1" : "=&v"(r) : "v"(addr) : "memory"); return r; }
__device__ __forceinline__ bf16x8 cat8(s16x4 l, s16x4 h) { return (bf16x8){l[0], l[1], l[2], l[3], h[0], h[1], h[2], h[3]}; }
__device__ __forceinline__ bf16x8 pack8(const f32x16& x, int base) {
    u32x4 w; w[0] = pk2(x[base + 0], x[base + 1]); w[1] = pk2(x[base + 2], x[base + 3]); w[2] = pk2(x[base + 4], x[base + 5]); w[3] = pk2(x[base + 6], x[base + 7]);
    return *reinterpret_cast<bf16x8*>(&w);
}
}


#define HG_TOKP(dir, n) ((dir) ? ((n) < CTXL ? (CTXL - 1 - (n)) : (TPB + CTXL - 1 - (n))) : (n))
#define HG_DPP1(x, ctrl, rmask) __int_as_float(__builtin_amdgcn_update_dpp(0x3f800000, __float_as_int(x), ctrl, rmask, 0xf, false))
#define HG_DPP(x, ctrl, rmask) __int_as_float(__builtin_amdgcn_update_dpp(0, __float_as_int(x), ctrl, rmask, 0xf, false))
__device__ __forceinline__ void hgrn_prep_items(const Args& a, LAS unsigned char* lds, int tid) {
    using namespace hg;
    const bf16* Z = (const bf16*)(a.ws + WS_Z);
    unsigned char* HT = a.ws + WS_HT;
    const int wave = __builtin_amdgcn_readfirstlane(tid >> 6), lane = tid & 63, t = lane & 31, half = lane >> 5;
    const int c0 = 16 * wave + 8 * half;
    const int lr = tid >> 4, lch = tid & 15;
    LAS float* lbt = (LAS float*)lds;
    constexpr int P_RAW2 = 2048, P_IMG2 = P_RAW2 + 2 * RAW_BYTES;
    static_assert(P_IMG2 + 2 * IMG_BYTES <= 131072, "prep lds");
    __syncthreads();
    { const float l0 = a.in[I_LBL][tid], l1 = a.in[I_LBL][512 + tid], l2 = a.in[I_LBL][1024 + tid]; const float m = fmaxf(l0, fmaxf(l1, l2));
      const float e0 = __expf(l0 - m), e1 = __expf(l1 - m), e2 = __expf(l2 - m); lbt[tid] = e0 / (e0 + e1 + e2); }
    bf16x8 gq, gf;
#define HP_LOAD(it) do { const int ch_ = (it) % NCHUNK, cn_ = (it) / NCHUNK, dir_ = cn_ & 1, hd_ = (cn_ >> 1) & 3, b_ = cn_ >> 3; \
        const bf16* zr_ = Z + ((size_t)b_ * TPB + HG_TOKP(dir_, 32 * ch_ + lr)) * ZC; gq = *(const bf16x8*)(zr_ + ZHQ + hd_ * 128 + lch * 8); gf = *(const bf16x8*)(zr_ + (dir_ ? ZHB : ZHF) + hd_ * 128 + lch * 8); } while (0)
#define HP_STASH(bufi) do { LAS unsigned char* rb_ = lds + P_RAW2 + (bufi) * RAW_BYTES; *(LAS bf16x8*)(rb_ + R_Q + lr * RS + lch * 16) = gq; *(LAS bf16x8*)(rb_ + R_F + lr * RS + lch * 16) = gf; } while (0)
#define HP_COPYOUT(item, bufi) do { v4u* dst_ = (v4u*)(HT + (size_t)(item) * IMG_BYTES); const LAS v4u* src_ = (const LAS v4u*)(lds + P_IMG2 + (bufi) * IMG_BYTES); \
        dst_[tid] = src_[tid]; dst_[tid + 512] = src_[tid + 512]; dst_[tid + 1024] = src_[tid + 1024]; if (tid < 128) dst_[tid + 1536] = src_[tid + 1536]; } while (0)
    const int G = gridDim.x;
    int it = blockIdx.x, par = 0;
    if (it < NITEM) { HP_LOAD(it); HP_STASH(0); }
    if (it + G < NITEM) HP_LOAD(it + G);
    __syncthreads();
    for (; it < NITEM; it += G, par ^= 1) {
        if (it + G < NITEM) HP_STASH(par ^ 1);
        if (it != (int)blockIdx.x) HP_COPYOUT(it - G, par ^ 1);
        if (it + 2 * G < NITEM) HP_LOAD(it + 2 * G);
        const int hd = ((it / NCHUNK) >> 1) & 3;
        {
            const LAS unsigned char* rb_ = lds + P_RAW2 + par * RAW_BYTES;
            const bf16x8 RQ = *(const LAS bf16x8*)(rb_ + R_Q + t * RS + c0 * 2), RF = *(const LAS bf16x8*)(rb_ + R_F + t * RS + c0 * 2);
            const f32x4 lbA = *(const LAS f32x4*)(lbt + hd * 128 + c0), lbB = *(const LAS f32x4*)(lbt + hd * 128 + c0 + 4);
            LAS unsigned char* tb_ = lds + P_IMG2 + par * IMG_BYTES;
            float bb_[8], kk_[8];
#pragma unroll
            for (int i_ = 0; i_ < 8; ++i_) { const float lb_ = i_ < 4 ? lbA[i_] : lbB[i_ - 4]; const float f_ = lb_ + (1.f - lb_) * __builtin_amdgcn_rcpf(1.f + __expf(-bf2f((unsigned short)RF[i_]))); kk_[i_] = 1.f - f_; bb_[i_] = f_; }
#pragma unroll
            for (int i_ = 0; i_ < 8; ++i_) { float x_ = bb_[i_]; x_ *= HG_DPP1(x_, 0x111, 0xf); x_ *= HG_DPP1(x_, 0x112, 0xf); x_ *= HG_DPP1(x_, 0x114, 0xf); x_ *= HG_DPP1(x_, 0x118, 0xf);
                x_ *= HG_DPP1(x_, 0x142, 0xa); bb_[i_] = x_; }
            float qi_[8], ko_[8], ke_[8], dd_[8];
#pragma unroll
            for (int i_ = 0; i_ < 8; ++i_) { const int bi_ = __float_as_int(bb_[i_]); dd_[i_] = __int_as_float(half ? __builtin_amdgcn_readlane(bi_, 63) : __builtin_amdgcn_readlane(bi_, 31));
                const float e_ = bb_[i_]; const float ei_ = __builtin_amdgcn_rcpf(e_);
                qi_[i_] = bf2f((unsigned short)RQ[i_]) * e_; ko_[i_] = kk_[i_] * ei_; ke_[i_] = kk_[i_] * (dd_[i_] * ei_); }
            *(LAS v4u*)(tb_ + T_Q + t * RS + c0 * 2) = (v4u){pk2(qi_[0], qi_[1]), pk2(qi_[2], qi_[3]), pk2(qi_[4], qi_[5]), pk2(qi_[6], qi_[7])};
            *(LAS v4u*)(tb_ + T_KO + t * RS + c0 * 2) = (v4u){pk2(ko_[0], ko_[1]), pk2(ko_[2], ko_[3]), pk2(ko_[4], ko_[5]), pk2(ko_[6], ko_[7])};
            *(LAS v4u*)(tb_ + T_KE + t * RS + c0 * 2) = (v4u){pk2(ke_[0], ke_[1]), pk2(ke_[2], ke_[3]), pk2(ke_[4], ke_[5]), pk2(ke_[6], ke_[7])};
            if (t == 31) { *(LAS f32x4*)(tb_ + T_D + c0 * 4) = (f32x4){dd_[0], dd_[1], dd_[2], dd_[3]}; *(LAS f32x4*)(tb_ + T_D + c0 * 4 + 16) = (f32x4){dd_[4], dd_[5], dd_[6], dd_[7]}; }
            if (tid < 32) *(LAS v4u*)(tb_ + T_Q + tid * RS + 256) = (v4u){0u, 0u, 0u, 0u};
            else if (tid < 64) *(LAS v4u*)(tb_ + T_KO + (tid - 32) * RS + 256) = (v4u){0u, 0u, 0u, 0u};
            else if (tid < 96) *(LAS v4u*)(tb_ + T_KE + (tid - 64) * RS + 256) = (v4u){0u, 0u, 0u, 0u};
        }
        __syncthreads();
    }
    if (it - G >= (int)blockIdx.x && it - G < NITEM) HP_COPYOUT(it - G, par ^ 1);
    __syncthreads();
#undef HP_COPYOUT
#undef HP_LOAD
#undef HP_STASH
}

__device__ __forceinline__ void hgrn_unit_mfma(const Args& a, int unit, LAS unsigned char* lds, int tid) {
    using namespace hg;
    const int b = unit >> 5, head = (unit >> 3) & 3, dir = (unit >> 2) & 1, sl = unit & 3;
    const bf16* Z = (const bf16*)(a.ws + WS_Z);
    const unsigned char* HT = a.ws + WS_HT + (size_t)((b * 4 + head) * 2 + dir) * NCHUNK * IMG_BYTES;
    bf16* Od = (bf16*)(a.ws + (dir ? WS_OB : WS_OF));
    const int wave = __builtin_amdgcn_readfirstlane(tid >> 6), lane = tid & 63;
    const size_t zb = (size_t)b * TPB;
    constexpr int NCH = NCHUNK;
    const int vr = (tid >> 2) & 31, vp = tid & 3, lvcol = ZHI + head * 128 + sl * 32 + vp * 8, i3 = 1536 + (tid & 127);
    v4u gA0, gA1, gA2, gA3, gB0, gB1, gB2, gB3; bf16x8 gAv, gBv;
#define HG_LOAD(g0, g1, g2, g3, gv, ch) do { const int c_ = (ch) < NCH ? (ch) : NCH - 1; const v4u* src_ = (const v4u*)(HT + (size_t)c_ * IMG_BYTES); \
        g0 = src_[tid]; g1 = src_[tid + 512]; g2 = src_[tid + 1024]; g3 = src_[i3]; gv = *(const bf16x8*)(Z + (zb + HG_TOKP(dir, 32 * c_ + vr)) * ZC + lvcol); } while (0)
#define HG_STASH(g0, g1, g2, g3, gv, bufi) do { LAS unsigned char* tb_ = lds + OFF_TILES + (bufi) * TILE_BYTES; LAS v4u* d_ = (LAS v4u*)tb_; \
        d_[tid] = g0; d_[tid + 512] = g1; d_[tid + 1024] = g2; if (tid < 128) { d_[tid + 1536] = g3; *(LAS bf16x8*)(tb_ + T_V + vr * VS + vp * 16) = gv; } } while (0)
    const int r32 = lane & 31, hi = lane >> 5, g1 = (lane >> 4) & 1, q4 = (lane & 15) >> 2, p4 = lane & 3, cb = 32 * wave;
    const unsigned lbase = (unsigned)(uintptr_t)lds;
    f32x16 S = {};
    HG_LOAD(gA0, gA1, gA2, gA3, gAv, 0); HG_STASH(gA0, gA1, gA2, gA3, gAv, 0); HG_LOAD(gA0, gA1, gA2, gA3, gAv, 1); HG_STASH(gA0, gA1, gA2, gA3, gAv, 1);
    HG_LOAD(gA0, gA1, gA2, gA3, gAv, 2);
    __syncthreads();
#define HG_RD64(dst, addr, OFFS) asm volatile("ds_read_b64 %0, %1 offset:" #OFFS : "=&v"(dst) : "v"(addr) : "memory")
#define HG_MFMA_STAGE(n, bufi) do { \
            const unsigned tb = lbase + OFF_TILES + (bufi) * TILE_BYTES; const LAS unsigned char* tl_ = lds + OFF_TILES + (bufi) * TILE_BYTES; \
            bf16x8 ko[2], qi[2]; s16x4 pvl[2], pvh[2], pql[2], pqh[2], kl[2], kh[2], nvl[2], nvh[2]; f32x4 dsc[4]; \
            _Pragma("unroll") for (int kk = 0; kk < 2; ++kk) { ko[kk] = *(const LAS bf16x8*)(tl_ + T_KO + r32 * RS + (cb + 16 * kk + 8 * hi) * 2); qi[kk] = *(const LAS bf16x8*)(tl_ + T_Q + r32 * RS + (cb + 16 * kk + 8 * hi) * 2); } \
            _Pragma("unroll") for (int sp = 0; sp < 2; ++sp) { \
                const unsigned va = tb + T_V + (16 * sp + 4 * hi + q4) * VS + (16 * g1 + 4 * p4) * 2; pvl[sp] = tr_read(va); pvh[sp] = tr_read(va + 8 * VS);              \
                const unsigned qa = tb + T_Q + r32 * RS + (cb + 16 * sp + 4 * hi) * 2; HG_RD64(pql[sp], qa, 0); HG_RD64(pqh[sp], qa, 16);                                  \
                const unsigned ka = tb + T_KE + (16 * sp + 8 * hi + q4) * RS + (cb + 16 * g1 + 4 * p4) * 2; kl[sp] = tr_read(ka); kh[sp] = tr_read(ka + 4 * RS);        \
                const unsigned vb = tb + T_V + (16 * sp + 8 * hi + q4) * VS + (16 * g1 + 4 * p4) * 2; nvl[sp] = tr_read(vb); nvh[sp] = tr_read(vb + 4 * VS); }            \
            _Pragma("unroll") for (int g = 0; g < 4; ++g) dsc[g] = *(const LAS f32x4*)(tl_ + T_D + (cb + 8 * g + 4 * hi) * 4); \
            asm volatile("s_waitcnt lgkmcnt(0)" ::: "memory"); __builtin_amdgcn_sched_barrier(0); \
            f32x16 X = {}; \
            X = __builtin_amdgcn_mfma_f32_32x32x16_bf16(ko[0], qi[0], X, 0, 0, 0); X = __builtin_amdgcn_mfma_f32_32x32x16_bf16(ko[1], qi[1], X, 0, 0, 0); \
            f32x16 O = {}; \
            O = __builtin_amdgcn_mfma_f32_32x32x16_bf16(cat8(pql[0], pqh[0]), pack8(S, 0), O, 0, 0, 0); O = __builtin_amdgcn_mfma_f32_32x32x16_bf16(cat8(pql[1], pqh[1]), pack8(S, 8), O, 0, 0, 0); \
            _Pragma("unroll") for (int i = 0; i < 16; ++i) S[i] *= dsc[i >> 2][i & 3]; \
            S = __builtin_amdgcn_mfma_f32_32x32x16_bf16(cat8(kl[0], kh[0]), cat8(nvl[0], nvh[0]), S, 0, 0, 0); S = __builtin_amdgcn_mfma_f32_32x32x16_bf16(cat8(kl[1], kh[1]), cat8(nvl[1], nvh[1]), S, 0, 0, 0); \
            _Pragma("unroll") for (int i = 0; i < 16; ++i) X[i] = (crow(i, hi) <= r32) ? X[i] : 0.f; \
            O = __builtin_amdgcn_mfma_f32_32x32x16_bf16(pack8(X, 0), cat8(pvl[0], pvh[0]), O, 0, 0, 0); O = __builtin_amdgcn_mfma_f32_32x32x16_bf16(pack8(X, 8), cat8(pvl[1], pvh[1]), O, 0, 0, 0); \
            LAS float* op = (LAS float*)(lds + OFF_OPART + ((n) & 1) * OPART_BYTES + wave * 4096); \
            _Pragma("unroll") for (int i = 0; i < 16; ++i) op[crow(i, hi) * 32 + r32] = O[i]; } while (0)
#define HG_OUT_STAGE(n) do { \
            const int l2 = tid - 256, tt = l2 >> 3, vq = l2 & 7; \
            const LAS float* op = (const LAS float*)(lds + OFF_OPART + (((n) - 1) & 1) * OPART_BYTES) + tt * 32 + vq * 4; \
            const f32x4 s = (*(const LAS f32x4*)op + *(const LAS f32x4*)(op + 1024)) + (*(const LAS f32x4*)(op + 2048) + *(const LAS f32x4*)(op + 3072)); \
            const int p = HG_TOKP(dir, 32 * ((n) - 1) + tt); \
            if (p >= CTXL) *(v2u*)(Od + (zb + p) * 512 + head * 128 + sl * 32 + vq * 4) = (v2u){pk2(s[0], s[1]), pk2(s[2], s[3])}; } while (0)
#define HG_ITER(n, L0, L1, L2, L3, LV, S0, S1, S2, S3, SV) do { \
        HG_LOAD(L0, L1, L2, L3, LV, (n) + 3); \
        if (wave < 4) { HG_MFMA_STAGE(n, bcur); } else if ((n) > 0) { HG_OUT_STAGE(n); } \
        { const int bst_ = bcur == 0 ? 2 : bcur - 1; HG_STASH(S0, S1, S2, S3, SV, bst_); } \
        bcur = bcur == 2 ? 0 : bcur + 1; \
        __syncthreads(); } while (0)
    int bcur = 0;
    for (int n = 0; n < NCH; n += 2) {
        HG_ITER(n, gB0, gB1, gB2, gB3, gBv, gA0, gA1, gA2, gA3, gAv);
        HG_ITER(n + 1, gA0, gA1, gA2, gA3, gAv, gB0, gB1, gB2, gB3, gBv);
    }
    if (wave >= 4) { HG_OUT_STAGE(NCH); }
    __syncthreads();
#undef HG_MFMA_STAGE
#undef HG_OUT_STAGE
#undef HG_ITER
#undef HG_LOAD
#undef HG_STASH
#undef HG_RD64
}

__device__ __forceinline__ bool in_range(int lo, int hi, int k) { asm volatile("" : "+s"(lo), "+s"(hi)); return lo <= k && k < hi; }
constexpr int NPHASES = 21;
__global__ void __launch_bounds__(NTHR, 2) fwd_kernel(Args args) {
    extern __shared__ __attribute__((aligned(16))) unsigned char lds_raw[];
    LAS unsigned char* lds = (LAS unsigned char*)lds_raw;
    const int G = gridDim.x;
#define FRESH() int tid = threadIdx.x; asm volatile("" : "+v"(tid)); const int lane = tid & 63, wave = __builtin_amdgcn_readfirstlane(tid >> 6); (void)lane; (void)wave
    unsigned char* ws = args.ws;
    if (threadIdx.x < 16) ((LAS unsigned*)(lds + LDS_BAR_OFF))[threadIdx.x] = 0u;
    __syncthreads();
    XcdBarrier bar = xcd_barrier_post((unsigned*)(ws + WS_CTL), (volatile LAS unsigned*)(lds + LDS_BAR_OFF));
    const int lo = args.ph_lo, hi = args.ph_hi;
#define IN(k) in_range(lo, hi, (k))
#define NREP(k) (((PROBE_MASK >> (k)) & 1u) ? 2 : 1)
#define REPEAT(k) for (int rep_ = 0; rep_ < NREP(k); ++rep_) if (rep_ == 0 || (xcd_barrier(bar), true))
#define SEAM(k) do { if (IN(k) && IN((k) + 1)) xcd_barrier(bar); } while (0)
    bf16* const BX = (bf16*)(ws + WS_X); bf16* const BY = (bf16*)(ws + WS_Y);
    const float* const MODV = (const float*)(ws + WS_MODV);

#if defined(PROBE_BARS)
    for (int pbi = 0; pbi < PROBE_BARS; ++pbi) xcd_barrier(bar);
#endif
    if (IN(0)) REPEAT(0) { FRESH(); phase_prologue(args, lds, tid, lane, wave); } SEAM(0);
    if (IN(1)) REPEAT(1) { FRESH(); phase_mod0(args, lane, wave); } SEAM(1);
    if (IN(2)) REPEAT(2) {
        pg8::Gemm g{BX, (const bf16*)(ws + WS_WIN), NTOK, ZC, 1024}; pg8::AllOrder S; S.init(NTOK / 256, ZC / 256, G, (int)blockIdx.x);
        pg8::EpiBf16<0> E{(bf16*)(ws + WS_Z), ZC, nullptr, 0, 0, 1.f};
        pg8::gemm_phase<pg8::EpiBf16<0>, pg8::AllOrder, PG8_ALIGN, PG8_SP2>(lds, g, S, E);
    } SEAM(2);
    if (IN(3)) REPEAT(3) { FRESH(); phase_norm0(args, lane, wave); hgrn_prep_items(args, lds, tid); } SEAM(3);
    if (IN(4)) REPEAT(4) {
        { pg8::Gemm g{(const bf16*)(ws + WS_CQN), (const bf16*)(ws + WS_WUQ), NTOK, 768, 384}; pg8::LatOrder S; S.init(128, 3, G, (int)blockIdx.x);
          pg8::EpiBf16<0> E{(bf16*)(ws + WS_Q), 768, nullptr, 0, 0, 1.f};
          pg8::gemm_phase<pg8::EpiBf16<0>, pg8::LatOrder, PG8_ALIGN, PG8_SP2>(lds, g, S, E); }
        __syncthreads();
        { pg8::Gemm g{(const bf16*)(ws + WS_CKVN), (const bf16*)(ws + WS_WUKV), NTOK, 1024, 256}; pg8::AllOrder S; S.init(NTOK / 256, 4, G, (int)blockIdx.x);
          pg8::EpiBf16<0> E{(bf16*)(ws + WS_KV), 1024, nullptr, 0, 0, 1.f};
          pg8::gemm_phase<pg8::EpiBf16<0>, pg8::AllOrder, PG8_ALIGN, PG8_SP2>(lds, g, S, E); }
    } SEAM(4);
    if (IN(5)) {
        REPEAT(21) { FRESH();
        for (int u = blockIdx.x; u < 256; u += G) { __syncthreads(); hgrn_unit_mfma(args, (G == 256) ? ((u & 7) * 32 + (u >> 3)) : u, lds, tid); } }
        const bf16* Q = (const bf16*)(ws + WS_Q); const bf16* KV = (const bf16*)(ws + WS_KV); const bf16* KRR = (const bf16*)(ws + WS_KRR);
        const float* rope = (const float*)(ws + WS_ROPE);
        const int cslot = (G == 256) ? ((((int)blockIdx.x & 7) * 2 + (((int)blockIdx.x >> 3) >> 4)) % 5) : 0;
        REPEAT(22) {
        int ai = 0;
        for (int slot = 0; slot < 5; ++slot) {
            if (slot == cslot) { if (rep_ == 0) { FRESH(); __syncthreads(); convert_moe_share(args, lds, lane, wave); } continue; }
            for (int u = (G == 256) ? (int)blockIdx.x + ai * 256 : (int)blockIdx.x; u < ((G == 256) ? (int)blockIdx.x + ai * 256 + 1 : (ai == 0 ? 1024 : 0)); u += G) {
                int b, h, qb; if (G == 256) { const int x = (int)blockIdx.x & 7, j = (int)blockIdx.x >> 3, pr = (u >> 8) * 16 + 2 * x + (j >> 4); b = pr >> 3; h = pr & 7; qb = j & 15; } else { b = u >> 7; h = (u >> 4) & 7; qb = u & 15; }
                const size_t kb = (size_t)b * TPB, q0 = kb + CTXL + (size_t)qb * 256;
                __syncthreads();
                att::attn_unit(Q + q0 * 768 + h * 96, KV + kb * 1024 + h * 64, KRR + kb * 32, BY + q0 * 1024 + h * 64, rope + (size_t)qb * 256 * 32, TPB, (char*)lds_raw);
            }
            ++ai;
        }
        }
    } SEAM(5);
    if (IN(6)) REPEAT(6) { FRESH(); phase_readout(args, lane, wave); } SEAM(6);
    if (IN(7)) REPEAT(7) {
        pg8::Gemm g{BY, (const bf16*)(ws + WS_WOUT), NTOK, 1024, 1024}; pg8::LatOrder S; S.init(128, 4, G, (int)blockIdx.x);
        pg8::EpiRes E{args.in[I_X], (const float*)(ws + WS_H), (bf16*)(ws + WS_PRE), MODV, nullptr};
        pg8::gemm_phase<pg8::EpiRes, pg8::LatOrder, PG8_ALIGN, PG8_SP2>(lds, g, S, E);
    } SEAM(7);
    for (int l = 0; l < 2; ++l) {
        if (l == 1) {
            if (IN(13)) REPEAT(13) {
                pg8::Gemm g{BY, (const bf16*)(ws + WS_WPW1), NTOK, 2048, 1024}; pg8::LatOrder S; S.init(128, 8, G, (int)blockIdx.x);
                pg8::EpiGate<0> E{BX, (const float*)(ws + WS_PW1B), 8, 1.f, 1.f};
                pg8::gemm_phase<pg8::EpiGate<0>, pg8::LatOrder, PG8_ALIGN, PG8_SP2>(lds, g, S, E);
            } SEAM(13);
            if (IN(14)) REPEAT(14) { FRESH(); phase_conv(args, lds, tid, lane, wave); } SEAM(14);
            if (IN(15)) REPEAT(15) {
                pg8::Gemm g{BY, (const bf16*)(ws + WS_WPW2), NTOK, 1024, 1024}; pg8::LatOrder S; S.init(128, 4, G, (int)blockIdx.x);
                pg8::EpiRes E{nullptr, (const float*)(ws + WS_H), (bf16*)(ws + WS_PRE), MODV + 9 * 6144, args.in[I_PW2B]};
                pg8::gemm_phase<pg8::EpiRes, pg8::LatOrder, PG8_ALIGN, PG8_SP2>(lds, g, S, E);
            } SEAM(15);
        }
        const int pb = l ? 16 : 8;
        if (IN(pb)) REPEAT(pb) { FRESH(); phase_ln1(args, l, lds, tid, lane, wave); } SEAM(pb);
        if (IN(pb + 2) || IN(pb + 3)) {
            LAS int* tl = (LAS int*)(lds + LDS_TILE_E);
            FRESH();
            __syncthreads();
            if (tid < 32) tl[3 * MAXTILES + 64 + tid] = ld_ctl((const int*)(ws + WS_CURSOR) + l * 32 + tid);
            __syncthreads();
            if (tid == 0) { int ts = 0; for (int e = 0; e < 32; ++e) { tl[3 * MAXTILES + e] = ts; ts += (tl[3 * MAXTILES + 64 + e] + 255) >> 8; } tl[3 * MAXTILES + 32] = ts; }
            __syncthreads();
            const int ntiles = tl[3 * MAXTILES + 32];
            for (int t = tid; t < ntiles && t < MAXTILES; t += NTHR) { int e = 0; while (e < 31 && tl[3 * MAXTILES + e + 1] <= t) ++e; const int j = t - tl[3 * MAXTILES + e], rem = tl[3 * MAXTILES + 64 + e] - 256 * j;
                tl[t] = e; tl[MAXTILES + t] = e * ECAP + 256 * j; tl[2 * MAXTILES + t] = rem < 256 ? rem : 256; }
            __syncthreads();
            if (IN(pb + 2)) REPEAT(pb + 2) {
#if defined(PROBE_STAGGER)
                if (blockIdx.x & 1) { const unsigned long long t0 = __builtin_amdgcn_s_memrealtime(); while (__builtin_amdgcn_s_memrealtime() - t0 < PROBE_STAGGER) __builtin_amdgcn_s_sleep(8); }
#endif
                pg8::Gemm g{BX, (const bf16*)(ws + WS_WGU + (size_t)l * 32 * 2048 * 1024), 0, 0, 512};
                pg8::MoeOrder S; S.init(ntiles, 8, G, (int)blockIdx.x); S.tile_e = tl; S.nper = 8;
                pg8::EpiGate<1, true> E{(bf16*)(ws + WS_ACT), (const float*)(ws + WS_BGU) + (size_t)l * 32 * 2048, 8, 1.f / (SC_X8 * SC_WGU) * PROBE_KSC, SC_ACT};
                pg8::gemm_phase<pg8::EpiGate<1, true>, pg8::MoeOrder, PG8_ALIGN, true, true, true>(lds, g, S, E, (const int*)(ws + WS_ROWS), tl + MAXTILES);
            } SEAM(pb + 2);
            if (IN(pb + 3)) REPEAT(pb + 3) {
                pg8::Gemm g{(const bf16*)(ws + WS_ACT), (const bf16*)(ws + WS_WDN + (size_t)l * 32 * 1024 * 1024), 0, 0, 512};
                pg8::MoeOrder S; S.init(ntiles, 4, G, (int)blockIdx.x); S.tile_e = tl; S.nper = 4;
                pg8::EpiDown E{(bf16*)(ws + WS_YB), args.in[I_BDN] + (size_t)l * 32 * 1024, (const float*)(ws + WS_ROWW), (const int*)(ws + WS_ROWD), 1.f / (SC_ACT * SC_WDN) * PROBE_KSC, tl + MAXTILES, SC_Y};
                pg8::gemm_phase<pg8::EpiDown, pg8::MoeOrder, PG8_ALIGN, true, false, true>(lds, g, S, E);
            } SEAM(pb + 3);
        }
        if (IN(pb + 4)) REPEAT(pb + 4) { FRESH(); phase_ln2(args, l, lane, wave); }
        if (l == 0) SEAM(12);
    }
#undef IN
#undef SEAM
}

extern "C" void kernel_launch(void* const* d_in, const int* in_sizes, int n_in, void* d_out, int out_size, void* d_ws, size_t ws_size, hipStream_t stream) {
    static int grid = 0;
    if (grid == 0) {
        if (n_in != 33 || in_sizes[0] != NB * SEQ * D || out_size != NB * SEQ * D || ws_size < WS_END) {
            fprintf(stderr, "kernel_launch: unexpected shapes: n_in %d in0 %d out %d ws %zu (need %zu)\n", n_in, n_in > 0 ? in_sizes[0] : -1, out_size, ws_size, (size_t)WS_END); grid = -1; return; }
        int dev = 0, cus = 0;
        if (hipGetDevice(&dev) != hipSuccess || hipDeviceGetAttribute(&cus, hipDeviceAttributeMultiprocessorCount, dev) != hipSuccess) { grid = -1; return; }
        if (hipFuncSetAttribute((const void*)fwd_kernel, hipFuncAttributeMaxDynamicSharedMemorySize, LDS_BYTES) != hipSuccess) { fprintf(stderr, "kernel_launch: hipFuncSetAttribute failed\n"); grid = -1; return; }
        int per_cu = 0;
        if (hipOccupancyMaxActiveBlocksPerMultiprocessor(&per_cu, (const void*)fwd_kernel, NTHR, LDS_BYTES) != hipSuccess || per_cu < 1) fprintf(stderr, "kernel_launch: occupancy query reports %d\n", per_cu);
        (void)hipGetLastError();
        grid = cus;
    }
    if (grid < 0) return;
    if (hipMemsetAsync((char*)d_ws + WS_CTL, 0, CTL_ZERO_BYTES, stream) != hipSuccess) return;
    Args a{};
    for (int i = 0; i < 33; ++i) a.in[i] = (const float*)d_in[i];
    a.out = (float*)d_out; a.ws = (unsigned char*)d_ws;
#if MK_ONE_LAUNCH
    a.ph_lo = 0; a.ph_hi = NPHASES;
    hipLaunchKernelGGL(fwd_kernel, dim3(grid), dim3(NTHR), LDS_BYTES, stream, a);
#else
    for (int ph = 0; ph < NPHASES; ++ph) { a.ph_lo = ph; a.ph_hi = ph + 1; hipLaunchKernelGGL(fwd_kernel, dim3(grid), dim3(NTHR), LDS_BYTES, stream, a); }
#endif
    const hipError_t le = hipPeekAtLastError();
    if (le != hipSuccess) fprintf(stderr, "kernel_launch: launch failed: %s\n", hipGetErrorName(le));
}
```

```cpp
#include <hip/hip_runtime.h>
#include <cstdio>
#include <cstdint>

#ifndef PROBE_MASK
#define PROBE_MASK 0u
#endif
#if defined(PROBE_K2)
#define PROBE_KSC 0.5f
#else
#define PROBE_KSC 1.0f
#endif
#ifndef MK_ONE_LAUNCH
#define MK_ONE_LAUNCH 1
#endif

namespace pg8 {
#define PG8_LAS __attribute__((address_space(3)))
typedef unsigned short bf16_t;
typedef short bf16x8 __attribute__((ext_vector_type(8)));
typedef float f32x4 __attribute__((ext_vector_type(4)));
typedef unsigned u32x4 __attribute__((ext_vector_type(4)));
constexpr int BM = 256, BK = 64, HALF = 128, HTB = HALF * BK * 2  , STAGE_BYTES = 8 * HTB, NXCD = 8, WGM = 8;

__host__ __device__ __forceinline__ int lds_byte(int r, int c) { const int st = (r >> 4) * 2 + (c >> 5), rr = r & 15, cc = c & 31, ob = rr * 64 + cc * 2; return st * 1024 + (ob ^ (((ob >> 9) & 1) << 5)); }
__host__ __device__ __forceinline__ void stage_rc(int b, int& R, int& C) { const int st = b / 1024, sb = b % 1024, swz = sb ^ (((sb >> 9) & 1) << 5); R = (st >> 1) * 16 + swz / 64; C = (st & 1) * 32 + (swz % 64) / 2; }
__host__ __device__ __forceinline__ int perm32(int rho) { const int n = rho >> 4, i = rho & 15; return 8 * (i >> 2) + 4 * n + (i & 3); }

struct Unit { int pm, pn; };
struct Gemm { const bf16_t* A; const bf16_t* Bt; int M, N, K; };

struct StaticOrder {
    int nM, nN, nwg, G, c;
    __host__ __device__ void init(int M, int N, int G_, int c_) { nM = M / BM; nN = N / BM; nwg = nM * nN; G = G_; c = c_; }
    __host__ __device__ bool next(int i, Unit& u) const {
        const long L = (long)i * G + c; if (L >= nwg) return false;
        int wgid = (int)L; { const int q = nwg / NXCD, r = nwg % NXCD, xcd = wgid % NXCD, off = wgid / NXCD; wgid = (xcd < r ? xcd * (q + 1) : r * (q + 1) + (xcd - r) * q) + off; }
        const int nig = WGM * nN, gid = wgid / nig, fm = gid * WGM, gsz = (nM - fm) < WGM ? (nM - fm) : WGM;
        u.pm = fm + ((wgid % nig) % gsz); u.pn = (wgid % nig) / gsz; return true;
    }
    __device__ __forceinline__ void a_ready(const Unit&) const {}
    __device__ __forceinline__ void done(const Unit&) const {}
};

__device__ __forceinline__ unsigned cvt_pk_bf16(float lo, float hi) { unsigned r; asm volatile("v_cvt_pk_bf16_f32 %0, %1, %2" : "=v"(r) : "v"(lo), "v"(hi)); return r; }
typedef float f32x2 __attribute__((ext_vector_type(2)));
__device__ __forceinline__ f32x2 gelu_pk(f32x2 v) {
    const f32x2 av = __builtin_elementwise_abs(v), d = av * 0.2316418882f + 1.0f;
    f32x2 t; t.x = __builtin_amdgcn_rcpf(d.x); t.y = __builtin_amdgcn_rcpf(d.y);
    f32x2 q = t * 0.5307027145f + (-0.7265760135f); q = q * t + 0.7107068705f; q = q * t + (-0.142248368f); q = q * t + 0.127414796f; q = q * t;
    const f32x2 s = (v * v) * (-0.72134752044f);
    f32x2 e; e.x = __builtin_amdgcn_exp2f(s.x); e.y = __builtin_amdgcn_exp2f(s.y);
    const f32x2 m = v * (q * e), r = v - m;
    f32x2 o; o.x = v.x < 0.f ? m.x : r.x; o.y = v.y < 0.f ? m.y : r.y; return o;
}

template <int ACT  > struct EpiBf16 {
    static constexpr bool PERM = true, AFTER_DRAIN = false; static_assert(ACT == 0 || ACT == 1, "EpiBf16: ACT is 0 (none) or 1 (gelu_pk)");
    bf16_t* O; int ldc; const float* bias; int split_cols; size_t split_stride; float scale0;
    __device__ __forceinline__ void operator()(const f32x4 (&acc)[2][2][4][2], const Unit& u, int wr, int wc, int fr, int fq) const {
        const int row0 = u.pm * BM + wr * 64 + fr; int colt = u.pn * BM; bf16_t* base = O;
        float sc = 1.f; if (split_cols) { const int t = colt / split_cols; base += (size_t)t * split_stride; colt -= t * split_cols; if (t == 0) sc = scale0; }
        const int col0 = colt + wc * 32 + 8 * fq, bcol0 = u.pn * BM + wc * 32 + 8 * fq;
        f32x4 bv[2][2];
#pragma unroll
        for (int bj = 0; bj < 2; ++bj)
#pragma unroll
            for (int n = 0; n < 2; ++n) bv[bj][n] = bias ? *(const f32x4*)(bias + bcol0 + bj * HALF + 4 * n) : (f32x4){0.f, 0.f, 0.f, 0.f};
#pragma unroll
        for (int ai = 0; ai < 2; ++ai)
#pragma unroll
            for (int m = 0; m < 4; ++m) { bf16_t* rowp = base + (size_t)(row0 + ai * HALF + m * 16) * ldc + col0;
#pragma unroll
                for (int bj = 0; bj < 2; ++bj) { f32x4 v0 = acc[ai][bj][m][0] + bv[bj][0], v1 = acc[ai][bj][m][1] + bv[bj][1];
                    if (ACT == 1) { f32x2 a = gelu_pk((f32x2){v0[0], v0[1]}), b = gelu_pk((f32x2){v0[2], v0[3]}), c = gelu_pk((f32x2){v1[0], v1[1]}), d = gelu_pk((f32x2){v1[2], v1[3]});
                        v0 = (f32x4){a.x, a.y, b.x, b.y}; v1 = (f32x4){c.x, c.y, d.x, d.y}; }
                    v0 = v0 * sc; v1 = v1 * sc; u32x4 w; w.x = cvt_pk_bf16(v0[0], v0[1]); w.y = cvt_pk_bf16(v0[2], v0[3]); w.z = cvt_pk_bf16(v1[0], v1[1]); w.w = cvt_pk_bf16(v1[2], v1[3]);
                    *(u32x4*)(rowp + bj * HALF) = w; } }
    }
};
typedef int v4i_t __attribute__((ext_vector_type(4)));
typedef int v8i_t __attribute__((ext_vector_type(8)));
__device__ __forceinline__ v8i_t cat32(bf16x8 a, bf16x8 b) { const v4i_t x = __builtin_bit_cast(v4i_t, a), y = __builtin_bit_cast(v4i_t, b); return __builtin_shufflevector(x, y, 0, 1, 2, 3, 4, 5, 6, 7); }
template <class Epi, class Sched, bool ALIGN_EPI = false, bool SP2 = false, bool GATHER = false, bool FP8 = false>
__device__ __forceinline__ void gemm_phase(PG8_LAS unsigned char* lds, const Gemm g, const Sched& S, const Epi& E, const int* rowsrc = nullptr, const PG8_LAS int* gtab = nullptr) {
    static_assert(!GATHER || SP2, "GATHER is implemented on the SP2 loop only");
    int tid_l = threadIdx.x; asm volatile("" : "+v"(tid_l));
    const int tid = tid_l, wid = __builtin_amdgcn_readfirstlane(tid >> 6), lane = tid & 63, wr = wid >> 2, wc = wid & 3, fr = lane & 15, fq = lane >> 4;
#if defined(PROBE_K2)
    const int K = g.K, nt0 = K / BK, nt = FP8 ? 2 * nt0 : nt0;
#define PG8_KT(x) (FP8 ? ((x) & (nt0 - 1)) : (x))
#else
    const int K = g.K, nt = K / BK;
#define PG8_KT(x) (x)
#endif
    unsigned voffA[2], voffB[2];
#pragma unroll
    for (int i = 0; i < 2; ++i) { int R, C; stage_rc(tid * 16 + i * 8192, R, C); const int Rb = Epi::PERM ? ((R & ~31) + perm32(R & 31)) : R;
        voffA[i] = (unsigned)(R * K + C) * 2u; voffB[i] = (unsigned)(Rb * K + C) * 2u; }
    unsigned gAc[2][2], gAn[2][2]; int gR[2]; unsigned gC[2];
#pragma unroll
    for (int i = 0; i < 2; ++i) { int R, C; stage_rc(tid * 16 + i * 8192, R, C); gR[i] = R; gC[i] = (unsigned)C * 2u; gAc[0][i] = gAc[1][i] = gAn[0][i] = gAn[1][i] = 0u; }
#define PG8_GATHER(u_, o_) do { const int gtb_ = gtab[(u_).pm], gtc_ = gtab[576 + (u_).pm];     \
        _Pragma("unroll") for (int h_ = 0; h_ < 2; ++h_) _Pragma("unroll") for (int i_ = 0; i_ < 2; ++i_) \
        { const int rl_ = h_ * HALF + gR[i_]; const int src_ = rl_ < gtc_ ? rowsrc[gtb_ + rl_] : 0; o_[h_][i_] = (unsigned)src_ * (unsigned)(K * 2) + gC[i_]; } } while (0)
#define PG8_STAGE_A(bufoff, orig_gbase, NEXTSEL, H, KOFF) do { if constexpr (GATHER) { unsigned vo_[2]; vo_[0] = (NEXTSEL) ? gAn[H][0] : gAc[H][0]; vo_[1] = (NEXTSEL) ? gAn[H][1] : gAc[H][1]; \
        PG8_STAGE(bufoff, (const char*)g.A + (KOFF), vo_); } else { PG8_STAGE(bufoff, orig_gbase, voffA); } } while (0)
    const size_t kstep = (size_t)(BK * 2);
    const size_t hstep = (size_t)HALF * K * 2;
    const size_t tstep = 2 * hstep;
    const unsigned ldsw = (unsigned)wid * 1024u;
    const int aoff = lds_byte(wr * 64 + fr, fq * (FP8 ? 16 : 8)), boff = lds_byte(wc * 32 + fr, fq * (FP8 ? 16 : 8));
#define PG8_SA(b, h) (((b) * 2 + (h)) * HTB)
#define PG8_SB(b, h) ((4 + (b) * 2 + (h)) * HTB)
#define PG8_STAGE(bufoff, gbase, voff) do { _Pragma("unroll") for (int _i = 0; _i < 2; ++_i) \
        __builtin_amdgcn_global_load_lds((const unsigned*)((const char*)(gbase) + (voff)[_i]), (PG8_LAS unsigned*)(lds + (bufoff) + ldsw + _i * 8192), 16, 0, 0); } while (0)
#define PG8_LD32(var, addr) do { const bf16x8 lo_ = *(const PG8_LAS bf16x8*)(addr); const bf16x8 hi_ = *(const PG8_LAS bf16x8*)((addr) + 16); var = cat32(lo_, hi_); } while (0)
#define PG8_LDA(dst, b, h) do { if constexpr (FP8) { _Pragma("unroll") for (int m = 0; m < 4; ++m) PG8_LD32(dst##8[m], lds + PG8_SA(b, h) + aoff + m * 2048); } \
        else { _Pragma("unroll") for (int m = 0; m < 4; ++m) _Pragma("unroll") for (int k = 0; k < 2; ++k) dst[m][k] = *(const PG8_LAS bf16x8*)(lds + PG8_SA(b, h) + aoff + m * 2048 + k * 1024); } } while (0)
#define PG8_LDB(dst, b, h) do { if constexpr (FP8) { _Pragma("unroll") for (int n = 0; n < 2; ++n) PG8_LD32(dst##8[n], lds + PG8_SB(b, h) + boff + n * 2048); } \
        else { _Pragma("unroll") for (int n = 0; n < 2; ++n) _Pragma("unroll") for (int k = 0; k < 2; ++k) dst[n][k] = *(const PG8_LAS bf16x8*)(lds + PG8_SB(b, h) + boff + n * 2048 + k * 1024); } } while (0)
#define PG8_MMA(ai, bj, At, Bt) do { __builtin_amdgcn_s_setprio(1); \
        if constexpr (FP8) { _Pragma("unroll") for (int m = 0; m < 4; ++m) _Pragma("unroll") for (int n = 0; n < 2; ++n) \
            asm volatile("v_mfma_scale_f32_16x16x128_f8f6f4 %0, %1, %2, %0, %3, %3 op_sel_hi:[0,0,0]" : "+v"(acc[ai][bj][m][n]) : "v"(Bt##8[n]), "v"(At##8[m]), "v"(sc127)); } \
        else { _Pragma("unroll") for (int m = 0; m < 4; ++m) _Pragma("unroll") for (int n = 0; n < 2; ++n) _Pragma("unroll") for (int k = 0; k < 2; ++k) \
            acc[ai][bj][m][n] = __builtin_amdgcn_mfma_f32_16x16x32_bf16(Bt[n][k], At[m][k], acc[ai][bj][m][n], 0, 0, 0); } \
        __builtin_amdgcn_s_setprio(0); } while (0)
#define PG8_WAIT_V(n) asm volatile("s_waitcnt vmcnt(" #n ")" ::: "memory")
#define PG8_WAIT_L(n) asm volatile("s_waitcnt lgkmcnt(" #n ")" ::: "memory")
#define PG8_BAR __builtin_amdgcn_s_barrier()
#define PG8_SCHED __builtin_amdgcn_sched_barrier(0)
    Unit cur, nxt; int ui = 0;
    if (!S.next(0, cur)) return;
    f32x4 acc[2][2][4][2];
#pragma unroll
    for (int a = 0; a < 2; ++a)
#pragma unroll
        for (int b = 0; b < 2; ++b)
#pragma unroll
            for (int m = 0; m < 4; ++m)
#pragma unroll
                for (int n = 0; n < 2; ++n) acc[a][b][m][n] = (f32x4){0.f, 0.f, 0.f, 0.f};
    int sc127 = 0x7f7f7f7f; asm volatile("" : "+v"(sc127));
    bf16x8 At[4][2], B0[2][2], B1[2][2]; v8i_t At8[4], B08[2], B18[2]; (void)At; (void)B0; (void)B1; (void)At8; (void)B08; (void)B18;
    const char* cA = (const char*)g.A + (size_t)cur.pm * tstep; const char* cB = (const char*)g.Bt + (size_t)cur.pn * tstep;
    S.a_ready(cur);
    if constexpr (GATHER) { PG8_GATHER(cur, gAc); }
    if constexpr (SP2) {
        PG8_STAGE(PG8_SB(0, 0), cB, voffB); PG8_STAGE(PG8_SB(0, 1), cB + hstep, voffB); PG8_STAGE_A(PG8_SA(0, 0), cA, false, 0, (size_t)0); PG8_STAGE_A(PG8_SA(0, 1), cA + hstep, false, 1, (size_t)0);
        if (wr == 1) PG8_BAR;
        PG8_WAIT_V(2); PG8_BAR;
        PG8_STAGE(PG8_SB(1, 0), cB + kstep, voffB); PG8_STAGE_A(PG8_SA(1, 0), cA + kstep, false, 0, kstep); PG8_STAGE(PG8_SB(1, 1), cB + hstep + kstep, voffB);
        PG8_WAIT_V(6); PG8_BAR;
    } else {
        PG8_STAGE(PG8_SB(0, 0), cB, voffB); PG8_STAGE(PG8_SA(0, 0), cA, voffA); PG8_STAGE(PG8_SB(0, 1), cB + hstep, voffB); PG8_STAGE(PG8_SA(0, 1), cA + hstep, voffA);
        if (wr == 1) PG8_BAR;
        PG8_WAIT_V(4); PG8_BAR;
        PG8_STAGE(PG8_SB(1, 0), cB + kstep, voffB); PG8_STAGE(PG8_SA(1, 0), cA + kstep, voffA); PG8_STAGE(PG8_SB(1, 1), cB + hstep + kstep, voffB);
        PG8_WAIT_V(6); PG8_BAR;
    }
    for (;;) {
        const bool has_next = S.next(ui + 1, nxt);
        if constexpr (GATHER) { if (has_next) { PG8_GATHER(nxt, gAn); } else { _Pragma("unroll") for (int h_ = 0; h_ < 2; ++h_) _Pragma("unroll") for (int i_ = 0; i_ < 2; ++i_) gAn[h_][i_] = gAc[h_][i_]; } }
        const char* nA = has_next ? (const char*)g.A + (size_t)nxt.pm * tstep : cA; const char* nB = has_next ? (const char*)g.Bt + (size_t)nxt.pn * tstep : cB;
#pragma nounroll
        for (int t = 0; t < nt; t += 2) {
            const bool last = (t == nt - 2);
            const char* a1 = cA + (size_t)PG8_KT(t + 1) * kstep;
            const char* a2 = last ? nA : cA + (size_t)PG8_KT(t + 2) * kstep; const char* b2 = last ? nB : cB + (size_t)PG8_KT(t + 2) * kstep;
            const char* a3 = a2 + kstep; const char* b3 = b2 + kstep;
            const size_t k1 = (size_t)PG8_KT(t + 1) * kstep, k2 = last ? (size_t)0 : (size_t)PG8_KT(t + 2) * kstep, k3 = k2 + kstep; (void)k1; (void)k2; (void)k3;
            if (last && has_next) S.a_ready(nxt);
            if constexpr (SP2) {
            PG8_LDB(B0, 0, 0); PG8_LDB(B1, 0, 1); PG8_SCHED; PG8_LDA(At, 0, 0); PG8_STAGE_A(PG8_SA(1, 1), a1 + hstep, false, 1, k1);
            PG8_WAIT_V(8); PG8_WAIT_L(0); PG8_BAR; PG8_MMA(0, 0, At, B0); PG8_MMA(0, 1, At, B1); PG8_BAR; PG8_SCHED;
            PG8_LDA(At, 0, 1); PG8_STAGE(PG8_SB(0, 0), b2, voffB); PG8_STAGE(PG8_SB(0, 1), b2 + hstep, voffB); PG8_STAGE_A(PG8_SA(0, 0), a2, last, 0, k2);
            PG8_WAIT_V(8); PG8_WAIT_L(0); PG8_BAR; PG8_MMA(1, 0, At, B0); PG8_MMA(1, 1, At, B1); PG8_BAR; PG8_SCHED;
            PG8_LDB(B0, 1, 0); PG8_LDB(B1, 1, 1); PG8_SCHED; PG8_LDA(At, 1, 0); PG8_STAGE_A(PG8_SA(0, 1), a2 + hstep, last, 1, k2);
            PG8_WAIT_V(8); PG8_WAIT_L(0); PG8_BAR; PG8_MMA(0, 0, At, B0); PG8_MMA(0, 1, At, B1); PG8_BAR; PG8_SCHED;
            PG8_LDA(At, 1, 1); PG8_STAGE(PG8_SB(1, 0), b3, voffB); PG8_STAGE(PG8_SB(1, 1), b3 + hstep, voffB); PG8_STAGE_A(PG8_SA(1, 0), a3, last, 0, k3);
            PG8_WAIT_V(8); PG8_WAIT_L(0); PG8_BAR; PG8_MMA(1, 0, At, B0); PG8_MMA(1, 1, At, B1); PG8_BAR; PG8_SCHED;
            } else {
            PG8_LDB(B0, 0, 0); PG8_SCHED; PG8_LDA(At, 0, 0); PG8_STAGE(PG8_SA(1, 1), a1 + hstep, voffA);
            PG8_WAIT_L(8); PG8_BAR; PG8_WAIT_L(0); PG8_MMA(0, 0, At, B0); PG8_BAR; PG8_SCHED;
            PG8_LDB(B1, 0, 1); PG8_STAGE(PG8_SB(0, 0), b2, voffB);
            PG8_BAR; PG8_WAIT_L(0); PG8_MMA(0, 1, At, B1); PG8_BAR;
            PG8_LDA(At, 0, 1); PG8_STAGE(PG8_SA(0, 0), a2, voffA);
            PG8_BAR; PG8_WAIT_L(0); PG8_MMA(1, 0, At, B0); PG8_BAR; PG8_SCHED;
            PG8_STAGE(PG8_SB(0, 1), b2 + hstep, voffB);
            PG8_WAIT_V(6); PG8_BAR; PG8_MMA(1, 1, At, B1); PG8_BAR;
            PG8_LDB(B0, 1, 0); PG8_SCHED; PG8_LDA(At, 1, 0); PG8_STAGE(PG8_SA(0, 1), a2 + hstep, voffA);
            PG8_WAIT_L(8); PG8_BAR; PG8_WAIT_L(0); PG8_MMA(0, 0, At, B0); PG8_BAR; PG8_SCHED;
            PG8_LDB(B1, 1, 1); PG8_STAGE(PG8_SB(1, 0), b3, voffB);
            PG8_BAR; PG8_WAIT_L(0); PG8_MMA(0, 1, At, B1); PG8_BAR;
            PG8_LDA(At, 1, 1); PG8_STAGE(PG8_SA(1, 0), a3, voffA);
            PG8_BAR; PG8_WAIT_L(0); PG8_MMA(1, 0, At, B0); PG8_BAR; PG8_SCHED;
            PG8_STAGE(PG8_SB(1, 1), b3 + hstep, voffB);
            PG8_WAIT_V(6); PG8_BAR; PG8_MMA(1, 1, At, B1); PG8_BAR;
            }
        }
        if constexpr (ALIGN_EPI) { if (wr == 0) PG8_BAR; }
        if constexpr (FP8) { asm volatile("s_nop 15\n\ts_nop 15" ::: "memory"); }
        if constexpr (!Epi::AFTER_DRAIN) { E(acc, cur, wr, wc, fr, fq);
#if defined(PROBE_EPI2)
            if constexpr (FP8 == (PROBE_EPI2 == 1)) { E(acc, cur, wr, wc, fr, fq); }
#endif
            S.done(cur); }
        if (!has_next) break;
#pragma unroll
        for (int a = 0; a < 2; ++a)
#pragma unroll
            for (int b = 0; b < 2; ++b)
#pragma unroll
                for (int m = 0; m < 4; ++m)
#pragma unroll
                    for (int n = 0; n < 2; ++n) acc[a][b][m][n] = (f32x4){0.f, 0.f, 0.f, 0.f};
        cur = nxt; cA = nA; cB = nB; ++ui;
        if constexpr (GATHER) { _Pragma("unroll") for (int h_ = 0; h_ < 2; ++h_) _Pragma("unroll") for (int i_ = 0; i_ < 2; ++i_) gAc[h_][i_] = gAn[h_][i_]; }
        if constexpr (ALIGN_EPI) { if (wr == 1) PG8_BAR; }
    }
    PG8_WAIT_V(0);
    if constexpr (!ALIGN_EPI) { if (wr == 0) PG8_BAR; }
    PG8_BAR;
    if constexpr (Epi::AFTER_DRAIN) { E.fused(acc, cur, wr, wc, fr, fq, lds, wid, lane); S.done(cur); }
#undef PG8_SA
#undef PG8_SB
#undef PG8_STAGE
#undef PG8_STAGE_A
#undef PG8_GATHER
#undef PG8_LDA
#undef PG8_LD32
#undef PG8_LDB
#undef PG8_MMA
#undef PG8_WAIT_V
#undef PG8_WAIT_L
#undef PG8_BAR
#undef PG8_SCHED
}
}

#ifndef PG8_SP2
#define PG8_SP2 true
#endif
#ifndef PG8_ALIGN
#define PG8_ALIGN true
#endif

#define GAS __attribute__((address_space(1)))
#define LAS __attribute__((address_space(3)))
typedef unsigned short bf16;
typedef unsigned v4u __attribute__((ext_vector_type(4)));
typedef unsigned v2u __attribute__((ext_vector_type(2)));
typedef float f32x4 __attribute__((ext_vector_type(4)));
typedef short bf16x8 __attribute__((ext_vector_type(8)));

constexpr int D = 1024, NB = 8, SEQ = 4096, CTXL = 256, TPB = SEQ + CTXL, NTOK = NB * TPB, NLAT = NB * SEQ;
constexpr int ZC = 3328;
constexpr int ZQ = 0, ZKV = 384, ZKR = 640, ZHQ = 672, ZHF = 1184, ZHB = 1696, ZHI = 2208, ZHG = 2720;
constexpr int NEXP = 32;
constexpr float ALPHA = 1.4142135623730951f;
constexpr float LN_EPS = 1e-5f, RMS_EPS = 1e-6f;
constexpr int NWAVES = 8, NTHR = 512;
constexpr float SC_X8 = 16.f, SC_WGU = 64.f, SC_ACT = 8.f, SC_WDN = 128.f, SC_Y = 64.f;
constexpr int LDS_BYTES = 147456;
constexpr int LDS_BAR_OFF = LDS_BYTES - 64;
constexpr int LDS_TILE_E = 131072;
constexpr int MAXTILES = 576;

constexpr size_t MiB = 1u << 20;
constexpr size_t WS_CTL = 0, CTL_ZERO_BYTES = 16384;
constexpr size_t WS_MODV = 1 * MiB;
constexpr size_t WS_ROPE = 1 * MiB + 512 * 1024;
constexpr size_t WS_BGU = 2 * MiB;
constexpr size_t WS_PW1B = 2 * MiB + 512 * 1024;
constexpr size_t WS_BCNT = WS_PW1B + 64 * 1024;
constexpr size_t WS_TILEE = WS_BCNT + 64 * 1024;
constexpr size_t WS_META = WS_TILEE + 4096;
constexpr size_t WS_TOPI = 3 * MiB, WS_TOPW = 4 * MiB;
constexpr int ECAP = 32768;
constexpr size_t WS_ROWS = 160 * MiB, WS_ROWW = 164 * MiB, WS_ROWD = 168 * MiB;
constexpr size_t WS_CURSOR = 14336;
constexpr size_t WS_WIN = 8 * MiB, WS_WUQ = 15 * MiB, WS_WUKV = 16 * MiB, WS_WOUT = 17 * MiB, WS_WPW1 = 19 * MiB, WS_WPW2 = 23 * MiB;
constexpr size_t WS_WGU = 32 * MiB, WS_WDN = 288 * MiB;
constexpr size_t WS_H = 416 * MiB;
constexpr size_t WS_X = 552 * MiB, WS_Y = 620 * MiB;
constexpr size_t WS_BIG = 688 * MiB;
constexpr size_t WS_Z = WS_BIG, WS_CQN = WS_BIG + 221 * MiB, WS_CKVN = WS_BIG + 247 * MiB, WS_KRR = WS_BIG + 264 * MiB,
                 WS_Q = WS_BIG + 267 * MiB, WS_KV = WS_BIG + 318 * MiB, WS_OF = WS_BIG + 386 * MiB, WS_OB = WS_BIG + 454 * MiB;
constexpr size_t WS_HT = WS_BIG + 528 * MiB;
constexpr size_t WS_PRE = WS_BIG;
constexpr size_t WS_XS = WS_BIG, WS_ACT = WS_BIG + 288 * MiB, WS_YB = WS_BIG + 576 * MiB;
constexpr size_t WS_END = WS_BIG + 848 * MiB;
static_assert((size_t)NTOK * ZC * 2 <= 221 * MiB && (size_t)NTOK * 384 * 2 <= 26 * MiB && (size_t)NTOK * 256 * 2 <= 17 * MiB && (size_t)NTOK * 32 * 2 <= 3 * MiB, "ws map 1");
static_assert((size_t)NTOK * 768 * 2 <= 51 * MiB && (size_t)NTOK * 1024 * 2 <= 68 * MiB && (size_t)NTOK * 512 * 4 <= 68 * MiB, "ws map 2");
static_assert((size_t)64 * 136 * 26624 <= 320 * MiB && (size_t)MAXTILES * 256 * 2048 <= 288 * MiB && (size_t)NLAT * 4 * 2048 <= 272 * MiB && (size_t)NTOK * 1024 * 4 <= 136 * MiB, "ws map 3");

#define LDS_WAIT() asm volatile("s_waitcnt lgkmcnt(0)" ::: "memory")
#define VM_WAIT() asm volatile("s_waitcnt vmcnt(0)" ::: "memory")
__device__ __forceinline__ float bf2f(unsigned short b) { return __uint_as_float(((unsigned)b) << 16); }
__device__ __forceinline__ unsigned pk2(float lo, float hi) { return pg8::cvt_pk_bf16(lo, hi); }
__device__ __forceinline__ float sigm(float x) { return __builtin_amdgcn_rcpf(1.f + __expf(-x)); }
__device__ __forceinline__ float wave_sum(float v) {
#pragma unroll
    for (int o = 1; o < 64; o <<= 1) v += __shfl_xor(v, o);
    return v;
}
__device__ __forceinline__ int ld_ctl(const int* p) { return (int)__hip_atomic_load((const unsigned*)p, __ATOMIC_RELAXED, __HIP_MEMORY_SCOPE_AGENT); }
__device__ __forceinline__ int grow_of(int lr) { return (lr >> 12) * TPB + CTXL + (lr & 4095); }

#define XB_TMO      128
#define XB_XCNT(j)  (256  + 64 * (j))
#define XB_XSUB(j)  (1280 + 64 * (j))
#define XB_XGEN(j)  (2304 + 64 * (j))
#define XB_TOP      3328
#define XB_TOPGEN   3392
#define XCD_BAR_WORDS 3456
#define XB_SPIN_CAP (1u << 21)

__device__ __forceinline__ unsigned xb_ld(unsigned* p)              { return __hip_atomic_load(p, __ATOMIC_RELAXED, __HIP_MEMORY_SCOPE_AGENT); }
__device__ __forceinline__ unsigned xb_add(unsigned* p, unsigned v) { return __hip_atomic_fetch_add(p, v, __ATOMIC_RELAXED, __HIP_MEMORY_SCOPE_AGENT); }
__device__ __forceinline__ unsigned xb_xcc_id() { return (unsigned)__builtin_amdgcn_s_getreg((3 << 11) | 20) & 0xFu; }
#define XB_SPIN(cond, bar) do { unsigned _sp = 0; while (cond) { __builtin_amdgcn_s_sleep(1); \
    if ((++_sp & 255u) == 0u) { if (xb_ld(&(bar)[XB_TMO])) break; if (_sp > XB_SPIN_CAP) { atomicAdd(&(bar)[XB_TMO], 1u); break; } } } } while (0)

struct XcdBarrier { unsigned* bar; unsigned x; volatile LAS unsigned* st; };

__device__ __forceinline__ XcdBarrier xcd_barrier_post(unsigned* bar, volatile LAS unsigned* st) {
    XcdBarrier b; b.bar = bar; b.x = xb_xcc_id(); b.st = st;
    if (threadIdx.x == 0) (void)xb_add(&bar[XB_XCNT(b.x)], 1u);
    return b;
}
__device__ __forceinline__ void xcd_barrier_complete(unsigned* bar, unsigned x, unsigned& nloc, unsigned& nx) {
    const unsigned G = gridDim.x * gridDim.y * gridDim.z;
    unsigned sum, cnt, mine, sp = 0u;
    for (;;) {
        sum = 0u; cnt = 0u; mine = 0u;
#pragma unroll
        for (unsigned j = 0; j < 16; ++j) { const unsigned c = xb_ld(&bar[XB_XCNT(j)]); sum += c; cnt += (c > 0u) ? 1u : 0u; mine = (j == x) ? c : mine; }
        if (sum == G) break;
        __builtin_amdgcn_s_sleep(1);
        if ((++sp & 255u) == 0u) { if (xb_ld(&bar[XB_TMO])) break; if (sp > XB_SPIN_CAP) { atomicAdd(&bar[XB_TMO], 1u); break; } }
    }
    nloc = mine > 0u ? mine : 1u; nx = cnt > 0u ? cnt : 1u;
}
__device__ __forceinline__ void xcd_barrier(const XcdBarrier& b) {
    asm volatile("s_waitcnt vmcnt(0)" ::: "memory");
    __syncthreads();
    if (threadIdx.x == 0) {
        unsigned* bar = b.bar;
        __builtin_amdgcn_s_waitcnt(0);
        unsigned nloc = b.st[0], nx = b.st[1];
        if (nloc == 0u) { xcd_barrier_complete(bar, b.x, nloc, nx); b.st[0] = nloc; b.st[1] = nx; }
        const unsigned old = xb_add(&bar[XB_XSUB(b.x)], 1u);
        const unsigned gen = old / nloc;
        if (old + 1u == (gen + 1u) * nloc) {
            __builtin_amdgcn_fence(__ATOMIC_RELEASE, "agent");
            asm volatile("s_waitcnt vmcnt(0)" ::: "memory");
            const unsigned og = xb_add(&bar[XB_TOP], 1u);
            const unsigned tg = og / nx;
            if (og + 1u == (tg + 1u) * nx) xb_add(&bar[XB_TOPGEN], 1u);
            else XB_SPIN(xb_ld(&bar[XB_TOPGEN]) == tg, bar);
            __builtin_amdgcn_fence(__ATOMIC_ACQUIRE, "agent");
            xb_add(&bar[XB_XGEN(b.x)], 1u);
            asm volatile("s_waitcnt vmcnt(0)" ::: "memory");
        } else {
            XB_SPIN(xb_ld(&bar[XB_XGEN(b.x)]) == gen, bar);
            __builtin_amdgcn_fence(__ATOMIC_ACQUIRE, "agent");
            asm volatile("s_waitcnt vmcnt(0)" ::: "memory");
        }
    }
    __syncthreads();
}

namespace pg8 {
struct TileOrder {
    int nM, nN, nwg, G, c;
    __device__ __forceinline__ void init(int nM_, int nN_, int G_, int c_) { nM = nM_; nN = nN_; nwg = nM * nN; G = G_; c = c_; }
    __device__ __forceinline__ bool logical(int i, int& im, int& in) const {
        const long L = (long)i * G + c; if (L >= nwg) return false;
        int wgid = (int)L; { const int q = nwg / NXCD, r = nwg % NXCD, xcd = wgid % NXCD, off = wgid / NXCD; wgid = (xcd < r ? xcd * (q + 1) : r * (q + 1) + (xcd - r) * q) + off; }
        const int nig = WGM * nN, gid = wgid / nig, fm = gid * WGM, gsz = (nM - fm) < WGM ? (nM - fm) : WGM;
        im = fm + ((wgid % nig) % gsz); in = (wgid % nig) / gsz; return true;
    }
    __device__ __forceinline__ void a_ready(const Unit&) const {}
    __device__ __forceinline__ void done(const Unit&) const {}
};
struct AllOrder : TileOrder { __device__ __forceinline__ bool next(int i, Unit& u) const { int im, in; if (!logical(i, im, in)) return false; u.pm = im; u.pn = in; return true; } };
struct LatOrder : TileOrder {
    __device__ __forceinline__ bool next(int i, Unit& u) const { int im, in; if (!logical(i, im, in)) return false; u.pm = (im >> 4) * 17 + 1 + (im & 15); u.pn = in; return true; } };
struct MoeOrder : TileOrder {
    const PG8_LAS int* tile_e; int nper;
    __device__ __forceinline__ bool next(int i, Unit& u) const { int im, in; if (!logical(i, im, in)) return false; u.pm = im; u.pn = tile_e[im] * nper + in; return true; } };

struct EpiRes {
    static constexpr bool PERM = true, AFTER_DRAIN = false;
    const float* xin; const float* h; bf16_t* pre; const float* modv; const float* bias;
    __device__ __forceinline__ void operator()(const f32x4 (&acc)[2][2][4][2], const Unit& u, int wr, int wc, int fr, int fq) const {
        asm volatile("" : "+v"(fr), "+v"(fq));
        const int b = u.pm / 17, j = u.pm % 17;
        const int rl0 = wr * 64 + fr, col0 = u.pn * BM + wc * 32 + 8 * fq;
        const float* gate = modv + (size_t)b * 6144 + 2048;
        f32x4 gv[2][2], bv[2][2];
#pragma unroll
        for (int bj = 0; bj < 2; ++bj)
#pragma unroll
            for (int n = 0; n < 2; ++n) { gv[bj][n] = *(const f32x4*)(gate + col0 + bj * HALF + 4 * n); bv[bj][n] = bias ? *(const f32x4*)(bias + col0 + bj * HALF + 4 * n) : (f32x4){0.f, 0.f, 0.f, 0.f}; }
#pragma unroll
        for (int aim = 0; aim < 4; ++aim) { const int ai = aim >> 1, m0 = (aim & 1) * 2;
            f32x4 hv[2][2][2];
#pragma unroll
            for (int mm = 0; mm < 2; ++mm) { const int rl = rl0 + ai * HALF + (m0 + mm) * 16; const size_t grow = (size_t)u.pm * BM + rl;
                const float* hin = xin ? xin + ((size_t)b * 4096 + (size_t)(j - 1) * 256 + rl) * 1024 + col0 : h + grow * 1024 + col0;
#pragma unroll
                for (int bj = 0; bj < 2; ++bj) { hv[mm][bj][0] = *(const f32x4*)(hin + bj * HALF); hv[mm][bj][1] = *(const f32x4*)(hin + bj * HALF + 4); } }
            asm volatile("" ::: "memory");
#pragma unroll
            for (int mm = 0; mm < 2; ++mm) { const int m = m0 + mm; const int rl = rl0 + ai * HALF + m * 16; const size_t grow = (size_t)u.pm * BM + rl; bf16_t* po = pre + grow * 1024 + col0;
#pragma unroll
                for (int bj = 0; bj < 2; ++bj) {
                    const f32x4 v0 = hv[mm][bj][0] * 1.4142135623730951f + gv[bj][0] * (acc[ai][bj][m][0] + bv[bj][0]), v1 = hv[mm][bj][1] * 1.4142135623730951f + gv[bj][1] * (acc[ai][bj][m][1] + bv[bj][1]);
                    u32x4 w; w.x = cvt_pk_bf16(v0[0], v0[1]); w.y = cvt_pk_bf16(v0[2], v0[3]); w.z = cvt_pk_bf16(v1[0], v1[1]); w.w = cvt_pk_bf16(v1[2], v1[3]);
                    *(u32x4*)(po + bj * HALF) = w; } }
            asm volatile("" ::: "memory"); }
    }
};
template <int MODE, bool OUT8 = false> struct EpiGate {
    static constexpr bool PERM = true, AFTER_DRAIN = false;
    bf16_t* O; const float* bias; int nper; float ascale, oscale;
    __device__ __forceinline__ void operator()(const f32x4 (&acc)[2][2][4][2], const Unit& u, int wr, int wc, int fr, int fq) const {
        asm volatile("" : "+v"(fr), "+v"(fq));
        const int row0 = u.pm * BM + wr * 64 + fr, pnl = u.pn % nper, ocol0 = pnl * HALF + wc * 32 + 8 * fq, bcol0 = u.pn * BM + wc * 32 + 8 * fq;
        const float s0 = ascale, s1 = MODE == 1 ? ascale * oscale : ascale;
        f32x4 bv[2][2];
#pragma unroll
        for (int n = 0; n < 2; ++n) { bv[0][n] = *(const f32x4*)(bias + bcol0 + 4 * n); const f32x4 t = *(const f32x4*)(bias + bcol0 + HALF + 4 * n); bv[1][n] = MODE == 1 ? (t + 1.0f) * oscale : t; }
#pragma unroll
        for (int ai = 0; ai < 2; ++ai)
#pragma unroll
            for (int m = 0; m < 4; ++m) { bf16_t* rowp = O + (size_t)(row0 + ai * HALF + m * 16) * 1024 + ocol0;
                unsigned char* rowp8 = (unsigned char*)O + (size_t)(row0 + ai * HALF + m * 16) * 1024 + ocol0;
                float o[8];
#pragma unroll
                for (int n = 0; n < 2; ++n) { const f32x4 a = acc[ai][0][m][n] * s0 + bv[0][n], g = acc[ai][1][m][n] * s1 + bv[1][n];
#pragma unroll
                    for (int e = 0; e < 4; ++e) {
                        if (MODE == 0) { o[4 * n + e] = a[e] * __builtin_amdgcn_rcpf(1.f + __builtin_amdgcn_exp2f(g[e] * -1.4426950408889634f)); }
                        else { const float gt = fminf(a[e], 7.0f), up1 = __builtin_amdgcn_fmed3f(g[e], -6.0f * oscale, 8.0f * oscale);
                            o[4 * n + e] = up1 * (gt * __builtin_amdgcn_rcpf(1.f + __builtin_amdgcn_exp2f(gt * (-1.702f * 1.4426950408889634f)))); } } }
                if constexpr (OUT8) {
                    int w0 = 0, w1 = 0; w0 = __builtin_amdgcn_cvt_pk_fp8_f32(o[0], o[1], w0, false); w0 = __builtin_amdgcn_cvt_pk_fp8_f32(o[2], o[3], w0, true);
                    w1 = __builtin_amdgcn_cvt_pk_fp8_f32(o[4], o[5], w1, false); w1 = __builtin_amdgcn_cvt_pk_fp8_f32(o[6], o[7], w1, true);
                    typedef unsigned u32x2 __attribute__((ext_vector_type(2))); *(u32x2*)rowp8 = (u32x2){(unsigned)w0, (unsigned)w1}; (void)rowp;
                } else { (void)rowp8;
                u32x4 w; w.x = cvt_pk_bf16(o[0], o[1]); w.y = cvt_pk_bf16(o[2], o[3]); w.z = cvt_pk_bf16(o[4], o[5]); w.w = cvt_pk_bf16(o[6], o[7]);
                *(u32x4*)rowp = w; } }
    }
};
struct EpiDown {
    static constexpr bool PERM = true, AFTER_DRAIN = false;
    bf16_t* Y; const float* bias; const float* row_w; const int* row_dst; float ascale; const PG8_LAS int* gtab; float oscale;
    __device__ __forceinline__ void operator()(const f32x4 (&acc)[2][2][4][2], const Unit& u, int wr, int wc, int fr, int fq) const {
        asm volatile("" : "+v"(fr), "+v"(fq));
        const int pnl = u.pn & 3, ocol0 = pnl * BM + wc * 32 + 8 * fq, bcol0 = u.pn * BM + wc * 32 + 8 * fq; const int tbase = gtab[u.pm], tcnt = gtab[576 + u.pm];
        f32x4 bv[2][2];
#pragma unroll
        for (int bj = 0; bj < 2; ++bj)
#pragma unroll
            for (int n = 0; n < 2; ++n) bv[bj][n] = *(const f32x4*)(bias + bcol0 + bj * HALF + 4 * n);
        int dstv[2][4]; float wv[2][4];
#pragma unroll
        for (int ai = 0; ai < 2; ++ai)
#pragma unroll
            for (int m = 0; m < 4; ++m) { const int rl = wr * 64 + fr + ai * HALF + m * 16; const int ix = tbase + (rl < tcnt ? rl : 0); dstv[ai][m] = row_dst[ix]; wv[ai][m] = row_w[ix]; }
#pragma unroll
        for (int ai = 0; ai < 2; ++ai)
#pragma unroll
            for (int m = 0; m < 4; ++m) { const int rl = wr * 64 + fr + ai * HALF + m * 16;
                if (rl < tcnt) { const int dst = dstv[ai][m]; const float w8 = wv[ai][m] * oscale; unsigned char* rowp = (unsigned char*)Y + (size_t)dst * 1024 + ocol0;
#pragma unroll
                    for (int bj = 0; bj < 2; ++bj) { const f32x4 v0 = (acc[ai][bj][m][0] * ascale + bv[bj][0]) * w8, v1 = (acc[ai][bj][m][1] * ascale + bv[bj][1]) * w8;
                        int w0 = 0, w1 = 0; w0 = __builtin_amdgcn_cvt_pk_fp8_f32(fminf(fmaxf(v0[0], -448.f), 448.f), fminf(fmaxf(v0[1], -448.f), 448.f), w0, false); w0 = __builtin_amdgcn_cvt_pk_fp8_f32(fminf(fmaxf(v0[2], -448.f), 448.f), fminf(fmaxf(v0[3], -448.f), 448.f), w0, true);
                        w1 = __builtin_amdgcn_cvt_pk_fp8_f32(fminf(fmaxf(v1[0], -448.f), 448.f), fminf(fmaxf(v1[1], -448.f), 448.f), w1, false); w1 = __builtin_amdgcn_cvt_pk_fp8_f32(fminf(fmaxf(v1[2], -448.f), 448.f), fminf(fmaxf(v1[3], -448.f), 448.f), w1, true);
                        typedef unsigned u32x2 __attribute__((ext_vector_type(2))); *(u32x2*)(rowp + bj * HALF) = (u32x2){(unsigned)w0, (unsigned)w1}; } } }
    }
};
}

namespace att {
using bf16x8 = __attribute__((ext_vector_type(8))) short;
using s16x4  = __attribute__((ext_vector_type(4))) short;
using f32x16 = __attribute__((ext_vector_type(16))) float;
using u32x4  = __attribute__((ext_vector_type(4))) unsigned;
constexpr int NW = 8, QBLK = 32, KVBLK = 64;
constexpr float SCALE = 0.10206207261596575f;
constexpr float THR = 8.f;
constexpr int SHM_V = 16384, SHM_K = 16384, NBUF = 3, SHM_ATTN = NBUF * SHM_V + NBUF * SHM_K + NW * 64 * 4;
#define KSWZ(row, colB) ((row) * 256 + ((colB) ^ (((row) & 7) << 4)))
#define SBAR() __builtin_amdgcn_sched_barrier(0)
__device__ __forceinline__ int crow(int r, int hi) { return (r & 3) + 8 * (r >> 2) + 4 * hi; }
__device__ __forceinline__ unsigned cvtpk(float lo, float hi) { unsigned r; asm volatile("v_cvt_pk_bf16_f32 %0, %1, %2" : "=v"(r) : "v"(lo), "v"(hi)); return r; }

__device__ __forceinline__ void partialSM(f32x16& p0, f32x16& p1, float& m_reg, float& mn, float& alpha) {
  constexpr float C = SCALE * 1.4426950408889634f;
  float pmax = p0[0];
#pragma unroll
  for (int r = 1; r < 16; ++r) pmax = fmaxf(pmax, p0[r]);
#pragma unroll
  for (int r = 0; r < 16; ++r) pmax = fmaxf(pmax, p1[r]);
  { auto rr = __builtin_amdgcn_permlane32_swap(__float_as_uint(pmax), __float_as_uint(pmax), false, false);
    pmax = fmaxf(__uint_as_float(rr[0]), __uint_as_float(rr[1])); }
  if (__builtin_expect(__all(pmax - m_reg <= THR / SCALE), 1)) { mn = m_reg; alpha = 1.f; }
  else { mn = fmaxf(m_reg, pmax); alpha = __builtin_amdgcn_exp2f((m_reg - mn) * C); m_reg = mn; }
  float mnC = -mn * C;
#pragma unroll
  for (int r = 0; r < 16; ++r) p0[r] = fmaf(p0[r], C, mnC);
#pragma unroll
  for (int r = 0; r < 16; ++r) p1[r] = fmaf(p1[r], C, mnC);
#pragma unroll
  for (int r = 0; r < 16; ++r) p0[r] = __builtin_amdgcn_exp2f(p0[r]);
}
__device__ __forceinline__ void finishSM(f32x16& p0, f32x16& p1, float alpha, float& l_reg, bf16x8& pa0, bf16x8& pa1, bf16x8& pa2, bf16x8& pa3) {
#pragma unroll
  for (int r = 0; r < 16; ++r) p1[r] = __builtin_amdgcn_exp2f(p1[r]);
  float ps = 0;
#pragma unroll
  for (int r = 0; r < 16; ++r) ps += p0[r];
#pragma unroll
  for (int r = 0; r < 16; ++r) ps += p1[r];
  { auto rr = __builtin_amdgcn_permlane32_swap(__float_as_uint(ps), __float_as_uint(ps), false, false);
    ps = __uint_as_float(rr[0]) + __uint_as_float(rr[1]); }
  l_reg = l_reg * alpha + ps;
#define PK4(P, BASE, OUT) do { unsigned a0 = cvtpk(P[BASE + 0], P[BASE + 1]), a1 = cvtpk(P[BASE + 2], P[BASE + 3]);   \
    unsigned b0 = cvtpk(P[BASE + 4], P[BASE + 5]), b1 = cvtpk(P[BASE + 6], P[BASE + 7]);                              \
    auto r0 = __builtin_amdgcn_permlane32_swap(a0, b0, false, false); auto r1 = __builtin_amdgcn_permlane32_swap(a1, b1, false, false); \
    u32x4 w = {r0[0], r1[0], r0[1], r1[1]}; OUT = *reinterpret_cast<bf16x8*>(&w); } while (0)
  PK4(p0, 0, pa0); PK4(p0, 8, pa1); PK4(p1, 0, pa2); PK4(p1, 8, pa3);
#undef PK4
}
__device__ __forceinline__ void qkt(f32x16& p0, f32x16& p1, const bf16* Ks, const bf16x8* qr, int r32, int hi) {
  p0 = f32x16{}; p1 = f32x16{};
#pragma unroll
  for (int d0 = 0; d0 < 6; ++d0) { int cb = (d0 * 16 + hi * 8) * 2;
    bf16x8 b0 = *reinterpret_cast<const bf16x8*>((const char*)Ks + KSWZ(r32, cb));
    bf16x8 b1 = *reinterpret_cast<const bf16x8*>((const char*)Ks + KSWZ(32 + r32, cb));
    p0 = __builtin_amdgcn_mfma_f32_32x32x16_bf16(b0, qr[d0], p0, 0, 0, 0);
    p1 = __builtin_amdgcn_mfma_f32_32x32x16_bf16(b1, qr[d0], p1, 0, 0, 0); }
}
__device__ __forceinline__ int v_st(int k, int c) { const int kk = (k & ~0xC) | ((k & 4) << 1) | ((k & 8) >> 1); return ((kk >> 3) * 4 + (c >> 5)) * 512 + ((kk & 7) * 32 + (c & 31)) * 2; }
__device__ __forceinline__ int v_rd_base(int lane) { return ((lane & 3) << 3) | (((lane >> 2) & 3) << 6) | (((lane >> 4) & 1) << 5) | (((lane >> 5) & 1) << 8); }
constexpr int v_rd_off(int d0, int ks, int half) { return d0 * 512 + ks * 4096 + half * 2048; }
template <int OFF> __device__ __forceinline__ s16x4 tr_read(int vb) {
  s16x4 r; asm volatile("ds_read_b64_tr_b16 %0, %1 offset:%2" : "=&v"(r) : "v"(vb), "i"(OFF) : "memory"); return r;
}
template <int D0> __device__ __forceinline__ void pv_one(f32x16& od, int vb, bf16x8 pa0, bf16x8 pa1, bf16x8 pa2, bf16x8 pa3) {
  const s16x4 l0 = tr_read<v_rd_off(D0, 0, 0)>(vb), h0 = tr_read<v_rd_off(D0, 0, 1)>(vb), l1 = tr_read<v_rd_off(D0, 1, 0)>(vb), h1 = tr_read<v_rd_off(D0, 1, 1)>(vb);
  const s16x4 l2 = tr_read<v_rd_off(D0, 2, 0)>(vb), h2 = tr_read<v_rd_off(D0, 2, 1)>(vb), l3 = tr_read<v_rd_off(D0, 3, 0)>(vb), h3 = tr_read<v_rd_off(D0, 3, 1)>(vb);
  asm volatile("s_waitcnt lgkmcnt(0)" ::: "memory"); SBAR();
#define PK(L, H) (bf16x8){L[0], L[1], L[2], L[3], H[0], H[1], H[2], H[3]}
  od = __builtin_amdgcn_mfma_f32_32x32x16_bf16(pa0, PK(l0, h0), od, 0, 0, 0);
  od = __builtin_amdgcn_mfma_f32_32x32x16_bf16(pa1, PK(l1, h1), od, 0, 0, 0);
  od = __builtin_amdgcn_mfma_f32_32x32x16_bf16(pa2, PK(l2, h2), od, 0, 0, 0);
  od = __builtin_amdgcn_mfma_f32_32x32x16_bf16(pa3, PK(l3, h3), od, 0, 0, 0);
#undef PK
}
__device__ __forceinline__ void pv_d0(f32x16* o, int vb, bf16x8 pa0, bf16x8 pa1, bf16x8 pa2, bf16x8 pa3) {
  pv_one<0>(o[0], vb, pa0, pa1, pa2, pa3); pv_one<1>(o[1], vb, pa0, pa1, pa2, pa3);
}
__device__ __forceinline__ bf16x8 rope8(bf16x8 x, const float* tab, int pbase) {
  u32x4 w;
#pragma unroll
  for (int i = 0; i < 4; ++i) { const float x1 = __uint_as_float(((unsigned)(unsigned short)x[2 * i]) << 16), x2 = __uint_as_float(((unsigned)(unsigned short)x[2 * i + 1]) << 16);
    const float cs = tab[pbase + i], sn = tab[16 + pbase + i]; w[i] = cvtpk(x1 * cs - x2 * sn, x1 * sn + x2 * cs); }
  return *reinterpret_cast<bf16x8*>(&w);
}
__device__ __forceinline__ void attn_unit(const bf16* __restrict__ Qb, const bf16* __restrict__ KVb, const bf16* __restrict__ KRb, bf16* __restrict__ Ob,
                                          const float* __restrict__ rope, int seq, char* lds) {
  int tid_l = threadIdx.x; asm volatile("" : "+v"(tid_l));
  const int tid = tid_l, wid = tid >> 6, lane = tid & 63, r32 = lane & 31, hi = lane >> 5;
  bf16* V_lds = (bf16*)lds; bf16* K_lds = (bf16*)(lds + NBUF * SHM_V);
  float* ws = (float*)(lds + NBUF * SHM_V + NBUF * SHM_K) + wid * 64; float* li_l = ws; float* al_l = ws + 32;
  float m_reg = -1e30f, l_reg = 0; f32x16 o[2] = {}; bf16x8 qr[6];
  const bf16* Qw = Qb + (long)(wid * QBLK + r32) * 768 + hi * 8;
#pragma unroll
  for (int d0 = 0; d0 < 6; ++d0) qr[d0] = *reinterpret_cast<const bf16x8*>(Qw + d0 * 16);
  if (rope) { const float* tab = rope + (long)(wid * QBLK + r32) * 32; qr[4] = rope8(qr[4], tab, 4 * hi); qr[5] = rope8(qr[5], tab, 8 + 4 * hi); }
  const int sr = tid >> 4, ch = tid & 15;
  const bf16* kbase = ch < 8 ? KVb + ch * 8 : KRb + ((ch - 8) & 3) * 8; const long kstr = ch < 8 ? 1024 : 32;
  const int vkey = tid >> 3, vc8 = (tid & 7) * 8, vst0 = v_st(vkey, vc8);
  const bf16* vbase = KVb + 512 + vc8;
  const int vb0 = (int)(uintptr_t)V_lds + v_rd_base(lane);
  struct { bf16x8 vs0, ks0, ks1; } sr_[2];
#define SLOAD(i, k0) do { sr_[i].vs0 = *reinterpret_cast<const bf16x8*>(vbase + (long)((k0) + vkey) * 1024); \
    sr_[i].ks0 = *reinterpret_cast<const bf16x8*>(kbase + (long)((k0) + sr) * kstr); sr_[i].ks1 = *reinterpret_cast<const bf16x8*>(kbase + (long)((k0) + 32 + sr) * kstr); } while (0)
#define SWRITE(b, i) do { *(bf16x8*)((char*)V_lds + (b) * SHM_V + vst0) = sr_[i].vs0; int kc = ch * 16;               \
    *(bf16x8*)((char*)K_lds + (b) * SHM_K + KSWZ(sr, kc)) = sr_[i].ks0;                       \
    *(bf16x8*)((char*)K_lds + (b) * SHM_K + KSWZ(32 + sr, kc)) = sr_[i].ks1; } while (0)
#define SWAIT() asm volatile("s_waitcnt vmcnt(3)" ::: "memory")
#define RESC(a) do { if (__any((a) < 1.f)) { if (hi == 0) al_l[r32] = (a); asm volatile("s_waitcnt lgkmcnt(0)" ::: "memory"); \
    _Pragma("unroll") for (int d = 0; d < 2; ++d) _Pragma("unroll") for (int r = 0; r < 16; ++r) o[d][r] *= al_l[crow(r, hi)]; } } while (0)
  f32x16 pA0, pA1, pB0, pB1; float mnA, mnB, alA, alB; bf16x8 pa0, pa1, pa2, pa3; const int NT = seq / KVBLK;
  constexpr int SE = 0, SO = 1;
  SLOAD(SE, 0); asm volatile("s_waitcnt vmcnt(0)" ::: "memory"); SWRITE(0, SE); __syncthreads();
  qkt(pA0, pA1, K_lds, qr, r32, hi); partialSM(pA0, pA1, m_reg, mnA, alA);
  SLOAD(SO, KVBLK); if (2 < NT) SLOAD(SE, 2 * KVBLK);
  SWAIT(); SWRITE(1, SO); __syncthreads();
  int bprev = 0, bcur = 1, bnext = 2;
#define ATT_STEP(PN0, PN1, MNN, ALN, PO0, PO1, ALO, SL_LOAD, SL_WRITE, t) do { \
    SBAR(); qkt(PN0, PN1, (bf16*)((char*)K_lds + bcur * SHM_K), qr, r32, hi); \
    finishSM(PO0, PO1, ALO, l_reg, pa0, pa1, pa2, pa3); SBAR(); \
    if ((t) + 2 < NT) SLOAD(SL_LOAD, ((t) + 2) * KVBLK); SBAR(); \
    pv_d0(o, vb0 + bprev * (int)SHM_V, pa0, pa1, pa2, pa3); partialSM(PN0, PN1, m_reg, MNN, ALN); \
    SWAIT(); SWRITE(bnext, SL_WRITE); \
    RESC(ALN); __syncthreads(); \
    bprev = bcur; bcur = bnext; bnext = (bnext == 2) ? 0 : bnext + 1; } while (0)
  for (int j = 1; j + 1 < NT; j += 2) {
    ATT_STEP(pB0, pB1, mnB, alB, pA0, pA1, alA, SO, SE, j);
    ATT_STEP(pA0, pA1, mnA, alA, pB0, pB1, alB, SE, SO, j + 1);
  }
#undef ATT_STEP
  SBAR(); qkt(pB0, pB1, (bf16*)((char*)K_lds + bcur * SHM_K), qr, r32, hi);
  finishSM(pA0, pA1, alA, l_reg, pa0, pa1, pa2, pa3); SBAR();
  pv_d0(o, vb0 + bprev * (int)SHM_V, pa0, pa1, pa2, pa3); partialSM(pB0, pB1, m_reg, mnB, alB);
  RESC(alB);
  finishSM(pB0, pB1, alB, l_reg, pa0, pa1, pa2, pa3); SBAR();
  pv_d0(o, vb0 + bcur * (int)SHM_V, pa0, pa1, pa2, pa3);
  if (hi == 0) li_l[r32] = l_reg; asm volatile("s_waitcnt lgkmcnt(0)" ::: "memory");
  float rli[16];
#pragma unroll
  for (int r = 0; r < 16; ++r) rli[r] = __builtin_amdgcn_rcpf(li_l[crow(r, hi)]);
  bf16* Ow = Ob + (long)(wid * QBLK) * 1024;
#pragma unroll
  for (int r = 0; r < 16; ++r) { int orow = crow(r, hi);
#pragma unroll
    for (int d0 = 0; d0 < 2; ++d0) { const float v = o[d0][r] * rli[r]; Ow[(long)orow * 1024 + d0 * 32 + r32] = (bf16)(cvtpk(v, v) & 0xffffu); } }
#undef SLOAD
#undef SWRITE
#undef SWAIT
#undef RESC
}
}

struct Args { const float* in[33]; float* out; unsigned char* ws; int ph_lo, ph_hi; };
enum { I_X = 0, I_C, I_CTX, I_CCTX, I_MODW, I_MODB, I_LN1G, I_LN1B, I_LN2G, I_LN2B, I_WIN, I_QNORM, I_KVNORM, I_WUQ, I_WUK, I_WUV, I_LBL, I_HGNORM, I_WOUT,
       I_PW1W, I_PW1B, I_DWW, I_DWB, I_CLNG, I_CLNB, I_PW2W, I_PW2B, I_RW, I_RB, I_WGU, I_BGU, I_WDN, I_BDN };

__device__ __forceinline__ int dst_row(int n, int mode, int row_off) {
    if (mode == 0) return row_off + n;
    int f, g; if (mode == 1) { f = n >> 1; g = n & 1; } else { g = n >> 10; f = n & 1023; }
    return row_off + 256 * (f >> 7) + 128 * g + (f & 127);
}
__device__ __forceinline__ unsigned pack_fp8x4(float a, float b, float c, float d) { int w = 0; w = __builtin_amdgcn_cvt_pk_fp8_f32(fminf(fmaxf(a, -448.f), 448.f), fminf(fmaxf(b, -448.f), 448.f), w, false);
    w = __builtin_amdgcn_cvt_pk_fp8_f32(fminf(fmaxf(c, -448.f), 448.f), fminf(fmaxf(d, -448.f), 448.f), w, true); return (unsigned)w; }
struct TrItem { const float* W; bf16* WT; int K, N, mode, row_off, item; float f8scale; };
__device__ __forceinline__ void tr_load(const TrItem& d, f32x4 (&v)[16], int lane) {
    const int nblk = (d.N + 63) >> 6, kb = d.item / nblk, nb = d.item - kb * nblk, k0 = 64 * kb, n0 = 64 * nb;
    const int nc = n0 + 4 * (lane & 15), kr = lane >> 4;
#pragma unroll
    for (int i = 0; i < 16; ++i) v[i] = (nc < d.N) ? __builtin_nontemporal_load((const f32x4*)(d.W + (size_t)(k0 + 4 * i + kr) * d.N + nc)) : (f32x4){0.f, 0.f, 0.f, 0.f};
}
__device__ __forceinline__ void tr_lds_write(const f32x4 (&v)[16], LAS float* scr, int lane) {
    const int kr = lane >> 4;
#pragma unroll
    for (int i = 0; i < 16; ++i) { LAS float* s = scr + (4 * i + kr) * 65 + 4 * (lane & 15); s[0] = v[i][0]; s[1] = v[i][1]; s[2] = v[i][2]; s[3] = v[i][3]; }
}
__device__ __forceinline__ void tr_store(const TrItem& d, LAS float* scr, int lane) {
    const int nblk = (d.N + 63) >> 6, kb = d.item / nblk, nb = d.item - kb * nblk, k0 = 64 * kb, n0 = 64 * nb;
    const int c = lane & 7; const int K = d.K;
#pragma unroll
    for (int j = 0; j < 8; ++j) { const int nl = (lane >> 3) + 8 * j, n = n0 + nl; const LAS float* s = scr + (8 * c) * 65 + nl;
        if (n < d.N) { if (d.f8scale > 0.f) { const float f8 = d.f8scale; v2u o8; o8.x = pack_fp8x4(s[0 * 65] * f8, s[1 * 65] * f8, s[2 * 65] * f8, s[3 * 65] * f8); o8.y = pack_fp8x4(s[4 * 65] * f8, s[5 * 65] * f8, s[6 * 65] * f8, s[7 * 65] * f8);
                *(v2u*)((unsigned char*)d.WT + (size_t)dst_row(n, d.mode, d.row_off) * K + k0 + 8 * c) = o8; }
            else { v4u o; o.x = pk2(s[0 * 65], s[1 * 65]); o.y = pk2(s[2 * 65], s[3 * 65]); o.z = pk2(s[4 * 65], s[5 * 65]); o.w = pk2(s[6 * 65], s[7 * 65]);
                *(v4u*)(d.WT + (size_t)dst_row(n, d.mode, d.row_off) * K + k0 + 8 * c) = o; } } }
}
__device__ __forceinline__ void convert_items(const Args& a, unsigned char* ws, LAS float* scr, int lane, int gw, int NGW, int it_lo, int it_hi) {
    constexpr int I0 = 16 * 51, I1 = 6 * 12, I2 = 4 * 8, I3 = 4 * 8, I4 = 256, I5 = 512;
    constexpr int NGU = 64 * 512, NDN = 64 * 256;
    auto decode = [&](int it) -> TrItem {
        TrItem d; int r = it; d.f8scale = 0.f; d.mode = 0; d.row_off = 0;
        if (r < NGU) { const int mi = r >> 9; d.W = a.in[I_WGU] + (size_t)mi * 1024 * 2048; d.K = 1024; d.N = 2048; d.WT = (bf16*)(ws + WS_WGU + (size_t)mi * 2048 * 1024); d.mode = 1; d.item = r & 511; d.f8scale = SC_WGU; return d; } r -= NGU;
        if (r < NDN) { const int mi = r >> 8; d.W = a.in[I_WDN] + (size_t)mi * 1024 * 1024; d.K = 1024; d.N = 1024; d.WT = (bf16*)(ws + WS_WDN + (size_t)mi * 1024 * 1024); d.item = r & 255; d.f8scale = SC_WDN; return d; } r -= NDN;
        if (r < I0) { d.W = a.in[I_WIN]; d.K = 1024; d.N = 3232; d.WT = (bf16*)(ws + WS_WIN); d.item = r; return d; } r -= I0;
        if (r < I1) { d.W = a.in[I_WUQ]; d.K = 384; d.N = 768; d.WT = (bf16*)(ws + WS_WUQ); d.item = r; return d; } r -= I1;
        if (r < I2) { d.W = a.in[I_WUK]; d.K = 256; d.N = 512; d.WT = (bf16*)(ws + WS_WUKV); d.item = r; return d; } r -= I2;
        if (r < I3) { d.W = a.in[I_WUV]; d.K = 256; d.N = 512; d.WT = (bf16*)(ws + WS_WUKV); d.row_off = 512; d.item = r; return d; } r -= I3;
        if (r < I4) { d.W = a.in[I_WOUT]; d.K = 1024; d.N = 1024; d.WT = (bf16*)(ws + WS_WOUT); d.item = r; return d; } r -= I4;
        if (r < I5) { d.W = a.in[I_PW1W]; d.K = 1024; d.N = 2048; d.WT = (bf16*)(ws + WS_WPW1); d.mode = 2; d.item = r; return d; } r -= I5;
        d.W = a.in[I_PW2W]; d.K = 1024; d.N = 1024; d.WT = (bf16*)(ws + WS_WPW2); d.item = r; return d; };
    f32x4 tv[16];
    int it = it_lo + gw;
    if (it < it_hi) { const TrItem d0 = decode(it); tr_load(d0, tv, lane); }
    for (; it < it_hi; it += NGW) {
        const TrItem d = decode(it);
        tr_lds_write(tv, scr, lane);
        if (it + NGW < it_hi) { const TrItem dn = decode(it + NGW); tr_load(dn, tv, lane); }
        LDS_WAIT();
        tr_store(d, scr, lane);
        LDS_WAIT();
    }
}
__device__ __forceinline__ void phase_prologue(const Args& a, LAS unsigned char* lds, int tid, int lane, int wave) {
    unsigned char* ws = a.ws;
    const int G = gridDim.x, B = blockIdx.x;
    {
        LAS float* sc = (LAS float*)lds;
        LAS float* red = (LAS float*)(lds + 36864);
        float* modv = (float*)(ws + WS_MODV);
        bool have = false;
        for (int it = B; it < 192; it += G) {
            if (!have) { for (int i = tid; i < 9 * 1024; i += NTHR) { const int r = i >> 10, k = i & 1023; const float x = r < 8 ? a.in[I_C][r * 1024 + k] : a.in[I_CCTX][k]; sc[i] = x * sigm(x); } __syncthreads(); have = true; }
            const int l = it / 96, jc = it % 96, kg = tid >> 6, jj = tid & 63, j = jc * 64 + jj;
            float acc[9];
#pragma unroll
            for (int r = 0; r < 9; ++r) acc[r] = 0.f;
            const float* wp = a.in[I_MODW] + ((size_t)l * 1024 + kg * 128) * 6144 + j;
            for (int k0 = 0; k0 < 128; k0 += 16) { float w[16];
#pragma unroll
                for (int kk = 0; kk < 16; ++kk) w[kk] = wp[(size_t)(k0 + kk) * 6144];
#pragma unroll
                for (int kk = 0; kk < 16; ++kk)
#pragma unroll
                    for (int r = 0; r < 9; ++r) acc[r] += sc[r * 1024 + kg * 128 + k0 + kk] * w[kk]; }
#pragma unroll
            for (int r = 0; r < 9; ++r) red[(kg * 9 + r) * 64 + jj] = acc[r];
            __syncthreads();
            for (int i = tid; i < 576; i += NTHR) { const int r = i >> 6, j2 = i & 63; float s = a.in[I_MODB][l * 6144 + jc * 64 + j2];
#pragma unroll
                for (int g = 0; g < 8; ++g) s += red[(g * 9 + r) * 64 + j2];
                modv[((size_t)l * 9 + r) * 6144 + jc * 64 + j2] = s; }
            __syncthreads();
        }
        __syncthreads();
    }
    const int gw = B * NWAVES + wave, NGW = G * NWAVES, gt = B * NTHR + tid, NGT = G * NTHR;
    { float* rope = (float*)(ws + WS_ROPE);
      for (int i = gt; i < 4096 * 16; i += NGT) { const int t = i >> 4, p = i & 15; const float pos = (float)(p < 8 ? (t >> 6) : (t & 63));
          const float inv = __powf(10000.0f, -(float)(p & 7) * 0.125f); const float ang = pos * inv; rope[t * 32 + p] = cosf(ang); rope[t * 32 + 16 + p] = sinf(ang); }
      float* bgu = (float*)(ws + WS_BGU);
      for (int i = gt; i < 2 * 32 * 2048; i += NGT) { const int le = i >> 11, np = i & 2047, q = np >> 8, g = (np >> 7) & 1, r = np & 127, f = 128 * q + r; bgu[i] = a.in[I_BGU][(size_t)le * 2048 + 2 * f + g]; }
      float* pb = (float*)(ws + WS_PW1B);
      for (int i = gt; i < 2048; i += NGT) { const int q = i >> 8, g = (i >> 7) & 1, r = i & 127, f = 128 * q + r; pb[i] = a.in[I_PW1B][g * 1024 + f]; }
      v4u* zp = (v4u*)(ws + WS_WIN + (size_t)3232 * 1024 * 2);
      for (int i = gt; i < 96 * 1024 * 2 / 16; i += NGT) zp[i] = (v4u){0u, 0u, 0u, 0u};
    }
    LAS float* scr = (LAS float*)(lds + wave * 16640);
    constexpr int I0 = 16 * 51, I1 = 6 * 12, I2 = 4 * 8, I3 = 4 * 8, I4 = 256, I5 = 512, I6 = 256, SMALL = I0 + I1 + I2 + I3 + I4 + I5 + I6;
    constexpr int NGU = 64 * 512, NDN = 64 * 256, NITEMS = SMALL + NGU + NDN;
    convert_items(a, ws, scr, lane, B * NWAVES + wave, G * NWAVES, NGU + NDN, NITEMS);
}
__device__ __forceinline__ void convert_moe_share(const Args& a, LAS unsigned char* lds, int lane, int wave) {
    LAS float* scr = (LAS float*)(lds + wave * 16640);
    constexpr int NGU = 64 * 512, NDN = 64 * 256;
    convert_items(a, a.ws, scr, lane, blockIdx.x * NWAVES + wave, gridDim.x * NWAVES, 0, NGU + NDN);
}

__device__ __forceinline__ void phase_mod0(const Args& a, int lane, int wave) {
    const int gw = blockIdx.x * NWAVES + wave, NGW = gridDim.x * NWAVES;
    const float* modv = (const float*)(a.ws + WS_MODV);
    bf16* X = (bf16*)(a.ws + WS_X);
    for (int r0 = 2 * gw; r0 < NTOK; r0 += 2 * NGW) {
        f32x4 xv[2][4]; const float* mvp[2];
#pragma unroll
        for (int q = 0; q < 2; ++q) { const int r = r0 + q; const int b = r / TPB, p = r - b * TPB;
            const float* src = p < CTXL ? a.in[I_CTX] + ((size_t)b * CTXL + p) * 1024 : a.in[I_X] + ((size_t)b * SEQ + (p - CTXL)) * 1024;
            mvp[q] = modv + (size_t)(p < CTXL ? 8 : b) * 6144;
#pragma unroll
            for (int j = 0; j < 4; ++j) xv[q][j] = *(const f32x4*)(src + 4 * (lane + 64 * j)); }
#pragma unroll
        for (int q = 0; q < 2; ++q)
#pragma unroll
            for (int j = 0; j < 4; ++j) { const int c = 4 * (lane + 64 * j); const f32x4 sh = *(const f32x4*)(mvp[q] + c), sc = *(const f32x4*)(mvp[q] + 1024 + c);
                const f32x4 y = xv[q][j] * (sc + 1.0f) + sh; v2u o; o.x = pk2(y[0], y[1]); o.y = pk2(y[2], y[3]); *(v2u*)(X + (size_t)(r0 + q) * 1024 + c) = o; }
    }
}

__device__ __forceinline__ void phase_norm0(const Args& a, int lane, int wave) {
    const int gw = blockIdx.x * NWAVES + wave, NGW = gridDim.x * NWAVES;
    const bf16* Z = (const bf16*)(a.ws + WS_Z); bf16* CQN = (bf16*)(a.ws + WS_CQN); bf16* CKVN = (bf16*)(a.ws + WS_CKVN); bf16* KRR = (bf16*)(a.ws + WS_KRR);
    const float* rope = (const float*)(a.ws + WS_ROPE);
    float gq[8], gk[8];
#pragma unroll
    for (int i = 0; i < 8; ++i) { gq[i] = lane < 48 ? a.in[I_QNORM][8 * lane + i] : 0.f; gk[i] = lane < 32 ? a.in[I_KVNORM][8 * lane + i] : 0.f; }
    for (int r = gw; r < NTOK; r += NGW) {
        const bf16* z = Z + (size_t)r * ZC; const int p = r % TPB;
        bf16x8 q8 = {}, k8 = {}, r8 = {};
        if (lane < 48) q8 = *(const bf16x8*)(z + ZQ + 8 * lane);
        if (lane < 32) k8 = *(const bf16x8*)(z + ZKV + 8 * lane);
        if (lane < 4) r8 = *(const bf16x8*)(z + ZKR + 8 * lane);
        float qf[8], kf[8], sq = 0.f, sk = 0.f;
#pragma unroll
        for (int i = 0; i < 8; ++i) { qf[i] = bf2f((unsigned short)q8[i]); kf[i] = bf2f((unsigned short)k8[i]); sq += qf[i] * qf[i]; sk += kf[i] * kf[i]; }
        sq = wave_sum(sq); sk = wave_sum(sk);
        const float rq = rsqrtf(sq * (1.f / 384.f) + RMS_EPS), rk = rsqrtf(sk * (1.f / 256.f) + RMS_EPS);
        if (lane < 48) { v4u o; o.x = pk2(qf[0] * rq * gq[0], qf[1] * rq * gq[1]); o.y = pk2(qf[2] * rq * gq[2], qf[3] * rq * gq[3]); o.z = pk2(qf[4] * rq * gq[4], qf[5] * rq * gq[5]); o.w = pk2(qf[6] * rq * gq[6], qf[7] * rq * gq[7]);
            *(v4u*)(CQN + (size_t)r * 384 + 8 * lane) = o; }
        if (lane < 32) { v4u o; o.x = pk2(kf[0] * rk * gk[0], kf[1] * rk * gk[1]); o.y = pk2(kf[2] * rk * gk[2], kf[3] * rk * gk[3]); o.z = pk2(kf[4] * rk * gk[4], kf[5] * rk * gk[5]); o.w = pk2(kf[6] * rk * gk[6], kf[7] * rk * gk[7]);
            *(v4u*)(CKVN + (size_t)r * 256 + 8 * lane) = o; }
        if (lane < 4) { bf16x8 o8 = r8; if (p >= CTXL) o8 = att::rope8(r8, rope + (size_t)(p - CTXL) * 32, 4 * lane); *(bf16x8*)(KRR + (size_t)r * 32 + 8 * lane) = o8; }
    }
}

__device__ __forceinline__ void hgrn_unit(const Args& a, int unit, LAS unsigned char* lds, int tid) {
    const int b = unit >> 5, head = (unit >> 3) & 3, dir = (unit >> 2) & 1, sl = unit & 3;
    const bf16* Z = (const bf16*)(a.ws + WS_Z);
    float* Od = (float*)(a.ws + (dir ? WS_OB : WS_OF));
    LAS float* lbv = (LAS float*)lds;
    constexpr int BUF0 = 1024, BUFSZ = 28672, OFF_Q = 16384, OFF_V = 24576;
    if (tid < 128) { const int c = head * 128 + tid; const float l0 = a.in[I_LBL][c], l1 = a.in[I_LBL][512 + c], l2 = a.in[I_LBL][1024 + c]; const float m = fmaxf(l0, fmaxf(l1, l2));
        const float e0 = __expf(l0 - m), e1 = __expf(l1 - m), e2 = __expf(l2 - m); lbv[tid] = e0 / (e0 + e1 + e2); }
    __syncthreads();
    const int lt = tid >> 4, lcg = tid & 15;
    float lb8[8];
#pragma unroll
    for (int i = 0; i < 8; ++i) lb8[i] = lbv[8 * lcg + i];
    const int fcol = (dir ? ZHB : ZHF) + head * 128 + 8 * lcg, qcol = ZHQ + head * 128 + 8 * lcg;
    const int vt = tid >> 2, vcol = ZHI + head * 128 + sl * 32 + (tid & 3) * 8;
    const int wave = tid >> 6, lane = tid & 63, vv = lane >> 4, cg = lane & 15, vloc = wave * 4 + vv;
    const size_t zb = (size_t)b * TPB;
    bf16x8 rq, rf, rv;
#define TOKP(n) (dir ? ((n) < CTXL ? (CTXL - 1 - (n)) : (TPB + CTXL - 1 - (n))) : (n))
#define HG_LOAD(i) do { const int n_ = 32 * (i) + lt; const bf16* zr_ = Z + (zb + TOKP(n_)) * ZC; rq = *(const bf16x8*)(zr_ + qcol); rf = *(const bf16x8*)(zr_ + fcol); \
        if (tid < 128) { const int n2_ = 32 * (i) + vt; rv = *(const bf16x8*)(Z + (zb + TOKP(n2_)) * ZC + vcol); } } while (0)
#define HG_WRITE(bufi) do { LAS unsigned char* bp_ = lds + BUF0 + (bufi) * BUFSZ; float f_[8]; \
        _Pragma("unroll") for (int i_ = 0; i_ < 8; ++i_) f_[i_] = lb8[i_] + (1.f - lb8[i_]) * sigm(bf2f((unsigned short)rf[i_])); \
        *(LAS f32x4*)(bp_ + ((lt * 128 + lcg * 4) * 4)) = (f32x4){f_[0], f_[1], f_[2], f_[3]}; *(LAS f32x4*)(bp_ + ((lt * 128 + 64 + lcg * 4) * 4)) = (f32x4){f_[4], f_[5], f_[6], f_[7]}; \
        *(LAS bf16x8*)(bp_ + OFF_Q + (lt * 128 + lcg * 8) * 2) = rq; \
        if (tid < 128) { float v_[8]; _Pragma("unroll") for (int i_ = 0; i_ < 8; ++i_) v_[i_] = bf2f((unsigned short)rv[i_]); \
            *(LAS f32x4*)(bp_ + OFF_V + (vt * 32 + (tid & 3) * 8) * 4) = (f32x4){v_[0], v_[1], v_[2], v_[3]}; *(LAS f32x4*)(bp_ + OFF_V + (vt * 32 + (tid & 3) * 8 + 4) * 4) = (f32x4){v_[4], v_[5], v_[6], v_[7]}; } } while (0)
    float S[8];
#pragma unroll
    for (int j = 0; j < 8; ++j) S[j] = 0.f;
    HG_LOAD(0); HG_WRITE(0); __syncthreads();
    const bool b3 = (cg & 8) != 0, b2 = (cg & 4) != 0, b1 = (cg & 2) != 0, b0 = (cg & 1) != 0;
    for (int i = 0; i < TPB / 32; ++i) {
        if (i + 1 < TPB / 32) HG_LOAD(i + 1);
        const LAS unsigned char* bp = lds + BUF0 + (i & 1) * BUFSZ;
#pragma unroll 1
        for (int g = 0; g < 4; ++g) {
            const LAS unsigned char* gp = bp + g * 8 * 512;
            float ot[8];
#pragma unroll
            for (int t = 0; t < 8; ++t) {
                const f32x4 f0 = *(const LAS f32x4*)(gp + ((t * 128 + cg * 4) * 4)), f1 = *(const LAS f32x4*)(gp + ((t * 128 + 64 + cg * 4) * 4));
                const bf16x8 q8 = *(const LAS bf16x8*)(bp + OFF_Q + ((g * 8 + t) * 128 + cg * 8) * 2);
                const float v = *(const LAS float*)(bp + OFF_V + ((g * 8 + t) * 32 + vloc) * 4);
                float acc = 0.f;
#pragma unroll
                for (int j = 0; j < 8; ++j) { const float fj = j < 4 ? f0[j] : f1[j - 4]; const float qj = bf2f((unsigned short)q8[j]);
                    const float kv = fmaf(-fj, v, v); S[j] = fmaf(fj, S[j], kv); acc = fmaf(S[j], qj, acc); }
                ot[t] = acc;
            }
#pragma unroll
            for (int k = 0; k < 4; ++k) { const float snd = b3 ? ot[k] : ot[k + 4]; const float rcv = __shfl_xor(snd, 8); ot[k] = (b3 ? ot[k + 4] : ot[k]) + rcv; }
#pragma unroll
            for (int k = 0; k < 2; ++k) { const float snd = b2 ? ot[k] : ot[k + 2]; const float rcv = __shfl_xor(snd, 4); ot[k] = (b2 ? ot[k + 2] : ot[k]) + rcv; }
            { const float snd = b1 ? ot[0] : ot[1]; const float rcv = __shfl_xor(snd, 2); ot[0] = (b1 ? ot[1] : ot[0]) + rcv; }
            ot[0] += __shfl_xor(ot[0], 1);
            if (!b0) { const int n = 32 * i + 8 * g + (cg >> 1); const int p = TOKP(n); if (p >= CTXL) Od[(zb + p) * 512 + head * 128 + sl * 32 + vloc] = ot[0]; }
        }
        if (i + 1 < TPB / 32) HG_WRITE((i + 1) & 1);
        __syncthreads();
    }
#undef TOKP
#undef HG_LOAD
#undef HG_WRITE
}

__device__ __forceinline__ void phase_readout(const Args& a, int lane, int wave) {
    const int gw = blockIdx.x * NWAVES + wave, NGW = gridDim.x * NWAVES;
    const bf16* OF = (const bf16*)(a.ws + WS_OF); const bf16* OB = (const bf16*)(a.ws + WS_OB);
    const bf16* Z = (const bf16*)(a.ws + WS_Z); bf16* MIX = (bf16*)(a.ws + WS_Y);
    float hn[8];
#pragma unroll
    for (int i = 0; i < 8; ++i) hn[i] = a.in[I_HGNORM][((8 * lane) & 127) + i];
    for (int lr = gw; lr < NLAT; lr += NGW) {
        const size_t r = (size_t)grow_of(lr);
        const bf16x8 a8 = *(const bf16x8*)(OF + r * 512 + 8 * lane), c8 = *(const bf16x8*)(OB + r * 512 + 8 * lane);
        const bf16x8 g8 = *(const bf16x8*)(Z + r * ZC + ZHG + 8 * lane);
        float o[8]; float ss = 0.f;
#pragma unroll
        for (int i = 0; i < 8; ++i) o[i] = bf2f((unsigned short)a8[i]) + bf2f((unsigned short)c8[i]);
#pragma unroll
        for (int i = 0; i < 8; ++i) ss += o[i] * o[i];
        ss += __shfl_xor(ss, 1); ss += __shfl_xor(ss, 2); ss += __shfl_xor(ss, 4); ss += __shfl_xor(ss, 8);
        const float rs = rsqrtf(ss * (1.f / 128.f) + RMS_EPS);
        float y[8];
#pragma unroll
        for (int i = 0; i < 8; ++i) { const float g = bf2f((unsigned short)g8[i]); y[i] = o[i] * rs * hn[i] * (g * sigm(g)); }
        v4u w; w.x = pk2(y[0], y[1]); w.y = pk2(y[2], y[3]); w.z = pk2(y[4], y[5]); w.w = pk2(y[6], y[7]);
        *(v4u*)(MIX + r * 1024 + 512 + 8 * lane) = w;
    }
}

__device__ __forceinline__ int rows_per_block() { const int G = gridDim.x; return (((NLAT + G - 1) / G) + 15) & ~15; }
__device__ __forceinline__ void phase_ln1(const Args& a, int l, LAS unsigned char* lds, int tid, int lane, int wave) {
    typedef short bf16x8s __attribute__((ext_vector_type(8)));
    const int RB = rows_per_block(), lr_base = blockIdx.x * RB;
    const bf16* PRE = (const bf16*)(a.ws + WS_PRE); bf16* XB = (bf16*)(a.ws + WS_X);
    const float* modv = (const float*)(a.ws + WS_MODV) + (size_t)l * 9 * 6144;
    const float* lng = a.in[I_LN1G] + l * 1024; const float* lnb = a.in[I_LN1B] + l * 1024;
    const float* rw = a.in[I_RW] + (size_t)l * 1024 * 32; const float* rb = a.in[I_RB] + l * 32;
    constexpr int XT_LD = 1028, O_PART = 16 * XT_LD * 4, O_LG = O_PART + 8 * 32 * 16 * 4, O_HIST = O_LG + 16 * 33 * 4 + 64, O_CCNT = O_HIST + 256, O_TIL = O_CCNT + 2048, O_TWL = O_TIL + 4096;
    LAS float* XT = (LAS float*)lds; LAS float* PART = (LAS float*)(lds + O_PART); LAS float* LG = (LAS float*)(lds + O_LG);
    LAS int* hist = (LAS int*)(lds + O_HIST);
    LAS int* ccnt = (LAS int*)(lds + O_CCNT);
    LAS int* til = (LAS int*)(lds + O_TIL);
    LAS float* twl = (LAS float*)(lds + O_TWL);
    __syncthreads();
    if (tid < 32) hist[tid] = 0;
    bf16x8s whi[2][4], wlo[2][4];
    { const int e15 = lane & 15, kq = lane >> 4;
#pragma unroll
      for (int t = 0; t < 2; ++t)
#pragma unroll
          for (int sI = 0; sI < 4; ++sI) { float wv[8];
#pragma unroll
              for (int j = 0; j < 8; ++j) wv[j] = rw[(size_t)(128 * wave + 32 * sI + 8 * kq + j) * 32 + 16 * t + e15];
              v4u ph, pl;
#pragma unroll
              for (int j = 0; j < 4; ++j) { const unsigned p = pk2(wv[2 * j], wv[2 * j + 1]); const float h0 = __uint_as_float(p << 16), h1 = __uint_as_float(p & 0xffff0000u); ph[j] = p; pl[j] = pk2(wv[2 * j] - h0, wv[2 * j + 1] - h1); }
              whi[t][sI] = __builtin_bit_cast(bf16x8s, ph); wlo[t][sI] = __builtin_bit_cast(bf16x8s, pl); } }
    const int ngroups = RB / 16;
    v2u xr[2][4];
#define LN1_LOAD(g) do { _Pragma("unroll") for (int rr_ = 0; rr_ < 2; ++rr_) { const int lr_ = lr_base + 16 * (g) + 2 * wave + rr_; const size_t r_ = (size_t)grow_of(lr_ < NLAT ? lr_ : NLAT - 1); \
        _Pragma("unroll") for (int j_ = 0; j_ < 4; ++j_) xr[rr_][j_] = *(const v2u*)(PRE + r_ * 1024 + 4 * (lane + 64 * j_)); } } while (0)
#if defined(PROBE_LN1X2)
    for (int rep_ = 0; rep_ < 2; ++rep_) { __syncthreads(); if (tid < 32) hist[tid] = 0; __syncthreads();
#endif
    LN1_LOAD(0);
    for (int g = 0; g < ngroups; ++g) {
#pragma unroll
        for (int rr = 0; rr < 2; ++rr) {
            const int lr = lr_base + 16 * g + 2 * wave + rr; const bool ok = lr < NLAT; const size_t r = (size_t)grow_of(ok ? lr : NLAT - 1); const int b = (ok ? lr : NLAT - 1) >> 12;
            const float* mv = modv + (size_t)b * 6144;
            f32x4 x[4]; float s = 0.f;
#pragma unroll
            for (int j = 0; j < 4; ++j) { const v2u p = xr[rr][j]; x[j] = (f32x4){__uint_as_float(p.x << 16), __uint_as_float(p.x & 0xffff0000u), __uint_as_float(p.y << 16), __uint_as_float(p.y & 0xffff0000u)}; s += (x[j][0] + x[j][1]) + (x[j][2] + x[j][3]); }
            const float mean = wave_sum(s) * (1.f / 1024.f); float s2 = 0.f;
#pragma unroll
            for (int j = 0; j < 4; ++j) { x[j] = x[j] - mean; s2 += (x[j][0] * x[j][0] + x[j][1] * x[j][1]) + (x[j][2] * x[j][2] + x[j][3] * x[j][3]); }
            const float rstd = rsqrtf(wave_sum(s2) * (1.f / 1024.f) + LN_EPS);
#pragma unroll
            for (int j = 0; j < 4; ++j) { const int c = 4 * (lane + 64 * j); const f32x4 gg = *(const f32x4*)(lng + c), bb = *(const f32x4*)(lnb + c);
                const f32x4 hv = x[j] * rstd * gg + bb;
                const f32x4 sh = *(const f32x4*)(mv + 3 * 1024 + c), sc = *(const f32x4*)(mv + 4 * 1024 + c);
                const f32x4 bm = hv * (sc + 1.0f) + sh;
                if (ok) *(unsigned*)((unsigned char*)XB + r * 1024 + c) = pack_fp8x4(bm[0] * SC_X8, bm[1] * SC_X8, bm[2] * SC_X8, bm[3] * SC_X8);
                *(LAS f32x4*)(XT + (2 * wave + rr) * XT_LD + c) = bm; }
        }
        if (g + 1 < ngroups) LN1_LOAD(g + 1);
        __syncthreads();
        { const int rr = lane & 15, kq = lane >> 4;
          f32x4 acc0 = {0.f, 0.f, 0.f, 0.f}, acc1 = {0.f, 0.f, 0.f, 0.f};
#pragma unroll
          for (int sI = 0; sI < 4; ++sI) { const LAS float* xp = XT + rr * XT_LD + 128 * wave + 32 * sI + 8 * kq; const f32x4 v0 = *(const LAS f32x4*)xp, v1 = *(const LAS f32x4*)(xp + 4);
              const float bv[8] = {v0[0], v0[1], v0[2], v0[3], v1[0], v1[1], v1[2], v1[3]}; v4u ph, pl;
#pragma unroll
              for (int j = 0; j < 4; ++j) { const unsigned p = pk2(bv[2 * j], bv[2 * j + 1]); const float h0 = __uint_as_float(p << 16), h1 = __uint_as_float(p & 0xffff0000u); ph[j] = p; pl[j] = pk2(bv[2 * j] - h0, bv[2 * j + 1] - h1); }
              const bf16x8s bh = __builtin_bit_cast(bf16x8s, ph), bl = __builtin_bit_cast(bf16x8s, pl);
              acc0 = __builtin_amdgcn_mfma_f32_16x16x32_bf16(whi[0][sI], bh, acc0, 0, 0, 0); acc0 = __builtin_amdgcn_mfma_f32_16x16x32_bf16(whi[0][sI], bl, acc0, 0, 0, 0); acc0 = __builtin_amdgcn_mfma_f32_16x16x32_bf16(wlo[0][sI], bh, acc0, 0, 0, 0);
              acc1 = __builtin_amdgcn_mfma_f32_16x16x32_bf16(whi[1][sI], bh, acc1, 0, 0, 0); acc1 = __builtin_amdgcn_mfma_f32_16x16x32_bf16(whi[1][sI], bl, acc1, 0, 0, 0); acc1 = __builtin_amdgcn_mfma_f32_16x16x32_bf16(wlo[1][sI], bh, acc1, 0, 0, 0); }
#pragma unroll
          for (int q = 0; q < 4; ++q) { PART[(wave * 32 + 4 * kq + q) * 16 + rr] = acc0[q]; PART[(wave * 32 + 16 + 4 * kq + q) * 16 + rr] = acc1[q]; } }
        __syncthreads();
        { const int e = tid >> 4, rr = tid & 15; float sacc = rb[e];
#pragma unroll
          for (int w = 0; w < 8; ++w) sacc += PART[(w * 32 + e) * 16 + rr];
          LG[rr * 33 + e] = sacc; }
        __syncthreads();
        if (wave == (g & 7) && lane < 16) { const int lr = lr_base + 16 * g + lane;
            if (lr < NLAT) { float lg[32];
#pragma unroll
                for (int e = 0; e < 32; ++e) lg[e] = LG[lane * 33 + e];
                unsigned taken = 0u; float tv[4]; int ti[4];
#pragma unroll
                for (int kk = 0; kk < 4; ++kk) { float best = -3.0e38f; int bi = 0;
#pragma unroll
                    for (int e = 0; e < 32; ++e) { const bool okk = (lg[e] > best) && !((taken >> e) & 1u); best = okk ? lg[e] : best; bi = okk ? e : bi; }
                    taken |= 1u << bi; tv[kk] = best; ti[kk] = bi; }
                const float e1 = __expf(tv[1] - tv[0]), e2 = __expf(tv[2] - tv[0]), e3 = __expf(tv[3] - tv[0]); const float inv = 1.f / (1.f + e1 + e2 + e3);
                const int li = (16 * g + lane) * 4; til[li] = ti[0]; til[li + 1] = ti[1]; til[li + 2] = ti[2]; til[li + 3] = ti[3]; twl[li] = inv; twl[li + 1] = e1 * inv; twl[li + 2] = e2 * inv; twl[li + 3] = e3 * inv;
                __hip_atomic_fetch_add(hist + ti[0], 1, __ATOMIC_RELAXED, __HIP_MEMORY_SCOPE_WORKGROUP); __hip_atomic_fetch_add(hist + ti[1], 1, __ATOMIC_RELAXED, __HIP_MEMORY_SCOPE_WORKGROUP);
                __hip_atomic_fetch_add(hist + ti[2], 1, __ATOMIC_RELAXED, __HIP_MEMORY_SCOPE_WORKGROUP); __hip_atomic_fetch_add(hist + ti[3], 1, __ATOMIC_RELAXED, __HIP_MEMORY_SCOPE_WORKGROUP); } }
    }
#if defined(PROBE_LN1X2)
    }
#endif
#undef LN1_LOAD
    __syncthreads();
    int* cursor = (int*)(a.ws + WS_CURSOR) + l * 32;
    int* rows = (int*)(a.ws + WS_ROWS); float* roww = (float*)(a.ws + WS_ROWW); int* rowd = (int*)(a.ws + WS_ROWD);
    int nrows = NLAT - lr_base; nrows = nrows > RB ? RB : nrows; if (nrows < 0) nrows = 0;
    const int nas = nrows * 4, nchunks = (nas + 63) >> 6;
    int basev = 0; if (tid < 32) basev = (int)__hip_atomic_fetch_add((unsigned*)cursor + tid, (unsigned)hist[tid], __ATOMIC_RELAXED, __HIP_MEMORY_SCOPE_AGENT);
    int myrank[2] = {0, 0}, mye[2] = {-1, -1};
#pragma unroll
    for (int cc = 0; cc < 2; ++cc) { const int c = wave + 8 * cc; if (c < nchunks) { const int idx = c * 64 + lane; const int e = idx < nas ? til[idx] : -1; mye[cc] = e;
        for (int x = 0; x < 32; ++x) { const unsigned long long m = __ballot(e == x); if (e == x) myrank[cc] = __popcll(m & ((1ull << lane) - 1ull)); if (lane == 0) ccnt[c * 32 + x] = __popcll(m); } } }
    __syncthreads();
    if (tid < 32) hist[32 + tid] = basev;
    __syncthreads();
#pragma unroll
    for (int cc = 0; cc < 2; ++cc) { const int c = wave + 8 * cc; const int idx = c * 64 + lane; if (c < nchunks && idx < nas) { const int e = mye[cc]; int pos = hist[32 + e] + myrank[cc]; for (int c2 = 0; c2 < c; ++c2) pos += ccnt[c2 * 32 + e];
        const int lr = lr_base + (idx >> 2); const size_t pi = (size_t)e * ECAP + pos; rows[pi] = grow_of(lr); roww[pi] = twl[idx]; rowd[pi] = lr * 4 + (idx & 3); } }
}

__device__ __forceinline__ void phase_ln2(const Args& a, int l, int lane, int wave) {
    const int gw = blockIdx.x * NWAVES + wave, NGW = gridDim.x * NWAVES;
    float* H = (float*)(a.ws + WS_H); const bf16* PRE = (const bf16*)(a.ws + WS_PRE); const unsigned char* YB = (const unsigned char*)(a.ws + WS_YB); bf16* A1 = (bf16*)(a.ws + WS_Y);
    const float* modv = (const float*)(a.ws + WS_MODV);
    const float* ln1g = a.in[I_LN1G] + l * 1024; const float* ln1b = a.in[I_LN1B] + l * 1024;
    const float* lng = a.in[I_LN2G] + l * 1024; const float* lnb = a.in[I_LN2B] + l * 1024;
    for (int lr0 = 2 * gw; lr0 < NLAT; lr0 += 2 * NGW) {
        v2u hv[2][4]; unsigned yv[2][4][4];
#pragma unroll
        for (int q = 0; q < 2; ++q) { const int lr = lr0 + q; const size_t r = (size_t)grow_of(lr);
#pragma unroll
            for (int j = 0; j < 4; ++j) { const int c = 4 * (lane + 64 * j); hv[q][j] = *(const v2u*)(PRE + r * 1024 + c);
#pragma unroll
                for (int k = 0; k < 4; ++k) yv[q][j][k] = *(const unsigned*)(YB + ((size_t)lr * 4 + k) * 1024 + c); } }
#pragma unroll
        for (int q = 0; q < 2; ++q) {
            const int lr = lr0 + q; const size_t r = (size_t)grow_of(lr); const int b = lr >> 12;
            const float* mv = modv + ((size_t)l * 9 + b) * 6144; const float* mv1 = modv + ((size_t)9 + b) * 6144;
            f32x4 x[4]; float s = 0.f;
#pragma unroll
            for (int j = 0; j < 4; ++j) { const v2u p = hv[q][j]; x[j] = (f32x4){__uint_as_float(p.x << 16), __uint_as_float(p.x & 0xffff0000u), __uint_as_float(p.y << 16), __uint_as_float(p.y & 0xffff0000u)}; s += (x[j][0] + x[j][1]) + (x[j][2] + x[j][3]); }
            float mean = wave_sum(s) * (1.f / 1024.f), s2 = 0.f;
#pragma unroll
            for (int j = 0; j < 4; ++j) { x[j] = x[j] - mean; s2 += (x[j][0] * x[j][0] + x[j][1] * x[j][1]) + (x[j][2] * x[j][2] + x[j][3] * x[j][3]); }
            float rstd = rsqrtf(wave_sum(s2) * (1.f / 1024.f) + LN_EPS);
            s = 0.f;
#pragma unroll
            for (int j = 0; j < 4; ++j) { const int c = 4 * (lane + 64 * j); const f32x4 g = *(const f32x4*)(ln1g + c), bb = *(const f32x4*)(ln1b + c);
                const f32x4 h1 = x[j] * rstd * g + bb; f32x4 f = {0.f, 0.f, 0.f, 0.f};
#pragma unroll
                for (int k = 0; k < 4; ++k) { const unsigned y = yv[q][j][k]; const auto lo = __builtin_amdgcn_cvt_pk_f32_fp8((int)y, false), hi = __builtin_amdgcn_cvt_pk_f32_fp8((int)y, true);
                    f[0] += lo[0]; f[1] += lo[1]; f[2] += hi[0]; f[3] += hi[1]; }
                const f32x4 gt = *(const f32x4*)(mv + 5 * 1024 + c);
                x[j] = h1 * ALPHA + gt * (f * (1.f / SC_Y)); s += (x[j][0] + x[j][1]) + (x[j][2] + x[j][3]); }
            mean = wave_sum(s) * (1.f / 1024.f); s2 = 0.f;
#pragma unroll
            for (int j = 0; j < 4; ++j) { x[j] = x[j] - mean; s2 += (x[j][0] * x[j][0] + x[j][1] * x[j][1]) + (x[j][2] * x[j][2] + x[j][3] * x[j][3]); }
            rstd = rsqrtf(wave_sum(s2) * (1.f / 1024.f) + LN_EPS);
#pragma unroll
            for (int j = 0; j < 4; ++j) { const int c = 4 * (lane + 64 * j); const f32x4 g = *(const f32x4*)(lng + c), bb = *(const f32x4*)(lnb + c);
                const f32x4 o = x[j] * rstd * g + bb;
                if (l == 0) { *(f32x4*)(H + r * 1024 + c) = o; const f32x4 sh = *(const f32x4*)(mv1 + c), sc = *(const f32x4*)(mv1 + 1024 + c);
                    const f32x4 am = o * (sc + 1.0f) + sh; v2u w; w.x = pk2(am[0], am[1]); w.y = pk2(am[2], am[3]); *(v2u*)(A1 + r * 1024 + c) = w; }
                else *(f32x4*)(a.out + (size_t)lr * 1024 + c) = o; }
        }
    }
}

__device__ __forceinline__ void phase_conv(const Args& a, LAS unsigned char* lds, int tid, int lane, int wave) {
    const bf16* U = (const bf16*)(a.ws + WS_X); bf16* V = (bf16*)(a.ws + WS_Y);
    LAS float* part = (LAS float*)(lds + 126976);
    LAS float* st = part + 512;
    const int c0 = 2 * tid;
    const float db0 = a.in[I_DWB][c0], db1 = a.in[I_DWB][c0 + 1], g0 = a.in[I_CLNG][c0], g1 = a.in[I_CLNG][c0 + 1], be0 = a.in[I_CLNB][c0], be1 = a.in[I_CLNB][c0 + 1];
    for (int tile = blockIdx.x; tile < NLAT / 32; tile += gridDim.x) {
        const int b = tile >> 7, t0 = (tile & 127) * 32;
        const size_t rb0 = (size_t)b * TPB + CTXL;
        __syncthreads();
        for (int i = tid; i < 62 * 128; i += NTHR) { const int row = i >> 7, chk = i & 127, t = t0 - 15 + row;
            v4u val = {0u, 0u, 0u, 0u}; if (t >= 0 && t < SEQ) val = *(const v4u*)(U + (rb0 + t) * 1024 + chk * 8);
            *(LAS v4u*)(lds + row * 2048 + chk * 16) = val; }
        __syncthreads();
        float w0[31], w1[31];
#pragma unroll
        for (int j = 0; j < 31; ++j) { const float2 wv = *(const float2*)(a.in[I_DWW] + j * 1024 + c0); w0[j] = wv.x; w1[j] = wv.y; }
#pragma unroll 1
        for (int hh = 0; hh < 2; ++hh) {
            const LAS unsigned char* hp = lds + hh * 16 * 2048;
            float acc0[16], acc1[16];
#pragma unroll
            for (int t = 0; t < 16; ++t) { acc0[t] = db0; acc1[t] = db1; }
#pragma unroll
            for (int s = 0; s < 46; ++s) { const unsigned pr = *(const LAS unsigned*)(hp + s * 2048 + tid * 4); const float x0 = __uint_as_float(pr << 16), x1 = __uint_as_float(pr & 0xffff0000u);
#pragma unroll
                for (int t = (s > 30 ? s - 30 : 0); t <= (s < 15 ? s : 15); ++t) { acc0[t] = fmaf(x0, w0[s - t], acc0[t]); acc1[t] = fmaf(x1, w1[s - t], acc1[t]); } }
            float rs[32];
#pragma unroll
            for (int t = 0; t < 16; ++t) { rs[2 * t] = acc0[t] + acc1[t]; rs[2 * t + 1] = acc0[t] * acc0[t] + acc1[t] * acc1[t]; }
#define RS_STEP(NKEEP, XORV) { const bool bit_ = (lane & XORV) != 0; _Pragma("unroll") for (int k_ = 0; k_ < NKEEP; ++k_) { const float snd_ = bit_ ? rs[k_] : rs[k_ + NKEEP]; const float rcv_ = __shfl_xor(snd_, XORV); rs[k_] = (bit_ ? rs[k_ + NKEEP] : rs[k_]) + rcv_; } }
            RS_STEP(16, 32) RS_STEP(8, 16) RS_STEP(4, 8) RS_STEP(2, 4) RS_STEP(1, 2)
#undef RS_STEP
            rs[0] += __shfl_xor(rs[0], 1);
            __syncthreads();
            if ((lane & 1) == 0) part[wave * 32 + (lane >> 1)] = rs[0];
            __syncthreads();
            if (tid < 16) { float s1 = 0.f, s2 = 0.f;
#pragma unroll
                for (int w = 0; w < 8; ++w) { s1 += part[w * 32 + 2 * tid]; s2 += part[w * 32 + 2 * tid + 1]; }
                const float mean = s1 * (1.f / 1024.f); const float var = fmaxf(s2 * (1.f / 1024.f) - mean * mean, 0.f); st[2 * tid] = mean; st[2 * tid + 1] = rsqrtf(var + LN_EPS); }
            __syncthreads();
#pragma unroll
            for (int t = 0; t < 16; ++t) { const float mean = st[2 * t], rstd = st[2 * t + 1];
                const float y0 = (acc0[t] - mean) * rstd * g0 + be0, y1 = (acc1[t] - mean) * rstd * g1 + be1;
                *(unsigned*)(V + (rb0 + t0 + hh * 16 + t) * 1024 + c0) = pk2(y0 * sigm(y0), y1 * sigm(y1)); }
        }
    }
}

namespace hg {
using bf16x8 = __attribute__((ext_vector_type(8))) short;
using s16x4  = __attribute__((ext_vector_type(4))) short;
using f32x16 = __attribute__((ext_vector_type(16))) float;
using u32x4  = __attribute__((ext_vector_type(4))) unsigned;
constexpr int RS = 272;
constexpr int VS = 80;
constexpr int T_Q = 0, T_KO = 32 * RS, T_KE = 64 * RS, T_D = 96 * RS, IMG_BYTES = T_D + 512, T_V = IMG_BYTES, TILE_BYTES = T_V + 32 * VS;
constexpr int OFF_TILES = 1024, NTB = 3, OFF_OPART = OFF_TILES + NTB * TILE_BYTES, OPART_BYTES = 4 * 4096;
static_assert(OFF_OPART + 2 * OPART_BYTES <= 131072 && IMG_BYTES % 16 == 0 && IMG_BYTES / 16 == 1664, "hgrn lds");
constexpr int P_RAW = 1024, R_Q = 0, R_F = 32 * RS, RAW_BYTES = 64 * RS, P_IMG = P_RAW + RAW_BYTES;
constexpr int NCHUNK = TPB / 32, NCHAIN = NB * 4 * 2, NITEM = NCHAIN * NCHUNK;
__device__ __forceinline__ int crow(int r, int hi) { return (r & 3) + 8 * (r >> 2) + 4 * hi; }
__device__ __forceinline__ s16x4 tr_read(unsigned addr) { s16x4 r; asm volatile("ds_read_b64_tr_b16 %0, %1" : "=&v"(r) : "v"(addr) : "memory"); return r; }
__device__ __forceinline__ bf16x8 cat8(s16x4 l, s16x4 h) { return (bf16x8){l[0], l[1], l[2], l[3], h[0], h[1], h[2], h[3]}; }
__device__ __forceinline__ bf16x8 pack8(const f32x16& x, int base) {
    u32x4 w; w[0] = pk2(x[base + 0], x[base + 1]); w[1] = pk2(x[base + 2], x[base + 3]); w[2] = pk2(x[base + 4], x[base + 5]); w[3] = pk2(x[base + 6], x[base + 7]);
    return *reinterpret_cast<bf16x8*>(&w);
}
}


#define HG_TOKP(dir, n) ((dir) ? ((n) < CTXL ? (CTXL - 1 - (n)) : (TPB + CTXL - 1 - (n))) : (n))
#define HG_DPP1(x, ctrl, rmask) __int_as_float(__builtin_amdgcn_update_dpp(0x3f800000, __float_as_int(x), ctrl, rmask, 0xf, false))
#define HG_DPP(x, ctrl, rmask) __int_as_float(__builtin_amdgcn_update_dpp(0, __float_as_int(x), ctrl, rmask, 0xf, false))
__device__ __forceinline__ void hgrn_prep_items(const Args& a, LAS unsigned char* lds, int tid) {
    using namespace hg;
    const bf16* Z = (const bf16*)(a.ws + WS_Z);
    unsigned char* HT = a.ws + WS_HT;
    const int wave = __builtin_amdgcn_readfirstlane(tid >> 6), lane = tid & 63, t = lane & 31, half = lane >> 5;
    const int c0 = 16 * wave + 8 * half;
    const int lr = tid >> 4, lch = tid & 15;
    LAS float* lbt = (LAS float*)lds;
    constexpr int P_RAW2 = 2048, P_IMG2 = P_RAW2 + 2 * RAW_BYTES;
    static_assert(P_IMG2 + 2 * IMG_BYTES <= 131072, "prep lds");
    __syncthreads();
    { const float l0 = a.in[I_LBL][tid], l1 = a.in[I_LBL][512 + tid], l2 = a.in[I_LBL][1024 + tid]; const float m = fmaxf(l0, fmaxf(l1, l2));
      const float e0 = __expf(l0 - m), e1 = __expf(l1 - m), e2 = __expf(l2 - m); lbt[tid] = e0 / (e0 + e1 + e2); }
    bf16x8 gq, gf;
#define HP_LOAD(it) do { const int ch_ = (it) % NCHUNK, cn_ = (it) / NCHUNK, dir_ = cn_ & 1, hd_ = (cn_ >> 1) & 3, b_ = cn_ >> 3; \
        const bf16* zr_ = Z + ((size_t)b_ * TPB + HG_TOKP(dir_, 32 * ch_ + lr)) * ZC; gq = *(const bf16x8*)(zr_ + ZHQ + hd_ * 128 + lch * 8); gf = *(const bf16x8*)(zr_ + (dir_ ? ZHB : ZHF) + hd_ * 128 + lch * 8); } while (0)
#define HP_STASH(bufi) do { LAS unsigned char* rb_ = lds + P_RAW2 + (bufi) * RAW_BYTES; *(LAS bf16x8*)(rb_ + R_Q + lr * RS + lch * 16) = gq; *(LAS bf16x8*)(rb_ + R_F + lr * RS + lch * 16) = gf; } while (0)
#define HP_COPYOUT(item, bufi) do { v4u* dst_ = (v4u*)(HT + (size_t)(item) * IMG_BYTES); const LAS v4u* src_ = (const LAS v4u*)(lds + P_IMG2 + (bufi) * IMG_BYTES); \
        dst_[tid] = src_[tid]; dst_[tid + 512] = src_[tid + 512]; dst_[tid + 1024] = src_[tid + 1024]; if (tid < 128) dst_[tid + 1536] = src_[tid + 1536]; } while (0)
    const int G = gridDim.x;
    int it = blockIdx.x, par = 0;
    if (it < NITEM) { HP_LOAD(it); HP_STASH(0); }
    if (it + G < NITEM) HP_LOAD(it + G);
    __syncthreads();
    for (; it < NITEM; it += G, par ^= 1) {
        if (it + G < NITEM) HP_STASH(par ^ 1);
        if (it != (int)blockIdx.x) HP_COPYOUT(it - G, par ^ 1);
        if (it + 2 * G < NITEM) HP_LOAD(it + 2 * G);
        const int hd = ((it / NCHUNK) >> 1) & 3;
        {
            const LAS unsigned char* rb_ = lds + P_RAW2 + par * RAW_BYTES;
            const bf16x8 RQ = *(const LAS bf16x8*)(rb_ + R_Q + t * RS + c0 * 2), RF = *(const LAS bf16x8*)(rb_ + R_F + t * RS + c0 * 2);
            const f32x4 lbA = *(const LAS f32x4*)(lbt + hd * 128 + c0), lbB = *(const LAS f32x4*)(lbt + hd * 128 + c0 + 4);
            LAS unsigned char* tb_ = lds + P_IMG2 + par * IMG_BYTES;
            float bb_[8], kk_[8];
#pragma unroll
            for (int i_ = 0; i_ < 8; ++i_) { const float lb_ = i_ < 4 ? lbA[i_] : lbB[i_ - 4]; const float f_ = lb_ + (1.f - lb_) * __builtin_amdgcn_rcpf(1.f + __expf(-bf2f((unsigned short)RF[i_]))); kk_[i_] = 1.f - f_; bb_[i_] = f_; }
#pragma unroll
            for (int i_ = 0; i_ < 8; ++i_) { float x_ = bb_[i_]; x_ *= HG_DPP1(x_, 0x111, 0xf); x_ *= HG_DPP1(x_, 0x112, 0xf); x_ *= HG_DPP1(x_, 0x114, 0xf); x_ *= HG_DPP1(x_, 0x118, 0xf);
                x_ *= HG_DPP1(x_, 0x142, 0xa); bb_[i_] = x_; }
            float qi_[8], ko_[8], ke_[8], dd_[8];
#pragma unroll
            for (int i_ = 0; i_ < 8; ++i_) { const int bi_ = __float_as_int(bb_[i_]); dd_[i_] = __int_as_float(half ? __builtin_amdgcn_readlane(bi_, 63) : __builtin_amdgcn_readlane(bi_, 31));
                const float e_ = bb_[i_]; const float ei_ = __builtin_amdgcn_rcpf(e_);
                qi_[i_] = bf2f((unsigned short)RQ[i_]) * e_; ko_[i_] = kk_[i_] * ei_; ke_[i_] = kk_[i_] * (dd_[i_] * ei_); }
            *(LAS v4u*)(tb_ + T_Q + t * RS + c0 * 2) = (v4u){pk2(qi_[0], qi_[1]), pk2(qi_[2], qi_[3]), pk2(qi_[4], qi_[5]), pk2(qi_[6], qi_[7])};
            *(LAS v4u*)(tb_ + T_KO + t * RS + c0 * 2) = (v4u){pk2(ko_[0], ko_[1]), pk2(ko_[2], ko_[3]), pk2(ko_[4], ko_[5]), pk2(ko_[6], ko_[7])};
            *(LAS v4u*)(tb_ + T_KE + t * RS + c0 * 2) = (v4u){pk2(ke_[0], ke_[1]), pk2(ke_[2], ke_[3]), pk2(ke_[4], ke_[5]), pk2(ke_[6], ke_[7])};
            if (t == 31) { *(LAS f32x4*)(tb_ + T_D + c0 * 4) = (f32x4){dd_[0], dd_[1], dd_[2], dd_[3]}; *(LAS f32x4*)(tb_ + T_D + c0 * 4 + 16) = (f32x4){dd_[4], dd_[5], dd_[6], dd_[7]}; }
            if (tid < 32) *(LAS v4u*)(tb_ + T_Q + tid * RS + 256) = (v4u){0u, 0u, 0u, 0u};
            else if (tid < 64) *(LAS v4u*)(tb_ + T_KO + (tid - 32) * RS + 256) = (v4u){0u, 0u, 0u, 0u};
            else if (tid < 96) *(LAS v4u*)(tb_ + T_KE + (tid - 64) * RS + 256) = (v4u){0u, 0u, 0u, 0u};
        }
        __syncthreads();
    }
    if (it - G >= (int)blockIdx.x && it - G < NITEM) HP_COPYOUT(it - G, par ^ 1);
    __syncthreads();
#undef HP_COPYOUT
#undef HP_LOAD
#undef HP_STASH
}

__device__ __forceinline__ void hgrn_unit_mfma(const Args& a, int unit, LAS unsigned char* lds, int tid) {
    using namespace hg;
    const int b = unit >> 5, head = (unit >> 3) & 3, dir = (unit >> 2) & 1, sl = unit & 3;
    const bf16* Z = (const bf16*)(a.ws + WS_Z);
    const unsigned char* HT = a.ws + WS_HT + (size_t)((b * 4 + head) * 2 + dir) * NCHUNK * IMG_BYTES;
    bf16* Od = (bf16*)(a.ws + (dir ? WS_OB : WS_OF));
    const int wave = __builtin_amdgcn_readfirstlane(tid >> 6), lane = tid & 63;
    const size_t zb = (size_t)b * TPB;
    constexpr int NCH = NCHUNK;
    const int vr = (tid >> 2) & 31, vp = tid & 3, lvcol = ZHI + head * 128 + sl * 32 + vp * 8, i3 = 1536 + (tid & 127);
    v4u gA0, gA1, gA2, gA3, gB0, gB1, gB2, gB3; bf16x8 gAv, gBv;
#define HG_LOAD(g0, g1, g2, g3, gv, ch) do { const int c_ = (ch) < NCH ? (ch) : NCH - 1; const v4u* src_ = (const v4u*)(HT + (size_t)c_ * IMG_BYTES); \
        g0 = src_[tid]; g1 = src_[tid + 512]; g2 = src_[tid + 1024]; g3 = src_[i3]; gv = *(const bf16x8*)(Z + (zb + HG_TOKP(dir, 32 * c_ + vr)) * ZC + lvcol); } while (0)
#define HG_STASH(g0, g1, g2, g3, gv, bufi) do { LAS unsigned char* tb_ = lds + OFF_TILES + (bufi) * TILE_BYTES; LAS v4u* d_ = (LAS v4u*)tb_; \
        d_[tid] = g0; d_[tid + 512] = g1; d_[tid + 1024] = g2; if (tid < 128) { d_[tid + 1536] = g3; *(LAS bf16x8*)(tb_ + T_V + vr * VS + vp * 16) = gv; } } while (0)
    const int r32 = lane & 31, hi = lane >> 5, g1 = (lane >> 4) & 1, q4 = (lane & 15) >> 2, p4 = lane & 3, cb = 32 * wave;
    const unsigned lbase = (unsigned)(uintptr_t)lds;
    f32x16 S = {};
    HG_LOAD(gA0, gA1, gA2, gA3, gAv, 0); HG_STASH(gA0, gA1, gA2, gA3, gAv, 0); HG_LOAD(gA0, gA1, gA2, gA3, gAv, 1); HG_STASH(gA0, gA1, gA2, gA3, gAv, 1);
    HG_LOAD(gA0, gA1, gA2, gA3, gAv, 2);
    __syncthreads();
#define HG_RD64(dst, addr, OFFS) asm volatile("ds_read_b64 %0, %1 offset:" #OFFS : "=&v"(dst) : "v"(addr) : "memory")
#define HG_MFMA_STAGE(n, bufi) do { \
            const unsigned tb = lbase + OFF_TILES + (bufi) * TILE_BYTES; const LAS unsigned char* tl_ = lds + OFF_TILES + (bufi) * TILE_BYTES; \
            bf16x8 ko[2], qi[2]; s16x4 pvl[2], pvh[2], pql[2], pqh[2], kl[2], kh[2], nvl[2], nvh[2]; f32x4 dsc[4]; \
            _Pragma("unroll") for (int kk = 0; kk < 2; ++kk) { ko[kk] = *(const LAS bf16x8*)(tl_ + T_KO + r32 * RS + (cb + 16 * kk + 8 * hi) * 2); qi[kk] = *(const LAS bf16x8*)(tl_ + T_Q + r32 * RS + (cb + 16 * kk + 8 * hi) * 2); } \
            _Pragma("unroll") for (int sp = 0; sp < 2; ++sp) { \
                const unsigned va = tb + T_V + (16 * sp + 4 * hi + q4) * VS + (16 * g1 + 4 * p4) * 2; pvl[sp] = tr_read(va); pvh[sp] = tr_read(va + 8 * VS);              \
                const unsigned qa = tb + T_Q + r32 * RS + (cb + 16 * sp + 4 * hi) * 2; HG_RD64(pql[sp], qa, 0); HG_RD64(pqh[sp], qa, 16);                                  \
                const unsigned ka = tb + T_KE + (16 * sp + 8 * hi + q4) * RS + (cb + 16 * g1 + 4 * p4) * 2; kl[sp] = tr_read(ka); kh[sp] = tr_read(ka + 4 * RS);        \
                const unsigned vb = tb + T_V + (16 * sp + 8 * hi + q4) * VS + (16 * g1 + 4 * p4) * 2; nvl[sp] = tr_read(vb); nvh[sp] = tr_read(vb + 4 * VS); }            \
            _Pragma("unroll") for (int g = 0; g < 4; ++g) dsc[g] = *(const LAS f32x4*)(tl_ + T_D + (cb + 8 * g + 4 * hi) * 4); \
            asm volatile("s_waitcnt lgkmcnt(0)" ::: "memory"); __builtin_amdgcn_sched_barrier(0); \
            f32x16 X = {}; \
            X = __builtin_amdgcn_mfma_f32_32x32x16_bf16(ko[0], qi[0], X, 0, 0, 0); X = __builtin_amdgcn_mfma_f32_32x32x16_bf16(ko[1], qi[1], X, 0, 0, 0); \
            f32x16 O = {}; \
            O = __builtin_amdgcn_mfma_f32_32x32x16_bf16(cat8(pql[0], pqh[0]), pack8(S, 0), O, 0, 0, 0); O = __builtin_amdgcn_mfma_f32_32x32x16_bf16(cat8(pql[1], pqh[1]), pack8(S, 8), O, 0, 0, 0); \
            _Pragma("unroll") for (int i = 0; i < 16; ++i) S[i] *= dsc[i >> 2][i & 3]; \
            S = __builtin_amdgcn_mfma_f32_32x32x16_bf16(cat8(kl[0], kh[0]), cat8(nvl[0], nvh[0]), S, 0, 0, 0); S = __builtin_amdgcn_mfma_f32_32x32x16_bf16(cat8(kl[1], kh[1]), cat8(nvl[1], nvh[1]), S, 0, 0, 0); \
            _Pragma("unroll") for (int i = 0; i < 16; ++i) X[i] = (crow(i, hi) <= r32) ? X[i] : 0.f; \
            O = __builtin_amdgcn_mfma_f32_32x32x16_bf16(pack8(X, 0), cat8(pvl[0], pvh[0]), O, 0, 0, 0); O = __builtin_amdgcn_mfma_f32_32x32x16_bf16(pack8(X, 8), cat8(pvl[1], pvh[1]), O, 0, 0, 0); \
            LAS float* op = (LAS float*)(lds + OFF_OPART + ((n) & 1) * OPART_BYTES + wave * 4096); \
            _Pragma("unroll") for (int i = 0; i < 16; ++i) op[crow(i, hi) * 32 + r32] = O[i]; } while (0)
#define HG_OUT_STAGE(n) do { \
            const int l2 = tid - 256, tt = l2 >> 3, vq = l2 & 7; \
            const LAS float* op = (const LAS float*)(lds + OFF_OPART + (((n) - 1) & 1) * OPART_BYTES) + tt * 32 + vq * 4; \
            const f32x4 s = (*(const LAS f32x4*)op + *(const LAS f32x4*)(op + 1024)) + (*(const LAS f32x4*)(op + 2048) + *(const LAS f32x4*)(op + 3072)); \
            const int p = HG_TOKP(dir, 32 * ((n) - 1) + tt); \
            if (p >= CTXL) *(v2u*)(Od + (zb + p) * 512 + head * 128 + sl * 32 + vq * 4) = (v2u){pk2(s[0], s[1]), pk2(s[2], s[3])}; } while (0)
#define HG_ITER(n, L0, L1, L2, L3, LV, S0, S1, S2, S3, SV) do { \
        HG_LOAD(L0, L1, L2, L3, LV, (n) + 3); \
        if (wave < 4) { HG_MFMA_STAGE(n, bcur); } else if ((n) > 0) { HG_OUT_STAGE(n); } \
        { const int bst_ = bcur == 0 ? 2 : bcur - 1; HG_STASH(S0, S1, S2, S3, SV, bst_); } \
        bcur = bcur == 2 ? 0 : bcur + 1; \
        __syncthreads(); } while (0)
    int bcur = 0;
    for (int n = 0; n < NCH; n += 2) {
        HG_ITER(n, gB0, gB1, gB2, gB3, gBv, gA0, gA1, gA2, gA3, gAv);
        HG_ITER(n + 1, gA0, gA1, gA2, gA3, gAv, gB0, gB1, gB2, gB3, gBv);
    }
    if (wave >= 4) { HG_OUT_STAGE(NCH); }
    __syncthreads();
#undef HG_MFMA_STAGE
#undef HG_OUT_STAGE
#undef HG_ITER
#undef HG_LOAD
#undef HG_STASH
#undef HG_RD64
}

__device__ __forceinline__ bool in_range(int lo, int hi, int k) { asm volatile("" : "+s"(lo), "+s"(hi)); return lo <= k && k < hi; }
constexpr int NPHASES = 21;
__global__ void __launch_bounds__(NTHR, 2) fwd_kernel(Args args) {
    extern __shared__ __attribute__((aligned(16))) unsigned char lds_raw[];
    LAS unsigned char* lds = (LAS unsigned char*)lds_raw;
    const int G = gridDim.x;
#define FRESH() int tid = threadIdx.x; asm volatile("" : "+v"(tid)); const int lane = tid & 63, wave = __builtin_amdgcn_readfirstlane(tid >> 6); (void)lane; (void)wave
    unsigned char* ws = args.ws;
    if (threadIdx.x < 16) ((LAS unsigned*)(lds + LDS_BAR_OFF))[threadIdx.x] = 0u;
    __syncthreads();
    XcdBarrier bar = xcd_barrier_post((unsigned*)(ws + WS_CTL), (volatile LAS unsigned*)(lds + LDS_BAR_OFF));
    const int lo = args.ph_lo, hi = args.ph_hi;
#define IN(k) in_range(lo, hi, (k))
#define NREP(k) (((PROBE_MASK >> (k)) & 1u) ? 2 : 1)
#define REPEAT(k) for (int rep_ = 0; rep_ < NREP(k); ++rep_) if (rep_ == 0 || (xcd_barrier(bar), true))
#define SEAM(k) do { if (IN(k) && IN((k) + 1)) xcd_barrier(bar); } while (0)
    bf16* const BX = (bf16*)(ws + WS_X); bf16* const BY = (bf16*)(ws + WS_Y);
    const float* const MODV = (const float*)(ws + WS_MODV);

#if defined(PROBE_BARS)
    for (int pbi = 0; pbi < PROBE_BARS; ++pbi) xcd_barrier(bar);
#endif
    if (IN(0)) REPEAT(0) { FRESH(); phase_prologue(args, lds, tid, lane, wave); } SEAM(0);
    if (IN(1)) REPEAT(1) { FRESH(); phase_mod0(args, lane, wave); } SEAM(1);
    if (IN(2)) REPEAT(2) {
        pg8::Gemm g{BX, (const bf16*)(ws + WS_WIN), NTOK, ZC, 1024}; pg8::AllOrder S; S.init(NTOK / 256, ZC / 256, G, (int)blockIdx.x);
        pg8::EpiBf16<0> E{(bf16*)(ws + WS_Z), ZC, nullptr, 0, 0, 1.f};
        pg8::gemm_phase<pg8::EpiBf16<0>, pg8::AllOrder, PG8_ALIGN, PG8_SP2>(lds, g, S, E);
    } SEAM(2);
    if (IN(3)) REPEAT(3) { FRESH(); phase_norm0(args, lane, wave); hgrn_prep_items(args, lds, tid); } SEAM(3);
    if (IN(4)) REPEAT(4) {
        { pg8::Gemm g{(const bf16*)(ws + WS_CQN), (const bf16*)(ws + WS_WUQ), NTOK, 768, 384}; pg8::LatOrder S; S.init(128, 3, G, (int)blockIdx.x);
          pg8::EpiBf16<0> E{(bf16*)(ws + WS_Q), 768, nullptr, 0, 0, 1.f};
          pg8::gemm_phase<pg8::EpiBf16<0>, pg8::LatOrder, PG8_ALIGN, PG8_SP2>(lds, g, S, E); }
        __syncthreads();
        { pg8::Gemm g{(const bf16*)(ws + WS_CKVN), (const bf16*)(ws + WS_WUKV), NTOK, 1024, 256}; pg8::AllOrder S; S.init(NTOK / 256, 4, G, (int)blockIdx.x);
          pg8::EpiBf16<0> E{(bf16*)(ws + WS_KV), 1024, nullptr, 0, 0, 1.f};
          pg8::gemm_phase<pg8::EpiBf16<0>, pg8::AllOrder, PG8_ALIGN, PG8_SP2>(lds, g, S, E); }
    } SEAM(4);
    if (IN(5)) {
        REPEAT(21) { FRESH();
        for (int u = blockIdx.x; u < 256; u += G) { __syncthreads(); hgrn_unit_mfma(args, (G == 256) ? ((u & 7) * 32 + (u >> 3)) : u, lds, tid); } }
        const bf16* Q = (const bf16*)(ws + WS_Q); const bf16* KV = (const bf16*)(ws + WS_KV); const bf16* KRR = (const bf16*)(ws + WS_KRR);
        const float* rope = (const float*)(ws + WS_ROPE);
        const int cslot = (G == 256) ? ((((int)blockIdx.x & 7) * 2 + (((int)blockIdx.x >> 3) >> 4)) % 5) : 0;
        REPEAT(22) {
        int ai = 0;
        for (int slot = 0; slot < 5; ++slot) {
            if (slot == cslot) { if (rep_ == 0) { FRESH(); __syncthreads(); convert_moe_share(args, lds, lane, wave); } continue; }
            for (int u = (G == 256) ? (int)blockIdx.x + ai * 256 : (int)blockIdx.x; u < ((G == 256) ? (int)blockIdx.x + ai * 256 + 1 : (ai == 0 ? 1024 : 0)); u += G) {
                int b, h, qb; if (G == 256) { const int x = (int)blockIdx.x & 7, j = (int)blockIdx.x >> 3, pr = (u >> 8) * 16 + 2 * x + (j >> 4); b = pr >> 3; h = pr & 7; qb = j & 15; } else { b = u >> 7; h = (u >> 4) & 7; qb = u & 15; }
                const size_t kb = (size_t)b * TPB, q0 = kb + CTXL + (size_t)qb * 256;
                __syncthreads();
                att::attn_unit(Q + q0 * 768 + h * 96, KV + kb * 1024 + h * 64, KRR + kb * 32, BY + q0 * 1024 + h * 64, rope + (size_t)qb * 256 * 32, TPB, (char*)lds_raw);
            }
            ++ai;
        }
        }
    } SEAM(5);
    if (IN(6)) REPEAT(6) { FRESH(); phase_readout(args, lane, wave); } SEAM(6);
    if (IN(7)) REPEAT(7) {
        pg8::Gemm g{BY, (const bf16*)(ws + WS_WOUT), NTOK, 1024, 1024}; pg8::LatOrder S; S.init(128, 4, G, (int)blockIdx.x);
        pg8::EpiRes E{args.in[I_X], (const float*)(ws + WS_H), (bf16*)(ws + WS_PRE), MODV, nullptr};
        pg8::gemm_phase<pg8::EpiRes, pg8::LatOrder, PG8_ALIGN, PG8_SP2>(lds, g, S, E);
    } SEAM(7);
    for (int l = 0; l < 2; ++l) {
        if (l == 1) {
            if (IN(13)) REPEAT(13) {
                pg8::Gemm g{BY, (const bf16*)(ws + WS_WPW1), NTOK, 2048, 1024}; pg8::LatOrder S; S.init(128, 8, G, (int)blockIdx.x);
                pg8::EpiGate<0> E{BX, (const float*)(ws + WS_PW1B), 8, 1.f, 1.f};
                pg8::gemm_phase<pg8::EpiGate<0>, pg8::LatOrder, PG8_ALIGN, PG8_SP2>(lds, g, S, E);
            } SEAM(13);
            if (IN(14)) REPEAT(14) { FRESH(); phase_conv(args, lds, tid, lane, wave); } SEAM(14);
            if (IN(15)) REPEAT(15) {
                pg8::Gemm g{BY, (const bf16*)(ws + WS_WPW2), NTOK, 1024, 1024}; pg8::LatOrder S; S.init(128, 4, G, (int)blockIdx.x);
                pg8::EpiRes E{nullptr, (const float*)(ws + WS_H), (bf16*)(ws + WS_PRE), MODV + 9 * 6144, args.in[I_PW2B]};
                pg8::gemm_phase<pg8::EpiRes, pg8::LatOrder, PG8_ALIGN, PG8_SP2>(lds, g, S, E);
            } SEAM(15);
        }
        const int pb = l ? 16 : 8;
        if (IN(pb)) REPEAT(pb) { FRESH(); phase_ln1(args, l, lds, tid, lane, wave); } SEAM(pb);
        if (IN(pb + 2) || IN(pb + 3)) {
            LAS int* tl = (LAS int*)(lds + LDS_TILE_E);
            FRESH();
            __syncthreads();
            if (tid < 32) tl[3 * MAXTILES + 64 + tid] = ld_ctl((const int*)(ws + WS_CURSOR) + l * 32 + tid);
            __syncthreads();
            if (tid == 0) { int ts = 0; for (int e = 0; e < 32; ++e) { tl[3 * MAXTILES + e] = ts; ts += (tl[3 * MAXTILES + 64 + e] + 255) >> 8; } tl[3 * MAXTILES + 32] = ts; }
            __syncthreads();
            const int ntiles = tl[3 * MAXTILES + 32];
            for (int t = tid; t < ntiles && t < MAXTILES; t += NTHR) { int e = 0; while (e < 31 && tl[3 * MAXTILES + e + 1] <= t) ++e; const int j = t - tl[3 * MAXTILES + e], rem = tl[3 * MAXTILES + 64 + e] - 256 * j;
                tl[t] = e; tl[MAXTILES + t] = e * ECAP + 256 * j; tl[2 * MAXTILES + t] = rem < 256 ? rem : 256; }
            __syncthreads();
            if (IN(pb + 2)) REPEAT(pb + 2) {
#if defined(PROBE_STAGGER)
                if (blockIdx.x & 1) { const unsigned long long t0 = __builtin_amdgcn_s_memrealtime(); while (__builtin_amdgcn_s_memrealtime() - t0 < PROBE_STAGGER) __builtin_amdgcn_s_sleep(8); }
#endif
                pg8::Gemm g{BX, (const bf16*)(ws + WS_WGU + (size_t)l * 32 * 2048 * 1024), 0, 0, 512};
                pg8::MoeOrder S; S.init(ntiles, 8, G, (int)blockIdx.x); S.tile_e = tl; S.nper = 8;
                pg8::EpiGate<1, true> E{(bf16*)(ws + WS_ACT), (const float*)(ws + WS_BGU) + (size_t)l * 32 * 2048, 8, 1.f / (SC_X8 * SC_WGU) * PROBE_KSC, SC_ACT};
                pg8::gemm_phase<pg8::EpiGate<1, true>, pg8::MoeOrder, PG8_ALIGN, true, true, true>(lds, g, S, E, (const int*)(ws + WS_ROWS), tl + MAXTILES);
            } SEAM(pb + 2);
            if (IN(pb + 3)) REPEAT(pb + 3) {
                pg8::Gemm g{(const bf16*)(ws + WS_ACT), (const bf16*)(ws + WS_WDN + (size_t)l * 32 * 1024 * 1024), 0, 0, 512};
                pg8::MoeOrder S; S.init(ntiles, 4, G, (int)blockIdx.x); S.tile_e = tl; S.nper = 4;
                pg8::EpiDown E{(bf16*)(ws + WS_YB), args.in[I_BDN] + (size_t)l * 32 * 1024, (const float*)(ws + WS_ROWW), (const int*)(ws + WS_ROWD), 1.f / (SC_ACT * SC_WDN) * PROBE_KSC, tl + MAXTILES, SC_Y};
                pg8::gemm_phase<pg8::EpiDown, pg8::MoeOrder, PG8_ALIGN, true, false, true>(lds, g, S, E);
            } SEAM(pb + 3);
        }
        if (IN(pb + 4)) REPEAT(pb + 4) { FRESH(); phase_ln2(args, l, lane, wave); }
        if (l == 0) SEAM(12);
    }
#undef IN
#undef SEAM
}

extern "C" void kernel_launch(void* const* d_in, const int* in_sizes, int n_in, void* d_out, int out_size, void* d_ws, size_t ws_size, hipStream_t stream) {
    static int grid = 0;
    if (grid == 0) {
        if (n_in != 33 || in_sizes[0] != NB * SEQ * D || out_size != NB * SEQ * D || ws_size < WS_END) {
            fprintf(stderr, "kernel_launch: unexpected shapes: n_in %d in0 %d out %d ws %zu (need %zu)\n", n_in, n_in > 0 ? in_sizes[0] : -1, out_size, ws_size, (size_t)WS_END); grid = -1; return; }
        int dev = 0, cus = 0;
        if (hipGetDevice(&dev) != hipSuccess || hipDeviceGetAttribute(&cus, hipDeviceAttributeMultiprocessorCount, dev) != hipSuccess) { grid = -1; return; }
        if (hipFuncSetAttribute((const void*)fwd_kernel, hipFuncAttributeMaxDynamicSharedMemorySize, LDS_BYTES) != hipSuccess) { fprintf(stderr, "kernel_launch: hipFuncSetAttribute failed\n"); grid = -1; return; }
        int per_cu = 0;
        if (hipOccupancyMaxActiveBlocksPerMultiprocessor(&per_cu, (const void*)fwd_kernel, NTHR, LDS_BYTES) != hipSuccess || per_cu < 1) fprintf(stderr, "kernel_launch: occupancy query reports %d\n", per_cu);
        (void)hipGetLastError();
        grid = cus;
    }
    if (grid < 0) return;
    if (hipMemsetAsync((char*)d_ws + WS_CTL, 0, CTL_ZERO_BYTES, stream) != hipSuccess) return;
    Args a{};
    for (int i = 0; i < 33; ++i) a.in[i] = (const float*)d_in[i];
    a.out = (float*)d_out; a.ws = (unsigned char*)d_ws;
#if MK_ONE_LAUNCH
    a.ph_lo = 0; a.ph_hi = NPHASES;
    hipLaunchKernelGGL(fwd_kernel, dim3(grid), dim3(NTHR), LDS_BYTES, stream, a);
#else
    for (int ph = 0; ph < NPHASES; ++ph) { a.ph_lo = ph; a.ph_hi = ph + 1; hipLaunchKernelGGL(fwd_kernel, dim3(grid), dim3(NTHR), LDS_BYTES, stream, a); }
#endif
    const hipError_t le = hipPeekAtLastError();
    if (le != hipSuccess) fprintf(stderr, "kernel_launch: launch failed: %s\n", hipGetErrorName(le));
}
```

```cpp
#include <hip/hip_runtime.h>
#include <cstdio>
#include <cstdint>

#ifndef PROBE_MASK
#define PROBE_MASK 0u
#endif
#if defined(PROBE_K2)
#define PROBE_KSC 0.5f
#else
#define PROBE_KSC 1.0f
#endif
#ifndef MK_ONE_LAUNCH
#define MK_ONE_LAUNCH 1
#endif

namespace pg8 {
#define PG8_LAS __attribute__((address_space(3)))
typedef unsigned short bf16_t;
typedef short bf16x8 __attribute__((ext_vector_type(8)));
typedef float f32x4 __attribute__((ext_vector_type(4)));
typedef unsigned u32x4 __attribute__((ext_vector_type(4)));
constexpr int BM = 256, BK = 64, HALF = 128, HTB = HALF * BK * 2  , STAGE_BYTES = 8 * HTB, NXCD = 8, WGM = 8;

__host__ __device__ __forceinline__ int lds_byte(int r, int c) { const int st = (r >> 4) * 2 + (c >> 5), rr = r & 15, cc = c & 31, ob = rr * 64 + cc * 2; return st * 1024 + (ob ^ (((ob >> 9) & 1) << 5)); }
__host__ __device__ __forceinline__ void stage_rc(int b, int& R, int& C) { const int st = b / 1024, sb = b % 1024, swz = sb ^ (((sb >> 9) & 1) << 5); R = (st >> 1) * 16 + swz / 64; C = (st & 1) * 32 + (swz % 64) / 2; }
__host__ __device__ __forceinline__ int perm32(int rho) { const int n = rho >> 4, i = rho & 15; return 8 * (i >> 2) + 4 * n + (i & 3); }

struct Unit { int pm, pn; };
struct Gemm { const bf16_t* A; const bf16_t* Bt; int M, N, K; };

struct StaticOrder {
    int nM, nN, nwg, G, c;
    __host__ __device__ void init(int M, int N, int G_, int c_) { nM = M / BM; nN = N / BM; nwg = nM * nN; G = G_; c = c_; }
    __host__ __device__ bool next(int i, Unit& u) const {
        const long L = (long)i * G + c; if (L >= nwg) return false;
        int wgid = (int)L; { const int q = nwg / NXCD, r = nwg % NXCD, xcd = wgid % NXCD, off = wgid / NXCD; wgid = (xcd < r ? xcd * (q + 1) : r * (q + 1) + (xcd - r) * q) + off; }
        const int nig = WGM * nN, gid = wgid / nig, fm = gid * WGM, gsz = (nM - fm) < WGM ? (nM - fm) : WGM;
        u.pm = fm + ((wgid % nig) % gsz); u.pn = (wgid % nig) / gsz; return true;
    }
    __device__ __forceinline__ void a_ready(const Unit&) const {}
    __device__ __forceinline__ void done(const Unit&) const {}
};

__device__ __forceinline__ unsigned cvt_pk_bf16(float lo, float hi) { unsigned r; asm volatile("v_cvt_pk_bf16_f32 %0, %1, %2" : "=v"(r) : "v"(lo), "v"(hi)); return r; }
typedef float f32x2 __attribute__((ext_vector_type(2)));
__device__ __forceinline__ f32x2 gelu_pk(f32x2 v) {
    const f32x2 av = __builtin_elementwise_abs(v), d = av * 0.2316418882f + 1.0f;
    f32x2 t; t.x = __builtin_amdgcn_rcpf(d.x); t.y = __builtin_amdgcn_rcpf(d.y);
    f32x2 q = t * 0.5307027145f + (-0.7265760135f); q = q * t + 0.7107068705f; q = q * t + (-0.142248368f); q = q * t + 0.127414796f; q = q * t;
    const f32x2 s = (v * v) * (-0.72134752044f);
    f32x2 e; e.x = __builtin_amdgcn_exp2f(s.x); e.y = __builtin_amdgcn_exp2f(s.y);
    const f32x2 m = v * (q * e), r = v - m;
    f32x2 o; o.x = v.x < 0.f ? m.x : r.x; o.y = v.y < 0.f ? m.y : r.y; return o;
}

template <int ACT  > struct EpiBf16 {
    static constexpr bool PERM = true, AFTER_DRAIN = false; static_assert(ACT == 0 || ACT == 1, "EpiBf16: ACT is 0 (none) or 1 (gelu_pk)");
    bf16_t* O; int ldc; const float* bias; int split_cols; size_t split_stride; float scale0;
    __device__ __forceinline__ void operator()(const f32x4 (&acc)[2][2][4][2], const Unit& u, int wr, int wc, int fr, int fq) const {
        const int row0 = u.pm * BM + wr * 64 + fr; int colt = u.pn * BM; bf16_t* base = O;
        float sc = 1.f; if (split_cols) { const int t = colt / split_cols; base += (size_t)t * split_stride; colt -= t * split_cols; if (t == 0) sc = scale0; }
        const int col0 = colt + wc * 32 + 8 * fq, bcol0 = u.pn * BM + wc * 32 + 8 * fq;
        f32x4 bv[2][2];
#pragma unroll
        for (int bj = 0; bj < 2; ++bj)
#pragma unroll
            for (int n = 0; n < 2; ++n) bv[bj][n] = bias ? *(const f32x4*)(bias + bcol0 + bj * HALF + 4 * n) : (f32x4){0.f, 0.f, 0.f, 0.f};
#pragma unroll
        for (int ai = 0; ai < 2; ++ai)
#pragma unroll
            for (int m = 0; m < 4; ++m) { bf16_t* rowp = base + (size_t)(row0 + ai * HALF + m * 16) * ldc + col0;
#pragma unroll
                for (int bj = 0; bj < 2; ++bj) { f32x4 v0 = acc[ai][bj][m][0] + bv[bj][0], v1 = acc[ai][bj][m][1] + bv[bj][1];
                    if (ACT == 1) { f32x2 a = gelu_pk((f32x2){v0[0], v0[1]}), b = gelu_pk((f32x2){v0[2], v0[3]}), c = gelu_pk((f32x2){v1[0], v1[1]}), d = gelu_pk((f32x2){v1[2], v1[3]});
                        v0 = (f32x4){a.x, a.y, b.x, b.y}; v1 = (f32x4){c.x, c.y, d.x, d.y}; }
                    v0 = v0 * sc; v1 = v1 * sc; u32x4 w; w.x = cvt_pk_bf16(v0[0], v0[1]); w.y = cvt_pk_bf16(v0[2], v0[3]); w.z = cvt_pk_bf16(v1[0], v1[1]); w.w = cvt_pk_bf16(v1[2], v1[3]);
                    *(u32x4*)(rowp + bj * HALF) = w; } }
    }
};
typedef int v4i_t __attribute__((ext_vector_type(4)));
typedef int v8i_t __attribute__((ext_vector_type(8)));
__device__ __forceinline__ v8i_t cat32(bf16x8 a, bf16x8 b) { const v4i_t x = __builtin_bit_cast(v4i_t, a), y = __builtin_bit_cast(v4i_t, b); return __builtin_shufflevector(x, y, 0, 1, 2, 3, 4, 5, 6, 7); }
template <class Epi, class Sched, bool ALIGN_EPI = false, bool SP2 = false, bool GATHER = false, bool FP8 = false>
__device__ __forceinline__ void gemm_phase(PG8_LAS unsigned char* lds, const Gemm g, const Sched& S, const Epi& E, const int* rowsrc = nullptr, const PG8_LAS int* gtab = nullptr) {
    static_assert(!GATHER || SP2, "GATHER is implemented on the SP2 loop only");
    int tid_l = threadIdx.x; asm volatile("" : "+v"(tid_l));
    const int tid = tid_l, wid = __builtin_amdgcn_readfirstlane(tid >> 6), lane = tid & 63, wr = wid >> 2, wc = wid & 3, fr = lane & 15, fq = lane >> 4;
#if defined(PROBE_K2)
    const int K = g.K, nt0 = K / BK, nt = FP8 ? 2 * nt0 : nt0;
#define PG8_KT(x) (FP8 ? ((x) & (nt0 - 1)) : (x))
#else
    const int K = g.K, nt = K / BK;
#define PG8_KT(x) (x)
#endif
    unsigned voffA[2], voffB[2];
#pragma unroll
    for (int i = 0; i < 2; ++i) { int R, C; stage_rc(tid * 16 + i * 8192, R, C); const int Rb = Epi::PERM ? ((R & ~31) + perm32(R & 31)) : R;
        voffA[i] = (unsigned)(R * K + C) * 2u; voffB[i] = (unsigned)(Rb * K + C) * 2u; }
    unsigned gAc[2][2], gAn[2][2]; int gR[2]; unsigned gC[2];
#pragma unroll
    for (int i = 0; i < 2; ++i) { int R, C; stage_rc(tid * 16 + i * 8192, R, C); gR[i] = R; gC[i] = (unsigned)C * 2u; gAc[0][i] = gAc[1][i] = gAn[0][i] = gAn[1][i] = 0u; }
#define PG8_GATHER(u_, o_) do { const int gtb_ = gtab[(u_).pm], gtc_ = gtab[576 + (u_).pm];     \
        _Pragma("unroll") for (int h_ = 0; h_ < 2; ++h_) _Pragma("unroll") for (int i_ = 0; i_ < 2; ++i_) \
        { const int rl_ = h_ * HALF + gR[i_]; const int src_ = rl_ < gtc_ ? rowsrc[gtb_ + rl_] : 0; o_[h_][i_] = (unsigned)src_ * (unsigned)(K * 2) + gC[i_]; } } while (0)
#define PG8_STAGE_A(bufoff, orig_gbase, NEXTSEL, H, KOFF) do { if constexpr (GATHER) { unsigned vo_[2]; vo_[0] = (NEXTSEL) ? gAn[H][0] : gAc[H][0]; vo_[1] = (NEXTSEL) ? gAn[H][1] : gAc[H][1]; \
        PG8_STAGE(bufoff, (const char*)g.A + (KOFF), vo_); } else { PG8_STAGE(bufoff, orig_gbase, voffA); } } while (0)
    const size_t kstep = (size_t)(BK * 2);
    const size_t hstep = (size_t)HALF * K * 2;
    const size_t tstep = 2 * hstep;
    const unsigned ldsw = (unsigned)wid * 1024u;
    const int aoff = lds_byte(wr * 64 + fr, fq * (FP8 ? 16 : 8)), boff = lds_byte(wc * 32 + fr, fq * (FP8 ? 16 : 8));
#define PG8_SA(b, h) (((b) * 2 + (h)) * HTB)
#define PG8_SB(b, h) ((4 + (b) * 2 + (h)) * HTB)
#define PG8_STAGE(bufoff, gbase, voff) do { _Pragma("unroll") for (int _i = 0; _i < 2; ++_i) \
        __builtin_amdgcn_global_load_lds((const unsigned*)((const char*)(gbase) + (voff)[_i]), (PG8_LAS unsigned*)(lds + (bufoff) + ldsw + _i * 8192), 16, 0, 0); } while (0)
#define PG8_LD32(var, addr) do { const bf16x8 lo_ = *(const PG8_LAS bf16x8*)(addr); const bf16x8 hi_ = *(const PG8_LAS bf16x8*)((addr) + 16); var = cat32(lo_, hi_); } while (0)
#define PG8_LDA(dst, b, h) do { if constexpr (FP8) { _Pragma("unroll") for (int m = 0; m < 4; ++m) PG8_LD32(dst##8[m], lds + PG8_SA(b, h) + aoff + m * 2048); } \
        else { _Pragma("unroll") for (int m = 0; m < 4; ++m) _Pragma("unroll") for (int k = 0; k < 2; ++k) dst[m][k] = *(const PG8_LAS bf16x8*)(lds + PG8_SA(b, h) + aoff + m * 2048 + k * 1024); } } while (0)
#define PG8_LDB(dst, b, h) do { if constexpr (FP8) { _Pragma("unroll") for (int n = 0; n < 2; ++n) PG8_LD32(dst##8[n], lds + PG8_SB(b, h) + boff + n * 2048); } \
        else { _Pragma("unroll") for (int n = 0; n < 2; ++n) _Pragma("unroll") for (int k = 0; k < 2; ++k) dst[n][k] = *(const PG8_LAS bf16x8*)(lds + PG8_SB(b, h) + boff + n * 2048 + k * 1024); } } while (0)
#define PG8_MMA(ai, bj, At, Bt) do { __builtin_amdgcn_s_setprio(1); \
        if constexpr (FP8) { _Pragma("unroll") for (int m = 0; m < 4; ++m) _Pragma("unroll") for (int n = 0; n < 2; ++n) \
            asm volatile("v_mfma_scale_f32_16x16x128_f8f6f4 %0, %1, %2, %0, %3, %3 op_sel_hi:[0,0,0]" : "+v"(acc[ai][bj][m][n]) : "v"(Bt##8[n]), "v"(At##8[m]), "v"(sc127)); } \
        else { _Pragma("unroll") for (int m = 0; m < 4; ++m) _Pragma("unroll") for (int n = 0; n < 2; ++n) _Pragma("unroll") for (int k = 0; k < 2; ++k) \
            acc[ai][bj][m][n] = __builtin_amdgcn_mfma_f32_16x16x32_bf16(Bt[n][k], At[m][k], acc[ai][bj][m][n], 0, 0, 0); } \
        __builtin_amdgcn_s_setprio(0); } while (0)
#define PG8_WAIT_V(n) asm volatile("s_waitcnt vmcnt(" #n ")" ::: "memory")
#define PG8_WAIT_L(n) asm volatile("s_waitcnt lgkmcnt(" #n ")" ::: "memory")
#define PG8_BAR __builtin_amdgcn_s_barrier()
#define PG8_SCHED __builtin_amdgcn_sched_barrier(0)
    Unit cur, nxt; int ui = 0;
    if (!S.next(0, cur)) return;
    f32x4 acc[2][2][4][2];
#pragma unroll
    for (int a = 0; a < 2; ++a)
#pragma unroll
        for (int b = 0; b < 2; ++b)
#pragma unroll
            for (int m = 0; m < 4; ++m)
#pragma unroll
                for (int n = 0; n < 2; ++n) acc[a][b][m][n] = (f32x4){0.f, 0.f, 0.f, 0.f};
    int sc127 = 0x7f7f7f7f; asm volatile("" : "+v"(sc127));
    bf16x8 At[4][2], B0[2][2], B1[2][2]; v8i_t At8[4], B08[2], B18[2]; (void)At; (void)B0; (void)B1; (void)At8; (void)B08; (void)B18;
    const char* cA = (const char*)g.A + (size_t)cur.pm * tstep; const char* cB = (const char*)g.Bt + (size_t)cur.pn * tstep;
    S.a_ready(cur);
    if constexpr (GATHER) { PG8_GATHER(cur, gAc); }
    if constexpr (SP2) {
        PG8_STAGE(PG8_SB(0, 0), cB, voffB); PG8_STAGE(PG8_SB(0, 1), cB + hstep, voffB); PG8_STAGE_A(PG8_SA(0, 0), cA, false, 0, (size_t)0); PG8_STAGE_A(PG8_SA(0, 1), cA + hstep, false, 1, (size_t)0);
        if (wr == 1) PG8_BAR;
        PG8_WAIT_V(2); PG8_BAR;
        PG8_STAGE(PG8_SB(1, 0), cB + kstep, voffB); PG8_STAGE_A(PG8_SA(1, 0), cA + kstep, false, 0, kstep); PG8_STAGE(PG8_SB(1, 1), cB + hstep + kstep, voffB);
        PG8_WAIT_V(6); PG8_BAR;
    } else {
        PG8_STAGE(PG8_SB(0, 0), cB, voffB); PG8_STAGE(PG8_SA(0, 0), cA, voffA); PG8_STAGE(PG8_SB(0, 1), cB + hstep, voffB); PG8_STAGE(PG8_SA(0, 1), cA + hstep, voffA);
        if (wr == 1) PG8_BAR;
        PG8_WAIT_V(4); PG8_BAR;
        PG8_STAGE(PG8_SB(1, 0), cB + kstep, voffB); PG8_STAGE(PG8_SA(1, 0), cA + kstep, voffA); PG8_STAGE(PG8_SB(1, 1), cB + hstep + kstep, voffB);
        PG8_WAIT_V(6); PG8_BAR;
    }
    for (;;) {
        const bool has_next = S.next(ui + 1, nxt);
        if constexpr (GATHER) { if (has_next) { PG8_GATHER(nxt, gAn); } else { _Pragma("unroll") for (int h_ = 0; h_ < 2; ++h_) _Pragma("unroll") for (int i_ = 0; i_ < 2; ++i_) gAn[h_][i_] = gAc[h_][i_]; } }
        const char* nA = has_next ? (const char*)g.A + (size_t)nxt.pm * tstep : cA; const char* nB = has_next ? (const char*)g.Bt + (size_t)nxt.pn * tstep : cB;
#pragma nounroll
        for (int t = 0; t < nt; t += 2) {
            const bool last = (t == nt - 2);
            const char* a1 = cA + (size_t)PG8_KT(t + 1) * kstep;
            const char* a2 = last ? nA : cA + (size_t)PG8_KT(t + 2) * kstep; const char* b2 = last ? nB : cB + (size_t)PG8_KT(t + 2) * kstep;
            const char* a3 = a2 + kstep; const char* b3 = b2 + kstep;
            const size_t k1 = (size_t)PG8_KT(t + 1) * kstep, k2 = last ? (size_t)0 : (size_t)PG8_KT(t + 2) * kstep, k3 = k2 + kstep; (void)k1; (void)k2; (void)k3;
            if (last && has_next) S.a_ready(nxt);
            if constexpr (SP2) {
            PG8_LDB(B0, 0, 0); PG8_LDB(B1, 0, 1); PG8_SCHED; PG8_LDA(At, 0, 0); PG8_STAGE_A(PG8_SA(1, 1), a1 + hstep, false, 1, k1);
            PG8_WAIT_V(8); PG8_WAIT_L(0); PG8_BAR; PG8_MMA(0, 0, At, B0); PG8_MMA(0, 1, At, B1); PG8_BAR; PG8_SCHED;
            PG8_LDA(At, 0, 1); PG8_STAGE(PG8_SB(0, 0), b2, voffB); PG8_STAGE(PG8_SB(0, 1), b2 + hstep, voffB); PG8_STAGE_A(PG8_SA(0, 0), a2, last, 0, k2);
            PG8_WAIT_V(8); PG8_WAIT_L(0); PG8_BAR; PG8_MMA(1, 0, At, B0); PG8_MMA(1, 1, At, B1); PG8_BAR; PG8_SCHED;
            PG8_LDB(B0, 1, 0); PG8_LDB(B1, 1, 1); PG8_SCHED; PG8_LDA(At, 1, 0); PG8_STAGE_A(PG8_SA(0, 1), a2 + hstep, last, 1, k2);
            PG8_WAIT_V(8); PG8_WAIT_L(0); PG8_BAR; PG8_MMA(0, 0, At, B0); PG8_MMA(0, 1, At, B1); PG8_BAR; PG8_SCHED;
            PG8_LDA(At, 1, 1); PG8_STAGE(PG8_SB(1, 0), b3, voffB); PG8_STAGE(PG8_SB(1, 1), b3 + hstep, voffB); PG8_STAGE_A(PG8_SA(1, 0), a3, last, 0, k3);
            PG8_WAIT_V(8); PG8_WAIT_L(0); PG8_BAR; PG8_MMA(1, 0, At, B0); PG8_MMA(1, 1, At, B1); PG8_BAR; PG8_SCHED;
            } else {
            PG8_LDB(B0, 0, 0); PG8_SCHED; PG8_LDA(At, 0, 0); PG8_STAGE(PG8_SA(1, 1), a1 + hstep, voffA);
            PG8_WAIT_L(8); PG8_BAR; PG8_WAIT_L(0); PG8_MMA(0, 0, At, B0); PG8_BAR; PG8_SCHED;
            PG8_LDB(B1, 0, 1); PG8_STAGE(PG8_SB(0, 0), b2, voffB);
            PG8_BAR; PG8_WAIT_L(0); PG8_MMA(0, 1, At, B1); PG8_BAR;
            PG8_LDA(At, 0, 1); PG8_STAGE(PG8_SA(0, 0), a2, voffA);
            PG8_BAR; PG8_WAIT_L(0); PG8_MMA(1, 0, At, B0); PG8_BAR; PG8_SCHED;
            PG8_STAGE(PG8_SB(0, 1), b2 + hstep, voffB);
            PG8_WAIT_V(6); PG8_BAR; PG8_MMA(1, 1, At, B1); PG8_BAR;
            PG8_LDB(B0, 1, 0); PG8_SCHED; PG8_LDA(At, 1, 0); PG8_STAGE(PG8_SA(0, 1), a2 + hstep, voffA);
            PG8_WAIT_L(8); PG8_BAR; PG8_WAIT_L(0); PG8_MMA(0, 0, At, B0); PG8_BAR; PG8_SCHED;
            PG8_LDB(B1, 1, 1); PG8_STAGE(PG8_SB(1, 0), b3, voffB);
            PG8_BAR; PG8_WAIT_L(0); PG8_MMA(0, 1, At, B1); PG8_BAR;
            PG8_LDA(At, 1, 1); PG8_STAGE(PG8_SA(1, 0), a3, voffA);
            PG8_BAR; PG8_WAIT_L(0); PG8_MMA(1, 0, At, B0); PG8_BAR; PG8_SCHED;
            PG8_STAGE(PG8_SB(1, 1), b3 + hstep, voffB);
            PG8_WAIT_V(6); PG8_BAR; PG8_MMA(1, 1, At, B1); PG8_BAR;
            }
        }
        if constexpr (ALIGN_EPI) { if (wr == 0) PG8_BAR; }
        if constexpr (FP8) { asm volatile("s_nop 15\n\ts_nop 15" ::: "memory"); }
        if constexpr (!Epi::AFTER_DRAIN) { E(acc, cur, wr, wc, fr, fq);
#if defined(PROBE_EPI2)
            if constexpr (FP8 == (PROBE_EPI2 == 1)) { E(acc, cur, wr, wc, fr, fq); }
#endif
            S.done(cur); }
        if (!has_next) break;
#pragma unroll
        for (int a = 0; a < 2; ++a)
#pragma unroll
            for (int b = 0; b < 2; ++b)
#pragma unroll
                for (int m = 0; m < 4; ++m)
#pragma unroll
                    for (int n = 0; n < 2; ++n) acc[a][b][m][n] = (f32x4){0.f, 0.f, 0.f, 0.f};
        cur = nxt; cA = nA; cB = nB; ++ui;
        if constexpr (GATHER) { _Pragma("unroll") for (int h_ = 0; h_ < 2; ++h_) _Pragma("unroll") for (int i_ = 0; i_ < 2; ++i_) gAc[h_][i_] = gAn[h_][i_]; }
        if constexpr (ALIGN_EPI) { if (wr == 1) PG8_BAR; }
    }
    PG8_WAIT_V(0);
    if constexpr (!ALIGN_EPI) { if (wr == 0) PG8_BAR; }
    PG8_BAR;
    if constexpr (Epi::AFTER_DRAIN) { E.fused(acc, cur, wr, wc, fr, fq, lds, wid, lane); S.done(cur); }
#undef PG8_SA
#undef PG8_SB
#undef PG8_STAGE
#undef PG8_STAGE_A
#undef PG8_GATHER
#undef PG8_LDA
#undef PG8_LD32
#undef PG8_LDB
#undef PG8_MMA
#undef PG8_WAIT_V
#undef PG8_WAIT_L
#undef PG8_BAR
#undef PG8_SCHED
}
}

#ifndef PG8_SP2
#define PG8_SP2 true
#endif
#ifndef PG8_ALIGN
#define PG8_ALIGN true
#endif

#define GAS __attribute__((address_space(1)))
#define LAS __attribute__((address_space(3)))
typedef unsigned short bf16;
typedef unsigned v4u __attribute__((ext_vector_type(4)));
typedef unsigned v2u __attribute__((ext_vector_type(2)));
typedef float f32x4 __attribute__((ext_vector_type(4)));
typedef short bf16x8 __attribute__((ext_vector_type(8)));

constexpr int D = 1024, NB = 8, SEQ = 4096, CTXL = 256, TPB = SEQ + CTXL, NTOK = NB * TPB, NLAT = NB * SEQ;
constexpr int ZC = 3328;
constexpr int ZQ = 0, ZKV = 384, ZKR = 640, ZHQ = 672, ZHF = 1184, ZHB = 1696, ZHI = 2208, ZHG = 2720;
constexpr int NEXP = 32;
constexpr float ALPHA = 1.4142135623730951f;
constexpr float LN_EPS = 1e-5f, RMS_EPS = 1e-6f;
constexpr int NWAVES = 8, NTHR = 512;
constexpr float SC_X8 = 16.f, SC_WGU = 64.f, SC_ACT = 8.f, SC_WDN = 128.f, SC_Y = 64.f;
constexpr int LDS_BYTES = 147456;
constexpr int LDS_BAR_OFF = LDS_BYTES - 64;
constexpr int LDS_TILE_E = 131072;
constexpr int MAXTILES = 576;

constexpr size_t MiB = 1u << 20;
constexpr size_t WS_CTL = 0, CTL_ZERO_BYTES = 16384;
constexpr size_t WS_MODV = 1 * MiB;
constexpr size_t WS_ROPE = 1 * MiB + 512 * 1024;
constexpr size_t WS_BGU = 2 * MiB;
constexpr size_t WS_PW1B = 2 * MiB + 512 * 1024;
constexpr size_t WS_BCNT = WS_PW1B + 64 * 1024;
constexpr size_t WS_TILEE = WS_BCNT + 64 * 1024;
constexpr size_t WS_META = WS_TILEE + 4096;
constexpr size_t WS_TOPI = 3 * MiB, WS_TOPW = 4 * MiB;
constexpr int ECAP = 32768;
constexpr size_t WS_ROWS = 160 * MiB, WS_ROWW = 164 * MiB, WS_ROWD = 168 * MiB;
constexpr size_t WS_CURSOR = 14336;
constexpr size_t WS_WIN = 8 * MiB, WS_WUQ = 15 * MiB, WS_WUKV = 16 * MiB, WS_WOUT = 17 * MiB, WS_WPW1 = 19 * MiB, WS_WPW2 = 23 * MiB;
constexpr size_t WS_WGU = 32 * MiB, WS_WDN = 288 * MiB;
constexpr size_t WS_H = 416 * MiB;
constexpr size_t WS_X = 552 * MiB, WS_Y = 620 * MiB;
constexpr size_t WS_BIG = 688 * MiB;
constexpr size_t WS_Z = WS_BIG, WS_CQN = WS_BIG + 221 * MiB, WS_CKVN = WS_BIG + 247 * MiB, WS_KRR = WS_BIG + 264 * MiB,
                 WS_Q = WS_BIG + 267 * MiB, WS_KV = WS_BIG + 318 * MiB, WS_OF = WS_BIG + 386 * MiB, WS_OB = WS_BIG + 454 * MiB;
constexpr size_t WS_HT = WS_BIG + 528 * MiB;
constexpr size_t WS_PRE = WS_BIG;
constexpr size_t WS_XS = WS_BIG, WS_ACT = WS_BIG + 288 * MiB, WS_YB = WS_BIG + 576 * MiB;
constexpr size_t WS_END = WS_BIG + 848 * MiB;
static_assert((size_t)NTOK * ZC * 2 <= 221 * MiB && (size_t)NTOK * 384 * 2 <= 26 * MiB && (size_t)NTOK * 256 * 2 <= 17 * MiB && (size_t)NTOK * 32 * 2 <= 3 * MiB, "ws map 1");
static_assert((size_t)NTOK * 768 * 2 <= 51 * MiB && (size_t)NTOK * 1024 * 2 <= 68 * MiB && (size_t)NTOK * 512 * 4 <= 68 * MiB, "ws map 2");
static_assert((size_t)64 * 136 * 26624 <= 320 * MiB && (size_t)MAXTILES * 256 * 2048 <= 288 * MiB && (size_t)NLAT * 4 * 2048 <= 272 * MiB && (size_t)NTOK * 1024 * 4 <= 136 * MiB, "ws map 3");

#define LDS_WAIT() asm volatile("s_waitcnt lgkmcnt(0)" ::: "memory")
#define VM_WAIT() asm volatile("s_waitcnt vmcnt(0)" ::: "memory")
__device__ __forceinline__ float bf2f(unsigned short b) { return __uint_as_float(((unsigned)b) << 16); }
__device__ __forceinline__ unsigned pk2(float lo, float hi) { return pg8::cvt_pk_bf16(lo, hi); }
__device__ __forceinline__ float sigm(float x) { return __builtin_amdgcn_rcpf(1.f + __expf(-x)); }
__device__ __forceinline__ float wave_sum(float v) {
#pragma unroll
    for (int o = 1; o < 64; o <<= 1) v += __shfl_xor(v, o);
    return v;
}
__device__ __forceinline__ int ld_ctl(const int* p) { return (int)__hip_atomic_load((const unsigned*)p, __ATOMIC_RELAXED, __HIP_MEMORY_SCOPE_AGENT); }
__device__ __forceinline__ int grow_of(int lr) { return (lr >> 12) * TPB + CTXL + (lr & 4095); }

#define XB_TMO      128
#define XB_XCNT(j)  (256  + 64 * (j))
#define XB_XSUB(j)  (1280 + 64 * (j))
#define XB_XGEN(j)  (2304 + 64 * (j))
#define XB_TOP      3328
#define XB_TOPGEN   3392
#define XCD_BAR_WORDS 3456
#define XB_SPIN_CAP (1u << 21)

__device__ __forceinline__ unsigned xb_ld(unsigned* p)              { return __hip_atomic_load(p, __ATOMIC_RELAXED, __HIP_MEMORY_SCOPE_AGENT); }
__device__ __forceinline__ unsigned xb_add(unsigned* p, unsigned v) { return __hip_atomic_fetch_add(p, v, __ATOMIC_RELAXED, __HIP_MEMORY_SCOPE_AGENT); }
__device__ __forceinline__ unsigned xb_xcc_id() { return (unsigned)__builtin_amdgcn_s_getreg((3 << 11) | 20) & 0xFu; }
#define XB_SPIN(cond, bar) do { unsigned _sp = 0; while (cond) { __builtin_amdgcn_s_sleep(1); \
    if ((++_sp & 255u) == 0u) { if (xb_ld(&(bar)[XB_TMO])) break; if (_sp > XB_SPIN_CAP) { atomicAdd(&(bar)[XB_TMO], 1u); break; } } } } while (0)

struct XcdBarrier { unsigned* bar; unsigned x; volatile LAS unsigned* st; };

__device__ __forceinline__ XcdBarrier xcd_barrier_post(unsigned* bar, volatile LAS unsigned* st) {
    XcdBarrier b; b.bar = bar; b.x = xb_xcc_id(); b.st = st;
    if (threadIdx.x == 0) (void)xb_add(&bar[XB_XCNT(b.x)], 1u);
    return b;
}
__device__ __forceinline__ void xcd_barrier_complete(unsigned* bar, unsigned x, unsigned& nloc, unsigned& nx) {
    const unsigned G = gridDim.x * gridDim.y * gridDim.z;
    unsigned sum, cnt, mine, sp = 0u;
    for (;;) {
        sum = 0u; cnt = 0u; mine = 0u;
#pragma unroll
        for (unsigned j = 0; j < 16; ++j) { const unsigned c = xb_ld(&bar[XB_XCNT(j)]); sum += c; cnt += (c > 0u) ? 1u : 0u; mine = (j == x) ? c : mine; }
        if (sum == G) break;
        __builtin_amdgcn_s_sleep(1);
        if ((++sp & 255u) == 0u) { if (xb_ld(&bar[XB_TMO])) break; if (sp > XB_SPIN_CAP) { atomicAdd(&bar[XB_TMO], 1u); break; } }
    }
    nloc = mine > 0u ? mine : 1u; nx = cnt > 0u ? cnt : 1u;
}
__device__ __forceinline__ void xcd_barrier(const XcdBarrier& b) {
    asm volatile("s_waitcnt vmcnt(0)" ::: "memory");
    __syncthreads();
    if (threadIdx.x == 0) {
        unsigned* bar = b.bar;
        __builtin_amdgcn_s_waitcnt(0);
        unsigned nloc = b.st[0], nx = b.st[1];
        if (nloc == 0u) { xcd_barrier_complete(bar, b.x, nloc, nx); b.st[0] = nloc; b.st[1] = nx; }
        const unsigned old = xb_add(&bar[XB_XSUB(b.x)], 1u);
        const unsigned gen = old / nloc;
        if (old + 1u == (gen + 1u) * nloc) {
            __builtin_amdgcn_fence(__ATOMIC_RELEASE, "agent");
            asm volatile("s_waitcnt vmcnt(0)" ::: "memory");
            const unsigned og = xb_add(&bar[XB_TOP], 1u);
            const unsigned tg = og / nx;
            if (og + 1u == (tg + 1u) * nx) xb_add(&bar[XB_TOPGEN], 1u);
            else XB_SPIN(xb_ld(&bar[XB_TOPGEN]) == tg, bar);
            __builtin_amdgcn_fence(__ATOMIC_ACQUIRE, "agent");
            xb_add(&bar[XB_XGEN(b.x)], 1u);
            asm volatile("s_waitcnt vmcnt(0)" ::: "memory");
        } else {
            XB_SPIN(xb_ld(&bar[XB_XGEN(b.x)]) == gen, bar);
            __builtin_amdgcn_fence(__ATOMIC_ACQUIRE, "agent");
            asm volatile("s_waitcnt vmcnt(0)" ::: "memory");
        }
    }
    __syncthreads();
}

namespace pg8 {
struct TileOrder {
    int nM, nN, nwg, G, c;
    __device__ __forceinline__ void init(int nM_, int nN_, int G_, int c_) { nM = nM_; nN = nN_; nwg = nM * nN; G = G_; c = c_; }
    __device__ __forceinline__ bool logical(int i, int& im, int& in) const {
        const long L = (long)i * G + c; if (L >= nwg) return false;
        int wgid = (int)L; { const int q = nwg / NXCD, r = nwg % NXCD, xcd = wgid % NXCD, off = wgid / NXCD; wgid = (xcd < r ? xcd * (q + 1) : r * (q + 1) + (xcd - r) * q) + off; }
        const int nig = WGM * nN, gid = wgid / nig, fm = gid * WGM, gsz = (nM - fm) < WGM ? (nM - fm) : WGM;
        im = fm + ((wgid % nig) % gsz); in = (wgid % nig) / gsz; return true;
    }
    __device__ __forceinline__ void a_ready(const Unit&) const {}
    __device__ __forceinline__ void done(const Unit&) const {}
};
struct AllOrder : TileOrder { __device__ __forceinline__ bool next(int i, Unit& u) const { int im, in; if (!logical(i, im, in)) return false; u.pm = im; u.pn = in; return true; } };
struct LatOrder : TileOrder {
    __device__ __forceinline__ bool next(int i, Unit& u) const { int im, in; if (!logical(i, im, in)) return false; u.pm = (im >> 4) * 17 + 1 + (im & 15); u.pn = in; return true; } };
struct MoeOrder : TileOrder {
    const PG8_LAS int* tile_e; int nper;
    __device__ __forceinline__ bool next(int i, Unit& u) const { int im, in; if (!logical(i, im, in)) return false; u.pm = im; u.pn = tile_e[im] * nper + in; return true; } };

struct EpiRes {
    static constexpr bool PERM = true, AFTER_DRAIN = false;
    const float* xin; const float* h; bf16_t* pre; const float* modv; const float* bias;
    __device__ __forceinline__ void operator()(const f32x4 (&acc)[2][2][4][2], const Unit& u, int wr, int wc, int fr, int fq) const {
        asm volatile("" : "+v"(fr), "+v"(fq));
        const int b = u.pm / 17, j = u.pm % 17;
        const int rl0 = wr * 64 + fr, col0 = u.pn * BM + wc * 32 + 8 * fq;
        const float* gate = modv + (size_t)b * 6144 + 2048;
        f32x4 gv[2][2], bv[2][2];
#pragma unroll
        for (int bj = 0; bj < 2; ++bj)
#pragma unroll
            for (int n = 0; n < 2; ++n) { gv[bj][n] = *(const f32x4*)(gate + col0 + bj * HALF + 4 * n); bv[bj][n] = bias ? *(const f32x4*)(bias + col0 + bj * HALF + 4 * n) : (f32x4){0.f, 0.f, 0.f, 0.f}; }
#pragma unroll
        for (int aim = 0; aim < 4; ++aim) { const int ai = aim >> 1, m0 = (aim & 1) * 2;
            f32x4 hv[2][2][2];
#pragma unroll
            for (int mm = 0; mm < 2; ++mm) { const int rl = rl0 + ai * HALF + (m0 + mm) * 16; const size_t grow = (size_t)u.pm * BM + rl;
                const float* hin = xin ? xin + ((size_t)b * 4096 + (size_t)(j - 1) * 256 + rl) * 1024 + col0 : h + grow * 1024 + col0;
#pragma unroll
                for (int bj = 0; bj < 2; ++bj) { hv[mm][bj][0] = *(const f32x4*)(hin + bj * HALF); hv[mm][bj][1] = *(const f32x4*)(hin + bj * HALF + 4); } }
            asm volatile("" ::: "memory");
#pragma unroll
            for (int mm = 0; mm < 2; ++mm) { const int m = m0 + mm; const int rl = rl0 + ai * HALF + m * 16; const size_t grow = (size_t)u.pm * BM + rl; bf16_t* po = pre + grow * 1024 + col0;
#pragma unroll
                for (int bj = 0; bj < 2; ++bj) {
                    const f32x4 v0 = hv[mm][bj][0] * 1.4142135623730951f + gv[bj][0] * (acc[ai][bj][m][0] + bv[bj][0]), v1 = hv[mm][bj][1] * 1.4142135623730951f + gv[bj][1] * (acc[ai][bj][m][1] + bv[bj][1]);
                    u32x4 w; w.x = cvt_pk_bf16(v0[0], v0[1]); w.y = cvt_pk_bf16(v0[2], v0[3]); w.z = cvt_pk_bf16(v1[0], v1[1]); w.w = cvt_pk_bf16(v1[2], v1[3]);
                    *(u32x4*)(po + bj * HALF) = w; } }
            asm volatile("" ::: "memory"); }
    }
};
template <int MODE, bool OUT8 = false> struct EpiGate {
    static constexpr bool PERM = true, AFTER_DRAIN = false;
    bf16_t* O; const float* bias; int nper; float ascale, oscale;
    __device__ __forceinline__ void operator()(const f32x4 (&acc)[2][2][4][2], const Unit& u, int wr, int wc, int fr, int fq) const {
        asm volatile("" : "+v"(fr), "+v"(fq));
        const int row0 = u.pm * BM + wr * 64 + fr, pnl = u.pn % nper, ocol0 = pnl * HALF + wc * 32 + 8 * fq, bcol0 = u.pn * BM + wc * 32 + 8 * fq;
        const float s0 = ascale, s1 = MODE == 1 ? ascale * oscale : ascale;
        f32x4 bv[2][2];
#pragma unroll
        for (int n = 0; n < 2; ++n) { bv[0][n] = *(const f32x4*)(bias + bcol0 + 4 * n); const f32x4 t = *(const f32x4*)(bias + bcol0 + HALF + 4 * n); bv[1][n] = MODE == 1 ? (t + 1.0f) * oscale : t; }
#pragma unroll
        for (int ai = 0; ai < 2; ++ai)
#pragma unroll
            for (int m = 0; m < 4; ++m) { bf16_t* rowp = O + (size_t)(row0 + ai * HALF + m * 16) * 1024 + ocol0;
                unsigned char* rowp8 = (unsigned char*)O + (size_t)(row0 + ai * HALF + m * 16) * 1024 + ocol0;
                float o[8];
#pragma unroll
                for (int n = 0; n < 2; ++n) { const f32x4 a = acc[ai][0][m][n] * s0 + bv[0][n], g = acc[ai][1][m][n] * s1 + bv[1][n];
#pragma unroll
                    for (int e = 0; e < 4; ++e) {
                        if (MODE == 0) { o[4 * n + e] = a[e] * __builtin_amdgcn_rcpf(1.f + __builtin_amdgcn_exp2f(g[e] * -1.4426950408889634f)); }
                        else { const float gt = fminf(a[e], 7.0f), up1 = __builtin_amdgcn_fmed3f(g[e], -6.0f * oscale, 8.0f * oscale);
                            o[4 * n + e] = up1 * (gt * __builtin_amdgcn_rcpf(1.f + __builtin_amdgcn_exp2f(gt * (-1.702f * 1.4426950408889634f)))); } } }
                if constexpr (OUT8) {
                    int w0 = 0, w1 = 0; w0 = __builtin_amdgcn_cvt_pk_fp8_f32(o[0], o[1], w0, false); w0 = __builtin_amdgcn_cvt_pk_fp8_f32(o[2], o[3], w0, true);
                    w1 = __builtin_amdgcn_cvt_pk_fp8_f32(o[4], o[5], w1, false); w1 = __builtin_amdgcn_cvt_pk_fp8_f32(o[6], o[7], w1, true);
                    typedef unsigned u32x2 __attribute__((ext_vector_type(2))); *(u32x2*)rowp8 = (u32x2){(unsigned)w0, (unsigned)w1}; (void)rowp;
                } else { (void)rowp8;
                u32x4 w; w.x = cvt_pk_bf16(o[0], o[1]); w.y = cvt_pk_bf16(o[2], o[3]); w.z = cvt_pk_bf16(o[4], o[5]); w.w = cvt_pk_bf16(o[6], o[7]);
                *(u32x4*)rowp = w; } }
    }
};
struct EpiDown {
    static constexpr bool PERM = true, AFTER_DRAIN = false;
    bf16_t* Y; const float* bias; const float* row_w; const int* row_dst; float ascale; const PG8_LAS int* gtab; float oscale;
    __device__ __forceinline__ void operator()(const f32x4 (&acc)[2][2][4][2], const Unit& u, int wr, int wc, int fr, int fq) const {
        asm volatile("" : "+v"(fr), "+v"(fq));
        const int pnl = u.pn & 3, ocol0 = pnl * BM + wc * 32 + 8 * fq, bcol0 = u.pn * BM + wc * 32 + 8 * fq; const int tbase = gtab[u.pm], tcnt = gtab[576 + u.pm];
        f32x4 bv[2][2];
#pragma unroll
        for (int bj = 0; bj < 2; ++bj)
#pragma unroll
            for (int n = 0; n < 2; ++n) bv[bj][n] = *(const f32x4*)(bias + bcol0 + bj * HALF + 4 * n);
        int dstv[2][4]; float wv[2][4];
#pragma unroll
        for (int ai = 0; ai < 2; ++ai)
#pragma unroll
            for (int m = 0; m < 4; ++m) { const int rl = wr * 64 + fr + ai * HALF + m * 16; const int ix = tbase + (rl < tcnt ? rl : 0); dstv[ai][m] = row_dst[ix]; wv[ai][m] = row_w[ix]; }
#pragma unroll
        for (int ai = 0; ai < 2; ++ai)
#pragma unroll
            for (int m = 0; m < 4; ++m) { const int rl = wr * 64 + fr + ai * HALF + m * 16;
                if (rl < tcnt) { const int dst = dstv[ai][m]; const float w8 = wv[ai][m] * oscale; unsigned char* rowp = (unsigned char*)Y + (size_t)dst * 1024 + ocol0;
#pragma unroll
                    for (int bj = 0; bj < 2; ++bj) { const f32x4 v0 = (acc[ai][bj][m][0] * ascale + bv[bj][0]) * w8, v1 = (acc[ai][bj][m][1] * ascale + bv[bj][1]) * w8;
                        int w0 = 0, w1 = 0; w0 = __builtin_amdgcn_cvt_pk_fp8_f32(fminf(fmaxf(v0[0], -448.f), 448.f), fminf(fmaxf(v0[1], -448.f), 448.f), w0, false); w0 = __builtin_amdgcn_cvt_pk_fp8_f32(fminf(fmaxf(v0[2], -448.f), 448.f), fminf(fmaxf(v0[3], -448.f), 448.f), w0, true);
                        w1 = __builtin_amdgcn_cvt_pk_fp8_f32(fminf(fmaxf(v1[0], -448.f), 448.f), fminf(fmaxf(v1[1], -448.f), 448.f), w1, false); w1 = __builtin_amdgcn_cvt_pk_fp8_f32(fminf(fmaxf(v1[2], -448.f), 448.f), fminf(fmaxf(v1[3], -448.f), 448.f), w1, true);
                        typedef unsigned u32x2 __attribute__((ext_vector_type(2))); *(u32x2*)(rowp + bj * HALF) = (u32x2){(unsigned)w0, (unsigned)w1}; } } }
    }
};
}

namespace att {
using bf16x8 = __attribute__((ext_vector_type(8))) short;
using s16x4  = __attribute__((ext_vector_type(4))) short;
using f32x16 = __attribute__((ext_vector_type(16))) float;
using u32x4  = __attribute__((ext_vector_type(4))) unsigned;
constexpr int NW = 8, QBLK = 32, KVBLK = 64;
constexpr float SCALE = 0.10206207261596575f;
constexpr float THR = 8.f;
constexpr int SHM_V = 16384, SHM_K = 16384, NBUF = 3, SHM_ATTN = NBUF * SHM_V + NBUF * SHM_K + NW * 64 * 4;
#define KSWZ(row, colB) ((row) * 256 + ((colB) ^ (((row) & 7) << 4)))
#define SBAR() __builtin_amdgcn_sched_barrier(0)
__device__ __forceinline__ int crow(int r, int hi) { return (r & 3) + 8 * (r >> 2) + 4 * hi; }
__device__ __forceinline__ unsigned cvtpk(float lo, float hi) { unsigned r; asm volatile("v_cvt_pk_bf16_f32 %0, %1, %2" : "=v"(r) : "v"(lo), "v"(hi)); return r; }

__device__ __forceinline__ void partialSM(f32x16& p0, f32x16& p1, float& m_reg, float& mn, float& alpha) {
  constexpr float C = SCALE * 1.4426950408889634f;
  float pmax = p0[0];
#pragma unroll
  for (int r = 1; r < 16; ++r) pmax = fmaxf(pmax, p0[r]);
#pragma unroll
  for (int r = 0; r < 16; ++r) pmax = fmaxf(pmax, p1[r]);
  { auto rr = __builtin_amdgcn_permlane32_swap(__float_as_uint(pmax), __float_as_uint(pmax), false, false);
    pmax = fmaxf(__uint_as_float(rr[0]), __uint_as_float(rr[1])); }
  if (__builtin_expect(__all(pmax - m_reg <= THR / SCALE), 1)) { mn = m_reg; alpha = 1.f; }
  else { mn = fmaxf(m_reg, pmax); alpha = __builtin_amdgcn_exp2f((m_reg - mn) * C); m_reg = mn; }
  float mnC = -mn * C;
#pragma unroll
  for (int r = 0; r < 16; ++r) p0[r] = fmaf(p0[r], C, mnC);
#pragma unroll
  for (int r = 0; r < 16; ++r) p1[r] = fmaf(p1[r], C, mnC);
#pragma unroll
  for (int r = 0; r < 16; ++r) p0[r] = __builtin_amdgcn_exp2f(p0[r]);
}
__device__ __forceinline__ void finishSM(f32x16& p0, f32x16& p1, float alpha, float& l_reg, bf16x8& pa0, bf16x8& pa1, bf16x8& pa2, bf16x8& pa3) {
#pragma unroll
  for (int r = 0; r < 16; ++r) p1[r] = __builtin_amdgcn_exp2f(p1[r]);
  float ps = 0;
#pragma unroll
  for (int r = 0; r < 16; ++r) ps += p0[r];
#pragma unroll
  for (int r = 0; r < 16; ++r) ps += p1[r];
  { auto rr = __builtin_amdgcn_permlane32_swap(__float_as_uint(ps), __float_as_uint(ps), false, false);
    ps = __uint_as_float(rr[0]) + __uint_as_float(rr[1]); }
  l_reg = l_reg * alpha + ps;
#define PK4(P, BASE, OUT) do { unsigned a0 = cvtpk(P[BASE + 0], P[BASE + 1]), a1 = cvtpk(P[BASE + 2], P[BASE + 3]);   \
    unsigned b0 = cvtpk(P[BASE + 4], P[BASE + 5]), b1 = cvtpk(P[BASE + 6], P[BASE + 7]);                              \
    auto r0 = __builtin_amdgcn_permlane32_swap(a0, b0, false, false); auto r1 = __builtin_amdgcn_permlane32_swap(a1, b1, false, false); \
    u32x4 w = {r0[0], r1[0], r0[1], r1[1]}; OUT = *reinterpret_cast<bf16x8*>(&w); } while (0)
  PK4(p0, 0, pa0); PK4(p0, 8, pa1); PK4(p1, 0, pa2); PK4(p1, 8, pa3);
#undef PK4
}
__device__ __forceinline__ void qkt(f32x16& p0, f32x16& p1, const bf16* Ks, const bf16x8* qr, int r32, int hi) {
  p0 = f32x16{}; p1 = f32x16{};
#pragma unroll
  for (int d0 = 0; d0 < 6; ++d0) { int cb = (d0 * 16 + hi * 8) * 2;
    bf16x8 b0 = *reinterpret_cast<const bf16x8*>((const char*)Ks + KSWZ(r32, cb));
    bf16x8 b1 = *reinterpret_cast<const bf16x8*>((const char*)Ks + KSWZ(32 + r32, cb));
    p0 = __builtin_amdgcn_mfma_f32_32x32x16_bf16(b0, qr[d0], p0, 0, 0, 0);
    p1 = __builtin_amdgcn_mfma_f32_32x32x16_bf16(b1, qr[d0], p1, 0, 0, 0); }
}
__device__ __forceinline__ int v_st(int k, int c) { const int kk = (k & ~0xC) | ((k & 4) << 1) | ((k & 8) >> 1); return ((kk >> 3) * 4 + (c >> 5)) * 512 + ((kk & 7) * 32 + (c & 31)) * 2; }
__device__ __forceinline__ int v_rd_base(int lane) { return ((lane & 3) << 3) | (((lane >> 2) & 3) << 6) | (((lane >> 4) & 1) << 5) | (((lane >> 5) & 1) << 8); }
constexpr int v_rd_off(int d0, int ks, int half) { return d0 * 512 + ks * 4096 + half * 2048; }
template <int OFF> __device__ __forceinline__ s16x4 tr_read(int vb) {
  s16x4 r; asm volatile("ds_read_b64_tr_b16 %0, %1 offset:%2" : "=&v"(r) : "v"(vb), "i"(OFF) : "memory"); return r;
}
template <int D0> __device__ __forceinline__ void pv_one(f32x16& od, int vb, bf16x8 pa0, bf16x8 pa1, bf16x8 pa2, bf16x8 pa3) {
  const s16x4 l0 = tr_read<v_rd_off(D0, 0, 0)>(vb), h0 = tr_read<v_rd_off(D0, 0, 1)>(vb), l1 = tr_read<v_rd_off(D0, 1, 0)>(vb), h1 = tr_read<v_rd_off(D0, 1, 1)>(vb);
  const s16x4 l2 = tr_read<v_rd_off(D0, 2, 0)>(vb), h2 = tr_read<v_rd_off(D0, 2, 1)>(vb), l3 = tr_read<v_rd_off(D0, 3, 0)>(vb), h3 = tr_read<v_rd_off(D0, 3, 1)>(vb);
  asm volatile("s_waitcnt lgkmcnt(0)" ::: "memory"); SBAR();
#define PK(L, H) (bf16x8){L[0], L[1], L[2], L[3], H[0], H[1], H[2], H[3]}
  od = __builtin_amdgcn_mfma_f32_32x32x16_bf16(pa0, PK(l0, h0), od, 0, 0, 0);
  od = __builtin_amdgcn_mfma_f32_32x32x16_bf16(pa1, PK(l1, h1), od, 0, 0, 0);
  od = __builtin_amdgcn_mfma_f32_32x32x16_bf16(pa2, PK(l2, h2), od, 0, 0, 0);
  od = __builtin_amdgcn_mfma_f32_32x32x16_bf16(pa3, PK(l3, h3), od, 0, 0, 0);
#undef PK
}
__device__ __forceinline__ void pv_d0(f32x16* o, int vb, bf16x8 pa0, bf16x8 pa1, bf16x8 pa2, bf16x8 pa3) {
  pv_one<0>(o[0], vb, pa0, pa1, pa2, pa3); pv_one<1>(o[1], vb, pa0, pa1, pa2, pa3);
}
__device__ __forceinline__ bf16x8 rope8(bf16x8 x, const float* tab, int pbase) {
  u32x4 w;
#pragma unroll
  for (int i = 0; i < 4; ++i) { const float x1 = __uint_as_float(((unsigned)(unsigned short)x[2 * i]) << 16), x2 = __uint_as_float(((unsigned)(unsigned short)x[2 * i + 1]) << 16);
    const float cs = tab[pbase + i], sn = tab[16 + pbase + i]; w[i] = cvtpk(x1 * cs - x2 * sn, x1 * sn + x2 * cs); }
  return *reinterpret_cast<bf16x8*>(&w);
}
__device__ __forceinline__ void attn_unit(const bf16* __restrict__ Qb, const bf16* __restrict__ KVb, const bf16* __restrict__ KRb, bf16* __restrict__ Ob,
                                          const float* __restrict__ rope, int seq, char* lds) {
  int tid_l = threadIdx.x; asm volatile("" : "+v"(tid_l));
  const int tid = tid_l, wid = tid >> 6, lane = tid & 63, r32 = lane & 31, hi = lane >> 5;
  bf16* V_lds = (bf16*)lds; bf16* K_lds = (bf16*)(lds + NBUF * SHM_V);
  float* ws = (float*)(lds + NBUF * SHM_V + NBUF * SHM_K) + wid * 64; float* li_l = ws; float* al_l = ws + 32;
  float m_reg = -1e30f, l_reg = 0; f32x16 o[2] = {}; bf16x8 qr[6];
  const bf16* Qw = Qb + (long)(wid * QBLK + r32) * 768 + hi * 8;
#pragma unroll
  for (int d0 = 0; d0 < 6; ++d0) qr[d0] = *reinterpret_cast<const bf16x8*>(Qw + d0 * 16);
  if (rope) { const float* tab = rope + (long)(wid * QBLK + r32) * 32; qr[4] = rope8(qr[4], tab, 4 * hi); qr[5] = rope8(qr[5], tab, 8 + 4 * hi); }
  const int sr = tid >> 4, ch = tid & 15;
  const bf16* kbase = ch < 8 ? KVb + ch * 8 : KRb + ((ch - 8) & 3) * 8; const long kstr = ch < 8 ? 1024 : 32;
  const int vkey = tid >> 3, vc8 = (tid & 7) * 8, vst0 = v_st(vkey, vc8);
  const bf16* vbase = KVb + 512 + vc8;
  const int vb0 = (int)(uintptr_t)V_lds + v_rd_base(lane);
  struct { bf16x8 vs0, ks0, ks1; } sr_[2];
#define SLOAD(i, k0) do { sr_[i].vs0 = *reinterpret_cast<const bf16x8*>(vbase + (long)((k0) + vkey) * 1024); \
    sr_[i].ks0 = *reinterpret_cast<const bf16x8*>(kbase + (long)((k0) + sr) * kstr); sr_[i].ks1 = *reinterpret_cast<const bf16x8*>(kbase + (long)((k0) + 32 + sr) * kstr); } while (0)
#define SWRITE(b, i) do { *(bf16x8*)((char*)V_lds + (b) * SHM_V + vst0) = sr_[i].vs0; int kc = ch * 16;               \
    *(bf16x8*)((char*)K_lds + (b) * SHM_K + KSWZ(sr, kc)) = sr_[i].ks0;                       \
    *(bf16x8*)((char*)K_lds + (b) * SHM_K + KSWZ(32 + sr, kc)) = sr_[i].ks1; } while (0)
#define SWAIT() asm volatile("s_waitcnt vmcnt(3)" ::: "memory")
#define RESC(a) do { if (__any((a) < 1.f)) { if (hi == 0) al_l[r32] = (a); asm volatile("s_waitcnt lgkmcnt(0)" ::: "memory"); \
    _Pragma("unroll") for (int d = 0; d < 2; ++d) _Pragma("unroll") for (int r = 0; r < 16; ++r) o[d][r] *= al_l[crow(r, hi)]; } } while (0)
  f32x16 pA0, pA1, pB0, pB1; float mnA, mnB, alA, alB; bf16x8 pa0, pa1, pa2, pa3; const int NT = seq / KVBLK;
  constexpr int SE = 0, SO = 1;
  SLOAD(SE, 0); asm volatile("s_waitcnt vmcnt(0)" ::: "memory"); SWRITE(0, SE); __syncthreads();
  qkt(pA0, pA1, K_lds, qr, r32, hi); partialSM(pA0, pA1, m_reg, mnA, alA);
  SLOAD(SO, KVBLK); if (2 < NT) SLOAD(SE, 2 * KVBLK);
  SWAIT(); SWRITE(1, SO); __syncthreads();
  int bprev = 0, bcur = 1, bnext = 2;
#define ATT_STEP(PN0, PN1, MNN, ALN, PO0, PO1, ALO, SL_LOAD, SL_WRITE, t) do { \
    SBAR(); qkt(PN0, PN1, (bf16*)((char*)K_lds + bcur * SHM_K), qr, r32, hi); \
    finishSM(PO0, PO1, ALO, l_reg, pa0, pa1, pa2, pa3); SBAR(); \
    if ((t) + 2 < NT) SLOAD(SL_LOAD, ((t) + 2) * KVBLK); SBAR(); \
    pv_d0(o, vb0 + bprev * (int)SHM_V, pa0, pa1, pa2, pa3); partialSM(PN0, PN1, m_reg, MNN, ALN); \
    SWAIT(); SWRITE(bnext, SL_WRITE); \
    RESC(ALN); __syncthreads(); \
    bprev = bcur; bcur = bnext; bnext = (bnext == 2) ? 0 : bnext + 1; } while (0)
  for (int j = 1; j + 1 < NT; j += 2) {
    ATT_STEP(pB0, pB1, mnB, alB, pA0, pA1, alA, SO, SE, j);
    ATT_STEP(pA0, pA1, mnA, alA, pB0, pB1, alB, SE, SO, j + 1);
  }
#undef ATT_STEP
  SBAR(); qkt(pB0, pB1, (bf16*)((char*)K_lds + bcur * SHM_K), qr, r32, hi);
  finishSM(pA0, pA1, alA, l_reg, pa0, pa1, pa2, pa3); SBAR();
  pv_d0(o, vb0 + bprev * (int)SHM_V, pa0, pa1, pa2, pa3); partialSM(pB0, pB1, m_reg, mnB, alB);
  RESC(alB);
  finishSM(pB0, pB1, alB, l_reg, pa0, pa1, pa2, pa3); SBAR();
  pv_d0(o, vb0 + bcur * (int)SHM_V, pa0, pa1, pa2, pa3);
  if (hi == 0) li_l[r32] = l_reg; asm volatile("s_waitcnt lgkmcnt(0)" ::: "memory");
  float rli[16];
#pragma unroll
  for (int r = 0; r < 16; ++r) rli[r] = __builtin_amdgcn_rcpf(li_l[crow(r, hi)]);
  bf16* Ow = Ob + (long)(wid * QBLK) * 1024;
#pragma unroll
  for (int r = 0; r < 16; ++r) { int orow = crow(r, hi);
#pragma unroll
    for (int d0 = 0; d0 < 2; ++d0) { const float v = o[d0][r] * rli[r]; Ow[(long)orow * 1024 + d0 * 32 + r32] = (bf16)(cvtpk(v, v) & 0xffffu); } }
#undef SLOAD
#undef SWRITE
#undef SWAIT
#undef RESC
}
}

struct Args { const float* in[33]; float* out; unsigned char* ws; int ph_lo, ph_hi; };
enum { I_X = 0, I_C, I_CTX, I_CCTX, I_MODW, I_MODB, I_LN1G, I_LN1B, I_LN2G, I_LN2B, I_WIN, I_QNORM, I_KVNORM, I_WUQ, I_WUK, I_WUV, I_LBL, I_HGNORM, I_WOUT,
       I_PW1W, I_PW1B, I_DWW, I_DWB, I_CLNG, I_CLNB, I_PW2W, I_PW2B, I_RW, I_RB, I_WGU, I_BGU, I_WDN, I_BDN };

__device__ __forceinline__ int dst_row(int n, int mode, int row_off) {
    if (mode == 0) return row_off + n;
    int f, g; if (mode == 1) { f = n >> 1; g = n & 1; } else { g = n >> 10; f = n & 1023; }
    return row_off + 256 * (f >> 7) + 128 * g + (f & 127);
}
__device__ __forceinline__ unsigned pack_fp8x4(float a, float b, float c, float d) { int w = 0; w = __builtin_amdgcn_cvt_pk_fp8_f32(fminf(fmaxf(a, -448.f), 448.f), fminf(fmaxf(b, -448.f), 448.f), w, false);
    w = __builtin_amdgcn_cvt_pk_fp8_f32(fminf(fmaxf(c, -448.f), 448.f), fminf(fmaxf(d, -448.f), 448.f), w, true); return (unsigned)w; }
struct TrItem { const float* W; bf16* WT; int K, N, mode, row_off, item; float f8scale; };
__device__ __forceinline__ void tr_load(const TrItem& d, f32x4 (&v)[16], int lane) {
    const int nblk = (d.N + 63) >> 6, kb = d.item / nblk, nb = d.item - kb * nblk, k0 = 64 * kb, n0 = 64 * nb;
    const int nc = n0 + 4 * (lane & 15), kr = lane >> 4;
#pragma unroll
    for (int i = 0; i < 16; ++i) v[i] = (nc < d.N) ? __builtin_nontemporal_load((const f32x4*)(d.W + (size_t)(k0 + 4 * i + kr) * d.N + nc)) : (f32x4){0.f, 0.f, 0.f, 0.f};
}
__device__ __forceinline__ void tr_lds_write(const f32x4 (&v)[16], LAS float* scr, int lane) {
    const int kr = lane >> 4;
#pragma unroll
    for (int i = 0; i < 16; ++i) { LAS float* s = scr + (4 * i + kr) * 65 + 4 * (lane & 15); s[0] = v[i][0]; s[1] = v[i][1]; s[2] = v[i][2]; s[3] = v[i][3]; }
}
__device__ __forceinline__ void tr_store(const TrItem& d, LAS float* scr, int lane) {
    const int nblk = (d.N + 63) >> 6, kb = d.item / nblk, nb = d.item - kb * nblk, k0 = 64 * kb, n0 = 64 * nb;
    const int c = lane & 7; const int K = d.K;
#pragma unroll
    for (int j = 0; j < 8; ++j) { const int nl = (lane >> 3) + 8 * j, n = n0 + nl; const LAS float* s = scr + (8 * c) * 65 + nl;
        if (n < d.N) { if (d.f8scale > 0.f) { const float f8 = d.f8scale; v2u o8; o8.x = pack_fp8x4(s[0 * 65] * f8, s[1 * 65] * f8, s[2 * 65] * f8, s[3 * 65] * f8); o8.y = pack_fp8x4(s[4 * 65] * f8, s[5 * 65] * f8, s[6 * 65] * f8, s[7 * 65] * f8);
                *(v2u*)((unsigned char*)d.WT + (size_t)dst_row(n, d.mode, d.row_off) * K + k0 + 8 * c) = o8; }
            else { v4u o; o.x = pk2(s[0 * 65], s[1 * 65]); o.y = pk2(s[2 * 65], s[3 * 65]); o.z = pk2(s[4 * 65], s[5 * 65]); o.w = pk2(s[6 * 65], s[7 * 65]);
                *(v4u*)(d.WT + (size_t)dst_row(n, d.mode, d.row_off) * K + k0 + 8 * c) = o; } } }
}
__device__ __forceinline__ void convert_items(const Args& a, unsigned char* ws, LAS float* scr, int lane, int gw, int NGW, int it_lo, int it_hi) {
    constexpr int I0 = 16 * 51, I1 = 6 * 12, I2 = 4 * 8, I3 = 4 * 8, I4 = 256, I5 = 512;
    constexpr int NGU = 64 * 512, NDN = 64 * 256;
    auto decode = [&](int it) -> TrItem {
        TrItem d; int r = it; d.f8scale = 0.f; d.mode = 0; d.row_off = 0;
        if (r < NGU) { const int mi = r >> 9; d.W = a.in[I_WGU] + (size_t)mi * 1024 * 2048; d.K = 1024; d.N = 2048; d.WT = (bf16*)(ws + WS_WGU + (size_t)mi * 2048 * 1024); d.mode = 1; d.item = r & 511; d.f8scale = SC_WGU; return d; } r -= NGU;
        if (r < NDN) { const int mi = r >> 8; d.W = a.in[I_WDN] + (size_t)mi * 1024 * 1024; d.K = 1024; d.N = 1024; d.WT = (bf16*)(ws + WS_WDN + (size_t)mi * 1024 * 1024); d.item = r & 255; d.f8scale = SC_WDN; return d; } r -= NDN;
        if (r < I0) { d.W = a.in[I_WIN]; d.K = 1024; d.N = 3232; d.WT = (bf16*)(ws + WS_WIN); d.item = r; return d; } r -= I0;
        if (r < I1) { d.W = a.in[I_WUQ]; d.K = 384; d.N = 768; d.WT = (bf16*)(ws + WS_WUQ); d.item = r; return d; } r -= I1;
        if (r < I2) { d.W = a.in[I_WUK]; d.K = 256; d.N = 512; d.WT = (bf16*)(ws + WS_WUKV); d.item = r; return d; } r -= I2;
        if (r < I3) { d.W = a.in[I_WUV]; d.K = 256; d.N = 512; d.WT = (bf16*)(ws + WS_WUKV); d.row_off = 512; d.item = r; return d; } r -= I3;
        if (r < I4) { d.W = a.in[I_WOUT]; d.K = 1024; d.N = 1024; d.WT = (bf16*)(ws + WS_WOUT); d.item = r; return d; } r -= I4;
        if (r < I5) { d.W = a.in[I_PW1W]; d.K = 1024; d.N = 2048; d.WT = (bf16*)(ws + WS_WPW1); d.mode = 2; d.item = r; return d; } r -= I5;
        d.W = a.in[I_PW2W]; d.K = 1024; d.N = 1024; d.WT = (bf16*)(ws + WS_WPW2); d.item = r; return d; };
    f32x4 tv[16];
    int it = it_lo + gw;
    if (it < it_hi) { const TrItem d0 = decode(it); tr_load(d0, tv, lane); }
    for (; it < it_hi; it += NGW) {
        const TrItem d = decode(it);
        tr_lds_write(tv, scr, lane);
        if (it + NGW < it_hi) { const TrItem dn = decode(it + NGW); tr_load(dn, tv, lane); }
        LDS_WAIT();
        tr_store(d, scr, lane);
        LDS_WAIT();
    }
}
__device__ __forceinline__ void phase_prologue(const Args& a, LAS unsigned char* lds, int tid, int lane, int wave) {
    unsigned char* ws = a.ws;
    const int G = gridDim.x, B = blockIdx.x;
    {
        LAS float* sc = (LAS float*)lds;
        LAS float* red = (LAS float*)(lds + 36864);
        float* modv = (float*)(ws + WS_MODV);
        bool have = false;
        for (int it = B; it < 192; it += G) {
            if (!have) { for (int i = tid; i < 9 * 1024; i += NTHR) { const int r = i >> 10, k = i & 1023; const float x = r < 8 ? a.in[I_C][r * 1024 + k] : a.in[I_CCTX][k]; sc[i] = x * sigm(x); } __syncthreads(); have = true; }
            const int l = it / 96, jc = it % 96, kg = tid >> 6, jj = tid & 63, j = jc * 64 + jj;
            float acc[9];
#pragma unroll
            for (int r = 0; r < 9; ++r) acc[r] = 0.f;
            const float* wp = a.in[I_MODW] + ((size_t)l * 1024 + kg * 128) * 6144 + j;
            for (int k0 = 0; k0 < 128; k0 += 16) { float w[16];
#pragma unroll
                for (int kk = 0; kk < 16; ++kk) w[kk] = wp[(size_t)(k0 + kk) * 6144];
#pragma unroll
                for (int kk = 0; kk < 16; ++kk)
#pragma unroll
                    for (int r = 0; r < 9; ++r) acc[r] += sc[r * 1024 + kg * 128 + k0 + kk] * w[kk]; }
#pragma unroll
            for (int r = 0; r < 9; ++r) red[(kg * 9 + r) * 64 + jj] = acc[r];
            __syncthreads();
            for (int i = tid; i < 576; i += NTHR) { const int r = i >> 6, j2 = i & 63; float s = a.in[I_MODB][l * 6144 + jc * 64 + j2];
#pragma unroll
                for (int g = 0; g < 8; ++g) s += red[(g * 9 + r) * 64 + j2];
                modv[((size_t)l * 9 + r) * 6144 + jc * 64 + j2] = s; }
            __syncthreads();
        }
        __syncthreads();
    }
    const int gw = B * NWAVES + wave, NGW = G * NWAVES, gt = B * NTHR + tid, NGT = G * NTHR;
    { float* rope = (float*)(ws + WS_ROPE);
      for (int i = gt; i < 4096 * 16; i += NGT) { const int t = i >> 4, p = i & 15; const float pos = (float)(p < 8 ? (t >> 6) : (t & 63));
          const float inv = __powf(10000.0f, -(float)(p & 7) * 0.125f); const float ang = pos * inv; rope[t * 32 + p] = cosf(ang); rope[t * 32 + 16 + p] = sinf(ang); }
      float* bgu = (float*)(ws + WS_BGU);
      for (int i = gt; i < 2 * 32 * 2048; i += NGT) { const int le = i >> 11, np = i & 2047, q = np >> 8, g = (np >> 7) & 1, r = np & 127, f = 128 * q + r; bgu[i] = a.in[I_BGU][(size_t)le * 2048 + 2 * f + g]; }
      float* pb = (float*)(ws + WS_PW1B);
      for (int i = gt; i < 2048; i += NGT) { const int q = i >> 8, g = (i >> 7) & 1, r = i & 127, f = 128 * q + r; pb[i] = a.in[I_PW1B][g * 1024 + f]; }
      v4u* zp = (v4u*)(ws + WS_WIN + (size_t)3232 * 1024 * 2);
      for (int i = gt; i < 96 * 1024 * 2 / 16; i += NGT) zp[i] = (v4u){0u, 0u, 0u, 0u};
    }
    LAS float* scr = (LAS float*)(lds + wave * 16640);
    constexpr int I0 = 16 * 51, I1 = 6 * 12, I2 = 4 * 8, I3 = 4 * 8, I4 = 256, I5 = 512, I6 = 256, SMALL = I0 + I1 + I2 + I3 + I4 + I5 + I6;
    constexpr int NGU = 64 * 512, NDN = 64 * 256, NITEMS = SMALL + NGU + NDN;
    convert_items(a, ws, scr, lane, B * NWAVES + wave, G * NWAVES, NGU + NDN, NITEMS);
}
__device__ __forceinline__ void convert_moe_share(const Args& a, LAS unsigned char* lds, int lane, int wave) {
    LAS float* scr = (LAS float*)(lds + wave * 16640);
    constexpr int NGU = 64 * 512, NDN = 64 * 256;
    convert_items(a, a.ws, scr, lane, blockIdx.x * NWAVES + wave, gridDim.x * NWAVES, 0, NGU + NDN);
}

__device__ __forceinline__ void phase_mod0(const Args& a, int lane, int wave) {
    const int gw = blockIdx.x * NWAVES + wave, NGW = gridDim.x * NWAVES;
    const float* modv = (const float*)(a.ws + WS_MODV);
    bf16* X = (bf16*)(a.ws + WS_X);
    for (int r0 = 2 * gw; r0 < NTOK; r0 += 2 * NGW) {
        f32x4 xv[2][4]; const float* mvp[2];
#pragma unroll
        for (int q = 0; q < 2; ++q) { const int r = r0 + q; const int b = r / TPB, p = r - b * TPB;
            const float* src = p < CTXL ? a.in[I_CTX] + ((size_t)b * CTXL + p) * 1024 : a.in[I_X] + ((size_t)b * SEQ + (p - CTXL)) * 1024;
            mvp[q] = modv + (size_t)(p < CTXL ? 8 : b) * 6144;
#pragma unroll
            for (int j = 0; j < 4; ++j) xv[q][j] = *(const f32x4*)(src + 4 * (lane + 64 * j)); }
#pragma unroll
        for (int q = 0; q < 2; ++q)
#pragma unroll
            for (int j = 0; j < 4; ++j) { const int c = 4 * (lane + 64 * j); const f32x4 sh = *(const f32x4*)(mvp[q] + c), sc = *(const f32x4*)(mvp[q] + 1024 + c);
                const f32x4 y = xv[q][j] * (sc + 1.0f) + sh; v2u o; o.x = pk2(y[0], y[1]); o.y = pk2(y[2], y[3]); *(v2u*)(X + (size_t)(r0 + q) * 1024 + c) = o; }
    }
}

__device__ __forceinline__ void phase_norm0(const Args& a, int lane, int wave) {
    const int gw = blockIdx.x * NWAVES + wave, NGW = gridDim.x * NWAVES;
    const bf16* Z = (const bf16*)(a.ws + WS_Z); bf16* CQN = (bf16*)(a.ws + WS_CQN); bf16* CKVN = (bf16*)(a.ws + WS_CKVN); bf16* KRR = (bf16*)(a.ws + WS_KRR);
    const float* rope = (const float*)(a.ws + WS_ROPE);
    float gq[8], gk[8];
#pragma unroll
    for (int i = 0; i < 8; ++i) { gq[i] = lane < 48 ? a.in[I_QNORM][8 * lane + i] : 0.f; gk[i] = lane < 32 ? a.in[I_KVNORM][8 * lane + i] : 0.f; }
    for (int r = gw; r < NTOK; r += NGW) {
        const bf16* z = Z + (size_t)r * ZC; const int p = r % TPB;
        bf16x8 q8 = {}, k8 = {}, r8 = {};
        if (lane < 48) q8 = *(const bf16x8*)(z + ZQ + 8 * lane);
        if (lane < 32) k8 = *(const bf16x8*)(z + ZKV + 8 * lane);
        if (lane < 4) r8 = *(const bf16x8*)(z + ZKR + 8 * lane);
        float qf[8], kf[8], sq = 0.f, sk = 0.f;
#pragma unroll
        for (int i = 0; i < 8; ++i) { qf[i] = bf2f((unsigned short)q8[i]); kf[i] = bf2f((unsigned short)k8[i]); sq += qf[i] * qf[i]; sk += kf[i] * kf[i]; }
        sq = wave_sum(sq); sk = wave_sum(sk);
        const float rq = rsqrtf(sq * (1.f / 384.f) + RMS_EPS), rk = rsqrtf(sk * (1.f / 256.f) + RMS_EPS);
        if (lane < 48) { v4u o; o.x = pk2(qf[0] * rq * gq[0], qf[1] * rq * gq[1]); o.y = pk2(qf[2] * rq * gq[2], qf[3] * rq * gq[3]); o.z = pk2(qf[4] * rq * gq[4], qf[5] * rq * gq[5]); o.w = pk2(qf[6] * rq * gq[6], qf[7] * rq * gq[7]);
            *(v4u*)(CQN + (size_t)r * 384 + 8 * lane) = o; }
        if (lane < 32) { v4u o; o.x = pk2(kf[0] * rk * gk[0], kf[1] * rk * gk[1]); o.y = pk2(kf[2] * rk * gk[2], kf[3] * rk * gk[3]); o.z = pk2(kf[4] * rk * gk[4], kf[5] * rk * gk[5]); o.w = pk2(kf[6] * rk * gk[6], kf[7] * rk * gk[7]);
            *(v4u*)(CKVN + (size_t)r * 256 + 8 * lane) = o; }
        if (lane < 4) { bf16x8 o8 = r8; if (p >= CTXL) o8 = att::rope8(r8, rope + (size_t)(p - CTXL) * 32, 4 * lane); *(bf16x8*)(KRR + (size_t)r * 32 + 8 * lane) = o8; }
    }
}

__device__ __forceinline__ void hgrn_unit(const Args& a, int unit, LAS unsigned char* lds, int tid) {
    const int b = unit >> 5, head = (unit >> 3) & 3, dir = (unit >> 2) & 1, sl = unit & 3;
    const bf16* Z = (const bf16*)(a.ws + WS_Z);
    float* Od = (float*)(a.ws + (dir ? WS_OB : WS_OF));
    LAS float* lbv = (LAS float*)lds;
    constexpr int BUF0 = 1024, BUFSZ = 28672, OFF_Q = 16384, OFF_V = 24576;
    if (tid < 128) { const int c = head * 128 + tid; const float l0 = a.in[I_LBL][c], l1 = a.in[I_LBL][512 + c], l2 = a.in[I_LBL][1024 + c]; const float m = fmaxf(l0, fmaxf(l1, l2));
        const float e0 = __expf(l0 - m), e1 = __expf(l1 - m), e2 = __expf(l2 - m); lbv[tid] = e0 / (e0 + e1 + e2); }
    __syncthreads();
    const int lt = tid >> 4, lcg = tid & 15;
    float lb8[8];
#pragma unroll
    for (int i = 0; i < 8; ++i) lb8[i] = lbv[8 * lcg + i];
    const int fcol = (dir ? ZHB : ZHF) + head * 128 + 8 * lcg, qcol = ZHQ + head * 128 + 8 * lcg;
    const int vt = tid >> 2, vcol = ZHI + head * 128 + sl * 32 + (tid & 3) * 8;
    const int wave = tid >> 6, lane = tid & 63, vv = lane >> 4, cg = lane & 15, vloc = wave * 4 + vv;
    const size_t zb = (size_t)b * TPB;
    bf16x8 rq, rf, rv;
#define TOKP(n) (dir ? ((n) < CTXL ? (CTXL - 1 - (n)) : (TPB + CTXL - 1 - (n))) : (n))
#define HG_LOAD(i) do { const int n_ = 32 * (i) + lt; const bf16* zr_ = Z + (zb + TOKP(n_)) * ZC; rq = *(const bf16x8*)(zr_ + qcol); rf = *(const bf16x8*)(zr_ + fcol); \
        if (tid < 128) { const int n2_ = 32 * (i) + vt; rv = *(const bf16x8*)(Z + (zb + TOKP(n2_)) * ZC + vcol); } } while (0)
#define HG_WRITE(bufi) do { LAS unsigned char* bp_ = lds + BUF0 + (bufi) * BUFSZ; float f_[8]; \
        _Pragma("unroll") for (int i_ = 0; i_ < 8; ++i_) f_[i_] = lb8[i_] + (1.f - lb8[i_]) * sigm(bf2f((unsigned short)rf[i_])); \
        *(LAS f32x4*)(bp_ + ((lt * 128 + lcg * 4) * 4)) = (f32x4){f_[0], f_[1], f_[2], f_[3]}; *(LAS f32x4*)(bp_ + ((lt * 128 + 64 + lcg * 4) * 4)) = (f32x4){f_[4], f_[5], f_[6], f_[7]}; \
        *(LAS bf16x8*)(bp_ + OFF_Q + (lt * 128 + lcg * 8) * 2) = rq; \
        if (tid < 128) { float v_[8]; _Pragma("unroll") for (int i_ = 0; i_ < 8; ++i_) v_[i_] = bf2f((unsigned short)rv[i_]); \
            *(LAS f32x4*)(bp_ + OFF_V + (vt * 32 + (tid & 3) * 8) * 4) = (f32x4){v_[0], v_[1], v_[2], v_[3]}; *(LAS f32x4*)(bp_ + OFF_V + (vt * 32 + (tid & 3) * 8 + 4) * 4) = (f32x4){v_[4], v_[5], v_[6], v_[7]}; } } while (0)
    float S[8];
#pragma unroll
    for (int j = 0; j < 8; ++j) S[j] = 0.f;
    HG_LOAD(0); HG_WRITE(0); __syncthreads();
    const bool b3 = (cg & 8) != 0, b2 = (cg & 4) != 0, b1 = (cg & 2) != 0, b0 = (cg & 1) != 0;
    for (int i = 0; i < TPB / 32; ++i) {
        if (i + 1 < TPB / 32) HG_LOAD(i + 1);
        const LAS unsigned char* bp = lds + BUF0 + (i & 1) * BUFSZ;
#pragma unroll 1
        for (int g = 0; g < 4; ++g) {
            const LAS unsigned char* gp = bp + g * 8 * 512;
            float ot[8];
#pragma unroll
            for (int t = 0; t < 8; ++t) {
                const f32x4 f0 = *(const LAS f32x4*)(gp + ((t * 128 + cg * 4) * 4)), f1 = *(const LAS f32x4*)(gp + ((t * 128 + 64 + cg * 4) * 4));
                const bf16x8 q8 = *(const LAS bf16x8*)(bp + OFF_Q + ((g * 8 + t) * 128 + cg * 8) * 2);
                const float v = *(const LAS float*)(bp + OFF_V + ((g * 8 + t) * 32 + vloc) * 4);
                float acc = 0.f;
#pragma unroll
                for (int j = 0; j < 8; ++j) { const float fj = j < 4 ? f0[j] : f1[j - 4]; const float qj = bf2f((unsigned short)q8[j]);
                    const float kv = fmaf(-fj, v, v); S[j] = fmaf(fj, S[j], kv); acc = fmaf(S[j], qj, acc); }
                ot[t] = acc;
            }
#pragma unroll
            for (int k = 0; k < 4; ++k) { const float snd = b3 ? ot[k] : ot[k + 4]; const float rcv = __shfl_xor(snd, 8); ot[k] = (b3 ? ot[k + 4] : ot[k]) + rcv; }
#pragma unroll
            for (int k = 0; k < 2; ++k) { const float snd = b2 ? ot[k] : ot[k + 2]; const float rcv = __shfl_xor(snd, 4); ot[k] = (b2 ? ot[k + 2] : ot[k]) + rcv; }
            { const float snd = b1 ? ot[0] : ot[1]; const float rcv = __shfl_xor(snd, 2); ot[0] = (b1 ? ot[1] : ot[0]) + rcv; }
            ot[0] += __shfl_xor(ot[0], 1);
            if (!b0) { const int n = 32 * i + 8 * g + (cg >> 1); const int p = TOKP(n); if (p >= CTXL) Od[(zb + p) * 512 + head * 128 + sl * 32 + vloc] = ot[0]; }
        }
        if (i + 1 < TPB / 32) HG_WRITE((i + 1) & 1);
        __syncthreads();
    }
#undef TOKP
#undef HG_LOAD
#undef HG_WRITE
}

__device__ __forceinline__ void phase_readout(const Args& a, int lane, int wave) {
    const int gw = blockIdx.x * NWAVES + wave, NGW = gridDim.x * NWAVES;
    const bf16* OF = (const bf16*)(a.ws + WS_OF); const bf16* OB = (const bf16*)(a.ws + WS_OB);
    const bf16* Z = (const bf16*)(a.ws + WS_Z); bf16* MIX = (bf16*)(a.ws + WS_Y);
    float hn[8];
#pragma unroll
    for (int i = 0; i < 8; ++i) hn[i] = a.in[I_HGNORM][((8 * lane) & 127) + i];
    for (int lr = gw; lr < NLAT; lr += NGW) {
        const size_t r = (size_t)grow_of(lr);
        const bf16x8 a8 = *(const bf16x8*)(OF + r * 512 + 8 * lane), c8 = *(const bf16x8*)(OB + r * 512 + 8 * lane);
        const bf16x8 g8 = *(const bf16x8*)(Z + r * ZC + ZHG + 8 * lane);
        float o[8]; float ss = 0.f;
#pragma unroll
        for (int i = 0; i < 8; ++i) o[i] = bf2f((unsigned short)a8[i]) + bf2f((unsigned short)c8[i]);
#pragma unroll
        for (int i = 0; i < 8; ++i) ss += o[i] * o[i];
        ss += __shfl_xor(ss, 1); ss += __shfl_xor(ss, 2); ss += __shfl_xor(ss, 4); ss += __shfl_xor(ss, 8);
        const float rs = rsqrtf(ss * (1.f / 128.f) + RMS_EPS);
        float y[8];
#pragma unroll
        for (int i = 0; i < 8; ++i) { const float g = bf2f((unsigned short)g8[i]); y[i] = o[i] * rs * hn[i] * (g * sigm(g)); }
        v4u w; w.x = pk2(y[0], y[1]); w.y = pk2(y[2], y[3]); w.z = pk2(y[4], y[5]); w.w = pk2(y[6], y[7]);
        *(v4u*)(MIX + r * 1024 + 512 + 8 * lane) = w;
    }
}

__device__ __forceinline__ int rows_per_block() { const int G = gridDim.x; return (((NLAT + G - 1) / G) + 15) & ~15; }
__device__ __forceinline__ void phase_ln1(const Args& a, int l, LAS unsigned char* lds, int tid, int lane, int wave) {
    typedef short bf16x8s __attribute__((ext_vector_type(8)));
    const int RB = rows_per_block(), lr_base = blockIdx.x * RB;
    const bf16* PRE = (const bf16*)(a.ws + WS_PRE); bf16* XB = (bf16*)(a.ws + WS_X);
    const float* modv = (const float*)(a.ws + WS_MODV) + (size_t)l * 9 * 6144;
    const float* lng = a.in[I_LN1G] + l * 1024; const float* lnb = a.in[I_LN1B] + l * 1024;
    const float* rw = a.in[I_RW] + (size_t)l * 1024 * 32; const float* rb = a.in[I_RB] + l * 32;
    constexpr int XT_LD = 1028, O_PART = 16 * XT_LD * 4, O_LG = O_PART + 8 * 32 * 16 * 4, O_HIST = O_LG + 16 * 33 * 4 + 64, O_CCNT = O_HIST + 256, O_TIL = O_CCNT + 2048, O_TWL = O_TIL + 4096;
    LAS float* XT = (LAS float*)lds; LAS float* PART = (LAS float*)(lds + O_PART); LAS float* LG = (LAS float*)(lds + O_LG);
    LAS int* hist = (LAS int*)(lds + O_HIST);
    LAS int* ccnt = (LAS int*)(lds + O_CCNT);
    LAS int* til = (LAS int*)(lds + O_TIL);
    LAS float* twl = (LAS float*)(lds + O_TWL);
    __syncthreads();
    if (tid < 32) hist[tid] = 0;
    bf16x8s whi[2][4], wlo[2][4];
    { const int e15 = lane & 15, kq = lane >> 4;
#pragma unroll
      for (int t = 0; t < 2; ++t)
#pragma unroll
          for (int sI = 0; sI < 4; ++sI) { float wv[8];
#pragma unroll
              for (int j = 0; j < 8; ++j) wv[j] = rw[(size_t)(128 * wave + 32 * sI + 8 * kq + j) * 32 + 16 * t + e15];
              v4u ph, pl;
#pragma unroll
              for (int j = 0; j < 4; ++j) { const unsigned p = pk2(wv[2 * j], wv[2 * j + 1]); const float h0 = __uint_as_float(p << 16), h1 = __uint_as_float(p & 0xffff0000u); ph[j] = p; pl[j] = pk2(wv[2 * j] - h0, wv[2 * j + 1] - h1); }
              whi[t][sI] = __builtin_bit_cast(bf16x8s, ph); wlo[t][sI] = __builtin_bit_cast(bf16x8s, pl); } }
    const int ngroups = RB / 16;
    v2u xr[2][4];
#define LN1_LOAD(g) do { _Pragma("unroll") for (int rr_ = 0; rr_ < 2; ++rr_) { const int lr_ = lr_base + 16 * (g) + 2 * wave + rr_; const size_t r_ = (size_t)grow_of(lr_ < NLAT ? lr_ : NLAT - 1); \
        _Pragma("unroll") for (int j_ = 0; j_ < 4; ++j_) xr[rr_][j_] = *(const v2u*)(PRE + r_ * 1024 + 4 * (lane + 64 * j_)); } } while (0)
#if defined(PROBE_LN1X2)
    for (int rep_ = 0; rep_ < 2; ++rep_) { __syncthreads(); if (tid < 32) hist[tid] = 0; __syncthreads();
#endif
    LN1_LOAD(0);
    for (int g = 0; g < ngroups; ++g) {
#pragma unroll
        for (int rr = 0; rr < 2; ++rr) {
            const int lr = lr_base + 16 * g + 2 * wave + rr; const bool ok = lr < NLAT; const size_t r = (size_t)grow_of(ok ? lr : NLAT - 1); const int b = (ok ? lr : NLAT - 1) >> 12;
            const float* mv = modv + (size_t)b * 6144;
            f32x4 x[4]; float s = 0.f;
#pragma unroll
            for (int j = 0; j < 4; ++j) { const v2u p = xr[rr][j]; x[j] = (f32x4){__uint_as_float(p.x << 16), __uint_as_float(p.x & 0xffff0000u), __uint_as_float(p.y << 16), __uint_as_float(p.y & 0xffff0000u)}; s += (x[j][0] + x[j][1]) + (x[j][2] + x[j][3]); }
            const float mean = wave_sum(s) * (1.f / 1024.f); float s2 = 0.f;
#pragma unroll
            for (int j = 0; j < 4; ++j) { x[j] = x[j] - mean; s2 += (x[j][0] * x[j][0] + x[j][1] * x[j][1]) + (x[j][2] * x[j][2] + x[j][3] * x[j][3]); }
            const float rstd = rsqrtf(wave_sum(s2) * (1.f / 1024.f) + LN_EPS);
#pragma unroll
            for (int j = 0; j < 4; ++j) { const int c = 4 * (lane + 64 * j); const f32x4 gg = *(const f32x4*)(lng + c), bb = *(const f32x4*)(lnb + c);
                const f32x4 hv = x[j] * rstd * gg + bb;
                const f32x4 sh = *(const f32x4*)(mv + 3 * 1024 + c), sc = *(const f32x4*)(mv + 4 * 1024 + c);
                const f32x4 bm = hv * (sc + 1.0f) + sh;
                if (ok) *(unsigned*)((unsigned char*)XB + r * 1024 + c) = pack_fp8x4(bm[0] * SC_X8, bm[1] * SC_X8, bm[2] * SC_X8, bm[3] * SC_X8);
                *(LAS f32x4*)(XT + (2 * wave + rr) * XT_LD + c) = bm; }
        }
        if (g + 1 < ngroups) LN1_LOAD(g + 1);
        __syncthreads();
        { const int rr = lane & 15, kq = lane >> 4;
          f32x4 acc0 = {0.f, 0.f, 0.f, 0.f}, acc1 = {0.f, 0.f, 0.f, 0.f};
#pragma unroll
          for (int sI = 0; sI < 4; ++sI) { const LAS float* xp = XT + rr * XT_LD + 128 * wave + 32 * sI + 8 * kq; const f32x4 v0 = *(const LAS f32x4*)xp, v1 = *(const LAS f32x4*)(xp + 4);
              const float bv[8] = {v0[0], v0[1], v0[2], v0[3], v1[0], v1[1], v1[2], v1[3]}; v4u ph, pl;
#pragma unroll
              for (int j = 0; j < 4; ++j) { const unsigned p = pk2(bv[2 * j], bv[2 * j + 1]); const float h0 = __uint_as_float(p << 16), h1 = __uint_as_float(p & 0xffff0000u); ph[j] = p; pl[j] = pk2(bv[2 * j] - h0, bv[2 * j + 1] - h1); }
              const bf16x8s bh = __builtin_bit_cast(bf16x8s, ph), bl = __builtin_bit_cast(bf16x8s, pl);
              acc0 = __builtin_amdgcn_mfma_f32_16x16x32_bf16(whi[0][sI], bh, acc0, 0, 0, 0); acc0 = __builtin_amdgcn_mfma_f32_16x16x32_bf16(whi[0][sI], bl, acc0, 0, 0, 0); acc0 = __builtin_amdgcn_mfma_f32_16x16x32_bf16(wlo[0][sI], bh, acc0, 0, 0, 0);
              acc1 = __builtin_amdgcn_mfma_f32_16x16x32_bf16(whi[1][sI], bh, acc1, 0, 0, 0); acc1 = __builtin_amdgcn_mfma_f32_16x16x32_bf16(whi[1][sI], bl, acc1, 0, 0, 0); acc1 = __builtin_amdgcn_mfma_f32_16x16x32_bf16(wlo[1][sI], bh, acc1, 0, 0, 0); }
#pragma unroll
          for (int q = 0; q < 4; ++q) { PART[(wave * 32 + 4 * kq + q) * 16 + rr] = acc0[q]; PART[(wave * 32 + 16 + 4 * kq + q) * 16 + rr] = acc1[q]; } }
        __syncthreads();
        { const int e = tid >> 4, rr = tid & 15; float sacc = rb[e];
#pragma unroll
          for (int w = 0; w < 8; ++w) sacc += PART[(w * 32 + e) * 16 + rr];
          LG[rr * 33 + e] = sacc; }
        __syncthreads();
        if (wave == (g & 7) && lane < 16) { const int lr = lr_base + 16 * g + lane;
            if (lr < NLAT) { float lg[32];
#pragma unroll
                for (int e = 0; e < 32; ++e) lg[e] = LG[lane * 33 + e];
                unsigned taken = 0u; float tv[4]; int ti[4];
#pragma unroll
                for (int kk = 0; kk < 4; ++kk) { float best = -3.0e38f; int bi = 0;
#pragma unroll
                    for (int e = 0; e < 32; ++e) { const bool okk = (lg[e] > best) && !((taken >> e) & 1u); best = okk ? lg[e] : best; bi = okk ? e : bi; }
                    taken |= 1u << bi; tv[kk] = best; ti[kk] = bi; }
                const float e1 = __expf(tv[1] - tv[0]), e2 = __expf(tv[2] - tv[0]), e3 = __expf(tv[3] - tv[0]); const float inv = 1.f / (1.f + e1 + e2 + e3);
                const int li = (16 * g + lane) * 4; til[li] = ti[0]; til[li + 1] = ti[1]; til[li + 2] = ti[2]; til[li + 3] = ti[3]; twl[li] = inv; twl[li + 1] = e1 * inv; twl[li + 2] = e2 * inv; twl[li + 3] = e3 * inv;
                __hip_atomic_fetch_add(hist + ti[0], 1, __ATOMIC_RELAXED, __HIP_MEMORY_SCOPE_WORKGROUP); __hip_atomic_fetch_add(hist + ti[1], 1, __ATOMIC_RELAXED, __HIP_MEMORY_SCOPE_WORKGROUP);
                __hip_atomic_fetch_add(hist + ti[2], 1, __ATOMIC_RELAXED, __HIP_MEMORY_SCOPE_WORKGROUP); __hip_atomic_fetch_add(hist + ti[3], 1, __ATOMIC_RELAXED, __HIP_MEMORY_SCOPE_WORKGROUP); } }
    }
#if defined(PROBE_LN1X2)
    }
#endif
#undef LN1_LOAD
    __syncthreads();
    int* cursor = (int*)(a.ws + WS_CURSOR) + l * 32;
    int* rows = (int*)(a.ws + WS_ROWS); float* roww = (float*)(a.ws + WS_ROWW); int* rowd = (int*)(a.ws + WS_ROWD);
    int nrows = NLAT - lr_base; nrows = nrows > RB ? RB : nrows; if (nrows < 0) nrows = 0;
    const int nas = nrows * 4, nchunks = (nas + 63) >> 6;
    int basev = 0; if (tid < 32) basev = (int)__hip_atomic_fetch_add((unsigned*)cursor + tid, (unsigned)hist[tid], __ATOMIC_RELAXED, __HIP_MEMORY_SCOPE_AGENT);
    int myrank[2] = {0, 0}, mye[2] = {-1, -1};
#pragma unroll
    for (int cc = 0; cc < 2; ++cc) { const int c = wave + 8 * cc; if (c < nchunks) { const int idx = c * 64 + lane; const int e = idx < nas ? til[idx] : -1; mye[cc] = e;
        for (int x = 0; x < 32; ++x) { const unsigned long long m = __ballot(e == x); if (e == x) myrank[cc] = __popcll(m & ((1ull << lane) - 1ull)); if (lane == 0) ccnt[c * 32 + x] = __popcll(m); } } }
    __syncthreads();
    if (tid < 32) hist[32 + tid] = basev;
    __syncthreads();
#pragma unroll
    for (int cc = 0; cc < 2; ++cc) { const int c = wave + 8 * cc; const int idx = c * 64 + lane; if (c < nchunks && idx < nas) { const int e = mye[cc]; int pos = hist[32 + e] + myrank[cc]; for (int c2 = 0; c2 < c; ++c2) pos += ccnt[c2 * 32 + e];
        const int lr = lr_base + (idx >> 2); const size_t pi = (size_t)e * ECAP + pos; rows[pi] = grow_of(lr); roww[pi] = twl[idx]; rowd[pi] = lr * 4 + (idx & 3); } }
}

__device__ __forceinline__ void phase_ln2(const Args& a, int l, int lane, int wave) {
    const int gw = blockIdx.x * NWAVES + wave, NGW = gridDim.x * NWAVES;
    float* H = (float*)(a.ws + WS_H); const bf16* PRE = (const bf16*)(a.ws + WS_PRE); const unsigned char* YB = (const unsigned char*)(a.ws + WS_YB); bf16* A1 = (bf16*)(a.ws + WS_Y);
    const float* modv = (const float*)(a.ws + WS_MODV);
    const float* ln1g = a.in[I_LN1G] + l * 1024; const float* ln1b = a.in[I_LN1B] + l * 1024;
    const float* lng = a.in[I_LN2G] + l * 1024; const float* lnb = a.in[I_LN2B] + l * 1024;
    for (int lr0 = 2 * gw; lr0 < NLAT; lr0 += 2 * NGW) {
        v2u hv[2][4]; unsigned yv[2][4][4];
#pragma unroll
        for (int q = 0; q < 2; ++q) { const int lr = lr0 + q; const size_t r = (size_t)grow_of(lr);
#pragma unroll
            for (int j = 0; j < 4; ++j) { const int c = 4 * (lane + 64 * j); hv[q][j] = *(const v2u*)(PRE + r * 1024 + c);
#pragma unroll
                for (int k = 0; k < 4; ++k) yv[q][j][k] = *(const unsigned*)(YB + ((size_t)lr * 4 + k) * 1024 + c); } }
#pragma unroll
        for (int q = 0; q < 2; ++q) {
            const int lr = lr0 + q; const size_t r = (size_t)grow_of(lr); const int b = lr >> 12;
            const float* mv = modv + ((size_t)l * 9 + b) * 6144; const float* mv1 = modv + ((size_t)9 + b) * 6144;
            f32x4 x[4]; float s = 0.f;
#pragma unroll
            for (int j = 0; j < 4; ++j) { const v2u p = hv[q][j]; x[j] = (f32x4){__uint_as_float(p.x << 16), __uint_as_float(p.x & 0xffff0000u), __uint_as_float(p.y << 16), __uint_as_float(p.y & 0xffff0000u)}; s += (x[j][0] + x[j][1]) + (x[j][2] + x[j][3]); }
            float mean = wave_sum(s) * (1.f / 1024.f), s2 = 0.f;
#pragma unroll
            for (int j = 0; j < 4; ++j) { x[j] = x[j] - mean; s2 += (x[j][0] * x[j][0] + x[j][1] * x[j][1]) + (x[j][2] * x[j][2] + x[j][3] * x[j][3]); }
            float rstd = rsqrtf(wave_sum(s2) * (1.f / 1024.f) + LN_EPS);
            s = 0.f;
#pragma unroll
            for (int j = 0; j < 4; ++j) { const int c = 4 * (lane + 64 * j); const f32x4 g = *(const f32x4*)(ln1g + c), bb = *(const f32x4*)(ln1b + c);
                const f32x4 h1 = x[j] * rstd * g + bb; f32x4 f = {0.f, 0.f, 0.f, 0.f};
#pragma unroll
                for (int k = 0; k < 4; ++k) { const unsigned y = yv[q][j][k]; const auto lo = __builtin_amdgcn_cvt_pk_f32_fp8((int)y, false), hi = __builtin_amdgcn_cvt_pk_f32_fp8((int)y, true);
                    f[0] += lo[0]; f[1] += lo[1]; f[2] += hi[0]; f[3] += hi[1]; }
                const f32x4 gt = *(const f32x4*)(mv + 5 * 1024 + c);
                x[j] = h1 * ALPHA + gt * (f * (1.f / SC_Y)); s += (x[j][0] + x[j][1]) + (x[j][2] + x[j][3]); }
            mean = wave_sum(s) * (1.f / 1024.f); s2 = 0.f;
#pragma unroll
            for (int j = 0; j < 4; ++j) { x[j] = x[j] - mean; s2 += (x[j][0] * x[j][0] + x[j][1] * x[j][1]) + (x[j][2] * x[j][2] + x[j][3] * x[j][3]); }
            rstd = rsqrtf(wave_sum(s2) * (1.f / 1024.f) + LN_EPS);
#pragma unroll
            for (int j = 0; j < 4; ++j) { const int c = 4 * (lane + 64 * j); const f32x4 g = *(const f32x4*)(lng + c), bb = *(const f32x4*)(lnb + c);
                const f32x4 o = x[j] * rstd * g + bb;
                if (l == 0) { *(f32x4*)(H + r * 1024 + c) = o; const f32x4 sh = *(const f32x4*)(mv1 + c), sc = *(const f32x4*)(mv1 + 1024 + c);
                    const f32x4 am = o * (sc + 1.0f) + sh; v2u w; w.x = pk2(am[0], am[1]); w.y = pk2(am[2], am[3]); *(v2u*)(A1 + r * 1024 + c) = w; }
                else *(f32x4*)(a.out + (size_t)lr * 1024 + c) = o; }
        }
    }
}

__device__ __forceinline__ void phase_conv(const Args& a, LAS unsigned char* lds, int tid, int lane, int wave) {
    const bf16* U = (const bf16*)(a.ws + WS_X); bf16* V = (bf16*)(a.ws + WS_Y);
    LAS float* part = (LAS float*)(lds + 126976);
    LAS float* st = part + 512;
    const int c0 = 2 * tid;
    const float db0 = a.in[I_DWB][c0], db1 = a.in[I_DWB][c0 + 1], g0 = a.in[I_CLNG][c0], g1 = a.in[I_CLNG][c0 + 1], be0 = a.in[I_CLNB][c0], be1 = a.in[I_CLNB][c0 + 1];
    for (int tile = blockIdx.x; tile < NLAT / 32; tile += gridDim.x) {
        const int b = tile >> 7, t0 = (tile & 127) * 32;
        const size_t rb0 = (size_t)b * TPB + CTXL;
        __syncthreads();
        for (int i = tid; i < 62 * 128; i += NTHR) { const int row = i >> 7, chk = i & 127, t = t0 - 15 + row;
            v4u val = {0u, 0u, 0u, 0u}; if (t >= 0 && t < SEQ) val = *(const v4u*)(U + (rb0 + t) * 1024 + chk * 8);
            *(LAS v4u*)(lds + row * 2048 + chk * 16) = val; }
        __syncthreads();
        float w0[31], w1[31];
#pragma unroll
        for (int j = 0; j < 31; ++j) { const float2 wv = *(const float2*)(a.in[I_DWW] + j * 1024 + c0); w0[j] = wv.x; w1[j] = wv.y; }
#pragma unroll 1
        for (int hh = 0; hh < 2; ++hh) {
            const LAS unsigned char* hp = lds + hh * 16 * 2048;
            float acc0[16], acc1[16];
#pragma unroll
            for (int t = 0; t < 16; ++t) { acc0[t] = db0; acc1[t] = db1; }
#pragma unroll
            for (int s = 0; s < 46; ++s) { const unsigned pr = *(const LAS unsigned*)(hp + s * 2048 + tid * 4); const float x0 = __uint_as_float(pr << 16), x1 = __uint_as_float(pr & 0xffff0000u);
#pragma unroll
                for (int t = (s > 30 ? s - 30 : 0); t <= (s < 15 ? s : 15); ++t) { acc0[t] = fmaf(x0, w0[s - t], acc0[t]); acc1[t] = fmaf(x1, w1[s - t], acc1[t]); } }
            float rs[32];
#pragma unroll
            for (int t = 0; t < 16; ++t) { rs[2 * t] = acc0[t] + acc1[t]; rs[2 * t + 1] = acc0[t] * acc0[t] + acc1[t] * acc1[t]; }
#define RS_STEP(NKEEP, XORV) { const bool bit_ = (lane & XORV) != 0; _Pragma("unroll") for (int k_ = 0; k_ < NKEEP; ++k_) { const float snd_ = bit_ ? rs[k_] : rs[k_ + NKEEP]; const float rcv_ = __shfl_xor(snd_, XORV); rs[k_] = (bit_ ? rs[k_ + NKEEP] : rs[k_]) + rcv_; } }
            RS_STEP(16, 32) RS_STEP(8, 16) RS_STEP(4, 8) RS_STEP(2, 4) RS_STEP(1, 2)
#undef RS_STEP
            rs[0] += __shfl_xor(rs[0], 1);
            __syncthreads();
            if ((lane & 1) == 0) part[wave * 32 + (lane >> 1)] = rs[0];
            __syncthreads();
            if (tid < 16) { float s1 = 0.f, s2 = 0.f;
#pragma unroll
                for (int w = 0; w < 8; ++w) { s1 += part[w * 32 + 2 * tid]; s2 += part[w * 32 + 2 * tid + 1]; }
                const float mean = s1 * (1.f / 1024.f); const float var = fmaxf(s2 * (1.f / 1024.f) - mean * mean, 0.f); st[2 * tid] = mean; st[2 * tid + 1] = rsqrtf(var + LN_EPS); }
            __syncthreads();
#pragma unroll
            for (int t = 0; t < 16; ++t) { const float mean = st[2 * t], rstd = st[2 * t + 1];
                const float y0 = (acc0[t] - mean) * rstd * g0 + be0, y1 = (acc1[t] - mean) * rstd * g1 + be1;
                *(unsigned*)(V + (rb0 + t0 + hh * 16 + t) * 1024 + c0) = pk2(y0 * sigm(y0), y1 * sigm(y1)); }
        }
    }
}

namespace hg {
using bf16x8 = __attribute__((ext_vector_type(8))) short;
using s16x4  = __attribute__((ext_vector_type(4))) short;
using f32x16 = __attribute__((ext_vector_type(16))) float;
using u32x4  = __attribute__((ext_vector_type(4))) unsigned;
constexpr int RS = 272;
constexpr int VS = 80;
constexpr int T_Q = 0, T_KO = 32 * RS, T_KE = 64 * RS, T_D = 96 * RS, IMG_BYTES = T_D + 512, T_V = IMG_BYTES, TILE_BYTES = T_V + 32 * VS;
constexpr int OFF_TILES = 1024, NTB = 3, OFF_OPART = OFF_TILES + NTB * TILE_BYTES, OPART_BYTES = 4 * 4096;
static_assert(OFF_OPART + 2 * OPART_BYTES <= 131072 && IMG_BYTES % 16 == 0 && IMG_BYTES / 16 == 1664, "hgrn lds");
constexpr int P_RAW = 1024, R_Q = 0, R_F = 32 * RS, RAW_BYTES = 64 * RS, P_IMG = P_RAW + RAW_BYTES;
constexpr int NCHUNK = TPB / 32, NCHAIN = NB * 4 * 2, NITEM = NCHAIN * NCHUNK;
__device__ __forceinline__ int crow(int r, int hi) { return (r & 3) + 8 * (r >> 2) + 4 * hi; }
__device__ __forceinline__ s16x4 tr_read(unsigned addr) { s16x4 r; asm volatile("ds_read_b64_tr_b16 %0, %1" : "=&v"(r) : "v"(addr) : "memory"); return r; }
__device__ __forceinline__ bf16x8 cat8(s16x4 l, s16x4 h) { return (bf16x8){l[0], l[1], l[2], l[3], h[0], h[1], h[2], h[3]}; }
__device__ __forceinline__ bf16x8 pack8(const f32x16& x, int base) {
    u32x4 w; w[0] = pk2(x[base + 0], x[base + 1]); w[1] = pk2(x[base + 2], x[base + 3]); w[2] = pk2(x[base + 4], x[base + 5]); w[3] = pk2(x[base + 6], x[base + 7]);
    return *reinterpret_cast<bf16x8*>(&w);
}
}


#define HG_TOKP(dir, n) ((dir) ? ((n) < CTXL ? (CTXL - 1 - (n)) : (TPB + CTXL - 1 - (n))) : (n))
#define HG_DPP1(x, ctrl, rmask) __int_as_float(__builtin_amdgcn_update_dpp(0x3f800000, __float_as_int(x), ctrl, rmask, 0xf, false))
#define HG_DPP(x, ctrl, rmask) __int_as_float(__builtin_amdgcn_update_dpp(0, __float_as_int(x), ctrl, rmask, 0xf, false))
__device__ __forceinline__ void hgrn_prep_items(const Args& a, LAS unsigned char* lds, int tid) {
    using namespace hg;
    const bf16* Z = (const bf16*)(a.ws + WS_Z);
    unsigned char* HT = a.ws + WS_HT;
    const int wave = __builtin_amdgcn_readfirstlane(tid >> 6), lane = tid & 63, t = lane & 31, half = lane >> 5;
    const int c0 = 16 * wave + 8 * half;
    const int lr = tid >> 4, lch = tid & 15;
    LAS float* lbt = (LAS float*)lds;
    constexpr int P_RAW2 = 2048, P_IMG2 = P_RAW2 + 2 * RAW_BYTES;
    static_assert(P_IMG2 + 2 * IMG_BYTES <= 131072, "prep lds");
    __syncthreads();
    { const float l0 = a.in[I_LBL][tid], l1 = a.in[I_LBL][512 + tid], l2 = a.in[I_LBL][1024 + tid]; const float m = fmaxf(l0, fmaxf(l1, l2));
      const float e0 = __expf(l0 - m), e1 = __expf(l1 - m), e2 = __expf(l2 - m); lbt[tid] = e0 / (e0 + e1 + e2); }
    bf16x8 gq, gf;
#define HP_LOAD(it) do { const int ch_ = (it) % NCHUNK, cn_ = (it) / NCHUNK, dir_ = cn_ & 1, hd_ = (cn_ >> 1) & 3, b_ = cn_ >> 3; \
        const bf16* zr_ = Z + ((size_t)b_ * TPB + HG_TOKP(dir_, 32 * ch_ + lr)) * ZC; gq = *(const bf16x8*)(zr_ + ZHQ + hd_ * 128 + lch * 8); gf = *(const bf16x8*)(zr_ + (dir_ ? ZHB : ZHF) + hd_ * 128 + lch * 8); } while (0)
#define HP_STASH(bufi) do { LAS unsigned char* rb_ = lds + P_RAW2 + (bufi) * RAW_BYTES; *(LAS bf16x8*)(rb_ + R_Q + lr * RS + lch * 16) = gq; *(LAS bf16x8*)(rb_ + R_F + lr * RS + lch * 16) = gf; } while (0)
#define HP_COPYOUT(item, bufi) do { v4u* dst_ = (v4u*)(HT + (size_t)(item) * IMG_BYTES); const LAS v4u* src_ = (const LAS v4u*)(lds + P_IMG2 + (bufi) * IMG_BYTES); \
        dst_[tid] = src_[tid]; dst_[tid + 512] = src_[tid + 512]; dst_[tid + 1024] = src_[tid + 1024]; if (tid < 128) dst_[tid + 1536] = src_[tid + 1536]; } while (0)
    const int G = gridDim.x;
    int it = blockIdx.x, par = 0;
    if (it < NITEM) { HP_LOAD(it); HP_STASH(0); }
    if (it + G < NITEM) HP_LOAD(it + G);
    __syncthreads();
    for (; it < NITEM; it += G, par ^= 1) {
        if (it + G < NITEM) HP_STASH(par ^ 1);
        if (it != (int)blockIdx.x) HP_COPYOUT(it - G, par ^ 1);
        if (it + 2 * G < NITEM) HP_LOAD(it + 2 * G);
        const int hd = ((it / NCHUNK) >> 1) & 3;
        {
            const LAS unsigned char* rb_ = lds + P_RAW2 + par * RAW_BYTES;
            const bf16x8 RQ = *(const LAS bf16x8*)(rb_ + R_Q + t * RS + c0 * 2), RF = *(const LAS bf16x8*)(rb_ + R_F + t * RS + c0 * 2);
            const f32x4 lbA = *(const LAS f32x4*)(lbt + hd * 128 + c0), lbB = *(const LAS f32x4*)(lbt + hd * 128 + c0 + 4);
            LAS unsigned char* tb_ = lds + P_IMG2 + par * IMG_BYTES;
            float bb_[8], kk_[8];
#pragma unroll
            for (int i_ = 0; i_ < 8; ++i_) { const float lb_ = i_ < 4 ? lbA[i_] : lbB[i_ - 4]; const float f_ = lb_ + (1.f - lb_) * __builtin_amdgcn_rcpf(1.f + __expf(-bf2f((unsigned short)RF[i_]))); kk_[i_] = 1.f - f_; bb_[i_] = f_; }
#pragma unroll
            for (int i_ = 0; i_ < 8; ++i_) { float x_ = bb_[i_]; x_ *= HG_DPP1(x_, 0x111, 0xf); x_ *= HG_DPP1(x_, 0x112, 0xf); x_ *= HG_DPP1(x_, 0x114, 0xf); x_ *= HG_DPP1(x_, 0x118, 0xf);
                x_ *= HG_DPP1(x_, 0x142, 0xa); bb_[i_] = x_; }
            float qi_[8], ko_[8], ke_[8], dd_[8];
#pragma unroll
            for (int i_ = 0; i_ < 8; ++i_) { const int bi_ = __float_as_int(bb_[i_]); dd_[i_] = __int_as_float(half ? __builtin_amdgcn_readlane(bi_, 63) : __builtin_amdgcn_readlane(bi_, 31));
                const float e_ = bb_[i_]; const float ei_ = __builtin_amdgcn_rcpf(e_);
                qi_[i_] = bf2f((unsigned short)RQ[i_]) * e_; ko_[i_] = kk_[i_] * ei_; ke_[i_] = kk_[i_] * (dd_[i_] * ei_); }
            *(LAS v4u*)(tb_ + T_Q + t * RS + c0 * 2) = (v4u){pk2(qi_[0], qi_[1]), pk2(qi_[2], qi_[3]), pk2(qi_[4], qi_[5]), pk2(qi_[6], qi_[7])};
            *(LAS v4u*)(tb_ + T_KO + t * RS + c0 * 2) = (v4u){pk2(ko_[0], ko_[1]), pk2(ko_[2], ko_[3]), pk2(ko_[4], ko_[5]), pk2(ko_[6], ko_[7])};
            *(LAS v4u*)(tb_ + T_KE + t * RS + c0 * 2) = (v4u){pk2(ke_[0], ke_[1]), pk2(ke_[2], ke_[3]), pk2(ke_[4], ke_[5]), pk2(ke_[6], ke_[7])};
            if (t == 31) { *(LAS f32x4*)(tb_ + T_D + c0 * 4) = (f32x4){dd_[0], dd_[1], dd_[2], dd_[3]}; *(LAS f32x4*)(tb_ + T_D + c0 * 4 + 16) = (f32x4){dd_[4], dd_[5], dd_[6], dd_[7]}; }
            if (tid < 32) *(LAS v4u*)(tb_ + T_Q + tid * RS + 256) = (v4u){0u, 0u, 0u, 0u};
            else if (tid < 64) *(LAS v4u*)(tb_ + T_KO + (tid - 32) * RS + 256) = (v4u){0u, 0u, 0u, 0u};
            else if (tid < 96) *(LAS v4u*)(tb_ + T_KE + (tid - 64) * RS + 256) = (v4u){0u, 0u, 0u, 0u};
        }
        __syncthreads();
    }
    if (it - G >= (int)blockIdx.x && it - G < NITEM) HP_COPYOUT(it - G, par ^ 1);
    __syncthreads();
#undef HP_COPYOUT
#undef HP_LOAD
#undef HP_STASH
}

__device__ __forceinline__ void hgrn_unit_mfma(const Args& a, int unit, LAS unsigned char* lds, int tid) {
    using namespace hg;
    const int b = unit >> 5, head = (unit >> 3) & 3, dir = (unit >> 2) & 1, sl = unit & 3;
    const bf16* Z = (const bf16*)(a.ws + WS_Z);
    const unsigned char* HT = a.ws + WS_HT + (size_t)((b * 4 + head) * 2 + dir) * NCHUNK * IMG_BYTES;
    bf16* Od = (bf16*)(a.ws + (dir ? WS_OB : WS_OF));
    const int wave = __builtin_amdgcn_readfirstlane(tid >> 6), lane = tid & 63;
    const size_t zb = (size_t)b * TPB;
    constexpr int NCH = NCHUNK;
    const int vr = (tid >> 2) & 31, vp = tid & 3, lvcol = ZHI + head * 128 + sl * 32 + vp * 8, i3 = 1536 + (tid & 127);
    v4u gA0, gA1, gA2, gA3, gB0, gB1, gB2, gB3; bf16x8 gAv, gBv;
#define HG_LOAD(g0, g1, g2, g3, gv, ch) do { const int c_ = (ch) < NCH ? (ch) : NCH - 1; const v4u* src_ = (const v4u*)(HT + (size_t)c_ * IMG_BYTES); \
        g0 = src_[tid]; g1 = src_[tid + 512]; g2 = src_[tid + 1024]; g3 = src_[i3]; gv = *(const bf16x8*)(Z + (zb + HG_TOKP(dir, 32 * c_ + vr)) * ZC + lvcol); } while (0)
#define HG_STASH(g0, g1, g2, g3, gv, bufi) do { LAS unsigned char* tb_ = lds + OFF_TILES + (bufi) * TILE_BYTES; LAS v4u* d_ = (LAS v4u*)tb_; \
        d_[tid] = g0; d_[tid + 512] = g1; d_[tid + 1024] = g2; if (tid < 128) { d_[tid + 1536] = g3; *(LAS bf16x8*)(tb_ + T_V + vr * VS + vp * 16) = gv; } } while (0)
    const int r32 = lane & 31, hi = lane >> 5, g1 = (lane >> 4) & 1, q4 = (lane & 15) >> 2, p4 = lane & 3, cb = 32 * wave;
    const unsigned lbase = (unsigned)(uintptr_t)lds;
    f32x16 S = {};
    HG_LOAD(gA0, gA1, gA2, gA3, gAv, 0); HG_STASH(gA0, gA1, gA2, gA3, gAv, 0); HG_LOAD(gA0, gA1, gA2, gA3, gAv, 1); HG_STASH(gA0, gA1, gA2, gA3, gAv, 1);
    HG_LOAD(gA0, gA1, gA2, gA3, gAv, 2);
    __syncthreads();
#define HG_RD64(dst, addr, OFFS) asm volatile("ds_read_b64 %0, %1 offset:" #OFFS : "=&v"(dst) : "v"(addr) : "memory")
#define HG_MFMA_STAGE(n, bufi) do { \
            const unsigned tb = lbase + OFF_TILES + (bufi) * TILE_BYTES; const LAS unsigned char* tl_ = lds + OFF_TILES + (bufi) * TILE_BYTES; \
            bf16x8 ko[2], qi[2]; s16x4 pvl[2], pvh[2], pql[2], pqh[2], kl[2], kh[2], nvl[2], nvh[2]; f32x4 dsc[4]; \
            _Pragma("unroll") for (int kk = 0; kk < 2; ++kk) { ko[kk] = *(const LAS bf16x8*)(tl_ + T_KO + r32 * RS + (cb + 16 * kk + 8 * hi) * 2); qi[kk] = *(const LAS bf16x8*)(tl_ + T_Q + r32 * RS + (cb + 16 * kk + 8 * hi) * 2); } \
            _Pragma("unroll") for (int sp = 0; sp < 2; ++sp) { \
                const unsigned va = tb + T_V + (16 * sp + 4 * hi + q4) * VS + (16 * g1 + 4 * p4) * 2; pvl[sp] = tr_read(va); pvh[sp] = tr_read(va + 8 * VS);              \
                const unsigned qa = tb + T_Q + r32 * RS + (cb + 16 * sp + 4 * hi) * 2; HG_RD64(pql[sp], qa, 0); HG_RD64(pqh[sp], qa, 16);                                  \
                const unsigned ka = tb + T_KE + (16 * sp + 8 * hi + q4) * RS + (cb + 16 * g1 + 4 * p4) * 2; kl[sp] = tr_read(ka); kh[sp] = tr_read(ka + 4 * RS);        \
                const unsigned vb = tb + T_V + (16 * sp + 8 * hi + q4) * VS + (16 * g1 + 4 * p4) * 2; nvl[sp] = tr_read(vb); nvh[sp] = tr_read(vb + 4 * VS); }            \
            _Pragma("unroll") for (int g = 0; g < 4; ++g) dsc[g] = *(const LAS f32x4*)(tl_ + T_D + (cb + 8 * g + 4 * hi) * 4); \
            asm volatile("s_waitcnt lgkmcnt(0)" ::: "memory"); __builtin_amdgcn_sched_barrier(0); \
            f32x16 X = {}; \
            X = __builtin_amdgcn_mfma_f32_32x32x16_bf16(ko[0], qi[0], X, 0, 0, 0); X = __builtin_amdgcn_mfma_f32_32x32x16_bf16(ko[1], qi[1], X, 0, 0, 0); \
            f32x16 O = {}; \
            O = __builtin_amdgcn_mfma_f32_32x32x16_bf16(cat8(pql[0], pqh[0]), pack8(S, 0), O, 0, 0, 0); O = __builtin_amdgcn_mfma_f32_32x32x16_bf16(cat8(pql[1], pqh[1]), pack8(S, 8), O, 0, 0, 0); \
            _Pragma("unroll") for (int i = 0; i < 16; ++i) S[i] *= dsc[i >> 2][i & 3]; \
            S = __builtin_amdgcn_mfma_f32_32x32x16_bf16(cat8(kl[0], kh[0]), cat8(nvl[0], nvh[0]), S, 0, 0, 0); S = __builtin_amdgcn_mfma_f32_32x32x16_bf16(cat8(kl[1], kh[1]), cat8(nvl[1], nvh[1]), S, 0, 0, 0); \
            _Pragma("unroll") for (int i = 0; i < 16; ++i) X[i] = (crow(i, hi) <= r32) ? X[i] : 0.f; \
            O = __builtin_amdgcn_mfma_f32_32x32x16_bf16(pack8(X, 0), cat8(pvl[0], pvh[0]), O, 0, 0, 0); O = __builtin_amdgcn_mfma_f32_32x32x16_bf16(pack8(X, 8), cat8(pvl[1], pvh[1]), O, 0, 0, 0); \
            LAS float* op = (LAS float*)(lds + OFF_OPART + ((n) & 1) * OPART_BYTES + wave * 4096); \
            _Pragma("unroll") for (int i = 0; i < 16; ++i) op[crow(i, hi) * 32 + r32] = O[i]; } while (0)
#define HG_OUT_STAGE(n) do { \
            const int l2 = tid - 256, tt = l2 >> 3, vq = l2 & 7; \
            const LAS float* op = (const LAS float*)(lds + OFF_OPART + (((n) - 1) & 1) * OPART_BYTES) + tt * 32 + vq * 4; \
            const f32x4 s = (*(const LAS f32x4*)op + *(const LAS f32x4*)(op + 1024)) + (*(const LAS f32x4*)(op + 2048) + *(const LAS f32x4*)(op + 3072)); \
            const int p = HG_TOKP(dir, 32 * ((n) - 1) + tt); \
            if (p >= CTXL) *(v2u*)(Od + (zb + p) * 512 + head * 128 + sl * 32 + vq * 4) = (v2u){pk2(s[0], s[1]), pk2(s[2], s[3])}; } while (0)
#define HG_ITER(n, L0, L1, L2, L3, LV, S0, S1, S2, S3, SV) do { \
        HG_LOAD(L0, L1, L2, L3, LV, (n) + 3); \
        if (wave < 4) { HG_MFMA_STAGE(n, bcur); } else if ((n) > 0) { HG_OUT_STAGE(n); } \
        { const int bst_ = bcur == 0 ? 2 : bcur - 1; HG_STASH(S0, S1, S2, S3, SV, bst_); } \
        bcur = bcur == 2 ? 0 : bcur + 1; \
        __syncthreads(); } while (0)
    int bcur = 0;
    for (int n = 0; n < NCH; n += 2) {
        HG_ITER(n, gB0, gB1, gB2, gB3, gBv, gA0, gA1, gA2, gA3, gAv);
        HG_ITER(n + 1, gA0, gA1, gA2, gA3, gAv, gB0, gB1, gB2, gB3, gBv);
    }
    if (wave >= 4) { HG_OUT_STAGE(NCH); }
    __syncthreads();
#undef HG_MFMA_STAGE
#undef HG_OUT_STAGE
#undef HG_ITER
#undef HG_LOAD
#undef HG_STASH
#undef HG_RD64
}

__device__ __forceinline__ bool in_range(int lo, int hi, int k) { asm volatile("" : "+s"(lo), "+s"(hi)); return lo <= k && k < hi; }
constexpr int NPHASES = 21;
__global__ void __launch_bounds__(NTHR, 2) fwd_kernel(Args args) {
    extern __shared__ __attribute__((aligned(16))) unsigned char lds_raw[];
    LAS unsigned char* lds = (LAS unsigned char*)lds_raw;
    const int G = gridDim.x;
#define FRESH() int tid = threadIdx.x; asm volatile("" : "+v"(tid)); const int lane = tid & 63, wave = __builtin_amdgcn_readfirstlane(tid >> 6); (void)lane; (void)wave
    unsigned char* ws = args.ws;
    if (threadIdx.x < 16) ((LAS unsigned*)(lds + LDS_BAR_OFF))[threadIdx.x] = 0u;
    __syncthreads();
    XcdBarrier bar = xcd_barrier_post((unsigned*)(ws + WS_CTL), (volatile LAS unsigned*)(lds + LDS_BAR_OFF));
    const int lo = args.ph_lo, hi = args.ph_hi;
#define IN(k) in_range(lo, hi, (k))
#define NREP(k) (((PROBE_MASK >> (k)) & 1u) ? 2 : 1)
#define REPEAT(k) for (int rep_ = 0; rep_ < NREP(k); ++rep_) if (rep_ == 0 || (xcd_barrier(bar), true))
#define SEAM(k) do { if (IN(k) && IN((k) + 1)) xcd_barrier(bar); } while (0)
    bf16* const BX = (bf16*)(ws + WS_X); bf16* const BY = (bf16*)(ws + WS_Y);
    const float* const MODV = (const float*)(ws + WS_MODV);

#if defined(PROBE_BARS)
    for (int pbi = 0; pbi < PROBE_BARS; ++pbi) xcd_barrier(bar);
#endif
    if (IN(0)) REPEAT(0) { FRESH(); phase_prologue(args, lds, tid, lane, wave); } SEAM(0);
    if (IN(1)) REPEAT(1) { FRESH(); phase_mod0(args, lane, wave); } SEAM(1);
    if (IN(2)) REPEAT(2) {
        pg8::Gemm g{BX, (const bf16*)(ws + WS_WIN), NTOK, ZC, 1024}; pg8::AllOrder S; S.init(NTOK / 256, ZC / 256, G, (int)blockIdx.x);
        pg8::EpiBf16<0> E{(bf16*)(ws + WS_Z), ZC, nullptr, 0, 0, 1.f};
        pg8::gemm_phase<pg8::EpiBf16<0>, pg8::AllOrder, PG8_ALIGN, PG8_SP2>(lds, g, S, E);
    } SEAM(2);
    if (IN(3)) REPEAT(3) { FRESH(); phase_norm0(args, lane, wave); hgrn_prep_items(args, lds, tid); } SEAM(3);
    if (IN(4)) REPEAT(4) {
        { pg8::Gemm g{(const bf16*)(ws + WS_CQN), (const bf16*)(ws + WS_WUQ), NTOK, 768, 384}; pg8::LatOrder S; S.init(128, 3, G, (int)blockIdx.x);
          pg8::EpiBf16<0> E{(bf16*)(ws + WS_Q), 768, nullptr, 0, 0, 1.f};
          pg8::gemm_phase<pg8::EpiBf16<0>, pg8::LatOrder, PG8_ALIGN, PG8_SP2>(lds, g, S, E); }
        __syncthreads();
        { pg8::Gemm g{(const bf16*)(ws + WS_CKVN), (const bf16*)(ws + WS_WUKV), NTOK, 1024, 256}; pg8::AllOrder S; S.init(NTOK / 256, 4, G, G - 1 - (int)blockIdx.x);
          pg8::EpiBf16<0> E{(bf16*)(ws + WS_KV), 1024, nullptr, 0, 0, 1.f};
          pg8::gemm_phase<pg8::EpiBf16<0>, pg8::AllOrder, PG8_ALIGN, PG8_SP2>(lds, g, S, E); }
    } SEAM(4);
    if (IN(5)) {
        REPEAT(21) { FRESH();
        for (int u = blockIdx.x; u < 256; u += G) { __syncthreads(); hgrn_unit_mfma(args, (G == 256) ? ((u & 7) * 32 + (u >> 3)) : u, lds, tid); } }
        const bf16* Q = (const bf16*)(ws + WS_Q); const bf16* KV = (const bf16*)(ws + WS_KV); const bf16* KRR = (const bf16*)(ws + WS_KRR);
        const float* rope = (const float*)(ws + WS_ROPE);
        const int cslot = (G == 256) ? ((((int)blockIdx.x & 7) * 2 + (((int)blockIdx.x >> 3) >> 4)) % 5) : 0;
        REPEAT(22) {
        int ai = 0;
        for (int slot = 0; slot < 5; ++slot) {
            if (slot == cslot) { if (rep_ == 0) { FRESH(); __syncthreads(); convert_moe_share(args, lds, lane, wave); } continue; }
            for (int u = (G == 256) ? (int)blockIdx.x + ai * 256 : (int)blockIdx.x; u < ((G == 256) ? (int)blockIdx.x + ai * 256 + 1 : (ai == 0 ? 1024 : 0)); u += G) {
                int b, h, qb; if (G == 256) { const int x = (int)blockIdx.x & 7, j = (int)blockIdx.x >> 3, pr = (u >> 8) * 16 + 2 * x + (j >> 4); b = pr >> 3; h = pr & 7; qb = j & 15; } else { b = u >> 7; h = (u >> 4) & 7; qb = u & 15; }
                const size_t kb = (size_t)b * TPB, q0 = kb + CTXL + (size_t)qb * 256;
                __syncthreads();
                att::attn_unit(Q + q0 * 768 + h * 96, KV + kb * 1024 + h * 64, KRR + kb * 32, BY + q0 * 1024 + h * 64, rope + (size_t)qb * 256 * 32, TPB, (char*)lds_raw);
            }
            ++ai;
        }
        }
    } SEAM(5);
    if (IN(6)) REPEAT(6) { FRESH(); phase_readout(args, lane, wave); } SEAM(6);
    if (IN(7)) REPEAT(7) {
        pg8::Gemm g{BY, (const bf16*)(ws + WS_WOUT), NTOK, 1024, 1024}; pg8::LatOrder S; S.init(128, 4, G, (int)blockIdx.x);
        pg8::EpiRes E{args.in[I_X], (const float*)(ws + WS_H), (bf16*)(ws + WS_PRE), MODV, nullptr};
        pg8::gemm_phase<pg8::EpiRes, pg8::LatOrder, PG8_ALIGN, PG8_SP2>(lds, g, S, E);
    } SEAM(7);
    for (int l = 0; l < 2; ++l) {
        if (l == 1) {
            if (IN(13)) REPEAT(13) {
                pg8::Gemm g{BY, (const bf16*)(ws + WS_WPW1), NTOK, 2048, 1024}; pg8::LatOrder S; S.init(128, 8, G, (int)blockIdx.x);
                pg8::EpiGate<0> E{BX, (const float*)(ws + WS_PW1B), 8, 1.f, 1.f};
                pg8::gemm_phase<pg8::EpiGate<0>, pg8::LatOrder, PG8_ALIGN, PG8_SP2>(lds, g, S, E);
            } SEAM(13);
            if (IN(14)) REPEAT(14) { FRESH(); phase_conv(args, lds, tid, lane, wave); } SEAM(14);
            if (IN(15)) REPEAT(15) {
                pg8::Gemm g{BY, (const bf16*)(ws + WS_WPW2), NTOK, 1024, 1024}; pg8::LatOrder S; S.init(128, 4, G, (int)blockIdx.x);
                pg8::EpiRes E{nullptr, (const float*)(ws + WS_H), (bf16*)(ws + WS_PRE), MODV + 9 * 6144, args.in[I_PW2B]};
                pg8::gemm_phase<pg8::EpiRes, pg8::LatOrder, PG8_ALIGN, PG8_SP2>(lds, g, S, E);
            } SEAM(15);
        }
        const int pb = l ? 16 : 8;
        if (IN(pb)) REPEAT(pb) { FRESH(); phase_ln1(args, l, lds, tid, lane, wave); } SEAM(pb);
        if (IN(pb + 2) || IN(pb + 3)) {
            LAS int* tl = (LAS int*)(lds + LDS_TILE_E);
            FRESH();
            __syncthreads();
            if (tid < 32) tl[3 * MAXTILES + 64 + tid] = ld_ctl((const int*)(ws + WS_CURSOR) + l * 32 + tid);
            __syncthreads();
            if (tid == 0) { int ts = 0; for (int e = 0; e < 32; ++e) { tl[3 * MAXTILES + e] = ts; ts += (tl[3 * MAXTILES + 64 + e] + 255) >> 8; } tl[3 * MAXTILES + 32] = ts; }
            __syncthreads();
            const int ntiles = tl[3 * MAXTILES + 32];
            for (int t = tid; t < ntiles && t < MAXTILES; t += NTHR) { int e = 0; while (e < 31 && tl[3 * MAXTILES + e + 1] <= t) ++e; const int j = t - tl[3 * MAXTILES + e], rem = tl[3 * MAXTILES + 64 + e] - 256 * j;
                tl[t] = e; tl[MAXTILES + t] = e * ECAP + 256 * j; tl[2 * MAXTILES + t] = rem < 256 ? rem : 256; }
            __syncthreads();
            if (IN(pb + 2)) REPEAT(pb + 2) {
#if defined(PROBE_STAGGER)
                if (blockIdx.x & 1) { const unsigned long long t0 = __builtin_amdgcn_s_memrealtime(); while (__builtin_amdgcn_s_memrealtime() - t0 < PROBE_STAGGER) __builtin_amdgcn_s_sleep(8); }
#endif
                pg8::Gemm g{BX, (const bf16*)(ws + WS_WGU + (size_t)l * 32 * 2048 * 1024), 0, 0, 512};
                pg8::MoeOrder S; S.init(ntiles, 8, G, (int)blockIdx.x); S.tile_e = tl; S.nper = 8;
                pg8::EpiGate<1, true> E{(bf16*)(ws + WS_ACT), (const float*)(ws + WS_BGU) + (size_t)l * 32 * 2048, 8, 1.f / (SC_X8 * SC_WGU) * PROBE_KSC, SC_ACT};
                pg8::gemm_phase<pg8::EpiGate<1, true>, pg8::MoeOrder, PG8_ALIGN, true, true, true>(lds, g, S, E, (const int*)(ws + WS_ROWS), tl + MAXTILES);
            } SEAM(pb + 2);
            if (IN(pb + 3)) REPEAT(pb + 3) {
                pg8::Gemm g{(const bf16*)(ws + WS_ACT), (const bf16*)(ws + WS_WDN + (size_t)l * 32 * 1024 * 1024), 0, 0, 512};
                pg8::MoeOrder S; S.init(ntiles, 4, G, (int)blockIdx.x); S.tile_e = tl; S.nper = 4;
                pg8::EpiDown E{(bf16*)(ws + WS_YB), args.in[I_BDN] + (size_t)l * 32 * 1024, (const float*)(ws + WS_ROWW), (const int*)(ws + WS_ROWD), 1.f / (SC_ACT * SC_WDN) * PROBE_KSC, tl + MAXTILES, SC_Y};
                pg8::gemm_phase<pg8::EpiDown, pg8::MoeOrder, PG8_ALIGN, true, false, true>(lds, g, S, E);
            } SEAM(pb + 3);
        }
        if (IN(pb + 4)) REPEAT(pb + 4) { FRESH(); phase_ln2(args, l, lane, wave); }
        if (l == 0) SEAM(12);
    }
#undef IN
#undef SEAM
}

extern "C" void kernel_launch(void* const* d_in, const int* in_sizes, int n_in, void* d_out, int out_size, void* d_ws, size_t ws_size, hipStream_t stream) {
    static int grid = 0;
    if (grid == 0) {
        if (n_in != 33 || in_sizes[0] != NB * SEQ * D || out_size != NB * SEQ * D || ws_size < WS_END) {
            fprintf(stderr, "kernel_launch: unexpected shapes: n_in %d in0 %d out %d ws %zu (need %zu)\n", n_in, n_in > 0 ? in_sizes[0] : -1, out_size, ws_size, (size_t)WS_END); grid = -1; return; }
        int dev = 0, cus = 0;
        if (hipGetDevice(&dev) != hipSuccess || hipDeviceGetAttribute(&cus, hipDeviceAttributeMultiprocessorCount, dev) != hipSuccess) { grid = -1; return; }
        if (hipFuncSetAttribute((const void*)fwd_kernel, hipFuncAttributeMaxDynamicSharedMemorySize, LDS_BYTES) != hipSuccess) { fprintf(stderr, "kernel_launch: hipFuncSetAttribute failed\n"); grid = -1; return; }
        int per_cu = 0;
        if (hipOccupancyMaxActiveBlocksPerMultiprocessor(&per_cu, (const void*)fwd_kernel, NTHR, LDS_BYTES) != hipSuccess || per_cu < 1) fprintf(stderr, "kernel_launch: occupancy query reports %d\n", per_cu);
        (void)hipGetLastError();
        grid = cus;
    }
    if (grid < 0) return;
    if (hipMemsetAsync((char*)d_ws + WS_CTL, 0, CTL_ZERO_BYTES, stream) != hipSuccess) return;
    Args a{};
    for (int i = 0; i < 33; ++i) a.in[i] = (const float*)d_in[i];
    a.out = (float*)d_out; a.ws = (unsigned char*)d_ws;
#if MK_ONE_LAUNCH
    a.ph_lo = 0; a.ph_hi = NPHASES;
    hipLaunchKernelGGL(fwd_kernel, dim3(grid), dim3(NTHR), LDS_BYTES, stream, a);
#else
    for (int ph = 0; ph < NPHASES; ++ph) { a.ph_lo = ph; a.ph_hi = ph + 1; hipLaunchKernelGGL(fwd_kernel, dim3(grid), dim3(NTHR), LDS_BYTES, stream, a); }
#endif
    const hipError_t le = hipPeekAtLastError();
    if (le != hipSuccess) fprintf(stderr, "kernel_launch: launch failed: %s\n", hipGetErrorName(le));
}
```

```cpp
#include <hip/hip_runtime.h>
#include <cstdio>
#include <cstdint>

#ifndef PROBE_MASK
#define PROBE_MASK 0u
#endif
#if defined(PROBE_K2)
#define PROBE_KSC 0.5f
#else
#define PROBE_KSC 1.0f
#endif
#ifndef MK_ONE_LAUNCH
#define MK_ONE_LAUNCH 1
#endif

namespace pg8 {
#define PG8_LAS __attribute__((address_space(3)))
typedef unsigned short bf16_t;
typedef short bf16x8 __attribute__((ext_vector_type(8)));
typedef float f32x4 __attribute__((ext_vector_type(4)));
typedef unsigned u32x4 __attribute__((ext_vector_type(4)));
constexpr int BM = 256, BK = 64, HALF = 128, HTB = HALF * BK * 2  , STAGE_BYTES = 8 * HTB, NXCD = 8, WGM = 8;

__host__ __device__ __forceinline__ int lds_byte(int r, int c) { const int st = (r >> 4) * 2 + (c >> 5), rr = r & 15, cc = c & 31, ob = rr * 64 + cc * 2; return st * 1024 + (ob ^ (((ob >> 9) & 1) << 5)); }
__host__ __device__ __forceinline__ void stage_rc(int b, int& R, int& C) { const int st = b / 1024, sb = b % 1024, swz = sb ^ (((sb >> 9) & 1) << 5); R = (st >> 1) * 16 + swz / 64; C = (st & 1) * 32 + (swz % 64) / 2; }
__host__ __device__ __forceinline__ int perm32(int rho) { const int n = rho >> 4, i = rho & 15; return 8 * (i >> 2) + 4 * n + (i & 3); }

struct Unit { int pm, pn; };
struct Gemm { const bf16_t* A; const bf16_t* Bt; int M, N, K; };

struct StaticOrder {
    int nM, nN, nwg, G, c;
    __host__ __device__ void init(int M, int N, int G_, int c_) { nM = M / BM; nN = N / BM; nwg = nM * nN; G = G_; c = c_; }
    __host__ __device__ bool next(int i, Unit& u) const {
        const long L = (long)i * G + c; if (L >= nwg) return false;
        int wgid = (int)L; { const int q = nwg / NXCD, r = nwg % NXCD, xcd = wgid % NXCD, off = wgid / NXCD; wgid = (xcd < r ? xcd * (q + 1) : r * (q + 1) + (xcd - r) * q) + off; }
        const int nig = WGM * nN, gid = wgid / nig, fm = gid * WGM, gsz = (nM - fm) < WGM ? (nM - fm) : WGM;
        u.pm = fm + ((wgid % nig) % gsz); u.pn = (wgid % nig) / gsz; return true;
    }
    __device__ __forceinline__ void a_ready(const Unit&) const {}
    __device__ __forceinline__ void done(const Unit&) const {}
};

__device__ __forceinline__ unsigned cvt_pk_bf16(float lo, float hi) { unsigned r; asm volatile("v_cvt_pk_bf16_f32 %0, %1, %2" : "=v"(r) : "v"(lo), "v"(hi)); return r; }
typedef float f32x2 __attribute__((ext_vector_type(2)));
__device__ __forceinline__ f32x2 gelu_pk(f32x2 v) {
    const f32x2 av = __builtin_elementwise_abs(v), d = av * 0.2316418882f + 1.0f;
    f32x2 t; t.x = __builtin_amdgcn_rcpf(d.x); t.y = __builtin_amdgcn_rcpf(d.y);
    f32x2 q = t * 0.5307027145f + (-0.7265760135f); q = q * t + 0.7107068705f; q = q * t + (-0.142248368f); q = q * t + 0.127414796f; q = q * t;
    const f32x2 s = (v * v) * (-0.72134752044f);
    f32x2 e; e.x = __builtin_amdgcn_exp2f(s.x); e.y = __builtin_amdgcn_exp2f(s.y);
    const f32x2 m = v * (q * e), r = v - m;
    f32x2 o; o.x = v.x < 0.f ? m.x : r.x; o.y = v.y < 0.f ? m.y : r.y; return o;
}

template <int ACT  > struct EpiBf16 {
    static constexpr bool PERM = true, AFTER_DRAIN = false; static_assert(ACT == 0 || ACT == 1, "EpiBf16: ACT is 0 (none) or 1 (gelu_pk)");
    bf16_t* O; int ldc; const float* bias; int split_cols; size_t split_stride; float scale0;
    __device__ __forceinline__ void operator()(const f32x4 (&acc)[2][2][4][2], const Unit& u, int wr, int wc, int fr, int fq) const {
        const int row0 = u.pm * BM + wr * 64 + fr; int colt = u.pn * BM; bf16_t* base = O;
        float sc = 1.f; if (split_cols) { const int t = colt / split_cols; base += (size_t)t * split_stride; colt -= t * split_cols; if (t == 0) sc = scale0; }
        const int col0 = colt + wc * 32 + 8 * fq, bcol0 = u.pn * BM + wc * 32 + 8 * fq;
        f32x4 bv[2][2];
#pragma unroll
        for (int bj = 0; bj < 2; ++bj)
#pragma unroll
            for (int n = 0; n < 2; ++n) bv[bj][n] = bias ? *(const f32x4*)(bias + bcol0 + bj * HALF + 4 * n) : (f32x4){0.f, 0.f, 0.f, 0.f};
#pragma unroll
        for (int ai = 0; ai < 2; ++ai)
#pragma unroll
            for (int m = 0; m < 4; ++m) { bf16_t* rowp = base + (size_t)(row0 + ai * HALF + m * 16) * ldc + col0;
#pragma unroll
                for (int bj = 0; bj < 2; ++bj) { f32x4 v0 = acc[ai][bj][m][0] + bv[bj][0], v1 = acc[ai][bj][m][1] + bv[bj][1];
                    if (ACT == 1) { f32x2 a = gelu_pk((f32x2){v0[0], v0[1]}), b = gelu_pk((f32x2){v0[2], v0[3]}), c = gelu_pk((f32x2){v1[0], v1[1]}), d = gelu_pk((f32x2){v1[2], v1[3]});
                        v0 = (f32x4){a.x, a.y, b.x, b.y}; v1 = (f32x4){c.x, c.y, d.x, d.y}; }
                    v0 = v0 * sc; v1 = v1 * sc; u32x4 w; w.x = cvt_pk_bf16(v0[0], v0[1]); w.y = cvt_pk_bf16(v0[2], v0[3]); w.z = cvt_pk_bf16(v1[0], v1[1]); w.w = cvt_pk_bf16(v1[2], v1[3]);
                    *(u32x4*)(rowp + bj * HALF) = w; } }
    }
};
typedef int v4i_t __attribute__((ext_vector_type(4)));
typedef int v8i_t __attribute__((ext_vector_type(8)));
__device__ __forceinline__ v8i_t cat32(bf16x8 a, bf16x8 b) { const v4i_t x = __builtin_bit_cast(v4i_t, a), y = __builtin_bit_cast(v4i_t, b); return __builtin_shufflevector(x, y, 0, 1, 2, 3, 4, 5, 6, 7); }
template <class Epi, class Sched, bool ALIGN_EPI = false, bool SP2 = false, bool GATHER = false, bool FP8 = false>
__device__ __forceinline__ void gemm_phase(PG8_LAS unsigned char* lds, const Gemm g, const Sched& S, const Epi& E, const int* rowsrc = nullptr, const PG8_LAS int* gtab = nullptr) {
    static_assert(!GATHER || SP2, "GATHER is implemented on the SP2 loop only");
    int tid_l = threadIdx.x; asm volatile("" : "+v"(tid_l));
    const int tid = tid_l, wid = __builtin_amdgcn_readfirstlane(tid >> 6), lane = tid & 63, wr = wid >> 2, wc = wid & 3, fr = lane & 15, fq = lane >> 4;
#if defined(PROBE_K2)
    const int K = g.K, nt0 = K / BK, nt = FP8 ? 2 * nt0 : nt0;
#define PG8_KT(x) (FP8 ? ((x) & (nt0 - 1)) : (x))
#else
    const int K = g.K, nt = K / BK;
#define PG8_KT(x) (x)
#endif
    unsigned voffA[2], voffB[2];
#pragma unroll
    for (int i = 0; i < 2; ++i) { int R, C; stage_rc(tid * 16 + i * 8192, R, C); const int Rb = Epi::PERM ? ((R & ~31) + perm32(R & 31)) : R;
        voffA[i] = (unsigned)(R * K + C) * 2u; voffB[i] = (unsigned)(Rb * K + C) * 2u; }
    unsigned gAc[2][2], gAn[2][2]; int gR[2]; unsigned gC[2];
#pragma unroll
    for (int i = 0; i < 2; ++i) { int R, C; stage_rc(tid * 16 + i * 8192, R, C); gR[i] = R; gC[i] = (unsigned)C * 2u; gAc[0][i] = gAc[1][i] = gAn[0][i] = gAn[1][i] = 0u; }
#define PG8_GATHER(u_, o_) do { const int gtb_ = gtab[(u_).pm], gtc_ = gtab[576 + (u_).pm];     \
        _Pragma("unroll") for (int h_ = 0; h_ < 2; ++h_) _Pragma("unroll") for (int i_ = 0; i_ < 2; ++i_) \
        { const int rl_ = h_ * HALF + gR[i_]; const int src_ = rl_ < gtc_ ? rowsrc[gtb_ + rl_] : 0; o_[h_][i_] = (unsigned)src_ * (unsigned)(K * 2) + gC[i_]; } } while (0)
#define PG8_STAGE_A(bufoff, orig_gbase, NEXTSEL, H, KOFF) do { if constexpr (GATHER) { unsigned vo_[2]; vo_[0] = (NEXTSEL) ? gAn[H][0] : gAc[H][0]; vo_[1] = (NEXTSEL) ? gAn[H][1] : gAc[H][1]; \
        PG8_STAGE(bufoff, (const char*)g.A + (KOFF), vo_); } else { PG8_STAGE(bufoff, orig_gbase, voffA); } } while (0)
    const size_t kstep = (size_t)(BK * 2);
    const size_t hstep = (size_t)HALF * K * 2;
    const size_t tstep = 2 * hstep;
    const unsigned ldsw = (unsigned)wid * 1024u;
    const int aoff = lds_byte(wr * 64 + fr, fq * 8), boff = lds_byte(wc * 32 + fr, fq * 8);
#define PG8_SA(b, h) (((b) * 2 + (h)) * HTB)
#define PG8_SB(b, h) ((4 + (b) * 2 + (h)) * HTB)
#define PG8_STAGE(bufoff, gbase, voff) do { _Pragma("unroll") for (int _i = 0; _i < 2; ++_i) \
        __builtin_amdgcn_global_load_lds((const unsigned*)((const char*)(gbase) + (voff)[_i]), (PG8_LAS unsigned*)(lds + (bufoff) + ldsw + _i * 8192), 16, 0, 0); } while (0)
#define PG8_LD32(var, addr) do { const bf16x8 lo_ = *(const PG8_LAS bf16x8*)(addr); const bf16x8 hi_ = *(const PG8_LAS bf16x8*)((addr) + 1024); var = cat32(lo_, hi_); } while (0)
#define PG8_LDA(dst, b, h) do { if constexpr (FP8) { _Pragma("unroll") for (int m = 0; m < 4; ++m) PG8_LD32(dst##8[m], lds + PG8_SA(b, h) + aoff + m * 2048); } \
        else { _Pragma("unroll") for (int m = 0; m < 4; ++m) _Pragma("unroll") for (int k = 0; k < 2; ++k) dst[m][k] = *(const PG8_LAS bf16x8*)(lds + PG8_SA(b, h) + aoff + m * 2048 + k * 1024); } } while (0)
#define PG8_LDB(dst, b, h) do { if constexpr (FP8) { _Pragma("unroll") for (int n = 0; n < 2; ++n) PG8_LD32(dst##8[n], lds + PG8_SB(b, h) + boff + n * 2048); } \
        else { _Pragma("unroll") for (int n = 0; n < 2; ++n) _Pragma("unroll") for (int k = 0; k < 2; ++k) dst[n][k] = *(const PG8_LAS bf16x8*)(lds + PG8_SB(b, h) + boff + n * 2048 + k * 1024); } } while (0)
#define PG8_MMA(ai, bj, At, Bt) do { __builtin_amdgcn_s_setprio(1); \
        if constexpr (FP8) { _Pragma("unroll") for (int m = 0; m < 4; ++m) _Pragma("unroll") for (int n = 0; n < 2; ++n) \
            asm volatile("v_mfma_scale_f32_16x16x128_f8f6f4 %0, %1, %2, %0, %3, %3 op_sel_hi:[0,0,0]" : "+v"(acc[ai][bj][m][n]) : "v"(Bt##8[n]), "v"(At##8[m]), "v"(sc127)); } \
        else { _Pragma("unroll") for (int m = 0; m < 4; ++m) _Pragma("unroll") for (int n = 0; n < 2; ++n) _Pragma("unroll") for (int k = 0; k < 2; ++k) \
            acc[ai][bj][m][n] = __builtin_amdgcn_mfma_f32_16x16x32_bf16(Bt[n][k], At[m][k], acc[ai][bj][m][n], 0, 0, 0); } \
        __builtin_amdgcn_s_setprio(0); } while (0)
#define PG8_WAIT_V(n) asm volatile("s_waitcnt vmcnt(" #n ")" ::: "memory")
#define PG8_WAIT_L(n) asm volatile("s_waitcnt lgkmcnt(" #n ")" ::: "memory")
#define PG8_BAR __builtin_amdgcn_s_barrier()
#define PG8_SCHED __builtin_amdgcn_sched_barrier(0)
    Unit cur, nxt; int ui = 0;
    if (!S.next(0, cur)) return;
    f32x4 acc[2][2][4][2];
#pragma unroll
    for (int a = 0; a < 2; ++a)
#pragma unroll
        for (int b = 0; b < 2; ++b)
#pragma unroll
            for (int m = 0; m < 4; ++m)
#pragma unroll
                for (int n = 0; n < 2; ++n) acc[a][b][m][n] = (f32x4){0.f, 0.f, 0.f, 0.f};
    int sc127 = 0x7f7f7f7f; asm volatile("" : "+v"(sc127));
    bf16x8 At[4][2], B0[2][2], B1[2][2]; v8i_t At8[4], B08[2], B18[2]; (void)At; (void)B0; (void)B1; (void)At8; (void)B08; (void)B18;
    const char* cA = (const char*)g.A + (size_t)cur.pm * tstep; const char* cB = (const char*)g.Bt + (size_t)cur.pn * tstep;
    S.a_ready(cur);
    if constexpr (GATHER) { PG8_GATHER(cur, gAc); }
    if constexpr (SP2) {
        PG8_STAGE(PG8_SB(0, 0), cB, voffB); PG8_STAGE(PG8_SB(0, 1), cB + hstep, voffB); PG8_STAGE_A(PG8_SA(0, 0), cA, false, 0, (size_t)0); PG8_STAGE_A(PG8_SA(0, 1), cA + hstep, false, 1, (size_t)0);
        if (wr == 1) PG8_BAR;
        PG8_WAIT_V(2); PG8_BAR;
        PG8_STAGE(PG8_SB(1, 0), cB + kstep, voffB); PG8_STAGE_A(PG8_SA(1, 0), cA + kstep, false, 0, kstep); PG8_STAGE(PG8_SB(1, 1), cB + hstep + kstep, voffB);
        PG8_WAIT_V(6); PG8_BAR;
    } else {
        PG8_STAGE(PG8_SB(0, 0), cB, voffB); PG8_STAGE(PG8_SA(0, 0), cA, voffA); PG8_STAGE(PG8_SB(0, 1), cB + hstep, voffB); PG8_STAGE(PG8_SA(0, 1), cA + hstep, voffA);
        if (wr == 1) PG8_BAR;
        PG8_WAIT_V(4); PG8_BAR;
        PG8_STAGE(PG8_SB(1, 0), cB + kstep, voffB); PG8_STAGE(PG8_SA(1, 0), cA + kstep, voffA); PG8_STAGE(PG8_SB(1, 1), cB + hstep + kstep, voffB);
        PG8_WAIT_V(6); PG8_BAR;
    }
    for (;;) {
        const bool has_next = S.next(ui + 1, nxt);
        if constexpr (GATHER) { if (has_next) { PG8_GATHER(nxt, gAn); } else { _Pragma("unroll") for (int h_ = 0; h_ < 2; ++h_) _Pragma("unroll") for (int i_ = 0; i_ < 2; ++i_) gAn[h_][i_] = gAc[h_][i_]; } }
        const char* nA = has_next ? (const char*)g.A + (size_t)nxt.pm * tstep : cA; const char* nB = has_next ? (const char*)g.Bt + (size_t)nxt.pn * tstep : cB;
#pragma nounroll
        for (int t = 0; t < nt; t += 2) {
            const bool last = (t == nt - 2);
            const char* a1 = cA + (size_t)PG8_KT(t + 1) * kstep;
            const char* a2 = last ? nA : cA + (size_t)PG8_KT(t + 2) * kstep; const char* b2 = last ? nB : cB + (size_t)PG8_KT(t + 2) * kstep;
            const char* a3 = a2 + kstep; const char* b3 = b2 + kstep;
            const size_t k1 = (size_t)PG8_KT(t + 1) * kstep, k2 = last ? (size_t)0 : (size_t)PG8_KT(t + 2) * kstep, k3 = k2 + kstep; (void)k1; (void)k2; (void)k3;
            if (last && has_next) S.a_ready(nxt);
            if constexpr (SP2) {
            PG8_LDB(B0, 0, 0); PG8_LDB(B1, 0, 1); PG8_SCHED; PG8_LDA(At, 0, 0); PG8_STAGE_A(PG8_SA(1, 1), a1 + hstep, false, 1, k1);
            PG8_WAIT_V(8); PG8_WAIT_L(0); PG8_BAR; PG8_MMA(0, 0, At, B0); PG8_MMA(0, 1, At, B1); PG8_BAR; PG8_SCHED;
            PG8_LDA(At, 0, 1); PG8_STAGE(PG8_SB(0, 0), b2, voffB); PG8_STAGE(PG8_SB(0, 1), b2 + hstep, voffB); PG8_STAGE_A(PG8_SA(0, 0), a2, last, 0, k2);
            PG8_WAIT_V(8); PG8_WAIT_L(0); PG8_BAR; PG8_MMA(1, 0, At, B0); PG8_MMA(1, 1, At, B1); PG8_BAR; PG8_SCHED;
            PG8_LDB(B0, 1, 0); PG8_LDB(B1, 1, 1); PG8_SCHED; PG8_LDA(At, 1, 0); PG8_STAGE_A(PG8_SA(0, 1), a2 + hstep, last, 1, k2);
            PG8_WAIT_V(8); PG8_WAIT_L(0); PG8_BAR; PG8_MMA(0, 0, At, B0); PG8_MMA(0, 1, At, B1); PG8_BAR; PG8_SCHED;
            PG8_LDA(At, 1, 1); PG8_STAGE(PG8_SB(1, 0), b3, voffB); PG8_STAGE(PG8_SB(1, 1), b3 + hstep, voffB); PG8_STAGE_A(PG8_SA(1, 0), a3, last, 0, k3);
            PG8_WAIT_V(8); PG8_WAIT_L(0); PG8_BAR; PG8_MMA(1, 0, At, B0); PG8_MMA(1, 1, At, B1); PG8_BAR; PG8_SCHED;
            } else {
            PG8_LDB(B0, 0, 0); PG8_SCHED; PG8_LDA(At, 0, 0); PG8_STAGE(PG8_SA(1, 1), a1 + hstep, voffA);
            PG8_WAIT_L(8); PG8_BAR; PG8_WAIT_L(0); PG8_MMA(0, 0, At, B0); PG8_BAR; PG8_SCHED;
            PG8_LDB(B1, 0, 1); PG8_STAGE(PG8_SB(0, 0), b2, voffB);
            PG8_BAR; PG8_WAIT_L(0); PG8_MMA(0, 1, At, B1); PG8_BAR;
            PG8_LDA(At, 0, 1); PG8_STAGE(PG8_SA(0, 0), a2, voffA);
            PG8_BAR; PG8_WAIT_L(0); PG8_MMA(1, 0, At, B0); PG8_BAR; PG8_SCHED;
            PG8_STAGE(PG8_SB(0, 1), b2 + hstep, voffB);
            PG8_WAIT_V(6); PG8_BAR; PG8_MMA(1, 1, At, B1); PG8_BAR;
            PG8_LDB(B0, 1, 0); PG8_SCHED; PG8_LDA(At, 1, 0); PG8_STAGE(PG8_SA(0, 1), a2 + hstep, voffA);
            PG8_WAIT_L(8); PG8_BAR; PG8_WAIT_L(0); PG8_MMA(0, 0, At, B0); PG8_BAR; PG8_SCHED;
            PG8_LDB(B1, 1, 1); PG8_STAGE(PG8_SB(1, 0), b3, voffB);
            PG8_BAR; PG8_WAIT_L(0); PG8_MMA(0, 1, At, B1); PG8_BAR;
            PG8_LDA(At, 1, 1); PG8_STAGE(PG8_SA(1, 0), a3, voffA);
            PG8_BAR; PG8_WAIT_L(0); PG8_MMA(1, 0, At, B0); PG8_BAR; PG8_SCHED;
            PG8_STAGE(PG8_SB(1, 1), b3 + hstep, voffB);
            PG8_WAIT_V(6); PG8_BAR; PG8_MMA(1, 1, At, B1); PG8_BAR;
            }
        }
        if constexpr (ALIGN_EPI) { if (wr == 0) PG8_BAR; }
        if constexpr (FP8) { asm volatile("s_nop 15\n\ts_nop 15" ::: "memory"); }
        if constexpr (!Epi::AFTER_DRAIN) { E(acc, cur, wr, wc, fr, fq);
#if defined(PROBE_EPI2)
            if constexpr (FP8 == (PROBE_EPI2 == 1)) { E(acc, cur, wr, wc, fr, fq); }
#endif
            S.done(cur); }
        if (!has_next) break;
#pragma unroll
        for (int a = 0; a < 2; ++a)
#pragma unroll
            for (int b = 0; b < 2; ++b)
#pragma unroll
                for (int m = 0; m < 4; ++m)
#pragma unroll
                    for (int n = 0; n < 2; ++n) acc[a][b][m][n] = (f32x4){0.f, 0.f, 0.f, 0.f};
        cur = nxt; cA = nA; cB = nB; ++ui;
        if constexpr (GATHER) { _Pragma("unroll") for (int h_ = 0; h_ < 2; ++h_) _Pragma("unroll") for (int i_ = 0; i_ < 2; ++i_) gAc[h_][i_] = gAn[h_][i_]; }
        if constexpr (ALIGN_EPI) { if (wr == 1) PG8_BAR; }
    }
    PG8_WAIT_V(0);
    if constexpr (!ALIGN_EPI) { if (wr == 0) PG8_BAR; }
    PG8_BAR;
    if constexpr (Epi::AFTER_DRAIN) { E.fused(acc, cur, wr, wc, fr, fq, lds, wid, lane); S.done(cur); }
#undef PG8_SA
#undef PG8_SB
#undef PG8_STAGE
#undef PG8_STAGE_A
#undef PG8_GATHER
#undef PG8_LDA
#undef PG8_LD32
#undef PG8_LDB
#undef PG8_MMA
#undef PG8_WAIT_V
#undef PG8_WAIT_L
#undef PG8_BAR
#undef PG8_SCHED
}
}

#ifndef PG8_SP2
#define PG8_SP2 true
#endif
#ifndef PG8_ALIGN
#define PG8_ALIGN true
#endif

#define GAS __attribute__((address_space(1)))
#define LAS __attribute__((address_space(3)))
typedef unsigned short bf16;
typedef unsigned v4u __attribute__((ext_vector_type(4)));
typedef unsigned v2u __attribute__((ext_vector_type(2)));
typedef float f32x4 __attribute__((ext_vector_type(4)));
typedef short bf16x8 __attribute__((ext_vector_type(8)));

constexpr int D = 1024, NB = 8, SEQ = 4096, CTXL = 256, TPB = SEQ + CTXL, NTOK = NB * TPB, NLAT = NB * SEQ;
constexpr int ZC = 3328;
constexpr int ZQ = 0, ZKV = 384, ZKR = 640, ZHQ = 672, ZHF = 1184, ZHB = 1696, ZHI = 2208, ZHG = 2720;
constexpr int NEXP = 32;
constexpr float ALPHA = 1.4142135623730951f;
constexpr float LN_EPS = 1e-5f, RMS_EPS = 1e-6f;
constexpr int NWAVES = 8, NTHR = 512;
constexpr float SC_X8 = 16.f, SC_WGU = 64.f, SC_ACT = 8.f, SC_WDN = 128.f, SC_Y = 64.f;
constexpr int LDS_BYTES = 147456;
constexpr int LDS_BAR_OFF = LDS_BYTES - 64;
constexpr int LDS_TILE_E = 131072;
constexpr int MAXTILES = 576;

constexpr size_t MiB = 1u << 20;
constexpr size_t WS_CTL = 0, CTL_ZERO_BYTES = 16384;
constexpr size_t WS_MODV = 1 * MiB;
constexpr size_t WS_ROPE = 1 * MiB + 512 * 1024;
constexpr size_t WS_BGU = 2 * MiB;
constexpr size_t WS_PW1B = 2 * MiB + 512 * 1024;
constexpr size_t WS_BCNT = WS_PW1B + 64 * 1024;
constexpr size_t WS_TILEE = WS_BCNT + 64 * 1024;
constexpr size_t WS_META = WS_TILEE + 4096;
constexpr size_t WS_TOPI = 3 * MiB, WS_TOPW = 4 * MiB;
constexpr int ECAP = 32768;
constexpr size_t WS_ROWS = 160 * MiB, WS_ROWW = 164 * MiB, WS_ROWD = 168 * MiB;
constexpr size_t WS_CURSOR = 14336;
constexpr size_t WS_WIN = 8 * MiB, WS_WUQ = 15 * MiB, WS_WUKV = 16 * MiB, WS_WOUT = 17 * MiB, WS_WPW1 = 19 * MiB, WS_WPW2 = 23 * MiB;
constexpr size_t WS_WGU = 32 * MiB, WS_WDN = 288 * MiB;
constexpr size_t WS_H = 416 * MiB;
constexpr size_t WS_X = 552 * MiB, WS_Y = 620 * MiB;
constexpr size_t WS_BIG = 688 * MiB;
constexpr size_t WS_Z = WS_BIG, WS_CQN = WS_BIG + 221 * MiB, WS_CKVN = WS_BIG + 247 * MiB, WS_KRR = WS_BIG + 264 * MiB,
                 WS_Q = WS_BIG + 267 * MiB, WS_KV = WS_BIG + 318 * MiB, WS_OF = WS_BIG + 386 * MiB, WS_OB = WS_BIG + 454 * MiB;
constexpr size_t WS_HT = WS_BIG + 528 * MiB;
constexpr size_t WS_PRE = WS_BIG;
constexpr size_t WS_XS = WS_BIG, WS_ACT = WS_BIG + 288 * MiB, WS_YB = WS_BIG + 576 * MiB;
constexpr size_t WS_END = WS_BIG + 848 * MiB;
static_assert((size_t)NTOK * ZC * 2 <= 221 * MiB && (size_t)NTOK * 384 * 2 <= 26 * MiB && (size_t)NTOK * 256 * 2 <= 17 * MiB && (size_t)NTOK * 32 * 2 <= 3 * MiB, "ws map 1");
static_assert((size_t)NTOK * 768 * 2 <= 51 * MiB && (size_t)NTOK * 1024 * 2 <= 68 * MiB && (size_t)NTOK * 512 * 4 <= 68 * MiB, "ws map 2");
static_assert((size_t)64 * 136 * 26624 <= 320 * MiB && (size_t)MAXTILES * 256 * 2048 <= 288 * MiB && (size_t)NLAT * 4 * 2048 <= 272 * MiB && (size_t)NTOK * 1024 * 4 <= 136 * MiB, "ws map 3");

#define LDS_WAIT() asm volatile("s_waitcnt lgkmcnt(0)" ::: "memory")
#define VM_WAIT() asm volatile("s_waitcnt vmcnt(0)" ::: "memory")
__device__ __forceinline__ float bf2f(unsigned short b) { return __uint_as_float(((unsigned)b) << 16); }
__device__ __forceinline__ unsigned pk2(float lo, float hi) { return pg8::cvt_pk_bf16(lo, hi); }
__device__ __forceinline__ float sigm(float x) { return __builtin_amdgcn_rcpf(1.f + __expf(-x)); }
__device__ __forceinline__ float wave_sum(float v) {
#pragma unroll
    for (int o = 1; o < 64; o <<= 1) v += __shfl_xor(v, o);
    return v;
}
__device__ __forceinline__ int ld_ctl(const int* p) { return (int)__hip_atomic_load((const unsigned*)p, __ATOMIC_RELAXED, __HIP_MEMORY_SCOPE_AGENT); }
__device__ __forceinline__ int grow_of(int lr) { return (lr >> 12) * TPB + CTXL + (lr & 4095); }

#define XB_TMO      128
#define XB_XCNT(j)  (256  + 64 * (j))
#define XB_XSUB(j)  (1280 + 64 * (j))
#define XB_XGEN(j)  (2304 + 64 * (j))
#define XB_TOP      3328
#define XB_TOPGEN   3392
#define XCD_BAR_WORDS 3456
#define XB_SPIN_CAP (1u << 21)

__device__ __forceinline__ unsigned xb_ld(unsigned* p)              { return __hip_atomic_load(p, __ATOMIC_RELAXED, __HIP_MEMORY_SCOPE_AGENT); }
__device__ __forceinline__ unsigned xb_add(unsigned* p, unsigned v) { return __hip_atomic_fetch_add(p, v, __ATOMIC_RELAXED, __HIP_MEMORY_SCOPE_AGENT); }
__device__ __forceinline__ unsigned xb_xcc_id() { return (unsigned)__builtin_amdgcn_s_getreg((3 << 11) | 20) & 0xFu; }
#define XB_SPIN(cond, bar) do { unsigned _sp = 0; while (cond) { __builtin_amdgcn_s_sleep(1); \
    if ((++_sp & 255u) == 0u) { if (xb_ld(&(bar)[XB_TMO])) break; if (_sp > XB_SPIN_CAP) { atomicAdd(&(bar)[XB_TMO], 1u); break; } } } } while (0)

struct XcdBarrier { unsigned* bar; unsigned x; volatile LAS unsigned* st; };

__device__ __forceinline__ XcdBarrier xcd_barrier_post(unsigned* bar, volatile LAS unsigned* st) {
    XcdBarrier b; b.bar = bar; b.x = xb_xcc_id(); b.st = st;
    if (threadIdx.x == 0) (void)xb_add(&bar[XB_XCNT(b.x)], 1u);
    return b;
}
__device__ __forceinline__ void xcd_barrier_complete(unsigned* bar, unsigned x, unsigned& nloc, unsigned& nx) {
    const unsigned G = gridDim.x * gridDim.y * gridDim.z;
    unsigned sum, cnt, mine, sp = 0u;
    for (;;) {
        sum = 0u; cnt = 0u; mine = 0u;
#pragma unroll
        for (unsigned j = 0; j < 16; ++j) { const unsigned c = xb_ld(&bar[XB_XCNT(j)]); sum += c; cnt += (c > 0u) ? 1u : 0u; mine = (j == x) ? c : mine; }
        if (sum == G) break;
        __builtin_amdgcn_s_sleep(1);
        if ((++sp & 255u) == 0u) { if (xb_ld(&bar[XB_TMO])) break; if (sp > XB_SPIN_CAP) { atomicAdd(&bar[XB_TMO], 1u); break; } }
    }
    nloc = mine > 0u ? mine : 1u; nx = cnt > 0u ? cnt : 1u;
}
__device__ __forceinline__ void xcd_barrier(const XcdBarrier& b) {
    asm volatile("s_waitcnt vmcnt(0)" ::: "memory");
    __syncthreads();
    if (threadIdx.x == 0) {
        unsigned* bar = b.bar;
        __builtin_amdgcn_s_waitcnt(0);
        unsigned nloc = b.st[0], nx = b.st[1];
        if (nloc == 0u) { xcd_barrier_complete(bar, b.x, nloc, nx); b.st[0] = nloc; b.st[1] = nx; }
        const unsigned old = xb_add(&bar[XB_XSUB(b.x)], 1u);
        const unsigned gen = old / nloc;
        if (old + 1u == (gen + 1u) * nloc) {
            __builtin_amdgcn_fence(__ATOMIC_RELEASE, "agent");
            asm volatile("s_waitcnt vmcnt(0)" ::: "memory");
            const unsigned og = xb_add(&bar[XB_TOP], 1u);
            const unsigned tg = og / nx;
            if (og + 1u == (tg + 1u) * nx) xb_add(&bar[XB_TOPGEN], 1u);
            else XB_SPIN(xb_ld(&bar[XB_TOPGEN]) == tg, bar);
            __builtin_amdgcn_fence(__ATOMIC_ACQUIRE, "agent");
            xb_add(&bar[XB_XGEN(b.x)], 1u);
            asm volatile("s_waitcnt vmcnt(0)" ::: "memory");
        } else {
            XB_SPIN(xb_ld(&bar[XB_XGEN(b.x)]) == gen, bar);
            __builtin_amdgcn_fence(__ATOMIC_ACQUIRE, "agent");
            asm volatile("s_waitcnt vmcnt(0)" ::: "memory");
        }
    }
    __syncthreads();
}

namespace pg8 {
struct TileOrder {
    int nM, nN, nwg, G, c;
    __device__ __forceinline__ void init(int nM_, int nN_, int G_, int c_) { nM = nM_; nN = nN_; nwg = nM * nN; G = G_; c = c_; }
    __device__ __forceinline__ bool logical(int i, int& im, int& in) const {
        const long L = (long)i * G + c; if (L >= nwg) return false;
        int wgid = (int)L; { const int q = nwg / NXCD, r = nwg % NXCD, xcd = wgid % NXCD, off = wgid / NXCD; wgid = (xcd < r ? xcd * (q + 1) : r * (q + 1) + (xcd - r) * q) + off; }
        const int nig = WGM * nN, gid = wgid / nig, fm = gid * WGM, gsz = (nM - fm) < WGM ? (nM - fm) : WGM;
        im = fm + ((wgid % nig) % gsz); in = (wgid % nig) / gsz; return true;
    }
    __device__ __forceinline__ void a_ready(const Unit&) const {}
    __device__ __forceinline__ void done(const Unit&) const {}
};
struct AllOrder : TileOrder { __device__ __forceinline__ bool next(int i, Unit& u) const { int im, in; if (!logical(i, im, in)) return false; u.pm = im; u.pn = in; return true; } };
struct LatOrder : TileOrder {
    __device__ __forceinline__ bool next(int i, Unit& u) const { int im, in; if (!logical(i, im, in)) return false; u.pm = (im >> 4) * 17 + 1 + (im & 15); u.pn = in; return true; } };
struct MoeOrder : TileOrder {
    const PG8_LAS int* tile_e; int nper;
    __device__ __forceinline__ bool next(int i, Unit& u) const { int im, in; if (!logical(i, im, in)) return false; u.pm = im; u.pn = tile_e[im] * nper + in; return true; } };

struct EpiRes {
    static constexpr bool PERM = true, AFTER_DRAIN = false;
    const float* xin; const float* h; bf16_t* pre; const float* modv; const float* bias;
    __device__ __forceinline__ void operator()(const f32x4 (&acc)[2][2][4][2], const Unit& u, int wr, int wc, int fr, int fq) const {
        asm volatile("" : "+v"(fr), "+v"(fq));
        const int b = u.pm / 17, j = u.pm % 17;
        const int rl0 = wr * 64 + fr, col0 = u.pn * BM + wc * 32 + 8 * fq;
        const float* gate = modv + (size_t)b * 6144 + 2048;
        f32x4 gv[2][2], bv[2][2];
#pragma unroll
        for (int bj = 0; bj < 2; ++bj)
#pragma unroll
            for (int n = 0; n < 2; ++n) { gv[bj][n] = *(const f32x4*)(gate + col0 + bj * HALF + 4 * n); bv[bj][n] = bias ? *(const f32x4*)(bias + col0 + bj * HALF + 4 * n) : (f32x4){0.f, 0.f, 0.f, 0.f}; }
#pragma unroll
        for (int aim = 0; aim < 4; ++aim) { const int ai = aim >> 1, m0 = (aim & 1) * 2;
            f32x4 hv[2][2][2];
#pragma unroll
            for (int mm = 0; mm < 2; ++mm) { const int rl = rl0 + ai * HALF + (m0 + mm) * 16; const size_t grow = (size_t)u.pm * BM + rl;
                const float* hin = xin ? xin + ((size_t)b * 4096 + (size_t)(j - 1) * 256 + rl) * 1024 + col0 : h + grow * 1024 + col0;
#pragma unroll
                for (int bj = 0; bj < 2; ++bj) { hv[mm][bj][0] = *(const f32x4*)(hin + bj * HALF); hv[mm][bj][1] = *(const f32x4*)(hin + bj * HALF + 4); } }
            asm volatile("" ::: "memory");
#pragma unroll
            for (int mm = 0; mm < 2; ++mm) { const int m = m0 + mm; const int rl = rl0 + ai * HALF + m * 16; const size_t grow = (size_t)u.pm * BM + rl; bf16_t* po = pre + grow * 1024 + col0;
#pragma unroll
                for (int bj = 0; bj < 2; ++bj) {
                    const f32x4 v0 = hv[mm][bj][0] * 1.4142135623730951f + gv[bj][0] * (acc[ai][bj][m][0] + bv[bj][0]), v1 = hv[mm][bj][1] * 1.4142135623730951f + gv[bj][1] * (acc[ai][bj][m][1] + bv[bj][1]);
                    u32x4 w; w.x = cvt_pk_bf16(v0[0], v0[1]); w.y = cvt_pk_bf16(v0[2], v0[3]); w.z = cvt_pk_bf16(v1[0], v1[1]); w.w = cvt_pk_bf16(v1[2], v1[3]);
                    *(u32x4*)(po + bj * HALF) = w; } }
            asm volatile("" ::: "memory"); }
    }
};
template <int MODE, bool OUT8 = false> struct EpiGate {
    static constexpr bool PERM = true, AFTER_DRAIN = false;
    bf16_t* O; const float* bias; int nper; float ascale, oscale;
    __device__ __forceinline__ void operator()(const f32x4 (&acc)[2][2][4][2], const Unit& u, int wr, int wc, int fr, int fq) const {
        asm volatile("" : "+v"(fr), "+v"(fq));
        const int row0 = u.pm * BM + wr * 64 + fr, pnl = u.pn % nper, ocol0 = pnl * HALF + wc * 32 + 8 * fq, bcol0 = u.pn * BM + wc * 32 + 8 * fq;
        const float s0 = ascale, s1 = MODE == 1 ? ascale * oscale : ascale;
        f32x4 bv[2][2];
#pragma unroll
        for (int n = 0; n < 2; ++n) { bv[0][n] = *(const f32x4*)(bias + bcol0 + 4 * n); const f32x4 t = *(const f32x4*)(bias + bcol0 + HALF + 4 * n); bv[1][n] = MODE == 1 ? (t + 1.0f) * oscale : t; }
#pragma unroll
        for (int ai = 0; ai < 2; ++ai)
#pragma unroll
            for (int m = 0; m < 4; ++m) { bf16_t* rowp = O + (size_t)(row0 + ai * HALF + m * 16) * 1024 + ocol0;
                unsigned char* rowp8 = (unsigned char*)O + (size_t)(row0 + ai * HALF + m * 16) * 1024 + ocol0;
                float o[8];
#pragma unroll
                for (int n = 0; n < 2; ++n) { const f32x4 a = acc[ai][0][m][n] * s0 + bv[0][n], g = acc[ai][1][m][n] * s1 + bv[1][n];
#pragma unroll
                    for (int e = 0; e < 4; ++e) {
                        if (MODE == 0) { o[4 * n + e] = a[e] * __builtin_amdgcn_rcpf(1.f + __builtin_amdgcn_exp2f(g[e] * -1.4426950408889634f)); }
                        else { const float gt = fminf(a[e], 7.0f), up1 = __builtin_amdgcn_fmed3f(g[e], -6.0f * oscale, 8.0f * oscale);
                            o[4 * n + e] = up1 * (gt * __builtin_amdgcn_rcpf(1.f + __builtin_amdgcn_exp2f(gt * (-1.702f * 1.4426950408889634f)))); } } }
                if constexpr (OUT8) {
                    int w0 = 0, w1 = 0; w0 = __builtin_amdgcn_cvt_pk_fp8_f32(o[0], o[1], w0, false); w0 = __builtin_amdgcn_cvt_pk_fp8_f32(o[2], o[3], w0, true);
                    w1 = __builtin_amdgcn_cvt_pk_fp8_f32(o[4], o[5], w1, false); w1 = __builtin_amdgcn_cvt_pk_fp8_f32(o[6], o[7], w1, true);
                    typedef unsigned u32x2 __attribute__((ext_vector_type(2))); *(u32x2*)rowp8 = (u32x2){(unsigned)w0, (unsigned)w1}; (void)rowp;
                } else { (void)rowp8;
                u32x4 w; w.x = cvt_pk_bf16(o[0], o[1]); w.y = cvt_pk_bf16(o[2], o[3]); w.z = cvt_pk_bf16(o[4], o[5]); w.w = cvt_pk_bf16(o[6], o[7]);
                *(u32x4*)rowp = w; } }
    }
};
struct EpiDown {
    static constexpr bool PERM = true, AFTER_DRAIN = false;
    bf16_t* Y; const float* bias; const float* row_w; const int* row_dst; float ascale; const PG8_LAS int* gtab; float oscale;
    __device__ __forceinline__ void operator()(const f32x4 (&acc)[2][2][4][2], const Unit& u, int wr, int wc, int fr, int fq) const {
        asm volatile("" : "+v"(fr), "+v"(fq));
        const int pnl = u.pn & 3, ocol0 = pnl * BM + wc * 32 + 8 * fq, bcol0 = u.pn * BM + wc * 32 + 8 * fq; const int tbase = gtab[u.pm], tcnt = gtab[576 + u.pm];
        f32x4 bv[2][2];
#pragma unroll
        for (int bj = 0; bj < 2; ++bj)
#pragma unroll
            for (int n = 0; n < 2; ++n) bv[bj][n] = *(const f32x4*)(bias + bcol0 + bj * HALF + 4 * n);
        int dstv[2][4]; float wv[2][4];
#pragma unroll
        for (int ai = 0; ai < 2; ++ai)
#pragma unroll
            for (int m = 0; m < 4; ++m) { const int rl = wr * 64 + fr + ai * HALF + m * 16; const int ix = tbase + (rl < tcnt ? rl : 0); dstv[ai][m] = row_dst[ix]; wv[ai][m] = row_w[ix]; }
#pragma unroll
        for (int ai = 0; ai < 2; ++ai)
#pragma unroll
            for (int m = 0; m < 4; ++m) { const int rl = wr * 64 + fr + ai * HALF + m * 16;
                if (rl < tcnt) { const int dst = dstv[ai][m]; const float w8 = wv[ai][m] * oscale; unsigned char* rowp = (unsigned char*)Y + (size_t)dst * 1024 + ocol0;
#pragma unroll
                    for (int bj = 0; bj < 2; ++bj) { const f32x4 v0 = (acc[ai][bj][m][0] * ascale + bv[bj][0]) * w8, v1 = (acc[ai][bj][m][1] * ascale + bv[bj][1]) * w8;
                        int w0 = 0, w1 = 0; w0 = __builtin_amdgcn_cvt_pk_fp8_f32(fminf(fmaxf(v0[0], -448.f), 448.f), fminf(fmaxf(v0[1], -448.f), 448.f), w0, false); w0 = __builtin_amdgcn_cvt_pk_fp8_f32(fminf(fmaxf(v0[2], -448.f), 448.f), fminf(fmaxf(v0[3], -448.f), 448.f), w0, true);
                        w1 = __builtin_amdgcn_cvt_pk_fp8_f32(fminf(fmaxf(v1[0], -448.f), 448.f), fminf(fmaxf(v1[1], -448.f), 448.f), w1, false); w1 = __builtin_amdgcn_cvt_pk_fp8_f32(fminf(fmaxf(v1[2], -448.f), 448.f), fminf(fmaxf(v1[3], -448.f), 448.f), w1, true);
                        typedef unsigned u32x2 __attribute__((ext_vector_type(2))); *(u32x2*)(rowp + bj * HALF) = (u32x2){(unsigned)w0, (unsigned)w1}; } } }
    }
};
}

namespace att {
using bf16x8 = __attribute__((ext_vector_type(8))) short;
using s16x4  = __attribute__((ext_vector_type(4))) short;
using f32x16 = __attribute__((ext_vector_type(16))) float;
using u32x4  = __attribute__((ext_vector_type(4))) unsigned;
constexpr int NW = 8, QBLK = 32, KVBLK = 64;
constexpr float SCALE = 0.10206207261596575f;
constexpr float THR = 8.f;
constexpr int SHM_V = 16384, SHM_K = 16384, NBUF = 3, SHM_ATTN = NBUF * SHM_V + NBUF * SHM_K + NW * 64 * 4;
#define KSWZ(row, colB) ((row) * 256 + ((colB) ^ (((row) & 7) << 4)))
#define SBAR() __builtin_amdgcn_sched_barrier(0)
__device__ __forceinline__ int crow(int r, int hi) { return (r & 3) + 8 * (r >> 2) + 4 * hi; }
__device__ __forceinline__ unsigned cvtpk(float lo, float hi) { unsigned r; asm volatile("v_cvt_pk_bf16_f32 %0, %1, %2" : "=v"(r) : "v"(lo), "v"(hi)); return r; }

__device__ __forceinline__ void partialSM(f32x16& p0, f32x16& p1, float& m_reg, float& mn, float& alpha) {
  constexpr float C = SCALE * 1.4426950408889634f;
  float pmax = p0[0];
#pragma unroll
  for (int r = 1; r < 16; ++r) pmax = fmaxf(pmax, p0[r]);
#pragma unroll
  for (int r = 0; r < 16; ++r) pmax = fmaxf(pmax, p1[r]);
  { auto rr = __builtin_amdgcn_permlane32_swap(__float_as_uint(pmax), __float_as_uint(pmax), false, false);
    pmax = fmaxf(__uint_as_float(rr[0]), __uint_as_float(rr[1])); }
  if (__builtin_expect(__all(pmax - m_reg <= THR / SCALE), 1)) { mn = m_reg; alpha = 1.f; }
  else { mn = fmaxf(m_reg, pmax); alpha = __builtin_amdgcn_exp2f((m_reg - mn) * C); m_reg = mn; }
  float mnC = -mn * C;
#pragma unroll
  for (int r = 0; r < 16; ++r) p0[r] = fmaf(p0[r], C, mnC);
#pragma unroll
  for (int r = 0; r < 16; ++r) p1[r] = fmaf(p1[r], C, mnC);
#pragma unroll
  for (int r = 0; r < 16; ++r) p0[r] = __builtin_amdgcn_exp2f(p0[r]);
}
__device__ __forceinline__ void finishSM(f32x16& p0, f32x16& p1, float alpha, float& l_reg, bf16x8& pa0, bf16x8& pa1, bf16x8& pa2, bf16x8& pa3) {
#pragma unroll
  for (int r = 0; r < 16; ++r) p1[r] = __builtin_amdgcn_exp2f(p1[r]);
  float ps = 0;
#pragma unroll
  for (int r = 0; r < 16; ++r) ps += p0[r];
#pragma unroll
  for (int r = 0; r < 16; ++r) ps += p1[r];
  { auto rr = __builtin_amdgcn_permlane32_swap(__float_as_uint(ps), __float_as_uint(ps), false, false);
    ps = __uint_as_float(rr[0]) + __uint_as_float(rr[1]); }
  l_reg = l_reg * alpha + ps;
#define PK4(P, BASE, OUT) do { unsigned a0 = cvtpk(P[BASE + 0], P[BASE + 1]), a1 = cvtpk(P[BASE + 2], P[BASE + 3]);   \
    unsigned b0 = cvtpk(P[BASE + 4], P[BASE + 5]), b1 = cvtpk(P[BASE + 6], P[BASE + 7]);                              \
    auto r0 = __builtin_amdgcn_permlane32_swap(a0, b0, false, false); auto r1 = __builtin_amdgcn_permlane32_swap(a1, b1, false, false); \
    u32x4 w = {r0[0], r1[0], r0[1], r1[1]}; OUT = *reinterpret_cast<bf16x8*>(&w); } while (0)
  PK4(p0, 0, pa0); PK4(p0, 8, pa1); PK4(p1, 0, pa2); PK4(p1, 8, pa3);
#undef PK4
}
__device__ __forceinline__ void qkt(f32x16& p0, f32x16& p1, const bf16* Ks, const bf16x8* qr, int r32, int hi) {
  p0 = f32x16{}; p1 = f32x16{};
#pragma unroll
  for (int d0 = 0; d0 < 6; ++d0) { int cb = (d0 * 16 + hi * 8) * 2;
    bf16x8 b0 = *reinterpret_cast<const bf16x8*>((const char*)Ks + KSWZ(r32, cb));
    bf16x8 b1 = *reinterpret_cast<const bf16x8*>((const char*)Ks + KSWZ(32 + r32, cb));
    p0 = __builtin_amdgcn_mfma_f32_32x32x16_bf16(b0, qr[d0], p0, 0, 0, 0);
    p1 = __builtin_amdgcn_mfma_f32_32x32x16_bf16(b1, qr[d0], p1, 0, 0, 0); }
}
__device__ __forceinline__ int v_st(int k, int c) { const int kk = (k & ~0xC) | ((k & 4) << 1) | ((k & 8) >> 1); return ((kk >> 3) * 4 + (c >> 5)) * 512 + ((kk & 7) * 32 + (c & 31)) * 2; }
__device__ __forceinline__ int v_rd_base(int lane) { return ((lane & 3) << 3) | (((lane >> 2) & 3) << 6) | (((lane >> 4) & 1) << 5) | (((lane >> 5) & 1) << 8); }
constexpr int v_rd_off(int d0, int ks, int half) { return d0 * 512 + ks * 4096 + half * 2048; }
template <int OFF> __device__ __forceinline__ s16x4 tr_read(int vb) {
  s16x4 r; asm volatile("ds_read_b64_tr_b16 %0, %1 offset:%2" : "=&v"(r) : "v"(vb), "i"(OFF) : "memory"); return r;
}
template <int D0> __device__ __forceinline__ void pv_one(f32x16& od, int vb, bf16x8 pa0, bf16x8 pa1, bf16x8 pa2, bf16x8 pa3) {
  const s16x4 l0 = tr_read<v_rd_off(D0, 0, 0)>(vb), h0 = tr_read<v_rd_off(D0, 0, 1)>(vb), l1 = tr_read<v_rd_off(D0, 1, 0)>(vb), h1 = tr_read<v_rd_off(D0, 1, 1)>(vb);
  const s16x4 l2 = tr_read<v_rd_off(D0, 2, 0)>(vb), h2 = tr_read<v_rd_off(D0, 2, 1)>(vb), l3 = tr_read<v_rd_off(D0, 3, 0)>(vb), h3 = tr_read<v_rd_off(D0, 3, 1)>(vb);
  asm volatile("s_waitcnt lgkmcnt(0)" ::: "memory"); SBAR();
#define PK(L, H) (bf16x8){L[0], L[1], L[2], L[3], H[0], H[1], H[2], H[3]}
  od = __builtin_amdgcn_mfma_f32_32x32x16_bf16(pa0, PK(l0, h0), od, 0, 0, 0);
  od = __builtin_amdgcn_mfma_f32_32x32x16_bf16(pa1, PK(l1, h1), od, 0, 0, 0);
  od = __builtin_amdgcn_mfma_f32_32x32x16_bf16(pa2, PK(l2, h2), od, 0, 0, 0);
  od = __builtin_amdgcn_mfma_f32_32x32x16_bf16(pa3, PK(l3, h3), od, 0, 0, 0);
#undef PK
}
__device__ __forceinline__ void pv_d0(f32x16* o, int vb, bf16x8 pa0, bf16x8 pa1, bf16x8 pa2, bf16x8 pa3) {
  pv_one<0>(o[0], vb, pa0, pa1, pa2, pa3); pv_one<1>(o[1], vb, pa0, pa1, pa2, pa3);
}
__device__ __forceinline__ bf16x8 rope8(bf16x8 x, const float* tab, int pbase) {
  u32x4 w;
#pragma unroll
  for (int i = 0; i < 4; ++i) { const float x1 = __uint_as_float(((unsigned)(unsigned short)x[2 * i]) << 16), x2 = __uint_as_float(((unsigned)(unsigned short)x[2 * i + 1]) << 16);
    const float cs = tab[pbase + i], sn = tab[16 + pbase + i]; w[i] = cvtpk(x1 * cs - x2 * sn, x1 * sn + x2 * cs); }
  return *reinterpret_cast<bf16x8*>(&w);
}
__device__ __forceinline__ void attn_unit(const bf16* __restrict__ Qb, const bf16* __restrict__ KVb, const bf16* __restrict__ KRb, bf16* __restrict__ Ob,
                                          const float* __restrict__ rope, int seq, char* lds) {
  int tid_l = threadIdx.x; asm volatile("" : "+v"(tid_l));
  const int tid = tid_l, wid = tid >> 6, lane = tid & 63, r32 = lane & 31, hi = lane >> 5;
  bf16* V_lds = (bf16*)lds; bf16* K_lds = (bf16*)(lds + NBUF * SHM_V);
  float* ws = (float*)(lds + NBUF * SHM_V + NBUF * SHM_K) + wid * 64; float* li_l = ws; float* al_l = ws + 32;
  float m_reg = -1e30f, l_reg = 0; f32x16 o[2] = {}; bf16x8 qr[6];
  const bf16* Qw = Qb + (long)(wid * QBLK + r32) * 768 + hi * 8;
#pragma unroll
  for (int d0 = 0; d0 < 6; ++d0) qr[d0] = *reinterpret_cast<const bf16x8*>(Qw + d0 * 16);
  if (rope) { const float* tab = rope + (long)(wid * QBLK + r32) * 32; qr[4] = rope8(qr[4], tab, 4 * hi); qr[5] = rope8(qr[5], tab, 8 + 4 * hi); }
  const int sr = tid >> 4, ch = tid & 15;
  const bf16* kbase = ch < 8 ? KVb + ch * 8 : KRb + ((ch - 8) & 3) * 8; const long kstr = ch < 8 ? 1024 : 32;
  const int vkey = tid >> 3, vc8 = (tid & 7) * 8, vst0 = v_st(vkey, vc8);
  const bf16* vbase = KVb + 512 + vc8;
  const int vb0 = (int)(uintptr_t)V_lds + v_rd_base(lane);
  struct { bf16x8 vs0, ks0, ks1; } sr_[2];
#define SLOAD(i, k0) do { sr_[i].vs0 = *reinterpret_cast<const bf16x8*>(vbase + (long)((k0) + vkey) * 1024); \
    sr_[i].ks0 = *reinterpret_cast<const bf16x8*>(kbase + (long)((k0) + sr) * kstr); sr_[i].ks1 = *reinterpret_cast<const bf16x8*>(kbase + (long)((k0) + 32 + sr) * kstr); } while (0)
#define SWRITE(b, i) do { *(bf16x8*)((char*)V_lds + (b) * SHM_V + vst0) = sr_[i].vs0; int kc = ch * 16;               \
    *(bf16x8*)((char*)K_lds + (b) * SHM_K + KSWZ(sr, kc)) = sr_[i].ks0;                       \
    *(bf16x8*)((char*)K_lds + (b) * SHM_K + KSWZ(32 + sr, kc)) = sr_[i].ks1; } while (0)
#define SWAIT() asm volatile("s_waitcnt vmcnt(3)" ::: "memory")
#define RESC(a) do { if (__any((a) < 1.f)) { if (hi == 0) al_l[r32] = (a); asm volatile("s_waitcnt lgkmcnt(0)" ::: "memory"); \
    _Pragma("unroll") for (int d = 0; d < 2; ++d) _Pragma("unroll") for (int r = 0; r < 16; ++r) o[d][r] *= al_l[crow(r, hi)]; } } while (0)
  f32x16 pA0, pA1, pB0, pB1; float mnA, mnB, alA, alB; bf16x8 pa0, pa1, pa2, pa3; const int NT = seq / KVBLK;
  constexpr int SE = 0, SO = 1;
  SLOAD(SE, 0); asm volatile("s_waitcnt vmcnt(0)" ::: "memory"); SWRITE(0, SE); __syncthreads();
  qkt(pA0, pA1, K_lds, qr, r32, hi); partialSM(pA0, pA1, m_reg, mnA, alA);
  SLOAD(SO, KVBLK); if (2 < NT) SLOAD(SE, 2 * KVBLK);
  SWAIT(); SWRITE(1, SO); __syncthreads();
  int bprev = 0, bcur = 1, bnext = 2;
#define ATT_STEP(PN0, PN1, MNN, ALN, PO0, PO1, ALO, SL_LOAD, SL_WRITE, t) do { \
    SBAR(); qkt(PN0, PN1, (bf16*)((char*)K_lds + bcur * SHM_K), qr, r32, hi); \
    finishSM(PO0, PO1, ALO, l_reg, pa0, pa1, pa2, pa3); SBAR(); \
    if ((t) + 2 < NT) SLOAD(SL_LOAD, ((t) + 2) * KVBLK); SBAR(); \
    pv_d0(o, vb0 + bprev * (int)SHM_V, pa0, pa1, pa2, pa3); partialSM(PN0, PN1, m_reg, MNN, ALN); \
    SWAIT(); SWRITE(bnext, SL_WRITE); \
    RESC(ALN); __syncthreads(); \
    bprev = bcur; bcur = bnext; bnext = (bnext == 2) ? 0 : bnext + 1; } while (0)
  for (int j = 1; j + 1 < NT; j += 2) {
    ATT_STEP(pB0, pB1, mnB, alB, pA0, pA1, alA, SO, SE, j);
    ATT_STEP(pA0, pA1, mnA, alA, pB0, pB1, alB, SE, SO, j + 1);
  }
#undef ATT_STEP
  SBAR(); qkt(pB0, pB1, (bf16*)((char*)K_lds + bcur * SHM_K), qr, r32, hi);
  finishSM(pA0, pA1, alA, l_reg, pa0, pa1, pa2, pa3); SBAR();
  pv_d0(o, vb0 + bprev * (int)SHM_V, pa0, pa1, pa2, pa3); partialSM(pB0, pB1, m_reg, mnB, alB);
  RESC(alB);
  finishSM(pB0, pB1, alB, l_reg, pa0, pa1, pa2, pa3); SBAR();
  pv_d0(o, vb0 + bcur * (int)SHM_V, pa0, pa1, pa2, pa3);
  if (hi == 0) li_l[r32] = l_reg; asm volatile("s_waitcnt lgkmcnt(0)" ::: "memory");
  float rli[16];
#pragma unroll
  for (int r = 0; r < 16; ++r) rli[r] = __builtin_amdgcn_rcpf(li_l[crow(r, hi)]);
  bf16* Ow = Ob + (long)(wid * QBLK) * 1024;
#pragma unroll
  for (int r = 0; r < 16; ++r) { int orow = crow(r, hi);
#pragma unroll
    for (int d0 = 0; d0 < 2; ++d0) { const float v = o[d0][r] * rli[r]; Ow[(long)orow * 1024 + d0 * 32 + r32] = (bf16)(cvtpk(v, v) & 0xffffu); } }
#undef SLOAD
#undef SWRITE
#undef SWAIT
#undef RESC
}
}

struct Args { const float* in[33]; float* out; unsigned char* ws; int ph_lo, ph_hi; };
enum { I_X = 0, I_C, I_CTX, I_CCTX, I_MODW, I_MODB, I_LN1G, I_LN1B, I_LN2G, I_LN2B, I_WIN, I_QNORM, I_KVNORM, I_WUQ, I_WUK, I_WUV, I_LBL, I_HGNORM, I_WOUT,
       I_PW1W, I_PW1B, I_DWW, I_DWB, I_CLNG, I_CLNB, I_PW2W, I_PW2B, I_RW, I_RB, I_WGU, I_BGU, I_WDN, I_BDN };

__device__ __forceinline__ int dst_row(int n, int mode, int row_off) {
    if (mode == 0) return row_off + n;
    int f, g; if (mode == 1) { f = n >> 1; g = n & 1; } else { g = n >> 10; f = n & 1023; }
    return row_off + 256 * (f >> 7) + 128 * g + (f & 127);
}
__device__ __forceinline__ unsigned pack_fp8x4(float a, float b, float c, float d) { int w = 0; w = __builtin_amdgcn_cvt_pk_fp8_f32(fminf(fmaxf(a, -448.f), 448.f), fminf(fmaxf(b, -448.f), 448.f), w, false);
    w = __builtin_amdgcn_cvt_pk_fp8_f32(fminf(fmaxf(c, -448.f), 448.f), fminf(fmaxf(d, -448.f), 448.f), w, true); return (unsigned)w; }
struct TrItem { const float* W; bf16* WT; int K, N, mode, row_off, item; float f8scale; };
__device__ __forceinline__ void tr_load(const TrItem& d, f32x4 (&v)[16], int lane) {
    const int nblk = (d.N + 63) >> 6, kb = d.item / nblk, nb = d.item - kb * nblk, k0 = 64 * kb, n0 = 64 * nb;
    const int nc = n0 + 4 * (lane & 15), kr = lane >> 4;
#pragma unroll
    for (int i = 0; i < 16; ++i) v[i] = (nc < d.N) ? __builtin_nontemporal_load((const f32x4*)(d.W + (size_t)(k0 + 4 * i + kr) * d.N + nc)) : (f32x4){0.f, 0.f, 0.f, 0.f};
}
__device__ __forceinline__ void tr_lds_write(const f32x4 (&v)[16], LAS float* scr, int lane) {
    const int kr = lane >> 4;
#pragma unroll
    for (int i = 0; i < 16; ++i) { LAS float* s = scr + (4 * i + kr) * 65 + 4 * (lane & 15); s[0] = v[i][0]; s[1] = v[i][1]; s[2] = v[i][2]; s[3] = v[i][3]; }
}
__device__ __forceinline__ void tr_store(const TrItem& d, LAS float* scr, int lane) {
    const int nblk = (d.N + 63) >> 6, kb = d.item / nblk, nb = d.item - kb * nblk, k0 = 64 * kb, n0 = 64 * nb;
    const int c = lane & 7; const int K = d.K;
#pragma unroll
    for (int j = 0; j < 8; ++j) { const int nl = (lane >> 3) + 8 * j, n = n0 + nl; const LAS float* s = scr + (8 * c) * 65 + nl;
        if (n < d.N) { if (d.f8scale > 0.f) { const float f8 = d.f8scale; v2u o8; o8.x = pack_fp8x4(s[0 * 65] * f8, s[1 * 65] * f8, s[2 * 65] * f8, s[3 * 65] * f8); o8.y = pack_fp8x4(s[4 * 65] * f8, s[5 * 65] * f8, s[6 * 65] * f8, s[7 * 65] * f8);
                *(v2u*)((unsigned char*)d.WT + (size_t)dst_row(n, d.mode, d.row_off) * K + k0 + 8 * c) = o8; }
            else { v4u o; o.x = pk2(s[0 * 65], s[1 * 65]); o.y = pk2(s[2 * 65], s[3 * 65]); o.z = pk2(s[4 * 65], s[5 * 65]); o.w = pk2(s[6 * 65], s[7 * 65]);
                *(v4u*)(d.WT + (size_t)dst_row(n, d.mode, d.row_off) * K + k0 + 8 * c) = o; } } }
}
__device__ __forceinline__ void convert_items(const Args& a, unsigned char* ws, LAS float* scr, int lane, int gw, int NGW, int it_lo, int it_hi) {
    constexpr int I0 = 16 * 51, I1 = 6 * 12, I2 = 4 * 8, I3 = 4 * 8, I4 = 256, I5 = 512;
    constexpr int NGU = 64 * 512, NDN = 64 * 256;
    auto decode = [&](int it) -> TrItem {
        TrItem d; int r = it; d.f8scale = 0.f; d.mode = 0; d.row_off = 0;
        if (r < NGU) { const int mi = r >> 9; d.W = a.in[I_WGU] + (size_t)mi * 1024 * 2048; d.K = 1024; d.N = 2048; d.WT = (bf16*)(ws + WS_WGU + (size_t)mi * 2048 * 1024); d.mode = 1; d.item = r & 511; d.f8scale = SC_WGU; return d; } r -= NGU;
        if (r < NDN) { const int mi = r >> 8; d.W = a.in[I_WDN] + (size_t)mi * 1024 * 1024; d.K = 1024; d.N = 1024; d.WT = (bf16*)(ws + WS_WDN + (size_t)mi * 1024 * 1024); d.item = r & 255; d.f8scale = SC_WDN; return d; } r -= NDN;
        if (r < I0) { d.W = a.in[I_WIN]; d.K = 1024; d.N = 3232; d.WT = (bf16*)(ws + WS_WIN); d.item = r; return d; } r -= I0;
        if (r < I1) { d.W = a.in[I_WUQ]; d.K = 384; d.N = 768; d.WT = (bf16*)(ws + WS_WUQ); d.item = r; return d; } r -= I1;
        if (r < I2) { d.W = a.in[I_WUK]; d.K = 256; d.N = 512; d.WT = (bf16*)(ws + WS_WUKV); d.item = r; return d; } r -= I2;
        if (r < I3) { d.W = a.in[I_WUV]; d.K = 256; d.N = 512; d.WT = (bf16*)(ws + WS_WUKV); d.row_off = 512; d.item = r; return d; } r -= I3;
        if (r < I4) { d.W = a.in[I_WOUT]; d.K = 1024; d.N = 1024; d.WT = (bf16*)(ws + WS_WOUT); d.item = r; return d; } r -= I4;
        if (r < I5) { d.W = a.in[I_PW1W]; d.K = 1024; d.N = 2048; d.WT = (bf16*)(ws + WS_WPW1); d.mode = 2; d.item = r; return d; } r -= I5;
        d.W = a.in[I_PW2W]; d.K = 1024; d.N = 1024; d.WT = (bf16*)(ws + WS_WPW2); d.item = r; return d; };
    f32x4 tv[16];
    int it = it_lo + gw;
    if (it < it_hi) { const TrItem d0 = decode(it); tr_load(d0, tv, lane); }
    for (; it < it_hi; it += NGW) {
        const TrItem d = decode(it);
        tr_lds_write(tv, scr, lane);
        if (it + NGW < it_hi) { const TrItem dn = decode(it + NGW); tr_load(dn, tv, lane); }
        LDS_WAIT();
        tr_store(d, scr, lane);
        LDS_WAIT();
    }
}
__device__ __forceinline__ void phase_prologue(const Args& a, LAS unsigned char* lds, int tid, int lane, int wave) {
    unsigned char* ws = a.ws;
    const int G = gridDim.x, B = blockIdx.x;
    {
        LAS float* sc = (LAS float*)lds;
        LAS float* red = (LAS float*)(lds + 36864);
        float* modv = (float*)(ws + WS_MODV);
        bool have = false;
        for (int it = B; it < 192; it += G) {
            if (!have) { for (int i = tid; i < 9 * 1024; i += NTHR) { const int r = i >> 10, k = i & 1023; const float x = r < 8 ? a.in[I_C][r * 1024 + k] : a.in[I_CCTX][k]; sc[i] = x * sigm(x); } __syncthreads(); have = true; }
            const int l = it / 96, jc = it % 96, kg = tid >> 6, jj = tid & 63, j = jc * 64 + jj;
            float acc[9];
#pragma unroll
            for (int r = 0; r < 9; ++r) acc[r] = 0.f;
            const float* wp = a.in[I_MODW] + ((size_t)l * 1024 + kg * 128) * 6144 + j;
            for (int k0 = 0; k0 < 128; k0 += 16) { float w[16];
#pragma unroll
                for (int kk = 0; kk < 16; ++kk) w[kk] = wp[(size_t)(k0 + kk) * 6144];
#pragma unroll
                for (int kk = 0; kk < 16; ++kk)
#pragma unroll
                    for (int r = 0; r < 9; ++r) acc[r] += sc[r * 1024 + kg * 128 + k0 + kk] * w[kk]; }
#pragma unroll
            for (int r = 0; r < 9; ++r) red[(kg * 9 + r) * 64 + jj] = acc[r];
            __syncthreads();
            for (int i = tid; i < 576; i += NTHR) { const int r = i >> 6, j2 = i & 63; float s = a.in[I_MODB][l * 6144 + jc * 64 + j2];
#pragma unroll
                for (int g = 0; g < 8; ++g) s += red[(g * 9 + r) * 64 + j2];
                modv[((size_t)l * 9 + r) * 6144 + jc * 64 + j2] = s; }
            __syncthreads();
        }
        __syncthreads();
    }
    const int gw = B * NWAVES + wave, NGW = G * NWAVES, gt = B * NTHR + tid, NGT = G * NTHR;
    { float* rope = (float*)(ws + WS_ROPE);
      for (int i = gt; i < 4096 * 16; i += NGT) { const int t = i >> 4, p = i & 15; const float pos = (float)(p < 8 ? (t >> 6) : (t & 63));
          const float inv = __powf(10000.0f, -(float)(p & 7) * 0.125f); const float ang = pos * inv; rope[t * 32 + p] = cosf(ang); rope[t * 32 + 16 + p] = sinf(ang); }
      float* bgu = (float*)(ws + WS_BGU);
      for (int i = gt; i < 2 * 32 * 2048; i += NGT) { const int le = i >> 11, np = i & 2047, q = np >> 8, g = (np >> 7) & 1, r = np & 127, f = 128 * q + r; bgu[i] = a.in[I_BGU][(size_t)le * 2048 + 2 * f + g]; }
      float* pb = (float*)(ws + WS_PW1B);
      for (int i = gt; i < 2048; i += NGT) { const int q = i >> 8, g = (i >> 7) & 1, r = i & 127, f = 128 * q + r; pb[i] = a.in[I_PW1B][g * 1024 + f]; }
      v4u* zp = (v4u*)(ws + WS_WIN + (size_t)3232 * 1024 * 2);
      for (int i = gt; i < 96 * 1024 * 2 / 16; i += NGT) zp[i] = (v4u){0u, 0u, 0u, 0u};
    }
    LAS float* scr = (LAS float*)(lds + wave * 16640);
    constexpr int I0 = 16 * 51, I1 = 6 * 12, I2 = 4 * 8, I3 = 4 * 8, I4 = 256, I5 = 512, I6 = 256, SMALL = I0 + I1 + I2 + I3 + I4 + I5 + I6;
    constexpr int NGU = 64 * 512, NDN = 64 * 256, NITEMS = SMALL + NGU + NDN;
    convert_items(a, ws, scr, lane, B * NWAVES + wave, G * NWAVES, NGU + NDN, NITEMS);
}
__device__ __forceinline__ void convert_moe_share(const Args& a, LAS unsigned char* lds, int lane, int wave) {
    LAS float* scr = (LAS float*)(lds + wave * 16640);
    constexpr int NGU = 64 * 512, NDN = 64 * 256;
    convert_items(a, a.ws, scr, lane, blockIdx.x * NWAVES + wave, gridDim.x * NWAVES, 0, NGU + NDN);
}

__device__ __forceinline__ void phase_mod0(const Args& a, int lane, int wave) {
    const int gw = blockIdx.x * NWAVES + wave, NGW = gridDim.x * NWAVES;
    const float* modv = (const float*)(a.ws + WS_MODV);
    bf16* X = (bf16*)(a.ws + WS_X);
    for (int r0 = 2 * gw; r0 < NTOK; r0 += 2 * NGW) {
        f32x4 xv[2][4]; const float* mvp[2];
#pragma unroll
        for (int q = 0; q < 2; ++q) { const int r = r0 + q; const int b = r / TPB, p = r - b * TPB;
            const float* src = p < CTXL ? a.in[I_CTX] + ((size_t)b * CTXL + p) * 1024 : a.in[I_X] + ((size_t)b * SEQ + (p - CTXL)) * 1024;
            mvp[q] = modv + (size_t)(p < CTXL ? 8 : b) * 6144;
#pragma unroll
            for (int j = 0; j < 4; ++j) xv[q][j] = *(const f32x4*)(src + 4 * (lane + 64 * j)); }
#pragma unroll
        for (int q = 0; q < 2; ++q)
#pragma unroll
            for (int j = 0; j < 4; ++j) { const int c = 4 * (lane + 64 * j); const f32x4 sh = *(const f32x4*)(mvp[q] + c), sc = *(const f32x4*)(mvp[q] + 1024 + c);
                const f32x4 y = xv[q][j] * (sc + 1.0f) + sh; v2u o; o.x = pk2(y[0], y[1]); o.y = pk2(y[2], y[3]); *(v2u*)(X + (size_t)(r0 + q) * 1024 + c) = o; }
    }
}

__device__ __forceinline__ void phase_norm0(const Args& a, int lane, int wave) {
    const int gw = blockIdx.x * NWAVES + wave, NGW = gridDim.x * NWAVES;
    const bf16* Z = (const bf16*)(a.ws + WS_Z); bf16* CQN = (bf16*)(a.ws + WS_CQN); bf16* CKVN = (bf16*)(a.ws + WS_CKVN); bf16* KRR = (bf16*)(a.ws + WS_KRR);
    const float* rope = (const float*)(a.ws + WS_ROPE);
    float gq[8], gk[8];
#pragma unroll
    for (int i = 0; i < 8; ++i) { gq[i] = lane < 48 ? a.in[I_QNORM][8 * lane + i] : 0.f; gk[i] = lane < 32 ? a.in[I_KVNORM][8 * lane + i] : 0.f; }
    for (int r = gw; r < NTOK; r += NGW) {
        const bf16* z = Z + (size_t)r * ZC; const int p = r % TPB;
        bf16x8 q8 = {}, k8 = {}, r8 = {};
        if (lane < 48) q8 = *(const bf16x8*)(z + ZQ + 8 * lane);
        if (lane < 32) k8 = *(const bf16x8*)(z + ZKV + 8 * lane);
        if (lane < 4) r8 = *(const bf16x8*)(z + ZKR + 8 * lane);
        float qf[8], kf[8], sq = 0.f, sk = 0.f;
#pragma unroll
        for (int i = 0; i < 8; ++i) { qf[i] = bf2f((unsigned short)q8[i]); kf[i] = bf2f((unsigned short)k8[i]); sq += qf[i] * qf[i]; sk += kf[i] * kf[i]; }
        sq = wave_sum(sq); sk = wave_sum(sk);
        const float rq = rsqrtf(sq * (1.f / 384.f) + RMS_EPS), rk = rsqrtf(sk * (1.f / 256.f) + RMS_EPS);
        if (lane < 48) { v4u o; o.x = pk2(qf[0] * rq * gq[0], qf[1] * rq * gq[1]); o.y = pk2(qf[2] * rq * gq[2], qf[3] * rq * gq[3]); o.z = pk2(qf[4] * rq * gq[4], qf[5] * rq * gq[5]); o.w = pk2(qf[6] * rq * gq[6], qf[7] * rq * gq[7]);
            *(v4u*)(CQN + (size_t)r * 384 + 8 * lane) = o; }
        if (lane < 32) { v4u o; o.x = pk2(kf[0] * rk * gk[0], kf[1] * rk * gk[1]); o.y = pk2(kf[2] * rk * gk[2], kf[3] * rk * gk[3]); o.z = pk2(kf[4] * rk * gk[4], kf[5] * rk * gk[5]); o.w = pk2(kf[6] * rk * gk[6], kf[7] * rk * gk[7]);
            *(v4u*)(CKVN + (size_t)r * 256 + 8 * lane) = o; }
        if (lane < 4) { bf16x8 o8 = r8; if (p >= CTXL) o8 = att::rope8(r8, rope + (size_t)(p - CTXL) * 32, 4 * lane); *(bf16x8*)(KRR + (size_t)r * 32 + 8 * lane) = o8; }
    }
}

__device__ __forceinline__ void hgrn_unit(const Args& a, int unit, LAS unsigned char* lds, int tid) {
    const int b = unit >> 5, head = (unit >> 3) & 3, dir = (unit >> 2) & 1, sl = unit & 3;
    const bf16* Z = (const bf16*)(a.ws + WS_Z);
    float* Od = (float*)(a.ws + (dir ? WS_OB : WS_OF));
    LAS float* lbv = (LAS float*)lds;
    constexpr int BUF0 = 1024, BUFSZ = 28672, OFF_Q = 16384, OFF_V = 24576;
    if (tid < 128) { const int c = head * 128 + tid; const float l0 = a.in[I_LBL][c], l1 = a.in[I_LBL][512 + c], l2 = a.in[I_LBL][1024 + c]; const float m = fmaxf(l0, fmaxf(l1, l2));
        const float e0 = __expf(l0 - m), e1 = __expf(l1 - m), e2 = __expf(l2 - m); lbv[tid] = e0 / (e0 + e1 + e2); }
    __syncthreads();
    const int lt = tid >> 4, lcg = tid & 15;
    float lb8[8];
#pragma unroll
    for (int i = 0; i < 8; ++i) lb8[i] = lbv[8 * lcg + i];
    const int fcol = (dir ? ZHB : ZHF) + head * 128 + 8 * lcg, qcol = ZHQ + head * 128 + 8 * lcg;
    const int vt = tid >> 2, vcol = ZHI + head * 128 + sl * 32 + (tid & 3) * 8;
    const int wave = tid >> 6, lane = tid & 63, vv = lane >> 4, cg = lane & 15, vloc = wave * 4 + vv;
    const size_t zb = (size_t)b * TPB;
    bf16x8 rq, rf, rv;
#define TOKP(n) (dir ? ((n) < CTXL ? (CTXL - 1 - (n)) : (TPB + CTXL - 1 - (n))) : (n))
#define HG_LOAD(i) do { const int n_ = 32 * (i) + lt; const bf16* zr_ = Z + (zb + TOKP(n_)) * ZC; rq = *(const bf16x8*)(zr_ + qcol); rf = *(const bf16x8*)(zr_ + fcol); \
        if (tid < 128) { const int n2_ = 32 * (i) + vt; rv = *(const bf16x8*)(Z + (zb + TOKP(n2_)) * ZC + vcol); } } while (0)
#define HG_WRITE(bufi) do { LAS unsigned char* bp_ = lds + BUF0 + (bufi) * BUFSZ; float f_[8]; \
        _Pragma("unroll") for (int i_ = 0; i_ < 8; ++i_) f_[i_] = lb8[i_] + (1.f - lb8[i_]) * sigm(bf2f((unsigned short)rf[i_])); \
        *(LAS f32x4*)(bp_ + ((lt * 128 + lcg * 4) * 4)) = (f32x4){f_[0], f_[1], f_[2], f_[3]}; *(LAS f32x4*)(bp_ + ((lt * 128 + 64 + lcg * 4) * 4)) = (f32x4){f_[4], f_[5], f_[6], f_[7]}; \
        *(LAS bf16x8*)(bp_ + OFF_Q + (lt * 128 + lcg * 8) * 2) = rq; \
        if (tid < 128) { float v_[8]; _Pragma("unroll") for (int i_ = 0; i_ < 8; ++i_) v_[i_] = bf2f((unsigned short)rv[i_]); \
            *(LAS f32x4*)(bp_ + OFF_V + (vt * 32 + (tid & 3) * 8) * 4) = (f32x4){v_[0], v_[1], v_[2], v_[3]}; *(LAS f32x4*)(bp_ + OFF_V + (vt * 32 + (tid & 3) * 8 + 4) * 4) = (f32x4){v_[4], v_[5], v_[6], v_[7]}; } } while (0)
    float S[8];
#pragma unroll
    for (int j = 0; j < 8; ++j) S[j] = 0.f;
    HG_LOAD(0); HG_WRITE(0); __syncthreads();
    const bool b3 = (cg & 8) != 0, b2 = (cg & 4) != 0, b1 = (cg & 2) != 0, b0 = (cg & 1) != 0;
    for (int i = 0; i < TPB / 32; ++i) {
        if (i + 1 < TPB / 32) HG_LOAD(i + 1);
        const LAS unsigned char* bp = lds + BUF0 + (i & 1) * BUFSZ;
#pragma unroll 1
        for (int g = 0; g < 4; ++g) {
            const LAS unsigned char* gp = bp + g * 8 * 512;
            float ot[8];
#pragma unroll
            for (int t = 0; t < 8; ++t) {
                const f32x4 f0 = *(const LAS f32x4*)(gp + ((t * 128 + cg * 4) * 4)), f1 = *(const LAS f32x4*)(gp + ((t * 128 + 64 + cg * 4) * 4));
                const bf16x8 q8 = *(const LAS bf16x8*)(bp + OFF_Q + ((g * 8 + t) * 128 + cg * 8) * 2);
                const float v = *(const LAS float*)(bp + OFF_V + ((g * 8 + t) * 32 + vloc) * 4);
                float acc = 0.f;
#pragma unroll
                for (int j = 0; j < 8; ++j) { const float fj = j < 4 ? f0[j] : f1[j - 4]; const float qj = bf2f((unsigned short)q8[j]);
                    const float kv = fmaf(-fj, v, v); S[j] = fmaf(fj, S[j], kv); acc = fmaf(S[j], qj, acc); }
                ot[t] = acc;
            }
#pragma unroll
            for (int k = 0; k < 4; ++k) { const float snd = b3 ? ot[k] : ot[k + 4]; const float rcv = __shfl_xor(snd, 8); ot[k] = (b3 ? ot[k + 4] : ot[k]) + rcv; }
#pragma unroll
            for (int k = 0; k < 2; ++k) { const float snd = b2 ? ot[k] : ot[k + 2]; const float rcv = __shfl_xor(snd, 4); ot[k] = (b2 ? ot[k + 2] : ot[k]) + rcv; }
            { const float snd = b1 ? ot[0] : ot[1]; const float rcv = __shfl_xor(snd, 2); ot[0] = (b1 ? ot[1] : ot[0]) + rcv; }
            ot[0] += __shfl_xor(ot[0], 1);
            if (!b0) { const int n = 32 * i + 8 * g + (cg >> 1); const int p = TOKP(n); if (p >= CTXL) Od[(zb + p) * 512 + head * 128 + sl * 32 + vloc] = ot[0]; }
        }
        if (i + 1 < TPB / 32) HG_WRITE((i + 1) & 1);
        __syncthreads();
    }
#undef TOKP
#undef HG_LOAD
#undef HG_WRITE
}

__device__ __forceinline__ void phase_readout(const Args& a, int lane, int wave) {
    const int gw = blockIdx.x * NWAVES + wave, NGW = gridDim.x * NWAVES;
    const bf16* OF = (const bf16*)(a.ws + WS_OF); const bf16* OB = (const bf16*)(a.ws + WS_OB);
    const bf16* Z = (const bf16*)(a.ws + WS_Z); bf16* MIX = (bf16*)(a.ws + WS_Y);
    float hn[8];
#pragma unroll
    for (int i = 0; i < 8; ++i) hn[i] = a.in[I_HGNORM][((8 * lane) & 127) + i];
    for (int lr = gw; lr < NLAT; lr += NGW) {
        const size_t r = (size_t)grow_of(lr);
        const bf16x8 a8 = *(const bf16x8*)(OF + r * 512 + 8 * lane), c8 = *(const bf16x8*)(OB + r * 512 + 8 * lane);
        const bf16x8 g8 = *(const bf16x8*)(Z + r * ZC + ZHG + 8 * lane);
        float o[8]; float ss = 0.f;
#pragma unroll
        for (int i = 0; i < 8; ++i) o[i] = bf2f((unsigned short)a8[i]) + bf2f((unsigned short)c8[i]);
#pragma unroll
        for (int i = 0; i < 8; ++i) ss += o[i] * o[i];
        ss += __shfl_xor(ss, 1); ss += __shfl_xor(ss, 2); ss += __shfl_xor(ss, 4); ss += __shfl_xor(ss, 8);
        const float rs = rsqrtf(ss * (1.f / 128.f) + RMS_EPS);
        float y[8];
#pragma unroll
        for (int i = 0; i < 8; ++i) { const float g = bf2f((unsigned short)g8[i]); y[i] = o[i] * rs * hn[i] * (g * sigm(g)); }
        v4u w; w.x = pk2(y[0], y[1]); w.y = pk2(y[2], y[3]); w.z = pk2(y[4], y[5]); w.w = pk2(y[6], y[7]);
        *(v4u*)(MIX + r * 1024 + 512 + 8 * lane) = w;
    }
}

__device__ __forceinline__ int rows_per_block() { const int G = gridDim.x; return (((NLAT + G - 1) / G) + 15) & ~15; }
__device__ __forceinline__ void phase_ln1(const Args& a, int l, LAS unsigned char* lds, int tid, int lane, int wave) {
    typedef short bf16x8s __attribute__((ext_vector_type(8)));
    const int RB = rows_per_block(), lr_base = blockIdx.x * RB;
    const bf16* PRE = (const bf16*)(a.ws + WS_PRE); bf16* XB = (bf16*)(a.ws + WS_X);
    const float* modv = (const float*)(a.ws + WS_MODV) + (size_t)l * 9 * 6144;
    const float* lng = a.in[I_LN1G] + l * 1024; const float* lnb = a.in[I_LN1B] + l * 1024;
    const float* rw = a.in[I_RW] + (size_t)l * 1024 * 32; const float* rb = a.in[I_RB] + l * 32;
    constexpr int XT_LD = 1028, O_PART = 16 * XT_LD * 4, O_LG = O_PART + 8 * 32 * 16 * 4, O_HIST = O_LG + 16 * 33 * 4 + 64, O_CCNT = O_HIST + 256, O_TIL = O_CCNT + 2048, O_TWL = O_TIL + 4096;
    LAS float* XT = (LAS float*)lds; LAS float* PART = (LAS float*)(lds + O_PART); LAS float* LG = (LAS float*)(lds + O_LG);
    LAS int* hist = (LAS int*)(lds + O_HIST);
    LAS int* ccnt = (LAS int*)(lds + O_CCNT);
    LAS int* til = (LAS int*)(lds + O_TIL);
    LAS float* twl = (LAS float*)(lds + O_TWL);
    __syncthreads();
    if (tid < 32) hist[tid] = 0;
    bf16x8s whi[2][4], wlo[2][4];
    { const int e15 = lane & 15, kq = lane >> 4;
#pragma unroll
      for (int t = 0; t < 2; ++t)
#pragma unroll
          for (int sI = 0; sI < 4; ++sI) { float wv[8];
#pragma unroll
              for (int j = 0; j < 8; ++j) wv[j] = rw[(size_t)(128 * wave + 32 * sI + 8 * kq + j) * 32 + 16 * t + e15];
              v4u ph, pl;
#pragma unroll
              for (int j = 0; j < 4; ++j) { const unsigned p = pk2(wv[2 * j], wv[2 * j + 1]); const float h0 = __uint_as_float(p << 16), h1 = __uint_as_float(p & 0xffff0000u); ph[j] = p; pl[j] = pk2(wv[2 * j] - h0, wv[2 * j + 1] - h1); }
              whi[t][sI] = __builtin_bit_cast(bf16x8s, ph); wlo[t][sI] = __builtin_bit_cast(bf16x8s, pl); } }
    const int ngroups = RB / 16;
    v2u xr[2][4];
#define LN1_LOAD(g) do { _Pragma("unroll") for (int rr_ = 0; rr_ < 2; ++rr_) { const int lr_ = lr_base + 16 * (g) + 2 * wave + rr_; const size_t r_ = (size_t)grow_of(lr_ < NLAT ? lr_ : NLAT - 1); \
        _Pragma("unroll") for (int j_ = 0; j_ < 4; ++j_) xr[rr_][j_] = *(const v2u*)(PRE + r_ * 1024 + 4 * (lane + 64 * j_)); } } while (0)
#if defined(PROBE_LN1X2)
    for (int rep_ = 0; rep_ < 2; ++rep_) { __syncthreads(); if (tid < 32) hist[tid] = 0; __syncthreads();
#endif
    LN1_LOAD(0);
    for (int g = 0; g < ngroups; ++g) {
#pragma unroll
        for (int rr = 0; rr < 2; ++rr) {
            const int lr = lr_base + 16 * g + 2 * wave + rr; const bool ok = lr < NLAT; const size_t r = (size_t)grow_of(ok ? lr : NLAT - 1); const int b = (ok ? lr : NLAT - 1) >> 12;
            const float* mv = modv + (size_t)b * 6144;
            f32x4 x[4]; float s = 0.f;
#pragma unroll
            for (int j = 0; j < 4; ++j) { const v2u p = xr[rr][j]; x[j] = (f32x4){__uint_as_float(p.x << 16), __uint_as_float(p.x & 0xffff0000u), __uint_as_float(p.y << 16), __uint_as_float(p.y & 0xffff0000u)}; s += (x[j][0] + x[j][1]) + (x[j][2] + x[j][3]); }
            const float mean = wave_sum(s) * (1.f / 1024.f); float s2 = 0.f;
#pragma unroll
            for (int j = 0; j < 4; ++j) { x[j] = x[j] - mean; s2 += (x[j][0] * x[j][0] + x[j][1] * x[j][1]) + (x[j][2] * x[j][2] + x[j][3] * x[j][3]); }
            const float rstd = rsqrtf(wave_sum(s2) * (1.f / 1024.f) + LN_EPS);
#pragma unroll
            for (int j = 0; j < 4; ++j) { const int c = 4 * (lane + 64 * j); const f32x4 gg = *(const f32x4*)(lng + c), bb = *(const f32x4*)(lnb + c);
                const f32x4 hv = x[j] * rstd * gg + bb;
                const f32x4 sh = *(const f32x4*)(mv + 3 * 1024 + c), sc = *(const f32x4*)(mv + 4 * 1024 + c);
                const f32x4 bm = hv * (sc + 1.0f) + sh;
                if (ok) *(unsigned*)((unsigned char*)XB + r * 1024 + c) = pack_fp8x4(bm[0] * SC_X8, bm[1] * SC_X8, bm[2] * SC_X8, bm[3] * SC_X8);
                *(LAS f32x4*)(XT + (2 * wave + rr) * XT_LD + c) = bm; }
        }
        if (g + 1 < ngroups) LN1_LOAD(g + 1);
        __syncthreads();
        { const int rr = lane & 15, kq = lane >> 4;
          f32x4 acc0 = {0.f, 0.f, 0.f, 0.f}, acc1 = {0.f, 0.f, 0.f, 0.f};
#pragma unroll
          for (int sI = 0; sI < 4; ++sI) { const LAS float* xp = XT + rr * XT_LD + 128 * wave + 32 * sI + 8 * kq; const f32x4 v0 = *(const LAS f32x4*)xp, v1 = *(const LAS f32x4*)(xp + 4);
              const float bv[8] = {v0[0], v0[1], v0[2], v0[3], v1[0], v1[1], v1[2], v1[3]}; v4u ph, pl;
#pragma unroll
              for (int j = 0; j < 4; ++j) { const unsigned p = pk2(bv[2 * j], bv[2 * j + 1]); const float h0 = __uint_as_float(p << 16), h1 = __uint_as_float(p & 0xffff0000u); ph[j] = p; pl[j] = pk2(bv[2 * j] - h0, bv[2 * j + 1] - h1); }
              const bf16x8s bh = __builtin_bit_cast(bf16x8s, ph), bl = __builtin_bit_cast(bf16x8s, pl);
              acc0 = __builtin_amdgcn_mfma_f32_16x16x32_bf16(whi[0][sI], bh, acc0, 0, 0, 0); acc0 = __builtin_amdgcn_mfma_f32_16x16x32_bf16(whi[0][sI], bl, acc0, 0, 0, 0); acc0 = __builtin_amdgcn_mfma_f32_16x16x32_bf16(wlo[0][sI], bh, acc0, 0, 0, 0);
              acc1 = __builtin_amdgcn_mfma_f32_16x16x32_bf16(whi[1][sI], bh, acc1, 0, 0, 0); acc1 = __builtin_amdgcn_mfma_f32_16x16x32_bf16(whi[1][sI], bl, acc1, 0, 0, 0); acc1 = __builtin_amdgcn_mfma_f32_16x16x32_bf16(wlo[1][sI], bh, acc1, 0, 0, 0); }
#pragma unroll
          for (int q = 0; q < 4; ++q) { PART[(wave * 32 + 4 * kq + q) * 16 + rr] = acc0[q]; PART[(wave * 32 + 16 + 4 * kq + q) * 16 + rr] = acc1[q]; } }
        __syncthreads();
        { const int e = tid >> 4, rr = tid & 15; float sacc = rb[e];
#pragma unroll
          for (int w = 0; w < 8; ++w) sacc += PART[(w * 32 + e) * 16 + rr];
          LG[rr * 33 + e] = sacc; }
        __syncthreads();
        if (wave == (g & 7) && lane < 16) { const int lr = lr_base + 16 * g + lane;
            if (lr < NLAT) { float lg[32];
#pragma unroll
                for (int e = 0; e < 32; ++e) lg[e] = LG[lane * 33 + e];
                unsigned taken = 0u; float tv[4]; int ti[4];
#pragma unroll
                for (int kk = 0; kk < 4; ++kk) { float best = -3.0e38f; int bi = 0;
#pragma unroll
                    for (int e = 0; e < 32; ++e) { const bool okk = (lg[e] > best) && !((taken >> e) & 1u); best = okk ? lg[e] : best; bi = okk ? e : bi; }
                    taken |= 1u << bi; tv[kk] = best; ti[kk] = bi; }
                const float e1 = __expf(tv[1] - tv[0]), e2 = __expf(tv[2] - tv[0]), e3 = __expf(tv[3] - tv[0]); const float inv = 1.f / (1.f + e1 + e2 + e3);
                const int li = (16 * g + lane) * 4; til[li] = ti[0]; til[li + 1] = ti[1]; til[li + 2] = ti[2]; til[li + 3] = ti[3]; twl[li] = inv; twl[li + 1] = e1 * inv; twl[li + 2] = e2 * inv; twl[li + 3] = e3 * inv;
                __hip_atomic_fetch_add(hist + ti[0], 1, __ATOMIC_RELAXED, __HIP_MEMORY_SCOPE_WORKGROUP); __hip_atomic_fetch_add(hist + ti[1], 1, __ATOMIC_RELAXED, __HIP_MEMORY_SCOPE_WORKGROUP);
                __hip_atomic_fetch_add(hist + ti[2], 1, __ATOMIC_RELAXED, __HIP_MEMORY_SCOPE_WORKGROUP); __hip_atomic_fetch_add(hist + ti[3], 1, __ATOMIC_RELAXED, __HIP_MEMORY_SCOPE_WORKGROUP); } }
    }
#if defined(PROBE_LN1X2)
    }
#endif
#undef LN1_LOAD
    __syncthreads();
    int* cursor = (int*)(a.ws + WS_CURSOR) + l * 32;
    int* rows = (int*)(a.ws + WS_ROWS); float* roww = (float*)(a.ws + WS_ROWW); int* rowd = (int*)(a.ws + WS_ROWD);
    int nrows = NLAT - lr_base; nrows = nrows > RB ? RB : nrows; if (nrows < 0) nrows = 0;
    const int nas = nrows * 4, nchunks = (nas + 63) >> 6;
    int basev = 0; if (tid < 32) basev = (int)__hip_atomic_fetch_add((unsigned*)cursor + tid, (unsigned)hist[tid], __ATOMIC_RELAXED, __HIP_MEMORY_SCOPE_AGENT);
    int myrank[2] = {0, 0}, mye[2] = {-1, -1};
#pragma unroll
    for (int cc = 0; cc < 2; ++cc) { const int c = wave + 8 * cc; if (c < nchunks) { const int idx = c * 64 + lane; const int e = idx < nas ? til[idx] : -1; mye[cc] = e;
        for (int x = 0; x < 32; ++x) { const unsigned long long m = __ballot(e == x); if (e == x) myrank[cc] = __popcll(m & ((1ull << lane) - 1ull)); if (lane == 0) ccnt[c * 32 + x] = __popcll(m); } } }
    __syncthreads();
    if (tid < 32) hist[32 + tid] = basev;
    __syncthreads();
#pragma unroll
    for (int cc = 0; cc < 2; ++cc) { const int c = wave + 8 * cc; const int idx = c * 64 + lane; if (c < nchunks && idx < nas) { const int e = mye[cc]; int pos = hist[32 + e] + myrank[cc]; for (int c2 = 0; c2 < c; ++c2) pos += ccnt[c2 * 32 + e];
        const int lr = lr_base + (idx >> 2); const size_t pi = (size_t)e * ECAP + pos; rows[pi] = grow_of(lr); roww[pi] = twl[idx]; rowd[pi] = lr * 4 + (idx & 3); } }
}

__device__ __forceinline__ void phase_ln2(const Args& a, int l, int lane, int wave) {
    const int gw = blockIdx.x * NWAVES + wave, NGW = gridDim.x * NWAVES;
    float* H = (float*)(a.ws + WS_H); const bf16* PRE = (const bf16*)(a.ws + WS_PRE); const unsigned char* YB = (const unsigned char*)(a.ws + WS_YB); bf16* A1 = (bf16*)(a.ws + WS_Y);
    const float* modv = (const float*)(a.ws + WS_MODV);
    const float* ln1g = a.in[I_LN1G] + l * 1024; const float* ln1b = a.in[I_LN1B] + l * 1024;
    const float* lng = a.in[I_LN2G] + l * 1024; const float* lnb = a.in[I_LN2B] + l * 1024;
    for (int lr0 = 2 * gw; lr0 < NLAT; lr0 += 2 * NGW) {
        v2u hv[2][4]; unsigned yv[2][4][4];
#pragma unroll
        for (int q = 0; q < 2; ++q) { const int lr = lr0 + q; const size_t r = (size_t)grow_of(lr);
#pragma unroll
            for (int j = 0; j < 4; ++j) { const int c = 4 * (lane + 64 * j); hv[q][j] = *(const v2u*)(PRE + r * 1024 + c);
#pragma unroll
                for (int k = 0; k < 4; ++k) yv[q][j][k] = *(const unsigned*)(YB + ((size_t)lr * 4 + k) * 1024 + c); } }
#pragma unroll
        for (int q = 0; q < 2; ++q) {
            const int lr = lr0 + q; const size_t r = (size_t)grow_of(lr); const int b = lr >> 12;
            const float* mv = modv + ((size_t)l * 9 + b) * 6144; const float* mv1 = modv + ((size_t)9 + b) * 6144;
            f32x4 x[4]; float s = 0.f;
#pragma unroll
            for (int j = 0; j < 4; ++j) { const v2u p = hv[q][j]; x[j] = (f32x4){__uint_as_float(p.x << 16), __uint_as_float(p.x & 0xffff0000u), __uint_as_float(p.y << 16), __uint_as_float(p.y & 0xffff0000u)}; s += (x[j][0] + x[j][1]) + (x[j][2] + x[j][3]); }
            float mean = wave_sum(s) * (1.f / 1024.f), s2 = 0.f;
#pragma unroll
            for (int j = 0; j < 4; ++j) { x[j] = x[j] - mean; s2 += (x[j][0] * x[j][0] + x[j][1] * x[j][1]) + (x[j][2] * x[j][2] + x[j][3] * x[j][3]); }
            float rstd = rsqrtf(wave_sum(s2) * (1.f / 1024.f) + LN_EPS);
            s = 0.f;
#pragma unroll
            for (int j = 0; j < 4; ++j) { const int c = 4 * (lane + 64 * j); const f32x4 g = *(const f32x4*)(ln1g + c), bb = *(const f32x4*)(ln1b + c);
                const f32x4 h1 = x[j] * rstd * g + bb; f32x4 f = {0.f, 0.f, 0.f, 0.f};
#pragma unroll
                for (int k = 0; k < 4; ++k) { const unsigned y = yv[q][j][k]; const auto lo = __builtin_amdgcn_cvt_pk_f32_fp8((int)y, false), hi = __builtin_amdgcn_cvt_pk_f32_fp8((int)y, true);
                    f[0] += lo[0]; f[1] += lo[1]; f[2] += hi[0]; f[3] += hi[1]; }
                const f32x4 gt = *(const f32x4*)(mv + 5 * 1024 + c);
                x[j] = h1 * ALPHA + gt * (f * (1.f / SC_Y)); s += (x[j][0] + x[j][1]) + (x[j][2] + x[j][3]); }
            mean = wave_sum(s) * (1.f / 1024.f); s2 = 0.f;
#pragma unroll
            for (int j = 0; j < 4; ++j) { x[j] = x[j] - mean; s2 += (x[j][0] * x[j][0] + x[j][1] * x[j][1]) + (x[j][2] * x[j][2] + x[j][3] * x[j][3]); }
            rstd = rsqrtf(wave_sum(s2) * (1.f / 1024.f) + LN_EPS);
#pragma unroll
            for (int j = 0; j < 4; ++j) { const int c = 4 * (lane + 64 * j); const f32x4 g = *(const f32x4*)(lng + c), bb = *(const f32x4*)(lnb + c);
                const f32x4 o = x[j] * rstd * g + bb;
                if (l == 0) { *(f32x4*)(H + r * 1024 + c) = o; const f32x4 sh = *(const f32x4*)(mv1 + c), sc = *(const f32x4*)(mv1 + 1024 + c);
                    const f32x4 am = o * (sc + 1.0f) + sh; v2u w; w.x = pk2(am[0], am[1]); w.y = pk2(am[2], am[3]); *(v2u*)(A1 + r * 1024 + c) = w; }
                else *(f32x4*)(a.out + (size_t)lr * 1024 + c) = o; }
        }
    }
}

__device__ __forceinline__ void phase_conv(const Args& a, LAS unsigned char* lds, int tid, int lane, int wave) {
    const bf16* U = (const bf16*)(a.ws + WS_X); bf16* V = (bf16*)(a.ws + WS_Y);
    LAS float* part = (LAS float*)(lds + 126976);
    LAS float* st = part + 512;
    const int c0 = 2 * tid;
    const float db0 = a.in[I_DWB][c0], db1 = a.in[I_DWB][c0 + 1], g0 = a.in[I_CLNG][c0], g1 = a.in[I_CLNG][c0 + 1], be0 = a.in[I_CLNB][c0], be1 = a.in[I_CLNB][c0 + 1];
    for (int tile = blockIdx.x; tile < NLAT / 32; tile += gridDim.x) {
        const int b = tile >> 7, t0 = (tile & 127) * 32;
        const size_t rb0 = (size_t)b * TPB + CTXL;
        __syncthreads();
        for (int i = tid; i < 62 * 128; i += NTHR) { const int row = i >> 7, chk = i & 127, t = t0 - 15 + row;
            v4u val = {0u, 0u, 0u, 0u}; if (t >= 0 && t < SEQ) val = *(const v4u*)(U + (rb0 + t) * 1024 + chk * 8);
            *(LAS v4u*)(lds + row * 2048 + chk * 16) = val; }
        __syncthreads();
        float w0[31], w1[31];
#pragma unroll
        for (int j = 0; j < 31; ++j) { const float2 wv = *(const float2*)(a.in[I_DWW] + j * 1024 + c0); w0[j] = wv.x; w1[j] = wv.y; }
#pragma unroll 1
        for (int hh = 0; hh < 2; ++hh) {
            const LAS unsigned char* hp = lds + hh * 16 * 2048;
            float acc0[16], acc1[16];
#pragma unroll
            for (int t = 0; t < 16; ++t) { acc0[t] = db0; acc1[t] = db1; }
#pragma unroll
            for (int s = 0; s < 46; ++s) { const unsigned pr = *(const LAS unsigned*)(hp + s * 2048 + tid * 4); const float x0 = __uint_as_float(pr << 16), x1 = __uint_as_float(pr & 0xffff0000u);
#pragma unroll
                for (int t = (s > 30 ? s - 30 : 0); t <= (s < 15 ? s : 15); ++t) { acc0[t] = fmaf(x0, w0[s - t], acc0[t]); acc1[t] = fmaf(x1, w1[s - t], acc1[t]); } }
            float rs[32];
#pragma unroll
            for (int t = 0; t < 16; ++t) { rs[2 * t] = acc0[t] + acc1[t]; rs[2 * t + 1] = acc0[t] * acc0[t] + acc1[t] * acc1[t]; }
#define RS_STEP(NKEEP, XORV) { const bool bit_ = (lane & XORV) != 0; _Pragma("unroll") for (int k_ = 0; k_ < NKEEP; ++k_) { const float snd_ = bit_ ? rs[k_] : rs[k_ + NKEEP]; const float rcv_ = __shfl_xor(snd_, XORV); rs[k_] = (bit_ ? rs[k_ + NKEEP] : rs[k_]) + rcv_; } }
            RS_STEP(16, 32) RS_STEP(8, 16) RS_STEP(4, 8) RS_STEP(2, 4) RS_STEP(1, 2)
#undef RS_STEP
            rs[0] += __shfl_xor(rs[0], 1);
            __syncthreads();
            if ((lane & 1) == 0) part[wave * 32 + (lane >> 1)] = rs[0];
            __syncthreads();
            if (tid < 16) { float s1 = 0.f, s2 = 0.f;
#pragma unroll
                for (int w = 0; w < 8; ++w) { s1 += part[w * 32 + 2 * tid]; s2 += part[w * 32 + 2 * tid + 1]; }
                const float mean = s1 * (1.f / 1024.f); const float var = fmaxf(s2 * (1.f / 1024.f) - mean * mean, 0.f); st[2 * tid] = mean; st[2 * tid + 1] = rsqrtf(var + LN_EPS); }
            __syncthreads();
#pragma unroll
            for (int t = 0; t < 16; ++t) { const float mean = st[2 * t], rstd = st[2 * t + 1];
                const float y0 = (acc0[t] - mean) * rstd * g0 + be0, y1 = (acc1[t] - mean) * rstd * g1 + be1;
                *(unsigned*)(V + (rb0 + t0 + hh * 16 + t) * 1024 + c0) = pk2(y0 * sigm(y0), y1 * sigm(y1)); }
        }
    }
}

namespace hg {
using bf16x8 = __attribute__((ext_vector_type(8))) short;
using s16x4  = __attribute__((ext_vector_type(4))) short;
using f32x16 = __attribute__((ext_vector_type(16))) float;
using u32x4  = __attribute__((ext_vector_type(4))) unsigned;
constexpr int RS = 272;
constexpr int VS = 80;
constexpr int T_Q = 0, T_KO = 32 * RS, T_KE = 64 * RS, T_D = 96 * RS, IMG_BYTES = T_D + 512, T_V = IMG_BYTES, TILE_BYTES = T_V + 32 * VS;
constexpr int OFF_TILES = 1024, NTB = 3, OFF_OPART = OFF_TILES + NTB * TILE_BYTES, OPART_BYTES = 4 * 4096;
static_assert(OFF_OPART + 2 * OPART_BYTES <= 131072 && IMG_BYTES % 16 == 0 && IMG_BYTES / 16 == 1664, "hgrn lds");
constexpr int P_RAW = 1024, R_Q = 0, R_F = 32 * RS, RAW_BYTES = 64 * RS, P_IMG = P_RAW + RAW_BYTES;
constexpr int NCHUNK = TPB / 32, NCHAIN = NB * 4 * 2, NITEM = NCHAIN * NCHUNK;
__device__ __forceinline__ int crow(int r, int hi) { return (r & 3) + 8 * (r >> 2) + 4 * hi; }
__device__ __forceinline__ s16x4 tr_read(unsigned addr) { s16x4 r; asm volatile("ds_read_b64_tr_b16 %0, %1" : "=&v"(r) : "v"(addr) : "memory"); return r; }
__device__ __forceinline__ bf16x8 cat8(s16x4 l, s16x4 h) { return (bf16x8){l[0], l[1], l[2], l[3], h[0], h[1], h[2], h[3]}; }
__device__ __forceinline__ bf16x8 pack8(const f32x16& x, int base) {
    u32x4 w; w[0] = pk2(x[base + 0], x[base + 1]); w[1] = pk2(x[base + 2], x[base + 3]); w[2] = pk2(x[base + 4], x[base + 5]); w[3] = pk2(x[base + 6], x[base + 7]);
    return *reinterpret_cast<bf16x8*>(&w);
}
}


#define HG_TOKP(dir, n) ((dir) ? ((n) < CTXL ? (CTXL - 1 - (n)) : (TPB + CTXL - 1 - (n))) : (n))
#define HG_DPP1(x, ctrl, rmask) __int_as_float(__builtin_amdgcn_update_dpp(0x3f800000, __float_as_int(x), ctrl, rmask, 0xf, false))
#define HG_DPP(x, ctrl, rmask) __int_as_float(__builtin_amdgcn_update_dpp(0, __float_as_int(x), ctrl, rmask, 0xf, false))
__device__ __forceinline__ void hgrn_prep_items(const Args& a, LAS unsigned char* lds, int tid) {
    using namespace hg;
    const bf16* Z = (const bf16*)(a.ws + WS_Z);
    unsigned char* HT = a.ws + WS_HT;
    const int wave = __builtin_amdgcn_readfirstlane(tid >> 6), lane = tid & 63, t = lane & 31, half = lane >> 5;
    const int c0 = 16 * wave + 8 * half;
    const int lr = tid >> 4, lch = tid & 15;
    LAS float* lbt = (LAS float*)lds;
    constexpr int P_RAW2 = 2048, P_IMG2 = P_RAW2 + 2 * RAW_BYTES;
    static_assert(P_IMG2 + 2 * IMG_BYTES <= 131072, "prep lds");
    __syncthreads();
    { const float l0 = a.in[I_LBL][tid], l1 = a.in[I_LBL][512 + tid], l2 = a.in[I_LBL][1024 + tid]; const float m = fmaxf(l0, fmaxf(l1, l2));
      const float e0 = __expf(l0 - m), e1 = __expf(l1 - m), e2 = __expf(l2 - m); lbt[tid] = e0 / (e0 + e1 + e2); }
    bf16x8 gq, gf;
#define HP_LOAD(it) do { const int ch_ = (it) % NCHUNK, cn_ = (it) / NCHUNK, dir_ = cn_ & 1, hd_ = (cn_ >> 1) & 3, b_ = cn_ >> 3; \
        const bf16* zr_ = Z + ((size_t)b_ * TPB + HG_TOKP(dir_, 32 * ch_ + lr)) * ZC; gq = *(const bf16x8*)(zr_ + ZHQ + hd_ * 128 + lch * 8); gf = *(const bf16x8*)(zr_ + (dir_ ? ZHB : ZHF) + hd_ * 128 + lch * 8); } while (0)
#define HP_STASH(bufi) do { LAS unsigned char* rb_ = lds + P_RAW2 + (bufi) * RAW_BYTES; *(LAS bf16x8*)(rb_ + R_Q + lr * RS + lch * 16) = gq; *(LAS bf16x8*)(rb_ + R_F + lr * RS + lch * 16) = gf; } while (0)
#define HP_COPYOUT(item, bufi) do { v4u* dst_ = (v4u*)(HT + (size_t)(item) * IMG_BYTES); const LAS v4u* src_ = (const LAS v4u*)(lds + P_IMG2 + (bufi) * IMG_BYTES); \
        dst_[tid] = src_[tid]; dst_[tid + 512] = src_[tid + 512]; dst_[tid + 1024] = src_[tid + 1024]; if (tid < 128) dst_[tid + 1536] = src_[tid + 1536]; } while (0)
    const int G = gridDim.x;
    int it = blockIdx.x, par = 0;
    if (it < NITEM) { HP_LOAD(it); HP_STASH(0); }
    if (it + G < NITEM) HP_LOAD(it + G);
    __syncthreads();
    for (; it < NITEM; it += G, par ^= 1) {
        if (it + G < NITEM) HP_STASH(par ^ 1);
        if (it != (int)blockIdx.x) HP_COPYOUT(it - G, par ^ 1);
        if (it + 2 * G < NITEM) HP_LOAD(it + 2 * G);
        const int hd = ((it / NCHUNK) >> 1) & 3;
        {
            const LAS unsigned char* rb_ = lds + P_RAW2 + par * RAW_BYTES;
            const bf16x8 RQ = *(const LAS bf16x8*)(rb_ + R_Q + t * RS + c0 * 2), RF = *(const LAS bf16x8*)(rb_ + R_F + t * RS + c0 * 2);
            const f32x4 lbA = *(const LAS f32x4*)(lbt + hd * 128 + c0), lbB = *(const LAS f32x4*)(lbt + hd * 128 + c0 + 4);
            LAS unsigned char* tb_ = lds + P_IMG2 + par * IMG_BYTES;
            float bb_[8], kk_[8];
#pragma unroll
            for (int i_ = 0; i_ < 8; ++i_) { const float lb_ = i_ < 4 ? lbA[i_] : lbB[i_ - 4]; const float f_ = lb_ + (1.f - lb_) * __builtin_amdgcn_rcpf(1.f + __expf(-bf2f((unsigned short)RF[i_]))); kk_[i_] = 1.f - f_; bb_[i_] = f_; }
#pragma unroll
            for (int i_ = 0; i_ < 8; ++i_) { float x_ = bb_[i_]; x_ *= HG_DPP1(x_, 0x111, 0xf); x_ *= HG_DPP1(x_, 0x112, 0xf); x_ *= HG_DPP1(x_, 0x114, 0xf); x_ *= HG_DPP1(x_, 0x118, 0xf);
                x_ *= HG_DPP1(x_, 0x142, 0xa); bb_[i_] = x_; }
            float qi_[8], ko_[8], ke_[8], dd_[8];
#pragma unroll
            for (int i_ = 0; i_ < 8; ++i_) { const int bi_ = __float_as_int(bb_[i_]); dd_[i_] = __int_as_float(half ? __builtin_amdgcn_readlane(bi_, 63) : __builtin_amdgcn_readlane(bi_, 31));
                const float e_ = bb_[i_]; const float ei_ = __builtin_amdgcn_rcpf(e_);
                qi_[i_] = bf2f((unsigned short)RQ[i_]) * e_; ko_[i_] = kk_[i_] * ei_; ke_[i_] = kk_[i_] * (dd_[i_] * ei_); }
            *(LAS v4u*)(tb_ + T_Q + t * RS + c0 * 2) = (v4u){pk2(qi_[0], qi_[1]), pk2(qi_[2], qi_[3]), pk2(qi_[4], qi_[5]), pk2(qi_[6], qi_[7])};
            *(LAS v4u*)(tb_ + T_KO + t * RS + c0 * 2) = (v4u){pk2(ko_[0], ko_[1]), pk2(ko_[2], ko_[3]), pk2(ko_[4], ko_[5]), pk2(ko_[6], ko_[7])};
            *(LAS v4u*)(tb_ + T_KE + t * RS + c0 * 2) = (v4u){pk2(ke_[0], ke_[1]), pk2(ke_[2], ke_[3]), pk2(ke_[4], ke_[5]), pk2(ke_[6], ke_[7])};
            if (t == 31) { *(LAS f32x4*)(tb_ + T_D + c0 * 4) = (f32x4){dd_[0], dd_[1], dd_[2], dd_[3]}; *(LAS f32x4*)(tb_ + T_D + c0 * 4 + 16) = (f32x4){dd_[4], dd_[5], dd_[6], dd_[7]}; }
            if (tid < 32) *(LAS v4u*)(tb_ + T_Q + tid * RS + 256) = (v4u){0u, 0u, 0u, 0u};
            else if (tid < 64) *(LAS v4u*)(tb_ + T_KO + (tid - 32) * RS + 256) = (v4u){0u, 0u, 0u, 0u};
            else if (tid < 96) *(LAS v4u*)(tb_ + T_KE + (tid - 64) * RS + 256) = (v4u){0u, 0u, 0u, 0u};
        }
        __syncthreads();
    }
    if (it - G >= (int)blockIdx.x && it - G < NITEM) HP_COPYOUT(it - G, par ^ 1);
    __syncthreads();
#undef HP_COPYOUT
#undef HP_LOAD
#undef HP_STASH
}

__device__ __forceinline__ void hgrn_unit_mfma(const Args& a, int unit, LAS unsigned char* lds, int tid) {
    using namespace hg;
    const int b = unit >> 5, head = (unit >> 3) & 3, dir = (unit >> 2) & 1, sl = unit & 3;
    const bf16* Z = (const bf16*)(a.ws + WS_Z);
    const unsigned char* HT = a.ws + WS_HT + (size_t)((b * 4 + head) * 2 + dir) * NCHUNK * IMG_BYTES;
    bf16* Od = (bf16*)(a.ws + (dir ? WS_OB : WS_OF));
    const int wave = __builtin_amdgcn_readfirstlane(tid >> 6), lane = tid & 63;
    const size_t zb = (size_t)b * TPB;
    constexpr int NCH = NCHUNK;
    const int vr = (tid >> 2) & 31, vp = tid & 3, lvcol = ZHI + head * 128 + sl * 32 + vp * 8, i3 = 1536 + (tid & 127);
    v4u gA0, gA1, gA2, gA3, gB0, gB1, gB2, gB3; bf16x8 gAv, gBv;
#define HG_LOAD(g0, g1, g2, g3, gv, ch) do { const int c_ = (ch) < NCH ? (ch) : NCH - 1; const v4u* src_ = (const v4u*)(HT + (size_t)c_ * IMG_BYTES); \
        g0 = src_[tid]; g1 = src_[tid + 512]; g2 = src_[tid + 1024]; g3 = src_[i3]; gv = *(const bf16x8*)(Z + (zb + HG_TOKP(dir, 32 * c_ + vr)) * ZC + lvcol); } while (0)
#define HG_STASH(g0, g1, g2, g3, gv, bufi) do { LAS unsigned char* tb_ = lds + OFF_TILES + (bufi) * TILE_BYTES; LAS v4u* d_ = (LAS v4u*)tb_; \
        d_[tid] = g0; d_[tid + 512] = g1; d_[tid + 1024] = g2; if (tid < 128) { d_[tid + 1536] = g3; *(LAS bf16x8*)(tb_ + T_V + vr * VS + vp * 16) = gv; } } while (0)
    const int r32 = lane & 31, hi = lane >> 5, g1 = (lane >> 4) & 1, q4 = (lane & 15) >> 2, p4 = lane & 3, cb = 32 * wave;
    const unsigned lbase = (unsigned)(uintptr_t)lds;
    f32x16 S = {};
    HG_LOAD(gA0, gA1, gA2, gA3, gAv, 0); HG_STASH(gA0, gA1, gA2, gA3, gAv, 0); HG_LOAD(gA0, gA1, gA2, gA3, gAv, 1); HG_STASH(gA0, gA1, gA2, gA3, gAv, 1);
    HG_LOAD(gA0, gA1, gA2, gA3, gAv, 2);
    __syncthreads();
#define HG_RD64(dst, addr, OFFS) asm volatile("ds_read_b64 %0, %1 offset:" #OFFS : "=&v"(dst) : "v"(addr) : "memory")
#define HG_MFMA_STAGE(n, bufi) do { \
            const unsigned tb = lbase + OFF_TILES + (bufi) * TILE_BYTES; const LAS unsigned char* tl_ = lds + OFF_TILES + (bufi) * TILE_BYTES; \
            bf16x8 ko[2], qi[2]; s16x4 pvl[2], pvh[2], pql[2], pqh[2], kl[2], kh[2], nvl[2], nvh[2]; f32x4 dsc[4]; \
            _Pragma("unroll") for (int kk = 0; kk < 2; ++kk) { ko[kk] = *(const LAS bf16x8*)(tl_ + T_KO + r32 * RS + (cb + 16 * kk + 8 * hi) * 2); qi[kk] = *(const LAS bf16x8*)(tl_ + T_Q + r32 * RS + (cb + 16 * kk + 8 * hi) * 2); } \
            _Pragma("unroll") for (int sp = 0; sp < 2; ++sp) { \
                const unsigned va = tb + T_V + (16 * sp + 4 * hi + q4) * VS + (16 * g1 + 4 * p4) * 2; pvl[sp] = tr_read(va); pvh[sp] = tr_read(va + 8 * VS);              \
                const unsigned qa = tb + T_Q + r32 * RS + (cb + 16 * sp + 4 * hi) * 2; HG_RD64(pql[sp], qa, 0); HG_RD64(pqh[sp], qa, 16);                                  \
                const unsigned ka = tb + T_KE + (16 * sp + 8 * hi + q4) * RS + (cb + 16 * g1 + 4 * p4) * 2; kl[sp] = tr_read(ka); kh[sp] = tr_read(ka + 4 * RS);        \
                const unsigned vb = tb + T_V + (16 * sp + 8 * hi + q4) * VS + (16 * g1 + 4 * p4) * 2; nvl[sp] = tr_read(vb); nvh[sp] = tr_read(vb + 4 * VS); }            \
            _Pragma("unroll") for (int g = 0; g < 4; ++g) dsc[g] = *(const LAS f32x4*)(tl_ + T_D + (cb + 8 * g + 4 * hi) * 4); \
            asm volatile("s_waitcnt lgkmcnt(0)" ::: "memory"); __builtin_amdgcn_sched_barrier(0); \
            f32x16 X = {}; \
            X = __builtin_amdgcn_mfma_f32_32x32x16_bf16(ko[0], qi[0], X, 0, 0, 0); X = __builtin_amdgcn_mfma_f32_32x32x16_bf16(ko[1], qi[1], X, 0, 0, 0); \
            f32x16 O = {}; \
            O = __builtin_amdgcn_mfma_f32_32x32x16_bf16(cat8(pql[0], pqh[0]), pack8(S, 0), O, 0, 0, 0); O = __builtin_amdgcn_mfma_f32_32x32x16_bf16(cat8(pql[1], pqh[1]), pack8(S, 8), O, 0, 0, 0); \
            _Pragma("unroll") for (int i = 0; i < 16; ++i) S[i] *= dsc[i >> 2][i & 3]; \
            S = __builtin_amdgcn_mfma_f32_32x32x16_bf16(cat8(kl[0], kh[0]), cat8(nvl[0], nvh[0]), S, 0, 0, 0); S = __builtin_amdgcn_mfma_f32_32x32x16_bf16(cat8(kl[1], kh[1]), cat8(nvl[1], nvh[1]), S, 0, 0, 0); \
            _Pragma("unroll") for (int i = 0; i < 16; ++i) X[i] = (crow(i, hi) <= r32) ? X[i] : 0.f; \
            O = __builtin_amdgcn_mfma_f32_32x32x16_bf16(pack8(X, 0), cat8(pvl[0], pvh[0]), O, 0, 0, 0); O = __builtin_amdgcn_mfma_f32_32x32x16_bf16(pack8(X, 8), cat8(pvl[1], pvh[1]), O, 0, 0, 0); \
            LAS float* op = (LAS float*)(lds + OFF_OPART + ((n) & 1) * OPART_BYTES + wave * 4096); \
            _Pragma("unroll") for (int i = 0; i < 16; ++i) op[crow(i, hi) * 32 + r32] = O[i]; } while (0)
#define HG_OUT_STAGE(n) do { \
            const int l2 = tid - 256, tt = l2 >> 3, vq = l2 & 7; \
            const LAS float* op = (const LAS float*)(lds + OFF_OPART + (((n) - 1) & 1) * OPART_BYTES) + tt * 32 + vq * 4; \
            const f32x4 s = (*(const LAS f32x4*)op + *(const LAS f32x4*)(op + 1024)) + (*(const LAS f32x4*)(op + 2048) + *(const LAS f32x4*)(op + 3072)); \
            const int p = HG_TOKP(dir, 32 * ((n) - 1) + tt); \
            if (p >= CTXL) *(v2u*)(Od + (zb + p) * 512 + head * 128 + sl * 32 + vq * 4) = (v2u){pk2(s[0], s[1]), pk2(s[2], s[3])}; } while (0)
#define HG_ITER(n, L0, L1, L2, L3, LV, S0, S1, S2, S3, SV) do { \
        HG_LOAD(L0, L1, L2, L3, LV, (n) + 3); \
        if (wave < 4) { HG_MFMA_STAGE(n, bcur); } else if ((n) > 0) { HG_OUT_STAGE(n); } \
        { const int bst_ = bcur == 0 ? 2 : bcur - 1; HG_STASH(S0, S1, S2, S3, SV, bst_); } \
        bcur = bcur == 2 ? 0 : bcur + 1; \
        __syncthreads(); } while (0)
    int bcur = 0;
    for (int n = 0; n < NCH; n += 2) {
        HG_ITER(n, gB0, gB1, gB2, gB3, gBv, gA0, gA1, gA2, gA3, gAv);
        HG_ITER(n + 1, gA0, gA1, gA2, gA3, gAv, gB0, gB1, gB2, gB3, gBv);
    }
    if (wave >= 4) { HG_OUT_STAGE(NCH); }
    __syncthreads();
#undef HG_MFMA_STAGE
#undef HG_OUT_STAGE
#undef HG_ITER
#undef HG_LOAD
#undef HG_STASH
#undef HG_RD64
}

__device__ __forceinline__ bool in_range(int lo, int hi, int k) { asm volatile("" : "+s"(lo), "+s"(hi)); return lo <= k && k < hi; }
constexpr int NPHASES = 21;
__global__ void __launch_bounds__(NTHR, 2) fwd_kernel(Args args) {
    extern __shared__ __attribute__((aligned(16))) unsigned char lds_raw[];
    LAS unsigned char* lds = (LAS unsigned char*)lds_raw;
    const int G = gridDim.x;
#define FRESH() int tid = threadIdx.x; asm volatile("" : "+v"(tid)); const int lane = tid & 63, wave = __builtin_amdgcn_readfirstlane(tid >> 6); (void)lane; (void)wave
    unsigned char* ws = args.ws;
    if (threadIdx.x < 16) ((LAS unsigned*)(lds + LDS_BAR_OFF))[threadIdx.x] = 0u;
    __syncthreads();
    XcdBarrier bar = xcd_barrier_post((unsigned*)(ws + WS_CTL), (volatile LAS unsigned*)(lds + LDS_BAR_OFF));
    const int lo = args.ph_lo, hi = args.ph_hi;
#define IN(k) in_range(lo, hi, (k))
#define NREP(k) (((PROBE_MASK >> (k)) & 1u) ? 2 : 1)
#define REPEAT(k) for (int rep_ = 0; rep_ < NREP(k); ++rep_) if (rep_ == 0 || (xcd_barrier(bar), true))
#define SEAM(k) do { if (IN(k) && IN((k) + 1)) xcd_barrier(bar); } while (0)
    bf16* const BX = (bf16*)(ws + WS_X); bf16* const BY = (bf16*)(ws + WS_Y);
    const float* const MODV = (const float*)(ws + WS_MODV);

#if defined(PROBE_BARS)
    for (int pbi = 0; pbi < PROBE_BARS; ++pbi) xcd_barrier(bar);
#endif
    if (IN(0)) REPEAT(0) { FRESH(); phase_prologue(args, lds, tid, lane, wave); } SEAM(0);
    if (IN(1)) REPEAT(1) { FRESH(); phase_mod0(args, lane, wave); } SEAM(1);
    if (IN(2)) REPEAT(2) {
        pg8::Gemm g{BX, (const bf16*)(ws + WS_WIN), NTOK, ZC, 1024}; pg8::AllOrder S; S.init(NTOK / 256, ZC / 256, G, (int)blockIdx.x);
        pg8::EpiBf16<0> E{(bf16*)(ws + WS_Z), ZC, nullptr, 0, 0, 1.f};
        pg8::gemm_phase<pg8::EpiBf16<0>, pg8::AllOrder, PG8_ALIGN, PG8_SP2>(lds, g, S, E);
    } SEAM(2);
    if (IN(3)) REPEAT(3) { FRESH(); phase_norm0(args, lane, wave); hgrn_prep_items(args, lds, tid); } SEAM(3);
    if (IN(4)) REPEAT(4) {
        { pg8::Gemm g{(const bf16*)(ws + WS_CQN), (const bf16*)(ws + WS_WUQ), NTOK, 768, 384}; pg8::LatOrder S; S.init(128, 3, G, (int)blockIdx.x);
          pg8::EpiBf16<0> E{(bf16*)(ws + WS_Q), 768, nullptr, 0, 0, 1.f};
          pg8::gemm_phase<pg8::EpiBf16<0>, pg8::LatOrder, PG8_ALIGN, PG8_SP2>(lds, g, S, E); }
        __syncthreads();
        { pg8::Gemm g{(const bf16*)(ws + WS_CKVN), (const bf16*)(ws + WS_WUKV), NTOK, 1024, 256}; pg8::AllOrder S; S.init(NTOK / 256, 4, G, G - 1 - (int)blockIdx.x);
          pg8::EpiBf16<0> E{(bf16*)(ws + WS_KV), 1024, nullptr, 0, 0, 1.f};
          pg8::gemm_phase<pg8::EpiBf16<0>, pg8::AllOrder, PG8_ALIGN, PG8_SP2>(lds, g, S, E); }
    } SEAM(4);
    if (IN(5)) {
        REPEAT(21) { FRESH();
        for (int u = blockIdx.x; u < 256; u += G) { __syncthreads(); hgrn_unit_mfma(args, (G == 256) ? ((u & 7) * 32 + (u >> 3)) : u, lds, tid); } }
        const bf16* Q = (const bf16*)(ws + WS_Q); const bf16* KV = (const bf16*)(ws + WS_KV); const bf16* KRR = (const bf16*)(ws + WS_KRR);
        const float* rope = (const float*)(ws + WS_ROPE);
        const int cslot = (G == 256) ? ((((int)blockIdx.x & 7) * 2 + (((int)blockIdx.x >> 3) >> 4)) % 5) : 0;
        REPEAT(22) {
        int ai = 0;
        for (int slot = 0; slot < 5; ++slot) {
            if (slot == cslot) { if (rep_ == 0) { FRESH(); __syncthreads(); convert_moe_share(args, lds, lane, wave); } continue; }
            for (int u = (G == 256) ? (int)blockIdx.x + ai * 256 : (int)blockIdx.x; u < ((G == 256) ? (int)blockIdx.x + ai * 256 + 1 : (ai == 0 ? 1024 : 0)); u += G) {
                int b, h, qb; if (G == 256) { const int x = (int)blockIdx.x & 7, j = (int)blockIdx.x >> 3, pr = (u >> 8) * 16 + 2 * x + (j >> 4); b = pr >> 3; h = pr & 7; qb = j & 15; } else { b = u >> 7; h = (u >> 4) & 7; qb = u & 15; }
                const size_t kb = (size_t)b * TPB, q0 = kb + CTXL + (size_t)qb * 256;
                __syncthreads();
                att::attn_unit(Q + q0 * 768 + h * 96, KV + kb * 1024 + h * 64, KRR + kb * 32, BY + q0 * 1024 + h * 64, rope + (size_t)qb * 256 * 32, TPB, (char*)lds_raw);
            }
            ++ai;
        }
        }
    } SEAM(5);
    if (IN(6)) REPEAT(6) { FRESH(); phase_readout(args, lane, wave); } SEAM(6);
    if (IN(7)) REPEAT(7) {
        pg8::Gemm g{BY, (const bf16*)(ws + WS_WOUT), NTOK, 1024, 1024}; pg8::LatOrder S; S.init(128, 4, G, (int)blockIdx.x);
        pg8::EpiRes E{args.in[I_X], (const float*)(ws + WS_H), (bf16*)(ws + WS_PRE), MODV, nullptr};
        pg8::gemm_phase<pg8::EpiRes, pg8::LatOrder, PG8_ALIGN, PG8_SP2>(lds, g, S, E);
    } SEAM(7);
    for (int l = 0; l < 2; ++l) {
        if (l == 1) {
            if (IN(13)) REPEAT(13) {
                pg8::Gemm g{BY, (const bf16*)(ws + WS_WPW1), NTOK, 2048, 1024}; pg8::LatOrder S; S.init(128, 8, G, (int)blockIdx.x);
                pg8::EpiGate<0> E{BX, (const float*)(ws + WS_PW1B), 8, 1.f, 1.f};
                pg8::gemm_phase<pg8::EpiGate<0>, pg8::LatOrder, PG8_ALIGN, PG8_SP2>(lds, g, S, E);
            } SEAM(13);
            if (IN(14)) REPEAT(14) { FRESH(); phase_conv(args, lds, tid, lane, wave); } SEAM(14);
            if (IN(15)) REPEAT(15) {
                pg8::Gemm g{BY, (const bf16*)(ws + WS_WPW2), NTOK, 1024, 1024}; pg8::LatOrder S; S.init(128, 4, G, (int)blockIdx.x);
                pg8::EpiRes E{nullptr, (const float*)(ws + WS_H), (bf16*)(ws + WS_PRE), MODV + 9 * 6144, args.in[I_PW2B]};
                pg8::gemm_phase<pg8::EpiRes, pg8::LatOrder, PG8_ALIGN, PG8_SP2>(lds, g, S, E);
            } SEAM(15);
        }
        const int pb = l ? 16 : 8;
        if (IN(pb)) REPEAT(pb) { FRESH(); phase_ln1(args, l, lds, tid, lane, wave); } SEAM(pb);
        if (IN(pb + 2) || IN(pb + 3)) {
            LAS int* tl = (LAS int*)(lds + LDS_TILE_E);
            FRESH();
            __syncthreads();
            if (tid < 32) tl[3 * MAXTILES + 64 + tid] = ld_ctl((const int*)(ws + WS_CURSOR) + l * 32 + tid);
            __syncthreads();
            if (tid == 0) { int ts = 0; for (int e = 0; e < 32; ++e) { tl[3 * MAXTILES + e] = ts; ts += (tl[3 * MAXTILES + 64 + e] + 255) >> 8; } tl[3 * MAXTILES + 32] = ts; }
            __syncthreads();
            const int ntiles = tl[3 * MAXTILES + 32];
            for (int t = tid; t < ntiles && t < MAXTILES; t += NTHR) { int e = 0; while (e < 31 && tl[3 * MAXTILES + e + 1] <= t) ++e; const int j = t - tl[3 * MAXTILES + e], rem = tl[3 * MAXTILES + 64 + e] - 256 * j;
                tl[t] = e; tl[MAXTILES + t] = e * ECAP + 256 * j; tl[2 * MAXTILES + t] = rem < 256 ? rem : 256; }
            __syncthreads();
            if (IN(pb + 2)) REPEAT(pb + 2) {
#if defined(PROBE_STAGGER)
                if (blockIdx.x & 1) { const unsigned long long t0 = __builtin_amdgcn_s_memrealtime(); while (__builtin_amdgcn_s_memrealtime() - t0 < PROBE_STAGGER) __builtin_amdgcn_s_sleep(8); }
#endif
                pg8::Gemm g{BX, (const bf16*)(ws + WS_WGU + (size_t)l * 32 * 2048 * 1024), 0, 0, 512};
                pg8::MoeOrder S; S.init(ntiles, 8, G, (int)blockIdx.x); S.tile_e = tl; S.nper = 8;
                pg8::EpiGate<1, true> E{(bf16*)(ws + WS_ACT), (const float*)(ws + WS_BGU) + (size_t)l * 32 * 2048, 8, 1.f / (SC_X8 * SC_WGU) * PROBE_KSC, SC_ACT};
                pg8::gemm_phase<pg8::EpiGate<1, true>, pg8::MoeOrder, PG8_ALIGN, true, true, true>(lds, g, S, E, (const int*)(ws + WS_ROWS), tl + MAXTILES);
            } SEAM(pb + 2);
            if (IN(pb + 3)) REPEAT(pb + 3) {
                pg8::Gemm g{(const bf16*)(ws + WS_ACT), (const bf16*)(ws + WS_WDN + (size_t)l * 32 * 1024 * 1024), 0, 0, 512};
                pg8::MoeOrder S; S.init(ntiles, 4, G, (int)blockIdx.x); S.tile_e = tl; S.nper = 4;
                pg8::EpiDown E{(bf16*)(ws + WS_YB), args.in[I_BDN] + (size_t)l * 32 * 1024, (const float*)(ws + WS_ROWW), (const int*)(ws + WS_ROWD), 1.f / (SC_ACT * SC_WDN) * PROBE_KSC, tl + MAXTILES, SC_Y};
                pg8::gemm_phase<pg8::EpiDown, pg8::MoeOrder, PG8_ALIGN, true, false, true>(lds, g, S, E);
            } SEAM(pb + 3);
        }
        if (IN(pb + 4)) REPEAT(pb + 4) { FRESH(); phase_ln2(args, l, lane, wave); }
        if (l == 0) SEAM(12);
    }
#undef IN
#undef SEAM
}

extern "C" void kernel_launch(void* const* d_in, const int* in_sizes, int n_in, void* d_out, int out_size, void* d_ws, size_t ws_size, hipStream_t stream) {
    static int grid = 0;
    if (grid == 0) {
        if (n_in != 33 || in_sizes[0] != NB * SEQ * D || out_size != NB * SEQ * D || ws_size < WS_END) {
            fprintf(stderr, "kernel_launch: unexpected shapes: n_in %d in0 %d out %d ws %zu (need %zu)\n", n_in, n_in > 0 ? in_sizes[0] : -1, out_size, ws_size, (size_t)WS_END); grid = -1; return; }
        int dev = 0, cus = 0;
        if (hipGetDevice(&dev) != hipSuccess || hipDeviceGetAttribute(&cus, hipDeviceAttributeMultiprocessorCount, dev) != hipSuccess) { grid = -1; return; }
        if (hipFuncSetAttribute((const void*)fwd_kernel, hipFuncAttributeMaxDynamicSharedMemorySize, LDS_BYTES) != hipSuccess) { fprintf(stderr, "kernel_launch: hipFuncSetAttribute failed\n"); grid = -1; return; }
        int per_cu = 0;
        if (hipOccupancyMaxActiveBlocksPerMultiprocessor(&per_cu, (const void*)fwd_kernel, NTHR, LDS_BYTES) != hipSuccess || per_cu < 1) fprintf(stderr, "kernel_launch: occupancy query reports %d\n", per_cu);
        (void)hipGetLastError();
        grid = cus;
    }
    if (grid < 0) return;
    if (hipMemsetAsync((char*)d_ws + WS_CTL, 0, CTL_ZERO_BYTES, stream) != hipSuccess) return;
    Args a{};
    for (int i = 0; i < 33; ++i) a.in[i] = (const float*)d_in[i];
    a.out = (float*)d_out; a.ws = (unsigned char*)d_ws;
#if MK_ONE_LAUNCH
    a.ph_lo = 0; a.ph_hi = NPHASES;
    hipLaunchKernelGGL(fwd_kernel, dim3(grid), dim3(NTHR), LDS_BYTES, stream, a);
#else
    for (int ph = 0; ph < NPHASES; ++ph) { a.ph_lo = ph; a.ph_hi = ph + 1; hipLaunchKernelGGL(fwd_kernel, dim3(grid), dim3(NTHR), LDS_BYTES, stream, a); }
#endif
    const hipError_t le = hipPeekAtLastError();
    if (le != hipSuccess) fprintf(stderr, "kernel_launch: launch failed: %s\n", hipGetErrorName(le));
}
```

```cpp
#include <hip/hip_runtime.h>
#include <cstdio>
#include <cstdint>

#ifndef PROBE_MASK
#define PROBE_MASK 0u
#endif
#if defined(PROBE_K2)
#define PROBE_KSC 0.5f
#else
#define PROBE_KSC 1.0f
#endif
#ifndef MK_ONE_LAUNCH
#define MK_ONE_LAUNCH 1
#endif

namespace pg8 {
#define PG8_LAS __attribute__((address_space(3)))
typedef unsigned short bf16_t;
typedef short bf16x8 __attribute__((ext_vector_type(8)));
typedef float f32x4 __attribute__((ext_vector_type(4)));
typedef unsigned u32x4 __attribute__((ext_vector_type(4)));
constexpr int BM = 256, BK = 64, HALF = 128, HTB = HALF * BK * 2  , STAGE_BYTES = 8 * HTB, NXCD = 8, WGM = 8;

__host__ __device__ __forceinline__ int lds_byte(int r, int c) { const int st = (r >> 4) * 2 + (c >> 5), rr = r & 15, cc = c & 31, ob = rr * 64 + cc * 2; return st * 1024 + (ob ^ (((ob >> 9) & 1) << 5)); }
__host__ __device__ __forceinline__ void stage_rc(int b, int& R, int& C) { const int st = b / 1024, sb = b % 1024, swz = sb ^ (((sb >> 9) & 1) << 5); R = (st >> 1) * 16 + swz / 64; C = (st & 1) * 32 + (swz % 64) / 2; }
__host__ __device__ __forceinline__ int perm32(int rho) { const int n = rho >> 4, i = rho & 15; return 8 * (i >> 2) + 4 * n + (i & 3); }

struct Unit { int pm, pn; };
struct Gemm { const bf16_t* A; const bf16_t* Bt; int M, N, K; };

struct StaticOrder {
    int nM, nN, nwg, G, c;
    __host__ __device__ void init(int M, int N, int G_, int c_) { nM = M / BM; nN = N / BM; nwg = nM * nN; G = G_; c = c_; }
    __host__ __device__ bool next(int i, Unit& u) const {
        const long L = (long)i * G + c; if (L >= nwg) return false;
        int wgid = (int)L; { const int q = nwg / NXCD, r = nwg % NXCD, xcd = wgid % NXCD, off = wgid / NXCD; wgid = (xcd < r ? xcd * (q + 1) : r * (q + 1) + (xcd - r) * q) + off; }
        const int nig = WGM * nN, gid = wgid / nig, fm = gid * WGM, gsz = (nM - fm) < WGM ? (nM - fm) : WGM;
        u.pm = fm + ((wgid % nig) % gsz); u.pn = (wgid % nig) / gsz; return true;
    }
    __device__ __forceinline__ void a_ready(const Unit&) const {}
    __device__ __forceinline__ void done(const Unit&) const {}
};

__device__ __forceinline__ unsigned cvt_pk_bf16(float lo, float hi) { unsigned r; asm volatile("v_cvt_pk_bf16_f32 %0, %1, %2" : "=v"(r) : "v"(lo), "v"(hi)); return r; }
typedef float f32x2 __attribute__((ext_vector_type(2)));
__device__ __forceinline__ f32x2 gelu_pk(f32x2 v) {
    const f32x2 av = __builtin_elementwise_abs(v), d = av * 0.2316418882f + 1.0f;
    f32x2 t; t.x = __builtin_amdgcn_rcpf(d.x); t.y = __builtin_amdgcn_rcpf(d.y);
    f32x2 q = t * 0.5307027145f + (-0.7265760135f); q = q * t + 0.7107068705f; q = q * t + (-0.142248368f); q = q * t + 0.127414796f; q = q * t;
    const f32x2 s = (v * v) * (-0.72134752044f);
    f32x2 e; e.x = __builtin_amdgcn_exp2f(s.x); e.y = __builtin_amdgcn_exp2f(s.y);
    const f32x2 m = v * (q * e), r = v - m;
    f32x2 o; o.x = v.x < 0.f ? m.x : r.x; o.y = v.y < 0.f ? m.y : r.y; return o;
}

template <int ACT  > struct EpiBf16 {
    static constexpr bool PERM = true, AFTER_DRAIN = false; static_assert(ACT == 0 || ACT == 1, "EpiBf16: ACT is 0 (none) or 1 (gelu_pk)");
    bf16_t* O; int ldc; const float* bias; int split_cols; size_t split_stride; float scale0;
    __device__ __forceinline__ void operator()(const f32x4 (&acc)[2][2][4][2], const Unit& u, int wr, int wc, int fr, int fq) const {
        const int row0 = u.pm * BM + wr * 64 + fr; int colt = u.pn * BM; bf16_t* base = O;
        float sc = 1.f; if (split_cols) { const int t = colt / split_cols; base += (size_t)t * split_stride; colt -= t * split_cols; if (t == 0) sc = scale0; }
        const int col0 = colt + wc * 32 + 8 * fq, bcol0 = u.pn * BM + wc * 32 + 8 * fq;
        f32x4 bv[2][2];
#pragma unroll
        for (int bj = 0; bj < 2; ++bj)
#pragma unroll
            for (int n = 0; n < 2; ++n) bv[bj][n] = bias ? *(const f32x4*)(bias + bcol0 + bj * HALF + 4 * n) : (f32x4){0.f, 0.f, 0.f, 0.f};
#pragma unroll
        for (int ai = 0; ai < 2; ++ai)
#pragma unroll
            for (int m = 0; m < 4; ++m) { bf16_t* rowp = base + (size_t)(row0 + ai * HALF + m * 16) * ldc + col0;
#pragma unroll
                for (int bj = 0; bj < 2; ++bj) { f32x4 v0 = acc[ai][bj][m][0] + bv[bj][0], v1 = acc[ai][bj][m][1] + bv[bj][1];
                    if (ACT == 1) { f32x2 a = gelu_pk((f32x2){v0[0], v0[1]}), b = gelu_pk((f32x2){v0[2], v0[3]}), c = gelu_pk((f32x2){v1[0], v1[1]}), d = gelu_pk((f32x2){v1[2], v1[3]});
                        v0 = (f32x4){a.x, a.y, b.x, b.y}; v1 = (f32x4){c.x, c.y, d.x, d.y}; }
                    v0 = v0 * sc; v1 = v1 * sc; u32x4 w; w.x = cvt_pk_bf16(v0[0], v0[1]); w.y = cvt_pk_bf16(v0[2], v0[3]); w.z = cvt_pk_bf16(v1[0], v1[1]); w.w = cvt_pk_bf16(v1[2], v1[3]);
                    *(u32x4*)(rowp + bj * HALF) = w; } }
    }
};
typedef int v4i_t __attribute__((ext_vector_type(4)));
typedef int v8i_t __attribute__((ext_vector_type(8)));
__device__ __forceinline__ v8i_t cat32(bf16x8 a, bf16x8 b) { const v4i_t x = __builtin_bit_cast(v4i_t, a), y = __builtin_bit_cast(v4i_t, b); return __builtin_shufflevector(x, y, 0, 1, 2, 3, 4, 5, 6, 7); }
template <class Epi, class Sched, bool ALIGN_EPI = false, bool SP2 = false, bool GATHER = false, bool FP8 = false>
__device__ __forceinline__ void gemm_phase(PG8_LAS unsigned char* lds, const Gemm g, const Sched& S, const Epi& E, const int* rowsrc = nullptr, const PG8_LAS int* gtab = nullptr) {
    static_assert(!GATHER || SP2, "GATHER is implemented on the SP2 loop only");
    int tid_l = threadIdx.x; asm volatile("" : "+v"(tid_l));
    const int tid = tid_l, wid = __builtin_amdgcn_readfirstlane(tid >> 6), lane = tid & 63, wr = wid >> 2, wc = wid & 3, fr = lane & 15, fq = lane >> 4;
#if defined(PROBE_K2)
    const int K = g.K, nt0 = K / BK, nt = FP8 ? 2 * nt0 : nt0;
#define PG8_KT(x) (FP8 ? ((x) & (nt0 - 1)) : (x))
#else
    const int K = g.K, nt = K / BK;
#define PG8_KT(x) (x)
#endif
    unsigned voffA[2], voffB[2];
#pragma unroll
    for (int i = 0; i < 2; ++i) { int R, C; stage_rc(tid * 16 + i * 8192, R, C); const int Rb = Epi::PERM ? ((R & ~31) + perm32(R & 31)) : R;
        voffA[i] = (unsigned)(R * K + C) * 2u; voffB[i] = (unsigned)(Rb * K + C) * 2u; }
    unsigned gAc[2][2], gAn[2][2]; int gR[2]; unsigned gC[2];
#pragma unroll
    for (int i = 0; i < 2; ++i) { int R, C; stage_rc(tid * 16 + i * 8192, R, C); gR[i] = R; gC[i] = (unsigned)C * 2u; gAc[0][i] = gAc[1][i] = gAn[0][i] = gAn[1][i] = 0u; }
#define PG8_GATHER(u_, o_) do { const int gtb_ = gtab[(u_).pm], gtc_ = gtab[576 + (u_).pm];     \
        _Pragma("unroll") for (int h_ = 0; h_ < 2; ++h_) _Pragma("unroll") for (int i_ = 0; i_ < 2; ++i_) \
        { const int rl_ = h_ * HALF + gR[i_]; const int src_ = rl_ < gtc_ ? rowsrc[gtb_ + rl_] : 0; o_[h_][i_] = (unsigned)src_ * (unsigned)(K * 2) + gC[i_]; } } while (0)
#define PG8_STAGE_A(bufoff, orig_gbase, NEXTSEL, H, KOFF) do { if constexpr (GATHER) { unsigned vo_[2]; vo_[0] = (NEXTSEL) ? gAn[H][0] : gAc[H][0]; vo_[1] = (NEXTSEL) ? gAn[H][1] : gAc[H][1]; \
        PG8_STAGE(bufoff, (const char*)g.A + (KOFF), vo_); } else { PG8_STAGE(bufoff, orig_gbase, voffA); } } while (0)
    const size_t kstep = (size_t)(BK * 2);
    const size_t hstep = (size_t)HALF * K * 2;
    const size_t tstep = 2 * hstep;
    const unsigned ldsw = (unsigned)wid * 1024u;
    const int aoff = lds_byte(wr * 64 + fr, fq * 8), boff = lds_byte(wc * 32 + fr, fq * 8);
#define PG8_SA(b, h) (((b) * 2 + (h)) * HTB)
#define PG8_SB(b, h) ((4 + (b) * 2 + (h)) * HTB)
#define PG8_STAGE(bufoff, gbase, voff) do { _Pragma("unroll") for (int _i = 0; _i < 2; ++_i) \
        __builtin_amdgcn_global_load_lds((const unsigned*)((const char*)(gbase) + (voff)[_i]), (PG8_LAS unsigned*)(lds + (bufoff) + ldsw + _i * 8192), 16, 0, 0); } while (0)
#define PG8_LD32(var, addr) do { const bf16x8 lo_ = *(const PG8_LAS bf16x8*)(addr); const bf16x8 hi_ = *(const PG8_LAS bf16x8*)((addr) + 1024); var = cat32(lo_, hi_); } while (0)
#define PG8_LDA(dst, b, h) do { if constexpr (FP8) { _Pragma("unroll") for (int m = 0; m < 4; ++m) PG8_LD32(dst##8[m], lds + PG8_SA(b, h) + aoff + m * 2048); } \
        else { _Pragma("unroll") for (int m = 0; m < 4; ++m) _Pragma("unroll") for (int k = 0; k < 2; ++k) dst[m][k] = *(const PG8_LAS bf16x8*)(lds + PG8_SA(b, h) + aoff + m * 2048 + k * 1024); } } while (0)
#define PG8_LDB(dst, b, h) do { if constexpr (FP8) { _Pragma("unroll") for (int n = 0; n < 2; ++n) PG8_LD32(dst##8[n], lds + PG8_SB(b, h) + boff + n * 2048); } \
        else { _Pragma("unroll") for (int n = 0; n < 2; ++n) _Pragma("unroll") for (int k = 0; k < 2; ++k) dst[n][k] = *(const PG8_LAS bf16x8*)(lds + PG8_SB(b, h) + boff + n * 2048 + k * 1024); } } while (0)
#define PG8_MMA(ai, bj, At, Bt) do { __builtin_amdgcn_s_setprio(1); \
        if constexpr (FP8) { _Pragma("unroll") for (int m = 0; m < 4; ++m) _Pragma("unroll") for (int n = 0; n < 2; ++n) \
            asm volatile("v_mfma_scale_f32_16x16x128_f8f6f4 %0, %1, %2, %0, %3, %3 op_sel_hi:[0,0,0]" : "+v"(acc[ai][bj][m][n]) : "v"(Bt##8[n]), "v"(At##8[m]), "v"(sc127)); } \
        else { _Pragma("unroll") for (int m = 0; m < 4; ++m) _Pragma("unroll") for (int n = 0; n < 2; ++n) _Pragma("unroll") for (int k = 0; k < 2; ++k) \
            acc[ai][bj][m][n] = __builtin_amdgcn_mfma_f32_16x16x32_bf16(Bt[n][k], At[m][k], acc[ai][bj][m][n], 0, 0, 0); } \
        __builtin_amdgcn_s_setprio(0); } while (0)
#define PG8_WAIT_V(n) asm volatile("s_waitcnt vmcnt(" #n ")" ::: "memory")
#define PG8_WAIT_L(n) asm volatile("s_waitcnt lgkmcnt(" #n ")" ::: "memory")
#define PG8_BAR __builtin_amdgcn_s_barrier()
#define PG8_SCHED __builtin_amdgcn_sched_barrier(0)
    Unit cur, nxt; int ui = 0;
    if (!S.next(0, cur)) return;
    f32x4 acc[2][2][4][2];
#pragma unroll
    for (int a = 0; a < 2; ++a)
#pragma unroll
        for (int b = 0; b < 2; ++b)
#pragma unroll
            for (int m = 0; m < 4; ++m)
#pragma unroll
                for (int n = 0; n < 2; ++n) acc[a][b][m][n] = (f32x4){0.f, 0.f, 0.f, 0.f};
    int sc127 = 0x7f7f7f7f; asm volatile("" : "+v"(sc127));
    bf16x8 At[4][2], B0[2][2], B1[2][2]; v8i_t At8[4], B08[2], B18[2]; (void)At; (void)B0; (void)B1; (void)At8; (void)B08; (void)B18;
    const char* cA = (const char*)g.A + (size_t)cur.pm * tstep; const char* cB = (const char*)g.Bt + (size_t)cur.pn * tstep;
    S.a_ready(cur);
    if constexpr (GATHER) { PG8_GATHER(cur, gAc); }
    if constexpr (SP2) {
        PG8_STAGE(PG8_SB(0, 0), cB, voffB); PG8_STAGE(PG8_SB(0, 1), cB + hstep, voffB); PG8_STAGE_A(PG8_SA(0, 0), cA, false, 0, (size_t)0); PG8_STAGE_A(PG8_SA(0, 1), cA + hstep, false, 1, (size_t)0);
        if (wr == 1) PG8_BAR;
        PG8_WAIT_V(2); PG8_BAR;
        PG8_STAGE(PG8_SB(1, 0), cB + kstep, voffB); PG8_STAGE_A(PG8_SA(1, 0), cA + kstep, false, 0, kstep); PG8_STAGE(PG8_SB(1, 1), cB + hstep + kstep, voffB);
        PG8_WAIT_V(6); PG8_BAR;
    } else {
        PG8_STAGE(PG8_SB(0, 0), cB, voffB); PG8_STAGE(PG8_SA(0, 0), cA, voffA); PG8_STAGE(PG8_SB(0, 1), cB + hstep, voffB); PG8_STAGE(PG8_SA(0, 1), cA + hstep, voffA);
        if (wr == 1) PG8_BAR;
        PG8_WAIT_V(4); PG8_BAR;
        PG8_STAGE(PG8_SB(1, 0), cB + kstep, voffB); PG8_STAGE(PG8_SA(1, 0), cA + kstep, voffA); PG8_STAGE(PG8_SB(1, 1), cB + hstep + kstep, voffB);
        PG8_WAIT_V(6); PG8_BAR;
    }
    for (;;) {
        const bool has_next = S.next(ui + 1, nxt);
        if constexpr (GATHER) { if (has_next) { PG8_GATHER(nxt, gAn); } else { _Pragma("unroll") for (int h_ = 0; h_ < 2; ++h_) _Pragma("unroll") for (int i_ = 0; i_ < 2; ++i_) gAn[h_][i_] = gAc[h_][i_]; } }
        const char* nA = has_next ? (const char*)g.A + (size_t)nxt.pm * tstep : cA; const char* nB = has_next ? (const char*)g.Bt + (size_t)nxt.pn * tstep : cB;
#pragma nounroll
        for (int t = 0; t < nt; t += 2) {
            const bool last = (t == nt - 2);
            const char* a1 = cA + (size_t)PG8_KT(t + 1) * kstep;
            const char* a2 = last ? nA : cA + (size_t)PG8_KT(t + 2) * kstep; const char* b2 = last ? nB : cB + (size_t)PG8_KT(t + 2) * kstep;
            const char* a3 = a2 + kstep; const char* b3 = b2 + kstep;
            const size_t k1 = (size_t)PG8_KT(t + 1) * kstep, k2 = last ? (size_t)0 : (size_t)PG8_KT(t + 2) * kstep, k3 = k2 + kstep; (void)k1; (void)k2; (void)k3;
            if (last && has_next) S.a_ready(nxt);
            if constexpr (SP2) {
            PG8_LDB(B0, 0, 0); PG8_LDB(B1, 0, 1); PG8_SCHED; PG8_LDA(At, 0, 0); PG8_STAGE_A(PG8_SA(1, 1), a1 + hstep, false, 1, k1);
            PG8_WAIT_V(8); PG8_WAIT_L(0); PG8_BAR; PG8_MMA(0, 0, At, B0); PG8_MMA(0, 1, At, B1); PG8_BAR; PG8_SCHED;
            PG8_LDA(At, 0, 1); PG8_STAGE(PG8_SB(0, 0), b2, voffB); PG8_STAGE(PG8_SB(0, 1), b2 + hstep, voffB); PG8_STAGE_A(PG8_SA(0, 0), a2, last, 0, k2);
            PG8_WAIT_V(8); PG8_WAIT_L(0); PG8_BAR; PG8_MMA(1, 0, At, B0); PG8_MMA(1, 1, At, B1); PG8_BAR; PG8_SCHED;
            PG8_LDB(B0, 1, 0); PG8_LDB(B1, 1, 1); PG8_SCHED; PG8_LDA(At, 1, 0); PG8_STAGE_A(PG8_SA(0, 1), a2 + hstep, last, 1, k2);
            PG8_WAIT_V(8); PG8_WAIT_L(0); PG8_BAR; PG8_MMA(0, 0, At, B0); PG8_MMA(0, 1, At, B1); PG8_BAR; PG8_SCHED;
            PG8_LDA(At, 1, 1); PG8_STAGE(PG8_SB(1, 0), b3, voffB); PG8_STAGE(PG8_SB(1, 1), b3 + hstep, voffB); PG8_STAGE_A(PG8_SA(1, 0), a3, last, 0, k3);
            PG8_WAIT_V(8); PG8_WAIT_L(0); PG8_BAR; PG8_MMA(1, 0, At, B0); PG8_MMA(1, 1, At, B1); PG8_BAR; PG8_SCHED;
            } else {
            PG8_LDB(B0, 0, 0); PG8_SCHED; PG8_LDA(At, 0, 0); PG8_STAGE(PG8_SA(1, 1), a1 + hstep, voffA);
            PG8_WAIT_L(8); PG8_BAR; PG8_WAIT_L(0); PG8_MMA(0, 0, At, B0); PG8_BAR; PG8_SCHED;
            PG8_LDB(B1, 0, 1); PG8_STAGE(PG8_SB(0, 0), b2, voffB);
            PG8_BAR; PG8_WAIT_L(0); PG8_MMA(0, 1, At, B1); PG8_BAR;
            PG8_LDA(At, 0, 1); PG8_STAGE(PG8_SA(0, 0), a2, voffA);
            PG8_BAR; PG8_WAIT_L(0); PG8_MMA(1, 0, At, B0); PG8_BAR; PG8_SCHED;
            PG8_STAGE(PG8_SB(0, 1), b2 + hstep, voffB);
            PG8_WAIT_V(6); PG8_BAR; PG8_MMA(1, 1, At, B1); PG8_BAR;
            PG8_LDB(B0, 1, 0); PG8_SCHED; PG8_LDA(At, 1, 0); PG8_STAGE(PG8_SA(0, 1), a2 + hstep, voffA);
            PG8_WAIT_L(8); PG8_BAR; PG8_WAIT_L(0); PG8_MMA(0, 0, At, B0); PG8_BAR; PG8_SCHED;
            PG8_LDB(B1, 1, 1); PG8_STAGE(PG8_SB(1, 0), b3, voffB);
            PG8_BAR; PG8_WAIT_L(0); PG8_MMA(0, 1, At, B1); PG8_BAR;
            PG8_LDA(At, 1, 1); PG8_STAGE(PG8_SA(1, 0), a3, voffA);
            PG8_BAR; PG8_WAIT_L(0); PG8_MMA(1, 0, At, B0); PG8_BAR; PG8_SCHED;
            PG8_STAGE(PG8_SB(1, 1), b3 + hstep, voffB);
            PG8_WAIT_V(6); PG8_BAR; PG8_MMA(1, 1, At, B1); PG8_BAR;
            }
        }
        if constexpr (ALIGN_EPI) { if (wr == 0) PG8_BAR; }
        if constexpr (FP8) { asm volatile("s_nop 15\n\ts_nop 15" ::: "memory"); }
        if constexpr (!Epi::AFTER_DRAIN) { E(acc, cur, wr, wc, fr, fq);
#if defined(PROBE_EPI2)
            if constexpr (FP8 == (PROBE_EPI2 == 1)) { E(acc, cur, wr, wc, fr, fq); }
#endif
            S.done(cur); }
        if (!has_next) break;
#pragma unroll
        for (int a = 0; a < 2; ++a)
#pragma unroll
            for (int b = 0; b < 2; ++b)
#pragma unroll
                for (int m = 0; m < 4; ++m)
#pragma unroll
                    for (int n = 0; n < 2; ++n) acc[a][b][m][n] = (f32x4){0.f, 0.f, 0.f, 0.f};
        cur = nxt; cA = nA; cB = nB; ++ui;
        if constexpr (GATHER) { _Pragma("unroll") for (int h_ = 0; h_ < 2; ++h_) _Pragma("unroll") for (int i_ = 0; i_ < 2; ++i_) gAc[h_][i_] = gAn[h_][i_]; }
        if constexpr (ALIGN_EPI) { if (wr == 1) PG8_BAR; }
    }
    PG8_WAIT_V(0);
    if constexpr (!ALIGN_EPI) { if (wr == 0) PG8_BAR; }
    PG8_BAR;
    if constexpr (Epi::AFTER_DRAIN) { E.fused(acc, cur, wr, wc, fr, fq, lds, wid, lane); S.done(cur); }
#undef PG8_SA
#undef PG8_SB
#undef PG8_STAGE
#undef PG8_STAGE_A
#undef PG8_GATHER
#undef PG8_LDA
#undef PG8_LD32
#undef PG8_LDB
#undef PG8_MMA
#undef PG8_WAIT_V
#undef PG8_WAIT_L
#undef PG8_BAR
#undef PG8_SCHED
}
}

#ifndef PG8_SP2
#define PG8_SP2 true
#endif
#ifndef PG8_ALIGN
#define PG8_ALIGN true
#endif

#define GAS __attribute__((address_space(1)))
#define LAS __attribute__((address_space(3)))
typedef unsigned short bf16;
typedef unsigned v4u __attribute__((ext_vector_type(4)));
typedef unsigned v2u __attribute__((ext_vector_type(2)));
typedef float f32x4 __attribute__((ext_vector_type(4)));
typedef short bf16x8 __attribute__((ext_vector_type(8)));

constexpr int D = 1024, NB = 8, SEQ = 4096, CTXL = 256, TPB = SEQ + CTXL, NTOK = NB * TPB, NLAT = NB * SEQ;
constexpr int ZC = 3328;
constexpr int ZQ = 0, ZKV = 384, ZKR = 640, ZHQ = 672, ZHF = 1184, ZHB = 1696, ZHI = 2208, ZHG = 2720;
constexpr int NEXP = 32;
constexpr float ALPHA = 1.4142135623730951f;
constexpr float LN_EPS = 1e-5f, RMS_EPS = 1e-6f;
constexpr int NWAVES = 8, NTHR = 512;
constexpr float SC_X8 = 16.f, SC_WGU = 64.f, SC_ACT = 8.f, SC_WDN = 128.f, SC_Y = 64.f, SC_A1 = 16.f, SC_WPW = 64.f, SC_CV = 16.f;
constexpr int LDS_BYTES = 147456;
constexpr int LDS_BAR_OFF = LDS_BYTES - 64;
constexpr int LDS_TILE_E = 131072;
constexpr int MAXTILES = 576;

constexpr size_t MiB = 1u << 20;
constexpr size_t WS_CTL = 0, CTL_ZERO_BYTES = 16384;
constexpr size_t WS_MODV = 1 * MiB;
constexpr size_t WS_ROPE = 1 * MiB + 512 * 1024;
constexpr size_t WS_BGU = 2 * MiB;
constexpr size_t WS_PW1B = 2 * MiB + 512 * 1024;
constexpr size_t WS_BCNT = WS_PW1B + 64 * 1024;
constexpr size_t WS_TILEE = WS_BCNT + 64 * 1024;
constexpr size_t WS_META = WS_TILEE + 4096;
constexpr size_t WS_TOPI = 3 * MiB, WS_TOPW = 4 * MiB;
constexpr int ECAP = 32768;
constexpr size_t WS_ROWS = 160 * MiB, WS_ROWW = 164 * MiB, WS_ROWD = 168 * MiB;
constexpr size_t WS_CURSOR = 14336;
constexpr size_t WS_WIN = 8 * MiB, WS_WUQ = 15 * MiB, WS_WUKV = 16 * MiB, WS_WOUT = 17 * MiB, WS_WPW1 = 19 * MiB, WS_WPW2 = 23 * MiB;
constexpr size_t WS_WGU = 32 * MiB, WS_WDN = 288 * MiB;
constexpr size_t WS_H = 416 * MiB;
constexpr size_t WS_X = 552 * MiB, WS_Y = 620 * MiB;
constexpr size_t WS_BIG = 688 * MiB;
constexpr size_t WS_Z = WS_BIG, WS_CQN = WS_BIG + 221 * MiB, WS_CKVN = WS_BIG + 247 * MiB, WS_KRR = WS_BIG + 264 * MiB,
                 WS_Q = WS_BIG + 267 * MiB, WS_KV = WS_BIG + 318 * MiB, WS_OF = WS_BIG + 386 * MiB, WS_OB = WS_BIG + 454 * MiB;
constexpr size_t WS_HT = WS_BIG + 528 * MiB;
constexpr size_t WS_PRE = WS_BIG;
constexpr size_t WS_XS = WS_BIG, WS_ACT = WS_BIG + 288 * MiB, WS_YB = WS_BIG + 576 * MiB;
constexpr size_t WS_END = WS_BIG + 848 * MiB;
static_assert((size_t)NTOK * ZC * 2 <= 221 * MiB && (size_t)NTOK * 384 * 2 <= 26 * MiB && (size_t)NTOK * 256 * 2 <= 17 * MiB && (size_t)NTOK * 32 * 2 <= 3 * MiB, "ws map 1");
static_assert((size_t)NTOK * 768 * 2 <= 51 * MiB && (size_t)NTOK * 1024 * 2 <= 68 * MiB && (size_t)NTOK * 512 * 4 <= 68 * MiB, "ws map 2");
static_assert((size_t)64 * 136 * 26624 <= 320 * MiB && (size_t)MAXTILES * 256 * 2048 <= 288 * MiB && (size_t)NLAT * 4 * 2048 <= 272 * MiB && (size_t)NTOK * 1024 * 4 <= 136 * MiB, "ws map 3");

#define LDS_WAIT() asm volatile("s_waitcnt lgkmcnt(0)" ::: "memory")
#define VM_WAIT() asm volatile("s_waitcnt vmcnt(0)" ::: "memory")
__device__ __forceinline__ float bf2f(unsigned short b) { return __uint_as_float(((unsigned)b) << 16); }
__device__ __forceinline__ unsigned pk2(float lo, float hi) { return pg8::cvt_pk_bf16(lo, hi); }
__device__ __forceinline__ float sigm(float x) { return __builtin_amdgcn_rcpf(1.f + __expf(-x)); }
__device__ __forceinline__ float wave_sum(float v) {
#pragma unroll
    for (int o = 1; o < 64; o <<= 1) v += __shfl_xor(v, o);
    return v;
}
__device__ __forceinline__ int ld_ctl(const int* p) { return (int)__hip_atomic_load((const unsigned*)p, __ATOMIC_RELAXED, __HIP_MEMORY_SCOPE_AGENT); }
__device__ __forceinline__ int grow_of(int lr) { return (lr >> 12) * TPB + CTXL + (lr & 4095); }

#define XB_TMO      128
#define XB_XCNT(j)  (256  + 64 * (j))
#define XB_XSUB(j)  (1280 + 64 * (j))
#define XB_XGEN(j)  (2304 + 64 * (j))
#define XB_TOP      3328
#define XB_TOPGEN   3392
#define XCD_BAR_WORDS 3456
#define XB_SPIN_CAP (1u << 21)

__device__ __forceinline__ unsigned xb_ld(unsigned* p)              { return __hip_atomic_load(p, __ATOMIC_RELAXED, __HIP_MEMORY_SCOPE_AGENT); }
__device__ __forceinline__ unsigned xb_add(unsigned* p, unsigned v) { return __hip_atomic_fetch_add(p, v, __ATOMIC_RELAXED, __HIP_MEMORY_SCOPE_AGENT); }
__device__ __forceinline__ unsigned xb_xcc_id() { return (unsigned)__builtin_amdgcn_s_getreg((3 << 11) | 20) & 0xFu; }
#define XB_SPIN(cond, bar) do { unsigned _sp = 0; while (cond) { __builtin_amdgcn_s_sleep(1); \
    if ((++_sp & 255u) == 0u) { if (xb_ld(&(bar)[XB_TMO])) break; if (_sp > XB_SPIN_CAP) { atomicAdd(&(bar)[XB_TMO], 1u); break; } } } } while (0)

struct XcdBarrier { unsigned* bar; unsigned x; volatile LAS unsigned* st; };

__device__ __forceinline__ XcdBarrier xcd_barrier_post(unsigned* bar, volatile LAS unsigned* st) {
    XcdBarrier b; b.bar = bar; b.x = xb_xcc_id(); b.st = st;
    if (threadIdx.x == 0) (void)xb_add(&bar[XB_XCNT(b.x)], 1u);
    return b;
}
__device__ __forceinline__ void xcd_barrier_complete(unsigned* bar, unsigned x, unsigned& nloc, unsigned& nx) {
    const unsigned G = gridDim.x * gridDim.y * gridDim.z;
    unsigned sum, cnt, mine, sp = 0u;
    for (;;) {
        sum = 0u; cnt = 0u; mine = 0u;
#pragma unroll
        for (unsigned j = 0; j < 16; ++j) { const unsigned c = xb_ld(&bar[XB_XCNT(j)]); sum += c; cnt += (c > 0u) ? 1u : 0u; mine = (j == x) ? c : mine; }
        if (sum == G) break;
        __builtin_amdgcn_s_sleep(1);
        if ((++sp & 255u) == 0u) { if (xb_ld(&bar[XB_TMO])) break; if (sp > XB_SPIN_CAP) { atomicAdd(&bar[XB_TMO], 1u); break; } }
    }
    nloc = mine > 0u ? mine : 1u; nx = cnt > 0u ? cnt : 1u;
}
__device__ __forceinline__ void xcd_barrier(const XcdBarrier& b) {
    asm volatile("s_waitcnt vmcnt(0)" ::: "memory");
    __syncthreads();
    if (threadIdx.x == 0) {
        unsigned* bar = b.bar;
        __builtin_amdgcn_s_waitcnt(0);
        unsigned nloc = b.st[0], nx = b.st[1];
        if (nloc == 0u) { xcd_barrier_complete(bar, b.x, nloc, nx); b.st[0] = nloc; b.st[1] = nx; }
        const unsigned old = xb_add(&bar[XB_XSUB(b.x)], 1u);
        const unsigned gen = old / nloc;
        if (old + 1u == (gen + 1u) * nloc) {
            __builtin_amdgcn_fence(__ATOMIC_RELEASE, "agent");
            asm volatile("s_waitcnt vmcnt(0)" ::: "memory");
            const unsigned og = xb_add(&bar[XB_TOP], 1u);
            const unsigned tg = og / nx;
            if (og + 1u == (tg + 1u) * nx) xb_add(&bar[XB_TOPGEN], 1u);
            else XB_SPIN(xb_ld(&bar[XB_TOPGEN]) == tg, bar);
            __builtin_amdgcn_fence(__ATOMIC_ACQUIRE, "agent");
            xb_add(&bar[XB_XGEN(b.x)], 1u);
            asm volatile("s_waitcnt vmcnt(0)" ::: "memory");
        } else {
            XB_SPIN(xb_ld(&bar[XB_XGEN(b.x)]) == gen, bar);
            __builtin_amdgcn_fence(__ATOMIC_ACQUIRE, "agent");
            asm volatile("s_waitcnt vmcnt(0)" ::: "memory");
        }
    }
    __syncthreads();
}

namespace pg8 {
struct TileOrder {
    int nM, nN, nwg, G, c;
    __device__ __forceinline__ void init(int nM_, int nN_, int G_, int c_) { nM = nM_; nN = nN_; nwg = nM * nN; G = G_; c = c_; }
    __device__ __forceinline__ bool logical(int i, int& im, int& in) const {
        const long L = (long)i * G + c; if (L >= nwg) return false;
        int wgid = (int)L; { const int q = nwg / NXCD, r = nwg % NXCD, xcd = wgid % NXCD, off = wgid / NXCD; wgid = (xcd < r ? xcd * (q + 1) : r * (q + 1) + (xcd - r) * q) + off; }
        const int nig = WGM * nN, gid = wgid / nig, fm = gid * WGM, gsz = (nM - fm) < WGM ? (nM - fm) : WGM;
        im = fm + ((wgid % nig) % gsz); in = (wgid % nig) / gsz; return true;
    }
    __device__ __forceinline__ void a_ready(const Unit&) const {}
    __device__ __forceinline__ void done(const Unit&) const {}
};
struct AllOrder : TileOrder { __device__ __forceinline__ bool next(int i, Unit& u) const { int im, in; if (!logical(i, im, in)) return false; u.pm = im; u.pn = in; return true; } };
struct LatOrder : TileOrder {
    __device__ __forceinline__ bool next(int i, Unit& u) const { int im, in; if (!logical(i, im, in)) return false; u.pm = (im >> 4) * 17 + 1 + (im & 15); u.pn = in; return true; } };
struct MoeOrder : TileOrder {
    const PG8_LAS int* tile_e; int nper;
    __device__ __forceinline__ bool next(int i, Unit& u) const { int im, in; if (!logical(i, im, in)) return false; u.pm = im; u.pn = tile_e[im] * nper + in; return true; } };

struct EpiRes {
    static constexpr bool PERM = true, AFTER_DRAIN = false;
    const float* xin; const float* h; bf16_t* pre; const float* modv; const float* bias; float ascale;
    __device__ __forceinline__ void operator()(const f32x4 (&acc)[2][2][4][2], const Unit& u, int wr, int wc, int fr, int fq) const {
        asm volatile("" : "+v"(fr), "+v"(fq));
        const int b = u.pm / 17, j = u.pm % 17;
        const int rl0 = wr * 64 + fr, col0 = u.pn * BM + wc * 32 + 8 * fq;
        const float* gate = modv + (size_t)b * 6144 + 2048;
        f32x4 gv[2][2], bv[2][2];
#pragma unroll
        for (int bj = 0; bj < 2; ++bj)
#pragma unroll
            for (int n = 0; n < 2; ++n) { gv[bj][n] = *(const f32x4*)(gate + col0 + bj * HALF + 4 * n); bv[bj][n] = bias ? *(const f32x4*)(bias + col0 + bj * HALF + 4 * n) : (f32x4){0.f, 0.f, 0.f, 0.f}; }
#pragma unroll
        for (int aim = 0; aim < 4; ++aim) { const int ai = aim >> 1, m0 = (aim & 1) * 2;
            f32x4 hv[2][2][2];
#pragma unroll
            for (int mm = 0; mm < 2; ++mm) { const int rl = rl0 + ai * HALF + (m0 + mm) * 16; const size_t grow = (size_t)u.pm * BM + rl;
                const float* hin = xin ? xin + ((size_t)b * 4096 + (size_t)(j - 1) * 256 + rl) * 1024 + col0 : h + grow * 1024 + col0;
#pragma unroll
                for (int bj = 0; bj < 2; ++bj) { hv[mm][bj][0] = *(const f32x4*)(hin + bj * HALF); hv[mm][bj][1] = *(const f32x4*)(hin + bj * HALF + 4); } }
            asm volatile("" ::: "memory");
#pragma unroll
            for (int mm = 0; mm < 2; ++mm) { const int m = m0 + mm; const int rl = rl0 + ai * HALF + m * 16; const size_t grow = (size_t)u.pm * BM + rl; bf16_t* po = pre + grow * 1024 + col0;
#pragma unroll
                for (int bj = 0; bj < 2; ++bj) {
                    const f32x4 v0 = hv[mm][bj][0] * 1.4142135623730951f + gv[bj][0] * (acc[ai][bj][m][0] * ascale + bv[bj][0]), v1 = hv[mm][bj][1] * 1.4142135623730951f + gv[bj][1] * (acc[ai][bj][m][1] * ascale + bv[bj][1]);
                    u32x4 w; w.x = cvt_pk_bf16(v0[0], v0[1]); w.y = cvt_pk_bf16(v0[2], v0[3]); w.z = cvt_pk_bf16(v1[0], v1[1]); w.w = cvt_pk_bf16(v1[2], v1[3]);
                    *(u32x4*)(po + bj * HALF) = w; } }
            asm volatile("" ::: "memory"); }
    }
};
template <int MODE, bool OUT8 = false> struct EpiGate {
    static constexpr bool PERM = true, AFTER_DRAIN = false;
    bf16_t* O; const float* bias; int nper; float ascale, oscale;
    __device__ __forceinline__ void operator()(const f32x4 (&acc)[2][2][4][2], const Unit& u, int wr, int wc, int fr, int fq) const {
        asm volatile("" : "+v"(fr), "+v"(fq));
        const int row0 = u.pm * BM + wr * 64 + fr, pnl = u.pn % nper, ocol0 = pnl * HALF + wc * 32 + 8 * fq, bcol0 = u.pn * BM + wc * 32 + 8 * fq;
        const float s0 = ascale, s1 = MODE == 1 ? ascale * oscale : ascale;
        f32x4 bv[2][2];
#pragma unroll
        for (int n = 0; n < 2; ++n) { bv[0][n] = *(const f32x4*)(bias + bcol0 + 4 * n); const f32x4 t = *(const f32x4*)(bias + bcol0 + HALF + 4 * n); bv[1][n] = MODE == 1 ? (t + 1.0f) * oscale : t; }
#pragma unroll
        for (int ai = 0; ai < 2; ++ai)
#pragma unroll
            for (int m = 0; m < 4; ++m) { bf16_t* rowp = O + (size_t)(row0 + ai * HALF + m * 16) * 1024 + ocol0;
                unsigned char* rowp8 = (unsigned char*)O + (size_t)(row0 + ai * HALF + m * 16) * 1024 + ocol0;
                float o[8];
#pragma unroll
                for (int n = 0; n < 2; ++n) { const f32x4 a = acc[ai][0][m][n] * s0 + bv[0][n], g = acc[ai][1][m][n] * s1 + bv[1][n];
#pragma unroll
                    for (int e = 0; e < 4; ++e) {
                        if (MODE == 0) { o[4 * n + e] = a[e] * __builtin_amdgcn_rcpf(1.f + __builtin_amdgcn_exp2f(g[e] * -1.4426950408889634f)); }
                        else { const float gt = fminf(a[e], 7.0f), up1 = __builtin_amdgcn_fmed3f(g[e], -6.0f * oscale, 8.0f * oscale);
                            o[4 * n + e] = up1 * (gt * __builtin_amdgcn_rcpf(1.f + __builtin_amdgcn_exp2f(gt * (-1.702f * 1.4426950408889634f)))); } } }
                if constexpr (OUT8) {
                    int w0 = 0, w1 = 0; w0 = __builtin_amdgcn_cvt_pk_fp8_f32(o[0], o[1], w0, false); w0 = __builtin_amdgcn_cvt_pk_fp8_f32(o[2], o[3], w0, true);
                    w1 = __builtin_amdgcn_cvt_pk_fp8_f32(o[4], o[5], w1, false); w1 = __builtin_amdgcn_cvt_pk_fp8_f32(o[6], o[7], w1, true);
                    typedef unsigned u32x2 __attribute__((ext_vector_type(2))); *(u32x2*)rowp8 = (u32x2){(unsigned)w0, (unsigned)w1}; (void)rowp;
                } else { (void)rowp8;
                u32x4 w; w.x = cvt_pk_bf16(o[0], o[1]); w.y = cvt_pk_bf16(o[2], o[3]); w.z = cvt_pk_bf16(o[4], o[5]); w.w = cvt_pk_bf16(o[6], o[7]);
                *(u32x4*)rowp = w; } }
    }
};
struct EpiDown {
    static constexpr bool PERM = true, AFTER_DRAIN = false;
    bf16_t* Y; const float* bias; const float* row_w; const int* row_dst; float ascale; const PG8_LAS int* gtab; float oscale;
    __device__ __forceinline__ void operator()(const f32x4 (&acc)[2][2][4][2], const Unit& u, int wr, int wc, int fr, int fq) const {
        asm volatile("" : "+v"(fr), "+v"(fq));
        const int pnl = u.pn & 3, ocol0 = pnl * BM + wc * 32 + 8 * fq, bcol0 = u.pn * BM + wc * 32 + 8 * fq; const int tbase = gtab[u.pm], tcnt = gtab[576 + u.pm];
        f32x4 bv[2][2];
#pragma unroll
        for (int bj = 0; bj < 2; ++bj)
#pragma unroll
            for (int n = 0; n < 2; ++n) bv[bj][n] = *(const f32x4*)(bias + bcol0 + bj * HALF + 4 * n);
        int dstv[2][4]; float wv[2][4];
#pragma unroll
        for (int ai = 0; ai < 2; ++ai)
#pragma unroll
            for (int m = 0; m < 4; ++m) { const int rl = wr * 64 + fr + ai * HALF + m * 16; const int ix = tbase + (rl < tcnt ? rl : 0); dstv[ai][m] = row_dst[ix]; wv[ai][m] = row_w[ix]; }
#pragma unroll
        for (int ai = 0; ai < 2; ++ai)
#pragma unroll
            for (int m = 0; m < 4; ++m) { const int rl = wr * 64 + fr + ai * HALF + m * 16;
                if (rl < tcnt) { const int dst = dstv[ai][m]; const float w8 = wv[ai][m] * oscale; unsigned char* rowp = (unsigned char*)Y + (size_t)dst * 1024 + ocol0;
#pragma unroll
                    for (int bj = 0; bj < 2; ++bj) { const f32x4 v0 = (acc[ai][bj][m][0] * ascale + bv[bj][0]) * w8, v1 = (acc[ai][bj][m][1] * ascale + bv[bj][1]) * w8;
                        int w0 = 0, w1 = 0; w0 = __builtin_amdgcn_cvt_pk_fp8_f32(fminf(fmaxf(v0[0], -448.f), 448.f), fminf(fmaxf(v0[1], -448.f), 448.f), w0, false); w0 = __builtin_amdgcn_cvt_pk_fp8_f32(fminf(fmaxf(v0[2], -448.f), 448.f), fminf(fmaxf(v0[3], -448.f), 448.f), w0, true);
                        w1 = __builtin_amdgcn_cvt_pk_fp8_f32(fminf(fmaxf(v1[0], -448.f), 448.f), fminf(fmaxf(v1[1], -448.f), 448.f), w1, false); w1 = __builtin_amdgcn_cvt_pk_fp8_f32(fminf(fmaxf(v1[2], -448.f), 448.f), fminf(fmaxf(v1[3], -448.f), 448.f), w1, true);
                        typedef unsigned u32x2 __attribute__((ext_vector_type(2))); *(u32x2*)(rowp + bj * HALF) = (u32x2){(unsigned)w0, (unsigned)w1}; } } }
    }
};
}

namespace att {
using bf16x8 = __attribute__((ext_vector_type(8))) short;
using s16x4  = __attribute__((ext_vector_type(4))) short;
using f32x16 = __attribute__((ext_vector_type(16))) float;
using u32x4  = __attribute__((ext_vector_type(4))) unsigned;
constexpr int NW = 8, QBLK = 32, KVBLK = 64;
constexpr float SCALE = 0.10206207261596575f;
constexpr float THR = 8.f;
constexpr int SHM_V = 16384, SHM_K = 16384, NBUF = 3, SHM_ATTN = NBUF * SHM_V + NBUF * SHM_K + NW * 64 * 4;
#define KSWZ(row, colB) ((row) * 256 + ((colB) ^ (((row) & 7) << 4)))
#define SBAR() __builtin_amdgcn_sched_barrier(0)
__device__ __forceinline__ int crow(int r, int hi) { return (r & 3) + 8 * (r >> 2) + 4 * hi; }
__device__ __forceinline__ unsigned cvtpk(float lo, float hi) { unsigned r; asm volatile("v_cvt_pk_bf16_f32 %0, %1, %2" : "=v"(r) : "v"(lo), "v"(hi)); return r; }

__device__ __forceinline__ void partialSM(f32x16& p0, f32x16& p1, float& m_reg, float& mn, float& alpha) {
  constexpr float C = SCALE * 1.4426950408889634f;
  float pmax = p0[0];
#pragma unroll
  for (int r = 1; r < 16; ++r) pmax = fmaxf(pmax, p0[r]);
#pragma unroll
  for (int r = 0; r < 16; ++r) pmax = fmaxf(pmax, p1[r]);
  { auto rr = __builtin_amdgcn_permlane32_swap(__float_as_uint(pmax), __float_as_uint(pmax), false, false);
    pmax = fmaxf(__uint_as_float(rr[0]), __uint_as_float(rr[1])); }
  if (__builtin_expect(__all(pmax - m_reg <= THR / SCALE), 1)) { mn = m_reg; alpha = 1.f; }
  else { mn = fmaxf(m_reg, pmax); alpha = __builtin_amdgcn_exp2f((m_reg - mn) * C); m_reg = mn; }
  float mnC = -mn * C;
#pragma unroll
  for (int r = 0; r < 16; ++r) p0[r] = fmaf(p0[r], C, mnC);
#pragma unroll
  for (int r = 0; r < 16; ++r) p1[r] = fmaf(p1[r], C, mnC);
#pragma unroll
  for (int r = 0; r < 16; ++r) p0[r] = __builtin_amdgcn_exp2f(p0[r]);
}
__device__ __forceinline__ void finishSM(f32x16& p0, f32x16& p1, float alpha, float& l_reg, bf16x8& pa0, bf16x8& pa1, bf16x8& pa2, bf16x8& pa3) {
#pragma unroll
  for (int r = 0; r < 16; ++r) p1[r] = __builtin_amdgcn_exp2f(p1[r]);
  float ps = 0;
#pragma unroll
  for (int r = 0; r < 16; ++r) ps += p0[r];
#pragma unroll
  for (int r = 0; r < 16; ++r) ps += p1[r];
  { auto rr = __builtin_amdgcn_permlane32_swap(__float_as_uint(ps), __float_as_uint(ps), false, false);
    ps = __uint_as_float(rr[0]) + __uint_as_float(rr[1]); }
  l_reg = l_reg * alpha + ps;
#define PK4(P, BASE, OUT) do { unsigned a0 = cvtpk(P[BASE + 0], P[BASE + 1]), a1 = cvtpk(P[BASE + 2], P[BASE + 3]);   \
    unsigned b0 = cvtpk(P[BASE + 4], P[BASE + 5]), b1 = cvtpk(P[BASE + 6], P[BASE + 7]);                              \
    auto r0 = __builtin_amdgcn_permlane32_swap(a0, b0, false, false); auto r1 = __builtin_amdgcn_permlane32_swap(a1, b1, false, false); \
    u32x4 w = {r0[0], r1[0], r0[1], r1[1]}; OUT = *reinterpret_cast<bf16x8*>(&w); } while (0)
  PK4(p0, 0, pa0); PK4(p0, 8, pa1); PK4(p1, 0, pa2); PK4(p1, 8, pa3);
#undef PK4
}
__device__ __forceinline__ void qkt(f32x16& p0, f32x16& p1, const bf16* Ks, const bf16x8* qr, int r32, int hi) {
  p0 = f32x16{}; p1 = f32x16{};
#pragma unroll
  for (int d0 = 0; d0 < 6; ++d0) { int cb = (d0 * 16 + hi * 8) * 2;
    bf16x8 b0 = *reinterpret_cast<const bf16x8*>((const char*)Ks + KSWZ(r32, cb));
    bf16x8 b1 = *reinterpret_cast<const bf16x8*>((const char*)Ks + KSWZ(32 + r32, cb));
    p0 = __builtin_amdgcn_mfma_f32_32x32x16_bf16(b0, qr[d0], p0, 0, 0, 0);
    p1 = __builtin_amdgcn_mfma_f32_32x32x16_bf16(b1, qr[d0], p1, 0, 0, 0); }
}
__device__ __forceinline__ int v_st(int k, int c) { const int kk = (k & ~0xC) | ((k & 4) << 1) | ((k & 8) >> 1); return ((kk >> 3) * 4 + (c >> 5)) * 512 + ((kk & 7) * 32 + (c & 31)) * 2; }
__device__ __forceinline__ int v_rd_base(int lane) { return ((lane & 3) << 3) | (((lane >> 2) & 3) << 6) | (((lane >> 4) & 1) << 5) | (((lane >> 5) & 1) << 8); }
constexpr int v_rd_off(int d0, int ks, int half) { return d0 * 512 + ks * 4096 + half * 2048; }
template <int OFF> __device__ __forceinline__ s16x4 tr_read(int vb) {
  s16x4 r; asm volatile("ds_read_b64_tr_b16 %0, %1 offset:%2" : "=&v"(r) : "v"(vb), "i"(OFF) : "memory"); return r;
}
template <int D0> __device__ __forceinline__ void pv_one(f32x16& od, int vb, bf16x8 pa0, bf16x8 pa1, bf16x8 pa2, bf16x8 pa3) {
  const s16x4 l0 = tr_read<v_rd_off(D0, 0, 0)>(vb), h0 = tr_read<v_rd_off(D0, 0, 1)>(vb), l1 = tr_read<v_rd_off(D0, 1, 0)>(vb), h1 = tr_read<v_rd_off(D0, 1, 1)>(vb);
  const s16x4 l2 = tr_read<v_rd_off(D0, 2, 0)>(vb), h2 = tr_read<v_rd_off(D0, 2, 1)>(vb), l3 = tr_read<v_rd_off(D0, 3, 0)>(vb), h3 = tr_read<v_rd_off(D0, 3, 1)>(vb);
  asm volatile("s_waitcnt lgkmcnt(0)" ::: "memory"); SBAR();
#define PK(L, H) (bf16x8){L[0], L[1], L[2], L[3], H[0], H[1], H[2], H[3]}
  od = __builtin_amdgcn_mfma_f32_32x32x16_bf16(pa0, PK(l0, h0), od, 0, 0, 0);
  od = __builtin_amdgcn_mfma_f32_32x32x16_bf16(pa1, PK(l1, h1), od, 0, 0, 0);
  od = __builtin_amdgcn_mfma_f32_32x32x16_bf16(pa2, PK(l2, h2), od, 0, 0, 0);
  od = __builtin_amdgcn_mfma_f32_32x32x16_bf16(pa3, PK(l3, h3), od, 0, 0, 0);
#undef PK
}
__device__ __forceinline__ void pv_d0(f32x16* o, int vb, bf16x8 pa0, bf16x8 pa1, bf16x8 pa2, bf16x8 pa3) {
  pv_one<0>(o[0], vb, pa0, pa1, pa2, pa3); pv_one<1>(o[1], vb, pa0, pa1, pa2, pa3);
}
__device__ __forceinline__ bf16x8 rope8(bf16x8 x, const float* tab, int pbase) {
  u32x4 w;
#pragma unroll
  for (int i = 0; i < 4; ++i) { const float x1 = __uint_as_float(((unsigned)(unsigned short)x[2 * i]) << 16), x2 = __uint_as_float(((unsigned)(unsigned short)x[2 * i + 1]) << 16);
    const float cs = tab[pbase + i], sn = tab[16 + pbase + i]; w[i] = cvtpk(x1 * cs - x2 * sn, x1 * sn + x2 * cs); }
  return *reinterpret_cast<bf16x8*>(&w);
}
__device__ __forceinline__ void attn_unit(const bf16* __restrict__ Qb, const bf16* __restrict__ KVb, const bf16* __restrict__ KRb, bf16* __restrict__ Ob,
                                          const float* __restrict__ rope, int seq, char* lds) {
  int tid_l = threadIdx.x; asm volatile("" : "+v"(tid_l));
  const int tid = tid_l, wid = tid >> 6, lane = tid & 63, r32 = lane & 31, hi = lane >> 5;
  bf16* V_lds = (bf16*)lds; bf16* K_lds = (bf16*)(lds + NBUF * SHM_V);
  float* ws = (float*)(lds + NBUF * SHM_V + NBUF * SHM_K) + wid * 64; float* li_l = ws; float* al_l = ws + 32;
  float m_reg = -1e30f, l_reg = 0; f32x16 o[2] = {}; bf16x8 qr[6];
  const bf16* Qw = Qb + (long)(wid * QBLK + r32) * 768 + hi * 8;
#pragma unroll
  for (int d0 = 0; d0 < 6; ++d0) qr[d0] = *reinterpret_cast<const bf16x8*>(Qw + d0 * 16);
  if (rope) { const float* tab = rope + (long)(wid * QBLK + r32) * 32; qr[4] = rope8(qr[4], tab, 4 * hi); qr[5] = rope8(qr[5], tab, 8 + 4 * hi); }
  const int sr = tid >> 4, ch = tid & 15;
  const bf16* kbase = ch < 8 ? KVb + ch * 8 : KRb + ((ch - 8) & 3) * 8; const long kstr = ch < 8 ? 1024 : 32;
  const int vkey = tid >> 3, vc8 = (tid & 7) * 8, vst0 = v_st(vkey, vc8);
  const bf16* vbase = KVb + 512 + vc8;
  const int vb0 = (int)(uintptr_t)V_lds + v_rd_base(lane);
  struct { bf16x8 vs0, ks0, ks1; } sr_[2];
#define SLOAD(i, k0) do { sr_[i].vs0 = *reinterpret_cast<const bf16x8*>(vbase + (long)((k0) + vkey) * 1024); \
    sr_[i].ks0 = *reinterpret_cast<const bf16x8*>(kbase + (long)((k0) + sr) * kstr); sr_[i].ks1 = *reinterpret_cast<const bf16x8*>(kbase + (long)((k0) + 32 + sr) * kstr); } while (0)
#define SWRITE(b, i) do { *(bf16x8*)((char*)V_lds + (b) * SHM_V + vst0) = sr_[i].vs0; int kc = ch * 16;               \
    *(bf16x8*)((char*)K_lds + (b) * SHM_K + KSWZ(sr, kc)) = sr_[i].ks0;                       \
    *(bf16x8*)((char*)K_lds + (b) * SHM_K + KSWZ(32 + sr, kc)) = sr_[i].ks1; } while (0)
#define SWAIT() asm volatile("s_waitcnt vmcnt(3)" ::: "memory")
#define RESC(a) do { if (__any((a) < 1.f)) { if (hi == 0) al_l[r32] = (a); asm volatile("s_waitcnt lgkmcnt(0)" ::: "memory"); \
    _Pragma("unroll") for (int d = 0; d < 2; ++d) _Pragma("unroll") for (int r = 0; r < 16; ++r) o[d][r] *= al_l[crow(r, hi)]; } } while (0)
  f32x16 pA0, pA1, pB0, pB1; float mnA, mnB, alA, alB; bf16x8 pa0, pa1, pa2, pa3; const int NT = seq / KVBLK;
  constexpr int SE = 0, SO = 1;
  SLOAD(SE, 0); asm volatile("s_waitcnt vmcnt(0)" ::: "memory"); SWRITE(0, SE); __syncthreads();
  qkt(pA0, pA1, K_lds, qr, r32, hi); partialSM(pA0, pA1, m_reg, mnA, alA);
  SLOAD(SO, KVBLK); if (2 < NT) SLOAD(SE, 2 * KVBLK);
  SWAIT(); SWRITE(1, SO); __syncthreads();
  int bprev = 0, bcur = 1, bnext = 2;
#define ATT_STEP(PN0, PN1, MNN, ALN, PO0, PO1, ALO, SL_LOAD, SL_WRITE, t) do { \
    SBAR(); qkt(PN0, PN1, (bf16*)((char*)K_lds + bcur * SHM_K), qr, r32, hi); \
    finishSM(PO0, PO1, ALO, l_reg, pa0, pa1, pa2, pa3); SBAR(); \
    if ((t) + 2 < NT) SLOAD(SL_LOAD, ((t) + 2) * KVBLK); SBAR(); \
    pv_d0(o, vb0 + bprev * (int)SHM_V, pa0, pa1, pa2, pa3); partialSM(PN0, PN1, m_reg, MNN, ALN); \
    SWAIT(); SWRITE(bnext, SL_WRITE); \
    RESC(ALN); __syncthreads(); \
    bprev = bcur; bcur = bnext; bnext = (bnext == 2) ? 0 : bnext + 1; } while (0)
  for (int j = 1; j + 1 < NT; j += 2) {
    ATT_STEP(pB0, pB1, mnB, alB, pA0, pA1, alA, SO, SE, j);
    ATT_STEP(pA0, pA1, mnA, alA, pB0, pB1, alB, SE, SO, j + 1);
  }
#undef ATT_STEP
  SBAR(); qkt(pB0, pB1, (bf16*)((char*)K_lds + bcur * SHM_K), qr, r32, hi);
  finishSM(pA0, pA1, alA, l_reg, pa0, pa1, pa2, pa3); SBAR();
  pv_d0(o, vb0 + bprev * (int)SHM_V, pa0, pa1, pa2, pa3); partialSM(pB0, pB1, m_reg, mnB, alB);
  RESC(alB);
  finishSM(pB0, pB1, alB, l_reg, pa0, pa1, pa2, pa3); SBAR();
  pv_d0(o, vb0 + bcur * (int)SHM_V, pa0, pa1, pa2, pa3);
  if (hi == 0) li_l[r32] = l_reg; asm volatile("s_waitcnt lgkmcnt(0)" ::: "memory");
  float rli[16];
#pragma unroll
  for (int r = 0; r < 16; ++r) rli[r] = __builtin_amdgcn_rcpf(li_l[crow(r, hi)]);
  bf16* Ow = Ob + (long)(wid * QBLK) * 1024;
#pragma unroll
  for (int r = 0; r < 16; ++r) { int orow = crow(r, hi);
#pragma unroll
    for (int d0 = 0; d0 < 2; ++d0) { const float v = o[d0][r] * rli[r]; Ow[(long)orow * 1024 + d0 * 32 + r32] = (bf16)(cvtpk(v, v) & 0xffffu); } }
#undef SLOAD
#undef SWRITE
#undef SWAIT
#undef RESC
}
}

struct Args { const float* in[33]; float* out; unsigned char* ws; int ph_lo, ph_hi; };
enum { I_X = 0, I_C, I_CTX, I_CCTX, I_MODW, I_MODB, I_LN1G, I_LN1B, I_LN2G, I_LN2B, I_WIN, I_QNORM, I_KVNORM, I_WUQ, I_WUK, I_WUV, I_LBL, I_HGNORM, I_WOUT,
       I_PW1W, I_PW1B, I_DWW, I_DWB, I_CLNG, I_CLNB, I_PW2W, I_PW2B, I_RW, I_RB, I_WGU, I_BGU, I_WDN, I_BDN };

__device__ __forceinline__ int dst_row(int n, int mode, int row_off) {
    if (mode == 0) return row_off + n;
    int f, g; if (mode == 1) { f = n >> 1; g = n & 1; } else { g = n >> 10; f = n & 1023; }
    return row_off + 256 * (f >> 7) + 128 * g + (f & 127);
}
__device__ __forceinline__ unsigned pack_fp8x4(float a, float b, float c, float d) { int w = 0; w = __builtin_amdgcn_cvt_pk_fp8_f32(fminf(fmaxf(a, -448.f), 448.f), fminf(fmaxf(b, -448.f), 448.f), w, false);
    w = __builtin_amdgcn_cvt_pk_fp8_f32(fminf(fmaxf(c, -448.f), 448.f), fminf(fmaxf(d, -448.f), 448.f), w, true); return (unsigned)w; }
struct TrItem { const float* W; bf16* WT; int K, N, mode, row_off, item; float f8scale; };
__device__ __forceinline__ void tr_load(const TrItem& d, f32x4 (&v)[16], int lane) {
    const int nblk = (d.N + 63) >> 6, kb = d.item / nblk, nb = d.item - kb * nblk, k0 = 64 * kb, n0 = 64 * nb;
    const int nc = n0 + 4 * (lane & 15), kr = lane >> 4;
#pragma unroll
    for (int i = 0; i < 16; ++i) v[i] = (nc < d.N) ? __builtin_nontemporal_load((const f32x4*)(d.W + (size_t)(k0 + 4 * i + kr) * d.N + nc)) : (f32x4){0.f, 0.f, 0.f, 0.f};
}
__device__ __forceinline__ void tr_lds_write(const f32x4 (&v)[16], LAS float* scr, int lane) {
    const int kr = lane >> 4;
#pragma unroll
    for (int i = 0; i < 16; ++i) { LAS float* s = scr + (4 * i + kr) * 65 + 4 * (lane & 15); s[0] = v[i][0]; s[1] = v[i][1]; s[2] = v[i][2]; s[3] = v[i][3]; }
}
__device__ __forceinline__ void tr_store(const TrItem& d, LAS float* scr, int lane) {
    const int nblk = (d.N + 63) >> 6, kb = d.item / nblk, nb = d.item - kb * nblk, k0 = 64 * kb, n0 = 64 * nb;
    const int c = lane & 7; const int K = d.K;
#pragma unroll
    for (int j = 0; j < 8; ++j) { const int nl = (lane >> 3) + 8 * j, n = n0 + nl; const LAS float* s = scr + (8 * c) * 65 + nl;
        if (n < d.N) { if (d.f8scale > 0.f) { const float f8 = d.f8scale; v2u o8; o8.x = pack_fp8x4(s[0 * 65] * f8, s[1 * 65] * f8, s[2 * 65] * f8, s[3 * 65] * f8); o8.y = pack_fp8x4(s[4 * 65] * f8, s[5 * 65] * f8, s[6 * 65] * f8, s[7 * 65] * f8);
                *(v2u*)((unsigned char*)d.WT + (size_t)dst_row(n, d.mode, d.row_off) * K + k0 + 8 * c) = o8; }
            else { v4u o; o.x = pk2(s[0 * 65], s[1 * 65]); o.y = pk2(s[2 * 65], s[3 * 65]); o.z = pk2(s[4 * 65], s[5 * 65]); o.w = pk2(s[6 * 65], s[7 * 65]);
                *(v4u*)(d.WT + (size_t)dst_row(n, d.mode, d.row_off) * K + k0 + 8 * c) = o; } } }
}
__device__ __forceinline__ void convert_items(const Args& a, unsigned char* ws, LAS float* scr, int lane, int gw, int NGW, int it_lo, int it_hi) {
    constexpr int I0 = 16 * 51, I1 = 6 * 12, I2 = 4 * 8, I3 = 4 * 8, I4 = 256, I5 = 512;
    constexpr int NGU = 64 * 512, NDN = 64 * 256;
    auto decode = [&](int it) -> TrItem {
        TrItem d; int r = it; d.f8scale = 0.f; d.mode = 0; d.row_off = 0;
        if (r < NGU) { const int mi = r >> 9; d.W = a.in[I_WGU] + (size_t)mi * 1024 * 2048; d.K = 1024; d.N = 2048; d.WT = (bf16*)(ws + WS_WGU + (size_t)mi * 2048 * 1024); d.mode = 1; d.item = r & 511; d.f8scale = SC_WGU; return d; } r -= NGU;
        if (r < NDN) { const int mi = r >> 8; d.W = a.in[I_WDN] + (size_t)mi * 1024 * 1024; d.K = 1024; d.N = 1024; d.WT = (bf16*)(ws + WS_WDN + (size_t)mi * 1024 * 1024); d.item = r & 255; d.f8scale = SC_WDN; return d; } r -= NDN;
        if (r < I0) { d.W = a.in[I_WIN]; d.K = 1024; d.N = 3232; d.WT = (bf16*)(ws + WS_WIN); d.item = r; return d; } r -= I0;
        if (r < I1) { d.W = a.in[I_WUQ]; d.K = 384; d.N = 768; d.WT = (bf16*)(ws + WS_WUQ); d.item = r; return d; } r -= I1;
        if (r < I2) { d.W = a.in[I_WUK]; d.K = 256; d.N = 512; d.WT = (bf16*)(ws + WS_WUKV); d.item = r; return d; } r -= I2;
        if (r < I3) { d.W = a.in[I_WUV]; d.K = 256; d.N = 512; d.WT = (bf16*)(ws + WS_WUKV); d.row_off = 512; d.item = r; return d; } r -= I3;
        if (r < I4) { d.W = a.in[I_WOUT]; d.K = 1024; d.N = 1024; d.WT = (bf16*)(ws + WS_WOUT); d.item = r; return d; } r -= I4;
        if (r < I5) { d.W = a.in[I_PW1W]; d.K = 1024; d.N = 2048; d.WT = (bf16*)(ws + WS_WPW1); d.mode = 2; d.item = r; d.f8scale = SC_WPW; return d; } r -= I5;
        d.W = a.in[I_PW2W]; d.K = 1024; d.N = 1024; d.WT = (bf16*)(ws + WS_WPW2); d.item = r; d.f8scale = SC_WPW; return d; };
    f32x4 tv[16];
    int it = it_lo + gw;
    if (it < it_hi) { const TrItem d0 = decode(it); tr_load(d0, tv, lane); }
    for (; it < it_hi; it += NGW) {
        const TrItem d = decode(it);
        tr_lds_write(tv, scr, lane);
        if (it + NGW < it_hi) { const TrItem dn = decode(it + NGW); tr_load(dn, tv, lane); }
        LDS_WAIT();
        tr_store(d, scr, lane);
        LDS_WAIT();
    }
}
__device__ __forceinline__ void phase_prologue(const Args& a, LAS unsigned char* lds, int tid, int lane, int wave) {
    unsigned char* ws = a.ws;
    const int G = gridDim.x, B = blockIdx.x;
    {
        LAS float* sc = (LAS float*)lds;
        LAS float* red = (LAS float*)(lds + 36864);
        float* modv = (float*)(ws + WS_MODV);
        bool have = false;
        for (int it = B; it < 192; it += G) {
            if (!have) { for (int i = tid; i < 9 * 1024; i += NTHR) { const int r = i >> 10, k = i & 1023; const float x = r < 8 ? a.in[I_C][r * 1024 + k] : a.in[I_CCTX][k]; sc[i] = x * sigm(x); } __syncthreads(); have = true; }
            const int l = it / 96, jc = it % 96, kg = tid >> 6, jj = tid & 63, j = jc * 64 + jj;
            float acc[9];
#pragma unroll
            for (int r = 0; r < 9; ++r) acc[r] = 0.f;
            const float* wp = a.in[I_MODW] + ((size_t)l * 1024 + kg * 128) * 6144 + j;
            for (int k0 = 0; k0 < 128; k0 += 16) { float w[16];
#pragma unroll
                for (int kk = 0; kk < 16; ++kk) w[kk] = wp[(size_t)(k0 + kk) * 6144];
#pragma unroll
                for (int kk = 0; kk < 16; ++kk)
#pragma unroll
                    for (int r = 0; r < 9; ++r) acc[r] += sc[r * 1024 + kg * 128 + k0 + kk] * w[kk]; }
#pragma unroll
            for (int r = 0; r < 9; ++r) red[(kg * 9 + r) * 64 + jj] = acc[r];
            __syncthreads();
            for (int i = tid; i < 576; i += NTHR) { const int r = i >> 6, j2 = i & 63; float s = a.in[I_MODB][l * 6144 + jc * 64 + j2];
#pragma unroll
                for (int g = 0; g < 8; ++g) s += red[(g * 9 + r) * 64 + j2];
                modv[((size_t)l * 9 + r) * 6144 + jc * 64 + j2] = s; }
            __syncthreads();
        }
        __syncthreads();
    }
    const int gw = B * NWAVES + wave, NGW = G * NWAVES, gt = B * NTHR + tid, NGT = G * NTHR;
    { float* rope = (float*)(ws + WS_ROPE);
      for (int i = gt; i < 4096 * 16; i += NGT) { const int t = i >> 4, p = i & 15; const float pos = (float)(p < 8 ? (t >> 6) : (t & 63));
          const float inv = __powf(10000.0f, -(float)(p & 7) * 0.125f); const float ang = pos * inv; rope[t * 32 + p] = cosf(ang); rope[t * 32 + 16 + p] = sinf(ang); }
      float* bgu = (float*)(ws + WS_BGU);
      for (int i = gt; i < 2 * 32 * 2048; i += NGT) { const int le = i >> 11, np = i & 2047, q = np >> 8, g = (np >> 7) & 1, r = np & 127, f = 128 * q + r; bgu[i] = a.in[I_BGU][(size_t)le * 2048 + 2 * f + g]; }
      float* pb = (float*)(ws + WS_PW1B);
      for (int i = gt; i < 2048; i += NGT) { const int q = i >> 8, g = (i >> 7) & 1, r = i & 127, f = 128 * q + r; pb[i] = a.in[I_PW1B][g * 1024 + f]; }
      v4u* zp = (v4u*)(ws + WS_WIN + (size_t)3232 * 1024 * 2);
      for (int i = gt; i < 96 * 1024 * 2 / 16; i += NGT) zp[i] = (v4u){0u, 0u, 0u, 0u};
    }
    LAS float* scr = (LAS float*)(lds + wave * 16640);
    constexpr int I0 = 16 * 51, I1 = 6 * 12, I2 = 4 * 8, I3 = 4 * 8, I4 = 256, I5 = 512, I6 = 256, SMALL = I0 + I1 + I2 + I3 + I4 + I5 + I6;
    constexpr int NGU = 64 * 512, NDN = 64 * 256, NITEMS = SMALL + NGU + NDN;
    convert_items(a, ws, scr, lane, B * NWAVES + wave, G * NWAVES, NGU + NDN, NITEMS);
}
__device__ __forceinline__ void convert_moe_share(const Args& a, LAS unsigned char* lds, int lane, int wave) {
    LAS float* scr = (LAS float*)(lds + wave * 16640);
    constexpr int NGU = 64 * 512, NDN = 64 * 256;
    convert_items(a, a.ws, scr, lane, blockIdx.x * NWAVES + wave, gridDim.x * NWAVES, 0, NGU + NDN);
}

__device__ __forceinline__ void phase_mod0(const Args& a, int lane, int wave) {
    const int gw = blockIdx.x * NWAVES + wave, NGW = gridDim.x * NWAVES;
    const float* modv = (const float*)(a.ws + WS_MODV);
    bf16* X = (bf16*)(a.ws + WS_X);
    for (int r0 = 2 * gw; r0 < NTOK; r0 += 2 * NGW) {
        f32x4 xv[2][4]; const float* mvp[2];
#pragma unroll
        for (int q = 0; q < 2; ++q) { const int r = r0 + q; const int b = r / TPB, p = r - b * TPB;
            const float* src = p < CTXL ? a.in[I_CTX] + ((size_t)b * CTXL + p) * 1024 : a.in[I_X] + ((size_t)b * SEQ + (p - CTXL)) * 1024;
            mvp[q] = modv + (size_t)(p < CTXL ? 8 : b) * 6144;
#pragma unroll
            for (int j = 0; j < 4; ++j) xv[q][j] = *(const f32x4*)(src + 4 * (lane + 64 * j)); }
#pragma unroll
        for (int q = 0; q < 2; ++q)
#pragma unroll
            for (int j = 0; j < 4; ++j) { const int c = 4 * (lane + 64 * j); const f32x4 sh = *(const f32x4*)(mvp[q] + c), sc = *(const f32x4*)(mvp[q] + 1024 + c);
                const f32x4 y = xv[q][j] * (sc + 1.0f) + sh; v2u o; o.x = pk2(y[0], y[1]); o.y = pk2(y[2], y[3]); *(v2u*)(X + (size_t)(r0 + q) * 1024 + c) = o; }
    }
}

__device__ __forceinline__ void phase_norm0(const Args& a, int lane, int wave) {
    const int gw = blockIdx.x * NWAVES + wave, NGW = gridDim.x * NWAVES;
    const bf16* Z = (const bf16*)(a.ws + WS_Z); bf16* CQN = (bf16*)(a.ws + WS_CQN); bf16* CKVN = (bf16*)(a.ws + WS_CKVN); bf16* KRR = (bf16*)(a.ws + WS_KRR);
    const float* rope = (const float*)(a.ws + WS_ROPE);
    float gq[8], gk[8];
#pragma unroll
    for (int i = 0; i < 8; ++i) { gq[i] = lane < 48 ? a.in[I_QNORM][8 * lane + i] : 0.f; gk[i] = lane < 32 ? a.in[I_KVNORM][8 * lane + i] : 0.f; }
    for (int r = gw; r < NTOK; r += NGW) {
        const bf16* z = Z + (size_t)r * ZC; const int p = r % TPB;
        bf16x8 q8 = {}, k8 = {}, r8 = {};
        if (lane < 48) q8 = *(const bf16x8*)(z + ZQ + 8 * lane);
        if (lane < 32) k8 = *(const bf16x8*)(z + ZKV + 8 * lane);
        if (lane < 4) r8 = *(const bf16x8*)(z + ZKR + 8 * lane);
        float qf[8], kf[8], sq = 0.f, sk = 0.f;
#pragma unroll
        for (int i = 0; i < 8; ++i) { qf[i] = bf2f((unsigned short)q8[i]); kf[i] = bf2f((unsigned short)k8[i]); sq += qf[i] * qf[i]; sk += kf[i] * kf[i]; }
        sq = wave_sum(sq); sk = wave_sum(sk);
        const float rq = rsqrtf(sq * (1.f / 384.f) + RMS_EPS), rk = rsqrtf(sk * (1.f / 256.f) + RMS_EPS);
        if (lane < 48) { v4u o; o.x = pk2(qf[0] * rq * gq[0], qf[1] * rq * gq[1]); o.y = pk2(qf[2] * rq * gq[2], qf[3] * rq * gq[3]); o.z = pk2(qf[4] * rq * gq[4], qf[5] * rq * gq[5]); o.w = pk2(qf[6] * rq * gq[6], qf[7] * rq * gq[7]);
            *(v4u*)(CQN + (size_t)r * 384 + 8 * lane) = o; }
        if (lane < 32) { v4u o; o.x = pk2(kf[0] * rk * gk[0], kf[1] * rk * gk[1]); o.y = pk2(kf[2] * rk * gk[2], kf[3] * rk * gk[3]); o.z = pk2(kf[4] * rk * gk[4], kf[5] * rk * gk[5]); o.w = pk2(kf[6] * rk * gk[6], kf[7] * rk * gk[7]);
            *(v4u*)(CKVN + (size_t)r * 256 + 8 * lane) = o; }
        if (lane < 4) { bf16x8 o8 = r8; if (p >= CTXL) o8 = att::rope8(r8, rope + (size_t)(p - CTXL) * 32, 4 * lane); *(bf16x8*)(KRR + (size_t)r * 32 + 8 * lane) = o8; }
    }
}

__device__ __forceinline__ void hgrn_unit(const Args& a, int unit, LAS unsigned char* lds, int tid) {
    const int b = unit >> 5, head = (unit >> 3) & 3, dir = (unit >> 2) & 1, sl = unit & 3;
    const bf16* Z = (const bf16*)(a.ws + WS_Z);
    float* Od = (float*)(a.ws + (dir ? WS_OB : WS_OF));
    LAS float* lbv = (LAS float*)lds;
    constexpr int BUF0 = 1024, BUFSZ = 28672, OFF_Q = 16384, OFF_V = 24576;
    if (tid < 128) { const int c = head * 128 + tid; const float l0 = a.in[I_LBL][c], l1 = a.in[I_LBL][512 + c], l2 = a.in[I_LBL][1024 + c]; const float m = fmaxf(l0, fmaxf(l1, l2));
        const float e0 = __expf(l0 - m), e1 = __expf(l1 - m), e2 = __expf(l2 - m); lbv[tid] = e0 / (e0 + e1 + e2); }
    __syncthreads();
    const int lt = tid >> 4, lcg = tid & 15;
    float lb8[8];
#pragma unroll
    for (int i = 0; i < 8; ++i) lb8[i] = lbv[8 * lcg + i];
    const int fcol = (dir ? ZHB : ZHF) + head * 128 + 8 * lcg, qcol = ZHQ + head * 128 + 8 * lcg;
    const int vt = tid >> 2, vcol = ZHI + head * 128 + sl * 32 + (tid & 3) * 8;
    const int wave = tid >> 6, lane = tid & 63, vv = lane >> 4, cg = lane & 15, vloc = wave * 4 + vv;
    const size_t zb = (size_t)b * TPB;
    bf16x8 rq, rf, rv;
#define TOKP(n) (dir ? ((n) < CTXL ? (CTXL - 1 - (n)) : (TPB + CTXL - 1 - (n))) : (n))
#define HG_LOAD(i) do { const int n_ = 32 * (i) + lt; const bf16* zr_ = Z + (zb + TOKP(n_)) * ZC; rq = *(const bf16x8*)(zr_ + qcol); rf = *(const bf16x8*)(zr_ + fcol); \
        if (tid < 128) { const int n2_ = 32 * (i) + vt; rv = *(const bf16x8*)(Z + (zb + TOKP(n2_)) * ZC + vcol); } } while (0)
#define HG_WRITE(bufi) do { LAS unsigned char* bp_ = lds + BUF0 + (bufi) * BUFSZ; float f_[8]; \
        _Pragma("unroll") for (int i_ = 0; i_ < 8; ++i_) f_[i_] = lb8[i_] + (1.f - lb8[i_]) * sigm(bf2f((unsigned short)rf[i_])); \
        *(LAS f32x4*)(bp_ + ((lt * 128 + lcg * 4) * 4)) = (f32x4){f_[0], f_[1], f_[2], f_[3]}; *(LAS f32x4*)(bp_ + ((lt * 128 + 64 + lcg * 4) * 4)) = (f32x4){f_[4], f_[5], f_[6], f_[7]}; \
        *(LAS bf16x8*)(bp_ + OFF_Q + (lt * 128 + lcg * 8) * 2) = rq; \
        if (tid < 128) { float v_[8]; _Pragma("unroll") for (int i_ = 0; i_ < 8; ++i_) v_[i_] = bf2f((unsigned short)rv[i_]); \
            *(LAS f32x4*)(bp_ + OFF_V + (vt * 32 + (tid & 3) * 8) * 4) = (f32x4){v_[0], v_[1], v_[2], v_[3]}; *(LAS f32x4*)(bp_ + OFF_V + (vt * 32 + (tid & 3) * 8 + 4) * 4) = (f32x4){v_[4], v_[5], v_[6], v_[7]}; } } while (0)
    float S[8];
#pragma unroll
    for (int j = 0; j < 8; ++j) S[j] = 0.f;
    HG_LOAD(0); HG_WRITE(0); __syncthreads();
    const bool b3 = (cg & 8) != 0, b2 = (cg & 4) != 0, b1 = (cg & 2) != 0, b0 = (cg & 1) != 0;
    for (int i = 0; i < TPB / 32; ++i) {
        if (i + 1 < TPB / 32) HG_LOAD(i + 1);
        const LAS unsigned char* bp = lds + BUF0 + (i & 1) * BUFSZ;
#pragma unroll 1
        for (int g = 0; g < 4; ++g) {
            const LAS unsigned char* gp = bp + g * 8 * 512;
            float ot[8];
#pragma unroll
            for (int t = 0; t < 8; ++t) {
                const f32x4 f0 = *(const LAS f32x4*)(gp + ((t * 128 + cg * 4) * 4)), f1 = *(const LAS f32x4*)(gp + ((t * 128 + 64 + cg * 4) * 4));
                const bf16x8 q8 = *(const LAS bf16x8*)(bp + OFF_Q + ((g * 8 + t) * 128 + cg * 8) * 2);
                const float v = *(const LAS float*)(bp + OFF_V + ((g * 8 + t) * 32 + vloc) * 4);
                float acc = 0.f;
#pragma unroll
                for (int j = 0; j < 8; ++j) { const float fj = j < 4 ? f0[j] : f1[j - 4]; const float qj = bf2f((unsigned short)q8[j]);
                    const float kv = fmaf(-fj, v, v); S[j] = fmaf(fj, S[j], kv); acc = fmaf(S[j], qj, acc); }
                ot[t] = acc;
            }
#pragma unroll
            for (int k = 0; k < 4; ++k) { const float snd = b3 ? ot[k] : ot[k + 4]; const float rcv = __shfl_xor(snd, 8); ot[k] = (b3 ? ot[k + 4] : ot[k]) + rcv; }
#pragma unroll
            for (int k = 0; k < 2; ++k) { const float snd = b2 ? ot[k] : ot[k + 2]; const float rcv = __shfl_xor(snd, 4); ot[k] = (b2 ? ot[k + 2] : ot[k]) + rcv; }
            { const float snd = b1 ? ot[0] : ot[1]; const float rcv = __shfl_xor(snd, 2); ot[0] = (b1 ? ot[1] : ot[0]) + rcv; }
            ot[0] += __shfl_xor(ot[0], 1);
            if (!b0) { const int n = 32 * i + 8 * g + (cg >> 1); const int p = TOKP(n); if (p >= CTXL) Od[(zb + p) * 512 + head * 128 + sl * 32 + vloc] = ot[0]; }
        }
        if (i + 1 < TPB / 32) HG_WRITE((i + 1) & 1);
        __syncthreads();
    }
#undef TOKP
#undef HG_LOAD
#undef HG_WRITE
}

__device__ __forceinline__ void phase_readout(const Args& a, int lane, int wave) {
    const int gw = blockIdx.x * NWAVES + wave, NGW = gridDim.x * NWAVES;
    const bf16* OF = (const bf16*)(a.ws + WS_OF); const bf16* OB = (const bf16*)(a.ws + WS_OB);
    const bf16* Z = (const bf16*)(a.ws + WS_Z); bf16* MIX = (bf16*)(a.ws + WS_Y);
    float hn[8];
#pragma unroll
    for (int i = 0; i < 8; ++i) hn[i] = a.in[I_HGNORM][((8 * lane) & 127) + i];
    for (int lr = gw; lr < NLAT; lr += NGW) {
        const size_t r = (size_t)grow_of(lr);
        const bf16x8 a8 = *(const bf16x8*)(OF + r * 512 + 8 * lane), c8 = *(const bf16x8*)(OB + r * 512 + 8 * lane);
        const bf16x8 g8 = *(const bf16x8*)(Z + r * ZC + ZHG + 8 * lane);
        float o[8]; float ss = 0.f;
#pragma unroll
        for (int i = 0; i < 8; ++i) o[i] = bf2f((unsigned short)a8[i]) + bf2f((unsigned short)c8[i]);
#pragma unroll
        for (int i = 0; i < 8; ++i) ss += o[i] * o[i];
        ss += __shfl_xor(ss, 1); ss += __shfl_xor(ss, 2); ss += __shfl_xor(ss, 4); ss += __shfl_xor(ss, 8);
        const float rs = rsqrtf(ss * (1.f / 128.f) + RMS_EPS);
        float y[8];
#pragma unroll
        for (int i = 0; i < 8; ++i) { const float g = bf2f((unsigned short)g8[i]); y[i] = o[i] * rs * hn[i] * (g * sigm(g)); }
        v4u w; w.x = pk2(y[0], y[1]); w.y = pk2(y[2], y[3]); w.z = pk2(y[4], y[5]); w.w = pk2(y[6], y[7]);
        *(v4u*)(MIX + r * 1024 + 512 + 8 * lane) = w;
    }
}

__device__ __forceinline__ int rows_per_block() { const int G = gridDim.x; return (((NLAT + G - 1) / G) + 15) & ~15; }
__device__ __forceinline__ void phase_ln1(const Args& a, int l, LAS unsigned char* lds, int tid, int lane, int wave) {
    typedef short bf16x8s __attribute__((ext_vector_type(8)));
    const int RB = rows_per_block(), lr_base = blockIdx.x * RB;
    const bf16* PRE = (const bf16*)(a.ws + WS_PRE); bf16* XB = (bf16*)(a.ws + WS_X);
    const float* modv = (const float*)(a.ws + WS_MODV) + (size_t)l * 9 * 6144;
    const float* lng = a.in[I_LN1G] + l * 1024; const float* lnb = a.in[I_LN1B] + l * 1024;
    const float* rw = a.in[I_RW] + (size_t)l * 1024 * 32; const float* rb = a.in[I_RB] + l * 32;
    constexpr int XT_LD = 1028, O_PART = 16 * XT_LD * 4, O_LG = O_PART + 8 * 32 * 16 * 4, O_HIST = O_LG + 16 * 33 * 4 + 64, O_CCNT = O_HIST + 256, O_TIL = O_CCNT + 2048, O_TWL = O_TIL + 4096;
    LAS float* XT = (LAS float*)lds; LAS float* PART = (LAS float*)(lds + O_PART); LAS float* LG = (LAS float*)(lds + O_LG);
    LAS int* hist = (LAS int*)(lds + O_HIST);
    LAS int* ccnt = (LAS int*)(lds + O_CCNT);
    LAS int* til = (LAS int*)(lds + O_TIL);
    LAS float* twl = (LAS float*)(lds + O_TWL);
    __syncthreads();
    if (tid < 32) hist[tid] = 0;
    bf16x8s whi[2][4], wlo[2][4];
    { const int e15 = lane & 15, kq = lane >> 4;
#pragma unroll
      for (int t = 0; t < 2; ++t)
#pragma unroll
          for (int sI = 0; sI < 4; ++sI) { float wv[8];
#pragma unroll
              for (int j = 0; j < 8; ++j) wv[j] = rw[(size_t)(128 * wave + 32 * sI + 8 * kq + j) * 32 + 16 * t + e15];
              v4u ph, pl;
#pragma unroll
              for (int j = 0; j < 4; ++j) { const unsigned p = pk2(wv[2 * j], wv[2 * j + 1]); const float h0 = __uint_as_float(p << 16), h1 = __uint_as_float(p & 0xffff0000u); ph[j] = p; pl[j] = pk2(wv[2 * j] - h0, wv[2 * j + 1] - h1); }
              whi[t][sI] = __builtin_bit_cast(bf16x8s, ph); wlo[t][sI] = __builtin_bit_cast(bf16x8s, pl); } }
    const int ngroups = RB / 16;
    v2u xr[2][4];
#define LN1_LOAD(g) do { _Pragma("unroll") for (int rr_ = 0; rr_ < 2; ++rr_) { const int lr_ = lr_base + 16 * (g) + 2 * wave + rr_; const size_t r_ = (size_t)grow_of(lr_ < NLAT ? lr_ : NLAT - 1); \
        _Pragma("unroll") for (int j_ = 0; j_ < 4; ++j_) xr[rr_][j_] = *(const v2u*)(PRE + r_ * 1024 + 4 * (lane + 64 * j_)); } } while (0)
#if defined(PROBE_LN1X2)
    for (int rep_ = 0; rep_ < 2; ++rep_) { __syncthreads(); if (tid < 32) hist[tid] = 0; __syncthreads();
#endif
    LN1_LOAD(0);
    for (int g = 0; g < ngroups; ++g) {
#pragma unroll
        for (int rr = 0; rr < 2; ++rr) {
            const int lr = lr_base + 16 * g + 2 * wave + rr; const bool ok = lr < NLAT; const size_t r = (size_t)grow_of(ok ? lr : NLAT - 1); const int b = (ok ? lr : NLAT - 1) >> 12;
            const float* mv = modv + (size_t)b * 6144;
            f32x4 x[4]; float s = 0.f;
#pragma unroll
            for (int j = 0; j < 4; ++j) { const v2u p = xr[rr][j]; x[j] = (f32x4){__uint_as_float(p.x << 16), __uint_as_float(p.x & 0xffff0000u), __uint_as_float(p.y << 16), __uint_as_float(p.y & 0xffff0000u)}; s += (x[j][0] + x[j][1]) + (x[j][2] + x[j][3]); }
            const float mean = wave_sum(s) * (1.f / 1024.f); float s2 = 0.f;
#pragma unroll
            for (int j = 0; j < 4; ++j) { x[j] = x[j] - mean; s2 += (x[j][0] * x[j][0] + x[j][1] * x[j][1]) + (x[j][2] * x[j][2] + x[j][3] * x[j][3]); }
            const float rstd = rsqrtf(wave_sum(s2) * (1.f / 1024.f) + LN_EPS);
#pragma unroll
            for (int j = 0; j < 4; ++j) { const int c = 4 * (lane + 64 * j); const f32x4 gg = *(const f32x4*)(lng + c), bb = *(const f32x4*)(lnb + c);
                const f32x4 hv = x[j] * rstd * gg + bb;
                const f32x4 sh = *(const f32x4*)(mv + 3 * 1024 + c), sc = *(const f32x4*)(mv + 4 * 1024 + c);
                const f32x4 bm = hv * (sc + 1.0f) + sh;
                if (ok) *(unsigned*)((unsigned char*)XB + r * 1024 + c) = pack_fp8x4(bm[0] * SC_X8, bm[1] * SC_X8, bm[2] * SC_X8, bm[3] * SC_X8);
                *(LAS f32x4*)(XT + (2 * wave + rr) * XT_LD + c) = bm; }
        }
        if (g + 1 < ngroups) LN1_LOAD(g + 1);
        __syncthreads();
        { const int rr = lane & 15, kq = lane >> 4;
          f32x4 acc0 = {0.f, 0.f, 0.f, 0.f}, acc1 = {0.f, 0.f, 0.f, 0.f};
#pragma unroll
          for (int sI = 0; sI < 4; ++sI) { const LAS float* xp = XT + rr * XT_LD + 128 * wave + 32 * sI + 8 * kq; const f32x4 v0 = *(const LAS f32x4*)xp, v1 = *(const LAS f32x4*)(xp + 4);
              const float bv[8] = {v0[0], v0[1], v0[2], v0[3], v1[0], v1[1], v1[2], v1[3]}; v4u ph, pl;
#pragma unroll
              for (int j = 0; j < 4; ++j) { const unsigned p = pk2(bv[2 * j], bv[2 * j + 1]); const float h0 = __uint_as_float(p << 16), h1 = __uint_as_float(p & 0xffff0000u); ph[j] = p; pl[j] = pk2(bv[2 * j] - h0, bv[2 * j + 1] - h1); }
              const bf16x8s bh = __builtin_bit_cast(bf16x8s, ph), bl = __builtin_bit_cast(bf16x8s, pl);
              acc0 = __builtin_amdgcn_mfma_f32_16x16x32_bf16(whi[0][sI], bh, acc0, 0, 0, 0); acc0 = __builtin_amdgcn_mfma_f32_16x16x32_bf16(whi[0][sI], bl, acc0, 0, 0, 0); acc0 = __builtin_amdgcn_mfma_f32_16x16x32_bf16(wlo[0][sI], bh, acc0, 0, 0, 0);
              acc1 = __builtin_amdgcn_mfma_f32_16x16x32_bf16(whi[1][sI], bh, acc1, 0, 0, 0); acc1 = __builtin_amdgcn_mfma_f32_16x16x32_bf16(whi[1][sI], bl, acc1, 0, 0, 0); acc1 = __builtin_amdgcn_mfma_f32_16x16x32_bf16(wlo[1][sI], bh, acc1, 0, 0, 0); }
#pragma unroll
          for (int q = 0; q < 4; ++q) { PART[(wave * 32 + 4 * kq + q) * 16 + rr] = acc0[q]; PART[(wave * 32 + 16 + 4 * kq + q) * 16 + rr] = acc1[q]; } }
        __syncthreads();
        { const int e = tid >> 4, rr = tid & 15; float sacc = rb[e];
#pragma unroll
          for (int w = 0; w < 8; ++w) sacc += PART[(w * 32 + e) * 16 + rr];
          LG[rr * 33 + e] = sacc; }
        __syncthreads();
        if (wave == (g & 7) && lane < 16) { const int lr = lr_base + 16 * g + lane;
            if (lr < NLAT) { float lg[32];
#pragma unroll
                for (int e = 0; e < 32; ++e) lg[e] = LG[lane * 33 + e];
                unsigned taken = 0u; float tv[4]; int ti[4];
#pragma unroll
                for (int kk = 0; kk < 4; ++kk) { float best = -3.0e38f; int bi = 0;
#pragma unroll
                    for (int e = 0; e < 32; ++e) { const bool okk = (lg[e] > best) && !((taken >> e) & 1u); best = okk ? lg[e] : best; bi = okk ? e : bi; }
                    taken |= 1u << bi; tv[kk] = best; ti[kk] = bi; }
                const float e1 = __expf(tv[1] - tv[0]), e2 = __expf(tv[2] - tv[0]), e3 = __expf(tv[3] - tv[0]); const float inv = 1.f / (1.f + e1 + e2 + e3);
                const int li = (16 * g + lane) * 4; til[li] = ti[0]; til[li + 1] = ti[1]; til[li + 2] = ti[2]; til[li + 3] = ti[3]; twl[li] = inv; twl[li + 1] = e1 * inv; twl[li + 2] = e2 * inv; twl[li + 3] = e3 * inv;
                __hip_atomic_fetch_add(hist + ti[0], 1, __ATOMIC_RELAXED, __HIP_MEMORY_SCOPE_WORKGROUP); __hip_atomic_fetch_add(hist + ti[1], 1, __ATOMIC_RELAXED, __HIP_MEMORY_SCOPE_WORKGROUP);
                __hip_atomic_fetch_add(hist + ti[2], 1, __ATOMIC_RELAXED, __HIP_MEMORY_SCOPE_WORKGROUP); __hip_atomic_fetch_add(hist + ti[3], 1, __ATOMIC_RELAXED, __HIP_MEMORY_SCOPE_WORKGROUP); } }
    }
#if defined(PROBE_LN1X2)
    }
#endif
#undef LN1_LOAD
    __syncthreads();
    int* cursor = (int*)(a.ws + WS_CURSOR) + l * 32;
    int* rows = (int*)(a.ws + WS_ROWS); float* roww = (float*)(a.ws + WS_ROWW); int* rowd = (int*)(a.ws + WS_ROWD);
    int nrows = NLAT - lr_base; nrows = nrows > RB ? RB : nrows; if (nrows < 0) nrows = 0;
    const int nas = nrows * 4, nchunks = (nas + 63) >> 6;
    int basev = 0; if (tid < 32) basev = (int)__hip_atomic_fetch_add((unsigned*)cursor + tid, (unsigned)hist[tid], __ATOMIC_RELAXED, __HIP_MEMORY_SCOPE_AGENT);
    int myrank[2] = {0, 0}, mye[2] = {-1, -1};
#pragma unroll
    for (int cc = 0; cc < 2; ++cc) { const int c = wave + 8 * cc; if (c < nchunks) { const int idx = c * 64 + lane; const int e = idx < nas ? til[idx] : -1; mye[cc] = e;
        for (int x = 0; x < 32; ++x) { const unsigned long long m = __ballot(e == x); if (e == x) myrank[cc] = __popcll(m & ((1ull << lane) - 1ull)); if (lane == 0) ccnt[c * 32 + x] = __popcll(m); } } }
    __syncthreads();
    if (tid < 32) hist[32 + tid] = basev;
    __syncthreads();
#pragma unroll
    for (int cc = 0; cc < 2; ++cc) { const int c = wave + 8 * cc; const int idx = c * 64 + lane; if (c < nchunks && idx < nas) { const int e = mye[cc]; int pos = hist[32 + e] + myrank[cc]; for (int c2 = 0; c2 < c; ++c2) pos += ccnt[c2 * 32 + e];
        const int lr = lr_base + (idx >> 2); const size_t pi = (size_t)e * ECAP + pos; rows[pi] = grow_of(lr); roww[pi] = twl[idx]; rowd[pi] = lr * 4 + (idx & 3); } }
}

__device__ __forceinline__ void phase_ln2(const Args& a, int l, int lane, int wave) {
    const int gw = blockIdx.x * NWAVES + wave, NGW = gridDim.x * NWAVES;
    float* H = (float*)(a.ws + WS_H); const bf16* PRE = (const bf16*)(a.ws + WS_PRE); const unsigned char* YB = (const unsigned char*)(a.ws + WS_YB); bf16* A1 = (bf16*)(a.ws + WS_Y);
    const float* modv = (const float*)(a.ws + WS_MODV);
    const float* ln1g = a.in[I_LN1G] + l * 1024; const float* ln1b = a.in[I_LN1B] + l * 1024;
    const float* lng = a.in[I_LN2G] + l * 1024; const float* lnb = a.in[I_LN2B] + l * 1024;
    for (int lr0 = 2 * gw; lr0 < NLAT; lr0 += 2 * NGW) {
        v2u hv[2][4]; unsigned yv[2][4][4];
#pragma unroll
        for (int q = 0; q < 2; ++q) { const int lr = lr0 + q; const size_t r = (size_t)grow_of(lr);
#pragma unroll
            for (int j = 0; j < 4; ++j) { const int c = 4 * (lane + 64 * j); hv[q][j] = *(const v2u*)(PRE + r * 1024 + c);
#pragma unroll
                for (int k = 0; k < 4; ++k) yv[q][j][k] = *(const unsigned*)(YB + ((size_t)lr * 4 + k) * 1024 + c); } }
#pragma unroll
        for (int q = 0; q < 2; ++q) {
            const int lr = lr0 + q; const size_t r = (size_t)grow_of(lr); const int b = lr >> 12;
            const float* mv = modv + ((size_t)l * 9 + b) * 6144; const float* mv1 = modv + ((size_t)9 + b) * 6144;
            f32x4 x[4]; float s = 0.f;
#pragma unroll
            for (int j = 0; j < 4; ++j) { const v2u p = hv[q][j]; x[j] = (f32x4){__uint_as_float(p.x << 16), __uint_as_float(p.x & 0xffff0000u), __uint_as_float(p.y << 16), __uint_as_float(p.y & 0xffff0000u)}; s += (x[j][0] + x[j][1]) + (x[j][2] + x[j][3]); }
            float mean = wave_sum(s) * (1.f / 1024.f), s2 = 0.f;
#pragma unroll
            for (int j = 0; j < 4; ++j) { x[j] = x[j] - mean; s2 += (x[j][0] * x[j][0] + x[j][1] * x[j][1]) + (x[j][2] * x[j][2] + x[j][3] * x[j][3]); }
            float rstd = rsqrtf(wave_sum(s2) * (1.f / 1024.f) + LN_EPS);
            s = 0.f;
#pragma unroll
            for (int j = 0; j < 4; ++j) { const int c = 4 * (lane + 64 * j); const f32x4 g = *(const f32x4*)(ln1g + c), bb = *(const f32x4*)(ln1b + c);
                const f32x4 h1 = x[j] * rstd * g + bb; f32x4 f = {0.f, 0.f, 0.f, 0.f};
#pragma unroll
                for (int k = 0; k < 4; ++k) { const unsigned y = yv[q][j][k]; const auto lo = __builtin_amdgcn_cvt_pk_f32_fp8((int)y, false), hi = __builtin_amdgcn_cvt_pk_f32_fp8((int)y, true);
                    f[0] += lo[0]; f[1] += lo[1]; f[2] += hi[0]; f[3] += hi[1]; }
                const f32x4 gt = *(const f32x4*)(mv + 5 * 1024 + c);
                x[j] = h1 * ALPHA + gt * (f * (1.f / SC_Y)); s += (x[j][0] + x[j][1]) + (x[j][2] + x[j][3]); }
            mean = wave_sum(s) * (1.f / 1024.f); s2 = 0.f;
#pragma unroll
            for (int j = 0; j < 4; ++j) { x[j] = x[j] - mean; s2 += (x[j][0] * x[j][0] + x[j][1] * x[j][1]) + (x[j][2] * x[j][2] + x[j][3] * x[j][3]); }
            rstd = rsqrtf(wave_sum(s2) * (1.f / 1024.f) + LN_EPS);
#pragma unroll
            for (int j = 0; j < 4; ++j) { const int c = 4 * (lane + 64 * j); const f32x4 g = *(const f32x4*)(lng + c), bb = *(const f32x4*)(lnb + c);
                const f32x4 o = x[j] * rstd * g + bb;
                if (l == 0) { *(f32x4*)(H + r * 1024 + c) = o; const f32x4 sh = *(const f32x4*)(mv1 + c), sc = *(const f32x4*)(mv1 + 1024 + c);
                    const f32x4 am = (o * (sc + 1.0f) + sh) * SC_A1; *(unsigned*)((unsigned char*)A1 + r * 1024 + c) = pack_fp8x4(am[0], am[1], am[2], am[3]); }
                else *(f32x4*)(a.out + (size_t)lr * 1024 + c) = o; }
        }
    }
}

__device__ __forceinline__ void phase_conv(const Args& a, LAS unsigned char* lds, int tid, int lane, int wave) {
    const bf16* U = (const bf16*)(a.ws + WS_X); bf16* V = (bf16*)(a.ws + WS_Y);
    LAS float* part = (LAS float*)(lds + 126976);
    LAS float* st = part + 512;
    const int c0 = 2 * tid;
    const float db0 = a.in[I_DWB][c0], db1 = a.in[I_DWB][c0 + 1], g0 = a.in[I_CLNG][c0], g1 = a.in[I_CLNG][c0 + 1], be0 = a.in[I_CLNB][c0], be1 = a.in[I_CLNB][c0 + 1];
    for (int tile = blockIdx.x; tile < NLAT / 32; tile += gridDim.x) {
        const int b = tile >> 7, t0 = (tile & 127) * 32;
        const size_t rb0 = (size_t)b * TPB + CTXL;
        __syncthreads();
        for (int i = tid; i < 62 * 128; i += NTHR) { const int row = i >> 7, chk = i & 127, t = t0 - 15 + row;
            v4u val = {0u, 0u, 0u, 0u}; if (t >= 0 && t < SEQ) val = *(const v4u*)(U + (rb0 + t) * 1024 + chk * 8);
            *(LAS v4u*)(lds + row * 2048 + chk * 16) = val; }
        __syncthreads();
        float w0[31], w1[31];
#pragma unroll
        for (int j = 0; j < 31; ++j) { const float2 wv = *(const float2*)(a.in[I_DWW] + j * 1024 + c0); w0[j] = wv.x; w1[j] = wv.y; }
#pragma unroll 1
        for (int hh = 0; hh < 2; ++hh) {
            const LAS unsigned char* hp = lds + hh * 16 * 2048;
            float acc0[16], acc1[16];
#pragma unroll
            for (int t = 0; t < 16; ++t) { acc0[t] = db0; acc1[t] = db1; }
#pragma unroll
            for (int s = 0; s < 46; ++s) { const unsigned pr = *(const LAS unsigned*)(hp + s * 2048 + tid * 4); const float x0 = __uint_as_float(pr << 16), x1 = __uint_as_float(pr & 0xffff0000u);
#pragma unroll
                for (int t = (s > 30 ? s - 30 : 0); t <= (s < 15 ? s : 15); ++t) { acc0[t] = fmaf(x0, w0[s - t], acc0[t]); acc1[t] = fmaf(x1, w1[s - t], acc1[t]); } }
            float rs[32];
#pragma unroll
            for (int t = 0; t < 16; ++t) { rs[2 * t] = acc0[t] + acc1[t]; rs[2 * t + 1] = acc0[t] * acc0[t] + acc1[t] * acc1[t]; }
#define RS_STEP(NKEEP, XORV) { const bool bit_ = (lane & XORV) != 0; _Pragma("unroll") for (int k_ = 0; k_ < NKEEP; ++k_) { const float snd_ = bit_ ? rs[k_] : rs[k_ + NKEEP]; const float rcv_ = __shfl_xor(snd_, XORV); rs[k_] = (bit_ ? rs[k_ + NKEEP] : rs[k_]) + rcv_; } }
            RS_STEP(16, 32) RS_STEP(8, 16) RS_STEP(4, 8) RS_STEP(2, 4) RS_STEP(1, 2)
#undef RS_STEP
            rs[0] += __shfl_xor(rs[0], 1);
            __syncthreads();
            if ((lane & 1) == 0) part[wave * 32 + (lane >> 1)] = rs[0];
            __syncthreads();
            if (tid < 16) { float s1 = 0.f, s2 = 0.f;
#pragma unroll
                for (int w = 0; w < 8; ++w) { s1 += part[w * 32 + 2 * tid]; s2 += part[w * 32 + 2 * tid + 1]; }
                const float mean = s1 * (1.f / 1024.f); const float var = fmaxf(s2 * (1.f / 1024.f) - mean * mean, 0.f); st[2 * tid] = mean; st[2 * tid + 1] = rsqrtf(var + LN_EPS); }
            __syncthreads();
#pragma unroll
            for (int t = 0; t < 16; ++t) { const float mean = st[2 * t], rstd = st[2 * t + 1];
                const float y0 = (acc0[t] - mean) * rstd * g0 + be0, y1 = (acc1[t] - mean) * rstd * g1 + be1;
                const float z0 = fminf(fmaxf(y0 * sigm(y0) * SC_CV, -448.f), 448.f), z1 = fminf(fmaxf(y1 * sigm(y1) * SC_CV, -448.f), 448.f);
                *(unsigned short*)((unsigned char*)V + (rb0 + t0 + hh * 16 + t) * 1024 + c0) = (unsigned short)__builtin_amdgcn_cvt_pk_fp8_f32(z0, z1, 0, false); }
        }
    }
}

namespace hg {
using bf16x8 = __attribute__((ext_vector_type(8))) short;
using s16x4  = __attribute__((ext_vector_type(4))) short;
using f32x16 = __attribute__((ext_vector_type(16))) float;
using u32x4  = __attribute__((ext_vector_type(4))) unsigned;
constexpr int RS = 272;
constexpr int VS = 80;
constexpr int T_Q = 0, T_KO = 32 * RS, T_KE = 64 * RS, T_D = 96 * RS, IMG_BYTES = T_D + 512, T_V = IMG_BYTES, TILE_BYTES = T_V + 32 * VS;
constexpr int OFF_TILES = 1024, NTB = 3, OFF_OPART = OFF_TILES + NTB * TILE_BYTES, OPART_BYTES = 4 * 4096;
static_assert(OFF_OPART + 2 * OPART_BYTES <= 131072 && IMG_BYTES % 16 == 0 && IMG_BYTES / 16 == 1664, "hgrn lds");
constexpr int P_RAW = 1024, R_Q = 0, R_F = 32 * RS, RAW_BYTES = 64 * RS, P_IMG = P_RAW + RAW_BYTES;
constexpr int NCHUNK = TPB / 32, NCHAIN = NB * 4 * 2, NITEM = NCHAIN * NCHUNK;
__device__ __forceinline__ int crow(int r, int hi) { return (r & 3) + 8 * (r >> 2) + 4 * hi; }
__device__ __forceinline__ s16x4 tr_read(unsigned addr) { s16x4 r; asm volatile("ds_read_b64_tr_b16 %0, %1" : "=&v"(r) : "v"(addr) : "memory"); return r; }
__device__ __forceinline__ bf16x8 cat8(s16x4 l, s16x4 h) { return (bf16x8){l[0], l[1], l[2], l[3], h[0], h[1], h[2], h[3]}; }
__device__ __forceinline__ bf16x8 pack8(const f32x16& x, int base) {
    u32x4 w; w[0] = pk2(x[base + 0], x[base + 1]); w[1] = pk2(x[base + 2], x[base + 3]); w[2] = pk2(x[base + 4], x[base + 5]); w[3] = pk2(x[base + 6], x[base + 7]);
    return *reinterpret_cast<bf16x8*>(&w);
}
}


#define HG_TOKP(dir, n) ((dir) ? ((n) < CTXL ? (CTXL - 1 - (n)) : (TPB + CTXL - 1 - (n))) : (n))
#define HG_DPP1(x, ctrl, rmask) __int_as_float(__builtin_amdgcn_update_dpp(0x3f800000, __float_as_int(x), ctrl, rmask, 0xf, false))
#define HG_DPP(x, ctrl, rmask) __int_as_float(__builtin_amdgcn_update_dpp(0, __float_as_int(x), ctrl, rmask, 0xf, false))
__device__ __forceinline__ void hgrn_prep_items(const Args& a, LAS unsigned char* lds, int tid) {
    using namespace hg;
    const bf16* Z = (const bf16*)(a.ws + WS_Z);
    unsigned char* HT = a.ws + WS_HT;
    const int wave = __builtin_amdgcn_readfirstlane(tid >> 6), lane = tid & 63, t = lane & 31, half = lane >> 5;
    const int c0 = 16 * wave + 8 * half;
    const int lr = tid >> 4, lch = tid & 15;
    LAS float* lbt = (LAS float*)lds;
    constexpr int P_RAW2 = 2048, P_IMG2 = P_RAW2 + 2 * RAW_BYTES;
    static_assert(P_IMG2 + 2 * IMG_BYTES <= 131072, "prep lds");
    __syncthreads();
    { const float l0 = a.in[I_LBL][tid], l1 = a.in[I_LBL][512 + tid], l2 = a.in[I_LBL][1024 + tid]; const float m = fmaxf(l0, fmaxf(l1, l2));
      const float e0 = __expf(l0 - m), e1 = __expf(l1 - m), e2 = __expf(l2 - m); lbt[tid] = e0 / (e0 + e1 + e2); }
    bf16x8 gq, gf;
#define HP_LOAD(it) do { const int ch_ = (it) % NCHUNK, cn_ = (it) / NCHUNK, dir_ = cn_ & 1, hd_ = (cn_ >> 1) & 3, b_ = cn_ >> 3; \
        const bf16* zr_ = Z + ((size_t)b_ * TPB + HG_TOKP(dir_, 32 * ch_ + lr)) * ZC; gq = *(const bf16x8*)(zr_ + ZHQ + hd_ * 128 + lch * 8); gf = *(const bf16x8*)(zr_ + (dir_ ? ZHB : ZHF) + hd_ * 128 + lch * 8); } while (0)
#define HP_STASH(bufi) do { LAS unsigned char* rb_ = lds + P_RAW2 + (bufi) * RAW_BYTES; *(LAS bf16x8*)(rb_ + R_Q + lr * RS + lch * 16) = gq; *(LAS bf16x8*)(rb_ + R_F + lr * RS + lch * 16) = gf; } while (0)
#define HP_COPYOUT(item, bufi) do { v4u* dst_ = (v4u*)(HT + (size_t)(item) * IMG_BYTES); const LAS v4u* src_ = (const LAS v4u*)(lds + P_IMG2 + (bufi) * IMG_BYTES); \
        dst_[tid] = src_[tid]; dst_[tid + 512] = src_[tid + 512]; dst_[tid + 1024] = src_[tid + 1024]; if (tid < 128) dst_[tid + 1536] = src_[tid + 1536]; } while (0)
    const int G = gridDim.x;
    int it = blockIdx.x, par = 0;
    if (it < NITEM) { HP_LOAD(it); HP_STASH(0); }
    if (it + G < NITEM) HP_LOAD(it + G);
    __syncthreads();
    for (; it < NITEM; it += G, par ^= 1) {
        if (it + G < NITEM) HP_STASH(par ^ 1);
        if (it != (int)blockIdx.x) HP_COPYOUT(it - G, par ^ 1);
        if (it + 2 * G < NITEM) HP_LOAD(it + 2 * G);
        const int hd = ((it / NCHUNK) >> 1) & 3;
        {
            const LAS unsigned char* rb_ = lds + P_RAW2 + par * RAW_BYTES;
            const bf16x8 RQ = *(const LAS bf16x8*)(rb_ + R_Q + t * RS + c0 * 2), RF = *(const LAS bf16x8*)(rb_ + R_F + t * RS + c0 * 2);
            const f32x4 lbA = *(const LAS f32x4*)(lbt + hd * 128 + c0), lbB = *(const LAS f32x4*)(lbt + hd * 128 + c0 + 4);
            LAS unsigned char* tb_ = lds + P_IMG2 + par * IMG_BYTES;
            float bb_[8], kk_[8];
#pragma unroll
            for (int i_ = 0; i_ < 8; ++i_) { const float lb_ = i_ < 4 ? lbA[i_] : lbB[i_ - 4]; const float f_ = lb_ + (1.f - lb_) * __builtin_amdgcn_rcpf(1.f + __expf(-bf2f((unsigned short)RF[i_]))); kk_[i_] = 1.f - f_; bb_[i_] = f_; }
#pragma unroll
            for (int i_ = 0; i_ < 8; ++i_) { float x_ = bb_[i_]; x_ *= HG_DPP1(x_, 0x111, 0xf); x_ *= HG_DPP1(x_, 0x112, 0xf); x_ *= HG_DPP1(x_, 0x114, 0xf); x_ *= HG_DPP1(x_, 0x118, 0xf);
                x_ *= HG_DPP1(x_, 0x142, 0xa); bb_[i_] = x_; }
            float qi_[8], ko_[8], ke_[8], dd_[8];
#pragma unroll
            for (int i_ = 0; i_ < 8; ++i_) { const int bi_ = __float_as_int(bb_[i_]); dd_[i_] = __int_as_float(half ? __builtin_amdgcn_readlane(bi_, 63) : __builtin_amdgcn_readlane(bi_, 31));
                const float e_ = bb_[i_]; const float ei_ = __builtin_amdgcn_rcpf(e_);
                qi_[i_] = bf2f((unsigned short)RQ[i_]) * e_; ko_[i_] = kk_[i_] * ei_; ke_[i_] = kk_[i_] * (dd_[i_] * ei_); }
            *(LAS v4u*)(tb_ + T_Q + t * RS + c0 * 2) = (v4u){pk2(qi_[0], qi_[1]), pk2(qi_[2], qi_[3]), pk2(qi_[4], qi_[5]), pk2(qi_[6], qi_[7])};
            *(LAS v4u*)(tb_ + T_KO + t * RS + c0 * 2) = (v4u){pk2(ko_[0], ko_[1]), pk2(ko_[2], ko_[3]), pk2(ko_[4], ko_[5]), pk2(ko_[6], ko_[7])};
            *(LAS v4u*)(tb_ + T_KE + t * RS + c0 * 2) = (v4u){pk2(ke_[0], ke_[1]), pk2(ke_[2], ke_[3]), pk2(ke_[4], ke_[5]), pk2(ke_[6], ke_[7])};
            if (t == 31) { *(LAS f32x4*)(tb_ + T_D + c0 * 4) = (f32x4){dd_[0], dd_[1], dd_[2], dd_[3]}; *(LAS f32x4*)(tb_ + T_D + c0 * 4 + 16) = (f32x4){dd_[4], dd_[5], dd_[6], dd_[7]}; }
            if (tid < 32) *(LAS v4u*)(tb_ + T_Q + tid * RS + 256) = (v4u){0u, 0u, 0u, 0u};
            else if (tid < 64) *(LAS v4u*)(tb_ + T_KO + (tid - 32) * RS + 256) = (v4u){0u, 0u, 0u, 0u};
            else if (tid < 96) *(LAS v4u*)(tb_ + T_KE + (tid - 64) * RS + 256) = (v4u){0u, 0u, 0u, 0u};
        }
        __syncthreads();
    }
    if (it - G >= (int)blockIdx.x && it - G < NITEM) HP_COPYOUT(it - G, par ^ 1);
    __syncthreads();
#undef HP_COPYOUT
#undef HP_LOAD
#undef HP_STASH
}

__device__ __forceinline__ void hgrn_unit_mfma(const Args& a, int unit, LAS unsigned char* lds, int tid) {
    using namespace hg;
    const int b = unit >> 5, head = (unit >> 3) & 3, dir = (unit >> 2) & 1, sl = unit & 3;
    const bf16* Z = (const bf16*)(a.ws + WS_Z);
    const unsigned char* HT = a.ws + WS_HT + (size_t)((b * 4 + head) * 2 + dir) * NCHUNK * IMG_BYTES;
    bf16* Od = (bf16*)(a.ws + (dir ? WS_OB : WS_OF));
    const int wave = __builtin_amdgcn_readfirstlane(tid >> 6), lane = tid & 63;
    const size_t zb = (size_t)b * TPB;
    constexpr int NCH = NCHUNK;
    const int vr = (tid >> 2) & 31, vp = tid & 3, lvcol = ZHI + head * 128 + sl * 32 + vp * 8, i3 = 1536 + (tid & 127);
    v4u gA0, gA1, gA2, gA3, gB0, gB1, gB2, gB3; bf16x8 gAv, gBv;
#define HG_LOAD(g0, g1, g2, g3, gv, ch) do { const int c_ = (ch) < NCH ? (ch) : NCH - 1; const v4u* src_ = (const v4u*)(HT + (size_t)c_ * IMG_BYTES); \
        g0 = src_[tid]; g1 = src_[tid + 512]; g2 = src_[tid + 1024]; g3 = src_[i3]; gv = *(const bf16x8*)(Z + (zb + HG_TOKP(dir, 32 * c_ + vr)) * ZC + lvcol); } while (0)
#define HG_STASH(g0, g1, g2, g3, gv, bufi) do { LAS unsigned char* tb_ = lds + OFF_TILES + (bufi) * TILE_BYTES; LAS v4u* d_ = (LAS v4u*)tb_; \
        d_[tid] = g0; d_[tid + 512] = g1; d_[tid + 1024] = g2; if (tid < 128) { d_[tid + 1536] = g3; *(LAS bf16x8*)(tb_ + T_V + vr * VS + vp * 16) = gv; } } while (0)
    const int r32 = lane & 31, hi = lane >> 5, g1 = (lane >> 4) & 1, q4 = (lane & 15) >> 2, p4 = lane & 3, cb = 32 * wave;
    const unsigned lbase = (unsigned)(uintptr_t)lds;
    f32x16 S = {};
    HG_LOAD(gA0, gA1, gA2, gA3, gAv, 0); HG_STASH(gA0, gA1, gA2, gA3, gAv, 0); HG_LOAD(gA0, gA1, gA2, gA3, gAv, 1); HG_STASH(gA0, gA1, gA2, gA3, gAv, 1);
    HG_LOAD(gA0, gA1, gA2, gA3, gAv, 2);
    __syncthreads();
#define HG_RD64(dst, addr, OFFS) asm volatile("ds_read_b64 %0, %1 offset:" #OFFS : "=&v"(dst) : "v"(addr) : "memory")
#define HG_MFMA_STAGE(n, bufi) do { \
            const unsigned tb = lbase + OFF_TILES + (bufi) * TILE_BYTES; const LAS unsigned char* tl_ = lds + OFF_TILES + (bufi) * TILE_BYTES; \
            bf16x8 ko[2], qi[2]; s16x4 pvl[2], pvh[2], pql[2], pqh[2], kl[2], kh[2], nvl[2], nvh[2]; f32x4 dsc[4]; \
            _Pragma("unroll") for (int kk = 0; kk < 2; ++kk) { ko[kk] = *(const LAS bf16x8*)(tl_ + T_KO + r32 * RS + (cb + 16 * kk + 8 * hi) * 2); qi[kk] = *(const LAS bf16x8*)(tl_ + T_Q + r32 * RS + (cb + 16 * kk + 8 * hi) * 2); } \
            _Pragma("unroll") for (int sp = 0; sp < 2; ++sp) { \
                const unsigned va = tb + T_V + (16 * sp + 4 * hi + q4) * VS + (16 * g1 + 4 * p4) * 2; pvl[sp] = tr_read(va); pvh[sp] = tr_read(va + 8 * VS);              \
                const unsigned qa = tb + T_Q + r32 * RS + (cb + 16 * sp + 4 * hi) * 2; HG_RD64(pql[sp], qa, 0); HG_RD64(pqh[sp], qa, 16);                                  \
                const unsigned ka = tb + T_KE + (16 * sp + 8 * hi + q4) * RS + (cb + 16 * g1 + 4 * p4) * 2; kl[sp] = tr_read(ka); kh[sp] = tr_read(ka + 4 * RS);        \
                const unsigned vb = tb + T_V + (16 * sp + 8 * hi + q4) * VS + (16 * g1 + 4 * p4) * 2; nvl[sp] = tr_read(vb); nvh[sp] = tr_read(vb + 4 * VS); }            \
            _Pragma("unroll") for (int g = 0; g < 4; ++g) dsc[g] = *(const LAS f32x4*)(tl_ + T_D + (cb + 8 * g + 4 * hi) * 4); \
            asm volatile("s_waitcnt lgkmcnt(0)" ::: "memory"); __builtin_amdgcn_sched_barrier(0); \
            f32x16 X = {}; \
            X = __builtin_amdgcn_mfma_f32_32x32x16_bf16(ko[0], qi[0], X, 0, 0, 0); X = __builtin_amdgcn_mfma_f32_32x32x16_bf16(ko[1], qi[1], X, 0, 0, 0); \
            f32x16 O = {}; \
            O = __builtin_amdgcn_mfma_f32_32x32x16_bf16(cat8(pql[0], pqh[0]), pack8(S, 0), O, 0, 0, 0); O = __builtin_amdgcn_mfma_f32_32x32x16_bf16(cat8(pql[1], pqh[1]), pack8(S, 8), O, 0, 0, 0); \
            _Pragma("unroll") for (int i = 0; i < 16; ++i) S[i] *= dsc[i >> 2][i & 3]; \
            S = __builtin_amdgcn_mfma_f32_32x32x16_bf16(cat8(kl[0], kh[0]), cat8(nvl[0], nvh[0]), S, 0, 0, 0); S = __builtin_amdgcn_mfma_f32_32x32x16_bf16(cat8(kl[1], kh[1]), cat8(nvl[1], nvh[1]), S, 0, 0, 0); \
            _Pragma("unroll") for (int i = 0; i < 16; ++i) X[i] = (crow(i, hi) <= r32) ? X[i] : 0.f; \
            O = __builtin_amdgcn_mfma_f32_32x32x16_bf16(pack8(X, 0), cat8(pvl[0], pvh[0]), O, 0, 0, 0); O = __builtin_amdgcn_mfma_f32_32x32x16_bf16(pack8(X, 8), cat8(pvl[1], pvh[1]), O, 0, 0, 0); \
            LAS float* op = (LAS float*)(lds + OFF_OPART + ((n) & 1) * OPART_BYTES + wave * 4096); \
            _Pragma("unroll") for (int i = 0; i < 16; ++i) op[crow(i, hi) * 32 + r32] = O[i]; } while (0)
#define HG_OUT_STAGE(n) do { \
            const int l2 = tid - 256, tt = l2 >> 3, vq = l2 & 7; \
            const LAS float* op = (const LAS float*)(lds + OFF_OPART + (((n) - 1) & 1) * OPART_BYTES) + tt * 32 + vq * 4; \
            const f32x4 s = (*(const LAS f32x4*)op + *(const LAS f32x4*)(op + 1024)) + (*(const LAS f32x4*)(op + 2048) + *(const LAS f32x4*)(op + 3072)); \
            const int p = HG_TOKP(dir, 32 * ((n) - 1) + tt); \
            if (p >= CTXL) *(v2u*)(Od + (zb + p) * 512 + head * 128 + sl * 32 + vq * 4) = (v2u){pk2(s[0], s[1]), pk2(s[2], s[3])}; } while (0)
#define HG_ITER(n, L0, L1, L2, L3, LV, S0, S1, S2, S3, SV) do { \
        HG_LOAD(L0, L1, L2, L3, LV, (n) + 3); \
        if (wave < 4) { HG_MFMA_STAGE(n, bcur); } else if ((n) > 0) { HG_OUT_STAGE(n); } \
        { const int bst_ = bcur == 0 ? 2 : bcur - 1; HG_STASH(S0, S1, S2, S3, SV, bst_); } \
        bcur = bcur == 2 ? 0 : bcur + 1; \
        __syncthreads(); } while (0)
    int bcur = 0;
    for (int n = 0; n < NCH; n += 2) {
        HG_ITER(n, gB0, gB1, gB2, gB3, gBv, gA0, gA1, gA2, gA3, gAv);
        HG_ITER(n + 1, gA0, gA1, gA2, gA3, gAv, gB0, gB1, gB2, gB3, gBv);
    }
    if (wave >= 4) { HG_OUT_STAGE(NCH); }
    __syncthreads();
#undef HG_MFMA_STAGE
#undef HG_OUT_STAGE
#undef HG_ITER
#undef HG_LOAD
#undef HG_STASH
#undef HG_RD64
}

__device__ __forceinline__ bool in_range(int lo, int hi, int k) { asm volatile("" : "+s"(lo), "+s"(hi)); return lo <= k && k < hi; }
constexpr int NPHASES = 21;
__global__ void __launch_bounds__(NTHR, 2) fwd_kernel(Args args) {
    extern __shared__ __attribute__((aligned(16))) unsigned char lds_raw[];
    LAS unsigned char* lds = (LAS unsigned char*)lds_raw;
    const int G = gridDim.x;
#define FRESH() int tid = threadIdx.x; asm volatile("" : "+v"(tid)); const int lane = tid & 63, wave = __builtin_amdgcn_readfirstlane(tid >> 6); (void)lane; (void)wave
    unsigned char* ws = args.ws;
    if (threadIdx.x < 16) ((LAS unsigned*)(lds + LDS_BAR_OFF))[threadIdx.x] = 0u;
    __syncthreads();
    XcdBarrier bar = xcd_barrier_post((unsigned*)(ws + WS_CTL), (volatile LAS unsigned*)(lds + LDS_BAR_OFF));
    const int lo = args.ph_lo, hi = args.ph_hi;
#define IN(k) in_range(lo, hi, (k))
#define NREP(k) (((PROBE_MASK >> (k)) & 1u) ? 2 : 1)
#define REPEAT(k) for (int rep_ = 0; rep_ < NREP(k); ++rep_) if (rep_ == 0 || (xcd_barrier(bar), true))
#define SEAM(k) do { if (IN(k) && IN((k) + 1)) xcd_barrier(bar); } while (0)
    bf16* const BX = (bf16*)(ws + WS_X); bf16* const BY = (bf16*)(ws + WS_Y);
    const float* const MODV = (const float*)(ws + WS_MODV);

#if defined(PROBE_BARS)
    for (int pbi = 0; pbi < PROBE_BARS; ++pbi) xcd_barrier(bar);
#endif
    if (IN(0)) REPEAT(0) { FRESH(); phase_prologue(args, lds, tid, lane, wave); } SEAM(0);
    if (IN(1)) REPEAT(1) { FRESH(); phase_mod0(args, lane, wave); } SEAM(1);
    if (IN(2)) REPEAT(2) {
        pg8::Gemm g{BX, (const bf16*)(ws + WS_WIN), NTOK, ZC, 1024}; pg8::AllOrder S; S.init(NTOK / 256, ZC / 256, G, (int)blockIdx.x);
        pg8::EpiBf16<0> E{(bf16*)(ws + WS_Z), ZC, nullptr, 0, 0, 1.f};
        pg8::gemm_phase<pg8::EpiBf16<0>, pg8::AllOrder, PG8_ALIGN, PG8_SP2>(lds, g, S, E);
    } SEAM(2);
    if (IN(3)) REPEAT(3) { FRESH(); phase_norm0(args, lane, wave); hgrn_prep_items(args, lds, tid); } SEAM(3);
    if (IN(4)) REPEAT(4) {
        { pg8::Gemm g{(const bf16*)(ws + WS_CQN), (const bf16*)(ws + WS_WUQ), NTOK, 768, 384}; pg8::LatOrder S; S.init(128, 3, G, (int)blockIdx.x);
          pg8::EpiBf16<0> E{(bf16*)(ws + WS_Q), 768, nullptr, 0, 0, 1.f};
          pg8::gemm_phase<pg8::EpiBf16<0>, pg8::LatOrder, PG8_ALIGN, PG8_SP2>(lds, g, S, E); }
        __syncthreads();
        { pg8::Gemm g{(const bf16*)(ws + WS_CKVN), (const bf16*)(ws + WS_WUKV), NTOK, 1024, 256}; pg8::AllOrder S; S.init(NTOK / 256, 4, G, G - 1 - (int)blockIdx.x);
          pg8::EpiBf16<0> E{(bf16*)(ws + WS_KV), 1024, nullptr, 0, 0, 1.f};
          pg8::gemm_phase<pg8::EpiBf16<0>, pg8::AllOrder, PG8_ALIGN, PG8_SP2>(lds, g, S, E); }
    } SEAM(4);
    if (IN(5)) {
        REPEAT(21) { FRESH();
        for (int u = blockIdx.x; u < 256; u += G) { __syncthreads(); hgrn_unit_mfma(args, (G == 256) ? ((u & 7) * 32 + (u >> 3)) : u, lds, tid); } }
        const bf16* Q = (const bf16*)(ws + WS_Q); const bf16* KV = (const bf16*)(ws + WS_KV); const bf16* KRR = (const bf16*)(ws + WS_KRR);
        const float* rope = (const float*)(ws + WS_ROPE);
        const int cslot = (G == 256) ? ((((int)blockIdx.x & 7) * 2 + (((int)blockIdx.x >> 3) >> 4)) % 5) : 0;
        REPEAT(22) {
        int ai = 0;
        for (int slot = 0; slot < 5; ++slot) {
            if (slot == cslot) { if (rep_ == 0) { FRESH(); __syncthreads(); convert_moe_share(args, lds, lane, wave); } continue; }
            for (int u = (G == 256) ? (int)blockIdx.x + ai * 256 : (int)blockIdx.x; u < ((G == 256) ? (int)blockIdx.x + ai * 256 + 1 : (ai == 0 ? 1024 : 0)); u += G) {
                int b, h, qb; if (G == 256) { const int x = (int)blockIdx.x & 7, j = (int)blockIdx.x >> 3, pr = (u >> 8) * 16 + 2 * x + (j >> 4); b = pr >> 3; h = pr & 7; qb = j & 15; } else { b = u >> 7; h = (u >> 4) & 7; qb = u & 15; }
                const size_t kb = (size_t)b * TPB, q0 = kb + CTXL + (size_t)qb * 256;
                __syncthreads();
                att::attn_unit(Q + q0 * 768 + h * 96, KV + kb * 1024 + h * 64, KRR + kb * 32, BY + q0 * 1024 + h * 64, rope + (size_t)qb * 256 * 32, TPB, (char*)lds_raw);
            }
            ++ai;
        }
        }
    } SEAM(5);
    if (IN(6)) REPEAT(6) { FRESH(); phase_readout(args, lane, wave); } SEAM(6);
    if (IN(7)) REPEAT(7) {
        pg8::Gemm g{BY, (const bf16*)(ws + WS_WOUT), NTOK, 1024, 1024}; pg8::LatOrder S; S.init(128, 4, G, (int)blockIdx.x);
        pg8::EpiRes E{args.in[I_X], (const float*)(ws + WS_H), (bf16*)(ws + WS_PRE), MODV, nullptr, 1.f};
        pg8::gemm_phase<pg8::EpiRes, pg8::LatOrder, PG8_ALIGN, PG8_SP2>(lds, g, S, E);
    } SEAM(7);
    for (int l = 0; l < 2; ++l) {
        if (l == 1) {
            if (IN(13)) REPEAT(13) {
                pg8::Gemm g{BY, (const bf16*)(ws + WS_WPW1), NTOK, 2048, 512}; pg8::LatOrder S; S.init(128, 8, G, (int)blockIdx.x);
                pg8::EpiGate<0> E{BX, (const float*)(ws + WS_PW1B), 8, 1.f / (SC_A1 * SC_WPW), 1.f};
                pg8::gemm_phase<pg8::EpiGate<0>, pg8::LatOrder, PG8_ALIGN, true, false, true>(lds, g, S, E);
            } SEAM(13);
            if (IN(14)) REPEAT(14) { FRESH(); phase_conv(args, lds, tid, lane, wave); } SEAM(14);
            if (IN(15)) REPEAT(15) {
                pg8::Gemm g{BY, (const bf16*)(ws + WS_WPW2), NTOK, 1024, 512}; pg8::LatOrder S; S.init(128, 4, G, (int)blockIdx.x);
                pg8::EpiRes E{nullptr, (const float*)(ws + WS_H), (bf16*)(ws + WS_PRE), MODV + 9 * 6144, args.in[I_PW2B], 1.f / (SC_CV * SC_WPW)};
                pg8::gemm_phase<pg8::EpiRes, pg8::LatOrder, PG8_ALIGN, true, false, true>(lds, g, S, E);
            } SEAM(15);
        }
        const int pb = l ? 16 : 8;
        if (IN(pb)) REPEAT(pb) { FRESH(); phase_ln1(args, l, lds, tid, lane, wave); } SEAM(pb);
        if (IN(pb + 2) || IN(pb + 3)) {
            LAS int* tl = (LAS int*)(lds + LDS_TILE_E);
            FRESH();
            __syncthreads();
            if (tid < 32) tl[3 * MAXTILES + 64 + tid] = ld_ctl((const int*)(ws + WS_CURSOR) + l * 32 + tid);
            __syncthreads();
            if (tid == 0) { int ts = 0; for (int e = 0; e < 32; ++e) { tl[3 * MAXTILES + e] = ts; ts += (tl[3 * MAXTILES + 64 + e] + 255) >> 8; } tl[3 * MAXTILES + 32] = ts; }
            __syncthreads();
            const int ntiles = tl[3 * MAXTILES + 32];
            for (int t = tid; t < ntiles && t < MAXTILES; t += NTHR) { int e = 0; while (e < 31 && tl[3 * MAXTILES + e + 1] <= t) ++e; const int j = t - tl[3 * MAXTILES + e], rem = tl[3 * MAXTILES + 64 + e] - 256 * j;
                tl[t] = e; tl[MAXTILES + t] = e * ECAP + 256 * j; tl[2 * MAXTILES + t] = rem < 256 ? rem : 256; }
            __syncthreads();
            if (IN(pb + 2)) REPEAT(pb + 2) {
#if defined(PROBE_STAGGER)
                if (blockIdx.x & 1) { const unsigned long long t0 = __builtin_amdgcn_s_memrealtime(); while (__builtin_amdgcn_s_memrealtime() - t0 < PROBE_STAGGER) __builtin_amdgcn_s_sleep(8); }
#endif
                pg8::Gemm g{BX, (const bf16*)(ws + WS_WGU + (size_t)l * 32 * 2048 * 1024), 0, 0, 512};
                pg8::MoeOrder S; S.init(ntiles, 8, G, (int)blockIdx.x); S.tile_e = tl; S.nper = 8;
                pg8::EpiGate<1, true> E{(bf16*)(ws + WS_ACT), (const float*)(ws + WS_BGU) + (size_t)l * 32 * 2048, 8, 1.f / (SC_X8 * SC_WGU) * PROBE_KSC, SC_ACT};
                pg8::gemm_phase<pg8::EpiGate<1, true>, pg8::MoeOrder, PG8_ALIGN, true, true, true>(lds, g, S, E, (const int*)(ws + WS_ROWS), tl + MAXTILES);
            } SEAM(pb + 2);
            if (IN(pb + 3)) REPEAT(pb + 3) {
                pg8::Gemm g{(const bf16*)(ws + WS_ACT), (const bf16*)(ws + WS_WDN + (size_t)l * 32 * 1024 * 1024), 0, 0, 512};
                pg8::MoeOrder S; S.init(ntiles, 4, G, (int)blockIdx.x); S.tile_e = tl; S.nper = 4;
                pg8::EpiDown E{(bf16*)(ws + WS_YB), args.in[I_BDN] + (size_t)l * 32 * 1024, (const float*)(ws + WS_ROWW), (const int*)(ws + WS_ROWD), 1.f / (SC_ACT * SC_WDN) * PROBE_KSC, tl + MAXTILES, SC_Y};
                pg8::gemm_phase<pg8::EpiDown, pg8::MoeOrder, PG8_ALIGN, true, false, true>(lds, g, S, E);
            } SEAM(pb + 3);
        }
        if (IN(pb + 4)) REPEAT(pb + 4) { FRESH(); phase_ln2(args, l, lane, wave); }
        if (l == 0) SEAM(12);
    }
#undef IN
#undef SEAM
}

extern "C" void kernel_launch(void* const* d_in, const int* in_sizes, int n_in, void* d_out, int out_size, void* d_ws, size_t ws_size, hipStream_t stream) {
    static int grid = 0;
    if (grid == 0) {
        if (n_in != 33 || in_sizes[0] != NB * SEQ * D || out_size != NB * SEQ * D || ws_size < WS_END) {
            fprintf(stderr, "kernel_launch: unexpected shapes: n_in %d in0 %d out %d ws %zu (need %zu)\n", n_in, n_in > 0 ? in_sizes[0] : -1, out_size, ws_size, (size_t)WS_END); grid = -1; return; }
        int dev = 0, cus = 0;
        if (hipGetDevice(&dev) != hipSuccess || hipDeviceGetAttribute(&cus, hipDeviceAttributeMultiprocessorCount, dev) != hipSuccess) { grid = -1; return; }
        if (hipFuncSetAttribute((const void*)fwd_kernel, hipFuncAttributeMaxDynamicSharedMemorySize, LDS_BYTES) != hipSuccess) { fprintf(stderr, "kernel_launch: hipFuncSetAttribute failed\n"); grid = -1; return; }
        int per_cu = 0;
        if (hipOccupancyMaxActiveBlocksPerMultiprocessor(&per_cu, (const void*)fwd_kernel, NTHR, LDS_BYTES) != hipSuccess || per_cu < 1) fprintf(stderr, "kernel_launch: occupancy query reports %d\n", per_cu);
        (void)hipGetLastError();
        grid = cus;
    }
    if (grid < 0) return;
    if (hipMemsetAsync((char*)d_ws + WS_CTL, 0, CTL_ZERO_BYTES, stream) != hipSuccess) return;
    Args a{};
    for (int i = 0; i < 33; ++i) a.in[i] = (const float*)d_in[i];
    a.out = (float*)d_out; a.ws = (unsigned char*)d_ws;
#if MK_ONE_LAUNCH
    a.ph_lo = 0; a.ph_hi = NPHASES;
    hipLaunchKernelGGL(fwd_kernel, dim3(grid), dim3(NTHR), LDS_BYTES, stream, a);
#else
    for (int ph = 0; ph < NPHASES; ++ph) { a.ph_lo = ph; a.ph_hi = ph + 1; hipLaunchKernelGGL(fwd_kernel, dim3(grid), dim3(NTHR), LDS_BYTES, stream, a); }
#endif
    const hipError_t le = hipPeekAtLastError();
    if (le != hipSuccess) fprintf(stderr, "kernel_launch: launch failed: %s\n", hipGetErrorName(le));
}
```

```cpp
#include <hip/hip_runtime.h>
#include <cstdio>
#include <cstdint>

#ifndef PROBE_MASK
#define PROBE_MASK 0u
#endif
#if defined(PROBE_K2)
#define PROBE_KSC 0.5f
#else
#define PROBE_KSC 1.0f
#endif
#ifndef MK_ONE_LAUNCH
#define MK_ONE_LAUNCH 1
#endif

namespace pg8 {
#define PG8_LAS __attribute__((address_space(3)))
typedef unsigned short bf16_t;
typedef short bf16x8 __attribute__((ext_vector_type(8)));
typedef float f32x4 __attribute__((ext_vector_type(4)));
typedef unsigned u32x4 __attribute__((ext_vector_type(4)));
constexpr int BM = 256, BK = 64, HALF = 128, HTB = HALF * BK * 2  , STAGE_BYTES = 8 * HTB, NXCD = 8, WGM = 8;

__host__ __device__ __forceinline__ int lds_byte(int r, int c) { const int st = (r >> 4) * 2 + (c >> 5), rr = r & 15, cc = c & 31, ob = rr * 64 + cc * 2; return st * 1024 + (ob ^ (((ob >> 9) & 1) << 5)); }
__host__ __device__ __forceinline__ void stage_rc(int b, int& R, int& C) { const int st = b / 1024, sb = b % 1024, swz = sb ^ (((sb >> 9) & 1) << 5); R = (st >> 1) * 16 + swz / 64; C = (st & 1) * 32 + (swz % 64) / 2; }
__host__ __device__ __forceinline__ int perm32(int rho) { const int n = rho >> 4, i = rho & 15; return 8 * (i >> 2) + 4 * n + (i & 3); }

struct Unit { int pm, pn; };
struct Gemm { const bf16_t* A; const bf16_t* Bt; int M, N, K; };

struct StaticOrder {
    int nM, nN, nwg, G, c;
    __host__ __device__ void init(int M, int N, int G_, int c_) { nM = M / BM; nN = N / BM; nwg = nM * nN; G = G_; c = c_; }
    __host__ __device__ bool next(int i, Unit& u) const {
        const long L = (long)i * G + c; if (L >= nwg) return false;
        int wgid = (int)L; { const int q = nwg / NXCD, r = nwg % NXCD, xcd = wgid % NXCD, off = wgid / NXCD; wgid = (xcd < r ? xcd * (q + 1) : r * (q + 1) + (xcd - r) * q) + off; }
        const int nig = WGM * nN, gid = wgid / nig, fm = gid * WGM, gsz = (nM - fm) < WGM ? (nM - fm) : WGM;
        u.pm = fm + ((wgid % nig) % gsz); u.pn = (wgid % nig) / gsz; return true;
    }
    __device__ __forceinline__ void a_ready(const Unit&) const {}
    __device__ __forceinline__ void done(const Unit&) const {}
};

__device__ __forceinline__ unsigned cvt_pk_bf16(float lo, float hi) { unsigned r; asm volatile("v_cvt_pk_bf16_f32 %0, %1, %2" : "=v"(r) : "v"(lo), "v"(hi)); return r; }
typedef float f32x2 __attribute__((ext_vector_type(2)));
__device__ __forceinline__ f32x2 gelu_pk(f32x2 v) {
    const f32x2 av = __builtin_elementwise_abs(v), d = av * 0.2316418882f + 1.0f;
    f32x2 t; t.x = __builtin_amdgcn_rcpf(d.x); t.y = __builtin_amdgcn_rcpf(d.y);
    f32x2 q = t * 0.5307027145f + (-0.7265760135f); q = q * t + 0.7107068705f; q = q * t + (-0.142248368f); q = q * t + 0.127414796f; q = q * t;
    const f32x2 s = (v * v) * (-0.72134752044f);
    f32x2 e; e.x = __builtin_amdgcn_exp2f(s.x); e.y = __builtin_amdgcn_exp2f(s.y);
    const f32x2 m = v * (q * e), r = v - m;
    f32x2 o; o.x = v.x < 0.f ? m.x : r.x; o.y = v.y < 0.f ? m.y : r.y; return o;
}

template <int ACT  > struct EpiBf16 {
    static constexpr bool PERM = true, AFTER_DRAIN = false; static_assert(ACT == 0 || ACT == 1, "EpiBf16: ACT is 0 (none) or 1 (gelu_pk)");
    bf16_t* O; int ldc; const float* bias; int split_cols; size_t split_stride; float scale0;
    __device__ __forceinline__ void operator()(const f32x4 (&acc)[2][2][4][2], const Unit& u, int wr, int wc, int fr, int fq) const {
        const int row0 = u.pm * BM + wr * 64 + fr; int colt = u.pn * BM; bf16_t* base = O;
        float sc = 1.f; if (split_cols) { const int t = colt / split_cols; base += (size_t)t * split_stride; colt -= t * split_cols; if (t == 0) sc = scale0; }
        const int col0 = colt + wc * 32 + 8 * fq, bcol0 = u.pn * BM + wc * 32 + 8 * fq;
        f32x4 bv[2][2];
#pragma unroll
        for (int bj = 0; bj < 2; ++bj)
#pragma unroll
            for (int n = 0; n < 2; ++n) bv[bj][n] = bias ? *(const f32x4*)(bias + bcol0 + bj * HALF + 4 * n) : (f32x4){0.f, 0.f, 0.f, 0.f};
#pragma unroll
        for (int ai = 0; ai < 2; ++ai)
#pragma unroll
            for (int m = 0; m < 4; ++m) { bf16_t* rowp = base + (size_t)(row0 + ai * HALF + m * 16) * ldc + col0;
#pragma unroll
                for (int bj = 0; bj < 2; ++bj) { f32x4 v0 = acc[ai][bj][m][0] + bv[bj][0], v1 = acc[ai][bj][m][1] + bv[bj][1];
                    if (ACT == 1) { f32x2 a = gelu_pk((f32x2){v0[0], v0[1]}), b = gelu_pk((f32x2){v0[2], v0[3]}), c = gelu_pk((f32x2){v1[0], v1[1]}), d = gelu_pk((f32x2){v1[2], v1[3]});
                        v0 = (f32x4){a.x, a.y, b.x, b.y}; v1 = (f32x4){c.x, c.y, d.x, d.y}; }
                    v0 = v0 * sc; v1 = v1 * sc; u32x4 w; w.x = cvt_pk_bf16(v0[0], v0[1]); w.y = cvt_pk_bf16(v0[2], v0[3]); w.z = cvt_pk_bf16(v1[0], v1[1]); w.w = cvt_pk_bf16(v1[2], v1[3]);
                    *(u32x4*)(rowp + bj * HALF) = w; } }
    }
};
typedef int v4i_t __attribute__((ext_vector_type(4)));
typedef int v8i_t __attribute__((ext_vector_type(8)));
__device__ __forceinline__ v8i_t cat32(bf16x8 a, bf16x8 b) { const v4i_t x = __builtin_bit_cast(v4i_t, a), y = __builtin_bit_cast(v4i_t, b); return __builtin_shufflevector(x, y, 0, 1, 2, 3, 4, 5, 6, 7); }
template <class Epi, class Sched, bool ALIGN_EPI = false, bool SP2 = false, bool GATHER = false, bool FP8 = false>
__device__ __forceinline__ void gemm_phase(PG8_LAS unsigned char* lds, const Gemm g, const Sched& S, const Epi& E, const int* rowsrc = nullptr, const PG8_LAS int* gtab = nullptr) {
    static_assert(!GATHER || SP2, "GATHER is implemented on the SP2 loop only");
    int tid_l = threadIdx.x; asm volatile("" : "+v"(tid_l));
    const int tid = tid_l, wid = __builtin_amdgcn_readfirstlane(tid >> 6), lane = tid & 63, wr = wid >> 2, wc = wid & 3, fr = lane & 15, fq = lane >> 4;
#if defined(PROBE_K2)
    const int K = g.K, nt0 = K / BK, nt = FP8 ? 2 * nt0 : nt0;
#define PG8_KT(x) (FP8 ? ((x) & (nt0 - 1)) : (x))
#else
    const int K = g.K, nt = K / BK;
#define PG8_KT(x) (x)
#endif
    unsigned voffA[2], voffB[2];
#pragma unroll
    for (int i = 0; i < 2; ++i) { int R, C; stage_rc(tid * 16 + i * 8192, R, C); const int Rb = Epi::PERM ? ((R & ~31) + perm32(R & 31)) : R;
        voffA[i] = (unsigned)(R * K + C) * 2u; voffB[i] = (unsigned)(Rb * K + C) * 2u; }
    unsigned gAc[2][2], gAn[2][2]; int gR[2]; unsigned gC[2];
#pragma unroll
    for (int i = 0; i < 2; ++i) { int R, C; stage_rc(tid * 16 + i * 8192, R, C); gR[i] = R; gC[i] = (unsigned)C * 2u; gAc[0][i] = gAc[1][i] = gAn[0][i] = gAn[1][i] = 0u; }
#define PG8_GATHER(u_, o_) do { const int gtb_ = gtab[(u_).pm], gtc_ = gtab[576 + (u_).pm];     \
        _Pragma("unroll") for (int h_ = 0; h_ < 2; ++h_) _Pragma("unroll") for (int i_ = 0; i_ < 2; ++i_) \
        { const int rl_ = h_ * HALF + gR[i_]; const int src_ = rl_ < gtc_ ? rowsrc[gtb_ + rl_] : 0; o_[h_][i_] = (unsigned)src_ * (unsigned)(K * 2) + gC[i_]; } } while (0)
#define PG8_STAGE_A(bufoff, orig_gbase, NEXTSEL, H, KOFF) do { if constexpr (GATHER) { unsigned vo_[2]; vo_[0] = (NEXTSEL) ? gAn[H][0] : gAc[H][0]; vo_[1] = (NEXTSEL) ? gAn[H][1] : gAc[H][1]; \
        PG8_STAGE(bufoff, (const char*)g.A + (KOFF), vo_); } else { PG8_STAGE(bufoff, orig_gbase, voffA); } } while (0)
    const size_t kstep = (size_t)(BK * 2);
    const size_t hstep = (size_t)HALF * K * 2;
    const size_t tstep = 2 * hstep;
    const unsigned ldsw = (unsigned)wid * 1024u;
    const int aoff = lds_byte(wr * 64 + fr, fq * 8), boff = lds_byte(wc * 32 + fr, fq * 8);
#define PG8_SA(b, h) (((b) * 2 + (h)) * HTB)
#define PG8_SB(b, h) ((4 + (b) * 2 + (h)) * HTB)
#define PG8_STAGE(bufoff, gbase, voff) do { _Pragma("unroll") for (int _i = 0; _i < 2; ++_i) \
        __builtin_amdgcn_global_load_lds((const unsigned*)((const char*)(gbase) + (voff)[_i]), (PG8_LAS unsigned*)(lds + (bufoff) + ldsw + _i * 8192), 16, 0, 0); } while (0)
#define PG8_LD32(var, addr) do { const bf16x8 lo_ = *(const PG8_LAS bf16x8*)(addr); const bf16x8 hi_ = *(const PG8_LAS bf16x8*)((addr) + 1024); var = cat32(lo_, hi_); } while (0)
#define PG8_LDA(dst, b, h) do { if constexpr (FP8) { _Pragma("unroll") for (int m = 0; m < 4; ++m) PG8_LD32(dst##8[m], lds + PG8_SA(b, h) + aoff + m * 2048); } \
        else { _Pragma("unroll") for (int m = 0; m < 4; ++m) _Pragma("unroll") for (int k = 0; k < 2; ++k) dst[m][k] = *(const PG8_LAS bf16x8*)(lds + PG8_SA(b, h) + aoff + m * 2048 + k * 1024); } } while (0)
#define PG8_LDB(dst, b, h) do { if constexpr (FP8) { _Pragma("unroll") for (int n = 0; n < 2; ++n) PG8_LD32(dst##8[n], lds + PG8_SB(b, h) + boff + n * 2048); } \
        else { _Pragma("unroll") for (int n = 0; n < 2; ++n) _Pragma("unroll") for (int k = 0; k < 2; ++k) dst[n][k] = *(const PG8_LAS bf16x8*)(lds + PG8_SB(b, h) + boff + n * 2048 + k * 1024); } } while (0)
#define PG8_MMA(ai, bj, At, Bt) do { __builtin_amdgcn_s_setprio(1); \
        if constexpr (FP8) { _Pragma("unroll") for (int m = 0; m < 4; ++m) _Pragma("unroll") for (int n = 0; n < 2; ++n) \
            asm volatile("v_mfma_scale_f32_16x16x128_f8f6f4 %0, %1, %2, %0, %3, %3 op_sel_hi:[0,0,0]" : "+v"(acc[ai][bj][m][n]) : "v"(Bt##8[n]), "v"(At##8[m]), "v"(sc127)); } \
        else { _Pragma("unroll") for (int m = 0; m < 4; ++m) _Pragma("unroll") for (int n = 0; n < 2; ++n) _Pragma("unroll") for (int k = 0; k < 2; ++k) \
            acc[ai][bj][m][n] = __builtin_amdgcn_mfma_f32_16x16x32_bf16(Bt[n][k], At[m][k], acc[ai][bj][m][n], 0, 0, 0); } \
        __builtin_amdgcn_s_setprio(0); } while (0)
#define PG8_WAIT_V(n) asm volatile("s_waitcnt vmcnt(" #n ")" ::: "memory")
#define PG8_WAIT_L(n) asm volatile("s_waitcnt lgkmcnt(" #n ")" ::: "memory")
#define PG8_BAR __builtin_amdgcn_s_barrier()
#define PG8_SCHED __builtin_amdgcn_sched_barrier(0)
    Unit cur, nxt; int ui = 0;
    if (!S.next(0, cur)) return;
    f32x4 acc[2][2][4][2];
#pragma unroll
    for (int a = 0; a < 2; ++a)
#pragma unroll
        for (int b = 0; b < 2; ++b)
#pragma unroll
            for (int m = 0; m < 4; ++m)
#pragma unroll
                for (int n = 0; n < 2; ++n) acc[a][b][m][n] = (f32x4){0.f, 0.f, 0.f, 0.f};
    int sc127 = 0x7f7f7f7f; asm volatile("" : "+v"(sc127));
    bf16x8 At[4][2], B0[2][2], B1[2][2]; v8i_t At8[4], B08[2], B18[2]; (void)At; (void)B0; (void)B1; (void)At8; (void)B08; (void)B18;
    const char* cA = (const char*)g.A + (size_t)cur.pm * tstep; const char* cB = (const char*)g.Bt + (size_t)cur.pn * tstep;
    S.a_ready(cur);
    if constexpr (GATHER) { PG8_GATHER(cur, gAc); }
    if constexpr (SP2) {
        PG8_STAGE(PG8_SB(0, 0), cB, voffB); PG8_STAGE(PG8_SB(0, 1), cB + hstep, voffB); PG8_STAGE_A(PG8_SA(0, 0), cA, false, 0, (size_t)0); PG8_STAGE_A(PG8_SA(0, 1), cA + hstep, false, 1, (size_t)0);
        if (wr == 1) PG8_BAR;
        PG8_WAIT_V(2); PG8_BAR;
        PG8_STAGE(PG8_SB(1, 0), cB + kstep, voffB); PG8_STAGE_A(PG8_SA(1, 0), cA + kstep, false, 0, kstep); PG8_STAGE(PG8_SB(1, 1), cB + hstep + kstep, voffB);
        PG8_WAIT_V(6); PG8_BAR;
    } else {
        PG8_STAGE(PG8_SB(0, 0), cB, voffB); PG8_STAGE(PG8_SA(0, 0), cA, voffA); PG8_STAGE(PG8_SB(0, 1), cB + hstep, voffB); PG8_STAGE(PG8_SA(0, 1), cA + hstep, voffA);
        if (wr == 1) PG8_BAR;
        PG8_WAIT_V(4); PG8_BAR;
        PG8_STAGE(PG8_SB(1, 0), cB + kstep, voffB); PG8_STAGE(PG8_SA(1, 0), cA + kstep, voffA); PG8_STAGE(PG8_SB(1, 1), cB + hstep + kstep, voffB);
        PG8_WAIT_V(6); PG8_BAR;
    }
    for (;;) {
        const bool has_next = S.next(ui + 1, nxt);
        if constexpr (GATHER) { if (has_next) { PG8_GATHER(nxt, gAn); } else { _Pragma("unroll") for (int h_ = 0; h_ < 2; ++h_) _Pragma("unroll") for (int i_ = 0; i_ < 2; ++i_) gAn[h_][i_] = gAc[h_][i_]; } }
        const char* nA = has_next ? (const char*)g.A + (size_t)nxt.pm * tstep : cA; const char* nB = has_next ? (const char*)g.Bt + (size_t)nxt.pn * tstep : cB;
#pragma nounroll
        for (int t = 0; t < nt; t += 2) {
            const bool last = (t == nt - 2);
            const char* a1 = cA + (size_t)PG8_KT(t + 1) * kstep;
            const char* a2 = last ? nA : cA + (size_t)PG8_KT(t + 2) * kstep; const char* b2 = last ? nB : cB + (size_t)PG8_KT(t + 2) * kstep;
            const char* a3 = a2 + kstep; const char* b3 = b2 + kstep;
            const size_t k1 = (size_t)PG8_KT(t + 1) * kstep, k2 = last ? (size_t)0 : (size_t)PG8_KT(t + 2) * kstep, k3 = k2 + kstep; (void)k1; (void)k2; (void)k3;
            if (last && has_next) S.a_ready(nxt);
            if constexpr (SP2) {
            PG8_LDB(B0, 0, 0); PG8_LDB(B1, 0, 1); PG8_SCHED; PG8_LDA(At, 0, 0); PG8_STAGE_A(PG8_SA(1, 1), a1 + hstep, false, 1, k1);
            PG8_WAIT_V(8); PG8_WAIT_L(0); PG8_BAR; PG8_MMA(0, 0, At, B0); PG8_MMA(0, 1, At, B1); PG8_BAR; PG8_SCHED;
            PG8_LDA(At, 0, 1); PG8_STAGE(PG8_SB(0, 0), b2, voffB); PG8_STAGE(PG8_SB(0, 1), b2 + hstep, voffB); PG8_STAGE_A(PG8_SA(0, 0), a2, last, 0, k2);
            PG8_WAIT_V(8); PG8_WAIT_L(0); PG8_BAR; PG8_MMA(1, 0, At, B0); PG8_MMA(1, 1, At, B1); PG8_BAR; PG8_SCHED;
            PG8_LDB(B0, 1, 0); PG8_LDB(B1, 1, 1); PG8_SCHED; PG8_LDA(At, 1, 0); PG8_STAGE_A(PG8_SA(0, 1), a2 + hstep, last, 1, k2);
            PG8_WAIT_V(8); PG8_WAIT_L(0); PG8_BAR; PG8_MMA(0, 0, At, B0); PG8_MMA(0, 1, At, B1); PG8_BAR; PG8_SCHED;
            PG8_LDA(At, 1, 1); PG8_STAGE(PG8_SB(1, 0), b3, voffB); PG8_STAGE(PG8_SB(1, 1), b3 + hstep, voffB); PG8_STAGE_A(PG8_SA(1, 0), a3, last, 0, k3);
            PG8_WAIT_V(8); PG8_WAIT_L(0); PG8_BAR; PG8_MMA(1, 0, At, B0); PG8_MMA(1, 1, At, B1); PG8_BAR; PG8_SCHED;
            } else {
            PG8_LDB(B0, 0, 0); PG8_SCHED; PG8_LDA(At, 0, 0); PG8_STAGE(PG8_SA(1, 1), a1 + hstep, voffA);
            PG8_WAIT_L(8); PG8_BAR; PG8_WAIT_L(0); PG8_MMA(0, 0, At, B0); PG8_BAR; PG8_SCHED;
            PG8_LDB(B1, 0, 1); PG8_STAGE(PG8_SB(0, 0), b2, voffB);
            PG8_BAR; PG8_WAIT_L(0); PG8_MMA(0, 1, At, B1); PG8_BAR;
            PG8_LDA(At, 0, 1); PG8_STAGE(PG8_SA(0, 0), a2, voffA);
            PG8_BAR; PG8_WAIT_L(0); PG8_MMA(1, 0, At, B0); PG8_BAR; PG8_SCHED;
            PG8_STAGE(PG8_SB(0, 1), b2 + hstep, voffB);
            PG8_WAIT_V(6); PG8_BAR; PG8_MMA(1, 1, At, B1); PG8_BAR;
            PG8_LDB(B0, 1, 0); PG8_SCHED; PG8_LDA(At, 1, 0); PG8_STAGE(PG8_SA(0, 1), a2 + hstep, voffA);
            PG8_WAIT_L(8); PG8_BAR; PG8_WAIT_L(0); PG8_MMA(0, 0, At, B0); PG8_BAR; PG8_SCHED;
            PG8_LDB(B1, 1, 1); PG8_STAGE(PG8_SB(1, 0), b3, voffB);
            PG8_BAR; PG8_WAIT_L(0); PG8_MMA(0, 1, At, B1); PG8_BAR;
            PG8_LDA(At, 1, 1); PG8_STAGE(PG8_SA(1, 0), a3, voffA);
            PG8_BAR; PG8_WAIT_L(0); PG8_MMA(1, 0, At, B0); PG8_BAR; PG8_SCHED;
            PG8_STAGE(PG8_SB(1, 1), b3 + hstep, voffB);
            PG8_WAIT_V(6); PG8_BAR; PG8_MMA(1, 1, At, B1); PG8_BAR;
            }
        }
        if constexpr (ALIGN_EPI) { if (wr == 0) PG8_BAR; }
        if constexpr (FP8) { asm volatile("s_nop 15\n\ts_nop 15" ::: "memory"); }
        if constexpr (!Epi::AFTER_DRAIN) { E(acc, cur, wr, wc, fr, fq);
#if defined(PROBE_EPI2)
            if constexpr (FP8 == (PROBE_EPI2 == 1)) { E(acc, cur, wr, wc, fr, fq); }
#endif
            S.done(cur); }
        if (!has_next) break;
#pragma unroll
        for (int a = 0; a < 2; ++a)
#pragma unroll
            for (int b = 0; b < 2; ++b)
#pragma unroll
                for (int m = 0; m < 4; ++m)
#pragma unroll
                    for (int n = 0; n < 2; ++n) acc[a][b][m][n] = (f32x4){0.f, 0.f, 0.f, 0.f};
        cur = nxt; cA = nA; cB = nB; ++ui;
        if constexpr (GATHER) { _Pragma("unroll") for (int h_ = 0; h_ < 2; ++h_) _Pragma("unroll") for (int i_ = 0; i_ < 2; ++i_) gAc[h_][i_] = gAn[h_][i_]; }
        if constexpr (ALIGN_EPI) { if (wr == 1) PG8_BAR; }
    }
    PG8_WAIT_V(0);
    if constexpr (!ALIGN_EPI) { if (wr == 0) PG8_BAR; }
    PG8_BAR;
    if constexpr (Epi::AFTER_DRAIN) { E.fused(acc, cur, wr, wc, fr, fq, lds, wid, lane); S.done(cur); }
#undef PG8_SA
#undef PG8_SB
#undef PG8_STAGE
#undef PG8_STAGE_A
#undef PG8_GATHER
#undef PG8_LDA
#undef PG8_LD32
#undef PG8_LDB
#undef PG8_MMA
#undef PG8_WAIT_V
#undef PG8_WAIT_L
#undef PG8_BAR
#undef PG8_SCHED
}
}

#ifndef PG8_SP2
#define PG8_SP2 true
#endif
#ifndef PG8_ALIGN
#define PG8_ALIGN true
#endif

#define GAS __attribute__((address_space(1)))
#define LAS __attribute__((address_space(3)))
typedef unsigned short bf16;
typedef unsigned v4u __attribute__((ext_vector_type(4)));
typedef unsigned v2u __attribute__((ext_vector_type(2)));
typedef float f32x4 __attribute__((ext_vector_type(4)));
typedef short bf16x8 __attribute__((ext_vector_type(8)));

constexpr int D = 1024, NB = 8, SEQ = 4096, CTXL = 256, TPB = SEQ + CTXL, NTOK = NB * TPB, NLAT = NB * SEQ;
constexpr int ZC = 3328;
constexpr int ZQ = 0, ZKV = 384, ZKR = 640, ZHQ = 672, ZHF = 1184, ZHB = 1696, ZHI = 2208, ZHG = 2720;
constexpr int NEXP = 32;
constexpr float ALPHA = 1.4142135623730951f;
constexpr float LN_EPS = 1e-5f, RMS_EPS = 1e-6f;
constexpr int NWAVES = 8, NTHR = 512;
constexpr float SC_X8 = 16.f, SC_WGU = 64.f, SC_ACT = 8.f, SC_WDN = 128.f, SC_Y = 64.f, SC_A1 = 16.f, SC_WPW = 64.f, SC_CV = 16.f, SC_A0 = 16.f, SC_WIN = 64.f;
constexpr int LDS_BYTES = 147456;
constexpr int LDS_BAR_OFF = LDS_BYTES - 64;
constexpr int LDS_TILE_E = 131072;
constexpr int MAXTILES = 576;

constexpr size_t MiB = 1u << 20;
constexpr size_t WS_CTL = 0, CTL_ZERO_BYTES = 16384;
constexpr size_t WS_MODV = 1 * MiB;
constexpr size_t WS_ROPE = 1 * MiB + 512 * 1024;
constexpr size_t WS_BGU = 2 * MiB;
constexpr size_t WS_PW1B = 2 * MiB + 512 * 1024;
constexpr size_t WS_BCNT = WS_PW1B + 64 * 1024;
constexpr size_t WS_TILEE = WS_BCNT + 64 * 1024;
constexpr size_t WS_META = WS_TILEE + 4096;
constexpr size_t WS_TOPI = 3 * MiB, WS_TOPW = 4 * MiB;
constexpr int ECAP = 32768;
constexpr size_t WS_ROWS = 160 * MiB, WS_ROWW = 164 * MiB, WS_ROWD = 168 * MiB;
constexpr size_t WS_CURSOR = 14336;
constexpr size_t WS_WIN = 8 * MiB, WS_WUQ = 15 * MiB, WS_WUKV = 16 * MiB, WS_WOUT = 17 * MiB, WS_WPW1 = 19 * MiB, WS_WPW2 = 23 * MiB;
constexpr size_t WS_WGU = 32 * MiB, WS_WDN = 288 * MiB;
constexpr size_t WS_H = 416 * MiB;
constexpr size_t WS_X = 552 * MiB, WS_Y = 620 * MiB;
constexpr size_t WS_BIG = 688 * MiB;
constexpr size_t WS_Z = WS_BIG, WS_CQN = WS_BIG + 221 * MiB, WS_CKVN = WS_BIG + 247 * MiB, WS_KRR = WS_BIG + 264 * MiB,
                 WS_Q = WS_BIG + 267 * MiB, WS_KV = WS_BIG + 318 * MiB, WS_OF = WS_BIG + 386 * MiB, WS_OB = WS_BIG + 454 * MiB;
constexpr size_t WS_HT = WS_BIG + 528 * MiB;
constexpr size_t WS_PRE = WS_BIG;
constexpr size_t WS_XS = WS_BIG, WS_ACT = WS_BIG + 288 * MiB, WS_YB = WS_BIG + 576 * MiB;
constexpr size_t WS_END = WS_BIG + 848 * MiB;
static_assert((size_t)NTOK * ZC * 2 <= 221 * MiB && (size_t)NTOK * 384 * 2 <= 26 * MiB && (size_t)NTOK * 256 * 2 <= 17 * MiB && (size_t)NTOK * 32 * 2 <= 3 * MiB, "ws map 1");
static_assert((size_t)NTOK * 768 * 2 <= 51 * MiB && (size_t)NTOK * 1024 * 2 <= 68 * MiB && (size_t)NTOK * 512 * 4 <= 68 * MiB, "ws map 2");
static_assert((size_t)64 * 136 * 26624 <= 320 * MiB && (size_t)MAXTILES * 256 * 2048 <= 288 * MiB && (size_t)NLAT * 4 * 2048 <= 272 * MiB && (size_t)NTOK * 1024 * 4 <= 136 * MiB, "ws map 3");

#define LDS_WAIT() asm volatile("s_waitcnt lgkmcnt(0)" ::: "memory")
#define VM_WAIT() asm volatile("s_waitcnt vmcnt(0)" ::: "memory")
__device__ __forceinline__ float bf2f(unsigned short b) { return __uint_as_float(((unsigned)b) << 16); }
__device__ __forceinline__ unsigned pk2(float lo, float hi) { return pg8::cvt_pk_bf16(lo, hi); }
__device__ __forceinline__ float sigm(float x) { return __builtin_amdgcn_rcpf(1.f + __expf(-x)); }
__device__ __forceinline__ float wave_sum(float v) {
#pragma unroll
    for (int o = 1; o < 64; o <<= 1) v += __shfl_xor(v, o);
    return v;
}
__device__ __forceinline__ int ld_ctl(const int* p) { return (int)__hip_atomic_load((const unsigned*)p, __ATOMIC_RELAXED, __HIP_MEMORY_SCOPE_AGENT); }
__device__ __forceinline__ int grow_of(int lr) { return (lr >> 12) * TPB + CTXL + (lr & 4095); }

#define XB_TMO      128
#define XB_XCNT(j)  (256  + 64 * (j))
#define XB_XSUB(j)  (1280 + 64 * (j))
#define XB_XGEN(j)  (2304 + 64 * (j))
#define XB_TOP      3328
#define XB_TOPGEN   3392
#define XCD_BAR_WORDS 3456
#define XB_SPIN_CAP (1u << 21)

__device__ __forceinline__ unsigned xb_ld(unsigned* p)              { return __hip_atomic_load(p, __ATOMIC_RELAXED, __HIP_MEMORY_SCOPE_AGENT); }
__device__ __forceinline__ unsigned xb_add(unsigned* p, unsigned v) { return __hip_atomic_fetch_add(p, v, __ATOMIC_RELAXED, __HIP_MEMORY_SCOPE_AGENT); }
__device__ __forceinline__ unsigned xb_xcc_id() { return (unsigned)__builtin_amdgcn_s_getreg((3 << 11) | 20) & 0xFu; }
#define XB_SPIN(cond, bar) do { unsigned _sp = 0; while (cond) { __builtin_amdgcn_s_sleep(1); \
    if ((++_sp & 255u) == 0u) { if (xb_ld(&(bar)[XB_TMO])) break; if (_sp > XB_SPIN_CAP) { atomicAdd(&(bar)[XB_TMO], 1u); break; } } } } while (0)

struct XcdBarrier { unsigned* bar; unsigned x; volatile LAS unsigned* st; };

__device__ __forceinline__ XcdBarrier xcd_barrier_post(unsigned* bar, volatile LAS unsigned* st) {
    XcdBarrier b; b.bar = bar; b.x = xb_xcc_id(); b.st = st;
    if (threadIdx.x == 0) (void)xb_add(&bar[XB_XCNT(b.x)], 1u);
    return b;
}
__device__ __forceinline__ void xcd_barrier_complete(unsigned* bar, unsigned x, unsigned& nloc, unsigned& nx) {
    const unsigned G = gridDim.x * gridDim.y * gridDim.z;
    unsigned sum, cnt, mine, sp = 0u;
    for (;;) {
        sum = 0u; cnt = 0u; mine = 0u;
#pragma unroll
        for (unsigned j = 0; j < 16; ++j) { const unsigned c = xb_ld(&bar[XB_XCNT(j)]); sum += c; cnt += (c > 0u) ? 1u : 0u; mine = (j == x) ? c : mine; }
        if (sum == G) break;
        __builtin_amdgcn_s_sleep(1);
        if ((++sp & 255u) == 0u) { if (xb_ld(&bar[XB_TMO])) break; if (sp > XB_SPIN_CAP) { atomicAdd(&bar[XB_TMO], 1u); break; } }
    }
    nloc = mine > 0u ? mine : 1u; nx = cnt > 0u ? cnt : 1u;
}
__device__ __forceinline__ void xcd_barrier(const XcdBarrier& b) {
    asm volatile("s_waitcnt vmcnt(0)" ::: "memory");
    __syncthreads();
    if (threadIdx.x == 0) {
        unsigned* bar = b.bar;
        __builtin_amdgcn_s_waitcnt(0);
        unsigned nloc = b.st[0], nx = b.st[1];
        if (nloc == 0u) { xcd_barrier_complete(bar, b.x, nloc, nx); b.st[0] = nloc; b.st[1] = nx; }
        const unsigned old = xb_add(&bar[XB_XSUB(b.x)], 1u);
        const unsigned gen = old / nloc;
        if (old + 1u == (gen + 1u) * nloc) {
            __builtin_amdgcn_fence(__ATOMIC_RELEASE, "agent");
            asm volatile("s_waitcnt vmcnt(0)" ::: "memory");
            const unsigned og = xb_add(&bar[XB_TOP], 1u);
            const unsigned tg = og / nx;
            if (og + 1u == (tg + 1u) * nx) xb_add(&bar[XB_TOPGEN], 1u);
            else XB_SPIN(xb_ld(&bar[XB_TOPGEN]) == tg, bar);
            __builtin_amdgcn_fence(__ATOMIC_ACQUIRE, "agent");
            xb_add(&bar[XB_XGEN(b.x)], 1u);
            asm volatile("s_waitcnt vmcnt(0)" ::: "memory");
        } else {
            XB_SPIN(xb_ld(&bar[XB_XGEN(b.x)]) == gen, bar);
            __builtin_amdgcn_fence(__ATOMIC_ACQUIRE, "agent");
            asm volatile("s_waitcnt vmcnt(0)" ::: "memory");
        }
    }
    __syncthreads();
}

namespace pg8 {
struct TileOrder {
    int nM, nN, nwg, G, c;
    __device__ __forceinline__ void init(int nM_, int nN_, int G_, int c_) { nM = nM_; nN = nN_; nwg = nM * nN; G = G_; c = c_; }
    __device__ __forceinline__ bool logical(int i, int& im, int& in) const {
        const long L = (long)i * G + c; if (L >= nwg) return false;
        int wgid = (int)L; { const int q = nwg / NXCD, r = nwg % NXCD, xcd = wgid % NXCD, off = wgid / NXCD; wgid = (xcd < r ? xcd * (q + 1) : r * (q + 1) + (xcd - r) * q) + off; }
        const int nig = WGM * nN, gid = wgid / nig, fm = gid * WGM, gsz = (nM - fm) < WGM ? (nM - fm) : WGM;
        im = fm + ((wgid % nig) % gsz); in = (wgid % nig) / gsz; return true;
    }
    __device__ __forceinline__ void a_ready(const Unit&) const {}
    __device__ __forceinline__ void done(const Unit&) const {}
};
struct AllOrder : TileOrder { __device__ __forceinline__ bool next(int i, Unit& u) const { int im, in; if (!logical(i, im, in)) return false; u.pm = im; u.pn = in; return true; } };
struct LatOrder : TileOrder {
    __device__ __forceinline__ bool next(int i, Unit& u) const { int im, in; if (!logical(i, im, in)) return false; u.pm = (im >> 4) * 17 + 1 + (im & 15); u.pn = in; return true; } };
struct MoeOrder : TileOrder {
    const PG8_LAS int* tile_e; int nper;
    __device__ __forceinline__ bool next(int i, Unit& u) const { int im, in; if (!logical(i, im, in)) return false; u.pm = im; u.pn = tile_e[im] * nper + in; return true; } };

struct EpiRes {
    static constexpr bool PERM = true, AFTER_DRAIN = false;
    const float* xin; const float* h; bf16_t* pre; const float* modv; const float* bias; float ascale;
    __device__ __forceinline__ void operator()(const f32x4 (&acc)[2][2][4][2], const Unit& u, int wr, int wc, int fr, int fq) const {
        asm volatile("" : "+v"(fr), "+v"(fq));
        const int b = u.pm / 17, j = u.pm % 17;
        const int rl0 = wr * 64 + fr, col0 = u.pn * BM + wc * 32 + 8 * fq;
        const float* gate = modv + (size_t)b * 6144 + 2048;
        f32x4 gv[2][2], bv[2][2];
#pragma unroll
        for (int bj = 0; bj < 2; ++bj)
#pragma unroll
            for (int n = 0; n < 2; ++n) { gv[bj][n] = *(const f32x4*)(gate + col0 + bj * HALF + 4 * n); bv[bj][n] = bias ? *(const f32x4*)(bias + col0 + bj * HALF + 4 * n) : (f32x4){0.f, 0.f, 0.f, 0.f}; }
#pragma unroll
        for (int aim = 0; aim < 4; ++aim) { const int ai = aim >> 1, m0 = (aim & 1) * 2;
            f32x4 hv[2][2][2];
#pragma unroll
            for (int mm = 0; mm < 2; ++mm) { const int rl = rl0 + ai * HALF + (m0 + mm) * 16; const size_t grow = (size_t)u.pm * BM + rl;
                const float* hin = xin ? xin + ((size_t)b * 4096 + (size_t)(j - 1) * 256 + rl) * 1024 + col0 : h + grow * 1024 + col0;
#pragma unroll
                for (int bj = 0; bj < 2; ++bj) { hv[mm][bj][0] = *(const f32x4*)(hin + bj * HALF); hv[mm][bj][1] = *(const f32x4*)(hin + bj * HALF + 4); } }
            asm volatile("" ::: "memory");
#pragma unroll
            for (int mm = 0; mm < 2; ++mm) { const int m = m0 + mm; const int rl = rl0 + ai * HALF + m * 16; const size_t grow = (size_t)u.pm * BM + rl; bf16_t* po = pre + grow * 1024 + col0;
#pragma unroll
                for (int bj = 0; bj < 2; ++bj) {
                    const f32x4 v0 = hv[mm][bj][0] * 1.4142135623730951f + gv[bj][0] * (acc[ai][bj][m][0] * ascale + bv[bj][0]), v1 = hv[mm][bj][1] * 1.4142135623730951f + gv[bj][1] * (acc[ai][bj][m][1] * ascale + bv[bj][1]);
                    u32x4 w; w.x = cvt_pk_bf16(v0[0], v0[1]); w.y = cvt_pk_bf16(v0[2], v0[3]); w.z = cvt_pk_bf16(v1[0], v1[1]); w.w = cvt_pk_bf16(v1[2], v1[3]);
                    *(u32x4*)(po + bj * HALF) = w; } }
            asm volatile("" ::: "memory"); }
    }
};
template <int MODE, bool OUT8 = false> struct EpiGate {
    static constexpr bool PERM = true, AFTER_DRAIN = false;
    bf16_t* O; const float* bias; int nper; float ascale, oscale;
    __device__ __forceinline__ void operator()(const f32x4 (&acc)[2][2][4][2], const Unit& u, int wr, int wc, int fr, int fq) const {
        asm volatile("" : "+v"(fr), "+v"(fq));
        const int row0 = u.pm * BM + wr * 64 + fr, pnl = u.pn % nper, ocol0 = pnl * HALF + wc * 32 + 8 * fq, bcol0 = u.pn * BM + wc * 32 + 8 * fq;
        const float s0 = ascale, s1 = MODE == 1 ? ascale * oscale : ascale;
        f32x4 bv[2][2];
#pragma unroll
        for (int n = 0; n < 2; ++n) { bv[0][n] = *(const f32x4*)(bias + bcol0 + 4 * n); const f32x4 t = *(const f32x4*)(bias + bcol0 + HALF + 4 * n); bv[1][n] = MODE == 1 ? (t + 1.0f) * oscale : t; }
#pragma unroll
        for (int ai = 0; ai < 2; ++ai)
#pragma unroll
            for (int m = 0; m < 4; ++m) { bf16_t* rowp = O + (size_t)(row0 + ai * HALF + m * 16) * 1024 + ocol0;
                unsigned char* rowp8 = (unsigned char*)O + (size_t)(row0 + ai * HALF + m * 16) * 1024 + ocol0;
                float o[8];
#pragma unroll
                for (int n = 0; n < 2; ++n) { const f32x4 a = acc[ai][0][m][n] * s0 + bv[0][n], g = acc[ai][1][m][n] * s1 + bv[1][n];
#pragma unroll
                    for (int e = 0; e < 4; ++e) {
                        if (MODE == 0) { o[4 * n + e] = a[e] * __builtin_amdgcn_rcpf(1.f + __builtin_amdgcn_exp2f(g[e] * -1.4426950408889634f)); }
                        else { const float gt = fminf(a[e], 7.0f), up1 = __builtin_amdgcn_fmed3f(g[e], -6.0f * oscale, 8.0f * oscale);
                            o[4 * n + e] = up1 * (gt * __builtin_amdgcn_rcpf(1.f + __builtin_amdgcn_exp2f(gt * (-1.702f * 1.4426950408889634f)))); } } }
                if constexpr (OUT8) {
                    int w0 = 0, w1 = 0; w0 = __builtin_amdgcn_cvt_pk_fp8_f32(o[0], o[1], w0, false); w0 = __builtin_amdgcn_cvt_pk_fp8_f32(o[2], o[3], w0, true);
                    w1 = __builtin_amdgcn_cvt_pk_fp8_f32(o[4], o[5], w1, false); w1 = __builtin_amdgcn_cvt_pk_fp8_f32(o[6], o[7], w1, true);
                    typedef unsigned u32x2 __attribute__((ext_vector_type(2))); *(u32x2*)rowp8 = (u32x2){(unsigned)w0, (unsigned)w1}; (void)rowp;
                } else { (void)rowp8;
                u32x4 w; w.x = cvt_pk_bf16(o[0], o[1]); w.y = cvt_pk_bf16(o[2], o[3]); w.z = cvt_pk_bf16(o[4], o[5]); w.w = cvt_pk_bf16(o[6], o[7]);
                *(u32x4*)rowp = w; } }
    }
};
struct EpiDown {
    static constexpr bool PERM = true, AFTER_DRAIN = false;
    bf16_t* Y; const float* bias; const float* row_w; const int* row_dst; float ascale; const PG8_LAS int* gtab; float oscale;
    __device__ __forceinline__ void operator()(const f32x4 (&acc)[2][2][4][2], const Unit& u, int wr, int wc, int fr, int fq) const {
        asm volatile("" : "+v"(fr), "+v"(fq));
        const int pnl = u.pn & 3, ocol0 = pnl * BM + wc * 32 + 8 * fq, bcol0 = u.pn * BM + wc * 32 + 8 * fq; const int tbase = gtab[u.pm], tcnt = gtab[576 + u.pm];
        f32x4 bv[2][2];
#pragma unroll
        for (int bj = 0; bj < 2; ++bj)
#pragma unroll
            for (int n = 0; n < 2; ++n) bv[bj][n] = *(const f32x4*)(bias + bcol0 + bj * HALF + 4 * n);
        int dstv[2][4]; float wv[2][4];
#pragma unroll
        for (int ai = 0; ai < 2; ++ai)
#pragma unroll
            for (int m = 0; m < 4; ++m) { const int rl = wr * 64 + fr + ai * HALF + m * 16; const int ix = tbase + (rl < tcnt ? rl : 0); dstv[ai][m] = row_dst[ix]; wv[ai][m] = row_w[ix]; }
#pragma unroll
        for (int ai = 0; ai < 2; ++ai)
#pragma unroll
            for (int m = 0; m < 4; ++m) { const int rl = wr * 64 + fr + ai * HALF + m * 16;
                if (rl < tcnt) { const int dst = dstv[ai][m]; const float w8 = wv[ai][m] * oscale; unsigned char* rowp = (unsigned char*)Y + (size_t)dst * 1024 + ocol0;
#pragma unroll
                    for (int bj = 0; bj < 2; ++bj) { const f32x4 v0 = (acc[ai][bj][m][0] * ascale + bv[bj][0]) * w8, v1 = (acc[ai][bj][m][1] * ascale + bv[bj][1]) * w8;
                        int w0 = 0, w1 = 0; w0 = __builtin_amdgcn_cvt_pk_fp8_f32(fminf(fmaxf(v0[0], -448.f), 448.f), fminf(fmaxf(v0[1], -448.f), 448.f), w0, false); w0 = __builtin_amdgcn_cvt_pk_fp8_f32(fminf(fmaxf(v0[2], -448.f), 448.f), fminf(fmaxf(v0[3], -448.f), 448.f), w0, true);
                        w1 = __builtin_amdgcn_cvt_pk_fp8_f32(fminf(fmaxf(v1[0], -448.f), 448.f), fminf(fmaxf(v1[1], -448.f), 448.f), w1, false); w1 = __builtin_amdgcn_cvt_pk_fp8_f32(fminf(fmaxf(v1[2], -448.f), 448.f), fminf(fmaxf(v1[3], -448.f), 448.f), w1, true);
                        typedef unsigned u32x2 __attribute__((ext_vector_type(2))); *(u32x2*)(rowp + bj * HALF) = (u32x2){(unsigned)w0, (unsigned)w1}; } } }
    }
};
}

namespace att {
using bf16x8 = __attribute__((ext_vector_type(8))) short;
using s16x4  = __attribute__((ext_vector_type(4))) short;
using f32x16 = __attribute__((ext_vector_type(16))) float;
using u32x4  = __attribute__((ext_vector_type(4))) unsigned;
constexpr int NW = 8, QBLK = 32, KVBLK = 64;
constexpr float SCALE = 0.10206207261596575f;
constexpr float THR = 8.f;
constexpr int SHM_V = 16384, SHM_K = 16384, NBUF = 3, SHM_ATTN = NBUF * SHM_V + NBUF * SHM_K + NW * 64 * 4;
#define KSWZ(row, colB) ((row) * 256 + ((colB) ^ (((row) & 7) << 4)))
#define SBAR() __builtin_amdgcn_sched_barrier(0)
__device__ __forceinline__ int crow(int r, int hi) { return (r & 3) + 8 * (r >> 2) + 4 * hi; }
__device__ __forceinline__ unsigned cvtpk(float lo, float hi) { unsigned r; asm volatile("v_cvt_pk_bf16_f32 %0, %1, %2" : "=v"(r) : "v"(lo), "v"(hi)); return r; }

__device__ __forceinline__ void partialSM(f32x16& p0, f32x16& p1, float& m_reg, float& mn, float& alpha) {
  constexpr float C = SCALE * 1.4426950408889634f;
  float pmax = p0[0];
#pragma unroll
  for (int r = 1; r < 16; ++r) pmax = fmaxf(pmax, p0[r]);
#pragma unroll
  for (int r = 0; r < 16; ++r) pmax = fmaxf(pmax, p1[r]);
  { auto rr = __builtin_amdgcn_permlane32_swap(__float_as_uint(pmax), __float_as_uint(pmax), false, false);
    pmax = fmaxf(__uint_as_float(rr[0]), __uint_as_float(rr[1])); }
  if (__builtin_expect(__all(pmax - m_reg <= THR / SCALE), 1)) { mn = m_reg; alpha = 1.f; }
  else { mn = fmaxf(m_reg, pmax); alpha = __builtin_amdgcn_exp2f((m_reg - mn) * C); m_reg = mn; }
  float mnC = -mn * C;
#pragma unroll
  for (int r = 0; r < 16; ++r) p0[r] = fmaf(p0[r], C, mnC);
#pragma unroll
  for (int r = 0; r < 16; ++r) p1[r] = fmaf(p1[r], C, mnC);
#pragma unroll
  for (int r = 0; r < 16; ++r) p0[r] = __builtin_amdgcn_exp2f(p0[r]);
}
__device__ __forceinline__ void finishSM(f32x16& p0, f32x16& p1, float alpha, float& l_reg, bf16x8& pa0, bf16x8& pa1, bf16x8& pa2, bf16x8& pa3) {
#pragma unroll
  for (int r = 0; r < 16; ++r) p1[r] = __builtin_amdgcn_exp2f(p1[r]);
  float ps = 0;
#pragma unroll
  for (int r = 0; r < 16; ++r) ps += p0[r];
#pragma unroll
  for (int r = 0; r < 16; ++r) ps += p1[r];
  { auto rr = __builtin_amdgcn_permlane32_swap(__float_as_uint(ps), __float_as_uint(ps), false, false);
    ps = __uint_as_float(rr[0]) + __uint_as_float(rr[1]); }
  l_reg = l_reg * alpha + ps;
#define PK4(P, BASE, OUT) do { unsigned a0 = cvtpk(P[BASE + 0], P[BASE + 1]), a1 = cvtpk(P[BASE + 2], P[BASE + 3]);   \
    unsigned b0 = cvtpk(P[BASE + 4], P[BASE + 5]), b1 = cvtpk(P[BASE + 6], P[BASE + 7]);                              \
    auto r0 = __builtin_amdgcn_permlane32_swap(a0, b0, false, false); auto r1 = __builtin_amdgcn_permlane32_swap(a1, b1, false, false); \
    u32x4 w = {r0[0], r1[0], r0[1], r1[1]}; OUT = *reinterpret_cast<bf16x8*>(&w); } while (0)
  PK4(p0, 0, pa0); PK4(p0, 8, pa1); PK4(p1, 0, pa2); PK4(p1, 8, pa3);
#undef PK4
}
__device__ __forceinline__ void qkt(f32x16& p0, f32x16& p1, const bf16* Ks, const bf16x8* qr, int r32, int hi) {
  p0 = f32x16{}; p1 = f32x16{};
#pragma unroll
  for (int d0 = 0; d0 < 6; ++d0) { int cb = (d0 * 16 + hi * 8) * 2;
    bf16x8 b0 = *reinterpret_cast<const bf16x8*>((const char*)Ks + KSWZ(r32, cb));
    bf16x8 b1 = *reinterpret_cast<const bf16x8*>((const char*)Ks + KSWZ(32 + r32, cb));
    p0 = __builtin_amdgcn_mfma_f32_32x32x16_bf16(b0, qr[d0], p0, 0, 0, 0);
    p1 = __builtin_amdgcn_mfma_f32_32x32x16_bf16(b1, qr[d0], p1, 0, 0, 0); }
}
__device__ __forceinline__ int v_st(int k, int c) { const int kk = (k & ~0xC) | ((k & 4) << 1) | ((k & 8) >> 1); return ((kk >> 3) * 4 + (c >> 5)) * 512 + ((kk & 7) * 32 + (c & 31)) * 2; }
__device__ __forceinline__ int v_rd_base(int lane) { return ((lane & 3) << 3) | (((lane >> 2) & 3) << 6) | (((lane >> 4) & 1) << 5) | (((lane >> 5) & 1) << 8); }
constexpr int v_rd_off(int d0, int ks, int half) { return d0 * 512 + ks * 4096 + half * 2048; }
template <int OFF> __device__ __forceinline__ s16x4 tr_read(int vb) {
  s16x4 r; asm volatile("ds_read_b64_tr_b16 %0, %1 offset:%2" : "=&v"(r) : "v"(vb), "i"(OFF) : "memory"); return r;
}
template <int D0> __device__ __forceinline__ void pv_one(f32x16& od, int vb, bf16x8 pa0, bf16x8 pa1, bf16x8 pa2, bf16x8 pa3) {
  const s16x4 l0 = tr_read<v_rd_off(D0, 0, 0)>(vb), h0 = tr_read<v_rd_off(D0, 0, 1)>(vb), l1 = tr_read<v_rd_off(D0, 1, 0)>(vb), h1 = tr_read<v_rd_off(D0, 1, 1)>(vb);
  const s16x4 l2 = tr_read<v_rd_off(D0, 2, 0)>(vb), h2 = tr_read<v_rd_off(D0, 2, 1)>(vb), l3 = tr_read<v_rd_off(D0, 3, 0)>(vb), h3 = tr_read<v_rd_off(D0, 3, 1)>(vb);
  asm volatile("s_waitcnt lgkmcnt(0)" ::: "memory"); SBAR();
#define PK(L, H) (bf16x8){L[0], L[1], L[2], L[3], H[0], H[1], H[2], H[3]}
  od = __builtin_amdgcn_mfma_f32_32x32x16_bf16(pa0, PK(l0, h0), od, 0, 0, 0);
  od = __builtin_amdgcn_mfma_f32_32x32x16_bf16(pa1, PK(l1, h1), od, 0, 0, 0);
  od = __builtin_amdgcn_mfma_f32_32x32x16_bf16(pa2, PK(l2, h2), od, 0, 0, 0);
  od = __builtin_amdgcn_mfma_f32_32x32x16_bf16(pa3, PK(l3, h3), od, 0, 0, 0);
#undef PK
}
__device__ __forceinline__ void pv_d0(f32x16* o, int vb, bf16x8 pa0, bf16x8 pa1, bf16x8 pa2, bf16x8 pa3) {
  pv_one<0>(o[0], vb, pa0, pa1, pa2, pa3); pv_one<1>(o[1], vb, pa0, pa1, pa2, pa3);
}
__device__ __forceinline__ bf16x8 rope8(bf16x8 x, const float* tab, int pbase) {
  u32x4 w;
#pragma unroll
  for (int i = 0; i < 4; ++i) { const float x1 = __uint_as_float(((unsigned)(unsigned short)x[2 * i]) << 16), x2 = __uint_as_float(((unsigned)(unsigned short)x[2 * i + 1]) << 16);
    const float cs = tab[pbase + i], sn = tab[16 + pbase + i]; w[i] = cvtpk(x1 * cs - x2 * sn, x1 * sn + x2 * cs); }
  return *reinterpret_cast<bf16x8*>(&w);
}
__device__ __forceinline__ void attn_unit(const bf16* __restrict__ Qb, const bf16* __restrict__ KVb, const bf16* __restrict__ KRb, bf16* __restrict__ Ob,
                                          const float* __restrict__ rope, int seq, char* lds) {
  int tid_l = threadIdx.x; asm volatile("" : "+v"(tid_l));
  const int tid = tid_l, wid = tid >> 6, lane = tid & 63, r32 = lane & 31, hi = lane >> 5;
  bf16* V_lds = (bf16*)lds; bf16* K_lds = (bf16*)(lds + NBUF * SHM_V);
  float* ws = (float*)(lds + NBUF * SHM_V + NBUF * SHM_K) + wid * 64; float* li_l = ws; float* al_l = ws + 32;
  float m_reg = -1e30f, l_reg = 0; f32x16 o[2] = {}; bf16x8 qr[6];
  const bf16* Qw = Qb + (long)(wid * QBLK + r32) * 768 + hi * 8;
#pragma unroll
  for (int d0 = 0; d0 < 6; ++d0) qr[d0] = *reinterpret_cast<const bf16x8*>(Qw + d0 * 16);
  if (rope) { const float* tab = rope + (long)(wid * QBLK + r32) * 32; qr[4] = rope8(qr[4], tab, 4 * hi); qr[5] = rope8(qr[5], tab, 8 + 4 * hi); }
  const int sr = tid >> 4, ch = tid & 15;
  const bf16* kbase = ch < 8 ? KVb + ch * 8 : KRb + ((ch - 8) & 3) * 8; const long kstr = ch < 8 ? 1024 : 32;
  const int vkey = tid >> 3, vc8 = (tid & 7) * 8, vst0 = v_st(vkey, vc8);
  const bf16* vbase = KVb + 512 + vc8;
  const int vb0 = (int)(uintptr_t)V_lds + v_rd_base(lane);
  struct { bf16x8 vs0, ks0, ks1; } sr_[2];
#define SLOAD(i, k0) do { sr_[i].vs0 = *reinterpret_cast<const bf16x8*>(vbase + (long)((k0) + vkey) * 1024); \
    sr_[i].ks0 = *reinterpret_cast<const bf16x8*>(kbase + (long)((k0) + sr) * kstr); sr_[i].ks1 = *reinterpret_cast<const bf16x8*>(kbase + (long)((k0) + 32 + sr) * kstr); } while (0)
#define SWRITE(b, i) do { *(bf16x8*)((char*)V_lds + (b) * SHM_V + vst0) = sr_[i].vs0; int kc = ch * 16;               \
    *(bf16x8*)((char*)K_lds + (b) * SHM_K + KSWZ(sr, kc)) = sr_[i].ks0;                       \
    *(bf16x8*)((char*)K_lds + (b) * SHM_K + KSWZ(32 + sr, kc)) = sr_[i].ks1; } while (0)
#define SWAIT() asm volatile("s_waitcnt vmcnt(3)" ::: "memory")
#define RESC(a) do { if (__any((a) < 1.f)) { if (hi == 0) al_l[r32] = (a); asm volatile("s_waitcnt lgkmcnt(0)" ::: "memory"); \
    _Pragma("unroll") for (int d = 0; d < 2; ++d) _Pragma("unroll") for (int r = 0; r < 16; ++r) o[d][r] *= al_l[crow(r, hi)]; } } while (0)
  f32x16 pA0, pA1, pB0, pB1; float mnA, mnB, alA, alB; bf16x8 pa0, pa1, pa2, pa3; const int NT = seq / KVBLK;
  constexpr int SE = 0, SO = 1;
  SLOAD(SE, 0); asm volatile("s_waitcnt vmcnt(0)" ::: "memory"); SWRITE(0, SE); __syncthreads();
  qkt(pA0, pA1, K_lds, qr, r32, hi); partialSM(pA0, pA1, m_reg, mnA, alA);
  SLOAD(SO, KVBLK); if (2 < NT) SLOAD(SE, 2 * KVBLK);
  SWAIT(); SWRITE(1, SO); __syncthreads();
  int bprev = 0, bcur = 1, bnext = 2;
#define ATT_STEP(PN0, PN1, MNN, ALN, PO0, PO1, ALO, SL_LOAD, SL_WRITE, t) do { \
    SBAR(); qkt(PN0, PN1, (bf16*)((char*)K_lds + bcur * SHM_K), qr, r32, hi); \
    finishSM(PO0, PO1, ALO, l_reg, pa0, pa1, pa2, pa3); SBAR(); \
    if ((t) + 2 < NT) SLOAD(SL_LOAD, ((t) + 2) * KVBLK); SBAR(); \
    pv_d0(o, vb0 + bprev * (int)SHM_V, pa0, pa1, pa2, pa3); partialSM(PN0, PN1, m_reg, MNN, ALN); \
    SWAIT(); SWRITE(bnext, SL_WRITE); \
    RESC(ALN); __syncthreads(); \
    bprev = bcur; bcur = bnext; bnext = (bnext == 2) ? 0 : bnext + 1; } while (0)
  for (int j = 1; j + 1 < NT; j += 2) {
    ATT_STEP(pB0, pB1, mnB, alB, pA0, pA1, alA, SO, SE, j);
    ATT_STEP(pA0, pA1, mnA, alA, pB0, pB1, alB, SE, SO, j + 1);
  }
#undef ATT_STEP
  SBAR(); qkt(pB0, pB1, (bf16*)((char*)K_lds + bcur * SHM_K), qr, r32, hi);
  finishSM(pA0, pA1, alA, l_reg, pa0, pa1, pa2, pa3); SBAR();
  pv_d0(o, vb0 + bprev * (int)SHM_V, pa0, pa1, pa2, pa3); partialSM(pB0, pB1, m_reg, mnB, alB);
  RESC(alB);
  finishSM(pB0, pB1, alB, l_reg, pa0, pa1, pa2, pa3); SBAR();
  pv_d0(o, vb0 + bcur * (int)SHM_V, pa0, pa1, pa2, pa3);
  if (hi == 0) li_l[r32] = l_reg; asm volatile("s_waitcnt lgkmcnt(0)" ::: "memory");
  float rli[16];
#pragma unroll
  for (int r = 0; r < 16; ++r) rli[r] = __builtin_amdgcn_rcpf(li_l[crow(r, hi)]);
  bf16* Ow = Ob + (long)(wid * QBLK) * 1024;
#pragma unroll
  for (int r = 0; r < 16; ++r) { int orow = crow(r, hi);
#pragma unroll
    for (int d0 = 0; d0 < 2; ++d0) { const float v = o[d0][r] * rli[r]; Ow[(long)orow * 1024 + d0 * 32 + r32] = (bf16)(cvtpk(v, v) & 0xffffu); } }
#undef SLOAD
#undef SWRITE
#undef SWAIT
#undef RESC
}
}

struct Args { const float* in[33]; float* out; unsigned char* ws; int ph_lo, ph_hi; };
enum { I_X = 0, I_C, I_CTX, I_CCTX, I_MODW, I_MODB, I_LN1G, I_LN1B, I_LN2G, I_LN2B, I_WIN, I_QNORM, I_KVNORM, I_WUQ, I_WUK, I_WUV, I_LBL, I_HGNORM, I_WOUT,
       I_PW1W, I_PW1B, I_DWW, I_DWB, I_CLNG, I_CLNB, I_PW2W, I_PW2B, I_RW, I_RB, I_WGU, I_BGU, I_WDN, I_BDN };

__device__ __forceinline__ int dst_row(int n, int mode, int row_off) {
    if (mode == 0) return row_off + n;
    int f, g; if (mode == 1) { f = n >> 1; g = n & 1; } else { g = n >> 10; f = n & 1023; }
    return row_off + 256 * (f >> 7) + 128 * g + (f & 127);
}
__device__ __forceinline__ unsigned pack_fp8x4(float a, float b, float c, float d) { int w = 0; w = __builtin_amdgcn_cvt_pk_fp8_f32(fminf(fmaxf(a, -448.f), 448.f), fminf(fmaxf(b, -448.f), 448.f), w, false);
    w = __builtin_amdgcn_cvt_pk_fp8_f32(fminf(fmaxf(c, -448.f), 448.f), fminf(fmaxf(d, -448.f), 448.f), w, true); return (unsigned)w; }
struct TrItem { const float* W; bf16* WT; int K, N, mode, row_off, item; float f8scale; };
__device__ __forceinline__ void tr_load(const TrItem& d, f32x4 (&v)[16], int lane) {
    const int nblk = (d.N + 63) >> 6, kb = d.item / nblk, nb = d.item - kb * nblk, k0 = 64 * kb, n0 = 64 * nb;
    const int nc = n0 + 4 * (lane & 15), kr = lane >> 4;
#pragma unroll
    for (int i = 0; i < 16; ++i) v[i] = (nc < d.N) ? __builtin_nontemporal_load((const f32x4*)(d.W + (size_t)(k0 + 4 * i + kr) * d.N + nc)) : (f32x4){0.f, 0.f, 0.f, 0.f};
}
__device__ __forceinline__ void tr_lds_write(const f32x4 (&v)[16], LAS float* scr, int lane) {
    const int kr = lane >> 4;
#pragma unroll
    for (int i = 0; i < 16; ++i) { LAS float* s = scr + (4 * i + kr) * 65 + 4 * (lane & 15); s[0] = v[i][0]; s[1] = v[i][1]; s[2] = v[i][2]; s[3] = v[i][3]; }
}
__device__ __forceinline__ void tr_store(const TrItem& d, LAS float* scr, int lane) {
    const int nblk = (d.N + 63) >> 6, kb = d.item / nblk, nb = d.item - kb * nblk, k0 = 64 * kb, n0 = 64 * nb;
    const int c = lane & 7; const int K = d.K;
#pragma unroll
    for (int j = 0; j < 8; ++j) { const int nl = (lane >> 3) + 8 * j, n = n0 + nl; const LAS float* s = scr + (8 * c) * 65 + nl;
        if (n < d.N) { if (d.f8scale > 0.f) { const float f8 = d.f8scale; v2u o8; o8.x = pack_fp8x4(s[0 * 65] * f8, s[1 * 65] * f8, s[2 * 65] * f8, s[3 * 65] * f8); o8.y = pack_fp8x4(s[4 * 65] * f8, s[5 * 65] * f8, s[6 * 65] * f8, s[7 * 65] * f8);
                *(v2u*)((unsigned char*)d.WT + (size_t)dst_row(n, d.mode, d.row_off) * K + k0 + 8 * c) = o8; }
            else { v4u o; o.x = pk2(s[0 * 65], s[1 * 65]); o.y = pk2(s[2 * 65], s[3 * 65]); o.z = pk2(s[4 * 65], s[5 * 65]); o.w = pk2(s[6 * 65], s[7 * 65]);
                *(v4u*)(d.WT + (size_t)dst_row(n, d.mode, d.row_off) * K + k0 + 8 * c) = o; } } }
}
__device__ __forceinline__ void convert_items(const Args& a, unsigned char* ws, LAS float* scr, int lane, int gw, int NGW, int it_lo, int it_hi) {
    constexpr int I0 = 16 * 51, I1 = 6 * 12, I2 = 4 * 8, I3 = 4 * 8, I4 = 256, I5 = 512;
    constexpr int NGU = 64 * 512, NDN = 64 * 256;
    auto decode = [&](int it) -> TrItem {
        TrItem d; int r = it; d.f8scale = 0.f; d.mode = 0; d.row_off = 0;
        if (r < NGU) { const int mi = r >> 9; d.W = a.in[I_WGU] + (size_t)mi * 1024 * 2048; d.K = 1024; d.N = 2048; d.WT = (bf16*)(ws + WS_WGU + (size_t)mi * 2048 * 1024); d.mode = 1; d.item = r & 511; d.f8scale = SC_WGU; return d; } r -= NGU;
        if (r < NDN) { const int mi = r >> 8; d.W = a.in[I_WDN] + (size_t)mi * 1024 * 1024; d.K = 1024; d.N = 1024; d.WT = (bf16*)(ws + WS_WDN + (size_t)mi * 1024 * 1024); d.item = r & 255; d.f8scale = SC_WDN; return d; } r -= NDN;
        if (r < I0) { d.W = a.in[I_WIN]; d.K = 1024; d.N = 3232; d.WT = (bf16*)(ws + WS_WIN); d.item = r; d.f8scale = SC_WIN; return d; } r -= I0;
        if (r < I1) { d.W = a.in[I_WUQ]; d.K = 384; d.N = 768; d.WT = (bf16*)(ws + WS_WUQ); d.item = r; return d; } r -= I1;
        if (r < I2) { d.W = a.in[I_WUK]; d.K = 256; d.N = 512; d.WT = (bf16*)(ws + WS_WUKV); d.item = r; return d; } r -= I2;
        if (r < I3) { d.W = a.in[I_WUV]; d.K = 256; d.N = 512; d.WT = (bf16*)(ws + WS_WUKV); d.row_off = 512; d.item = r; return d; } r -= I3;
        if (r < I4) { d.W = a.in[I_WOUT]; d.K = 1024; d.N = 1024; d.WT = (bf16*)(ws + WS_WOUT); d.item = r; return d; } r -= I4;
        if (r < I5) { d.W = a.in[I_PW1W]; d.K = 1024; d.N = 2048; d.WT = (bf16*)(ws + WS_WPW1); d.mode = 2; d.item = r; d.f8scale = SC_WPW; return d; } r -= I5;
        d.W = a.in[I_PW2W]; d.K = 1024; d.N = 1024; d.WT = (bf16*)(ws + WS_WPW2); d.item = r; d.f8scale = SC_WPW; return d; };
    f32x4 tv[16];
    int it = it_lo + gw;
    if (it < it_hi) { const TrItem d0 = decode(it); tr_load(d0, tv, lane); }
    for (; it < it_hi; it += NGW) {
        const TrItem d = decode(it);
        tr_lds_write(tv, scr, lane);
        if (it + NGW < it_hi) { const TrItem dn = decode(it + NGW); tr_load(dn, tv, lane); }
        LDS_WAIT();
        tr_store(d, scr, lane);
        LDS_WAIT();
    }
}
__device__ __forceinline__ void phase_prologue(const Args& a, LAS unsigned char* lds, int tid, int lane, int wave) {
    unsigned char* ws = a.ws;
    const int G = gridDim.x, B = blockIdx.x;
    {
        LAS float* sc = (LAS float*)lds;
        LAS float* red = (LAS float*)(lds + 36864);
        float* modv = (float*)(ws + WS_MODV);
        bool have = false;
        for (int it = B; it < 192; it += G) {
            if (!have) { for (int i = tid; i < 9 * 1024; i += NTHR) { const int r = i >> 10, k = i & 1023; const float x = r < 8 ? a.in[I_C][r * 1024 + k] : a.in[I_CCTX][k]; sc[i] = x * sigm(x); } __syncthreads(); have = true; }
            const int l = it / 96, jc = it % 96, kg = tid >> 6, jj = tid & 63, j = jc * 64 + jj;
            float acc[9];
#pragma unroll
            for (int r = 0; r < 9; ++r) acc[r] = 0.f;
            const float* wp = a.in[I_MODW] + ((size_t)l * 1024 + kg * 128) * 6144 + j;
            for (int k0 = 0; k0 < 128; k0 += 16) { float w[16];
#pragma unroll
                for (int kk = 0; kk < 16; ++kk) w[kk] = wp[(size_t)(k0 + kk) * 6144];
#pragma unroll
                for (int kk = 0; kk < 16; ++kk)
#pragma unroll
                    for (int r = 0; r < 9; ++r) acc[r] += sc[r * 1024 + kg * 128 + k0 + kk] * w[kk]; }
#pragma unroll
            for (int r = 0; r < 9; ++r) red[(kg * 9 + r) * 64 + jj] = acc[r];
            __syncthreads();
            for (int i = tid; i < 576; i += NTHR) { const int r = i >> 6, j2 = i & 63; float s = a.in[I_MODB][l * 6144 + jc * 64 + j2];
#pragma unroll
                for (int g = 0; g < 8; ++g) s += red[(g * 9 + r) * 64 + j2];
                modv[((size_t)l * 9 + r) * 6144 + jc * 64 + j2] = s; }
            __syncthreads();
        }
        __syncthreads();
    }
    const int gw = B * NWAVES + wave, NGW = G * NWAVES, gt = B * NTHR + tid, NGT = G * NTHR;
    { float* rope = (float*)(ws + WS_ROPE);
      for (int i = gt; i < 4096 * 16; i += NGT) { const int t = i >> 4, p = i & 15; const float pos = (float)(p < 8 ? (t >> 6) : (t & 63));
          const float inv = __powf(10000.0f, -(float)(p & 7) * 0.125f); const float ang = pos * inv; rope[t * 32 + p] = cosf(ang); rope[t * 32 + 16 + p] = sinf(ang); }
      float* bgu = (float*)(ws + WS_BGU);
      for (int i = gt; i < 2 * 32 * 2048; i += NGT) { const int le = i >> 11, np = i & 2047, q = np >> 8, g = (np >> 7) & 1, r = np & 127, f = 128 * q + r; bgu[i] = a.in[I_BGU][(size_t)le * 2048 + 2 * f + g]; }
      float* pb = (float*)(ws + WS_PW1B);
      for (int i = gt; i < 2048; i += NGT) { const int q = i >> 8, g = (i >> 7) & 1, r = i & 127, f = 128 * q + r; pb[i] = a.in[I_PW1B][g * 1024 + f]; }
      v4u* zp = (v4u*)(ws + WS_WIN + (size_t)3232 * 1024);
      for (int i = gt; i < 96 * 1024 / 16; i += NGT) zp[i] = (v4u){0u, 0u, 0u, 0u};
    }
    LAS float* scr = (LAS float*)(lds + wave * 16640);
    constexpr int I0 = 16 * 51, I1 = 6 * 12, I2 = 4 * 8, I3 = 4 * 8, I4 = 256, I5 = 512, I6 = 256, SMALL = I0 + I1 + I2 + I3 + I4 + I5 + I6;
    constexpr int NGU = 64 * 512, NDN = 64 * 256, NITEMS = SMALL + NGU + NDN;
    convert_items(a, ws, scr, lane, B * NWAVES + wave, G * NWAVES, NGU + NDN, NITEMS);
}
__device__ __forceinline__ void convert_moe_share(const Args& a, LAS unsigned char* lds, int lane, int wave) {
    LAS float* scr = (LAS float*)(lds + wave * 16640);
    constexpr int NGU = 64 * 512, NDN = 64 * 256;
    convert_items(a, a.ws, scr, lane, blockIdx.x * NWAVES + wave, gridDim.x * NWAVES, 0, NGU + NDN);
}

__device__ __forceinline__ void phase_mod0(const Args& a, int lane, int wave) {
    const int gw = blockIdx.x * NWAVES + wave, NGW = gridDim.x * NWAVES;
    const float* modv = (const float*)(a.ws + WS_MODV);
    bf16* X = (bf16*)(a.ws + WS_X);
    for (int r0 = 2 * gw; r0 < NTOK; r0 += 2 * NGW) {
        f32x4 xv[2][4]; const float* mvp[2];
#pragma unroll
        for (int q = 0; q < 2; ++q) { const int r = r0 + q; const int b = r / TPB, p = r - b * TPB;
            const float* src = p < CTXL ? a.in[I_CTX] + ((size_t)b * CTXL + p) * 1024 : a.in[I_X] + ((size_t)b * SEQ + (p - CTXL)) * 1024;
            mvp[q] = modv + (size_t)(p < CTXL ? 8 : b) * 6144;
#pragma unroll
            for (int j = 0; j < 4; ++j) xv[q][j] = *(const f32x4*)(src + 4 * (lane + 64 * j)); }
#pragma unroll
        for (int q = 0; q < 2; ++q)
#pragma unroll
            for (int j = 0; j < 4; ++j) { const int c = 4 * (lane + 64 * j); const f32x4 sh = *(const f32x4*)(mvp[q] + c), sc = *(const f32x4*)(mvp[q] + 1024 + c);
                const f32x4 y = (xv[q][j] * (sc + 1.0f) + sh) * SC_A0; *(unsigned*)((unsigned char*)X + (size_t)(r0 + q) * 1024 + c) = pack_fp8x4(y[0], y[1], y[2], y[3]); }
    }
}

__device__ __forceinline__ void phase_norm0(const Args& a, int lane, int wave) {
    const int gw = blockIdx.x * NWAVES + wave, NGW = gridDim.x * NWAVES;
    const bf16* Z = (const bf16*)(a.ws + WS_Z); bf16* CQN = (bf16*)(a.ws + WS_CQN); bf16* CKVN = (bf16*)(a.ws + WS_CKVN); bf16* KRR = (bf16*)(a.ws + WS_KRR);
    const float* rope = (const float*)(a.ws + WS_ROPE);
    float gq[8], gk[8];
#pragma unroll
    for (int i = 0; i < 8; ++i) { gq[i] = lane < 48 ? a.in[I_QNORM][8 * lane + i] : 0.f; gk[i] = lane < 32 ? a.in[I_KVNORM][8 * lane + i] : 0.f; }
    for (int r = gw; r < NTOK; r += NGW) {
        const bf16* z = Z + (size_t)r * ZC; const int p = r % TPB;
        bf16x8 q8 = {}, k8 = {}, r8 = {};
        if (lane < 48) q8 = *(const bf16x8*)(z + ZQ + 8 * lane);
        if (lane < 32) k8 = *(const bf16x8*)(z + ZKV + 8 * lane);
        if (lane < 4) r8 = *(const bf16x8*)(z + ZKR + 8 * lane);
        float qf[8], kf[8], sq = 0.f, sk = 0.f;
#pragma unroll
        for (int i = 0; i < 8; ++i) { qf[i] = bf2f((unsigned short)q8[i]); kf[i] = bf2f((unsigned short)k8[i]); sq += qf[i] * qf[i]; sk += kf[i] * kf[i]; }
        sq = wave_sum(sq); sk = wave_sum(sk);
        const float rq = rsqrtf(sq * (1.f / 384.f) + RMS_EPS), rk = rsqrtf(sk * (1.f / 256.f) + RMS_EPS);
        if (lane < 48) { v4u o; o.x = pk2(qf[0] * rq * gq[0], qf[1] * rq * gq[1]); o.y = pk2(qf[2] * rq * gq[2], qf[3] * rq * gq[3]); o.z = pk2(qf[4] * rq * gq[4], qf[5] * rq * gq[5]); o.w = pk2(qf[6] * rq * gq[6], qf[7] * rq * gq[7]);
            *(v4u*)(CQN + (size_t)r * 384 + 8 * lane) = o; }
        if (lane < 32) { v4u o; o.x = pk2(kf[0] * rk * gk[0], kf[1] * rk * gk[1]); o.y = pk2(kf[2] * rk * gk[2], kf[3] * rk * gk[3]); o.z = pk2(kf[4] * rk * gk[4], kf[5] * rk * gk[5]); o.w = pk2(kf[6] * rk * gk[6], kf[7] * rk * gk[7]);
            *(v4u*)(CKVN + (size_t)r * 256 + 8 * lane) = o; }
        if (lane < 4) { bf16x8 o8 = r8; if (p >= CTXL) o8 = att::rope8(r8, rope + (size_t)(p - CTXL) * 32, 4 * lane); *(bf16x8*)(KRR + (size_t)r * 32 + 8 * lane) = o8; }
    }
}

__device__ __forceinline__ void hgrn_unit(const Args& a, int unit, LAS unsigned char* lds, int tid) {
    const int b = unit >> 5, head = (unit >> 3) & 3, dir = (unit >> 2) & 1, sl = unit & 3;
    const bf16* Z = (const bf16*)(a.ws + WS_Z);
    float* Od = (float*)(a.ws + (dir ? WS_OB : WS_OF));
    LAS float* lbv = (LAS float*)lds;
    constexpr int BUF0 = 1024, BUFSZ = 28672, OFF_Q = 16384, OFF_V = 24576;
    if (tid < 128) { const int c = head * 128 + tid; const float l0 = a.in[I_LBL][c], l1 = a.in[I_LBL][512 + c], l2 = a.in[I_LBL][1024 + c]; const float m = fmaxf(l0, fmaxf(l1, l2));
        const float e0 = __expf(l0 - m), e1 = __expf(l1 - m), e2 = __expf(l2 - m); lbv[tid] = e0 / (e0 + e1 + e2); }
    __syncthreads();
    const int lt = tid >> 4, lcg = tid & 15;
    float lb8[8];
#pragma unroll
    for (int i = 0; i < 8; ++i) lb8[i] = lbv[8 * lcg + i];
    const int fcol = (dir ? ZHB : ZHF) + head * 128 + 8 * lcg, qcol = ZHQ + head * 128 + 8 * lcg;
    const int vt = tid >> 2, vcol = ZHI + head * 128 + sl * 32 + (tid & 3) * 8;
    const int wave = tid >> 6, lane = tid & 63, vv = lane >> 4, cg = lane & 15, vloc = wave * 4 + vv;
    const size_t zb = (size_t)b * TPB;
    bf16x8 rq, rf, rv;
#define TOKP(n) (dir ? ((n) < CTXL ? (CTXL - 1 - (n)) : (TPB + CTXL - 1 - (n))) : (n))
#define HG_LOAD(i) do { const int n_ = 32 * (i) + lt; const bf16* zr_ = Z + (zb + TOKP(n_)) * ZC; rq = *(const bf16x8*)(zr_ + qcol); rf = *(const bf16x8*)(zr_ + fcol); \
        if (tid < 128) { const int n2_ = 32 * (i) + vt; rv = *(const bf16x8*)(Z + (zb + TOKP(n2_)) * ZC + vcol); } } while (0)
#define HG_WRITE(bufi) do { LAS unsigned char* bp_ = lds + BUF0 + (bufi) * BUFSZ; float f_[8]; \
        _Pragma("unroll") for (int i_ = 0; i_ < 8; ++i_) f_[i_] = lb8[i_] + (1.f - lb8[i_]) * sigm(bf2f((unsigned short)rf[i_])); \
        *(LAS f32x4*)(bp_ + ((lt * 128 + lcg * 4) * 4)) = (f32x4){f_[0], f_[1], f_[2], f_[3]}; *(LAS f32x4*)(bp_ + ((lt * 128 + 64 + lcg * 4) * 4)) = (f32x4){f_[4], f_[5], f_[6], f_[7]}; \
        *(LAS bf16x8*)(bp_ + OFF_Q + (lt * 128 + lcg * 8) * 2) = rq; \
        if (tid < 128) { float v_[8]; _Pragma("unroll") for (int i_ = 0; i_ < 8; ++i_) v_[i_] = bf2f((unsigned short)rv[i_]); \
            *(LAS f32x4*)(bp_ + OFF_V + (vt * 32 + (tid & 3) * 8) * 4) = (f32x4){v_[0], v_[1], v_[2], v_[3]}; *(LAS f32x4*)(bp_ + OFF_V + (vt * 32 + (tid & 3) * 8 + 4) * 4) = (f32x4){v_[4], v_[5], v_[6], v_[7]}; } } while (0)
    float S[8];
#pragma unroll
    for (int j = 0; j < 8; ++j) S[j] = 0.f;
    HG_LOAD(0); HG_WRITE(0); __syncthreads();
    const bool b3 = (cg & 8) != 0, b2 = (cg & 4) != 0, b1 = (cg & 2) != 0, b0 = (cg & 1) != 0;
    for (int i = 0; i < TPB / 32; ++i) {
        if (i + 1 < TPB / 32) HG_LOAD(i + 1);
        const LAS unsigned char* bp = lds + BUF0 + (i & 1) * BUFSZ;
#pragma unroll 1
        for (int g = 0; g < 4; ++g) {
            const LAS unsigned char* gp = bp + g * 8 * 512;
            float ot[8];
#pragma unroll
            for (int t = 0; t < 8; ++t) {
                const f32x4 f0 = *(const LAS f32x4*)(gp + ((t * 128 + cg * 4) * 4)), f1 = *(const LAS f32x4*)(gp + ((t * 128 + 64 + cg * 4) * 4));
                const bf16x8 q8 = *(const LAS bf16x8*)(bp + OFF_Q + ((g * 8 + t) * 128 + cg * 8) * 2);
                const float v = *(const LAS float*)(bp + OFF_V + ((g * 8 + t) * 32 + vloc) * 4);
                float acc = 0.f;
#pragma unroll
                for (int j = 0; j < 8; ++j) { const float fj = j < 4 ? f0[j] : f1[j - 4]; const float qj = bf2f((unsigned short)q8[j]);
                    const float kv = fmaf(-fj, v, v); S[j] = fmaf(fj, S[j], kv); acc = fmaf(S[j], qj, acc); }
                ot[t] = acc;
            }
#pragma unroll
            for (int k = 0; k < 4; ++k) { const float snd = b3 ? ot[k] : ot[k + 4]; const float rcv = __shfl_xor(snd, 8); ot[k] = (b3 ? ot[k + 4] : ot[k]) + rcv; }
#pragma unroll
            for (int k = 0; k < 2; ++k) { const float snd = b2 ? ot[k] : ot[k + 2]; const float rcv = __shfl_xor(snd, 4); ot[k] = (b2 ? ot[k + 2] : ot[k]) + rcv; }
            { const float snd = b1 ? ot[0] : ot[1]; const float rcv = __shfl_xor(snd, 2); ot[0] = (b1 ? ot[1] : ot[0]) + rcv; }
            ot[0] += __shfl_xor(ot[0], 1);
            if (!b0) { const int n = 32 * i + 8 * g + (cg >> 1); const int p = TOKP(n); if (p >= CTXL) Od[(zb + p) * 512 + head * 128 + sl * 32 + vloc] = ot[0]; }
        }
        if (i + 1 < TPB / 32) HG_WRITE((i + 1) & 1);
        __syncthreads();
    }
#undef TOKP
#undef HG_LOAD
#undef HG_WRITE
}

__device__ __forceinline__ void phase_readout(const Args& a, int lane, int wave) {
    const int gw = blockIdx.x * NWAVES + wave, NGW = gridDim.x * NWAVES;
    const bf16* OF = (const bf16*)(a.ws + WS_OF); const bf16* OB = (const bf16*)(a.ws + WS_OB);
    const bf16* Z = (const bf16*)(a.ws + WS_Z); bf16* MIX = (bf16*)(a.ws + WS_Y);
    float hn[8];
#pragma unroll
    for (int i = 0; i < 8; ++i) hn[i] = a.in[I_HGNORM][((8 * lane) & 127) + i];
    for (int lr = gw; lr < NLAT; lr += NGW) {
        const size_t r = (size_t)grow_of(lr);
        const bf16x8 a8 = *(const bf16x8*)(OF + r * 512 + 8 * lane), c8 = *(const bf16x8*)(OB + r * 512 + 8 * lane);
        const bf16x8 g8 = *(const bf16x8*)(Z + r * ZC + ZHG + 8 * lane);
        float o[8]; float ss = 0.f;
#pragma unroll
        for (int i = 0; i < 8; ++i) o[i] = bf2f((unsigned short)a8[i]) + bf2f((unsigned short)c8[i]);
#pragma unroll
        for (int i = 0; i < 8; ++i) ss += o[i] * o[i];
        ss += __shfl_xor(ss, 1); ss += __shfl_xor(ss, 2); ss += __shfl_xor(ss, 4); ss += __shfl_xor(ss, 8);
        const float rs = rsqrtf(ss * (1.f / 128.f) + RMS_EPS);
        float y[8];
#pragma unroll
        for (int i = 0; i < 8; ++i) { const float g = bf2f((unsigned short)g8[i]); y[i] = o[i] * rs * hn[i] * (g * sigm(g)); }
        v4u w; w.x = pk2(y[0], y[1]); w.y = pk2(y[2], y[3]); w.z = pk2(y[4], y[5]); w.w = pk2(y[6], y[7]);
        *(v4u*)(MIX + r * 1024 + 512 + 8 * lane) = w;
    }
}

__device__ __forceinline__ int rows_per_block() { const int G = gridDim.x; return (((NLAT + G - 1) / G) + 15) & ~15; }
__device__ __forceinline__ void phase_ln1(const Args& a, int l, LAS unsigned char* lds, int tid, int lane, int wave) {
    typedef short bf16x8s __attribute__((ext_vector_type(8)));
    const int RB = rows_per_block(), lr_base = blockIdx.x * RB;
    const bf16* PRE = (const bf16*)(a.ws + WS_PRE); bf16* XB = (bf16*)(a.ws + WS_X);
    const float* modv = (const float*)(a.ws + WS_MODV) + (size_t)l * 9 * 6144;
    const float* lng = a.in[I_LN1G] + l * 1024; const float* lnb = a.in[I_LN1B] + l * 1024;
    const float* rw = a.in[I_RW] + (size_t)l * 1024 * 32; const float* rb = a.in[I_RB] + l * 32;
    constexpr int XT_LD = 1028, O_PART = 16 * XT_LD * 4, O_LG = O_PART + 8 * 32 * 16 * 4, O_HIST = O_LG + 16 * 33 * 4 + 64, O_CCNT = O_HIST + 256, O_TIL = O_CCNT + 2048, O_TWL = O_TIL + 4096;
    LAS float* XT = (LAS float*)lds; LAS float* PART = (LAS float*)(lds + O_PART); LAS float* LG = (LAS float*)(lds + O_LG);
    LAS int* hist = (LAS int*)(lds + O_HIST);
    LAS int* ccnt = (LAS int*)(lds + O_CCNT);
    LAS int* til = (LAS int*)(lds + O_TIL);
    LAS float* twl = (LAS float*)(lds + O_TWL);
    __syncthreads();
    if (tid < 32) hist[tid] = 0;
    bf16x8s whi[2][4], wlo[2][4];
    { const int e15 = lane & 15, kq = lane >> 4;
#pragma unroll
      for (int t = 0; t < 2; ++t)
#pragma unroll
          for (int sI = 0; sI < 4; ++sI) { float wv[8];
#pragma unroll
              for (int j = 0; j < 8; ++j) wv[j] = rw[(size_t)(128 * wave + 32 * sI + 8 * kq + j) * 32 + 16 * t + e15];
              v4u ph, pl;
#pragma unroll
              for (int j = 0; j < 4; ++j) { const unsigned p = pk2(wv[2 * j], wv[2 * j + 1]); const float h0 = __uint_as_float(p << 16), h1 = __uint_as_float(p & 0xffff0000u); ph[j] = p; pl[j] = pk2(wv[2 * j] - h0, wv[2 * j + 1] - h1); }
              whi[t][sI] = __builtin_bit_cast(bf16x8s, ph); wlo[t][sI] = __builtin_bit_cast(bf16x8s, pl); } }
    const int ngroups = RB / 16;
    v2u xr[2][4];
#define LN1_LOAD(g) do { _Pragma("unroll") for (int rr_ = 0; rr_ < 2; ++rr_) { const int lr_ = lr_base + 16 * (g) + 2 * wave + rr_; const size_t r_ = (size_t)grow_of(lr_ < NLAT ? lr_ : NLAT - 1); \
        _Pragma("unroll") for (int j_ = 0; j_ < 4; ++j_) xr[rr_][j_] = *(const v2u*)(PRE + r_ * 1024 + 4 * (lane + 64 * j_)); } } while (0)
#if defined(PROBE_LN1X2)
    for (int rep_ = 0; rep_ < 2; ++rep_) { __syncthreads(); if (tid < 32) hist[tid] = 0; __syncthreads();
#endif
    LN1_LOAD(0);
    for (int g = 0; g < ngroups; ++g) {
#pragma unroll
        for (int rr = 0; rr < 2; ++rr) {
            const int lr = lr_base + 16 * g + 2 * wave + rr; const bool ok = lr < NLAT; const size_t r = (size_t)grow_of(ok ? lr : NLAT - 1); const int b = (ok ? lr : NLAT - 1) >> 12;
            const float* mv = modv + (size_t)b * 6144;
            f32x4 x[4]; float s = 0.f;
#pragma unroll
            for (int j = 0; j < 4; ++j) { const v2u p = xr[rr][j]; x[j] = (f32x4){__uint_as_float(p.x << 16), __uint_as_float(p.x & 0xffff0000u), __uint_as_float(p.y << 16), __uint_as_float(p.y & 0xffff0000u)}; s += (x[j][0] + x[j][1]) + (x[j][2] + x[j][3]); }
            const float mean = wave_sum(s) * (1.f / 1024.f); float s2 = 0.f;
#pragma unroll
            for (int j = 0; j < 4; ++j) { x[j] = x[j] - mean; s2 += (x[j][0] * x[j][0] + x[j][1] * x[j][1]) + (x[j][2] * x[j][2] + x[j][3] * x[j][3]); }
            const float rstd = rsqrtf(wave_sum(s2) * (1.f / 1024.f) + LN_EPS);
#pragma unroll
            for (int j = 0; j < 4; ++j) { const int c = 4 * (lane + 64 * j); const f32x4 gg = *(const f32x4*)(lng + c), bb = *(const f32x4*)(lnb + c);
                const f32x4 hv = x[j] * rstd * gg + bb;
                const f32x4 sh = *(const f32x4*)(mv + 3 * 1024 + c), sc = *(const f32x4*)(mv + 4 * 1024 + c);
                const f32x4 bm = hv * (sc + 1.0f) + sh;
                if (ok) *(unsigned*)((unsigned char*)XB + r * 1024 + c) = pack_fp8x4(bm[0] * SC_X8, bm[1] * SC_X8, bm[2] * SC_X8, bm[3] * SC_X8);
                *(LAS f32x4*)(XT + (2 * wave + rr) * XT_LD + c) = bm; }
        }
        if (g + 1 < ngroups) LN1_LOAD(g + 1);
        __syncthreads();
        { const int rr = lane & 15, kq = lane >> 4;
          f32x4 acc0 = {0.f, 0.f, 0.f, 0.f}, acc1 = {0.f, 0.f, 0.f, 0.f};
#pragma unroll
          for (int sI = 0; sI < 4; ++sI) { const LAS float* xp = XT + rr * XT_LD + 128 * wave + 32 * sI + 8 * kq; const f32x4 v0 = *(const LAS f32x4*)xp, v1 = *(const LAS f32x4*)(xp + 4);
              const float bv[8] = {v0[0], v0[1], v0[2], v0[3], v1[0], v1[1], v1[2], v1[3]}; v4u ph, pl;
#pragma unroll
              for (int j = 0; j < 4; ++j) { const unsigned p = pk2(bv[2 * j], bv[2 * j + 1]); const float h0 = __uint_as_float(p << 16), h1 = __uint_as_float(p & 0xffff0000u); ph[j] = p; pl[j] = pk2(bv[2 * j] - h0, bv[2 * j + 1] - h1); }
              const bf16x8s bh = __builtin_bit_cast(bf16x8s, ph), bl = __builtin_bit_cast(bf16x8s, pl);
              acc0 = __builtin_amdgcn_mfma_f32_16x16x32_bf16(whi[0][sI], bh, acc0, 0, 0, 0); acc0 = __builtin_amdgcn_mfma_f32_16x16x32_bf16(whi[0][sI], bl, acc0, 0, 0, 0); acc0 = __builtin_amdgcn_mfma_f32_16x16x32_bf16(wlo[0][sI], bh, acc0, 0, 0, 0);
              acc1 = __builtin_amdgcn_mfma_f32_16x16x32_bf16(whi[1][sI], bh, acc1, 0, 0, 0); acc1 = __builtin_amdgcn_mfma_f32_16x16x32_bf16(whi[1][sI], bl, acc1, 0, 0, 0); acc1 = __builtin_amdgcn_mfma_f32_16x16x32_bf16(wlo[1][sI], bh, acc1, 0, 0, 0); }
#pragma unroll
          for (int q = 0; q < 4; ++q) { PART[(wave * 32 + 4 * kq + q) * 16 + rr] = acc0[q]; PART[(wave * 32 + 16 + 4 * kq + q) * 16 + rr] = acc1[q]; } }
        __syncthreads();
        { const int e = tid >> 4, rr = tid & 15; float sacc = rb[e];
#pragma unroll
          for (int w = 0; w < 8; ++w) sacc += PART[(w * 32 + e) * 16 + rr];
          LG[rr * 33 + e] = sacc; }
        __syncthreads();
        if (wave == (g & 7) && lane < 16) { const int lr = lr_base + 16 * g + lane;
            if (lr < NLAT) { float lg[32];
#pragma unroll
                for (int e = 0; e < 32; ++e) lg[e] = LG[lane * 33 + e];
                unsigned taken = 0u; float tv[4]; int ti[4];
#pragma unroll
                for (int kk = 0; kk < 4; ++kk) { float best = -3.0e38f; int bi = 0;
#pragma unroll
                    for (int e = 0; e < 32; ++e) { const bool okk = (lg[e] > best) && !((taken >> e) & 1u); best = okk ? lg[e] : best; bi = okk ? e : bi; }
                    taken |= 1u << bi; tv[kk] = best; ti[kk] = bi; }
                const float e1 = __expf(tv[1] - tv[0]), e2 = __expf(tv[2] - tv[0]), e3 = __expf(tv[3] - tv[0]); const float inv = 1.f / (1.f + e1 + e2 + e3);
                const int li = (16 * g + lane) * 4; til[li] = ti[0]; til[li + 1] = ti[1]; til[li + 2] = ti[2]; til[li + 3] = ti[3]; twl[li] = inv; twl[li + 1] = e1 * inv; twl[li + 2] = e2 * inv; twl[li + 3] = e3 * inv;
                __hip_atomic_fetch_add(hist + ti[0], 1, __ATOMIC_RELAXED, __HIP_MEMORY_SCOPE_WORKGROUP); __hip_atomic_fetch_add(hist + ti[1], 1, __ATOMIC_RELAXED, __HIP_MEMORY_SCOPE_WORKGROUP);
                __hip_atomic_fetch_add(hist + ti[2], 1, __ATOMIC_RELAXED, __HIP_MEMORY_SCOPE_WORKGROUP); __hip_atomic_fetch_add(hist + ti[3], 1, __ATOMIC_RELAXED, __HIP_MEMORY_SCOPE_WORKGROUP); } }
    }
#if defined(PROBE_LN1X2)
    }
#endif
#undef LN1_LOAD
    __syncthreads();
    int* cursor = (int*)(a.ws + WS_CURSOR) + l * 32;
    int* rows = (int*)(a.ws + WS_ROWS); float* roww = (float*)(a.ws + WS_ROWW); int* rowd = (int*)(a.ws + WS_ROWD);
    int nrows = NLAT - lr_base; nrows = nrows > RB ? RB : nrows; if (nrows < 0) nrows = 0;
    const int nas = nrows * 4, nchunks = (nas + 63) >> 6;
    int basev = 0; if (tid < 32) basev = (int)__hip_atomic_fetch_add((unsigned*)cursor + tid, (unsigned)hist[tid], __ATOMIC_RELAXED, __HIP_MEMORY_SCOPE_AGENT);
    int myrank[2] = {0, 0}, mye[2] = {-1, -1};
#pragma unroll
    for (int cc = 0; cc < 2; ++cc) { const int c = wave + 8 * cc; if (c < nchunks) { const int idx = c * 64 + lane; const int e = idx < nas ? til[idx] : -1; mye[cc] = e;
        for (int x = 0; x < 32; ++x) { const unsigned long long m = __ballot(e == x); if (e == x) myrank[cc] = __popcll(m & ((1ull << lane) - 1ull)); if (lane == 0) ccnt[c * 32 + x] = __popcll(m); } } }
    __syncthreads();
    if (tid < 32) hist[32 + tid] = basev;
    __syncthreads();
#pragma unroll
    for (int cc = 0; cc < 2; ++cc) { const int c = wave + 8 * cc; const int idx = c * 64 + lane; if (c < nchunks && idx < nas) { const int e = mye[cc]; int pos = hist[32 + e] + myrank[cc]; for (int c2 = 0; c2 < c; ++c2) pos += ccnt[c2 * 32 + e];
        const int lr = lr_base + (idx >> 2); const size_t pi = (size_t)e * ECAP + pos; rows[pi] = grow_of(lr); roww[pi] = twl[idx]; rowd[pi] = lr * 4 + (idx & 3); } }
}

__device__ __forceinline__ void phase_ln2(const Args& a, int l, int lane, int wave) {
    const int gw = blockIdx.x * NWAVES + wave, NGW = gridDim.x * NWAVES;
    float* H = (float*)(a.ws + WS_H); const bf16* PRE = (const bf16*)(a.ws + WS_PRE); const unsigned char* YB = (const unsigned char*)(a.ws + WS_YB); bf16* A1 = (bf16*)(a.ws + WS_Y);
    const float* modv = (const float*)(a.ws + WS_MODV);
    const float* ln1g = a.in[I_LN1G] + l * 1024; const float* ln1b = a.in[I_LN1B] + l * 1024;
    const float* lng = a.in[I_LN2G] + l * 1024; const float* lnb = a.in[I_LN2B] + l * 1024;
    for (int lr0 = 2 * gw; lr0 < NLAT; lr0 += 2 * NGW) {
        v2u hv[2][4]; unsigned yv[2][4][4];
#pragma unroll
        for (int q = 0; q < 2; ++q) { const int lr = lr0 + q; const size_t r = (size_t)grow_of(lr);
#pragma unroll
            for (int j = 0; j < 4; ++j) { const int c = 4 * (lane + 64 * j); hv[q][j] = *(const v2u*)(PRE + r * 1024 + c);
#pragma unroll
                for (int k = 0; k < 4; ++k) yv[q][j][k] = *(const unsigned*)(YB + ((size_t)lr * 4 + k) * 1024 + c); } }
#pragma unroll
        for (int q = 0; q < 2; ++q) {
            const int lr = lr0 + q; const size_t r = (size_t)grow_of(lr); const int b = lr >> 12;
            const float* mv = modv + ((size_t)l * 9 + b) * 6144; const float* mv1 = modv + ((size_t)9 + b) * 6144;
            f32x4 x[4]; float s = 0.f;
#pragma unroll
            for (int j = 0; j < 4; ++j) { const v2u p = hv[q][j]; x[j] = (f32x4){__uint_as_float(p.x << 16), __uint_as_float(p.x & 0xffff0000u), __uint_as_float(p.y << 16), __uint_as_float(p.y & 0xffff0000u)}; s += (x[j][0] + x[j][1]) + (x[j][2] + x[j][3]); }
            float mean = wave_sum(s) * (1.f / 1024.f), s2 = 0.f;
#pragma unroll
            for (int j = 0; j < 4; ++j) { x[j] = x[j] - mean; s2 += (x[j][0] * x[j][0] + x[j][1] * x[j][1]) + (x[j][2] * x[j][2] + x[j][3] * x[j][3]); }
            float rstd = rsqrtf(wave_sum(s2) * (1.f / 1024.f) + LN_EPS);
            s = 0.f;
#pragma unroll
            for (int j = 0; j < 4; ++j) { const int c = 4 * (lane + 64 * j); const f32x4 g = *(const f32x4*)(ln1g + c), bb = *(const f32x4*)(ln1b + c);
                const f32x4 h1 = x[j] * rstd * g + bb; f32x4 f = {0.f, 0.f, 0.f, 0.f};
#pragma unroll
                for (int k = 0; k < 4; ++k) { const unsigned y = yv[q][j][k]; const auto lo = __builtin_amdgcn_cvt_pk_f32_fp8((int)y, false), hi = __builtin_amdgcn_cvt_pk_f32_fp8((int)y, true);
                    f[0] += lo[0]; f[1] += lo[1]; f[2] += hi[0]; f[3] += hi[1]; }
                const f32x4 gt = *(const f32x4*)(mv + 5 * 1024 + c);
                x[j] = h1 * ALPHA + gt * (f * (1.f / SC_Y)); s += (x[j][0] + x[j][1]) + (x[j][2] + x[j][3]); }
            mean = wave_sum(s) * (1.f / 1024.f); s2 = 0.f;
#pragma unroll
            for (int j = 0; j < 4; ++j) { x[j] = x[j] - mean; s2 += (x[j][0] * x[j][0] + x[j][1] * x[j][1]) + (x[j][2] * x[j][2] + x[j][3] * x[j][3]); }
            rstd = rsqrtf(wave_sum(s2) * (1.f / 1024.f) + LN_EPS);
#pragma unroll
            for (int j = 0; j < 4; ++j) { const int c = 4 * (lane + 64 * j); const f32x4 g = *(const f32x4*)(lng + c), bb = *(const f32x4*)(lnb + c);
                const f32x4 o = x[j] * rstd * g + bb;
                if (l == 0) { *(f32x4*)(H + r * 1024 + c) = o; const f32x4 sh = *(const f32x4*)(mv1 + c), sc = *(const f32x4*)(mv1 + 1024 + c);
                    const f32x4 am = (o * (sc + 1.0f) + sh) * SC_A1; *(unsigned*)((unsigned char*)A1 + r * 1024 + c) = pack_fp8x4(am[0], am[1], am[2], am[3]); }
                else *(f32x4*)(a.out + (size_t)lr * 1024 + c) = o; }
        }
    }
}

__device__ __forceinline__ void phase_conv(const Args& a, LAS unsigned char* lds, int tid, int lane, int wave) {
    const bf16* U = (const bf16*)(a.ws + WS_X); bf16* V = (bf16*)(a.ws + WS_Y);
    LAS float* part = (LAS float*)(lds + 126976);
    LAS float* st = part + 512;
    const int c0 = 2 * tid;
    const float db0 = a.in[I_DWB][c0], db1 = a.in[I_DWB][c0 + 1], g0 = a.in[I_CLNG][c0], g1 = a.in[I_CLNG][c0 + 1], be0 = a.in[I_CLNB][c0], be1 = a.in[I_CLNB][c0 + 1];
    for (int tile = blockIdx.x; tile < NLAT / 32; tile += gridDim.x) {
        const int b = tile >> 7, t0 = (tile & 127) * 32;
        const size_t rb0 = (size_t)b * TPB + CTXL;
        __syncthreads();
        for (int i = tid; i < 62 * 128; i += NTHR) { const int row = i >> 7, chk = i & 127, t = t0 - 15 + row;
            v4u val = {0u, 0u, 0u, 0u}; if (t >= 0 && t < SEQ) val = *(const v4u*)(U + (rb0 + t) * 1024 + chk * 8);
            *(LAS v4u*)(lds + row * 2048 + chk * 16) = val; }
        __syncthreads();
        float w0[31], w1[31];
#pragma unroll
        for (int j = 0; j < 31; ++j) { const float2 wv = *(const float2*)(a.in[I_DWW] + j * 1024 + c0); w0[j] = wv.x; w1[j] = wv.y; }
#pragma unroll 1
        for (int hh = 0; hh < 2; ++hh) {
            const LAS unsigned char* hp = lds + hh * 16 * 2048;
            float acc0[16], acc1[16];
#pragma unroll
            for (int t = 0; t < 16; ++t) { acc0[t] = db0; acc1[t] = db1; }
#pragma unroll
            for (int s = 0; s < 46; ++s) { const unsigned pr = *(const LAS unsigned*)(hp + s * 2048 + tid * 4); const float x0 = __uint_as_float(pr << 16), x1 = __uint_as_float(pr & 0xffff0000u);
#pragma unroll
                for (int t = (s > 30 ? s - 30 : 0); t <= (s < 15 ? s : 15); ++t) { acc0[t] = fmaf(x0, w0[s - t], acc0[t]); acc1[t] = fmaf(x1, w1[s - t], acc1[t]); } }
            float rs[32];
#pragma unroll
            for (int t = 0; t < 16; ++t) { rs[2 * t] = acc0[t] + acc1[t]; rs[2 * t + 1] = acc0[t] * acc0[t] + acc1[t] * acc1[t]; }
#define RS_STEP(NKEEP, XORV) { const bool bit_ = (lane & XORV) != 0; _Pragma("unroll") for (int k_ = 0; k_ < NKEEP; ++k_) { const float snd_ = bit_ ? rs[k_] : rs[k_ + NKEEP]; const float rcv_ = __shfl_xor(snd_, XORV); rs[k_] = (bit_ ? rs[k_ + NKEEP] : rs[k_]) + rcv_; } }
            RS_STEP(16, 32) RS_STEP(8, 16) RS_STEP(4, 8) RS_STEP(2, 4) RS_STEP(1, 2)
#undef RS_STEP
            rs[0] += __shfl_xor(rs[0], 1);
            __syncthreads();
            if ((lane & 1) == 0) part[wave * 32 + (lane >> 1)] = rs[0];
            __syncthreads();
            if (tid < 16) { float s1 = 0.f, s2 = 0.f;
#pragma unroll
                for (int w = 0; w < 8; ++w) { s1 += part[w * 32 + 2 * tid]; s2 += part[w * 32 + 2 * tid + 1]; }
                const float mean = s1 * (1.f / 1024.f); const float var = fmaxf(s2 * (1.f / 1024.f) - mean * mean, 0.f); st[2 * tid] = mean; st[2 * tid + 1] = rsqrtf(var + LN_EPS); }
            __syncthreads();
#pragma unroll
            for (int t = 0; t < 16; ++t) { const float mean = st[2 * t], rstd = st[2 * t + 1];
                const float y0 = (acc0[t] - mean) * rstd * g0 + be0, y1 = (acc1[t] - mean) * rstd * g1 + be1;
                const float z0 = fminf(fmaxf(y0 * sigm(y0) * SC_CV, -448.f), 448.f), z1 = fminf(fmaxf(y1 * sigm(y1) * SC_CV, -448.f), 448.f);
                *(unsigned short*)((unsigned char*)V + (rb0 + t0 + hh * 16 + t) * 1024 + c0) = (unsigned short)__builtin_amdgcn_cvt_pk_fp8_f32(z0, z1, 0, false); }
        }
    }
}

namespace hg {
using bf16x8 = __attribute__((ext_vector_type(8))) short;
using s16x4  = __attribute__((ext_vector_type(4))) short;
using f32x16 = __attribute__((ext_vector_type(16))) float;
using u32x4  = __attribute__((ext_vector_type(4))) unsigned;
constexpr int RS = 272;
constexpr int VS = 80;
constexpr int T_Q = 0, T_KO = 32 * RS, T_KE = 64 * RS, T_D = 96 * RS, IMG_BYTES = T_D + 512, T_V = IMG_BYTES, TILE_BYTES = T_V + 32 * VS;
constexpr int OFF_TILES = 1024, NTB = 3, OFF_OPART = OFF_TILES + NTB * TILE_BYTES, OPART_BYTES = 4 * 4096;
static_assert(OFF_OPART + 2 * OPART_BYTES <= 131072 && IMG_BYTES % 16 == 0 && IMG_BYTES / 16 == 1664, "hgrn lds");
constexpr int P_RAW = 1024, R_Q = 0, R_F = 32 * RS, RAW_BYTES = 64 * RS, P_IMG = P_RAW + RAW_BYTES;
constexpr int NCHUNK = TPB / 32, NCHAIN = NB * 4 * 2, NITEM = NCHAIN * NCHUNK;
__device__ __forceinline__ int crow(int r, int hi) { return (r & 3) + 8 * (r >> 2) + 4 * hi; }
__device__ __forceinline__ s16x4 tr_read(unsigned addr) { s16x4 r; asm volatile("ds_read_b64_tr_b16 %0, %1" : "=&v"(r) : "v"(addr) : "memory"); return r; }
__device__ __forceinline__ bf16x8 cat8(s16x4 l, s16x4 h) { return (bf16x8){l[0], l[1], l[2], l[3], h[0], h[1], h[2], h[3]}; }
__device__ __forceinline__ bf16x8 pack8(const f32x16& x, int base) {
    u32x4 w; w[0] = pk2(x[base + 0], x[base + 1]); w[1] = pk2(x[base + 2], x[base + 3]); w[2] = pk2(x[base + 4], x[base + 5]); w[3] = pk2(x[base + 6], x[base + 7]);
    return *reinterpret_cast<bf16x8*>(&w);
}
}


#define HG_TOKP(dir, n) ((dir) ? ((n) < CTXL ? (CTXL - 1 - (n)) : (TPB + CTXL - 1 - (n))) : (n))
#define HG_DPP1(x, ctrl, rmask) __int_as_float(__builtin_amdgcn_update_dpp(0x3f800000, __float_as_int(x), ctrl, rmask, 0xf, false))
#define HG_DPP(x, ctrl, rmask) __int_as_float(__builtin_amdgcn_update_dpp(0, __float_as_int(x), ctrl, rmask, 0xf, false))
__device__ __forceinline__ void hgrn_prep_items(const Args& a, LAS unsigned char* lds, int tid) {
    using namespace hg;
    const bf16* Z = (const bf16*)(a.ws + WS_Z);
    unsigned char* HT = a.ws + WS_HT;
    const int wave = __builtin_amdgcn_readfirstlane(tid >> 6), lane = tid & 63, t = lane & 31, half = lane >> 5;
    const int c0 = 16 * wave + 8 * half;
    const int lr = tid >> 4, lch = tid & 15;
    LAS float* lbt = (LAS float*)lds;
    constexpr int P_RAW2 = 2048, P_IMG2 = P_RAW2 + 2 * RAW_BYTES;
    static_assert(P_IMG2 + 2 * IMG_BYTES <= 131072, "prep lds");
    __syncthreads();
    { const float l0 = a.in[I_LBL][tid], l1 = a.in[I_LBL][512 + tid], l2 = a.in[I_LBL][1024 + tid]; const float m = fmaxf(l0, fmaxf(l1, l2));
      const float e0 = __expf(l0 - m), e1 = __expf(l1 - m), e2 = __expf(l2 - m); lbt[tid] = e0 / (e0 + e1 + e2); }
    bf16x8 gq, gf;
#define HP_LOAD(it) do { const int ch_ = (it) % NCHUNK, cn_ = (it) / NCHUNK, dir_ = cn_ & 1, hd_ = (cn_ >> 1) & 3, b_ = cn_ >> 3; \
        const bf16* zr_ = Z + ((size_t)b_ * TPB + HG_TOKP(dir_, 32 * ch_ + lr)) * ZC; gq = *(const bf16x8*)(zr_ + ZHQ + hd_ * 128 + lch * 8); gf = *(const bf16x8*)(zr_ + (dir_ ? ZHB : ZHF) + hd_ * 128 + lch * 8); } while (0)
#define HP_STASH(bufi) do { LAS unsigned char* rb_ = lds + P_RAW2 + (bufi) * RAW_BYTES; *(LAS bf16x8*)(rb_ + R_Q + lr * RS + lch * 16) = gq; *(LAS bf16x8*)(rb_ + R_F + lr * RS + lch * 16) = gf; } while (0)
#define HP_COPYOUT(item, bufi) do { v4u* dst_ = (v4u*)(HT + (size_t)(item) * IMG_BYTES); const LAS v4u* src_ = (const LAS v4u*)(lds + P_IMG2 + (bufi) * IMG_BYTES); \
        dst_[tid] = src_[tid]; dst_[tid + 512] = src_[tid + 512]; dst_[tid + 1024] = src_[tid + 1024]; if (tid < 128) dst_[tid + 1536] = src_[tid + 1536]; } while (0)
    const int G = gridDim.x;
    int it = blockIdx.x, par = 0;
    if (it < NITEM) { HP_LOAD(it); HP_STASH(0); }
    if (it + G < NITEM) HP_LOAD(it + G);
    __syncthreads();
    for (; it < NITEM; it += G, par ^= 1) {
        if (it + G < NITEM) HP_STASH(par ^ 1);
        if (it != (int)blockIdx.x) HP_COPYOUT(it - G, par ^ 1);
        if (it + 2 * G < NITEM) HP_LOAD(it + 2 * G);
        const int hd = ((it / NCHUNK) >> 1) & 3;
        {
            const LAS unsigned char* rb_ = lds + P_RAW2 + par * RAW_BYTES;
            const bf16x8 RQ = *(const LAS bf16x8*)(rb_ + R_Q + t * RS + c0 * 2), RF = *(const LAS bf16x8*)(rb_ + R_F + t * RS + c0 * 2);
            const f32x4 lbA = *(const LAS f32x4*)(lbt + hd * 128 + c0), lbB = *(const LAS f32x4*)(lbt + hd * 128 + c0 + 4);
            LAS unsigned char* tb_ = lds + P_IMG2 + par * IMG_BYTES;
            float bb_[8], kk_[8];
#pragma unroll
            for (int i_ = 0; i_ < 8; ++i_) { const float lb_ = i_ < 4 ? lbA[i_] : lbB[i_ - 4]; const float f_ = lb_ + (1.f - lb_) * __builtin_amdgcn_rcpf(1.f + __expf(-bf2f((unsigned short)RF[i_]))); kk_[i_] = 1.f - f_; bb_[i_] = f_; }
#pragma unroll
            for (int i_ = 0; i_ < 8; ++i_) { float x_ = bb_[i_]; x_ *= HG_DPP1(x_, 0x111, 0xf); x_ *= HG_DPP1(x_, 0x112, 0xf); x_ *= HG_DPP1(x_, 0x114, 0xf); x_ *= HG_DPP1(x_, 0x118, 0xf);
                x_ *= HG_DPP1(x_, 0x142, 0xa); bb_[i_] = x_; }
            float qi_[8], ko_[8], ke_[8], dd_[8];
#pragma unroll
            for (int i_ = 0; i_ < 8; ++i_) { const int bi_ = __float_as_int(bb_[i_]); dd_[i_] = __int_as_float(half ? __builtin_amdgcn_readlane(bi_, 63) : __builtin_amdgcn_readlane(bi_, 31));
                const float e_ = bb_[i_]; const float ei_ = __builtin_amdgcn_rcpf(e_);
                qi_[i_] = bf2f((unsigned short)RQ[i_]) * e_; ko_[i_] = kk_[i_] * ei_; ke_[i_] = kk_[i_] * (dd_[i_] * ei_); }
            *(LAS v4u*)(tb_ + T_Q + t * RS + c0 * 2) = (v4u){pk2(qi_[0], qi_[1]), pk2(qi_[2], qi_[3]), pk2(qi_[4], qi_[5]), pk2(qi_[6], qi_[7])};
            *(LAS v4u*)(tb_ + T_KO + t * RS + c0 * 2) = (v4u){pk2(ko_[0], ko_[1]), pk2(ko_[2], ko_[3]), pk2(ko_[4], ko_[5]), pk2(ko_[6], ko_[7])};
            *(LAS v4u*)(tb_ + T_KE + t * RS + c0 * 2) = (v4u){pk2(ke_[0], ke_[1]), pk2(ke_[2], ke_[3]), pk2(ke_[4], ke_[5]), pk2(ke_[6], ke_[7])};
            if (t == 31) { *(LAS f32x4*)(tb_ + T_D + c0 * 4) = (f32x4){dd_[0], dd_[1], dd_[2], dd_[3]}; *(LAS f32x4*)(tb_ + T_D + c0 * 4 + 16) = (f32x4){dd_[4], dd_[5], dd_[6], dd_[7]}; }
            if (tid < 32) *(LAS v4u*)(tb_ + T_Q + tid * RS + 256) = (v4u){0u, 0u, 0u, 0u};
            else if (tid < 64) *(LAS v4u*)(tb_ + T_KO + (tid - 32) * RS + 256) = (v4u){0u, 0u, 0u, 0u};
            else if (tid < 96) *(LAS v4u*)(tb_ + T_KE + (tid - 64) * RS + 256) = (v4u){0u, 0u, 0u, 0u};
        }
        __syncthreads();
    }
    if (it - G >= (int)blockIdx.x && it - G < NITEM) HP_COPYOUT(it - G, par ^ 1);
    __syncthreads();
#undef HP_COPYOUT
#undef HP_LOAD
#undef HP_STASH
}

__device__ __forceinline__ void hgrn_unit_mfma(const Args& a, int unit, LAS unsigned char* lds, int tid) {
    using namespace hg;
    const int b = unit >> 5, head = (unit >> 3) & 3, dir = (unit >> 2) & 1, sl = unit & 3;
    const bf16* Z = (const bf16*)(a.ws + WS_Z);
    const unsigned char* HT = a.ws + WS_HT + (size_t)((b * 4 + head) * 2 + dir) * NCHUNK * IMG_BYTES;
    bf16* Od = (bf16*)(a.ws + (dir ? WS_OB : WS_OF));
    const int wave = __builtin_amdgcn_readfirstlane(tid >> 6), lane = tid & 63;
    const size_t zb = (size_t)b * TPB;
    constexpr int NCH = NCHUNK;
    const int vr = (tid >> 2) & 31, vp = tid & 3, lvcol = ZHI + head * 128 + sl * 32 + vp * 8, i3 = 1536 + (tid & 127);
    v4u gA0, gA1, gA2, gA3, gB0, gB1, gB2, gB3; bf16x8 gAv, gBv;
#define HG_LOAD(g0, g1, g2, g3, gv, ch) do { const int c_ = (ch) < NCH ? (ch) : NCH - 1; const v4u* src_ = (const v4u*)(HT + (size_t)c_ * IMG_BYTES); \
        g0 = src_[tid]; g1 = src_[tid + 512]; g2 = src_[tid + 1024]; g3 = src_[i3]; gv = *(const bf16x8*)(Z + (zb + HG_TOKP(dir, 32 * c_ + vr)) * ZC + lvcol); } while (0)
#define HG_STASH(g0, g1, g2, g3, gv, bufi) do { LAS unsigned char* tb_ = lds + OFF_TILES + (bufi) * TILE_BYTES; LAS v4u* d_ = (LAS v4u*)tb_; \
        d_[tid] = g0; d_[tid + 512] = g1; d_[tid + 1024] = g2; if (tid < 128) { d_[tid + 1536] = g3; *(LAS bf16x8*)(tb_ + T_V + vr * VS + vp * 16) = gv; } } while (0)
    const int r32 = lane & 31, hi = lane >> 5, g1 = (lane >> 4) & 1, q4 = (lane & 15) >> 2, p4 = lane & 3, cb = 32 * wave;
    const unsigned lbase = (unsigned)(uintptr_t)lds;
    f32x16 S = {};
    HG_LOAD(gA0, gA1, gA2, gA3, gAv, 0); HG_STASH(gA0, gA1, gA2, gA3, gAv, 0); HG_LOAD(gA0, gA1, gA2, gA3, gAv, 1); HG_STASH(gA0, gA1, gA2, gA3, gAv, 1);
    HG_LOAD(gA0, gA1, gA2, gA3, gAv, 2);
    __syncthreads();
#define HG_RD64(dst, addr, OFFS) asm volatile("ds_read_b64 %0, %1 offset:" #OFFS : "=&v"(dst) : "v"(addr) : "memory")
#define HG_MFMA_STAGE(n, bufi) do { \
            const unsigned tb = lbase + OFF_TILES + (bufi) * TILE_BYTES; const LAS unsigned char* tl_ = lds + OFF_TILES + (bufi) * TILE_BYTES; \
            bf16x8 ko[2], qi[2]; s16x4 pvl[2], pvh[2], pql[2], pqh[2], kl[2], kh[2], nvl[2], nvh[2]; f32x4 dsc[4]; \
            _Pragma("unroll") for (int kk = 0; kk < 2; ++kk) { ko[kk] = *(const LAS bf16x8*)(tl_ + T_KO + r32 * RS + (cb + 16 * kk + 8 * hi) * 2); qi[kk] = *(const LAS bf16x8*)(tl_ + T_Q + r32 * RS + (cb + 16 * kk + 8 * hi) * 2); } \
            _Pragma("unroll") for (int sp = 0; sp < 2; ++sp) { \
                const unsigned va = tb + T_V + (16 * sp + 4 * hi + q4) * VS + (16 * g1 + 4 * p4) * 2; pvl[sp] = tr_read(va); pvh[sp] = tr_read(va + 8 * VS);              \
                const unsigned qa = tb + T_Q + r32 * RS + (cb + 16 * sp + 4 * hi) * 2; HG_RD64(pql[sp], qa, 0); HG_RD64(pqh[sp], qa, 16);                                  \
                const unsigned ka = tb + T_KE + (16 * sp + 8 * hi + q4) * RS + (cb + 16 * g1 + 4 * p4) * 2; kl[sp] = tr_read(ka); kh[sp] = tr_read(ka + 4 * RS);        \
                const unsigned vb = tb + T_V + (16 * sp + 8 * hi + q4) * VS + (16 * g1 + 4 * p4) * 2; nvl[sp] = tr_read(vb); nvh[sp] = tr_read(vb + 4 * VS); }            \
            _Pragma("unroll") for (int g = 0; g < 4; ++g) dsc[g] = *(const LAS f32x4*)(tl_ + T_D + (cb + 8 * g + 4 * hi) * 4); \
            asm volatile("s_waitcnt lgkmcnt(0)" ::: "memory"); __builtin_amdgcn_sched_barrier(0); \
            f32x16 X = {}; \
            X = __builtin_amdgcn_mfma_f32_32x32x16_bf16(ko[0], qi[0], X, 0, 0, 0); X = __builtin_amdgcn_mfma_f32_32x32x16_bf16(ko[1], qi[1], X, 0, 0, 0); \
            f32x16 O = {}; \
            O = __builtin_amdgcn_mfma_f32_32x32x16_bf16(cat8(pql[0], pqh[0]), pack8(S, 0), O, 0, 0, 0); O = __builtin_amdgcn_mfma_f32_32x32x16_bf16(cat8(pql[1], pqh[1]), pack8(S, 8), O, 0, 0, 0); \
            _Pragma("unroll") for (int i = 0; i < 16; ++i) S[i] *= dsc[i >> 2][i & 3]; \
            S = __builtin_amdgcn_mfma_f32_32x32x16_bf16(cat8(kl[0], kh[0]), cat8(nvl[0], nvh[0]), S, 0, 0, 0); S = __builtin_amdgcn_mfma_f32_32x32x16_bf16(cat8(kl[1], kh[1]), cat8(nvl[1], nvh[1]), S, 0, 0, 0); \
            _Pragma("unroll") for (int i = 0; i < 16; ++i) X[i] = (crow(i, hi) <= r32) ? X[i] : 0.f; \
            O = __builtin_amdgcn_mfma_f32_32x32x16_bf16(pack8(X, 0), cat8(pvl[0], pvh[0]), O, 0, 0, 0); O = __builtin_amdgcn_mfma_f32_32x32x16_bf16(pack8(X, 8), cat8(pvl[1], pvh[1]), O, 0, 0, 0); \
            LAS float* op = (LAS float*)(lds + OFF_OPART + ((n) & 1) * OPART_BYTES + wave * 4096); \
            _Pragma("unroll") for (int i = 0; i < 16; ++i) op[crow(i, hi) * 32 + r32] = O[i]; } while (0)
#define HG_OUT_STAGE(n) do { \
            const int l2 = tid - 256, tt = l2 >> 3, vq = l2 & 7; \
            const LAS float* op = (const LAS float*)(lds + OFF_OPART + (((n) - 1) & 1) * OPART_BYTES) + tt * 32 + vq * 4; \
            const f32x4 s = (*(const LAS f32x4*)op + *(const LAS f32x4*)(op + 1024)) + (*(const LAS f32x4*)(op + 2048) + *(const LAS f32x4*)(op + 3072)); \
            const int p = HG_TOKP(dir, 32 * ((n) - 1) + tt); \
            if (p >= CTXL) *(v2u*)(Od + (zb + p) * 512 + head * 128 + sl * 32 + vq * 4) = (v2u){pk2(s[0], s[1]), pk2(s[2], s[3])}; } while (0)
#define HG_ITER(n, L0, L1, L2, L3, LV, S0, S1, S2, S3, SV) do { \
        HG_LOAD(L0, L1, L2, L3, LV, (n) + 3); \
        if (wave < 4) { HG_MFMA_STAGE(n, bcur); } else if ((n) > 0) { HG_OUT_STAGE(n); } \
        { const int bst_ = bcur == 0 ? 2 : bcur - 1; HG_STASH(S0, S1, S2, S3, SV, bst_); } \
        bcur = bcur == 2 ? 0 : bcur + 1; \
        __syncthreads(); } while (0)
    int bcur = 0;
    for (int n = 0; n < NCH; n += 2) {
        HG_ITER(n, gB0, gB1, gB2, gB3, gBv, gA0, gA1, gA2, gA3, gAv);
        HG_ITER(n + 1, gA0, gA1, gA2, gA3, gAv, gB0, gB1, gB2, gB3, gBv);
    }
    if (wave >= 4) { HG_OUT_STAGE(NCH); }
    __syncthreads();
#undef HG_MFMA_STAGE
#undef HG_OUT_STAGE
#undef HG_ITER
#undef HG_LOAD
#undef HG_STASH
#undef HG_RD64
}

__device__ __forceinline__ bool in_range(int lo, int hi, int k) { asm volatile("" : "+s"(lo), "+s"(hi)); return lo <= k && k < hi; }
constexpr int NPHASES = 21;
__global__ void __launch_bounds__(NTHR, 2) fwd_kernel(Args args) {
    extern __shared__ __attribute__((aligned(16))) unsigned char lds_raw[];
    LAS unsigned char* lds = (LAS unsigned char*)lds_raw;
    const int G = gridDim.x;
#define FRESH() int tid = threadIdx.x; asm volatile("" : "+v"(tid)); const int lane = tid & 63, wave = __builtin_amdgcn_readfirstlane(tid >> 6); (void)lane; (void)wave
    unsigned char* ws = args.ws;
    if (threadIdx.x < 16) ((LAS unsigned*)(lds + LDS_BAR_OFF))[threadIdx.x] = 0u;
    __syncthreads();
    XcdBarrier bar = xcd_barrier_post((unsigned*)(ws + WS_CTL), (volatile LAS unsigned*)(lds + LDS_BAR_OFF));
    const int lo = args.ph_lo, hi = args.ph_hi;
#define IN(k) in_range(lo, hi, (k))
#define NREP(k) (((PROBE_MASK >> (k)) & 1u) ? 2 : 1)
#define REPEAT(k) for (int rep_ = 0; rep_ < NREP(k); ++rep_) if (rep_ == 0 || (xcd_barrier(bar), true))
#define SEAM(k) do { if (IN(k) && IN((k) + 1)) xcd_barrier(bar); } while (0)
    bf16* const BX = (bf16*)(ws + WS_X); bf16* const BY = (bf16*)(ws + WS_Y);
    const float* const MODV = (const float*)(ws + WS_MODV);

#if defined(PROBE_BARS)
    for (int pbi = 0; pbi < PROBE_BARS; ++pbi) xcd_barrier(bar);
#endif
    if (IN(0)) REPEAT(0) { FRESH(); phase_prologue(args, lds, tid, lane, wave); } SEAM(0);
    if (IN(1)) REPEAT(1) { FRESH(); phase_mod0(args, lane, wave); } SEAM(1);
    if (IN(2)) REPEAT(2) {
        pg8::Gemm g{BX, (const bf16*)(ws + WS_WIN), NTOK, ZC, 512}; pg8::AllOrder S; S.init(NTOK / 256, ZC / 256, G, (int)blockIdx.x);
        pg8::EpiBf16<0> E{(bf16*)(ws + WS_Z), ZC, nullptr, ZC, 0, 1.f / (SC_A0 * SC_WIN)};
        pg8::gemm_phase<pg8::EpiBf16<0>, pg8::AllOrder, PG8_ALIGN, true, false, true>(lds, g, S, E);
    } SEAM(2);
    if (IN(3)) REPEAT(3) { FRESH(); phase_norm0(args, lane, wave); hgrn_prep_items(args, lds, tid); } SEAM(3);
    if (IN(4)) REPEAT(4) {
        { pg8::Gemm g{(const bf16*)(ws + WS_CQN), (const bf16*)(ws + WS_WUQ), NTOK, 768, 384}; pg8::LatOrder S; S.init(128, 3, G, (int)blockIdx.x);
          pg8::EpiBf16<0> E{(bf16*)(ws + WS_Q), 768, nullptr, 0, 0, 1.f};
          pg8::gemm_phase<pg8::EpiBf16<0>, pg8::LatOrder, PG8_ALIGN, PG8_SP2>(lds, g, S, E); }
        __syncthreads();
        { pg8::Gemm g{(const bf16*)(ws + WS_CKVN), (const bf16*)(ws + WS_WUKV), NTOK, 1024, 256}; pg8::AllOrder S; S.init(NTOK / 256, 4, G, G - 1 - (int)blockIdx.x);
          pg8::EpiBf16<0> E{(bf16*)(ws + WS_KV), 1024, nullptr, 0, 0, 1.f};
          pg8::gemm_phase<pg8::EpiBf16<0>, pg8::AllOrder, PG8_ALIGN, PG8_SP2>(lds, g, S, E); }
    } SEAM(4);
    if (IN(5)) {
        REPEAT(21) { FRESH();
        for (int u = blockIdx.x; u < 256; u += G) { __syncthreads(); hgrn_unit_mfma(args, (G == 256) ? ((u & 7) * 32 + (u >> 3)) : u, lds, tid); } }
        const bf16* Q = (const bf16*)(ws + WS_Q); const bf16* KV = (const bf16*)(ws + WS_KV); const bf16* KRR = (const bf16*)(ws + WS_KRR);
        const float* rope = (const float*)(ws + WS_ROPE);
        const int cslot = (G == 256) ? ((((int)blockIdx.x & 7) * 2 + (((int)blockIdx.x >> 3) >> 4)) % 5) : 0;
        REPEAT(22) {
        int ai = 0;
        for (int slot = 0; slot < 5; ++slot) {
            if (slot == cslot) { if (rep_ == 0) { FRESH(); __syncthreads(); convert_moe_share(args, lds, lane, wave); } continue; }
            for (int u = (G == 256) ? (int)blockIdx.x + ai * 256 : (int)blockIdx.x; u < ((G == 256) ? (int)blockIdx.x + ai * 256 + 1 : (ai == 0 ? 1024 : 0)); u += G) {
                int b, h, qb; if (G == 256) { const int x = (int)blockIdx.x & 7, j = (int)blockIdx.x >> 3, pr = (u >> 8) * 16 + 2 * x + (j >> 4); b = pr >> 3; h = pr & 7; qb = j & 15; } else { b = u >> 7; h = (u >> 4) & 7; qb = u & 15; }
                const size_t kb = (size_t)b * TPB, q0 = kb + CTXL + (size_t)qb * 256;
                __syncthreads();
                att::attn_unit(Q + q0 * 768 + h * 96, KV + kb * 1024 + h * 64, KRR + kb * 32, BY + q0 * 1024 + h * 64, rope + (size_t)qb * 256 * 32, TPB, (char*)lds_raw);
            }
            ++ai;
        }
        }
    } SEAM(5);
    if (IN(6)) REPEAT(6) { FRESH(); phase_readout(args, lane, wave); } SEAM(6);
    if (IN(7)) REPEAT(7) {
        pg8::Gemm g{BY, (const bf16*)(ws + WS_WOUT), NTOK, 1024, 1024}; pg8::LatOrder S; S.init(128, 4, G, (int)blockIdx.x);
        pg8::EpiRes E{args.in[I_X], (const float*)(ws + WS_H), (bf16*)(ws + WS_PRE), MODV, nullptr, 1.f};
        pg8::gemm_phase<pg8::EpiRes, pg8::LatOrder, PG8_ALIGN, PG8_SP2>(lds, g, S, E);
    } SEAM(7);
    for (int l = 0; l < 2; ++l) {
        if (l == 1) {
            if (IN(13)) REPEAT(13) {
                pg8::Gemm g{BY, (const bf16*)(ws + WS_WPW1), NTOK, 2048, 512}; pg8::LatOrder S; S.init(128, 8, G, (int)blockIdx.x);
                pg8::EpiGate<0> E{BX, (const float*)(ws + WS_PW1B), 8, 1.f / (SC_A1 * SC_WPW), 1.f};
                pg8::gemm_phase<pg8::EpiGate<0>, pg8::LatOrder, PG8_ALIGN, true, false, true>(lds, g, S, E);
            } SEAM(13);
            if (IN(14)) REPEAT(14) { FRESH(); phase_conv(args, lds, tid, lane, wave); } SEAM(14);
            if (IN(15)) REPEAT(15) {
                pg8::Gemm g{BY, (const bf16*)(ws + WS_WPW2), NTOK, 1024, 512}; pg8::LatOrder S; S.init(128, 4, G, (int)blockIdx.x);
                pg8::EpiRes E{nullptr, (const float*)(ws + WS_H), (bf16*)(ws + WS_PRE), MODV + 9 * 6144, args.in[I_PW2B], 1.f / (SC_CV * SC_WPW)};
                pg8::gemm_phase<pg8::EpiRes, pg8::LatOrder, PG8_ALIGN, true, false, true>(lds, g, S, E);
            } SEAM(15);
        }
        const int pb = l ? 16 : 8;
        if (IN(pb)) REPEAT(pb) { FRESH(); phase_ln1(args, l, lds, tid, lane, wave); } SEAM(pb);
        if (IN(pb + 2) || IN(pb + 3)) {
            LAS int* tl = (LAS int*)(lds + LDS_TILE_E);
            FRESH();
            __syncthreads();
            if (tid < 32) tl[3 * MAXTILES + 64 + tid] = ld_ctl((const int*)(ws + WS_CURSOR) + l * 32 + tid);
            __syncthreads();
            if (tid == 0) { int ts = 0; for (int e = 0; e < 32; ++e) { tl[3 * MAXTILES + e] = ts; ts += (tl[3 * MAXTILES + 64 + e] + 255) >> 8; } tl[3 * MAXTILES + 32] = ts; }
            __syncthreads();
            const int ntiles = tl[3 * MAXTILES + 32];
            for (int t = tid; t < ntiles && t < MAXTILES; t += NTHR) { int e = 0; while (e < 31 && tl[3 * MAXTILES + e + 1] <= t) ++e; const int j = t - tl[3 * MAXTILES + e], rem = tl[3 * MAXTILES + 64 + e] - 256 * j;
                tl[t] = e; tl[MAXTILES + t] = e * ECAP + 256 * j; tl[2 * MAXTILES + t] = rem < 256 ? rem : 256; }
            __syncthreads();
            if (IN(pb + 2)) REPEAT(pb + 2) {
#if defined(PROBE_STAGGER)
                if (blockIdx.x & 1) { const unsigned long long t0 = __builtin_amdgcn_s_memrealtime(); while (__builtin_amdgcn_s_memrealtime() - t0 < PROBE_STAGGER) __builtin_amdgcn_s_sleep(8); }
#endif
                pg8::Gemm g{BX, (const bf16*)(ws + WS_WGU + (size_t)l * 32 * 2048 * 1024), 0, 0, 512};
                pg8::MoeOrder S; S.init(ntiles, 8, G, (int)blockIdx.x); S.tile_e = tl; S.nper = 8;
                pg8::EpiGate<1, true> E{(bf16*)(ws + WS_ACT), (const float*)(ws + WS_BGU) + (size_t)l * 32 * 2048, 8, 1.f / (SC_X8 * SC_WGU) * PROBE_KSC, SC_ACT};
                pg8::gemm_phase<pg8::EpiGate<1, true>, pg8::MoeOrder, PG8_ALIGN, true, true, true>(lds, g, S, E, (const int*)(ws + WS_ROWS), tl + MAXTILES);
            } SEAM(pb + 2);
            if (IN(pb + 3)) REPEAT(pb + 3) {
                pg8::Gemm g{(const bf16*)(ws + WS_ACT), (const bf16*)(ws + WS_WDN + (size_t)l * 32 * 1024 * 1024), 0, 0, 512};
                pg8::MoeOrder S; S.init(ntiles, 4, G, (int)blockIdx.x); S.tile_e = tl; S.nper = 4;
                pg8::EpiDown E{(bf16*)(ws + WS_YB), args.in[I_BDN] + (size_t)l * 32 * 1024, (const float*)(ws + WS_ROWW), (const int*)(ws + WS_ROWD), 1.f / (SC_ACT * SC_WDN) * PROBE_KSC, tl + MAXTILES, SC_Y};
                pg8::gemm_phase<pg8::EpiDown, pg8::MoeOrder, PG8_ALIGN, true, false, true>(lds, g, S, E);
            } SEAM(pb + 3);
        }
        if (IN(pb + 4)) REPEAT(pb + 4) { FRESH(); phase_ln2(args, l, lane, wave); }
        if (l == 0) SEAM(12);
    }
#undef IN
#undef SEAM
}

extern "C" void kernel_launch(void* const* d_in, const int* in_sizes, int n_in, void* d_out, int out_size, void* d_ws, size_t ws_size, hipStream_t stream) {
    static int grid = 0;
    if (grid == 0) {
        if (n_in != 33 || in_sizes[0] != NB * SEQ * D || out_size != NB * SEQ * D || ws_size < WS_END) {
            fprintf(stderr, "kernel_launch: unexpected shapes: n_in %d in0 %d out %d ws %zu (need %zu)\n", n_in, n_in > 0 ? in_sizes[0] : -1, out_size, ws_size, (size_t)WS_END); grid = -1; return; }
        int dev = 0, cus = 0;
        if (hipGetDevice(&dev) != hipSuccess || hipDeviceGetAttribute(&cus, hipDeviceAttributeMultiprocessorCount, dev) != hipSuccess) { grid = -1; return; }
        if (hipFuncSetAttribute((const void*)fwd_kernel, hipFuncAttributeMaxDynamicSharedMemorySize, LDS_BYTES) != hipSuccess) { fprintf(stderr, "kernel_launch: hipFuncSetAttribute failed\n"); grid = -1; return; }
        int per_cu = 0;
        if (hipOccupancyMaxActiveBlocksPerMultiprocessor(&per_cu, (const void*)fwd_kernel, NTHR, LDS_BYTES) != hipSuccess || per_cu < 1) fprintf(stderr, "kernel_launch: occupancy query reports %d\n", per_cu);
        (void)hipGetLastError();
        grid = cus;
    }
    if (grid < 0) return;
    if (hipMemsetAsync((char*)d_ws + WS_CTL, 0, CTL_ZERO_BYTES, stream) != hipSuccess) return;
    Args a{};
    for (int i = 0; i < 33; ++i) a.in[i] = (const float*)d_in[i];
    a.out = (float*)d_out; a.ws = (unsigned char*)d_ws;
#if MK_ONE_LAUNCH
    a.ph_lo = 0; a.ph_hi = NPHASES;
    hipLaunchKernelGGL(fwd_kernel, dim3(grid), dim3(NTHR), LDS_BYTES, stream, a);
#else
    for (int ph = 0; ph < NPHASES; ++ph) { a.ph_lo = ph; a.ph_hi = ph + 1; hipLaunchKernelGGL(fwd_kernel, dim3(grid), dim3(NTHR), LDS_BYTES, stream, a); }
#endif
    const hipError_t le = hipPeekAtLastError();
    if (le != hipSuccess) fprintf(stderr, "kernel_launch: launch failed: %s\n", hipGetErrorName(le));
}
```

```cpp
#include <hip/hip_runtime.h>
#include <cstdio>
#include <cstdint>

#ifndef PROBE_MASK
#define PROBE_MASK 0u
#endif
#if defined(PROBE_K2)
#define PROBE_KSC 0.5f
#else
#define PROBE_KSC 1.0f
#endif
#ifndef MK_ONE_LAUNCH
#define MK_ONE_LAUNCH 1
#endif

namespace pg8 {
#define PG8_LAS __attribute__((address_space(3)))
typedef unsigned short bf16_t;
typedef short bf16x8 __attribute__((ext_vector_type(8)));
typedef float f32x4 __attribute__((ext_vector_type(4)));
typedef unsigned u32x4 __attribute__((ext_vector_type(4)));
constexpr int BM = 256, BK = 64, HALF = 128, HTB = HALF * BK * 2  , STAGE_BYTES = 8 * HTB, NXCD = 8, WGM = 8;

__host__ __device__ __forceinline__ int lds_byte(int r, int c) { const int st = (r >> 4) * 2 + (c >> 5), rr = r & 15, cc = c & 31, ob = rr * 64 + cc * 2; return st * 1024 + (ob ^ (((ob >> 9) & 1) << 5)); }
__host__ __device__ __forceinline__ void stage_rc(int b, int& R, int& C) { const int st = b / 1024, sb = b % 1024, swz = sb ^ (((sb >> 9) & 1) << 5); R = (st >> 1) * 16 + swz / 64; C = (st & 1) * 32 + (swz % 64) / 2; }
__host__ __device__ __forceinline__ int perm32(int rho) { const int n = rho >> 4, i = rho & 15; return 8 * (i >> 2) + 4 * n + (i & 3); }

struct Unit { int pm, pn; };
struct Gemm { const bf16_t* A; const bf16_t* Bt; int M, N, K; };

struct StaticOrder {
    int nM, nN, nwg, G, c;
    __host__ __device__ void init(int M, int N, int G_, int c_) { nM = M / BM; nN = N / BM; nwg = nM * nN; G = G_; c = c_; }
    __host__ __device__ bool next(int i, Unit& u) const {
        const long L = (long)i * G + c; if (L >= nwg) return false;
        int wgid = (int)L; { const int q = nwg / NXCD, r = nwg % NXCD, xcd = wgid % NXCD, off = wgid / NXCD; wgid = (xcd < r ? xcd * (q + 1) : r * (q + 1) + (xcd - r) * q) + off; }
        const int nig = WGM * nN, gid = wgid / nig, fm = gid * WGM, gsz = (nM - fm) < WGM ? (nM - fm) : WGM;
        u.pm = fm + ((wgid % nig) % gsz); u.pn = (wgid % nig) / gsz; return true;
    }
    __device__ __forceinline__ void a_ready(const Unit&) const {}
    __device__ __forceinline__ void done(const Unit&) const {}
};

__device__ __forceinline__ unsigned cvt_pk_bf16(float lo, float hi) { unsigned r; asm volatile("v_cvt_pk_bf16_f32 %0, %1, %2" : "=v"(r) : "v"(lo), "v"(hi)); return r; }
typedef float f32x2 __attribute__((ext_vector_type(2)));
__device__ __forceinline__ f32x2 gelu_pk(f32x2 v) {
    const f32x2 av = __builtin_elementwise_abs(v), d = av * 0.2316418882f + 1.0f;
    f32x2 t; t.x = __builtin_amdgcn_rcpf(d.x); t.y = __builtin_amdgcn_rcpf(d.y);
    f32x2 q = t * 0.5307027145f + (-0.7265760135f); q = q * t + 0.7107068705f; q = q * t + (-0.142248368f); q = q * t + 0.127414796f; q = q * t;
    const f32x2 s = (v * v) * (-0.72134752044f);
    f32x2 e; e.x = __builtin_amdgcn_exp2f(s.x); e.y = __builtin_amdgcn_exp2f(s.y);
    const f32x2 m = v * (q * e), r = v - m;
    f32x2 o; o.x = v.x < 0.f ? m.x : r.x; o.y = v.y < 0.f ? m.y : r.y; return o;
}

template <int ACT  > struct EpiBf16 {
    static constexpr bool PERM = true, AFTER_DRAIN = false; static_assert(ACT == 0 || ACT == 1, "EpiBf16: ACT is 0 (none) or 1 (gelu_pk)");
    bf16_t* O; int ldc; const float* bias; int split_cols; size_t split_stride; float scale0;
    __device__ __forceinline__ void operator()(const f32x4 (&acc)[2][2][4][2], const Unit& u, int wr, int wc, int fr, int fq) const {
        const int row0 = u.pm * BM + wr * 64 + fr; int colt = u.pn * BM; bf16_t* base = O;
        float sc = 1.f; if (split_cols) { const int t = colt / split_cols; base += (size_t)t * split_stride; colt -= t * split_cols; if (t == 0) sc = scale0; }
        const int col0 = colt + wc * 32 + 8 * fq, bcol0 = u.pn * BM + wc * 32 + 8 * fq;
        f32x4 bv[2][2];
#pragma unroll
        for (int bj = 0; bj < 2; ++bj)
#pragma unroll
            for (int n = 0; n < 2; ++n) bv[bj][n] = bias ? *(const f32x4*)(bias + bcol0 + bj * HALF + 4 * n) : (f32x4){0.f, 0.f, 0.f, 0.f};
#pragma unroll
        for (int ai = 0; ai < 2; ++ai)
#pragma unroll
            for (int m = 0; m < 4; ++m) { bf16_t* rowp = base + (size_t)(row0 + ai * HALF + m * 16) * ldc + col0;
#pragma unroll
                for (int bj = 0; bj < 2; ++bj) { f32x4 v0 = acc[ai][bj][m][0] + bv[bj][0], v1 = acc[ai][bj][m][1] + bv[bj][1];
                    if (ACT == 1) { f32x2 a = gelu_pk((f32x2){v0[0], v0[1]}), b = gelu_pk((f32x2){v0[2], v0[3]}), c = gelu_pk((f32x2){v1[0], v1[1]}), d = gelu_pk((f32x2){v1[2], v1[3]});
                        v0 = (f32x4){a.x, a.y, b.x, b.y}; v1 = (f32x4){c.x, c.y, d.x, d.y}; }
                    v0 = v0 * sc; v1 = v1 * sc; u32x4 w; w.x = cvt_pk_bf16(v0[0], v0[1]); w.y = cvt_pk_bf16(v0[2], v0[3]); w.z = cvt_pk_bf16(v1[0], v1[1]); w.w = cvt_pk_bf16(v1[2], v1[3]);
                    *(u32x4*)(rowp + bj * HALF) = w; } }
    }
};
typedef int v4i_t __attribute__((ext_vector_type(4)));
typedef int v8i_t __attribute__((ext_vector_type(8)));
__device__ __forceinline__ v8i_t cat32(bf16x8 a, bf16x8 b) { const v4i_t x = __builtin_bit_cast(v4i_t, a), y = __builtin_bit_cast(v4i_t, b); return __builtin_shufflevector(x, y, 0, 1, 2, 3, 4, 5, 6, 7); }
template <class Epi, class Sched, bool ALIGN_EPI = false, bool SP2 = false, bool GATHER = false, bool FP8 = false>
__device__ __forceinline__ void gemm_phase(PG8_LAS unsigned char* lds, const Gemm g, const Sched& S, const Epi& E, const int* rowsrc = nullptr, const PG8_LAS int* gtab = nullptr) {
    static_assert(!GATHER || SP2, "GATHER is implemented on the SP2 loop only");
    int tid_l = threadIdx.x; asm volatile("" : "+v"(tid_l));
    const int tid = tid_l, wid = __builtin_amdgcn_readfirstlane(tid >> 6), lane = tid & 63, wr = wid >> 2, wc = wid & 3, fr = lane & 15, fq = lane >> 4;
#if defined(PROBE_K2)
    const int K = g.K, nt0 = K / BK, nt = FP8 ? 2 * nt0 : nt0;
#define PG8_KT(x) (FP8 ? ((x) & (nt0 - 1)) : (x))
#else
    const int K = g.K, nt = K / BK;
#define PG8_KT(x) (x)
#endif
    unsigned voffA[2], voffB[2];
#pragma unroll
    for (int i = 0; i < 2; ++i) { int R, C; stage_rc(tid * 16 + i * 8192, R, C); const int Rb = Epi::PERM ? ((R & ~31) + perm32(R & 31)) : R;
        voffA[i] = (unsigned)(R * K + C) * 2u; voffB[i] = (unsigned)(Rb * K + C) * 2u; }
    unsigned gAc[2][2], gAn[2][2]; int gR[2]; unsigned gC[2];
#pragma unroll
    for (int i = 0; i < 2; ++i) { int R, C; stage_rc(tid * 16 + i * 8192, R, C); gR[i] = R; gC[i] = (unsigned)C * 2u; gAc[0][i] = gAc[1][i] = gAn[0][i] = gAn[1][i] = 0u; }
#define PG8_GATHER(u_, o_) do { const int gtb_ = gtab[(u_).pm], gtc_ = gtab[576 + (u_).pm];     \
        _Pragma("unroll") for (int h_ = 0; h_ < 2; ++h_) _Pragma("unroll") for (int i_ = 0; i_ < 2; ++i_) \
        { const int rl_ = h_ * HALF + gR[i_]; const int src_ = rl_ < gtc_ ? rowsrc[gtb_ + rl_] : 0; o_[h_][i_] = (unsigned)src_ * (unsigned)(K * 2) + gC[i_]; } } while (0)
#define PG8_STAGE_A(bufoff, orig_gbase, NEXTSEL, H, KOFF) do { if constexpr (GATHER) { unsigned vo_[2]; vo_[0] = (NEXTSEL) ? gAn[H][0] : gAc[H][0]; vo_[1] = (NEXTSEL) ? gAn[H][1] : gAc[H][1]; \
        PG8_STAGE(bufoff, (const char*)g.A + (KOFF), vo_); } else { PG8_STAGE(bufoff, orig_gbase, voffA); } } while (0)
    const size_t kstep = (size_t)(BK * 2);
    const size_t hstep = (size_t)HALF * K * 2;
    const size_t tstep = 2 * hstep;
    const unsigned ldsw = (unsigned)wid * 1024u;
    const int aoff = lds_byte(wr * 64 + fr, fq * 8), boff = lds_byte(wc * 32 + fr, fq * 8);
#define PG8_SA(b, h) (((b) * 2 + (h)) * HTB)
#define PG8_SB(b, h) ((4 + (b) * 2 + (h)) * HTB)
#define PG8_STAGE(bufoff, gbase, voff) do { _Pragma("unroll") for (int _i = 0; _i < 2; ++_i) \
        __builtin_amdgcn_global_load_lds((const unsigned*)((const char*)(gbase) + (voff)[_i]), (PG8_LAS unsigned*)(lds + (bufoff) + ldsw + _i * 8192), 16, 0, 0); } while (0)
#define PG8_LD32(var, addr) do { const bf16x8 lo_ = *(const PG8_LAS bf16x8*)(addr); const bf16x8 hi_ = *(const PG8_LAS bf16x8*)((addr) + 1024); var = cat32(lo_, hi_); } while (0)
#define PG8_LDA(dst, b, h) do { if constexpr (FP8) { _Pragma("unroll") for (int m = 0; m < 4; ++m) PG8_LD32(dst##8[m], lds + PG8_SA(b, h) + aoff + m * 2048); } \
        else { _Pragma("unroll") for (int m = 0; m < 4; ++m) _Pragma("unroll") for (int k = 0; k < 2; ++k) dst[m][k] = *(const PG8_LAS bf16x8*)(lds + PG8_SA(b, h) + aoff + m * 2048 + k * 1024); } } while (0)
#define PG8_LDB(dst, b, h) do { if constexpr (FP8) { _Pragma("unroll") for (int n = 0; n < 2; ++n) PG8_LD32(dst##8[n], lds + PG8_SB(b, h) + boff + n * 2048); } \
        else { _Pragma("unroll") for (int n = 0; n < 2; ++n) _Pragma("unroll") for (int k = 0; k < 2; ++k) dst[n][k] = *(const PG8_LAS bf16x8*)(lds + PG8_SB(b, h) + boff + n * 2048 + k * 1024); } } while (0)
#define PG8_MMA(ai, bj, At, Bt) do { __builtin_amdgcn_s_setprio(1); \
        if constexpr (FP8) { _Pragma("unroll") for (int m = 0; m < 4; ++m) _Pragma("unroll") for (int n = 0; n < 2; ++n) \
            asm volatile("v_mfma_scale_f32_16x16x128_f8f6f4 %0, %1, %2, %0, %3, %3 op_sel_hi:[0,0,0]" : "+v"(acc[ai][bj][m][n]) : "v"(Bt##8[n]), "v"(At##8[m]), "v"(sc127)); } \
        else { _Pragma("unroll") for (int m = 0; m < 4; ++m) _Pragma("unroll") for (int n = 0; n < 2; ++n) _Pragma("unroll") for (int k = 0; k < 2; ++k) \
            acc[ai][bj][m][n] = __builtin_amdgcn_mfma_f32_16x16x32_bf16(Bt[n][k], At[m][k], acc[ai][bj][m][n], 0, 0, 0); } \
        __builtin_amdgcn_s_setprio(0); } while (0)
#define PG8_WAIT_V(n) asm volatile("s_waitcnt vmcnt(" #n ")" ::: "memory")
#define PG8_WAIT_L(n) asm volatile("s_waitcnt lgkmcnt(" #n ")" ::: "memory")
#define PG8_BAR __builtin_amdgcn_s_barrier()
#define PG8_SCHED __builtin_amdgcn_sched_barrier(0)
    Unit cur, nxt; int ui = 0;
    if (!S.next(0, cur)) return;
    f32x4 acc[2][2][4][2];
#pragma unroll
    for (int a = 0; a < 2; ++a)
#pragma unroll
        for (int b = 0; b < 2; ++b)
#pragma unroll
            for (int m = 0; m < 4; ++m)
#pragma unroll
                for (int n = 0; n < 2; ++n) acc[a][b][m][n] = (f32x4){0.f, 0.f, 0.f, 0.f};
    int sc127 = 0x7f7f7f7f; asm volatile("" : "+v"(sc127));
    bf16x8 At[4][2], B0[2][2], B1[2][2]; v8i_t At8[4], B08[2], B18[2]; (void)At; (void)B0; (void)B1; (void)At8; (void)B08; (void)B18;
    const char* cA = (const char*)g.A + (size_t)cur.pm * tstep; const char* cB = (const char*)g.Bt + (size_t)cur.pn * tstep;
    S.a_ready(cur);
    if constexpr (GATHER) { PG8_GATHER(cur, gAc); }
    if constexpr (SP2) {
        PG8_STAGE(PG8_SB(0, 0), cB, voffB); PG8_STAGE(PG8_SB(0, 1), cB + hstep, voffB); PG8_STAGE_A(PG8_SA(0, 0), cA, false, 0, (size_t)0); PG8_STAGE_A(PG8_SA(0, 1), cA + hstep, false, 1, (size_t)0);
        if (wr == 1) PG8_BAR;
        PG8_WAIT_V(2); PG8_BAR;
        PG8_STAGE(PG8_SB(1, 0), cB + kstep, voffB); PG8_STAGE_A(PG8_SA(1, 0), cA + kstep, false, 0, kstep); PG8_STAGE(PG8_SB(1, 1), cB + hstep + kstep, voffB);
        PG8_WAIT_V(6); PG8_BAR;
    } else {
        PG8_STAGE(PG8_SB(0, 0), cB, voffB); PG8_STAGE(PG8_SA(0, 0), cA, voffA); PG8_STAGE(PG8_SB(0, 1), cB + hstep, voffB); PG8_STAGE(PG8_SA(0, 1), cA + hstep, voffA);
        if (wr == 1) PG8_BAR;
        PG8_WAIT_V(4); PG8_BAR;
        PG8_STAGE(PG8_SB(1, 0), cB + kstep, voffB); PG8_STAGE(PG8_SA(1, 0), cA + kstep, voffA); PG8_STAGE(PG8_SB(1, 1), cB + hstep + kstep, voffB);
        PG8_WAIT_V(6); PG8_BAR;
    }
    for (;;) {
        const bool has_next = S.next(ui + 1, nxt);
        if constexpr (GATHER) { if (has_next) { PG8_GATHER(nxt, gAn); } else { _Pragma("unroll") for (int h_ = 0; h_ < 2; ++h_) _Pragma("unroll") for (int i_ = 0; i_ < 2; ++i_) gAn[h_][i_] = gAc[h_][i_]; } }
        const char* nA = has_next ? (const char*)g.A + (size_t)nxt.pm * tstep : cA; const char* nB = has_next ? (const char*)g.Bt + (size_t)nxt.pn * tstep : cB;
#pragma nounroll
        for (int t = 0; t < nt; t += 2) {
            const bool last = (t == nt - 2);
            const char* a1 = cA + (size_t)PG8_KT(t + 1) * kstep;
            const char* a2 = last ? nA : cA + (size_t)PG8_KT(t + 2) * kstep; const char* b2 = last ? nB : cB + (size_t)PG8_KT(t + 2) * kstep;
            const char* a3 = a2 + kstep; const char* b3 = b2 + kstep;
            const size_t k1 = (size_t)PG8_KT(t + 1) * kstep, k2 = last ? (size_t)0 : (size_t)PG8_KT(t + 2) * kstep, k3 = k2 + kstep; (void)k1; (void)k2; (void)k3;
            if (last && has_next) S.a_ready(nxt);
            if constexpr (SP2) {
            PG8_LDB(B0, 0, 0); PG8_LDB(B1, 0, 1); PG8_SCHED; PG8_LDA(At, 0, 0); PG8_STAGE_A(PG8_SA(1, 1), a1 + hstep, false, 1, k1);
            PG8_WAIT_V(8); PG8_WAIT_L(0); PG8_BAR; PG8_MMA(0, 0, At, B0); PG8_MMA(0, 1, At, B1); PG8_BAR; PG8_SCHED;
            PG8_LDA(At, 0, 1); PG8_STAGE(PG8_SB(0, 0), b2, voffB); PG8_STAGE(PG8_SB(0, 1), b2 + hstep, voffB); PG8_STAGE_A(PG8_SA(0, 0), a2, last, 0, k2);
            PG8_WAIT_V(8); PG8_WAIT_L(0); PG8_BAR; PG8_MMA(1, 0, At, B0); PG8_MMA(1, 1, At, B1); PG8_BAR; PG8_SCHED;
            PG8_LDB(B0, 1, 0); PG8_LDB(B1, 1, 1); PG8_SCHED; PG8_LDA(At, 1, 0); PG8_STAGE_A(PG8_SA(0, 1), a2 + hstep, last, 1, k2);
            PG8_WAIT_V(8); PG8_WAIT_L(0); PG8_BAR; PG8_MMA(0, 0, At, B0); PG8_MMA(0, 1, At, B1); PG8_BAR; PG8_SCHED;
            PG8_LDA(At, 1, 1); PG8_STAGE(PG8_SB(1, 0), b3, voffB); PG8_STAGE(PG8_SB(1, 1), b3 + hstep, voffB); PG8_STAGE_A(PG8_SA(1, 0), a3, last, 0, k3);
            PG8_WAIT_V(8); PG8_WAIT_L(0); PG8_BAR; PG8_MMA(1, 0, At, B0); PG8_MMA(1, 1, At, B1); PG8_BAR; PG8_SCHED;
            } else {
            PG8_LDB(B0, 0, 0); PG8_SCHED; PG8_LDA(At, 0, 0); PG8_STAGE(PG8_SA(1, 1), a1 + hstep, voffA);
            PG8_WAIT_L(8); PG8_BAR; PG8_WAIT_L(0); PG8_MMA(0, 0, At, B0); PG8_BAR; PG8_SCHED;
            PG8_LDB(B1, 0, 1); PG8_STAGE(PG8_SB(0, 0), b2, voffB);
            PG8_BAR; PG8_WAIT_L(0); PG8_MMA(0, 1, At, B1); PG8_BAR;
            PG8_LDA(At, 0, 1); PG8_STAGE(PG8_SA(0, 0), a2, voffA);
            PG8_BAR; PG8_WAIT_L(0); PG8_MMA(1, 0, At, B0); PG8_BAR; PG8_SCHED;
            PG8_STAGE(PG8_SB(0, 1), b2 + hstep, voffB);
            PG8_WAIT_V(6); PG8_BAR; PG8_MMA(1, 1, At, B1); PG8_BAR;
            PG8_LDB(B0, 1, 0); PG8_SCHED; PG8_LDA(At, 1, 0); PG8_STAGE(PG8_SA(0, 1), a2 + hstep, voffA);
            PG8_WAIT_L(8); PG8_BAR; PG8_WAIT_L(0); PG8_MMA(0, 0, At, B0); PG8_BAR; PG8_SCHED;
            PG8_LDB(B1, 1, 1); PG8_STAGE(PG8_SB(1, 0), b3, voffB);
            PG8_BAR; PG8_WAIT_L(0); PG8_MMA(0, 1, At, B1); PG8_BAR;
            PG8_LDA(At, 1, 1); PG8_STAGE(PG8_SA(1, 0), a3, voffA);
            PG8_BAR; PG8_WAIT_L(0); PG8_MMA(1, 0, At, B0); PG8_BAR; PG8_SCHED;
            PG8_STAGE(PG8_SB(1, 1), b3 + hstep, voffB);
            PG8_WAIT_V(6); PG8_BAR; PG8_MMA(1, 1, At, B1); PG8_BAR;
            }
        }
        if constexpr (ALIGN_EPI) { if (wr == 0) PG8_BAR; }
        if constexpr (FP8) { asm volatile("s_nop 15\n\ts_nop 15" ::: "memory"); }
        if constexpr (!Epi::AFTER_DRAIN) { E(acc, cur, wr, wc, fr, fq);
#if defined(PROBE_EPI2)
            if constexpr (FP8 == (PROBE_EPI2 == 1)) { E(acc, cur, wr, wc, fr, fq); }
#endif
            S.done(cur); }
        if (!has_next) break;
#pragma unroll
        for (int a = 0; a < 2; ++a)
#pragma unroll
            for (int b = 0; b < 2; ++b)
#pragma unroll
                for (int m = 0; m < 4; ++m)
#pragma unroll
                    for (int n = 0; n < 2; ++n) acc[a][b][m][n] = (f32x4){0.f, 0.f, 0.f, 0.f};
        cur = nxt; cA = nA; cB = nB; ++ui;
        if constexpr (GATHER) { _Pragma("unroll") for (int h_ = 0; h_ < 2; ++h_) _Pragma("unroll") for (int i_ = 0; i_ < 2; ++i_) gAc[h_][i_] = gAn[h_][i_]; }
        if constexpr (ALIGN_EPI) { if (wr == 1) PG8_BAR; }
    }
    PG8_WAIT_V(0);
    if constexpr (!ALIGN_EPI) { if (wr == 0) PG8_BAR; }
    PG8_BAR;
    if constexpr (Epi::AFTER_DRAIN) { E.fused(acc, cur, wr, wc, fr, fq, lds, wid, lane); S.done(cur); }
#undef PG8_SA
#undef PG8_SB
#undef PG8_STAGE
#undef PG8_STAGE_A
#undef PG8_GATHER
#undef PG8_LDA
#undef PG8_LD32
#undef PG8_LDB
#undef PG8_MMA
#undef PG8_WAIT_V
#undef PG8_WAIT_L
#undef PG8_BAR
#undef PG8_SCHED
}
}

#ifndef PG8_SP2
#define PG8_SP2 true
#endif
#ifndef PG8_ALIGN
#define PG8_ALIGN true
#endif

#define GAS __attribute__((address_space(1)))
#define LAS __attribute__((address_space(3)))
typedef unsigned short bf16;
typedef unsigned v4u __attribute__((ext_vector_type(4)));
typedef unsigned v2u __attribute__((ext_vector_type(2)));
typedef float f32x4 __attribute__((ext_vector_type(4)));
typedef short bf16x8 __attribute__((ext_vector_type(8)));

constexpr int D = 1024, NB = 8, SEQ = 4096, CTXL = 256, TPB = SEQ + CTXL, NTOK = NB * TPB, NLAT = NB * SEQ;
constexpr int ZC = 3328;
constexpr int ZQ = 0, ZKV = 384, ZKR = 640, ZHQ = 672, ZHF = 1184, ZHB = 1696, ZHI = 2208, ZHG = 2720;
constexpr int NEXP = 32;
constexpr float ALPHA = 1.4142135623730951f;
constexpr float LN_EPS = 1e-5f, RMS_EPS = 1e-6f;
constexpr int NWAVES = 8, NTHR = 512;
constexpr float SC_X8 = 16.f, SC_WGU = 64.f, SC_ACT = 8.f, SC_WDN = 128.f, SC_Y = 64.f, SC_A1 = 16.f, SC_WPW = 64.f, SC_CV = 16.f, SC_A0 = 16.f, SC_WIN = 64.f;
constexpr int LDS_BYTES = 147456;
constexpr int LDS_BAR_OFF = LDS_BYTES - 64;
constexpr int LDS_TILE_E = 131072;
constexpr int MAXTILES = 576;

constexpr size_t MiB = 1u << 20;
constexpr size_t WS_CTL = 0, CTL_ZERO_BYTES = 16384;
constexpr size_t WS_MODV = 1 * MiB;
constexpr size_t WS_ROPE = 1 * MiB + 512 * 1024;
constexpr size_t WS_BGU = 2 * MiB;
constexpr size_t WS_PW1B = 2 * MiB + 512 * 1024;
constexpr size_t WS_BCNT = WS_PW1B + 64 * 1024;
constexpr size_t WS_TILEE = WS_BCNT + 64 * 1024;
constexpr size_t WS_META = WS_TILEE + 4096;
constexpr size_t WS_TOPI = 3 * MiB, WS_TOPW = 4 * MiB;
constexpr int ECAP = 32768;
constexpr size_t WS_ROWS = 160 * MiB, WS_ROWW = 164 * MiB, WS_ROWD = 168 * MiB;
constexpr size_t WS_CURSOR = 14336;
constexpr size_t WS_WIN = 8 * MiB, WS_WUQ = 15 * MiB, WS_WUKV = 16 * MiB, WS_WOUT = 17 * MiB, WS_WPW1 = 19 * MiB, WS_WPW2 = 23 * MiB;
constexpr size_t WS_WGU = 32 * MiB, WS_WDN = 288 * MiB;
constexpr size_t WS_H = 416 * MiB;
constexpr size_t WS_X = 552 * MiB, WS_Y = 620 * MiB;
constexpr size_t WS_BIG = 688 * MiB;
constexpr size_t WS_Z = WS_BIG, WS_CQN = WS_BIG + 221 * MiB, WS_CKVN = WS_BIG + 247 * MiB, WS_KRR = WS_BIG + 264 * MiB,
                 WS_Q = WS_BIG + 267 * MiB, WS_KV = WS_BIG + 318 * MiB, WS_OF = WS_BIG + 386 * MiB, WS_OB = WS_BIG + 454 * MiB;
constexpr size_t WS_HT = WS_BIG + 528 * MiB;
constexpr size_t WS_PRE = WS_BIG;
constexpr size_t WS_XS = WS_BIG, WS_ACT = WS_BIG + 288 * MiB, WS_YB = WS_BIG + 576 * MiB;
constexpr size_t WS_END = WS_BIG + 848 * MiB;
static_assert((size_t)NTOK * ZC * 2 <= 221 * MiB && (size_t)NTOK * 384 * 2 <= 26 * MiB && (size_t)NTOK * 256 * 2 <= 17 * MiB && (size_t)NTOK * 32 * 2 <= 3 * MiB, "ws map 1");
static_assert((size_t)NTOK * 768 * 2 <= 51 * MiB && (size_t)NTOK * 1024 * 2 <= 68 * MiB && (size_t)NTOK * 512 * 4 <= 68 * MiB, "ws map 2");
static_assert((size_t)64 * 136 * 26624 <= 320 * MiB && (size_t)MAXTILES * 256 * 2048 <= 288 * MiB && (size_t)NLAT * 4 * 2048 <= 272 * MiB && (size_t)NTOK * 1024 * 4 <= 136 * MiB, "ws map 3");

#define LDS_WAIT() asm volatile("s_waitcnt lgkmcnt(0)" ::: "memory")
#define VM_WAIT() asm volatile("s_waitcnt vmcnt(0)" ::: "memory")
__device__ __forceinline__ float bf2f(unsigned short b) { return __uint_as_float(((unsigned)b) << 16); }
__device__ __forceinline__ unsigned pk2(float lo, float hi) { return pg8::cvt_pk_bf16(lo, hi); }
__device__ __forceinline__ float sigm(float x) { return __builtin_amdgcn_rcpf(1.f + __expf(-x)); }
__device__ __forceinline__ float wave_sum(float v) {
#pragma unroll
    for (int o = 1; o < 64; o <<= 1) v += __shfl_xor(v, o);
    return v;
}
__device__ __forceinline__ int ld_ctl(const int* p) { return (int)__hip_atomic_load((const unsigned*)p, __ATOMIC_RELAXED, __HIP_MEMORY_SCOPE_AGENT); }
__device__ __forceinline__ int grow_of(int lr) { return (lr >> 12) * TPB + CTXL + (lr & 4095); }

#define XB_TMO      128
#define XB_XCNT(j)  (256  + 64 * (j))
#define XB_XSUB(j)  (1280 + 64 * (j))
#define XB_XGEN(j)  (2304 + 64 * (j))
#define XB_TOP      3328
#define XB_TOPGEN   3392
#define XCD_BAR_WORDS 3456
#define XB_SPIN_CAP (1u << 21)

__device__ __forceinline__ unsigned xb_ld(unsigned* p)              { return __hip_atomic_load(p, __ATOMIC_RELAXED, __HIP_MEMORY_SCOPE_AGENT); }
__device__ __forceinline__ unsigned xb_add(unsigned* p, unsigned v) { return __hip_atomic_fetch_add(p, v, __ATOMIC_RELAXED, __HIP_MEMORY_SCOPE_AGENT); }
__device__ __forceinline__ unsigned xb_xcc_id() { return (unsigned)__builtin_amdgcn_s_getreg((3 << 11) | 20) & 0xFu; }
#define XB_SPIN(cond, bar) do { unsigned _sp = 0; while (cond) { __builtin_amdgcn_s_sleep(1); \
    if ((++_sp & 255u) == 0u) { if (xb_ld(&(bar)[XB_TMO])) break; if (_sp > XB_SPIN_CAP) { atomicAdd(&(bar)[XB_TMO], 1u); break; } } } } while (0)

struct XcdBarrier { unsigned* bar; unsigned x; volatile LAS unsigned* st; };

__device__ __forceinline__ XcdBarrier xcd_barrier_post(unsigned* bar, volatile LAS unsigned* st) {
    XcdBarrier b; b.bar = bar; b.x = xb_xcc_id(); b.st = st;
    if (threadIdx.x == 0) (void)xb_add(&bar[XB_XCNT(b.x)], 1u);
    return b;
}
__device__ __forceinline__ void xcd_barrier_complete(unsigned* bar, unsigned x, unsigned& nloc, unsigned& nx) {
    const unsigned G = gridDim.x * gridDim.y * gridDim.z;
    unsigned sum, cnt, mine, sp = 0u;
    for (;;) {
        sum = 0u; cnt = 0u; mine = 0u;
#pragma unroll
        for (unsigned j = 0; j < 16; ++j) { const unsigned c = xb_ld(&bar[XB_XCNT(j)]); sum += c; cnt += (c > 0u) ? 1u : 0u; mine = (j == x) ? c : mine; }
        if (sum == G) break;
        __builtin_amdgcn_s_sleep(1);
        if ((++sp & 255u) == 0u) { if (xb_ld(&bar[XB_TMO])) break; if (sp > XB_SPIN_CAP) { atomicAdd(&bar[XB_TMO], 1u); break; } }
    }
    nloc = mine > 0u ? mine : 1u; nx = cnt > 0u ? cnt : 1u;
}
__device__ __forceinline__ void xcd_barrier(const XcdBarrier& b) {
    asm volatile("s_waitcnt vmcnt(0)" ::: "memory");
    __syncthreads();
    if (threadIdx.x == 0) {
        unsigned* bar = b.bar;
        __builtin_amdgcn_s_waitcnt(0);
        unsigned nloc = b.st[0], nx = b.st[1];
        if (nloc == 0u) { xcd_barrier_complete(bar, b.x, nloc, nx); b.st[0] = nloc; b.st[1] = nx; }
        const unsigned old = xb_add(&bar[XB_XSUB(b.x)], 1u);
        const unsigned gen = old / nloc;
        if (old + 1u == (gen + 1u) * nloc) {
            __builtin_amdgcn_fence(__ATOMIC_RELEASE, "agent");
            asm volatile("s_waitcnt vmcnt(0)" ::: "memory");
            const unsigned og = xb_add(&bar[XB_TOP], 1u);
            const unsigned tg = og / nx;
            if (og + 1u == (tg + 1u) * nx) xb_add(&bar[XB_TOPGEN], 1u);
            else XB_SPIN(xb_ld(&bar[XB_TOPGEN]) == tg, bar);
            __builtin_amdgcn_fence(__ATOMIC_ACQUIRE, "agent");
            xb_add(&bar[XB_XGEN(b.x)], 1u);
            asm volatile("s_waitcnt vmcnt(0)" ::: "memory");
        } else {
            XB_SPIN(xb_ld(&bar[XB_XGEN(b.x)]) == gen, bar);
            __builtin_amdgcn_fence(__ATOMIC_ACQUIRE, "agent");
            asm volatile("s_waitcnt vmcnt(0)" ::: "memory");
        }
    }
    __syncthreads();
}

namespace pg8 {
struct TileOrder {
    int nM, nN, nwg, G, c;
    __device__ __forceinline__ void init(int nM_, int nN_, int G_, int c_) { nM = nM_; nN = nN_; nwg = nM * nN; G = G_; c = c_; }
    __device__ __forceinline__ bool logical(int i, int& im, int& in) const {
        const long L = (long)i * G + c; if (L >= nwg) return false;
        int wgid = (int)L; { const int q = nwg / NXCD, r = nwg % NXCD, xcd = wgid % NXCD, off = wgid / NXCD; wgid = (xcd < r ? xcd * (q + 1) : r * (q + 1) + (xcd - r) * q) + off; }
        const int nig = WGM * nN, gid = wgid / nig, fm = gid * WGM, gsz = (nM - fm) < WGM ? (nM - fm) : WGM;
        im = fm + ((wgid % nig) % gsz); in = (wgid % nig) / gsz; return true;
    }
    __device__ __forceinline__ void a_ready(const Unit&) const {}
    __device__ __forceinline__ void done(const Unit&) const {}
};
struct AllOrder : TileOrder { __device__ __forceinline__ bool next(int i, Unit& u) const { int im, in; if (!logical(i, im, in)) return false; u.pm = im; u.pn = in; return true; } };
struct LatOrder : TileOrder {
    __device__ __forceinline__ bool next(int i, Unit& u) const { int im, in; if (!logical(i, im, in)) return false; u.pm = (im >> 4) * 17 + 1 + (im & 15); u.pn = in; return true; } };
struct MoeOrder : TileOrder {
    const PG8_LAS int* tile_e; int nper;
    __device__ __forceinline__ bool next(int i, Unit& u) const { int im, in; if (!logical(i, im, in)) return false; u.pm = im; u.pn = tile_e[im] * nper + in; return true; } };

struct EpiRes {
    static constexpr bool PERM = true, AFTER_DRAIN = false;
    const float* xin; const float* h; bf16_t* pre; const float* modv; const float* bias; float ascale;
    __device__ __forceinline__ void operator()(const f32x4 (&acc)[2][2][4][2], const Unit& u, int wr, int wc, int fr, int fq) const {
        asm volatile("" : "+v"(fr), "+v"(fq));
        const int b = u.pm / 17, j = u.pm % 17;
        const int rl0 = wr * 64 + fr, col0 = u.pn * BM + wc * 32 + 8 * fq;
        const float* gate = modv + (size_t)b * 6144 + 2048;
        f32x4 gv[2][2], bv[2][2];
#pragma unroll
        for (int bj = 0; bj < 2; ++bj)
#pragma unroll
            for (int n = 0; n < 2; ++n) { gv[bj][n] = *(const f32x4*)(gate + col0 + bj * HALF + 4 * n); bv[bj][n] = bias ? *(const f32x4*)(bias + col0 + bj * HALF + 4 * n) : (f32x4){0.f, 0.f, 0.f, 0.f}; }
#pragma unroll
        for (int aim = 0; aim < 4; ++aim) { const int ai = aim >> 1, m0 = (aim & 1) * 2;
            f32x4 hv[2][2][2];
#pragma unroll
            for (int mm = 0; mm < 2; ++mm) { const int rl = rl0 + ai * HALF + (m0 + mm) * 16; const size_t grow = (size_t)u.pm * BM + rl;
                const float* hin = xin ? xin + ((size_t)b * 4096 + (size_t)(j - 1) * 256 + rl) * 1024 + col0 : h + grow * 1024 + col0;
#pragma unroll
                for (int bj = 0; bj < 2; ++bj) { hv[mm][bj][0] = *(const f32x4*)(hin + bj * HALF); hv[mm][bj][1] = *(const f32x4*)(hin + bj * HALF + 4); } }
            asm volatile("" ::: "memory");
#pragma unroll
            for (int mm = 0; mm < 2; ++mm) { const int m = m0 + mm; const int rl = rl0 + ai * HALF + m * 16; const size_t grow = (size_t)u.pm * BM + rl; bf16_t* po = pre + grow * 1024 + col0;
#pragma unroll
                for (int bj = 0; bj < 2; ++bj) {
                    const f32x4 v0 = hv[mm][bj][0] * 1.4142135623730951f + gv[bj][0] * (acc[ai][bj][m][0] * ascale + bv[bj][0]), v1 = hv[mm][bj][1] * 1.4142135623730951f + gv[bj][1] * (acc[ai][bj][m][1] * ascale + bv[bj][1]);
                    u32x4 w; w.x = cvt_pk_bf16(v0[0], v0[1]); w.y = cvt_pk_bf16(v0[2], v0[3]); w.z = cvt_pk_bf16(v1[0], v1[1]); w.w = cvt_pk_bf16(v1[2], v1[3]);
                    *(u32x4*)(po + bj * HALF) = w; } }
            asm volatile("" ::: "memory"); }
    }
};
template <int MODE, bool OUT8 = false> struct EpiGate {
    static constexpr bool PERM = true, AFTER_DRAIN = false;
    bf16_t* O; const float* bias; int nper; float ascale, oscale;
    __device__ __forceinline__ void operator()(const f32x4 (&acc)[2][2][4][2], const Unit& u, int wr, int wc, int fr, int fq) const {
        asm volatile("" : "+v"(fr), "+v"(fq));
        const int row0 = u.pm * BM + wr * 64 + fr, pnl = u.pn % nper, ocol0 = pnl * HALF + wc * 32 + 8 * fq, bcol0 = u.pn * BM + wc * 32 + 8 * fq;
        const float s0 = ascale, s1 = MODE == 1 ? ascale * oscale : ascale;
        f32x4 bv[2][2];
#pragma unroll
        for (int n = 0; n < 2; ++n) { bv[0][n] = *(const f32x4*)(bias + bcol0 + 4 * n); const f32x4 t = *(const f32x4*)(bias + bcol0 + HALF + 4 * n); bv[1][n] = MODE == 1 ? (t + 1.0f) * oscale : t; }
#pragma unroll
        for (int ai = 0; ai < 2; ++ai)
#pragma unroll
            for (int m = 0; m < 4; ++m) { bf16_t* rowp = O + (size_t)(row0 + ai * HALF + m * 16) * 1024 + ocol0;
                unsigned char* rowp8 = (unsigned char*)O + (size_t)(row0 + ai * HALF + m * 16) * 1024 + ocol0;
                float o[8];
#pragma unroll
                for (int n = 0; n < 2; ++n) { const f32x4 a = acc[ai][0][m][n] * s0 + bv[0][n], g = acc[ai][1][m][n] * s1 + bv[1][n];
#pragma unroll
                    for (int e = 0; e < 4; ++e) {
                        if (MODE == 0) { o[4 * n + e] = a[e] * __builtin_amdgcn_rcpf(1.f + __builtin_amdgcn_exp2f(g[e] * -1.4426950408889634f)); }
                        else { const float gt = fminf(a[e], 7.0f), up1 = __builtin_amdgcn_fmed3f(g[e], -6.0f * oscale, 8.0f * oscale);
                            o[4 * n + e] = up1 * (gt * __builtin_amdgcn_rcpf(1.f + __builtin_amdgcn_exp2f(gt * (-1.702f * 1.4426950408889634f)))); } } }
                if constexpr (OUT8) {
                    int w0 = 0, w1 = 0; w0 = __builtin_amdgcn_cvt_pk_fp8_f32(o[0], o[1], w0, false); w0 = __builtin_amdgcn_cvt_pk_fp8_f32(o[2], o[3], w0, true);
                    w1 = __builtin_amdgcn_cvt_pk_fp8_f32(o[4], o[5], w1, false); w1 = __builtin_amdgcn_cvt_pk_fp8_f32(o[6], o[7], w1, true);
                    typedef unsigned u32x2 __attribute__((ext_vector_type(2))); *(u32x2*)rowp8 = (u32x2){(unsigned)w0, (unsigned)w1}; (void)rowp;
                } else { (void)rowp8;
                u32x4 w; w.x = cvt_pk_bf16(o[0], o[1]); w.y = cvt_pk_bf16(o[2], o[3]); w.z = cvt_pk_bf16(o[4], o[5]); w.w = cvt_pk_bf16(o[6], o[7]);
                *(u32x4*)rowp = w; } }
    }
};
struct EpiDown {
    static constexpr bool PERM = true, AFTER_DRAIN = false;
    bf16_t* Y; const float* bias; const float* row_w; const int* row_dst; float ascale; const PG8_LAS int* gtab; float oscale;
    __device__ __forceinline__ void operator()(const f32x4 (&acc)[2][2][4][2], const Unit& u, int wr, int wc, int fr, int fq) const {
        asm volatile("" : "+v"(fr), "+v"(fq));
        const int pnl = u.pn & 3, ocol0 = pnl * BM + wc * 32 + 8 * fq, bcol0 = u.pn * BM + wc * 32 + 8 * fq; const int tbase = gtab[u.pm], tcnt = gtab[576 + u.pm];
        f32x4 bv[2][2];
#pragma unroll
        for (int bj = 0; bj < 2; ++bj)
#pragma unroll
            for (int n = 0; n < 2; ++n) bv[bj][n] = *(const f32x4*)(bias + bcol0 + bj * HALF + 4 * n);
        int dstv[2][4]; float wv[2][4];
#pragma unroll
        for (int ai = 0; ai < 2; ++ai)
#pragma unroll
            for (int m = 0; m < 4; ++m) { const int rl = wr * 64 + fr + ai * HALF + m * 16; const int ix = tbase + (rl < tcnt ? rl : 0); dstv[ai][m] = row_dst[ix]; wv[ai][m] = row_w[ix]; }
#pragma unroll
        for (int ai = 0; ai < 2; ++ai)
#pragma unroll
            for (int m = 0; m < 4; ++m) { const int rl = wr * 64 + fr + ai * HALF + m * 16;
                if (rl < tcnt) { const int dst = dstv[ai][m]; const float w8 = wv[ai][m] * oscale; unsigned char* rowp = (unsigned char*)Y + (size_t)dst * 1024 + ocol0;
#pragma unroll
                    for (int bj = 0; bj < 2; ++bj) { const f32x4 v0 = (acc[ai][bj][m][0] * ascale + bv[bj][0]) * w8, v1 = (acc[ai][bj][m][1] * ascale + bv[bj][1]) * w8;
                        int w0 = 0, w1 = 0; w0 = __builtin_amdgcn_cvt_pk_fp8_f32(fminf(fmaxf(v0[0], -448.f), 448.f), fminf(fmaxf(v0[1], -448.f), 448.f), w0, false); w0 = __builtin_amdgcn_cvt_pk_fp8_f32(fminf(fmaxf(v0[2], -448.f), 448.f), fminf(fmaxf(v0[3], -448.f), 448.f), w0, true);
                        w1 = __builtin_amdgcn_cvt_pk_fp8_f32(fminf(fmaxf(v1[0], -448.f), 448.f), fminf(fmaxf(v1[1], -448.f), 448.f), w1, false); w1 = __builtin_amdgcn_cvt_pk_fp8_f32(fminf(fmaxf(v1[2], -448.f), 448.f), fminf(fmaxf(v1[3], -448.f), 448.f), w1, true);
                        typedef unsigned u32x2 __attribute__((ext_vector_type(2))); *(u32x2*)(rowp + bj * HALF) = (u32x2){(unsigned)w0, (unsigned)w1}; } } }
    }
};
}

namespace att {
using bf16x8 = __attribute__((ext_vector_type(8))) short;
using s16x4  = __attribute__((ext_vector_type(4))) short;
using f32x16 = __attribute__((ext_vector_type(16))) float;
using u32x4  = __attribute__((ext_vector_type(4))) unsigned;
constexpr int NW = 8, QBLK = 32, KVBLK = 64;
constexpr float SCALE = 0.10206207261596575f;
constexpr float THR = 8.f;
constexpr int SHM_V = 16384, SHM_K = 16384, NBUF = 3, SHM_ATTN = NBUF * SHM_V + NBUF * SHM_K + NW * 64 * 4;
#define KSWZ(row, colB) ((row) * 256 + ((colB) ^ (((row) & 7) << 4)))
#define SBAR() __builtin_amdgcn_sched_barrier(0)
__device__ __forceinline__ int crow(int r, int hi) { return (r & 3) + 8 * (r >> 2) + 4 * hi; }
__device__ __forceinline__ unsigned cvtpk(float lo, float hi) { unsigned r; asm volatile("v_cvt_pk_bf16_f32 %0, %1, %2" : "=v"(r) : "v"(lo), "v"(hi)); return r; }

__device__ __forceinline__ void partialSM(f32x16& p0, f32x16& p1, float& m_reg, float& mn, float& alpha) {
  constexpr float C = SCALE * 1.4426950408889634f;
  float pmax = p0[0];
#pragma unroll
  for (int r = 1; r < 16; ++r) pmax = fmaxf(pmax, p0[r]);
#pragma unroll
  for (int r = 0; r < 16; ++r) pmax = fmaxf(pmax, p1[r]);
  { auto rr = __builtin_amdgcn_permlane32_swap(__float_as_uint(pmax), __float_as_uint(pmax), false, false);
    pmax = fmaxf(__uint_as_float(rr[0]), __uint_as_float(rr[1])); }
  if (__builtin_expect(__all(pmax - m_reg <= THR / SCALE), 1)) { mn = m_reg; alpha = 1.f; }
  else { mn = fmaxf(m_reg, pmax); alpha = __builtin_amdgcn_exp2f((m_reg - mn) * C); m_reg = mn; }
  float mnC = -mn * C;
#pragma unroll
  for (int r = 0; r < 16; ++r) p0[r] = fmaf(p0[r], C, mnC);
#pragma unroll
  for (int r = 0; r < 16; ++r) p1[r] = fmaf(p1[r], C, mnC);
#pragma unroll
  for (int r = 0; r < 16; ++r) p0[r] = __builtin_amdgcn_exp2f(p0[r]);
}
__device__ __forceinline__ void finishSM(f32x16& p0, f32x16& p1, float alpha, float& l_reg, bf16x8& pa0, bf16x8& pa1, bf16x8& pa2, bf16x8& pa3) {
#pragma unroll
  for (int r = 0; r < 16; ++r) p1[r] = __builtin_amdgcn_exp2f(p1[r]);
  float ps = 0;
#pragma unroll
  for (int r = 0; r < 16; ++r) ps += p0[r];
#pragma unroll
  for (int r = 0; r < 16; ++r) ps += p1[r];
  { auto rr = __builtin_amdgcn_permlane32_swap(__float_as_uint(ps), __float_as_uint(ps), false, false);
    ps = __uint_as_float(rr[0]) + __uint_as_float(rr[1]); }
  l_reg = l_reg * alpha + ps;
#define PK4(P, BASE, OUT) do { unsigned a0 = cvtpk(P[BASE + 0], P[BASE + 1]), a1 = cvtpk(P[BASE + 2], P[BASE + 3]);   \
    unsigned b0 = cvtpk(P[BASE + 4], P[BASE + 5]), b1 = cvtpk(P[BASE + 6], P[BASE + 7]);                              \
    auto r0 = __builtin_amdgcn_permlane32_swap(a0, b0, false, false); auto r1 = __builtin_amdgcn_permlane32_swap(a1, b1, false, false); \
    u32x4 w = {r0[0], r1[0], r0[1], r1[1]}; OUT = *reinterpret_cast<bf16x8*>(&w); } while (0)
  PK4(p0, 0, pa0); PK4(p0, 8, pa1); PK4(p1, 0, pa2); PK4(p1, 8, pa3);
#undef PK4
}
__device__ __forceinline__ void qkt(f32x16& p0, f32x16& p1, const bf16* Ks, const bf16x8* qr, int r32, int hi) {
  p0 = f32x16{}; p1 = f32x16{};
#pragma unroll
  for (int d0 = 0; d0 < 6; ++d0) { int cb = (d0 * 16 + hi * 8) * 2;
    bf16x8 b0 = *reinterpret_cast<const bf16x8*>((const char*)Ks + KSWZ(r32, cb));
    bf16x8 b1 = *reinterpret_cast<const bf16x8*>((const char*)Ks + KSWZ(32 + r32, cb));
    p0 = __builtin_amdgcn_mfma_f32_32x32x16_bf16(b0, qr[d0], p0, 0, 0, 0);
    p1 = __builtin_amdgcn_mfma_f32_32x32x16_bf16(b1, qr[d0], p1, 0, 0, 0); }
}
__device__ __forceinline__ int v_st(int k, int c) { const int kk = (k & ~0xC) | ((k & 4) << 1) | ((k & 8) >> 1); return ((kk >> 3) * 4 + (c >> 5)) * 512 + ((kk & 7) * 32 + (c & 31)) * 2; }
__device__ __forceinline__ int v_rd_base(int lane) { return ((lane & 3) << 3) | (((lane >> 2) & 3) << 6) | (((lane >> 4) & 1) << 5) | (((lane >> 5) & 1) << 8); }
constexpr int v_rd_off(int d0, int ks, int half) { return d0 * 512 + ks * 4096 + half * 2048; }
template <int OFF> __device__ __forceinline__ s16x4 tr_read(int vb) {
  s16x4 r; asm volatile("ds_read_b64_tr_b16 %0, %1 offset:%2" : "=&v"(r) : "v"(vb), "i"(OFF) : "memory"); return r;
}
template <int D0> __device__ __forceinline__ void pv_one(f32x16& od, int vb, bf16x8 pa0, bf16x8 pa1, bf16x8 pa2, bf16x8 pa3) {
  const s16x4 l0 = tr_read<v_rd_off(D0, 0, 0)>(vb), h0 = tr_read<v_rd_off(D0, 0, 1)>(vb), l1 = tr_read<v_rd_off(D0, 1, 0)>(vb), h1 = tr_read<v_rd_off(D0, 1, 1)>(vb);
  const s16x4 l2 = tr_read<v_rd_off(D0, 2, 0)>(vb), h2 = tr_read<v_rd_off(D0, 2, 1)>(vb), l3 = tr_read<v_rd_off(D0, 3, 0)>(vb), h3 = tr_read<v_rd_off(D0, 3, 1)>(vb);
  asm volatile("s_waitcnt lgkmcnt(0)" ::: "memory"); SBAR();
#define PK(L, H) (bf16x8){L[0], L[1], L[2], L[3], H[0], H[1], H[2], H[3]}
  od = __builtin_amdgcn_mfma_f32_32x32x16_bf16(pa0, PK(l0, h0), od, 0, 0, 0);
  od = __builtin_amdgcn_mfma_f32_32x32x16_bf16(pa1, PK(l1, h1), od, 0, 0, 0);
  od = __builtin_amdgcn_mfma_f32_32x32x16_bf16(pa2, PK(l2, h2), od, 0, 0, 0);
  od = __builtin_amdgcn_mfma_f32_32x32x16_bf16(pa3, PK(l3, h3), od, 0, 0, 0);
#undef PK
}
__device__ __forceinline__ void pv_d0(f32x16* o, int vb, bf16x8 pa0, bf16x8 pa1, bf16x8 pa2, bf16x8 pa3) {
  pv_one<0>(o[0], vb, pa0, pa1, pa2, pa3); pv_one<1>(o[1], vb, pa0, pa1, pa2, pa3);
}
__device__ __forceinline__ bf16x8 rope8(bf16x8 x, const float* tab, int pbase) {
  u32x4 w;
#pragma unroll
  for (int i = 0; i < 4; ++i) { const float x1 = __uint_as_float(((unsigned)(unsigned short)x[2 * i]) << 16), x2 = __uint_as_float(((unsigned)(unsigned short)x[2 * i + 1]) << 16);
    const float cs = tab[pbase + i], sn = tab[16 + pbase + i]; w[i] = cvtpk(x1 * cs - x2 * sn, x1 * sn + x2 * cs); }
  return *reinterpret_cast<bf16x8*>(&w);
}
__device__ __forceinline__ void attn_unit(const bf16* __restrict__ Qb, const bf16* __restrict__ KVb, const bf16* __restrict__ KRb, bf16* __restrict__ Ob,
                                          const float* __restrict__ rope, int seq, char* lds) {
  int tid_l = threadIdx.x; asm volatile("" : "+v"(tid_l));
  const int tid = tid_l, wid = tid >> 6, lane = tid & 63, r32 = lane & 31, hi = lane >> 5;
  bf16* V_lds = (bf16*)lds; bf16* K_lds = (bf16*)(lds + NBUF * SHM_V);
  float* ws = (float*)(lds + NBUF * SHM_V + NBUF * SHM_K) + wid * 64; float* li_l = ws; float* al_l = ws + 32;
  float m_reg = -1e30f, l_reg = 0; f32x16 o[2] = {}; bf16x8 qr[6];
  const bf16* Qw = Qb + (long)(wid * QBLK + r32) * 768 + hi * 8;
#pragma unroll
  for (int d0 = 0; d0 < 6; ++d0) qr[d0] = *reinterpret_cast<const bf16x8*>(Qw + d0 * 16);
  if (rope) { const float* tab = rope + (long)(wid * QBLK + r32) * 32; qr[4] = rope8(qr[4], tab, 4 * hi); qr[5] = rope8(qr[5], tab, 8 + 4 * hi); }
  const int sr = tid >> 4, ch = tid & 15;
  const bf16* kbase = ch < 8 ? KVb + ch * 8 : KRb + ((ch - 8) & 3) * 8; const long kstr = ch < 8 ? 1024 : 32;
  const int vkey = tid >> 3, vc8 = (tid & 7) * 8, vst0 = v_st(vkey, vc8);
  const bf16* vbase = KVb + 512 + vc8;
  const int vb0 = (int)(uintptr_t)V_lds + v_rd_base(lane);
  struct { bf16x8 vs0, ks0, ks1; } sr_[2];
#define SLOAD(i, k0) do { sr_[i].vs0 = *reinterpret_cast<const bf16x8*>(vbase + (long)((k0) + vkey) * 1024); \
    sr_[i].ks0 = *reinterpret_cast<const bf16x8*>(kbase + (long)((k0) + sr) * kstr); sr_[i].ks1 = *reinterpret_cast<const bf16x8*>(kbase + (long)((k0) + 32 + sr) * kstr); } while (0)
#define SWRITE(b, i) do { *(bf16x8*)((char*)V_lds + (b) * SHM_V + vst0) = sr_[i].vs0; int kc = ch * 16;               \
    *(bf16x8*)((char*)K_lds + (b) * SHM_K + KSWZ(sr, kc)) = sr_[i].ks0;                       \
    *(bf16x8*)((char*)K_lds + (b) * SHM_K + KSWZ(32 + sr, kc)) = sr_[i].ks1; } while (0)
#define SWAIT() asm volatile("s_waitcnt vmcnt(3)" ::: "memory")
#define RESC(a) do { if (__any((a) < 1.f)) { if (hi == 0) al_l[r32] = (a); asm volatile("s_waitcnt lgkmcnt(0)" ::: "memory"); \
    _Pragma("unroll") for (int d = 0; d < 2; ++d) _Pragma("unroll") for (int r = 0; r < 16; ++r) o[d][r] *= al_l[crow(r, hi)]; } } while (0)
  f32x16 pA0, pA1, pB0, pB1; float mnA, mnB, alA, alB; bf16x8 pa0, pa1, pa2, pa3; const int NT = seq / KVBLK;
  constexpr int SE = 0, SO = 1;
  SLOAD(SE, 0); asm volatile("s_waitcnt vmcnt(0)" ::: "memory"); SWRITE(0, SE); __syncthreads();
  qkt(pA0, pA1, K_lds, qr, r32, hi); partialSM(pA0, pA1, m_reg, mnA, alA);
  SLOAD(SO, KVBLK); if (2 < NT) SLOAD(SE, 2 * KVBLK);
  SWAIT(); SWRITE(1, SO); __syncthreads();
  int bprev = 0, bcur = 1, bnext = 2;
#define ATT_STEP(PN0, PN1, MNN, ALN, PO0, PO1, ALO, SL_LOAD, SL_WRITE, t) do { \
    SBAR(); qkt(PN0, PN1, (bf16*)((char*)K_lds + bcur * SHM_K), qr, r32, hi); \
    finishSM(PO0, PO1, ALO, l_reg, pa0, pa1, pa2, pa3); SBAR(); \
    if ((t) + 2 < NT) SLOAD(SL_LOAD, ((t) + 2) * KVBLK); SBAR(); \
    pv_d0(o, vb0 + bprev * (int)SHM_V, pa0, pa1, pa2, pa3); partialSM(PN0, PN1, m_reg, MNN, ALN); \
    SWAIT(); SWRITE(bnext, SL_WRITE); \
    RESC(ALN); __syncthreads(); \
    bprev = bcur; bcur = bnext; bnext = (bnext == 2) ? 0 : bnext + 1; } while (0)
  for (int j = 1; j + 1 < NT; j += 2) {
    ATT_STEP(pB0, pB1, mnB, alB, pA0, pA1, alA, SO, SE, j);
    ATT_STEP(pA0, pA1, mnA, alA, pB0, pB1, alB, SE, SO, j + 1);
  }
#undef ATT_STEP
  SBAR(); qkt(pB0, pB1, (bf16*)((char*)K_lds + bcur * SHM_K), qr, r32, hi);
  finishSM(pA0, pA1, alA, l_reg, pa0, pa1, pa2, pa3); SBAR();
  pv_d0(o, vb0 + bprev * (int)SHM_V, pa0, pa1, pa2, pa3); partialSM(pB0, pB1, m_reg, mnB, alB);
  RESC(alB);
  finishSM(pB0, pB1, alB, l_reg, pa0, pa1, pa2, pa3); SBAR();
  pv_d0(o, vb0 + bcur * (int)SHM_V, pa0, pa1, pa2, pa3);
  if (hi == 0) li_l[r32] = l_reg; asm volatile("s_waitcnt lgkmcnt(0)" ::: "memory");
  float rli[16];
#pragma unroll
  for (int r = 0; r < 16; ++r) rli[r] = __builtin_amdgcn_rcpf(li_l[crow(r, hi)]);
  bf16* Ow = Ob + (long)(wid * QBLK) * 1024;
#pragma unroll
  for (int r = 0; r < 16; ++r) { int orow = crow(r, hi);
#pragma unroll
    for (int d0 = 0; d0 < 2; ++d0) { const float v = o[d0][r] * rli[r]; Ow[(long)orow * 1024 + d0 * 32 + r32] = (bf16)(cvtpk(v, v) & 0xffffu); } }
#undef SLOAD
#undef SWRITE
#undef SWAIT
#undef RESC
}
}

struct Args { const float* in[33]; float* out; unsigned char* ws; int ph_lo, ph_hi; };
enum { I_X = 0, I_C, I_CTX, I_CCTX, I_MODW, I_MODB, I_LN1G, I_LN1B, I_LN2G, I_LN2B, I_WIN, I_QNORM, I_KVNORM, I_WUQ, I_WUK, I_WUV, I_LBL, I_HGNORM, I_WOUT,
       I_PW1W, I_PW1B, I_DWW, I_DWB, I_CLNG, I_CLNB, I_PW2W, I_PW2B, I_RW, I_RB, I_WGU, I_BGU, I_WDN, I_BDN };

__device__ __forceinline__ int dst_row(int n, int mode, int row_off) {
    if (mode == 0) return row_off + n;
    int f, g; if (mode == 1) { f = n >> 1; g = n & 1; } else { g = n >> 10; f = n & 1023; }
    return row_off + 256 * (f >> 7) + 128 * g + (f & 127);
}
__device__ __forceinline__ unsigned pack_fp8x4(float a, float b, float c, float d) { int w = 0; w = __builtin_amdgcn_cvt_pk_fp8_f32(fminf(fmaxf(a, -448.f), 448.f), fminf(fmaxf(b, -448.f), 448.f), w, false);
    w = __builtin_amdgcn_cvt_pk_fp8_f32(fminf(fmaxf(c, -448.f), 448.f), fminf(fmaxf(d, -448.f), 448.f), w, true); return (unsigned)w; }
struct TrItem { const float* W; bf16* WT; int K, N, mode, row_off, item; float f8scale; };
__device__ __forceinline__ void tr_load(const TrItem& d, f32x4 (&v)[16], int lane) {
    const int nblk = (d.N + 63) >> 6, kb = d.item / nblk, nb = d.item - kb * nblk, k0 = 64 * kb, n0 = 64 * nb;
    const int nc = n0 + 4 * (lane & 15), kr = lane >> 4;
#pragma unroll
    for (int i = 0; i < 16; ++i) v[i] = (nc < d.N) ? __builtin_nontemporal_load((const f32x4*)(d.W + (size_t)(k0 + 4 * i + kr) * d.N + nc)) : (f32x4){0.f, 0.f, 0.f, 0.f};
}
__device__ __forceinline__ void tr_lds_write(const f32x4 (&v)[16], LAS float* scr, int lane) {
    const int kr = lane >> 4;
#pragma unroll
    for (int i = 0; i < 16; ++i) { LAS float* s = scr + (4 * i + kr) * 65 + 4 * (lane & 15); s[0] = v[i][0]; s[1] = v[i][1]; s[2] = v[i][2]; s[3] = v[i][3]; }
}
__device__ __forceinline__ void tr_store(const TrItem& d, LAS float* scr, int lane) {
    const int nblk = (d.N + 63) >> 6, kb = d.item / nblk, nb = d.item - kb * nblk, k0 = 64 * kb, n0 = 64 * nb;
    const int c = lane & 7; const int K = d.K;
#pragma unroll
    for (int j = 0; j < 8; ++j) { const int nl = (lane >> 3) + 8 * j, n = n0 + nl; const LAS float* s = scr + (8 * c) * 65 + nl;
        if (n < d.N) { if (d.f8scale > 0.f) { const float f8 = d.f8scale; v2u o8; o8.x = pack_fp8x4(s[0 * 65] * f8, s[1 * 65] * f8, s[2 * 65] * f8, s[3 * 65] * f8); o8.y = pack_fp8x4(s[4 * 65] * f8, s[5 * 65] * f8, s[6 * 65] * f8, s[7 * 65] * f8);
                *(v2u*)((unsigned char*)d.WT + (size_t)dst_row(n, d.mode, d.row_off) * K + k0 + 8 * c) = o8; }
            else { v4u o; o.x = pk2(s[0 * 65], s[1 * 65]); o.y = pk2(s[2 * 65], s[3 * 65]); o.z = pk2(s[4 * 65], s[5 * 65]); o.w = pk2(s[6 * 65], s[7 * 65]);
                *(v4u*)(d.WT + (size_t)dst_row(n, d.mode, d.row_off) * K + k0 + 8 * c) = o; } } }
}
__device__ __forceinline__ void convert_items(const Args& a, unsigned char* ws, LAS float* scr, int lane, int gw, int NGW, int it_lo, int it_hi) {
    constexpr int I0 = 16 * 51, I1 = 6 * 12, I2 = 4 * 8, I3 = 4 * 8, I4 = 256, I5 = 512;
    constexpr int NGU = 64 * 512, NDN = 64 * 256;
    auto decode = [&](int it) -> TrItem {
        TrItem d; int r = it; d.f8scale = 0.f; d.mode = 0; d.row_off = 0;
        if (r < NGU) { const int mi = r >> 9; d.W = a.in[I_WGU] + (size_t)mi * 1024 * 2048; d.K = 1024; d.N = 2048; d.WT = (bf16*)(ws + WS_WGU + (size_t)mi * 2048 * 1024); d.mode = 1; d.item = r & 511; d.f8scale = SC_WGU; return d; } r -= NGU;
        if (r < NDN) { const int mi = r >> 8; d.W = a.in[I_WDN] + (size_t)mi * 1024 * 1024; d.K = 1024; d.N = 1024; d.WT = (bf16*)(ws + WS_WDN + (size_t)mi * 1024 * 1024); d.item = r & 255; d.f8scale = SC_WDN; return d; } r -= NDN;
        if (r < I0) { d.W = a.in[I_WIN]; d.K = 1024; d.N = 3232; d.WT = (bf16*)(ws + WS_WIN); d.item = r; d.f8scale = SC_WIN; return d; } r -= I0;
        if (r < I1) { d.W = a.in[I_WUQ]; d.K = 384; d.N = 768; d.WT = (bf16*)(ws + WS_WUQ); d.item = r; return d; } r -= I1;
        if (r < I2) { d.W = a.in[I_WUK]; d.K = 256; d.N = 512; d.WT = (bf16*)(ws + WS_WUKV); d.item = r; return d; } r -= I2;
        if (r < I3) { d.W = a.in[I_WUV]; d.K = 256; d.N = 512; d.WT = (bf16*)(ws + WS_WUKV); d.row_off = 512; d.item = r; return d; } r -= I3;
        if (r < I4) { d.W = a.in[I_WOUT]; d.K = 1024; d.N = 1024; d.WT = (bf16*)(ws + WS_WOUT); d.item = r; return d; } r -= I4;
        if (r < I5) { d.W = a.in[I_PW1W]; d.K = 1024; d.N = 2048; d.WT = (bf16*)(ws + WS_WPW1); d.mode = 2; d.item = r; d.f8scale = SC_WPW; return d; } r -= I5;
        d.W = a.in[I_PW2W]; d.K = 1024; d.N = 1024; d.WT = (bf16*)(ws + WS_WPW2); d.item = r; d.f8scale = SC_WPW; return d; };
    f32x4 tv[16];
    int it = it_lo + gw;
    if (it < it_hi) { const TrItem d0 = decode(it); tr_load(d0, tv, lane); }
    for (; it < it_hi; it += NGW) {
        const TrItem d = decode(it);
        tr_lds_write(tv, scr, lane);
        if (it + NGW < it_hi) { const TrItem dn = decode(it + NGW); tr_load(dn, tv, lane); }
        LDS_WAIT();
        tr_store(d, scr, lane);
        LDS_WAIT();
    }
}
__device__ __forceinline__ void phase_prologue(const Args& a, LAS unsigned char* lds, int tid, int lane, int wave) {
    unsigned char* ws = a.ws;
    const int G = gridDim.x, B = blockIdx.x;
    {
        LAS float* sc = (LAS float*)lds;
        LAS float* red = (LAS float*)(lds + 36864);
        float* modv = (float*)(ws + WS_MODV);
        bool have = false;
        for (int it = B; it < 192; it += G) {
            if (!have) { for (int i = tid; i < 9 * 1024; i += NTHR) { const int r = i >> 10, k = i & 1023; const float x = r < 8 ? a.in[I_C][r * 1024 + k] : a.in[I_CCTX][k]; sc[i] = x * sigm(x); } __syncthreads(); have = true; }
            const int l = it / 96, jc = it % 96, kg = tid >> 6, jj = tid & 63, j = jc * 64 + jj;
            float acc[9];
#pragma unroll
            for (int r = 0; r < 9; ++r) acc[r] = 0.f;
            const float* wp = a.in[I_MODW] + ((size_t)l * 1024 + kg * 128) * 6144 + j;
            for (int k0 = 0; k0 < 128; k0 += 16) { float w[16];
#pragma unroll
                for (int kk = 0; kk < 16; ++kk) w[kk] = wp[(size_t)(k0 + kk) * 6144];
#pragma unroll
                for (int kk = 0; kk < 16; ++kk)
#pragma unroll
                    for (int r = 0; r < 9; ++r) acc[r] += sc[r * 1024 + kg * 128 + k0 + kk] * w[kk]; }
#pragma unroll
            for (int r = 0; r < 9; ++r) red[(kg * 9 + r) * 64 + jj] = acc[r];
            __syncthreads();
            for (int i = tid; i < 576; i += NTHR) { const int r = i >> 6, j2 = i & 63; float s = a.in[I_MODB][l * 6144 + jc * 64 + j2];
#pragma unroll
                for (int g = 0; g < 8; ++g) s += red[(g * 9 + r) * 64 + j2];
                modv[((size_t)l * 9 + r) * 6144 + jc * 64 + j2] = s; }
            __syncthreads();
        }
        __syncthreads();
    }
    const int gw = B * NWAVES + wave, NGW = G * NWAVES, gt = B * NTHR + tid, NGT = G * NTHR;
    { float* rope = (float*)(ws + WS_ROPE);
      for (int i = gt; i < 4096 * 16; i += NGT) { const int t = i >> 4, p = i & 15; const float pos = (float)(p < 8 ? (t >> 6) : (t & 63));
          const float inv = __powf(10000.0f, -(float)(p & 7) * 0.125f); const float ang = pos * inv; rope[t * 32 + p] = cosf(ang); rope[t * 32 + 16 + p] = sinf(ang); }
      float* bgu = (float*)(ws + WS_BGU);
      for (int i = gt; i < 2 * 32 * 2048; i += NGT) { const int le = i >> 11, np = i & 2047, q = np >> 8, g = (np >> 7) & 1, r = np & 127, f = 128 * q + r; bgu[i] = a.in[I_BGU][(size_t)le * 2048 + 2 * f + g]; }
      float* pb = (float*)(ws + WS_PW1B);
      for (int i = gt; i < 2048; i += NGT) { const int q = i >> 8, g = (i >> 7) & 1, r = i & 127, f = 128 * q + r; pb[i] = a.in[I_PW1B][g * 1024 + f]; }
      v4u* zp = (v4u*)(ws + WS_WIN + (size_t)3232 * 1024);
      for (int i = gt; i < 96 * 1024 / 16; i += NGT) zp[i] = (v4u){0u, 0u, 0u, 0u};
    }
    LAS float* scr = (LAS float*)(lds + wave * 16640);
    constexpr int I0 = 16 * 51, I1 = 6 * 12, I2 = 4 * 8, I3 = 4 * 8, I4 = 256, I5 = 512, I6 = 256, SMALL = I0 + I1 + I2 + I3 + I4 + I5 + I6;
    constexpr int NGU = 64 * 512, NDN = 64 * 256, NITEMS = SMALL + NGU + NDN;
    convert_items(a, ws, scr, lane, B * NWAVES + wave, G * NWAVES, NGU + NDN, NITEMS);
}
__device__ __forceinline__ void convert_moe_share(const Args& a, LAS unsigned char* lds, int lane, int wave) {
    LAS float* scr = (LAS float*)(lds + wave * 16640);
    constexpr int NGU = 64 * 512, NDN = 64 * 256;
    convert_items(a, a.ws, scr, lane, blockIdx.x * NWAVES + wave, gridDim.x * NWAVES, 0, NGU + NDN);
}

__device__ __forceinline__ void phase_mod0(const Args& a, int lane, int wave) {
    const int gw = blockIdx.x * NWAVES + wave, NGW = gridDim.x * NWAVES;
    const float* modv = (const float*)(a.ws + WS_MODV);
    bf16* X = (bf16*)(a.ws + WS_X);
    for (int r0 = 2 * gw; r0 < NTOK; r0 += 2 * NGW) {
        f32x4 xv[2][4]; const float* mvp[2];
#pragma unroll
        for (int q = 0; q < 2; ++q) { const int r = r0 + q; const int b = r / TPB, p = r - b * TPB;
            const float* src = p < CTXL ? a.in[I_CTX] + ((size_t)b * CTXL + p) * 1024 : a.in[I_X] + ((size_t)b * SEQ + (p - CTXL)) * 1024;
            mvp[q] = modv + (size_t)(p < CTXL ? 8 : b) * 6144;
#pragma unroll
            for (int j = 0; j < 4; ++j) xv[q][j] = *(const f32x4*)(src + 4 * (lane + 64 * j)); }
#pragma unroll
        for (int q = 0; q < 2; ++q)
#pragma unroll
            for (int j = 0; j < 4; ++j) { const int c = 4 * (lane + 64 * j); const f32x4 sh = *(const f32x4*)(mvp[q] + c), sc = *(const f32x4*)(mvp[q] + 1024 + c);
                const f32x4 y = (xv[q][j] * (sc + 1.0f) + sh) * SC_A0; *(unsigned*)((unsigned char*)X + (size_t)(r0 + q) * 1024 + c) = pack_fp8x4(y[0], y[1], y[2], y[3]); }
    }
}

__device__ __forceinline__ void phase_norm0(const Args& a, int lane, int wave) {
    const int gw = blockIdx.x * NWAVES + wave, NGW = gridDim.x * NWAVES;
    const bf16* Z = (const bf16*)(a.ws + WS_Z); bf16* CQN = (bf16*)(a.ws + WS_CQN); bf16* CKVN = (bf16*)(a.ws + WS_CKVN); bf16* KRR = (bf16*)(a.ws + WS_KRR);
    const float* rope = (const float*)(a.ws + WS_ROPE);
    float gq[8], gk[8];
#pragma unroll
    for (int i = 0; i < 8; ++i) { gq[i] = lane < 48 ? a.in[I_QNORM][8 * lane + i] : 0.f; gk[i] = lane < 32 ? a.in[I_KVNORM][8 * lane + i] : 0.f; }
    for (int r = gw; r < NTOK; r += NGW) {
        const bf16* z = Z + (size_t)r * ZC; const int p = r % TPB;
        bf16x8 q8 = {}, k8 = {}, r8 = {};
        if (lane < 48) q8 = *(const bf16x8*)(z + ZQ + 8 * lane);
        if (lane < 32) k8 = *(const bf16x8*)(z + ZKV + 8 * lane);
        if (lane < 4) r8 = *(const bf16x8*)(z + ZKR + 8 * lane);
        float qf[8], kf[8], sq = 0.f, sk = 0.f;
#pragma unroll
        for (int i = 0; i < 8; ++i) { qf[i] = bf2f((unsigned short)q8[i]); kf[i] = bf2f((unsigned short)k8[i]); sq += qf[i] * qf[i]; sk += kf[i] * kf[i]; }
        sq = wave_sum(sq); sk = wave_sum(sk);
        const float rq = rsqrtf(sq * (1.f / 384.f) + RMS_EPS), rk = rsqrtf(sk * (1.f / 256.f) + RMS_EPS);
        if (lane < 48) { v4u o; o.x = pk2(qf[0] * rq * gq[0], qf[1] * rq * gq[1]); o.y = pk2(qf[2] * rq * gq[2], qf[3] * rq * gq[3]); o.z = pk2(qf[4] * rq * gq[4], qf[5] * rq * gq[5]); o.w = pk2(qf[6] * rq * gq[6], qf[7] * rq * gq[7]);
            *(v4u*)(CQN + (size_t)r * 384 + 8 * lane) = o; }
        if (lane < 32) { v4u o; o.x = pk2(kf[0] * rk * gk[0], kf[1] * rk * gk[1]); o.y = pk2(kf[2] * rk * gk[2], kf[3] * rk * gk[3]); o.z = pk2(kf[4] * rk * gk[4], kf[5] * rk * gk[5]); o.w = pk2(kf[6] * rk * gk[6], kf[7] * rk * gk[7]);
            *(v4u*)(CKVN + (size_t)r * 256 + 8 * lane) = o; }
        if (lane < 4) { bf16x8 o8 = r8; if (p >= CTXL) o8 = att::rope8(r8, rope + (size_t)(p - CTXL) * 32, 4 * lane); *(bf16x8*)(KRR + (size_t)r * 32 + 8 * lane) = o8; }
    }
}

__device__ __forceinline__ void hgrn_unit(const Args& a, int unit, LAS unsigned char* lds, int tid) {
    const int b = unit >> 5, head = (unit >> 3) & 3, dir = (unit >> 2) & 1, sl = unit & 3;
    const bf16* Z = (const bf16*)(a.ws + WS_Z);
    float* Od = (float*)(a.ws + (dir ? WS_OB : WS_OF));
    LAS float* lbv = (LAS float*)lds;
    constexpr int BUF0 = 1024, BUFSZ = 28672, OFF_Q = 16384, OFF_V = 24576;
    if (tid < 128) { const int c = head * 128 + tid; const float l0 = a.in[I_LBL][c], l1 = a.in[I_LBL][512 + c], l2 = a.in[I_LBL][1024 + c]; const float m = fmaxf(l0, fmaxf(l1, l2));
        const float e0 = __expf(l0 - m), e1 = __expf(l1 - m), e2 = __expf(l2 - m); lbv[tid] = e0 / (e0 + e1 + e2); }
    __syncthreads();
    const int lt = tid >> 4, lcg = tid & 15;
    float lb8[8];
#pragma unroll
    for (int i = 0; i < 8; ++i) lb8[i] = lbv[8 * lcg + i];
    const int fcol = (dir ? ZHB : ZHF) + head * 128 + 8 * lcg, qcol = ZHQ + head * 128 + 8 * lcg;
    const int vt = tid >> 2, vcol = ZHI + head * 128 + sl * 32 + (tid & 3) * 8;
    const int wave = tid >> 6, lane = tid & 63, vv = lane >> 4, cg = lane & 15, vloc = wave * 4 + vv;
    const size_t zb = (size_t)b * TPB;
    bf16x8 rq, rf, rv;
#define TOKP(n) (dir ? ((n) < CTXL ? (CTXL - 1 - (n)) : (TPB + CTXL - 1 - (n))) : (n))
#define HG_LOAD(i) do { const int n_ = 32 * (i) + lt; const bf16* zr_ = Z + (zb + TOKP(n_)) * ZC; rq = *(const bf16x8*)(zr_ + qcol); rf = *(const bf16x8*)(zr_ + fcol); \
        if (tid < 128) { const int n2_ = 32 * (i) + vt; rv = *(const bf16x8*)(Z + (zb + TOKP(n2_)) * ZC + vcol); } } while (0)
#define HG_WRITE(bufi) do { LAS unsigned char* bp_ = lds + BUF0 + (bufi) * BUFSZ; float f_[8]; \
        _Pragma("unroll") for (int i_ = 0; i_ < 8; ++i_) f_[i_] = lb8[i_] + (1.f - lb8[i_]) * sigm(bf2f((unsigned short)rf[i_])); \
        *(LAS f32x4*)(bp_ + ((lt * 128 + lcg * 4) * 4)) = (f32x4){f_[0], f_[1], f_[2], f_[3]}; *(LAS f32x4*)(bp_ + ((lt * 128 + 64 + lcg * 4) * 4)) = (f32x4){f_[4], f_[5], f_[6], f_[7]}; \
        *(LAS bf16x8*)(bp_ + OFF_Q + (lt * 128 + lcg * 8) * 2) = rq; \
        if (tid < 128) { float v_[8]; _Pragma("unroll") for (int i_ = 0; i_ < 8; ++i_) v_[i_] = bf2f((unsigned short)rv[i_]); \
            *(LAS f32x4*)(bp_ + OFF_V + (vt * 32 + (tid & 3) * 8) * 4) = (f32x4){v_[0], v_[1], v_[2], v_[3]}; *(LAS f32x4*)(bp_ + OFF_V + (vt * 32 + (tid & 3) * 8 + 4) * 4) = (f32x4){v_[4], v_[5], v_[6], v_[7]}; } } while (0)
    float S[8];
#pragma unroll
    for (int j = 0; j < 8; ++j) S[j] = 0.f;
    HG_LOAD(0); HG_WRITE(0); __syncthreads();
    const bool b3 = (cg & 8) != 0, b2 = (cg & 4) != 0, b1 = (cg & 2) != 0, b0 = (cg & 1) != 0;
    for (int i = 0; i < TPB / 32; ++i) {
        if (i + 1 < TPB / 32) HG_LOAD(i + 1);
        const LAS unsigned char* bp = lds + BUF0 + (i & 1) * BUFSZ;
#pragma unroll 1
        for (int g = 0; g < 4; ++g) {
            const LAS unsigned char* gp = bp + g * 8 * 512;
            float ot[8];
#pragma unroll
            for (int t = 0; t < 8; ++t) {
                const f32x4 f0 = *(const LAS f32x4*)(gp + ((t * 128 + cg * 4) * 4)), f1 = *(const LAS f32x4*)(gp + ((t * 128 + 64 + cg * 4) * 4));
                const bf16x8 q8 = *(const LAS bf16x8*)(bp + OFF_Q + ((g * 8 + t) * 128 + cg * 8) * 2);
                const float v = *(const LAS float*)(bp + OFF_V + ((g * 8 + t) * 32 + vloc) * 4);
                float acc = 0.f;
#pragma unroll
                for (int j = 0; j < 8; ++j) { const float fj = j < 4 ? f0[j] : f1[j - 4]; const float qj = bf2f((unsigned short)q8[j]);
                    const float kv = fmaf(-fj, v, v); S[j] = fmaf(fj, S[j], kv); acc = fmaf(S[j], qj, acc); }
                ot[t] = acc;
            }
#pragma unroll
            for (int k = 0; k < 4; ++k) { const float snd = b3 ? ot[k] : ot[k + 4]; const float rcv = __shfl_xor(snd, 8); ot[k] = (b3 ? ot[k + 4] : ot[k]) + rcv; }
#pragma unroll
            for (int k = 0; k < 2; ++k) { const float snd = b2 ? ot[k] : ot[k + 2]; const float rcv = __shfl_xor(snd, 4); ot[k] = (b2 ? ot[k + 2] : ot[k]) + rcv; }
            { const float snd = b1 ? ot[0] : ot[1]; const float rcv = __shfl_xor(snd, 2); ot[0] = (b1 ? ot[1] : ot[0]) + rcv; }
            ot[0] += __shfl_xor(ot[0], 1);
            if (!b0) { const int n = 32 * i + 8 * g + (cg >> 1); const int p = TOKP(n); if (p >= CTXL) Od[(zb + p) * 512 + head * 128 + sl * 32 + vloc] = ot[0]; }
        }
        if (i + 1 < TPB / 32) HG_WRITE((i + 1) & 1);
        __syncthreads();
    }
#undef TOKP
#undef HG_LOAD
#undef HG_WRITE
}

__device__ __forceinline__ void phase_readout(const Args& a, int lane, int wave) {
    const int gw = blockIdx.x * NWAVES + wave, NGW = gridDim.x * NWAVES;
    const bf16* OF = (const bf16*)(a.ws + WS_OF); const bf16* OB = (const bf16*)(a.ws + WS_OB);
    const bf16* Z = (const bf16*)(a.ws + WS_Z); bf16* MIX = (bf16*)(a.ws + WS_Y);
    float hn[8];
#pragma unroll
    for (int i = 0; i < 8; ++i) hn[i] = a.in[I_HGNORM][((8 * lane) & 127) + i];
    for (int lr = gw; lr < NLAT; lr += NGW) {
        const size_t r = (size_t)grow_of(lr);
        const bf16x8 a8 = *(const bf16x8*)(OF + r * 512 + 8 * lane), c8 = *(const bf16x8*)(OB + r * 512 + 8 * lane);
        const bf16x8 g8 = *(const bf16x8*)(Z + r * ZC + ZHG + 8 * lane);
        float o[8]; float ss = 0.f;
#pragma unroll
        for (int i = 0; i < 8; ++i) o[i] = bf2f((unsigned short)a8[i]) + bf2f((unsigned short)c8[i]);
#pragma unroll
        for (int i = 0; i < 8; ++i) ss += o[i] * o[i];
        ss += __shfl_xor(ss, 1); ss += __shfl_xor(ss, 2); ss += __shfl_xor(ss, 4); ss += __shfl_xor(ss, 8);
        const float rs = rsqrtf(ss * (1.f / 128.f) + RMS_EPS);
        float y[8];
#pragma unroll
        for (int i = 0; i < 8; ++i) { const float g = bf2f((unsigned short)g8[i]); y[i] = o[i] * rs * hn[i] * (g * sigm(g)); }
        v4u w; w.x = pk2(y[0], y[1]); w.y = pk2(y[2], y[3]); w.z = pk2(y[4], y[5]); w.w = pk2(y[6], y[7]);
        *(v4u*)(MIX + r * 1024 + 512 + 8 * lane) = w;
    }
}

__device__ __forceinline__ int rows_per_block() { const int G = gridDim.x; return (((NLAT + G - 1) / G) + 15) & ~15; }
__device__ __forceinline__ void phase_ln1(const Args& a, int l, LAS unsigned char* lds, int tid, int lane, int wave) {
    typedef short bf16x8s __attribute__((ext_vector_type(8)));
    const int RB = rows_per_block(), lr_base = blockIdx.x * RB;
    const bf16* PRE = (const bf16*)(a.ws + WS_PRE); bf16* XB = (bf16*)(a.ws + WS_X);
    const float* modv = (const float*)(a.ws + WS_MODV) + (size_t)l * 9 * 6144;
    const float* lng = a.in[I_LN1G] + l * 1024; const float* lnb = a.in[I_LN1B] + l * 1024;
    const float* rw = a.in[I_RW] + (size_t)l * 1024 * 32; const float* rb = a.in[I_RB] + l * 32;
    constexpr int XT_LD = 1028, O_PART = 16 * XT_LD * 4, O_LG = O_PART + 8 * 32 * 16 * 4, O_HIST = O_LG + 16 * 33 * 4 + 64, O_CCNT = O_HIST + 256, O_TIL = O_CCNT + 2048, O_TWL = O_TIL + 4096;
    LAS float* XT = (LAS float*)lds; LAS float* PART = (LAS float*)(lds + O_PART); LAS float* LG = (LAS float*)(lds + O_LG);
    LAS int* hist = (LAS int*)(lds + O_HIST);
    LAS int* ccnt = (LAS int*)(lds + O_CCNT);
    LAS int* til = (LAS int*)(lds + O_TIL);
    LAS float* twl = (LAS float*)(lds + O_TWL);
    __syncthreads();
    if (tid < 32) hist[tid] = 0;
    bf16x8s whi[2][4], wlo[2][4];
    { const int e15 = lane & 15, kq = lane >> 4;
#pragma unroll
      for (int t = 0; t < 2; ++t)
#pragma unroll
          for (int sI = 0; sI < 4; ++sI) { float wv[8];
#pragma unroll
              for (int j = 0; j < 8; ++j) wv[j] = rw[(size_t)(128 * wave + 32 * sI + 8 * kq + j) * 32 + 16 * t + e15];
              v4u ph, pl;
#pragma unroll
              for (int j = 0; j < 4; ++j) { const unsigned p = pk2(wv[2 * j], wv[2 * j + 1]); const float h0 = __uint_as_float(p << 16), h1 = __uint_as_float(p & 0xffff0000u); ph[j] = p; pl[j] = pk2(wv[2 * j] - h0, wv[2 * j + 1] - h1); }
              whi[t][sI] = __builtin_bit_cast(bf16x8s, ph); wlo[t][sI] = __builtin_bit_cast(bf16x8s, pl); } }
    const int ngroups = RB / 16;
    f32x4 fP[4], fQ[4]; int fb = -1;
    const float rbias = rb[tid >> 4];
    v2u xr[2][4];
#define LN1_LOAD(g) do { _Pragma("unroll") for (int rr_ = 0; rr_ < 2; ++rr_) { const int lr_ = lr_base + 16 * (g) + 2 * wave + rr_; const size_t r_ = (size_t)grow_of(lr_ < NLAT ? lr_ : NLAT - 1); \
        _Pragma("unroll") for (int j_ = 0; j_ < 4; ++j_) xr[rr_][j_] = *(const v2u*)(PRE + r_ * 1024 + 4 * (lane + 64 * j_)); } } while (0)
#if defined(PROBE_LN1X2)
    for (int rep_ = 0; rep_ < 2; ++rep_) { __syncthreads(); if (tid < 32) hist[tid] = 0; __syncthreads();
#endif
    LN1_LOAD(0);
    for (int g = 0; g < ngroups; ++g) {
#pragma unroll
        for (int rr = 0; rr < 2; ++rr) {
            const int lr = lr_base + 16 * g + 2 * wave + rr; const bool ok = lr < NLAT; const size_t r = (size_t)grow_of(ok ? lr : NLAT - 1); const int b = (ok ? lr : NLAT - 1) >> 12;
            if (b != fb) { const float* mv = modv + (size_t)b * 6144; fb = b;
#pragma unroll
                for (int j = 0; j < 4; ++j) { const int c = 4 * (lane + 64 * j); const f32x4 gg = *(const f32x4*)(lng + c), bb = *(const f32x4*)(lnb + c), sh = *(const f32x4*)(mv + 3 * 1024 + c), sc = *(const f32x4*)(mv + 4 * 1024 + c);
                    fP[j] = gg * (sc + 1.0f); fQ[j] = bb * (sc + 1.0f) + sh; } }
            f32x4 x[4]; float s = 0.f;
#pragma unroll
            for (int j = 0; j < 4; ++j) { const v2u p = xr[rr][j]; x[j] = (f32x4){__uint_as_float(p.x << 16), __uint_as_float(p.x & 0xffff0000u), __uint_as_float(p.y << 16), __uint_as_float(p.y & 0xffff0000u)}; s += (x[j][0] + x[j][1]) + (x[j][2] + x[j][3]); }
            const float mean = wave_sum(s) * (1.f / 1024.f); float s2 = 0.f;
#pragma unroll
            for (int j = 0; j < 4; ++j) { x[j] = x[j] - mean; s2 += (x[j][0] * x[j][0] + x[j][1] * x[j][1]) + (x[j][2] * x[j][2] + x[j][3] * x[j][3]); }
            const float rstd = rsqrtf(wave_sum(s2) * (1.f / 1024.f) + LN_EPS);
#pragma unroll
            for (int j = 0; j < 4; ++j) { const int c = 4 * (lane + 64 * j);
                const f32x4 bm = (x[j] * rstd) * fP[j] + fQ[j];
                if (ok) *(unsigned*)((unsigned char*)XB + r * 1024 + c) = pack_fp8x4(bm[0] * SC_X8, bm[1] * SC_X8, bm[2] * SC_X8, bm[3] * SC_X8);
                *(LAS f32x4*)(XT + (2 * wave + rr) * XT_LD + c) = bm; }
        }
        if (g + 1 < ngroups) LN1_LOAD(g + 1);
        __syncthreads();
        { const int rr = lane & 15, kq = lane >> 4;
          f32x4 acc0 = {0.f, 0.f, 0.f, 0.f}, acc1 = {0.f, 0.f, 0.f, 0.f};
#pragma unroll
          for (int sI = 0; sI < 4; ++sI) { const LAS float* xp = XT + rr * XT_LD + 128 * wave + 32 * sI + 8 * kq; const f32x4 v0 = *(const LAS f32x4*)xp, v1 = *(const LAS f32x4*)(xp + 4);
              const float bv[8] = {v0[0], v0[1], v0[2], v0[3], v1[0], v1[1], v1[2], v1[3]}; v4u ph, pl;
#pragma unroll
              for (int j = 0; j < 4; ++j) { const unsigned p = pk2(bv[2 * j], bv[2 * j + 1]); const float h0 = __uint_as_float(p << 16), h1 = __uint_as_float(p & 0xffff0000u); ph[j] = p; pl[j] = pk2(bv[2 * j] - h0, bv[2 * j + 1] - h1); }
              const bf16x8s bh = __builtin_bit_cast(bf16x8s, ph), bl = __builtin_bit_cast(bf16x8s, pl);
              acc0 = __builtin_amdgcn_mfma_f32_16x16x32_bf16(whi[0][sI], bh, acc0, 0, 0, 0); acc0 = __builtin_amdgcn_mfma_f32_16x16x32_bf16(whi[0][sI], bl, acc0, 0, 0, 0); acc0 = __builtin_amdgcn_mfma_f32_16x16x32_bf16(wlo[0][sI], bh, acc0, 0, 0, 0);
              acc1 = __builtin_amdgcn_mfma_f32_16x16x32_bf16(whi[1][sI], bh, acc1, 0, 0, 0); acc1 = __builtin_amdgcn_mfma_f32_16x16x32_bf16(whi[1][sI], bl, acc1, 0, 0, 0); acc1 = __builtin_amdgcn_mfma_f32_16x16x32_bf16(wlo[1][sI], bh, acc1, 0, 0, 0); }
#pragma unroll
          for (int q = 0; q < 4; ++q) { PART[(wave * 32 + 4 * kq + q) * 16 + rr] = acc0[q]; PART[(wave * 32 + 16 + 4 * kq + q) * 16 + rr] = acc1[q]; } }
        __syncthreads();
        { const int e = tid >> 4, rr = tid & 15; float sacc = rbias;
#pragma unroll
          for (int w = 0; w < 8; ++w) sacc += PART[(w * 32 + e) * 16 + rr];
          LG[rr * 33 + e] = sacc; }
        __syncthreads();
        if (wave == (g & 7) && lane < 16) { const int lr = lr_base + 16 * g + lane;
            if (lr < NLAT) { float lg[32];
#pragma unroll
                for (int e = 0; e < 32; ++e) lg[e] = LG[lane * 33 + e];
                unsigned taken = 0u; float tv[4]; int ti[4];
#pragma unroll
                for (int kk = 0; kk < 4; ++kk) { float best = -3.0e38f; int bi = 0;
#pragma unroll
                    for (int e = 0; e < 32; ++e) { const bool okk = (lg[e] > best) && !((taken >> e) & 1u); best = okk ? lg[e] : best; bi = okk ? e : bi; }
                    taken |= 1u << bi; tv[kk] = best; ti[kk] = bi; }
                const float e1 = __expf(tv[1] - tv[0]), e2 = __expf(tv[2] - tv[0]), e3 = __expf(tv[3] - tv[0]); const float inv = 1.f / (1.f + e1 + e2 + e3);
                const int li = (16 * g + lane) * 4; til[li] = ti[0]; til[li + 1] = ti[1]; til[li + 2] = ti[2]; til[li + 3] = ti[3]; twl[li] = inv; twl[li + 1] = e1 * inv; twl[li + 2] = e2 * inv; twl[li + 3] = e3 * inv;
                __hip_atomic_fetch_add(hist + ti[0], 1, __ATOMIC_RELAXED, __HIP_MEMORY_SCOPE_WORKGROUP); __hip_atomic_fetch_add(hist + ti[1], 1, __ATOMIC_RELAXED, __HIP_MEMORY_SCOPE_WORKGROUP);
                __hip_atomic_fetch_add(hist + ti[2], 1, __ATOMIC_RELAXED, __HIP_MEMORY_SCOPE_WORKGROUP); __hip_atomic_fetch_add(hist + ti[3], 1, __ATOMIC_RELAXED, __HIP_MEMORY_SCOPE_WORKGROUP); } }
    }
#if defined(PROBE_LN1X2)
    }
#endif
#undef LN1_LOAD
    __syncthreads();
    int* cursor = (int*)(a.ws + WS_CURSOR) + l * 32;
    int* rows = (int*)(a.ws + WS_ROWS); float* roww = (float*)(a.ws + WS_ROWW); int* rowd = (int*)(a.ws + WS_ROWD);
    int nrows = NLAT - lr_base; nrows = nrows > RB ? RB : nrows; if (nrows < 0) nrows = 0;
    const int nas = nrows * 4, nchunks = (nas + 63) >> 6;
    int basev = 0; if (tid < 32) basev = (int)__hip_atomic_fetch_add((unsigned*)cursor + tid, (unsigned)hist[tid], __ATOMIC_RELAXED, __HIP_MEMORY_SCOPE_AGENT);
    int myrank[2] = {0, 0}, mye[2] = {-1, -1};
#pragma unroll
    for (int cc = 0; cc < 2; ++cc) { const int c = wave + 8 * cc; if (c < nchunks) { const int idx = c * 64 + lane; const int e = idx < nas ? til[idx] : -1; mye[cc] = e;
        for (int x = 0; x < 32; ++x) { const unsigned long long m = __ballot(e == x); if (e == x) myrank[cc] = __popcll(m & ((1ull << lane) - 1ull)); if (lane == 0) ccnt[c * 32 + x] = __popcll(m); } } }
    __syncthreads();
    if (tid < 32) hist[32 + tid] = basev;
    __syncthreads();
#pragma unroll
    for (int cc = 0; cc < 2; ++cc) { const int c = wave + 8 * cc; const int idx = c * 64 + lane; if (c < nchunks && idx < nas) { const int e = mye[cc]; int pos = hist[32 + e] + myrank[cc]; for (int c2 = 0; c2 < c; ++c2) pos += ccnt[c2 * 32 + e];
        const int lr = lr_base + (idx >> 2); const size_t pi = (size_t)e * ECAP + pos; rows[pi] = grow_of(lr); roww[pi] = twl[idx]; rowd[pi] = lr * 4 + (idx & 3); } }
}

__device__ __forceinline__ void phase_ln2(const Args& a, int l, int lane, int wave) {
    const int gw = blockIdx.x * NWAVES + wave, NGW = gridDim.x * NWAVES;
    float* H = (float*)(a.ws + WS_H); const bf16* PRE = (const bf16*)(a.ws + WS_PRE); const unsigned char* YB = (const unsigned char*)(a.ws + WS_YB); bf16* A1 = (bf16*)(a.ws + WS_Y);
    const float* modv = (const float*)(a.ws + WS_MODV);
    const float* ln1g = a.in[I_LN1G] + l * 1024; const float* ln1b = a.in[I_LN1B] + l * 1024;
    const float* lng = a.in[I_LN2G] + l * 1024; const float* lnb = a.in[I_LN2B] + l * 1024;
    f32x4 P1[4], Q1[4], G2[4], g2v[4], b2v[4], P3[4], Q3[4]; int fb = -1;
    const int rows_w = (((NLAT + NGW - 1) / NGW) + 1) & ~1, lr_lo = gw * rows_w, lr_hi = lr_lo + rows_w < NLAT ? lr_lo + rows_w : NLAT;
    for (int lr0 = lr_lo; lr0 < lr_hi; lr0 += 2) {
        v2u hv[2][4]; unsigned yv[2][4][4];
#pragma unroll
        for (int q = 0; q < 2; ++q) { const int lr = lr0 + q; const size_t r = (size_t)grow_of(lr);
#pragma unroll
            for (int j = 0; j < 4; ++j) { const int c = 4 * (lane + 64 * j); hv[q][j] = *(const v2u*)(PRE + r * 1024 + c);
#pragma unroll
                for (int k = 0; k < 4; ++k) yv[q][j][k] = *(const unsigned*)(YB + ((size_t)lr * 4 + k) * 1024 + c); } }
#pragma unroll
        for (int q = 0; q < 2; ++q) {
            const int lr = lr0 + q; const size_t r = (size_t)grow_of(lr); const int b = lr >> 12;
            if (b != fb) { fb = b; const float* mv = modv + ((size_t)l * 9 + b) * 6144; const float* mv1 = modv + ((size_t)9 + b) * 6144;
#pragma unroll
                for (int j = 0; j < 4; ++j) { const int c = 4 * (lane + 64 * j); const f32x4 g1 = *(const f32x4*)(ln1g + c), b1 = *(const f32x4*)(ln1b + c), gt = *(const f32x4*)(mv + 5 * 1024 + c);
                    P1[j] = g1 * ALPHA; Q1[j] = b1 * ALPHA; G2[j] = gt * (1.f / SC_Y); g2v[j] = *(const f32x4*)(lng + c); b2v[j] = *(const f32x4*)(lnb + c);
                    if (l == 0) { const f32x4 sh = *(const f32x4*)(mv1 + c), sc = *(const f32x4*)(mv1 + 1024 + c); P3[j] = g2v[j] * (sc + 1.0f) * SC_A1; Q3[j] = (b2v[j] * (sc + 1.0f) + sh) * SC_A1; } } }
            f32x4 x[4]; float s = 0.f;
#pragma unroll
            for (int j = 0; j < 4; ++j) { const v2u p = hv[q][j]; x[j] = (f32x4){__uint_as_float(p.x << 16), __uint_as_float(p.x & 0xffff0000u), __uint_as_float(p.y << 16), __uint_as_float(p.y & 0xffff0000u)}; s += (x[j][0] + x[j][1]) + (x[j][2] + x[j][3]); }
            float mean = wave_sum(s) * (1.f / 1024.f), s2 = 0.f;
#pragma unroll
            for (int j = 0; j < 4; ++j) { x[j] = x[j] - mean; s2 += (x[j][0] * x[j][0] + x[j][1] * x[j][1]) + (x[j][2] * x[j][2] + x[j][3] * x[j][3]); }
            float rstd = rsqrtf(wave_sum(s2) * (1.f / 1024.f) + LN_EPS);
            s = 0.f;
#pragma unroll
            for (int j = 0; j < 4; ++j) { f32x4 f = {0.f, 0.f, 0.f, 0.f};
#pragma unroll
                for (int k = 0; k < 4; ++k) { const unsigned y = yv[q][j][k]; const auto lo = __builtin_amdgcn_cvt_pk_f32_fp8((int)y, false), hi = __builtin_amdgcn_cvt_pk_f32_fp8((int)y, true);
                    f[0] += lo[0]; f[1] += lo[1]; f[2] += hi[0]; f[3] += hi[1]; }
                x[j] = (x[j] * rstd) * P1[j] + Q1[j] + G2[j] * f; s += (x[j][0] + x[j][1]) + (x[j][2] + x[j][3]); }
            mean = wave_sum(s) * (1.f / 1024.f); s2 = 0.f;
#pragma unroll
            for (int j = 0; j < 4; ++j) { x[j] = x[j] - mean; s2 += (x[j][0] * x[j][0] + x[j][1] * x[j][1]) + (x[j][2] * x[j][2] + x[j][3] * x[j][3]); }
            rstd = rsqrtf(wave_sum(s2) * (1.f / 1024.f) + LN_EPS);
#pragma unroll
            for (int j = 0; j < 4; ++j) { const int c = 4 * (lane + 64 * j); const f32x4 xh = x[j] * rstd;
                const f32x4 o = xh * g2v[j] + b2v[j];
                if (l == 0) { *(f32x4*)(H + r * 1024 + c) = o;
                    const f32x4 am = xh * P3[j] + Q3[j]; *(unsigned*)((unsigned char*)A1 + r * 1024 + c) = pack_fp8x4(am[0], am[1], am[2], am[3]); }
                else *(f32x4*)(a.out + (size_t)lr * 1024 + c) = o; }
        }
    }
}

__device__ __forceinline__ void phase_conv(const Args& a, LAS unsigned char* lds, int tid, int lane, int wave) {
    const bf16* U = (const bf16*)(a.ws + WS_X); bf16* V = (bf16*)(a.ws + WS_Y);
    LAS float* part = (LAS float*)(lds + 126976);
    LAS float* st = part + 512;
    const int c0 = 2 * tid;
    const float db0 = a.in[I_DWB][c0], db1 = a.in[I_DWB][c0 + 1], g0 = a.in[I_CLNG][c0], g1 = a.in[I_CLNG][c0 + 1], be0 = a.in[I_CLNB][c0], be1 = a.in[I_CLNB][c0 + 1];
    for (int tile = blockIdx.x; tile < NLAT / 32; tile += gridDim.x) {
        const int b = tile >> 7, t0 = (tile & 127) * 32;
        const size_t rb0 = (size_t)b * TPB + CTXL;
        __syncthreads();
        for (int i = tid; i < 62 * 128; i += NTHR) { const int row = i >> 7, chk = i & 127, t = t0 - 15 + row;
            v4u val = {0u, 0u, 0u, 0u}; if (t >= 0 && t < SEQ) val = *(const v4u*)(U + (rb0 + t) * 1024 + chk * 8);
            *(LAS v4u*)(lds + row * 2048 + chk * 16) = val; }
        __syncthreads();
        float w0[31], w1[31];
#pragma unroll
        for (int j = 0; j < 31; ++j) { const float2 wv = *(const float2*)(a.in[I_DWW] + j * 1024 + c0); w0[j] = wv.x; w1[j] = wv.y; }
#pragma unroll 1
        for (int hh = 0; hh < 2; ++hh) {
            const LAS unsigned char* hp = lds + hh * 16 * 2048;
            float acc0[16], acc1[16];
#pragma unroll
            for (int t = 0; t < 16; ++t) { acc0[t] = db0; acc1[t] = db1; }
#pragma unroll
            for (int s = 0; s < 46; ++s) { const unsigned pr = *(const LAS unsigned*)(hp + s * 2048 + tid * 4); const float x0 = __uint_as_float(pr << 16), x1 = __uint_as_float(pr & 0xffff0000u);
#pragma unroll
                for (int t = (s > 30 ? s - 30 : 0); t <= (s < 15 ? s : 15); ++t) { acc0[t] = fmaf(x0, w0[s - t], acc0[t]); acc1[t] = fmaf(x1, w1[s - t], acc1[t]); } }
            float rs[32];
#pragma unroll
            for (int t = 0; t < 16; ++t) { rs[2 * t] = acc0[t] + acc1[t]; rs[2 * t + 1] = acc0[t] * acc0[t] + acc1[t] * acc1[t]; }
#define RS_STEP(NKEEP, XORV) { const bool bit_ = (lane & XORV) != 0; _Pragma("unroll") for (int k_ = 0; k_ < NKEEP; ++k_) { const float snd_ = bit_ ? rs[k_] : rs[k_ + NKEEP]; const float rcv_ = __shfl_xor(snd_, XORV); rs[k_] = (bit_ ? rs[k_ + NKEEP] : rs[k_]) + rcv_; } }
            RS_STEP(16, 32) RS_STEP(8, 16) RS_STEP(4, 8) RS_STEP(2, 4) RS_STEP(1, 2)
#undef RS_STEP
            rs[0] += __shfl_xor(rs[0], 1);
            __syncthreads();
            if ((lane & 1) == 0) part[wave * 32 + (lane >> 1)] = rs[0];
            __syncthreads();
            if (tid < 16) { float s1 = 0.f, s2 = 0.f;
#pragma unroll
                for (int w = 0; w < 8; ++w) { s1 += part[w * 32 + 2 * tid]; s2 += part[w * 32 + 2 * tid + 1]; }
                const float mean = s1 * (1.f / 1024.f); const float var = fmaxf(s2 * (1.f / 1024.f) - mean * mean, 0.f); st[2 * tid] = mean; st[2 * tid + 1] = rsqrtf(var + LN_EPS); }
            __syncthreads();
#pragma unroll
            for (int t = 0; t < 16; ++t) { const float mean = st[2 * t], rstd = st[2 * t + 1];
                const float y0 = (acc0[t] - mean) * rstd * g0 + be0, y1 = (acc1[t] - mean) * rstd * g1 + be1;
                const float z0 = fminf(fmaxf(y0 * sigm(y0) * SC_CV, -448.f), 448.f), z1 = fminf(fmaxf(y1 * sigm(y1) * SC_CV, -448.f), 448.f);
                *(unsigned short*)((unsigned char*)V + (rb0 + t0 + hh * 16 + t) * 1024 + c0) = (unsigned short)__builtin_amdgcn_cvt_pk_fp8_f32(z0, z1, 0, false); }
        }
    }
}

namespace hg {
using bf16x8 = __attribute__((ext_vector_type(8))) short;
using s16x4  = __attribute__((ext_vector_type(4))) short;
using f32x16 = __attribute__((ext_vector_type(16))) float;
using u32x4  = __attribute__((ext_vector_type(4))) unsigned;
constexpr int RS = 272;
constexpr int VS = 80;
constexpr int T_Q = 0, T_KO = 32 * RS, T_KE = 64 * RS, T_D = 96 * RS, IMG_BYTES = T_D + 512, T_V = IMG_BYTES, TILE_BYTES = T_V + 32 * VS;
constexpr int OFF_TILES = 1024, NTB = 3, OFF_OPART = OFF_TILES + NTB * TILE_BYTES, OPART_BYTES = 4 * 4096;
static_assert(OFF_OPART + 2 * OPART_BYTES <= 131072 && IMG_BYTES % 16 == 0 && IMG_BYTES / 16 == 1664, "hgrn lds");
constexpr int P_RAW = 1024, R_Q = 0, R_F = 32 * RS, RAW_BYTES = 64 * RS, P_IMG = P_RAW + RAW_BYTES;
constexpr int NCHUNK = TPB / 32, NCHAIN = NB * 4 * 2, NITEM = NCHAIN * NCHUNK;
__device__ __forceinline__ int crow(int r, int hi) { return (r & 3) + 8 * (r >> 2) + 4 * hi; }
__device__ __forceinline__ s16x4 tr_read(unsigned addr) { s16x4 r; asm volatile("ds_read_b64_tr_b16 %0, %1" : "=&v"(r) : "v"(addr) : "memory"); return r; }
__device__ __forceinline__ bf16x8 cat8(s16x4 l, s16x4 h) { return (bf16x8){l[0], l[1], l[2], l[3], h[0], h[1], h[2], h[3]}; }
__device__ __forceinline__ bf16x8 pack8(const f32x16& x, int base) {
    u32x4 w; w[0] = pk2(x[base + 0], x[base + 1]); w[1] = pk2(x[base + 2], x[base + 3]); w[2] = pk2(x[base + 4], x[base + 5]); w[3] = pk2(x[base + 6], x[base + 7]);
    return *reinterpret_cast<bf16x8*>(&w);
}
}


#define HG_TOKP(dir, n) ((dir) ? ((n) < CTXL ? (CTXL - 1 - (n)) : (TPB + CTXL - 1 - (n))) : (n))
#define HG_DPP1(x, ctrl, rmask) __int_as_float(__builtin_amdgcn_update_dpp(0x3f800000, __float_as_int(x), ctrl, rmask, 0xf, false))
#define HG_DPP(x, ctrl, rmask) __int_as_float(__builtin_amdgcn_update_dpp(0, __float_as_int(x), ctrl, rmask, 0xf, false))
__device__ __forceinline__ void hgrn_prep_items(const Args& a, LAS unsigned char* lds, int tid) {
    using namespace hg;
    const bf16* Z = (const bf16*)(a.ws + WS_Z);
    unsigned char* HT = a.ws + WS_HT;
    const int wave = __builtin_amdgcn_readfirstlane(tid >> 6), lane = tid & 63, t = lane & 31, half = lane >> 5;
    const int c0 = 16 * wave + 8 * half;
    const int lr = tid >> 4, lch = tid & 15;
    LAS float* lbt = (LAS float*)lds;
    constexpr int P_RAW2 = 2048, P_IMG2 = P_RAW2 + 2 * RAW_BYTES;
    static_assert(P_IMG2 + 2 * IMG_BYTES <= 131072, "prep lds");
    __syncthreads();
    { const float l0 = a.in[I_LBL][tid], l1 = a.in[I_LBL][512 + tid], l2 = a.in[I_LBL][1024 + tid]; const float m = fmaxf(l0, fmaxf(l1, l2));
      const float e0 = __expf(l0 - m), e1 = __expf(l1 - m), e2 = __expf(l2 - m); lbt[tid] = e0 / (e0 + e1 + e2); }
    bf16x8 gq, gf;
#define HP_LOAD(it) do { const int ch_ = (it) % NCHUNK, cn_ = (it) / NCHUNK, dir_ = cn_ & 1, hd_ = (cn_ >> 1) & 3, b_ = cn_ >> 3; \
        const bf16* zr_ = Z + ((size_t)b_ * TPB + HG_TOKP(dir_, 32 * ch_ + lr)) * ZC; gq = *(const bf16x8*)(zr_ + ZHQ + hd_ * 128 + lch * 8); gf = *(const bf16x8*)(zr_ + (dir_ ? ZHB : ZHF) + hd_ * 128 + lch * 8); } while (0)
#define HP_STASH(bufi) do { LAS unsigned char* rb_ = lds + P_RAW2 + (bufi) * RAW_BYTES; *(LAS bf16x8*)(rb_ + R_Q + lr * RS + lch * 16) = gq; *(LAS bf16x8*)(rb_ + R_F + lr * RS + lch * 16) = gf; } while (0)
#define HP_COPYOUT(item, bufi) do { v4u* dst_ = (v4u*)(HT + (size_t)(item) * IMG_BYTES); const LAS v4u* src_ = (const LAS v4u*)(lds + P_IMG2 + (bufi) * IMG_BYTES); \
        dst_[tid] = src_[tid]; dst_[tid + 512] = src_[tid + 512]; dst_[tid + 1024] = src_[tid + 1024]; if (tid < 128) dst_[tid + 1536] = src_[tid + 1536]; } while (0)
    const int G = gridDim.x;
    int it = blockIdx.x, par = 0;
    if (it < NITEM) { HP_LOAD(it); HP_STASH(0); }
    if (it + G < NITEM) HP_LOAD(it + G);
    __syncthreads();
    for (; it < NITEM; it += G, par ^= 1) {
        if (it + G < NITEM) HP_STASH(par ^ 1);
        if (it != (int)blockIdx.x) HP_COPYOUT(it - G, par ^ 1);
        if (it + 2 * G < NITEM) HP_LOAD(it + 2 * G);
        const int hd = ((it / NCHUNK) >> 1) & 3;
        {
            const LAS unsigned char* rb_ = lds + P_RAW2 + par * RAW_BYTES;
            const bf16x8 RQ = *(const LAS bf16x8*)(rb_ + R_Q + t * RS + c0 * 2), RF = *(const LAS bf16x8*)(rb_ + R_F + t * RS + c0 * 2);
            const f32x4 lbA = *(const LAS f32x4*)(lbt + hd * 128 + c0), lbB = *(const LAS f32x4*)(lbt + hd * 128 + c0 + 4);
            LAS unsigned char* tb_ = lds + P_IMG2 + par * IMG_BYTES;
            float bb_[8], kk_[8];
#pragma unroll
            for (int i_ = 0; i_ < 8; ++i_) { const float lb_ = i_ < 4 ? lbA[i_] : lbB[i_ - 4]; const float f_ = lb_ + (1.f - lb_) * __builtin_amdgcn_rcpf(1.f + __expf(-bf2f((unsigned short)RF[i_]))); kk_[i_] = 1.f - f_; bb_[i_] = f_; }
#pragma unroll
            for (int i_ = 0; i_ < 8; ++i_) { float x_ = bb_[i_]; x_ *= HG_DPP1(x_, 0x111, 0xf); x_ *= HG_DPP1(x_, 0x112, 0xf); x_ *= HG_DPP1(x_, 0x114, 0xf); x_ *= HG_DPP1(x_, 0x118, 0xf);
                x_ *= HG_DPP1(x_, 0x142, 0xa); bb_[i_] = x_; }
            float qi_[8], ko_[8], ke_[8], dd_[8];
#pragma unroll
            for (int i_ = 0; i_ < 8; ++i_) { const int bi_ = __float_as_int(bb_[i_]); dd_[i_] = __int_as_float(half ? __builtin_amdgcn_readlane(bi_, 63) : __builtin_amdgcn_readlane(bi_, 31));
                const float e_ = bb_[i_]; const float ei_ = __builtin_amdgcn_rcpf(e_);
                qi_[i_] = bf2f((unsigned short)RQ[i_]) * e_; ko_[i_] = kk_[i_] * ei_; ke_[i_] = kk_[i_] * (dd_[i_] * ei_); }
            *(LAS v4u*)(tb_ + T_Q + t * RS + c0 * 2) = (v4u){pk2(qi_[0], qi_[1]), pk2(qi_[2], qi_[3]), pk2(qi_[4], qi_[5]), pk2(qi_[6], qi_[7])};
            *(LAS v4u*)(tb_ + T_KO + t * RS + c0 * 2) = (v4u){pk2(ko_[0], ko_[1]), pk2(ko_[2], ko_[3]), pk2(ko_[4], ko_[5]), pk2(ko_[6], ko_[7])};
            *(LAS v4u*)(tb_ + T_KE + t * RS + c0 * 2) = (v4u){pk2(ke_[0], ke_[1]), pk2(ke_[2], ke_[3]), pk2(ke_[4], ke_[5]), pk2(ke_[6], ke_[7])};
            if (t == 31) { *(LAS f32x4*)(tb_ + T_D + c0 * 4) = (f32x4){dd_[0], dd_[1], dd_[2], dd_[3]}; *(LAS f32x4*)(tb_ + T_D + c0 * 4 + 16) = (f32x4){dd_[4], dd_[5], dd_[6], dd_[7]}; }
            if (tid < 32) *(LAS v4u*)(tb_ + T_Q + tid * RS + 256) = (v4u){0u, 0u, 0u, 0u};
            else if (tid < 64) *(LAS v4u*)(tb_ + T_KO + (tid - 32) * RS + 256) = (v4u){0u, 0u, 0u, 0u};
            else if (tid < 96) *(LAS v4u*)(tb_ + T_KE + (tid - 64) * RS + 256) = (v4u){0u, 0u, 0u, 0u};
        }
        __syncthreads();
    }
    if (it - G >= (int)blockIdx.x && it - G < NITEM) HP_COPYOUT(it - G, par ^ 1);
    __syncthreads();
#undef HP_COPYOUT
#undef HP_LOAD
#undef HP_STASH
}

__device__ __forceinline__ void hgrn_unit_mfma(const Args& a, int unit, LAS unsigned char* lds, int tid) {
    using namespace hg;
    const int b = unit >> 5, head = (unit >> 3) & 3, dir = (unit >> 2) & 1, sl = unit & 3;
    const bf16* Z = (const bf16*)(a.ws + WS_Z);
    const unsigned char* HT = a.ws + WS_HT + (size_t)((b * 4 + head) * 2 + dir) * NCHUNK * IMG_BYTES;
    bf16* Od = (bf16*)(a.ws + (dir ? WS_OB : WS_OF));
    const int wave = __builtin_amdgcn_readfirstlane(tid >> 6), lane = tid & 63;
    const size_t zb = (size_t)b * TPB;
    constexpr int NCH = NCHUNK;
    const int vr = (tid >> 2) & 31, vp = tid & 3, lvcol = ZHI + head * 128 + sl * 32 + vp * 8, i3 = 1536 + (tid & 127);
    v4u gA0, gA1, gA2, gA3, gB0, gB1, gB2, gB3; bf16x8 gAv, gBv;
#define HG_LOAD(g0, g1, g2, g3, gv, ch) do { const int c_ = (ch) < NCH ? (ch) : NCH - 1; const v4u* src_ = (const v4u*)(HT + (size_t)c_ * IMG_BYTES); \
        g0 = src_[tid]; g1 = src_[tid + 512]; g2 = src_[tid + 1024]; g3 = src_[i3]; gv = *(const bf16x8*)(Z + (zb + HG_TOKP(dir, 32 * c_ + vr)) * ZC + lvcol); } while (0)
#define HG_STASH(g0, g1, g2, g3, gv, bufi) do { LAS unsigned char* tb_ = lds + OFF_TILES + (bufi) * TILE_BYTES; LAS v4u* d_ = (LAS v4u*)tb_; \
        d_[tid] = g0; d_[tid + 512] = g1; d_[tid + 1024] = g2; if (tid < 128) { d_[tid + 1536] = g3; *(LAS bf16x8*)(tb_ + T_V + vr * VS + vp * 16) = gv; } } while (0)
    const int r32 = lane & 31, hi = lane >> 5, g1 = (lane >> 4) & 1, q4 = (lane & 15) >> 2, p4 = lane & 3, cb = 32 * wave;
    const unsigned lbase = (unsigned)(uintptr_t)lds;
    f32x16 S = {};
    HG_LOAD(gA0, gA1, gA2, gA3, gAv, 0); HG_STASH(gA0, gA1, gA2, gA3, gAv, 0); HG_LOAD(gA0, gA1, gA2, gA3, gAv, 1); HG_STASH(gA0, gA1, gA2, gA3, gAv, 1);
    HG_LOAD(gA0, gA1, gA2, gA3, gAv, 2);
    __syncthreads();
#define HG_RD64(dst, addr, OFFS) asm volatile("ds_read_b64 %0, %1 offset:" #OFFS : "=&v"(dst) : "v"(addr) : "memory")
#define HG_MFMA_STAGE(n, bufi) do { \
            const unsigned tb = lbase + OFF_TILES + (bufi) * TILE_BYTES; const LAS unsigned char* tl_ = lds + OFF_TILES + (bufi) * TILE_BYTES; \
            bf16x8 ko[2], qi[2]; s16x4 pvl[2], pvh[2], pql[2], pqh[2], kl[2], kh[2], nvl[2], nvh[2]; f32x4 dsc[4]; \
            _Pragma("unroll") for (int kk = 0; kk < 2; ++kk) { ko[kk] = *(const LAS bf16x8*)(tl_ + T_KO + r32 * RS + (cb + 16 * kk + 8 * hi) * 2); qi[kk] = *(const LAS bf16x8*)(tl_ + T_Q + r32 * RS + (cb + 16 * kk + 8 * hi) * 2); } \
            _Pragma("unroll") for (int sp = 0; sp < 2; ++sp) { \
                const unsigned va = tb + T_V + (16 * sp + 4 * hi + q4) * VS + (16 * g1 + 4 * p4) * 2; pvl[sp] = tr_read(va); pvh[sp] = tr_read(va + 8 * VS);              \
                const unsigned qa = tb + T_Q + r32 * RS + (cb + 16 * sp + 4 * hi) * 2; HG_RD64(pql[sp], qa, 0); HG_RD64(pqh[sp], qa, 16);                                  \
                const unsigned ka = tb + T_KE + (16 * sp + 8 * hi + q4) * RS + (cb + 16 * g1 + 4 * p4) * 2; kl[sp] = tr_read(ka); kh[sp] = tr_read(ka + 4 * RS);        \
                const unsigned vb = tb + T_V + (16 * sp + 8 * hi + q4) * VS + (16 * g1 + 4 * p4) * 2; nvl[sp] = tr_read(vb); nvh[sp] = tr_read(vb + 4 * VS); }            \
            _Pragma("unroll") for (int g = 0; g < 4; ++g) dsc[g] = *(const LAS f32x4*)(tl_ + T_D + (cb + 8 * g + 4 * hi) * 4); \
            asm volatile("s_waitcnt lgkmcnt(0)" ::: "memory"); __builtin_amdgcn_sched_barrier(0); \
            f32x16 X = {}; \
            X = __builtin_amdgcn_mfma_f32_32x32x16_bf16(ko[0], qi[0], X, 0, 0, 0); X = __builtin_amdgcn_mfma_f32_32x32x16_bf16(ko[1], qi[1], X, 0, 0, 0); \
            f32x16 O = {}; \
            O = __builtin_amdgcn_mfma_f32_32x32x16_bf16(cat8(pql[0], pqh[0]), pack8(S, 0), O, 0, 0, 0); O = __builtin_amdgcn_mfma_f32_32x32x16_bf16(cat8(pql[1], pqh[1]), pack8(S, 8), O, 0, 0, 0); \
            _Pragma("unroll") for (int i = 0; i < 16; ++i) S[i] *= dsc[i >> 2][i & 3]; \
            S = __builtin_amdgcn_mfma_f32_32x32x16_bf16(cat8(kl[0], kh[0]), cat8(nvl[0], nvh[0]), S, 0, 0, 0); S = __builtin_amdgcn_mfma_f32_32x32x16_bf16(cat8(kl[1], kh[1]), cat8(nvl[1], nvh[1]), S, 0, 0, 0); \
            _Pragma("unroll") for (int i = 0; i < 16; ++i) X[i] = (crow(i, hi) <= r32) ? X[i] : 0.f; \
            O = __builtin_amdgcn_mfma_f32_32x32x16_bf16(pack8(X, 0), cat8(pvl[0], pvh[0]), O, 0, 0, 0); O = __builtin_amdgcn_mfma_f32_32x32x16_bf16(pack8(X, 8), cat8(pvl[1], pvh[1]), O, 0, 0, 0); \
            LAS float* op = (LAS float*)(lds + OFF_OPART + ((n) & 1) * OPART_BYTES + wave * 4096); \
            _Pragma("unroll") for (int i = 0; i < 16; ++i) op[crow(i, hi) * 32 + r32] = O[i]; } while (0)
#define HG_OUT_STAGE(n) do { \
            const int l2 = tid - 256, tt = l2 >> 3, vq = l2 & 7; \
            const LAS float* op = (const LAS float*)(lds + OFF_OPART + (((n) - 1) & 1) * OPART_BYTES) + tt * 32 + vq * 4; \
            const f32x4 s = (*(const LAS f32x4*)op + *(const LAS f32x4*)(op + 1024)) + (*(const LAS f32x4*)(op + 2048) + *(const LAS f32x4*)(op + 3072)); \
            const int p = HG_TOKP(dir, 32 * ((n) - 1) + tt); \
            if (p >= CTXL) *(v2u*)(Od + (zb + p) * 512 + head * 128 + sl * 32 + vq * 4) = (v2u){pk2(s[0], s[1]), pk2(s[2], s[3])}; } while (0)
#define HG_ITER(n, L0, L1, L2, L3, LV, S0, S1, S2, S3, SV) do { \
        HG_LOAD(L0, L1, L2, L3, LV, (n) + 3); \
        if (wave < 4) { HG_MFMA_STAGE(n, bcur); } else if ((n) > 0) { HG_OUT_STAGE(n); } \
        { const int bst_ = bcur == 0 ? 2 : bcur - 1; HG_STASH(S0, S1, S2, S3, SV, bst_); } \
        bcur = bcur == 2 ? 0 : bcur + 1; \
        __syncthreads(); } while (0)
    int bcur = 0;
    for (int n = 0; n < NCH; n += 2) {
        HG_ITER(n, gB0, gB1, gB2, gB3, gBv, gA0, gA1, gA2, gA3, gAv);
        HG_ITER(n + 1, gA0, gA1, gA2, gA3, gAv, gB0, gB1, gB2, gB3, gBv);
    }
    if (wave >= 4) { HG_OUT_STAGE(NCH); }
    __syncthreads();
#undef HG_MFMA_STAGE
#undef HG_OUT_STAGE
#undef HG_ITER
#undef HG_LOAD
#undef HG_STASH
#undef HG_RD64
}

__device__ __forceinline__ bool in_range(int lo, int hi, int k) { asm volatile("" : "+s"(lo), "+s"(hi)); return lo <= k && k < hi; }
constexpr int NPHASES = 21;
__global__ void __launch_bounds__(NTHR, 2) fwd_kernel(Args args) {
    extern __shared__ __attribute__((aligned(16))) unsigned char lds_raw[];
    LAS unsigned char* lds = (LAS unsigned char*)lds_raw;
    const int G = gridDim.x;
#define FRESH() int tid = threadIdx.x; asm volatile("" : "+v"(tid)); const int lane = tid & 63, wave = __builtin_amdgcn_readfirstlane(tid >> 6); (void)lane; (void)wave
    unsigned char* ws = args.ws;
    if (threadIdx.x < 16) ((LAS unsigned*)(lds + LDS_BAR_OFF))[threadIdx.x] = 0u;
    __syncthreads();
    XcdBarrier bar = xcd_barrier_post((unsigned*)(ws + WS_CTL), (volatile LAS unsigned*)(lds + LDS_BAR_OFF));
    const int lo = args.ph_lo, hi = args.ph_hi;
#define IN(k) in_range(lo, hi, (k))
#define NREP(k) (((PROBE_MASK >> (k)) & 1u) ? 2 : 1)
#define REPEAT(k) for (int rep_ = 0; rep_ < NREP(k); ++rep_) if (rep_ == 0 || (xcd_barrier(bar), true))
#define SEAM(k) do { if (IN(k) && IN((k) + 1)) xcd_barrier(bar); } while (0)
    bf16* const BX = (bf16*)(ws + WS_X); bf16* const BY = (bf16*)(ws + WS_Y);
    const float* const MODV = (const float*)(ws + WS_MODV);

#if defined(PROBE_BARS)
    for (int pbi = 0; pbi < PROBE_BARS; ++pbi) xcd_barrier(bar);
#endif
    if (IN(0)) REPEAT(0) { FRESH(); phase_prologue(args, lds, tid, lane, wave); } SEAM(0);
    if (IN(1)) REPEAT(1) { FRESH(); phase_mod0(args, lane, wave); } SEAM(1);
    if (IN(2)) REPEAT(2) {
        pg8::Gemm g{BX, (const bf16*)(ws + WS_WIN), NTOK, ZC, 512}; pg8::AllOrder S; S.init(NTOK / 256, ZC / 256, G, (int)blockIdx.x);
        pg8::EpiBf16<0> E{(bf16*)(ws + WS_Z), ZC, nullptr, ZC, 0, 1.f / (SC_A0 * SC_WIN)};
        pg8::gemm_phase<pg8::EpiBf16<0>, pg8::AllOrder, PG8_ALIGN, true, false, true>(lds, g, S, E);
    } SEAM(2);
    if (IN(3)) REPEAT(3) { FRESH(); phase_norm0(args, lane, wave); hgrn_prep_items(args, lds, tid); } SEAM(3);
    if (IN(4)) REPEAT(4) {
        { pg8::Gemm g{(const bf16*)(ws + WS_CQN), (const bf16*)(ws + WS_WUQ), NTOK, 768, 384}; pg8::LatOrder S; S.init(128, 3, G, (int)blockIdx.x);
          pg8::EpiBf16<0> E{(bf16*)(ws + WS_Q), 768, nullptr, 0, 0, 1.f};
          pg8::gemm_phase<pg8::EpiBf16<0>, pg8::LatOrder, PG8_ALIGN, PG8_SP2>(lds, g, S, E); }
        __syncthreads();
        { pg8::Gemm g{(const bf16*)(ws + WS_CKVN), (const bf16*)(ws + WS_WUKV), NTOK, 1024, 256}; pg8::AllOrder S; S.init(NTOK / 256, 4, G, G - 1 - (int)blockIdx.x);
          pg8::EpiBf16<0> E{(bf16*)(ws + WS_KV), 1024, nullptr, 0, 0, 1.f};
          pg8::gemm_phase<pg8::EpiBf16<0>, pg8::AllOrder, PG8_ALIGN, PG8_SP2>(lds, g, S, E); }
    } SEAM(4);
    if (IN(5)) {
        REPEAT(21) { FRESH();
        for (int u = blockIdx.x; u < 256; u += G) { __syncthreads(); hgrn_unit_mfma(args, (G == 256) ? ((u & 7) * 32 + (u >> 3)) : u, lds, tid); } }
        const bf16* Q = (const bf16*)(ws + WS_Q); const bf16* KV = (const bf16*)(ws + WS_KV); const bf16* KRR = (const bf16*)(ws + WS_KRR);
        const float* rope = (const float*)(ws + WS_ROPE);
        const int cslot = (G == 256) ? ((((int)blockIdx.x & 7) * 2 + (((int)blockIdx.x >> 3) >> 4)) % 5) : 0;
        REPEAT(22) {
        int ai = 0;
        for (int slot = 0; slot < 5; ++slot) {
            if (slot == cslot) { if (rep_ == 0) { FRESH(); __syncthreads(); convert_moe_share(args, lds, lane, wave); } continue; }
            for (int u = (G == 256) ? (int)blockIdx.x + ai * 256 : (int)blockIdx.x; u < ((G == 256) ? (int)blockIdx.x + ai * 256 + 1 : (ai == 0 ? 1024 : 0)); u += G) {
                int b, h, qb; if (G == 256) { const int x = (int)blockIdx.x & 7, j = (int)blockIdx.x >> 3, pr = (u >> 8) * 16 + 2 * x + (j >> 4); b = pr >> 3; h = pr & 7; qb = j & 15; } else { b = u >> 7; h = (u >> 4) & 7; qb = u & 15; }
                const size_t kb = (size_t)b * TPB, q0 = kb + CTXL + (size_t)qb * 256;
                __syncthreads();
                att::attn_unit(Q + q0 * 768 + h * 96, KV + kb * 1024 + h * 64, KRR + kb * 32, BY + q0 * 1024 + h * 64, rope + (size_t)qb * 256 * 32, TPB, (char*)lds_raw);
            }
            ++ai;
        }
        }
    } SEAM(5);
    if (IN(6)) REPEAT(6) { FRESH(); phase_readout(args, lane, wave); } SEAM(6);
    if (IN(7)) REPEAT(7) {
        pg8::Gemm g{BY, (const bf16*)(ws + WS_WOUT), NTOK, 1024, 1024}; pg8::LatOrder S; S.init(128, 4, G, (int)blockIdx.x);
        pg8::EpiRes E{args.in[I_X], (const float*)(ws + WS_H), (bf16*)(ws + WS_PRE), MODV, nullptr, 1.f};
        pg8::gemm_phase<pg8::EpiRes, pg8::LatOrder, PG8_ALIGN, PG8_SP2>(lds, g, S, E);
    } SEAM(7);
    for (int l = 0; l < 2; ++l) {
        if (l == 1) {
            if (IN(13)) REPEAT(13) {
                pg8::Gemm g{BY, (const bf16*)(ws + WS_WPW1), NTOK, 2048, 512}; pg8::LatOrder S; S.init(128, 8, G, (int)blockIdx.x);
                pg8::EpiGate<0> E{BX, (const float*)(ws + WS_PW1B), 8, 1.f / (SC_A1 * SC_WPW), 1.f};
                pg8::gemm_phase<pg8::EpiGate<0>, pg8::LatOrder, PG8_ALIGN, true, false, true>(lds, g, S, E);
            } SEAM(13);
            if (IN(14)) REPEAT(14) { FRESH(); phase_conv(args, lds, tid, lane, wave); } SEAM(14);
            if (IN(15)) REPEAT(15) {
                pg8::Gemm g{BY, (const bf16*)(ws + WS_WPW2), NTOK, 1024, 512}; pg8::LatOrder S; S.init(128, 4, G, (int)blockIdx.x);
                pg8::EpiRes E{nullptr, (const float*)(ws + WS_H), (bf16*)(ws + WS_PRE), MODV + 9 * 6144, args.in[I_PW2B], 1.f / (SC_CV * SC_WPW)};
                pg8::gemm_phase<pg8::EpiRes, pg8::LatOrder, PG8_ALIGN, true, false, true>(lds, g, S, E);
            } SEAM(15);
        }
        const int pb = l ? 16 : 8;
        if (IN(pb)) REPEAT(pb) { FRESH(); phase_ln1(args, l, lds, tid, lane, wave); } SEAM(pb);
        if (IN(pb + 2) || IN(pb + 3)) {
            LAS int* tl = (LAS int*)(lds + LDS_TILE_E);
            FRESH();
            __syncthreads();
            if (tid < 32) tl[3 * MAXTILES + 64 + tid] = ld_ctl((const int*)(ws + WS_CURSOR) + l * 32 + tid);
            __syncthreads();
            if (tid == 0) { int ts = 0; for (int e = 0; e < 32; ++e) { tl[3 * MAXTILES + e] = ts; ts += (tl[3 * MAXTILES + 64 + e] + 255) >> 8; } tl[3 * MAXTILES + 32] = ts; }
            __syncthreads();
            const int ntiles = tl[3 * MAXTILES + 32];
            for (int t = tid; t < ntiles && t < MAXTILES; t += NTHR) { int e = 0; while (e < 31 && tl[3 * MAXTILES + e + 1] <= t) ++e; const int j = t - tl[3 * MAXTILES + e], rem = tl[3 * MAXTILES + 64 + e] - 256 * j;
                tl[t] = e; tl[MAXTILES + t] = e * ECAP + 256 * j; tl[2 * MAXTILES + t] = rem < 256 ? rem : 256; }
            __syncthreads();
            if (IN(pb + 2)) REPEAT(pb + 2) {
#if defined(PROBE_STAGGER)
                if (blockIdx.x & 1) { const unsigned long long t0 = __builtin_amdgcn_s_memrealtime(); while (__builtin_amdgcn_s_memrealtime() - t0 < PROBE_STAGGER) __builtin_amdgcn_s_sleep(8); }
#endif
                pg8::Gemm g{BX, (const bf16*)(ws + WS_WGU + (size_t)l * 32 * 2048 * 1024), 0, 0, 512};
                pg8::MoeOrder S; S.init(ntiles, 8, G, (int)blockIdx.x); S.tile_e = tl; S.nper = 8;
                pg8::EpiGate<1, true> E{(bf16*)(ws + WS_ACT), (const float*)(ws + WS_BGU) + (size_t)l * 32 * 2048, 8, 1.f / (SC_X8 * SC_WGU) * PROBE_KSC, SC_ACT};
                pg8::gemm_phase<pg8::EpiGate<1, true>, pg8::MoeOrder, PG8_ALIGN, true, true, true>(lds, g, S, E, (const int*)(ws + WS_ROWS), tl + MAXTILES);
            } SEAM(pb + 2);
            if (IN(pb + 3)) REPEAT(pb + 3) {
                pg8::Gemm g{(const bf16*)(ws + WS_ACT), (const bf16*)(ws + WS_WDN + (size_t)l * 32 * 1024 * 1024), 0, 0, 512};
                pg8::MoeOrder S; S.init(ntiles, 4, G, (int)blockIdx.x); S.tile_e = tl; S.nper = 4;
                pg8::EpiDown E{(bf16*)(ws + WS_YB), args.in[I_BDN] + (size_t)l * 32 * 1024, (const float*)(ws + WS_ROWW), (const int*)(ws + WS_ROWD), 1.f / (SC_ACT * SC_WDN) * PROBE_KSC, tl + MAXTILES, SC_Y};
                pg8::gemm_phase<pg8::EpiDown, pg8::MoeOrder, PG8_ALIGN, true, false, true>(lds, g, S, E);
            } SEAM(pb + 3);
        }
        if (IN(pb + 4)) REPEAT(pb + 4) { FRESH(); phase_ln2(args, l, lane, wave); }
        if (l == 0) SEAM(12);
    }
#undef IN
#undef SEAM
}

extern "C" void kernel_launch(void* const* d_in, const int* in_sizes, int n_in, void* d_out, int out_size, void* d_ws, size_t ws_size, hipStream_t stream) {
    static int grid = 0;
    if (grid == 0) {
        if (n_in != 33 || in_sizes[0] != NB * SEQ * D || out_size != NB * SEQ * D || ws_size < WS_END) {
            fprintf(stderr, "kernel_launch: unexpected shapes: n_in %d in0 %d out %d ws %zu (need %zu)\n", n_in, n_in > 0 ? in_sizes[0] : -1, out_size, ws_size, (size_t)WS_END); grid = -1; return; }
        int dev = 0, cus = 0;
        if (hipGetDevice(&dev) != hipSuccess || hipDeviceGetAttribute(&cus, hipDeviceAttributeMultiprocessorCount, dev) != hipSuccess) { grid = -1; return; }
        if (hipFuncSetAttribute((const void*)fwd_kernel, hipFuncAttributeMaxDynamicSharedMemorySize, LDS_BYTES) != hipSuccess) { fprintf(stderr, "kernel_launch: hipFuncSetAttribute failed\n"); grid = -1; return; }
        int per_cu = 0;
        if (hipOccupancyMaxActiveBlocksPerMultiprocessor(&per_cu, (const void*)fwd_kernel, NTHR, LDS_BYTES) != hipSuccess || per_cu < 1) fprintf(stderr, "kernel_launch: occupancy query reports %d\n", per_cu);
        (void)hipGetLastError();
        grid = cus;
    }
    if (grid < 0) return;
    if (hipMemsetAsync((char*)d_ws + WS_CTL, 0, CTL_ZERO_BYTES, stream) != hipSuccess) return;
    Args a{};
    for (int i = 0; i < 33; ++i) a.in[i] = (const float*)d_in[i];
    a.out = (float*)d_out; a.ws = (unsigned char*)d_ws;
#if MK_ONE_LAUNCH
    a.ph_lo = 0; a.ph_hi = NPHASES;
    hipLaunchKernelGGL(fwd_kernel, dim3(grid), dim3(NTHR), LDS_BYTES, stream, a);
#else
    for (int ph = 0; ph < NPHASES; ++ph) { a.ph_lo = ph; a.ph_hi = ph + 1; hipLaunchKernelGGL(fwd_kernel, dim3(grid), dim3(NTHR), LDS_BYTES, stream, a); }
#endif
    const hipError_t le = hipPeekAtLastError();
    if (le != hipSuccess) fprintf(stderr, "kernel_launch: launch failed: %s\n", hipGetErrorName(le));
}
```

```cpp
#include <hip/hip_runtime.h>
#include <cstdio>
#include <cstdint>

#ifndef PROBE_MASK
#define PROBE_MASK 0u
#endif
#if defined(PROBE_K2)
#define PROBE_KSC 0.5f
#else
#define PROBE_KSC 1.0f
#endif
#ifndef MK_ONE_LAUNCH
#define MK_ONE_LAUNCH 1
#endif

namespace pg8 {
#define PG8_LAS __attribute__((address_space(3)))
typedef unsigned short bf16_t;
typedef short bf16x8 __attribute__((ext_vector_type(8)));
typedef float f32x4 __attribute__((ext_vector_type(4)));
typedef unsigned u32x4 __attribute__((ext_vector_type(4)));
constexpr int BM = 256, BK = 64, HALF = 128, HTB = HALF * BK * 2  , STAGE_BYTES = 8 * HTB, NXCD = 8, WGM = 8;

__host__ __device__ __forceinline__ int lds_byte(int r, int c) { const int st = (r >> 4) * 2 + (c >> 5), rr = r & 15, cc = c & 31, ob = rr * 64 + cc * 2; return st * 1024 + (ob ^ (((ob >> 9) & 1) << 5)); }
__host__ __device__ __forceinline__ void stage_rc(int b, int& R, int& C) { const int st = b / 1024, sb = b % 1024, swz = sb ^ (((sb >> 9) & 1) << 5); R = (st >> 1) * 16 + swz / 64; C = (st & 1) * 32 + (swz % 64) / 2; }
__host__ __device__ __forceinline__ int perm32(int rho) { const int n = rho >> 4, i = rho & 15; return 8 * (i >> 2) + 4 * n + (i & 3); }

struct Unit { int pm, pn; };
struct Gemm { const bf16_t* A; const bf16_t* Bt; int M, N, K; };

struct StaticOrder {
    int nM, nN, nwg, G, c;
    __host__ __device__ void init(int M, int N, int G_, int c_) { nM = M / BM; nN = N / BM; nwg = nM * nN; G = G_; c = c_; }
    __host__ __device__ bool next(int i, Unit& u) const {
        const long L = (long)i * G + c; if (L >= nwg) return false;
        int wgid = (int)L; { const int q = nwg / NXCD, r = nwg % NXCD, xcd = wgid % NXCD, off = wgid / NXCD; wgid = (xcd < r ? xcd * (q + 1) : r * (q + 1) + (xcd - r) * q) + off; }
        const int nig = WGM * nN, gid = wgid / nig, fm = gid * WGM, gsz = (nM - fm) < WGM ? (nM - fm) : WGM;
        u.pm = fm + ((wgid % nig) % gsz); u.pn = (wgid % nig) / gsz; return true;
    }
    __device__ __forceinline__ void a_ready(const Unit&) const {}
    __device__ __forceinline__ void done(const Unit&) const {}
};

__device__ __forceinline__ unsigned cvt_pk_bf16(float lo, float hi) { unsigned r; asm volatile("v_cvt_pk_bf16_f32 %0, %1, %2" : "=v"(r) : "v"(lo), "v"(hi)); return r; }
typedef float f32x2 __attribute__((ext_vector_type(2)));
__device__ __forceinline__ f32x2 gelu_pk(f32x2 v) {
    const f32x2 av = __builtin_elementwise_abs(v), d = av * 0.2316418882f + 1.0f;
    f32x2 t; t.x = __builtin_amdgcn_rcpf(d.x); t.y = __builtin_amdgcn_rcpf(d.y);
    f32x2 q = t * 0.5307027145f + (-0.7265760135f); q = q * t + 0.7107068705f; q = q * t + (-0.142248368f); q = q * t + 0.127414796f; q = q * t;
    const f32x2 s = (v * v) * (-0.72134752044f);
    f32x2 e; e.x = __builtin_amdgcn_exp2f(s.x); e.y = __builtin_amdgcn_exp2f(s.y);
    const f32x2 m = v * (q * e), r = v - m;
    f32x2 o; o.x = v.x < 0.f ? m.x : r.x; o.y = v.y < 0.f ? m.y : r.y; return o;
}

template <int ACT  > struct EpiBf16 {
    static constexpr bool PERM = true, AFTER_DRAIN = false; static_assert(ACT == 0 || ACT == 1, "EpiBf16: ACT is 0 (none) or 1 (gelu_pk)");
    bf16_t* O; int ldc; const float* bias; int split_cols; size_t split_stride; float scale0;
    __device__ __forceinline__ void operator()(const f32x4 (&acc)[2][2][4][2], const Unit& u, int wr, int wc, int fr, int fq) const {
        const int row0 = u.pm * BM + wr * 64 + fr; int colt = u.pn * BM; bf16_t* base = O;
        float sc = 1.f; if (split_cols) { const int t = colt / split_cols; base += (size_t)t * split_stride; colt -= t * split_cols; if (t == 0) sc = scale0; }
        const int col0 = colt + wc * 32 + 8 * fq, bcol0 = u.pn * BM + wc * 32 + 8 * fq;
        f32x4 bv[2][2];
#pragma unroll
        for (int bj = 0; bj < 2; ++bj)
#pragma unroll
            for (int n = 0; n < 2; ++n) bv[bj][n] = bias ? *(const f32x4*)(bias + bcol0 + bj * HALF + 4 * n) : (f32x4){0.f, 0.f, 0.f, 0.f};
#pragma unroll
        for (int ai = 0; ai < 2; ++ai)
#pragma unroll
            for (int m = 0; m < 4; ++m) { bf16_t* rowp = base + (size_t)(row0 + ai * HALF + m * 16) * ldc + col0;
#pragma unroll
                for (int bj = 0; bj < 2; ++bj) { f32x4 v0 = acc[ai][bj][m][0] + bv[bj][0], v1 = acc[ai][bj][m][1] + bv[bj][1];
                    if (ACT == 1) { f32x2 a = gelu_pk((f32x2){v0[0], v0[1]}), b = gelu_pk((f32x2){v0[2], v0[3]}), c = gelu_pk((f32x2){v1[0], v1[1]}), d = gelu_pk((f32x2){v1[2], v1[3]});
                        v0 = (f32x4){a.x, a.y, b.x, b.y}; v1 = (f32x4){c.x, c.y, d.x, d.y}; }
                    v0 = v0 * sc; v1 = v1 * sc; u32x4 w; w.x = cvt_pk_bf16(v0[0], v0[1]); w.y = cvt_pk_bf16(v0[2], v0[3]); w.z = cvt_pk_bf16(v1[0], v1[1]); w.w = cvt_pk_bf16(v1[2], v1[3]);
                    *(u32x4*)(rowp + bj * HALF) = w; } }
    }
};
typedef int v4i_t __attribute__((ext_vector_type(4)));
typedef int v8i_t __attribute__((ext_vector_type(8)));
__device__ __forceinline__ v8i_t cat32(bf16x8 a, bf16x8 b) { const v4i_t x = __builtin_bit_cast(v4i_t, a), y = __builtin_bit_cast(v4i_t, b); return __builtin_shufflevector(x, y, 0, 1, 2, 3, 4, 5, 6, 7); }
template <class Epi, class Sched, bool ALIGN_EPI = false, bool SP2 = false, bool GATHER = false, bool FP8 = false>
__device__ __forceinline__ void gemm_phase(PG8_LAS unsigned char* lds, const Gemm g, const Sched& S, const Epi& E, const int* rowsrc = nullptr, const PG8_LAS int* gtab = nullptr) {
    static_assert(!GATHER || SP2, "GATHER is implemented on the SP2 loop only");
    int tid_l = threadIdx.x; asm volatile("" : "+v"(tid_l));
    const int tid = tid_l, wid = __builtin_amdgcn_readfirstlane(tid >> 6), lane = tid & 63, wr = wid >> 2, wc = wid & 3, fr = lane & 15, fq = lane >> 4;
#if defined(PROBE_K2)
    const int K = g.K, nt0 = K / BK, nt = FP8 ? 2 * nt0 : nt0;
#define PG8_KT(x) (FP8 ? ((x) & (nt0 - 1)) : (x))
#else
    const int K = g.K, nt = K / BK;
#define PG8_KT(x) (x)
#endif
    unsigned voffA[2], voffB[2];
#pragma unroll
    for (int i = 0; i < 2; ++i) { int R, C; stage_rc(tid * 16 + i * 8192, R, C); const int Rb = Epi::PERM ? ((R & ~31) + perm32(R & 31)) : R;
        voffA[i] = (unsigned)(R * K + C) * 2u; voffB[i] = (unsigned)(Rb * K + C) * 2u; }
    unsigned gAc[2][2], gAn[2][2]; int gR[2]; unsigned gC[2];
#pragma unroll
    for (int i = 0; i < 2; ++i) { int R, C; stage_rc(tid * 16 + i * 8192, R, C); gR[i] = R; gC[i] = (unsigned)C * 2u; gAc[0][i] = gAc[1][i] = gAn[0][i] = gAn[1][i] = 0u; }
#define PG8_GATHER(u_, o_) do { const int gtb_ = gtab[(u_).pm], gtc_ = gtab[576 + (u_).pm];     \
        _Pragma("unroll") for (int h_ = 0; h_ < 2; ++h_) _Pragma("unroll") for (int i_ = 0; i_ < 2; ++i_) \
        { const int rl_ = h_ * HALF + gR[i_]; const int src_ = rl_ < gtc_ ? rowsrc[gtb_ + rl_] : 0; o_[h_][i_] = (unsigned)src_ * (unsigned)(K * 2) + gC[i_]; } } while (0)
#define PG8_STAGE_A(bufoff, orig_gbase, NEXTSEL, H, KOFF) do { if constexpr (GATHER) { unsigned vo_[2]; vo_[0] = (NEXTSEL) ? gAn[H][0] : gAc[H][0]; vo_[1] = (NEXTSEL) ? gAn[H][1] : gAc[H][1]; \
        PG8_STAGE(bufoff, (const char*)g.A + (KOFF), vo_); } else { PG8_STAGE(bufoff, orig_gbase, voffA); } } while (0)
    const size_t kstep = (size_t)(BK * 2);
    const size_t hstep = (size_t)HALF * K * 2;
    const size_t tstep = 2 * hstep;
    const unsigned ldsw = (unsigned)wid * 1024u;
    const int aoff = lds_byte(wr * 64 + fr, fq * 8), boff = lds_byte(wc * 32 + fr, fq * 8);
#define PG8_SA(b, h) (((b) * 2 + (h)) * HTB)
#define PG8_SB(b, h) ((4 + (b) * 2 + (h)) * HTB)
#define PG8_STAGE(bufoff, gbase, voff) do { _Pragma("unroll") for (int _i = 0; _i < 2; ++_i) \
        __builtin_amdgcn_global_load_lds((const unsigned*)((const char*)(gbase) + (voff)[_i]), (PG8_LAS unsigned*)(lds + (bufoff) + ldsw + _i * 8192), 16, 0, 0); } while (0)
#define PG8_LD32(var, addr) do { const bf16x8 lo_ = *(const PG8_LAS bf16x8*)(addr); const bf16x8 hi_ = *(const PG8_LAS bf16x8*)((addr) + 1024); var = cat32(lo_, hi_); } while (0)
#define PG8_LDA(dst, b, h) do { if constexpr (FP8) { _Pragma("unroll") for (int m = 0; m < 4; ++m) PG8_LD32(dst##8[m], lds + PG8_SA(b, h) + aoff + m * 2048); } \
        else { _Pragma("unroll") for (int m = 0; m < 4; ++m) _Pragma("unroll") for (int k = 0; k < 2; ++k) dst[m][k] = *(const PG8_LAS bf16x8*)(lds + PG8_SA(b, h) + aoff + m * 2048 + k * 1024); } } while (0)
#define PG8_LDB(dst, b, h) do { if constexpr (FP8) { _Pragma("unroll") for (int n = 0; n < 2; ++n) PG8_LD32(dst##8[n], lds + PG8_SB(b, h) + boff + n * 2048); } \
        else { _Pragma("unroll") for (int n = 0; n < 2; ++n) _Pragma("unroll") for (int k = 0; k < 2; ++k) dst[n][k] = *(const PG8_LAS bf16x8*)(lds + PG8_SB(b, h) + boff + n * 2048 + k * 1024); } } while (0)
#define PG8_MMA(ai, bj, At, Bt) do { __builtin_amdgcn_s_setprio(1); \
        if constexpr (FP8) { _Pragma("unroll") for (int m = 0; m < 4; ++m) _Pragma("unroll") for (int n = 0; n < 2; ++n) \
            asm volatile("v_mfma_scale_f32_16x16x128_f8f6f4 %0, %1, %2, %0, %3, %3 op_sel_hi:[0,0,0]" : "+v"(acc[ai][bj][m][n]) : "v"(Bt##8[n]), "v"(At##8[m]), "v"(sc127)); } \
        else { _Pragma("unroll") for (int m = 0; m < 4; ++m) _Pragma("unroll") for (int n = 0; n < 2; ++n) _Pragma("unroll") for (int k = 0; k < 2; ++k) \
            acc[ai][bj][m][n] = __builtin_amdgcn_mfma_f32_16x16x32_bf16(Bt[n][k], At[m][k], acc[ai][bj][m][n], 0, 0, 0); } \
        __builtin_amdgcn_s_setprio(0); } while (0)
#define PG8_WAIT_V(n) asm volatile("s_waitcnt vmcnt(" #n ")" ::: "memory")
#define PG8_WAIT_L(n) asm volatile("s_waitcnt lgkmcnt(" #n ")" ::: "memory")
#define PG8_BAR __builtin_amdgcn_s_barrier()
#define PG8_SCHED __builtin_amdgcn_sched_barrier(0)
    Unit cur, nxt; int ui = 0;
    if (!S.next(0, cur)) return;
    f32x4 acc[2][2][4][2];
#pragma unroll
    for (int a = 0; a < 2; ++a)
#pragma unroll
        for (int b = 0; b < 2; ++b)
#pragma unroll
            for (int m = 0; m < 4; ++m)
#pragma unroll
                for (int n = 0; n < 2; ++n) acc[a][b][m][n] = (f32x4){0.f, 0.f, 0.f, 0.f};
    int sc127 = 0x7f7f7f7f; asm volatile("" : "+v"(sc127));
    bf16x8 At[4][2], B0[2][2], B1[2][2]; v8i_t At8[4], B08[2], B18[2]; (void)At; (void)B0; (void)B1; (void)At8; (void)B08; (void)B18;
    const char* cA = (const char*)g.A + (size_t)cur.pm * tstep; const char* cB = (const char*)g.Bt + (size_t)cur.pn * tstep;
    S.a_ready(cur);
    if constexpr (GATHER) { PG8_GATHER(cur, gAc); }
    if constexpr (SP2) {
        PG8_STAGE(PG8_SB(0, 0), cB, voffB); PG8_STAGE(PG8_SB(0, 1), cB + hstep, voffB); PG8_STAGE_A(PG8_SA(0, 0), cA, false, 0, (size_t)0); PG8_STAGE_A(PG8_SA(0, 1), cA + hstep, false, 1, (size_t)0);
        if (wr == 1) PG8_BAR;
        PG8_WAIT_V(2); PG8_BAR;
        PG8_STAGE(PG8_SB(1, 0), cB + kstep, voffB); PG8_STAGE_A(PG8_SA(1, 0), cA + kstep, false, 0, kstep); PG8_STAGE(PG8_SB(1, 1), cB + hstep + kstep, voffB);
        PG8_WAIT_V(6); PG8_BAR;
    } else {
        PG8_STAGE(PG8_SB(0, 0), cB, voffB); PG8_STAGE(PG8_SA(0, 0), cA, voffA); PG8_STAGE(PG8_SB(0, 1), cB + hstep, voffB); PG8_STAGE(PG8_SA(0, 1), cA + hstep, voffA);
        if (wr == 1) PG8_BAR;
        PG8_WAIT_V(4); PG8_BAR;
        PG8_STAGE(PG8_SB(1, 0), cB + kstep, voffB); PG8_STAGE(PG8_SA(1, 0), cA + kstep, voffA); PG8_STAGE(PG8_SB(1, 1), cB + hstep + kstep, voffB);
        PG8_WAIT_V(6); PG8_BAR;
    }
    for (;;) {
        const bool has_next = S.next(ui + 1, nxt);
        if constexpr (GATHER) { if (has_next) { PG8_GATHER(nxt, gAn); } else { _Pragma("unroll") for (int h_ = 0; h_ < 2; ++h_) _Pragma("unroll") for (int i_ = 0; i_ < 2; ++i_) gAn[h_][i_] = gAc[h_][i_]; } }
        const char* nA = has_next ? (const char*)g.A + (size_t)nxt.pm * tstep : cA; const char* nB = has_next ? (const char*)g.Bt + (size_t)nxt.pn * tstep : cB;
#pragma nounroll
        for (int t = 0; t < nt; t += 2) {
            const bool last = (t == nt - 2);
            const char* a1 = cA + (size_t)PG8_KT(t + 1) * kstep;
            const char* a2 = last ? nA : cA + (size_t)PG8_KT(t + 2) * kstep; const char* b2 = last ? nB : cB + (size_t)PG8_KT(t + 2) * kstep;
            const char* a3 = a2 + kstep; const char* b3 = b2 + kstep;
            const size_t k1 = (size_t)PG8_KT(t + 1) * kstep, k2 = last ? (size_t)0 : (size_t)PG8_KT(t + 2) * kstep, k3 = k2 + kstep; (void)k1; (void)k2; (void)k3;
            if (last && has_next) S.a_ready(nxt);
            if constexpr (SP2) {
            PG8_LDB(B0, 0, 0); PG8_LDB(B1, 0, 1); PG8_SCHED; PG8_LDA(At, 0, 0); PG8_STAGE_A(PG8_SA(1, 1), a1 + hstep, false, 1, k1);
            PG8_WAIT_V(8); PG8_WAIT_L(0); PG8_BAR; PG8_MMA(0, 0, At, B0); PG8_MMA(0, 1, At, B1); PG8_BAR; PG8_SCHED;
            PG8_LDA(At, 0, 1); PG8_STAGE(PG8_SB(0, 0), b2, voffB); PG8_STAGE(PG8_SB(0, 1), b2 + hstep, voffB); PG8_STAGE_A(PG8_SA(0, 0), a2, last, 0, k2);
            PG8_WAIT_V(8); PG8_WAIT_L(0); PG8_BAR; PG8_MMA(1, 0, At, B0); PG8_MMA(1, 1, At, B1); PG8_BAR; PG8_SCHED;
            PG8_LDB(B0, 1, 0); PG8_LDB(B1, 1, 1); PG8_SCHED; PG8_LDA(At, 1, 0); PG8_STAGE_A(PG8_SA(0, 1), a2 + hstep, last, 1, k2);
            PG8_WAIT_V(8); PG8_WAIT_L(0); PG8_BAR; PG8_MMA(0, 0, At, B0); PG8_MMA(0, 1, At, B1); PG8_BAR; PG8_SCHED;
            PG8_LDA(At, 1, 1); PG8_STAGE(PG8_SB(1, 0), b3, voffB); PG8_STAGE(PG8_SB(1, 1), b3 + hstep, voffB); PG8_STAGE_A(PG8_SA(1, 0), a3, last, 0, k3);
            PG8_WAIT_V(8); PG8_WAIT_L(0); PG8_BAR; PG8_MMA(1, 0, At, B0); PG8_MMA(1, 1, At, B1); PG8_BAR; PG8_SCHED;
            } else {
            PG8_LDB(B0, 0, 0); PG8_SCHED; PG8_LDA(At, 0, 0); PG8_STAGE(PG8_SA(1, 1), a1 + hstep, voffA);
            PG8_WAIT_L(8); PG8_BAR; PG8_WAIT_L(0); PG8_MMA(0, 0, At, B0); PG8_BAR; PG8_SCHED;
            PG8_LDB(B1, 0, 1); PG8_STAGE(PG8_SB(0, 0), b2, voffB);
            PG8_BAR; PG8_WAIT_L(0); PG8_MMA(0, 1, At, B1); PG8_BAR;
            PG8_LDA(At, 0, 1); PG8_STAGE(PG8_SA(0, 0), a2, voffA);
            PG8_BAR; PG8_WAIT_L(0); PG8_MMA(1, 0, At, B0); PG8_BAR; PG8_SCHED;
            PG8_STAGE(PG8_SB(0, 1), b2 + hstep, voffB);
            PG8_WAIT_V(6); PG8_BAR; PG8_MMA(1, 1, At, B1); PG8_BAR;
            PG8_LDB(B0, 1, 0); PG8_SCHED; PG8_LDA(At, 1, 0); PG8_STAGE(PG8_SA(0, 1), a2 + hstep, voffA);
            PG8_WAIT_L(8); PG8_BAR; PG8_WAIT_L(0); PG8_MMA(0, 0, At, B0); PG8_BAR; PG8_SCHED;
            PG8_LDB(B1, 1, 1); PG8_STAGE(PG8_SB(1, 0), b3, voffB);
            PG8_BAR; PG8_WAIT_L(0); PG8_MMA(0, 1, At, B1); PG8_BAR;
            PG8_LDA(At, 1, 1); PG8_STAGE(PG8_SA(1, 0), a3, voffA);
            PG8_BAR; PG8_WAIT_L(0); PG8_MMA(1, 0, At, B0); PG8_BAR; PG8_SCHED;
            PG8_STAGE(PG8_SB(1, 1), b3 + hstep, voffB);
            PG8_WAIT_V(6); PG8_BAR; PG8_MMA(1, 1, At, B1); PG8_BAR;
            }
        }
        if constexpr (ALIGN_EPI) { if (wr == 0) PG8_BAR; }
        if constexpr (FP8) { asm volatile("s_nop 15\n\ts_nop 15" ::: "memory"); }
        if constexpr (!Epi::AFTER_DRAIN) { E(acc, cur, wr, wc, fr, fq);
#if defined(PROBE_EPI2)
            if constexpr (FP8 == (PROBE_EPI2 == 1)) { E(acc, cur, wr, wc, fr, fq); }
#endif
            S.done(cur); }
        if (!has_next) break;
#pragma unroll
        for (int a = 0; a < 2; ++a)
#pragma unroll
            for (int b = 0; b < 2; ++b)
#pragma unroll
                for (int m = 0; m < 4; ++m)
#pragma unroll
                    for (int n = 0; n < 2; ++n) acc[a][b][m][n] = (f32x4){0.f, 0.f, 0.f, 0.f};
        cur = nxt; cA = nA; cB = nB; ++ui;
        if constexpr (GATHER) { _Pragma("unroll") for (int h_ = 0; h_ < 2; ++h_) _Pragma("unroll") for (int i_ = 0; i_ < 2; ++i_) gAc[h_][i_] = gAn[h_][i_]; }
        if constexpr (ALIGN_EPI) { if (wr == 1) PG8_BAR; }
    }
    PG8_WAIT_V(0);
    if constexpr (!ALIGN_EPI) { if (wr == 0) PG8_BAR; }
    PG8_BAR;
    if constexpr (Epi::AFTER_DRAIN) { E.fused(acc, cur, wr, wc, fr, fq, lds, wid, lane); S.done(cur); }
#undef PG8_SA
#undef PG8_SB
#undef PG8_STAGE
#undef PG8_STAGE_A
#undef PG8_GATHER
#undef PG8_LDA
#undef PG8_LD32
#undef PG8_LDB
#undef PG8_MMA
#undef PG8_WAIT_V
#undef PG8_WAIT_L
#undef PG8_BAR
#undef PG8_SCHED
}
}

#ifndef PG8_SP2
#define PG8_SP2 true
#endif
#ifndef PG8_ALIGN
#define PG8_ALIGN true
#endif

#define GAS __attribute__((address_space(1)))
#define LAS __attribute__((address_space(3)))
typedef unsigned short bf16;
typedef unsigned v4u __attribute__((ext_vector_type(4)));
typedef unsigned v2u __attribute__((ext_vector_type(2)));
typedef float f32x4 __attribute__((ext_vector_type(4)));
typedef short bf16x8 __attribute__((ext_vector_type(8)));

constexpr int D = 1024, NB = 8, SEQ = 4096, CTXL = 256, TPB = SEQ + CTXL, NTOK = NB * TPB, NLAT = NB * SEQ;
constexpr int ZC = 3328;
constexpr int ZQ = 0, ZKV = 384, ZKR = 640, ZHQ = 672, ZHF = 1184, ZHB = 1696, ZHI = 2208, ZHG = 2720;
constexpr int NEXP = 32;
constexpr float ALPHA = 1.4142135623730951f;
constexpr float LN_EPS = 1e-5f, RMS_EPS = 1e-6f;
constexpr int NWAVES = 8, NTHR = 512;
constexpr float SC_X8 = 16.f, SC_WGU = 64.f, SC_ACT = 8.f, SC_WDN = 128.f, SC_Y = 64.f, SC_A1 = 16.f, SC_WPW = 64.f, SC_CV = 16.f, SC_A0 = 16.f, SC_WIN = 64.f;
constexpr int LDS_BYTES = 147456;
constexpr int LDS_BAR_OFF = LDS_BYTES - 64;
constexpr int LDS_TILE_E = 131072;
constexpr int MAXTILES = 576;

constexpr size_t MiB = 1u << 20;
constexpr size_t WS_CTL = 0, CTL_ZERO_BYTES = 16384;
constexpr size_t WS_MODV = 1 * MiB;
constexpr size_t WS_ROPE = 1 * MiB + 512 * 1024;
constexpr size_t WS_BGU = 2 * MiB;
constexpr size_t WS_PW1B = 2 * MiB + 512 * 1024;
constexpr size_t WS_BCNT = WS_PW1B + 64 * 1024;
constexpr size_t WS_TILEE = WS_BCNT + 64 * 1024;
constexpr size_t WS_META = WS_TILEE + 4096;
constexpr size_t WS_TOPI = 3 * MiB, WS_TOPW = 4 * MiB;
constexpr int ECAP = 32768;
constexpr size_t WS_ROWS = 160 * MiB, WS_ROWW = 164 * MiB, WS_ROWD = 168 * MiB;
constexpr size_t WS_CURSOR = 14336;
constexpr size_t WS_WIN = 8 * MiB, WS_WUQ = 15 * MiB, WS_WUKV = 16 * MiB, WS_WOUT = 17 * MiB, WS_WPW1 = 19 * MiB, WS_WPW2 = 23 * MiB;
constexpr size_t WS_WGU = 32 * MiB, WS_WDN = 288 * MiB;
constexpr size_t WS_H = 416 * MiB;
constexpr size_t WS_X = 552 * MiB, WS_Y = 620 * MiB;
constexpr size_t WS_BIG = 688 * MiB;
constexpr size_t WS_Z = WS_BIG, WS_CQN = WS_BIG + 221 * MiB, WS_CKVN = WS_BIG + 247 * MiB, WS_KRR = WS_BIG + 264 * MiB,
                 WS_Q = WS_BIG + 267 * MiB, WS_KV = WS_BIG + 318 * MiB, WS_OF = WS_BIG + 386 * MiB, WS_OB = WS_BIG + 454 * MiB;
constexpr size_t WS_HT = WS_BIG + 528 * MiB;
constexpr size_t WS_PRE = WS_BIG;
constexpr size_t WS_XS = WS_BIG, WS_ACT = WS_BIG + 288 * MiB, WS_YB = WS_BIG + 576 * MiB;
constexpr size_t WS_END = WS_BIG + 848 * MiB;
static_assert((size_t)NTOK * ZC * 2 <= 221 * MiB && (size_t)NTOK * 384 * 2 <= 26 * MiB && (size_t)NTOK * 256 * 2 <= 17 * MiB && (size_t)NTOK * 32 * 2 <= 3 * MiB, "ws map 1");
static_assert((size_t)NTOK * 768 * 2 <= 51 * MiB && (size_t)NTOK * 1024 * 2 <= 68 * MiB && (size_t)NTOK * 512 * 4 <= 68 * MiB, "ws map 2");
static_assert((size_t)64 * 136 * 26624 <= 320 * MiB && (size_t)MAXTILES * 256 * 2048 <= 288 * MiB && (size_t)NLAT * 4 * 2048 <= 272 * MiB && (size_t)NTOK * 1024 * 4 <= 136 * MiB, "ws map 3");

#define LDS_WAIT() asm volatile("s_waitcnt lgkmcnt(0)" ::: "memory")
#define VM_WAIT() asm volatile("s_waitcnt vmcnt(0)" ::: "memory")
__device__ __forceinline__ float bf2f(unsigned short b) { return __uint_as_float(((unsigned)b) << 16); }
__device__ __forceinline__ unsigned pk2(float lo, float hi) { return pg8::cvt_pk_bf16(lo, hi); }
__device__ __forceinline__ float sigm(float x) { return __builtin_amdgcn_rcpf(1.f + __expf(-x)); }
__device__ __forceinline__ float wave_sum(float v) {
#pragma unroll
    for (int o = 1; o < 64; o <<= 1) v += __shfl_xor(v, o);
    return v;
}
__device__ __forceinline__ int ld_ctl(const int* p) { return (int)__hip_atomic_load((const unsigned*)p, __ATOMIC_RELAXED, __HIP_MEMORY_SCOPE_AGENT); }
__device__ __forceinline__ int grow_of(int lr) { return (lr >> 12) * TPB + CTXL + (lr & 4095); }

#define XB_TMO      128
#define XB_XCNT(j)  (256  + 64 * (j))
#define XB_XSUB(j)  (1280 + 64 * (j))
#define XB_XGEN(j)  (2304 + 64 * (j))
#define XB_TOP      3328
#define XB_TOPGEN   3392
#define XCD_BAR_WORDS 3456
#define XB_SPIN_CAP (1u << 21)

__device__ __forceinline__ unsigned xb_ld(unsigned* p)              { return __hip_atomic_load(p, __ATOMIC_RELAXED, __HIP_MEMORY_SCOPE_AGENT); }
__device__ __forceinline__ unsigned xb_add(unsigned* p, unsigned v) { return __hip_atomic_fetch_add(p, v, __ATOMIC_RELAXED, __HIP_MEMORY_SCOPE_AGENT); }
__device__ __forceinline__ unsigned xb_xcc_id() { return (unsigned)__builtin_amdgcn_s_getreg((3 << 11) | 20) & 0xFu; }
#define XB_SPIN(cond, bar) do { unsigned _sp = 0; while (cond) { __builtin_amdgcn_s_sleep(1); \
    if ((++_sp & 255u) == 0u) { if (xb_ld(&(bar)[XB_TMO])) break; if (_sp > XB_SPIN_CAP) { atomicAdd(&(bar)[XB_TMO], 1u); break; } } } } while (0)

struct XcdBarrier { unsigned* bar; unsigned x; volatile LAS unsigned* st; };

__device__ __forceinline__ XcdBarrier xcd_barrier_post(unsigned* bar, volatile LAS unsigned* st) {
    XcdBarrier b; b.bar = bar; b.x = xb_xcc_id(); b.st = st;
    if (threadIdx.x == 0) (void)xb_add(&bar[XB_XCNT(b.x)], 1u);
    return b;
}
__device__ __forceinline__ void xcd_barrier_complete(unsigned* bar, unsigned x, unsigned& nloc, unsigned& nx) {
    const unsigned G = gridDim.x * gridDim.y * gridDim.z;
    unsigned sum, cnt, mine, sp = 0u;
    for (;;) {
        sum = 0u; cnt = 0u; mine = 0u;
#pragma unroll
        for (unsigned j = 0; j < 16; ++j) { const unsigned c = xb_ld(&bar[XB_XCNT(j)]); sum += c; cnt += (c > 0u) ? 1u : 0u; mine = (j == x) ? c : mine; }
        if (sum == G) break;
        __builtin_amdgcn_s_sleep(1);
        if ((++sp & 255u) == 0u) { if (xb_ld(&bar[XB_TMO])) break; if (sp > XB_SPIN_CAP) { atomicAdd(&bar[XB_TMO], 1u); break; } }
    }
    nloc = mine > 0u ? mine : 1u; nx = cnt > 0u ? cnt : 1u;
}
__device__ __forceinline__ void xcd_barrier(const XcdBarrier& b) {
    asm volatile("s_waitcnt vmcnt(0)" ::: "memory");
    __syncthreads();
    if (threadIdx.x == 0) {
        unsigned* bar = b.bar;
        __builtin_amdgcn_s_waitcnt(0);
        unsigned nloc = b.st[0], nx = b.st[1];
        if (nloc == 0u) { xcd_barrier_complete(bar, b.x, nloc, nx); b.st[0] = nloc; b.st[1] = nx; }
        const unsigned old = xb_add(&bar[XB_XSUB(b.x)], 1u);
        const unsigned gen = old / nloc;
        if (old + 1u == (gen + 1u) * nloc) {
            __builtin_amdgcn_fence(__ATOMIC_RELEASE, "agent");
            asm volatile("s_waitcnt vmcnt(0)" ::: "memory");
            const unsigned og = xb_add(&bar[XB_TOP], 1u);
            const unsigned tg = og / nx;
            if (og + 1u == (tg + 1u) * nx) xb_add(&bar[XB_TOPGEN], 1u);
            else XB_SPIN(xb_ld(&bar[XB_TOPGEN]) == tg, bar);
            __builtin_amdgcn_fence(__ATOMIC_ACQUIRE, "agent");
            xb_add(&bar[XB_XGEN(b.x)], 1u);
            asm volatile("s_waitcnt vmcnt(0)" ::: "memory");
        } else {
            XB_SPIN(xb_ld(&bar[XB_XGEN(b.x)]) == gen, bar);
            __builtin_amdgcn_fence(__ATOMIC_ACQUIRE, "agent");
            asm volatile("s_waitcnt vmcnt(0)" ::: "memory");
        }
    }
    __syncthreads();
}

namespace pg8 {
struct TileOrder {
    int nM, nN, nwg, G, c;
    __device__ __forceinline__ void init(int nM_, int nN_, int G_, int c_) { nM = nM_; nN = nN_; nwg = nM * nN; G = G_; c = c_; }
    __device__ __forceinline__ bool logical(int i, int& im, int& in) const {
        const long L = (long)i * G + c; if (L >= nwg) return false;
        int wgid = (int)L; { const int q = nwg / NXCD, r = nwg % NXCD, xcd = wgid % NXCD, off = wgid / NXCD; wgid = (xcd < r ? xcd * (q + 1) : r * (q + 1) + (xcd - r) * q) + off; }
        const int nig = WGM * nN, gid = wgid / nig, fm = gid * WGM, gsz = (nM - fm) < WGM ? (nM - fm) : WGM;
        im = fm + ((wgid % nig) % gsz); in = (wgid % nig) / gsz; return true;
    }
    __device__ __forceinline__ void a_ready(const Unit&) const {}
    __device__ __forceinline__ void done(const Unit&) const {}
};
struct AllOrder : TileOrder { __device__ __forceinline__ bool next(int i, Unit& u) const { int im, in; if (!logical(i, im, in)) return false; u.pm = im; u.pn = in; return true; } };
struct LatOrder : TileOrder {
    __device__ __forceinline__ bool next(int i, Unit& u) const { int im, in; if (!logical(i, im, in)) return false; u.pm = (im >> 4) * 17 + 1 + (im & 15); u.pn = in; return true; } };
struct MoeOrder : TileOrder {
    const PG8_LAS int* tile_e; int nper;
    __device__ __forceinline__ bool next(int i, Unit& u) const { int im, in; if (!logical(i, im, in)) return false; u.pm = im; u.pn = tile_e[im] * nper + in; return true; } };

template <bool HB16> struct EpiRes {
    static constexpr bool PERM = true, AFTER_DRAIN = false;
    const float* xin; const bf16_t* h; bf16_t* pre; const float* modv; const float* bias; float ascale;
    __device__ __forceinline__ void operator()(const f32x4 (&acc)[2][2][4][2], const Unit& u, int wr, int wc, int fr, int fq) const {
        asm volatile("" : "+v"(fr), "+v"(fq));
        const int b = u.pm / 17, j = u.pm % 17;
        const int rl0 = wr * 64 + fr, col0 = u.pn * BM + wc * 32 + 8 * fq;
        const float* gate = modv + (size_t)b * 6144 + 2048;
        f32x4 gv[2][2], bv[2][2];
#pragma unroll
        for (int bj = 0; bj < 2; ++bj)
#pragma unroll
            for (int n = 0; n < 2; ++n) { gv[bj][n] = *(const f32x4*)(gate + col0 + bj * HALF + 4 * n); bv[bj][n] = bias ? *(const f32x4*)(bias + col0 + bj * HALF + 4 * n) : (f32x4){0.f, 0.f, 0.f, 0.f}; }
        if constexpr (HB16) {
#pragma unroll
        for (int ai = 0; ai < 2; ++ai) {
            u32x4 hb[4][2];
#pragma unroll
            for (int m = 0; m < 4; ++m) { const int rl = rl0 + ai * HALF + m * 16; const size_t grow = (size_t)u.pm * BM + rl; const bf16_t* hin = h + grow * 1024 + col0;
#pragma unroll
                for (int bj = 0; bj < 2; ++bj) hb[m][bj] = *(const u32x4*)(hin + bj * HALF); }
            asm volatile("" ::: "memory");
#pragma unroll
            for (int m = 0; m < 4; ++m) { const int rl = rl0 + ai * HALF + m * 16; const size_t grow = (size_t)u.pm * BM + rl; bf16_t* po = pre + grow * 1024 + col0;
#pragma unroll
                for (int bj = 0; bj < 2; ++bj) { const u32x4 q = hb[m][bj];
                    const f32x4 h0 = {__builtin_bit_cast(float, q.x << 16), __builtin_bit_cast(float, q.x & 0xffff0000u), __builtin_bit_cast(float, q.y << 16), __builtin_bit_cast(float, q.y & 0xffff0000u)};
                    const f32x4 h1 = {__builtin_bit_cast(float, q.z << 16), __builtin_bit_cast(float, q.z & 0xffff0000u), __builtin_bit_cast(float, q.w << 16), __builtin_bit_cast(float, q.w & 0xffff0000u)};
                    const f32x4 v0 = h0 * 1.4142135623730951f + gv[bj][0] * (acc[ai][bj][m][0] * ascale + bv[bj][0]), v1 = h1 * 1.4142135623730951f + gv[bj][1] * (acc[ai][bj][m][1] * ascale + bv[bj][1]);
                    u32x4 w; w.x = cvt_pk_bf16(v0[0], v0[1]); w.y = cvt_pk_bf16(v0[2], v0[3]); w.z = cvt_pk_bf16(v1[0], v1[1]); w.w = cvt_pk_bf16(v1[2], v1[3]);
                    *(u32x4*)(po + bj * HALF) = w; } }
            asm volatile("" ::: "memory"); }
        } else {
#pragma unroll
        for (int aim = 0; aim < 4; ++aim) { const int ai = aim >> 1, m0 = (aim & 1) * 2;
            f32x4 hv[2][2][2];
#pragma unroll
            for (int mm = 0; mm < 2; ++mm) { const int rl = rl0 + ai * HALF + (m0 + mm) * 16; const size_t grow = (size_t)u.pm * BM + rl;
                const float* hin = xin + ((size_t)b * 4096 + (size_t)(j - 1) * 256 + rl) * 1024 + col0; (void)grow;
#pragma unroll
                for (int bj = 0; bj < 2; ++bj) { hv[mm][bj][0] = *(const f32x4*)(hin + bj * HALF); hv[mm][bj][1] = *(const f32x4*)(hin + bj * HALF + 4); } }
            asm volatile("" ::: "memory");
#pragma unroll
            for (int mm = 0; mm < 2; ++mm) { const int m = m0 + mm; const int rl = rl0 + ai * HALF + m * 16; const size_t grow = (size_t)u.pm * BM + rl; bf16_t* po = pre + grow * 1024 + col0;
#pragma unroll
                for (int bj = 0; bj < 2; ++bj) {
                    const f32x4 v0 = hv[mm][bj][0] * 1.4142135623730951f + gv[bj][0] * (acc[ai][bj][m][0] * ascale + bv[bj][0]), v1 = hv[mm][bj][1] * 1.4142135623730951f + gv[bj][1] * (acc[ai][bj][m][1] * ascale + bv[bj][1]);
                    u32x4 w; w.x = cvt_pk_bf16(v0[0], v0[1]); w.y = cvt_pk_bf16(v0[2], v0[3]); w.z = cvt_pk_bf16(v1[0], v1[1]); w.w = cvt_pk_bf16(v1[2], v1[3]);
                    *(u32x4*)(po + bj * HALF) = w; } }
            asm volatile("" ::: "memory"); }
        }
    }
};
template <int MODE, bool OUT8 = false> struct EpiGate {
    static constexpr bool PERM = true, AFTER_DRAIN = false;
    bf16_t* O; const float* bias; int nper; float ascale, oscale;
    __device__ __forceinline__ void operator()(const f32x4 (&acc)[2][2][4][2], const Unit& u, int wr, int wc, int fr, int fq) const {
        asm volatile("" : "+v"(fr), "+v"(fq));
        const int row0 = u.pm * BM + wr * 64 + fr, pnl = u.pn % nper, ocol0 = pnl * HALF + wc * 32 + 8 * fq, bcol0 = u.pn * BM + wc * 32 + 8 * fq;
        const float s0 = ascale, s1 = MODE == 1 ? ascale * oscale : ascale;
        f32x4 bv[2][2];
#pragma unroll
        for (int n = 0; n < 2; ++n) { bv[0][n] = *(const f32x4*)(bias + bcol0 + 4 * n); const f32x4 t = *(const f32x4*)(bias + bcol0 + HALF + 4 * n); bv[1][n] = MODE == 1 ? (t + 1.0f) * oscale : t; }
#pragma unroll
        for (int ai = 0; ai < 2; ++ai)
#pragma unroll
            for (int m = 0; m < 4; ++m) { bf16_t* rowp = O + (size_t)(row0 + ai * HALF + m * 16) * 1024 + ocol0;
                unsigned char* rowp8 = (unsigned char*)O + (size_t)(row0 + ai * HALF + m * 16) * 1024 + ocol0;
                float o[8];
#pragma unroll
                for (int n = 0; n < 2; ++n) { const f32x4 a = acc[ai][0][m][n] * s0 + bv[0][n], g = acc[ai][1][m][n] * s1 + bv[1][n];
#pragma unroll
                    for (int e = 0; e < 4; ++e) {
                        if (MODE == 0) { o[4 * n + e] = a[e] * __builtin_amdgcn_rcpf(1.f + __builtin_amdgcn_exp2f(g[e] * -1.4426950408889634f)); }
                        else { const float gt = fminf(a[e], 7.0f), up1 = __builtin_amdgcn_fmed3f(g[e], -6.0f * oscale, 8.0f * oscale);
                            o[4 * n + e] = up1 * (gt * __builtin_amdgcn_rcpf(1.f + __builtin_amdgcn_exp2f(gt * (-1.702f * 1.4426950408889634f)))); } } }
                if constexpr (OUT8) {
                    int w0 = 0, w1 = 0; w0 = __builtin_amdgcn_cvt_pk_fp8_f32(o[0], o[1], w0, false); w0 = __builtin_amdgcn_cvt_pk_fp8_f32(o[2], o[3], w0, true);
                    w1 = __builtin_amdgcn_cvt_pk_fp8_f32(o[4], o[5], w1, false); w1 = __builtin_amdgcn_cvt_pk_fp8_f32(o[6], o[7], w1, true);
                    typedef unsigned u32x2 __attribute__((ext_vector_type(2))); *(u32x2*)rowp8 = (u32x2){(unsigned)w0, (unsigned)w1}; (void)rowp;
                } else { (void)rowp8;
                u32x4 w; w.x = cvt_pk_bf16(o[0], o[1]); w.y = cvt_pk_bf16(o[2], o[3]); w.z = cvt_pk_bf16(o[4], o[5]); w.w = cvt_pk_bf16(o[6], o[7]);
                *(u32x4*)rowp = w; } }
    }
};
struct EpiDown {
    static constexpr bool PERM = true, AFTER_DRAIN = false;
    bf16_t* Y; const float* bias; const float* row_w; const int* row_dst; float ascale; const PG8_LAS int* gtab; float oscale;
    __device__ __forceinline__ void operator()(const f32x4 (&acc)[2][2][4][2], const Unit& u, int wr, int wc, int fr, int fq) const {
        asm volatile("" : "+v"(fr), "+v"(fq));
        const int pnl = u.pn & 3, ocol0 = pnl * BM + wc * 32 + 8 * fq, bcol0 = u.pn * BM + wc * 32 + 8 * fq; const int tbase = gtab[u.pm], tcnt = gtab[576 + u.pm];
        f32x4 bv[2][2];
#pragma unroll
        for (int bj = 0; bj < 2; ++bj)
#pragma unroll
            for (int n = 0; n < 2; ++n) bv[bj][n] = *(const f32x4*)(bias + bcol0 + bj * HALF + 4 * n);
        int dstv[2][4]; float wv[2][4];
#pragma unroll
        for (int ai = 0; ai < 2; ++ai)
#pragma unroll
            for (int m = 0; m < 4; ++m) { const int rl = wr * 64 + fr + ai * HALF + m * 16; const int ix = tbase + (rl < tcnt ? rl : 0); dstv[ai][m] = row_dst[ix]; wv[ai][m] = row_w[ix]; }
#pragma unroll
        for (int ai = 0; ai < 2; ++ai)
#pragma unroll
            for (int m = 0; m < 4; ++m) { const int rl = wr * 64 + fr + ai * HALF + m * 16;
                if (rl < tcnt) { const int dst = dstv[ai][m]; const float w8 = wv[ai][m] * oscale; unsigned char* rowp = (unsigned char*)Y + (size_t)dst * 1024 + ocol0;
#pragma unroll
                    for (int bj = 0; bj < 2; ++bj) { const f32x4 v0 = (acc[ai][bj][m][0] * ascale + bv[bj][0]) * w8, v1 = (acc[ai][bj][m][1] * ascale + bv[bj][1]) * w8;
                        int w0 = 0, w1 = 0; w0 = __builtin_amdgcn_cvt_pk_fp8_f32(fminf(fmaxf(v0[0], -448.f), 448.f), fminf(fmaxf(v0[1], -448.f), 448.f), w0, false); w0 = __builtin_amdgcn_cvt_pk_fp8_f32(fminf(fmaxf(v0[2], -448.f), 448.f), fminf(fmaxf(v0[3], -448.f), 448.f), w0, true);
                        w1 = __builtin_amdgcn_cvt_pk_fp8_f32(fminf(fmaxf(v1[0], -448.f), 448.f), fminf(fmaxf(v1[1], -448.f), 448.f), w1, false); w1 = __builtin_amdgcn_cvt_pk_fp8_f32(fminf(fmaxf(v1[2], -448.f), 448.f), fminf(fmaxf(v1[3], -448.f), 448.f), w1, true);
                        typedef unsigned u32x2 __attribute__((ext_vector_type(2))); *(u32x2*)(rowp + bj * HALF) = (u32x2){(unsigned)w0, (unsigned)w1}; } } }
    }
};
}

namespace att {
using bf16x8 = __attribute__((ext_vector_type(8))) short;
using s16x4  = __attribute__((ext_vector_type(4))) short;
using f32x16 = __attribute__((ext_vector_type(16))) float;
using u32x4  = __attribute__((ext_vector_type(4))) unsigned;
constexpr int NW = 8, QBLK = 32, KVBLK = 64;
constexpr float SCALE = 0.10206207261596575f;
constexpr float THR = 8.f;
constexpr int SHM_V = 16384, SHM_K = 16384, NBUF = 3, SHM_ATTN = NBUF * SHM_V + NBUF * SHM_K + NW * 64 * 4;
#define KSWZ(row, colB) ((row) * 256 + ((colB) ^ (((row) & 7) << 4)))
#define SBAR() __builtin_amdgcn_sched_barrier(0)
__device__ __forceinline__ int crow(int r, int hi) { return (r & 3) + 8 * (r >> 2) + 4 * hi; }
__device__ __forceinline__ unsigned cvtpk(float lo, float hi) { unsigned r; asm volatile("v_cvt_pk_bf16_f32 %0, %1, %2" : "=v"(r) : "v"(lo), "v"(hi)); return r; }

__device__ __forceinline__ void partialSM(f32x16& p0, f32x16& p1, float& m_reg, float& mn, float& alpha) {
  constexpr float C = SCALE * 1.4426950408889634f;
  float pmax = p0[0];
#pragma unroll
  for (int r = 1; r < 16; ++r) pmax = fmaxf(pmax, p0[r]);
#pragma unroll
  for (int r = 0; r < 16; ++r) pmax = fmaxf(pmax, p1[r]);
  { auto rr = __builtin_amdgcn_permlane32_swap(__float_as_uint(pmax), __float_as_uint(pmax), false, false);
    pmax = fmaxf(__uint_as_float(rr[0]), __uint_as_float(rr[1])); }
  if (__builtin_expect(__all(pmax - m_reg <= THR / SCALE), 1)) { mn = m_reg; alpha = 1.f; }
  else { mn = fmaxf(m_reg, pmax); alpha = __builtin_amdgcn_exp2f((m_reg - mn) * C); m_reg = mn; }
  float mnC = -mn * C;
#pragma unroll
  for (int r = 0; r < 16; ++r) p0[r] = fmaf(p0[r], C, mnC);
#pragma unroll
  for (int r = 0; r < 16; ++r) p1[r] = fmaf(p1[r], C, mnC);
#pragma unroll
  for (int r = 0; r < 16; ++r) p0[r] = __builtin_amdgcn_exp2f(p0[r]);
}
__device__ __forceinline__ void finishSM(f32x16& p0, f32x16& p1, float alpha, float& l_reg, bf16x8& pa0, bf16x8& pa1, bf16x8& pa2, bf16x8& pa3) {
#pragma unroll
  for (int r = 0; r < 16; ++r) p1[r] = __builtin_amdgcn_exp2f(p1[r]);
  float ps = 0;
#pragma unroll
  for (int r = 0; r < 16; ++r) ps += p0[r];
#pragma unroll
  for (int r = 0; r < 16; ++r) ps += p1[r];
  { auto rr = __builtin_amdgcn_permlane32_swap(__float_as_uint(ps), __float_as_uint(ps), false, false);
    ps = __uint_as_float(rr[0]) + __uint_as_float(rr[1]); }
  l_reg = l_reg * alpha + ps;
#define PK4(P, BASE, OUT) do { unsigned a0 = cvtpk(P[BASE + 0], P[BASE + 1]), a1 = cvtpk(P[BASE + 2], P[BASE + 3]);   \
    unsigned b0 = cvtpk(P[BASE + 4], P[BASE + 5]), b1 = cvtpk(P[BASE + 6], P[BASE + 7]);                              \
    auto r0 = __builtin_amdgcn_permlane32_swap(a0, b0, false, false); auto r1 = __builtin_amdgcn_permlane32_swap(a1, b1, false, false); \
    u32x4 w = {r0[0], r1[0], r0[1], r1[1]}; OUT = *reinterpret_cast<bf16x8*>(&w); } while (0)
  PK4(p0, 0, pa0); PK4(p0, 8, pa1); PK4(p1, 0, pa2); PK4(p1, 8, pa3);
#undef PK4
}
__device__ __forceinline__ void qkt(f32x16& p0, f32x16& p1, const bf16* Ks, const bf16x8* qr, int r32, int hi) {
  p0 = f32x16{}; p1 = f32x16{};
#pragma unroll
  for (int d0 = 0; d0 < 6; ++d0) { int cb = (d0 * 16 + hi * 8) * 2;
    bf16x8 b0 = *reinterpret_cast<const bf16x8*>((const char*)Ks + KSWZ(r32, cb));
    bf16x8 b1 = *reinterpret_cast<const bf16x8*>((const char*)Ks + KSWZ(32 + r32, cb));
    p0 = __builtin_amdgcn_mfma_f32_32x32x16_bf16(b0, qr[d0], p0, 0, 0, 0);
    p1 = __builtin_amdgcn_mfma_f32_32x32x16_bf16(b1, qr[d0], p1, 0, 0, 0); }
}
__device__ __forceinline__ int v_st(int k, int c) { const int kk = (k & ~0xC) | ((k & 4) << 1) | ((k & 8) >> 1); return ((kk >> 3) * 4 + (c >> 5)) * 512 + ((kk & 7) * 32 + (c & 31)) * 2; }
__device__ __forceinline__ int v_rd_base(int lane) { return ((lane & 3) << 3) | (((lane >> 2) & 3) << 6) | (((lane >> 4) & 1) << 5) | (((lane >> 5) & 1) << 8); }
constexpr int v_rd_off(int d0, int ks, int half) { return d0 * 512 + ks * 4096 + half * 2048; }
template <int OFF> __device__ __forceinline__ s16x4 tr_read(int vb) {
  s16x4 r; asm volatile("ds_read_b64_tr_b16 %0, %1 offset:%2" : "=&v"(r) : "v"(vb), "i"(OFF) : "memory"); return r;
}
template <int D0> __device__ __forceinline__ void pv_one(f32x16& od, int vb, bf16x8 pa0, bf16x8 pa1, bf16x8 pa2, bf16x8 pa3) {
  const s16x4 l0 = tr_read<v_rd_off(D0, 0, 0)>(vb), h0 = tr_read<v_rd_off(D0, 0, 1)>(vb), l1 = tr_read<v_rd_off(D0, 1, 0)>(vb), h1 = tr_read<v_rd_off(D0, 1, 1)>(vb);
  const s16x4 l2 = tr_read<v_rd_off(D0, 2, 0)>(vb), h2 = tr_read<v_rd_off(D0, 2, 1)>(vb), l3 = tr_read<v_rd_off(D0, 3, 0)>(vb), h3 = tr_read<v_rd_off(D0, 3, 1)>(vb);
  asm volatile("s_waitcnt lgkmcnt(0)" ::: "memory"); SBAR();
#define PK(L, H) (bf16x8){L[0], L[1], L[2], L[3], H[0], H[1], H[2], H[3]}
  od = __builtin_amdgcn_mfma_f32_32x32x16_bf16(pa0, PK(l0, h0), od, 0, 0, 0);
  od = __builtin_amdgcn_mfma_f32_32x32x16_bf16(pa1, PK(l1, h1), od, 0, 0, 0);
  od = __builtin_amdgcn_mfma_f32_32x32x16_bf16(pa2, PK(l2, h2), od, 0, 0, 0);
  od = __builtin_amdgcn_mfma_f32_32x32x16_bf16(pa3, PK(l3, h3), od, 0, 0, 0);
#undef PK
}
__device__ __forceinline__ void pv_d0(f32x16* o, int vb, bf16x8 pa0, bf16x8 pa1, bf16x8 pa2, bf16x8 pa3) {
  pv_one<0>(o[0], vb, pa0, pa1, pa2, pa3); pv_one<1>(o[1], vb, pa0, pa1, pa2, pa3);
}
__device__ __forceinline__ bf16x8 rope8(bf16x8 x, const float* tab, int pbase) {
  u32x4 w;
#pragma unroll
  for (int i = 0; i < 4; ++i) { const float x1 = __uint_as_float(((unsigned)(unsigned short)x[2 * i]) << 16), x2 = __uint_as_float(((unsigned)(unsigned short)x[2 * i + 1]) << 16);
    const float cs = tab[pbase + i], sn = tab[16 + pbase + i]; w[i] = cvtpk(x1 * cs - x2 * sn, x1 * sn + x2 * cs); }
  return *reinterpret_cast<bf16x8*>(&w);
}
__device__ __forceinline__ void attn_unit(const bf16* __restrict__ Qb, const bf16* __restrict__ KVb, const bf16* __restrict__ KRb, bf16* __restrict__ Ob,
                                          const float* __restrict__ rope, int seq, char* lds) {
  int tid_l = threadIdx.x; asm volatile("" : "+v"(tid_l));
  const int tid = tid_l, wid = tid >> 6, lane = tid & 63, r32 = lane & 31, hi = lane >> 5;
  bf16* V_lds = (bf16*)lds; bf16* K_lds = (bf16*)(lds + NBUF * SHM_V);
  float* ws = (float*)(lds + NBUF * SHM_V + NBUF * SHM_K) + wid * 64; float* li_l = ws; float* al_l = ws + 32;
  float m_reg = -1e30f, l_reg = 0; f32x16 o[2] = {}; bf16x8 qr[6];
  const bf16* Qw = Qb + (long)(wid * QBLK + r32) * 768 + hi * 8;
#pragma unroll
  for (int d0 = 0; d0 < 6; ++d0) qr[d0] = *reinterpret_cast<const bf16x8*>(Qw + d0 * 16);
  if (rope) { const float* tab = rope + (long)(wid * QBLK + r32) * 32; qr[4] = rope8(qr[4], tab, 4 * hi); qr[5] = rope8(qr[5], tab, 8 + 4 * hi); }
  const int sr = tid >> 4, ch = tid & 15;
  const bf16* kbase = ch < 8 ? KVb + ch * 8 : KRb + ((ch - 8) & 3) * 8; const long kstr = ch < 8 ? 1024 : 32;
  const int vkey = tid >> 3, vc8 = (tid & 7) * 8, vst0 = v_st(vkey, vc8);
  const bf16* vbase = KVb + 512 + vc8;
  const int vb0 = (int)(uintptr_t)V_lds + v_rd_base(lane);
  struct { bf16x8 vs0, ks0, ks1; } sr_[2];
#define SLOAD(i, k0) do { sr_[i].vs0 = *reinterpret_cast<const bf16x8*>(vbase + (long)((k0) + vkey) * 1024); \
    sr_[i].ks0 = *reinterpret_cast<const bf16x8*>(kbase + (long)((k0) + sr) * kstr); sr_[i].ks1 = *reinterpret_cast<const bf16x8*>(kbase + (long)((k0) + 32 + sr) * kstr); } while (0)
#define SWRITE(b, i) do { *(bf16x8*)((char*)V_lds + (b) * SHM_V + vst0) = sr_[i].vs0; int kc = ch * 16;               \
    *(bf16x8*)((char*)K_lds + (b) * SHM_K + KSWZ(sr, kc)) = sr_[i].ks0;                       \
    *(bf16x8*)((char*)K_lds + (b) * SHM_K + KSWZ(32 + sr, kc)) = sr_[i].ks1; } while (0)
#define SWAIT() asm volatile("s_waitcnt vmcnt(3)" ::: "memory")
#define RESC(a) do { if (__any((a) < 1.f)) { if (hi == 0) al_l[r32] = (a); asm volatile("s_waitcnt lgkmcnt(0)" ::: "memory"); \
    _Pragma("unroll") for (int d = 0; d < 2; ++d) _Pragma("unroll") for (int r = 0; r < 16; ++r) o[d][r] *= al_l[crow(r, hi)]; } } while (0)
  f32x16 pA0, pA1, pB0, pB1; float mnA, mnB, alA, alB; bf16x8 pa0, pa1, pa2, pa3; const int NT = seq / KVBLK;
  constexpr int SE = 0, SO = 1;
  SLOAD(SE, 0); asm volatile("s_waitcnt vmcnt(0)" ::: "memory"); SWRITE(0, SE); __syncthreads();
  qkt(pA0, pA1, K_lds, qr, r32, hi); partialSM(pA0, pA1, m_reg, mnA, alA);
  SLOAD(SO, KVBLK); if (2 < NT) SLOAD(SE, 2 * KVBLK);
  SWAIT(); SWRITE(1, SO); __syncthreads();
  int bprev = 0, bcur = 1, bnext = 2;
#define ATT_STEP(PN0, PN1, MNN, ALN, PO0, PO1, ALO, SL_LOAD, SL_WRITE, t) do { \
    SBAR(); qkt(PN0, PN1, (bf16*)((char*)K_lds + bcur * SHM_K), qr, r32, hi); \
    finishSM(PO0, PO1, ALO, l_reg, pa0, pa1, pa2, pa3); SBAR(); \
    if ((t) + 2 < NT) SLOAD(SL_LOAD, ((t) + 2) * KVBLK); SBAR(); \
    pv_d0(o, vb0 + bprev * (int)SHM_V, pa0, pa1, pa2, pa3); partialSM(PN0, PN1, m_reg, MNN, ALN); \
    SWAIT(); SWRITE(bnext, SL_WRITE); \
    RESC(ALN); __syncthreads(); \
    bprev = bcur; bcur = bnext; bnext = (bnext == 2) ? 0 : bnext + 1; } while (0)
  for (int j = 1; j + 1 < NT; j += 2) {
    ATT_STEP(pB0, pB1, mnB, alB, pA0, pA1, alA, SO, SE, j);
    ATT_STEP(pA0, pA1, mnA, alA, pB0, pB1, alB, SE, SO, j + 1);
  }
#undef ATT_STEP
  SBAR(); qkt(pB0, pB1, (bf16*)((char*)K_lds + bcur * SHM_K), qr, r32, hi);
  finishSM(pA0, pA1, alA, l_reg, pa0, pa1, pa2, pa3); SBAR();
  pv_d0(o, vb0 + bprev * (int)SHM_V, pa0, pa1, pa2, pa3); partialSM(pB0, pB1, m_reg, mnB, alB);
  RESC(alB);
  finishSM(pB0, pB1, alB, l_reg, pa0, pa1, pa2, pa3); SBAR();
  pv_d0(o, vb0 + bcur * (int)SHM_V, pa0, pa1, pa2, pa3);
  if (hi == 0) li_l[r32] = l_reg; asm volatile("s_waitcnt lgkmcnt(0)" ::: "memory");
  float rli[16];
#pragma unroll
  for (int r = 0; r < 16; ++r) rli[r] = __builtin_amdgcn_rcpf(li_l[crow(r, hi)]);
  bf16* Ow = Ob + (long)(wid * QBLK) * 1024;
#pragma unroll
  for (int r = 0; r < 16; ++r) { int orow = crow(r, hi);
#pragma unroll
    for (int d0 = 0; d0 < 2; ++d0) { const float v = o[d0][r] * rli[r]; Ow[(long)orow * 1024 + d0 * 32 + r32] = (bf16)(cvtpk(v, v) & 0xffffu); } }
#undef SLOAD
#undef SWRITE
#undef SWAIT
#undef RESC
}
}

struct Args { const float* in[33]; float* out; unsigned char* ws; int ph_lo, ph_hi; };
enum { I_X = 0, I_C, I_CTX, I_CCTX, I_MODW, I_MODB, I_LN1G, I_LN1B, I_LN2G, I_LN2B, I_WIN, I_QNORM, I_KVNORM, I_WUQ, I_WUK, I_WUV, I_LBL, I_HGNORM, I_WOUT,
       I_PW1W, I_PW1B, I_DWW, I_DWB, I_CLNG, I_CLNB, I_PW2W, I_PW2B, I_RW, I_RB, I_WGU, I_BGU, I_WDN, I_BDN };

__device__ __forceinline__ int dst_row(int n, int mode, int row_off) {
    if (mode == 0) return row_off + n;
    int f, g; if (mode == 1) { f = n >> 1; g = n & 1; } else { g = n >> 10; f = n & 1023; }
    return row_off + 256 * (f >> 7) + 128 * g + (f & 127);
}
__device__ __forceinline__ unsigned pack_fp8x4(float a, float b, float c, float d) { int w = 0; w = __builtin_amdgcn_cvt_pk_fp8_f32(fminf(fmaxf(a, -448.f), 448.f), fminf(fmaxf(b, -448.f), 448.f), w, false);
    w = __builtin_amdgcn_cvt_pk_fp8_f32(fminf(fmaxf(c, -448.f), 448.f), fminf(fmaxf(d, -448.f), 448.f), w, true); return (unsigned)w; }
struct TrItem { const float* W; bf16* WT; int K, N, mode, row_off, item; float f8scale; };
__device__ __forceinline__ void tr_load(const TrItem& d, f32x4 (&v)[16], int lane) {
    const int nblk = (d.N + 63) >> 6, kb = d.item / nblk, nb = d.item - kb * nblk, k0 = 64 * kb, n0 = 64 * nb;
    const int nc = n0 + 4 * (lane & 15), kr = lane >> 4;
#pragma unroll
    for (int i = 0; i < 16; ++i) v[i] = (nc < d.N) ? __builtin_nontemporal_load((const f32x4*)(d.W + (size_t)(k0 + 4 * i + kr) * d.N + nc)) : (f32x4){0.f, 0.f, 0.f, 0.f};
}
__device__ __forceinline__ void tr_lds_write(const f32x4 (&v)[16], LAS float* scr, int lane) {
    const int kr = lane >> 4;
#pragma unroll
    for (int i = 0; i < 16; ++i) { LAS float* s = scr + (4 * i + kr) * 65 + 4 * (lane & 15); s[0] = v[i][0]; s[1] = v[i][1]; s[2] = v[i][2]; s[3] = v[i][3]; }
}
__device__ __forceinline__ void tr_store(const TrItem& d, LAS float* scr, int lane) {
    const int nblk = (d.N + 63) >> 6, kb = d.item / nblk, nb = d.item - kb * nblk, k0 = 64 * kb, n0 = 64 * nb;
    const int c = lane & 7; const int K = d.K;
#pragma unroll
    for (int j = 0; j < 8; ++j) { const int nl = (lane >> 3) + 8 * j, n = n0 + nl; const LAS float* s = scr + (8 * c) * 65 + nl;
        if (n < d.N) { if (d.f8scale > 0.f) { const float f8 = d.f8scale; v2u o8; o8.x = pack_fp8x4(s[0 * 65] * f8, s[1 * 65] * f8, s[2 * 65] * f8, s[3 * 65] * f8); o8.y = pack_fp8x4(s[4 * 65] * f8, s[5 * 65] * f8, s[6 * 65] * f8, s[7 * 65] * f8);
                *(v2u*)((unsigned char*)d.WT + (size_t)dst_row(n, d.mode, d.row_off) * K + k0 + 8 * c) = o8; }
            else { v4u o; o.x = pk2(s[0 * 65], s[1 * 65]); o.y = pk2(s[2 * 65], s[3 * 65]); o.z = pk2(s[4 * 65], s[5 * 65]); o.w = pk2(s[6 * 65], s[7 * 65]);
                *(v4u*)(d.WT + (size_t)dst_row(n, d.mode, d.row_off) * K + k0 + 8 * c) = o; } } }
}
__device__ __forceinline__ void convert_items(const Args& a, unsigned char* ws, LAS float* scr, int lane, int gw, int NGW, int it_lo, int it_hi) {
    constexpr int I0 = 16 * 51, I1 = 6 * 12, I2 = 4 * 8, I3 = 4 * 8, I4 = 256, I5 = 512;
    constexpr int NGU = 64 * 512, NDN = 64 * 256;
    auto decode = [&](int it) -> TrItem {
        TrItem d; int r = it; d.f8scale = 0.f; d.mode = 0; d.row_off = 0;
        if (r < NGU) { const int mi = r >> 9; d.W = a.in[I_WGU] + (size_t)mi * 1024 * 2048; d.K = 1024; d.N = 2048; d.WT = (bf16*)(ws + WS_WGU + (size_t)mi * 2048 * 1024); d.mode = 1; d.item = r & 511; d.f8scale = SC_WGU; return d; } r -= NGU;
        if (r < NDN) { const int mi = r >> 8; d.W = a.in[I_WDN] + (size_t)mi * 1024 * 1024; d.K = 1024; d.N = 1024; d.WT = (bf16*)(ws + WS_WDN + (size_t)mi * 1024 * 1024); d.item = r & 255; d.f8scale = SC_WDN; return d; } r -= NDN;
        if (r < I0) { d.W = a.in[I_WIN]; d.K = 1024; d.N = 3232; d.WT = (bf16*)(ws + WS_WIN); d.item = r; d.f8scale = SC_WIN; return d; } r -= I0;
        if (r < I1) { d.W = a.in[I_WUQ]; d.K = 384; d.N = 768; d.WT = (bf16*)(ws + WS_WUQ); d.item = r; return d; } r -= I1;
        if (r < I2) { d.W = a.in[I_WUK]; d.K = 256; d.N = 512; d.WT = (bf16*)(ws + WS_WUKV); d.item = r; return d; } r -= I2;
        if (r < I3) { d.W = a.in[I_WUV]; d.K = 256; d.N = 512; d.WT = (bf16*)(ws + WS_WUKV); d.row_off = 512; d.item = r; return d; } r -= I3;
        if (r < I4) { d.W = a.in[I_WOUT]; d.K = 1024; d.N = 1024; d.WT = (bf16*)(ws + WS_WOUT); d.item = r; return d; } r -= I4;
        if (r < I5) { d.W = a.in[I_PW1W]; d.K = 1024; d.N = 2048; d.WT = (bf16*)(ws + WS_WPW1); d.mode = 2; d.item = r; d.f8scale = SC_WPW; return d; } r -= I5;
        d.W = a.in[I_PW2W]; d.K = 1024; d.N = 1024; d.WT = (bf16*)(ws + WS_WPW2); d.item = r; d.f8scale = SC_WPW; return d; };
    f32x4 tv[16];
    int it = it_lo + gw;
    if (it < it_hi) { const TrItem d0 = decode(it); tr_load(d0, tv, lane); }
    for (; it < it_hi; it += NGW) {
        const TrItem d = decode(it);
        tr_lds_write(tv, scr, lane);
        if (it + NGW < it_hi) { const TrItem dn = decode(it + NGW); tr_load(dn, tv, lane); }
        LDS_WAIT();
        tr_store(d, scr, lane);
        LDS_WAIT();
    }
}
__device__ __forceinline__ void phase_prologue(const Args& a, LAS unsigned char* lds, int tid, int lane, int wave) {
    unsigned char* ws = a.ws;
    const int G = gridDim.x, B = blockIdx.x;
    {
        LAS float* sc = (LAS float*)lds;
        LAS float* red = (LAS float*)(lds + 36864);
        float* modv = (float*)(ws + WS_MODV);
        bool have = false;
        for (int it = B; it < 192; it += G) {
            if (!have) { for (int i = tid; i < 9 * 1024; i += NTHR) { const int r = i >> 10, k = i & 1023; const float x = r < 8 ? a.in[I_C][r * 1024 + k] : a.in[I_CCTX][k]; sc[i] = x * sigm(x); } __syncthreads(); have = true; }
            const int l = it / 96, jc = it % 96, kg = tid >> 6, jj = tid & 63, j = jc * 64 + jj;
            float acc[9];
#pragma unroll
            for (int r = 0; r < 9; ++r) acc[r] = 0.f;
            const float* wp = a.in[I_MODW] + ((size_t)l * 1024 + kg * 128) * 6144 + j;
            for (int k0 = 0; k0 < 128; k0 += 16) { float w[16];
#pragma unroll
                for (int kk = 0; kk < 16; ++kk) w[kk] = wp[(size_t)(k0 + kk) * 6144];
#pragma unroll
                for (int kk = 0; kk < 16; ++kk)
#pragma unroll
                    for (int r = 0; r < 9; ++r) acc[r] += sc[r * 1024 + kg * 128 + k0 + kk] * w[kk]; }
#pragma unroll
            for (int r = 0; r < 9; ++r) red[(kg * 9 + r) * 64 + jj] = acc[r];
            __syncthreads();
            for (int i = tid; i < 576; i += NTHR) { const int r = i >> 6, j2 = i & 63; float s = a.in[I_MODB][l * 6144 + jc * 64 + j2];
#pragma unroll
                for (int g = 0; g < 8; ++g) s += red[(g * 9 + r) * 64 + j2];
                modv[((size_t)l * 9 + r) * 6144 + jc * 64 + j2] = s; }
            __syncthreads();
        }
        __syncthreads();
    }
    const int gw = B * NWAVES + wave, NGW = G * NWAVES, gt = B * NTHR + tid, NGT = G * NTHR;
    { float* rope = (float*)(ws + WS_ROPE);
      for (int i = gt; i < 4096 * 16; i += NGT) { const int t = i >> 4, p = i & 15; const float pos = (float)(p < 8 ? (t >> 6) : (t & 63));
          const float inv = __powf(10000.0f, -(float)(p & 7) * 0.125f); const float ang = pos * inv; rope[t * 32 + p] = cosf(ang); rope[t * 32 + 16 + p] = sinf(ang); }
      float* bgu = (float*)(ws + WS_BGU);
      for (int i = gt; i < 2 * 32 * 2048; i += NGT) { const int le = i >> 11, np = i & 2047, q = np >> 8, g = (np >> 7) & 1, r = np & 127, f = 128 * q + r; bgu[i] = a.in[I_BGU][(size_t)le * 2048 + 2 * f + g]; }
      float* pb = (float*)(ws + WS_PW1B);
      for (int i = gt; i < 2048; i += NGT) { const int q = i >> 8, g = (i >> 7) & 1, r = i & 127, f = 128 * q + r; pb[i] = a.in[I_PW1B][g * 1024 + f]; }
      v4u* zp = (v4u*)(ws + WS_WIN + (size_t)3232 * 1024);
      for (int i = gt; i < 96 * 1024 / 16; i += NGT) zp[i] = (v4u){0u, 0u, 0u, 0u};
    }
    LAS float* scr = (LAS float*)(lds + wave * 16640);
    constexpr int I0 = 16 * 51, I1 = 6 * 12, I2 = 4 * 8, I3 = 4 * 8, I4 = 256, I5 = 512, I6 = 256, SMALL = I0 + I1 + I2 + I3 + I4 + I5 + I6;
    constexpr int NGU = 64 * 512, NDN = 64 * 256, NITEMS = SMALL + NGU + NDN;
    convert_items(a, ws, scr, lane, B * NWAVES + wave, G * NWAVES, NGU + NDN, NITEMS);
}
__device__ __forceinline__ void convert_moe_share(const Args& a, LAS unsigned char* lds, int lane, int wave) {
    LAS float* scr = (LAS float*)(lds + wave * 16640);
    constexpr int NGU = 64 * 512, NDN = 64 * 256;
    convert_items(a, a.ws, scr, lane, blockIdx.x * NWAVES + wave, gridDim.x * NWAVES, 0, NGU + NDN);
}

__device__ __forceinline__ void phase_mod0(const Args& a, int lane, int wave) {
    const int gw = blockIdx.x * NWAVES + wave, NGW = gridDim.x * NWAVES;
    const float* modv = (const float*)(a.ws + WS_MODV);
    bf16* X = (bf16*)(a.ws + WS_X);
    f32x4 xv[2][4], xn[2][4];
#define MOD0_LOAD(dst, r0_) do { _Pragma("unroll") for (int q = 0; q < 2; ++q) { const int r = (r0_) + q; const int b = r / TPB, p = r - b * TPB; \
            const float* src = p < CTXL ? a.in[I_CTX] + ((size_t)b * CTXL + p) * 1024 : a.in[I_X] + ((size_t)b * SEQ + (p - CTXL)) * 1024; \
            _Pragma("unroll") for (int j = 0; j < 4; ++j) dst[q][j] = *(const f32x4*)(src + 4 * (lane + 64 * j)); } } while (0)
    if (2 * gw < NTOK) MOD0_LOAD(xv, 2 * gw);
    for (int r0 = 2 * gw; r0 < NTOK; r0 += 2 * NGW) {
        f32x4 shv[2][4], scv[2][4];
#pragma unroll
        for (int q = 0; q < 2; ++q) { const int r = r0 + q; const int b = r / TPB, p = r - b * TPB; const float* mvp = modv + (size_t)(p < CTXL ? 8 : b) * 6144;
#pragma unroll
            for (int j = 0; j < 4; ++j) { const int c = 4 * (lane + 64 * j); shv[q][j] = *(const f32x4*)(mvp + c); scv[q][j] = *(const f32x4*)(mvp + 1024 + c); } }
        if (r0 + 2 * NGW < NTOK) MOD0_LOAD(xn, r0 + 2 * NGW);
#pragma unroll
        for (int q = 0; q < 2; ++q)
#pragma unroll
            for (int j = 0; j < 4; ++j) { const int c = 4 * (lane + 64 * j); const f32x4 sh = shv[q][j], sc = scv[q][j];
                const f32x4 y = (xv[q][j] * (sc + 1.0f) + sh) * SC_A0; *(unsigned*)((unsigned char*)X + (size_t)(r0 + q) * 1024 + c) = pack_fp8x4(y[0], y[1], y[2], y[3]); }
#pragma unroll
        for (int q = 0; q < 2; ++q)
#pragma unroll
            for (int j = 0; j < 4; ++j) xv[q][j] = xn[q][j];
    }
#undef MOD0_LOAD
}

__device__ __forceinline__ void phase_norm0(const Args& a, int lane, int wave) {
    const int gw = blockIdx.x * NWAVES + wave, NGW = gridDim.x * NWAVES;
    const bf16* Z = (const bf16*)(a.ws + WS_Z); bf16* CQN = (bf16*)(a.ws + WS_CQN); bf16* CKVN = (bf16*)(a.ws + WS_CKVN); bf16* KRR = (bf16*)(a.ws + WS_KRR);
    const float* rope = (const float*)(a.ws + WS_ROPE);
    float gq[8], gk[8];
#pragma unroll
    for (int i = 0; i < 8; ++i) { gq[i] = lane < 48 ? a.in[I_QNORM][8 * lane + i] : 0.f; gk[i] = lane < 32 ? a.in[I_KVNORM][8 * lane + i] : 0.f; }
    bf16x8 q8 = {}, k8 = {}, r8 = {}, nq8 = {}, nk8 = {}, nr8 = {};
#define N0_LOAD(dq, dk, dr, r_) do { const bf16* z_ = Z + (size_t)(r_) * ZC; if (lane < 48) dq = *(const bf16x8*)(z_ + ZQ + 8 * lane); if (lane < 32) dk = *(const bf16x8*)(z_ + ZKV + 8 * lane); if (lane < 4) dr = *(const bf16x8*)(z_ + ZKR + 8 * lane); } while (0)
    if (gw < NTOK) N0_LOAD(q8, k8, r8, gw);
    for (int r = gw; r < NTOK; r += NGW, q8 = nq8, k8 = nk8, r8 = nr8) {
        const int p = r % TPB;
        if (r + NGW < NTOK) N0_LOAD(nq8, nk8, nr8, r + NGW);
        float qf[8], kf[8], sq = 0.f, sk = 0.f;
#pragma unroll
        for (int i = 0; i < 8; ++i) { qf[i] = bf2f((unsigned short)q8[i]); kf[i] = bf2f((unsigned short)k8[i]); sq += qf[i] * qf[i]; sk += kf[i] * kf[i]; }
        sq = wave_sum(sq); sk = wave_sum(sk);
        const float rq = rsqrtf(sq * (1.f / 384.f) + RMS_EPS), rk = rsqrtf(sk * (1.f / 256.f) + RMS_EPS);
        if (lane < 48) { v4u o; o.x = pk2(qf[0] * rq * gq[0], qf[1] * rq * gq[1]); o.y = pk2(qf[2] * rq * gq[2], qf[3] * rq * gq[3]); o.z = pk2(qf[4] * rq * gq[4], qf[5] * rq * gq[5]); o.w = pk2(qf[6] * rq * gq[6], qf[7] * rq * gq[7]);
            *(v4u*)(CQN + (size_t)r * 384 + 8 * lane) = o; }
        if (lane < 32) { v4u o; o.x = pk2(kf[0] * rk * gk[0], kf[1] * rk * gk[1]); o.y = pk2(kf[2] * rk * gk[2], kf[3] * rk * gk[3]); o.z = pk2(kf[4] * rk * gk[4], kf[5] * rk * gk[5]); o.w = pk2(kf[6] * rk * gk[6], kf[7] * rk * gk[7]);
            *(v4u*)(CKVN + (size_t)r * 256 + 8 * lane) = o; }
        if (lane < 4) { bf16x8 o8 = r8; if (p >= CTXL) o8 = att::rope8(r8, rope + (size_t)(p - CTXL) * 32, 4 * lane); *(bf16x8*)(KRR + (size_t)r * 32 + 8 * lane) = o8; }
    }
#undef N0_LOAD
}

__device__ __forceinline__ void hgrn_unit(const Args& a, int unit, LAS unsigned char* lds, int tid) {
    const int b = unit >> 5, head = (unit >> 3) & 3, dir = (unit >> 2) & 1, sl = unit & 3;
    const bf16* Z = (const bf16*)(a.ws + WS_Z);
    float* Od = (float*)(a.ws + (dir ? WS_OB : WS_OF));
    LAS float* lbv = (LAS float*)lds;
    constexpr int BUF0 = 1024, BUFSZ = 28672, OFF_Q = 16384, OFF_V = 24576;
    if (tid < 128) { const int c = head * 128 + tid; const float l0 = a.in[I_LBL][c], l1 = a.in[I_LBL][512 + c], l2 = a.in[I_LBL][1024 + c]; const float m = fmaxf(l0, fmaxf(l1, l2));
        const float e0 = __expf(l0 - m), e1 = __expf(l1 - m), e2 = __expf(l2 - m); lbv[tid] = e0 / (e0 + e1 + e2); }
    __syncthreads();
    const int lt = tid >> 4, lcg = tid & 15;
    float lb8[8];
#pragma unroll
    for (int i = 0; i < 8; ++i) lb8[i] = lbv[8 * lcg + i];
    const int fcol = (dir ? ZHB : ZHF) + head * 128 + 8 * lcg, qcol = ZHQ + head * 128 + 8 * lcg;
    const int vt = tid >> 2, vcol = ZHI + head * 128 + sl * 32 + (tid & 3) * 8;
    const int wave = tid >> 6, lane = tid & 63, vv = lane >> 4, cg = lane & 15, vloc = wave * 4 + vv;
    const size_t zb = (size_t)b * TPB;
    bf16x8 rq, rf, rv;
#define TOKP(n) (dir ? ((n) < CTXL ? (CTXL - 1 - (n)) : (TPB + CTXL - 1 - (n))) : (n))
#define HG_LOAD(i) do { const int n_ = 32 * (i) + lt; const bf16* zr_ = Z + (zb + TOKP(n_)) * ZC; rq = *(const bf16x8*)(zr_ + qcol); rf = *(const bf16x8*)(zr_ + fcol); \
        if (tid < 128) { const int n2_ = 32 * (i) + vt; rv = *(const bf16x8*)(Z + (zb + TOKP(n2_)) * ZC + vcol); } } while (0)
#define HG_WRITE(bufi) do { LAS unsigned char* bp_ = lds + BUF0 + (bufi) * BUFSZ; float f_[8]; \
        _Pragma("unroll") for (int i_ = 0; i_ < 8; ++i_) f_[i_] = lb8[i_] + (1.f - lb8[i_]) * sigm(bf2f((unsigned short)rf[i_])); \
        *(LAS f32x4*)(bp_ + ((lt * 128 + lcg * 4) * 4)) = (f32x4){f_[0], f_[1], f_[2], f_[3]}; *(LAS f32x4*)(bp_ + ((lt * 128 + 64 + lcg * 4) * 4)) = (f32x4){f_[4], f_[5], f_[6], f_[7]}; \
        *(LAS bf16x8*)(bp_ + OFF_Q + (lt * 128 + lcg * 8) * 2) = rq; \
        if (tid < 128) { float v_[8]; _Pragma("unroll") for (int i_ = 0; i_ < 8; ++i_) v_[i_] = bf2f((unsigned short)rv[i_]); \
            *(LAS f32x4*)(bp_ + OFF_V + (vt * 32 + (tid & 3) * 8) * 4) = (f32x4){v_[0], v_[1], v_[2], v_[3]}; *(LAS f32x4*)(bp_ + OFF_V + (vt * 32 + (tid & 3) * 8 + 4) * 4) = (f32x4){v_[4], v_[5], v_[6], v_[7]}; } } while (0)
    float S[8];
#pragma unroll
    for (int j = 0; j < 8; ++j) S[j] = 0.f;
    HG_LOAD(0); HG_WRITE(0); __syncthreads();
    const bool b3 = (cg & 8) != 0, b2 = (cg & 4) != 0, b1 = (cg & 2) != 0, b0 = (cg & 1) != 0;
    for (int i = 0; i < TPB / 32; ++i) {
        if (i + 1 < TPB / 32) HG_LOAD(i + 1);
        const LAS unsigned char* bp = lds + BUF0 + (i & 1) * BUFSZ;
#pragma unroll 1
        for (int g = 0; g < 4; ++g) {
            const LAS unsigned char* gp = bp + g * 8 * 512;
            float ot[8];
#pragma unroll
            for (int t = 0; t < 8; ++t) {
                const f32x4 f0 = *(const LAS f32x4*)(gp + ((t * 128 + cg * 4) * 4)), f1 = *(const LAS f32x4*)(gp + ((t * 128 + 64 + cg * 4) * 4));
                const bf16x8 q8 = *(const LAS bf16x8*)(bp + OFF_Q + ((g * 8 + t) * 128 + cg * 8) * 2);
                const float v = *(const LAS float*)(bp + OFF_V + ((g * 8 + t) * 32 + vloc) * 4);
                float acc = 0.f;
#pragma unroll
                for (int j = 0; j < 8; ++j) { const float fj = j < 4 ? f0[j] : f1[j - 4]; const float qj = bf2f((unsigned short)q8[j]);
                    const float kv = fmaf(-fj, v, v); S[j] = fmaf(fj, S[j], kv); acc = fmaf(S[j], qj, acc); }
                ot[t] = acc;
            }
#pragma unroll
            for (int k = 0; k < 4; ++k) { const float snd = b3 ? ot[k] : ot[k + 4]; const float rcv = __shfl_xor(snd, 8); ot[k] = (b3 ? ot[k + 4] : ot[k]) + rcv; }
#pragma unroll
            for (int k = 0; k < 2; ++k) { const float snd = b2 ? ot[k] : ot[k + 2]; const float rcv = __shfl_xor(snd, 4); ot[k] = (b2 ? ot[k + 2] : ot[k]) + rcv; }
            { const float snd = b1 ? ot[0] : ot[1]; const float rcv = __shfl_xor(snd, 2); ot[0] = (b1 ? ot[1] : ot[0]) + rcv; }
            ot[0] += __shfl_xor(ot[0], 1);
            if (!b0) { const int n = 32 * i + 8 * g + (cg >> 1); const int p = TOKP(n); if (p >= CTXL) Od[(zb + p) * 512 + head * 128 + sl * 32 + vloc] = ot[0]; }
        }
        if (i + 1 < TPB / 32) HG_WRITE((i + 1) & 1);
        __syncthreads();
    }
#undef TOKP
#undef HG_LOAD
#undef HG_WRITE
}

__device__ __forceinline__ void phase_readout(const Args& a, int lane, int wave) {
    const int gw = blockIdx.x * NWAVES + wave, NGW = gridDim.x * NWAVES;
    const bf16* OF = (const bf16*)(a.ws + WS_OF); const bf16* OB = (const bf16*)(a.ws + WS_OB);
    const bf16* Z = (const bf16*)(a.ws + WS_Z); bf16* MIX = (bf16*)(a.ws + WS_Y);
    float hn[8];
#pragma unroll
    for (int i = 0; i < 8; ++i) hn[i] = a.in[I_HGNORM][((8 * lane) & 127) + i];
    bf16x8 a8 = {}, c8 = {}, g8 = {}, na8 = {}, nc8 = {}, ng8 = {};
#define RO_LOAD(da, dc, dg, lr_) do { const size_t r_ = (size_t)grow_of(lr_); da = *(const bf16x8*)(OF + r_ * 512 + 8 * lane); dc = *(const bf16x8*)(OB + r_ * 512 + 8 * lane); dg = *(const bf16x8*)(Z + r_ * ZC + ZHG + 8 * lane); } while (0)
    if (gw < NLAT) RO_LOAD(a8, c8, g8, gw);
    for (int lr = gw; lr < NLAT; lr += NGW, a8 = na8, c8 = nc8, g8 = ng8) {
        const size_t r = (size_t)grow_of(lr);
        if (lr + NGW < NLAT) RO_LOAD(na8, nc8, ng8, lr + NGW);
        float o[8]; float ss = 0.f;
#pragma unroll
        for (int i = 0; i < 8; ++i) o[i] = bf2f((unsigned short)a8[i]) + bf2f((unsigned short)c8[i]);
#pragma unroll
        for (int i = 0; i < 8; ++i) ss += o[i] * o[i];
        ss += __shfl_xor(ss, 1); ss += __shfl_xor(ss, 2); ss += __shfl_xor(ss, 4); ss += __shfl_xor(ss, 8);
        const float rs = rsqrtf(ss * (1.f / 128.f) + RMS_EPS);
        float y[8];
#pragma unroll
        for (int i = 0; i < 8; ++i) { const float g = bf2f((unsigned short)g8[i]); y[i] = o[i] * rs * hn[i] * (g * sigm(g)); }
        v4u w; w.x = pk2(y[0], y[1]); w.y = pk2(y[2], y[3]); w.z = pk2(y[4], y[5]); w.w = pk2(y[6], y[7]);
        *(v4u*)(MIX + r * 1024 + 512 + 8 * lane) = w;
    }
#undef RO_LOAD
}

__device__ __forceinline__ int rows_per_block() { const int G = gridDim.x; return (((NLAT + G - 1) / G) + 15) & ~15; }
__device__ __forceinline__ void phase_ln1(const Args& a, int l, LAS unsigned char* lds, int tid, int lane, int wave) {
    typedef short bf16x8s __attribute__((ext_vector_type(8)));
    const int RB = rows_per_block(), lr_base = blockIdx.x * RB;
    const bf16* PRE = (const bf16*)(a.ws + WS_PRE); bf16* XB = (bf16*)(a.ws + WS_X);
    const float* modv = (const float*)(a.ws + WS_MODV) + (size_t)l * 9 * 6144;
    const float* lng = a.in[I_LN1G] + l * 1024; const float* lnb = a.in[I_LN1B] + l * 1024;
    const float* rw = a.in[I_RW] + (size_t)l * 1024 * 32; const float* rb = a.in[I_RB] + l * 32;
    constexpr int XT_LD = 1028, O_PART = 16 * XT_LD * 4, O_LG = O_PART + 8 * 32 * 16 * 4, O_HIST = O_LG + 16 * 33 * 4 + 64, O_CCNT = O_HIST + 256, O_TIL = O_CCNT + 2048, O_TWL = O_TIL + 4096;
    LAS float* XT = (LAS float*)lds; LAS float* PART = (LAS float*)(lds + O_PART); LAS float* LG = (LAS float*)(lds + O_LG);
    LAS int* hist = (LAS int*)(lds + O_HIST);
    LAS int* ccnt = (LAS int*)(lds + O_CCNT);
    LAS int* til = (LAS int*)(lds + O_TIL);
    LAS float* twl = (LAS float*)(lds + O_TWL);
    __syncthreads();
    if (tid < 32) hist[tid] = 0;
    bf16x8s whi[2][4], wlo[2][4];
    { const int e15 = lane & 15, kq = lane >> 4;
#pragma unroll
      for (int t = 0; t < 2; ++t)
#pragma unroll
          for (int sI = 0; sI < 4; ++sI) { float wv[8];
#pragma unroll
              for (int j = 0; j < 8; ++j) wv[j] = rw[(size_t)(128 * wave + 32 * sI + 8 * kq + j) * 32 + 16 * t + e15];
              v4u ph, pl;
#pragma unroll
              for (int j = 0; j < 4; ++j) { const unsigned p = pk2(wv[2 * j], wv[2 * j + 1]); const float h0 = __uint_as_float(p << 16), h1 = __uint_as_float(p & 0xffff0000u); ph[j] = p; pl[j] = pk2(wv[2 * j] - h0, wv[2 * j + 1] - h1); }
              whi[t][sI] = __builtin_bit_cast(bf16x8s, ph); wlo[t][sI] = __builtin_bit_cast(bf16x8s, pl); } }
    const int ngroups = RB / 16;
    f32x4 fP[4], fQ[4]; int fb = -1;
    const float rbias = rb[tid >> 4];
    v2u xr[2][4];
#define LN1_LOAD(g) do { _Pragma("unroll") for (int rr_ = 0; rr_ < 2; ++rr_) { const int lr_ = lr_base + 16 * (g) + 2 * wave + rr_; const size_t r_ = (size_t)grow_of(lr_ < NLAT ? lr_ : NLAT - 1); \
        _Pragma("unroll") for (int j_ = 0; j_ < 4; ++j_) xr[rr_][j_] = *(const v2u*)(PRE + r_ * 1024 + 4 * (lane + 64 * j_)); } } while (0)
#if defined(PROBE_LN1X2)
    for (int rep_ = 0; rep_ < 2; ++rep_) { __syncthreads(); if (tid < 32) hist[tid] = 0; __syncthreads();
#endif
    LN1_LOAD(0);
    for (int g = 0; g < ngroups; ++g) {
#pragma unroll
        for (int rr = 0; rr < 2; ++rr) {
            const int lr = lr_base + 16 * g + 2 * wave + rr; const bool ok = lr < NLAT; const size_t r = (size_t)grow_of(ok ? lr : NLAT - 1); const int b = (ok ? lr : NLAT - 1) >> 12;
            if (b != fb) { const float* mv = modv + (size_t)b * 6144; fb = b;
#pragma unroll
                for (int j = 0; j < 4; ++j) { const int c = 4 * (lane + 64 * j); const f32x4 gg = *(const f32x4*)(lng + c), bb = *(const f32x4*)(lnb + c), sh = *(const f32x4*)(mv + 3 * 1024 + c), sc = *(const f32x4*)(mv + 4 * 1024 + c);
                    fP[j] = gg * (sc + 1.0f); fQ[j] = bb * (sc + 1.0f) + sh; } }
            f32x4 x[4]; float s = 0.f;
#pragma unroll
            for (int j = 0; j < 4; ++j) { const v2u p = xr[rr][j]; x[j] = (f32x4){__uint_as_float(p.x << 16), __uint_as_float(p.x & 0xffff0000u), __uint_as_float(p.y << 16), __uint_as_float(p.y & 0xffff0000u)}; s += (x[j][0] + x[j][1]) + (x[j][2] + x[j][3]); }
            const float mean = wave_sum(s) * (1.f / 1024.f); float s2 = 0.f;
#pragma unroll
            for (int j = 0; j < 4; ++j) { x[j] = x[j] - mean; s2 += (x[j][0] * x[j][0] + x[j][1] * x[j][1]) + (x[j][2] * x[j][2] + x[j][3] * x[j][3]); }
            const float rstd = rsqrtf(wave_sum(s2) * (1.f / 1024.f) + LN_EPS);
#pragma unroll
            for (int j = 0; j < 4; ++j) { const int c = 4 * (lane + 64 * j);
                const f32x4 bm = (x[j] * rstd) * fP[j] + fQ[j];
                if (ok) *(unsigned*)((unsigned char*)XB + r * 1024 + c) = pack_fp8x4(bm[0] * SC_X8, bm[1] * SC_X8, bm[2] * SC_X8, bm[3] * SC_X8);
                *(LAS f32x4*)(XT + (2 * wave + rr) * XT_LD + c) = bm; }
        }
        if (g + 1 < ngroups) LN1_LOAD(g + 1);
        __syncthreads();
        { const int rr = lane & 15, kq = lane >> 4;
          f32x4 acc0 = {0.f, 0.f, 0.f, 0.f}, acc1 = {0.f, 0.f, 0.f, 0.f};
#pragma unroll
          for (int sI = 0; sI < 4; ++sI) { const LAS float* xp = XT + rr * XT_LD + 128 * wave + 32 * sI + 8 * kq; const f32x4 v0 = *(const LAS f32x4*)xp, v1 = *(const LAS f32x4*)(xp + 4);
              const float bv[8] = {v0[0], v0[1], v0[2], v0[3], v1[0], v1[1], v1[2], v1[3]}; v4u ph, pl;
#pragma unroll
              for (int j = 0; j < 4; ++j) { const unsigned p = pk2(bv[2 * j], bv[2 * j + 1]); const float h0 = __uint_as_float(p << 16), h1 = __uint_as_float(p & 0xffff0000u); ph[j] = p; pl[j] = pk2(bv[2 * j] - h0, bv[2 * j + 1] - h1); }
              const bf16x8s bh = __builtin_bit_cast(bf16x8s, ph), bl = __builtin_bit_cast(bf16x8s, pl);
              acc0 = __builtin_amdgcn_mfma_f32_16x16x32_bf16(whi[0][sI], bh, acc0, 0, 0, 0); acc0 = __builtin_amdgcn_mfma_f32_16x16x32_bf16(whi[0][sI], bl, acc0, 0, 0, 0); acc0 = __builtin_amdgcn_mfma_f32_16x16x32_bf16(wlo[0][sI], bh, acc0, 0, 0, 0);
              acc1 = __builtin_amdgcn_mfma_f32_16x16x32_bf16(whi[1][sI], bh, acc1, 0, 0, 0); acc1 = __builtin_amdgcn_mfma_f32_16x16x32_bf16(whi[1][sI], bl, acc1, 0, 0, 0); acc1 = __builtin_amdgcn_mfma_f32_16x16x32_bf16(wlo[1][sI], bh, acc1, 0, 0, 0); }
#pragma unroll
          for (int q = 0; q < 4; ++q) { PART[(wave * 32 + 4 * kq + q) * 16 + rr] = acc0[q]; PART[(wave * 32 + 16 + 4 * kq + q) * 16 + rr] = acc1[q]; } }
        __syncthreads();
        { const int e = tid >> 4, rr = tid & 15; float sacc = rbias;
#pragma unroll
          for (int w = 0; w < 8; ++w) sacc += PART[(w * 32 + e) * 16 + rr];
          LG[rr * 33 + e] = sacc; }
        __syncthreads();
        if (wave == (g & 7) && lane < 16) { const int lr = lr_base + 16 * g + lane;
            if (lr < NLAT) { float lg[32];
#pragma unroll
                for (int e = 0; e < 32; ++e) lg[e] = LG[lane * 33 + e];
                unsigned taken = 0u; float tv[4]; int ti[4];
#pragma unroll
                for (int kk = 0; kk < 4; ++kk) { float best = -3.0e38f; int bi = 0;
#pragma unroll
                    for (int e = 0; e < 32; ++e) { const bool okk = (lg[e] > best) && !((taken >> e) & 1u); best = okk ? lg[e] : best; bi = okk ? e : bi; }
                    taken |= 1u << bi; tv[kk] = best; ti[kk] = bi; }
                const float e1 = __expf(tv[1] - tv[0]), e2 = __expf(tv[2] - tv[0]), e3 = __expf(tv[3] - tv[0]); const float inv = 1.f / (1.f + e1 + e2 + e3);
                const int li = (16 * g + lane) * 4; til[li] = ti[0]; til[li + 1] = ti[1]; til[li + 2] = ti[2]; til[li + 3] = ti[3]; twl[li] = inv; twl[li + 1] = e1 * inv; twl[li + 2] = e2 * inv; twl[li + 3] = e3 * inv;
                __hip_atomic_fetch_add(hist + ti[0], 1, __ATOMIC_RELAXED, __HIP_MEMORY_SCOPE_WORKGROUP); __hip_atomic_fetch_add(hist + ti[1], 1, __ATOMIC_RELAXED, __HIP_MEMORY_SCOPE_WORKGROUP);
                __hip_atomic_fetch_add(hist + ti[2], 1, __ATOMIC_RELAXED, __HIP_MEMORY_SCOPE_WORKGROUP); __hip_atomic_fetch_add(hist + ti[3], 1, __ATOMIC_RELAXED, __HIP_MEMORY_SCOPE_WORKGROUP); } }
    }
#if defined(PROBE_LN1X2)
    }
#endif
#undef LN1_LOAD
    __syncthreads();
    int* cursor = (int*)(a.ws + WS_CURSOR) + l * 32;
    int* rows = (int*)(a.ws + WS_ROWS); float* roww = (float*)(a.ws + WS_ROWW); int* rowd = (int*)(a.ws + WS_ROWD);
    int nrows = NLAT - lr_base; nrows = nrows > RB ? RB : nrows; if (nrows < 0) nrows = 0;
    const int nas = nrows * 4, nchunks = (nas + 63) >> 6;
    int basev = 0; if (tid < 32) basev = (int)__hip_atomic_fetch_add((unsigned*)cursor + tid, (unsigned)hist[tid], __ATOMIC_RELAXED, __HIP_MEMORY_SCOPE_AGENT);
    int myrank[2] = {0, 0}, mye[2] = {-1, -1};
#pragma unroll
    for (int cc = 0; cc < 2; ++cc) { const int c = wave + 8 * cc; if (c < nchunks) { const int idx = c * 64 + lane; const int e = idx < nas ? til[idx] : -1; mye[cc] = e;
        for (int x = 0; x < 32; ++x) { const unsigned long long m = __ballot(e == x); if (e == x) myrank[cc] = __popcll(m & ((1ull << lane) - 1ull)); if (lane == 0) ccnt[c * 32 + x] = __popcll(m); } } }
    __syncthreads();
    if (tid < 32) hist[32 + tid] = basev;
    __syncthreads();
#pragma unroll
    for (int cc = 0; cc < 2; ++cc) { const int c = wave + 8 * cc; const int idx = c * 64 + lane; if (c < nchunks && idx < nas) { const int e = mye[cc]; int pos = hist[32 + e] + myrank[cc]; for (int c2 = 0; c2 < c; ++c2) pos += ccnt[c2 * 32 + e];
        const int lr = lr_base + (idx >> 2); const size_t pi = (size_t)e * ECAP + pos; rows[pi] = grow_of(lr); roww[pi] = twl[idx]; rowd[pi] = lr * 4 + (idx & 3); } }
}

__device__ __forceinline__ void phase_ln2(const Args& a, int l, int lane, int wave) {
    const int gw = blockIdx.x * NWAVES + wave, NGW = gridDim.x * NWAVES;
    float* H = (float*)(a.ws + WS_H); const bf16* PRE = (const bf16*)(a.ws + WS_PRE); const unsigned char* YB = (const unsigned char*)(a.ws + WS_YB); bf16* A1 = (bf16*)(a.ws + WS_Y);
    const float* modv = (const float*)(a.ws + WS_MODV);
    const float* ln1g = a.in[I_LN1G] + l * 1024; const float* ln1b = a.in[I_LN1B] + l * 1024;
    const float* lng = a.in[I_LN2G] + l * 1024; const float* lnb = a.in[I_LN2B] + l * 1024;
    f32x4 P1[4], Q1[4], G2[4], g2v[4], b2v[4], P3[4], Q3[4]; int fb = -1;
    const int rows_w = (((NLAT + NGW - 1) / NGW) + 1) & ~1, lr_lo = gw * rows_w, lr_hi = lr_lo + rows_w < NLAT ? lr_lo + rows_w : NLAT;
    for (int lr0 = lr_lo; lr0 < lr_hi; lr0 += 2) {
        v2u hv[2][4]; unsigned yv[2][4][4];
#pragma unroll
        for (int q = 0; q < 2; ++q) { const int lr = lr0 + q; const size_t r = (size_t)grow_of(lr);
#pragma unroll
            for (int j = 0; j < 4; ++j) { const int c = 4 * (lane + 64 * j); hv[q][j] = *(const v2u*)(PRE + r * 1024 + c);
#pragma unroll
                for (int k = 0; k < 4; ++k) yv[q][j][k] = *(const unsigned*)(YB + ((size_t)lr * 4 + k) * 1024 + c); } }
#pragma unroll
        for (int q = 0; q < 2; ++q) {
            const int lr = lr0 + q; const size_t r = (size_t)grow_of(lr); const int b = lr >> 12;
            if (b != fb) { fb = b; const float* mv = modv + ((size_t)l * 9 + b) * 6144; const float* mv1 = modv + ((size_t)9 + b) * 6144;
#pragma unroll
                for (int j = 0; j < 4; ++j) { const int c = 4 * (lane + 64 * j); const f32x4 g1 = *(const f32x4*)(ln1g + c), b1 = *(const f32x4*)(ln1b + c), gt = *(const f32x4*)(mv + 5 * 1024 + c);
                    P1[j] = g1 * ALPHA; Q1[j] = b1 * ALPHA; G2[j] = gt * (1.f / SC_Y); g2v[j] = *(const f32x4*)(lng + c); b2v[j] = *(const f32x4*)(lnb + c);
                    if (l == 0) { const f32x4 sh = *(const f32x4*)(mv1 + c), sc = *(const f32x4*)(mv1 + 1024 + c); P3[j] = g2v[j] * (sc + 1.0f) * SC_A1; Q3[j] = (b2v[j] * (sc + 1.0f) + sh) * SC_A1; } } }
            f32x4 x[4]; float s = 0.f;
#pragma unroll
            for (int j = 0; j < 4; ++j) { const v2u p = hv[q][j]; x[j] = (f32x4){__uint_as_float(p.x << 16), __uint_as_float(p.x & 0xffff0000u), __uint_as_float(p.y << 16), __uint_as_float(p.y & 0xffff0000u)}; s += (x[j][0] + x[j][1]) + (x[j][2] + x[j][3]); }
            float mean = wave_sum(s) * (1.f / 1024.f), s2 = 0.f;
#pragma unroll
            for (int j = 0; j < 4; ++j) { x[j] = x[j] - mean; s2 += (x[j][0] * x[j][0] + x[j][1] * x[j][1]) + (x[j][2] * x[j][2] + x[j][3] * x[j][3]); }
            float rstd = rsqrtf(wave_sum(s2) * (1.f / 1024.f) + LN_EPS);
            s = 0.f;
#pragma unroll
            for (int j = 0; j < 4; ++j) { f32x4 f = {0.f, 0.f, 0.f, 0.f};
#pragma unroll
                for (int k = 0; k < 4; ++k) { const unsigned y = yv[q][j][k]; const auto lo = __builtin_amdgcn_cvt_pk_f32_fp8((int)y, false), hi = __builtin_amdgcn_cvt_pk_f32_fp8((int)y, true);
                    f[0] += lo[0]; f[1] += lo[1]; f[2] += hi[0]; f[3] += hi[1]; }
                x[j] = (x[j] * rstd) * P1[j] + Q1[j] + G2[j] * f; s += (x[j][0] + x[j][1]) + (x[j][2] + x[j][3]); }
            mean = wave_sum(s) * (1.f / 1024.f); s2 = 0.f;
#pragma unroll
            for (int j = 0; j < 4; ++j) { x[j] = x[j] - mean; s2 += (x[j][0] * x[j][0] + x[j][1] * x[j][1]) + (x[j][2] * x[j][2] + x[j][3] * x[j][3]); }
            rstd = rsqrtf(wave_sum(s2) * (1.f / 1024.f) + LN_EPS);
#pragma unroll
            for (int j = 0; j < 4; ++j) { const int c = 4 * (lane + 64 * j); const f32x4 xh = x[j] * rstd;
                const f32x4 o = xh * g2v[j] + b2v[j];
                if (l == 0) { v2u hw; hw.x = pk2(o[0], o[1]); hw.y = pk2(o[2], o[3]); *(v2u*)((bf16*)H + r * 1024 + c) = hw;
                    const f32x4 am = xh * P3[j] + Q3[j]; *(unsigned*)((unsigned char*)A1 + r * 1024 + c) = pack_fp8x4(am[0], am[1], am[2], am[3]); }
                else *(f32x4*)(a.out + (size_t)lr * 1024 + c) = o; }
        }
    }
}

__device__ __forceinline__ void phase_conv(const Args& a, LAS unsigned char* lds, int tid, int lane, int wave) {
    const bf16* U = (const bf16*)(a.ws + WS_X); bf16* V = (bf16*)(a.ws + WS_Y);
    LAS float* part = (LAS float*)(lds + 126976);
    LAS float* st = part + 512;
    const int c0 = 2 * tid;
    const float db0 = a.in[I_DWB][c0], db1 = a.in[I_DWB][c0 + 1], g0 = a.in[I_CLNG][c0], g1 = a.in[I_CLNG][c0 + 1], be0 = a.in[I_CLNB][c0], be1 = a.in[I_CLNB][c0 + 1];
    for (int tile = blockIdx.x; tile < NLAT / 32; tile += gridDim.x) {
        const int b = tile >> 7, t0 = (tile & 127) * 32;
        const size_t rb0 = (size_t)b * TPB + CTXL;
        __syncthreads();
        for (int i = tid; i < 62 * 128; i += NTHR) { const int row = i >> 7, chk = i & 127, t = t0 - 15 + row;
            v4u val = {0u, 0u, 0u, 0u}; if (t >= 0 && t < SEQ) val = *(const v4u*)(U + (rb0 + t) * 1024 + chk * 8);
            *(LAS v4u*)(lds + row * 2048 + chk * 16) = val; }
        __syncthreads();
        float w0[31], w1[31];
#pragma unroll
        for (int j = 0; j < 31; ++j) { const float2 wv = *(const float2*)(a.in[I_DWW] + j * 1024 + c0); w0[j] = wv.x; w1[j] = wv.y; }
#pragma unroll 1
        for (int hh = 0; hh < 2; ++hh) {
            const LAS unsigned char* hp = lds + hh * 16 * 2048;
            float acc0[16], acc1[16];
#pragma unroll
            for (int t = 0; t < 16; ++t) { acc0[t] = db0; acc1[t] = db1; }
#pragma unroll
            for (int s = 0; s < 46; ++s) { const unsigned pr = *(const LAS unsigned*)(hp + s * 2048 + tid * 4); const float x0 = __uint_as_float(pr << 16), x1 = __uint_as_float(pr & 0xffff0000u);
#pragma unroll
                for (int t = (s > 30 ? s - 30 : 0); t <= (s < 15 ? s : 15); ++t) { acc0[t] = fmaf(x0, w0[s - t], acc0[t]); acc1[t] = fmaf(x1, w1[s - t], acc1[t]); } }
            float rs[32];
#pragma unroll
            for (int t = 0; t < 16; ++t) { rs[2 * t] = acc0[t] + acc1[t]; rs[2 * t + 1] = acc0[t] * acc0[t] + acc1[t] * acc1[t]; }
#define RS_STEP(NKEEP, XORV) { const bool bit_ = (lane & XORV) != 0; _Pragma("unroll") for (int k_ = 0; k_ < NKEEP; ++k_) { const float snd_ = bit_ ? rs[k_] : rs[k_ + NKEEP]; const float rcv_ = __shfl_xor(snd_, XORV); rs[k_] = (bit_ ? rs[k_ + NKEEP] : rs[k_]) + rcv_; } }
            RS_STEP(16, 32) RS_STEP(8, 16) RS_STEP(4, 8) RS_STEP(2, 4) RS_STEP(1, 2)
#undef RS_STEP
            rs[0] += __shfl_xor(rs[0], 1);
            __syncthreads();
            if ((lane & 1) == 0) part[wave * 32 + (lane >> 1)] = rs[0];
            __syncthreads();
            if (tid < 16) { float s1 = 0.f, s2 = 0.f;
#pragma unroll
                for (int w = 0; w < 8; ++w) { s1 += part[w * 32 + 2 * tid]; s2 += part[w * 32 + 2 * tid + 1]; }
                const float mean = s1 * (1.f / 1024.f); const float var = fmaxf(s2 * (1.f / 1024.f) - mean * mean, 0.f); st[2 * tid] = mean; st[2 * tid + 1] = rsqrtf(var + LN_EPS); }
            __syncthreads();
#pragma unroll
            for (int t = 0; t < 16; ++t) { const float mean = st[2 * t], rstd = st[2 * t + 1];
                const float y0 = (acc0[t] - mean) * rstd * g0 + be0, y1 = (acc1[t] - mean) * rstd * g1 + be1;
                const float z0 = fminf(fmaxf(y0 * sigm(y0) * SC_CV, -448.f), 448.f), z1 = fminf(fmaxf(y1 * sigm(y1) * SC_CV, -448.f), 448.f);
                *(unsigned short*)((unsigned char*)V + (rb0 + t0 + hh * 16 + t) * 1024 + c0) = (unsigned short)__builtin_amdgcn_cvt_pk_fp8_f32(z0, z1, 0, false); }
        }
    }
}

namespace hg {
using bf16x8 = __attribute__((ext_vector_type(8))) short;
using s16x4  = __attribute__((ext_vector_type(4))) short;
using f32x16 = __attribute__((ext_vector_type(16))) float;
using u32x4  = __attribute__((ext_vector_type(4))) unsigned;
constexpr int RS = 272;
constexpr int VS = 80;
constexpr int T_Q = 0, T_KO = 32 * RS, T_KE = 64 * RS, T_D = 96 * RS, IMG_BYTES = T_D + 512, T_V = IMG_BYTES, TILE_BYTES = T_V + 32 * VS;
constexpr int OFF_TILES = 1024, NTB = 3, OFF_OPART = OFF_TILES + NTB * TILE_BYTES, OPART_BYTES = 4 * 4096;
static_assert(OFF_OPART + 2 * OPART_BYTES <= 131072 && IMG_BYTES % 16 == 0 && IMG_BYTES / 16 == 1664, "hgrn lds");
constexpr int P_RAW = 1024, R_Q = 0, R_F = 32 * RS, RAW_BYTES = 64 * RS, P_IMG = P_RAW + RAW_BYTES;
constexpr int NCHUNK = TPB / 32, NCHAIN = NB * 4 * 2, NITEM = NCHAIN * NCHUNK;
__device__ __forceinline__ int crow(int r, int hi) { return (r & 3) + 8 * (r >> 2) + 4 * hi; }
__device__ __forceinline__ s16x4 tr_read(unsigned addr) { s16x4 r; asm volatile("ds_read_b64_tr_b16 %0, %1" : "=&v"(r) : "v"(addr) : "memory"); return r; }
__device__ __forceinline__ bf16x8 cat8(s16x4 l, s16x4 h) { return (bf16x8){l[0], l[1], l[2], l[3], h[0], h[1], h[2], h[3]}; }
__device__ __forceinline__ bf16x8 pack8(const f32x16& x, int base) {
    u32x4 w; w[0] = pk2(x[base + 0], x[base + 1]); w[1] = pk2(x[base + 2], x[base + 3]); w[2] = pk2(x[base + 4], x[base + 5]); w[3] = pk2(x[base + 6], x[base + 7]);
    return *reinterpret_cast<bf16x8*>(&w);
}
}


#define HG_TOKP(dir, n) ((dir) ? ((n) < CTXL ? (CTXL - 1 - (n)) : (TPB + CTXL - 1 - (n))) : (n))
#define HG_DPP1(x, ctrl, rmask) __int_as_float(__builtin_amdgcn_update_dpp(0x3f800000, __float_as_int(x), ctrl, rmask, 0xf, false))
#define HG_DPP(x, ctrl, rmask) __int_as_float(__builtin_amdgcn_update_dpp(0, __float_as_int(x), ctrl, rmask, 0xf, false))
__device__ __forceinline__ void hgrn_prep_items(const Args& a, LAS unsigned char* lds, int tid) {
    using namespace hg;
    const bf16* Z = (const bf16*)(a.ws + WS_Z);
    unsigned char* HT = a.ws + WS_HT;
    const int wave = __builtin_amdgcn_readfirstlane(tid >> 6), lane = tid & 63, t = lane & 31, half = lane >> 5;
    const int c0 = 16 * wave + 8 * half;
    const int lr = tid >> 4, lch = tid & 15;
    LAS float* lbt = (LAS float*)lds;
    constexpr int P_RAW2 = 2048, P_IMG2 = P_RAW2 + 2 * RAW_BYTES;
    static_assert(P_IMG2 + 2 * IMG_BYTES <= 131072, "prep lds");
    __syncthreads();
    { const float l0 = a.in[I_LBL][tid], l1 = a.in[I_LBL][512 + tid], l2 = a.in[I_LBL][1024 + tid]; const float m = fmaxf(l0, fmaxf(l1, l2));
      const float e0 = __expf(l0 - m), e1 = __expf(l1 - m), e2 = __expf(l2 - m); lbt[tid] = e0 / (e0 + e1 + e2); }
    bf16x8 gq, gf;
#define HP_LOAD(it) do { const int ch_ = (it) % NCHUNK, cn_ = (it) / NCHUNK, dir_ = cn_ & 1, hd_ = (cn_ >> 1) & 3, b_ = cn_ >> 3; \
        const bf16* zr_ = Z + ((size_t)b_ * TPB + HG_TOKP(dir_, 32 * ch_ + lr)) * ZC; gq = *(const bf16x8*)(zr_ + ZHQ + hd_ * 128 + lch * 8); gf = *(const bf16x8*)(zr_ + (dir_ ? ZHB : ZHF) + hd_ * 128 + lch * 8); } while (0)
#define HP_STASH(bufi) do { LAS unsigned char* rb_ = lds + P_RAW2 + (bufi) * RAW_BYTES; *(LAS bf16x8*)(rb_ + R_Q + lr * RS + lch * 16) = gq; *(LAS bf16x8*)(rb_ + R_F + lr * RS + lch * 16) = gf; } while (0)
#define HP_COPYOUT(item, bufi) do { v4u* dst_ = (v4u*)(HT + (size_t)(item) * IMG_BYTES); const LAS v4u* src_ = (const LAS v4u*)(lds + P_IMG2 + (bufi) * IMG_BYTES); \
        dst_[tid] = src_[tid]; dst_[tid + 512] = src_[tid + 512]; dst_[tid + 1024] = src_[tid + 1024]; if (tid < 128) dst_[tid + 1536] = src_[tid + 1536]; } while (0)
    const int G = gridDim.x;
    int it = blockIdx.x, par = 0;
    if (it < NITEM) { HP_LOAD(it); HP_STASH(0); }
    if (it + G < NITEM) HP_LOAD(it + G);
    __syncthreads();
    for (; it < NITEM; it += G, par ^= 1) {
        if (it + G < NITEM) HP_STASH(par ^ 1);
        if (it != (int)blockIdx.x) HP_COPYOUT(it - G, par ^ 1);
        if (it + 2 * G < NITEM) HP_LOAD(it + 2 * G);
        const int hd = ((it / NCHUNK) >> 1) & 3;
        {
            const LAS unsigned char* rb_ = lds + P_RAW2 + par * RAW_BYTES;
            const bf16x8 RQ = *(const LAS bf16x8*)(rb_ + R_Q + t * RS + c0 * 2), RF = *(const LAS bf16x8*)(rb_ + R_F + t * RS + c0 * 2);
            const f32x4 lbA = *(const LAS f32x4*)(lbt + hd * 128 + c0), lbB = *(const LAS f32x4*)(lbt + hd * 128 + c0 + 4);
            LAS unsigned char* tb_ = lds + P_IMG2 + par * IMG_BYTES;
            float bb_[8], kk_[8];
#pragma unroll
            for (int i_ = 0; i_ < 8; ++i_) { const float lb_ = i_ < 4 ? lbA[i_] : lbB[i_ - 4]; const float f_ = lb_ + (1.f - lb_) * __builtin_amdgcn_rcpf(1.f + __expf(-bf2f((unsigned short)RF[i_]))); kk_[i_] = 1.f - f_; bb_[i_] = f_; }
#pragma unroll
            for (int i_ = 0; i_ < 8; ++i_) { float x_ = bb_[i_]; x_ *= HG_DPP1(x_, 0x111, 0xf); x_ *= HG_DPP1(x_, 0x112, 0xf); x_ *= HG_DPP1(x_, 0x114, 0xf); x_ *= HG_DPP1(x_, 0x118, 0xf);
                x_ *= HG_DPP1(x_, 0x142, 0xa); bb_[i_] = x_; }
            float qi_[8], ko_[8], ke_[8], dd_[8];
#pragma unroll
            for (int i_ = 0; i_ < 8; ++i_) { const int bi_ = __float_as_int(bb_[i_]); dd_[i_] = __int_as_float(half ? __builtin_amdgcn_readlane(bi_, 63) : __builtin_amdgcn_readlane(bi_, 31));
                const float e_ = bb_[i_]; const float ei_ = __builtin_amdgcn_rcpf(e_);
                qi_[i_] = bf2f((unsigned short)RQ[i_]) * e_; ko_[i_] = kk_[i_] * ei_; ke_[i_] = kk_[i_] * (dd_[i_] * ei_); }
            *(LAS v4u*)(tb_ + T_Q + t * RS + c0 * 2) = (v4u){pk2(qi_[0], qi_[1]), pk2(qi_[2], qi_[3]), pk2(qi_[4], qi_[5]), pk2(qi_[6], qi_[7])};
            *(LAS v4u*)(tb_ + T_KO + t * RS + c0 * 2) = (v4u){pk2(ko_[0], ko_[1]), pk2(ko_[2], ko_[3]), pk2(ko_[4], ko_[5]), pk2(ko_[6], ko_[7])};
            *(LAS v4u*)(tb_ + T_KE + t * RS + c0 * 2) = (v4u){pk2(ke_[0], ke_[1]), pk2(ke_[2], ke_[3]), pk2(ke_[4], ke_[5]), pk2(ke_[6], ke_[7])};
            if (t == 31) { *(LAS f32x4*)(tb_ + T_D + c0 * 4) = (f32x4){dd_[0], dd_[1], dd_[2], dd_[3]}; *(LAS f32x4*)(tb_ + T_D + c0 * 4 + 16) = (f32x4){dd_[4], dd_[5], dd_[6], dd_[7]}; }
            if (tid < 32) *(LAS v4u*)(tb_ + T_Q + tid * RS + 256) = (v4u){0u, 0u, 0u, 0u};
            else if (tid < 64) *(LAS v4u*)(tb_ + T_KO + (tid - 32) * RS + 256) = (v4u){0u, 0u, 0u, 0u};
            else if (tid < 96) *(LAS v4u*)(tb_ + T_KE + (tid - 64) * RS + 256) = (v4u){0u, 0u, 0u, 0u};
        }
        __syncthreads();
    }
    if (it - G >= (int)blockIdx.x && it - G < NITEM) HP_COPYOUT(it - G, par ^ 1);
    __syncthreads();
#undef HP_COPYOUT
#undef HP_LOAD
#undef HP_STASH
}

__device__ __forceinline__ void hgrn_unit_mfma(const Args& a, int unit, LAS unsigned char* lds, int tid) {
    using namespace hg;
    const int b = unit >> 5, head = (unit >> 3) & 3, dir = (unit >> 2) & 1, sl = unit & 3;
    const bf16* Z = (const bf16*)(a.ws + WS_Z);
    const unsigned char* HT = a.ws + WS_HT + (size_t)((b * 4 + head) * 2 + dir) * NCHUNK * IMG_BYTES;
    bf16* Od = (bf16*)(a.ws + (dir ? WS_OB : WS_OF));
    const int wave = __builtin_amdgcn_readfirstlane(tid >> 6), lane = tid & 63;
    const size_t zb = (size_t)b * TPB;
    constexpr int NCH = NCHUNK;
    const int vr = (tid >> 2) & 31, vp = tid & 3, lvcol = ZHI + head * 128 + sl * 32 + vp * 8, i3 = 1536 + (tid & 127);
    v4u gA0, gA1, gA2, gA3, gB0, gB1, gB2, gB3; bf16x8 gAv, gBv;
#define HG_LOAD(g0, g1, g2, g3, gv, ch) do { const int c_ = (ch) < NCH ? (ch) : NCH - 1; const v4u* src_ = (const v4u*)(HT + (size_t)c_ * IMG_BYTES); \
        g0 = src_[tid]; g1 = src_[tid + 512]; g2 = src_[tid + 1024]; g3 = src_[i3]; gv = *(const bf16x8*)(Z + (zb + HG_TOKP(dir, 32 * c_ + vr)) * ZC + lvcol); } while (0)
#define HG_STASH(g0, g1, g2, g3, gv, bufi) do { LAS unsigned char* tb_ = lds + OFF_TILES + (bufi) * TILE_BYTES; LAS v4u* d_ = (LAS v4u*)tb_; \
        d_[tid] = g0; d_[tid + 512] = g1; d_[tid + 1024] = g2; if (tid < 128) { d_[tid + 1536] = g3; *(LAS bf16x8*)(tb_ + T_V + vr * VS + vp * 16) = gv; } } while (0)
    const int r32 = lane & 31, hi = lane >> 5, g1 = (lane >> 4) & 1, q4 = (lane & 15) >> 2, p4 = lane & 3, cb = 32 * wave;
    const unsigned lbase = (unsigned)(uintptr_t)lds;
    f32x16 S = {};
    HG_LOAD(gA0, gA1, gA2, gA3, gAv, 0); HG_STASH(gA0, gA1, gA2, gA3, gAv, 0); HG_LOAD(gA0, gA1, gA2, gA3, gAv, 1); HG_STASH(gA0, gA1, gA2, gA3, gAv, 1);
    HG_LOAD(gA0, gA1, gA2, gA3, gAv, 2);
    __syncthreads();
#define HG_RD64(dst, addr, OFFS) asm volatile("ds_read_b64 %0, %1 offset:" #OFFS : "=&v"(dst) : "v"(addr) : "memory")
#define HG_MFMA_STAGE(n, bufi) do { \
            const unsigned tb = lbase + OFF_TILES + (bufi) * TILE_BYTES; const LAS unsigned char* tl_ = lds + OFF_TILES + (bufi) * TILE_BYTES; \
            bf16x8 ko[2], qi[2]; s16x4 pvl[2], pvh[2], pql[2], pqh[2], kl[2], kh[2], nvl[2], nvh[2]; f32x4 dsc[4]; \
            _Pragma("unroll") for (int kk = 0; kk < 2; ++kk) { ko[kk] = *(const LAS bf16x8*)(tl_ + T_KO + r32 * RS + (cb + 16 * kk + 8 * hi) * 2); qi[kk] = *(const LAS bf16x8*)(tl_ + T_Q + r32 * RS + (cb + 16 * kk + 8 * hi) * 2); } \
            _Pragma("unroll") for (int sp = 0; sp < 2; ++sp) { \
                const unsigned va = tb + T_V + (16 * sp + 4 * hi + q4) * VS + (16 * g1 + 4 * p4) * 2; pvl[sp] = tr_read(va); pvh[sp] = tr_read(va + 8 * VS);              \
                const unsigned qa = tb + T_Q + r32 * RS + (cb + 16 * sp + 4 * hi) * 2; HG_RD64(pql[sp], qa, 0); HG_RD64(pqh[sp], qa, 16);                                  \
                const unsigned ka = tb + T_KE + (16 * sp + 8 * hi + q4) * RS + (cb + 16 * g1 + 4 * p4) * 2; kl[sp] = tr_read(ka); kh[sp] = tr_read(ka + 4 * RS);        \
                const unsigned vb = tb + T_V + (16 * sp + 8 * hi + q4) * VS + (16 * g1 + 4 * p4) * 2; nvl[sp] = tr_read(vb); nvh[sp] = tr_read(vb + 4 * VS); }            \
            _Pragma("unroll") for (int g = 0; g < 4; ++g) dsc[g] = *(const LAS f32x4*)(tl_ + T_D + (cb + 8 * g + 4 * hi) * 4); \
            asm volatile("s_waitcnt lgkmcnt(0)" ::: "memory"); __builtin_amdgcn_sched_barrier(0); \
            f32x16 X = {}; \
            X = __builtin_amdgcn_mfma_f32_32x32x16_bf16(ko[0], qi[0], X, 0, 0, 0); X = __builtin_amdgcn_mfma_f32_32x32x16_bf16(ko[1], qi[1], X, 0, 0, 0); \
            f32x16 O = {}; \
            O = __builtin_amdgcn_mfma_f32_32x32x16_bf16(cat8(pql[0], pqh[0]), pack8(S, 0), O, 0, 0, 0); O = __builtin_amdgcn_mfma_f32_32x32x16_bf16(cat8(pql[1], pqh[1]), pack8(S, 8), O, 0, 0, 0); \
            _Pragma("unroll") for (int i = 0; i < 16; ++i) S[i] *= dsc[i >> 2][i & 3]; \
            S = __builtin_amdgcn_mfma_f32_32x32x16_bf16(cat8(kl[0], kh[0]), cat8(nvl[0], nvh[0]), S, 0, 0, 0); S = __builtin_amdgcn_mfma_f32_32x32x16_bf16(cat8(kl[1], kh[1]), cat8(nvl[1], nvh[1]), S, 0, 0, 0); \
            _Pragma("unroll") for (int i = 0; i < 16; ++i) X[i] = (crow(i, hi) <= r32) ? X[i] : 0.f; \
            O = __builtin_amdgcn_mfma_f32_32x32x16_bf16(pack8(X, 0), cat8(pvl[0], pvh[0]), O, 0, 0, 0); O = __builtin_amdgcn_mfma_f32_32x32x16_bf16(pack8(X, 8), cat8(pvl[1], pvh[1]), O, 0, 0, 0); \
            LAS float* op = (LAS float*)(lds + OFF_OPART + ((n) & 1) * OPART_BYTES + wave * 4096); \
            _Pragma("unroll") for (int i = 0; i < 16; ++i) op[crow(i, hi) * 32 + r32] = O[i]; } while (0)
#define HG_OUT_STAGE(n) do { \
            const int l2 = tid - 256, tt = l2 >> 3, vq = l2 & 7; \
            const LAS float* op = (const LAS float*)(lds + OFF_OPART + (((n) - 1) & 1) * OPART_BYTES) + tt * 32 + vq * 4; \
            const f32x4 s = (*(const LAS f32x4*)op + *(const LAS f32x4*)(op + 1024)) + (*(const LAS f32x4*)(op + 2048) + *(const LAS f32x4*)(op + 3072)); \
            const int p = HG_TOKP(dir, 32 * ((n) - 1) + tt); \
            if (p >= CTXL) *(v2u*)(Od + (zb + p) * 512 + head * 128 + sl * 32 + vq * 4) = (v2u){pk2(s[0], s[1]), pk2(s[2], s[3])}; } while (0)
#define HG_ITER(n, L0, L1, L2, L3, LV, S0, S1, S2, S3, SV) do { \
        HG_LOAD(L0, L1, L2, L3, LV, (n) + 3); \
        if (wave < 4) { HG_MFMA_STAGE(n, bcur); } else if ((n) > 0) { HG_OUT_STAGE(n); } \
        { const int bst_ = bcur == 0 ? 2 : bcur - 1; HG_STASH(S0, S1, S2, S3, SV, bst_); } \
        bcur = bcur == 2 ? 0 : bcur + 1; \
        __syncthreads(); } while (0)
    int bcur = 0;
    for (int n = 0; n < NCH; n += 2) {
        HG_ITER(n, gB0, gB1, gB2, gB3, gBv, gA0, gA1, gA2, gA3, gAv);
        HG_ITER(n + 1, gA0, gA1, gA2, gA3, gAv, gB0, gB1, gB2, gB3, gBv);
    }
    if (wave >= 4) { HG_OUT_STAGE(NCH); }
    __syncthreads();
#undef HG_MFMA_STAGE
#undef HG_OUT_STAGE
#undef HG_ITER
#undef HG_LOAD
#undef HG_STASH
#undef HG_RD64
}

__device__ __forceinline__ bool in_range(int lo, int hi, int k) { asm volatile("" : "+s"(lo), "+s"(hi)); return lo <= k && k < hi; }
constexpr int NPHASES = 21;
__global__ void __launch_bounds__(NTHR, 2) fwd_kernel(Args args) {
    extern __shared__ __attribute__((aligned(16))) unsigned char lds_raw[];
    LAS unsigned char* lds = (LAS unsigned char*)lds_raw;
    const int G = gridDim.x;
#define FRESH() int tid = threadIdx.x; asm volatile("" : "+v"(tid)); const int lane = tid & 63, wave = __builtin_amdgcn_readfirstlane(tid >> 6); (void)lane; (void)wave
    unsigned char* ws = args.ws;
    if (threadIdx.x < 16) ((LAS unsigned*)(lds + LDS_BAR_OFF))[threadIdx.x] = 0u;
    __syncthreads();
    XcdBarrier bar = xcd_barrier_post((unsigned*)(ws + WS_CTL), (volatile LAS unsigned*)(lds + LDS_BAR_OFF));
    const int lo = args.ph_lo, hi = args.ph_hi;
#define IN(k) in_range(lo, hi, (k))
#define NREP(k) (((PROBE_MASK >> (k)) & 1u) ? 2 : 1)
#define REPEAT(k) for (int rep_ = 0; rep_ < NREP(k); ++rep_) if (rep_ == 0 || (xcd_barrier(bar), true))
#define SEAM(k) do { if (IN(k) && IN((k) + 1)) xcd_barrier(bar); } while (0)
    bf16* const BX = (bf16*)(ws + WS_X); bf16* const BY = (bf16*)(ws + WS_Y);
    const float* const MODV = (const float*)(ws + WS_MODV);

#if defined(PROBE_BARS)
    for (int pbi = 0; pbi < PROBE_BARS; ++pbi) xcd_barrier(bar);
#endif
    if (IN(0)) REPEAT(0) { FRESH(); phase_prologue(args, lds, tid, lane, wave); } SEAM(0);
    if (IN(1)) REPEAT(1) { FRESH(); phase_mod0(args, lane, wave); } SEAM(1);
    if (IN(2)) REPEAT(2) {
        pg8::Gemm g{BX, (const bf16*)(ws + WS_WIN), NTOK, ZC, 512}; pg8::AllOrder S; S.init(NTOK / 256, ZC / 256, G, (int)blockIdx.x);
        pg8::EpiBf16<0> E{(bf16*)(ws + WS_Z), ZC, nullptr, ZC, 0, 1.f / (SC_A0 * SC_WIN)};
        pg8::gemm_phase<pg8::EpiBf16<0>, pg8::AllOrder, PG8_ALIGN, true, false, true>(lds, g, S, E);
    } SEAM(2);
    if (IN(3)) REPEAT(3) { FRESH(); phase_norm0(args, lane, wave); hgrn_prep_items(args, lds, tid); } SEAM(3);
    if (IN(4)) REPEAT(4) {
        { pg8::Gemm g{(const bf16*)(ws + WS_CQN), (const bf16*)(ws + WS_WUQ), NTOK, 768, 384}; pg8::LatOrder S; S.init(128, 3, G, (int)blockIdx.x);
          pg8::EpiBf16<0> E{(bf16*)(ws + WS_Q), 768, nullptr, 0, 0, 1.f};
          pg8::gemm_phase<pg8::EpiBf16<0>, pg8::LatOrder, PG8_ALIGN, PG8_SP2>(lds, g, S, E); }
        __syncthreads();
        { pg8::Gemm g{(const bf16*)(ws + WS_CKVN), (const bf16*)(ws + WS_WUKV), NTOK, 1024, 256}; pg8::AllOrder S; S.init(NTOK / 256, 4, G, G - 1 - (int)blockIdx.x);
          pg8::EpiBf16<0> E{(bf16*)(ws + WS_KV), 1024, nullptr, 0, 0, 1.f};
          pg8::gemm_phase<pg8::EpiBf16<0>, pg8::AllOrder, PG8_ALIGN, PG8_SP2>(lds, g, S, E); }
    } SEAM(4);
    if (IN(5)) {
        REPEAT(21) { FRESH();
        for (int u = blockIdx.x; u < 256; u += G) { __syncthreads(); hgrn_unit_mfma(args, (G == 256) ? ((u & 7) * 32 + (u >> 3)) : u, lds, tid); } }
        const bf16* Q = (const bf16*)(ws + WS_Q); const bf16* KV = (const bf16*)(ws + WS_KV); const bf16* KRR = (const bf16*)(ws + WS_KRR);
        const float* rope = (const float*)(ws + WS_ROPE);
        const int cslot = (G == 256) ? ((((int)blockIdx.x & 7) * 2 + (((int)blockIdx.x >> 3) >> 4)) % 5) : 0;
        REPEAT(22) {
        int ai = 0;
        for (int slot = 0; slot < 5; ++slot) {
            if (slot == cslot) { if (rep_ == 0) { FRESH(); __syncthreads(); convert_moe_share(args, lds, lane, wave); } continue; }
            for (int u = (G == 256) ? (int)blockIdx.x + ai * 256 : (int)blockIdx.x; u < ((G == 256) ? (int)blockIdx.x + ai * 256 + 1 : (ai == 0 ? 1024 : 0)); u += G) {
                int b, h, qb; if (G == 256) { const int x = (int)blockIdx.x & 7, j = (int)blockIdx.x >> 3, pr = (u >> 8) * 16 + 2 * x + (j >> 4); b = pr >> 3; h = pr & 7; qb = j & 15; } else { b = u >> 7; h = (u >> 4) & 7; qb = u & 15; }
                const size_t kb = (size_t)b * TPB, q0 = kb + CTXL + (size_t)qb * 256;
                __syncthreads();
                att::attn_unit(Q + q0 * 768 + h * 96, KV + kb * 1024 + h * 64, KRR + kb * 32, BY + q0 * 1024 + h * 64, rope + (size_t)qb * 256 * 32, TPB, (char*)lds_raw);
            }
            ++ai;
        }
        }
    } SEAM(5);
    if (IN(6)) REPEAT(6) { FRESH(); phase_readout(args, lane, wave); } SEAM(6);
    if (IN(7)) REPEAT(7) {
        pg8::Gemm g{BY, (const bf16*)(ws + WS_WOUT), NTOK, 1024, 1024}; pg8::LatOrder S; S.init(128, 4, G, (int)blockIdx.x);
        pg8::EpiRes<false> E{args.in[I_X], nullptr, (bf16*)(ws + WS_PRE), MODV, nullptr, 1.f};
        pg8::gemm_phase<pg8::EpiRes<false>, pg8::LatOrder, PG8_ALIGN, PG8_SP2>(lds, g, S, E);
    } SEAM(7);
    for (int l = 0; l < 2; ++l) {
        if (l == 1) {
            if (IN(13)) REPEAT(13) {
                pg8::Gemm g{BY, (const bf16*)(ws + WS_WPW1), NTOK, 2048, 512}; pg8::LatOrder S; S.init(128, 8, G, (int)blockIdx.x);
                pg8::EpiGate<0> E{BX, (const float*)(ws + WS_PW1B), 8, 1.f / (SC_A1 * SC_WPW), 1.f};
                pg8::gemm_phase<pg8::EpiGate<0>, pg8::LatOrder, PG8_ALIGN, true, false, true>(lds, g, S, E);
            } SEAM(13);
            if (IN(14)) REPEAT(14) { FRESH(); phase_conv(args, lds, tid, lane, wave); } SEAM(14);
            if (IN(15)) REPEAT(15) {
                pg8::Gemm g{BY, (const bf16*)(ws + WS_WPW2), NTOK, 1024, 512}; pg8::LatOrder S; S.init(128, 4, G, (int)blockIdx.x);
                pg8::EpiRes<true> E{nullptr, (const bf16*)(ws + WS_H), (bf16*)(ws + WS_PRE), MODV + 9 * 6144, args.in[I_PW2B], 1.f / (SC_CV * SC_WPW)};
                pg8::gemm_phase<pg8::EpiRes<true>, pg8::LatOrder, PG8_ALIGN, true, false, true>(lds, g, S, E);
            } SEAM(15);
        }
        const int pb = l ? 16 : 8;
        if (IN(pb)) REPEAT(pb) { FRESH(); phase_ln1(args, l, lds, tid, lane, wave); } SEAM(pb);
        if (IN(pb + 2) || IN(pb + 3)) {
            LAS int* tl = (LAS int*)(lds + LDS_TILE_E);
            FRESH();
            __syncthreads();
            if (tid < 32) tl[3 * MAXTILES + 64 + tid] = ld_ctl((const int*)(ws + WS_CURSOR) + l * 32 + tid);
            __syncthreads();
            if (tid == 0) { int ts = 0; for (int e = 0; e < 32; ++e) { tl[3 * MAXTILES + e] = ts; ts += (tl[3 * MAXTILES + 64 + e] + 255) >> 8; } tl[3 * MAXTILES + 32] = ts; }
            __syncthreads();
            const int ntiles = tl[3 * MAXTILES + 32];
            for (int t = tid; t < ntiles && t < MAXTILES; t += NTHR) { int e = 0; while (e < 31 && tl[3 * MAXTILES + e + 1] <= t) ++e; const int j = t - tl[3 * MAXTILES + e], rem = tl[3 * MAXTILES + 64 + e] - 256 * j;
                tl[t] = e; tl[MAXTILES + t] = e * ECAP + 256 * j; tl[2 * MAXTILES + t] = rem < 256 ? rem : 256; }
            __syncthreads();
            if (IN(pb + 2)) REPEAT(pb + 2) {
#if defined(PROBE_STAGGER)
                if (blockIdx.x & 1) { const unsigned long long t0 = __builtin_amdgcn_s_memrealtime(); while (__builtin_amdgcn_s_memrealtime() - t0 < PROBE_STAGGER) __builtin_amdgcn_s_sleep(8); }
#endif
                pg8::Gemm g{BX, (const bf16*)(ws + WS_WGU + (size_t)l * 32 * 2048 * 1024), 0, 0, 512};
                pg8::MoeOrder S; S.init(ntiles, 8, G, (int)blockIdx.x); S.tile_e = tl; S.nper = 8;
                pg8::EpiGate<1, true> E{(bf16*)(ws + WS_ACT), (const float*)(ws + WS_BGU) + (size_t)l * 32 * 2048, 8, 1.f / (SC_X8 * SC_WGU) * PROBE_KSC, SC_ACT};
                pg8::gemm_phase<pg8::EpiGate<1, true>, pg8::MoeOrder, PG8_ALIGN, true, true, true>(lds, g, S, E, (const int*)(ws + WS_ROWS), tl + MAXTILES);
            } SEAM(pb + 2);
            if (IN(pb + 3)) REPEAT(pb + 3) {
                pg8::Gemm g{(const bf16*)(ws + WS_ACT), (const bf16*)(ws + WS_WDN + (size_t)l * 32 * 1024 * 1024), 0, 0, 512};
                pg8::MoeOrder S; S.init(ntiles, 4, G, (int)blockIdx.x); S.tile_e = tl; S.nper = 4;
                pg8::EpiDown E{(bf16*)(ws + WS_YB), args.in[I_BDN] + (size_t)l * 32 * 1024, (const float*)(ws + WS_ROWW), (const int*)(ws + WS_ROWD), 1.f / (SC_ACT * SC_WDN) * PROBE_KSC, tl + MAXTILES, SC_Y};
                pg8::gemm_phase<pg8::EpiDown, pg8::MoeOrder, PG8_ALIGN, true, false, true>(lds, g, S, E);
            } SEAM(pb + 3);
        }
        if (IN(pb + 4)) REPEAT(pb + 4) { FRESH(); phase_ln2(args, l, lane, wave); }
        if (l == 0) SEAM(12);
    }
#undef IN
#undef SEAM
}

extern "C" void kernel_launch(void* const* d_in, const int* in_sizes, int n_in, void* d_out, int out_size, void* d_ws, size_t ws_size, hipStream_t stream) {
    static int grid = 0;
    if (grid == 0) {
        if (n_in != 33 || in_sizes[0] != NB * SEQ * D || out_size != NB * SEQ * D || ws_size < WS_END) {
            fprintf(stderr, "kernel_launch: unexpected shapes: n_in %d in0 %d out %d ws %zu (need %zu)\n", n_in, n_in > 0 ? in_sizes[0] : -1, out_size, ws_size, (size_t)WS_END); grid = -1; return; }
        int dev = 0, cus = 0;
        if (hipGetDevice(&dev) != hipSuccess || hipDeviceGetAttribute(&cus, hipDeviceAttributeMultiprocessorCount, dev) != hipSuccess) { grid = -1; return; }
        if (hipFuncSetAttribute((const void*)fwd_kernel, hipFuncAttributeMaxDynamicSharedMemorySize, LDS_BYTES) != hipSuccess) { fprintf(stderr, "kernel_launch: hipFuncSetAttribute failed\n"); grid = -1; return; }
        int per_cu = 0;
        if (hipOccupancyMaxActiveBlocksPerMultiprocessor(&per_cu, (const void*)fwd_kernel, NTHR, LDS_BYTES) != hipSuccess || per_cu < 1) fprintf(stderr, "kernel_launch: occupancy query reports %d\n", per_cu);
        (void)hipGetLastError();
        grid = cus;
    }
    if (grid < 0) return;
    if (hipMemsetAsync((char*)d_ws + WS_CTL, 0, CTL_ZERO_BYTES, stream) != hipSuccess) return;
    Args a{};
    for (int i = 0; i < 33; ++i) a.in[i] = (const float*)d_in[i];
    a.out = (float*)d_out; a.ws = (unsigned char*)d_ws;
#if MK_ONE_LAUNCH
    a.ph_lo = 0; a.ph_hi = NPHASES;
    hipLaunchKernelGGL(fwd_kernel, dim3(grid), dim3(NTHR), LDS_BYTES, stream, a);
#else
    for (int ph = 0; ph < NPHASES; ++ph) { a.ph_lo = ph; a.ph_hi = ph + 1; hipLaunchKernelGGL(fwd_kernel, dim3(grid), dim3(NTHR), LDS_BYTES, stream, a); }
#endif
    const hipError_t le = hipPeekAtLastError();
    if (le != hipSuccess) fprintf(stderr, "kernel_launch: launch failed: %s\n", hipGetErrorName(le));
}
```

```cpp
#include <hip/hip_runtime.h>
#include <cstdio>
#include <cstdint>

#ifndef PROBE_MASK
#define PROBE_MASK 0u
#endif
#if defined(PROBE_K2)
#define PROBE_KSC 0.5f
#else
#define PROBE_KSC 1.0f
#endif
#ifndef MK_ONE_LAUNCH
#define MK_ONE_LAUNCH 1
#endif

namespace pg8 {
#define PG8_LAS __attribute__((address_space(3)))
typedef unsigned short bf16_t;
typedef short bf16x8 __attribute__((ext_vector_type(8)));
typedef float f32x4 __attribute__((ext_vector_type(4)));
typedef unsigned u32x4 __attribute__((ext_vector_type(4)));
constexpr int BM = 256, BK = 64, HALF = 128, HTB = HALF * BK * 2  , STAGE_BYTES = 8 * HTB, NXCD = 8, WGM = 8;

__host__ __device__ __forceinline__ int lds_byte(int r, int c) { const int st = (r >> 4) * 2 + (c >> 5), rr = r & 15, cc = c & 31, ob = rr * 64 + cc * 2; return st * 1024 + (ob ^ (((ob >> 9) & 1) << 5)); }
__host__ __device__ __forceinline__ void stage_rc(int b, int& R, int& C) { const int st = b / 1024, sb = b % 1024, swz = sb ^ (((sb >> 9) & 1) << 5); R = (st >> 1) * 16 + swz / 64; C = (st & 1) * 32 + (swz % 64) / 2; }
__host__ __device__ __forceinline__ int perm32(int rho) { const int n = rho >> 4, i = rho & 15; return 8 * (i >> 2) + 4 * n + (i & 3); }

struct Unit { int pm, pn; };
struct Gemm { const bf16_t* A; const bf16_t* Bt; int M, N, K; };

struct StaticOrder {
    int nM, nN, nwg, G, c;
    __host__ __device__ void init(int M, int N, int G_, int c_) { nM = M / BM; nN = N / BM; nwg = nM * nN; G = G_; c = c_; }
    __host__ __device__ bool next(int i, Unit& u) const {
        const long L = (long)i * G + c; if (L >= nwg) return false;
        int wgid = (int)L; { const int q = nwg / NXCD, r = nwg % NXCD, xcd = wgid % NXCD, off = wgid / NXCD; wgid = (xcd < r ? xcd * (q + 1) : r * (q + 1) + (xcd - r) * q) + off; }
        const int nig = WGM * nN, gid = wgid / nig, fm = gid * WGM, gsz = (nM - fm) < WGM ? (nM - fm) : WGM;
        u.pm = fm + ((wgid % nig) % gsz); u.pn = (wgid % nig) / gsz; return true;
    }
    __device__ __forceinline__ void a_ready(const Unit&) const {}
    __device__ __forceinline__ void done(const Unit&) const {}
};

__device__ __forceinline__ unsigned cvt_pk_bf16(float lo, float hi) { unsigned r; asm volatile("v_cvt_pk_bf16_f32 %0, %1, %2" : "=v"(r) : "v"(lo), "v"(hi)); return r; }
typedef float f32x2 __attribute__((ext_vector_type(2)));
__device__ __forceinline__ f32x2 gelu_pk(f32x2 v) {
    const f32x2 av = __builtin_elementwise_abs(v), d = av * 0.2316418882f + 1.0f;
    f32x2 t; t.x = __builtin_amdgcn_rcpf(d.x); t.y = __builtin_amdgcn_rcpf(d.y);
    f32x2 q = t * 0.5307027145f + (-0.7265760135f); q = q * t + 0.7107068705f; q = q * t + (-0.142248368f); q = q * t + 0.127414796f; q = q * t;
    const f32x2 s = (v * v) * (-0.72134752044f);
    f32x2 e; e.x = __builtin_amdgcn_exp2f(s.x); e.y = __builtin_amdgcn_exp2f(s.y);
    const f32x2 m = v * (q * e), r = v - m;
    f32x2 o; o.x = v.x < 0.f ? m.x : r.x; o.y = v.y < 0.f ? m.y : r.y; return o;
}

template <int ACT  > struct EpiBf16 {
    static constexpr bool PERM = true, AFTER_DRAIN = false; static_assert(ACT == 0 || ACT == 1, "EpiBf16: ACT is 0 (none) or 1 (gelu_pk)");
    bf16_t* O; int ldc; const float* bias; int split_cols; size_t split_stride; float scale0;
    __device__ __forceinline__ void operator()(const f32x4 (&acc)[2][2][4][2], const Unit& u, int wr, int wc, int fr, int fq) const {
        const int row0 = u.pm * BM + wr * 64 + fr; int colt = u.pn * BM; bf16_t* base = O;
        float sc = 1.f; if (split_cols) { const int t = colt / split_cols; base += (size_t)t * split_stride; colt -= t * split_cols; if (t == 0) sc = scale0; }
        const int col0 = colt + wc * 32 + 8 * fq, bcol0 = u.pn * BM + wc * 32 + 8 * fq;
        f32x4 bv[2][2];
#pragma unroll
        for (int bj = 0; bj < 2; ++bj)
#pragma unroll
            for (int n = 0; n < 2; ++n) bv[bj][n] = bias ? *(const f32x4*)(bias + bcol0 + bj * HALF + 4 * n) : (f32x4){0.f, 0.f, 0.f, 0.f};
#pragma unroll
        for (int ai = 0; ai < 2; ++ai)
#pragma unroll
            for (int m = 0; m < 4; ++m) { bf16_t* rowp = base + (size_t)(row0 + ai * HALF + m * 16) * ldc + col0;
#pragma unroll
                for (int bj = 0; bj < 2; ++bj) { f32x4 v0 = acc[ai][bj][m][0] + bv[bj][0], v1 = acc[ai][bj][m][1] + bv[bj][1];
                    if (ACT == 1) { f32x2 a = gelu_pk((f32x2){v0[0], v0[1]}), b = gelu_pk((f32x2){v0[2], v0[3]}), c = gelu_pk((f32x2){v1[0], v1[1]}), d = gelu_pk((f32x2){v1[2], v1[3]});
                        v0 = (f32x4){a.x, a.y, b.x, b.y}; v1 = (f32x4){c.x, c.y, d.x, d.y}; }
                    v0 = v0 * sc; v1 = v1 * sc; u32x4 w; w.x = cvt_pk_bf16(v0[0], v0[1]); w.y = cvt_pk_bf16(v0[2], v0[3]); w.z = cvt_pk_bf16(v1[0], v1[1]); w.w = cvt_pk_bf16(v1[2], v1[3]);
                    *(u32x4*)(rowp + bj * HALF) = w; } }
    }
};
typedef int v4i_t __attribute__((ext_vector_type(4)));
typedef int v8i_t __attribute__((ext_vector_type(8)));
__device__ __forceinline__ v8i_t cat32(bf16x8 a, bf16x8 b) { const v4i_t x = __builtin_bit_cast(v4i_t, a), y = __builtin_bit_cast(v4i_t, b); return __builtin_shufflevector(x, y, 0, 1, 2, 3, 4, 5, 6, 7); }
template <class Epi, class Sched, bool ALIGN_EPI = false, bool SP2 = false, bool GATHER = false, bool FP8 = false>
__device__ __forceinline__ void gemm_phase(PG8_LAS unsigned char* lds, const Gemm g, const Sched& S, const Epi& E, const int* rowsrc = nullptr, const PG8_LAS int* gtab = nullptr) {
    static_assert(!GATHER || SP2, "GATHER is implemented on the SP2 loop only");
    int tid_l = threadIdx.x; asm volatile("" : "+v"(tid_l));
    const int tid = tid_l, wid = __builtin_amdgcn_readfirstlane(tid >> 6), lane = tid & 63, wr = wid >> 2, wc = wid & 3, fr = lane & 15, fq = lane >> 4;
#if defined(PROBE_K2)
    const int K = g.K, nt0 = K / BK, nt = FP8 ? 2 * nt0 : nt0;
#define PG8_KT(x) (FP8 ? ((x) & (nt0 - 1)) : (x))
#else
    const int K = g.K, nt = K / BK;
#define PG8_KT(x) (x)
#endif
    unsigned voffA[2], voffB[2];
#pragma unroll
    for (int i = 0; i < 2; ++i) { int R, C; stage_rc(tid * 16 + i * 8192, R, C); const int Rb = Epi::PERM ? ((R & ~31) + perm32(R & 31)) : R;
        voffA[i] = (unsigned)(R * K + C) * 2u; voffB[i] = (unsigned)(Rb * K + C) * 2u; }
    unsigned gAc[2][2], gAn[2][2]; int gR[2]; unsigned gC[2];
#pragma unroll
    for (int i = 0; i < 2; ++i) { int R, C; stage_rc(tid * 16 + i * 8192, R, C); gR[i] = R; gC[i] = (unsigned)C * 2u; gAc[0][i] = gAc[1][i] = gAn[0][i] = gAn[1][i] = 0u; }
#define PG8_GATHER(u_, o_) do { const int gtb_ = gtab[(u_).pm], gtc_ = gtab[576 + (u_).pm];     \
        _Pragma("unroll") for (int h_ = 0; h_ < 2; ++h_) _Pragma("unroll") for (int i_ = 0; i_ < 2; ++i_) \
        { const int rl_ = h_ * HALF + gR[i_]; const int src_ = rl_ < gtc_ ? rowsrc[gtb_ + rl_] : 0; o_[h_][i_] = (unsigned)src_ * (unsigned)(K * 2) + gC[i_]; } } while (0)
#define PG8_STAGE_A(bufoff, orig_gbase, NEXTSEL, H, KOFF) do { if constexpr (GATHER) { unsigned vo_[2]; vo_[0] = (NEXTSEL) ? gAn[H][0] : gAc[H][0]; vo_[1] = (NEXTSEL) ? gAn[H][1] : gAc[H][1]; \
        PG8_STAGE(bufoff, (const char*)g.A + (KOFF), vo_); } else { PG8_STAGE(bufoff, orig_gbase, voffA); } } while (0)
    const size_t kstep = (size_t)(BK * 2);
    const size_t hstep = (size_t)HALF * K * 2;
    const size_t tstep = 2 * hstep;
    const unsigned ldsw = (unsigned)wid * 1024u;
    const int aoff = lds_byte(wr * 64 + fr, fq * 8), boff = lds_byte(wc * 32 + fr, fq * 8);
#define PG8_SA(b, h) (((b) * 2 + (h)) * HTB)
#define PG8_SB(b, h) ((4 + (b) * 2 + (h)) * HTB)
#define PG8_STAGE(bufoff, gbase, voff) do { _Pragma("unroll") for (int _i = 0; _i < 2; ++_i) \
        __builtin_amdgcn_global_load_lds((const unsigned*)((const char*)(gbase) + (voff)[_i]), (PG8_LAS unsigned*)(lds + (bufoff) + ldsw + _i * 8192), 16, 0, 0); } while (0)
#define PG8_LD32(var, addr) do { const bf16x8 lo_ = *(const PG8_LAS bf16x8*)(addr); const bf16x8 hi_ = *(const PG8_LAS bf16x8*)((addr) + 1024); var = cat32(lo_, hi_); } while (0)
#define PG8_LDA(dst, b, h) do { if constexpr (FP8) { _Pragma("unroll") for (int m = 0; m < 4; ++m) PG8_LD32(dst##8[m], lds + PG8_SA(b, h) + aoff + m * 2048); } \
        else { _Pragma("unroll") for (int m = 0; m < 4; ++m) _Pragma("unroll") for (int k = 0; k < 2; ++k) dst[m][k] = *(const PG8_LAS bf16x8*)(lds + PG8_SA(b, h) + aoff + m * 2048 + k * 1024); } } while (0)
#define PG8_LDB(dst, b, h) do { if constexpr (FP8) { _Pragma("unroll") for (int n = 0; n < 2; ++n) PG8_LD32(dst##8[n], lds + PG8_SB(b, h) + boff + n * 2048); } \
        else { _Pragma("unroll") for (int n = 0; n < 2; ++n) _Pragma("unroll") for (int k = 0; k < 2; ++k) dst[n][k] = *(const PG8_LAS bf16x8*)(lds + PG8_SB(b, h) + boff + n * 2048 + k * 1024); } } while (0)
#define PG8_MMA(ai, bj, At, Bt) do { __builtin_amdgcn_s_setprio(1); \
        if constexpr (FP8) { _Pragma("unroll") for (int m = 0; m < 4; ++m) _Pragma("unroll") for (int n = 0; n < 2; ++n) \
            asm volatile("v_mfma_scale_f32_16x16x128_f8f6f4 %0, %1, %2, %0, %3, %3 op_sel_hi:[0,0,0]" : "+v"(acc[ai][bj][m][n]) : "v"(Bt##8[n]), "v"(At##8[m]), "v"(sc127)); } \
        else { _Pragma("unroll") for (int m = 0; m < 4; ++m) _Pragma("unroll") for (int n = 0; n < 2; ++n) _Pragma("unroll") for (int k = 0; k < 2; ++k) \
            acc[ai][bj][m][n] = __builtin_amdgcn_mfma_f32_16x16x32_bf16(Bt[n][k], At[m][k], acc[ai][bj][m][n], 0, 0, 0); } \
        __builtin_amdgcn_s_setprio(0); } while (0)
#define PG8_WAIT_V(n) asm volatile("s_waitcnt vmcnt(" #n ")" ::: "memory")
#define PG8_WAIT_L(n) asm volatile("s_waitcnt lgkmcnt(" #n ")" ::: "memory")
#define PG8_BAR __builtin_amdgcn_s_barrier()
#define PG8_SCHED __builtin_amdgcn_sched_barrier(0)
    Unit cur, nxt; int ui = 0;
    if (!S.next(0, cur)) return;
    f32x4 acc[2][2][4][2];
#pragma unroll
    for (int a = 0; a < 2; ++a)
#pragma unroll
        for (int b = 0; b < 2; ++b)
#pragma unroll
            for (int m = 0; m < 4; ++m)
#pragma unroll
                for (int n = 0; n < 2; ++n) acc[a][b][m][n] = (f32x4){0.f, 0.f, 0.f, 0.f};
    int sc127 = 0x7f7f7f7f; asm volatile("" : "+v"(sc127));
    bf16x8 At[4][2], B0[2][2], B1[2][2]; v8i_t At8[4], B08[2], B18[2]; (void)At; (void)B0; (void)B1; (void)At8; (void)B08; (void)B18;
    const char* cA = (const char*)g.A + (size_t)cur.pm * tstep; const char* cB = (const char*)g.Bt + (size_t)cur.pn * tstep;
    S.a_ready(cur);
    if constexpr (GATHER) { PG8_GATHER(cur, gAc); }
    if constexpr (SP2) {
        PG8_STAGE(PG8_SB(0, 0), cB, voffB); PG8_STAGE(PG8_SB(0, 1), cB + hstep, voffB); PG8_STAGE_A(PG8_SA(0, 0), cA, false, 0, (size_t)0); PG8_STAGE_A(PG8_SA(0, 1), cA + hstep, false, 1, (size_t)0);
        if (wr == 1) PG8_BAR;
        PG8_WAIT_V(2); PG8_BAR;
        PG8_STAGE(PG8_SB(1, 0), cB + kstep, voffB); PG8_STAGE_A(PG8_SA(1, 0), cA + kstep, false, 0, kstep); PG8_STAGE(PG8_SB(1, 1), cB + hstep + kstep, voffB);
        PG8_WAIT_V(6); PG8_BAR;
    } else {
        PG8_STAGE(PG8_SB(0, 0), cB, voffB); PG8_STAGE(PG8_SA(0, 0), cA, voffA); PG8_STAGE(PG8_SB(0, 1), cB + hstep, voffB); PG8_STAGE(PG8_SA(0, 1), cA + hstep, voffA);
        if (wr == 1) PG8_BAR;
        PG8_WAIT_V(4); PG8_BAR;
        PG8_STAGE(PG8_SB(1, 0), cB + kstep, voffB); PG8_STAGE(PG8_SA(1, 0), cA + kstep, voffA); PG8_STAGE(PG8_SB(1, 1), cB + hstep + kstep, voffB);
        PG8_WAIT_V(6); PG8_BAR;
    }
    for (;;) {
        const bool has_next = S.next(ui + 1, nxt);
        if constexpr (GATHER) { if (has_next) { PG8_GATHER(nxt, gAn); } else { _Pragma("unroll") for (int h_ = 0; h_ < 2; ++h_) _Pragma("unroll") for (int i_ = 0; i_ < 2; ++i_) gAn[h_][i_] = gAc[h_][i_]; } }
        const char* nA = has_next ? (const char*)g.A + (size_t)nxt.pm * tstep : cA; const char* nB = has_next ? (const char*)g.Bt + (size_t)nxt.pn * tstep : cB;
#pragma nounroll
        for (int t = 0; t < nt; t += 2) {
            const bool last = (t == nt - 2);
            const char* a1 = cA + (size_t)PG8_KT(t + 1) * kstep;
            const char* a2 = last ? nA : cA + (size_t)PG8_KT(t + 2) * kstep; const char* b2 = last ? nB : cB + (size_t)PG8_KT(t + 2) * kstep;
            const char* a3 = a2 + kstep; const char* b3 = b2 + kstep;
            const size_t k1 = (size_t)PG8_KT(t + 1) * kstep, k2 = last ? (size_t)0 : (size_t)PG8_KT(t + 2) * kstep, k3 = k2 + kstep; (void)k1; (void)k2; (void)k3;
            if (last && has_next) S.a_ready(nxt);
            if constexpr (SP2) {
            PG8_LDB(B0, 0, 0); PG8_LDB(B1, 0, 1); PG8_SCHED; PG8_LDA(At, 0, 0); PG8_STAGE_A(PG8_SA(1, 1), a1 + hstep, false, 1, k1);
            PG8_WAIT_V(8); PG8_WAIT_L(0); PG8_BAR; PG8_MMA(0, 0, At, B0); PG8_MMA(0, 1, At, B1); PG8_BAR; PG8_SCHED;
            PG8_LDA(At, 0, 1); PG8_STAGE(PG8_SB(0, 0), b2, voffB); PG8_STAGE(PG8_SB(0, 1), b2 + hstep, voffB); PG8_STAGE_A(PG8_SA(0, 0), a2, last, 0, k2);
            PG8_WAIT_V(8); PG8_WAIT_L(0); PG8_BAR; PG8_MMA(1, 0, At, B0); PG8_MMA(1, 1, At, B1); PG8_BAR; PG8_SCHED;
            PG8_LDB(B0, 1, 0); PG8_LDB(B1, 1, 1); PG8_SCHED; PG8_LDA(At, 1, 0); PG8_STAGE_A(PG8_SA(0, 1), a2 + hstep, last, 1, k2);
            PG8_WAIT_V(8); PG8_WAIT_L(0); PG8_BAR; PG8_MMA(0, 0, At, B0); PG8_MMA(0, 1, At, B1); PG8_BAR; PG8_SCHED;
            PG8_LDA(At, 1, 1); PG8_STAGE(PG8_SB(1, 0), b3, voffB); PG8_STAGE(PG8_SB(1, 1), b3 + hstep, voffB); PG8_STAGE_A(PG8_SA(1, 0), a3, last, 0, k3);
            PG8_WAIT_V(8); PG8_WAIT_L(0); PG8_BAR; PG8_MMA(1, 0, At, B0); PG8_MMA(1, 1, At, B1); PG8_BAR; PG8_SCHED;
            } else {
            PG8_LDB(B0, 0, 0); PG8_SCHED; PG8_LDA(At, 0, 0); PG8_STAGE(PG8_SA(1, 1), a1 + hstep, voffA);
            PG8_WAIT_L(8); PG8_BAR; PG8_WAIT_L(0); PG8_MMA(0, 0, At, B0); PG8_BAR; PG8_SCHED;
            PG8_LDB(B1, 0, 1); PG8_STAGE(PG8_SB(0, 0), b2, voffB);
            PG8_BAR; PG8_WAIT_L(0); PG8_MMA(0, 1, At, B1); PG8_BAR;
            PG8_LDA(At, 0, 1); PG8_STAGE(PG8_SA(0, 0), a2, voffA);
            PG8_BAR; PG8_WAIT_L(0); PG8_MMA(1, 0, At, B0); PG8_BAR; PG8_SCHED;
            PG8_STAGE(PG8_SB(0, 1), b2 + hstep, voffB);
            PG8_WAIT_V(6); PG8_BAR; PG8_MMA(1, 1, At, B1); PG8_BAR;
            PG8_LDB(B0, 1, 0); PG8_SCHED; PG8_LDA(At, 1, 0); PG8_STAGE(PG8_SA(0, 1), a2 + hstep, voffA);
            PG8_WAIT_L(8); PG8_BAR; PG8_WAIT_L(0); PG8_MMA(0, 0, At, B0); PG8_BAR; PG8_SCHED;
            PG8_LDB(B1, 1, 1); PG8_STAGE(PG8_SB(1, 0), b3, voffB);
            PG8_BAR; PG8_WAIT_L(0); PG8_MMA(0, 1, At, B1); PG8_BAR;
            PG8_LDA(At, 1, 1); PG8_STAGE(PG8_SA(1, 0), a3, voffA);
            PG8_BAR; PG8_WAIT_L(0); PG8_MMA(1, 0, At, B0); PG8_BAR; PG8_SCHED;
            PG8_STAGE(PG8_SB(1, 1), b3 + hstep, voffB);
            PG8_WAIT_V(6); PG8_BAR; PG8_MMA(1, 1, At, B1); PG8_BAR;
            }
        }
        if constexpr (ALIGN_EPI) { if (wr == 0) PG8_BAR; }
        if constexpr (FP8) { asm volatile("s_nop 15\n\ts_nop 15" ::: "memory"); }
        if constexpr (!Epi::AFTER_DRAIN) { E(acc, cur, wr, wc, fr, fq);
#if defined(PROBE_EPI2)
            if constexpr (FP8 == (PROBE_EPI2 == 1)) { E(acc, cur, wr, wc, fr, fq); }
#endif
            S.done(cur); }
        if (!has_next) break;
#pragma unroll
        for (int a = 0; a < 2; ++a)
#pragma unroll
            for (int b = 0; b < 2; ++b)
#pragma unroll
                for (int m = 0; m < 4; ++m)
#pragma unroll
                    for (int n = 0; n < 2; ++n) acc[a][b][m][n] = (f32x4){0.f, 0.f, 0.f, 0.f};
        cur = nxt; cA = nA; cB = nB; ++ui;
        if constexpr (GATHER) { _Pragma("unroll") for (int h_ = 0; h_ < 2; ++h_) _Pragma("unroll") for (int i_ = 0; i_ < 2; ++i_) gAc[h_][i_] = gAn[h_][i_]; }
        if constexpr (ALIGN_EPI) { if (wr == 1) PG8_BAR; }
    }
    PG8_WAIT_V(0);
    if constexpr (!ALIGN_EPI) { if (wr == 0) PG8_BAR; }
    PG8_BAR;
    if constexpr (Epi::AFTER_DRAIN) { E.fused(acc, cur, wr, wc, fr, fq, lds, wid, lane); S.done(cur); }
#undef PG8_SA
#undef PG8_SB
#undef PG8_STAGE
#undef PG8_STAGE_A
#undef PG8_GATHER
#undef PG8_LDA
#undef PG8_LD32
#undef PG8_LDB
#undef PG8_MMA
#undef PG8_WAIT_V
#undef PG8_WAIT_L
#undef PG8_BAR
#undef PG8_SCHED
}
}

#ifndef PG8_SP2
#define PG8_SP2 true
#endif
#ifndef PG8_ALIGN
#define PG8_ALIGN true
#endif

#define GAS __attribute__((address_space(1)))
#define LAS __attribute__((address_space(3)))
typedef unsigned short bf16;
typedef unsigned v4u __attribute__((ext_vector_type(4)));
typedef unsigned v2u __attribute__((ext_vector_type(2)));
typedef float f32x4 __attribute__((ext_vector_type(4)));
typedef short bf16x8 __attribute__((ext_vector_type(8)));

constexpr int D = 1024, NB = 8, SEQ = 4096, CTXL = 256, TPB = SEQ + CTXL, NTOK = NB * TPB, NLAT = NB * SEQ;
constexpr int ZC = 3328;
constexpr int ZQ = 0, ZKV = 384, ZKR = 640, ZHQ = 672, ZHF = 1184, ZHB = 1696, ZHI = 2208, ZHG = 2720;
constexpr int NEXP = 32;
constexpr float ALPHA = 1.4142135623730951f;
constexpr float LN_EPS = 1e-5f, RMS_EPS = 1e-6f;
constexpr int NWAVES = 8, NTHR = 512;
constexpr float SC_X8 = 16.f, SC_WGU = 64.f, SC_ACT = 8.f, SC_WDN = 128.f, SC_Y = 64.f, SC_A1 = 16.f, SC_WPW = 64.f, SC_CV = 16.f, SC_A0 = 16.f, SC_WIN = 64.f;
constexpr int LDS_BYTES = 163840;
constexpr int LDS_BAR_OFF = LDS_BYTES - 64;
constexpr int LDS_TILE_E = 131072;
constexpr int MAXTILES = 576;
constexpr int LDS_EPI_B = 139264;
static_assert(LDS_TILE_E + (3 * MAXTILES + 96) * 4 <= LDS_EPI_B && LDS_EPI_B + 16384 <= LDS_BYTES - 64, "lds map");

constexpr size_t MiB = 1u << 20;
constexpr size_t WS_CTL = 0, CTL_ZERO_BYTES = 16384;
constexpr size_t WS_MODV = 1 * MiB;
constexpr size_t WS_ROPE = 1 * MiB + 512 * 1024;
constexpr size_t WS_BGU = 2 * MiB;
constexpr size_t WS_PW1B = 2 * MiB + 512 * 1024;
constexpr size_t WS_BCNT = WS_PW1B + 64 * 1024;
constexpr size_t WS_TILEE = WS_BCNT + 64 * 1024;
constexpr size_t WS_META = WS_TILEE + 4096;
constexpr size_t WS_TOPI = 3 * MiB, WS_TOPW = 4 * MiB;
constexpr int ECAP = 32768;
constexpr size_t WS_ROWS = 160 * MiB, WS_ROWW = 164 * MiB, WS_ROWD = 168 * MiB;
constexpr size_t WS_CURSOR = 14336;
constexpr size_t WS_WIN = 8 * MiB, WS_WUQ = 15 * MiB, WS_WUKV = 16 * MiB, WS_WOUT = 17 * MiB, WS_WPW1 = 19 * MiB, WS_WPW2 = 23 * MiB;
constexpr size_t WS_WGU = 32 * MiB, WS_WDN = 288 * MiB;
constexpr size_t WS_H = 416 * MiB;
constexpr size_t WS_X = 552 * MiB, WS_Y = 620 * MiB;
constexpr size_t WS_BIG = 688 * MiB;
constexpr size_t WS_Z = WS_BIG, WS_CQN = WS_BIG + 221 * MiB, WS_CKVN = WS_BIG + 247 * MiB, WS_KRR = WS_BIG + 264 * MiB,
                 WS_Q = WS_BIG + 267 * MiB, WS_KV = WS_BIG + 318 * MiB, WS_OF = WS_BIG + 386 * MiB, WS_OB = WS_BIG + 454 * MiB;
constexpr size_t WS_HT = WS_BIG + 528 * MiB;
constexpr size_t WS_PRE = WS_BIG;
constexpr size_t WS_XS = WS_BIG, WS_ACT = WS_BIG + 288 * MiB, WS_YB = WS_BIG + 576 * MiB;
constexpr size_t WS_END = WS_BIG + 848 * MiB;
static_assert((size_t)NTOK * ZC * 2 <= 221 * MiB && (size_t)NTOK * 384 * 2 <= 26 * MiB && (size_t)NTOK * 256 * 2 <= 17 * MiB && (size_t)NTOK * 32 * 2 <= 3 * MiB, "ws map 1");
static_assert((size_t)NTOK * 768 * 2 <= 51 * MiB && (size_t)NTOK * 1024 * 2 <= 68 * MiB && (size_t)NTOK * 512 * 4 <= 68 * MiB, "ws map 2");
static_assert((size_t)64 * 136 * 26624 <= 320 * MiB && (size_t)MAXTILES * 256 * 2048 <= 288 * MiB && (size_t)NLAT * 4 * 2048 <= 272 * MiB && (size_t)NTOK * 1024 * 4 <= 136 * MiB, "ws map 3");

#define LDS_WAIT() asm volatile("s_waitcnt lgkmcnt(0)" ::: "memory")
#define VM_WAIT() asm volatile("s_waitcnt vmcnt(0)" ::: "memory")
__device__ __forceinline__ float bf2f(unsigned short b) { return __uint_as_float(((unsigned)b) << 16); }
__device__ __forceinline__ unsigned pk2(float lo, float hi) { return pg8::cvt_pk_bf16(lo, hi); }
__device__ __forceinline__ float sigm(float x) { return __builtin_amdgcn_rcpf(1.f + __expf(-x)); }
__device__ __forceinline__ float wave_sum(float v) {
#pragma unroll
    for (int o = 1; o < 64; o <<= 1) v += __shfl_xor(v, o);
    return v;
}
__device__ __forceinline__ int ld_ctl(const int* p) { return (int)__hip_atomic_load((const unsigned*)p, __ATOMIC_RELAXED, __HIP_MEMORY_SCOPE_AGENT); }
__device__ __forceinline__ int grow_of(int lr) { return (lr >> 12) * TPB + CTXL + (lr & 4095); }

#define XB_TMO      128
#define XB_XCNT(j)  (256  + 64 * (j))
#define XB_XSUB(j)  (1280 + 64 * (j))
#define XB_XGEN(j)  (2304 + 64 * (j))
#define XB_TOP      3328
#define XB_TOPGEN   3392
#define XCD_BAR_WORDS 3456
#define XB_SPIN_CAP (1u << 21)

__device__ __forceinline__ unsigned xb_ld(unsigned* p)              { return __hip_atomic_load(p, __ATOMIC_RELAXED, __HIP_MEMORY_SCOPE_AGENT); }
__device__ __forceinline__ unsigned xb_add(unsigned* p, unsigned v) { return __hip_atomic_fetch_add(p, v, __ATOMIC_RELAXED, __HIP_MEMORY_SCOPE_AGENT); }
__device__ __forceinline__ unsigned xb_xcc_id() { return (unsigned)__builtin_amdgcn_s_getreg((3 << 11) | 20) & 0xFu; }
#define XB_SPIN(cond, bar) do { unsigned _sp = 0; while (cond) { __builtin_amdgcn_s_sleep(1); \
    if ((++_sp & 255u) == 0u) { if (xb_ld(&(bar)[XB_TMO])) break; if (_sp > XB_SPIN_CAP) { atomicAdd(&(bar)[XB_TMO], 1u); break; } } } } while (0)

struct XcdBarrier { unsigned* bar; unsigned x; volatile LAS unsigned* st; };

__device__ __forceinline__ XcdBarrier xcd_barrier_post(unsigned* bar, volatile LAS unsigned* st) {
    XcdBarrier b; b.bar = bar; b.x = xb_xcc_id(); b.st = st;
    if (threadIdx.x == 0) (void)xb_add(&bar[XB_XCNT(b.x)], 1u);
    return b;
}
__device__ __forceinline__ void xcd_barrier_complete(unsigned* bar, unsigned x, unsigned& nloc, unsigned& nx) {
    const unsigned G = gridDim.x * gridDim.y * gridDim.z;
    unsigned sum, cnt, mine, sp = 0u;
    for (;;) {
        sum = 0u; cnt = 0u; mine = 0u;
#pragma unroll
        for (unsigned j = 0; j < 16; ++j) { const unsigned c = xb_ld(&bar[XB_XCNT(j)]); sum += c; cnt += (c > 0u) ? 1u : 0u; mine = (j == x) ? c : mine; }
        if (sum == G) break;
        __builtin_amdgcn_s_sleep(1);
        if ((++sp & 255u) == 0u) { if (xb_ld(&bar[XB_TMO])) break; if (sp > XB_SPIN_CAP) { atomicAdd(&bar[XB_TMO], 1u); break; } }
    }
    nloc = mine > 0u ? mine : 1u; nx = cnt > 0u ? cnt : 1u;
}
__device__ __forceinline__ void xcd_barrier(const XcdBarrier& b) {
    asm volatile("s_waitcnt vmcnt(0)" ::: "memory");
    __syncthreads();
    if (threadIdx.x == 0) {
        unsigned* bar = b.bar;
        __builtin_amdgcn_s_waitcnt(0);
        unsigned nloc = b.st[0], nx = b.st[1];
        if (nloc == 0u) { xcd_barrier_complete(bar, b.x, nloc, nx); b.st[0] = nloc; b.st[1] = nx; }
        const unsigned old = xb_add(&bar[XB_XSUB(b.x)], 1u);
        const unsigned gen = old / nloc;
        if (old + 1u == (gen + 1u) * nloc) {
            __builtin_amdgcn_fence(__ATOMIC_RELEASE, "agent");
            asm volatile("s_waitcnt vmcnt(0)" ::: "memory");
            const unsigned og = xb_add(&bar[XB_TOP], 1u);
            const unsigned tg = og / nx;
            if (og + 1u == (tg + 1u) * nx) xb_add(&bar[XB_TOPGEN], 1u);
            else XB_SPIN(xb_ld(&bar[XB_TOPGEN]) == tg, bar);
            __builtin_amdgcn_fence(__ATOMIC_ACQUIRE, "agent");
            xb_add(&bar[XB_XGEN(b.x)], 1u);
            asm volatile("s_waitcnt vmcnt(0)" ::: "memory");
        } else {
            XB_SPIN(xb_ld(&bar[XB_XGEN(b.x)]) == gen, bar);
            __builtin_amdgcn_fence(__ATOMIC_ACQUIRE, "agent");
            asm volatile("s_waitcnt vmcnt(0)" ::: "memory");
        }
    }
    __syncthreads();
}

namespace pg8 {
struct TileOrder {
    int nM, nN, nwg, G, c;
    __device__ __forceinline__ void init(int nM_, int nN_, int G_, int c_) { nM = nM_; nN = nN_; nwg = nM * nN; G = G_; c = c_; }
    __device__ __forceinline__ bool logical(int i, int& im, int& in) const {
        const long L = (long)i * G + c; if (L >= nwg) return false;
        int wgid = (int)L; { const int q = nwg / NXCD, r = nwg % NXCD, xcd = wgid % NXCD, off = wgid / NXCD; wgid = (xcd < r ? xcd * (q + 1) : r * (q + 1) + (xcd - r) * q) + off; }
        const int nig = WGM * nN, gid = wgid / nig, fm = gid * WGM, gsz = (nM - fm) < WGM ? (nM - fm) : WGM;
        im = fm + ((wgid % nig) % gsz); in = (wgid % nig) / gsz; return true;
    }
    __device__ __forceinline__ void a_ready(const Unit&) const {}
    __device__ __forceinline__ void done(const Unit&) const {}
};
struct AllOrder : TileOrder { __device__ __forceinline__ bool next(int i, Unit& u) const { int im, in; if (!logical(i, im, in)) return false; u.pm = im; u.pn = in; return true; } };
struct LatOrder : TileOrder {
    __device__ __forceinline__ bool next(int i, Unit& u) const { int im, in; if (!logical(i, im, in)) return false; u.pm = (im >> 4) * 17 + 1 + (im & 15); u.pn = in; return true; } };
struct MoeOrder : TileOrder {
    const PG8_LAS int* tile_e; int nper;
    __device__ __forceinline__ bool next(int i, Unit& u) const { int im, in; if (!logical(i, im, in)) return false; u.pm = im; u.pn = tile_e[im] * nper + in; return true; } };

template <bool HB16> struct EpiRes {
    static constexpr bool PERM = true, AFTER_DRAIN = false;
    const float* xin; const bf16_t* h; bf16_t* pre; const float* modv; const float* bias; float ascale;
    __device__ __forceinline__ void operator()(const f32x4 (&acc)[2][2][4][2], const Unit& u, int wr, int wc, int fr, int fq) const {
        asm volatile("" : "+v"(fr), "+v"(fq));
        const int b = u.pm / 17, j = u.pm % 17;
        const int rl0 = wr * 64 + fr, col0 = u.pn * BM + wc * 32 + 8 * fq;
        const float* gate = modv + (size_t)b * 6144 + 2048;
        f32x4 gv[2][2], bv[2][2];
#pragma unroll
        for (int bj = 0; bj < 2; ++bj)
#pragma unroll
            for (int n = 0; n < 2; ++n) { gv[bj][n] = *(const f32x4*)(gate + col0 + bj * HALF + 4 * n); bv[bj][n] = bias ? *(const f32x4*)(bias + col0 + bj * HALF + 4 * n) : (f32x4){0.f, 0.f, 0.f, 0.f}; }
        if constexpr (HB16) {
#pragma unroll
        for (int ai = 0; ai < 2; ++ai) {
            u32x4 hb[4][2];
#pragma unroll
            for (int m = 0; m < 4; ++m) { const int rl = rl0 + ai * HALF + m * 16; const size_t grow = (size_t)u.pm * BM + rl; const bf16_t* hin = h + grow * 1024 + col0;
#pragma unroll
                for (int bj = 0; bj < 2; ++bj) hb[m][bj] = *(const u32x4*)(hin + bj * HALF); }
            asm volatile("" ::: "memory");
#pragma unroll
            for (int m = 0; m < 4; ++m) { const int rl = rl0 + ai * HALF + m * 16; const size_t grow = (size_t)u.pm * BM + rl; bf16_t* po = pre + grow * 1024 + col0;
#pragma unroll
                for (int bj = 0; bj < 2; ++bj) { const u32x4 q = hb[m][bj];
                    const f32x4 h0 = {__builtin_bit_cast(float, q.x << 16), __builtin_bit_cast(float, q.x & 0xffff0000u), __builtin_bit_cast(float, q.y << 16), __builtin_bit_cast(float, q.y & 0xffff0000u)};
                    const f32x4 h1 = {__builtin_bit_cast(float, q.z << 16), __builtin_bit_cast(float, q.z & 0xffff0000u), __builtin_bit_cast(float, q.w << 16), __builtin_bit_cast(float, q.w & 0xffff0000u)};
                    const f32x4 v0 = h0 * 1.4142135623730951f + gv[bj][0] * (acc[ai][bj][m][0] * ascale + bv[bj][0]), v1 = h1 * 1.4142135623730951f + gv[bj][1] * (acc[ai][bj][m][1] * ascale + bv[bj][1]);
                    u32x4 w; w.x = cvt_pk_bf16(v0[0], v0[1]); w.y = cvt_pk_bf16(v0[2], v0[3]); w.z = cvt_pk_bf16(v1[0], v1[1]); w.w = cvt_pk_bf16(v1[2], v1[3]);
                    *(u32x4*)(po + bj * HALF) = w; } }
            asm volatile("" ::: "memory"); }
        } else {
#pragma unroll
        for (int aim = 0; aim < 4; ++aim) { const int ai = aim >> 1, m0 = (aim & 1) * 2;
            f32x4 hv[2][2][2];
#pragma unroll
            for (int mm = 0; mm < 2; ++mm) { const int rl = rl0 + ai * HALF + (m0 + mm) * 16; const size_t grow = (size_t)u.pm * BM + rl;
                const float* hin = xin + ((size_t)b * 4096 + (size_t)(j - 1) * 256 + rl) * 1024 + col0; (void)grow;
#pragma unroll
                for (int bj = 0; bj < 2; ++bj) { hv[mm][bj][0] = *(const f32x4*)(hin + bj * HALF); hv[mm][bj][1] = *(const f32x4*)(hin + bj * HALF + 4); } }
            asm volatile("" ::: "memory");
#pragma unroll
            for (int mm = 0; mm < 2; ++mm) { const int m = m0 + mm; const int rl = rl0 + ai * HALF + m * 16; const size_t grow = (size_t)u.pm * BM + rl; bf16_t* po = pre + grow * 1024 + col0;
#pragma unroll
                for (int bj = 0; bj < 2; ++bj) {
                    const f32x4 v0 = hv[mm][bj][0] * 1.4142135623730951f + gv[bj][0] * (acc[ai][bj][m][0] * ascale + bv[bj][0]), v1 = hv[mm][bj][1] * 1.4142135623730951f + gv[bj][1] * (acc[ai][bj][m][1] * ascale + bv[bj][1]);
                    u32x4 w; w.x = cvt_pk_bf16(v0[0], v0[1]); w.y = cvt_pk_bf16(v0[2], v0[3]); w.z = cvt_pk_bf16(v1[0], v1[1]); w.w = cvt_pk_bf16(v1[2], v1[3]);
                    *(u32x4*)(po + bj * HALF) = w; } }
            asm volatile("" ::: "memory"); }
        }
    }
};
template <int MODE, bool OUT8 = false> struct EpiGate {
    static constexpr bool PERM = true, AFTER_DRAIN = false;
    bf16_t* O; const float* bias; int nper; float ascale, oscale;
    __device__ __forceinline__ void operator()(const f32x4 (&acc)[2][2][4][2], const Unit& u, int wr, int wc, int fr, int fq) const {
        asm volatile("" : "+v"(fr), "+v"(fq));
        const int row0 = u.pm * BM + wr * 64 + fr, pnl = u.pn % nper, ocol0 = pnl * HALF + wc * 32 + 8 * fq, bcol0 = u.pn * BM + wc * 32 + 8 * fq;
        const float s0 = ascale, s1 = MODE == 1 ? ascale * oscale : ascale;
        f32x4 bv[2][2];
#pragma unroll
        for (int n = 0; n < 2; ++n) { bv[0][n] = *(const f32x4*)(bias + bcol0 + 4 * n); const f32x4 t = *(const f32x4*)(bias + bcol0 + HALF + 4 * n); bv[1][n] = MODE == 1 ? (t + 1.0f) * oscale : t; }
#pragma unroll
        for (int ai = 0; ai < 2; ++ai)
#pragma unroll
            for (int m = 0; m < 4; ++m) { bf16_t* rowp = O + (size_t)(row0 + ai * HALF + m * 16) * 1024 + ocol0;
                unsigned char* rowp8 = (unsigned char*)O + (size_t)(row0 + ai * HALF + m * 16) * 1024 + ocol0;
                float o[8];
#pragma unroll
                for (int n = 0; n < 2; ++n) { const f32x4 a = acc[ai][0][m][n] * s0 + bv[0][n], g = acc[ai][1][m][n] * s1 + bv[1][n];
#pragma unroll
                    for (int e = 0; e < 4; ++e) {
                        if (MODE == 0) { o[4 * n + e] = a[e] * __builtin_amdgcn_rcpf(1.f + __builtin_amdgcn_exp2f(g[e] * -1.4426950408889634f)); }
                        else { const float gt = fminf(a[e], 7.0f), up1 = __builtin_amdgcn_fmed3f(g[e], -6.0f * oscale, 8.0f * oscale);
                            o[4 * n + e] = up1 * (gt * __builtin_amdgcn_rcpf(1.f + __builtin_amdgcn_exp2f(gt * (-1.702f * 1.4426950408889634f)))); } } }
                if constexpr (OUT8) {
                    int w0 = 0, w1 = 0; w0 = __builtin_amdgcn_cvt_pk_fp8_f32(o[0], o[1], w0, false); w0 = __builtin_amdgcn_cvt_pk_fp8_f32(o[2], o[3], w0, true);
                    w1 = __builtin_amdgcn_cvt_pk_fp8_f32(o[4], o[5], w1, false); w1 = __builtin_amdgcn_cvt_pk_fp8_f32(o[6], o[7], w1, true);
                    typedef unsigned u32x2 __attribute__((ext_vector_type(2))); *(u32x2*)rowp8 = (u32x2){(unsigned)w0, (unsigned)w1}; (void)rowp;
                } else { (void)rowp8;
                u32x4 w; w.x = cvt_pk_bf16(o[0], o[1]); w.y = cvt_pk_bf16(o[2], o[3]); w.z = cvt_pk_bf16(o[4], o[5]); w.w = cvt_pk_bf16(o[6], o[7]);
                *(u32x4*)rowp = w; } }
    }
};
struct EpiDown {
    static constexpr bool PERM = true, AFTER_DRAIN = false;
    bf16_t* Y; const float* bias; const float* row_w; const int* row_dst; float ascale; const PG8_LAS int* gtab; float oscale; PG8_LAS unsigned char* lds;
    __device__ __forceinline__ void operator()(const f32x4 (&acc)[2][2][4][2], const Unit& u, int wr, int wc, int fr, int fq) const {
        asm volatile("" : "+v"(fr), "+v"(fq));
        const int tid = (wr * 4 + wc) * 64 + fq * 16 + fr;
        const int pnl = u.pn & 3, bcol0 = u.pn * BM + wc * 32 + 8 * fq; const int tbase = gtab[u.pm], tcnt = gtab[576 + u.pm];
        f32x4 bv[2][2];
#pragma unroll
        for (int bj = 0; bj < 2; ++bj)
#pragma unroll
            for (int n = 0; n < 2; ++n) bv[bj][n] = *(const f32x4*)(bias + bcol0 + bj * HALF + 4 * n);
        float wv[2][4]; int dstv[2][2];
#pragma unroll
        for (int ai = 0; ai < 2; ++ai) {
#pragma unroll
            for (int m = 0; m < 4; ++m) { const int rl = wr * 64 + fr + ai * HALF + m * 16; wv[ai][m] = row_w[tbase + (rl < tcnt ? rl : 0)]; }
#pragma unroll
            for (int k = 0; k < 2; ++k) { const int rl = ai * HALF + (tid >> 3) + 64 * k; dstv[ai][k] = row_dst[tbase + (rl < tcnt ? rl : 0)]; } }
        PG8_LAS unsigned char* const reg0 = lds + 3 * HTB; PG8_LAS unsigned char* const reg1 = lds + LDS_EPI_B;
        const int wbase = (wr * 64 + fr) * 128 + (((wc * 4 + fq) ^ fr) * 8);
        const int rrow = tid >> 3, rch = tid & 7;
        typedef unsigned u32x2 __attribute__((ext_vector_type(2)));
#pragma unroll
        for (int ai = 0; ai < 2; ++ai) {
#pragma unroll
            for (int m = 0; m < 4; ++m) { const float w8 = wv[ai][m] * oscale;
#pragma unroll
                for (int bj = 0; bj < 2; ++bj) { const f32x4 v0 = (acc[ai][bj][m][0] * ascale + bv[bj][0]) * w8, v1 = (acc[ai][bj][m][1] * ascale + bv[bj][1]) * w8;
                    int w0 = 0, w1 = 0; w0 = __builtin_amdgcn_cvt_pk_fp8_f32(__builtin_amdgcn_fmed3f(v0[0], -448.f, 448.f), __builtin_amdgcn_fmed3f(v0[1], -448.f, 448.f), w0, false); w0 = __builtin_amdgcn_cvt_pk_fp8_f32(__builtin_amdgcn_fmed3f(v0[2], -448.f, 448.f), __builtin_amdgcn_fmed3f(v0[3], -448.f, 448.f), w0, true);
                    w1 = __builtin_amdgcn_cvt_pk_fp8_f32(__builtin_amdgcn_fmed3f(v1[0], -448.f, 448.f), __builtin_amdgcn_fmed3f(v1[1], -448.f, 448.f), w1, false); w1 = __builtin_amdgcn_cvt_pk_fp8_f32(__builtin_amdgcn_fmed3f(v1[2], -448.f, 448.f), __builtin_amdgcn_fmed3f(v1[3], -448.f, 448.f), w1, true);
                    *(PG8_LAS u32x2*)((bj ? reg1 : reg0) + wbase + m * 2048) = (u32x2){(unsigned)w0, (unsigned)w1}; } }
            asm volatile("s_waitcnt lgkmcnt(0)" ::: "memory"); __builtin_amdgcn_s_barrier();
            u32x4 rd[2][2];
#pragma unroll
            for (int bj = 0; bj < 2; ++bj)
#pragma unroll
                for (int k = 0; k < 2; ++k) { const int row = rrow + 64 * k; rd[bj][k] = *(const PG8_LAS u32x4*)((bj ? reg1 : reg0) + row * 128 + ((rch ^ ((row & 15) >> 1)) * 16)); }
            asm volatile("s_waitcnt lgkmcnt(0)" ::: "memory"); __builtin_amdgcn_s_barrier();
#pragma unroll
            for (int k = 0; k < 2; ++k) { const int row = rrow + 64 * k, rl = ai * HALF + row;
                if (rl < tcnt) { unsigned char* rowp = (unsigned char*)Y + (size_t)dstv[ai][k] * 1024 + pnl * BM + rch * 16;
#pragma unroll
                    for (int bj = 0; bj < 2; ++bj) { u32x4 q = rd[bj][k]; if (row & 1) q = (u32x4){q.z, q.w, q.x, q.y}; *(u32x4*)(rowp + bj * HALF) = q; } } }
        }
    }
};
}

namespace att {
using bf16x8 = __attribute__((ext_vector_type(8))) short;
using s16x4  = __attribute__((ext_vector_type(4))) short;
using f32x16 = __attribute__((ext_vector_type(16))) float;
using u32x4  = __attribute__((ext_vector_type(4))) unsigned;
constexpr int NW = 8, QBLK = 32, KVBLK = 64;
constexpr float SCALE = 0.10206207261596575f;
constexpr float THR = 8.f;
constexpr int SHM_V = 16384, SHM_K = 16384, NBUF = 3, SHM_ATTN = NBUF * SHM_V + NBUF * SHM_K + NW * 64 * 4;
#define KSWZ(row, colB) ((row) * 256 + ((colB) ^ (((row) & 7) << 4)))
#define SBAR() __builtin_amdgcn_sched_barrier(0)
__device__ __forceinline__ int crow(int r, int hi) { return (r & 3) + 8 * (r >> 2) + 4 * hi; }
__device__ __forceinline__ unsigned cvtpk(float lo, float hi) { unsigned r; asm volatile("v_cvt_pk_bf16_f32 %0, %1, %2" : "=v"(r) : "v"(lo), "v"(hi)); return r; }

__device__ __forceinline__ void partialSM(f32x16& p0, f32x16& p1, float& m_reg, float& mn, float& alpha) {
  constexpr float C = SCALE * 1.4426950408889634f;
  float pmax = p0[0];
#pragma unroll
  for (int r = 1; r < 16; ++r) pmax = fmaxf(pmax, p0[r]);
#pragma unroll
  for (int r = 0; r < 16; ++r) pmax = fmaxf(pmax, p1[r]);
  { auto rr = __builtin_amdgcn_permlane32_swap(__float_as_uint(pmax), __float_as_uint(pmax), false, false);
    pmax = fmaxf(__uint_as_float(rr[0]), __uint_as_float(rr[1])); }
  if (__builtin_expect(__all(pmax - m_reg <= THR / SCALE), 1)) { mn = m_reg; alpha = 1.f; }
  else { mn = fmaxf(m_reg, pmax); alpha = __builtin_amdgcn_exp2f((m_reg - mn) * C); m_reg = mn; }
  float mnC = -mn * C;
#pragma unroll
  for (int r = 0; r < 16; ++r) p0[r] = fmaf(p0[r], C, mnC);
#pragma unroll
  for (int r = 0; r < 16; ++r) p1[r] = fmaf(p1[r], C, mnC);
#pragma unroll
  for (int r = 0; r < 16; ++r) p0[r] = __builtin_amdgcn_exp2f(p0[r]);
}
__device__ __forceinline__ void finishSM(f32x16& p0, f32x16& p1, float alpha, float& l_reg, bf16x8& pa0, bf16x8& pa1, bf16x8& pa2, bf16x8& pa3) {
#pragma unroll
  for (int r = 0; r < 16; ++r) p1[r] = __builtin_amdgcn_exp2f(p1[r]);
  float ps = 0;
#pragma unroll
  for (int r = 0; r < 16; ++r) ps += p0[r];
#pragma unroll
  for (int r = 0; r < 16; ++r) ps += p1[r];
  { auto rr = __builtin_amdgcn_permlane32_swap(__float_as_uint(ps), __float_as_uint(ps), false, false);
    ps = __uint_as_float(rr[0]) + __uint_as_float(rr[1]); }
  l_reg = l_reg * alpha + ps;
#define PK4(P, BASE, OUT) do { unsigned a0 = cvtpk(P[BASE + 0], P[BASE + 1]), a1 = cvtpk(P[BASE + 2], P[BASE + 3]);   \
    unsigned b0 = cvtpk(P[BASE + 4], P[BASE + 5]), b1 = cvtpk(P[BASE + 6], P[BASE + 7]);                              \
    auto r0 = __builtin_amdgcn_permlane32_swap(a0, b0, false, false); auto r1 = __builtin_amdgcn_permlane32_swap(a1, b1, false, false); \
    u32x4 w = {r0[0], r1[0], r0[1], r1[1]}; OUT = *reinterpret_cast<bf16x8*>(&w); } while (0)
  PK4(p0, 0, pa0); PK4(p0, 8, pa1); PK4(p1, 0, pa2); PK4(p1, 8, pa3);
#undef PK4
}
__device__ __forceinline__ void qkt(f32x16& p0, f32x16& p1, const bf16* Ks, const bf16x8* qr, int r32, int hi) {
  p0 = f32x16{}; p1 = f32x16{};
#pragma unroll
  for (int d0 = 0; d0 < 6; ++d0) { int cb = (d0 * 16 + hi * 8) * 2;
    bf16x8 b0 = *reinterpret_cast<const bf16x8*>((const char*)Ks + KSWZ(r32, cb));
    bf16x8 b1 = *reinterpret_cast<const bf16x8*>((const char*)Ks + KSWZ(32 + r32, cb));
    p0 = __builtin_amdgcn_mfma_f32_32x32x16_bf16(b0, qr[d0], p0, 0, 0, 0);
    p1 = __builtin_amdgcn_mfma_f32_32x32x16_bf16(b1, qr[d0], p1, 0, 0, 0); }
}
__device__ __forceinline__ int v_st(int k, int c) { const int kk = (k & ~0xC) | ((k & 4) << 1) | ((k & 8) >> 1); return ((kk >> 3) * 4 + (c >> 5)) * 512 + ((kk & 7) * 32 + (c & 31)) * 2; }
__device__ __forceinline__ int v_rd_base(int lane) { return ((lane & 3) << 3) | (((lane >> 2) & 3) << 6) | (((lane >> 4) & 1) << 5) | (((lane >> 5) & 1) << 8); }
constexpr int v_rd_off(int d0, int ks, int half) { return d0 * 512 + ks * 4096 + half * 2048; }
template <int OFF> __device__ __forceinline__ s16x4 tr_read(int vb) {
  s16x4 r; asm volatile("ds_read_b64_tr_b16 %0, %1 offset:%2" : "=&v"(r) : "v"(vb), "i"(OFF) : "memory"); return r;
}
template <int D0> __device__ __forceinline__ void pv_one(f32x16& od, int vb, bf16x8 pa0, bf16x8 pa1, bf16x8 pa2, bf16x8 pa3) {
  const s16x4 l0 = tr_read<v_rd_off(D0, 0, 0)>(vb), h0 = tr_read<v_rd_off(D0, 0, 1)>(vb), l1 = tr_read<v_rd_off(D0, 1, 0)>(vb), h1 = tr_read<v_rd_off(D0, 1, 1)>(vb);
  const s16x4 l2 = tr_read<v_rd_off(D0, 2, 0)>(vb), h2 = tr_read<v_rd_off(D0, 2, 1)>(vb), l3 = tr_read<v_rd_off(D0, 3, 0)>(vb), h3 = tr_read<v_rd_off(D0, 3, 1)>(vb);
  asm volatile("s_waitcnt lgkmcnt(0)" ::: "memory"); SBAR();
#define PK(L, H) (bf16x8){L[0], L[1], L[2], L[3], H[0], H[1], H[2], H[3]}
  od = __builtin_amdgcn_mfma_f32_32x32x16_bf16(pa0, PK(l0, h0), od, 0, 0, 0);
  od = __builtin_amdgcn_mfma_f32_32x32x16_bf16(pa1, PK(l1, h1), od, 0, 0, 0);
  od = __builtin_amdgcn_mfma_f32_32x32x16_bf16(pa2, PK(l2, h2), od, 0, 0, 0);
  od = __builtin_amdgcn_mfma_f32_32x32x16_bf16(pa3, PK(l3, h3), od, 0, 0, 0);
#undef PK
}
__device__ __forceinline__ void pv_d0(f32x16* o, int vb, bf16x8 pa0, bf16x8 pa1, bf16x8 pa2, bf16x8 pa3) {
  pv_one<0>(o[0], vb, pa0, pa1, pa2, pa3); pv_one<1>(o[1], vb, pa0, pa1, pa2, pa3);
}
__device__ __forceinline__ bf16x8 rope8(bf16x8 x, const float* tab, int pbase) {
  u32x4 w;
#pragma unroll
  for (int i = 0; i < 4; ++i) { const float x1 = __uint_as_float(((unsigned)(unsigned short)x[2 * i]) << 16), x2 = __uint_as_float(((unsigned)(unsigned short)x[2 * i + 1]) << 16);
    const float cs = tab[pbase + i], sn = tab[16 + pbase + i]; w[i] = cvtpk(x1 * cs - x2 * sn, x1 * sn + x2 * cs); }
  return *reinterpret_cast<bf16x8*>(&w);
}
__device__ __forceinline__ void attn_unit(const bf16* __restrict__ Qb, const bf16* __restrict__ KVb, const bf16* __restrict__ KRb, bf16* __restrict__ Ob,
                                          const float* __restrict__ rope, int seq, char* lds) {
  int tid_l = threadIdx.x; asm volatile("" : "+v"(tid_l));
  const int tid = tid_l, wid = tid >> 6, lane = tid & 63, r32 = lane & 31, hi = lane >> 5;
  bf16* V_lds = (bf16*)lds; bf16* K_lds = (bf16*)(lds + NBUF * SHM_V);
  float* ws = (float*)(lds + NBUF * SHM_V + NBUF * SHM_K) + wid * 64; float* li_l = ws; float* al_l = ws + 32;
  float m_reg = -1e30f, l_reg = 0; f32x16 o[2] = {}; bf16x8 qr[6];
  const bf16* Qw = Qb + (long)(wid * QBLK + r32) * 768 + hi * 8;
#pragma unroll
  for (int d0 = 0; d0 < 6; ++d0) qr[d0] = *reinterpret_cast<const bf16x8*>(Qw + d0 * 16);
  if (rope) { const float* tab = rope + (long)(wid * QBLK + r32) * 32; qr[4] = rope8(qr[4], tab, 4 * hi); qr[5] = rope8(qr[5], tab, 8 + 4 * hi); }
  const int sr = tid >> 4, ch = tid & 15;
  const bf16* kbase = ch < 8 ? KVb + ch * 8 : KRb + ((ch - 8) & 3) * 8; const long kstr = ch < 8 ? 1024 : 32;
  const int vkey = tid >> 3, vc8 = (tid & 7) * 8, vst0 = v_st(vkey, vc8);
  const bf16* vbase = KVb + 512 + vc8;
  const int vb0 = (int)(uintptr_t)V_lds + v_rd_base(lane);
  struct { bf16x8 vs0, ks0, ks1; } sr_[2];
#define SLOAD(i, k0) do { sr_[i].vs0 = *reinterpret_cast<const bf16x8*>(vbase + (long)((k0) + vkey) * 1024); \
    sr_[i].ks0 = *reinterpret_cast<const bf16x8*>(kbase + (long)((k0) + sr) * kstr); sr_[i].ks1 = *reinterpret_cast<const bf16x8*>(kbase + (long)((k0) + 32 + sr) * kstr); } while (0)
#define SWRITE(b, i) do { *(bf16x8*)((char*)V_lds + (b) * SHM_V + vst0) = sr_[i].vs0; int kc = ch * 16;               \
    *(bf16x8*)((char*)K_lds + (b) * SHM_K + KSWZ(sr, kc)) = sr_[i].ks0;                       \
    *(bf16x8*)((char*)K_lds + (b) * SHM_K + KSWZ(32 + sr, kc)) = sr_[i].ks1; } while (0)
#define SWAIT() asm volatile("s_waitcnt vmcnt(3)" ::: "memory")
#define RESC(a) do { if (__any((a) < 1.f)) { if (hi == 0) al_l[r32] = (a); asm volatile("s_waitcnt lgkmcnt(0)" ::: "memory"); \
    _Pragma("unroll") for (int d = 0; d < 2; ++d) _Pragma("unroll") for (int r = 0; r < 16; ++r) o[d][r] *= al_l[crow(r, hi)]; } } while (0)
  f32x16 pA0, pA1, pB0, pB1; float mnA, mnB, alA, alB; bf16x8 pa0, pa1, pa2, pa3; const int NT = seq / KVBLK;
  constexpr int SE = 0, SO = 1;
  SLOAD(SE, 0); asm volatile("s_waitcnt vmcnt(0)" ::: "memory"); SWRITE(0, SE); __syncthreads();
  qkt(pA0, pA1, K_lds, qr, r32, hi); partialSM(pA0, pA1, m_reg, mnA, alA);
  SLOAD(SO, KVBLK); if (2 < NT) SLOAD(SE, 2 * KVBLK);
  SWAIT(); SWRITE(1, SO); __syncthreads();
  int bprev = 0, bcur = 1, bnext = 2;
#define ATT_STEP(PN0, PN1, MNN, ALN, PO0, PO1, ALO, SL_LOAD, SL_WRITE, t) do { \
    SBAR(); qkt(PN0, PN1, (bf16*)((char*)K_lds + bcur * SHM_K), qr, r32, hi); \
    finishSM(PO0, PO1, ALO, l_reg, pa0, pa1, pa2, pa3); SBAR(); \
    if ((t) + 2 < NT) SLOAD(SL_LOAD, ((t) + 2) * KVBLK); SBAR(); \
    pv_d0(o, vb0 + bprev * (int)SHM_V, pa0, pa1, pa2, pa3); partialSM(PN0, PN1, m_reg, MNN, ALN); \
    SWAIT(); SWRITE(bnext, SL_WRITE); \
    RESC(ALN); __syncthreads(); \
    bprev = bcur; bcur = bnext; bnext = (bnext == 2) ? 0 : bnext + 1; } while (0)
  for (int j = 1; j + 1 < NT; j += 2) {
    ATT_STEP(pB0, pB1, mnB, alB, pA0, pA1, alA, SO, SE, j);
    ATT_STEP(pA0, pA1, mnA, alA, pB0, pB1, alB, SE, SO, j + 1);
  }
#undef ATT_STEP
  SBAR(); qkt(pB0, pB1, (bf16*)((char*)K_lds + bcur * SHM_K), qr, r32, hi);
  finishSM(pA0, pA1, alA, l_reg, pa0, pa1, pa2, pa3); SBAR();
  pv_d0(o, vb0 + bprev * (int)SHM_V, pa0, pa1, pa2, pa3); partialSM(pB0, pB1, m_reg, mnB, alB);
  RESC(alB);
  finishSM(pB0, pB1, alB, l_reg, pa0, pa1, pa2, pa3); SBAR();
  pv_d0(o, vb0 + bcur * (int)SHM_V, pa0, pa1, pa2, pa3);
  if (hi == 0) li_l[r32] = l_reg; asm volatile("s_waitcnt lgkmcnt(0)" ::: "memory");
  float rli[16];
#pragma unroll
  for (int r = 0; r < 16; ++r) rli[r] = __builtin_amdgcn_rcpf(li_l[crow(r, hi)]);
  bf16* Ow = Ob + (long)(wid * QBLK) * 1024;
#pragma unroll
  for (int r = 0; r < 16; ++r) { int orow = crow(r, hi);
#pragma unroll
    for (int d0 = 0; d0 < 2; ++d0) { const float v = o[d0][r] * rli[r]; Ow[(long)orow * 1024 + d0 * 32 + r32] = (bf16)(cvtpk(v, v) & 0xffffu); } }
#undef SLOAD
#undef SWRITE
#undef SWAIT
#undef RESC
}
}

struct Args { const float* in[33]; float* out; unsigned char* ws; int ph_lo, ph_hi; };
enum { I_X = 0, I_C, I_CTX, I_CCTX, I_MODW, I_MODB, I_LN1G, I_LN1B, I_LN2G, I_LN2B, I_WIN, I_QNORM, I_KVNORM, I_WUQ, I_WUK, I_WUV, I_LBL, I_HGNORM, I_WOUT,
       I_PW1W, I_PW1B, I_DWW, I_DWB, I_CLNG, I_CLNB, I_PW2W, I_PW2B, I_RW, I_RB, I_WGU, I_BGU, I_WDN, I_BDN };

__device__ __forceinline__ int dst_row(int n, int mode, int row_off) {
    if (mode == 0) return row_off + n;
    int f, g; if (mode == 1) { f = n >> 1; g = n & 1; } else { g = n >> 10; f = n & 1023; }
    return row_off + 256 * (f >> 7) + 128 * g + (f & 127);
}
__device__ __forceinline__ unsigned pack_fp8x4(float a, float b, float c, float d) { int w = 0; w = __builtin_amdgcn_cvt_pk_fp8_f32(fminf(fmaxf(a, -448.f), 448.f), fminf(fmaxf(b, -448.f), 448.f), w, false);
    w = __builtin_amdgcn_cvt_pk_fp8_f32(fminf(fmaxf(c, -448.f), 448.f), fminf(fmaxf(d, -448.f), 448.f), w, true); return (unsigned)w; }
struct TrItem { const float* W; bf16* WT; int K, N, mode, row_off, item; float f8scale; };
__device__ __forceinline__ void tr_load(const TrItem& d, f32x4 (&v)[16], int lane) {
    const int nblk = (d.N + 63) >> 6, kb = d.item / nblk, nb = d.item - kb * nblk, k0 = 64 * kb, n0 = 64 * nb;
    const int nc = n0 + 4 * (lane & 15), kr = lane >> 4;
#pragma unroll
    for (int i = 0; i < 16; ++i) v[i] = (nc < d.N) ? __builtin_nontemporal_load((const f32x4*)(d.W + (size_t)(k0 + 4 * i + kr) * d.N + nc)) : (f32x4){0.f, 0.f, 0.f, 0.f};
}
__device__ __forceinline__ void tr_lds_write(const f32x4 (&v)[16], LAS float* scr, int lane) {
    const int kr = lane >> 4;
#pragma unroll
    for (int i = 0; i < 16; ++i) { LAS float* s = scr + (4 * i + kr) * 65 + 4 * (lane & 15); s[0] = v[i][0]; s[1] = v[i][1]; s[2] = v[i][2]; s[3] = v[i][3]; }
}
__device__ __forceinline__ void tr_store(const TrItem& d, LAS float* scr, int lane) {
    const int nblk = (d.N + 63) >> 6, kb = d.item / nblk, nb = d.item - kb * nblk, k0 = 64 * kb, n0 = 64 * nb;
    const int c = lane & 7; const int K = d.K;
#pragma unroll
    for (int j = 0; j < 8; ++j) { const int nl = (lane >> 3) + 8 * j, n = n0 + nl; const LAS float* s = scr + (8 * c) * 65 + nl;
        if (n < d.N) { if (d.f8scale > 0.f) { const float f8 = d.f8scale; v2u o8; o8.x = pack_fp8x4(s[0 * 65] * f8, s[1 * 65] * f8, s[2 * 65] * f8, s[3 * 65] * f8); o8.y = pack_fp8x4(s[4 * 65] * f8, s[5 * 65] * f8, s[6 * 65] * f8, s[7 * 65] * f8);
                *(v2u*)((unsigned char*)d.WT + (size_t)dst_row(n, d.mode, d.row_off) * K + k0 + 8 * c) = o8; }
            else { v4u o; o.x = pk2(s[0 * 65], s[1 * 65]); o.y = pk2(s[2 * 65], s[3 * 65]); o.z = pk2(s[4 * 65], s[5 * 65]); o.w = pk2(s[6 * 65], s[7 * 65]);
                *(v4u*)(d.WT + (size_t)dst_row(n, d.mode, d.row_off) * K + k0 + 8 * c) = o; } } }
}
__device__ __forceinline__ void convert_items(const Args& a, unsigned char* ws, LAS float* scr, int lane, int gw, int NGW, int it_lo, int it_hi) {
    constexpr int I0 = 16 * 51, I1 = 6 * 12, I2 = 4 * 8, I3 = 4 * 8, I4 = 256, I5 = 512;
    constexpr int NGU = 64 * 512, NDN = 64 * 256;
    auto decode = [&](int it) -> TrItem {
        TrItem d; int r = it; d.f8scale = 0.f; d.mode = 0; d.row_off = 0;
        if (r < NGU) { const int mi = r >> 9; d.W = a.in[I_WGU] + (size_t)mi * 1024 * 2048; d.K = 1024; d.N = 2048; d.WT = (bf16*)(ws + WS_WGU + (size_t)mi * 2048 * 1024); d.mode = 1; d.item = r & 511; d.f8scale = SC_WGU; return d; } r -= NGU;
        if (r < NDN) { const int mi = r >> 8; d.W = a.in[I_WDN] + (size_t)mi * 1024 * 1024; d.K = 1024; d.N = 1024; d.WT = (bf16*)(ws + WS_WDN + (size_t)mi * 1024 * 1024); d.item = r & 255; d.f8scale = SC_WDN; return d; } r -= NDN;
        if (r < I0) { d.W = a.in[I_WIN]; d.K = 1024; d.N = 3232; d.WT = (bf16*)(ws + WS_WIN); d.item = r; d.f8scale = SC_WIN; return d; } r -= I0;
        if (r < I1) { d.W = a.in[I_WUQ]; d.K = 384; d.N = 768; d.WT = (bf16*)(ws + WS_WUQ); d.item = r; return d; } r -= I1;
        if (r < I2) { d.W = a.in[I_WUK]; d.K = 256; d.N = 512; d.WT = (bf16*)(ws + WS_WUKV); d.item = r; return d; } r -= I2;
        if (r < I3) { d.W = a.in[I_WUV]; d.K = 256; d.N = 512; d.WT = (bf16*)(ws + WS_WUKV); d.row_off = 512; d.item = r; return d; } r -= I3;
        if (r < I4) { d.W = a.in[I_WOUT]; d.K = 1024; d.N = 1024; d.WT = (bf16*)(ws + WS_WOUT); d.item = r; return d; } r -= I4;
        if (r < I5) { d.W = a.in[I_PW1W]; d.K = 1024; d.N = 2048; d.WT = (bf16*)(ws + WS_WPW1); d.mode = 2; d.item = r; d.f8scale = SC_WPW; return d; } r -= I5;
        d.W = a.in[I_PW2W]; d.K = 1024; d.N = 1024; d.WT = (bf16*)(ws + WS_WPW2); d.item = r; d.f8scale = SC_WPW; return d; };
    f32x4 tv[16];
    int it = it_lo + gw;
    if (it < it_hi) { const TrItem d0 = decode(it); tr_load(d0, tv, lane); }
    for (; it < it_hi; it += NGW) {
        const TrItem d = decode(it);
        tr_lds_write(tv, scr, lane);
        if (it + NGW < it_hi) { const TrItem dn = decode(it + NGW); tr_load(dn, tv, lane); }
        LDS_WAIT();
        tr_store(d, scr, lane);
        LDS_WAIT();
    }
}
__device__ __forceinline__ void phase_prologue(const Args& a, LAS unsigned char* lds, int tid, int lane, int wave) {
    unsigned char* ws = a.ws;
    const int G = gridDim.x, B = blockIdx.x;
    {
        LAS float* sc = (LAS float*)lds;
        LAS float* red = (LAS float*)(lds + 36864);
        float* modv = (float*)(ws + WS_MODV);
        bool have = false;
        for (int it = B; it < 192; it += G) {
            if (!have) { for (int i = tid; i < 9 * 1024; i += NTHR) { const int r = i >> 10, k = i & 1023; const float x = r < 8 ? a.in[I_C][r * 1024 + k] : a.in[I_CCTX][k]; sc[i] = x * sigm(x); } __syncthreads(); have = true; }
            const int l = it / 96, jc = it % 96, kg = tid >> 6, jj = tid & 63, j = jc * 64 + jj;
            float acc[9];
#pragma unroll
            for (int r = 0; r < 9; ++r) acc[r] = 0.f;
            const float* wp = a.in[I_MODW] + ((size_t)l * 1024 + kg * 128) * 6144 + j;
            for (int k0 = 0; k0 < 128; k0 += 16) { float w[16];
#pragma unroll
                for (int kk = 0; kk < 16; ++kk) w[kk] = wp[(size_t)(k0 + kk) * 6144];
#pragma unroll
                for (int kk = 0; kk < 16; ++kk)
#pragma unroll
                    for (int r = 0; r < 9; ++r) acc[r] += sc[r * 1024 + kg * 128 + k0 + kk] * w[kk]; }
#pragma unroll
            for (int r = 0; r < 9; ++r) red[(kg * 9 + r) * 64 + jj] = acc[r];
            __syncthreads();
            for (int i = tid; i < 576; i += NTHR) { const int r = i >> 6, j2 = i & 63; float s = a.in[I_MODB][l * 6144 + jc * 64 + j2];
#pragma unroll
                for (int g = 0; g < 8; ++g) s += red[(g * 9 + r) * 64 + j2];
                modv[((size_t)l * 9 + r) * 6144 + jc * 64 + j2] = s; }
            __syncthreads();
        }
        __syncthreads();
    }
    const int gw = B * NWAVES + wave, NGW = G * NWAVES, gt = B * NTHR + tid, NGT = G * NTHR;
    { float* rope = (float*)(ws + WS_ROPE);
      for (int i = gt; i < 4096 * 16; i += NGT) { const int t = i >> 4, p = i & 15; const float pos = (float)(p < 8 ? (t >> 6) : (t & 63));
          const float inv = __powf(10000.0f, -(float)(p & 7) * 0.125f); const float ang = pos * inv; rope[t * 32 + p] = cosf(ang); rope[t * 32 + 16 + p] = sinf(ang); }
      float* bgu = (float*)(ws + WS_BGU);
      for (int i = gt; i < 2 * 32 * 2048; i += NGT) { const int le = i >> 11, np = i & 2047, q = np >> 8, g = (np >> 7) & 1, r = np & 127, f = 128 * q + r; bgu[i] = a.in[I_BGU][(size_t)le * 2048 + 2 * f + g]; }
      float* pb = (float*)(ws + WS_PW1B);
      for (int i = gt; i < 2048; i += NGT) { const int q = i >> 8, g = (i >> 7) & 1, r = i & 127, f = 128 * q + r; pb[i] = a.in[I_PW1B][g * 1024 + f]; }
      v4u* zp = (v4u*)(ws + WS_WIN + (size_t)3232 * 1024);
      for (int i = gt; i < 96 * 1024 / 16; i += NGT) zp[i] = (v4u){0u, 0u, 0u, 0u};
    }
    LAS float* scr = (LAS float*)(lds + wave * 16640);
    constexpr int I0 = 16 * 51, I1 = 6 * 12, I2 = 4 * 8, I3 = 4 * 8, I4 = 256, I5 = 512, I6 = 256, SMALL = I0 + I1 + I2 + I3 + I4 + I5 + I6;
    constexpr int NGU = 64 * 512, NDN = 64 * 256, NITEMS = SMALL + NGU + NDN;
    convert_items(a, ws, scr, lane, B * NWAVES + wave, G * NWAVES, NGU + NDN, NITEMS);
}
__device__ __forceinline__ void convert_moe_share(const Args& a, LAS unsigned char* lds, int lane, int wave) {
    LAS float* scr = (LAS float*)(lds + wave * 16640);
    constexpr int NGU = 64 * 512, NDN = 64 * 256;
    convert_items(a, a.ws, scr, lane, blockIdx.x * NWAVES + wave, gridDim.x * NWAVES, 0, NGU + NDN);
}

__device__ __forceinline__ void phase_mod0(const Args& a, int lane, int wave) {
    const int gw = blockIdx.x * NWAVES + wave, NGW = gridDim.x * NWAVES;
    const float* modv = (const float*)(a.ws + WS_MODV);
    bf16* X = (bf16*)(a.ws + WS_X);
    f32x4 xv[2][4], xn[2][4];
#define MOD0_LOAD(dst, r0_) do { _Pragma("unroll") for (int q = 0; q < 2; ++q) { const int r = (r0_) + q; const int b = r / TPB, p = r - b * TPB; \
            const float* src = p < CTXL ? a.in[I_CTX] + ((size_t)b * CTXL + p) * 1024 : a.in[I_X] + ((size_t)b * SEQ + (p - CTXL)) * 1024; \
            _Pragma("unroll") for (int j = 0; j < 4; ++j) dst[q][j] = *(const f32x4*)(src + 4 * (lane + 64 * j)); } } while (0)
    if (2 * gw < NTOK) MOD0_LOAD(xv, 2 * gw);
    for (int r0 = 2 * gw; r0 < NTOK; r0 += 2 * NGW) {
        f32x4 shv[2][4], scv[2][4];
#pragma unroll
        for (int q = 0; q < 2; ++q) { const int r = r0 + q; const int b = r / TPB, p = r - b * TPB; const float* mvp = modv + (size_t)(p < CTXL ? 8 : b) * 6144;
#pragma unroll
            for (int j = 0; j < 4; ++j) { const int c = 4 * (lane + 64 * j); shv[q][j] = *(const f32x4*)(mvp + c); scv[q][j] = *(const f32x4*)(mvp + 1024 + c); } }
        if (r0 + 2 * NGW < NTOK) MOD0_LOAD(xn, r0 + 2 * NGW);
#pragma unroll
        for (int q = 0; q < 2; ++q)
#pragma unroll
            for (int j = 0; j < 4; ++j) { const int c = 4 * (lane + 64 * j); const f32x4 sh = shv[q][j], sc = scv[q][j];
                const f32x4 y = (xv[q][j] * (sc + 1.0f) + sh) * SC_A0; *(unsigned*)((unsigned char*)X + (size_t)(r0 + q) * 1024 + c) = pack_fp8x4(y[0], y[1], y[2], y[3]); }
#pragma unroll
        for (int q = 0; q < 2; ++q)
#pragma unroll
            for (int j = 0; j < 4; ++j) xv[q][j] = xn[q][j];
    }
#undef MOD0_LOAD
}

__device__ __forceinline__ void phase_norm0(const Args& a, int lane, int wave) {
    const int gw = blockIdx.x * NWAVES + wave, NGW = gridDim.x * NWAVES;
    const bf16* Z = (const bf16*)(a.ws + WS_Z); bf16* CQN = (bf16*)(a.ws + WS_CQN); bf16* CKVN = (bf16*)(a.ws + WS_CKVN); bf16* KRR = (bf16*)(a.ws + WS_KRR);
    const float* rope = (const float*)(a.ws + WS_ROPE);
    float gq[8], gk[8];
#pragma unroll
    for (int i = 0; i < 8; ++i) { gq[i] = lane < 48 ? a.in[I_QNORM][8 * lane + i] : 0.f; gk[i] = lane < 32 ? a.in[I_KVNORM][8 * lane + i] : 0.f; }
    bf16x8 q8 = {}, k8 = {}, r8 = {}, nq8 = {}, nk8 = {}, nr8 = {};
#define N0_LOAD(dq, dk, dr, r_) do { const bf16* z_ = Z + (size_t)(r_) * ZC; if (lane < 48) dq = *(const bf16x8*)(z_ + ZQ + 8 * lane); if (lane < 32) dk = *(const bf16x8*)(z_ + ZKV + 8 * lane); if (lane < 4) dr = *(const bf16x8*)(z_ + ZKR + 8 * lane); } while (0)
    if (gw < NTOK) N0_LOAD(q8, k8, r8, gw);
    for (int r = gw; r < NTOK; r += NGW, q8 = nq8, k8 = nk8, r8 = nr8) {
        const int p = r % TPB;
        if (r + NGW < NTOK) N0_LOAD(nq8, nk8, nr8, r + NGW);
        float qf[8], kf[8], sq = 0.f, sk = 0.f;
#pragma unroll
        for (int i = 0; i < 8; ++i) { qf[i] = bf2f((unsigned short)q8[i]); kf[i] = bf2f((unsigned short)k8[i]); sq += qf[i] * qf[i]; sk += kf[i] * kf[i]; }
        sq = wave_sum(sq); sk = wave_sum(sk);
        const float rq = rsqrtf(sq * (1.f / 384.f) + RMS_EPS), rk = rsqrtf(sk * (1.f / 256.f) + RMS_EPS);
        if (lane < 48) { v4u o; o.x = pk2(qf[0] * rq * gq[0], qf[1] * rq * gq[1]); o.y = pk2(qf[2] * rq * gq[2], qf[3] * rq * gq[3]); o.z = pk2(qf[4] * rq * gq[4], qf[5] * rq * gq[5]); o.w = pk2(qf[6] * rq * gq[6], qf[7] * rq * gq[7]);
            *(v4u*)(CQN + (size_t)r * 384 + 8 * lane) = o; }
        if (lane < 32) { v4u o; o.x = pk2(kf[0] * rk * gk[0], kf[1] * rk * gk[1]); o.y = pk2(kf[2] * rk * gk[2], kf[3] * rk * gk[3]); o.z = pk2(kf[4] * rk * gk[4], kf[5] * rk * gk[5]); o.w = pk2(kf[6] * rk * gk[6], kf[7] * rk * gk[7]);
            *(v4u*)(CKVN + (size_t)r * 256 + 8 * lane) = o; }
        if (lane < 4) { bf16x8 o8 = r8; if (p >= CTXL) o8 = att::rope8(r8, rope + (size_t)(p - CTXL) * 32, 4 * lane); *(bf16x8*)(KRR + (size_t)r * 32 + 8 * lane) = o8; }
    }
#undef N0_LOAD
}

__device__ __forceinline__ void hgrn_unit(const Args& a, int unit, LAS unsigned char* lds, int tid) {
    const int b = unit >> 5, head = (unit >> 3) & 3, dir = (unit >> 2) & 1, sl = unit & 3;
    const bf16* Z = (const bf16*)(a.ws + WS_Z);
    float* Od = (float*)(a.ws + (dir ? WS_OB : WS_OF));
    LAS float* lbv = (LAS float*)lds;
    constexpr int BUF0 = 1024, BUFSZ = 28672, OFF_Q = 16384, OFF_V = 24576;
    if (tid < 128) { const int c = head * 128 + tid; const float l0 = a.in[I_LBL][c], l1 = a.in[I_LBL][512 + c], l2 = a.in[I_LBL][1024 + c]; const float m = fmaxf(l0, fmaxf(l1, l2));
        const float e0 = __expf(l0 - m), e1 = __expf(l1 - m), e2 = __expf(l2 - m); lbv[tid] = e0 / (e0 + e1 + e2); }
    __syncthreads();
    const int lt = tid >> 4, lcg = tid & 15;
    float lb8[8];
#pragma unroll
    for (int i = 0; i < 8; ++i) lb8[i] = lbv[8 * lcg + i];
    const int fcol = (dir ? ZHB : ZHF) + head * 128 + 8 * lcg, qcol = ZHQ + head * 128 + 8 * lcg;
    const int vt = tid >> 2, vcol = ZHI + head * 128 + sl * 32 + (tid & 3) * 8;
    const int wave = tid >> 6, lane = tid & 63, vv = lane >> 4, cg = lane & 15, vloc = wave * 4 + vv;
    const size_t zb = (size_t)b * TPB;
    bf16x8 rq, rf, rv;
#define TOKP(n) (dir ? ((n) < CTXL ? (CTXL - 1 - (n)) : (TPB + CTXL - 1 - (n))) : (n))
#define HG_LOAD(i) do { const int n_ = 32 * (i) + lt; const bf16* zr_ = Z + (zb + TOKP(n_)) * ZC; rq = *(const bf16x8*)(zr_ + qcol); rf = *(const bf16x8*)(zr_ + fcol); \
        if (tid < 128) { const int n2_ = 32 * (i) + vt; rv = *(const bf16x8*)(Z + (zb + TOKP(n2_)) * ZC + vcol); } } while (0)
#define HG_WRITE(bufi) do { LAS unsigned char* bp_ = lds + BUF0 + (bufi) * BUFSZ; float f_[8]; \
        _Pragma("unroll") for (int i_ = 0; i_ < 8; ++i_) f_[i_] = lb8[i_] + (1.f - lb8[i_]) * sigm(bf2f((unsigned short)rf[i_])); \
        *(LAS f32x4*)(bp_ + ((lt * 128 + lcg * 4) * 4)) = (f32x4){f_[0], f_[1], f_[2], f_[3]}; *(LAS f32x4*)(bp_ + ((lt * 128 + 64 + lcg * 4) * 4)) = (f32x4){f_[4], f_[5], f_[6], f_[7]}; \
        *(LAS bf16x8*)(bp_ + OFF_Q + (lt * 128 + lcg * 8) * 2) = rq; \
        if (tid < 128) { float v_[8]; _Pragma("unroll") for (int i_ = 0; i_ < 8; ++i_) v_[i_] = bf2f((unsigned short)rv[i_]); \
            *(LAS f32x4*)(bp_ + OFF_V + (vt * 32 + (tid & 3) * 8) * 4) = (f32x4){v_[0], v_[1], v_[2], v_[3]}; *(LAS f32x4*)(bp_ + OFF_V + (vt * 32 + (tid & 3) * 8 + 4) * 4) = (f32x4){v_[4], v_[5], v_[6], v_[7]}; } } while (0)
    float S[8];
#pragma unroll
    for (int j = 0; j < 8; ++j) S[j] = 0.f;
    HG_LOAD(0); HG_WRITE(0); __syncthreads();
    const bool b3 = (cg & 8) != 0, b2 = (cg & 4) != 0, b1 = (cg & 2) != 0, b0 = (cg & 1) != 0;
    for (int i = 0; i < TPB / 32; ++i) {
        if (i + 1 < TPB / 32) HG_LOAD(i + 1);
        const LAS unsigned char* bp = lds + BUF0 + (i & 1) * BUFSZ;
#pragma unroll 1
        for (int g = 0; g < 4; ++g) {
            const LAS unsigned char* gp = bp + g * 8 * 512;
            float ot[8];
#pragma unroll
            for (int t = 0; t < 8; ++t) {
                const f32x4 f0 = *(const LAS f32x4*)(gp + ((t * 128 + cg * 4) * 4)), f1 = *(const LAS f32x4*)(gp + ((t * 128 + 64 + cg * 4) * 4));
                const bf16x8 q8 = *(const LAS bf16x8*)(bp + OFF_Q + ((g * 8 + t) * 128 + cg * 8) * 2);
                const float v = *(const LAS float*)(bp + OFF_V + ((g * 8 + t) * 32 + vloc) * 4);
                float acc = 0.f;
#pragma unroll
                for (int j = 0; j < 8; ++j) { const float fj = j < 4 ? f0[j] : f1[j - 4]; const float qj = bf2f((unsigned short)q8[j]);
                    const float kv = fmaf(-fj, v, v); S[j] = fmaf(fj, S[j], kv); acc = fmaf(S[j], qj, acc); }
                ot[t] = acc;
            }
#pragma unroll
            for (int k = 0; k < 4; ++k) { const float snd = b3 ? ot[k] : ot[k + 4]; const float rcv = __shfl_xor(snd, 8); ot[k] = (b3 ? ot[k + 4] : ot[k]) + rcv; }
#pragma unroll
            for (int k = 0; k < 2; ++k) { const float snd = b2 ? ot[k] : ot[k + 2]; const float rcv = __shfl_xor(snd, 4); ot[k] = (b2 ? ot[k + 2] : ot[k]) + rcv; }
            { const float snd = b1 ? ot[0] : ot[1]; const float rcv = __shfl_xor(snd, 2); ot[0] = (b1 ? ot[1] : ot[0]) + rcv; }
            ot[0] += __shfl_xor(ot[0], 1);
            if (!b0) { const int n = 32 * i + 8 * g + (cg >> 1); const int p = TOKP(n); if (p >= CTXL) Od[(zb + p) * 512 + head * 128 + sl * 32 + vloc] = ot[0]; }
        }
        if (i + 1 < TPB / 32) HG_WRITE((i + 1) & 1);
        __syncthreads();
    }
#undef TOKP
#undef HG_LOAD
#undef HG_WRITE
}

__device__ __forceinline__ void phase_readout(const Args& a, int lane, int wave) {
    const int gw = blockIdx.x * NWAVES + wave, NGW = gridDim.x * NWAVES;
    const bf16* OF = (const bf16*)(a.ws + WS_OF); const bf16* OB = (const bf16*)(a.ws + WS_OB);
    const bf16* Z = (const bf16*)(a.ws + WS_Z); bf16* MIX = (bf16*)(a.ws + WS_Y);
    float hn[8];
#pragma unroll
    for (int i = 0; i < 8; ++i) hn[i] = a.in[I_HGNORM][((8 * lane) & 127) + i];
    bf16x8 a8 = {}, c8 = {}, g8 = {}, na8 = {}, nc8 = {}, ng8 = {};
#define RO_LOAD(da, dc, dg, lr_) do { const size_t r_ = (size_t)grow_of(lr_); da = *(const bf16x8*)(OF + r_ * 512 + 8 * lane); dc = *(const bf16x8*)(OB + r_ * 512 + 8 * lane); dg = *(const bf16x8*)(Z + r_ * ZC + ZHG + 8 * lane); } while (0)
    if (gw < NLAT) RO_LOAD(a8, c8, g8, gw);
    for (int lr = gw; lr < NLAT; lr += NGW, a8 = na8, c8 = nc8, g8 = ng8) {
        const size_t r = (size_t)grow_of(lr);
        if (lr + NGW < NLAT) RO_LOAD(na8, nc8, ng8, lr + NGW);
        float o[8]; float ss = 0.f;
#pragma unroll
        for (int i = 0; i < 8; ++i) o[i] = bf2f((unsigned short)a8[i]) + bf2f((unsigned short)c8[i]);
#pragma unroll
        for (int i = 0; i < 8; ++i) ss += o[i] * o[i];
        ss += __shfl_xor(ss, 1); ss += __shfl_xor(ss, 2); ss += __shfl_xor(ss, 4); ss += __shfl_xor(ss, 8);
        const float rs = rsqrtf(ss * (1.f / 128.f) + RMS_EPS);
        float y[8];
#pragma unroll
        for (int i = 0; i < 8; ++i) { const float g = bf2f((unsigned short)g8[i]); y[i] = o[i] * rs * hn[i] * (g * sigm(g)); }
        v4u w; w.x = pk2(y[0], y[1]); w.y = pk2(y[2], y[3]); w.z = pk2(y[4], y[5]); w.w = pk2(y[6], y[7]);
        *(v4u*)(MIX + r * 1024 + 512 + 8 * lane) = w;
    }
#undef RO_LOAD
}

__device__ __forceinline__ int rows_per_block() { const int G = gridDim.x; return (((NLAT + G - 1) / G) + 15) & ~15; }
__device__ __forceinline__ void phase_ln1(const Args& a, int l, LAS unsigned char* lds, int tid, int lane, int wave) {
    typedef short bf16x8s __attribute__((ext_vector_type(8)));
    const int RB = rows_per_block(), lr_base = blockIdx.x * RB;
    const bf16* PRE = (const bf16*)(a.ws + WS_PRE); bf16* XB = (bf16*)(a.ws + WS_X);
    const float* modv = (const float*)(a.ws + WS_MODV) + (size_t)l * 9 * 6144;
    const float* lng = a.in[I_LN1G] + l * 1024; const float* lnb = a.in[I_LN1B] + l * 1024;
    const float* rw = a.in[I_RW] + (size_t)l * 1024 * 32; const float* rb = a.in[I_RB] + l * 32;
    constexpr int XT_LD = 1028, O_PART = 16 * XT_LD * 4, O_LG = O_PART + 8 * 32 * 16 * 4, O_HIST = O_LG + 16 * 33 * 4 + 64, O_CCNT = O_HIST + 256, O_TIL = O_CCNT + 2048, O_TWL = O_TIL + 4096;
    LAS float* XT = (LAS float*)lds; LAS float* PART = (LAS float*)(lds + O_PART); LAS float* LG = (LAS float*)(lds + O_LG);
    LAS int* hist = (LAS int*)(lds + O_HIST);
    LAS int* ccnt = (LAS int*)(lds + O_CCNT);
    LAS int* til = (LAS int*)(lds + O_TIL);
    LAS float* twl = (LAS float*)(lds + O_TWL);
    __syncthreads();
    if (tid < 32) hist[tid] = 0;
    bf16x8s whi[2][4], wlo[2][4];
    { const int e15 = lane & 15, kq = lane >> 4;
#pragma unroll
      for (int t = 0; t < 2; ++t)
#pragma unroll
          for (int sI = 0; sI < 4; ++sI) { float wv[8];
#pragma unroll
              for (int j = 0; j < 8; ++j) wv[j] = rw[(size_t)(128 * wave + 32 * sI + 8 * kq + j) * 32 + 16 * t + e15];
              v4u ph, pl;
#pragma unroll
              for (int j = 0; j < 4; ++j) { const unsigned p = pk2(wv[2 * j], wv[2 * j + 1]); const float h0 = __uint_as_float(p << 16), h1 = __uint_as_float(p & 0xffff0000u); ph[j] = p; pl[j] = pk2(wv[2 * j] - h0, wv[2 * j + 1] - h1); }
              whi[t][sI] = __builtin_bit_cast(bf16x8s, ph); wlo[t][sI] = __builtin_bit_cast(bf16x8s, pl); } }
    const int ngroups = RB / 16;
    f32x4 fP[4], fQ[4]; int fb = -1;
    const float rbias = rb[tid >> 4];
    v2u xr[2][4];
#define LN1_LOAD(g) do { _Pragma("unroll") for (int rr_ = 0; rr_ < 2; ++rr_) { const int lr_ = lr_base + 16 * (g) + 2 * wave + rr_; const size_t r_ = (size_t)grow_of(lr_ < NLAT ? lr_ : NLAT - 1); \
        _Pragma("unroll") for (int j_ = 0; j_ < 4; ++j_) xr[rr_][j_] = *(const v2u*)(PRE + r_ * 1024 + 4 * (lane + 64 * j_)); } } while (0)
#if defined(PROBE_LN1X2)
    for (int rep_ = 0; rep_ < 2; ++rep_) { __syncthreads(); if (tid < 32) hist[tid] = 0; __syncthreads();
#endif
    LN1_LOAD(0);
    for (int g = 0; g < ngroups; ++g) {
#pragma unroll
        for (int rr = 0; rr < 2; ++rr) {
            const int lr = lr_base + 16 * g + 2 * wave + rr; const bool ok = lr < NLAT; const size_t r = (size_t)grow_of(ok ? lr : NLAT - 1); const int b = (ok ? lr : NLAT - 1) >> 12;
            if (b != fb) { const float* mv = modv + (size_t)b * 6144; fb = b;
#pragma unroll
                for (int j = 0; j < 4; ++j) { const int c = 4 * (lane + 64 * j); const f32x4 gg = *(const f32x4*)(lng + c), bb = *(const f32x4*)(lnb + c), sh = *(const f32x4*)(mv + 3 * 1024 + c), sc = *(const f32x4*)(mv + 4 * 1024 + c);
                    fP[j] = gg * (sc + 1.0f); fQ[j] = bb * (sc + 1.0f) + sh; } }
            f32x4 x[4]; float s = 0.f;
#pragma unroll
            for (int j = 0; j < 4; ++j) { const v2u p = xr[rr][j]; x[j] = (f32x4){__uint_as_float(p.x << 16), __uint_as_float(p.x & 0xffff0000u), __uint_as_float(p.y << 16), __uint_as_float(p.y & 0xffff0000u)}; s += (x[j][0] + x[j][1]) + (x[j][2] + x[j][3]); }
            const float mean = wave_sum(s) * (1.f / 1024.f); float s2 = 0.f;
#pragma unroll
            for (int j = 0; j < 4; ++j) { x[j] = x[j] - mean; s2 += (x[j][0] * x[j][0] + x[j][1] * x[j][1]) + (x[j][2] * x[j][2] + x[j][3] * x[j][3]); }
            const float rstd = rsqrtf(wave_sum(s2) * (1.f / 1024.f) + LN_EPS);
#pragma unroll
            for (int j = 0; j < 4; ++j) { const int c = 4 * (lane + 64 * j);
                const f32x4 bm = (x[j] * rstd) * fP[j] + fQ[j];
                if (ok) *(unsigned*)((unsigned char*)XB + r * 1024 + c) = pack_fp8x4(bm[0] * SC_X8, bm[1] * SC_X8, bm[2] * SC_X8, bm[3] * SC_X8);
                *(LAS f32x4*)(XT + (2 * wave + rr) * XT_LD + c) = bm; }
        }
        if (g + 1 < ngroups) LN1_LOAD(g + 1);
        __syncthreads();
        { const int rr = lane & 15, kq = lane >> 4;
          f32x4 acc0 = {0.f, 0.f, 0.f, 0.f}, acc1 = {0.f, 0.f, 0.f, 0.f};
#pragma unroll
          for (int sI = 0; sI < 4; ++sI) { const LAS float* xp = XT + rr * XT_LD + 128 * wave + 32 * sI + 8 * kq; const f32x4 v0 = *(const LAS f32x4*)xp, v1 = *(const LAS f32x4*)(xp + 4);
              const float bv[8] = {v0[0], v0[1], v0[2], v0[3], v1[0], v1[1], v1[2], v1[3]}; v4u ph, pl;
#pragma unroll
              for (int j = 0; j < 4; ++j) { const unsigned p = pk2(bv[2 * j], bv[2 * j + 1]); const float h0 = __uint_as_float(p << 16), h1 = __uint_as_float(p & 0xffff0000u); ph[j] = p; pl[j] = pk2(bv[2 * j] - h0, bv[2 * j + 1] - h1); }
              const bf16x8s bh = __builtin_bit_cast(bf16x8s, ph), bl = __builtin_bit_cast(bf16x8s, pl);
              acc0 = __builtin_amdgcn_mfma_f32_16x16x32_bf16(whi[0][sI], bh, acc0, 0, 0, 0); acc0 = __builtin_amdgcn_mfma_f32_16x16x32_bf16(whi[0][sI], bl, acc0, 0, 0, 0); acc0 = __builtin_amdgcn_mfma_f32_16x16x32_bf16(wlo[0][sI], bh, acc0, 0, 0, 0);
              acc1 = __builtin_amdgcn_mfma_f32_16x16x32_bf16(whi[1][sI], bh, acc1, 0, 0, 0); acc1 = __builtin_amdgcn_mfma_f32_16x16x32_bf16(whi[1][sI], bl, acc1, 0, 0, 0); acc1 = __builtin_amdgcn_mfma_f32_16x16x32_bf16(wlo[1][sI], bh, acc1, 0, 0, 0); }
#pragma unroll
          for (int q = 0; q < 4; ++q) { PART[(wave * 32 + 4 * kq + q) * 16 + rr] = acc0[q]; PART[(wave * 32 + 16 + 4 * kq + q) * 16 + rr] = acc1[q]; } }
        __syncthreads();
        { const int e = tid >> 4, rr = tid & 15; float sacc = rbias;
#pragma unroll
          for (int w = 0; w < 8; ++w) sacc += PART[(w * 32 + e) * 16 + rr];
          LG[rr * 33 + e] = sacc; }
        __syncthreads();
        if (wave == (g & 7) && lane < 16) { const int lr = lr_base + 16 * g + lane;
            if (lr < NLAT) { float lg[32];
#pragma unroll
                for (int e = 0; e < 32; ++e) lg[e] = LG[lane * 33 + e];
                unsigned taken = 0u; float tv[4]; int ti[4];
#pragma unroll
                for (int kk = 0; kk < 4; ++kk) { float best = -3.0e38f; int bi = 0;
#pragma unroll
                    for (int e = 0; e < 32; ++e) { const bool okk = (lg[e] > best) && !((taken >> e) & 1u); best = okk ? lg[e] : best; bi = okk ? e : bi; }
                    taken |= 1u << bi; tv[kk] = best; ti[kk] = bi; }
                const float e1 = __expf(tv[1] - tv[0]), e2 = __expf(tv[2] - tv[0]), e3 = __expf(tv[3] - tv[0]); const float inv = 1.f / (1.f + e1 + e2 + e3);
                const int li = (16 * g + lane) * 4; til[li] = ti[0]; til[li + 1] = ti[1]; til[li + 2] = ti[2]; til[li + 3] = ti[3]; twl[li] = inv; twl[li + 1] = e1 * inv; twl[li + 2] = e2 * inv; twl[li + 3] = e3 * inv;
                __hip_atomic_fetch_add(hist + ti[0], 1, __ATOMIC_RELAXED, __HIP_MEMORY_SCOPE_WORKGROUP); __hip_atomic_fetch_add(hist + ti[1], 1, __ATOMIC_RELAXED, __HIP_MEMORY_SCOPE_WORKGROUP);
                __hip_atomic_fetch_add(hist + ti[2], 1, __ATOMIC_RELAXED, __HIP_MEMORY_SCOPE_WORKGROUP); __hip_atomic_fetch_add(hist + ti[3], 1, __ATOMIC_RELAXED, __HIP_MEMORY_SCOPE_WORKGROUP); } }
    }
#if defined(PROBE_LN1X2)
    }
#endif
#undef LN1_LOAD
    __syncthreads();
    int* cursor = (int*)(a.ws + WS_CURSOR) + l * 32;
    int* rows = (int*)(a.ws + WS_ROWS); float* roww = (float*)(a.ws + WS_ROWW); int* rowd = (int*)(a.ws + WS_ROWD);
    int nrows = NLAT - lr_base; nrows = nrows > RB ? RB : nrows; if (nrows < 0) nrows = 0;
    const int nas = nrows * 4, nchunks = (nas + 63) >> 6;
    int basev = 0; if (tid < 32) basev = (int)__hip_atomic_fetch_add((unsigned*)cursor + tid, (unsigned)hist[tid], __ATOMIC_RELAXED, __HIP_MEMORY_SCOPE_AGENT);
    int myrank[2] = {0, 0}, mye[2] = {-1, -1};
#pragma unroll
    for (int cc = 0; cc < 2; ++cc) { const int c = wave + 8 * cc; if (c < nchunks) { const int idx = c * 64 + lane; const int e = idx < nas ? til[idx] : -1; mye[cc] = e;
        for (int x = 0; x < 32; ++x) { const unsigned long long m = __ballot(e == x); if (e == x) myrank[cc] = __popcll(m & ((1ull << lane) - 1ull)); if (lane == 0) ccnt[c * 32 + x] = __popcll(m); } } }
    __syncthreads();
    if (tid < 32) hist[32 + tid] = basev;
    __syncthreads();
#pragma unroll
    for (int cc = 0; cc < 2; ++cc) { const int c = wave + 8 * cc; const int idx = c * 64 + lane; if (c < nchunks && idx < nas) { const int e = mye[cc]; int pos = hist[32 + e] + myrank[cc]; for (int c2 = 0; c2 < c; ++c2) pos += ccnt[c2 * 32 + e];
        const int lr = lr_base + (idx >> 2); const size_t pi = (size_t)e * ECAP + pos; rows[pi] = grow_of(lr); roww[pi] = twl[idx]; rowd[pi] = lr * 4 + (idx & 3); } }
}

__device__ __forceinline__ void phase_ln2(const Args& a, int l, int lane, int wave) {
    const int gw = blockIdx.x * NWAVES + wave, NGW = gridDim.x * NWAVES;
    float* H = (float*)(a.ws + WS_H); const bf16* PRE = (const bf16*)(a.ws + WS_PRE); const unsigned char* YB = (const unsigned char*)(a.ws + WS_YB); bf16* A1 = (bf16*)(a.ws + WS_Y);
    const float* modv = (const float*)(a.ws + WS_MODV);
    const float* ln1g = a.in[I_LN1G] + l * 1024; const float* ln1b = a.in[I_LN1B] + l * 1024;
    const float* lng = a.in[I_LN2G] + l * 1024; const float* lnb = a.in[I_LN2B] + l * 1024;
    f32x4 P1[4], Q1[4], G2[4], g2v[4], b2v[4], P3[4], Q3[4]; int fb = -1;
    const int rows_w = (((NLAT + NGW - 1) / NGW) + 1) & ~1, lr_lo = gw * rows_w, lr_hi = lr_lo + rows_w < NLAT ? lr_lo + rows_w : NLAT;
    for (int lr0 = lr_lo; lr0 < lr_hi; lr0 += 2) {
        v2u hv[2][4]; unsigned yv[2][4][4];
#pragma unroll
        for (int q = 0; q < 2; ++q) { const int lr = lr0 + q; const size_t r = (size_t)grow_of(lr);
#pragma unroll
            for (int j = 0; j < 4; ++j) { const int c = 4 * (lane + 64 * j); hv[q][j] = *(const v2u*)(PRE + r * 1024 + c);
#pragma unroll
                for (int k = 0; k < 4; ++k) yv[q][j][k] = *(const unsigned*)(YB + ((size_t)lr * 4 + k) * 1024 + c); } }
#pragma unroll
        for (int q = 0; q < 2; ++q) {
            const int lr = lr0 + q; const size_t r = (size_t)grow_of(lr); const int b = lr >> 12;
            if (b != fb) { fb = b; const float* mv = modv + ((size_t)l * 9 + b) * 6144; const float* mv1 = modv + ((size_t)9 + b) * 6144;
#pragma unroll
                for (int j = 0; j < 4; ++j) { const int c = 4 * (lane + 64 * j); const f32x4 g1 = *(const f32x4*)(ln1g + c), b1 = *(const f32x4*)(ln1b + c), gt = *(const f32x4*)(mv + 5 * 1024 + c);
                    P1[j] = g1 * ALPHA; Q1[j] = b1 * ALPHA; G2[j] = gt * (1.f / SC_Y); g2v[j] = *(const f32x4*)(lng + c); b2v[j] = *(const f32x4*)(lnb + c);
                    if (l == 0) { const f32x4 sh = *(const f32x4*)(mv1 + c), sc = *(const f32x4*)(mv1 + 1024 + c); P3[j] = g2v[j] * (sc + 1.0f) * SC_A1; Q3[j] = (b2v[j] * (sc + 1.0f) + sh) * SC_A1; } } }
            f32x4 x[4]; float s = 0.f;
#pragma unroll
            for (int j = 0; j < 4; ++j) { const v2u p = hv[q][j]; x[j] = (f32x4){__uint_as_float(p.x << 16), __uint_as_float(p.x & 0xffff0000u), __uint_as_float(p.y << 16), __uint_as_float(p.y & 0xffff0000u)}; s += (x[j][0] + x[j][1]) + (x[j][2] + x[j][3]); }
            float mean = wave_sum(s) * (1.f / 1024.f), s2 = 0.f;
#pragma unroll
            for (int j = 0; j < 4; ++j) { x[j] = x[j] - mean; s2 += (x[j][0] * x[j][0] + x[j][1] * x[j][1]) + (x[j][2] * x[j][2] + x[j][3] * x[j][3]); }
            float rstd = rsqrtf(wave_sum(s2) * (1.f / 1024.f) + LN_EPS);
            s = 0.f;
#pragma unroll
            for (int j = 0; j < 4; ++j) { f32x4 f = {0.f, 0.f, 0.f, 0.f};
#pragma unroll
                for (int k = 0; k < 4; ++k) { const unsigned y = yv[q][j][k]; const auto lo = __builtin_amdgcn_cvt_pk_f32_fp8((int)y, false), hi = __builtin_amdgcn_cvt_pk_f32_fp8((int)y, true);
                    f[0] += lo[0]; f[1] += lo[1]; f[2] += hi[0]; f[3] += hi[1]; }
                x[j] = (x[j] * rstd) * P1[j] + Q1[j] + G2[j] * f; s += (x[j][0] + x[j][1]) + (x[j][2] + x[j][3]); }
            mean = wave_sum(s) * (1.f / 1024.f); s2 = 0.f;
#pragma unroll
            for (int j = 0; j < 4; ++j) { x[j] = x[j] - mean; s2 += (x[j][0] * x[j][0] + x[j][1] * x[j][1]) + (x[j][2] * x[j][2] + x[j][3] * x[j][3]); }
            rstd = rsqrtf(wave_sum(s2) * (1.f / 1024.f) + LN_EPS);
#pragma unroll
            for (int j = 0; j < 4; ++j) { const int c = 4 * (lane + 64 * j); const f32x4 xh = x[j] * rstd;
                const f32x4 o = xh * g2v[j] + b2v[j];
                if (l == 0) { v2u hw; hw.x = pk2(o[0], o[1]); hw.y = pk2(o[2], o[3]); *(v2u*)((bf16*)H + r * 1024 + c) = hw;
                    const f32x4 am = xh * P3[j] + Q3[j]; *(unsigned*)((unsigned char*)A1 + r * 1024 + c) = pack_fp8x4(am[0], am[1], am[2], am[3]); }
                else *(f32x4*)(a.out + (size_t)lr * 1024 + c) = o; }
        }
    }
}

__device__ __forceinline__ void phase_conv(const Args& a, LAS unsigned char* lds, int tid, int lane, int wave) {
    const bf16* U = (const bf16*)(a.ws + WS_X); bf16* V = (bf16*)(a.ws + WS_Y);
    LAS float* part = (LAS float*)(lds + 126976);
    LAS float* st = part + 512;
    const int c0 = 2 * tid;
    const float db0 = a.in[I_DWB][c0], db1 = a.in[I_DWB][c0 + 1], g0 = a.in[I_CLNG][c0], g1 = a.in[I_CLNG][c0 + 1], be0 = a.in[I_CLNB][c0], be1 = a.in[I_CLNB][c0 + 1];
    for (int tile = blockIdx.x; tile < NLAT / 32; tile += gridDim.x) {
        const int b = tile >> 7, t0 = (tile & 127) * 32;
        const size_t rb0 = (size_t)b * TPB + CTXL;
        __syncthreads();
        for (int i = tid; i < 62 * 128; i += NTHR) { const int row = i >> 7, chk = i & 127, t = t0 - 15 + row;
            v4u val = {0u, 0u, 0u, 0u}; if (t >= 0 && t < SEQ) val = *(const v4u*)(U + (rb0 + t) * 1024 + chk * 8);
            *(LAS v4u*)(lds + row * 2048 + chk * 16) = val; }
        __syncthreads();
        float w0[31], w1[31];
#pragma unroll
        for (int j = 0; j < 31; ++j) { const float2 wv = *(const float2*)(a.in[I_DWW] + j * 1024 + c0); w0[j] = wv.x; w1[j] = wv.y; }
#pragma unroll 1
        for (int hh = 0; hh < 2; ++hh) {
            const LAS unsigned char* hp = lds + hh * 16 * 2048;
            float acc0[16], acc1[16];
#pragma unroll
            for (int t = 0; t < 16; ++t) { acc0[t] = db0; acc1[t] = db1; }
#pragma unroll
            for (int s = 0; s < 46; ++s) { const unsigned pr = *(const LAS unsigned*)(hp + s * 2048 + tid * 4); const float x0 = __uint_as_float(pr << 16), x1 = __uint_as_float(pr & 0xffff0000u);
#pragma unroll
                for (int t = (s > 30 ? s - 30 : 0); t <= (s < 15 ? s : 15); ++t) { acc0[t] = fmaf(x0, w0[s - t], acc0[t]); acc1[t] = fmaf(x1, w1[s - t], acc1[t]); } }
            float rs[32];
#pragma unroll
            for (int t = 0; t < 16; ++t) { rs[2 * t] = acc0[t] + acc1[t]; rs[2 * t + 1] = acc0[t] * acc0[t] + acc1[t] * acc1[t]; }
#define RS_STEP(NKEEP, XORV) { const bool bit_ = (lane & XORV) != 0; _Pragma("unroll") for (int k_ = 0; k_ < NKEEP; ++k_) { const float snd_ = bit_ ? rs[k_] : rs[k_ + NKEEP]; const float rcv_ = __shfl_xor(snd_, XORV); rs[k_] = (bit_ ? rs[k_ + NKEEP] : rs[k_]) + rcv_; } }
            RS_STEP(16, 32) RS_STEP(8, 16) RS_STEP(4, 8) RS_STEP(2, 4) RS_STEP(1, 2)
#undef RS_STEP
            rs[0] += __shfl_xor(rs[0], 1);
            __syncthreads();
            if ((lane & 1) == 0) part[wave * 32 + (lane >> 1)] = rs[0];
            __syncthreads();
            if (tid < 16) { float s1 = 0.f, s2 = 0.f;
#pragma unroll
                for (int w = 0; w < 8; ++w) { s1 += part[w * 32 + 2 * tid]; s2 += part[w * 32 + 2 * tid + 1]; }
                const float mean = s1 * (1.f / 1024.f); const float var = fmaxf(s2 * (1.f / 1024.f) - mean * mean, 0.f); st[2 * tid] = mean; st[2 * tid + 1] = rsqrtf(var + LN_EPS); }
            __syncthreads();
#pragma unroll
            for (int t = 0; t < 16; ++t) { const float mean = st[2 * t], rstd = st[2 * t + 1];
                const float y0 = (acc0[t] - mean) * rstd * g0 + be0, y1 = (acc1[t] - mean) * rstd * g1 + be1;
                const float z0 = fminf(fmaxf(y0 * sigm(y0) * SC_CV, -448.f), 448.f), z1 = fminf(fmaxf(y1 * sigm(y1) * SC_CV, -448.f), 448.f);
                *(unsigned short*)((unsigned char*)V + (rb0 + t0 + hh * 16 + t) * 1024 + c0) = (unsigned short)__builtin_amdgcn_cvt_pk_fp8_f32(z0, z1, 0, false); }
        }
    }
}

namespace hg {
using bf16x8 = __attribute__((ext_vector_type(8))) short;
using s16x4  = __attribute__((ext_vector_type(4))) short;
using f32x16 = __attribute__((ext_vector_type(16))) float;
using u32x4  = __attribute__((ext_vector_type(4))) unsigned;
constexpr int RS = 272;
constexpr int VS = 80;
constexpr int T_Q = 0, T_KO = 32 * RS, T_D = 64 * RS, IMG_BYTES = T_D + 512, T_V = IMG_BYTES, TILE_BYTES = T_V + 32 * VS;
constexpr int OFF_TILES = 1024, NTB = 3, OFF_OPART = OFF_TILES + NTB * TILE_BYTES, OPART_BYTES = 4 * 4096;
static_assert(OFF_OPART + 2 * OPART_BYTES <= 131072 && IMG_BYTES % 16 == 0 && IMG_BYTES / 16 == 1120, "hgrn lds");
constexpr int P_RAW = 1024, R_Q = 0, R_F = 32 * RS, RAW_BYTES = 64 * RS, P_IMG = P_RAW + RAW_BYTES;
constexpr int NCHUNK = TPB / 32, NCHAIN = NB * 4 * 2, NITEM = NCHAIN * NCHUNK;
__device__ __forceinline__ int crow(int r, int hi) { return (r & 3) + 8 * (r >> 2) + 4 * hi; }
__device__ __forceinline__ s16x4 tr_read(unsigned addr) { s16x4 r; asm volatile("ds_read_b64_tr_b16 %0, %1" : "=&v"(r) : "v"(addr) : "memory"); return r; }
__device__ __forceinline__ bf16x8 cat8(s16x4 l, s16x4 h) { return (bf16x8){l[0], l[1], l[2], l[3], h[0], h[1], h[2], h[3]}; }
__device__ __forceinline__ bf16x8 pack8(const f32x16& x, int base) {
    u32x4 w; w[0] = pk2(x[base + 0], x[base + 1]); w[1] = pk2(x[base + 2], x[base + 3]); w[2] = pk2(x[base + 4], x[base + 5]); w[3] = pk2(x[base + 6], x[base + 7]);
    return *reinterpret_cast<bf16x8*>(&w);
}
}


#define HG_TOKP(dir, n) ((dir) ? ((n) < CTXL ? (CTXL - 1 - (n)) : (TPB + CTXL - 1 - (n))) : (n))
#define HG_DPP1(x, ctrl, rmask) __int_as_float(__builtin_amdgcn_update_dpp(0x3f800000, __float_as_int(x), ctrl, rmask, 0xf, false))
#define HG_DPP(x, ctrl, rmask) __int_as_float(__builtin_amdgcn_update_dpp(0, __float_as_int(x), ctrl, rmask, 0xf, false))
__device__ __forceinline__ void hgrn_prep_items(const Args& a, LAS unsigned char* lds, int tid) {
    using namespace hg;
    const bf16* Z = (const bf16*)(a.ws + WS_Z);
    unsigned char* HT = a.ws + WS_HT;
    const int wave = __builtin_amdgcn_readfirstlane(tid >> 6), lane = tid & 63, t = lane & 31, half = lane >> 5;
    const int c0 = 16 * wave + 8 * half;
    const int lr = tid >> 4, lch = tid & 15;
    LAS float* lbt = (LAS float*)lds;
    constexpr int P_RAW2 = 2048, P_IMG2 = P_RAW2 + 2 * RAW_BYTES;
    static_assert(P_IMG2 + 2 * IMG_BYTES <= 131072, "prep lds");
    __syncthreads();
    { const float l0 = a.in[I_LBL][tid], l1 = a.in[I_LBL][512 + tid], l2 = a.in[I_LBL][1024 + tid]; const float m = fmaxf(l0, fmaxf(l1, l2));
      const float e0 = __expf(l0 - m), e1 = __expf(l1 - m), e2 = __expf(l2 - m); lbt[tid] = e0 / (e0 + e1 + e2); }
    bf16x8 gq, gf;
#define HP_LOAD(it) do { const int ch_ = (it) % NCHUNK, cn_ = (it) / NCHUNK, dir_ = cn_ & 1, hd_ = (cn_ >> 1) & 3, b_ = cn_ >> 3; \
        const bf16* zr_ = Z + ((size_t)b_ * TPB + HG_TOKP(dir_, 32 * ch_ + lr)) * ZC; gq = *(const bf16x8*)(zr_ + ZHQ + hd_ * 128 + lch * 8); gf = *(const bf16x8*)(zr_ + (dir_ ? ZHB : ZHF) + hd_ * 128 + lch * 8); } while (0)
#define HP_STASH(bufi) do { LAS unsigned char* rb_ = lds + P_RAW2 + (bufi) * RAW_BYTES; *(LAS bf16x8*)(rb_ + R_Q + lr * RS + lch * 16) = gq; *(LAS bf16x8*)(rb_ + R_F + lr * RS + lch * 16) = gf; } while (0)
#define HP_COPYOUT(item, bufi) do { v4u* dst_ = (v4u*)(HT + (size_t)(item) * IMG_BYTES); const LAS v4u* src_ = (const LAS v4u*)(lds + P_IMG2 + (bufi) * IMG_BYTES); \
        dst_[tid] = src_[tid]; dst_[tid + 512] = src_[tid + 512]; if (tid < 96) dst_[tid + 1024] = src_[tid + 1024]; } while (0)
    const int G = gridDim.x;
    int it = blockIdx.x, par = 0;
    if (it < NITEM) { HP_LOAD(it); HP_STASH(0); }
    if (it + G < NITEM) HP_LOAD(it + G);
    __syncthreads();
    for (; it < NITEM; it += G, par ^= 1) {
        if (it + G < NITEM) HP_STASH(par ^ 1);
        if (it != (int)blockIdx.x) HP_COPYOUT(it - G, par ^ 1);
        if (it + 2 * G < NITEM) HP_LOAD(it + 2 * G);
        const int hd = ((it / NCHUNK) >> 1) & 3;
        {
            const LAS unsigned char* rb_ = lds + P_RAW2 + par * RAW_BYTES;
            const bf16x8 RQ = *(const LAS bf16x8*)(rb_ + R_Q + t * RS + c0 * 2), RF = *(const LAS bf16x8*)(rb_ + R_F + t * RS + c0 * 2);
            const f32x4 lbA = *(const LAS f32x4*)(lbt + hd * 128 + c0), lbB = *(const LAS f32x4*)(lbt + hd * 128 + c0 + 4);
            LAS unsigned char* tb_ = lds + P_IMG2 + par * IMG_BYTES;
            float bb_[8], kk_[8];
#pragma unroll
            for (int i_ = 0; i_ < 8; ++i_) { const float lb_ = i_ < 4 ? lbA[i_] : lbB[i_ - 4]; const float f_ = lb_ + (1.f - lb_) * __builtin_amdgcn_rcpf(1.f + __expf(-bf2f((unsigned short)RF[i_]))); kk_[i_] = 1.f - f_; bb_[i_] = f_; }
#pragma unroll
            for (int i_ = 0; i_ < 8; ++i_) { float x_ = bb_[i_]; x_ *= HG_DPP1(x_, 0x111, 0xf); x_ *= HG_DPP1(x_, 0x112, 0xf); x_ *= HG_DPP1(x_, 0x114, 0xf); x_ *= HG_DPP1(x_, 0x118, 0xf);
                x_ *= HG_DPP1(x_, 0x142, 0xa); bb_[i_] = x_; }
            float qi_[8], ko_[8], dd_[8];
#pragma unroll
            for (int i_ = 0; i_ < 8; ++i_) { const int bi_ = __float_as_int(bb_[i_]); dd_[i_] = __int_as_float(half ? __builtin_amdgcn_readlane(bi_, 63) : __builtin_amdgcn_readlane(bi_, 31));
                const float e_ = bb_[i_]; const float ei_ = __builtin_amdgcn_rcpf(e_);
                qi_[i_] = bf2f((unsigned short)RQ[i_]) * e_; ko_[i_] = kk_[i_] * ei_; }
            *(LAS v4u*)(tb_ + T_Q + t * RS + c0 * 2) = (v4u){pk2(qi_[0], qi_[1]), pk2(qi_[2], qi_[3]), pk2(qi_[4], qi_[5]), pk2(qi_[6], qi_[7])};
            *(LAS v4u*)(tb_ + T_KO + t * RS + c0 * 2) = (v4u){pk2(ko_[0], ko_[1]), pk2(ko_[2], ko_[3]), pk2(ko_[4], ko_[5]), pk2(ko_[6], ko_[7])};
            if (t == 31) { *(LAS f32x4*)(tb_ + T_D + c0 * 4) = (f32x4){dd_[0], dd_[1], dd_[2], dd_[3]}; *(LAS f32x4*)(tb_ + T_D + c0 * 4 + 16) = (f32x4){dd_[4], dd_[5], dd_[6], dd_[7]}; }
            if (tid < 32) *(LAS v4u*)(tb_ + T_Q + tid * RS + 256) = (v4u){0u, 0u, 0u, 0u};
            else if (tid < 64) *(LAS v4u*)(tb_ + T_KO + (tid - 32) * RS + 256) = (v4u){0u, 0u, 0u, 0u};
        }
        __syncthreads();
    }
    if (it - G >= (int)blockIdx.x && it - G < NITEM) HP_COPYOUT(it - G, par ^ 1);
    __syncthreads();
#undef HP_COPYOUT
#undef HP_LOAD
#undef HP_STASH
}

__device__ __forceinline__ void hgrn_unit_mfma(const Args& a, int unit, LAS unsigned char* lds, int tid) {
    using namespace hg;
    const int b = unit >> 5, head = (unit >> 3) & 3, dir = (unit >> 2) & 1, sl = unit & 3;
    const bf16* Z = (const bf16*)(a.ws + WS_Z);
    const unsigned char* HT = a.ws + WS_HT + (size_t)((b * 4 + head) * 2 + dir) * NCHUNK * IMG_BYTES;
    bf16* Od = (bf16*)(a.ws + (dir ? WS_OB : WS_OF));
    const int wave = __builtin_amdgcn_readfirstlane(tid >> 6), lane = tid & 63;
    const size_t zb = (size_t)b * TPB;
    constexpr int NCH = NCHUNK;
    const int vr = (tid >> 2) & 31, vp = tid & 3, lvcol = ZHI + head * 128 + sl * 32 + vp * 8, i3 = 1024 + (tid < 96 ? tid : 0);
    v4u gA0, gA1, gA2, gB0, gB1, gB2; bf16x8 gAv, gBv;
#define HG_LOAD(g0, g1, g2, gv, ch) do { const int c_ = (ch) < NCH ? (ch) : NCH - 1; const v4u* src_ = (const v4u*)(HT + (size_t)c_ * IMG_BYTES); \
        g0 = src_[tid]; g1 = src_[tid + 512]; g2 = src_[i3]; gv = *(const bf16x8*)(Z + (zb + HG_TOKP(dir, 32 * c_ + vr)) * ZC + lvcol); } while (0)
#define HG_STASH(g0, g1, g2, gv, bufi) do { LAS unsigned char* tb_ = lds + OFF_TILES + (bufi) * TILE_BYTES; LAS v4u* d_ = (LAS v4u*)tb_; \
        d_[tid] = g0; d_[tid + 512] = g1; if (tid < 96) d_[tid + 1024] = g2; if (tid < 128) *(LAS bf16x8*)(tb_ + T_V + vr * VS + vp * 16) = gv; } while (0)
    const int r32 = lane & 31, hi = lane >> 5, g1 = (lane >> 4) & 1, q4 = (lane & 15) >> 2, p4 = lane & 3, cb = 32 * wave;
    const unsigned lbase = (unsigned)(uintptr_t)lds;
    f32x16 S = {};
    HG_LOAD(gA0, gA1, gA2, gAv, 0); HG_STASH(gA0, gA1, gA2, gAv, 0); HG_LOAD(gA0, gA1, gA2, gAv, 1); HG_STASH(gA0, gA1, gA2, gAv, 1);
    HG_LOAD(gA0, gA1, gA2, gAv, 2);
    __syncthreads();
#define HG_RD64(dst, addr, OFFS) asm volatile("ds_read_b64 %0, %1 offset:" #OFFS : "=&v"(dst) : "v"(addr) : "memory")
#define HG_MFMA_STAGE(n, bufi) do { \
            const unsigned tb = lbase + OFF_TILES + (bufi) * TILE_BYTES; const LAS unsigned char* tl_ = lds + OFF_TILES + (bufi) * TILE_BYTES; \
            bf16x8 ko[2], qi[2]; s16x4 pvl[2], pvh[2], pql[2], pqh[2], kl[2], kh[2], nvl[2], nvh[2]; f32x4 dsc[4]; \
            _Pragma("unroll") for (int kk = 0; kk < 2; ++kk) { ko[kk] = *(const LAS bf16x8*)(tl_ + T_KO + r32 * RS + (cb + 16 * kk + 8 * hi) * 2); qi[kk] = *(const LAS bf16x8*)(tl_ + T_Q + r32 * RS + (cb + 16 * kk + 8 * hi) * 2); } \
            _Pragma("unroll") for (int sp = 0; sp < 2; ++sp) { \
                const unsigned va = tb + T_V + (16 * sp + 4 * hi + q4) * VS + (16 * g1 + 4 * p4) * 2; pvl[sp] = tr_read(va); pvh[sp] = tr_read(va + 8 * VS);              \
                const unsigned qa = tb + T_Q + r32 * RS + (cb + 16 * sp + 4 * hi) * 2; HG_RD64(pql[sp], qa, 0); HG_RD64(pqh[sp], qa, 16);                                  \
                const unsigned ka = tb + T_KO + (16 * sp + 8 * hi + q4) * RS + (cb + 16 * g1 + 4 * p4) * 2; kl[sp] = tr_read(ka); kh[sp] = tr_read(ka + 4 * RS);        \
                const unsigned vb = tb + T_V + (16 * sp + 8 * hi + q4) * VS + (16 * g1 + 4 * p4) * 2; nvl[sp] = tr_read(vb); nvh[sp] = tr_read(vb + 4 * VS); }            \
            _Pragma("unroll") for (int g = 0; g < 4; ++g) dsc[g] = *(const LAS f32x4*)(tl_ + T_D + (cb + 8 * g + 4 * hi) * 4); \
            asm volatile("s_waitcnt lgkmcnt(0)" ::: "memory"); __builtin_amdgcn_sched_barrier(0); \
            f32x16 X = {}; \
            X = __builtin_amdgcn_mfma_f32_32x32x16_bf16(ko[0], qi[0], X, 0, 0, 0); X = __builtin_amdgcn_mfma_f32_32x32x16_bf16(ko[1], qi[1], X, 0, 0, 0); \
            f32x16 O = {}; \
            O = __builtin_amdgcn_mfma_f32_32x32x16_bf16(cat8(pql[0], pqh[0]), pack8(S, 0), O, 0, 0, 0); O = __builtin_amdgcn_mfma_f32_32x32x16_bf16(cat8(pql[1], pqh[1]), pack8(S, 8), O, 0, 0, 0); \
            S = __builtin_amdgcn_mfma_f32_32x32x16_bf16(cat8(kl[0], kh[0]), cat8(nvl[0], nvh[0]), S, 0, 0, 0); S = __builtin_amdgcn_mfma_f32_32x32x16_bf16(cat8(kl[1], kh[1]), cat8(nvl[1], nvh[1]), S, 0, 0, 0); \
            _Pragma("unroll") for (int i = 0; i < 16; ++i) X[i] = (crow(i, hi) <= r32) ? X[i] : 0.f; \
            O = __builtin_amdgcn_mfma_f32_32x32x16_bf16(pack8(X, 0), cat8(pvl[0], pvh[0]), O, 0, 0, 0); O = __builtin_amdgcn_mfma_f32_32x32x16_bf16(pack8(X, 8), cat8(pvl[1], pvh[1]), O, 0, 0, 0); \
            _Pragma("unroll") for (int i = 0; i < 16; ++i) S[i] *= dsc[i >> 2][i & 3]; \
            LAS float* op = (LAS float*)(lds + OFF_OPART + ((n) & 1) * OPART_BYTES + wave * 4096); \
            _Pragma("unroll") for (int i = 0; i < 16; ++i) op[crow(i, hi) * 32 + r32] = O[i]; } while (0)
#define HG_OUT_STAGE(n) do { \
            const int l2 = tid - 256, tt = l2 >> 3, vq = l2 & 7; \
            const LAS float* op = (const LAS float*)(lds + OFF_OPART + (((n) - 1) & 1) * OPART_BYTES) + tt * 32 + vq * 4; \
            const f32x4 s = (*(const LAS f32x4*)op + *(const LAS f32x4*)(op + 1024)) + (*(const LAS f32x4*)(op + 2048) + *(const LAS f32x4*)(op + 3072)); \
            const int p = HG_TOKP(dir, 32 * ((n) - 1) + tt); \
            if (p >= CTXL) *(v2u*)(Od + (zb + p) * 512 + head * 128 + sl * 32 + vq * 4) = (v2u){pk2(s[0], s[1]), pk2(s[2], s[3])}; } while (0)
#define HG_ITER(n, L0, L1, L2, LV, S0, S1, S2, SV) do { \
        HG_LOAD(L0, L1, L2, LV, (n) + 3); \
        if (wave < 4) { HG_MFMA_STAGE(n, bcur); } else if ((n) > 0) { HG_OUT_STAGE(n); } \
        { const int bst_ = bcur == 0 ? 2 : bcur - 1; HG_STASH(S0, S1, S2, SV, bst_); } \
        bcur = bcur == 2 ? 0 : bcur + 1; \
        __syncthreads(); } while (0)
    int bcur = 0;
    for (int n = 0; n < NCH; n += 2) {
        HG_ITER(n, gB0, gB1, gB2, gBv, gA0, gA1, gA2, gAv);
        HG_ITER(n + 1, gA0, gA1, gA2, gAv, gB0, gB1, gB2, gBv);
    }
    if (wave >= 4) { HG_OUT_STAGE(NCH); }
    __syncthreads();
#undef HG_MFMA_STAGE
#undef HG_OUT_STAGE
#undef HG_ITER
#undef HG_LOAD
#undef HG_STASH
#undef HG_RD64
}

__device__ __forceinline__ bool in_range(int lo, int hi, int k) { asm volatile("" : "+s"(lo), "+s"(hi)); return lo <= k && k < hi; }
constexpr int NPHASES = 21;
__global__ void __launch_bounds__(NTHR, 2) fwd_kernel(Args args) {
    extern __shared__ __attribute__((aligned(16))) unsigned char lds_raw[];
    LAS unsigned char* lds = (LAS unsigned char*)lds_raw;
    const int G = gridDim.x;
#define FRESH() int tid = threadIdx.x; asm volatile("" : "+v"(tid)); const int lane = tid & 63, wave = __builtin_amdgcn_readfirstlane(tid >> 6); (void)lane; (void)wave
    unsigned char* ws = args.ws;
    if (threadIdx.x < 16) ((LAS unsigned*)(lds + LDS_BAR_OFF))[threadIdx.x] = 0u;
    __syncthreads();
    XcdBarrier bar = xcd_barrier_post((unsigned*)(ws + WS_CTL), (volatile LAS unsigned*)(lds + LDS_BAR_OFF));
    const int lo = args.ph_lo, hi = args.ph_hi;
#define IN(k) in_range(lo, hi, (k))
#define NREP(k) (((PROBE_MASK >> (k)) & 1u) ? 2 : 1)
#define REPEAT(k) for (int rep_ = 0; rep_ < NREP(k); ++rep_) if (rep_ == 0 || (xcd_barrier(bar), true))
#define SEAM(k) do { if (IN(k) && IN((k) + 1)) xcd_barrier(bar); } while (0)
    bf16* const BX = (bf16*)(ws + WS_X); bf16* const BY = (bf16*)(ws + WS_Y);
    const float* const MODV = (const float*)(ws + WS_MODV);

#if defined(PROBE_BARS)
    for (int pbi = 0; pbi < PROBE_BARS; ++pbi) xcd_barrier(bar);
#endif
    if (IN(0)) REPEAT(0) { FRESH(); phase_prologue(args, lds, tid, lane, wave); } SEAM(0);
    if (IN(1)) REPEAT(1) { FRESH(); phase_mod0(args, lane, wave); } SEAM(1);
    if (IN(2)) REPEAT(2) {
        pg8::Gemm g{BX, (const bf16*)(ws + WS_WIN), NTOK, ZC, 512}; pg8::AllOrder S; S.init(NTOK / 256, ZC / 256, G, (int)blockIdx.x);
        pg8::EpiBf16<0> E{(bf16*)(ws + WS_Z), ZC, nullptr, ZC, 0, 1.f / (SC_A0 * SC_WIN)};
        pg8::gemm_phase<pg8::EpiBf16<0>, pg8::AllOrder, PG8_ALIGN, true, false, true>(lds, g, S, E);
    } SEAM(2);
    if (IN(3)) REPEAT(3) { FRESH(); phase_norm0(args, lane, wave); hgrn_prep_items(args, lds, tid); } SEAM(3);
    if (IN(4)) REPEAT(4) {
        { pg8::Gemm g{(const bf16*)(ws + WS_CQN), (const bf16*)(ws + WS_WUQ), NTOK, 768, 384}; pg8::LatOrder S; S.init(128, 3, G, (int)blockIdx.x);
          pg8::EpiBf16<0> E{(bf16*)(ws + WS_Q), 768, nullptr, 0, 0, 1.f};
          pg8::gemm_phase<pg8::EpiBf16<0>, pg8::LatOrder, PG8_ALIGN, PG8_SP2>(lds, g, S, E); }
        __syncthreads();
        { pg8::Gemm g{(const bf16*)(ws + WS_CKVN), (const bf16*)(ws + WS_WUKV), NTOK, 1024, 256}; pg8::AllOrder S; S.init(NTOK / 256, 4, G, G - 1 - (int)blockIdx.x);
          pg8::EpiBf16<0> E{(bf16*)(ws + WS_KV), 1024, nullptr, 0, 0, 1.f};
          pg8::gemm_phase<pg8::EpiBf16<0>, pg8::AllOrder, PG8_ALIGN, PG8_SP2>(lds, g, S, E); }
    } SEAM(4);
    if (IN(5)) {
        REPEAT(21) { FRESH();
        for (int u = blockIdx.x; u < 256; u += G) { __syncthreads(); hgrn_unit_mfma(args, (G == 256) ? ((u & 7) * 32 + (u >> 3)) : u, lds, tid); } }
        const bf16* Q = (const bf16*)(ws + WS_Q); const bf16* KV = (const bf16*)(ws + WS_KV); const bf16* KRR = (const bf16*)(ws + WS_KRR);
        const float* rope = (const float*)(ws + WS_ROPE);
        const int cslot = (G == 256) ? ((((int)blockIdx.x & 7) * 2 + (((int)blockIdx.x >> 3) >> 4)) % 5) : 0;
        REPEAT(22) {
        int ai = 0;
        for (int slot = 0; slot < 5; ++slot) {
            if (slot == cslot) { if (rep_ == 0) { FRESH(); __syncthreads(); convert_moe_share(args, lds, lane, wave); } continue; }
            for (int u = (G == 256) ? (int)blockIdx.x + ai * 256 : (int)blockIdx.x; u < ((G == 256) ? (int)blockIdx.x + ai * 256 + 1 : (ai == 0 ? 1024 : 0)); u += G) {
                int b, h, qb; if (G == 256) { const int x = (int)blockIdx.x & 7, j = (int)blockIdx.x >> 3, pr = (u >> 8) * 16 + 2 * x + (j >> 4); b = pr >> 3; h = pr & 7; qb = j & 15; } else { b = u >> 7; h = (u >> 4) & 7; qb = u & 15; }
                const size_t kb = (size_t)b * TPB, q0 = kb + CTXL + (size_t)qb * 256;
                __syncthreads();
                att::attn_unit(Q + q0 * 768 + h * 96, KV + kb * 1024 + h * 64, KRR + kb * 32, BY + q0 * 1024 + h * 64, rope + (size_t)qb * 256 * 32, TPB, (char*)lds_raw);
            }
            ++ai;
        }
        }
    } SEAM(5);
    if (IN(6)) REPEAT(6) { FRESH(); phase_readout(args, lane, wave); } SEAM(6);
    if (IN(7)) REPEAT(7) {
        pg8::Gemm g{BY, (const bf16*)(ws + WS_WOUT), NTOK, 1024, 1024}; pg8::LatOrder S; S.init(128, 4, G, (int)blockIdx.x);
        pg8::EpiRes<false> E{args.in[I_X], nullptr, (bf16*)(ws + WS_PRE), MODV, nullptr, 1.f};
        pg8::gemm_phase<pg8::EpiRes<false>, pg8::LatOrder, PG8_ALIGN, PG8_SP2>(lds, g, S, E);
    } SEAM(7);
    for (int l = 0; l < 2; ++l) {
        if (l == 1) {
            if (IN(13)) REPEAT(13) {
                pg8::Gemm g{BY, (const bf16*)(ws + WS_WPW1), NTOK, 2048, 512}; pg8::LatOrder S; S.init(128, 8, G, (int)blockIdx.x);
                pg8::EpiGate<0> E{BX, (const float*)(ws + WS_PW1B), 8, 1.f / (SC_A1 * SC_WPW), 1.f};
                pg8::gemm_phase<pg8::EpiGate<0>, pg8::LatOrder, PG8_ALIGN, true, false, true>(lds, g, S, E);
            } SEAM(13);
            if (IN(14)) REPEAT(14) { FRESH(); phase_conv(args, lds, tid, lane, wave); } SEAM(14);
            if (IN(15)) REPEAT(15) {
                pg8::Gemm g{BY, (const bf16*)(ws + WS_WPW2), NTOK, 1024, 512}; pg8::LatOrder S; S.init(128, 4, G, (int)blockIdx.x);
                pg8::EpiRes<true> E{nullptr, (const bf16*)(ws + WS_H), (bf16*)(ws + WS_PRE), MODV + 9 * 6144, args.in[I_PW2B], 1.f / (SC_CV * SC_WPW)};
                pg8::gemm_phase<pg8::EpiRes<true>, pg8::LatOrder, PG8_ALIGN, true, false, true>(lds, g, S, E);
            } SEAM(15);
        }
        const int pb = l ? 16 : 8;
        if (IN(pb)) REPEAT(pb) { FRESH(); phase_ln1(args, l, lds, tid, lane, wave); } SEAM(pb);
        if (IN(pb + 2) || IN(pb + 3)) {
            LAS int* tl = (LAS int*)(lds + LDS_TILE_E);
            FRESH();
            __syncthreads();
            if (tid < 32) tl[3 * MAXTILES + 64 + tid] = ld_ctl((const int*)(ws + WS_CURSOR) + l * 32 + tid);
            __syncthreads();
            if (tid == 0) { int ts = 0; for (int e = 0; e < 32; ++e) { tl[3 * MAXTILES + e] = ts; ts += (tl[3 * MAXTILES + 64 + e] + 255) >> 8; } tl[3 * MAXTILES + 32] = ts; }
            __syncthreads();
            const int ntiles = tl[3 * MAXTILES + 32];
            for (int t = tid; t < ntiles && t < MAXTILES; t += NTHR) { int e = 0; while (e < 31 && tl[3 * MAXTILES + e + 1] <= t) ++e; const int j = t - tl[3 * MAXTILES + e], rem = tl[3 * MAXTILES + 64 + e] - 256 * j;
                tl[t] = e; tl[MAXTILES + t] = e * ECAP + 256 * j; tl[2 * MAXTILES + t] = rem < 256 ? rem : 256; }
            __syncthreads();
            if (IN(pb + 2)) REPEAT(pb + 2) {
#if defined(PROBE_STAGGER)
                if (blockIdx.x & 1) { const unsigned long long t0 = __builtin_amdgcn_s_memrealtime(); while (__builtin_amdgcn_s_memrealtime() - t0 < PROBE_STAGGER) __builtin_amdgcn_s_sleep(8); }
#endif
                pg8::Gemm g{BX, (const bf16*)(ws + WS_WGU + (size_t)l * 32 * 2048 * 1024), 0, 0, 512};
                pg8::MoeOrder S; S.init(ntiles, 8, G, (int)blockIdx.x); S.tile_e = tl; S.nper = 8;
                pg8::EpiGate<1, true> E{(bf16*)(ws + WS_ACT), (const float*)(ws + WS_BGU) + (size_t)l * 32 * 2048, 8, 1.f / (SC_X8 * SC_WGU) * PROBE_KSC, SC_ACT};
                pg8::gemm_phase<pg8::EpiGate<1, true>, pg8::MoeOrder, PG8_ALIGN, true, true, true>(lds, g, S, E, (const int*)(ws + WS_ROWS), tl + MAXTILES);
            } SEAM(pb + 2);
            if (IN(pb + 3)) REPEAT(pb + 3) {
                pg8::Gemm g{(const bf16*)(ws + WS_ACT), (const bf16*)(ws + WS_WDN + (size_t)l * 32 * 1024 * 1024), 0, 0, 512};
                pg8::MoeOrder S; S.init(ntiles, 4, G, (int)blockIdx.x); S.tile_e = tl; S.nper = 4;
                pg8::EpiDown E{(bf16*)(ws + WS_YB), args.in[I_BDN] + (size_t)l * 32 * 1024, (const float*)(ws + WS_ROWW), (const int*)(ws + WS_ROWD), 1.f / (SC_ACT * SC_WDN) * PROBE_KSC, tl + MAXTILES, SC_Y, lds};
                pg8::gemm_phase<pg8::EpiDown, pg8::MoeOrder, PG8_ALIGN, true, false, true>(lds, g, S, E);
            } SEAM(pb + 3);
        }
        if (IN(pb + 4)) REPEAT(pb + 4) { FRESH(); phase_ln2(args, l, lane, wave); }
        if (l == 0) SEAM(12);
    }
#undef IN
#undef SEAM
}

extern "C" void kernel_launch(void* const* d_in, const int* in_sizes, int n_in, void* d_out, int out_size, void* d_ws, size_t ws_size, hipStream_t stream) {
    static int grid = 0;
    if (grid == 0) {
        if (n_in != 33 || in_sizes[0] != NB * SEQ * D || out_size != NB * SEQ * D || ws_size < WS_END) {
            fprintf(stderr, "kernel_launch: unexpected shapes: n_in %d in0 %d out %d ws %zu (need %zu)\n", n_in, n_in > 0 ? in_sizes[0] : -1, out_size, ws_size, (size_t)WS_END); grid = -1; return; }
        int dev = 0, cus = 0;
        if (hipGetDevice(&dev) != hipSuccess || hipDeviceGetAttribute(&cus, hipDeviceAttributeMultiprocessorCount, dev) != hipSuccess) { grid = -1; return; }
        if (hipFuncSetAttribute((const void*)fwd_kernel, hipFuncAttributeMaxDynamicSharedMemorySize, LDS_BYTES) != hipSuccess) { fprintf(stderr, "kernel_launch: hipFuncSetAttribute failed\n"); grid = -1; return; }
        int per_cu = 0;
        if (hipOccupancyMaxActiveBlocksPerMultiprocessor(&per_cu, (const void*)fwd_kernel, NTHR, LDS_BYTES) != hipSuccess || per_cu < 1) fprintf(stderr, "kernel_launch: occupancy query reports %d\n", per_cu);
        (void)hipGetLastError();
        grid = cus;
    }
    if (grid < 0) return;
    if (hipMemsetAsync((char*)d_ws + WS_CTL, 0, CTL_ZERO_BYTES, stream) != hipSuccess) return;
    Args a{};
    for (int i = 0; i < 33; ++i) a.in[i] = (const float*)d_in[i];
    a.out = (float*)d_out; a.ws = (unsigned char*)d_ws;
#if MK_ONE_LAUNCH
    a.ph_lo = 0; a.ph_hi = NPHASES;
    hipLaunchKernelGGL(fwd_kernel, dim3(grid), dim3(NTHR), LDS_BYTES, stream, a);
#else
    for (int ph = 0; ph < NPHASES; ++ph) { a.ph_lo = ph; a.ph_hi = ph + 1; hipLaunchKernelGGL(fwd_kernel, dim3(grid), dim3(NTHR), LDS_BYTES, stream, a); }
#endif
    const hipError_t le = hipPeekAtLastError();
    if (le != hipSuccess) fprintf(stderr, "kernel_launch: launch failed: %s\n", hipGetErrorName(le));
}
```

```cpp
#include <hip/hip_runtime.h>
#include <cstdio>
#include <cstdint>

#ifndef PROBE_MASK
#define PROBE_MASK 0u
#endif
#if defined(PROBE_K2)
#define PROBE_KSC 0.5f
#else
#define PROBE_KSC 1.0f
#endif
#ifndef MK_ONE_LAUNCH
#define MK_ONE_LAUNCH 1
#endif

namespace pg8 {
#define PG8_LAS __attribute__((address_space(3)))
typedef unsigned short bf16_t;
typedef short bf16x8 __attribute__((ext_vector_type(8)));
typedef float f32x4 __attribute__((ext_vector_type(4)));
typedef unsigned u32x4 __attribute__((ext_vector_type(4)));
constexpr int BM = 256, BK = 64, HALF = 128, HTB = HALF * BK * 2  , STAGE_BYTES = 8 * HTB, NXCD = 8, WGM = 8;

__host__ __device__ __forceinline__ int lds_byte(int r, int c) { const int st = (r >> 4) * 2 + (c >> 5), rr = r & 15, cc = c & 31, ob = rr * 64 + cc * 2; return st * 1024 + (ob ^ (((ob >> 9) & 1) << 5)); }
__host__ __device__ __forceinline__ void stage_rc(int b, int& R, int& C) { const int st = b / 1024, sb = b % 1024, swz = sb ^ (((sb >> 9) & 1) << 5); R = (st >> 1) * 16 + swz / 64; C = (st & 1) * 32 + (swz % 64) / 2; }
__host__ __device__ __forceinline__ int perm32(int rho) { const int n = rho >> 4, i = rho & 15; return 8 * (i >> 2) + 4 * n + (i & 3); }

struct Unit { int pm, pn; };
struct Gemm { const bf16_t* A; const bf16_t* Bt; int M, N, K; };

struct StaticOrder {
    int nM, nN, nwg, G, c;
    __host__ __device__ void init(int M, int N, int G_, int c_) { nM = M / BM; nN = N / BM; nwg = nM * nN; G = G_; c = c_; }
    __host__ __device__ bool next(int i, Unit& u) const {
        const long L = (long)i * G + c; if (L >= nwg) return false;
        int wgid = (int)L; { const int q = nwg / NXCD, r = nwg % NXCD, xcd = wgid % NXCD, off = wgid / NXCD; wgid = (xcd < r ? xcd * (q + 1) : r * (q + 1) + (xcd - r) * q) + off; }
        const int nig = WGM * nN, gid = wgid / nig, fm = gid * WGM, gsz = (nM - fm) < WGM ? (nM - fm) : WGM;
        u.pm = fm + ((wgid % nig) % gsz); u.pn = (wgid % nig) / gsz; return true;
    }
    __device__ __forceinline__ void a_ready(const Unit&) const {}
    __device__ __forceinline__ void done(const Unit&) const {}
};

__device__ __forceinline__ unsigned cvt_pk_bf16(float lo, float hi) { unsigned r; asm volatile("v_cvt_pk_bf16_f32 %0, %1, %2" : "=v"(r) : "v"(lo), "v"(hi)); return r; }
typedef float f32x2 __attribute__((ext_vector_type(2)));
__device__ __forceinline__ f32x2 gelu_pk(f32x2 v) {
    const f32x2 av = __builtin_elementwise_abs(v), d = av * 0.2316418882f + 1.0f;
    f32x2 t; t.x = __builtin_amdgcn_rcpf(d.x); t.y = __builtin_amdgcn_rcpf(d.y);
    f32x2 q = t * 0.5307027145f + (-0.7265760135f); q = q * t + 0.7107068705f; q = q * t + (-0.142248368f); q = q * t + 0.127414796f; q = q * t;
    const f32x2 s = (v * v) * (-0.72134752044f);
    f32x2 e; e.x = __builtin_amdgcn_exp2f(s.x); e.y = __builtin_amdgcn_exp2f(s.y);
    const f32x2 m = v * (q * e), r = v - m;
    f32x2 o; o.x = v.x < 0.f ? m.x : r.x; o.y = v.y < 0.f ? m.y : r.y; return o;
}

template <int ACT  > struct EpiBf16 {
    static constexpr bool PERM = true, AFTER_DRAIN = false, PREFETCH = false; static_assert(ACT == 0 || ACT == 1, "EpiBf16: ACT is 0 (none) or 1 (gelu_pk)");
    bf16_t* O; int ldc; const float* bias; int split_cols; size_t split_stride; float scale0;
    __device__ __forceinline__ void operator()(const f32x4 (&acc)[2][2][4][2], const Unit& u, int wr, int wc, int fr, int fq) const {
        const int row0 = u.pm * BM + wr * 64 + fr; int colt = u.pn * BM; bf16_t* base = O;
        float sc = 1.f; if (split_cols) { const int t = colt / split_cols; base += (size_t)t * split_stride; colt -= t * split_cols; if (t == 0) sc = scale0; }
        const int col0 = colt + wc * 32 + 8 * fq, bcol0 = u.pn * BM + wc * 32 + 8 * fq;
        f32x4 bv[2][2];
#pragma unroll
        for (int bj = 0; bj < 2; ++bj)
#pragma unroll
            for (int n = 0; n < 2; ++n) bv[bj][n] = bias ? *(const f32x4*)(bias + bcol0 + bj * HALF + 4 * n) : (f32x4){0.f, 0.f, 0.f, 0.f};
#pragma unroll
        for (int ai = 0; ai < 2; ++ai)
#pragma unroll
            for (int m = 0; m < 4; ++m) { bf16_t* rowp = base + (size_t)(row0 + ai * HALF + m * 16) * ldc + col0;
#pragma unroll
                for (int bj = 0; bj < 2; ++bj) { f32x4 v0 = acc[ai][bj][m][0] + bv[bj][0], v1 = acc[ai][bj][m][1] + bv[bj][1];
                    if (ACT == 1) { f32x2 a = gelu_pk((f32x2){v0[0], v0[1]}), b = gelu_pk((f32x2){v0[2], v0[3]}), c = gelu_pk((f32x2){v1[0], v1[1]}), d = gelu_pk((f32x2){v1[2], v1[3]});
                        v0 = (f32x4){a.x, a.y, b.x, b.y}; v1 = (f32x4){c.x, c.y, d.x, d.y}; }
                    v0 = v0 * sc; v1 = v1 * sc; u32x4 w; w.x = cvt_pk_bf16(v0[0], v0[1]); w.y = cvt_pk_bf16(v0[2], v0[3]); w.z = cvt_pk_bf16(v1[0], v1[1]); w.w = cvt_pk_bf16(v1[2], v1[3]);
                    *(u32x4*)(rowp + bj * HALF) = w; } }
    }
};
typedef int v4i_t __attribute__((ext_vector_type(4)));
typedef int v8i_t __attribute__((ext_vector_type(8)));
__device__ __forceinline__ v8i_t cat32(bf16x8 a, bf16x8 b) { const v4i_t x = __builtin_bit_cast(v4i_t, a), y = __builtin_bit_cast(v4i_t, b); return __builtin_shufflevector(x, y, 0, 1, 2, 3, 4, 5, 6, 7); }
template <class Epi, class Sched, bool ALIGN_EPI = false, bool SP2 = false, bool GATHER = false, bool FP8 = false>
__device__ __forceinline__ void gemm_phase(PG8_LAS unsigned char* lds, const Gemm g, const Sched& S, const Epi& E, const int* rowsrc = nullptr, const PG8_LAS int* gtab = nullptr) {
    static_assert(!GATHER || SP2, "GATHER is implemented on the SP2 loop only");
    int tid_l = threadIdx.x; asm volatile("" : "+v"(tid_l));
    const int tid = tid_l, wid = __builtin_amdgcn_readfirstlane(tid >> 6), lane = tid & 63, wr = wid >> 2, wc = wid & 3, fr = lane & 15, fq = lane >> 4;
#if defined(PROBE_K2)
    const int K = g.K, nt0 = K / BK, nt = FP8 ? 2 * nt0 : nt0;
#define PG8_KT(x) (FP8 ? ((x) & (nt0 - 1)) : (x))
#else
    const int K = g.K, nt = K / BK;
#define PG8_KT(x) (x)
#endif
    unsigned voffA[2], voffB[2];
#pragma unroll
    for (int i = 0; i < 2; ++i) { int R, C; stage_rc(tid * 16 + i * 8192, R, C); const int Rb = Epi::PERM ? ((R & ~31) + perm32(R & 31)) : R;
        voffA[i] = (unsigned)(R * K + C) * 2u; voffB[i] = (unsigned)(Rb * K + C) * 2u; }
    unsigned gAc[2][2], gAn[2][2]; int gR[2]; unsigned gC[2];
#pragma unroll
    for (int i = 0; i < 2; ++i) { int R, C; stage_rc(tid * 16 + i * 8192, R, C); gR[i] = R; gC[i] = (unsigned)C * 2u; gAc[0][i] = gAc[1][i] = gAn[0][i] = gAn[1][i] = 0u; }
#define PG8_GATHER(u_, o_) do { const int gtb_ = gtab[(u_).pm], gtc_ = gtab[576 + (u_).pm];     \
        _Pragma("unroll") for (int h_ = 0; h_ < 2; ++h_) _Pragma("unroll") for (int i_ = 0; i_ < 2; ++i_) \
        { const int rl_ = h_ * HALF + gR[i_]; const int src_ = rl_ < gtc_ ? rowsrc[gtb_ + rl_] : 0; o_[h_][i_] = (unsigned)src_ * (unsigned)(K * 2) + gC[i_]; } } while (0)
#define PG8_STAGE_A(bufoff, orig_gbase, NEXTSEL, H, KOFF) do { if constexpr (GATHER) { unsigned vo_[2]; vo_[0] = (NEXTSEL) ? gAn[H][0] : gAc[H][0]; vo_[1] = (NEXTSEL) ? gAn[H][1] : gAc[H][1]; \
        PG8_STAGE(bufoff, (const char*)g.A + (KOFF), vo_); } else { PG8_STAGE(bufoff, orig_gbase, voffA); } } while (0)
    const size_t kstep = (size_t)(BK * 2);
    const size_t hstep = (size_t)HALF * K * 2;
    const size_t tstep = 2 * hstep;
    const unsigned ldsw = (unsigned)wid * 1024u;
    const int aoff = lds_byte(wr * 64 + fr, fq * 8), boff = lds_byte(wc * 32 + fr, fq * 8);
#define PG8_SA(b, h) (((b) * 2 + (h)) * HTB)
#define PG8_SB(b, h) ((4 + (b) * 2 + (h)) * HTB)
#define PG8_STAGE(bufoff, gbase, voff) do { _Pragma("unroll") for (int _i = 0; _i < 2; ++_i) \
        __builtin_amdgcn_global_load_lds((const unsigned*)((const char*)(gbase) + (voff)[_i]), (PG8_LAS unsigned*)(lds + (bufoff) + ldsw + _i * 8192), 16, 0, 0); } while (0)
#define PG8_LD32(var, addr) do { const bf16x8 lo_ = *(const PG8_LAS bf16x8*)(addr); const bf16x8 hi_ = *(const PG8_LAS bf16x8*)((addr) + 1024); var = cat32(lo_, hi_); } while (0)
#define PG8_LDA(dst, b, h) do { if constexpr (FP8) { _Pragma("unroll") for (int m = 0; m < 4; ++m) PG8_LD32(dst##8[m], lds + PG8_SA(b, h) + aoff + m * 2048); } \
        else { _Pragma("unroll") for (int m = 0; m < 4; ++m) _Pragma("unroll") for (int k = 0; k < 2; ++k) dst[m][k] = *(const PG8_LAS bf16x8*)(lds + PG8_SA(b, h) + aoff + m * 2048 + k * 1024); } } while (0)
#define PG8_LDB(dst, b, h) do { if constexpr (FP8) { _Pragma("unroll") for (int n = 0; n < 2; ++n) PG8_LD32(dst##8[n], lds + PG8_SB(b, h) + boff + n * 2048); } \
        else { _Pragma("unroll") for (int n = 0; n < 2; ++n) _Pragma("unroll") for (int k = 0; k < 2; ++k) dst[n][k] = *(const PG8_LAS bf16x8*)(lds + PG8_SB(b, h) + boff + n * 2048 + k * 1024); } } while (0)
#define PG8_MMA(ai, bj, At, Bt) do { __builtin_amdgcn_s_setprio(1); \
        if constexpr (FP8) { _Pragma("unroll") for (int m = 0; m < 4; ++m) _Pragma("unroll") for (int n = 0; n < 2; ++n) \
            asm volatile("v_mfma_scale_f32_16x16x128_f8f6f4 %0, %1, %2, %0, %3, %3 op_sel_hi:[0,0,0]" : "+v"(acc[ai][bj][m][n]) : "v"(Bt##8[n]), "v"(At##8[m]), "v"(sc127)); } \
        else { _Pragma("unroll") for (int m = 0; m < 4; ++m) _Pragma("unroll") for (int n = 0; n < 2; ++n) _Pragma("unroll") for (int k = 0; k < 2; ++k) \
            acc[ai][bj][m][n] = __builtin_amdgcn_mfma_f32_16x16x32_bf16(Bt[n][k], At[m][k], acc[ai][bj][m][n], 0, 0, 0); } \
        __builtin_amdgcn_s_setprio(0); } while (0)
#define PG8_WAIT_V(n) asm volatile("s_waitcnt vmcnt(" #n ")" ::: "memory")
#define PG8_WAIT_L(n) asm volatile("s_waitcnt lgkmcnt(" #n ")" ::: "memory")
#define PG8_BAR __builtin_amdgcn_s_barrier()
#define PG8_SCHED __builtin_amdgcn_sched_barrier(0)
    Unit cur, nxt; int ui = 0;
    if (!S.next(0, cur)) return;
    f32x4 acc[2][2][4][2];
#pragma unroll
    for (int a = 0; a < 2; ++a)
#pragma unroll
        for (int b = 0; b < 2; ++b)
#pragma unroll
            for (int m = 0; m < 4; ++m)
#pragma unroll
                for (int n = 0; n < 2; ++n) acc[a][b][m][n] = (f32x4){0.f, 0.f, 0.f, 0.f};
    int sc127 = 0x7f7f7f7f; asm volatile("" : "+v"(sc127));
    bf16x8 At[4][2], B0[2][2], B1[2][2]; v8i_t At8[4], B08[2], B18[2]; (void)At; (void)B0; (void)B1; (void)At8; (void)B08; (void)B18;
    const char* cA = (const char*)g.A + (size_t)cur.pm * tstep; const char* cB = (const char*)g.Bt + (size_t)cur.pn * tstep;
    S.a_ready(cur);
    if constexpr (GATHER) { PG8_GATHER(cur, gAc); }
    if constexpr (Epi::PREFETCH) E.prefetch(cur, 0, wid, lane);
    if constexpr (SP2) {
        PG8_STAGE(PG8_SB(0, 0), cB, voffB); PG8_STAGE(PG8_SB(0, 1), cB + hstep, voffB); PG8_STAGE_A(PG8_SA(0, 0), cA, false, 0, (size_t)0); PG8_STAGE_A(PG8_SA(0, 1), cA + hstep, false, 1, (size_t)0);
        if (wr == 1) PG8_BAR;
        PG8_WAIT_V(2); PG8_BAR;
        PG8_STAGE(PG8_SB(1, 0), cB + kstep, voffB); PG8_STAGE_A(PG8_SA(1, 0), cA + kstep, false, 0, kstep); PG8_STAGE(PG8_SB(1, 1), cB + hstep + kstep, voffB);
        PG8_WAIT_V(6); PG8_BAR;
    } else {
        PG8_STAGE(PG8_SB(0, 0), cB, voffB); PG8_STAGE(PG8_SA(0, 0), cA, voffA); PG8_STAGE(PG8_SB(0, 1), cB + hstep, voffB); PG8_STAGE(PG8_SA(0, 1), cA + hstep, voffA);
        if (wr == 1) PG8_BAR;
        PG8_WAIT_V(4); PG8_BAR;
        PG8_STAGE(PG8_SB(1, 0), cB + kstep, voffB); PG8_STAGE(PG8_SA(1, 0), cA + kstep, voffA); PG8_STAGE(PG8_SB(1, 1), cB + hstep + kstep, voffB);
        PG8_WAIT_V(6); PG8_BAR;
    }
    for (;;) {
        const bool has_next = S.next(ui + 1, nxt);
        if constexpr (GATHER) { if (has_next) { PG8_GATHER(nxt, gAn); } else { _Pragma("unroll") for (int h_ = 0; h_ < 2; ++h_) _Pragma("unroll") for (int i_ = 0; i_ < 2; ++i_) gAn[h_][i_] = gAc[h_][i_]; } }
        const char* nA = has_next ? (const char*)g.A + (size_t)nxt.pm * tstep : cA; const char* nB = has_next ? (const char*)g.Bt + (size_t)nxt.pn * tstep : cB;
#pragma nounroll
        for (int t = 0; t < nt; t += 2) {
            const bool last = (t == nt - 2);
            const char* a1 = cA + (size_t)PG8_KT(t + 1) * kstep;
            const char* a2 = last ? nA : cA + (size_t)PG8_KT(t + 2) * kstep; const char* b2 = last ? nB : cB + (size_t)PG8_KT(t + 2) * kstep;
            const char* a3 = a2 + kstep; const char* b3 = b2 + kstep;
            const size_t k1 = (size_t)PG8_KT(t + 1) * kstep, k2 = last ? (size_t)0 : (size_t)PG8_KT(t + 2) * kstep, k3 = k2 + kstep; (void)k1; (void)k2; (void)k3;
            if (last && has_next) S.a_ready(nxt);
            if constexpr (SP2) {
            PG8_LDB(B0, 0, 0); PG8_LDB(B1, 0, 1); PG8_SCHED; PG8_LDA(At, 0, 0); PG8_STAGE_A(PG8_SA(1, 1), a1 + hstep, false, 1, k1);
            PG8_WAIT_V(8); PG8_WAIT_L(0); PG8_BAR; PG8_MMA(0, 0, At, B0); PG8_MMA(0, 1, At, B1); PG8_BAR; PG8_SCHED;
            PG8_LDA(At, 0, 1); PG8_STAGE(PG8_SB(0, 0), b2, voffB); PG8_STAGE(PG8_SB(0, 1), b2 + hstep, voffB); PG8_STAGE_A(PG8_SA(0, 0), a2, last, 0, k2);
            PG8_WAIT_V(8); PG8_WAIT_L(0); PG8_BAR; PG8_MMA(1, 0, At, B0); PG8_MMA(1, 1, At, B1); PG8_BAR; PG8_SCHED;
            PG8_LDB(B0, 1, 0); PG8_LDB(B1, 1, 1); PG8_SCHED; PG8_LDA(At, 1, 0); PG8_STAGE_A(PG8_SA(0, 1), a2 + hstep, last, 1, k2);
            PG8_WAIT_V(8); PG8_WAIT_L(0); PG8_BAR; PG8_MMA(0, 0, At, B0); PG8_MMA(0, 1, At, B1); PG8_BAR; PG8_SCHED;
            PG8_LDA(At, 1, 1); PG8_STAGE(PG8_SB(1, 0), b3, voffB); PG8_STAGE(PG8_SB(1, 1), b3 + hstep, voffB); PG8_STAGE_A(PG8_SA(1, 0), a3, last, 0, k3);
            PG8_WAIT_V(8); PG8_WAIT_L(0); PG8_BAR; PG8_MMA(1, 0, At, B0); PG8_MMA(1, 1, At, B1); PG8_BAR; PG8_SCHED;
            } else {
            PG8_LDB(B0, 0, 0); PG8_SCHED; PG8_LDA(At, 0, 0); PG8_STAGE(PG8_SA(1, 1), a1 + hstep, voffA);
            PG8_WAIT_L(8); PG8_BAR; PG8_WAIT_L(0); PG8_MMA(0, 0, At, B0); PG8_BAR; PG8_SCHED;
            PG8_LDB(B1, 0, 1); PG8_STAGE(PG8_SB(0, 0), b2, voffB);
            PG8_BAR; PG8_WAIT_L(0); PG8_MMA(0, 1, At, B1); PG8_BAR;
            PG8_LDA(At, 0, 1); PG8_STAGE(PG8_SA(0, 0), a2, voffA);
            PG8_BAR; PG8_WAIT_L(0); PG8_MMA(1, 0, At, B0); PG8_BAR; PG8_SCHED;
            PG8_STAGE(PG8_SB(0, 1), b2 + hstep, voffB);
            PG8_WAIT_V(6); PG8_BAR; PG8_MMA(1, 1, At, B1); PG8_BAR;
            PG8_LDB(B0, 1, 0); PG8_SCHED; PG8_LDA(At, 1, 0); PG8_STAGE(PG8_SA(0, 1), a2 + hstep, voffA);
            PG8_WAIT_L(8); PG8_BAR; PG8_WAIT_L(0); PG8_MMA(0, 0, At, B0); PG8_BAR; PG8_SCHED;
            PG8_LDB(B1, 1, 1); PG8_STAGE(PG8_SB(1, 0), b3, voffB);
            PG8_BAR; PG8_WAIT_L(0); PG8_MMA(0, 1, At, B1); PG8_BAR;
            PG8_LDA(At, 1, 1); PG8_STAGE(PG8_SA(1, 0), a3, voffA);
            PG8_BAR; PG8_WAIT_L(0); PG8_MMA(1, 0, At, B0); PG8_BAR; PG8_SCHED;
            PG8_STAGE(PG8_SB(1, 1), b3 + hstep, voffB);
            PG8_WAIT_V(6); PG8_BAR; PG8_MMA(1, 1, At, B1); PG8_BAR;
            }
        }
        if constexpr (ALIGN_EPI) { if (wr == 0) PG8_BAR; }
        if constexpr (FP8) { asm volatile("s_nop 15\n\ts_nop 15" ::: "memory"); }
        if constexpr (!Epi::AFTER_DRAIN) { if constexpr (Epi::PREFETCH) E(acc, cur, wr, wc, fr, fq, ui & 1); else E(acc, cur, wr, wc, fr, fq);
#if defined(PROBE_EPI2)
            if constexpr (FP8 == (PROBE_EPI2 == 1)) { if constexpr (Epi::PREFETCH) E(acc, cur, wr, wc, fr, fq, ui & 1); else E(acc, cur, wr, wc, fr, fq); }
#endif
            S.done(cur); }
        if (!has_next) break;
#pragma unroll
        for (int a = 0; a < 2; ++a)
#pragma unroll
            for (int b = 0; b < 2; ++b)
#pragma unroll
                for (int m = 0; m < 4; ++m)
#pragma unroll
                    for (int n = 0; n < 2; ++n) acc[a][b][m][n] = (f32x4){0.f, 0.f, 0.f, 0.f};
        cur = nxt; cA = nA; cB = nB; ++ui;
        if constexpr (Epi::PREFETCH) E.prefetch(cur, ui & 1, wid, lane);
        if constexpr (GATHER) { _Pragma("unroll") for (int h_ = 0; h_ < 2; ++h_) _Pragma("unroll") for (int i_ = 0; i_ < 2; ++i_) gAc[h_][i_] = gAn[h_][i_]; }
        if constexpr (ALIGN_EPI) { if (wr == 1) PG8_BAR; }
    }
    PG8_WAIT_V(0);
    if constexpr (!ALIGN_EPI) { if (wr == 0) PG8_BAR; }
    PG8_BAR;
    if constexpr (Epi::AFTER_DRAIN) { E.fused(acc, cur, wr, wc, fr, fq, lds, wid, lane); S.done(cur); }
#undef PG8_SA
#undef PG8_SB
#undef PG8_STAGE
#undef PG8_STAGE_A
#undef PG8_GATHER
#undef PG8_LDA
#undef PG8_LD32
#undef PG8_LDB
#undef PG8_MMA
#undef PG8_WAIT_V
#undef PG8_WAIT_L
#undef PG8_BAR
#undef PG8_SCHED
}
}

#ifndef PG8_SP2
#define PG8_SP2 true
#endif
#ifndef PG8_ALIGN
#define PG8_ALIGN true
#endif

#define GAS __attribute__((address_space(1)))
#define LAS __attribute__((address_space(3)))
typedef unsigned short bf16;
typedef unsigned v4u __attribute__((ext_vector_type(4)));
typedef unsigned v2u __attribute__((ext_vector_type(2)));
typedef float f32x4 __attribute__((ext_vector_type(4)));
typedef short bf16x8 __attribute__((ext_vector_type(8)));

constexpr int D = 1024, NB = 8, SEQ = 4096, CTXL = 256, TPB = SEQ + CTXL, NTOK = NB * TPB, NLAT = NB * SEQ;
constexpr int ZC = 3328;
constexpr int ZQ = 0, ZKV = 384, ZKR = 640, ZHQ = 672, ZHF = 1184, ZHB = 1696, ZHI = 2208, ZHG = 2720;
constexpr int NEXP = 32;
constexpr float ALPHA = 1.4142135623730951f;
constexpr float LN_EPS = 1e-5f, RMS_EPS = 1e-6f;
constexpr int NWAVES = 8, NTHR = 512;
constexpr float SC_X8 = 16.f, SC_WGU = 64.f, SC_ACT = 8.f, SC_WDN = 128.f, SC_Y = 64.f, SC_A1 = 16.f, SC_WPW = 64.f, SC_CV = 16.f, SC_A0 = 16.f, SC_WIN = 64.f;
constexpr int LDS_BYTES = 163840;
constexpr int LDS_BAR_OFF = LDS_BYTES - 64;
constexpr int LDS_TILE_E = 131072;
constexpr int MAXTILES = 576;
constexpr int LDS_SIDE = 155648, SIDE_BYTES = 3072;
static_assert(LDS_SIDE + 2 * SIDE_BYTES <= LDS_BYTES - 64, "lds side");
constexpr int LDS_EPI_B = 139264;
static_assert(LDS_TILE_E + (3 * MAXTILES + 96) * 4 <= LDS_EPI_B && LDS_EPI_B + 16384 <= LDS_BYTES - 64, "lds map");

constexpr size_t MiB = 1u << 20;
constexpr size_t WS_CTL = 0, CTL_ZERO_BYTES = 16384;
constexpr size_t WS_MODV = 1 * MiB;
constexpr size_t WS_ROPE = 1 * MiB + 512 * 1024;
constexpr size_t WS_BGU = 2 * MiB;
constexpr size_t WS_PW1B = 2 * MiB + 512 * 1024;
constexpr size_t WS_BCNT = WS_PW1B + 64 * 1024;
constexpr size_t WS_TILEE = WS_BCNT + 64 * 1024;
constexpr size_t WS_META = WS_TILEE + 4096;
constexpr size_t WS_TOPI = 3 * MiB, WS_TOPW = 4 * MiB;
constexpr int ECAP = 32768;
constexpr size_t WS_ROWS = 160 * MiB, WS_ROWW = 164 * MiB, WS_ROWD = 168 * MiB;
constexpr size_t WS_CURSOR = 14336;
constexpr size_t WS_WIN = 8 * MiB, WS_WUQ = 15 * MiB, WS_WUKV = 16 * MiB, WS_WOUT = 17 * MiB, WS_WPW1 = 19 * MiB, WS_WPW2 = 23 * MiB;
constexpr size_t WS_WGU = 32 * MiB, WS_WDN = 288 * MiB;
constexpr size_t WS_H = 416 * MiB;
constexpr size_t WS_X = 552 * MiB, WS_Y = 620 * MiB;
constexpr size_t WS_BIG = 688 * MiB;
constexpr size_t WS_Z = WS_BIG, WS_CQN = WS_BIG + 221 * MiB, WS_CKVN = WS_BIG + 247 * MiB, WS_KRR = WS_BIG + 264 * MiB,
                 WS_Q = WS_BIG + 267 * MiB, WS_KV = WS_BIG + 318 * MiB, WS_OF = WS_BIG + 386 * MiB, WS_OB = WS_BIG + 454 * MiB;
constexpr size_t WS_HT = WS_BIG + 528 * MiB;
constexpr size_t WS_PRE = WS_BIG;
constexpr size_t WS_XS = WS_BIG, WS_ACT = WS_BIG + 288 * MiB, WS_YB = WS_BIG + 576 * MiB;
constexpr size_t WS_END = WS_BIG + 848 * MiB;
static_assert((size_t)NTOK * ZC * 2 <= 221 * MiB && (size_t)NTOK * 384 * 2 <= 26 * MiB && (size_t)NTOK * 256 * 2 <= 17 * MiB && (size_t)NTOK * 32 * 2 <= 3 * MiB, "ws map 1");
static_assert((size_t)NTOK * 768 * 2 <= 51 * MiB && (size_t)NTOK * 1024 * 2 <= 68 * MiB && (size_t)NTOK * 512 * 4 <= 68 * MiB, "ws map 2");
static_assert((size_t)64 * 136 * 26624 <= 320 * MiB && (size_t)MAXTILES * 256 * 2048 <= 288 * MiB && (size_t)NLAT * 4 * 2048 <= 272 * MiB && (size_t)NTOK * 1024 * 4 <= 136 * MiB, "ws map 3");

#define LDS_WAIT() asm volatile("s_waitcnt lgkmcnt(0)" ::: "memory")
#define VM_WAIT() asm volatile("s_waitcnt vmcnt(0)" ::: "memory")
__device__ __forceinline__ float bf2f(unsigned short b) { return __uint_as_float(((unsigned)b) << 16); }
__device__ __forceinline__ unsigned pk2(float lo, float hi) { return pg8::cvt_pk_bf16(lo, hi); }
__device__ __forceinline__ float sigm(float x) { return __builtin_amdgcn_rcpf(1.f + __expf(-x)); }
__device__ __forceinline__ float wave_sum(float v) {
#pragma unroll
    for (int o = 1; o < 64; o <<= 1) v += __shfl_xor(v, o);
    return v;
}
__device__ __forceinline__ int ld_ctl(const int* p) { return (int)__hip_atomic_load((const unsigned*)p, __ATOMIC_RELAXED, __HIP_MEMORY_SCOPE_AGENT); }
__device__ __forceinline__ int grow_of(int lr) { return (lr >> 12) * TPB + CTXL + (lr & 4095); }

#define XB_TMO      128
#define XB_XCNT(j)  (256  + 64 * (j))
#define XB_XSUB(j)  (1280 + 64 * (j))
#define XB_XGEN(j)  (2304 + 64 * (j))
#define XB_TOP      3328
#define XB_TOPGEN   3392
#define XCD_BAR_WORDS 3456
#define XB_SPIN_CAP (1u << 21)

__device__ __forceinline__ unsigned xb_ld(unsigned* p)              { return __hip_atomic_load(p, __ATOMIC_RELAXED, __HIP_MEMORY_SCOPE_AGENT); }
__device__ __forceinline__ unsigned xb_add(unsigned* p, unsigned v) { return __hip_atomic_fetch_add(p, v, __ATOMIC_RELAXED, __HIP_MEMORY_SCOPE_AGENT); }
__device__ __forceinline__ unsigned xb_xcc_id() { return (unsigned)__builtin_amdgcn_s_getreg((3 << 11) | 20) & 0xFu; }
#define XB_SPIN(cond, bar) do { unsigned _sp = 0; while (cond) { __builtin_amdgcn_s_sleep(1); \
    if ((++_sp & 255u) == 0u) { if (xb_ld(&(bar)[XB_TMO])) break; if (_sp > XB_SPIN_CAP) { atomicAdd(&(bar)[XB_TMO], 1u); break; } } } } while (0)

struct XcdBarrier { unsigned* bar; unsigned x; volatile LAS unsigned* st; };

__device__ __forceinline__ XcdBarrier xcd_barrier_post(unsigned* bar, volatile LAS unsigned* st) {
    XcdBarrier b; b.bar = bar; b.x = xb_xcc_id(); b.st = st;
    if (threadIdx.x == 0) (void)xb_add(&bar[XB_XCNT(b.x)], 1u);
    return b;
}
__device__ __forceinline__ void xcd_barrier_complete(unsigned* bar, unsigned x, unsigned& nloc, unsigned& nx) {
    const unsigned G = gridDim.x * gridDim.y * gridDim.z;
    unsigned sum, cnt, mine, sp = 0u;
    for (;;) {
        sum = 0u; cnt = 0u; mine = 0u;
#pragma unroll
        for (unsigned j = 0; j < 16; ++j) { const unsigned c = xb_ld(&bar[XB_XCNT(j)]); sum += c; cnt += (c > 0u) ? 1u : 0u; mine = (j == x) ? c : mine; }
        if (sum == G) break;
        __builtin_amdgcn_s_sleep(1);
        if ((++sp & 255u) == 0u) { if (xb_ld(&bar[XB_TMO])) break; if (sp > XB_SPIN_CAP) { atomicAdd(&bar[XB_TMO], 1u); break; } }
    }
    nloc = mine > 0u ? mine : 1u; nx = cnt > 0u ? cnt : 1u;
}
__device__ __forceinline__ void xcd_barrier(const XcdBarrier& b) {
    asm volatile("s_waitcnt vmcnt(0)" ::: "memory");
    __syncthreads();
    if (threadIdx.x == 0) {
        unsigned* bar = b.bar;
        __builtin_amdgcn_s_waitcnt(0);
        unsigned nloc = b.st[0], nx = b.st[1];
        if (nloc == 0u) { xcd_barrier_complete(bar, b.x, nloc, nx); b.st[0] = nloc; b.st[1] = nx; }
        const unsigned old = xb_add(&bar[XB_XSUB(b.x)], 1u);
        const unsigned gen = old / nloc;
        if (old + 1u == (gen + 1u) * nloc) {
            __builtin_amdgcn_fence(__ATOMIC_RELEASE, "agent");
            asm volatile("s_waitcnt vmcnt(0)" ::: "memory");
            const unsigned og = xb_add(&bar[XB_TOP], 1u);
            const unsigned tg = og / nx;
            if (og + 1u == (tg + 1u) * nx) xb_add(&bar[XB_TOPGEN], 1u);
            else XB_SPIN(xb_ld(&bar[XB_TOPGEN]) == tg, bar);
            __builtin_amdgcn_fence(__ATOMIC_ACQUIRE, "agent");
            xb_add(&bar[XB_XGEN(b.x)], 1u);
            asm volatile("s_waitcnt vmcnt(0)" ::: "memory");
        } else {
            XB_SPIN(xb_ld(&bar[XB_XGEN(b.x)]) == gen, bar);
            __builtin_amdgcn_fence(__ATOMIC_ACQUIRE, "agent");
            asm volatile("s_waitcnt vmcnt(0)" ::: "memory");
        }
    }
    __syncthreads();
}

namespace pg8 {
struct TileOrder {
    int nM, nN, nwg, G, c;
    __device__ __forceinline__ void init(int nM_, int nN_, int G_, int c_) { nM = nM_; nN = nN_; nwg = nM * nN; G = G_; c = c_; }
    __device__ __forceinline__ bool logical(int i, int& im, int& in) const {
        const long L = (long)i * G + c; if (L >= nwg) return false;
        int wgid = (int)L; { const int q = nwg / NXCD, r = nwg % NXCD, xcd = wgid % NXCD, off = wgid / NXCD; wgid = (xcd < r ? xcd * (q + 1) : r * (q + 1) + (xcd - r) * q) + off; }
        const int nig = WGM * nN, gid = wgid / nig, fm = gid * WGM, gsz = (nM - fm) < WGM ? (nM - fm) : WGM;
        im = fm + ((wgid % nig) % gsz); in = (wgid % nig) / gsz; return true;
    }
    __device__ __forceinline__ void a_ready(const Unit&) const {}
    __device__ __forceinline__ void done(const Unit&) const {}
};
struct AllOrder : TileOrder { __device__ __forceinline__ bool next(int i, Unit& u) const { int im, in; if (!logical(i, im, in)) return false; u.pm = im; u.pn = in; return true; } };
struct LatOrder : TileOrder {
    __device__ __forceinline__ bool next(int i, Unit& u) const { int im, in; if (!logical(i, im, in)) return false; u.pm = (im >> 4) * 17 + 1 + (im & 15); u.pn = in; return true; } };
struct MoeOrder : TileOrder {
    const PG8_LAS int* tile_e; int nper;
    __device__ __forceinline__ bool next(int i, Unit& u) const { int im, in; if (!logical(i, im, in)) return false; u.pm = im; u.pn = tile_e[im] * nper + in; return true; } };

template <bool HB16> struct EpiRes {
    static constexpr bool PERM = true, AFTER_DRAIN = false, PREFETCH = false;
    const float* xin; const bf16_t* h; bf16_t* pre; const float* modv; const float* bias; float ascale;
    __device__ __forceinline__ void operator()(const f32x4 (&acc)[2][2][4][2], const Unit& u, int wr, int wc, int fr, int fq) const {
        asm volatile("" : "+v"(fr), "+v"(fq));
        const int b = u.pm / 17, j = u.pm % 17;
        const int rl0 = wr * 64 + fr, col0 = u.pn * BM + wc * 32 + 8 * fq;
        const float* gate = modv + (size_t)b * 6144 + 2048;
        f32x4 gv[2][2], bv[2][2];
#pragma unroll
        for (int bj = 0; bj < 2; ++bj)
#pragma unroll
            for (int n = 0; n < 2; ++n) { gv[bj][n] = *(const f32x4*)(gate + col0 + bj * HALF + 4 * n); bv[bj][n] = bias ? *(const f32x4*)(bias + col0 + bj * HALF + 4 * n) : (f32x4){0.f, 0.f, 0.f, 0.f}; }
        if constexpr (HB16) {
#pragma unroll
        for (int ai = 0; ai < 2; ++ai) {
            u32x4 hb[4][2];
#pragma unroll
            for (int m = 0; m < 4; ++m) { const int rl = rl0 + ai * HALF + m * 16; const size_t grow = (size_t)u.pm * BM + rl; const bf16_t* hin = h + grow * 1024 + col0;
#pragma unroll
                for (int bj = 0; bj < 2; ++bj) hb[m][bj] = *(const u32x4*)(hin + bj * HALF); }
            asm volatile("" ::: "memory");
#pragma unroll
            for (int m = 0; m < 4; ++m) { const int rl = rl0 + ai * HALF + m * 16; const size_t grow = (size_t)u.pm * BM + rl; bf16_t* po = pre + grow * 1024 + col0;
#pragma unroll
                for (int bj = 0; bj < 2; ++bj) { const u32x4 q = hb[m][bj];
                    const f32x4 h0 = {__builtin_bit_cast(float, q.x << 16), __builtin_bit_cast(float, q.x & 0xffff0000u), __builtin_bit_cast(float, q.y << 16), __builtin_bit_cast(float, q.y & 0xffff0000u)};
                    const f32x4 h1 = {__builtin_bit_cast(float, q.z << 16), __builtin_bit_cast(float, q.z & 0xffff0000u), __builtin_bit_cast(float, q.w << 16), __builtin_bit_cast(float, q.w & 0xffff0000u)};
                    const f32x4 v0 = h0 * 1.4142135623730951f + gv[bj][0] * (acc[ai][bj][m][0] * ascale + bv[bj][0]), v1 = h1 * 1.4142135623730951f + gv[bj][1] * (acc[ai][bj][m][1] * ascale + bv[bj][1]);
                    u32x4 w; w.x = cvt_pk_bf16(v0[0], v0[1]); w.y = cvt_pk_bf16(v0[2], v0[3]); w.z = cvt_pk_bf16(v1[0], v1[1]); w.w = cvt_pk_bf16(v1[2], v1[3]);
                    *(u32x4*)(po + bj * HALF) = w; } }
            asm volatile("" ::: "memory"); }
        } else {
#pragma unroll
        for (int aim = 0; aim < 4; ++aim) { const int ai = aim >> 1, m0 = (aim & 1) * 2;
            f32x4 hv[2][2][2];
#pragma unroll
            for (int mm = 0; mm < 2; ++mm) { const int rl = rl0 + ai * HALF + (m0 + mm) * 16; const size_t grow = (size_t)u.pm * BM + rl;
                const float* hin = xin + ((size_t)b * 4096 + (size_t)(j - 1) * 256 + rl) * 1024 + col0; (void)grow;
#pragma unroll
                for (int bj = 0; bj < 2; ++bj) { hv[mm][bj][0] = *(const f32x4*)(hin + bj * HALF); hv[mm][bj][1] = *(const f32x4*)(hin + bj * HALF + 4); } }
            asm volatile("" ::: "memory");
#pragma unroll
            for (int mm = 0; mm < 2; ++mm) { const int m = m0 + mm; const int rl = rl0 + ai * HALF + m * 16; const size_t grow = (size_t)u.pm * BM + rl; bf16_t* po = pre + grow * 1024 + col0;
#pragma unroll
                for (int bj = 0; bj < 2; ++bj) {
                    const f32x4 v0 = hv[mm][bj][0] * 1.4142135623730951f + gv[bj][0] * (acc[ai][bj][m][0] * ascale + bv[bj][0]), v1 = hv[mm][bj][1] * 1.4142135623730951f + gv[bj][1] * (acc[ai][bj][m][1] * ascale + bv[bj][1]);
                    u32x4 w; w.x = cvt_pk_bf16(v0[0], v0[1]); w.y = cvt_pk_bf16(v0[2], v0[3]); w.z = cvt_pk_bf16(v1[0], v1[1]); w.w = cvt_pk_bf16(v1[2], v1[3]);
                    *(u32x4*)(po + bj * HALF) = w; } }
            asm volatile("" ::: "memory"); }
        }
    }
};
#define PG8_DMA4(gptr, ldsptr) __builtin_amdgcn_global_load_lds((const unsigned*)(gptr), (PG8_LAS unsigned*)(ldsptr), 4, 0, 0)
template <int MODE, bool OUT8 = false> struct EpiGate {
    static constexpr bool PERM = true, AFTER_DRAIN = false, PREFETCH = true;
    bf16_t* O; const float* bias; int nper; float ascale, oscale; PG8_LAS unsigned char* lds;
    __device__ __forceinline__ void prefetch(const Unit& u, int par, int wid, int lane) const { if (wid < 4) PG8_DMA4(bias + u.pn * BM + 64 * wid + lane, lds + LDS_SIDE + par * SIDE_BYTES + wid * 256); }
    __device__ __forceinline__ void operator()(const f32x4 (&acc)[2][2][4][2], const Unit& u, int wr, int wc, int fr, int fq, int par) const {
        asm volatile("" : "+v"(fr), "+v"(fq));
        const int row0 = u.pm * BM + wr * 64 + fr, pnl = u.pn % nper, ocol0 = pnl * HALF + wc * 32 + 8 * fq, bcol0 = u.pn * BM + wc * 32 + 8 * fq;
        const float s0 = ascale, s1 = MODE == 1 ? ascale * oscale : ascale;
        f32x4 bv[2][2];
#pragma unroll
        for (int n = 0; n < 2; ++n) { const PG8_LAS float* bl = (const PG8_LAS float*)(lds + LDS_SIDE + par * SIDE_BYTES) + wc * 32 + 8 * fq + 4 * n; bv[0][n] = *(const PG8_LAS f32x4*)bl; const f32x4 t = *(const PG8_LAS f32x4*)(bl + HALF); bv[1][n] = MODE == 1 ? (t + 1.0f) * oscale : t; }
        (void)bcol0;
#pragma unroll
        for (int ai = 0; ai < 2; ++ai)
#pragma unroll
            for (int m = 0; m < 4; ++m) { bf16_t* rowp = O + (size_t)(row0 + ai * HALF + m * 16) * 1024 + ocol0;
                unsigned char* rowp8 = (unsigned char*)O + (size_t)(row0 + ai * HALF + m * 16) * 1024 + ocol0;
                float o[8];
#pragma unroll
                for (int n = 0; n < 2; ++n) { const f32x4 a = acc[ai][0][m][n] * s0 + bv[0][n], g = acc[ai][1][m][n] * s1 + bv[1][n];
#pragma unroll
                    for (int e = 0; e < 4; ++e) {
                        if (MODE == 0) { o[4 * n + e] = a[e] * __builtin_amdgcn_rcpf(1.f + __builtin_amdgcn_exp2f(g[e] * -1.4426950408889634f)); }
                        else { const float gt = fminf(a[e], 7.0f), up1 = __builtin_amdgcn_fmed3f(g[e], -6.0f * oscale, 8.0f * oscale);
                            o[4 * n + e] = up1 * (gt * __builtin_amdgcn_rcpf(1.f + __builtin_amdgcn_exp2f(gt * (-1.702f * 1.4426950408889634f)))); } } }
                if constexpr (OUT8) {
                    int w0 = 0, w1 = 0; w0 = __builtin_amdgcn_cvt_pk_fp8_f32(o[0], o[1], w0, false); w0 = __builtin_amdgcn_cvt_pk_fp8_f32(o[2], o[3], w0, true);
                    w1 = __builtin_amdgcn_cvt_pk_fp8_f32(o[4], o[5], w1, false); w1 = __builtin_amdgcn_cvt_pk_fp8_f32(o[6], o[7], w1, true);
                    typedef unsigned u32x2 __attribute__((ext_vector_type(2))); *(u32x2*)rowp8 = (u32x2){(unsigned)w0, (unsigned)w1}; (void)rowp;
                } else { (void)rowp8;
                u32x4 w; w.x = cvt_pk_bf16(o[0], o[1]); w.y = cvt_pk_bf16(o[2], o[3]); w.z = cvt_pk_bf16(o[4], o[5]); w.w = cvt_pk_bf16(o[6], o[7]);
                *(u32x4*)rowp = w; } }
    }
};
struct EpiDown {
    static constexpr bool PERM = true, AFTER_DRAIN = false, PREFETCH = true;
    bf16_t* Y; const float* bias; const float* row_w; const int* row_dst; float ascale; const PG8_LAS int* gtab; float oscale; PG8_LAS unsigned char* lds;
    __device__ __forceinline__ void prefetch(const Unit& u, int par, int wid, int lane) const { PG8_LAS unsigned char* sd = lds + LDS_SIDE + par * SIDE_BYTES; const int tbase = gtab[u.pm];
        if (wid < 4) { PG8_DMA4(bias + u.pn * BM + 64 * wid + lane, sd + wid * 256); PG8_DMA4(row_w + tbase + 64 * wid + lane, sd + 1024 + wid * 256); } else PG8_DMA4(row_dst + tbase + 64 * (wid - 4) + lane, sd + 2048 + (wid - 4) * 256); }
    __device__ __forceinline__ void operator()(const f32x4 (&acc)[2][2][4][2], const Unit& u, int wr, int wc, int fr, int fq, int par) const {
        asm volatile("" : "+v"(fr), "+v"(fq));
        const int tid = (wr * 4 + wc) * 64 + fq * 16 + fr;
        const PG8_LAS unsigned char* sd = lds + LDS_SIDE + par * SIDE_BYTES;
        const int pnl = u.pn & 3; const int tcnt = gtab[576 + u.pm];
        f32x4 bv[2][2];
#pragma unroll
        for (int bj = 0; bj < 2; ++bj)
#pragma unroll
            for (int n = 0; n < 2; ++n) bv[bj][n] = *(const PG8_LAS f32x4*)(sd + (wc * 32 + 8 * fq + bj * HALF + 4 * n) * 4);
        float wv[2][4]; int dstv[2][2];
#pragma unroll
        for (int ai = 0; ai < 2; ++ai) {
#pragma unroll
            for (int m = 0; m < 4; ++m) { const int rl = wr * 64 + fr + ai * HALF + m * 16; wv[ai][m] = *(const PG8_LAS float*)(sd + 1024 + rl * 4); }
#pragma unroll
            for (int k = 0; k < 2; ++k) { const int rl = ai * HALF + (tid >> 3) + 64 * k; dstv[ai][k] = *(const PG8_LAS int*)(sd + 2048 + rl * 4); } }
        PG8_LAS unsigned char* const reg0 = lds + 3 * HTB; PG8_LAS unsigned char* const reg1 = lds + LDS_EPI_B;
        const int wbase = (wr * 64 + fr) * 128 + (((wc * 4 + fq) ^ fr) * 8);
        const int rrow = tid >> 3, rch = tid & 7;
        typedef unsigned u32x2 __attribute__((ext_vector_type(2)));
#pragma unroll
        for (int ai = 0; ai < 2; ++ai) {
#pragma unroll
            for (int m = 0; m < 4; ++m) { const float w8 = wv[ai][m] * oscale;
#pragma unroll
                for (int bj = 0; bj < 2; ++bj) { const f32x4 v0 = (acc[ai][bj][m][0] * ascale + bv[bj][0]) * w8, v1 = (acc[ai][bj][m][1] * ascale + bv[bj][1]) * w8;
                    int w0 = 0, w1 = 0; w0 = __builtin_amdgcn_cvt_pk_fp8_f32(__builtin_amdgcn_fmed3f(v0[0], -448.f, 448.f), __builtin_amdgcn_fmed3f(v0[1], -448.f, 448.f), w0, false); w0 = __builtin_amdgcn_cvt_pk_fp8_f32(__builtin_amdgcn_fmed3f(v0[2], -448.f, 448.f), __builtin_amdgcn_fmed3f(v0[3], -448.f, 448.f), w0, true);
                    w1 = __builtin_amdgcn_cvt_pk_fp8_f32(__builtin_amdgcn_fmed3f(v1[0], -448.f, 448.f), __builtin_amdgcn_fmed3f(v1[1], -448.f, 448.f), w1, false); w1 = __builtin_amdgcn_cvt_pk_fp8_f32(__builtin_amdgcn_fmed3f(v1[2], -448.f, 448.f), __builtin_amdgcn_fmed3f(v1[3], -448.f, 448.f), w1, true);
                    *(PG8_LAS u32x2*)((bj ? reg1 : reg0) + wbase + m * 2048) = (u32x2){(unsigned)w0, (unsigned)w1}; } }
            asm volatile("s_waitcnt lgkmcnt(0)" ::: "memory"); __builtin_amdgcn_s_barrier();
            u32x4 rd[2][2];
#pragma unroll
            for (int bj = 0; bj < 2; ++bj)
#pragma unroll
                for (int k = 0; k < 2; ++k) { const int row = rrow + 64 * k; rd[bj][k] = *(const PG8_LAS u32x4*)((bj ? reg1 : reg0) + row * 128 + ((rch ^ ((row & 15) >> 1)) * 16)); }
            asm volatile("s_waitcnt lgkmcnt(0)" ::: "memory"); __builtin_amdgcn_s_barrier();
#pragma unroll
            for (int k = 0; k < 2; ++k) { const int row = rrow + 64 * k, rl = ai * HALF + row;
                if (rl < tcnt) { unsigned char* rowp = (unsigned char*)Y + (size_t)dstv[ai][k] * 1024 + pnl * BM + rch * 16;
#pragma unroll
                    for (int bj = 0; bj < 2; ++bj) { u32x4 q = rd[bj][k]; if (row & 1) q = (u32x4){q.z, q.w, q.x, q.y}; *(u32x4*)(rowp + bj * HALF) = q; } } }
        }
    }
};
}

namespace att {
using bf16x8 = __attribute__((ext_vector_type(8))) short;
using s16x4  = __attribute__((ext_vector_type(4))) short;
using f32x16 = __attribute__((ext_vector_type(16))) float;
using u32x4  = __attribute__((ext_vector_type(4))) unsigned;
constexpr int NW = 8, QBLK = 32, KVBLK = 64;
constexpr float SCALE = 0.10206207261596575f;
constexpr float THR = 8.f;
constexpr int SHM_V = 16384, SHM_K = 16384, NBUF = 3, SHM_ATTN = NBUF * SHM_V + NBUF * SHM_K + NW * 64 * 4;
#define KSWZ(row, colB) ((row) * 256 + ((colB) ^ (((row) & 7) << 4)))
#define SBAR() __builtin_amdgcn_sched_barrier(0)
__device__ __forceinline__ int crow(int r, int hi) { return (r & 3) + 8 * (r >> 2) + 4 * hi; }
__device__ __forceinline__ unsigned cvtpk(float lo, float hi) { unsigned r; asm volatile("v_cvt_pk_bf16_f32 %0, %1, %2" : "=v"(r) : "v"(lo), "v"(hi)); return r; }

__device__ __forceinline__ void partialSM(f32x16& p0, f32x16& p1, float& m_reg, float& mn, float& alpha) {
  constexpr float C = SCALE * 1.4426950408889634f;
  float pmax = p0[0];
#pragma unroll
  for (int r = 1; r < 16; ++r) pmax = fmaxf(pmax, p0[r]);
#pragma unroll
  for (int r = 0; r < 16; ++r) pmax = fmaxf(pmax, p1[r]);
  { auto rr = __builtin_amdgcn_permlane32_swap(__float_as_uint(pmax), __float_as_uint(pmax), false, false);
    pmax = fmaxf(__uint_as_float(rr[0]), __uint_as_float(rr[1])); }
  if (__builtin_expect(__all(pmax - m_reg <= THR / SCALE), 1)) { mn = m_reg; alpha = 1.f; }
  else { mn = fmaxf(m_reg, pmax); alpha = __builtin_amdgcn_exp2f((m_reg - mn) * C); m_reg = mn; }
  float mnC = -mn * C;
#pragma unroll
  for (int r = 0; r < 16; ++r) p0[r] = fmaf(p0[r], C, mnC);
#pragma unroll
  for (int r = 0; r < 16; ++r) p1[r] = fmaf(p1[r], C, mnC);
#pragma unroll
  for (int r = 0; r < 16; ++r) p0[r] = __builtin_amdgcn_exp2f(p0[r]);
}
__device__ __forceinline__ void finishSM(f32x16& p0, f32x16& p1, float alpha, float& l_reg, bf16x8& pa0, bf16x8& pa1, bf16x8& pa2, bf16x8& pa3) {
#pragma unroll
  for (int r = 0; r < 16; ++r) p1[r] = __builtin_amdgcn_exp2f(p1[r]);
  float ps = 0;
#pragma unroll
  for (int r = 0; r < 16; ++r) ps += p0[r];
#pragma unroll
  for (int r = 0; r < 16; ++r) ps += p1[r];
  { auto rr = __builtin_amdgcn_permlane32_swap(__float_as_uint(ps), __float_as_uint(ps), false, false);
    ps = __uint_as_float(rr[0]) + __uint_as_float(rr[1]); }
  l_reg = l_reg * alpha + ps;
#define PK4(P, BASE, OUT) do { unsigned a0 = cvtpk(P[BASE + 0], P[BASE + 1]), a1 = cvtpk(P[BASE + 2], P[BASE + 3]);   \
    unsigned b0 = cvtpk(P[BASE + 4], P[BASE + 5]), b1 = cvtpk(P[BASE + 6], P[BASE + 7]);                              \
    auto r0 = __builtin_amdgcn_permlane32_swap(a0, b0, false, false); auto r1 = __builtin_amdgcn_permlane32_swap(a1, b1, false, false); \
    u32x4 w = {r0[0], r1[0], r0[1], r1[1]}; OUT = *reinterpret_cast<bf16x8*>(&w); } while (0)
  PK4(p0, 0, pa0); PK4(p0, 8, pa1); PK4(p1, 0, pa2); PK4(p1, 8, pa3);
#undef PK4
}
__device__ __forceinline__ void qkt(f32x16& p0, f32x16& p1, const bf16* Ks, const bf16x8* qr, int r32, int hi) {
  p0 = f32x16{}; p1 = f32x16{};
#pragma unroll
  for (int d0 = 0; d0 < 6; ++d0) { int cb = (d0 * 16 + hi * 8) * 2;
    bf16x8 b0 = *reinterpret_cast<const bf16x8*>((const char*)Ks + KSWZ(r32, cb));
    bf16x8 b1 = *reinterpret_cast<const bf16x8*>((const char*)Ks + KSWZ(32 + r32, cb));
    p0 = __builtin_amdgcn_mfma_f32_32x32x16_bf16(b0, qr[d0], p0, 0, 0, 0);
    p1 = __builtin_amdgcn_mfma_f32_32x32x16_bf16(b1, qr[d0], p1, 0, 0, 0); }
}
__device__ __forceinline__ int v_st(int k, int c) { const int kk = (k & ~0xC) | ((k & 4) << 1) | ((k & 8) >> 1); return ((kk >> 3) * 4 + (c >> 5)) * 512 + ((kk & 7) * 32 + (c & 31)) * 2; }
__device__ __forceinline__ int v_rd_base(int lane) { return ((lane & 3) << 3) | (((lane >> 2) & 3) << 6) | (((lane >> 4) & 1) << 5) | (((lane >> 5) & 1) << 8); }
constexpr int v_rd_off(int d0, int ks, int half) { return d0 * 512 + ks * 4096 + half * 2048; }
template <int OFF> __device__ __forceinline__ s16x4 tr_read(int vb) {
  s16x4 r; asm volatile("ds_read_b64_tr_b16 %0, %1 offset:%2" : "=&v"(r) : "v"(vb), "i"(OFF) : "memory"); return r;
}
template <int D0> __device__ __forceinline__ void pv_one(f32x16& od, int vb, bf16x8 pa0, bf16x8 pa1, bf16x8 pa2, bf16x8 pa3) {
  const s16x4 l0 = tr_read<v_rd_off(D0, 0, 0)>(vb), h0 = tr_read<v_rd_off(D0, 0, 1)>(vb), l1 = tr_read<v_rd_off(D0, 1, 0)>(vb), h1 = tr_read<v_rd_off(D0, 1, 1)>(vb);
  const s16x4 l2 = tr_read<v_rd_off(D0, 2, 0)>(vb), h2 = tr_read<v_rd_off(D0, 2, 1)>(vb), l3 = tr_read<v_rd_off(D0, 3, 0)>(vb), h3 = tr_read<v_rd_off(D0, 3, 1)>(vb);
  asm volatile("s_waitcnt lgkmcnt(0)" ::: "memory"); SBAR();
#define PK(L, H) (bf16x8){L[0], L[1], L[2], L[3], H[0], H[1], H[2], H[3]}
  od = __builtin_amdgcn_mfma_f32_32x32x16_bf16(pa0, PK(l0, h0), od, 0, 0, 0);
  od = __builtin_amdgcn_mfma_f32_32x32x16_bf16(pa1, PK(l1, h1), od, 0, 0, 0);
  od = __builtin_amdgcn_mfma_f32_32x32x16_bf16(pa2, PK(l2, h2), od, 0, 0, 0);
  od = __builtin_amdgcn_mfma_f32_32x32x16_bf16(pa3, PK(l3, h3), od, 0, 0, 0);
#undef PK
}
__device__ __forceinline__ void pv_d0(f32x16* o, int vb, bf16x8 pa0, bf16x8 pa1, bf16x8 pa2, bf16x8 pa3) {
  pv_one<0>(o[0], vb, pa0, pa1, pa2, pa3); pv_one<1>(o[1], vb, pa0, pa1, pa2, pa3);
}
__device__ __forceinline__ bf16x8 rope8(bf16x8 x, const float* tab, int pbase) {
  u32x4 w;
#pragma unroll
  for (int i = 0; i < 4; ++i) { const float x1 = __uint_as_float(((unsigned)(unsigned short)x[2 * i]) << 16), x2 = __uint_as_float(((unsigned)(unsigned short)x[2 * i + 1]) << 16);
    const float cs = tab[pbase + i], sn = tab[16 + pbase + i]; w[i] = cvtpk(x1 * cs - x2 * sn, x1 * sn + x2 * cs); }
  return *reinterpret_cast<bf16x8*>(&w);
}
__device__ __forceinline__ void attn_unit(const bf16* __restrict__ Qb, const bf16* __restrict__ KVb, const bf16* __restrict__ KRb, bf16* __restrict__ Ob,
                                          const float* __restrict__ rope, int seq, char* lds) {
  int tid_l = threadIdx.x; asm volatile("" : "+v"(tid_l));
  const int tid = tid_l, wid = tid >> 6, lane = tid & 63, r32 = lane & 31, hi = lane >> 5;
  bf16* V_lds = (bf16*)lds; bf16* K_lds = (bf16*)(lds + NBUF * SHM_V);
  float* ws = (float*)(lds + NBUF * SHM_V + NBUF * SHM_K) + wid * 64; float* li_l = ws; float* al_l = ws + 32;
  float m_reg = -1e30f, l_reg = 0; f32x16 o[2] = {}; bf16x8 qr[6];
  const bf16* Qw = Qb + (long)(wid * QBLK + r32) * 768 + hi * 8;
#pragma unroll
  for (int d0 = 0; d0 < 6; ++d0) qr[d0] = *reinterpret_cast<const bf16x8*>(Qw + d0 * 16);
  if (rope) { const float* tab = rope + (long)(wid * QBLK + r32) * 32; qr[4] = rope8(qr[4], tab, 4 * hi); qr[5] = rope8(qr[5], tab, 8 + 4 * hi); }
  const int sr = tid >> 4, ch = tid & 15;
  const bf16* kbase = ch < 8 ? KVb + ch * 8 : KRb + ((ch - 8) & 3) * 8; const long kstr = ch < 8 ? 1024 : 32;
  const int vkey = tid >> 3, vc8 = (tid & 7) * 8, vst0 = v_st(vkey, vc8);
  const bf16* vbase = KVb + 512 + vc8;
  const int vb0 = (int)(uintptr_t)V_lds + v_rd_base(lane);
  struct { bf16x8 vs0, ks0, ks1; } sr_[2];
#define SLOAD(i, k0) do { sr_[i].vs0 = *reinterpret_cast<const bf16x8*>(vbase + (long)((k0) + vkey) * 1024); \
    sr_[i].ks0 = *reinterpret_cast<const bf16x8*>(kbase + (long)((k0) + sr) * kstr); sr_[i].ks1 = *reinterpret_cast<const bf16x8*>(kbase + (long)((k0) + 32 + sr) * kstr); } while (0)
#define SWRITE(b, i) do { *(bf16x8*)((char*)V_lds + (b) * SHM_V + vst0) = sr_[i].vs0; int kc = ch * 16;               \
    *(bf16x8*)((char*)K_lds + (b) * SHM_K + KSWZ(sr, kc)) = sr_[i].ks0;                       \
    *(bf16x8*)((char*)K_lds + (b) * SHM_K + KSWZ(32 + sr, kc)) = sr_[i].ks1; } while (0)
#define SWAIT() asm volatile("s_waitcnt vmcnt(3)" ::: "memory")
#define RESC(a) do { if (__any((a) < 1.f)) { if (hi == 0) al_l[r32] = (a); asm volatile("s_waitcnt lgkmcnt(0)" ::: "memory"); \
    _Pragma("unroll") for (int d = 0; d < 2; ++d) _Pragma("unroll") for (int r = 0; r < 16; ++r) o[d][r] *= al_l[crow(r, hi)]; } } while (0)
  f32x16 pA0, pA1, pB0, pB1; float mnA, mnB, alA, alB; bf16x8 pa0, pa1, pa2, pa3; const int NT = seq / KVBLK;
  constexpr int SE = 0, SO = 1;
  SLOAD(SE, 0); asm volatile("s_waitcnt vmcnt(0)" ::: "memory"); SWRITE(0, SE); __syncthreads();
  qkt(pA0, pA1, K_lds, qr, r32, hi); partialSM(pA0, pA1, m_reg, mnA, alA);
  SLOAD(SO, KVBLK); if (2 < NT) SLOAD(SE, 2 * KVBLK);
  SWAIT(); SWRITE(1, SO); __syncthreads();
  int bprev = 0, bcur = 1, bnext = 2;
#define ATT_STEP(PN0, PN1, MNN, ALN, PO0, PO1, ALO, SL_LOAD, SL_WRITE, t) do { \
    SBAR(); qkt(PN0, PN1, (bf16*)((char*)K_lds + bcur * SHM_K), qr, r32, hi); \
    finishSM(PO0, PO1, ALO, l_reg, pa0, pa1, pa2, pa3); SBAR(); \
    if ((t) + 2 < NT) SLOAD(SL_LOAD, ((t) + 2) * KVBLK); SBAR(); \
    pv_d0(o, vb0 + bprev * (int)SHM_V, pa0, pa1, pa2, pa3); partialSM(PN0, PN1, m_reg, MNN, ALN); \
    SWAIT(); SWRITE(bnext, SL_WRITE); \
    RESC(ALN); __syncthreads(); \
    bprev = bcur; bcur = bnext; bnext = (bnext == 2) ? 0 : bnext + 1; } while (0)
  for (int j = 1; j + 1 < NT; j += 2) {
    ATT_STEP(pB0, pB1, mnB, alB, pA0, pA1, alA, SO, SE, j);
    ATT_STEP(pA0, pA1, mnA, alA, pB0, pB1, alB, SE, SO, j + 1);
  }
#undef ATT_STEP
  SBAR(); qkt(pB0, pB1, (bf16*)((char*)K_lds + bcur * SHM_K), qr, r32, hi);
  finishSM(pA0, pA1, alA, l_reg, pa0, pa1, pa2, pa3); SBAR();
  pv_d0(o, vb0 + bprev * (int)SHM_V, pa0, pa1, pa2, pa3); partialSM(pB0, pB1, m_reg, mnB, alB);
  RESC(alB);
  finishSM(pB0, pB1, alB, l_reg, pa0, pa1, pa2, pa3); SBAR();
  pv_d0(o, vb0 + bcur * (int)SHM_V, pa0, pa1, pa2, pa3);
  if (hi == 0) li_l[r32] = l_reg; asm volatile("s_waitcnt lgkmcnt(0)" ::: "memory");
  float rli[16];
#pragma unroll
  for (int r = 0; r < 16; ++r) rli[r] = __builtin_amdgcn_rcpf(li_l[crow(r, hi)]);
  bf16* Ow = Ob + (long)(wid * QBLK) * 1024;
#pragma unroll
  for (int r = 0; r < 16; ++r) { int orow = crow(r, hi);
#pragma unroll
    for (int d0 = 0; d0 < 2; ++d0) { const float v = o[d0][r] * rli[r]; Ow[(long)orow * 1024 + d0 * 32 + r32] = (bf16)(cvtpk(v, v) & 0xffffu); } }
#undef SLOAD
#undef SWRITE
#undef SWAIT
#undef RESC
}
}

struct Args { const float* in[33]; float* out; unsigned char* ws; int ph_lo, ph_hi; };
enum { I_X = 0, I_C, I_CTX, I_CCTX, I_MODW, I_MODB, I_LN1G, I_LN1B, I_LN2G, I_LN2B, I_WIN, I_QNORM, I_KVNORM, I_WUQ, I_WUK, I_WUV, I_LBL, I_HGNORM, I_WOUT,
       I_PW1W, I_PW1B, I_DWW, I_DWB, I_CLNG, I_CLNB, I_PW2W, I_PW2B, I_RW, I_RB, I_WGU, I_BGU, I_WDN, I_BDN };

__device__ __forceinline__ int dst_row(int n, int mode, int row_off) {
    if (mode == 0) return row_off + n;
    int f, g; if (mode == 1) { f = n >> 1; g = n & 1; } else { g = n >> 10; f = n & 1023; }
    return row_off + 256 * (f >> 7) + 128 * g + (f & 127);
}
__device__ __forceinline__ unsigned pack_fp8x4(float a, float b, float c, float d) { int w = 0; w = __builtin_amdgcn_cvt_pk_fp8_f32(fminf(fmaxf(a, -448.f), 448.f), fminf(fmaxf(b, -448.f), 448.f), w, false);
    w = __builtin_amdgcn_cvt_pk_fp8_f32(fminf(fmaxf(c, -448.f), 448.f), fminf(fmaxf(d, -448.f), 448.f), w, true); return (unsigned)w; }
struct TrItem { const float* W; bf16* WT; int K, N, mode, row_off, item; float f8scale; };
__device__ __forceinline__ void tr_load(const TrItem& d, f32x4 (&v)[16], int lane) {
    const int nblk = (d.N + 63) >> 6, kb = d.item / nblk, nb = d.item - kb * nblk, k0 = 64 * kb, n0 = 64 * nb;
    const int nc = n0 + 4 * (lane & 15), kr = lane >> 4;
#pragma unroll
    for (int i = 0; i < 16; ++i) v[i] = (nc < d.N) ? __builtin_nontemporal_load((const f32x4*)(d.W + (size_t)(k0 + 4 * i + kr) * d.N + nc)) : (f32x4){0.f, 0.f, 0.f, 0.f};
}
__device__ __forceinline__ void tr_lds_write(const f32x4 (&v)[16], LAS float* scr, int lane) {
    const int kr = lane >> 4;
#pragma unroll
    for (int i = 0; i < 16; ++i) { LAS float* s = scr + (4 * i + kr) * 65 + 4 * (lane & 15); s[0] = v[i][0]; s[1] = v[i][1]; s[2] = v[i][2]; s[3] = v[i][3]; }
}
__device__ __forceinline__ void tr_store(const TrItem& d, LAS float* scr, int lane) {
    const int nblk = (d.N + 63) >> 6, kb = d.item / nblk, nb = d.item - kb * nblk, k0 = 64 * kb, n0 = 64 * nb;
    const int c = lane & 7; const int K = d.K;
#pragma unroll
    for (int j = 0; j < 8; ++j) { const int nl = (lane >> 3) + 8 * j, n = n0 + nl; const LAS float* s = scr + (8 * c) * 65 + nl;
        if (n < d.N) { if (d.f8scale > 0.f) { const float f8 = d.f8scale; v2u o8; o8.x = pack_fp8x4(s[0 * 65] * f8, s[1 * 65] * f8, s[2 * 65] * f8, s[3 * 65] * f8); o8.y = pack_fp8x4(s[4 * 65] * f8, s[5 * 65] * f8, s[6 * 65] * f8, s[7 * 65] * f8);
                *(v2u*)((unsigned char*)d.WT + (size_t)dst_row(n, d.mode, d.row_off) * K + k0 + 8 * c) = o8; }
            else { v4u o; o.x = pk2(s[0 * 65], s[1 * 65]); o.y = pk2(s[2 * 65], s[3 * 65]); o.z = pk2(s[4 * 65], s[5 * 65]); o.w = pk2(s[6 * 65], s[7 * 65]);
                *(v4u*)(d.WT + (size_t)dst_row(n, d.mode, d.row_off) * K + k0 + 8 * c) = o; } } }
}
__device__ __forceinline__ void convert_items(const Args& a, unsigned char* ws, LAS float* scr, int lane, int gw, int NGW, int it_lo, int it_hi) {
    constexpr int I0 = 16 * 51, I1 = 6 * 12, I2 = 4 * 8, I3 = 4 * 8, I4 = 256, I5 = 512;
    constexpr int NGU = 64 * 512, NDN = 64 * 256;
    auto decode = [&](int it) -> TrItem {
        TrItem d; int r = it; d.f8scale = 0.f; d.mode = 0; d.row_off = 0;
        if (r < NGU) { const int mi = r >> 9; d.W = a.in[I_WGU] + (size_t)mi * 1024 * 2048; d.K = 1024; d.N = 2048; d.WT = (bf16*)(ws + WS_WGU + (size_t)mi * 2048 * 1024); d.mode = 1; d.item = r & 511; d.f8scale = SC_WGU; return d; } r -= NGU;
        if (r < NDN) { const int mi = r >> 8; d.W = a.in[I_WDN] + (size_t)mi * 1024 * 1024; d.K = 1024; d.N = 1024; d.WT = (bf16*)(ws + WS_WDN + (size_t)mi * 1024 * 1024); d.item = r & 255; d.f8scale = SC_WDN; return d; } r -= NDN;
        if (r < I0) { d.W = a.in[I_WIN]; d.K = 1024; d.N = 3232; d.WT = (bf16*)(ws + WS_WIN); d.item = r; d.f8scale = SC_WIN; return d; } r -= I0;
        if (r < I1) { d.W = a.in[I_WUQ]; d.K = 384; d.N = 768; d.WT = (bf16*)(ws + WS_WUQ); d.item = r; return d; } r -= I1;
        if (r < I2) { d.W = a.in[I_WUK]; d.K = 256; d.N = 512; d.WT = (bf16*)(ws + WS_WUKV); d.item = r; return d; } r -= I2;
        if (r < I3) { d.W = a.in[I_WUV]; d.K = 256; d.N = 512; d.WT = (bf16*)(ws + WS_WUKV); d.row_off = 512; d.item = r; return d; } r -= I3;
        if (r < I4) { d.W = a.in[I_WOUT]; d.K = 1024; d.N = 1024; d.WT = (bf16*)(ws + WS_WOUT); d.item = r; return d; } r -= I4;
        if (r < I5) { d.W = a.in[I_PW1W]; d.K = 1024; d.N = 2048; d.WT = (bf16*)(ws + WS_WPW1); d.mode = 2; d.item = r; d.f8scale = SC_WPW; return d; } r -= I5;
        d.W = a.in[I_PW2W]; d.K = 1024; d.N = 1024; d.WT = (bf16*)(ws + WS_WPW2); d.item = r; d.f8scale = SC_WPW; return d; };
    f32x4 tv[16];
    int it = it_lo + gw;
    if (it < it_hi) { const TrItem d0 = decode(it); tr_load(d0, tv, lane); }
    for (; it < it_hi; it += NGW) {
        const TrItem d = decode(it);
        tr_lds_write(tv, scr, lane);
        if (it + NGW < it_hi) { const TrItem dn = decode(it + NGW); tr_load(dn, tv, lane); }
        LDS_WAIT();
        tr_store(d, scr, lane);
        LDS_WAIT();
    }
}
__device__ __forceinline__ void phase_prologue(const Args& a, LAS unsigned char* lds, int tid, int lane, int wave) {
    unsigned char* ws = a.ws;
    const int G = gridDim.x, B = blockIdx.x;
    {
        LAS float* sc = (LAS float*)lds;
        LAS float* red = (LAS float*)(lds + 36864);
        float* modv = (float*)(ws + WS_MODV);
        bool have = false;
        for (int it = B; it < 192; it += G) {
            if (!have) { for (int i = tid; i < 9 * 1024; i += NTHR) { const int r = i >> 10, k = i & 1023; const float x = r < 8 ? a.in[I_C][r * 1024 + k] : a.in[I_CCTX][k]; sc[i] = x * sigm(x); } __syncthreads(); have = true; }
            const int l = it / 96, jc = it % 96, kg = tid >> 6, jj = tid & 63, j = jc * 64 + jj;
            float acc[9];
#pragma unroll
            for (int r = 0; r < 9; ++r) acc[r] = 0.f;
            const float* wp = a.in[I_MODW] + ((size_t)l * 1024 + kg * 128) * 6144 + j;
            for (int k0 = 0; k0 < 128; k0 += 16) { float w[16];
#pragma unroll
                for (int kk = 0; kk < 16; ++kk) w[kk] = wp[(size_t)(k0 + kk) * 6144];
#pragma unroll
                for (int kk = 0; kk < 16; ++kk)
#pragma unroll
                    for (int r = 0; r < 9; ++r) acc[r] += sc[r * 1024 + kg * 128 + k0 + kk] * w[kk]; }
#pragma unroll
            for (int r = 0; r < 9; ++r) red[(kg * 9 + r) * 64 + jj] = acc[r];
            __syncthreads();
            for (int i = tid; i < 576; i += NTHR) { const int r = i >> 6, j2 = i & 63; float s = a.in[I_MODB][l * 6144 + jc * 64 + j2];
#pragma unroll
                for (int g = 0; g < 8; ++g) s += red[(g * 9 + r) * 64 + j2];
                modv[((size_t)l * 9 + r) * 6144 + jc * 64 + j2] = s; }
            __syncthreads();
        }
        __syncthreads();
    }
    const int gw = B * NWAVES + wave, NGW = G * NWAVES, gt = B * NTHR + tid, NGT = G * NTHR;
    { float* rope = (float*)(ws + WS_ROPE);
      for (int i = gt; i < 4096 * 16; i += NGT) { const int t = i >> 4, p = i & 15; const float pos = (float)(p < 8 ? (t >> 6) : (t & 63));
          const float inv = __powf(10000.0f, -(float)(p & 7) * 0.125f); const float ang = pos * inv; rope[t * 32 + p] = cosf(ang); rope[t * 32 + 16 + p] = sinf(ang); }
      float* bgu = (float*)(ws + WS_BGU);
      for (int i = gt; i < 2 * 32 * 2048; i += NGT) { const int le = i >> 11, np = i & 2047, q = np >> 8, g = (np >> 7) & 1, r = np & 127, f = 128 * q + r; bgu[i] = a.in[I_BGU][(size_t)le * 2048 + 2 * f + g]; }
      float* pb = (float*)(ws + WS_PW1B);
      for (int i = gt; i < 2048; i += NGT) { const int q = i >> 8, g = (i >> 7) & 1, r = i & 127, f = 128 * q + r; pb[i] = a.in[I_PW1B][g * 1024 + f]; }
      v4u* zp = (v4u*)(ws + WS_WIN + (size_t)3232 * 1024);
      for (int i = gt; i < 96 * 1024 / 16; i += NGT) zp[i] = (v4u){0u, 0u, 0u, 0u};
    }
    LAS float* scr = (LAS float*)(lds + wave * 16640);
    constexpr int I0 = 16 * 51, I1 = 6 * 12, I2 = 4 * 8, I3 = 4 * 8, I4 = 256, I5 = 512, I6 = 256, SMALL = I0 + I1 + I2 + I3 + I4 + I5 + I6;
    constexpr int NGU = 64 * 512, NDN = 64 * 256, NITEMS = SMALL + NGU + NDN;
    convert_items(a, ws, scr, lane, B * NWAVES + wave, G * NWAVES, NGU + NDN, NITEMS);
}
__device__ __forceinline__ void convert_moe_share(const Args& a, LAS unsigned char* lds, int lane, int wave) {
    LAS float* scr = (LAS float*)(lds + wave * 16640);
    constexpr int NGU = 64 * 512, NDN = 64 * 256;
    convert_items(a, a.ws, scr, lane, blockIdx.x * NWAVES + wave, gridDim.x * NWAVES, 0, NGU + NDN);
}

__device__ __forceinline__ void phase_mod0(const Args& a, int lane, int wave) {
    const int gw = blockIdx.x * NWAVES + wave, NGW = gridDim.x * NWAVES;
    const float* modv = (const float*)(a.ws + WS_MODV);
    bf16* X = (bf16*)(a.ws + WS_X);
    f32x4 xv[2][4], xn[2][4];
#define MOD0_LOAD(dst, r0_) do { _Pragma("unroll") for (int q = 0; q < 2; ++q) { const int r = (r0_) + q; const int b = r / TPB, p = r - b * TPB; \
            const float* src = p < CTXL ? a.in[I_CTX] + ((size_t)b * CTXL + p) * 1024 : a.in[I_X] + ((size_t)b * SEQ + (p - CTXL)) * 1024; \
            _Pragma("unroll") for (int j = 0; j < 4; ++j) dst[q][j] = *(const f32x4*)(src + 4 * (lane + 64 * j)); } } while (0)
    if (2 * gw < NTOK) MOD0_LOAD(xv, 2 * gw);
    for (int r0 = 2 * gw; r0 < NTOK; r0 += 2 * NGW) {
        f32x4 shv[2][4], scv[2][4];
#pragma unroll
        for (int q = 0; q < 2; ++q) { const int r = r0 + q; const int b = r / TPB, p = r - b * TPB; const float* mvp = modv + (size_t)(p < CTXL ? 8 : b) * 6144;
#pragma unroll
            for (int j = 0; j < 4; ++j) { const int c = 4 * (lane + 64 * j); shv[q][j] = *(const f32x4*)(mvp + c); scv[q][j] = *(const f32x4*)(mvp + 1024 + c); } }
        if (r0 + 2 * NGW < NTOK) MOD0_LOAD(xn, r0 + 2 * NGW);
#pragma unroll
        for (int q = 0; q < 2; ++q)
#pragma unroll
            for (int j = 0; j < 4; ++j) { const int c = 4 * (lane + 64 * j); const f32x4 sh = shv[q][j], sc = scv[q][j];
                const f32x4 y = (xv[q][j] * (sc + 1.0f) + sh) * SC_A0; *(unsigned*)((unsigned char*)X + (size_t)(r0 + q) * 1024 + c) = pack_fp8x4(y[0], y[1], y[2], y[3]); }
#pragma unroll
        for (int q = 0; q < 2; ++q)
#pragma unroll
            for (int j = 0; j < 4; ++j) xv[q][j] = xn[q][j];
    }
#undef MOD0_LOAD
}

__device__ __forceinline__ void phase_norm0(const Args& a, int lane, int wave) {
    const int gw = blockIdx.x * NWAVES + wave, NGW = gridDim.x * NWAVES;
    const bf16* Z = (const bf16*)(a.ws + WS_Z); bf16* CQN = (bf16*)(a.ws + WS_CQN); bf16* CKVN = (bf16*)(a.ws + WS_CKVN); bf16* KRR = (bf16*)(a.ws + WS_KRR);
    const float* rope = (const float*)(a.ws + WS_ROPE);
    float gq[8], gk[8];
#pragma unroll
    for (int i = 0; i < 8; ++i) { gq[i] = lane < 48 ? a.in[I_QNORM][8 * lane + i] : 0.f; gk[i] = lane < 32 ? a.in[I_KVNORM][8 * lane + i] : 0.f; }
    bf16x8 q8 = {}, k8 = {}, r8 = {}, nq8 = {}, nk8 = {}, nr8 = {};
#define N0_LOAD(dq, dk, dr, r_) do { const bf16* z_ = Z + (size_t)(r_) * ZC; if (lane < 48) dq = *(const bf16x8*)(z_ + ZQ + 8 * lane); if (lane < 32) dk = *(const bf16x8*)(z_ + ZKV + 8 * lane); if (lane < 4) dr = *(const bf16x8*)(z_ + ZKR + 8 * lane); } while (0)
    if (gw < NTOK) N0_LOAD(q8, k8, r8, gw);
    for (int r = gw; r < NTOK; r += NGW, q8 = nq8, k8 = nk8, r8 = nr8) {
        const int p = r % TPB;
        if (r + NGW < NTOK) N0_LOAD(nq8, nk8, nr8, r + NGW);
        float qf[8], kf[8], sq = 0.f, sk = 0.f;
#pragma unroll
        for (int i = 0; i < 8; ++i) { qf[i] = bf2f((unsigned short)q8[i]); kf[i] = bf2f((unsigned short)k8[i]); sq += qf[i] * qf[i]; sk += kf[i] * kf[i]; }
        sq = wave_sum(sq); sk = wave_sum(sk);
        const float rq = rsqrtf(sq * (1.f / 384.f) + RMS_EPS), rk = rsqrtf(sk * (1.f / 256.f) + RMS_EPS);
        if (lane < 48) { v4u o; o.x = pk2(qf[0] * rq * gq[0], qf[1] * rq * gq[1]); o.y = pk2(qf[2] * rq * gq[2], qf[3] * rq * gq[3]); o.z = pk2(qf[4] * rq * gq[4], qf[5] * rq * gq[5]); o.w = pk2(qf[6] * rq * gq[6], qf[7] * rq * gq[7]);
            *(v4u*)(CQN + (size_t)r * 384 + 8 * lane) = o; }
        if (lane < 32) { v4u o; o.x = pk2(kf[0] * rk * gk[0], kf[1] * rk * gk[1]); o.y = pk2(kf[2] * rk * gk[2], kf[3] * rk * gk[3]); o.z = pk2(kf[4] * rk * gk[4], kf[5] * rk * gk[5]); o.w = pk2(kf[6] * rk * gk[6], kf[7] * rk * gk[7]);
            *(v4u*)(CKVN + (size_t)r * 256 + 8 * lane) = o; }
        if (lane < 4) { bf16x8 o8 = r8; if (p >= CTXL) o8 = att::rope8(r8, rope + (size_t)(p - CTXL) * 32, 4 * lane); *(bf16x8*)(KRR + (size_t)r * 32 + 8 * lane) = o8; }
    }
#undef N0_LOAD
}

__device__ __forceinline__ void hgrn_unit(const Args& a, int unit, LAS unsigned char* lds, int tid) {
    const int b = unit >> 5, head = (unit >> 3) & 3, dir = (unit >> 2) & 1, sl = unit & 3;
    const bf16* Z = (const bf16*)(a.ws + WS_Z);
    float* Od = (float*)(a.ws + (dir ? WS_OB : WS_OF));
    LAS float* lbv = (LAS float*)lds;
    constexpr int BUF0 = 1024, BUFSZ = 28672, OFF_Q = 16384, OFF_V = 24576;
    if (tid < 128) { const int c = head * 128 + tid; const float l0 = a.in[I_LBL][c], l1 = a.in[I_LBL][512 + c], l2 = a.in[I_LBL][1024 + c]; const float m = fmaxf(l0, fmaxf(l1, l2));
        const float e0 = __expf(l0 - m), e1 = __expf(l1 - m), e2 = __expf(l2 - m); lbv[tid] = e0 / (e0 + e1 + e2); }
    __syncthreads();
    const int lt = tid >> 4, lcg = tid & 15;
    float lb8[8];
#pragma unroll
    for (int i = 0; i < 8; ++i) lb8[i] = lbv[8 * lcg + i];
    const int fcol = (dir ? ZHB : ZHF) + head * 128 + 8 * lcg, qcol = ZHQ + head * 128 + 8 * lcg;
    const int vt = tid >> 2, vcol = ZHI + head * 128 + sl * 32 + (tid & 3) * 8;
    const int wave = tid >> 6, lane = tid & 63, vv = lane >> 4, cg = lane & 15, vloc = wave * 4 + vv;
    const size_t zb = (size_t)b * TPB;
    bf16x8 rq, rf, rv;
#define TOKP(n) (dir ? ((n) < CTXL ? (CTXL - 1 - (n)) : (TPB + CTXL - 1 - (n))) : (n))
#define HG_LOAD(i) do { const int n_ = 32 * (i) + lt; const bf16* zr_ = Z + (zb + TOKP(n_)) * ZC; rq = *(const bf16x8*)(zr_ + qcol); rf = *(const bf16x8*)(zr_ + fcol); \
        if (tid < 128) { const int n2_ = 32 * (i) + vt; rv = *(const bf16x8*)(Z + (zb + TOKP(n2_)) * ZC + vcol); } } while (0)
#define HG_WRITE(bufi) do { LAS unsigned char* bp_ = lds + BUF0 + (bufi) * BUFSZ; float f_[8]; \
        _Pragma("unroll") for (int i_ = 0; i_ < 8; ++i_) f_[i_] = lb8[i_] + (1.f - lb8[i_]) * sigm(bf2f((unsigned short)rf[i_])); \
        *(LAS f32x4*)(bp_ + ((lt * 128 + lcg * 4) * 4)) = (f32x4){f_[0], f_[1], f_[2], f_[3]}; *(LAS f32x4*)(bp_ + ((lt * 128 + 64 + lcg * 4) * 4)) = (f32x4){f_[4], f_[5], f_[6], f_[7]}; \
        *(LAS bf16x8*)(bp_ + OFF_Q + (lt * 128 + lcg * 8) * 2) = rq; \
        if (tid < 128) { float v_[8]; _Pragma("unroll") for (int i_ = 0; i_ < 8; ++i_) v_[i_] = bf2f((unsigned short)rv[i_]); \
            *(LAS f32x4*)(bp_ + OFF_V + (vt * 32 + (tid & 3) * 8) * 4) = (f32x4){v_[0], v_[1], v_[2], v_[3]}; *(LAS f32x4*)(bp_ + OFF_V + (vt * 32 + (tid & 3) * 8 + 4) * 4) = (f32x4){v_[4], v_[5], v_[6], v_[7]}; } } while (0)
    float S[8];
#pragma unroll
    for (int j = 0; j < 8; ++j) S[j] = 0.f;
    HG_LOAD(0); HG_WRITE(0); __syncthreads();
    const bool b3 = (cg & 8) != 0, b2 = (cg & 4) != 0, b1 = (cg & 2) != 0, b0 = (cg & 1) != 0;
    for (int i = 0; i < TPB / 32; ++i) {
        if (i + 1 < TPB / 32) HG_LOAD(i + 1);
        const LAS unsigned char* bp = lds + BUF0 + (i & 1) * BUFSZ;
#pragma unroll 1
        for (int g = 0; g < 4; ++g) {
            const LAS unsigned char* gp = bp + g * 8 * 512;
            float ot[8];
#pragma unroll
            for (int t = 0; t < 8; ++t) {
                const f32x4 f0 = *(const LAS f32x4*)(gp + ((t * 128 + cg * 4) * 4)), f1 = *(const LAS f32x4*)(gp + ((t * 128 + 64 + cg * 4) * 4));
                const bf16x8 q8 = *(const LAS bf16x8*)(bp + OFF_Q + ((g * 8 + t) * 128 + cg * 8) * 2);
                const float v = *(const LAS float*)(bp + OFF_V + ((g * 8 + t) * 32 + vloc) * 4);
                float acc = 0.f;
#pragma unroll
                for (int j = 0; j < 8; ++j) { const float fj = j < 4 ? f0[j] : f1[j - 4]; const float qj = bf2f((unsigned short)q8[j]);
                    const float kv = fmaf(-fj, v, v); S[j] = fmaf(fj, S[j], kv); acc = fmaf(S[j], qj, acc); }
                ot[t] = acc;
            }
#pragma unroll
            for (int k = 0; k < 4; ++k) { const float snd = b3 ? ot[k] : ot[k + 4]; const float rcv = __shfl_xor(snd, 8); ot[k] = (b3 ? ot[k + 4] : ot[k]) + rcv; }
#pragma unroll
            for (int k = 0; k < 2; ++k) { const float snd = b2 ? ot[k] : ot[k + 2]; const float rcv = __shfl_xor(snd, 4); ot[k] = (b2 ? ot[k + 2] : ot[k]) + rcv; }
            { const float snd = b1 ? ot[0] : ot[1]; const float rcv = __shfl_xor(snd, 2); ot[0] = (b1 ? ot[1] : ot[0]) + rcv; }
            ot[0] += __shfl_xor(ot[0], 1);
            if (!b0) { const int n = 32 * i + 8 * g + (cg >> 1); const int p = TOKP(n); if (p >= CTXL) Od[(zb + p) * 512 + head * 128 + sl * 32 + vloc] = ot[0]; }
        }
        if (i + 1 < TPB / 32) HG_WRITE((i + 1) & 1);
        __syncthreads();
    }
#undef TOKP
#undef HG_LOAD
#undef HG_WRITE
}

__device__ __forceinline__ void phase_readout(const Args& a, int lane, int wave) {
    const int gw = blockIdx.x * NWAVES + wave, NGW = gridDim.x * NWAVES;
    const bf16* OF = (const bf16*)(a.ws + WS_OF); const bf16* OB = (const bf16*)(a.ws + WS_OB);
    const bf16* Z = (const bf16*)(a.ws + WS_Z); bf16* MIX = (bf16*)(a.ws + WS_Y);
    float hn[8];
#pragma unroll
    for (int i = 0; i < 8; ++i) hn[i] = a.in[I_HGNORM][((8 * lane) & 127) + i];
    bf16x8 a8 = {}, c8 = {}, g8 = {}, na8 = {}, nc8 = {}, ng8 = {};
#define RO_LOAD(da, dc, dg, lr_) do { const size_t r_ = (size_t)grow_of(lr_); da = *(const bf16x8*)(OF + r_ * 512 + 8 * lane); dc = *(const bf16x8*)(OB + r_ * 512 + 8 * lane); dg = *(const bf16x8*)(Z + r_ * ZC + ZHG + 8 * lane); } while (0)
    if (gw < NLAT) RO_LOAD(a8, c8, g8, gw);
    for (int lr = gw; lr < NLAT; lr += NGW, a8 = na8, c8 = nc8, g8 = ng8) {
        const size_t r = (size_t)grow_of(lr);
        if (lr + NGW < NLAT) RO_LOAD(na8, nc8, ng8, lr + NGW);
        float o[8]; float ss = 0.f;
#pragma unroll
        for (int i = 0; i < 8; ++i) o[i] = bf2f((unsigned short)a8[i]) + bf2f((unsigned short)c8[i]);
#pragma unroll
        for (int i = 0; i < 8; ++i) ss += o[i] * o[i];
        ss += __shfl_xor(ss, 1); ss += __shfl_xor(ss, 2); ss += __shfl_xor(ss, 4); ss += __shfl_xor(ss, 8);
        const float rs = rsqrtf(ss * (1.f / 128.f) + RMS_EPS);
        float y[8];
#pragma unroll
        for (int i = 0; i < 8; ++i) { const float g = bf2f((unsigned short)g8[i]); y[i] = o[i] * rs * hn[i] * (g * sigm(g)); }
        v4u w; w.x = pk2(y[0], y[1]); w.y = pk2(y[2], y[3]); w.z = pk2(y[4], y[5]); w.w = pk2(y[6], y[7]);
        *(v4u*)(MIX + r * 1024 + 512 + 8 * lane) = w;
    }
#undef RO_LOAD
}

__device__ __forceinline__ int rows_per_block() { const int G = gridDim.x; return (((NLAT + G - 1) / G) + 15) & ~15; }
__device__ __forceinline__ void phase_ln1(const Args& a, int l, LAS unsigned char* lds, int tid, int lane, int wave) {
    typedef short bf16x8s __attribute__((ext_vector_type(8)));
    const int RB = rows_per_block(), lr_base = blockIdx.x * RB;
    const bf16* PRE = (const bf16*)(a.ws + WS_PRE); bf16* XB = (bf16*)(a.ws + WS_X);
    const float* modv = (const float*)(a.ws + WS_MODV) + (size_t)l * 9 * 6144;
    const float* lng = a.in[I_LN1G] + l * 1024; const float* lnb = a.in[I_LN1B] + l * 1024;
    const float* rw = a.in[I_RW] + (size_t)l * 1024 * 32; const float* rb = a.in[I_RB] + l * 32;
    constexpr int XT_LD = 1028, O_PART = 16 * XT_LD * 4, O_LG = O_PART + 8 * 32 * 16 * 4, O_HIST = O_LG + 16 * 33 * 4 + 64, O_CCNT = O_HIST + 256, O_TIL = O_CCNT + 2048, O_TWL = O_TIL + 4096;
    LAS float* XT = (LAS float*)lds; LAS float* PART = (LAS float*)(lds + O_PART); LAS float* LG = (LAS float*)(lds + O_LG);
    LAS int* hist = (LAS int*)(lds + O_HIST);
    LAS int* ccnt = (LAS int*)(lds + O_CCNT);
    LAS int* til = (LAS int*)(lds + O_TIL);
    LAS float* twl = (LAS float*)(lds + O_TWL);
    __syncthreads();
    if (tid < 32) hist[tid] = 0;
    bf16x8s whi[2][4], wlo[2][4];
    { const int e15 = lane & 15, kq = lane >> 4;
#pragma unroll
      for (int t = 0; t < 2; ++t)
#pragma unroll
          for (int sI = 0; sI < 4; ++sI) { float wv[8];
#pragma unroll
              for (int j = 0; j < 8; ++j) wv[j] = rw[(size_t)(128 * wave + 32 * sI + 8 * kq + j) * 32 + 16 * t + e15];
              v4u ph, pl;
#pragma unroll
              for (int j = 0; j < 4; ++j) { const unsigned p = pk2(wv[2 * j], wv[2 * j + 1]); const float h0 = __uint_as_float(p << 16), h1 = __uint_as_float(p & 0xffff0000u); ph[j] = p; pl[j] = pk2(wv[2 * j] - h0, wv[2 * j + 1] - h1); }
              whi[t][sI] = __builtin_bit_cast(bf16x8s, ph); wlo[t][sI] = __builtin_bit_cast(bf16x8s, pl); } }
    const int ngroups = RB / 16;
    f32x4 fP[4], fQ[4]; int fb = -1;
    const float rbias = rb[tid >> 4];
    v2u xr[2][4];
#define LN1_LOAD(g) do { _Pragma("unroll") for (int rr_ = 0; rr_ < 2; ++rr_) { const int lr_ = lr_base + 16 * (g) + 2 * wave + rr_; const size_t r_ = (size_t)grow_of(lr_ < NLAT ? lr_ : NLAT - 1); \
        _Pragma("unroll") for (int j_ = 0; j_ < 4; ++j_) xr[rr_][j_] = *(const v2u*)(PRE + r_ * 1024 + 4 * (lane + 64 * j_)); } } while (0)
#if defined(PROBE_LN1X2)
    for (int rep_ = 0; rep_ < 2; ++rep_) { __syncthreads(); if (tid < 32) hist[tid] = 0; __syncthreads();
#endif
    LN1_LOAD(0);
    for (int g = 0; g < ngroups; ++g) {
#pragma unroll
        for (int rr = 0; rr < 2; ++rr) {
            const int lr = lr_base + 16 * g + 2 * wave + rr; const bool ok = lr < NLAT; const size_t r = (size_t)grow_of(ok ? lr : NLAT - 1); const int b = (ok ? lr : NLAT - 1) >> 12;
            if (b != fb) { const float* mv = modv + (size_t)b * 6144; fb = b;
#pragma unroll
                for (int j = 0; j < 4; ++j) { const int c = 4 * (lane + 64 * j); const f32x4 gg = *(const f32x4*)(lng + c), bb = *(const f32x4*)(lnb + c), sh = *(const f32x4*)(mv + 3 * 1024 + c), sc = *(const f32x4*)(mv + 4 * 1024 + c);
                    fP[j] = gg * (sc + 1.0f); fQ[j] = bb * (sc + 1.0f) + sh; } }
            f32x4 x[4]; float s = 0.f;
#pragma unroll
            for (int j = 0; j < 4; ++j) { const v2u p = xr[rr][j]; x[j] = (f32x4){__uint_as_float(p.x << 16), __uint_as_float(p.x & 0xffff0000u), __uint_as_float(p.y << 16), __uint_as_float(p.y & 0xffff0000u)}; s += (x[j][0] + x[j][1]) + (x[j][2] + x[j][3]); }
            const float mean = wave_sum(s) * (1.f / 1024.f); float s2 = 0.f;
#pragma unroll
            for (int j = 0; j < 4; ++j) { x[j] = x[j] - mean; s2 += (x[j][0] * x[j][0] + x[j][1] * x[j][1]) + (x[j][2] * x[j][2] + x[j][3] * x[j][3]); }
            const float rstd = rsqrtf(wave_sum(s2) * (1.f / 1024.f) + LN_EPS);
#pragma unroll
            for (int j = 0; j < 4; ++j) { const int c = 4 * (lane + 64 * j);
                const f32x4 bm = (x[j] * rstd) * fP[j] + fQ[j];
                if (ok) *(unsigned*)((unsigned char*)XB + r * 1024 + c) = pack_fp8x4(bm[0] * SC_X8, bm[1] * SC_X8, bm[2] * SC_X8, bm[3] * SC_X8);
                *(LAS f32x4*)(XT + (2 * wave + rr) * XT_LD + c) = bm; }
        }
        if (g + 1 < ngroups) LN1_LOAD(g + 1);
        __syncthreads();
        { const int rr = lane & 15, kq = lane >> 4;
          f32x4 acc0 = {0.f, 0.f, 0.f, 0.f}, acc1 = {0.f, 0.f, 0.f, 0.f};
#pragma unroll
          for (int sI = 0; sI < 4; ++sI) { const LAS float* xp = XT + rr * XT_LD + 128 * wave + 32 * sI + 8 * kq; const f32x4 v0 = *(const LAS f32x4*)xp, v1 = *(const LAS f32x4*)(xp + 4);
              const float bv[8] = {v0[0], v0[1], v0[2], v0[3], v1[0], v1[1], v1[2], v1[3]}; v4u ph, pl;
#pragma unroll
              for (int j = 0; j < 4; ++j) { const unsigned p = pk2(bv[2 * j], bv[2 * j + 1]); const float h0 = __uint_as_float(p << 16), h1 = __uint_as_float(p & 0xffff0000u); ph[j] = p; pl[j] = pk2(bv[2 * j] - h0, bv[2 * j + 1] - h1); }
              const bf16x8s bh = __builtin_bit_cast(bf16x8s, ph), bl = __builtin_bit_cast(bf16x8s, pl);
              acc0 = __builtin_amdgcn_mfma_f32_16x16x32_bf16(whi[0][sI], bh, acc0, 0, 0, 0); acc0 = __builtin_amdgcn_mfma_f32_16x16x32_bf16(whi[0][sI], bl, acc0, 0, 0, 0); acc0 = __builtin_amdgcn_mfma_f32_16x16x32_bf16(wlo[0][sI], bh, acc0, 0, 0, 0);
              acc1 = __builtin_amdgcn_mfma_f32_16x16x32_bf16(whi[1][sI], bh, acc1, 0, 0, 0); acc1 = __builtin_amdgcn_mfma_f32_16x16x32_bf16(whi[1][sI], bl, acc1, 0, 0, 0); acc1 = __builtin_amdgcn_mfma_f32_16x16x32_bf16(wlo[1][sI], bh, acc1, 0, 0, 0); }
#pragma unroll
          for (int q = 0; q < 4; ++q) { PART[(wave * 32 + 4 * kq + q) * 16 + rr] = acc0[q]; PART[(wave * 32 + 16 + 4 * kq + q) * 16 + rr] = acc1[q]; } }
        __syncthreads();
        { const int e = tid >> 4, rr = tid & 15; float sacc = rbias;
#pragma unroll
          for (int w = 0; w < 8; ++w) sacc += PART[(w * 32 + e) * 16 + rr];
          LG[rr * 33 + e] = sacc; }
        __syncthreads();
        if (wave == (g & 7) && lane < 16) { const int lr = lr_base + 16 * g + lane;
            if (lr < NLAT) { float lg[32];
#pragma unroll
                for (int e = 0; e < 32; ++e) lg[e] = LG[lane * 33 + e];
                unsigned taken = 0u; float tv[4]; int ti[4];
#pragma unroll
                for (int kk = 0; kk < 4; ++kk) { float best = -3.0e38f; int bi = 0;
#pragma unroll
                    for (int e = 0; e < 32; ++e) { const bool okk = (lg[e] > best) && !((taken >> e) & 1u); best = okk ? lg[e] : best; bi = okk ? e : bi; }
                    taken |= 1u << bi; tv[kk] = best; ti[kk] = bi; }
                const float e1 = __expf(tv[1] - tv[0]), e2 = __expf(tv[2] - tv[0]), e3 = __expf(tv[3] - tv[0]); const float inv = 1.f / (1.f + e1 + e2 + e3);
                const int li = (16 * g + lane) * 4; til[li] = ti[0]; til[li + 1] = ti[1]; til[li + 2] = ti[2]; til[li + 3] = ti[3]; twl[li] = inv; twl[li + 1] = e1 * inv; twl[li + 2] = e2 * inv; twl[li + 3] = e3 * inv;
                __hip_atomic_fetch_add(hist + ti[0], 1, __ATOMIC_RELAXED, __HIP_MEMORY_SCOPE_WORKGROUP); __hip_atomic_fetch_add(hist + ti[1], 1, __ATOMIC_RELAXED, __HIP_MEMORY_SCOPE_WORKGROUP);
                __hip_atomic_fetch_add(hist + ti[2], 1, __ATOMIC_RELAXED, __HIP_MEMORY_SCOPE_WORKGROUP); __hip_atomic_fetch_add(hist + ti[3], 1, __ATOMIC_RELAXED, __HIP_MEMORY_SCOPE_WORKGROUP); } }
    }
#if defined(PROBE_LN1X2)
    }
#endif
#undef LN1_LOAD
    __syncthreads();
    int* cursor = (int*)(a.ws + WS_CURSOR) + l * 32;
    int* rows = (int*)(a.ws + WS_ROWS); float* roww = (float*)(a.ws + WS_ROWW); int* rowd = (int*)(a.ws + WS_ROWD);
    int nrows = NLAT - lr_base; nrows = nrows > RB ? RB : nrows; if (nrows < 0) nrows = 0;
    const int nas = nrows * 4, nchunks = (nas + 63) >> 6;
    int basev = 0; if (tid < 32) basev = (int)__hip_atomic_fetch_add((unsigned*)cursor + tid, (unsigned)hist[tid], __ATOMIC_RELAXED, __HIP_MEMORY_SCOPE_AGENT);
    int myrank[2] = {0, 0}, mye[2] = {-1, -1};
#pragma unroll
    for (int cc = 0; cc < 2; ++cc) { const int c = wave + 8 * cc; if (c < nchunks) { const int idx = c * 64 + lane; const int e = idx < nas ? til[idx] : -1; mye[cc] = e;
        for (int x = 0; x < 32; ++x) { const unsigned long long m = __ballot(e == x); if (e == x) myrank[cc] = __popcll(m & ((1ull << lane) - 1ull)); if (lane == 0) ccnt[c * 32 + x] = __popcll(m); } } }
    __syncthreads();
    if (tid < 32) hist[32 + tid] = basev;
    __syncthreads();
#pragma unroll
    for (int cc = 0; cc < 2; ++cc) { const int c = wave + 8 * cc; const int idx = c * 64 + lane; if (c < nchunks && idx < nas) { const int e = mye[cc]; int pos = hist[32 + e] + myrank[cc]; for (int c2 = 0; c2 < c; ++c2) pos += ccnt[c2 * 32 + e];
        const int lr = lr_base + (idx >> 2); const size_t pi = (size_t)e * ECAP + pos; rows[pi] = grow_of(lr); roww[pi] = twl[idx]; rowd[pi] = lr * 4 + (idx & 3); } }
}

__device__ __forceinline__ void phase_ln2(const Args& a, int l, int lane, int wave) {
    const int gw = blockIdx.x * NWAVES + wave, NGW = gridDim.x * NWAVES;
    float* H = (float*)(a.ws + WS_H); const bf16* PRE = (const bf16*)(a.ws + WS_PRE); const unsigned char* YB = (const unsigned char*)(a.ws + WS_YB); bf16* A1 = (bf16*)(a.ws + WS_Y);
    const float* modv = (const float*)(a.ws + WS_MODV);
    const float* ln1g = a.in[I_LN1G] + l * 1024; const float* ln1b = a.in[I_LN1B] + l * 1024;
    const float* lng = a.in[I_LN2G] + l * 1024; const float* lnb = a.in[I_LN2B] + l * 1024;
    f32x4 P1[4], Q1[4], G2[4], g2v[4], b2v[4], P3[4], Q3[4]; int fb = -1;
    const int rows_w = (((NLAT + NGW - 1) / NGW) + 1) & ~1, lr_lo = gw * rows_w, lr_hi = lr_lo + rows_w < NLAT ? lr_lo + rows_w : NLAT;
    for (int lr0 = lr_lo; lr0 < lr_hi; lr0 += 2) {
        v2u hv[2][4]; unsigned yv[2][4][4];
#pragma unroll
        for (int q = 0; q < 2; ++q) { const int lr = lr0 + q; const size_t r = (size_t)grow_of(lr);
#pragma unroll
            for (int j = 0; j < 4; ++j) { const int c = 4 * (lane + 64 * j); hv[q][j] = *(const v2u*)(PRE + r * 1024 + c);
#pragma unroll
                for (int k = 0; k < 4; ++k) yv[q][j][k] = *(const unsigned*)(YB + ((size_t)lr * 4 + k) * 1024 + c); } }
#pragma unroll
        for (int q = 0; q < 2; ++q) {
            const int lr = lr0 + q; const size_t r = (size_t)grow_of(lr); const int b = lr >> 12;
            if (b != fb) { fb = b; const float* mv = modv + ((size_t)l * 9 + b) * 6144; const float* mv1 = modv + ((size_t)9 + b) * 6144;
#pragma unroll
                for (int j = 0; j < 4; ++j) { const int c = 4 * (lane + 64 * j); const f32x4 g1 = *(const f32x4*)(ln1g + c), b1 = *(const f32x4*)(ln1b + c), gt = *(const f32x4*)(mv + 5 * 1024 + c);
                    P1[j] = g1 * ALPHA; Q1[j] = b1 * ALPHA; G2[j] = gt * (1.f / SC_Y); g2v[j] = *(const f32x4*)(lng + c); b2v[j] = *(const f32x4*)(lnb + c);
                    if (l == 0) { const f32x4 sh = *(const f32x4*)(mv1 + c), sc = *(const f32x4*)(mv1 + 1024 + c); P3[j] = g2v[j] * (sc + 1.0f) * SC_A1; Q3[j] = (b2v[j] * (sc + 1.0f) + sh) * SC_A1; } } }
            f32x4 x[4]; float s = 0.f;
#pragma unroll
            for (int j = 0; j < 4; ++j) { const v2u p = hv[q][j]; x[j] = (f32x4){__uint_as_float(p.x << 16), __uint_as_float(p.x & 0xffff0000u), __uint_as_float(p.y << 16), __uint_as_float(p.y & 0xffff0000u)}; s += (x[j][0] + x[j][1]) + (x[j][2] + x[j][3]); }
            float mean = wave_sum(s) * (1.f / 1024.f), s2 = 0.f;
#pragma unroll
            for (int j = 0; j < 4; ++j) { x[j] = x[j] - mean; s2 += (x[j][0] * x[j][0] + x[j][1] * x[j][1]) + (x[j][2] * x[j][2] + x[j][3] * x[j][3]); }
            float rstd = rsqrtf(wave_sum(s2) * (1.f / 1024.f) + LN_EPS);
            s = 0.f;
#pragma unroll
            for (int j = 0; j < 4; ++j) { f32x4 f = {0.f, 0.f, 0.f, 0.f};
#pragma unroll
                for (int k = 0; k < 4; ++k) { const unsigned y = yv[q][j][k]; const auto lo = __builtin_amdgcn_cvt_pk_f32_fp8((int)y, false), hi = __builtin_amdgcn_cvt_pk_f32_fp8((int)y, true);
                    f[0] += lo[0]; f[1] += lo[1]; f[2] += hi[0]; f[3] += hi[1]; }
                x[j] = (x[j] * rstd) * P1[j] + Q1[j] + G2[j] * f; s += (x[j][0] + x[j][1]) + (x[j][2] + x[j][3]); }
            mean = wave_sum(s) * (1.f / 1024.f); s2 = 0.f;
#pragma unroll
            for (int j = 0; j < 4; ++j) { x[j] = x[j] - mean; s2 += (x[j][0] * x[j][0] + x[j][1] * x[j][1]) + (x[j][2] * x[j][2] + x[j][3] * x[j][3]); }
            rstd = rsqrtf(wave_sum(s2) * (1.f / 1024.f) + LN_EPS);
#pragma unroll
            for (int j = 0; j < 4; ++j) { const int c = 4 * (lane + 64 * j); const f32x4 xh = x[j] * rstd;
                const f32x4 o = xh * g2v[j] + b2v[j];
                if (l == 0) { v2u hw; hw.x = pk2(o[0], o[1]); hw.y = pk2(o[2], o[3]); *(v2u*)((bf16*)H + r * 1024 + c) = hw;
                    const f32x4 am = xh * P3[j] + Q3[j]; *(unsigned*)((unsigned char*)A1 + r * 1024 + c) = pack_fp8x4(am[0], am[1], am[2], am[3]); }
                else *(f32x4*)(a.out + (size_t)lr * 1024 + c) = o; }
        }
    }
}

__device__ __forceinline__ void phase_conv(const Args& a, LAS unsigned char* lds, int tid, int lane, int wave) {
    const bf16* U = (const bf16*)(a.ws + WS_X); bf16* V = (bf16*)(a.ws + WS_Y);
    LAS float* part = (LAS float*)(lds + 126976);
    LAS float* st = part + 512;
    const int c0 = 2 * tid;
    const float db0 = a.in[I_DWB][c0], db1 = a.in[I_DWB][c0 + 1], g0 = a.in[I_CLNG][c0], g1 = a.in[I_CLNG][c0 + 1], be0 = a.in[I_CLNB][c0], be1 = a.in[I_CLNB][c0 + 1];
    for (int tile = blockIdx.x; tile < NLAT / 32; tile += gridDim.x) {
        const int b = tile >> 7, t0 = (tile & 127) * 32;
        const size_t rb0 = (size_t)b * TPB + CTXL;
        __syncthreads();
        for (int i = tid; i < 62 * 128; i += NTHR) { const int row = i >> 7, chk = i & 127, t = t0 - 15 + row;
            v4u val = {0u, 0u, 0u, 0u}; if (t >= 0 && t < SEQ) val = *(const v4u*)(U + (rb0 + t) * 1024 + chk * 8);
            *(LAS v4u*)(lds + row * 2048 + chk * 16) = val; }
        __syncthreads();
        float w0[31], w1[31];
#pragma unroll
        for (int j = 0; j < 31; ++j) { const float2 wv = *(const float2*)(a.in[I_DWW] + j * 1024 + c0); w0[j] = wv.x; w1[j] = wv.y; }
#pragma unroll 1
        for (int hh = 0; hh < 2; ++hh) {
            const LAS unsigned char* hp = lds + hh * 16 * 2048;
            float acc0[16], acc1[16];
#pragma unroll
            for (int t = 0; t < 16; ++t) { acc0[t] = db0; acc1[t] = db1; }
#pragma unroll
            for (int s = 0; s < 46; ++s) { const unsigned pr = *(const LAS unsigned*)(hp + s * 2048 + tid * 4); const float x0 = __uint_as_float(pr << 16), x1 = __uint_as_float(pr & 0xffff0000u);
#pragma unroll
                for (int t = (s > 30 ? s - 30 : 0); t <= (s < 15 ? s : 15); ++t) { acc0[t] = fmaf(x0, w0[s - t], acc0[t]); acc1[t] = fmaf(x1, w1[s - t], acc1[t]); } }
            float rs[32];
#pragma unroll
            for (int t = 0; t < 16; ++t) { rs[2 * t] = acc0[t] + acc1[t]; rs[2 * t + 1] = acc0[t] * acc0[t] + acc1[t] * acc1[t]; }
#define RS_STEP(NKEEP, XORV) { const bool bit_ = (lane & XORV) != 0; _Pragma("unroll") for (int k_ = 0; k_ < NKEEP; ++k_) { const float snd_ = bit_ ? rs[k_] : rs[k_ + NKEEP]; const float rcv_ = __shfl_xor(snd_, XORV); rs[k_] = (bit_ ? rs[k_ + NKEEP] : rs[k_]) + rcv_; } }
            RS_STEP(16, 32) RS_STEP(8, 16) RS_STEP(4, 8) RS_STEP(2, 4) RS_STEP(1, 2)
#undef RS_STEP
            rs[0] += __shfl_xor(rs[0], 1);
            __syncthreads();
            if ((lane & 1) == 0) part[wave * 32 + (lane >> 1)] = rs[0];
            __syncthreads();
            if (tid < 16) { float s1 = 0.f, s2 = 0.f;
#pragma unroll
                for (int w = 0; w < 8; ++w) { s1 += part[w * 32 + 2 * tid]; s2 += part[w * 32 + 2 * tid + 1]; }
                const float mean = s1 * (1.f / 1024.f); const float var = fmaxf(s2 * (1.f / 1024.f) - mean * mean, 0.f); st[2 * tid] = mean; st[2 * tid + 1] = rsqrtf(var + LN_EPS); }
            __syncthreads();
#pragma unroll
            for (int t = 0; t < 16; ++t) { const float mean = st[2 * t], rstd = st[2 * t + 1];
                const float y0 = (acc0[t] - mean) * rstd * g0 + be0, y1 = (acc1[t] - mean) * rstd * g1 + be1;
                const float z0 = fminf(fmaxf(y0 * sigm(y0) * SC_CV, -448.f), 448.f), z1 = fminf(fmaxf(y1 * sigm(y1) * SC_CV, -448.f), 448.f);
                *(unsigned short*)((unsigned char*)V + (rb0 + t0 + hh * 16 + t) * 1024 + c0) = (unsigned short)__builtin_amdgcn_cvt_pk_fp8_f32(z0, z1, 0, false); }
        }
    }
}

namespace hg {
using bf16x8 = __attribute__((ext_vector_type(8))) short;
using s16x4  = __attribute__((ext_vector_type(4))) short;
using f32x16 = __attribute__((ext_vector_type(16))) float;
using u32x4  = __attribute__((ext_vector_type(4))) unsigned;
constexpr int RS = 272;
constexpr int VS = 80;
constexpr int T_Q = 0, T_KO = 32 * RS, T_D = 64 * RS, IMG_BYTES = T_D + 512, T_V = IMG_BYTES, TILE_BYTES = T_V + 32 * VS;
constexpr int OFF_TILES = 1024, NTB = 3, OFF_OPART = OFF_TILES + NTB * TILE_BYTES, OPART_BYTES = 4 * 4096;
static_assert(OFF_OPART + 2 * OPART_BYTES <= 131072 && IMG_BYTES % 16 == 0 && IMG_BYTES / 16 == 1120, "hgrn lds");
constexpr int P_RAW = 1024, R_Q = 0, R_F = 32 * RS, RAW_BYTES = 64 * RS, P_IMG = P_RAW + RAW_BYTES;
constexpr int NCHUNK = TPB / 32, NCHAIN = NB * 4 * 2, NITEM = NCHAIN * NCHUNK;
__device__ __forceinline__ int crow(int r, int hi) { return (r & 3) + 8 * (r >> 2) + 4 * hi; }
__device__ __forceinline__ s16x4 tr_read(unsigned addr) { s16x4 r; asm volatile("ds_read_b64_tr_b16 %0, %1" : "=&v"(r) : "v"(addr) : "memory"); return r; }
__device__ __forceinline__ bf16x8 cat8(s16x4 l, s16x4 h) { return (bf16x8){l[0], l[1], l[2], l[3], h[0], h[1], h[2], h[3]}; }
__device__ __forceinline__ bf16x8 pack8(const f32x16& x, int base) {
    u32x4 w; w[0] = pk2(x[base + 0], x[base + 1]); w[1] = pk2(x[base + 2], x[base + 3]); w[2] = pk2(x[base + 4], x[base + 5]); w[3] = pk2(x[base + 6], x[base + 7]);
    return *reinterpret_cast<bf16x8*>(&w);
}
}


#define HG_TOKP(dir, n) ((dir) ? ((n) < CTXL ? (CTXL - 1 - (n)) : (TPB + CTXL - 1 - (n))) : (n))
#define HG_DPP1(x, ctrl, rmask) __int_as_float(__builtin_amdgcn_update_dpp(0x3f800000, __float_as_int(x), ctrl, rmask, 0xf, false))
#define HG_DPP(x, ctrl, rmask) __int_as_float(__builtin_amdgcn_update_dpp(0, __float_as_int(x), ctrl, rmask, 0xf, false))
__device__ __forceinline__ void hgrn_prep_items(const Args& a, LAS unsigned char* lds, int tid) {
    using namespace hg;
    const bf16* Z = (const bf16*)(a.ws + WS_Z);
    unsigned char* HT = a.ws + WS_HT;
    const int wave = __builtin_amdgcn_readfirstlane(tid >> 6), lane = tid & 63, t = lane & 31, half = lane >> 5;
    const int c0 = 16 * wave + 8 * half;
    const int lr = tid >> 4, lch = tid & 15;
    LAS float* lbt = (LAS float*)lds;
    constexpr int P_RAW2 = 2048, P_IMG2 = P_RAW2 + 2 * RAW_BYTES;
    static_assert(P_IMG2 + 2 * IMG_BYTES <= 131072, "prep lds");
    __syncthreads();
    { const float l0 = a.in[I_LBL][tid], l1 = a.in[I_LBL][512 + tid], l2 = a.in[I_LBL][1024 + tid]; const float m = fmaxf(l0, fmaxf(l1, l2));
      const float e0 = __expf(l0 - m), e1 = __expf(l1 - m), e2 = __expf(l2 - m); lbt[tid] = e0 / (e0 + e1 + e2); }
    bf16x8 gq, gf;
#define HP_LOAD(it) do { const int ch_ = (it) % NCHUNK, cn_ = (it) / NCHUNK, dir_ = cn_ & 1, hd_ = (cn_ >> 1) & 3, b_ = cn_ >> 3; \
        const bf16* zr_ = Z + ((size_t)b_ * TPB + HG_TOKP(dir_, 32 * ch_ + lr)) * ZC; gq = *(const bf16x8*)(zr_ + ZHQ + hd_ * 128 + lch * 8); gf = *(const bf16x8*)(zr_ + (dir_ ? ZHB : ZHF) + hd_ * 128 + lch * 8); } while (0)
#define HP_STASH(bufi) do { LAS unsigned char* rb_ = lds + P_RAW2 + (bufi) * RAW_BYTES; *(LAS bf16x8*)(rb_ + R_Q + lr * RS + lch * 16) = gq; *(LAS bf16x8*)(rb_ + R_F + lr * RS + lch * 16) = gf; } while (0)
#define HP_COPYOUT(item, bufi) do { v4u* dst_ = (v4u*)(HT + (size_t)(item) * IMG_BYTES); const LAS v4u* src_ = (const LAS v4u*)(lds + P_IMG2 + (bufi) * IMG_BYTES); \
        dst_[tid] = src_[tid]; dst_[tid + 512] = src_[tid + 512]; if (tid < 96) dst_[tid + 1024] = src_[tid + 1024]; } while (0)
    const int G = gridDim.x;
    int it = blockIdx.x, par = 0;
    if (it < NITEM) { HP_LOAD(it); HP_STASH(0); }
    if (it + G < NITEM) HP_LOAD(it + G);
    __syncthreads();
    for (; it < NITEM; it += G, par ^= 1) {
        if (it + G < NITEM) HP_STASH(par ^ 1);
        if (it != (int)blockIdx.x) HP_COPYOUT(it - G, par ^ 1);
        if (it + 2 * G < NITEM) HP_LOAD(it + 2 * G);
        const int hd = ((it / NCHUNK) >> 1) & 3;
        {
            const LAS unsigned char* rb_ = lds + P_RAW2 + par * RAW_BYTES;
            const bf16x8 RQ = *(const LAS bf16x8*)(rb_ + R_Q + t * RS + c0 * 2), RF = *(const LAS bf16x8*)(rb_ + R_F + t * RS + c0 * 2);
            const f32x4 lbA = *(const LAS f32x4*)(lbt + hd * 128 + c0), lbB = *(const LAS f32x4*)(lbt + hd * 128 + c0 + 4);
            LAS unsigned char* tb_ = lds + P_IMG2 + par * IMG_BYTES;
            float bb_[8], kk_[8];
#pragma unroll
            for (int i_ = 0; i_ < 8; ++i_) { const float lb_ = i_ < 4 ? lbA[i_] : lbB[i_ - 4]; const float f_ = lb_ + (1.f - lb_) * __builtin_amdgcn_rcpf(1.f + __expf(-bf2f((unsigned short)RF[i_]))); kk_[i_] = 1.f - f_; bb_[i_] = f_; }
#pragma unroll
            for (int i_ = 0; i_ < 8; ++i_) { float x_ = bb_[i_]; x_ *= HG_DPP1(x_, 0x111, 0xf); x_ *= HG_DPP1(x_, 0x112, 0xf); x_ *= HG_DPP1(x_, 0x114, 0xf); x_ *= HG_DPP1(x_, 0x118, 0xf);
                x_ *= HG_DPP1(x_, 0x142, 0xa); bb_[i_] = x_; }
            float qi_[8], ko_[8], dd_[8];
#pragma unroll
            for (int i_ = 0; i_ < 8; ++i_) { const int bi_ = __float_as_int(bb_[i_]); dd_[i_] = __int_as_float(half ? __builtin_amdgcn_readlane(bi_, 63) : __builtin_amdgcn_readlane(bi_, 31));
                const float e_ = bb_[i_]; const float ei_ = __builtin_amdgcn_rcpf(e_);
                qi_[i_] = bf2f((unsigned short)RQ[i_]) * e_; ko_[i_] = kk_[i_] * ei_; }
            *(LAS v4u*)(tb_ + T_Q + t * RS + c0 * 2) = (v4u){pk2(qi_[0], qi_[1]), pk2(qi_[2], qi_[3]), pk2(qi_[4], qi_[5]), pk2(qi_[6], qi_[7])};
            *(LAS v4u*)(tb_ + T_KO + t * RS + c0 * 2) = (v4u){pk2(ko_[0], ko_[1]), pk2(ko_[2], ko_[3]), pk2(ko_[4], ko_[5]), pk2(ko_[6], ko_[7])};
            if (t == 31) { *(LAS f32x4*)(tb_ + T_D + c0 * 4) = (f32x4){dd_[0], dd_[1], dd_[2], dd_[3]}; *(LAS f32x4*)(tb_ + T_D + c0 * 4 + 16) = (f32x4){dd_[4], dd_[5], dd_[6], dd_[7]}; }
            if (tid < 32) *(LAS v4u*)(tb_ + T_Q + tid * RS + 256) = (v4u){0u, 0u, 0u, 0u};
            else if (tid < 64) *(LAS v4u*)(tb_ + T_KO + (tid - 32) * RS + 256) = (v4u){0u, 0u, 0u, 0u};
        }
        __syncthreads();
    }
    if (it - G >= (int)blockIdx.x && it - G < NITEM) HP_COPYOUT(it - G, par ^ 1);
    __syncthreads();
#undef HP_COPYOUT
#undef HP_LOAD
#undef HP_STASH
}

__device__ __forceinline__ void hgrn_unit_mfma(const Args& a, int unit, LAS unsigned char* lds, int tid) {
    using namespace hg;
    const int b = unit >> 5, head = (unit >> 3) & 3, dir = (unit >> 2) & 1, sl = unit & 3;
    const bf16* Z = (const bf16*)(a.ws + WS_Z);
    const unsigned char* HT = a.ws + WS_HT + (size_t)((b * 4 + head) * 2 + dir) * NCHUNK * IMG_BYTES;
    bf16* Od = (bf16*)(a.ws + (dir ? WS_OB : WS_OF));
    const int wave = __builtin_amdgcn_readfirstlane(tid >> 6), lane = tid & 63;
    const size_t zb = (size_t)b * TPB;
    constexpr int NCH = NCHUNK;
    const int vr = (tid >> 2) & 31, vp = tid & 3, lvcol = ZHI + head * 128 + sl * 32 + vp * 8, i3 = 1024 + (tid < 96 ? tid : 0);
    v4u gA0, gA1, gA2, gB0, gB1, gB2; bf16x8 gAv, gBv;
#define HG_LOAD(g0, g1, g2, gv, ch) do { const int c_ = (ch) < NCH ? (ch) : NCH - 1; const v4u* src_ = (const v4u*)(HT + (size_t)c_ * IMG_BYTES); \
        g0 = src_[tid]; g1 = src_[tid + 512]; g2 = src_[i3]; gv = *(const bf16x8*)(Z + (zb + HG_TOKP(dir, 32 * c_ + vr)) * ZC + lvcol); } while (0)
#define HG_STASH(g0, g1, g2, gv, bufi) do { LAS unsigned char* tb_ = lds + OFF_TILES + (bufi) * TILE_BYTES; LAS v4u* d_ = (LAS v4u*)tb_; \
        d_[tid] = g0; d_[tid + 512] = g1; if (tid < 96) d_[tid + 1024] = g2; if (tid < 128) *(LAS bf16x8*)(tb_ + T_V + vr * VS + vp * 16) = gv; } while (0)
    const int r32 = lane & 31, hi = lane >> 5, g1 = (lane >> 4) & 1, q4 = (lane & 15) >> 2, p4 = lane & 3, cb = 32 * wave;
    const unsigned lbase = (unsigned)(uintptr_t)lds;
    f32x16 S = {};
    HG_LOAD(gA0, gA1, gA2, gAv, 0); HG_STASH(gA0, gA1, gA2, gAv, 0); HG_LOAD(gA0, gA1, gA2, gAv, 1); HG_STASH(gA0, gA1, gA2, gAv, 1);
    HG_LOAD(gA0, gA1, gA2, gAv, 2);
    __syncthreads();
#define HG_RD64(dst, addr, OFFS) asm volatile("ds_read_b64 %0, %1 offset:" #OFFS : "=&v"(dst) : "v"(addr) : "memory")
#define HG_MFMA_STAGE(n, bufi) do { \
            const unsigned tb = lbase + OFF_TILES + (bufi) * TILE_BYTES; const LAS unsigned char* tl_ = lds + OFF_TILES + (bufi) * TILE_BYTES; \
            bf16x8 ko[2], qi[2]; s16x4 pvl[2], pvh[2], pql[2], pqh[2], kl[2], kh[2], nvl[2], nvh[2]; f32x4 dsc[4]; \
            _Pragma("unroll") for (int kk = 0; kk < 2; ++kk) { ko[kk] = *(const LAS bf16x8*)(tl_ + T_KO + r32 * RS + (cb + 16 * kk + 8 * hi) * 2); qi[kk] = *(const LAS bf16x8*)(tl_ + T_Q + r32 * RS + (cb + 16 * kk + 8 * hi) * 2); } \
            _Pragma("unroll") for (int sp = 0; sp < 2; ++sp) { \
                const unsigned va = tb + T_V + (16 * sp + 4 * hi + q4) * VS + (16 * g1 + 4 * p4) * 2; pvl[sp] = tr_read(va); pvh[sp] = tr_read(va + 8 * VS);              \
                const unsigned qa = tb + T_Q + r32 * RS + (cb + 16 * sp + 4 * hi) * 2; HG_RD64(pql[sp], qa, 0); HG_RD64(pqh[sp], qa, 16);                                  \
                const unsigned ka = tb + T_KO + (16 * sp + 8 * hi + q4) * RS + (cb + 16 * g1 + 4 * p4) * 2; kl[sp] = tr_read(ka); kh[sp] = tr_read(ka + 4 * RS);        \
                const unsigned vb = tb + T_V + (16 * sp + 8 * hi + q4) * VS + (16 * g1 + 4 * p4) * 2; nvl[sp] = tr_read(vb); nvh[sp] = tr_read(vb + 4 * VS); }            \
            _Pragma("unroll") for (int g = 0; g < 4; ++g) dsc[g] = *(const LAS f32x4*)(tl_ + T_D + (cb + 8 * g + 4 * hi) * 4); \
            asm volatile("s_waitcnt lgkmcnt(0)" ::: "memory"); __builtin_amdgcn_sched_barrier(0); \
            f32x16 X = {}; \
            X = __builtin_amdgcn_mfma_f32_32x32x16_bf16(ko[0], qi[0], X, 0, 0, 0); X = __builtin_amdgcn_mfma_f32_32x32x16_bf16(ko[1], qi[1], X, 0, 0, 0); \
            f32x16 O = {}; \
            O = __builtin_amdgcn_mfma_f32_32x32x16_bf16(cat8(pql[0], pqh[0]), pack8(S, 0), O, 0, 0, 0); O = __builtin_amdgcn_mfma_f32_32x32x16_bf16(cat8(pql[1], pqh[1]), pack8(S, 8), O, 0, 0, 0); \
            S = __builtin_amdgcn_mfma_f32_32x32x16_bf16(cat8(kl[0], kh[0]), cat8(nvl[0], nvh[0]), S, 0, 0, 0); S = __builtin_amdgcn_mfma_f32_32x32x16_bf16(cat8(kl[1], kh[1]), cat8(nvl[1], nvh[1]), S, 0, 0, 0); \
            _Pragma("unroll") for (int i = 0; i < 16; ++i) X[i] = (crow(i, hi) <= r32) ? X[i] : 0.f; \
            O = __builtin_amdgcn_mfma_f32_32x32x16_bf16(pack8(X, 0), cat8(pvl[0], pvh[0]), O, 0, 0, 0); O = __builtin_amdgcn_mfma_f32_32x32x16_bf16(pack8(X, 8), cat8(pvl[1], pvh[1]), O, 0, 0, 0); \
            _Pragma("unroll") for (int i = 0; i < 16; ++i) S[i] *= dsc[i >> 2][i & 3]; \
            LAS float* op = (LAS float*)(lds + OFF_OPART + ((n) & 1) * OPART_BYTES + wave * 4096); \
            _Pragma("unroll") for (int i = 0; i < 16; ++i) op[crow(i, hi) * 32 + r32] = O[i]; } while (0)
#define HG_OUT_STAGE(n) do { \
            const int l2 = tid - 256, tt = l2 >> 3, vq = l2 & 7; \
            const LAS float* op = (const LAS float*)(lds + OFF_OPART + (((n) - 1) & 1) * OPART_BYTES) + tt * 32 + vq * 4; \
            const f32x4 s = (*(const LAS f32x4*)op + *(const LAS f32x4*)(op + 1024)) + (*(const LAS f32x4*)(op + 2048) + *(const LAS f32x4*)(op + 3072)); \
            const int p = HG_TOKP(dir, 32 * ((n) - 1) + tt); \
            if (p >= CTXL) *(v2u*)(Od + (zb + p) * 512 + head * 128 + sl * 32 + vq * 4) = (v2u){pk2(s[0], s[1]), pk2(s[2], s[3])}; } while (0)
#define HG_ITER(n, L0, L1, L2, LV, S0, S1, S2, SV) do { \
        HG_LOAD(L0, L1, L2, LV, (n) + 3); \
        if (wave < 4) { HG_MFMA_STAGE(n, bcur); } else if ((n) > 0) { HG_OUT_STAGE(n); } \
        { const int bst_ = bcur == 0 ? 2 : bcur - 1; HG_STASH(S0, S1, S2, SV, bst_); } \
        bcur = bcur == 2 ? 0 : bcur + 1; \
        __syncthreads(); } while (0)
    int bcur = 0;
    for (int n = 0; n < NCH; n += 2) {
        HG_ITER(n, gB0, gB1, gB2, gBv, gA0, gA1, gA2, gAv);
        HG_ITER(n + 1, gA0, gA1, gA2, gAv, gB0, gB1, gB2, gBv);
    }
    if (wave >= 4) { HG_OUT_STAGE(NCH); }
    __syncthreads();
#undef HG_MFMA_STAGE
#undef HG_OUT_STAGE
#undef HG_ITER
#undef HG_LOAD
#undef HG_STASH
#undef HG_RD64
}

__device__ __forceinline__ bool in_range(int lo, int hi, int k) { asm volatile("" : "+s"(lo), "+s"(hi)); return lo <= k && k < hi; }
constexpr int NPHASES = 21;
__global__ void __launch_bounds__(NTHR, 2) fwd_kernel(Args args) {
    extern __shared__ __attribute__((aligned(16))) unsigned char lds_raw[];
    LAS unsigned char* lds = (LAS unsigned char*)lds_raw;
    const int G = gridDim.x;
#define FRESH() int tid = threadIdx.x; asm volatile("" : "+v"(tid)); const int lane = tid & 63, wave = __builtin_amdgcn_readfirstlane(tid >> 6); (void)lane; (void)wave
    unsigned char* ws = args.ws;
    if (threadIdx.x < 16) ((LAS unsigned*)(lds + LDS_BAR_OFF))[threadIdx.x] = 0u;
    __syncthreads();
    XcdBarrier bar = xcd_barrier_post((unsigned*)(ws + WS_CTL), (volatile LAS unsigned*)(lds + LDS_BAR_OFF));
    const int lo = args.ph_lo, hi = args.ph_hi;
#define IN(k) in_range(lo, hi, (k))
#define NREP(k) (((PROBE_MASK >> (k)) & 1u) ? 2 : 1)
#define REPEAT(k) for (int rep_ = 0; rep_ < NREP(k); ++rep_) if (rep_ == 0 || (xcd_barrier(bar), true))
#define SEAM(k) do { if (IN(k) && IN((k) + 1)) xcd_barrier(bar); } while (0)
    bf16* const BX = (bf16*)(ws + WS_X); bf16* const BY = (bf16*)(ws + WS_Y);
    const float* const MODV = (const float*)(ws + WS_MODV);

#if defined(PROBE_BARS)
    for (int pbi = 0; pbi < PROBE_BARS; ++pbi) xcd_barrier(bar);
#endif
    if (IN(0)) REPEAT(0) { FRESH(); phase_prologue(args, lds, tid, lane, wave); } SEAM(0);
    if (IN(1)) REPEAT(1) { FRESH(); phase_mod0(args, lane, wave); } SEAM(1);
    if (IN(2)) REPEAT(2) {
        pg8::Gemm g{BX, (const bf16*)(ws + WS_WIN), NTOK, ZC, 512}; pg8::AllOrder S; S.init(NTOK / 256, ZC / 256, G, (int)blockIdx.x);
        pg8::EpiBf16<0> E{(bf16*)(ws + WS_Z), ZC, nullptr, ZC, 0, 1.f / (SC_A0 * SC_WIN)};
        pg8::gemm_phase<pg8::EpiBf16<0>, pg8::AllOrder, PG8_ALIGN, true, false, true>(lds, g, S, E);
    } SEAM(2);
    if (IN(3)) REPEAT(3) { FRESH(); phase_norm0(args, lane, wave); hgrn_prep_items(args, lds, tid); } SEAM(3);
    if (IN(4)) REPEAT(4) {
        { pg8::Gemm g{(const bf16*)(ws + WS_CQN), (const bf16*)(ws + WS_WUQ), NTOK, 768, 384}; pg8::LatOrder S; S.init(128, 3, G, (int)blockIdx.x);
          pg8::EpiBf16<0> E{(bf16*)(ws + WS_Q), 768, nullptr, 0, 0, 1.f};
          pg8::gemm_phase<pg8::EpiBf16<0>, pg8::LatOrder, PG8_ALIGN, PG8_SP2>(lds, g, S, E); }
        __syncthreads();
        { pg8::Gemm g{(const bf16*)(ws + WS_CKVN), (const bf16*)(ws + WS_WUKV), NTOK, 1024, 256}; pg8::AllOrder S; S.init(NTOK / 256, 4, G, G - 1 - (int)blockIdx.x);
          pg8::EpiBf16<0> E{(bf16*)(ws + WS_KV), 1024, nullptr, 0, 0, 1.f};
          pg8::gemm_phase<pg8::EpiBf16<0>, pg8::AllOrder, PG8_ALIGN, PG8_SP2>(lds, g, S, E); }
    } SEAM(4);
    if (IN(5)) {
        REPEAT(21) { FRESH();
        for (int u = blockIdx.x; u < 256; u += G) { __syncthreads(); hgrn_unit_mfma(args, (G == 256) ? ((u & 7) * 32 + (u >> 3)) : u, lds, tid); } }
        const bf16* Q = (const bf16*)(ws + WS_Q); const bf16* KV = (const bf16*)(ws + WS_KV); const bf16* KRR = (const bf16*)(ws + WS_KRR);
        const float* rope = (const float*)(ws + WS_ROPE);
        const int cslot = (G == 256) ? ((((int)blockIdx.x & 7) * 2 + (((int)blockIdx.x >> 3) >> 4)) % 5) : 0;
        REPEAT(22) {
        int ai = 0;
        for (int slot = 0; slot < 5; ++slot) {
            if (slot == cslot) { if (rep_ == 0) { FRESH(); __syncthreads(); convert_moe_share(args, lds, lane, wave); } continue; }
            for (int u = (G == 256) ? (int)blockIdx.x + ai * 256 : (int)blockIdx.x; u < ((G == 256) ? (int)blockIdx.x + ai * 256 + 1 : (ai == 0 ? 1024 : 0)); u += G) {
                int b, h, qb; if (G == 256) { const int x = (int)blockIdx.x & 7, j = (int)blockIdx.x >> 3, pr = (u >> 8) * 16 + 2 * x + (j >> 4); b = pr >> 3; h = pr & 7; qb = j & 15; } else { b = u >> 7; h = (u >> 4) & 7; qb = u & 15; }
                const size_t kb = (size_t)b * TPB, q0 = kb + CTXL + (size_t)qb * 256;
                __syncthreads();
                att::attn_unit(Q + q0 * 768 + h * 96, KV + kb * 1024 + h * 64, KRR + kb * 32, BY + q0 * 1024 + h * 64, rope + (size_t)qb * 256 * 32, TPB, (char*)lds_raw);
            }
            ++ai;
        }
        }
    } SEAM(5);
    if (IN(6)) REPEAT(6) { FRESH(); phase_readout(args, lane, wave); } SEAM(6);
    if (IN(7)) REPEAT(7) {
        pg8::Gemm g{BY, (const bf16*)(ws + WS_WOUT), NTOK, 1024, 1024}; pg8::LatOrder S; S.init(128, 4, G, (int)blockIdx.x);
        pg8::EpiRes<false> E{args.in[I_X], nullptr, (bf16*)(ws + WS_PRE), MODV, nullptr, 1.f};
        pg8::gemm_phase<pg8::EpiRes<false>, pg8::LatOrder, PG8_ALIGN, PG8_SP2>(lds, g, S, E);
    } SEAM(7);
    for (int l = 0; l < 2; ++l) {
        if (l == 1) {
            if (IN(13)) REPEAT(13) {
                pg8::Gemm g{BY, (const bf16*)(ws + WS_WPW1), NTOK, 2048, 512}; pg8::LatOrder S; S.init(128, 8, G, (int)blockIdx.x);
                pg8::EpiGate<0> E{BX, (const float*)(ws + WS_PW1B), 8, 1.f / (SC_A1 * SC_WPW), 1.f, lds};
                pg8::gemm_phase<pg8::EpiGate<0>, pg8::LatOrder, PG8_ALIGN, true, false, true>(lds, g, S, E);
            } SEAM(13);
            if (IN(14)) REPEAT(14) { FRESH(); phase_conv(args, lds, tid, lane, wave); } SEAM(14);
            if (IN(15)) REPEAT(15) {
                pg8::Gemm g{BY, (const bf16*)(ws + WS_WPW2), NTOK, 1024, 512}; pg8::LatOrder S; S.init(128, 4, G, (int)blockIdx.x);
                pg8::EpiRes<true> E{nullptr, (const bf16*)(ws + WS_H), (bf16*)(ws + WS_PRE), MODV + 9 * 6144, args.in[I_PW2B], 1.f / (SC_CV * SC_WPW)};
                pg8::gemm_phase<pg8::EpiRes<true>, pg8::LatOrder, PG8_ALIGN, true, false, true>(lds, g, S, E);
            } SEAM(15);
        }
        const int pb = l ? 16 : 8;
        if (IN(pb)) REPEAT(pb) { FRESH(); phase_ln1(args, l, lds, tid, lane, wave); } SEAM(pb);
        if (IN(pb + 2) || IN(pb + 3)) {
            LAS int* tl = (LAS int*)(lds + LDS_TILE_E);
            FRESH();
            __syncthreads();
            if (tid < 32) tl[3 * MAXTILES + 64 + tid] = ld_ctl((const int*)(ws + WS_CURSOR) + l * 32 + tid);
            __syncthreads();
            if (tid == 0) { int ts = 0; for (int e = 0; e < 32; ++e) { tl[3 * MAXTILES + e] = ts; ts += (tl[3 * MAXTILES + 64 + e] + 255) >> 8; } tl[3 * MAXTILES + 32] = ts; }
            __syncthreads();
            const int ntiles = tl[3 * MAXTILES + 32];
            for (int t = tid; t < ntiles && t < MAXTILES; t += NTHR) { int e = 0; while (e < 31 && tl[3 * MAXTILES + e + 1] <= t) ++e; const int j = t - tl[3 * MAXTILES + e], rem = tl[3 * MAXTILES + 64 + e] - 256 * j;
                tl[t] = e; tl[MAXTILES + t] = e * ECAP + 256 * j; tl[2 * MAXTILES + t] = rem < 256 ? rem : 256; }
            __syncthreads();
            if (IN(pb + 2)) REPEAT(pb + 2) {
#if defined(PROBE_STAGGER)
                if (blockIdx.x & 1) { const unsigned long long t0 = __builtin_amdgcn_s_memrealtime(); while (__builtin_amdgcn_s_memrealtime() - t0 < PROBE_STAGGER) __builtin_amdgcn_s_sleep(8); }
#endif
                pg8::Gemm g{BX, (const bf16*)(ws + WS_WGU + (size_t)l * 32 * 2048 * 1024), 0, 0, 512};
                pg8::MoeOrder S; S.init(ntiles, 8, G, (int)blockIdx.x); S.tile_e = tl; S.nper = 8;
                pg8::EpiGate<1, true> E{(bf16*)(ws + WS_ACT), (const float*)(ws + WS_BGU) + (size_t)l * 32 * 2048, 8, 1.f / (SC_X8 * SC_WGU) * PROBE_KSC, SC_ACT, lds};
                pg8::gemm_phase<pg8::EpiGate<1, true>, pg8::MoeOrder, PG8_ALIGN, true, true, true>(lds, g, S, E, (const int*)(ws + WS_ROWS), tl + MAXTILES);
            } SEAM(pb + 2);
            if (IN(pb + 3)) REPEAT(pb + 3) {
                pg8::Gemm g{(const bf16*)(ws + WS_ACT), (const bf16*)(ws + WS_WDN + (size_t)l * 32 * 1024 * 1024), 0, 0, 512};
                pg8::MoeOrder S; S.init(ntiles, 4, G, (int)blockIdx.x); S.tile_e = tl; S.nper = 4;
                pg8::EpiDown E{(bf16*)(ws + WS_YB), args.in[I_BDN] + (size_t)l * 32 * 1024, (const float*)(ws + WS_ROWW), (const int*)(ws + WS_ROWD), 1.f / (SC_ACT * SC_WDN) * PROBE_KSC, tl + MAXTILES, SC_Y, lds};
                pg8::gemm_phase<pg8::EpiDown, pg8::MoeOrder, PG8_ALIGN, true, false, true>(lds, g, S, E);
            } SEAM(pb + 3);
        }
        if (IN(pb + 4)) REPEAT(pb + 4) { FRESH(); phase_ln2(args, l, lane, wave); }
        if (l == 0) SEAM(12);
    }
#undef IN
#undef SEAM
}

extern "C" void kernel_launch(void* const* d_in, const int* in_sizes, int n_in, void* d_out, int out_size, void* d_ws, size_t ws_size, hipStream_t stream) {
    static int grid = 0;
    if (grid == 0) {
        if (n_in != 33 || in_sizes[0] != NB * SEQ * D || out_size != NB * SEQ * D || ws_size < WS_END) {
            fprintf(stderr, "kernel_launch: unexpected shapes: n_in %d in0 %d out %d ws %zu (need %zu)\n", n_in, n_in > 0 ? in_sizes[0] : -1, out_size, ws_size, (size_t)WS_END); grid = -1; return; }
        int dev = 0, cus = 0;
        if (hipGetDevice(&dev) != hipSuccess || hipDeviceGetAttribute(&cus, hipDeviceAttributeMultiprocessorCount, dev) != hipSuccess) { grid = -1; return; }
        if (hipFuncSetAttribute((const void*)fwd_kernel, hipFuncAttributeMaxDynamicSharedMemorySize, LDS_BYTES) != hipSuccess) { fprintf(stderr, "kernel_launch: hipFuncSetAttribute failed\n"); grid = -1; return; }
        int per_cu = 0;
        if (hipOccupancyMaxActiveBlocksPerMultiprocessor(&per_cu, (const void*)fwd_kernel, NTHR, LDS_BYTES) != hipSuccess || per_cu < 1) fprintf(stderr, "kernel_launch: occupancy query reports %d\n", per_cu);
        (void)hipGetLastError();
        grid = cus;
    }
    if (grid < 0) return;
    if (hipMemsetAsync((char*)d_ws + WS_CTL, 0, CTL_ZERO_BYTES, stream) != hipSuccess) return;
    Args a{};
    for (int i = 0; i < 33; ++i) a.in[i] = (const float*)d_in[i];
    a.out = (float*)d_out; a.ws = (unsigned char*)d_ws;
#if MK_ONE_LAUNCH
    a.ph_lo = 0; a.ph_hi = NPHASES;
    hipLaunchKernelGGL(fwd_kernel, dim3(grid), dim3(NTHR), LDS_BYTES, stream, a);
#else
    for (int ph = 0; ph < NPHASES; ++ph) { a.ph_lo = ph; a.ph_hi = ph + 1; hipLaunchKernelGGL(fwd_kernel, dim3(grid), dim3(NTHR), LDS_BYTES, stream, a); }
#endif
    const hipError_t le = hipPeekAtLastError();
    if (le != hipSuccess) fprintf(stderr, "kernel_launch: launch failed: %s\n", hipGetErrorName(le));
}
```

```cpp
#include <hip/hip_runtime.h>
#include <cstdio>
#include <cstdint>

#ifndef PROBE_MASK
#define PROBE_MASK 0u
#endif
#if defined(PROBE_K2)
#define PROBE_KSC 0.5f
#else
#define PROBE_KSC 1.0f
#endif
#ifndef MK_ONE_LAUNCH
#define MK_ONE_LAUNCH 1
#endif

namespace pg8 {
#define PG8_LAS __attribute__((address_space(3)))
typedef unsigned short bf16_t;
typedef short bf16x8 __attribute__((ext_vector_type(8)));
typedef float f32x4 __attribute__((ext_vector_type(4)));
typedef unsigned u32x4 __attribute__((ext_vector_type(4)));
constexpr int BM = 256, BK = 64, HALF = 128, HTB = HALF * BK * 2  , STAGE_BYTES = 8 * HTB, NXCD = 8, WGM = 8;

__host__ __device__ __forceinline__ int lds_byte(int r, int c) { const int st = (r >> 4) * 2 + (c >> 5), rr = r & 15, cc = c & 31, ob = rr * 64 + cc * 2; return st * 1024 + (ob ^ (((ob >> 9) & 1) << 5)); }
__host__ __device__ __forceinline__ void stage_rc(int b, int& R, int& C) { const int st = b / 1024, sb = b % 1024, swz = sb ^ (((sb >> 9) & 1) << 5); R = (st >> 1) * 16 + swz / 64; C = (st & 1) * 32 + (swz % 64) / 2; }
__host__ __device__ __forceinline__ int perm32(int rho) { const int n = rho >> 4, i = rho & 15; return 8 * (i >> 2) + 4 * n + (i & 3); }

struct Unit { int pm, pn; };
struct Gemm { const bf16_t* A; const bf16_t* Bt; int M, N, K; };

struct StaticOrder {
    int nM, nN, nwg, G, c;
    __host__ __device__ void init(int M, int N, int G_, int c_) { nM = M / BM; nN = N / BM; nwg = nM * nN; G = G_; c = c_; }
    __host__ __device__ bool next(int i, Unit& u) const {
        const long L = (long)i * G + c; if (L >= nwg) return false;
        int wgid = (int)L; { const int q = nwg / NXCD, r = nwg % NXCD, xcd = wgid % NXCD, off = wgid / NXCD; wgid = (xcd < r ? xcd * (q + 1) : r * (q + 1) + (xcd - r) * q) + off; }
        const int nig = WGM * nN, gid = wgid / nig, fm = gid * WGM, gsz = (nM - fm) < WGM ? (nM - fm) : WGM;
        u.pm = fm + ((wgid % nig) % gsz); u.pn = (wgid % nig) / gsz; return true;
    }
    __device__ __forceinline__ void a_ready(const Unit&) const {}
    __device__ __forceinline__ void done(const Unit&) const {}
};

__device__ __forceinline__ unsigned cvt_pk_bf16(float lo, float hi) { unsigned r; asm volatile("v_cvt_pk_bf16_f32 %0, %1, %2" : "=v"(r) : "v"(lo), "v"(hi)); return r; }
typedef float f32x2 __attribute__((ext_vector_type(2)));
__device__ __forceinline__ f32x2 gelu_pk(f32x2 v) {
    const f32x2 av = __builtin_elementwise_abs(v), d = av * 0.2316418882f + 1.0f;
    f32x2 t; t.x = __builtin_amdgcn_rcpf(d.x); t.y = __builtin_amdgcn_rcpf(d.y);
    f32x2 q = t * 0.5307027145f + (-0.7265760135f); q = q * t + 0.7107068705f; q = q * t + (-0.142248368f); q = q * t + 0.127414796f; q = q * t;
    const f32x2 s = (v * v) * (-0.72134752044f);
    f32x2 e; e.x = __builtin_amdgcn_exp2f(s.x); e.y = __builtin_amdgcn_exp2f(s.y);
    const f32x2 m = v * (q * e), r = v - m;
    f32x2 o; o.x = v.x < 0.f ? m.x : r.x; o.y = v.y < 0.f ? m.y : r.y; return o;
}

template <int ACT  > struct EpiBf16 {
    static constexpr bool PERM = true, AFTER_DRAIN = false, PREFETCH = false; static_assert(ACT == 0 || ACT == 1, "EpiBf16: ACT is 0 (none) or 1 (gelu_pk)");
    bf16_t* O; int ldc; const float* bias; int split_cols; size_t split_stride; float scale0;
    __device__ __forceinline__ void operator()(const f32x4 (&acc)[2][2][4][2], const Unit& u, int wr, int wc, int fr, int fq) const {
        const int row0 = u.pm * BM + wr * 64 + fr; int colt = u.pn * BM; bf16_t* base = O;
        float sc = 1.f; if (split_cols) { const int t = colt / split_cols; base += (size_t)t * split_stride; colt -= t * split_cols; if (t == 0) sc = scale0; }
        const int col0 = colt + wc * 32 + 8 * fq, bcol0 = u.pn * BM + wc * 32 + 8 * fq;
        f32x4 bv[2][2];
#pragma unroll
        for (int bj = 0; bj < 2; ++bj)
#pragma unroll
            for (int n = 0; n < 2; ++n) bv[bj][n] = bias ? *(const f32x4*)(bias + bcol0 + bj * HALF + 4 * n) : (f32x4){0.f, 0.f, 0.f, 0.f};
#pragma unroll
        for (int ai = 0; ai < 2; ++ai)
#pragma unroll
            for (int m = 0; m < 4; ++m) { bf16_t* rowp = base + (size_t)(row0 + ai * HALF + m * 16) * ldc + col0;
#pragma unroll
                for (int bj = 0; bj < 2; ++bj) { f32x4 v0 = acc[ai][bj][m][0] + bv[bj][0], v1 = acc[ai][bj][m][1] + bv[bj][1];
                    if (ACT == 1) { f32x2 a = gelu_pk((f32x2){v0[0], v0[1]}), b = gelu_pk((f32x2){v0[2], v0[3]}), c = gelu_pk((f32x2){v1[0], v1[1]}), d = gelu_pk((f32x2){v1[2], v1[3]});
                        v0 = (f32x4){a.x, a.y, b.x, b.y}; v1 = (f32x4){c.x, c.y, d.x, d.y}; }
                    v0 = v0 * sc; v1 = v1 * sc; u32x4 w; w.x = cvt_pk_bf16(v0[0], v0[1]); w.y = cvt_pk_bf16(v0[2], v0[3]); w.z = cvt_pk_bf16(v1[0], v1[1]); w.w = cvt_pk_bf16(v1[2], v1[3]);
                    *(u32x4*)(rowp + bj * HALF) = w; } }
    }
};
typedef int v4i_t __attribute__((ext_vector_type(4)));
typedef int v8i_t __attribute__((ext_vector_type(8)));
__device__ __forceinline__ v8i_t cat32(bf16x8 a, bf16x8 b) { const v4i_t x = __builtin_bit_cast(v4i_t, a), y = __builtin_bit_cast(v4i_t, b); return __builtin_shufflevector(x, y, 0, 1, 2, 3, 4, 5, 6, 7); }
template <class Epi, class Sched, bool ALIGN_EPI = false, bool SP2 = false, bool GATHER = false, bool FP8 = false>
__device__ __forceinline__ void gemm_phase(PG8_LAS unsigned char* lds, const Gemm g, const Sched& S, const Epi& E, const int* rowsrc = nullptr, const PG8_LAS int* gtab = nullptr) {
    static_assert(!GATHER || SP2, "GATHER is implemented on the SP2 loop only");
    int tid_l = threadIdx.x; asm volatile("" : "+v"(tid_l));
    const int tid = tid_l, wid = __builtin_amdgcn_readfirstlane(tid >> 6), lane = tid & 63, wr = wid >> 2, wc = wid & 3, fr = lane & 15, fq = lane >> 4;
#if defined(PROBE_K2)
    const int K = g.K, nt0 = K / BK, nt = FP8 ? 2 * nt0 : nt0;
#define PG8_KT(x) (FP8 ? ((x) & (nt0 - 1)) : (x))
#else
    const int K = g.K, nt = K / BK;
#define PG8_KT(x) (x)
#endif
    unsigned voffA[2], voffB[2];
#pragma unroll
    for (int i = 0; i < 2; ++i) { int R, C; stage_rc(tid * 16 + i * 8192, R, C); const int Rb = Epi::PERM ? ((R & ~31) + perm32(R & 31)) : R;
        voffA[i] = (unsigned)(R * K + C) * 2u; voffB[i] = (unsigned)(Rb * K + C) * 2u; }
    unsigned gAc[2][2], gAn[2][2]; int gR[2]; unsigned gC[2];
#pragma unroll
    for (int i = 0; i < 2; ++i) { int R, C; stage_rc(tid * 16 + i * 8192, R, C); gR[i] = R; gC[i] = (unsigned)C * 2u; gAc[0][i] = gAc[1][i] = gAn[0][i] = gAn[1][i] = 0u; }
#define PG8_GATHER(u_, o_) do { const int gtb_ = gtab[(u_).pm], gtc_ = gtab[576 + (u_).pm];     \
        _Pragma("unroll") for (int h_ = 0; h_ < 2; ++h_) _Pragma("unroll") for (int i_ = 0; i_ < 2; ++i_) \
        { const int rl_ = h_ * HALF + gR[i_]; const int src_ = rl_ < gtc_ ? rowsrc[gtb_ + rl_] : 0; o_[h_][i_] = (unsigned)src_ * (unsigned)(K * 2) + gC[i_]; } } while (0)
#define PG8_STAGE_A(bufoff, orig_gbase, NEXTSEL, H, KOFF) do { if constexpr (GATHER) { unsigned vo_[2]; vo_[0] = (NEXTSEL) ? gAn[H][0] : gAc[H][0]; vo_[1] = (NEXTSEL) ? gAn[H][1] : gAc[H][1]; \
        PG8_STAGE(bufoff, (const char*)g.A + (KOFF), vo_); } else { PG8_STAGE(bufoff, orig_gbase, voffA); } } while (0)
    const size_t kstep = (size_t)(BK * 2);
    const size_t hstep = (size_t)HALF * K * 2;
    const size_t tstep = 2 * hstep;
    const unsigned ldsw = (unsigned)wid * 1024u;
    const int aoff = lds_byte(wr * 64 + fr, fq * 8), boff = lds_byte(wc * 32 + fr, fq * 8);
#define PG8_SA(b, h) (((b) * 2 + (h)) * HTB)
#define PG8_SB(b, h) ((4 + (b) * 2 + (h)) * HTB)
#define PG8_STAGE(bufoff, gbase, voff) do { _Pragma("unroll") for (int _i = 0; _i < 2; ++_i) \
        __builtin_amdgcn_global_load_lds((const unsigned*)((const char*)(gbase) + (voff)[_i]), (PG8_LAS unsigned*)(lds + (bufoff) + ldsw + _i * 8192), 16, 0, 0); } while (0)
#define PG8_LD32(var, addr) do { const bf16x8 lo_ = *(const PG8_LAS bf16x8*)(addr); const bf16x8 hi_ = *(const PG8_LAS bf16x8*)((addr) + 1024); var = cat32(lo_, hi_); } while (0)
#define PG8_LDA(dst, b, h) do { if constexpr (FP8) { _Pragma("unroll") for (int m = 0; m < 4; ++m) PG8_LD32(dst##8[m], lds + PG8_SA(b, h) + aoff + m * 2048); } \
        else { _Pragma("unroll") for (int m = 0; m < 4; ++m) _Pragma("unroll") for (int k = 0; k < 2; ++k) dst[m][k] = *(const PG8_LAS bf16x8*)(lds + PG8_SA(b, h) + aoff + m * 2048 + k * 1024); } } while (0)
#define PG8_LDB(dst, b, h) do { if constexpr (FP8) { _Pragma("unroll") for (int n = 0; n < 2; ++n) PG8_LD32(dst##8[n], lds + PG8_SB(b, h) + boff + n * 2048); } \
        else { _Pragma("unroll") for (int n = 0; n < 2; ++n) _Pragma("unroll") for (int k = 0; k < 2; ++k) dst[n][k] = *(const PG8_LAS bf16x8*)(lds + PG8_SB(b, h) + boff + n * 2048 + k * 1024); } } while (0)
#define PG8_MMA(ai, bj, At, Bt) do { __builtin_amdgcn_s_setprio(1); \
        if constexpr (FP8) { _Pragma("unroll") for (int m = 0; m < 4; ++m) _Pragma("unroll") for (int n = 0; n < 2; ++n) \
            asm volatile("v_mfma_scale_f32_16x16x128_f8f6f4 %0, %1, %2, %0, %3, %3 op_sel_hi:[0,0,0]" : "+v"(acc[ai][bj][m][n]) : "v"(Bt##8[n]), "v"(At##8[m]), "v"(sc127)); } \
        else { _Pragma("unroll") for (int m = 0; m < 4; ++m) _Pragma("unroll") for (int n = 0; n < 2; ++n) _Pragma("unroll") for (int k = 0; k < 2; ++k) \
            acc[ai][bj][m][n] = __builtin_amdgcn_mfma_f32_16x16x32_bf16(Bt[n][k], At[m][k], acc[ai][bj][m][n], 0, 0, 0); } \
        __builtin_amdgcn_s_setprio(0); } while (0)
#define PG8_WAIT_V(n) asm volatile("s_waitcnt vmcnt(" #n ")" ::: "memory")
#define PG8_WAIT_L(n) asm volatile("s_waitcnt lgkmcnt(" #n ")" ::: "memory")
#define PG8_BAR __builtin_amdgcn_s_barrier()
#define PG8_SCHED __builtin_amdgcn_sched_barrier(0)
    Unit cur, nxt; int ui = 0;
    if (!S.next(0, cur)) return;
    f32x4 acc[2][2][4][2];
#pragma unroll
    for (int a = 0; a < 2; ++a)
#pragma unroll
        for (int b = 0; b < 2; ++b)
#pragma unroll
            for (int m = 0; m < 4; ++m)
#pragma unroll
                for (int n = 0; n < 2; ++n) acc[a][b][m][n] = (f32x4){0.f, 0.f, 0.f, 0.f};
    int sc127 = 0x7f7f7f7f; asm volatile("" : "+v"(sc127));
    bf16x8 At[4][2], B0[2][2], B1[2][2]; v8i_t At8[4], B08[2], B18[2]; (void)At; (void)B0; (void)B1; (void)At8; (void)B08; (void)B18;
    const char* cA = (const char*)g.A + (size_t)cur.pm * tstep; const char* cB = (const char*)g.Bt + (size_t)cur.pn * tstep;
    S.a_ready(cur);
    if constexpr (GATHER) { PG8_GATHER(cur, gAc); }
    if constexpr (Epi::PREFETCH) E.prefetch(cur, 0, wid, lane);
    if constexpr (SP2) {
        PG8_STAGE(PG8_SB(0, 0), cB, voffB); PG8_STAGE(PG8_SB(0, 1), cB + hstep, voffB); PG8_STAGE_A(PG8_SA(0, 0), cA, false, 0, (size_t)0); PG8_STAGE_A(PG8_SA(0, 1), cA + hstep, false, 1, (size_t)0);
        if (wr == 1) PG8_BAR;
        PG8_WAIT_V(2); PG8_BAR;
        PG8_STAGE(PG8_SB(1, 0), cB + kstep, voffB); PG8_STAGE_A(PG8_SA(1, 0), cA + kstep, false, 0, kstep); PG8_STAGE(PG8_SB(1, 1), cB + hstep + kstep, voffB);
        PG8_WAIT_V(6); PG8_BAR;
    } else {
        PG8_STAGE(PG8_SB(0, 0), cB, voffB); PG8_STAGE(PG8_SA(0, 0), cA, voffA); PG8_STAGE(PG8_SB(0, 1), cB + hstep, voffB); PG8_STAGE(PG8_SA(0, 1), cA + hstep, voffA);
        if (wr == 1) PG8_BAR;
        PG8_WAIT_V(4); PG8_BAR;
        PG8_STAGE(PG8_SB(1, 0), cB + kstep, voffB); PG8_STAGE(PG8_SA(1, 0), cA + kstep, voffA); PG8_STAGE(PG8_SB(1, 1), cB + hstep + kstep, voffB);
        PG8_WAIT_V(6); PG8_BAR;
    }
    for (;;) {
        const bool has_next = S.next(ui + 1, nxt);
        if constexpr (GATHER) { if (has_next) { PG8_GATHER(nxt, gAn); } else { _Pragma("unroll") for (int h_ = 0; h_ < 2; ++h_) _Pragma("unroll") for (int i_ = 0; i_ < 2; ++i_) gAn[h_][i_] = gAc[h_][i_]; } }
        const char* nA = has_next ? (const char*)g.A + (size_t)nxt.pm * tstep : cA; const char* nB = has_next ? (const char*)g.Bt + (size_t)nxt.pn * tstep : cB;
#pragma nounroll
        for (int t = 0; t < nt; t += 2) {
            const bool last = (t == nt - 2);
            const char* a1 = cA + (size_t)PG8_KT(t + 1) * kstep;
            const char* a2 = last ? nA : cA + (size_t)PG8_KT(t + 2) * kstep; const char* b2 = last ? nB : cB + (size_t)PG8_KT(t + 2) * kstep;
            const char* a3 = a2 + kstep; const char* b3 = b2 + kstep;
            const size_t k1 = (size_t)PG8_KT(t + 1) * kstep, k2 = last ? (size_t)0 : (size_t)PG8_KT(t + 2) * kstep, k3 = k2 + kstep; (void)k1; (void)k2; (void)k3;
            if (last && has_next) S.a_ready(nxt);
            if constexpr (SP2) {
            PG8_LDB(B0, 0, 0); PG8_LDB(B1, 0, 1); PG8_SCHED; PG8_LDA(At, 0, 0); PG8_STAGE_A(PG8_SA(1, 1), a1 + hstep, false, 1, k1);
            PG8_WAIT_V(8); PG8_WAIT_L(0); PG8_BAR; PG8_MMA(0, 0, At, B0); PG8_MMA(0, 1, At, B1); PG8_BAR; PG8_SCHED;
            PG8_LDA(At, 0, 1); PG8_STAGE(PG8_SB(0, 0), b2, voffB); PG8_STAGE(PG8_SB(0, 1), b2 + hstep, voffB); PG8_STAGE_A(PG8_SA(0, 0), a2, last, 0, k2);
            PG8_WAIT_V(8); PG8_WAIT_L(0); PG8_BAR; PG8_MMA(1, 0, At, B0); PG8_MMA(1, 1, At, B1); PG8_BAR; PG8_SCHED;
            PG8_LDB(B0, 1, 0); PG8_LDB(B1, 1, 1); PG8_SCHED; PG8_LDA(At, 1, 0); PG8_STAGE_A(PG8_SA(0, 1), a2 + hstep, last, 1, k2);
            PG8_WAIT_V(8); PG8_WAIT_L(0); PG8_BAR; PG8_MMA(0, 0, At, B0); PG8_MMA(0, 1, At, B1); PG8_BAR; PG8_SCHED;
            PG8_LDA(At, 1, 1); PG8_STAGE(PG8_SB(1, 0), b3, voffB); PG8_STAGE(PG8_SB(1, 1), b3 + hstep, voffB); PG8_STAGE_A(PG8_SA(1, 0), a3, last, 0, k3);
            PG8_WAIT_V(8); PG8_WAIT_L(0); PG8_BAR; PG8_MMA(1, 0, At, B0); PG8_MMA(1, 1, At, B1); PG8_BAR; PG8_SCHED;
            } else {
            PG8_LDB(B0, 0, 0); PG8_SCHED; PG8_LDA(At, 0, 0); PG8_STAGE(PG8_SA(1, 1), a1 + hstep, voffA);
            PG8_WAIT_L(8); PG8_BAR; PG8_WAIT_L(0); PG8_MMA(0, 0, At, B0); PG8_BAR; PG8_SCHED;
            PG8_LDB(B1, 0, 1); PG8_STAGE(PG8_SB(0, 0), b2, voffB);
            PG8_BAR; PG8_WAIT_L(0); PG8_MMA(0, 1, At, B1); PG8_BAR;
            PG8_LDA(At, 0, 1); PG8_STAGE(PG8_SA(0, 0), a2, voffA);
            PG8_BAR; PG8_WAIT_L(0); PG8_MMA(1, 0, At, B0); PG8_BAR; PG8_SCHED;
            PG8_STAGE(PG8_SB(0, 1), b2 + hstep, voffB);
            PG8_WAIT_V(6); PG8_BAR; PG8_MMA(1, 1, At, B1); PG8_BAR;
            PG8_LDB(B0, 1, 0); PG8_SCHED; PG8_LDA(At, 1, 0); PG8_STAGE(PG8_SA(0, 1), a2 + hstep, voffA);
            PG8_WAIT_L(8); PG8_BAR; PG8_WAIT_L(0); PG8_MMA(0, 0, At, B0); PG8_BAR; PG8_SCHED;
            PG8_LDB(B1, 1, 1); PG8_STAGE(PG8_SB(1, 0), b3, voffB);
            PG8_BAR; PG8_WAIT_L(0); PG8_MMA(0, 1, At, B1); PG8_BAR;
            PG8_LDA(At, 1, 1); PG8_STAGE(PG8_SA(1, 0), a3, voffA);
            PG8_BAR; PG8_WAIT_L(0); PG8_MMA(1, 0, At, B0); PG8_BAR; PG8_SCHED;
            PG8_STAGE(PG8_SB(1, 1), b3 + hstep, voffB);
            PG8_WAIT_V(6); PG8_BAR; PG8_MMA(1, 1, At, B1); PG8_BAR;
            }
        }
        if constexpr (ALIGN_EPI) { if (wr == 0) PG8_BAR; }
        if constexpr (FP8) { asm volatile("s_nop 15\n\ts_nop 15" ::: "memory"); }
        if constexpr (!Epi::AFTER_DRAIN) { if constexpr (Epi::PREFETCH) E(acc, cur, wr, wc, fr, fq, ui & 1); else E(acc, cur, wr, wc, fr, fq);
#if defined(PROBE_EPI2)
            if constexpr (FP8 == (PROBE_EPI2 == 1)) { if constexpr (Epi::PREFETCH) E(acc, cur, wr, wc, fr, fq, ui & 1); else E(acc, cur, wr, wc, fr, fq); }
#endif
            S.done(cur); }
        if (!has_next) break;
#pragma unroll
        for (int a = 0; a < 2; ++a)
#pragma unroll
            for (int b = 0; b < 2; ++b)
#pragma unroll
                for (int m = 0; m < 4; ++m)
#pragma unroll
                    for (int n = 0; n < 2; ++n) acc[a][b][m][n] = (f32x4){0.f, 0.f, 0.f, 0.f};
        cur = nxt; cA = nA; cB = nB; ++ui;
        if constexpr (Epi::PREFETCH) E.prefetch(cur, ui & 1, wid, lane);
        if constexpr (GATHER) { _Pragma("unroll") for (int h_ = 0; h_ < 2; ++h_) _Pragma("unroll") for (int i_ = 0; i_ < 2; ++i_) gAc[h_][i_] = gAn[h_][i_]; }
        if constexpr (ALIGN_EPI) { if (wr == 1) PG8_BAR; }
    }
    PG8_WAIT_V(0);
    if constexpr (!ALIGN_EPI) { if (wr == 0) PG8_BAR; }
    PG8_BAR;
    if constexpr (Epi::AFTER_DRAIN) { E.fused(acc, cur, wr, wc, fr, fq, lds, wid, lane); S.done(cur); }
#undef PG8_SA
#undef PG8_SB
#undef PG8_STAGE
#undef PG8_STAGE_A
#undef PG8_GATHER
#undef PG8_LDA
#undef PG8_LD32
#undef PG8_LDB
#undef PG8_MMA
#undef PG8_WAIT_V
#undef PG8_WAIT_L
#undef PG8_BAR
#undef PG8_SCHED
}
}

#ifndef PG8_SP2
#define PG8_SP2 true
#endif
#ifndef PG8_ALIGN
#define PG8_ALIGN true
#endif

#define GAS __attribute__((address_space(1)))
#define LAS __attribute__((address_space(3)))
typedef unsigned short bf16;
typedef unsigned v4u __attribute__((ext_vector_type(4)));
typedef unsigned v2u __attribute__((ext_vector_type(2)));
typedef float f32x4 __attribute__((ext_vector_type(4)));
typedef short bf16x8 __attribute__((ext_vector_type(8)));

constexpr int D = 1024, NB = 8, SEQ = 4096, CTXL = 256, TPB = SEQ + CTXL, NTOK = NB * TPB, NLAT = NB * SEQ;
constexpr int ZC = 3328;
constexpr int ZQ = 0, ZKV = 384, ZKR = 640, ZHQ = 672, ZHF = 1184, ZHB = 1696, ZHI = 2208, ZHG = 2720;
constexpr int NEXP = 32;
constexpr float ALPHA = 1.4142135623730951f;
constexpr float LN_EPS = 1e-5f, RMS_EPS = 1e-6f;
constexpr int NWAVES = 8, NTHR = 512;
constexpr float SC_X8 = 16.f, SC_WGU = 64.f, SC_ACT = 8.f, SC_WDN = 128.f, SC_Y = 64.f, SC_A1 = 16.f, SC_WPW = 64.f, SC_CV = 16.f, SC_A0 = 16.f, SC_WIN = 64.f;
constexpr int LDS_BYTES = 163840;
constexpr int LDS_BAR_OFF = LDS_BYTES - 64;
constexpr int LDS_TILE_E = 131072;
constexpr int MAXTILES = 576;
constexpr int LDS_SIDE = 155648, SIDE_BYTES = 3072;
static_assert(LDS_SIDE + 2 * SIDE_BYTES <= LDS_BYTES - 64, "lds side");
constexpr int LDS_EPI_B = 139264;
static_assert(LDS_TILE_E + (3 * MAXTILES + 96) * 4 <= LDS_EPI_B && LDS_EPI_B + 16384 <= LDS_BYTES - 64, "lds map");

constexpr size_t MiB = 1u << 20;
constexpr size_t WS_CTL = 0, CTL_ZERO_BYTES = 16384;
constexpr size_t WS_MODV = 1 * MiB;
constexpr size_t WS_ROPE = 1 * MiB + 512 * 1024;
constexpr size_t WS_BGU = 2 * MiB;
constexpr size_t WS_PW1B = 2 * MiB + 512 * 1024;
constexpr size_t WS_BCNT = WS_PW1B + 64 * 1024;
constexpr size_t WS_TILEE = WS_BCNT + 64 * 1024;
constexpr size_t WS_META = WS_TILEE + 4096;
constexpr size_t WS_TOPI = 3 * MiB, WS_TOPW = 4 * MiB;
constexpr int ECAP = 32768;
constexpr size_t WS_ROWS = 160 * MiB, WS_ROWW = 164 * MiB, WS_ROWD = 168 * MiB;
constexpr size_t WS_CURSOR = 14336;
constexpr size_t WS_WIN = 8 * MiB, WS_WUQ = 15 * MiB, WS_WUKV = 16 * MiB, WS_WOUT = 17 * MiB, WS_WPW1 = 19 * MiB, WS_WPW2 = 23 * MiB;
constexpr size_t WS_WGU = 32 * MiB, WS_WDN = 288 * MiB;
constexpr size_t WS_H = 416 * MiB;
constexpr size_t WS_X = 552 * MiB, WS_Y = 620 * MiB;
constexpr size_t WS_BIG = 688 * MiB;
constexpr size_t WS_Z = WS_BIG, WS_CQN = WS_BIG + 221 * MiB, WS_CKVN = WS_BIG + 247 * MiB, WS_KRR = WS_BIG + 264 * MiB,
                 WS_Q = WS_BIG + 267 * MiB, WS_KV = WS_BIG + 318 * MiB, WS_OF = WS_BIG + 386 * MiB, WS_OB = WS_BIG + 454 * MiB;
constexpr size_t WS_HT = WS_BIG + 528 * MiB;
constexpr size_t WS_PRE = WS_BIG;
constexpr size_t WS_XS = WS_BIG, WS_ACT = WS_BIG + 288 * MiB, WS_YB = WS_BIG + 576 * MiB;
constexpr size_t WS_END = WS_BIG + 848 * MiB;
static_assert((size_t)NTOK * ZC * 2 <= 221 * MiB && (size_t)NTOK * 384 * 2 <= 26 * MiB && (size_t)NTOK * 256 * 2 <= 17 * MiB && (size_t)NTOK * 32 * 2 <= 3 * MiB, "ws map 1");
static_assert((size_t)NTOK * 768 * 2 <= 51 * MiB && (size_t)NTOK * 1024 * 2 <= 68 * MiB && (size_t)NTOK * 512 * 4 <= 68 * MiB, "ws map 2");
static_assert((size_t)64 * 136 * 26624 <= 320 * MiB && (size_t)MAXTILES * 256 * 2048 <= 288 * MiB && (size_t)NLAT * 4 * 2048 <= 272 * MiB && (size_t)NTOK * 1024 * 4 <= 136 * MiB, "ws map 3");

#define LDS_WAIT() asm volatile("s_waitcnt lgkmcnt(0)" ::: "memory")
#define VM_WAIT() asm volatile("s_waitcnt vmcnt(0)" ::: "memory")
__device__ __forceinline__ float bf2f(unsigned short b) { return __uint_as_float(((unsigned)b) << 16); }
__device__ __forceinline__ unsigned pk2(float lo, float hi) { return pg8::cvt_pk_bf16(lo, hi); }
__device__ __forceinline__ float sigm(float x) { return __builtin_amdgcn_rcpf(1.f + __expf(-x)); }
__device__ __forceinline__ float wave_sum(float v) {
#pragma unroll
    for (int o = 1; o < 64; o <<= 1) v += __shfl_xor(v, o);
    return v;
}
__device__ __forceinline__ int ld_ctl(const int* p) { return (int)__hip_atomic_load((const unsigned*)p, __ATOMIC_RELAXED, __HIP_MEMORY_SCOPE_AGENT); }
__device__ __forceinline__ int grow_of(int lr) { return (lr >> 12) * TPB + CTXL + (lr & 4095); }

#define XB_TMO      128
#define XB_XCNT(j)  (256  + 64 * (j))
#define XB_XSUB(j)  (1280 + 64 * (j))
#define XB_XGEN(j)  (2304 + 64 * (j))
#define XB_TOP      3328
#define XB_TOPGEN   3392
#define XCD_BAR_WORDS 3456
#define XB_SPIN_CAP (1u << 21)

__device__ __forceinline__ unsigned xb_ld(unsigned* p)              { return __hip_atomic_load(p, __ATOMIC_RELAXED, __HIP_MEMORY_SCOPE_AGENT); }
__device__ __forceinline__ unsigned xb_add(unsigned* p, unsigned v) { return __hip_atomic_fetch_add(p, v, __ATOMIC_RELAXED, __HIP_MEMORY_SCOPE_AGENT); }
__device__ __forceinline__ unsigned xb_xcc_id() { return (unsigned)__builtin_amdgcn_s_getreg((3 << 11) | 20) & 0xFu; }
#define XB_SPIN(cond, bar) do { unsigned _sp = 0; while (cond) { __builtin_amdgcn_s_sleep(1); \
    if ((++_sp & 255u) == 0u) { if (xb_ld(&(bar)[XB_TMO])) break; if (_sp > XB_SPIN_CAP) { atomicAdd(&(bar)[XB_TMO], 1u); break; } } } } while (0)

struct XcdBarrier { unsigned* bar; unsigned x; volatile LAS unsigned* st; };

__device__ __forceinline__ XcdBarrier xcd_barrier_post(unsigned* bar, volatile LAS unsigned* st) {
    XcdBarrier b; b.bar = bar; b.x = xb_xcc_id(); b.st = st;
    if (threadIdx.x == 0) (void)xb_add(&bar[XB_XCNT(b.x)], 1u);
    return b;
}
__device__ __forceinline__ void xcd_barrier_complete(unsigned* bar, unsigned x, unsigned& nloc, unsigned& nx) {
    const unsigned G = gridDim.x * gridDim.y * gridDim.z;
    unsigned sum, cnt, mine, sp = 0u;
    for (;;) {
        sum = 0u; cnt = 0u; mine = 0u;
#pragma unroll
        for (unsigned j = 0; j < 16; ++j) { const unsigned c = xb_ld(&bar[XB_XCNT(j)]); sum += c; cnt += (c > 0u) ? 1u : 0u; mine = (j == x) ? c : mine; }
        if (sum == G) break;
        __builtin_amdgcn_s_sleep(1);
        if ((++sp & 255u) == 0u) { if (xb_ld(&bar[XB_TMO])) break; if (sp > XB_SPIN_CAP) { atomicAdd(&bar[XB_TMO], 1u); break; } }
    }
    nloc = mine > 0u ? mine : 1u; nx = cnt > 0u ? cnt : 1u;
}
__device__ __forceinline__ void xcd_barrier(const XcdBarrier& b) {
    asm volatile("s_waitcnt vmcnt(0)" ::: "memory");
    __syncthreads();
    if (threadIdx.x == 0) {
        unsigned* bar = b.bar;
        __builtin_amdgcn_s_waitcnt(0);
        unsigned nloc = b.st[0], nx = b.st[1];
        if (nloc == 0u) { xcd_barrier_complete(bar, b.x, nloc, nx); b.st[0] = nloc; b.st[1] = nx; }
        const unsigned old = xb_add(&bar[XB_XSUB(b.x)], 1u);
        const unsigned gen = old / nloc;
        if (old + 1u == (gen + 1u) * nloc) {
            __builtin_amdgcn_fence(__ATOMIC_RELEASE, "agent");
            asm volatile("s_waitcnt vmcnt(0)" ::: "memory");
            const unsigned og = xb_add(&bar[XB_TOP], 1u);
            const unsigned tg = og / nx;
            if (og + 1u == (tg + 1u) * nx) xb_add(&bar[XB_TOPGEN], 1u);
            else XB_SPIN(xb_ld(&bar[XB_TOPGEN]) == tg, bar);
            __builtin_amdgcn_fence(__ATOMIC_ACQUIRE, "agent");
            xb_add(&bar[XB_XGEN(b.x)], 1u);
            asm volatile("s_waitcnt vmcnt(0)" ::: "memory");
        } else {
            XB_SPIN(xb_ld(&bar[XB_XGEN(b.x)]) == gen, bar);
            __builtin_amdgcn_fence(__ATOMIC_ACQUIRE, "agent");
            asm volatile("s_waitcnt vmcnt(0)" ::: "memory");
        }
    }
    __syncthreads();
}

namespace pg8 {
struct TileOrder {
    int nM, nN, nwg, G, c;
    __device__ __forceinline__ void init(int nM_, int nN_, int G_, int c_) { nM = nM_; nN = nN_; nwg = nM * nN; G = G_; c = c_; }
    __device__ __forceinline__ bool logical(int i, int& im, int& in) const {
        const long L = (long)i * G + c; if (L >= nwg) return false;
        int wgid = (int)L; { const int q = nwg / NXCD, r = nwg % NXCD, xcd = wgid % NXCD, off = wgid / NXCD; wgid = (xcd < r ? xcd * (q + 1) : r * (q + 1) + (xcd - r) * q) + off; }
        const int nig = WGM * nN, gid = wgid / nig, fm = gid * WGM, gsz = (nM - fm) < WGM ? (nM - fm) : WGM;
        im = fm + ((wgid % nig) % gsz); in = (wgid % nig) / gsz; return true;
    }
    __device__ __forceinline__ void a_ready(const Unit&) const {}
    __device__ __forceinline__ void done(const Unit&) const {}
};
struct AllOrder : TileOrder { __device__ __forceinline__ bool next(int i, Unit& u) const { int im, in; if (!logical(i, im, in)) return false; u.pm = im; u.pn = in; return true; } };
struct LatOrder : TileOrder {
    __device__ __forceinline__ bool next(int i, Unit& u) const { int im, in; if (!logical(i, im, in)) return false; u.pm = (im >> 4) * 17 + 1 + (im & 15); u.pn = in; return true; } };
struct MoeOrder : TileOrder {
    const PG8_LAS int* tile_e; int nper;
    __device__ __forceinline__ bool next(int i, Unit& u) const { int im, in; if (!logical(i, im, in)) return false; u.pm = im; u.pn = tile_e[im] * nper + in; return true; } };

template <bool HB16> struct EpiRes {
    static constexpr bool PERM = true, AFTER_DRAIN = false, PREFETCH = false;
    const float* xin; const bf16_t* h; bf16_t* pre; const float* modv; const float* bias; float ascale;
    __device__ __forceinline__ void operator()(const f32x4 (&acc)[2][2][4][2], const Unit& u, int wr, int wc, int fr, int fq) const {
        asm volatile("" : "+v"(fr), "+v"(fq));
        const int b = u.pm / 17, j = u.pm % 17;
        const int rl0 = wr * 64 + fr, col0 = u.pn * BM + wc * 32 + 8 * fq;
        const float* gate = modv + (size_t)b * 6144 + 2048;
        f32x4 gv[2][2], bv[2][2];
#pragma unroll
        for (int bj = 0; bj < 2; ++bj)
#pragma unroll
            for (int n = 0; n < 2; ++n) { gv[bj][n] = *(const f32x4*)(gate + col0 + bj * HALF + 4 * n); bv[bj][n] = bias ? *(const f32x4*)(bias + col0 + bj * HALF + 4 * n) : (f32x4){0.f, 0.f, 0.f, 0.f}; }
        if constexpr (HB16) {
#pragma unroll
        for (int ai = 0; ai < 2; ++ai) {
            u32x4 hb[4][2];
#pragma unroll
            for (int m = 0; m < 4; ++m) { const int rl = rl0 + ai * HALF + m * 16; const size_t grow = (size_t)u.pm * BM + rl; const bf16_t* hin = h + grow * 1024 + col0;
#pragma unroll
                for (int bj = 0; bj < 2; ++bj) hb[m][bj] = *(const u32x4*)(hin + bj * HALF); }
            asm volatile("" ::: "memory");
#pragma unroll
            for (int m = 0; m < 4; ++m) { const int rl = rl0 + ai * HALF + m * 16; const size_t grow = (size_t)u.pm * BM + rl; bf16_t* po = pre + grow * 1024 + col0;
#pragma unroll
                for (int bj = 0; bj < 2; ++bj) { const u32x4 q = hb[m][bj];
                    const f32x4 h0 = {__builtin_bit_cast(float, q.x << 16), __builtin_bit_cast(float, q.x & 0xffff0000u), __builtin_bit_cast(float, q.y << 16), __builtin_bit_cast(float, q.y & 0xffff0000u)};
                    const f32x4 h1 = {__builtin_bit_cast(float, q.z << 16), __builtin_bit_cast(float, q.z & 0xffff0000u), __builtin_bit_cast(float, q.w << 16), __builtin_bit_cast(float, q.w & 0xffff0000u)};
                    const f32x4 v0 = h0 * 1.4142135623730951f + gv[bj][0] * (acc[ai][bj][m][0] * ascale + bv[bj][0]), v1 = h1 * 1.4142135623730951f + gv[bj][1] * (acc[ai][bj][m][1] * ascale + bv[bj][1]);
                    u32x4 w; w.x = cvt_pk_bf16(v0[0], v0[1]); w.y = cvt_pk_bf16(v0[2], v0[3]); w.z = cvt_pk_bf16(v1[0], v1[1]); w.w = cvt_pk_bf16(v1[2], v1[3]);
                    *(u32x4*)(po + bj * HALF) = w; } }
            asm volatile("" ::: "memory"); }
        } else {
#pragma unroll
        for (int aim = 0; aim < 4; ++aim) { const int ai = aim >> 1, m0 = (aim & 1) * 2;
            f32x4 hv[2][2][2];
#pragma unroll
            for (int mm = 0; mm < 2; ++mm) { const int rl = rl0 + ai * HALF + (m0 + mm) * 16; const size_t grow = (size_t)u.pm * BM + rl;
                const float* hin = xin + ((size_t)b * 4096 + (size_t)(j - 1) * 256 + rl) * 1024 + col0; (void)grow;
#pragma unroll
                for (int bj = 0; bj < 2; ++bj) { hv[mm][bj][0] = *(const f32x4*)(hin + bj * HALF); hv[mm][bj][1] = *(const f32x4*)(hin + bj * HALF + 4); } }
            asm volatile("" ::: "memory");
#pragma unroll
            for (int mm = 0; mm < 2; ++mm) { const int m = m0 + mm; const int rl = rl0 + ai * HALF + m * 16; const size_t grow = (size_t)u.pm * BM + rl; bf16_t* po = pre + grow * 1024 + col0;
#pragma unroll
                for (int bj = 0; bj < 2; ++bj) {
                    const f32x4 v0 = hv[mm][bj][0] * 1.4142135623730951f + gv[bj][0] * (acc[ai][bj][m][0] * ascale + bv[bj][0]), v1 = hv[mm][bj][1] * 1.4142135623730951f + gv[bj][1] * (acc[ai][bj][m][1] * ascale + bv[bj][1]);
                    u32x4 w; w.x = cvt_pk_bf16(v0[0], v0[1]); w.y = cvt_pk_bf16(v0[2], v0[3]); w.z = cvt_pk_bf16(v1[0], v1[1]); w.w = cvt_pk_bf16(v1[2], v1[3]);
                    *(u32x4*)(po + bj * HALF) = w; } }
            asm volatile("" ::: "memory"); }
        }
    }
};
#define PG8_DMA4(gptr, ldsptr) __builtin_amdgcn_global_load_lds((const unsigned*)(gptr), (PG8_LAS unsigned*)(ldsptr), 4, 0, 0)
template <int MODE, bool OUT8 = false> struct EpiGate {
    static constexpr bool PERM = true, AFTER_DRAIN = false, PREFETCH = true;
    bf16_t* O; const float* bias; int nper; float ascale, oscale; PG8_LAS unsigned char* lds;
    __device__ __forceinline__ void prefetch(const Unit& u, int par, int wid, int lane) const { if (wid < 4) PG8_DMA4(bias + u.pn * BM + 64 * wid + lane, lds + LDS_SIDE + par * SIDE_BYTES + wid * 256); }
    __device__ __forceinline__ void operator()(const f32x4 (&acc)[2][2][4][2], const Unit& u, int wr, int wc, int fr, int fq, int par) const {
        asm volatile("" : "+v"(fr), "+v"(fq));
        const int row0 = u.pm * BM + wr * 64 + fr, pnl = u.pn % nper, ocol0 = pnl * HALF + wc * 32 + 8 * fq, bcol0 = u.pn * BM + wc * 32 + 8 * fq;
        const float s0 = ascale, s1 = MODE == 1 ? ascale * oscale : ascale;
        f32x4 bv[2][2];
#pragma unroll
        for (int n = 0; n < 2; ++n) { const PG8_LAS float* bl = (const PG8_LAS float*)(lds + LDS_SIDE + par * SIDE_BYTES) + wc * 32 + 8 * fq + 4 * n; bv[0][n] = *(const PG8_LAS f32x4*)bl; const f32x4 t = *(const PG8_LAS f32x4*)(bl + HALF); bv[1][n] = MODE == 1 ? (t + 1.0f) * oscale : t; }
        (void)bcol0;
#pragma unroll
        for (int ai = 0; ai < 2; ++ai)
#pragma unroll
            for (int m = 0; m < 4; ++m) { bf16_t* rowp = O + (size_t)(row0 + ai * HALF + m * 16) * 1024 + ocol0;
                unsigned char* rowp8 = (unsigned char*)O + (size_t)(row0 + ai * HALF + m * 16) * 1024 + ocol0;
                float o[8];
#pragma unroll
                for (int n = 0; n < 2; ++n) { const f32x4 a = acc[ai][0][m][n] * s0 + bv[0][n], g = acc[ai][1][m][n] * s1 + bv[1][n];
#pragma unroll
                    for (int e = 0; e < 4; ++e) {
                        if (MODE == 0) { o[4 * n + e] = a[e] * __builtin_amdgcn_rcpf(1.f + __builtin_amdgcn_exp2f(g[e] * -1.4426950408889634f)); }
                        else { const float gt = fminf(a[e], 7.0f), up1 = __builtin_amdgcn_fmed3f(g[e], -6.0f * oscale, 8.0f * oscale);
                            o[4 * n + e] = up1 * (gt * __builtin_amdgcn_rcpf(1.f + __builtin_amdgcn_exp2f(gt * (-1.702f * 1.4426950408889634f)))); } } }
                if constexpr (OUT8) {
                    int w0 = 0, w1 = 0; w0 = __builtin_amdgcn_cvt_pk_fp8_f32(o[0], o[1], w0, false); w0 = __builtin_amdgcn_cvt_pk_fp8_f32(o[2], o[3], w0, true);
                    w1 = __builtin_amdgcn_cvt_pk_fp8_f32(o[4], o[5], w1, false); w1 = __builtin_amdgcn_cvt_pk_fp8_f32(o[6], o[7], w1, true);
                    typedef unsigned u32x2 __attribute__((ext_vector_type(2))); *(u32x2*)rowp8 = (u32x2){(unsigned)w0, (unsigned)w1}; (void)rowp;
                } else { (void)rowp8;
                u32x4 w; w.x = cvt_pk_bf16(o[0], o[1]); w.y = cvt_pk_bf16(o[2], o[3]); w.z = cvt_pk_bf16(o[4], o[5]); w.w = cvt_pk_bf16(o[6], o[7]);
                *(u32x4*)rowp = w; } }
    }
};
struct EpiDown {
    static constexpr bool PERM = true, AFTER_DRAIN = false, PREFETCH = true;
    bf16_t* Y; const float* bias; const float* row_w; const int* row_dst; float ascale; const PG8_LAS int* gtab; float oscale; PG8_LAS unsigned char* lds;
    __device__ __forceinline__ void prefetch(const Unit& u, int par, int wid, int lane) const { PG8_LAS unsigned char* sd = lds + LDS_SIDE + par * SIDE_BYTES; const int tbase = gtab[u.pm];
        if (wid < 4) { PG8_DMA4(bias + u.pn * BM + 64 * wid + lane, sd + wid * 256); PG8_DMA4(row_w + tbase + 64 * wid + lane, sd + 1024 + wid * 256); } else PG8_DMA4(row_dst + tbase + 64 * (wid - 4) + lane, sd + 2048 + (wid - 4) * 256); }
    __device__ __forceinline__ void operator()(const f32x4 (&acc)[2][2][4][2], const Unit& u, int wr, int wc, int fr, int fq, int par) const {
        asm volatile("" : "+v"(fr), "+v"(fq));
        const int tid = (wr * 4 + wc) * 64 + fq * 16 + fr;
        const PG8_LAS unsigned char* sd = lds + LDS_SIDE + par * SIDE_BYTES;
        const int pnl = u.pn & 3; const int tcnt = gtab[576 + u.pm];
        f32x4 bv[2][2];
#pragma unroll
        for (int bj = 0; bj < 2; ++bj)
#pragma unroll
            for (int n = 0; n < 2; ++n) bv[bj][n] = *(const PG8_LAS f32x4*)(sd + (wc * 32 + 8 * fq + bj * HALF + 4 * n) * 4);
        float wv[2][4]; int dstv[2][2];
#pragma unroll
        for (int ai = 0; ai < 2; ++ai) {
#pragma unroll
            for (int m = 0; m < 4; ++m) { const int rl = wr * 64 + fr + ai * HALF + m * 16; wv[ai][m] = *(const PG8_LAS float*)(sd + 1024 + rl * 4); }
#pragma unroll
            for (int k = 0; k < 2; ++k) { const int rl = ai * HALF + (tid >> 3) + 64 * k; dstv[ai][k] = *(const PG8_LAS int*)(sd + 2048 + rl * 4); } }
        PG8_LAS unsigned char* const reg0 = lds + 3 * HTB; PG8_LAS unsigned char* const reg1 = lds + LDS_EPI_B;
        const int wbase = (wr * 64 + fr) * 128 + (((wc * 4 + fq) ^ fr) * 8);
        const int rrow = tid >> 3, rch = tid & 7;
        typedef unsigned u32x2 __attribute__((ext_vector_type(2)));
#pragma unroll
        for (int ai = 0; ai < 2; ++ai) {
#pragma unroll
            for (int m = 0; m < 4; ++m) { const float w8 = wv[ai][m] * oscale;
#pragma unroll
                for (int bj = 0; bj < 2; ++bj) { const f32x4 v0 = (acc[ai][bj][m][0] * ascale + bv[bj][0]) * w8, v1 = (acc[ai][bj][m][1] * ascale + bv[bj][1]) * w8;
                    int w0 = 0, w1 = 0; w0 = __builtin_amdgcn_cvt_pk_fp8_f32(__builtin_amdgcn_fmed3f(v0[0], -448.f, 448.f), __builtin_amdgcn_fmed3f(v0[1], -448.f, 448.f), w0, false); w0 = __builtin_amdgcn_cvt_pk_fp8_f32(__builtin_amdgcn_fmed3f(v0[2], -448.f, 448.f), __builtin_amdgcn_fmed3f(v0[3], -448.f, 448.f), w0, true);
                    w1 = __builtin_amdgcn_cvt_pk_fp8_f32(__builtin_amdgcn_fmed3f(v1[0], -448.f, 448.f), __builtin_amdgcn_fmed3f(v1[1], -448.f, 448.f), w1, false); w1 = __builtin_amdgcn_cvt_pk_fp8_f32(__builtin_amdgcn_fmed3f(v1[2], -448.f, 448.f), __builtin_amdgcn_fmed3f(v1[3], -448.f, 448.f), w1, true);
                    *(PG8_LAS u32x2*)((bj ? reg1 : reg0) + wbase + m * 2048) = (u32x2){(unsigned)w0, (unsigned)w1}; } }
            asm volatile("s_waitcnt lgkmcnt(0)" ::: "memory"); __builtin_amdgcn_s_barrier();
            u32x4 rd[2][2];
#pragma unroll
            for (int bj = 0; bj < 2; ++bj)
#pragma unroll
                for (int k = 0; k < 2; ++k) { const int row = rrow + 64 * k; rd[bj][k] = *(const PG8_LAS u32x4*)((bj ? reg1 : reg0) + row * 128 + ((rch ^ ((row & 15) >> 1)) * 16)); }
            asm volatile("s_waitcnt lgkmcnt(0)" ::: "memory"); __builtin_amdgcn_s_barrier();
#pragma unroll
            for (int k = 0; k < 2; ++k) { const int row = rrow + 64 * k, rl = ai * HALF + row;
                if (rl < tcnt) { unsigned char* rowp = (unsigned char*)Y + (size_t)dstv[ai][k] * 1024 + pnl * BM + rch * 16;
#pragma unroll
                    for (int bj = 0; bj < 2; ++bj) { u32x4 q = rd[bj][k]; if (row & 1) q = (u32x4){q.z, q.w, q.x, q.y}; *(u32x4*)(rowp + bj * HALF) = q; } } }
        }
    }
};
}

namespace att {
using bf16x8 = __attribute__((ext_vector_type(8))) short;
using s16x4  = __attribute__((ext_vector_type(4))) short;
using f32x16 = __attribute__((ext_vector_type(16))) float;
using u32x4  = __attribute__((ext_vector_type(4))) unsigned;
constexpr int NW = 8, QBLK = 32, KVBLK = 64;
constexpr float SCALE = 0.10206207261596575f;
constexpr float THR = 8.f;
constexpr int SHM_V = 16384, SHM_K = 16384, NBUF = 3, SHM_ATTN = NBUF * SHM_V + NBUF * SHM_K + NW * 64 * 4;
#define KSWZ(row, colB) ((row) * 256 + ((colB) ^ (((row) & 7) << 4)))
#define SBAR() __builtin_amdgcn_sched_barrier(0)
__device__ __forceinline__ int crow(int r, int hi) { return (r & 3) + 8 * (r >> 2) + 4 * hi; }
__device__ __forceinline__ unsigned cvtpk(float lo, float hi) { unsigned r; asm volatile("v_cvt_pk_bf16_f32 %0, %1, %2" : "=v"(r) : "v"(lo), "v"(hi)); return r; }

__device__ __forceinline__ void partialSM(f32x16& p0, f32x16& p1, float& m_reg, float& mn, float& alpha) {
  constexpr float C = SCALE * 1.4426950408889634f;
  float pmax = p0[0];
#pragma unroll
  for (int r = 1; r < 16; ++r) pmax = fmaxf(pmax, p0[r]);
#pragma unroll
  for (int r = 0; r < 16; ++r) pmax = fmaxf(pmax, p1[r]);
  { auto rr = __builtin_amdgcn_permlane32_swap(__float_as_uint(pmax), __float_as_uint(pmax), false, false);
    pmax = fmaxf(__uint_as_float(rr[0]), __uint_as_float(rr[1])); }
  if (__builtin_expect(__all(pmax - m_reg <= THR / SCALE), 1)) { mn = m_reg; alpha = 1.f; }
  else { mn = fmaxf(m_reg, pmax); alpha = __builtin_amdgcn_exp2f((m_reg - mn) * C); m_reg = mn; }
  float mnC = -mn * C;
#pragma unroll
  for (int r = 0; r < 16; ++r) p0[r] = fmaf(p0[r], C, mnC);
#pragma unroll
  for (int r = 0; r < 16; ++r) p1[r] = fmaf(p1[r], C, mnC);
#pragma unroll
  for (int r = 0; r < 16; ++r) p0[r] = __builtin_amdgcn_exp2f(p0[r]);
}
__device__ __forceinline__ void finishSM(f32x16& p0, f32x16& p1, float alpha, float& l_reg, bf16x8& pa0, bf16x8& pa1, bf16x8& pa2, bf16x8& pa3) {
#pragma unroll
  for (int r = 0; r < 16; ++r) p1[r] = __builtin_amdgcn_exp2f(p1[r]);
  float ps = 0;
#pragma unroll
  for (int r = 0; r < 16; ++r) ps += p0[r];
#pragma unroll
  for (int r = 0; r < 16; ++r) ps += p1[r];
  { auto rr = __builtin_amdgcn_permlane32_swap(__float_as_uint(ps), __float_as_uint(ps), false, false);
    ps = __uint_as_float(rr[0]) + __uint_as_float(rr[1]); }
  l_reg = l_reg * alpha + ps;
#define PK4(P, BASE, OUT) do { unsigned a0 = cvtpk(P[BASE + 0], P[BASE + 1]), a1 = cvtpk(P[BASE + 2], P[BASE + 3]);   \
    unsigned b0 = cvtpk(P[BASE + 4], P[BASE + 5]), b1 = cvtpk(P[BASE + 6], P[BASE + 7]);                              \
    auto r0 = __builtin_amdgcn_permlane32_swap(a0, b0, false, false); auto r1 = __builtin_amdgcn_permlane32_swap(a1, b1, false, false); \
    u32x4 w = {r0[0], r1[0], r0[1], r1[1]}; OUT = *reinterpret_cast<bf16x8*>(&w); } while (0)
  PK4(p0, 0, pa0); PK4(p0, 8, pa1); PK4(p1, 0, pa2); PK4(p1, 8, pa3);
#undef PK4
}
__device__ __forceinline__ void qkt(f32x16& p0, f32x16& p1, const bf16* Ks, const bf16x8* qr, int r32, int hi) {
  p0 = f32x16{}; p1 = f32x16{};
#pragma unroll
  for (int d0 = 0; d0 < 6; ++d0) { int cb = (d0 * 16 + hi * 8) * 2;
    bf16x8 b0 = *reinterpret_cast<const bf16x8*>((const char*)Ks + KSWZ(r32, cb));
    bf16x8 b1 = *reinterpret_cast<const bf16x8*>((const char*)Ks + KSWZ(32 + r32, cb));
    p0 = __builtin_amdgcn_mfma_f32_32x32x16_bf16(b0, qr[d0], p0, 0, 0, 0);
    p1 = __builtin_amdgcn_mfma_f32_32x32x16_bf16(b1, qr[d0], p1, 0, 0, 0); }
}
__device__ __forceinline__ int v_st(int k, int c) { const int kk = (k & ~0xC) | ((k & 4) << 1) | ((k & 8) >> 1); return ((kk >> 3) * 4 + (c >> 5)) * 512 + ((kk & 7) * 32 + (c & 31)) * 2; }
__device__ __forceinline__ int v_rd_base(int lane) { return ((lane & 3) << 3) | (((lane >> 2) & 3) << 6) | (((lane >> 4) & 1) << 5) | (((lane >> 5) & 1) << 8); }
constexpr int v_rd_off(int d0, int ks, int half) { return d0 * 512 + ks * 4096 + half * 2048; }
template <int OFF> __device__ __forceinline__ s16x4 tr_read(int vb) {
  s16x4 r; asm volatile("ds_read_b64_tr_b16 %0, %1 offset:%2" : "=&v"(r) : "v"(vb), "i"(OFF) : "memory"); return r;
}
template <int D0> __device__ __forceinline__ void pv_one(f32x16& od, int vb, bf16x8 pa0, bf16x8 pa1, bf16x8 pa2, bf16x8 pa3) {
  const s16x4 l0 = tr_read<v_rd_off(D0, 0, 0)>(vb), h0 = tr_read<v_rd_off(D0, 0, 1)>(vb), l1 = tr_read<v_rd_off(D0, 1, 0)>(vb), h1 = tr_read<v_rd_off(D0, 1, 1)>(vb);
  const s16x4 l2 = tr_read<v_rd_off(D0, 2, 0)>(vb), h2 = tr_read<v_rd_off(D0, 2, 1)>(vb), l3 = tr_read<v_rd_off(D0, 3, 0)>(vb), h3 = tr_read<v_rd_off(D0, 3, 1)>(vb);
  asm volatile("s_waitcnt lgkmcnt(0)" ::: "memory"); SBAR();
#define PK(L, H) (bf16x8){L[0], L[1], L[2], L[3], H[0], H[1], H[2], H[3]}
  od = __builtin_amdgcn_mfma_f32_32x32x16_bf16(pa0, PK(l0, h0), od, 0, 0, 0);
  od = __builtin_amdgcn_mfma_f32_32x32x16_bf16(pa1, PK(l1, h1), od, 0, 0, 0);
  od = __builtin_amdgcn_mfma_f32_32x32x16_bf16(pa2, PK(l2, h2), od, 0, 0, 0);
  od = __builtin_amdgcn_mfma_f32_32x32x16_bf16(pa3, PK(l3, h3), od, 0, 0, 0);
#undef PK
}
__device__ __forceinline__ void pv_d0(f32x16* o, int vb, bf16x8 pa0, bf16x8 pa1, bf16x8 pa2, bf16x8 pa3) {
  pv_one<0>(o[0], vb, pa0, pa1, pa2, pa3); pv_one<1>(o[1], vb, pa0, pa1, pa2, pa3);
}
__device__ __forceinline__ bf16x8 rope8(bf16x8 x, const float* tab, int pbase) {
  u32x4 w;
#pragma unroll
  for (int i = 0; i < 4; ++i) { const float x1 = __uint_as_float(((unsigned)(unsigned short)x[2 * i]) << 16), x2 = __uint_as_float(((unsigned)(unsigned short)x[2 * i + 1]) << 16);
    const float cs = tab[pbase + i], sn = tab[16 + pbase + i]; w[i] = cvtpk(x1 * cs - x2 * sn, x1 * sn + x2 * cs); }
  return *reinterpret_cast<bf16x8*>(&w);
}
__device__ __forceinline__ void attn_unit(const bf16* __restrict__ Qb, const bf16* __restrict__ KVb, const bf16* __restrict__ KRb, bf16* __restrict__ Ob,
                                          const float* __restrict__ rope, int seq, char* lds) {
  int tid_l = threadIdx.x; asm volatile("" : "+v"(tid_l));
  const int tid = tid_l, wid = tid >> 6, lane = tid & 63, r32 = lane & 31, hi = lane >> 5;
  bf16* V_lds = (bf16*)lds; bf16* K_lds = (bf16*)(lds + NBUF * SHM_V);
  float* ws = (float*)(lds + NBUF * SHM_V + NBUF * SHM_K) + wid * 64; float* li_l = ws; float* al_l = ws + 32;
  float m_reg = -1e30f, l_reg = 0; f32x16 o[2] = {}; bf16x8 qr[6];
  const bf16* Qw = Qb + (long)(wid * QBLK + r32) * 768 + hi * 8;
#pragma unroll
  for (int d0 = 0; d0 < 6; ++d0) qr[d0] = *reinterpret_cast<const bf16x8*>(Qw + d0 * 16);
  if (rope) { const float* tab = rope + (long)(wid * QBLK + r32) * 32; qr[4] = rope8(qr[4], tab, 4 * hi); qr[5] = rope8(qr[5], tab, 8 + 4 * hi); }
  const int sr = tid >> 4, ch = tid & 15;
  const bf16* kbase = ch < 8 ? KVb + ch * 8 : KRb + ((ch - 8) & 3) * 8; const long kstr = ch < 8 ? 1024 : 32;
  const int vkey = tid >> 3, vc8 = (tid & 7) * 8, vst0 = v_st(vkey, vc8);
  const bf16* vbase = KVb + 512 + vc8;
  const int vb0 = (int)(uintptr_t)V_lds + v_rd_base(lane);
  struct { bf16x8 vs0, ks0, ks1; } sr_[2];
#define SLOAD(i, k0) do { sr_[i].vs0 = *reinterpret_cast<const bf16x8*>(vbase + (long)((k0) + vkey) * 1024); \
    sr_[i].ks0 = *reinterpret_cast<const bf16x8*>(kbase + (long)((k0) + sr) * kstr); sr_[i].ks1 = *reinterpret_cast<const bf16x8*>(kbase + (long)((k0) + 32 + sr) * kstr); } while (0)
#define SWRITE(b, i) do { *(bf16x8*)((char*)V_lds + (b) * SHM_V + vst0) = sr_[i].vs0; int kc = ch * 16;               \
    *(bf16x8*)((char*)K_lds + (b) * SHM_K + KSWZ(sr, kc)) = sr_[i].ks0;                       \
    *(bf16x8*)((char*)K_lds + (b) * SHM_K + KSWZ(32 + sr, kc)) = sr_[i].ks1; } while (0)
#define SWAIT() asm volatile("s_waitcnt vmcnt(3)" ::: "memory")
#define RESC(a) do { if (__any((a) < 1.f)) { if (hi == 0) al_l[r32] = (a); asm volatile("s_waitcnt lgkmcnt(0)" ::: "memory"); \
    _Pragma("unroll") for (int d = 0; d < 2; ++d) _Pragma("unroll") for (int r = 0; r < 16; ++r) o[d][r] *= al_l[crow(r, hi)]; } } while (0)
  f32x16 pA0, pA1, pB0, pB1; float mnA, mnB, alA, alB; bf16x8 pa0, pa1, pa2, pa3; const int NT = seq / KVBLK;
  constexpr int SE = 0, SO = 1;
  SLOAD(SE, 0); asm volatile("s_waitcnt vmcnt(0)" ::: "memory"); SWRITE(0, SE); __syncthreads();
  qkt(pA0, pA1, K_lds, qr, r32, hi); partialSM(pA0, pA1, m_reg, mnA, alA);
  SLOAD(SO, KVBLK); if (2 < NT) SLOAD(SE, 2 * KVBLK);
  SWAIT(); SWRITE(1, SO); __syncthreads();
  int bprev = 0, bcur = 1, bnext = 2;
#define ATT_STEP(PN0, PN1, MNN, ALN, PO0, PO1, ALO, SL_LOAD, SL_WRITE, t) do { \
    SBAR(); qkt(PN0, PN1, (bf16*)((char*)K_lds + bcur * SHM_K), qr, r32, hi); \
    finishSM(PO0, PO1, ALO, l_reg, pa0, pa1, pa2, pa3); SBAR(); \
    if ((t) + 2 < NT) SLOAD(SL_LOAD, ((t) + 2) * KVBLK); SBAR(); \
    pv_d0(o, vb0 + bprev * (int)SHM_V, pa0, pa1, pa2, pa3); partialSM(PN0, PN1, m_reg, MNN, ALN); \
    SWAIT(); SWRITE(bnext, SL_WRITE); \
    RESC(ALN); __syncthreads(); \
    bprev = bcur; bcur = bnext; bnext = (bnext == 2) ? 0 : bnext + 1; } while (0)
  for (int j = 1; j + 1 < NT; j += 2) {
    ATT_STEP(pB0, pB1, mnB, alB, pA0, pA1, alA, SO, SE, j);
    ATT_STEP(pA0, pA1, mnA, alA, pB0, pB1, alB, SE, SO, j + 1);
  }
#undef ATT_STEP
  SBAR(); qkt(pB0, pB1, (bf16*)((char*)K_lds + bcur * SHM_K), qr, r32, hi);
  finishSM(pA0, pA1, alA, l_reg, pa0, pa1, pa2, pa3); SBAR();
  pv_d0(o, vb0 + bprev * (int)SHM_V, pa0, pa1, pa2, pa3); partialSM(pB0, pB1, m_reg, mnB, alB);
  RESC(alB);
  finishSM(pB0, pB1, alB, l_reg, pa0, pa1, pa2, pa3); SBAR();
  pv_d0(o, vb0 + bcur * (int)SHM_V, pa0, pa1, pa2, pa3);
  if (hi == 0) li_l[r32] = l_reg; asm volatile("s_waitcnt lgkmcnt(0)" ::: "memory");
  float rli[16];
#pragma unroll
  for (int r = 0; r < 16; ++r) rli[r] = __builtin_amdgcn_rcpf(li_l[crow(r, hi)]);
  bf16* Ow = Ob + (long)(wid * QBLK) * 1024;
#pragma unroll
  for (int r = 0; r < 16; ++r) { int orow = crow(r, hi);
#pragma unroll
    for (int d0 = 0; d0 < 2; ++d0) { const float v = o[d0][r] * rli[r]; Ow[(long)orow * 1024 + d0 * 32 + r32] = (bf16)(cvtpk(v, v) & 0xffffu); } }
#undef SLOAD
#undef SWRITE
#undef SWAIT
#undef RESC
}
}

struct Args { const float* in[33]; float* out; unsigned char* ws; int ph_lo, ph_hi; };
enum { I_X = 0, I_C, I_CTX, I_CCTX, I_MODW, I_MODB, I_LN1G, I_LN1B, I_LN2G, I_LN2B, I_WIN, I_QNORM, I_KVNORM, I_WUQ, I_WUK, I_WUV, I_LBL, I_HGNORM, I_WOUT,
       I_PW1W, I_PW1B, I_DWW, I_DWB, I_CLNG, I_CLNB, I_PW2W, I_PW2B, I_RW, I_RB, I_WGU, I_BGU, I_WDN, I_BDN };

__device__ __forceinline__ int dst_row(int n, int mode, int row_off) {
    if (mode == 0) return row_off + n;
    int f, g; if (mode == 1) { f = n >> 1; g = n & 1; } else { g = n >> 10; f = n & 1023; }
    return row_off + 256 * (f >> 7) + 128 * g + (f & 127);
}
__device__ __forceinline__ unsigned pack_fp8x4(float a, float b, float c, float d) { int w = 0; w = __builtin_amdgcn_cvt_pk_fp8_f32(fminf(fmaxf(a, -448.f), 448.f), fminf(fmaxf(b, -448.f), 448.f), w, false);
    w = __builtin_amdgcn_cvt_pk_fp8_f32(fminf(fmaxf(c, -448.f), 448.f), fminf(fmaxf(d, -448.f), 448.f), w, true); return (unsigned)w; }
struct TrItem { const float* W; bf16* WT; int K, N, mode, row_off, item; float f8scale; };
__device__ __forceinline__ void tr_load(const TrItem& d, f32x4 (&v)[16], int lane) {
    const int nblk = (d.N + 63) >> 6, kb = d.item / nblk, nb = d.item - kb * nblk, k0 = 64 * kb, n0 = 64 * nb;
    const int nc = n0 + 4 * (lane & 15), kr = lane >> 4;
#pragma unroll
    for (int i = 0; i < 16; ++i) v[i] = (nc < d.N) ? __builtin_nontemporal_load((const f32x4*)(d.W + (size_t)(k0 + 16 * kr + i) * d.N + nc)) : (f32x4){0.f, 0.f, 0.f, 0.f};
}
__device__ __forceinline__ void tr_store(const TrItem& d, const f32x4 (&v)[16], int lane) {
    const int nblk = (d.N + 63) >> 6, kb = d.item / nblk, nb = d.item - kb * nblk, k0 = 64 * kb, n0 = 64 * nb;
    const int nc = n0 + 4 * (lane & 15), kr = lane >> 4; const int K = d.K;
    if (nc >= d.N) return;
#pragma unroll
    for (int j = 0; j < 4; ++j) { const size_t row = (size_t)dst_row(nc + j, d.mode, d.row_off);
        if (d.f8scale > 0.f) { const float f8 = d.f8scale; v4u o;
            o.x = pack_fp8x4(v[0][j] * f8, v[1][j] * f8, v[2][j] * f8, v[3][j] * f8); o.y = pack_fp8x4(v[4][j] * f8, v[5][j] * f8, v[6][j] * f8, v[7][j] * f8);
            o.z = pack_fp8x4(v[8][j] * f8, v[9][j] * f8, v[10][j] * f8, v[11][j] * f8); o.w = pack_fp8x4(v[12][j] * f8, v[13][j] * f8, v[14][j] * f8, v[15][j] * f8);
            *(v4u*)((unsigned char*)d.WT + row * K + k0 + 16 * kr) = o; }
        else { v4u o0, o1; o0.x = pk2(v[0][j], v[1][j]); o0.y = pk2(v[2][j], v[3][j]); o0.z = pk2(v[4][j], v[5][j]); o0.w = pk2(v[6][j], v[7][j]);
            o1.x = pk2(v[8][j], v[9][j]); o1.y = pk2(v[10][j], v[11][j]); o1.z = pk2(v[12][j], v[13][j]); o1.w = pk2(v[14][j], v[15][j]);
            bf16* wp = d.WT + row * K + k0 + 16 * kr; *(v4u*)wp = o0; *(v4u*)(wp + 8) = o1; } }
}
__device__ __forceinline__ void convert_items(const Args& a, unsigned char* ws, LAS float* scr, int lane, int gw, int NGW, int it_lo, int it_hi) {
    constexpr int I0 = 16 * 51, I1 = 6 * 12, I2 = 4 * 8, I3 = 4 * 8, I4 = 256, I5 = 512;
    constexpr int NGU = 64 * 512, NDN = 64 * 256;
    auto decode = [&](int it) -> TrItem {
        TrItem d; int r = it; d.f8scale = 0.f; d.mode = 0; d.row_off = 0;
        if (r < NGU) { const int mi = r >> 9; d.W = a.in[I_WGU] + (size_t)mi * 1024 * 2048; d.K = 1024; d.N = 2048; d.WT = (bf16*)(ws + WS_WGU + (size_t)mi * 2048 * 1024); d.mode = 1; d.item = r & 511; d.f8scale = SC_WGU; return d; } r -= NGU;
        if (r < NDN) { const int mi = r >> 8; d.W = a.in[I_WDN] + (size_t)mi * 1024 * 1024; d.K = 1024; d.N = 1024; d.WT = (bf16*)(ws + WS_WDN + (size_t)mi * 1024 * 1024); d.item = r & 255; d.f8scale = SC_WDN; return d; } r -= NDN;
        if (r < I0) { d.W = a.in[I_WIN]; d.K = 1024; d.N = 3232; d.WT = (bf16*)(ws + WS_WIN); d.item = r; d.f8scale = SC_WIN; return d; } r -= I0;
        if (r < I1) { d.W = a.in[I_WUQ]; d.K = 384; d.N = 768; d.WT = (bf16*)(ws + WS_WUQ); d.item = r; return d; } r -= I1;
        if (r < I2) { d.W = a.in[I_WUK]; d.K = 256; d.N = 512; d.WT = (bf16*)(ws + WS_WUKV); d.item = r; return d; } r -= I2;
        if (r < I3) { d.W = a.in[I_WUV]; d.K = 256; d.N = 512; d.WT = (bf16*)(ws + WS_WUKV); d.row_off = 512; d.item = r; return d; } r -= I3;
        if (r < I4) { d.W = a.in[I_WOUT]; d.K = 1024; d.N = 1024; d.WT = (bf16*)(ws + WS_WOUT); d.item = r; return d; } r -= I4;
        if (r < I5) { d.W = a.in[I_PW1W]; d.K = 1024; d.N = 2048; d.WT = (bf16*)(ws + WS_WPW1); d.mode = 2; d.item = r; d.f8scale = SC_WPW; return d; } r -= I5;
        d.W = a.in[I_PW2W]; d.K = 1024; d.N = 1024; d.WT = (bf16*)(ws + WS_WPW2); d.item = r; d.f8scale = SC_WPW; return d; };
    f32x4 tv0[16], tv1[16];
    int it = it_lo + gw;
    if (it < it_hi) { const TrItem d0 = decode(it); tr_load(d0, tv0, lane); }
    if (it + NGW < it_hi) { const TrItem d1 = decode(it + NGW); tr_load(d1, tv1, lane); }
    for (; it < it_hi; it += 2 * NGW) {
        { const TrItem d = decode(it);
          tr_store(d, tv0, lane);
          if (it + 2 * NGW < it_hi) { const TrItem dn = decode(it + 2 * NGW); tr_load(dn, tv0, lane); } }
        if (it + NGW < it_hi) { const TrItem d = decode(it + NGW);
          tr_store(d, tv1, lane);
          if (it + 3 * NGW < it_hi) { const TrItem dn = decode(it + 3 * NGW); tr_load(dn, tv1, lane); } }
    }
}
__device__ __forceinline__ void phase_prologue(const Args& a, LAS unsigned char* lds, int tid, int lane, int wave) {
    unsigned char* ws = a.ws;
    const int G = gridDim.x, B = blockIdx.x;
    {
        LAS float* sc = (LAS float*)lds;
        LAS float* red = (LAS float*)(lds + 36864);
        float* modv = (float*)(ws + WS_MODV);
        bool have = false;
        for (int it = B; it < 192; it += G) {
            if (!have) { for (int i = tid; i < 9 * 1024; i += NTHR) { const int r = i >> 10, k = i & 1023; const float x = r < 8 ? a.in[I_C][r * 1024 + k] : a.in[I_CCTX][k]; sc[i] = x * sigm(x); } __syncthreads(); have = true; }
            const int l = it / 96, jc = it % 96, kg = tid >> 6, jj = tid & 63, j = jc * 64 + jj;
            float acc[9];
#pragma unroll
            for (int r = 0; r < 9; ++r) acc[r] = 0.f;
            const float* wp = a.in[I_MODW] + ((size_t)l * 1024 + kg * 128) * 6144 + j;
            for (int k0 = 0; k0 < 128; k0 += 16) { float w[16];
#pragma unroll
                for (int kk = 0; kk < 16; ++kk) w[kk] = wp[(size_t)(k0 + kk) * 6144];
#pragma unroll
                for (int kk = 0; kk < 16; ++kk)
#pragma unroll
                    for (int r = 0; r < 9; ++r) acc[r] += sc[r * 1024 + kg * 128 + k0 + kk] * w[kk]; }
#pragma unroll
            for (int r = 0; r < 9; ++r) red[(kg * 9 + r) * 64 + jj] = acc[r];
            __syncthreads();
            for (int i = tid; i < 576; i += NTHR) { const int r = i >> 6, j2 = i & 63; float s = a.in[I_MODB][l * 6144 + jc * 64 + j2];
#pragma unroll
                for (int g = 0; g < 8; ++g) s += red[(g * 9 + r) * 64 + j2];
                modv[((size_t)l * 9 + r) * 6144 + jc * 64 + j2] = s; }
            __syncthreads();
        }
        __syncthreads();
    }
    const int gw = B * NWAVES + wave, NGW = G * NWAVES, gt = B * NTHR + tid, NGT = G * NTHR;
    { float* rope = (float*)(ws + WS_ROPE);
      for (int i = gt; i < 4096 * 16; i += NGT) { const int t = i >> 4, p = i & 15; const float pos = (float)(p < 8 ? (t >> 6) : (t & 63));
          const float inv = __powf(10000.0f, -(float)(p & 7) * 0.125f); const float ang = pos * inv; rope[t * 32 + p] = cosf(ang); rope[t * 32 + 16 + p] = sinf(ang); }
      float* bgu = (float*)(ws + WS_BGU);
      for (int i = gt; i < 2 * 32 * 2048; i += NGT) { const int le = i >> 11, np = i & 2047, q = np >> 8, g = (np >> 7) & 1, r = np & 127, f = 128 * q + r; bgu[i] = a.in[I_BGU][(size_t)le * 2048 + 2 * f + g]; }
      float* pb = (float*)(ws + WS_PW1B);
      for (int i = gt; i < 2048; i += NGT) { const int q = i >> 8, g = (i >> 7) & 1, r = i & 127, f = 128 * q + r; pb[i] = a.in[I_PW1B][g * 1024 + f]; }
      v4u* zp = (v4u*)(ws + WS_WIN + (size_t)3232 * 1024);
      for (int i = gt; i < 96 * 1024 / 16; i += NGT) zp[i] = (v4u){0u, 0u, 0u, 0u};
    }
    LAS float* scr = (LAS float*)(lds + wave * 16640);
    constexpr int I0 = 16 * 51, I1 = 6 * 12, I2 = 4 * 8, I3 = 4 * 8, I4 = 256, I5 = 512, I6 = 256, SMALL = I0 + I1 + I2 + I3 + I4 + I5 + I6;
    constexpr int NGU = 64 * 512, NDN = 64 * 256, NITEMS = SMALL + NGU + NDN;
    convert_items(a, ws, scr, lane, B * NWAVES + wave, G * NWAVES, NGU + NDN, NITEMS);
}
__device__ __forceinline__ void convert_moe_share(const Args& a, LAS unsigned char* lds, int lane, int wave) {
    LAS float* scr = (LAS float*)(lds + wave * 16640);
    constexpr int NGU = 64 * 512, NDN = 64 * 256;
    convert_items(a, a.ws, scr, lane, blockIdx.x * NWAVES + wave, gridDim.x * NWAVES, 0, NGU + NDN);
}

__device__ __forceinline__ void phase_mod0(const Args& a, int lane, int wave) {
    const int gw = blockIdx.x * NWAVES + wave, NGW = gridDim.x * NWAVES;
    const float* modv = (const float*)(a.ws + WS_MODV);
    bf16* X = (bf16*)(a.ws + WS_X);
    f32x4 xv[2][4], xn[2][4];
#define MOD0_LOAD(dst, r0_) do { _Pragma("unroll") for (int q = 0; q < 2; ++q) { const int r = (r0_) + q; const int b = r / TPB, p = r - b * TPB; \
            const float* src = p < CTXL ? a.in[I_CTX] + ((size_t)b * CTXL + p) * 1024 : a.in[I_X] + ((size_t)b * SEQ + (p - CTXL)) * 1024; \
            _Pragma("unroll") for (int j = 0; j < 4; ++j) dst[q][j] = *(const f32x4*)(src + 4 * (lane + 64 * j)); } } while (0)
    if (2 * gw < NTOK) MOD0_LOAD(xv, 2 * gw);
    for (int r0 = 2 * gw; r0 < NTOK; r0 += 2 * NGW) {
        f32x4 shv[2][4], scv[2][4];
#pragma unroll
        for (int q = 0; q < 2; ++q) { const int r = r0 + q; const int b = r / TPB, p = r - b * TPB; const float* mvp = modv + (size_t)(p < CTXL ? 8 : b) * 6144;
#pragma unroll
            for (int j = 0; j < 4; ++j) { const int c = 4 * (lane + 64 * j); shv[q][j] = *(const f32x4*)(mvp + c); scv[q][j] = *(const f32x4*)(mvp + 1024 + c); } }
        if (r0 + 2 * NGW < NTOK) MOD0_LOAD(xn, r0 + 2 * NGW);
#pragma unroll
        for (int q = 0; q < 2; ++q)
#pragma unroll
            for (int j = 0; j < 4; ++j) { const int c = 4 * (lane + 64 * j); const f32x4 sh = shv[q][j], sc = scv[q][j];
                const f32x4 y = (xv[q][j] * (sc + 1.0f) + sh) * SC_A0; *(unsigned*)((unsigned char*)X + (size_t)(r0 + q) * 1024 + c) = pack_fp8x4(y[0], y[1], y[2], y[3]); }
#pragma unroll
        for (int q = 0; q < 2; ++q)
#pragma unroll
            for (int j = 0; j < 4; ++j) xv[q][j] = xn[q][j];
    }
#undef MOD0_LOAD
}

__device__ __forceinline__ void phase_norm0(const Args& a, int lane, int wave) {
    const int gw = blockIdx.x * NWAVES + wave, NGW = gridDim.x * NWAVES;
    const bf16* Z = (const bf16*)(a.ws + WS_Z); bf16* CQN = (bf16*)(a.ws + WS_CQN); bf16* CKVN = (bf16*)(a.ws + WS_CKVN); bf16* KRR = (bf16*)(a.ws + WS_KRR);
    const float* rope = (const float*)(a.ws + WS_ROPE);
    float gq[8], gk[8];
#pragma unroll
    for (int i = 0; i < 8; ++i) { gq[i] = lane < 48 ? a.in[I_QNORM][8 * lane + i] : 0.f; gk[i] = lane < 32 ? a.in[I_KVNORM][8 * lane + i] : 0.f; }
    bf16x8 q8 = {}, k8 = {}, r8 = {}, nq8 = {}, nk8 = {}, nr8 = {};
#define N0_LOAD(dq, dk, dr, r_) do { const bf16* z_ = Z + (size_t)(r_) * ZC; if (lane < 48) dq = *(const bf16x8*)(z_ + ZQ + 8 * lane); if (lane < 32) dk = *(const bf16x8*)(z_ + ZKV + 8 * lane); if (lane < 4) dr = *(const bf16x8*)(z_ + ZKR + 8 * lane); } while (0)
    if (gw < NTOK) N0_LOAD(q8, k8, r8, gw);
    for (int r = gw; r < NTOK; r += NGW, q8 = nq8, k8 = nk8, r8 = nr8) {
        const int p = r % TPB;
        if (r + NGW < NTOK) N0_LOAD(nq8, nk8, nr8, r + NGW);
        float qf[8], kf[8], sq = 0.f, sk = 0.f;
#pragma unroll
        for (int i = 0; i < 8; ++i) { qf[i] = bf2f((unsigned short)q8[i]); kf[i] = bf2f((unsigned short)k8[i]); sq += qf[i] * qf[i]; sk += kf[i] * kf[i]; }
        sq = wave_sum(sq); sk = wave_sum(sk);
        const float rq = rsqrtf(sq * (1.f / 384.f) + RMS_EPS), rk = rsqrtf(sk * (1.f / 256.f) + RMS_EPS);
        if (lane < 48) { v4u o; o.x = pk2(qf[0] * rq * gq[0], qf[1] * rq * gq[1]); o.y = pk2(qf[2] * rq * gq[2], qf[3] * rq * gq[3]); o.z = pk2(qf[4] * rq * gq[4], qf[5] * rq * gq[5]); o.w = pk2(qf[6] * rq * gq[6], qf[7] * rq * gq[7]);
            *(v4u*)(CQN + (size_t)r * 384 + 8 * lane) = o; }
        if (lane < 32) { v4u o; o.x = pk2(kf[0] * rk * gk[0], kf[1] * rk * gk[1]); o.y = pk2(kf[2] * rk * gk[2], kf[3] * rk * gk[3]); o.z = pk2(kf[4] * rk * gk[4], kf[5] * rk * gk[5]); o.w = pk2(kf[6] * rk * gk[6], kf[7] * rk * gk[7]);
            *(v4u*)(CKVN + (size_t)r * 256 + 8 * lane) = o; }
        if (lane < 4) { bf16x8 o8 = r8; if (p >= CTXL) o8 = att::rope8(r8, rope + (size_t)(p - CTXL) * 32, 4 * lane); *(bf16x8*)(KRR + (size_t)r * 32 + 8 * lane) = o8; }
    }
#undef N0_LOAD
}

__device__ __forceinline__ void hgrn_unit(const Args& a, int unit, LAS unsigned char* lds, int tid) {
    const int b = unit >> 5, head = (unit >> 3) & 3, dir = (unit >> 2) & 1, sl = unit & 3;
    const bf16* Z = (const bf16*)(a.ws + WS_Z);
    float* Od = (float*)(a.ws + (dir ? WS_OB : WS_OF));
    LAS float* lbv = (LAS float*)lds;
    constexpr int BUF0 = 1024, BUFSZ = 28672, OFF_Q = 16384, OFF_V = 24576;
    if (tid < 128) { const int c = head * 128 + tid; const float l0 = a.in[I_LBL][c], l1 = a.in[I_LBL][512 + c], l2 = a.in[I_LBL][1024 + c]; const float m = fmaxf(l0, fmaxf(l1, l2));
        const float e0 = __expf(l0 - m), e1 = __expf(l1 - m), e2 = __expf(l2 - m); lbv[tid] = e0 / (e0 + e1 + e2); }
    __syncthreads();
    const int lt = tid >> 4, lcg = tid & 15;
    float lb8[8];
#pragma unroll
    for (int i = 0; i < 8; ++i) lb8[i] = lbv[8 * lcg + i];
    const int fcol = (dir ? ZHB : ZHF) + head * 128 + 8 * lcg, qcol = ZHQ + head * 128 + 8 * lcg;
    const int vt = tid >> 2, vcol = ZHI + head * 128 + sl * 32 + (tid & 3) * 8;
    const int wave = tid >> 6, lane = tid & 63, vv = lane >> 4, cg = lane & 15, vloc = wave * 4 + vv;
    const size_t zb = (size_t)b * TPB;
    bf16x8 rq, rf, rv;
#define TOKP(n) (dir ? ((n) < CTXL ? (CTXL - 1 - (n)) : (TPB + CTXL - 1 - (n))) : (n))
#define HG_LOAD(i) do { const int n_ = 32 * (i) + lt; const bf16* zr_ = Z + (zb + TOKP(n_)) * ZC; rq = *(const bf16x8*)(zr_ + qcol); rf = *(const bf16x8*)(zr_ + fcol); \
        if (tid < 128) { const int n2_ = 32 * (i) + vt; rv = *(const bf16x8*)(Z + (zb + TOKP(n2_)) * ZC + vcol); } } while (0)
#define HG_WRITE(bufi) do { LAS unsigned char* bp_ = lds + BUF0 + (bufi) * BUFSZ; float f_[8]; \
        _Pragma("unroll") for (int i_ = 0; i_ < 8; ++i_) f_[i_] = lb8[i_] + (1.f - lb8[i_]) * sigm(bf2f((unsigned short)rf[i_])); \
        *(LAS f32x4*)(bp_ + ((lt * 128 + lcg * 4) * 4)) = (f32x4){f_[0], f_[1], f_[2], f_[3]}; *(LAS f32x4*)(bp_ + ((lt * 128 + 64 + lcg * 4) * 4)) = (f32x4){f_[4], f_[5], f_[6], f_[7]}; \
        *(LAS bf16x8*)(bp_ + OFF_Q + (lt * 128 + lcg * 8) * 2) = rq; \
        if (tid < 128) { float v_[8]; _Pragma("unroll") for (int i_ = 0; i_ < 8; ++i_) v_[i_] = bf2f((unsigned short)rv[i_]); \
            *(LAS f32x4*)(bp_ + OFF_V + (vt * 32 + (tid & 3) * 8) * 4) = (f32x4){v_[0], v_[1], v_[2], v_[3]}; *(LAS f32x4*)(bp_ + OFF_V + (vt * 32 + (tid & 3) * 8 + 4) * 4) = (f32x4){v_[4], v_[5], v_[6], v_[7]}; } } while (0)
    float S[8];
#pragma unroll
    for (int j = 0; j < 8; ++j) S[j] = 0.f;
    HG_LOAD(0); HG_WRITE(0); __syncthreads();
    const bool b3 = (cg & 8) != 0, b2 = (cg & 4) != 0, b1 = (cg & 2) != 0, b0 = (cg & 1) != 0;
    for (int i = 0; i < TPB / 32; ++i) {
        if (i + 1 < TPB / 32) HG_LOAD(i + 1);
        const LAS unsigned char* bp = lds + BUF0 + (i & 1) * BUFSZ;
#pragma unroll 1
        for (int g = 0; g < 4; ++g) {
            const LAS unsigned char* gp = bp + g * 8 * 512;
            float ot[8];
#pragma unroll
            for (int t = 0; t < 8; ++t) {
                const f32x4 f0 = *(const LAS f32x4*)(gp + ((t * 128 + cg * 4) * 4)), f1 = *(const LAS f32x4*)(gp + ((t * 128 + 64 + cg * 4) * 4));
                const bf16x8 q8 = *(const LAS bf16x8*)(bp + OFF_Q + ((g * 8 + t) * 128 + cg * 8) * 2);
                const float v = *(const LAS float*)(bp + OFF_V + ((g * 8 + t) * 32 + vloc) * 4);
                float acc = 0.f;
#pragma unroll
                for (int j = 0; j < 8; ++j) { const float fj = j < 4 ? f0[j] : f1[j - 4]; const float qj = bf2f((unsigned short)q8[j]);
                    const float kv = fmaf(-fj, v, v); S[j] = fmaf(fj, S[j], kv); acc = fmaf(S[j], qj, acc); }
                ot[t] = acc;
            }
#pragma unroll
            for (int k = 0; k < 4; ++k) { const float snd = b3 ? ot[k] : ot[k + 4]; const float rcv = __shfl_xor(snd, 8); ot[k] = (b3 ? ot[k + 4] : ot[k]) + rcv; }
#pragma unroll
            for (int k = 0; k < 2; ++k) { const float snd = b2 ? ot[k] : ot[k + 2]; const float rcv = __shfl_xor(snd, 4); ot[k] = (b2 ? ot[k + 2] : ot[k]) + rcv; }
            { const float snd = b1 ? ot[0] : ot[1]; const float rcv = __shfl_xor(snd, 2); ot[0] = (b1 ? ot[1] : ot[0]) + rcv; }
            ot[0] += __shfl_xor(ot[0], 1);
            if (!b0) { const int n = 32 * i + 8 * g + (cg >> 1); const int p = TOKP(n); if (p >= CTXL) Od[(zb + p) * 512 + head * 128 + sl * 32 + vloc] = ot[0]; }
        }
        if (i + 1 < TPB / 32) HG_WRITE((i + 1) & 1);
        __syncthreads();
    }
#undef TOKP
#undef HG_LOAD
#undef HG_WRITE
}

__device__ __forceinline__ void phase_readout(const Args& a, int lane, int wave) {
    const int gw = blockIdx.x * NWAVES + wave, NGW = gridDim.x * NWAVES;
    const bf16* OF = (const bf16*)(a.ws + WS_OF); const bf16* OB = (const bf16*)(a.ws + WS_OB);
    const bf16* Z = (const bf16*)(a.ws + WS_Z); bf16* MIX = (bf16*)(a.ws + WS_Y);
    float hn[8];
#pragma unroll
    for (int i = 0; i < 8; ++i) hn[i] = a.in[I_HGNORM][((8 * lane) & 127) + i];
    bf16x8 a8 = {}, c8 = {}, g8 = {}, na8 = {}, nc8 = {}, ng8 = {};
#define RO_LOAD(da, dc, dg, lr_) do { const size_t r_ = (size_t)grow_of(lr_); da = *(const bf16x8*)(OF + r_ * 512 + 8 * lane); dc = *(const bf16x8*)(OB + r_ * 512 + 8 * lane); dg = *(const bf16x8*)(Z + r_ * ZC + ZHG + 8 * lane); } while (0)
    if (gw < NLAT) RO_LOAD(a8, c8, g8, gw);
    for (int lr = gw; lr < NLAT; lr += NGW, a8 = na8, c8 = nc8, g8 = ng8) {
        const size_t r = (size_t)grow_of(lr);
        if (lr + NGW < NLAT) RO_LOAD(na8, nc8, ng8, lr + NGW);
        float o[8]; float ss = 0.f;
#pragma unroll
        for (int i = 0; i < 8; ++i) o[i] = bf2f((unsigned short)a8[i]) + bf2f((unsigned short)c8[i]);
#pragma unroll
        for (int i = 0; i < 8; ++i) ss += o[i] * o[i];
        ss += __shfl_xor(ss, 1); ss += __shfl_xor(ss, 2); ss += __shfl_xor(ss, 4); ss += __shfl_xor(ss, 8);
        const float rs = rsqrtf(ss * (1.f / 128.f) + RMS_EPS);
        float y[8];
#pragma unroll
        for (int i = 0; i < 8; ++i) { const float g = bf2f((unsigned short)g8[i]); y[i] = o[i] * rs * hn[i] * (g * sigm(g)); }
        v4u w; w.x = pk2(y[0], y[1]); w.y = pk2(y[2], y[3]); w.z = pk2(y[4], y[5]); w.w = pk2(y[6], y[7]);
        *(v4u*)(MIX + r * 1024 + 512 + 8 * lane) = w;
    }
#undef RO_LOAD
}

__device__ __forceinline__ int rows_per_block() { const int G = gridDim.x; return (((NLAT + G - 1) / G) + 15) & ~15; }
__device__ __forceinline__ void phase_ln1(const Args& a, int l, LAS unsigned char* lds, int tid, int lane, int wave) {
    typedef short bf16x8s __attribute__((ext_vector_type(8)));
    const int RB = rows_per_block(), lr_base = blockIdx.x * RB;
    const bf16* PRE = (const bf16*)(a.ws + WS_PRE); bf16* XB = (bf16*)(a.ws + WS_X);
    const float* modv = (const float*)(a.ws + WS_MODV) + (size_t)l * 9 * 6144;
    const float* lng = a.in[I_LN1G] + l * 1024; const float* lnb = a.in[I_LN1B] + l * 1024;
    const float* rw = a.in[I_RW] + (size_t)l * 1024 * 32; const float* rb = a.in[I_RB] + l * 32;
    constexpr int XT_LD = 1028, O_PART = 16 * XT_LD * 4, O_LG = O_PART + 8 * 32 * 16 * 4, O_HIST = O_LG + 16 * 33 * 4 + 64, O_CCNT = O_HIST + 256, O_TIL = O_CCNT + 2048, O_TWL = O_TIL + 4096;
    LAS float* XT = (LAS float*)lds; LAS float* PART = (LAS float*)(lds + O_PART); LAS float* LG = (LAS float*)(lds + O_LG);
    LAS int* hist = (LAS int*)(lds + O_HIST);
    LAS int* ccnt = (LAS int*)(lds + O_CCNT);
    LAS int* til = (LAS int*)(lds + O_TIL);
    LAS float* twl = (LAS float*)(lds + O_TWL);
    __syncthreads();
    if (tid < 32) hist[tid] = 0;
    bf16x8s whi[2][4], wlo[2][4];
    { const int e15 = lane & 15, kq = lane >> 4;
#pragma unroll
      for (int t = 0; t < 2; ++t)
#pragma unroll
          for (int sI = 0; sI < 4; ++sI) { float wv[8];
#pragma unroll
              for (int j = 0; j < 8; ++j) wv[j] = rw[(size_t)(128 * wave + 32 * sI + 8 * kq + j) * 32 + 16 * t + e15];
              v4u ph, pl;
#pragma unroll
              for (int j = 0; j < 4; ++j) { const unsigned p = pk2(wv[2 * j], wv[2 * j + 1]); const float h0 = __uint_as_float(p << 16), h1 = __uint_as_float(p & 0xffff0000u); ph[j] = p; pl[j] = pk2(wv[2 * j] - h0, wv[2 * j + 1] - h1); }
              whi[t][sI] = __builtin_bit_cast(bf16x8s, ph); wlo[t][sI] = __builtin_bit_cast(bf16x8s, pl); } }
    const int ngroups = RB / 16;
    f32x4 fP[4], fQ[4]; int fb = -1;
    const float rbias = rb[tid >> 4];
    v2u xr[2][4];
#define LN1_LOAD(g) do { _Pragma("unroll") for (int rr_ = 0; rr_ < 2; ++rr_) { const int lr_ = lr_base + 16 * (g) + 2 * wave + rr_; const size_t r_ = (size_t)grow_of(lr_ < NLAT ? lr_ : NLAT - 1); \
        _Pragma("unroll") for (int j_ = 0; j_ < 4; ++j_) xr[rr_][j_] = *(const v2u*)(PRE + r_ * 1024 + 4 * (lane + 64 * j_)); } } while (0)
#if defined(PROBE_LN1X2)
    for (int rep_ = 0; rep_ < 2; ++rep_) { __syncthreads(); if (tid < 32) hist[tid] = 0; __syncthreads();
#endif
    LN1_LOAD(0);
    for (int g = 0; g < ngroups; ++g) {
#pragma unroll
        for (int rr = 0; rr < 2; ++rr) {
            const int lr = lr_base + 16 * g + 2 * wave + rr; const bool ok = lr < NLAT; const size_t r = (size_t)grow_of(ok ? lr : NLAT - 1); const int b = (ok ? lr : NLAT - 1) >> 12;
            if (b != fb) { const float* mv = modv + (size_t)b * 6144; fb = b;
#pragma unroll
                for (int j = 0; j < 4; ++j) { const int c = 4 * (lane + 64 * j); const f32x4 gg = *(const f32x4*)(lng + c), bb = *(const f32x4*)(lnb + c), sh = *(const f32x4*)(mv + 3 * 1024 + c), sc = *(const f32x4*)(mv + 4 * 1024 + c);
                    fP[j] = gg * (sc + 1.0f); fQ[j] = bb * (sc + 1.0f) + sh; } }
            f32x4 x[4]; float s = 0.f;
#pragma unroll
            for (int j = 0; j < 4; ++j) { const v2u p = xr[rr][j]; x[j] = (f32x4){__uint_as_float(p.x << 16), __uint_as_float(p.x & 0xffff0000u), __uint_as_float(p.y << 16), __uint_as_float(p.y & 0xffff0000u)}; s += (x[j][0] + x[j][1]) + (x[j][2] + x[j][3]); }
            const float mean = wave_sum(s) * (1.f / 1024.f); float s2 = 0.f;
#pragma unroll
            for (int j = 0; j < 4; ++j) { x[j] = x[j] - mean; s2 += (x[j][0] * x[j][0] + x[j][1] * x[j][1]) + (x[j][2] * x[j][2] + x[j][3] * x[j][3]); }
            const float rstd = rsqrtf(wave_sum(s2) * (1.f / 1024.f) + LN_EPS);
#pragma unroll
            for (int j = 0; j < 4; ++j) { const int c = 4 * (lane + 64 * j);
                const f32x4 bm = (x[j] * rstd) * fP[j] + fQ[j];
                if (ok) *(unsigned*)((unsigned char*)XB + r * 1024 + c) = pack_fp8x4(bm[0] * SC_X8, bm[1] * SC_X8, bm[2] * SC_X8, bm[3] * SC_X8);
                *(LAS f32x4*)(XT + (2 * wave + rr) * XT_LD + c) = bm; }
        }
        if (g + 1 < ngroups) LN1_LOAD(g + 1);
        __syncthreads();
        { const int rr = lane & 15, kq = lane >> 4;
          f32x4 acc0 = {0.f, 0.f, 0.f, 0.f}, acc1 = {0.f, 0.f, 0.f, 0.f};
#pragma unroll
          for (int sI = 0; sI < 4; ++sI) { const LAS float* xp = XT + rr * XT_LD + 128 * wave + 32 * sI + 8 * kq; const f32x4 v0 = *(const LAS f32x4*)xp, v1 = *(const LAS f32x4*)(xp + 4);
              const float bv[8] = {v0[0], v0[1], v0[2], v0[3], v1[0], v1[1], v1[2], v1[3]}; v4u ph, pl;
#pragma unroll
              for (int j = 0; j < 4; ++j) { const unsigned p = pk2(bv[2 * j], bv[2 * j + 1]); const float h0 = __uint_as_float(p << 16), h1 = __uint_as_float(p & 0xffff0000u); ph[j] = p; pl[j] = pk2(bv[2 * j] - h0, bv[2 * j + 1] - h1); }
              const bf16x8s bh = __builtin_bit_cast(bf16x8s, ph), bl = __builtin_bit_cast(bf16x8s, pl);
              acc0 = __builtin_amdgcn_mfma_f32_16x16x32_bf16(whi[0][sI], bh, acc0, 0, 0, 0); acc0 = __builtin_amdgcn_mfma_f32_16x16x32_bf16(whi[0][sI], bl, acc0, 0, 0, 0); acc0 = __builtin_amdgcn_mfma_f32_16x16x32_bf16(wlo[0][sI], bh, acc0, 0, 0, 0);
              acc1 = __builtin_amdgcn_mfma_f32_16x16x32_bf16(whi[1][sI], bh, acc1, 0, 0, 0); acc1 = __builtin_amdgcn_mfma_f32_16x16x32_bf16(whi[1][sI], bl, acc1, 0, 0, 0); acc1 = __builtin_amdgcn_mfma_f32_16x16x32_bf16(wlo[1][sI], bh, acc1, 0, 0, 0); }
#pragma unroll
          for (int q = 0; q < 4; ++q) { PART[(wave * 32 + 4 * kq + q) * 16 + rr] = acc0[q]; PART[(wave * 32 + 16 + 4 * kq + q) * 16 + rr] = acc1[q]; } }
        __syncthreads();
        { const int e = tid >> 4, rr = tid & 15; float sacc = rbias;
#pragma unroll
          for (int w = 0; w < 8; ++w) sacc += PART[(w * 32 + e) * 16 + rr];
          LG[rr * 33 + e] = sacc; }
        __syncthreads();
        if (wave == (g & 7) && lane < 16) { const int lr = lr_base + 16 * g + lane;
            if (lr < NLAT) { float lg[32];
#pragma unroll
                for (int e = 0; e < 32; ++e) lg[e] = LG[lane * 33 + e];
                unsigned taken = 0u; float tv[4]; int ti[4];
#pragma unroll
                for (int kk = 0; kk < 4; ++kk) { float best = -3.0e38f; int bi = 0;
#pragma unroll
                    for (int e = 0; e < 32; ++e) { const bool okk = (lg[e] > best) && !((taken >> e) & 1u); best = okk ? lg[e] : best; bi = okk ? e : bi; }
                    taken |= 1u << bi; tv[kk] = best; ti[kk] = bi; }
                const float e1 = __expf(tv[1] - tv[0]), e2 = __expf(tv[2] - tv[0]), e3 = __expf(tv[3] - tv[0]); const float inv = 1.f / (1.f + e1 + e2 + e3);
                const int li = (16 * g + lane) * 4; til[li] = ti[0]; til[li + 1] = ti[1]; til[li + 2] = ti[2]; til[li + 3] = ti[3]; twl[li] = inv; twl[li + 1] = e1 * inv; twl[li + 2] = e2 * inv; twl[li + 3] = e3 * inv;
                __hip_atomic_fetch_add(hist + ti[0], 1, __ATOMIC_RELAXED, __HIP_MEMORY_SCOPE_WORKGROUP); __hip_atomic_fetch_add(hist + ti[1], 1, __ATOMIC_RELAXED, __HIP_MEMORY_SCOPE_WORKGROUP);
                __hip_atomic_fetch_add(hist + ti[2], 1, __ATOMIC_RELAXED, __HIP_MEMORY_SCOPE_WORKGROUP); __hip_atomic_fetch_add(hist + ti[3], 1, __ATOMIC_RELAXED, __HIP_MEMORY_SCOPE_WORKGROUP); } }
    }
#if defined(PROBE_LN1X2)
    }
#endif
#undef LN1_LOAD
    __syncthreads();
    int* cursor = (int*)(a.ws + WS_CURSOR) + l * 32;
    int* rows = (int*)(a.ws + WS_ROWS); float* roww = (float*)(a.ws + WS_ROWW); int* rowd = (int*)(a.ws + WS_ROWD);
    int nrows = NLAT - lr_base; nrows = nrows > RB ? RB : nrows; if (nrows < 0) nrows = 0;
    const int nas = nrows * 4, nchunks = (nas + 63) >> 6;
    int basev = 0; if (tid < 32) basev = (int)__hip_atomic_fetch_add((unsigned*)cursor + tid, (unsigned)hist[tid], __ATOMIC_RELAXED, __HIP_MEMORY_SCOPE_AGENT);
    int myrank[2] = {0, 0}, mye[2] = {-1, -1};
#pragma unroll
    for (int cc = 0; cc < 2; ++cc) { const int c = wave + 8 * cc; if (c < nchunks) { const int idx = c * 64 + lane; const int e = idx < nas ? til[idx] : -1; mye[cc] = e;
        for (int x = 0; x < 32; ++x) { const unsigned long long m = __ballot(e == x); if (e == x) myrank[cc] = __popcll(m & ((1ull << lane) - 1ull)); if (lane == 0) ccnt[c * 32 + x] = __popcll(m); } } }
    __syncthreads();
    if (tid < 32) hist[32 + tid] = basev;
    __syncthreads();
#pragma unroll
    for (int cc = 0; cc < 2; ++cc) { const int c = wave + 8 * cc; const int idx = c * 64 + lane; if (c < nchunks && idx < nas) { const int e = mye[cc]; int pos = hist[32 + e] + myrank[cc]; for (int c2 = 0; c2 < c; ++c2) pos += ccnt[c2 * 32 + e];
        const int lr = lr_base + (idx >> 2); const size_t pi = (size_t)e * ECAP + pos; rows[pi] = grow_of(lr); roww[pi] = twl[idx]; rowd[pi] = lr * 4 + (idx & 3); } }
}

__device__ __forceinline__ void phase_ln2(const Args& a, int l, int lane, int wave) {
    const int gw = blockIdx.x * NWAVES + wave, NGW = gridDim.x * NWAVES;
    float* H = (float*)(a.ws + WS_H); const bf16* PRE = (const bf16*)(a.ws + WS_PRE); const unsigned char* YB = (const unsigned char*)(a.ws + WS_YB); bf16* A1 = (bf16*)(a.ws + WS_Y);
    const float* modv = (const float*)(a.ws + WS_MODV);
    const float* ln1g = a.in[I_LN1G] + l * 1024; const float* ln1b = a.in[I_LN1B] + l * 1024;
    const float* lng = a.in[I_LN2G] + l * 1024; const float* lnb = a.in[I_LN2B] + l * 1024;
    f32x4 P1[4], Q1[4], G2[4], g2v[4], b2v[4], P3[4], Q3[4]; int fb = -1;
    const int rows_w = (((NLAT + NGW - 1) / NGW) + 1) & ~1, lr_lo = gw * rows_w, lr_hi = lr_lo + rows_w < NLAT ? lr_lo + rows_w : NLAT;
    for (int lr0 = lr_lo; lr0 < lr_hi; lr0 += 2) {
        v2u hv[2][4]; unsigned yv[2][4][4];
#pragma unroll
        for (int q = 0; q < 2; ++q) { const int lr = lr0 + q; const size_t r = (size_t)grow_of(lr);
#pragma unroll
            for (int j = 0; j < 4; ++j) { const int c = 4 * (lane + 64 * j); hv[q][j] = *(const v2u*)(PRE + r * 1024 + c);
#pragma unroll
                for (int k = 0; k < 4; ++k) yv[q][j][k] = *(const unsigned*)(YB + ((size_t)lr * 4 + k) * 1024 + c); } }
#pragma unroll
        for (int q = 0; q < 2; ++q) {
            const int lr = lr0 + q; const size_t r = (size_t)grow_of(lr); const int b = lr >> 12;
            if (b != fb) { fb = b; const float* mv = modv + ((size_t)l * 9 + b) * 6144; const float* mv1 = modv + ((size_t)9 + b) * 6144;
#pragma unroll
                for (int j = 0; j < 4; ++j) { const int c = 4 * (lane + 64 * j); const f32x4 g1 = *(const f32x4*)(ln1g + c), b1 = *(const f32x4*)(ln1b + c), gt = *(const f32x4*)(mv + 5 * 1024 + c);
                    P1[j] = g1 * ALPHA; Q1[j] = b1 * ALPHA; G2[j] = gt * (1.f / SC_Y); g2v[j] = *(const f32x4*)(lng + c); b2v[j] = *(const f32x4*)(lnb + c);
                    if (l == 0) { const f32x4 sh = *(const f32x4*)(mv1 + c), sc = *(const f32x4*)(mv1 + 1024 + c); P3[j] = g2v[j] * (sc + 1.0f) * SC_A1; Q3[j] = (b2v[j] * (sc + 1.0f) + sh) * SC_A1; } } }
            f32x4 x[4]; float s = 0.f;
#pragma unroll
            for (int j = 0; j < 4; ++j) { const v2u p = hv[q][j]; x[j] = (f32x4){__uint_as_float(p.x << 16), __uint_as_float(p.x & 0xffff0000u), __uint_as_float(p.y << 16), __uint_as_float(p.y & 0xffff0000u)}; s += (x[j][0] + x[j][1]) + (x[j][2] + x[j][3]); }
            float mean = wave_sum(s) * (1.f / 1024.f), s2 = 0.f;
#pragma unroll
            for (int j = 0; j < 4; ++j) { x[j] = x[j] - mean; s2 += (x[j][0] * x[j][0] + x[j][1] * x[j][1]) + (x[j][2] * x[j][2] + x[j][3] * x[j][3]); }
            float rstd = rsqrtf(wave_sum(s2) * (1.f / 1024.f) + LN_EPS);
            s = 0.f;
#pragma unroll
            for (int j = 0; j < 4; ++j) { f32x4 f = {0.f, 0.f, 0.f, 0.f};
#pragma unroll
                for (int k = 0; k < 4; ++k) { const unsigned y = yv[q][j][k]; const auto lo = __builtin_amdgcn_cvt_pk_f32_fp8((int)y, false), hi = __builtin_amdgcn_cvt_pk_f32_fp8((int)y, true);
                    f[0] += lo[0]; f[1] += lo[1]; f[2] += hi[0]; f[3] += hi[1]; }
                x[j] = (x[j] * rstd) * P1[j] + Q1[j] + G2[j] * f; s += (x[j][0] + x[j][1]) + (x[j][2] + x[j][3]); }
            mean = wave_sum(s) * (1.f / 1024.f); s2 = 0.f;
#pragma unroll
            for (int j = 0; j < 4; ++j) { x[j] = x[j] - mean; s2 += (x[j][0] * x[j][0] + x[j][1] * x[j][1]) + (x[j][2] * x[j][2] + x[j][3] * x[j][3]); }
            rstd = rsqrtf(wave_sum(s2) * (1.f / 1024.f) + LN_EPS);
#pragma unroll
            for (int j = 0; j < 4; ++j) { const int c = 4 * (lane + 64 * j); const f32x4 xh = x[j] * rstd;
                const f32x4 o = xh * g2v[j] + b2v[j];
                if (l == 0) { v2u hw; hw.x = pk2(o[0], o[1]); hw.y = pk2(o[2], o[3]); *(v2u*)((bf16*)H + r * 1024 + c) = hw;
                    const f32x4 am = xh * P3[j] + Q3[j]; *(unsigned*)((unsigned char*)A1 + r * 1024 + c) = pack_fp8x4(am[0], am[1], am[2], am[3]); }
                else *(f32x4*)(a.out + (size_t)lr * 1024 + c) = o; }
        }
    }
}

__device__ __forceinline__ void phase_conv(const Args& a, LAS unsigned char* lds, int tid, int lane, int wave) {
    const bf16* U = (const bf16*)(a.ws + WS_X); bf16* V = (bf16*)(a.ws + WS_Y);
    LAS float* part = (LAS float*)(lds + 126976);
    LAS float* st = part + 512;
    const int c0 = 2 * tid;
    const float db0 = a.in[I_DWB][c0], db1 = a.in[I_DWB][c0 + 1], g0 = a.in[I_CLNG][c0], g1 = a.in[I_CLNG][c0 + 1], be0 = a.in[I_CLNB][c0], be1 = a.in[I_CLNB][c0 + 1];
    for (int tile = blockIdx.x; tile < NLAT / 32; tile += gridDim.x) {
        const int b = tile >> 7, t0 = (tile & 127) * 32;
        const size_t rb0 = (size_t)b * TPB + CTXL;
        __syncthreads();
        for (int i = tid; i < 62 * 128; i += NTHR) { const int row = i >> 7, chk = i & 127, t = t0 - 15 + row;
            v4u val = {0u, 0u, 0u, 0u}; if (t >= 0 && t < SEQ) val = *(const v4u*)(U + (rb0 + t) * 1024 + chk * 8);
            *(LAS v4u*)(lds + row * 2048 + chk * 16) = val; }
        __syncthreads();
        float w0[31], w1[31];
#pragma unroll
        for (int j = 0; j < 31; ++j) { const float2 wv = *(const float2*)(a.in[I_DWW] + j * 1024 + c0); w0[j] = wv.x; w1[j] = wv.y; }
#pragma unroll 1
        for (int hh = 0; hh < 2; ++hh) {
            const LAS unsigned char* hp = lds + hh * 16 * 2048;
            float acc0[16], acc1[16];
#pragma unroll
            for (int t = 0; t < 16; ++t) { acc0[t] = db0; acc1[t] = db1; }
#pragma unroll
            for (int s = 0; s < 46; ++s) { const unsigned pr = *(const LAS unsigned*)(hp + s * 2048 + tid * 4); const float x0 = __uint_as_float(pr << 16), x1 = __uint_as_float(pr & 0xffff0000u);
#pragma unroll
                for (int t = (s > 30 ? s - 30 : 0); t <= (s < 15 ? s : 15); ++t) { acc0[t] = fmaf(x0, w0[s - t], acc0[t]); acc1[t] = fmaf(x1, w1[s - t], acc1[t]); } }
            float rs[32];
#pragma unroll
            for (int t = 0; t < 16; ++t) { rs[2 * t] = acc0[t] + acc1[t]; rs[2 * t + 1] = acc0[t] * acc0[t] + acc1[t] * acc1[t]; }
#define RS_STEP(NKEEP, XORV) { const bool bit_ = (lane & XORV) != 0; _Pragma("unroll") for (int k_ = 0; k_ < NKEEP; ++k_) { const float snd_ = bit_ ? rs[k_] : rs[k_ + NKEEP]; const float rcv_ = __shfl_xor(snd_, XORV); rs[k_] = (bit_ ? rs[k_ + NKEEP] : rs[k_]) + rcv_; } }
            RS_STEP(16, 32) RS_STEP(8, 16) RS_STEP(4, 8) RS_STEP(2, 4) RS_STEP(1, 2)
#undef RS_STEP
            rs[0] += __shfl_xor(rs[0], 1);
            __syncthreads();
            if ((lane & 1) == 0) part[wave * 32 + (lane >> 1)] = rs[0];
            __syncthreads();
            if (tid < 16) { float s1 = 0.f, s2 = 0.f;
#pragma unroll
                for (int w = 0; w < 8; ++w) { s1 += part[w * 32 + 2 * tid]; s2 += part[w * 32 + 2 * tid + 1]; }
                const float mean = s1 * (1.f / 1024.f); const float var = fmaxf(s2 * (1.f / 1024.f) - mean * mean, 0.f); st[2 * tid] = mean; st[2 * tid + 1] = rsqrtf(var + LN_EPS); }
            __syncthreads();
#pragma unroll
            for (int t = 0; t < 16; ++t) { const float mean = st[2 * t], rstd = st[2 * t + 1];
                const float y0 = (acc0[t] - mean) * rstd * g0 + be0, y1 = (acc1[t] - mean) * rstd * g1 + be1;
                const float z0 = fminf(fmaxf(y0 * sigm(y0) * SC_CV, -448.f), 448.f), z1 = fminf(fmaxf(y1 * sigm(y1) * SC_CV, -448.f), 448.f);
                *(unsigned short*)((unsigned char*)V + (rb0 + t0 + hh * 16 + t) * 1024 + c0) = (unsigned short)__builtin_amdgcn_cvt_pk_fp8_f32(z0, z1, 0, false); }
        }
    }
}

namespace hg {
using bf16x8 = __attribute__((ext_vector_type(8))) short;
using s16x4  = __attribute__((ext_vector_type(4))) short;
using f32x16 = __attribute__((ext_vector_type(16))) float;
using u32x4  = __attribute__((ext_vector_type(4))) unsigned;
constexpr int RS = 272;
constexpr int VS = 80;
constexpr int T_Q = 0, T_KO = 32 * RS, T_D = 64 * RS, IMG_BYTES = T_D + 512, T_V = IMG_BYTES, TILE_BYTES = T_V + 32 * VS;
constexpr int OFF_TILES = 1024, NTB = 3, OFF_OPART = OFF_TILES + NTB * TILE_BYTES, OPART_BYTES = 4 * 4096;
static_assert(OFF_OPART + 2 * OPART_BYTES <= 131072 && IMG_BYTES % 16 == 0 && IMG_BYTES / 16 == 1120, "hgrn lds");
constexpr int P_RAW = 1024, R_Q = 0, R_F = 32 * RS, RAW_BYTES = 64 * RS, P_IMG = P_RAW + RAW_BYTES;
constexpr int NCHUNK = TPB / 32, NCHAIN = NB * 4 * 2, NITEM = NCHAIN * NCHUNK;
__device__ __forceinline__ int crow(int r, int hi) { return (r & 3) + 8 * (r >> 2) + 4 * hi; }
__device__ __forceinline__ s16x4 tr_read(unsigned addr) { s16x4 r; asm volatile("ds_read_b64_tr_b16 %0, %1" : "=&v"(r) : "v"(addr) : "memory"); return r; }
__device__ __forceinline__ bf16x8 cat8(s16x4 l, s16x4 h) { return (bf16x8){l[0], l[1], l[2], l[3], h[0], h[1], h[2], h[3]}; }
__device__ __forceinline__ bf16x8 pack8(const f32x16& x, int base) {
    u32x4 w; w[0] = pk2(x[base + 0], x[base + 1]); w[1] = pk2(x[base + 2], x[base + 3]); w[2] = pk2(x[base + 4], x[base + 5]); w[3] = pk2(x[base + 6], x[base + 7]);
    return *reinterpret_cast<bf16x8*>(&w);
}
}


#define HG_TOKP(dir, n) ((dir) ? ((n) < CTXL ? (CTXL - 1 - (n)) : (TPB + CTXL - 1 - (n))) : (n))
#define HG_DPP1(x, ctrl, rmask) __int_as_float(__builtin_amdgcn_update_dpp(0x3f800000, __float_as_int(x), ctrl, rmask, 0xf, false))
#define HG_DPP(x, ctrl, rmask) __int_as_float(__builtin_amdgcn_update_dpp(0, __float_as_int(x), ctrl, rmask, 0xf, false))
__device__ __forceinline__ void hgrn_prep_items(const Args& a, LAS unsigned char* lds, int tid) {
    using namespace hg;
    const bf16* Z = (const bf16*)(a.ws + WS_Z);
    unsigned char* HT = a.ws + WS_HT;
    const int wave = __builtin_amdgcn_readfirstlane(tid >> 6), lane = tid & 63, t = lane & 31, half = lane >> 5;
    const int c0 = 16 * wave + 8 * half;
    const int lr = tid >> 4, lch = tid & 15;
    LAS float* lbt = (LAS float*)lds;
    constexpr int P_RAW2 = 2048, P_IMG2 = P_RAW2 + 2 * RAW_BYTES;
    static_assert(P_IMG2 + 2 * IMG_BYTES <= 131072, "prep lds");
    __syncthreads();
    { const float l0 = a.in[I_LBL][tid], l1 = a.in[I_LBL][512 + tid], l2 = a.in[I_LBL][1024 + tid]; const float m = fmaxf(l0, fmaxf(l1, l2));
      const float e0 = __expf(l0 - m), e1 = __expf(l1 - m), e2 = __expf(l2 - m); lbt[tid] = e0 / (e0 + e1 + e2); }
    bf16x8 gq, gf;
#define HP_LOAD(it) do { const int ch_ = (it) % NCHUNK, cn_ = (it) / NCHUNK, dir_ = cn_ & 1, hd_ = (cn_ >> 1) & 3, b_ = cn_ >> 3; \
        const bf16* zr_ = Z + ((size_t)b_ * TPB + HG_TOKP(dir_, 32 * ch_ + lr)) * ZC; gq = *(const bf16x8*)(zr_ + ZHQ + hd_ * 128 + lch * 8); gf = *(const bf16x8*)(zr_ + (dir_ ? ZHB : ZHF) + hd_ * 128 + lch * 8); } while (0)
#define HP_STASH(bufi) do { LAS unsigned char* rb_ = lds + P_RAW2 + (bufi) * RAW_BYTES; *(LAS bf16x8*)(rb_ + R_Q + lr * RS + lch * 16) = gq; *(LAS bf16x8*)(rb_ + R_F + lr * RS + lch * 16) = gf; } while (0)
#define HP_COPYOUT(item, bufi) do { v4u* dst_ = (v4u*)(HT + (size_t)(item) * IMG_BYTES); const LAS v4u* src_ = (const LAS v4u*)(lds + P_IMG2 + (bufi) * IMG_BYTES); \
        dst_[tid] = src_[tid]; dst_[tid + 512] = src_[tid + 512]; if (tid < 96) dst_[tid + 1024] = src_[tid + 1024]; } while (0)
    const int G = gridDim.x;
    int it = blockIdx.x, par = 0;
    if (it < NITEM) { HP_LOAD(it); HP_STASH(0); }
    if (it + G < NITEM) HP_LOAD(it + G);
    __syncthreads();
    for (; it < NITEM; it += G, par ^= 1) {
        if (it + G < NITEM) HP_STASH(par ^ 1);
        if (it != (int)blockIdx.x) HP_COPYOUT(it - G, par ^ 1);
        if (it + 2 * G < NITEM) HP_LOAD(it + 2 * G);
        const int hd = ((it / NCHUNK) >> 1) & 3;
        {
            const LAS unsigned char* rb_ = lds + P_RAW2 + par * RAW_BYTES;
            const bf16x8 RQ = *(const LAS bf16x8*)(rb_ + R_Q + t * RS + c0 * 2), RF = *(const LAS bf16x8*)(rb_ + R_F + t * RS + c0 * 2);
            const f32x4 lbA = *(const LAS f32x4*)(lbt + hd * 128 + c0), lbB = *(const LAS f32x4*)(lbt + hd * 128 + c0 + 4);
            LAS unsigned char* tb_ = lds + P_IMG2 + par * IMG_BYTES;
            float bb_[8], kk_[8];
#pragma unroll
            for (int i_ = 0; i_ < 8; ++i_) { const float lb_ = i_ < 4 ? lbA[i_] : lbB[i_ - 4]; const float f_ = lb_ + (1.f - lb_) * __builtin_amdgcn_rcpf(1.f + __expf(-bf2f((unsigned short)RF[i_]))); kk_[i_] = 1.f - f_; bb_[i_] = f_; }
#pragma unroll
            for (int i_ = 0; i_ < 8; ++i_) { float x_ = bb_[i_]; x_ *= HG_DPP1(x_, 0x111, 0xf); x_ *= HG_DPP1(x_, 0x112, 0xf); x_ *= HG_DPP1(x_, 0x114, 0xf); x_ *= HG_DPP1(x_, 0x118, 0xf);
                x_ *= HG_DPP1(x_, 0x142, 0xa); bb_[i_] = x_; }
            float qi_[8], ko_[8], dd_[8];
#pragma unroll
            for (int i_ = 0; i_ < 8; ++i_) { const int bi_ = __float_as_int(bb_[i_]); dd_[i_] = __int_as_float(half ? __builtin_amdgcn_readlane(bi_, 63) : __builtin_amdgcn_readlane(bi_, 31));
                const float e_ = bb_[i_]; const float ei_ = __builtin_amdgcn_rcpf(e_);
                qi_[i_] = bf2f((unsigned short)RQ[i_]) * e_; ko_[i_] = kk_[i_] * ei_; }
            *(LAS v4u*)(tb_ + T_Q + t * RS + c0 * 2) = (v4u){pk2(qi_[0], qi_[1]), pk2(qi_[2], qi_[3]), pk2(qi_[4], qi_[5]), pk2(qi_[6], qi_[7])};
            *(LAS v4u*)(tb_ + T_KO + t * RS + c0 * 2) = (v4u){pk2(ko_[0], ko_[1]), pk2(ko_[2], ko_[3]), pk2(ko_[4], ko_[5]), pk2(ko_[6], ko_[7])};
            if (t == 31) { *(LAS f32x4*)(tb_ + T_D + c0 * 4) = (f32x4){dd_[0], dd_[1], dd_[2], dd_[3]}; *(LAS f32x4*)(tb_ + T_D + c0 * 4 + 16) = (f32x4){dd_[4], dd_[5], dd_[6], dd_[7]}; }
            if (tid < 32) *(LAS v4u*)(tb_ + T_Q + tid * RS + 256) = (v4u){0u, 0u, 0u, 0u};
            else if (tid < 64) *(LAS v4u*)(tb_ + T_KO + (tid - 32) * RS + 256) = (v4u){0u, 0u, 0u, 0u};
        }
        __syncthreads();
    }
    if (it - G >= (int)blockIdx.x && it - G < NITEM) HP_COPYOUT(it - G, par ^ 1);
    __syncthreads();
#undef HP_COPYOUT
#undef HP_LOAD
#undef HP_STASH
}

__device__ __forceinline__ void hgrn_unit_mfma(const Args& a, int unit, LAS unsigned char* lds, int tid) {
    using namespace hg;
    const int b = unit >> 5, head = (unit >> 3) & 3, dir = (unit >> 2) & 1, sl = unit & 3;
    const bf16* Z = (const bf16*)(a.ws + WS_Z);
    const unsigned char* HT = a.ws + WS_HT + (size_t)((b * 4 + head) * 2 + dir) * NCHUNK * IMG_BYTES;
    bf16* Od = (bf16*)(a.ws + (dir ? WS_OB : WS_OF));
    const int wave = __builtin_amdgcn_readfirstlane(tid >> 6), lane = tid & 63;
    const size_t zb = (size_t)b * TPB;
    constexpr int NCH = NCHUNK;
    const int vr = (tid >> 2) & 31, vp = tid & 3, lvcol = ZHI + head * 128 + sl * 32 + vp * 8, i3 = 1024 + (tid < 96 ? tid : 0);
    v4u gA0, gA1, gA2, gB0, gB1, gB2; bf16x8 gAv, gBv;
#define HG_LOAD(g0, g1, g2, gv, ch) do { const int c_ = (ch) < NCH ? (ch) : NCH - 1; const v4u* src_ = (const v4u*)(HT + (size_t)c_ * IMG_BYTES); \
        g0 = src_[tid]; g1 = src_[tid + 512]; g2 = src_[i3]; gv = *(const bf16x8*)(Z + (zb + HG_TOKP(dir, 32 * c_ + vr)) * ZC + lvcol); } while (0)
#define HG_STASH(g0, g1, g2, gv, bufi) do { LAS unsigned char* tb_ = lds + OFF_TILES + (bufi) * TILE_BYTES; LAS v4u* d_ = (LAS v4u*)tb_; \
        d_[tid] = g0; d_[tid + 512] = g1; if (tid < 96) d_[tid + 1024] = g2; if (tid < 128) *(LAS bf16x8*)(tb_ + T_V + vr * VS + vp * 16) = gv; } while (0)
    const int r32 = lane & 31, hi = lane >> 5, g1 = (lane >> 4) & 1, q4 = (lane & 15) >> 2, p4 = lane & 3, cb = 32 * wave;
    const unsigned lbase = (unsigned)(uintptr_t)lds;
    f32x16 S = {};
    HG_LOAD(gA0, gA1, gA2, gAv, 0); HG_STASH(gA0, gA1, gA2, gAv, 0); HG_LOAD(gA0, gA1, gA2, gAv, 1); HG_STASH(gA0, gA1, gA2, gAv, 1);
    HG_LOAD(gA0, gA1, gA2, gAv, 2);
    __syncthreads();
#define HG_RD64(dst, addr, OFFS) asm volatile("ds_read_b64 %0, %1 offset:" #OFFS : "=&v"(dst) : "v"(addr) : "memory")
#define HG_MFMA_STAGE(n, bufi) do { \
            const unsigned tb = lbase + OFF_TILES + (bufi) * TILE_BYTES; const LAS unsigned char* tl_ = lds + OFF_TILES + (bufi) * TILE_BYTES; \
            bf16x8 ko[2], qi[2]; s16x4 pvl[2], pvh[2], pql[2], pqh[2], kl[2], kh[2], nvl[2], nvh[2]; f32x4 dsc[4]; \
            _Pragma("unroll") for (int kk = 0; kk < 2; ++kk) { ko[kk] = *(const LAS bf16x8*)(tl_ + T_KO + r32 * RS + (cb + 16 * kk + 8 * hi) * 2); qi[kk] = *(const LAS bf16x8*)(tl_ + T_Q + r32 * RS + (cb + 16 * kk + 8 * hi) * 2); } \
            _Pragma("unroll") for (int sp = 0; sp < 2; ++sp) { \
                const unsigned va = tb + T_V + (16 * sp + 4 * hi + q4) * VS + (16 * g1 + 4 * p4) * 2; pvl[sp] = tr_read(va); pvh[sp] = tr_read(va + 8 * VS);              \
                const unsigned qa = tb + T_Q + r32 * RS + (cb + 16 * sp + 4 * hi) * 2; HG_RD64(pql[sp], qa, 0); HG_RD64(pqh[sp], qa, 16);                                  \
                const unsigned ka = tb + T_KO + (16 * sp + 8 * hi + q4) * RS + (cb + 16 * g1 + 4 * p4) * 2; kl[sp] = tr_read(ka); kh[sp] = tr_read(ka + 4 * RS);        \
                const unsigned vb = tb + T_V + (16 * sp + 8 * hi + q4) * VS + (16 * g1 + 4 * p4) * 2; nvl[sp] = tr_read(vb); nvh[sp] = tr_read(vb + 4 * VS); }            \
            _Pragma("unroll") for (int g = 0; g < 4; ++g) dsc[g] = *(const LAS f32x4*)(tl_ + T_D + (cb + 8 * g + 4 * hi) * 4); \
            asm volatile("s_waitcnt lgkmcnt(0)" ::: "memory"); __builtin_amdgcn_sched_barrier(0); \
            f32x16 X = {}; \
            X = __builtin_amdgcn_mfma_f32_32x32x16_bf16(ko[0], qi[0], X, 0, 0, 0); X = __builtin_amdgcn_mfma_f32_32x32x16_bf16(ko[1], qi[1], X, 0, 0, 0); \
            f32x16 O = {}; \
            O = __builtin_amdgcn_mfma_f32_32x32x16_bf16(cat8(pql[0], pqh[0]), pack8(S, 0), O, 0, 0, 0); O = __builtin_amdgcn_mfma_f32_32x32x16_bf16(cat8(pql[1], pqh[1]), pack8(S, 8), O, 0, 0, 0); \
            S = __builtin_amdgcn_mfma_f32_32x32x16_bf16(cat8(kl[0], kh[0]), cat8(nvl[0], nvh[0]), S, 0, 0, 0); S = __builtin_amdgcn_mfma_f32_32x32x16_bf16(cat8(kl[1], kh[1]), cat8(nvl[1], nvh[1]), S, 0, 0, 0); \
            _Pragma("unroll") for (int i = 0; i < 16; ++i) X[i] = (crow(i, hi) <= r32) ? X[i] : 0.f; \
            O = __builtin_amdgcn_mfma_f32_32x32x16_bf16(pack8(X, 0), cat8(pvl[0], pvh[0]), O, 0, 0, 0); O = __builtin_amdgcn_mfma_f32_32x32x16_bf16(pack8(X, 8), cat8(pvl[1], pvh[1]), O, 0, 0, 0); \
            _Pragma("unroll") for (int i = 0; i < 16; ++i) S[i] *= dsc[i >> 2][i & 3]; \
            LAS float* op = (LAS float*)(lds + OFF_OPART + ((n) & 1) * OPART_BYTES + wave * 4096); \
            _Pragma("unroll") for (int i = 0; i < 16; ++i) op[crow(i, hi) * 32 + r32] = O[i]; } while (0)
#define HG_OUT_STAGE(n) do { \
            const int l2 = tid - 256, tt = l2 >> 3, vq = l2 & 7; \
            const LAS float* op = (const LAS float*)(lds + OFF_OPART + (((n) - 1) & 1) * OPART_BYTES) + tt * 32 + vq * 4; \
            const f32x4 s = (*(const LAS f32x4*)op + *(const LAS f32x4*)(op + 1024)) + (*(const LAS f32x4*)(op + 2048) + *(const LAS f32x4*)(op + 3072)); \
            const int p = HG_TOKP(dir, 32 * ((n) - 1) + tt); \
            if (p >= CTXL) *(v2u*)(Od + (zb + p) * 512 + head * 128 + sl * 32 + vq * 4) = (v2u){pk2(s[0], s[1]), pk2(s[2], s[3])}; } while (0)
#define HG_ITER(n, L0, L1, L2, LV, S0, S1, S2, SV) do { \
        HG_LOAD(L0, L1, L2, LV, (n) + 3); \
        if (wave < 4) { HG_MFMA_STAGE(n, bcur); } else if ((n) > 0) { HG_OUT_STAGE(n); } \
        { const int bst_ = bcur == 0 ? 2 : bcur - 1; HG_STASH(S0, S1, S2, SV, bst_); } \
        bcur = bcur == 2 ? 0 : bcur + 1; \
        __syncthreads(); } while (0)
    int bcur = 0;
    for (int n = 0; n < NCH; n += 2) {
        HG_ITER(n, gB0, gB1, gB2, gBv, gA0, gA1, gA2, gAv);
        HG_ITER(n + 1, gA0, gA1, gA2, gAv, gB0, gB1, gB2, gBv);
    }
    if (wave >= 4) { HG_OUT_STAGE(NCH); }
    __syncthreads();
#undef HG_MFMA_STAGE
#undef HG_OUT_STAGE
#undef HG_ITER
#undef HG_LOAD
#undef HG_STASH
#undef HG_RD64
}

__device__ __forceinline__ bool in_range(int lo, int hi, int k) { asm volatile("" : "+s"(lo), "+s"(hi)); return lo <= k && k < hi; }
constexpr int NPHASES = 21;
__global__ void __launch_bounds__(NTHR, 2) fwd_kernel(Args args) {
    extern __shared__ __attribute__((aligned(16))) unsigned char lds_raw[];
    LAS unsigned char* lds = (LAS unsigned char*)lds_raw;
    const int G = gridDim.x;
#define FRESH() int tid = threadIdx.x; asm volatile("" : "+v"(tid)); const int lane = tid & 63, wave = __builtin_amdgcn_readfirstlane(tid >> 6); (void)lane; (void)wave
    unsigned char* ws = args.ws;
    if (threadIdx.x < 16) ((LAS unsigned*)(lds + LDS_BAR_OFF))[threadIdx.x] = 0u;
    __syncthreads();
    XcdBarrier bar = xcd_barrier_post((unsigned*)(ws + WS_CTL), (volatile LAS unsigned*)(lds + LDS_BAR_OFF));
    const int lo = args.ph_lo, hi = args.ph_hi;
#define IN(k) in_range(lo, hi, (k))
#define NREP(k) (((PROBE_MASK >> (k)) & 1u) ? 2 : 1)
#define REPEAT(k) for (int rep_ = 0; rep_ < NREP(k); ++rep_) if (rep_ == 0 || (xcd_barrier(bar), true))
#define SEAM(k) do { if (IN(k) && IN((k) + 1)) xcd_barrier(bar); } while (0)
    bf16* const BX = (bf16*)(ws + WS_X); bf16* const BY = (bf16*)(ws + WS_Y);
    const float* const MODV = (const float*)(ws + WS_MODV);

#if defined(PROBE_BARS)
    for (int pbi = 0; pbi < PROBE_BARS; ++pbi) xcd_barrier(bar);
#endif
    if (IN(0)) REPEAT(0) { FRESH(); phase_prologue(args, lds, tid, lane, wave); } SEAM(0);
    if (IN(1)) REPEAT(1) { FRESH(); phase_mod0(args, lane, wave); } SEAM(1);
    if (IN(2)) REPEAT(2) {
        pg8::Gemm g{BX, (const bf16*)(ws + WS_WIN), NTOK, ZC, 512}; pg8::AllOrder S; S.init(NTOK / 256, ZC / 256, G, (int)blockIdx.x);
        pg8::EpiBf16<0> E{(bf16*)(ws + WS_Z), ZC, nullptr, ZC, 0, 1.f / (SC_A0 * SC_WIN)};
        pg8::gemm_phase<pg8::EpiBf16<0>, pg8::AllOrder, PG8_ALIGN, true, false, true>(lds, g, S, E);
    } SEAM(2);
    if (IN(3)) REPEAT(3) { FRESH(); phase_norm0(args, lane, wave); hgrn_prep_items(args, lds, tid); } SEAM(3);
    if (IN(4)) REPEAT(4) {
        { pg8::Gemm g{(const bf16*)(ws + WS_CQN), (const bf16*)(ws + WS_WUQ), NTOK, 768, 384}; pg8::LatOrder S; S.init(128, 3, G, (int)blockIdx.x);
          pg8::EpiBf16<0> E{(bf16*)(ws + WS_Q), 768, nullptr, 0, 0, 1.f};
          pg8::gemm_phase<pg8::EpiBf16<0>, pg8::LatOrder, PG8_ALIGN, PG8_SP2>(lds, g, S, E); }
        __syncthreads();
        { pg8::Gemm g{(const bf16*)(ws + WS_CKVN), (const bf16*)(ws + WS_WUKV), NTOK, 1024, 256}; pg8::AllOrder S; S.init(NTOK / 256, 4, G, G - 1 - (int)blockIdx.x);
          pg8::EpiBf16<0> E{(bf16*)(ws + WS_KV), 1024, nullptr, 0, 0, 1.f};
          pg8::gemm_phase<pg8::EpiBf16<0>, pg8::AllOrder, PG8_ALIGN, PG8_SP2>(lds, g, S, E); }
    } SEAM(4);
    if (IN(5)) {
        REPEAT(21) { FRESH();
        for (int u = blockIdx.x; u < 256; u += G) { __syncthreads(); hgrn_unit_mfma(args, (G == 256) ? ((u & 7) * 32 + (u >> 3)) : u, lds, tid); } }
        const bf16* Q = (const bf16*)(ws + WS_Q); const bf16* KV = (const bf16*)(ws + WS_KV); const bf16* KRR = (const bf16*)(ws + WS_KRR);
        const float* rope = (const float*)(ws + WS_ROPE);
        const int cslot = (G == 256) ? ((((int)blockIdx.x & 7) * 2 + (((int)blockIdx.x >> 3) >> 4)) % 5) : 0;
        REPEAT(22) {
        int ai = 0;
        for (int slot = 0; slot < 5; ++slot) {
            if (slot == cslot) { if (rep_ == 0) { FRESH(); __syncthreads(); convert_moe_share(args, lds, lane, wave); } continue; }
            for (int u = (G == 256) ? (int)blockIdx.x + ai * 256 : (int)blockIdx.x; u < ((G == 256) ? (int)blockIdx.x + ai * 256 + 1 : (ai == 0 ? 1024 : 0)); u += G) {
                int b, h, qb; if (G == 256) { const int x = (int)blockIdx.x & 7, j = (int)blockIdx.x >> 3, pr = (u >> 8) * 16 + 2 * x + (j >> 4); b = pr >> 3; h = pr & 7; qb = j & 15; } else { b = u >> 7; h = (u >> 4) & 7; qb = u & 15; }
                const size_t kb = (size_t)b * TPB, q0 = kb + CTXL + (size_t)qb * 256;
                __syncthreads();
                att::attn_unit(Q + q0 * 768 + h * 96, KV + kb * 1024 + h * 64, KRR + kb * 32, BY + q0 * 1024 + h * 64, rope + (size_t)qb * 256 * 32, TPB, (char*)lds_raw);
            }
            ++ai;
        }
        }
    } SEAM(5);
    if (IN(6)) REPEAT(6) { FRESH(); phase_readout(args, lane, wave); } SEAM(6);
    if (IN(7)) REPEAT(7) {
        pg8::Gemm g{BY, (const bf16*)(ws + WS_WOUT), NTOK, 1024, 1024}; pg8::LatOrder S; S.init(128, 4, G, (int)blockIdx.x);
        pg8::EpiRes<false> E{args.in[I_X], nullptr, (bf16*)(ws + WS_PRE), MODV, nullptr, 1.f};
        pg8::gemm_phase<pg8::EpiRes<false>, pg8::LatOrder, PG8_ALIGN, PG8_SP2>(lds, g, S, E);
    } SEAM(7);
    for (int l = 0; l < 2; ++l) {
        if (l == 1) {
            if (IN(13)) REPEAT(13) {
                pg8::Gemm g{BY, (const bf16*)(ws + WS_WPW1), NTOK, 2048, 512}; pg8::LatOrder S; S.init(128, 8, G, (int)blockIdx.x);
                pg8::EpiGate<0> E{BX, (const float*)(ws + WS_PW1B), 8, 1.f / (SC_A1 * SC_WPW), 1.f, lds};
                pg8::gemm_phase<pg8::EpiGate<0>, pg8::LatOrder, PG8_ALIGN, true, false, true>(lds, g, S, E);
            } SEAM(13);
            if (IN(14)) REPEAT(14) { FRESH(); phase_conv(args, lds, tid, lane, wave); } SEAM(14);
            if (IN(15)) REPEAT(15) {
                pg8::Gemm g{BY, (const bf16*)(ws + WS_WPW2), NTOK, 1024, 512}; pg8::LatOrder S; S.init(128, 4, G, (int)blockIdx.x);
                pg8::EpiRes<true> E{nullptr, (const bf16*)(ws + WS_H), (bf16*)(ws + WS_PRE), MODV + 9 * 6144, args.in[I_PW2B], 1.f / (SC_CV * SC_WPW)};
                pg8::gemm_phase<pg8::EpiRes<true>, pg8::LatOrder, PG8_ALIGN, true, false, true>(lds, g, S, E);
            } SEAM(15);
        }
        const int pb = l ? 16 : 8;
        if (IN(pb)) REPEAT(pb) { FRESH(); phase_ln1(args, l, lds, tid, lane, wave); } SEAM(pb);
        if (IN(pb + 2) || IN(pb + 3)) {
            LAS int* tl = (LAS int*)(lds + LDS_TILE_E);
            FRESH();
            __syncthreads();
            if (tid < 32) tl[3 * MAXTILES + 64 + tid] = ld_ctl((const int*)(ws + WS_CURSOR) + l * 32 + tid);
            __syncthreads();
            if (tid == 0) { int ts = 0; for (int e = 0; e < 32; ++e) { tl[3 * MAXTILES + e] = ts; ts += (tl[3 * MAXTILES + 64 + e] + 255) >> 8; } tl[3 * MAXTILES + 32] = ts; }
            __syncthreads();
            const int ntiles = tl[3 * MAXTILES + 32];
            for (int t = tid; t < ntiles && t < MAXTILES; t += NTHR) { int e = 0; while (e < 31 && tl[3 * MAXTILES + e + 1] <= t) ++e; const int j = t - tl[3 * MAXTILES + e], rem = tl[3 * MAXTILES + 64 + e] - 256 * j;
                tl[t] = e; tl[MAXTILES + t] = e * ECAP + 256 * j; tl[2 * MAXTILES + t] = rem < 256 ? rem : 256; }
            __syncthreads();
            if (IN(pb + 2)) REPEAT(pb + 2) {
#if defined(PROBE_STAGGER)
                if (blockIdx.x & 1) { const unsigned long long t0 = __builtin_amdgcn_s_memrealtime(); while (__builtin_amdgcn_s_memrealtime() - t0 < PROBE_STAGGER) __builtin_amdgcn_s_sleep(8); }
#endif
                pg8::Gemm g{BX, (const bf16*)(ws + WS_WGU + (size_t)l * 32 * 2048 * 1024), 0, 0, 512};
                pg8::MoeOrder S; S.init(ntiles, 8, G, (int)blockIdx.x); S.tile_e = tl; S.nper = 8;
                pg8::EpiGate<1, true> E{(bf16*)(ws + WS_ACT), (const float*)(ws + WS_BGU) + (size_t)l * 32 * 2048, 8, 1.f / (SC_X8 * SC_WGU) * PROBE_KSC, SC_ACT, lds};
                pg8::gemm_phase<pg8::EpiGate<1, true>, pg8::MoeOrder, PG8_ALIGN, true, true, true>(lds, g, S, E, (const int*)(ws + WS_ROWS), tl + MAXTILES);
            } SEAM(pb + 2);
            if (IN(pb + 3)) REPEAT(pb + 3) {
                pg8::Gemm g{(const bf16*)(ws + WS_ACT), (const bf16*)(ws + WS_WDN + (size_t)l * 32 * 1024 * 1024), 0, 0, 512};
                pg8::MoeOrder S; S.init(ntiles, 4, G, (int)blockIdx.x); S.tile_e = tl; S.nper = 4;
                pg8::EpiDown E{(bf16*)(ws + WS_YB), args.in[I_BDN] + (size_t)l * 32 * 1024, (const float*)(ws + WS_ROWW), (const int*)(ws + WS_ROWD), 1.f / (SC_ACT * SC_WDN) * PROBE_KSC, tl + MAXTILES, SC_Y, lds};
                pg8::gemm_phase<pg8::EpiDown, pg8::MoeOrder, PG8_ALIGN, true, false, true>(lds, g, S, E);
            } SEAM(pb + 3);
        }
        if (IN(pb + 4)) REPEAT(pb + 4) { FRESH(); phase_ln2(args, l, lane, wave); }
        if (l == 0) SEAM(12);
    }
#undef IN
#undef SEAM
}

extern "C" void kernel_launch(void* const* d_in, const int* in_sizes, int n_in, void* d_out, int out_size, void* d_ws, size_t ws_size, hipStream_t stream) {
    static int grid = 0;
    if (grid == 0) {
        if (n_in != 33 || in_sizes[0] != NB * SEQ * D || out_size != NB * SEQ * D || ws_size < WS_END) {
            fprintf(stderr, "kernel_launch: unexpected shapes: n_in %d in0 %d out %d ws %zu (need %zu)\n", n_in, n_in > 0 ? in_sizes[0] : -1, out_size, ws_size, (size_t)WS_END); grid = -1; return; }
        int dev = 0, cus = 0;
        if (hipGetDevice(&dev) != hipSuccess || hipDeviceGetAttribute(&cus, hipDeviceAttributeMultiprocessorCount, dev) != hipSuccess) { grid = -1; return; }
        if (hipFuncSetAttribute((const void*)fwd_kernel, hipFuncAttributeMaxDynamicSharedMemorySize, LDS_BYTES) != hipSuccess) { fprintf(stderr, "kernel_launch: hipFuncSetAttribute failed\n"); grid = -1; return; }
        int per_cu = 0;
        if (hipOccupancyMaxActiveBlocksPerMultiprocessor(&per_cu, (const void*)fwd_kernel, NTHR, LDS_BYTES) != hipSuccess || per_cu < 1) fprintf(stderr, "kernel_launch: occupancy query reports %d\n", per_cu);
        (void)hipGetLastError();
        grid = cus;
    }
    if (grid < 0) return;
    if (hipMemsetAsync((char*)d_ws + WS_CTL, 0, CTL_ZERO_BYTES, stream) != hipSuccess) return;
    Args a{};
    for (int i = 0; i < 33; ++i) a.in[i] = (const float*)d_in[i];
    a.out = (float*)d_out; a.ws = (unsigned char*)d_ws;
#if MK_ONE_LAUNCH
    a.ph_lo = 0; a.ph_hi = NPHASES;
    hipLaunchKernelGGL(fwd_kernel, dim3(grid), dim3(NTHR), LDS_BYTES, stream, a);
#else
    for (int ph = 0; ph < NPHASES; ++ph) { a.ph_lo = ph; a.ph_hi = ph + 1; hipLaunchKernelGGL(fwd_kernel, dim3(grid), dim3(NTHR), LDS_BYTES, stream, a); }
#endif
    const hipError_t le = hipPeekAtLastError();
    if (le != hipSuccess) fprintf(stderr, "kernel_launch: launch failed: %s\n", hipGetErrorName(le));
}
```

```cpp
#include <hip/hip_runtime.h>
#include <cstdio>
#include <cstdint>

#ifndef PROBE_MASK
#define PROBE_MASK 0u
#endif
#if defined(PROBE_K2)
#define PROBE_KSC 0.5f
#else
#define PROBE_KSC 1.0f
#endif
#ifndef MK_ONE_LAUNCH
#define MK_ONE_LAUNCH 1
#endif

namespace pg8 {
#define PG8_LAS __attribute__((address_space(3)))
typedef unsigned short bf16_t;
typedef short bf16x8 __attribute__((ext_vector_type(8)));
typedef float f32x4 __attribute__((ext_vector_type(4)));
typedef unsigned u32x4 __attribute__((ext_vector_type(4)));
constexpr int BM = 256, BK = 64, HALF = 128, HTB = HALF * BK * 2  , STAGE_BYTES = 8 * HTB, NXCD = 8, WGM = 8;

__host__ __device__ __forceinline__ int lds_byte(int r, int c) { const int st = (r >> 4) * 2 + (c >> 5), rr = r & 15, cc = c & 31, ob = rr * 64 + cc * 2; return st * 1024 + (ob ^ (((ob >> 9) & 1) << 5)); }
__host__ __device__ __forceinline__ void stage_rc(int b, int& R, int& C) { const int st = b / 1024, sb = b % 1024, swz = sb ^ (((sb >> 9) & 1) << 5); R = (st >> 1) * 16 + swz / 64; C = (st & 1) * 32 + (swz % 64) / 2; }
__host__ __device__ __forceinline__ int perm32(int rho) { const int n = rho >> 4, i = rho & 15; return 8 * (i >> 2) + 4 * n + (i & 3); }

struct Unit { int pm, pn; };
struct Gemm { const bf16_t* A; const bf16_t* Bt; int M, N, K; };

struct StaticOrder {
    int nM, nN, nwg, G, c;
    __host__ __device__ void init(int M, int N, int G_, int c_) { nM = M / BM; nN = N / BM; nwg = nM * nN; G = G_; c = c_; }
    __host__ __device__ bool next(int i, Unit& u) const {
        const long L = (long)i * G + c; if (L >= nwg) return false;
        int wgid = (int)L; { const int q = nwg / NXCD, r = nwg % NXCD, xcd = wgid % NXCD, off = wgid / NXCD; wgid = (xcd < r ? xcd * (q + 1) : r * (q + 1) + (xcd - r) * q) + off; }
        const int nig = WGM * nN, gid = wgid / nig, fm = gid * WGM, gsz = (nM - fm) < WGM ? (nM - fm) : WGM;
        u.pm = fm + ((wgid % nig) % gsz); u.pn = (wgid % nig) / gsz; return true;
    }
    __device__ __forceinline__ void a_ready(const Unit&) const {}
    __device__ __forceinline__ void done(const Unit&) const {}
};

__device__ __forceinline__ unsigned cvt_pk_bf16(float lo, float hi) { unsigned r; asm volatile("v_cvt_pk_bf16_f32 %0, %1, %2" : "=v"(r) : "v"(lo), "v"(hi)); return r; }
typedef float f32x2 __attribute__((ext_vector_type(2)));
__device__ __forceinline__ f32x2 gelu_pk(f32x2 v) {
    const f32x2 av = __builtin_elementwise_abs(v), d = av * 0.2316418882f + 1.0f;
    f32x2 t; t.x = __builtin_amdgcn_rcpf(d.x); t.y = __builtin_amdgcn_rcpf(d.y);
    f32x2 q = t * 0.5307027145f + (-0.7265760135f); q = q * t + 0.7107068705f; q = q * t + (-0.142248368f); q = q * t + 0.127414796f; q = q * t;
    const f32x2 s = (v * v) * (-0.72134752044f);
    f32x2 e; e.x = __builtin_amdgcn_exp2f(s.x); e.y = __builtin_amdgcn_exp2f(s.y);
    const f32x2 m = v * (q * e), r = v - m;
    f32x2 o; o.x = v.x < 0.f ? m.x : r.x; o.y = v.y < 0.f ? m.y : r.y; return o;
}

template <int ACT  > struct EpiBf16 {
    static constexpr bool PERM = true, AFTER_DRAIN = false, PREFETCH = false; static_assert(ACT == 0 || ACT == 1, "EpiBf16: ACT is 0 (none) or 1 (gelu_pk)");
    bf16_t* O; int ldc; const float* bias; int split_cols; size_t split_stride; float scale0;
    __device__ __forceinline__ void operator()(const f32x4 (&acc)[2][2][4][2], const Unit& u, int wr, int wc, int fr, int fq) const {
        const int row0 = u.pm * BM + wr * 64 + fr; int colt = u.pn * BM; bf16_t* base = O;
        float sc = 1.f; if (split_cols) { const int t = colt / split_cols; base += (size_t)t * split_stride; colt -= t * split_cols; if (t == 0) sc = scale0; }
        const int col0 = colt + wc * 32 + 8 * fq, bcol0 = u.pn * BM + wc * 32 + 8 * fq;
        f32x4 bv[2][2];
#pragma unroll
        for (int bj = 0; bj < 2; ++bj)
#pragma unroll
            for (int n = 0; n < 2; ++n) bv[bj][n] = bias ? *(const f32x4*)(bias + bcol0 + bj * HALF + 4 * n) : (f32x4){0.f, 0.f, 0.f, 0.f};
#pragma unroll
        for (int ai = 0; ai < 2; ++ai)
#pragma unroll
            for (int m = 0; m < 4; ++m) { bf16_t* rowp = base + (size_t)(row0 + ai * HALF + m * 16) * ldc + col0;
#pragma unroll
                for (int bj = 0; bj < 2; ++bj) { f32x4 v0 = acc[ai][bj][m][0] + bv[bj][0], v1 = acc[ai][bj][m][1] + bv[bj][1];
                    if (ACT == 1) { f32x2 a = gelu_pk((f32x2){v0[0], v0[1]}), b = gelu_pk((f32x2){v0[2], v0[3]}), c = gelu_pk((f32x2){v1[0], v1[1]}), d = gelu_pk((f32x2){v1[2], v1[3]});
                        v0 = (f32x4){a.x, a.y, b.x, b.y}; v1 = (f32x4){c.x, c.y, d.x, d.y}; }
                    v0 = v0 * sc; v1 = v1 * sc; u32x4 w; w.x = cvt_pk_bf16(v0[0], v0[1]); w.y = cvt_pk_bf16(v0[2], v0[3]); w.z = cvt_pk_bf16(v1[0], v1[1]); w.w = cvt_pk_bf16(v1[2], v1[3]);
                    *(u32x4*)(rowp + bj * HALF) = w; } }
    }
};
typedef int v4i_t __attribute__((ext_vector_type(4)));
typedef int v8i_t __attribute__((ext_vector_type(8)));
__device__ __forceinline__ v8i_t cat32(bf16x8 a, bf16x8 b) { const v4i_t x = __builtin_bit_cast(v4i_t, a), y = __builtin_bit_cast(v4i_t, b); return __builtin_shufflevector(x, y, 0, 1, 2, 3, 4, 5, 6, 7); }
template <class Epi, class Sched, bool ALIGN_EPI = false, bool SP2 = false, bool GATHER = false, bool FP8 = false>
__device__ __forceinline__ void gemm_phase(PG8_LAS unsigned char* lds, const Gemm g, const Sched& S, const Epi& E, const int* rowsrc = nullptr, const PG8_LAS int* gtab = nullptr) {
    static_assert(!GATHER || SP2, "GATHER is implemented on the SP2 loop only");
    int tid_l = threadIdx.x; asm volatile("" : "+v"(tid_l));
    const int tid = tid_l, wid = __builtin_amdgcn_readfirstlane(tid >> 6), lane = tid & 63, wr = wid >> 2, wc = wid & 3, fr = lane & 15, fq = lane >> 4;
#if defined(PROBE_K2)
    const int K = g.K, nt0 = K / BK, nt = FP8 ? 2 * nt0 : nt0;
#define PG8_KT(x) (FP8 ? ((x) & (nt0 - 1)) : (x))
#else
    const int K = g.K, nt = K / BK;
#define PG8_KT(x) (x)
#endif
    unsigned voffA[2], voffB[2];
#pragma unroll
    for (int i = 0; i < 2; ++i) { int R, C; stage_rc(tid * 16 + i * 8192, R, C); const int Rb = Epi::PERM ? ((R & ~31) + perm32(R & 31)) : R;
        voffA[i] = (unsigned)(R * K + C) * 2u; voffB[i] = (unsigned)(Rb * K + C) * 2u; }
    unsigned gAc[2][2], gAn[2][2]; int gR[2]; unsigned gC[2];
#pragma unroll
    for (int i = 0; i < 2; ++i) { int R, C; stage_rc(tid * 16 + i * 8192, R, C); gR[i] = R; gC[i] = (unsigned)C * 2u; gAc[0][i] = gAc[1][i] = gAn[0][i] = gAn[1][i] = 0u; }
#define PG8_GATHER(u_, o_) do { const int gtb_ = gtab[(u_).pm], gtc_ = gtab[576 + (u_).pm];     \
        _Pragma("unroll") for (int h_ = 0; h_ < 2; ++h_) _Pragma("unroll") for (int i_ = 0; i_ < 2; ++i_) \
        { const int rl_ = h_ * HALF + gR[i_]; const int src_ = rl_ < gtc_ ? rowsrc[gtb_ + rl_] : 0; o_[h_][i_] = (unsigned)src_ * (unsigned)(K * 2) + gC[i_]; } } while (0)
#define PG8_STAGE_A(bufoff, orig_gbase, NEXTSEL, H, KOFF) do { if constexpr (GATHER) { unsigned vo_[2]; vo_[0] = (NEXTSEL) ? gAn[H][0] : gAc[H][0]; vo_[1] = (NEXTSEL) ? gAn[H][1] : gAc[H][1]; \
        PG8_STAGE(bufoff, (const char*)g.A + (KOFF), vo_); } else { PG8_STAGE(bufoff, orig_gbase, voffA); } } while (0)
    const size_t kstep = (size_t)(BK * 2);
    const size_t hstep = (size_t)HALF * K * 2;
    const size_t tstep = 2 * hstep;
    const unsigned ldsw = (unsigned)wid * 1024u;
    const int aoff = lds_byte(wr * 64 + fr, fq * 8), boff = lds_byte(wc * 32 + fr, fq * 8);
#define PG8_SA(b, h) (((b) * 2 + (h)) * HTB)
#define PG8_SB(b, h) ((4 + (b) * 2 + (h)) * HTB)
#define PG8_STAGE(bufoff, gbase, voff) do { _Pragma("unroll") for (int _i = 0; _i < 2; ++_i) \
        __builtin_amdgcn_global_load_lds((const unsigned*)((const char*)(gbase) + (voff)[_i]), (PG8_LAS unsigned*)(lds + (bufoff) + ldsw + _i * 8192), 16, 0, 0); } while (0)
#define PG8_LD32(var, addr) do { const bf16x8 lo_ = *(const PG8_LAS bf16x8*)(addr); const bf16x8 hi_ = *(const PG8_LAS bf16x8*)((addr) + 1024); var = cat32(lo_, hi_); } while (0)
#define PG8_LDA(dst, b, h) do { if constexpr (FP8) { _Pragma("unroll") for (int m = 0; m < 4; ++m) PG8_LD32(dst##8[m], lds + PG8_SA(b, h) + aoff + m * 2048); } \
        else { _Pragma("unroll") for (int m = 0; m < 4; ++m) _Pragma("unroll") for (int k = 0; k < 2; ++k) dst[m][k] = *(const PG8_LAS bf16x8*)(lds + PG8_SA(b, h) + aoff + m * 2048 + k * 1024); } } while (0)
#define PG8_LDB(dst, b, h) do { if constexpr (FP8) { _Pragma("unroll") for (int n = 0; n < 2; ++n) PG8_LD32(dst##8[n], lds + PG8_SB(b, h) + boff + n * 2048); } \
        else { _Pragma("unroll") for (int n = 0; n < 2; ++n) _Pragma("unroll") for (int k = 0; k < 2; ++k) dst[n][k] = *(const PG8_LAS bf16x8*)(lds + PG8_SB(b, h) + boff + n * 2048 + k * 1024); } } while (0)
#define PG8_MMA(ai, bj, At, Bt) do { __builtin_amdgcn_s_setprio(1); \
        if constexpr (FP8) { _Pragma("unroll") for (int m = 0; m < 4; ++m) _Pragma("unroll") for (int n = 0; n < 2; ++n) \
            asm volatile("v_mfma_scale_f32_16x16x128_f8f6f4 %0, %1, %2, %0, %3, %3 op_sel_hi:[0,0,0]" : "+v"(acc[ai][bj][m][n]) : "v"(Bt##8[n]), "v"(At##8[m]), "v"(sc127)); } \
        else { _Pragma("unroll") for (int m = 0; m < 4; ++m) _Pragma("unroll") for (int n = 0; n < 2; ++n) _Pragma("unroll") for (int k = 0; k < 2; ++k) \
            acc[ai][bj][m][n] = __builtin_amdgcn_mfma_f32_16x16x32_bf16(Bt[n][k], At[m][k], acc[ai][bj][m][n], 0, 0, 0); } \
        __builtin_amdgcn_s_setprio(0); } while (0)
#define PG8_WAIT_V(n) asm volatile("s_waitcnt vmcnt(" #n ")" ::: "memory")
#define PG8_WAIT_L(n) asm volatile("s_waitcnt lgkmcnt(" #n ")" ::: "memory")
#define PG8_BAR __builtin_amdgcn_s_barrier()
#define PG8_SCHED __builtin_amdgcn_sched_barrier(0)
    Unit cur, nxt; int ui = 0;
    if (!S.next(0, cur)) return;
    f32x4 acc[2][2][4][2];
#pragma unroll
    for (int a = 0; a < 2; ++a)
#pragma unroll
        for (int b = 0; b < 2; ++b)
#pragma unroll
            for (int m = 0; m < 4; ++m)
#pragma unroll
                for (int n = 0; n < 2; ++n) acc[a][b][m][n] = (f32x4){0.f, 0.f, 0.f, 0.f};
    int sc127 = 0x7f7f7f7f; asm volatile("" : "+v"(sc127));
    bf16x8 At[4][2], B0[2][2], B1[2][2]; v8i_t At8[4], B08[2], B18[2]; (void)At; (void)B0; (void)B1; (void)At8; (void)B08; (void)B18;
    const char* cA = (const char*)g.A + (size_t)cur.pm * tstep; const char* cB = (const char*)g.Bt + (size_t)cur.pn * tstep;
    S.a_ready(cur);
    if constexpr (GATHER) { PG8_GATHER(cur, gAc); }
    if constexpr (Epi::PREFETCH) E.prefetch(cur, 0, wid, lane);
    if constexpr (SP2) {
        PG8_STAGE(PG8_SB(0, 0), cB, voffB); PG8_STAGE(PG8_SB(0, 1), cB + hstep, voffB); PG8_STAGE_A(PG8_SA(0, 0), cA, false, 0, (size_t)0); PG8_STAGE_A(PG8_SA(0, 1), cA + hstep, false, 1, (size_t)0);
        if (wr == 1) PG8_BAR;
        PG8_WAIT_V(2); PG8_BAR;
        PG8_STAGE(PG8_SB(1, 0), cB + kstep, voffB); PG8_STAGE_A(PG8_SA(1, 0), cA + kstep, false, 0, kstep); PG8_STAGE(PG8_SB(1, 1), cB + hstep + kstep, voffB);
        PG8_WAIT_V(6); PG8_BAR;
    } else {
        PG8_STAGE(PG8_SB(0, 0), cB, voffB); PG8_STAGE(PG8_SA(0, 0), cA, voffA); PG8_STAGE(PG8_SB(0, 1), cB + hstep, voffB); PG8_STAGE(PG8_SA(0, 1), cA + hstep, voffA);
        if (wr == 1) PG8_BAR;
        PG8_WAIT_V(4); PG8_BAR;
        PG8_STAGE(PG8_SB(1, 0), cB + kstep, voffB); PG8_STAGE(PG8_SA(1, 0), cA + kstep, voffA); PG8_STAGE(PG8_SB(1, 1), cB + hstep + kstep, voffB);
        PG8_WAIT_V(6); PG8_BAR;
    }
    for (;;) {
        const bool has_next = S.next(ui + 1, nxt);
        if constexpr (GATHER) { if (has_next) { PG8_GATHER(nxt, gAn); } else { _Pragma("unroll") for (int h_ = 0; h_ < 2; ++h_) _Pragma("unroll") for (int i_ = 0; i_ < 2; ++i_) gAn[h_][i_] = gAc[h_][i_]; } }
        const char* nA = has_next ? (const char*)g.A + (size_t)nxt.pm * tstep : cA; const char* nB = has_next ? (const char*)g.Bt + (size_t)nxt.pn * tstep : cB;
#pragma nounroll
        for (int t = 0; t < nt; t += 2) {
            const bool last = (t == nt - 2);
            const char* a1 = cA + (size_t)PG8_KT(t + 1) * kstep;
            const char* a2 = last ? nA : cA + (size_t)PG8_KT(t + 2) * kstep; const char* b2 = last ? nB : cB + (size_t)PG8_KT(t + 2) * kstep;
            const char* a3 = a2 + kstep; const char* b3 = b2 + kstep;
            const size_t k1 = (size_t)PG8_KT(t + 1) * kstep, k2 = last ? (size_t)0 : (size_t)PG8_KT(t + 2) * kstep, k3 = k2 + kstep; (void)k1; (void)k2; (void)k3;
            if (last && has_next) S.a_ready(nxt);
            if constexpr (SP2) {
            PG8_LDB(B0, 0, 0); PG8_LDB(B1, 0, 1); PG8_SCHED; PG8_LDA(At, 0, 0); PG8_STAGE_A(PG8_SA(1, 1), a1 + hstep, false, 1, k1);
            PG8_WAIT_V(8); PG8_WAIT_L(0); PG8_BAR; PG8_MMA(0, 0, At, B0); PG8_MMA(0, 1, At, B1); PG8_BAR; PG8_SCHED;
            PG8_LDA(At, 0, 1); PG8_STAGE(PG8_SB(0, 0), b2, voffB); PG8_STAGE(PG8_SB(0, 1), b2 + hstep, voffB); PG8_STAGE_A(PG8_SA(0, 0), a2, last, 0, k2);
            PG8_WAIT_V(8); PG8_WAIT_L(0); PG8_BAR; PG8_MMA(1, 0, At, B0); PG8_MMA(1, 1, At, B1); PG8_BAR; PG8_SCHED;
            PG8_LDB(B0, 1, 0); PG8_LDB(B1, 1, 1); PG8_SCHED; PG8_LDA(At, 1, 0); PG8_STAGE_A(PG8_SA(0, 1), a2 + hstep, last, 1, k2);
            PG8_WAIT_V(8); PG8_WAIT_L(0); PG8_BAR; PG8_MMA(0, 0, At, B0); PG8_MMA(0, 1, At, B1); PG8_BAR; PG8_SCHED;
            PG8_LDA(At, 1, 1); PG8_STAGE(PG8_SB(1, 0), b3, voffB); PG8_STAGE(PG8_SB(1, 1), b3 + hstep, voffB); PG8_STAGE_A(PG8_SA(1, 0), a3, last, 0, k3);
            PG8_WAIT_V(8); PG8_WAIT_L(0); PG8_BAR; PG8_MMA(1, 0, At, B0); PG8_MMA(1, 1, At, B1); PG8_BAR; PG8_SCHED;
            } else {
            PG8_LDB(B0, 0, 0); PG8_SCHED; PG8_LDA(At, 0, 0); PG8_STAGE(PG8_SA(1, 1), a1 + hstep, voffA);
            PG8_WAIT_L(8); PG8_BAR; PG8_WAIT_L(0); PG8_MMA(0, 0, At, B0); PG8_BAR; PG8_SCHED;
            PG8_LDB(B1, 0, 1); PG8_STAGE(PG8_SB(0, 0), b2, voffB);
            PG8_BAR; PG8_WAIT_L(0); PG8_MMA(0, 1, At, B1); PG8_BAR;
            PG8_LDA(At, 0, 1); PG8_STAGE(PG8_SA(0, 0), a2, voffA);
            PG8_BAR; PG8_WAIT_L(0); PG8_MMA(1, 0, At, B0); PG8_BAR; PG8_SCHED;
            PG8_STAGE(PG8_SB(0, 1), b2 + hstep, voffB);
            PG8_WAIT_V(6); PG8_BAR; PG8_MMA(1, 1, At, B1); PG8_BAR;
            PG8_LDB(B0, 1, 0); PG8_SCHED; PG8_LDA(At, 1, 0); PG8_STAGE(PG8_SA(0, 1), a2 + hstep, voffA);
            PG8_WAIT_L(8); PG8_BAR; PG8_WAIT_L(0); PG8_MMA(0, 0, At, B0); PG8_BAR; PG8_SCHED;
            PG8_LDB(B1, 1, 1); PG8_STAGE(PG8_SB(1, 0), b3, voffB);
            PG8_BAR; PG8_WAIT_L(0); PG8_MMA(0, 1, At, B1); PG8_BAR;
            PG8_LDA(At, 1, 1); PG8_STAGE(PG8_SA(1, 0), a3, voffA);
            PG8_BAR; PG8_WAIT_L(0); PG8_MMA(1, 0, At, B0); PG8_BAR; PG8_SCHED;
            PG8_STAGE(PG8_SB(1, 1), b3 + hstep, voffB);
            PG8_WAIT_V(6); PG8_BAR; PG8_MMA(1, 1, At, B1); PG8_BAR;
            }
        }
        if constexpr (ALIGN_EPI) { if (wr == 0) PG8_BAR; }
        if constexpr (FP8) { asm volatile("s_nop 15\n\ts_nop 15" ::: "memory"); }
        if constexpr (!Epi::AFTER_DRAIN) { if constexpr (Epi::PREFETCH) E(acc, cur, wr, wc, fr, fq, ui & 1); else E(acc, cur, wr, wc, fr, fq);
#if defined(PROBE_EPI2)
            if constexpr (FP8 == (PROBE_EPI2 == 1)) { if constexpr (Epi::PREFETCH) E(acc, cur, wr, wc, fr, fq, ui & 1); else E(acc, cur, wr, wc, fr, fq); }
#endif
            S.done(cur); }
        if (!has_next) break;
#pragma unroll
        for (int a = 0; a < 2; ++a)
#pragma unroll
            for (int b = 0; b < 2; ++b)
#pragma unroll
                for (int m = 0; m < 4; ++m)
#pragma unroll
                    for (int n = 0; n < 2; ++n) acc[a][b][m][n] = (f32x4){0.f, 0.f, 0.f, 0.f};
        cur = nxt; cA = nA; cB = nB; ++ui;
        if constexpr (Epi::PREFETCH) E.prefetch(cur, ui & 1, wid, lane);
        if constexpr (GATHER) { _Pragma("unroll") for (int h_ = 0; h_ < 2; ++h_) _Pragma("unroll") for (int i_ = 0; i_ < 2; ++i_) gAc[h_][i_] = gAn[h_][i_]; }
        if constexpr (ALIGN_EPI) { if (wr == 1) PG8_BAR; }
    }
    PG8_WAIT_V(0);
    if constexpr (!ALIGN_EPI) { if (wr == 0) PG8_BAR; }
    PG8_BAR;
    if constexpr (Epi::AFTER_DRAIN) { E.fused(acc, cur, wr, wc, fr, fq, lds, wid, lane); S.done(cur); }
#undef PG8_SA
#undef PG8_SB
#undef PG8_STAGE
#undef PG8_STAGE_A
#undef PG8_GATHER
#undef PG8_LDA
#undef PG8_LD32
#undef PG8_LDB
#undef PG8_MMA
#undef PG8_WAIT_V
#undef PG8_WAIT_L
#undef PG8_BAR
#undef PG8_SCHED
}
}

#ifndef PG8_SP2
#define PG8_SP2 true
#endif
#ifndef PG8_ALIGN
#define PG8_ALIGN true
#endif

#define GAS __attribute__((address_space(1)))
#define LAS __attribute__((address_space(3)))
typedef unsigned short bf16;
typedef unsigned v4u __attribute__((ext_vector_type(4)));
typedef unsigned v2u __attribute__((ext_vector_type(2)));
typedef float f32x4 __attribute__((ext_vector_type(4)));
typedef short bf16x8 __attribute__((ext_vector_type(8)));

constexpr int D = 1024, NB = 8, SEQ = 4096, CTXL = 256, TPB = SEQ + CTXL, NTOK = NB * TPB, NLAT = NB * SEQ;
constexpr int ZC = 3328;
constexpr int ZQ = 0, ZKV = 384, ZKR = 640, ZHQ = 672, ZHF = 1184, ZHB = 1696, ZHI = 2208, ZHG = 2720;
constexpr int NEXP = 32;
constexpr float ALPHA = 1.4142135623730951f;
constexpr float LN_EPS = 1e-5f, RMS_EPS = 1e-6f;
constexpr int NWAVES = 8, NTHR = 512;
constexpr float SC_X8 = 16.f, SC_WGU = 64.f, SC_ACT = 8.f, SC_WDN = 128.f, SC_Y = 64.f, SC_A1 = 16.f, SC_WPW = 64.f, SC_CV = 16.f, SC_A0 = 16.f, SC_WIN = 64.f;
constexpr int LDS_BYTES = 163840;
constexpr int LDS_BAR_OFF = LDS_BYTES - 64;
constexpr int LDS_TILE_E = 131072;
constexpr int MAXTILES = 576;
constexpr int LDS_SIDE = 155648, SIDE_BYTES = 3072;
static_assert(LDS_SIDE + 2 * SIDE_BYTES <= LDS_BYTES - 64, "lds side");
constexpr int LDS_EPI_B = 139264;
static_assert(LDS_TILE_E + (3 * MAXTILES + 96) * 4 <= LDS_EPI_B && LDS_EPI_B + 16384 <= LDS_BYTES - 64, "lds map");

constexpr size_t MiB = 1u << 20;
constexpr size_t WS_CTL = 0, CTL_ZERO_BYTES = 16384;
constexpr size_t WS_MODV = 1 * MiB;
constexpr size_t WS_ROPE = 1 * MiB + 512 * 1024;
constexpr size_t WS_BGU = 2 * MiB;
constexpr size_t WS_PW1B = 2 * MiB + 512 * 1024;
constexpr size_t WS_BCNT = WS_PW1B + 64 * 1024;
constexpr size_t WS_TILEE = WS_BCNT + 64 * 1024;
constexpr size_t WS_META = WS_TILEE + 4096;
constexpr size_t WS_TOPI = 3 * MiB, WS_TOPW = 4 * MiB;
constexpr int ECAP = 32768;
constexpr size_t WS_ROWS = 160 * MiB, WS_ROWW = 164 * MiB, WS_ROWD = 168 * MiB;
constexpr size_t WS_CURSOR = 14336;
constexpr size_t WS_WIN = 8 * MiB, WS_WUQ = 15 * MiB, WS_WUKV = 16 * MiB, WS_WOUT = 17 * MiB, WS_WPW1 = 19 * MiB, WS_WPW2 = 23 * MiB;
constexpr size_t WS_WGU = 32 * MiB, WS_WDN = 288 * MiB;
constexpr size_t WS_H = 416 * MiB;
constexpr size_t WS_X = 552 * MiB, WS_Y = 620 * MiB;
constexpr size_t WS_BIG = 688 * MiB;
constexpr size_t WS_Z = WS_BIG, WS_CQN = WS_BIG + 221 * MiB, WS_CKVN = WS_BIG + 247 * MiB, WS_KRR = WS_BIG + 264 * MiB,
                 WS_Q = WS_BIG + 267 * MiB, WS_KV = WS_BIG + 318 * MiB, WS_OF = WS_BIG + 386 * MiB, WS_OB = WS_BIG + 454 * MiB;
constexpr size_t WS_HT = WS_BIG + 528 * MiB;
constexpr size_t WS_PRE = WS_BIG;
constexpr size_t WS_XS = WS_BIG, WS_ACT = WS_BIG + 288 * MiB, WS_YB = WS_BIG + 576 * MiB;
constexpr size_t WS_END = WS_BIG + 848 * MiB;
static_assert((size_t)NTOK * ZC * 2 <= 221 * MiB && (size_t)NTOK * 384 * 2 <= 26 * MiB && (size_t)NTOK * 256 * 2 <= 17 * MiB && (size_t)NTOK * 32 * 2 <= 3 * MiB, "ws map 1");
static_assert((size_t)NTOK * 768 * 2 <= 51 * MiB && (size_t)NTOK * 1024 * 2 <= 68 * MiB && (size_t)NTOK * 512 * 4 <= 68 * MiB, "ws map 2");
static_assert((size_t)64 * 136 * 26624 <= 320 * MiB && (size_t)MAXTILES * 256 * 2048 <= 288 * MiB && (size_t)NLAT * 4 * 2048 <= 272 * MiB && (size_t)NTOK * 1024 * 4 <= 136 * MiB, "ws map 3");

#define LDS_WAIT() asm volatile("s_waitcnt lgkmcnt(0)" ::: "memory")
#define VM_WAIT() asm volatile("s_waitcnt vmcnt(0)" ::: "memory")
__device__ __forceinline__ float bf2f(unsigned short b) { return __uint_as_float(((unsigned)b) << 16); }
__device__ __forceinline__ unsigned pk2(float lo, float hi) { return pg8::cvt_pk_bf16(lo, hi); }
__device__ __forceinline__ float sigm(float x) { return __builtin_amdgcn_rcpf(1.f + __expf(-x)); }
__device__ __forceinline__ float wave_sum(float v) {
#pragma unroll
    for (int o = 1; o < 64; o <<= 1) v += __shfl_xor(v, o);
    return v;
}
__device__ __forceinline__ int ld_ctl(const int* p) { return (int)__hip_atomic_load((const unsigned*)p, __ATOMIC_RELAXED, __HIP_MEMORY_SCOPE_AGENT); }
__device__ __forceinline__ int grow_of(int lr) { return (lr >> 12) * TPB + CTXL + (lr & 4095); }

#define XB_TMO      128
#define XB_XCNT(j)  (256  + 64 * (j))
#define XB_XSUB(j)  (1280 + 64 * (j))
#define XB_XGEN(j)  (2304 + 64 * (j))
#define XB_TOP      3328
#define XB_TOPGEN   3392
#define XCD_BAR_WORDS 3456
#define XB_SPIN_CAP (1u << 21)

__device__ __forceinline__ unsigned xb_ld(unsigned* p)              { return __hip_atomic_load(p, __ATOMIC_RELAXED, __HIP_MEMORY_SCOPE_AGENT); }
__device__ __forceinline__ unsigned xb_add(unsigned* p, unsigned v) { return __hip_atomic_fetch_add(p, v, __ATOMIC_RELAXED, __HIP_MEMORY_SCOPE_AGENT); }
__device__ __forceinline__ unsigned xb_xcc_id() { return (unsigned)__builtin_amdgcn_s_getreg((3 << 11) | 20) & 0xFu; }
#define XB_SPIN(cond, bar) do { unsigned _sp = 0; while (cond) { __builtin_amdgcn_s_sleep(1); \
    if ((++_sp & 255u) == 0u) { if (xb_ld(&(bar)[XB_TMO])) break; if (_sp > XB_SPIN_CAP) { atomicAdd(&(bar)[XB_TMO], 1u); break; } } } } while (0)

struct XcdBarrier { unsigned* bar; unsigned x; volatile LAS unsigned* st; };

__device__ __forceinline__ XcdBarrier xcd_barrier_post(unsigned* bar, volatile LAS unsigned* st) {
    XcdBarrier b; b.bar = bar; b.x = xb_xcc_id(); b.st = st;
    if (threadIdx.x == 0) (void)xb_add(&bar[XB_XCNT(b.x)], 1u);
    return b;
}
__device__ __forceinline__ void xcd_barrier_complete(unsigned* bar, unsigned x, unsigned& nloc, unsigned& nx) {
    const unsigned G = gridDim.x * gridDim.y * gridDim.z;
    unsigned sum, cnt, mine, sp = 0u;
    for (;;) {
        sum = 0u; cnt = 0u; mine = 0u;
#pragma unroll
        for (unsigned j = 0; j < 16; ++j) { const unsigned c = xb_ld(&bar[XB_XCNT(j)]); sum += c; cnt += (c > 0u) ? 1u : 0u; mine = (j == x) ? c : mine; }
        if (sum == G) break;
        __builtin_amdgcn_s_sleep(1);
        if ((++sp & 255u) == 0u) { if (xb_ld(&bar[XB_TMO])) break; if (sp > XB_SPIN_CAP) { atomicAdd(&bar[XB_TMO], 1u); break; } }
    }
    nloc = mine > 0u ? mine : 1u; nx = cnt > 0u ? cnt : 1u;
}
__device__ __forceinline__ void xcd_barrier(const XcdBarrier& b) {
    asm volatile("s_waitcnt vmcnt(0)" ::: "memory");
    __syncthreads();
    if (threadIdx.x == 0) {
        unsigned* bar = b.bar;
        __builtin_amdgcn_s_waitcnt(0);
        unsigned nloc = b.st[0], nx = b.st[1];
        if (nloc == 0u) { xcd_barrier_complete(bar, b.x, nloc, nx); b.st[0] = nloc; b.st[1] = nx; }
        const unsigned old = xb_add(&bar[XB_XSUB(b.x)], 1u);
        const unsigned gen = old / nloc;
        if (old + 1u == (gen + 1u) * nloc) {
            __builtin_amdgcn_fence(__ATOMIC_RELEASE, "agent");
            asm volatile("s_waitcnt vmcnt(0)" ::: "memory");
            const unsigned og = xb_add(&bar[XB_TOP], 1u);
            const unsigned tg = og / nx;
            if (og + 1u == (tg + 1u) * nx) xb_add(&bar[XB_TOPGEN], 1u);
            else XB_SPIN(xb_ld(&bar[XB_TOPGEN]) == tg, bar);
            __builtin_amdgcn_fence(__ATOMIC_ACQUIRE, "agent");
            xb_add(&bar[XB_XGEN(b.x)], 1u);
            asm volatile("s_waitcnt vmcnt(0)" ::: "memory");
        } else {
            XB_SPIN(xb_ld(&bar[XB_XGEN(b.x)]) == gen, bar);
            __builtin_amdgcn_fence(__ATOMIC_ACQUIRE, "agent");
            asm volatile("s_waitcnt vmcnt(0)" ::: "memory");
        }
    }
    __syncthreads();
}

namespace pg8 {
struct TileOrder {
    int nM, nN, nwg, G, c;
    __device__ __forceinline__ void init(int nM_, int nN_, int G_, int c_) { nM = nM_; nN = nN_; nwg = nM * nN; G = G_; c = c_; }
    __device__ __forceinline__ bool logical(int i, int& im, int& in) const {
        const long L = (long)i * G + c; if (L >= nwg) return false;
        int wgid = (int)L; { const int q = nwg / NXCD, r = nwg % NXCD, xcd = wgid % NXCD, off = wgid / NXCD; wgid = (xcd < r ? xcd * (q + 1) : r * (q + 1) + (xcd - r) * q) + off; }
        const int nig = WGM * nN, gid = wgid / nig, fm = gid * WGM, gsz = (nM - fm) < WGM ? (nM - fm) : WGM;
        im = fm + ((wgid % nig) % gsz); in = (wgid % nig) / gsz; return true;
    }
    __device__ __forceinline__ void a_ready(const Unit&) const {}
    __device__ __forceinline__ void done(const Unit&) const {}
};
struct AllOrder : TileOrder { __device__ __forceinline__ bool next(int i, Unit& u) const { int im, in; if (!logical(i, im, in)) return false; u.pm = im; u.pn = in; return true; } };
struct LatOrder : TileOrder {
    __device__ __forceinline__ bool next(int i, Unit& u) const { int im, in; if (!logical(i, im, in)) return false; u.pm = (im >> 4) * 17 + 1 + (im & 15); u.pn = in; return true; } };
struct MoeOrder : TileOrder {
    const PG8_LAS int* tile_e; int nper;
    __device__ __forceinline__ bool next(int i, Unit& u) const { int im, in; if (!logical(i, im, in)) return false; u.pm = im; u.pn = tile_e[im] * nper + in; return true; } };

template <bool HB16> struct EpiRes {
    static constexpr bool PERM = true, AFTER_DRAIN = false, PREFETCH = false;
    const float* xin; const bf16_t* h; bf16_t* pre; const float* modv; const float* bias; float ascale;
    __device__ __forceinline__ void operator()(const f32x4 (&acc)[2][2][4][2], const Unit& u, int wr, int wc, int fr, int fq) const {
        asm volatile("" : "+v"(fr), "+v"(fq));
        const int b = u.pm / 17, j = u.pm % 17;
        const int rl0 = wr * 64 + fr, col0 = u.pn * BM + wc * 32 + 8 * fq;
        const float* gate = modv + (size_t)b * 6144 + 2048;
        f32x4 gv[2][2], bv[2][2];
#pragma unroll
        for (int bj = 0; bj < 2; ++bj)
#pragma unroll
            for (int n = 0; n < 2; ++n) { gv[bj][n] = *(const f32x4*)(gate + col0 + bj * HALF + 4 * n); bv[bj][n] = bias ? *(const f32x4*)(bias + col0 + bj * HALF + 4 * n) : (f32x4){0.f, 0.f, 0.f, 0.f}; }
        if constexpr (HB16) {
#pragma unroll
        for (int ai = 0; ai < 2; ++ai) {
            u32x4 hb[4][2];
#pragma unroll
            for (int m = 0; m < 4; ++m) { const int rl = rl0 + ai * HALF + m * 16; const size_t grow = (size_t)u.pm * BM + rl; const bf16_t* hin = h + grow * 1024 + col0;
#pragma unroll
                for (int bj = 0; bj < 2; ++bj) hb[m][bj] = *(const u32x4*)(hin + bj * HALF); }
            asm volatile("" ::: "memory");
#pragma unroll
            for (int m = 0; m < 4; ++m) { const int rl = rl0 + ai * HALF + m * 16; const size_t grow = (size_t)u.pm * BM + rl; bf16_t* po = pre + grow * 1024 + col0;
#pragma unroll
                for (int bj = 0; bj < 2; ++bj) { const u32x4 q = hb[m][bj];
                    const f32x4 h0 = {__builtin_bit_cast(float, q.x << 16), __builtin_bit_cast(float, q.x & 0xffff0000u), __builtin_bit_cast(float, q.y << 16), __builtin_bit_cast(float, q.y & 0xffff0000u)};
                    const f32x4 h1 = {__builtin_bit_cast(float, q.z << 16), __builtin_bit_cast(float, q.z & 0xffff0000u), __builtin_bit_cast(float, q.w << 16), __builtin_bit_cast(float, q.w & 0xffff0000u)};
                    const f32x4 v0 = h0 * 1.4142135623730951f + gv[bj][0] * (acc[ai][bj][m][0] * ascale + bv[bj][0]), v1 = h1 * 1.4142135623730951f + gv[bj][1] * (acc[ai][bj][m][1] * ascale + bv[bj][1]);
                    u32x4 w; w.x = cvt_pk_bf16(v0[0], v0[1]); w.y = cvt_pk_bf16(v0[2], v0[3]); w.z = cvt_pk_bf16(v1[0], v1[1]); w.w = cvt_pk_bf16(v1[2], v1[3]);
                    *(u32x4*)(po + bj * HALF) = w; } }
            asm volatile("" ::: "memory"); }
        } else {
#pragma unroll
        for (int aim = 0; aim < 4; ++aim) { const int ai = aim >> 1, m0 = (aim & 1) * 2;
            f32x4 hv[2][2][2];
#pragma unroll
            for (int mm = 0; mm < 2; ++mm) { const int rl = rl0 + ai * HALF + (m0 + mm) * 16; const size_t grow = (size_t)u.pm * BM + rl;
                const float* hin = xin + ((size_t)b * 4096 + (size_t)(j - 1) * 256 + rl) * 1024 + col0; (void)grow;
#pragma unroll
                for (int bj = 0; bj < 2; ++bj) { hv[mm][bj][0] = *(const f32x4*)(hin + bj * HALF); hv[mm][bj][1] = *(const f32x4*)(hin + bj * HALF + 4); } }
            asm volatile("" ::: "memory");
#pragma unroll
            for (int mm = 0; mm < 2; ++mm) { const int m = m0 + mm; const int rl = rl0 + ai * HALF + m * 16; const size_t grow = (size_t)u.pm * BM + rl; bf16_t* po = pre + grow * 1024 + col0;
#pragma unroll
                for (int bj = 0; bj < 2; ++bj) {
                    const f32x4 v0 = hv[mm][bj][0] * 1.4142135623730951f + gv[bj][0] * (acc[ai][bj][m][0] * ascale + bv[bj][0]), v1 = hv[mm][bj][1] * 1.4142135623730951f + gv[bj][1] * (acc[ai][bj][m][1] * ascale + bv[bj][1]);
                    u32x4 w; w.x = cvt_pk_bf16(v0[0], v0[1]); w.y = cvt_pk_bf16(v0[2], v0[3]); w.z = cvt_pk_bf16(v1[0], v1[1]); w.w = cvt_pk_bf16(v1[2], v1[3]);
                    *(u32x4*)(po + bj * HALF) = w; } }
            asm volatile("" ::: "memory"); }
        }
    }
};
#define PG8_DMA4(gptr, ldsptr) __builtin_amdgcn_global_load_lds((const unsigned*)(gptr), (PG8_LAS unsigned*)(ldsptr), 4, 0, 0)
template <int MODE, bool OUT8 = false> struct EpiGate {
    static constexpr bool PERM = true, AFTER_DRAIN = false, PREFETCH = true;
    bf16_t* O; const float* bias; int nper; float ascale, oscale; PG8_LAS unsigned char* lds;
    __device__ __forceinline__ void prefetch(const Unit& u, int par, int wid, int lane) const { if (wid < 4) PG8_DMA4(bias + u.pn * BM + 64 * wid + lane, lds + LDS_SIDE + par * SIDE_BYTES + wid * 256); }
    __device__ __forceinline__ void operator()(const f32x4 (&acc)[2][2][4][2], const Unit& u, int wr, int wc, int fr, int fq, int par) const {
        asm volatile("" : "+v"(fr), "+v"(fq));
        const int row0 = u.pm * BM + wr * 64 + fr, pnl = u.pn % nper, ocol0 = pnl * HALF + wc * 32 + 8 * fq, bcol0 = u.pn * BM + wc * 32 + 8 * fq;
        const float s0 = ascale, s1 = MODE == 1 ? ascale * oscale : ascale;
        f32x4 bv[2][2];
#pragma unroll
        for (int n = 0; n < 2; ++n) { const PG8_LAS float* bl = (const PG8_LAS float*)(lds + LDS_SIDE + par * SIDE_BYTES) + wc * 32 + 8 * fq + 4 * n; bv[0][n] = *(const PG8_LAS f32x4*)bl; const f32x4 t = *(const PG8_LAS f32x4*)(bl + HALF); bv[1][n] = MODE == 1 ? (t + 1.0f) * oscale : t; }
        (void)bcol0;
#pragma unroll
        for (int ai = 0; ai < 2; ++ai)
#pragma unroll
            for (int m = 0; m < 4; ++m) { bf16_t* rowp = O + (size_t)(row0 + ai * HALF + m * 16) * 1024 + ocol0;
                unsigned char* rowp8 = (unsigned char*)O + (size_t)(row0 + ai * HALF + m * 16) * 1024 + ocol0;
                float o[8];
#pragma unroll
                for (int n = 0; n < 2; ++n) { const f32x4 a = acc[ai][0][m][n] * s0 + bv[0][n], g = acc[ai][1][m][n] * s1 + bv[1][n];
#pragma unroll
                    for (int e = 0; e < 4; ++e) {
                        if (MODE == 0) { o[4 * n + e] = a[e] * __builtin_amdgcn_rcpf(1.f + __builtin_amdgcn_exp2f(g[e] * -1.4426950408889634f)); }
                        else { const float gt = fminf(a[e], 7.0f), up1 = __builtin_amdgcn_fmed3f(g[e], -6.0f * oscale, 8.0f * oscale);
                            o[4 * n + e] = up1 * (gt * __builtin_amdgcn_rcpf(1.f + __builtin_amdgcn_exp2f(gt * (-1.702f * 1.4426950408889634f)))); } } }
                if constexpr (OUT8) {
                    int w0 = 0, w1 = 0; w0 = __builtin_amdgcn_cvt_pk_fp8_f32(o[0], o[1], w0, false); w0 = __builtin_amdgcn_cvt_pk_fp8_f32(o[2], o[3], w0, true);
                    w1 = __builtin_amdgcn_cvt_pk_fp8_f32(o[4], o[5], w1, false); w1 = __builtin_amdgcn_cvt_pk_fp8_f32(o[6], o[7], w1, true);
                    typedef unsigned u32x2 __attribute__((ext_vector_type(2))); *(u32x2*)rowp8 = (u32x2){(unsigned)w0, (unsigned)w1}; (void)rowp;
                } else { (void)rowp8;
                u32x4 w; w.x = cvt_pk_bf16(o[0], o[1]); w.y = cvt_pk_bf16(o[2], o[3]); w.z = cvt_pk_bf16(o[4], o[5]); w.w = cvt_pk_bf16(o[6], o[7]);
                *(u32x4*)rowp = w; } }
    }
};
struct EpiDown {
    static constexpr bool PERM = true, AFTER_DRAIN = false, PREFETCH = true;
    bf16_t* Y; const float* bias; const float* row_w; const int* row_dst; float ascale; const PG8_LAS int* gtab; float oscale; PG8_LAS unsigned char* lds;
    __device__ __forceinline__ void prefetch(const Unit& u, int par, int wid, int lane) const { PG8_LAS unsigned char* sd = lds + LDS_SIDE + par * SIDE_BYTES; const int tbase = gtab[u.pm];
        if (wid < 4) { PG8_DMA4(bias + u.pn * BM + 64 * wid + lane, sd + wid * 256); PG8_DMA4(row_w + tbase + 64 * wid + lane, sd + 1024 + wid * 256); } else PG8_DMA4(row_dst + tbase + 64 * (wid - 4) + lane, sd + 2048 + (wid - 4) * 256); }
    __device__ __forceinline__ void operator()(const f32x4 (&acc)[2][2][4][2], const Unit& u, int wr, int wc, int fr, int fq, int par) const {
        asm volatile("" : "+v"(fr), "+v"(fq));
        const int tid = (wr * 4 + wc) * 64 + fq * 16 + fr;
        const PG8_LAS unsigned char* sd = lds + LDS_SIDE + par * SIDE_BYTES;
        const int pnl = u.pn & 3; const int tcnt = gtab[576 + u.pm];
        f32x4 bv[2][2];
#pragma unroll
        for (int bj = 0; bj < 2; ++bj)
#pragma unroll
            for (int n = 0; n < 2; ++n) bv[bj][n] = *(const PG8_LAS f32x4*)(sd + (wc * 32 + 8 * fq + bj * HALF + 4 * n) * 4);
        float wv[2][4]; int dstv[2][2];
#pragma unroll
        for (int ai = 0; ai < 2; ++ai) {
#pragma unroll
            for (int m = 0; m < 4; ++m) { const int rl = wr * 64 + fr + ai * HALF + m * 16; wv[ai][m] = *(const PG8_LAS float*)(sd + 1024 + rl * 4); }
#pragma unroll
            for (int k = 0; k < 2; ++k) { const int rl = ai * HALF + (tid >> 3) + 64 * k; dstv[ai][k] = *(const PG8_LAS int*)(sd + 2048 + rl * 4); } }
        PG8_LAS unsigned char* const reg0 = lds + 3 * HTB; PG8_LAS unsigned char* const reg1 = lds + LDS_EPI_B;
        const int wbase = (wr * 64 + fr) * 128 + (((wc * 4 + fq) ^ fr) * 8);
        const int rrow = tid >> 3, rch = tid & 7;
        typedef unsigned u32x2 __attribute__((ext_vector_type(2)));
#pragma unroll
        for (int ai = 0; ai < 2; ++ai) {
#pragma unroll
            for (int m = 0; m < 4; ++m) { const float w8 = wv[ai][m] * oscale;
#pragma unroll
                for (int bj = 0; bj < 2; ++bj) { const f32x4 v0 = (acc[ai][bj][m][0] * ascale + bv[bj][0]) * w8, v1 = (acc[ai][bj][m][1] * ascale + bv[bj][1]) * w8;
                    int w0 = 0, w1 = 0; w0 = __builtin_amdgcn_cvt_pk_fp8_f32(__builtin_amdgcn_fmed3f(v0[0], -448.f, 448.f), __builtin_amdgcn_fmed3f(v0[1], -448.f, 448.f), w0, false); w0 = __builtin_amdgcn_cvt_pk_fp8_f32(__builtin_amdgcn_fmed3f(v0[2], -448.f, 448.f), __builtin_amdgcn_fmed3f(v0[3], -448.f, 448.f), w0, true);
                    w1 = __builtin_amdgcn_cvt_pk_fp8_f32(__builtin_amdgcn_fmed3f(v1[0], -448.f, 448.f), __builtin_amdgcn_fmed3f(v1[1], -448.f, 448.f), w1, false); w1 = __builtin_amdgcn_cvt_pk_fp8_f32(__builtin_amdgcn_fmed3f(v1[2], -448.f, 448.f), __builtin_amdgcn_fmed3f(v1[3], -448.f, 448.f), w1, true);
                    *(PG8_LAS u32x2*)((bj ? reg1 : reg0) + wbase + m * 2048) = (u32x2){(unsigned)w0, (unsigned)w1}; } }
            asm volatile("s_waitcnt lgkmcnt(0)" ::: "memory"); __builtin_amdgcn_s_barrier();
            u32x4 rd[2][2];
#pragma unroll
            for (int bj = 0; bj < 2; ++bj)
#pragma unroll
                for (int k = 0; k < 2; ++k) { const int row = rrow + 64 * k; rd[bj][k] = *(const PG8_LAS u32x4*)((bj ? reg1 : reg0) + row * 128 + ((rch ^ ((row & 15) >> 1)) * 16)); }
            asm volatile("s_waitcnt lgkmcnt(0)" ::: "memory"); __builtin_amdgcn_s_barrier();
#pragma unroll
            for (int k = 0; k < 2; ++k) { const int row = rrow + 64 * k, rl = ai * HALF + row;
                if (rl < tcnt) { unsigned char* rowp = (unsigned char*)Y + (size_t)dstv[ai][k] * 1024 + pnl * BM + rch * 16;
#pragma unroll
                    for (int bj = 0; bj < 2; ++bj) { u32x4 q = rd[bj][k]; if (row & 1) q = (u32x4){q.z, q.w, q.x, q.y}; *(u32x4*)(rowp + bj * HALF) = q; } } }
        }
    }
};
}

namespace att {
using bf16x8 = __attribute__((ext_vector_type(8))) short;
using s16x4  = __attribute__((ext_vector_type(4))) short;
using f32x16 = __attribute__((ext_vector_type(16))) float;
using u32x4  = __attribute__((ext_vector_type(4))) unsigned;
constexpr int NW = 8, QBLK = 32, KVBLK = 64;
constexpr float SCALE = 0.10206207261596575f;
constexpr float THR = 8.f;
constexpr int SHM_V = 16384, SHM_K = 16384, NBUF = 3, SHM_ATTN = NBUF * SHM_V + NBUF * SHM_K + NW * 64 * 4;
#define KSWZ(row, colB) ((row) * 256 + ((colB) ^ (((row) & 7) << 4)))
#define SBAR() __builtin_amdgcn_sched_barrier(0)
__device__ __forceinline__ int crow(int r, int hi) { return (r & 3) + 8 * (r >> 2) + 4 * hi; }
__device__ __forceinline__ unsigned cvtpk(float lo, float hi) { unsigned r; asm volatile("v_cvt_pk_bf16_f32 %0, %1, %2" : "=v"(r) : "v"(lo), "v"(hi)); return r; }

__device__ __forceinline__ void partialSM(f32x16& p0, f32x16& p1, float& m_reg, float& mn, float& alpha) {
  constexpr float C = SCALE * 1.4426950408889634f;
  float pmax = p0[0];
#pragma unroll
  for (int r = 1; r < 16; ++r) pmax = fmaxf(pmax, p0[r]);
#pragma unroll
  for (int r = 0; r < 16; ++r) pmax = fmaxf(pmax, p1[r]);
  { auto rr = __builtin_amdgcn_permlane32_swap(__float_as_uint(pmax), __float_as_uint(pmax), false, false);
    pmax = fmaxf(__uint_as_float(rr[0]), __uint_as_float(rr[1])); }
  if (__builtin_expect(__all(pmax - m_reg <= THR / SCALE), 1)) { mn = m_reg; alpha = 1.f; }
  else { mn = fmaxf(m_reg, pmax); alpha = __builtin_amdgcn_exp2f((m_reg - mn) * C); m_reg = mn; }
  float mnC = -mn * C;
#pragma unroll
  for (int r = 0; r < 16; ++r) p0[r] = fmaf(p0[r], C, mnC);
#pragma unroll
  for (int r = 0; r < 16; ++r) p1[r] = fmaf(p1[r], C, mnC);
#pragma unroll
  for (int r = 0; r < 16; ++r) p0[r] = __builtin_amdgcn_exp2f(p0[r]);
}
__device__ __forceinline__ void finishSM(f32x16& p0, f32x16& p1, float alpha, float& l_reg, bf16x8& pa0, bf16x8& pa1, bf16x8& pa2, bf16x8& pa3) {
#pragma unroll
  for (int r = 0; r < 16; ++r) p1[r] = __builtin_amdgcn_exp2f(p1[r]);
  float ps = 0;
#pragma unroll
  for (int r = 0; r < 16; ++r) ps += p0[r];
#pragma unroll
  for (int r = 0; r < 16; ++r) ps += p1[r];
  { auto rr = __builtin_amdgcn_permlane32_swap(__float_as_uint(ps), __float_as_uint(ps), false, false);
    ps = __uint_as_float(rr[0]) + __uint_as_float(rr[1]); }
  l_reg = l_reg * alpha + ps;
#define PK4(P, BASE, OUT) do { unsigned a0 = cvtpk(P[BASE + 0], P[BASE + 1]), a1 = cvtpk(P[BASE + 2], P[BASE + 3]);   \
    unsigned b0 = cvtpk(P[BASE + 4], P[BASE + 5]), b1 = cvtpk(P[BASE + 6], P[BASE + 7]);                              \
    auto r0 = __builtin_amdgcn_permlane32_swap(a0, b0, false, false); auto r1 = __builtin_amdgcn_permlane32_swap(a1, b1, false, false); \
    u32x4 w = {r0[0], r1[0], r0[1], r1[1]}; OUT = *reinterpret_cast<bf16x8*>(&w); } while (0)
  PK4(p0, 0, pa0); PK4(p0, 8, pa1); PK4(p1, 0, pa2); PK4(p1, 8, pa3);
#undef PK4
}
__device__ __forceinline__ void qkt(f32x16& p0, f32x16& p1, const bf16* Ks, const bf16x8* qr, int r32, int hi) {
  p0 = f32x16{}; p1 = f32x16{};
#pragma unroll
  for (int d0 = 0; d0 < 6; ++d0) { int cb = (d0 * 16 + hi * 8) * 2;
    bf16x8 b0 = *reinterpret_cast<const bf16x8*>((const char*)Ks + KSWZ(r32, cb));
    bf16x8 b1 = *reinterpret_cast<const bf16x8*>((const char*)Ks + KSWZ(32 + r32, cb));
    p0 = __builtin_amdgcn_mfma_f32_32x32x16_bf16(b0, qr[d0], p0, 0, 0, 0);
    p1 = __builtin_amdgcn_mfma_f32_32x32x16_bf16(b1, qr[d0], p1, 0, 0, 0); }
}
__device__ __forceinline__ int v_st(int k, int c) { const int kk = (k & ~0xC) | ((k & 4) << 1) | ((k & 8) >> 1); return ((kk >> 3) * 4 + (c >> 5)) * 512 + ((kk & 7) * 32 + (c & 31)) * 2; }
__device__ __forceinline__ int v_rd_base(int lane) { return ((lane & 3) << 3) | (((lane >> 2) & 3) << 6) | (((lane >> 4) & 1) << 5) | (((lane >> 5) & 1) << 8); }
constexpr int v_rd_off(int d0, int ks, int half) { return d0 * 512 + ks * 4096 + half * 2048; }
template <int OFF> __device__ __forceinline__ s16x4 tr_read(int vb) {
  s16x4 r; asm volatile("ds_read_b64_tr_b16 %0, %1 offset:%2" : "=&v"(r) : "v"(vb), "i"(OFF) : "memory"); return r;
}
template <int D0> __device__ __forceinline__ void pv_one(f32x16& od, int vb, bf16x8 pa0, bf16x8 pa1, bf16x8 pa2, bf16x8 pa3) {
  const s16x4 l0 = tr_read<v_rd_off(D0, 0, 0)>(vb), h0 = tr_read<v_rd_off(D0, 0, 1)>(vb), l1 = tr_read<v_rd_off(D0, 1, 0)>(vb), h1 = tr_read<v_rd_off(D0, 1, 1)>(vb);
  const s16x4 l2 = tr_read<v_rd_off(D0, 2, 0)>(vb), h2 = tr_read<v_rd_off(D0, 2, 1)>(vb), l3 = tr_read<v_rd_off(D0, 3, 0)>(vb), h3 = tr_read<v_rd_off(D0, 3, 1)>(vb);
  asm volatile("s_waitcnt lgkmcnt(0)" ::: "memory"); SBAR();
#define PK(L, H) (bf16x8){L[0], L[1], L[2], L[3], H[0], H[1], H[2], H[3]}
  od = __builtin_amdgcn_mfma_f32_32x32x16_bf16(pa0, PK(l0, h0), od, 0, 0, 0);
  od = __builtin_amdgcn_mfma_f32_32x32x16_bf16(pa1, PK(l1, h1), od, 0, 0, 0);
  od = __builtin_amdgcn_mfma_f32_32x32x16_bf16(pa2, PK(l2, h2), od, 0, 0, 0);
  od = __builtin_amdgcn_mfma_f32_32x32x16_bf16(pa3, PK(l3, h3), od, 0, 0, 0);
#undef PK
}
__device__ __forceinline__ void pv_d0(f32x16* o, int vb, bf16x8 pa0, bf16x8 pa1, bf16x8 pa2, bf16x8 pa3) {
  pv_one<0>(o[0], vb, pa0, pa1, pa2, pa3); pv_one<1>(o[1], vb, pa0, pa1, pa2, pa3);
}
__device__ __forceinline__ bf16x8 rope8(bf16x8 x, const float* tab, int pbase) {
  u32x4 w;
#pragma unroll
  for (int i = 0; i < 4; ++i) { const float x1 = __uint_as_float(((unsigned)(unsigned short)x[2 * i]) << 16), x2 = __uint_as_float(((unsigned)(unsigned short)x[2 * i + 1]) << 16);
    const float cs = tab[pbase + i], sn = tab[16 + pbase + i]; w[i] = cvtpk(x1 * cs - x2 * sn, x1 * sn + x2 * cs); }
  return *reinterpret_cast<bf16x8*>(&w);
}
__device__ __forceinline__ void attn_unit(const bf16* __restrict__ Qb, const bf16* __restrict__ KVb, const bf16* __restrict__ KRb, bf16* __restrict__ Ob,
                                          const float* __restrict__ rope, int seq, char* lds) {
  int tid_l = threadIdx.x; asm volatile("" : "+v"(tid_l));
  const int tid = tid_l, wid = tid >> 6, lane = tid & 63, r32 = lane & 31, hi = lane >> 5;
  bf16* V_lds = (bf16*)lds; bf16* K_lds = (bf16*)(lds + NBUF * SHM_V);
  float* ws = (float*)(lds + NBUF * SHM_V + NBUF * SHM_K) + wid * 64; float* li_l = ws; float* al_l = ws + 32;
  float m_reg = -1e30f, l_reg = 0; f32x16 o[2] = {}; bf16x8 qr[6];
  const bf16* Qw = Qb + (long)(wid * QBLK + r32) * 768 + hi * 8;
#pragma unroll
  for (int d0 = 0; d0 < 6; ++d0) qr[d0] = *reinterpret_cast<const bf16x8*>(Qw + d0 * 16);
  if (rope) { const float* tab = rope + (long)(wid * QBLK + r32) * 32; qr[4] = rope8(qr[4], tab, 4 * hi); qr[5] = rope8(qr[5], tab, 8 + 4 * hi); }
  const int sr = tid >> 4, ch = tid & 15;
  const bf16* kbase = ch < 8 ? KVb + ch * 8 : KRb + ((ch - 8) & 3) * 8; const long kstr = ch < 8 ? 1024 : 32;
  const int vkey = tid >> 3, vc8 = (tid & 7) * 8, vst0 = v_st(vkey, vc8);
  const bf16* vbase = KVb + 512 + vc8;
  const int vb0 = (int)(uintptr_t)V_lds + v_rd_base(lane);
  struct { bf16x8 vs0, ks0, ks1; } sr_[2];
#define SLOAD(i, k0) do { sr_[i].vs0 = *reinterpret_cast<const bf16x8*>(vbase + (long)((k0) + vkey) * 1024); \
    sr_[i].ks0 = *reinterpret_cast<const bf16x8*>(kbase + (long)((k0) + sr) * kstr); sr_[i].ks1 = *reinterpret_cast<const bf16x8*>(kbase + (long)((k0) + 32 + sr) * kstr); } while (0)
#define SWRITE(b, i) do { *(bf16x8*)((char*)V_lds + (b) * SHM_V + vst0) = sr_[i].vs0; int kc = ch * 16;               \
    *(bf16x8*)((char*)K_lds + (b) * SHM_K + KSWZ(sr, kc)) = sr_[i].ks0;                       \
    *(bf16x8*)((char*)K_lds + (b) * SHM_K + KSWZ(32 + sr, kc)) = sr_[i].ks1; } while (0)
#define SWAIT() asm volatile("s_waitcnt vmcnt(3)" ::: "memory")
#define RESC(a) do { if (__any((a) < 1.f)) { if (hi == 0) al_l[r32] = (a); asm volatile("s_waitcnt lgkmcnt(0)" ::: "memory"); \
    _Pragma("unroll") for (int d = 0; d < 2; ++d) _Pragma("unroll") for (int r = 0; r < 16; ++r) o[d][r] *= al_l[crow(r, hi)]; } } while (0)
  f32x16 pA0, pA1, pB0, pB1; float mnA, mnB, alA, alB; bf16x8 pa0, pa1, pa2, pa3; const int NT = seq / KVBLK;
  constexpr int SE = 0, SO = 1;
  SLOAD(SE, 0); asm volatile("s_waitcnt vmcnt(0)" ::: "memory"); SWRITE(0, SE); __syncthreads();
  qkt(pA0, pA1, K_lds, qr, r32, hi); partialSM(pA0, pA1, m_reg, mnA, alA);
  SLOAD(SO, KVBLK); if (2 < NT) SLOAD(SE, 2 * KVBLK);
  SWAIT(); SWRITE(1, SO); __syncthreads();
  int bprev = 0, bcur = 1, bnext = 2;
#define ATT_STEP(PN0, PN1, MNN, ALN, PO0, PO1, ALO, SL_LOAD, SL_WRITE, t) do { \
    SBAR(); qkt(PN0, PN1, (bf16*)((char*)K_lds + bcur * SHM_K), qr, r32, hi); \
    finishSM(PO0, PO1, ALO, l_reg, pa0, pa1, pa2, pa3); SBAR(); \
    if ((t) + 2 < NT) SLOAD(SL_LOAD, ((t) + 2) * KVBLK); SBAR(); \
    pv_d0(o, vb0 + bprev * (int)SHM_V, pa0, pa1, pa2, pa3); partialSM(PN0, PN1, m_reg, MNN, ALN); \
    SWAIT(); SWRITE(bnext, SL_WRITE); \
    RESC(ALN); __syncthreads(); \
    bprev = bcur; bcur = bnext; bnext = (bnext == 2) ? 0 : bnext + 1; } while (0)
  for (int j = 1; j + 1 < NT; j += 2) {
    ATT_STEP(pB0, pB1, mnB, alB, pA0, pA1, alA, SO, SE, j);
    ATT_STEP(pA0, pA1, mnA, alA, pB0, pB1, alB, SE, SO, j + 1);
  }
#undef ATT_STEP
  SBAR(); qkt(pB0, pB1, (bf16*)((char*)K_lds + bcur * SHM_K), qr, r32, hi);
  finishSM(pA0, pA1, alA, l_reg, pa0, pa1, pa2, pa3); SBAR();
  pv_d0(o, vb0 + bprev * (int)SHM_V, pa0, pa1, pa2, pa3); partialSM(pB0, pB1, m_reg, mnB, alB);
  RESC(alB);
  finishSM(pB0, pB1, alB, l_reg, pa0, pa1, pa2, pa3); SBAR();
  pv_d0(o, vb0 + bcur * (int)SHM_V, pa0, pa1, pa2, pa3);
  if (hi == 0) li_l[r32] = l_reg; asm volatile("s_waitcnt lgkmcnt(0)" ::: "memory");
  float rli[16];
#pragma unroll
  for (int r = 0; r < 16; ++r) rli[r] = __builtin_amdgcn_rcpf(li_l[crow(r, hi)]);
  bf16* Ow = Ob + (long)(wid * QBLK) * 1024;
#pragma unroll
  for (int r = 0; r < 16; ++r) { int orow = crow(r, hi);
#pragma unroll
    for (int d0 = 0; d0 < 2; ++d0) { const float v = o[d0][r] * rli[r]; Ow[(long)orow * 1024 + d0 * 32 + r32] = (bf16)(cvtpk(v, v) & 0xffffu); } }
#undef SLOAD
#undef SWRITE
#undef SWAIT
#undef RESC
}
}

struct Args { const float* in[33]; float* out; unsigned char* ws; int ph_lo, ph_hi; };
enum { I_X = 0, I_C, I_CTX, I_CCTX, I_MODW, I_MODB, I_LN1G, I_LN1B, I_LN2G, I_LN2B, I_WIN, I_QNORM, I_KVNORM, I_WUQ, I_WUK, I_WUV, I_LBL, I_HGNORM, I_WOUT,
       I_PW1W, I_PW1B, I_DWW, I_DWB, I_CLNG, I_CLNB, I_PW2W, I_PW2B, I_RW, I_RB, I_WGU, I_BGU, I_WDN, I_BDN };

__device__ __forceinline__ int dst_row(int n, int mode, int row_off) {
    if (mode == 0) return row_off + n;
    int f, g; if (mode == 1) { f = n >> 1; g = n & 1; } else { g = n >> 10; f = n & 1023; }
    return row_off + 256 * (f >> 7) + 128 * g + (f & 127);
}
__device__ __forceinline__ unsigned pack_fp8x4(float a, float b, float c, float d) { int w = 0; w = __builtin_amdgcn_cvt_pk_fp8_f32(fminf(fmaxf(a, -448.f), 448.f), fminf(fmaxf(b, -448.f), 448.f), w, false);
    w = __builtin_amdgcn_cvt_pk_fp8_f32(fminf(fmaxf(c, -448.f), 448.f), fminf(fmaxf(d, -448.f), 448.f), w, true); return (unsigned)w; }
struct TrItem { const float* W; bf16* WT; int K, N, mode, row_off, item; float f8scale; };
__device__ __forceinline__ void tr_load(const TrItem& d, f32x4 (&v)[16], int lane) {
    const int nblk = (d.N + 31) >> 5, kb = d.item / nblk, nb = d.item - kb * nblk, k0 = 128 * kb + 16 * (lane >> 3), nc = 32 * nb + 4 * (lane & 7);
#pragma unroll
    for (int i = 0; i < 16; ++i) v[i] = (nc < d.N) ? __builtin_nontemporal_load((const f32x4*)(d.W + (size_t)(k0 + i) * d.N + nc)) : (f32x4){0.f, 0.f, 0.f, 0.f};
}
__device__ __forceinline__ void tr_store(const TrItem& d, const f32x4 (&v)[16], int lane) {
    const int nblk = (d.N + 31) >> 5, kb = d.item / nblk, nb = d.item - kb * nblk, k0 = 128 * kb + 16 * (lane >> 3), nc = 32 * nb + 4 * (lane & 7); const int K = d.K;
    if (nc >= d.N) return;
#pragma unroll
    for (int j = 0; j < 4; ++j) { const size_t row = (size_t)dst_row(nc + j, d.mode, d.row_off);
        if (d.f8scale > 0.f) { const float f8 = d.f8scale; v4u o;
            o.x = pack_fp8x4(v[0][j] * f8, v[1][j] * f8, v[2][j] * f8, v[3][j] * f8); o.y = pack_fp8x4(v[4][j] * f8, v[5][j] * f8, v[6][j] * f8, v[7][j] * f8);
            o.z = pack_fp8x4(v[8][j] * f8, v[9][j] * f8, v[10][j] * f8, v[11][j] * f8); o.w = pack_fp8x4(v[12][j] * f8, v[13][j] * f8, v[14][j] * f8, v[15][j] * f8);
            *(v4u*)((unsigned char*)d.WT + row * K + k0) = o; }
        else { v4u o0, o1; o0.x = pk2(v[0][j], v[1][j]); o0.y = pk2(v[2][j], v[3][j]); o0.z = pk2(v[4][j], v[5][j]); o0.w = pk2(v[6][j], v[7][j]);
            o1.x = pk2(v[8][j], v[9][j]); o1.y = pk2(v[10][j], v[11][j]); o1.z = pk2(v[12][j], v[13][j]); o1.w = pk2(v[14][j], v[15][j]);
            bf16* wp = d.WT + row * K + k0; *(v4u*)wp = o0; *(v4u*)(wp + 8) = o1; } }
}
__device__ __forceinline__ void convert_items(const Args& a, unsigned char* ws, LAS float* scr, int lane, int gw, int NGW, int it_lo, int it_hi) {
    constexpr int I0 = 8 * 101, I1 = 6 * 12, I2 = 4 * 8, I3 = 4 * 8, I4 = 256, I5 = 512;
    constexpr int NGU = 64 * 512, NDN = 64 * 256;
    auto decode = [&](int it) -> TrItem {
        TrItem d; int r = it; d.f8scale = 0.f; d.mode = 0; d.row_off = 0;
        if (r < NGU) { const int mi = r >> 9; d.W = a.in[I_WGU] + (size_t)mi * 1024 * 2048; d.K = 1024; d.N = 2048; d.WT = (bf16*)(ws + WS_WGU + (size_t)mi * 2048 * 1024); d.mode = 1; d.item = r & 511; d.f8scale = SC_WGU; return d; } r -= NGU;
        if (r < NDN) { const int mi = r >> 8; d.W = a.in[I_WDN] + (size_t)mi * 1024 * 1024; d.K = 1024; d.N = 1024; d.WT = (bf16*)(ws + WS_WDN + (size_t)mi * 1024 * 1024); d.item = r & 255; d.f8scale = SC_WDN; return d; } r -= NDN;
        if (r < I0) { d.W = a.in[I_WIN]; d.K = 1024; d.N = 3232; d.WT = (bf16*)(ws + WS_WIN); d.item = r; d.f8scale = SC_WIN; return d; } r -= I0;
        if (r < I1) { d.W = a.in[I_WUQ]; d.K = 384; d.N = 768; d.WT = (bf16*)(ws + WS_WUQ); d.item = r; return d; } r -= I1;
        if (r < I2) { d.W = a.in[I_WUK]; d.K = 256; d.N = 512; d.WT = (bf16*)(ws + WS_WUKV); d.item = r; return d; } r -= I2;
        if (r < I3) { d.W = a.in[I_WUV]; d.K = 256; d.N = 512; d.WT = (bf16*)(ws + WS_WUKV); d.row_off = 512; d.item = r; return d; } r -= I3;
        if (r < I4) { d.W = a.in[I_WOUT]; d.K = 1024; d.N = 1024; d.WT = (bf16*)(ws + WS_WOUT); d.item = r; return d; } r -= I4;
        if (r < I5) { d.W = a.in[I_PW1W]; d.K = 1024; d.N = 2048; d.WT = (bf16*)(ws + WS_WPW1); d.mode = 2; d.item = r; d.f8scale = SC_WPW; return d; } r -= I5;
        d.W = a.in[I_PW2W]; d.K = 1024; d.N = 1024; d.WT = (bf16*)(ws + WS_WPW2); d.item = r; d.f8scale = SC_WPW; return d; };
    f32x4 tv0[16], tv1[16];
    int it = it_lo + gw;
    if (it < it_hi) { const TrItem d0 = decode(it); tr_load(d0, tv0, lane); }
    if (it + NGW < it_hi) { const TrItem d1 = decode(it + NGW); tr_load(d1, tv1, lane); }
    for (; it < it_hi; it += 2 * NGW) {
        { const TrItem d = decode(it);
          tr_store(d, tv0, lane);
          if (it + 2 * NGW < it_hi) { const TrItem dn = decode(it + 2 * NGW); tr_load(dn, tv0, lane); } }
        if (it + NGW < it_hi) { const TrItem d = decode(it + NGW);
          tr_store(d, tv1, lane);
          if (it + 3 * NGW < it_hi) { const TrItem dn = decode(it + 3 * NGW); tr_load(dn, tv1, lane); } }
    }
}
__device__ __forceinline__ void phase_prologue(const Args& a, LAS unsigned char* lds, int tid, int lane, int wave) {
    unsigned char* ws = a.ws;
    const int G = gridDim.x, B = blockIdx.x;
    {
        LAS float* sc = (LAS float*)lds;
        LAS float* red = (LAS float*)(lds + 36864);
        float* modv = (float*)(ws + WS_MODV);
        bool have = false;
        for (int it = B; it < 192; it += G) {
            if (!have) { for (int i = tid; i < 9 * 1024; i += NTHR) { const int r = i >> 10, k = i & 1023; const float x = r < 8 ? a.in[I_C][r * 1024 + k] : a.in[I_CCTX][k]; sc[i] = x * sigm(x); } __syncthreads(); have = true; }
            const int l = it / 96, jc = it % 96, kg = tid >> 6, jj = tid & 63, j = jc * 64 + jj;
            float acc[9];
#pragma unroll
            for (int r = 0; r < 9; ++r) acc[r] = 0.f;
            const float* wp = a.in[I_MODW] + ((size_t)l * 1024 + kg * 128) * 6144 + j;
            for (int k0 = 0; k0 < 128; k0 += 16) { float w[16];
#pragma unroll
                for (int kk = 0; kk < 16; ++kk) w[kk] = wp[(size_t)(k0 + kk) * 6144];
#pragma unroll
                for (int kk = 0; kk < 16; ++kk)
#pragma unroll
                    for (int r = 0; r < 9; ++r) acc[r] += sc[r * 1024 + kg * 128 + k0 + kk] * w[kk]; }
#pragma unroll
            for (int r = 0; r < 9; ++r) red[(kg * 9 + r) * 64 + jj] = acc[r];
            __syncthreads();
            for (int i = tid; i < 576; i += NTHR) { const int r = i >> 6, j2 = i & 63; float s = a.in[I_MODB][l * 6144 + jc * 64 + j2];
#pragma unroll
                for (int g = 0; g < 8; ++g) s += red[(g * 9 + r) * 64 + j2];
                modv[((size_t)l * 9 + r) * 6144 + jc * 64 + j2] = s; }
            __syncthreads();
        }
        __syncthreads();
    }
    const int gw = B * NWAVES + wave, NGW = G * NWAVES, gt = B * NTHR + tid, NGT = G * NTHR;
    { float* rope = (float*)(ws + WS_ROPE);
      for (int i = gt; i < 4096 * 16; i += NGT) { const int t = i >> 4, p = i & 15; const float pos = (float)(p < 8 ? (t >> 6) : (t & 63));
          const float inv = __powf(10000.0f, -(float)(p & 7) * 0.125f); const float ang = pos * inv; rope[t * 32 + p] = cosf(ang); rope[t * 32 + 16 + p] = sinf(ang); }
      float* bgu = (float*)(ws + WS_BGU);
      for (int i = gt; i < 2 * 32 * 2048; i += NGT) { const int le = i >> 11, np = i & 2047, q = np >> 8, g = (np >> 7) & 1, r = np & 127, f = 128 * q + r; bgu[i] = a.in[I_BGU][(size_t)le * 2048 + 2 * f + g]; }
      float* pb = (float*)(ws + WS_PW1B);
      for (int i = gt; i < 2048; i += NGT) { const int q = i >> 8, g = (i >> 7) & 1, r = i & 127, f = 128 * q + r; pb[i] = a.in[I_PW1B][g * 1024 + f]; }
      v4u* zp = (v4u*)(ws + WS_WIN + (size_t)3232 * 1024);
      for (int i = gt; i < 96 * 1024 / 16; i += NGT) zp[i] = (v4u){0u, 0u, 0u, 0u};
    }
    LAS float* scr = (LAS float*)(lds + wave * 16640);
    constexpr int I0 = 8 * 101, I1 = 6 * 12, I2 = 4 * 8, I3 = 4 * 8, I4 = 256, I5 = 512, I6 = 256, SMALL = I0 + I1 + I2 + I3 + I4 + I5 + I6;
    constexpr int NGU = 64 * 512, NDN = 64 * 256, NITEMS = SMALL + NGU + NDN;
    convert_items(a, ws, scr, lane, B * NWAVES + wave, G * NWAVES, NGU + NDN, NITEMS);
}
__device__ __forceinline__ void convert_moe_share(const Args& a, LAS unsigned char* lds, int lane, int wave) {
    LAS float* scr = (LAS float*)(lds + wave * 16640);
    constexpr int NGU = 64 * 512, NDN = 64 * 256;
    convert_items(a, a.ws, scr, lane, blockIdx.x * NWAVES + wave, gridDim.x * NWAVES, 0, NGU + NDN);
}

__device__ __forceinline__ void phase_mod0(const Args& a, int lane, int wave) {
    const int gw = blockIdx.x * NWAVES + wave, NGW = gridDim.x * NWAVES;
    const float* modv = (const float*)(a.ws + WS_MODV);
    bf16* X = (bf16*)(a.ws + WS_X);
    f32x4 xv[2][4], xn[2][4];
#define MOD0_LOAD(dst, r0_) do { _Pragma("unroll") for (int q = 0; q < 2; ++q) { const int r = (r0_) + q; const int b = r / TPB, p = r - b * TPB; \
            const float* src = p < CTXL ? a.in[I_CTX] + ((size_t)b * CTXL + p) * 1024 : a.in[I_X] + ((size_t)b * SEQ + (p - CTXL)) * 1024; \
            _Pragma("unroll") for (int j = 0; j < 4; ++j) dst[q][j] = *(const f32x4*)(src + 4 * (lane + 64 * j)); } } while (0)
    if (2 * gw < NTOK) MOD0_LOAD(xv, 2 * gw);
    for (int r0 = 2 * gw; r0 < NTOK; r0 += 2 * NGW) {
        f32x4 shv[2][4], scv[2][4];
#pragma unroll
        for (int q = 0; q < 2; ++q) { const int r = r0 + q; const int b = r / TPB, p = r - b * TPB; const float* mvp = modv + (size_t)(p < CTXL ? 8 : b) * 6144;
#pragma unroll
            for (int j = 0; j < 4; ++j) { const int c = 4 * (lane + 64 * j); shv[q][j] = *(const f32x4*)(mvp + c); scv[q][j] = *(const f32x4*)(mvp + 1024 + c); } }
        if (r0 + 2 * NGW < NTOK) MOD0_LOAD(xn, r0 + 2 * NGW);
#pragma unroll
        for (int q = 0; q < 2; ++q)
#pragma unroll
            for (int j = 0; j < 4; ++j) { const int c = 4 * (lane + 64 * j); const f32x4 sh = shv[q][j], sc = scv[q][j];
                const f32x4 y = (xv[q][j] * (sc + 1.0f) + sh) * SC_A0; *(unsigned*)((unsigned char*)X + (size_t)(r0 + q) * 1024 + c) = pack_fp8x4(y[0], y[1], y[2], y[3]); }
#pragma unroll
        for (int q = 0; q < 2; ++q)
#pragma unroll
            for (int j = 0; j < 4; ++j) xv[q][j] = xn[q][j];
    }
#undef MOD0_LOAD
}

__device__ __forceinline__ void phase_norm0(const Args& a, int lane, int wave) {
    const int gw = blockIdx.x * NWAVES + wave, NGW = gridDim.x * NWAVES;
    const bf16* Z = (const bf16*)(a.ws + WS_Z); bf16* CQN = (bf16*)(a.ws + WS_CQN); bf16* CKVN = (bf16*)(a.ws + WS_CKVN); bf16* KRR = (bf16*)(a.ws + WS_KRR);
    const float* rope = (const float*)(a.ws + WS_ROPE);
    float gq[8], gk[8];
#pragma unroll
    for (int i = 0; i < 8; ++i) { gq[i] = lane < 48 ? a.in[I_QNORM][8 * lane + i] : 0.f; gk[i] = lane < 32 ? a.in[I_KVNORM][8 * lane + i] : 0.f; }
    bf16x8 q8 = {}, k8 = {}, r8 = {}, nq8 = {}, nk8 = {}, nr8 = {};
#define N0_LOAD(dq, dk, dr, r_) do { const bf16* z_ = Z + (size_t)(r_) * ZC; if (lane < 48) dq = *(const bf16x8*)(z_ + ZQ + 8 * lane); if (lane < 32) dk = *(const bf16x8*)(z_ + ZKV + 8 * lane); if (lane < 4) dr = *(const bf16x8*)(z_ + ZKR + 8 * lane); } while (0)
    if (gw < NTOK) N0_LOAD(q8, k8, r8, gw);
    for (int r = gw; r < NTOK; r += NGW, q8 = nq8, k8 = nk8, r8 = nr8) {
        const int p = r % TPB;
        if (r + NGW < NTOK) N0_LOAD(nq8, nk8, nr8, r + NGW);
        float qf[8], kf[8], sq = 0.f, sk = 0.f;
#pragma unroll
        for (int i = 0; i < 8; ++i) { qf[i] = bf2f((unsigned short)q8[i]); kf[i] = bf2f((unsigned short)k8[i]); sq += qf[i] * qf[i]; sk += kf[i] * kf[i]; }
        sq = wave_sum(sq); sk = wave_sum(sk);
        const float rq = rsqrtf(sq * (1.f / 384.f) + RMS_EPS), rk = rsqrtf(sk * (1.f / 256.f) + RMS_EPS);
        if (lane < 48) { v4u o; o.x = pk2(qf[0] * rq * gq[0], qf[1] * rq * gq[1]); o.y = pk2(qf[2] * rq * gq[2], qf[3] * rq * gq[3]); o.z = pk2(qf[4] * rq * gq[4], qf[5] * rq * gq[5]); o.w = pk2(qf[6] * rq * gq[6], qf[7] * rq * gq[7]);
            *(v4u*)(CQN + (size_t)r * 384 + 8 * lane) = o; }
        if (lane < 32) { v4u o; o.x = pk2(kf[0] * rk * gk[0], kf[1] * rk * gk[1]); o.y = pk2(kf[2] * rk * gk[2], kf[3] * rk * gk[3]); o.z = pk2(kf[4] * rk * gk[4], kf[5] * rk * gk[5]); o.w = pk2(kf[6] * rk * gk[6], kf[7] * rk * gk[7]);
            *(v4u*)(CKVN + (size_t)r * 256 + 8 * lane) = o; }
        if (lane < 4) { bf16x8 o8 = r8; if (p >= CTXL) o8 = att::rope8(r8, rope + (size_t)(p - CTXL) * 32, 4 * lane); *(bf16x8*)(KRR + (size_t)r * 32 + 8 * lane) = o8; }
    }
#undef N0_LOAD
}

__device__ __forceinline__ void hgrn_unit(const Args& a, int unit, LAS unsigned char* lds, int tid) {
    const int b = unit >> 5, head = (unit >> 3) & 3, dir = (unit >> 2) & 1, sl = unit & 3;
    const bf16* Z = (const bf16*)(a.ws + WS_Z);
    float* Od = (float*)(a.ws + (dir ? WS_OB : WS_OF));
    LAS float* lbv = (LAS float*)lds;
    constexpr int BUF0 = 1024, BUFSZ = 28672, OFF_Q = 16384, OFF_V = 24576;
    if (tid < 128) { const int c = head * 128 + tid; const float l0 = a.in[I_LBL][c], l1 = a.in[I_LBL][512 + c], l2 = a.in[I_LBL][1024 + c]; const float m = fmaxf(l0, fmaxf(l1, l2));
        const float e0 = __expf(l0 - m), e1 = __expf(l1 - m), e2 = __expf(l2 - m); lbv[tid] = e0 / (e0 + e1 + e2); }
    __syncthreads();
    const int lt = tid >> 4, lcg = tid & 15;
    float lb8[8];
#pragma unroll
    for (int i = 0; i < 8; ++i) lb8[i] = lbv[8 * lcg + i];
    const int fcol = (dir ? ZHB : ZHF) + head * 128 + 8 * lcg, qcol = ZHQ + head * 128 + 8 * lcg;
    const int vt = tid >> 2, vcol = ZHI + head * 128 + sl * 32 + (tid & 3) * 8;
    const int wave = tid >> 6, lane = tid & 63, vv = lane >> 4, cg = lane & 15, vloc = wave * 4 + vv;
    const size_t zb = (size_t)b * TPB;
    bf16x8 rq, rf, rv;
#define TOKP(n) (dir ? ((n) < CTXL ? (CTXL - 1 - (n)) : (TPB + CTXL - 1 - (n))) : (n))
#define HG_LOAD(i) do { const int n_ = 32 * (i) + lt; const bf16* zr_ = Z + (zb + TOKP(n_)) * ZC; rq = *(const bf16x8*)(zr_ + qcol); rf = *(const bf16x8*)(zr_ + fcol); \
        if (tid < 128) { const int n2_ = 32 * (i) + vt; rv = *(const bf16x8*)(Z + (zb + TOKP(n2_)) * ZC + vcol); } } while (0)
#define HG_WRITE(bufi) do { LAS unsigned char* bp_ = lds + BUF0 + (bufi) * BUFSZ; float f_[8]; \
        _Pragma("unroll") for (int i_ = 0; i_ < 8; ++i_) f_[i_] = lb8[i_] + (1.f - lb8[i_]) * sigm(bf2f((unsigned short)rf[i_])); \
        *(LAS f32x4*)(bp_ + ((lt * 128 + lcg * 4) * 4)) = (f32x4){f_[0], f_[1], f_[2], f_[3]}; *(LAS f32x4*)(bp_ + ((lt * 128 + 64 + lcg * 4) * 4)) = (f32x4){f_[4], f_[5], f_[6], f_[7]}; \
        *(LAS bf16x8*)(bp_ + OFF_Q + (lt * 128 + lcg * 8) * 2) = rq; \
        if (tid < 128) { float v_[8]; _Pragma("unroll") for (int i_ = 0; i_ < 8; ++i_) v_[i_] = bf2f((unsigned short)rv[i_]); \
            *(LAS f32x4*)(bp_ + OFF_V + (vt * 32 + (tid & 3) * 8) * 4) = (f32x4){v_[0], v_[1], v_[2], v_[3]}; *(LAS f32x4*)(bp_ + OFF_V + (vt * 32 + (tid & 3) * 8 + 4) * 4) = (f32x4){v_[4], v_[5], v_[6], v_[7]}; } } while (0)
    float S[8];
#pragma unroll
    for (int j = 0; j < 8; ++j) S[j] = 0.f;
    HG_LOAD(0); HG_WRITE(0); __syncthreads();
    const bool b3 = (cg & 8) != 0, b2 = (cg & 4) != 0, b1 = (cg & 2) != 0, b0 = (cg & 1) != 0;
    for (int i = 0; i < TPB / 32; ++i) {
        if (i + 1 < TPB / 32) HG_LOAD(i + 1);
        const LAS unsigned char* bp = lds + BUF0 + (i & 1) * BUFSZ;
#pragma unroll 1
        for (int g = 0; g < 4; ++g) {
            const LAS unsigned char* gp = bp + g * 8 * 512;
            float ot[8];
#pragma unroll
            for (int t = 0; t < 8; ++t) {
                const f32x4 f0 = *(const LAS f32x4*)(gp + ((t * 128 + cg * 4) * 4)), f1 = *(const LAS f32x4*)(gp + ((t * 128 + 64 + cg * 4) * 4));
                const bf16x8 q8 = *(const LAS bf16x8*)(bp + OFF_Q + ((g * 8 + t) * 128 + cg * 8) * 2);
                const float v = *(const LAS float*)(bp + OFF_V + ((g * 8 + t) * 32 + vloc) * 4);
                float acc = 0.f;
#pragma unroll
                for (int j = 0; j < 8; ++j) { const float fj = j < 4 ? f0[j] : f1[j - 4]; const float qj = bf2f((unsigned short)q8[j]);
                    const float kv = fmaf(-fj, v, v); S[j] = fmaf(fj, S[j], kv); acc = fmaf(S[j], qj, acc); }
                ot[t] = acc;
            }
#pragma unroll
            for (int k = 0; k < 4; ++k) { const float snd = b3 ? ot[k] : ot[k + 4]; const float rcv = __shfl_xor(snd, 8); ot[k] = (b3 ? ot[k + 4] : ot[k]) + rcv; }
#pragma unroll
            for (int k = 0; k < 2; ++k) { const float snd = b2 ? ot[k] : ot[k + 2]; const float rcv = __shfl_xor(snd, 4); ot[k] = (b2 ? ot[k + 2] : ot[k]) + rcv; }
            { const float snd = b1 ? ot[0] : ot[1]; const float rcv = __shfl_xor(snd, 2); ot[0] = (b1 ? ot[1] : ot[0]) + rcv; }
            ot[0] += __shfl_xor(ot[0], 1);
            if (!b0) { const int n = 32 * i + 8 * g + (cg >> 1); const int p = TOKP(n); if (p >= CTXL) Od[(zb + p) * 512 + head * 128 + sl * 32 + vloc] = ot[0]; }
        }
        if (i + 1 < TPB / 32) HG_WRITE((i + 1) & 1);
        __syncthreads();
    }
#undef TOKP
#undef HG_LOAD
#undef HG_WRITE
}

__device__ __forceinline__ void phase_readout(const Args& a, int lane, int wave) {
    const int gw = blockIdx.x * NWAVES + wave, NGW = gridDim.x * NWAVES;
    const bf16* OF = (const bf16*)(a.ws + WS_OF); const bf16* OB = (const bf16*)(a.ws + WS_OB);
    const bf16* Z = (const bf16*)(a.ws + WS_Z); bf16* MIX = (bf16*)(a.ws + WS_Y);
    float hn[8];
#pragma unroll
    for (int i = 0; i < 8; ++i) hn[i] = a.in[I_HGNORM][((8 * lane) & 127) + i];
    bf16x8 a8 = {}, c8 = {}, g8 = {}, na8 = {}, nc8 = {}, ng8 = {};
#define RO_LOAD(da, dc, dg, lr_) do { const size_t r_ = (size_t)grow_of(lr_); da = *(const bf16x8*)(OF + r_ * 512 + 8 * lane); dc = *(const bf16x8*)(OB + r_ * 512 + 8 * lane); dg = *(const bf16x8*)(Z + r_ * ZC + ZHG + 8 * lane); } while (0)
    if (gw < NLAT) RO_LOAD(a8, c8, g8, gw);
    for (int lr = gw; lr < NLAT; lr += NGW, a8 = na8, c8 = nc8, g8 = ng8) {
        const size_t r = (size_t)grow_of(lr);
        if (lr + NGW < NLAT) RO_LOAD(na8, nc8, ng8, lr + NGW);
        float o[8]; float ss = 0.f;
#pragma unroll
        for (int i = 0; i < 8; ++i) o[i] = bf2f((unsigned short)a8[i]) + bf2f((unsigned short)c8[i]);
#pragma unroll
        for (int i = 0; i < 8; ++i) ss += o[i] * o[i];
        ss += __shfl_xor(ss, 1); ss += __shfl_xor(ss, 2); ss += __shfl_xor(ss, 4); ss += __shfl_xor(ss, 8);
        const float rs = rsqrtf(ss * (1.f / 128.f) + RMS_EPS);
        float y[8];
#pragma unroll
        for (int i = 0; i < 8; ++i) { const float g = bf2f((unsigned short)g8[i]); y[i] = o[i] * rs * hn[i] * (g * sigm(g)); }
        v4u w; w.x = pk2(y[0], y[1]); w.y = pk2(y[2], y[3]); w.z = pk2(y[4], y[5]); w.w = pk2(y[6], y[7]);
        *(v4u*)(MIX + r * 1024 + 512 + 8 * lane) = w;
    }
#undef RO_LOAD
}

__device__ __forceinline__ int rows_per_block() { const int G = gridDim.x; return (((NLAT + G - 1) / G) + 15) & ~15; }
__device__ __forceinline__ void phase_ln1(const Args& a, int l, LAS unsigned char* lds, int tid, int lane, int wave) {
    typedef short bf16x8s __attribute__((ext_vector_type(8)));
    const int RB = rows_per_block(), lr_base = blockIdx.x * RB;
    const bf16* PRE = (const bf16*)(a.ws + WS_PRE); bf16* XB = (bf16*)(a.ws + WS_X);
    const float* modv = (const float*)(a.ws + WS_MODV) + (size_t)l * 9 * 6144;
    const float* lng = a.in[I_LN1G] + l * 1024; const float* lnb = a.in[I_LN1B] + l * 1024;
    const float* rw = a.in[I_RW] + (size_t)l * 1024 * 32; const float* rb = a.in[I_RB] + l * 32;
    constexpr int XT_LD = 1028, O_PART = 16 * XT_LD * 4, O_LG = O_PART + 8 * 32 * 16 * 4, O_HIST = O_LG + 16 * 33 * 4 + 64, O_CCNT = O_HIST + 256, O_TIL = O_CCNT + 2048, O_TWL = O_TIL + 4096;
    LAS float* XT = (LAS float*)lds; LAS float* PART = (LAS float*)(lds + O_PART); LAS float* LG = (LAS float*)(lds + O_LG);
    LAS int* hist = (LAS int*)(lds + O_HIST);
    LAS int* ccnt = (LAS int*)(lds + O_CCNT);
    LAS int* til = (LAS int*)(lds + O_TIL);
    LAS float* twl = (LAS float*)(lds + O_TWL);
    __syncthreads();
    if (tid < 32) hist[tid] = 0;
    bf16x8s whi[2][4], wlo[2][4];
    { const int e15 = lane & 15, kq = lane >> 4;
#pragma unroll
      for (int t = 0; t < 2; ++t)
#pragma unroll
          for (int sI = 0; sI < 4; ++sI) { float wv[8];
#pragma unroll
              for (int j = 0; j < 8; ++j) wv[j] = rw[(size_t)(128 * wave + 32 * sI + 8 * kq + j) * 32 + 16 * t + e15];
              v4u ph, pl;
#pragma unroll
              for (int j = 0; j < 4; ++j) { const unsigned p = pk2(wv[2 * j], wv[2 * j + 1]); const float h0 = __uint_as_float(p << 16), h1 = __uint_as_float(p & 0xffff0000u); ph[j] = p; pl[j] = pk2(wv[2 * j] - h0, wv[2 * j + 1] - h1); }
              whi[t][sI] = __builtin_bit_cast(bf16x8s, ph); wlo[t][sI] = __builtin_bit_cast(bf16x8s, pl); } }
    const int ngroups = RB / 16;
    f32x4 fP[4], fQ[4]; int fb = -1;
    const float rbias = rb[tid >> 4];
    v2u xr[2][4];
#define LN1_LOAD(g) do { _Pragma("unroll") for (int rr_ = 0; rr_ < 2; ++rr_) { const int lr_ = lr_base + 16 * (g) + 2 * wave + rr_; const size_t r_ = (size_t)grow_of(lr_ < NLAT ? lr_ : NLAT - 1); \
        _Pragma("unroll") for (int j_ = 0; j_ < 4; ++j_) xr[rr_][j_] = *(const v2u*)(PRE + r_ * 1024 + 4 * (lane + 64 * j_)); } } while (0)
#if defined(PROBE_LN1X2)
    for (int rep_ = 0; rep_ < 2; ++rep_) { __syncthreads(); if (tid < 32) hist[tid] = 0; __syncthreads();
#endif
    LN1_LOAD(0);
    for (int g = 0; g < ngroups; ++g) {
#pragma unroll
        for (int rr = 0; rr < 2; ++rr) {
            const int lr = lr_base + 16 * g + 2 * wave + rr; const bool ok = lr < NLAT; const size_t r = (size_t)grow_of(ok ? lr : NLAT - 1); const int b = (ok ? lr : NLAT - 1) >> 12;
            if (b != fb) { const float* mv = modv + (size_t)b * 6144; fb = b;
#pragma unroll
                for (int j = 0; j < 4; ++j) { const int c = 4 * (lane + 64 * j); const f32x4 gg = *(const f32x4*)(lng + c), bb = *(const f32x4*)(lnb + c), sh = *(const f32x4*)(mv + 3 * 1024 + c), sc = *(const f32x4*)(mv + 4 * 1024 + c);
                    fP[j] = gg * (sc + 1.0f); fQ[j] = bb * (sc + 1.0f) + sh; } }
            f32x4 x[4]; float s = 0.f;
#pragma unroll
            for (int j = 0; j < 4; ++j) { const v2u p = xr[rr][j]; x[j] = (f32x4){__uint_as_float(p.x << 16), __uint_as_float(p.x & 0xffff0000u), __uint_as_float(p.y << 16), __uint_as_float(p.y & 0xffff0000u)}; s += (x[j][0] + x[j][1]) + (x[j][2] + x[j][3]); }
            const float mean = wave_sum(s) * (1.f / 1024.f); float s2 = 0.f;
#pragma unroll
            for (int j = 0; j < 4; ++j) { x[j] = x[j] - mean; s2 += (x[j][0] * x[j][0] + x[j][1] * x[j][1]) + (x[j][2] * x[j][2] + x[j][3] * x[j][3]); }
            const float rstd = rsqrtf(wave_sum(s2) * (1.f / 1024.f) + LN_EPS);
#pragma unroll
            for (int j = 0; j < 4; ++j) { const int c = 4 * (lane + 64 * j);
                const f32x4 bm = (x[j] * rstd) * fP[j] + fQ[j];
                if (ok) *(unsigned*)((unsigned char*)XB + r * 1024 + c) = pack_fp8x4(bm[0] * SC_X8, bm[1] * SC_X8, bm[2] * SC_X8, bm[3] * SC_X8);
                *(LAS f32x4*)(XT + (2 * wave + rr) * XT_LD + c) = bm; }
        }
        if (g + 1 < ngroups) LN1_LOAD(g + 1);
        __syncthreads();
        { const int rr = lane & 15, kq = lane >> 4;
          f32x4 acc0 = {0.f, 0.f, 0.f, 0.f}, acc1 = {0.f, 0.f, 0.f, 0.f};
#pragma unroll
          for (int sI = 0; sI < 4; ++sI) { const LAS float* xp = XT + rr * XT_LD + 128 * wave + 32 * sI + 8 * kq; const f32x4 v0 = *(const LAS f32x4*)xp, v1 = *(const LAS f32x4*)(xp + 4);
              const float bv[8] = {v0[0], v0[1], v0[2], v0[3], v1[0], v1[1], v1[2], v1[3]}; v4u ph, pl;
#pragma unroll
              for (int j = 0; j < 4; ++j) { const unsigned p = pk2(bv[2 * j], bv[2 * j + 1]); const float h0 = __uint_as_float(p << 16), h1 = __uint_as_float(p & 0xffff0000u); ph[j] = p; pl[j] = pk2(bv[2 * j] - h0, bv[2 * j + 1] - h1); }
              const bf16x8s bh = __builtin_bit_cast(bf16x8s, ph), bl = __builtin_bit_cast(bf16x8s, pl);
              acc0 = __builtin_amdgcn_mfma_f32_16x16x32_bf16(whi[0][sI], bh, acc0, 0, 0, 0); acc0 = __builtin_amdgcn_mfma_f32_16x16x32_bf16(whi[0][sI], bl, acc0, 0, 0, 0); acc0 = __builtin_amdgcn_mfma_f32_16x16x32_bf16(wlo[0][sI], bh, acc0, 0, 0, 0);
              acc1 = __builtin_amdgcn_mfma_f32_16x16x32_bf16(whi[1][sI], bh, acc1, 0, 0, 0); acc1 = __builtin_amdgcn_mfma_f32_16x16x32_bf16(whi[1][sI], bl, acc1, 0, 0, 0); acc1 = __builtin_amdgcn_mfma_f32_16x16x32_bf16(wlo[1][sI], bh, acc1, 0, 0, 0); }
#pragma unroll
          for (int q = 0; q < 4; ++q) { PART[(wave * 32 + 4 * kq + q) * 16 + rr] = acc0[q]; PART[(wave * 32 + 16 + 4 * kq + q) * 16 + rr] = acc1[q]; } }
        __syncthreads();
        { const int e = tid >> 4, rr = tid & 15; float sacc = rbias;
#pragma unroll
          for (int w = 0; w < 8; ++w) sacc += PART[(w * 32 + e) * 16 + rr];
          LG[rr * 33 + e] = sacc; }
        __syncthreads();
        if (wave == (g & 7) && lane < 16) { const int lr = lr_base + 16 * g + lane;
            if (lr < NLAT) { float lg[32];
#pragma unroll
                for (int e = 0; e < 32; ++e) lg[e] = LG[lane * 33 + e];
                unsigned taken = 0u; float tv[4]; int ti[4];
#pragma unroll
                for (int kk = 0; kk < 4; ++kk) { float best = -3.0e38f; int bi = 0;
#pragma unroll
                    for (int e = 0; e < 32; ++e) { const bool okk = (lg[e] > best) && !((taken >> e) & 1u); best = okk ? lg[e] : best; bi = okk ? e : bi; }
                    taken |= 1u << bi; tv[kk] = best; ti[kk] = bi; }
                const float e1 = __expf(tv[1] - tv[0]), e2 = __expf(tv[2] - tv[0]), e3 = __expf(tv[3] - tv[0]); const float inv = 1.f / (1.f + e1 + e2 + e3);
                const int li = (16 * g + lane) * 4; til[li] = ti[0]; til[li + 1] = ti[1]; til[li + 2] = ti[2]; til[li + 3] = ti[3]; twl[li] = inv; twl[li + 1] = e1 * inv; twl[li + 2] = e2 * inv; twl[li + 3] = e3 * inv;
                __hip_atomic_fetch_add(hist + ti[0], 1, __ATOMIC_RELAXED, __HIP_MEMORY_SCOPE_WORKGROUP); __hip_atomic_fetch_add(hist + ti[1], 1, __ATOMIC_RELAXED, __HIP_MEMORY_SCOPE_WORKGROUP);
                __hip_atomic_fetch_add(hist + ti[2], 1, __ATOMIC_RELAXED, __HIP_MEMORY_SCOPE_WORKGROUP); __hip_atomic_fetch_add(hist + ti[3], 1, __ATOMIC_RELAXED, __HIP_MEMORY_SCOPE_WORKGROUP); } }
    }
#if defined(PROBE_LN1X2)
    }
#endif
#undef LN1_LOAD
    __syncthreads();
    int* cursor = (int*)(a.ws + WS_CURSOR) + l * 32;
    int* rows = (int*)(a.ws + WS_ROWS); float* roww = (float*)(a.ws + WS_ROWW); int* rowd = (int*)(a.ws + WS_ROWD);
    int nrows = NLAT - lr_base; nrows = nrows > RB ? RB : nrows; if (nrows < 0) nrows = 0;
    const int nas = nrows * 4, nchunks = (nas + 63) >> 6;
    int basev = 0; if (tid < 32) basev = (int)__hip_atomic_fetch_add((unsigned*)cursor + tid, (unsigned)hist[tid], __ATOMIC_RELAXED, __HIP_MEMORY_SCOPE_AGENT);
    int myrank[2] = {0, 0}, mye[2] = {-1, -1};
#pragma unroll
    for (int cc = 0; cc < 2; ++cc) { const int c = wave + 8 * cc; if (c < nchunks) { const int idx = c * 64 + lane; const int e = idx < nas ? til[idx] : -1; mye[cc] = e;
        for (int x = 0; x < 32; ++x) { const unsigned long long m = __ballot(e == x); if (e == x) myrank[cc] = __popcll(m & ((1ull << lane) - 1ull)); if (lane == 0) ccnt[c * 32 + x] = __popcll(m); } } }
    __syncthreads();
    if (tid < 32) hist[32 + tid] = basev;
    __syncthreads();
#pragma unroll
    for (int cc = 0; cc < 2; ++cc) { const int c = wave + 8 * cc; const int idx = c * 64 + lane; if (c < nchunks && idx < nas) { const int e = mye[cc]; int pos = hist[32 + e] + myrank[cc]; for (int c2 = 0; c2 < c; ++c2) pos += ccnt[c2 * 32 + e];
        const int lr = lr_base + (idx >> 2); const size_t pi = (size_t)e * ECAP + pos; rows[pi] = grow_of(lr); roww[pi] = twl[idx]; rowd[pi] = lr * 4 + (idx & 3); } }
}

__device__ __forceinline__ void phase_ln2(const Args& a, int l, int lane, int wave) {
    const int gw = blockIdx.x * NWAVES + wave, NGW = gridDim.x * NWAVES;
    float* H = (float*)(a.ws + WS_H); const bf16* PRE = (const bf16*)(a.ws + WS_PRE); const unsigned char* YB = (const unsigned char*)(a.ws + WS_YB); bf16* A1 = (bf16*)(a.ws + WS_Y);
    const float* modv = (const float*)(a.ws + WS_MODV);
    const float* ln1g = a.in[I_LN1G] + l * 1024; const float* ln1b = a.in[I_LN1B] + l * 1024;
    const float* lng = a.in[I_LN2G] + l * 1024; const float* lnb = a.in[I_LN2B] + l * 1024;
    f32x4 P1[4], Q1[4], G2[4], g2v[4], b2v[4], P3[4], Q3[4]; int fb = -1;
    const int rows_w = (((NLAT + NGW - 1) / NGW) + 1) & ~1, lr_lo = gw * rows_w, lr_hi = lr_lo + rows_w < NLAT ? lr_lo + rows_w : NLAT;
    for (int lr0 = lr_lo; lr0 < lr_hi; lr0 += 2) {
        v2u hv[2][4]; unsigned yv[2][4][4];
#pragma unroll
        for (int q = 0; q < 2; ++q) { const int lr = lr0 + q; const size_t r = (size_t)grow_of(lr);
#pragma unroll
            for (int j = 0; j < 4; ++j) { const int c = 4 * (lane + 64 * j); hv[q][j] = *(const v2u*)(PRE + r * 1024 + c);
#pragma unroll
                for (int k = 0; k < 4; ++k) yv[q][j][k] = *(const unsigned*)(YB + ((size_t)lr * 4 + k) * 1024 + c); } }
#pragma unroll
        for (int q = 0; q < 2; ++q) {
            const int lr = lr0 + q; const size_t r = (size_t)grow_of(lr); const int b = lr >> 12;
            if (b != fb) { fb = b; const float* mv = modv + ((size_t)l * 9 + b) * 6144; const float* mv1 = modv + ((size_t)9 + b) * 6144;
#pragma unroll
                for (int j = 0; j < 4; ++j) { const int c = 4 * (lane + 64 * j); const f32x4 g1 = *(const f32x4*)(ln1g + c), b1 = *(const f32x4*)(ln1b + c), gt = *(const f32x4*)(mv + 5 * 1024 + c);
                    P1[j] = g1 * ALPHA; Q1[j] = b1 * ALPHA; G2[j] = gt * (1.f / SC_Y); g2v[j] = *(const f32x4*)(lng + c); b2v[j] = *(const f32x4*)(lnb + c);
                    if (l == 0) { const f32x4 sh = *(const f32x4*)(mv1 + c), sc = *(const f32x4*)(mv1 + 1024 + c); P3[j] = g2v[j] * (sc + 1.0f) * SC_A1; Q3[j] = (b2v[j] * (sc + 1.0f) + sh) * SC_A1; } } }
            f32x4 x[4]; float s = 0.f;
#pragma unroll
            for (int j = 0; j < 4; ++j) { const v2u p = hv[q][j]; x[j] = (f32x4){__uint_as_float(p.x << 16), __uint_as_float(p.x & 0xffff0000u), __uint_as_float(p.y << 16), __uint_as_float(p.y & 0xffff0000u)}; s += (x[j][0] + x[j][1]) + (x[j][2] + x[j][3]); }
            float mean = wave_sum(s) * (1.f / 1024.f), s2 = 0.f;
#pragma unroll
            for (int j = 0; j < 4; ++j) { x[j] = x[j] - mean; s2 += (x[j][0] * x[j][0] + x[j][1] * x[j][1]) + (x[j][2] * x[j][2] + x[j][3] * x[j][3]); }
            float rstd = rsqrtf(wave_sum(s2) * (1.f / 1024.f) + LN_EPS);
            s = 0.f;
#pragma unroll
            for (int j = 0; j < 4; ++j) { f32x4 f = {0.f, 0.f, 0.f, 0.f};
#pragma unroll
                for (int k = 0; k < 4; ++k) { const unsigned y = yv[q][j][k]; const auto lo = __builtin_amdgcn_cvt_pk_f32_fp8((int)y, false), hi = __builtin_amdgcn_cvt_pk_f32_fp8((int)y, true);
                    f[0] += lo[0]; f[1] += lo[1]; f[2] += hi[0]; f[3] += hi[1]; }
                x[j] = (x[j] * rstd) * P1[j] + Q1[j] + G2[j] * f; s += (x[j][0] + x[j][1]) + (x[j][2] + x[j][3]); }
            mean = wave_sum(s) * (1.f / 1024.f); s2 = 0.f;
#pragma unroll
            for (int j = 0; j < 4; ++j) { x[j] = x[j] - mean; s2 += (x[j][0] * x[j][0] + x[j][1] * x[j][1]) + (x[j][2] * x[j][2] + x[j][3] * x[j][3]); }
            rstd = rsqrtf(wave_sum(s2) * (1.f / 1024.f) + LN_EPS);
#pragma unroll
            for (int j = 0; j < 4; ++j) { const int c = 4 * (lane + 64 * j); const f32x4 xh = x[j] * rstd;
                const f32x4 o = xh * g2v[j] + b2v[j];
                if (l == 0) { v2u hw; hw.x = pk2(o[0], o[1]); hw.y = pk2(o[2], o[3]); *(v2u*)((bf16*)H + r * 1024 + c) = hw;
                    const f32x4 am = xh * P3[j] + Q3[j]; *(unsigned*)((unsigned char*)A1 + r * 1024 + c) = pack_fp8x4(am[0], am[1], am[2], am[3]); }
                else *(f32x4*)(a.out + (size_t)lr * 1024 + c) = o; }
        }
    }
}

__device__ __forceinline__ void phase_conv(const Args& a, LAS unsigned char* lds, int tid, int lane, int wave) {
    const bf16* U = (const bf16*)(a.ws + WS_X); bf16* V = (bf16*)(a.ws + WS_Y);
    LAS float* part = (LAS float*)(lds + 126976);
    LAS float* st = part + 512;
    const int c0 = 2 * tid;
    const float db0 = a.in[I_DWB][c0], db1 = a.in[I_DWB][c0 + 1], g0 = a.in[I_CLNG][c0], g1 = a.in[I_CLNG][c0 + 1], be0 = a.in[I_CLNB][c0], be1 = a.in[I_CLNB][c0 + 1];
    for (int tile = blockIdx.x; tile < NLAT / 32; tile += gridDim.x) {
        const int b = tile >> 7, t0 = (tile & 127) * 32;
        const size_t rb0 = (size_t)b * TPB + CTXL;
        __syncthreads();
        for (int i = tid; i < 62 * 128; i += NTHR) { const int row = i >> 7, chk = i & 127, t = t0 - 15 + row;
            v4u val = {0u, 0u, 0u, 0u}; if (t >= 0 && t < SEQ) val = *(const v4u*)(U + (rb0 + t) * 1024 + chk * 8);
            *(LAS v4u*)(lds + row * 2048 + chk * 16) = val; }
        __syncthreads();
        float w0[31], w1[31];
#pragma unroll
        for (int j = 0; j < 31; ++j) { const float2 wv = *(const float2*)(a.in[I_DWW] + j * 1024 + c0); w0[j] = wv.x; w1[j] = wv.y; }
#pragma unroll 1
        for (int hh = 0; hh < 2; ++hh) {
            const LAS unsigned char* hp = lds + hh * 16 * 2048;
            float acc0[16], acc1[16];
#pragma unroll
            for (int t = 0; t < 16; ++t) { acc0[t] = db0; acc1[t] = db1; }
#pragma unroll
            for (int s = 0; s < 46; ++s) { const unsigned pr = *(const LAS unsigned*)(hp + s * 2048 + tid * 4); const float x0 = __uint_as_float(pr << 16), x1 = __uint_as_float(pr & 0xffff0000u);
#pragma unroll
                for (int t = (s > 30 ? s - 30 : 0); t <= (s < 15 ? s : 15); ++t) { acc0[t] = fmaf(x0, w0[s - t], acc0[t]); acc1[t] = fmaf(x1, w1[s - t], acc1[t]); } }
            float rs[32];
#pragma unroll
            for (int t = 0; t < 16; ++t) { rs[2 * t] = acc0[t] + acc1[t]; rs[2 * t + 1] = acc0[t] * acc0[t] + acc1[t] * acc1[t]; }
#define RS_STEP(NKEEP, XORV) { const bool bit_ = (lane & XORV) != 0; _Pragma("unroll") for (int k_ = 0; k_ < NKEEP; ++k_) { const float snd_ = bit_ ? rs[k_] : rs[k_ + NKEEP]; const float rcv_ = __shfl_xor(snd_, XORV); rs[k_] = (bit_ ? rs[k_ + NKEEP] : rs[k_]) + rcv_; } }
            RS_STEP(16, 32) RS_STEP(8, 16) RS_STEP(4, 8) RS_STEP(2, 4) RS_STEP(1, 2)
#undef RS_STEP
            rs[0] += __shfl_xor(rs[0], 1);
            __syncthreads();
            if ((lane & 1) == 0) part[wave * 32 + (lane >> 1)] = rs[0];
            __syncthreads();
            if (tid < 16) { float s1 = 0.f, s2 = 0.f;
#pragma unroll
                for (int w = 0; w < 8; ++w) { s1 += part[w * 32 + 2 * tid]; s2 += part[w * 32 + 2 * tid + 1]; }
                const float mean = s1 * (1.f / 1024.f); const float var = fmaxf(s2 * (1.f / 1024.f) - mean * mean, 0.f); st[2 * tid] = mean; st[2 * tid + 1] = rsqrtf(var + LN_EPS); }
            __syncthreads();
#pragma unroll
            for (int t = 0; t < 16; ++t) { const float mean = st[2 * t], rstd = st[2 * t + 1];
                const float y0 = (acc0[t] - mean) * rstd * g0 + be0, y1 = (acc1[t] - mean) * rstd * g1 + be1;
                const float z0 = fminf(fmaxf(y0 * sigm(y0) * SC_CV, -448.f), 448.f), z1 = fminf(fmaxf(y1 * sigm(y1) * SC_CV, -448.f), 448.f);
                *(unsigned short*)((unsigned char*)V + (rb0 + t0 + hh * 16 + t) * 1024 + c0) = (unsigned short)__builtin_amdgcn_cvt_pk_fp8_f32(z0, z1, 0, false); }
        }
    }
}

namespace hg {
using bf16x8 = __attribute__((ext_vector_type(8))) short;
using s16x4  = __attribute__((ext_vector_type(4))) short;
using f32x16 = __attribute__((ext_vector_type(16))) float;
using u32x4  = __attribute__((ext_vector_type(4))) unsigned;
constexpr int RS = 272;
constexpr int VS = 80;
constexpr int T_Q = 0, T_KO = 32 * RS, T_D = 64 * RS, IMG_BYTES = T_D + 512, T_V = IMG_BYTES, TILE_BYTES = T_V + 32 * VS;
constexpr int OFF_TILES = 1024, NTB = 3, OFF_OPART = OFF_TILES + NTB * TILE_BYTES, OPART_BYTES = 4 * 4096;
static_assert(OFF_OPART + 2 * OPART_BYTES <= 131072 && IMG_BYTES % 16 == 0 && IMG_BYTES / 16 == 1120, "hgrn lds");
constexpr int P_RAW = 1024, R_Q = 0, R_F = 32 * RS, RAW_BYTES = 64 * RS, P_IMG = P_RAW + RAW_BYTES;
constexpr int NCHUNK = TPB / 32, NCHAIN = NB * 4 * 2, NITEM = NCHAIN * NCHUNK;
__device__ __forceinline__ int crow(int r, int hi) { return (r & 3) + 8 * (r >> 2) + 4 * hi; }
__device__ __forceinline__ s16x4 tr_read(unsigned addr) { s16x4 r; asm volatile("ds_read_b64_tr_b16 %0, %1" : "=&v"(r) : "v"(addr) : "memory"); return r; }
__device__ __forceinline__ bf16x8 cat8(s16x4 l, s16x4 h) { return (bf16x8){l[0], l[1], l[2], l[3], h[0], h[1], h[2], h[3]}; }
__device__ __forceinline__ bf16x8 pack8(const f32x16& x, int base) {
    u32x4 w; w[0] = pk2(x[base + 0], x[base + 1]); w[1] = pk2(x[base + 2], x[base + 3]); w[2] = pk2(x[base + 4], x[base + 5]); w[3] = pk2(x[base + 6], x[base + 7]);
    return *reinterpret_cast<bf16x8*>(&w);
}
}


#define HG_TOKP(dir, n) ((dir) ? ((n) < CTXL ? (CTXL - 1 - (n)) : (TPB + CTXL - 1 - (n))) : (n))
#define HG_DPP1(x, ctrl, rmask) __int_as_float(__builtin_amdgcn_update_dpp(0x3f800000, __float_as_int(x), ctrl, rmask, 0xf, false))
#define HG_DPP(x, ctrl, rmask) __int_as_float(__builtin_amdgcn_update_dpp(0, __float_as_int(x), ctrl, rmask, 0xf, false))
__device__ __forceinline__ void hgrn_prep_items(const Args& a, LAS unsigned char* lds, int tid) {
    using namespace hg;
    const bf16* Z = (const bf16*)(a.ws + WS_Z);
    unsigned char* HT = a.ws + WS_HT;
    const int wave = __builtin_amdgcn_readfirstlane(tid >> 6), lane = tid & 63, t = lane & 31, half = lane >> 5;
    const int c0 = 16 * wave + 8 * half;
    const int lr = tid >> 4, lch = tid & 15;
    LAS float* lbt = (LAS float*)lds;
    constexpr int P_RAW2 = 2048, P_IMG2 = P_RAW2 + 2 * RAW_BYTES;
    static_assert(P_IMG2 + 2 * IMG_BYTES <= 131072, "prep lds");
    __syncthreads();
    { const float l0 = a.in[I_LBL][tid], l1 = a.in[I_LBL][512 + tid], l2 = a.in[I_LBL][1024 + tid]; const float m = fmaxf(l0, fmaxf(l1, l2));
      const float e0 = __expf(l0 - m), e1 = __expf(l1 - m), e2 = __expf(l2 - m); lbt[tid] = e0 / (e0 + e1 + e2); }
    bf16x8 gq, gf;
#define HP_LOAD(it) do { const int ch_ = (it) % NCHUNK, cn_ = (it) / NCHUNK, dir_ = cn_ & 1, hd_ = (cn_ >> 1) & 3, b_ = cn_ >> 3; \
        const bf16* zr_ = Z + ((size_t)b_ * TPB + HG_TOKP(dir_, 32 * ch_ + lr)) * ZC; gq = *(const bf16x8*)(zr_ + ZHQ + hd_ * 128 + lch * 8); gf = *(const bf16x8*)(zr_ + (dir_ ? ZHB : ZHF) + hd_ * 128 + lch * 8); } while (0)
#define HP_STASH(bufi) do { LAS unsigned char* rb_ = lds + P_RAW2 + (bufi) * RAW_BYTES; *(LAS bf16x8*)(rb_ + R_Q + lr * RS + lch * 16) = gq; *(LAS bf16x8*)(rb_ + R_F + lr * RS + lch * 16) = gf; } while (0)
#define HP_COPYOUT(item, bufi) do { v4u* dst_ = (v4u*)(HT + (size_t)(item) * IMG_BYTES); const LAS v4u* src_ = (const LAS v4u*)(lds + P_IMG2 + (bufi) * IMG_BYTES); \
        dst_[tid] = src_[tid]; dst_[tid + 512] = src_[tid + 512]; if (tid < 96) dst_[tid + 1024] = src_[tid + 1024]; } while (0)
    const int G = gridDim.x;
    int it = blockIdx.x, par = 0;
    if (it < NITEM) { HP_LOAD(it); HP_STASH(0); }
    if (it + G < NITEM) HP_LOAD(it + G);
    __syncthreads();
    for (; it < NITEM; it += G, par ^= 1) {
        if (it + G < NITEM) HP_STASH(par ^ 1);
        if (it != (int)blockIdx.x) HP_COPYOUT(it - G, par ^ 1);
        if (it + 2 * G < NITEM) HP_LOAD(it + 2 * G);
        const int hd = ((it / NCHUNK) >> 1) & 3;
        {
            const LAS unsigned char* rb_ = lds + P_RAW2 + par * RAW_BYTES;
            const bf16x8 RQ = *(const LAS bf16x8*)(rb_ + R_Q + t * RS + c0 * 2), RF = *(const LAS bf16x8*)(rb_ + R_F + t * RS + c0 * 2);
            const f32x4 lbA = *(const LAS f32x4*)(lbt + hd * 128 + c0), lbB = *(const LAS f32x4*)(lbt + hd * 128 + c0 + 4);
            LAS unsigned char* tb_ = lds + P_IMG2 + par * IMG_BYTES;
            float bb_[8], kk_[8];
#pragma unroll
            for (int i_ = 0; i_ < 8; ++i_) { const float lb_ = i_ < 4 ? lbA[i_] : lbB[i_ - 4]; const float f_ = lb_ + (1.f - lb_) * __builtin_amdgcn_rcpf(1.f + __expf(-bf2f((unsigned short)RF[i_]))); kk_[i_] = 1.f - f_; bb_[i_] = f_; }
#pragma unroll
            for (int i_ = 0; i_ < 8; ++i_) { float x_ = bb_[i_]; x_ *= HG_DPP1(x_, 0x111, 0xf); x_ *= HG_DPP1(x_, 0x112, 0xf); x_ *= HG_DPP1(x_, 0x114, 0xf); x_ *= HG_DPP1(x_, 0x118, 0xf);
                x_ *= HG_DPP1(x_, 0x142, 0xa); bb_[i_] = x_; }
            float qi_[8], ko_[8], dd_[8];
#pragma unroll
            for (int i_ = 0; i_ < 8; ++i_) { const int bi_ = __float_as_int(bb_[i_]); dd_[i_] = __int_as_float(half ? __builtin_amdgcn_readlane(bi_, 63) : __builtin_amdgcn_readlane(bi_, 31));
                const float e_ = bb_[i_]; const float ei_ = __builtin_amdgcn_rcpf(e_);
                qi_[i_] = bf2f((unsigned short)RQ[i_]) * e_; ko_[i_] = kk_[i_] * ei_; }
            *(LAS v4u*)(tb_ + T_Q + t * RS + c0 * 2) = (v4u){pk2(qi_[0], qi_[1]), pk2(qi_[2], qi_[3]), pk2(qi_[4], qi_[5]), pk2(qi_[6], qi_[7])};
            *(LAS v4u*)(tb_ + T_KO + t * RS + c0 * 2) = (v4u){pk2(ko_[0], ko_[1]), pk2(ko_[2], ko_[3]), pk2(ko_[4], ko_[5]), pk2(ko_[6], ko_[7])};
            if (t == 31) { *(LAS f32x4*)(tb_ + T_D + c0 * 4) = (f32x4){dd_[0], dd_[1], dd_[2], dd_[3]}; *(LAS f32x4*)(tb_ + T_D + c0 * 4 + 16) = (f32x4){dd_[4], dd_[5], dd_[6], dd_[7]}; }
            if (tid < 32) *(LAS v4u*)(tb_ + T_Q + tid * RS + 256) = (v4u){0u, 0u, 0u, 0u};
            else if (tid < 64) *(LAS v4u*)(tb_ + T_KO + (tid - 32) * RS + 256) = (v4u){0u, 0u, 0u, 0u};
        }
        __syncthreads();
    }
    if (it - G >= (int)blockIdx.x && it - G < NITEM) HP_COPYOUT(it - G, par ^ 1);
    __syncthreads();
#undef HP_COPYOUT
#undef HP_LOAD
#undef HP_STASH
}

__device__ __forceinline__ void hgrn_unit_mfma(const Args& a, int unit, LAS unsigned char* lds, int tid) {
    using namespace hg;
    const int b = unit >> 5, head = (unit >> 3) & 3, dir = (unit >> 2) & 1, sl = unit & 3;
    const bf16* Z = (const bf16*)(a.ws + WS_Z);
    const unsigned char* HT = a.ws + WS_HT + (size_t)((b * 4 + head) * 2 + dir) * NCHUNK * IMG_BYTES;
    bf16* Od = (bf16*)(a.ws + (dir ? WS_OB : WS_OF));
    const int wave = __builtin_amdgcn_readfirstlane(tid >> 6), lane = tid & 63;
    const size_t zb = (size_t)b * TPB;
    constexpr int NCH = NCHUNK;
    const int vr = (tid >> 2) & 31, vp = tid & 3, lvcol = ZHI + head * 128 + sl * 32 + vp * 8, i3 = 1024 + (tid < 96 ? tid : 0);
    v4u gA0, gA1, gA2, gB0, gB1, gB2; bf16x8 gAv, gBv;
#define HG_LOAD(g0, g1, g2, gv, ch) do { const int c_ = (ch) < NCH ? (ch) : NCH - 1; const v4u* src_ = (const v4u*)(HT + (size_t)c_ * IMG_BYTES); \
        g0 = src_[tid]; g1 = src_[tid + 512]; g2 = src_[i3]; gv = *(const bf16x8*)(Z + (zb + HG_TOKP(dir, 32 * c_ + vr)) * ZC + lvcol); } while (0)
#define HG_STASH(g0, g1, g2, gv, bufi) do { LAS unsigned char* tb_ = lds + OFF_TILES + (bufi) * TILE_BYTES; LAS v4u* d_ = (LAS v4u*)tb_; \
        d_[tid] = g0; d_[tid + 512] = g1; if (tid < 96) d_[tid + 1024] = g2; if (tid < 128) *(LAS bf16x8*)(tb_ + T_V + vr * VS + vp * 16) = gv; } while (0)
    const int r32 = lane & 31, hi = lane >> 5, g1 = (lane >> 4) & 1, q4 = (lane & 15) >> 2, p4 = lane & 3, cb = 32 * wave;
    const unsigned lbase = (unsigned)(uintptr_t)lds;
    f32x16 S = {};
    HG_LOAD(gA0, gA1, gA2, gAv, 0); HG_STASH(gA0, gA1, gA2, gAv, 0); HG_LOAD(gA0, gA1, gA2, gAv, 1); HG_STASH(gA0, gA1, gA2, gAv, 1);
    HG_LOAD(gA0, gA1, gA2, gAv, 2);
    __syncthreads();
#define HG_RD64(dst, addr, OFFS) asm volatile("ds_read_b64 %0, %1 offset:" #OFFS : "=&v"(dst) : "v"(addr) : "memory")
#define HG_MFMA_STAGE(n, bufi) do { \
            const unsigned tb = lbase + OFF_TILES + (bufi) * TILE_BYTES; const LAS unsigned char* tl_ = lds + OFF_TILES + (bufi) * TILE_BYTES; \
            bf16x8 ko[2], qi[2]; s16x4 pvl[2], pvh[2], pql[2], pqh[2], kl[2], kh[2], nvl[2], nvh[2]; f32x4 dsc[4]; \
            _Pragma("unroll") for (int kk = 0; kk < 2; ++kk) { ko[kk] = *(const LAS bf16x8*)(tl_ + T_KO + r32 * RS + (cb + 16 * kk + 8 * hi) * 2); qi[kk] = *(const LAS bf16x8*)(tl_ + T_Q + r32 * RS + (cb + 16 * kk + 8 * hi) * 2); } \
            _Pragma("unroll") for (int sp = 0; sp < 2; ++sp) { \
                const unsigned va = tb + T_V + (16 * sp + 4 * hi + q4) * VS + (16 * g1 + 4 * p4) * 2; pvl[sp] = tr_read(va); pvh[sp] = tr_read(va + 8 * VS);              \
                const unsigned qa = tb + T_Q + r32 * RS + (cb + 16 * sp + 4 * hi) * 2; HG_RD64(pql[sp], qa, 0); HG_RD64(pqh[sp], qa, 16);                                  \
                const unsigned ka = tb + T_KO + (16 * sp + 8 * hi + q4) * RS + (cb + 16 * g1 + 4 * p4) * 2; kl[sp] = tr_read(ka); kh[sp] = tr_read(ka + 4 * RS);        \
                const unsigned vb = tb + T_V + (16 * sp + 8 * hi + q4) * VS + (16 * g1 + 4 * p4) * 2; nvl[sp] = tr_read(vb); nvh[sp] = tr_read(vb + 4 * VS); }            \
            _Pragma("unroll") for (int g = 0; g < 4; ++g) dsc[g] = *(const LAS f32x4*)(tl_ + T_D + (cb + 8 * g + 4 * hi) * 4); \
            asm volatile("s_waitcnt lgkmcnt(0)" ::: "memory"); __builtin_amdgcn_sched_barrier(0); \
            f32x16 X = {}; \
            X = __builtin_amdgcn_mfma_f32_32x32x16_bf16(ko[0], qi[0], X, 0, 0, 0); X = __builtin_amdgcn_mfma_f32_32x32x16_bf16(ko[1], qi[1], X, 0, 0, 0); \
            f32x16 O = {}; \
            O = __builtin_amdgcn_mfma_f32_32x32x16_bf16(cat8(pql[0], pqh[0]), pack8(S, 0), O, 0, 0, 0); O = __builtin_amdgcn_mfma_f32_32x32x16_bf16(cat8(pql[1], pqh[1]), pack8(S, 8), O, 0, 0, 0); \
            S = __builtin_amdgcn_mfma_f32_32x32x16_bf16(cat8(kl[0], kh[0]), cat8(nvl[0], nvh[0]), S, 0, 0, 0); S = __builtin_amdgcn_mfma_f32_32x32x16_bf16(cat8(kl[1], kh[1]), cat8(nvl[1], nvh[1]), S, 0, 0, 0); \
            _Pragma("unroll") for (int i = 0; i < 16; ++i) X[i] = (crow(i, hi) <= r32) ? X[i] : 0.f; \
            O = __builtin_amdgcn_mfma_f32_32x32x16_bf16(pack8(X, 0), cat8(pvl[0], pvh[0]), O, 0, 0, 0); O = __builtin_amdgcn_mfma_f32_32x32x16_bf16(pack8(X, 8), cat8(pvl[1], pvh[1]), O, 0, 0, 0); \
            _Pragma("unroll") for (int i = 0; i < 16; ++i) S[i] *= dsc[i >> 2][i & 3]; \
            LAS float* op = (LAS float*)(lds + OFF_OPART + ((n) & 1) * OPART_BYTES + wave * 4096); \
            _Pragma("unroll") for (int i = 0; i < 16; ++i) op[crow(i, hi) * 32 + r32] = O[i]; } while (0)
#define HG_OUT_STAGE(n) do { \
            const int l2 = tid - 256, tt = l2 >> 3, vq = l2 & 7; \
            const LAS float* op = (const LAS float*)(lds + OFF_OPART + (((n) - 1) & 1) * OPART_BYTES) + tt * 32 + vq * 4; \
            const f32x4 s = (*(const LAS f32x4*)op + *(const LAS f32x4*)(op + 1024)) + (*(const LAS f32x4*)(op + 2048) + *(const LAS f32x4*)(op + 3072)); \
            const int p = HG_TOKP(dir, 32 * ((n) - 1) + tt); \
            if (p >= CTXL) *(v2u*)(Od + (zb + p) * 512 + head * 128 + sl * 32 + vq * 4) = (v2u){pk2(s[0], s[1]), pk2(s[2], s[3])}; } while (0)
#define HG_ITER(n, L0, L1, L2, LV, S0, S1, S2, SV) do { \
        HG_LOAD(L0, L1, L2, LV, (n) + 3); \
        if (wave < 4) { HG_MFMA_STAGE(n, bcur); } else if ((n) > 0) { HG_OUT_STAGE(n); } \
        { const int bst_ = bcur == 0 ? 2 : bcur - 1; HG_STASH(S0, S1, S2, SV, bst_); } \
        bcur = bcur == 2 ? 0 : bcur + 1; \
        __syncthreads(); } while (0)
    int bcur = 0;
    for (int n = 0; n < NCH; n += 2) {
        HG_ITER(n, gB0, gB1, gB2, gBv, gA0, gA1, gA2, gAv);
        HG_ITER(n + 1, gA0, gA1, gA2, gAv, gB0, gB1, gB2, gBv);
    }
    if (wave >= 4) { HG_OUT_STAGE(NCH); }
    __syncthreads();
#undef HG_MFMA_STAGE
#undef HG_OUT_STAGE
#undef HG_ITER
#undef HG_LOAD
#undef HG_STASH
#undef HG_RD64
}

__device__ __forceinline__ bool in_range(int lo, int hi, int k) { asm volatile("" : "+s"(lo), "+s"(hi)); return lo <= k && k < hi; }
constexpr int NPHASES = 21;
__global__ void __launch_bounds__(NTHR, 2) fwd_kernel(Args args) {
    extern __shared__ __attribute__((aligned(16))) unsigned char lds_raw[];
    LAS unsigned char* lds = (LAS unsigned char*)lds_raw;
    const int G = gridDim.x;
#define FRESH() int tid = threadIdx.x; asm volatile("" : "+v"(tid)); const int lane = tid & 63, wave = __builtin_amdgcn_readfirstlane(tid >> 6); (void)lane; (void)wave
    unsigned char* ws = args.ws;
    if (threadIdx.x < 16) ((LAS unsigned*)(lds + LDS_BAR_OFF))[threadIdx.x] = 0u;
    __syncthreads();
    XcdBarrier bar = xcd_barrier_post((unsigned*)(ws + WS_CTL), (volatile LAS unsigned*)(lds + LDS_BAR_OFF));
    const int lo = args.ph_lo, hi = args.ph_hi;
#define IN(k) in_range(lo, hi, (k))
#define NREP(k) (((PROBE_MASK >> (k)) & 1u) ? 2 : 1)
#define REPEAT(k) for (int rep_ = 0; rep_ < NREP(k); ++rep_) if (rep_ == 0 || (xcd_barrier(bar), true))
#define SEAM(k) do { if (IN(k) && IN((k) + 1)) xcd_barrier(bar); } while (0)
    bf16* const BX = (bf16*)(ws + WS_X); bf16* const BY = (bf16*)(ws + WS_Y);
    const float* const MODV = (const float*)(ws + WS_MODV);

#if defined(PROBE_BARS)
    for (int pbi = 0; pbi < PROBE_BARS; ++pbi) xcd_barrier(bar);
#endif
    if (IN(0)) REPEAT(0) { FRESH(); phase_prologue(args, lds, tid, lane, wave); } SEAM(0);
    if (IN(1)) REPEAT(1) { FRESH(); phase_mod0(args, lane, wave); } SEAM(1);
    if (IN(2)) REPEAT(2) {
        pg8::Gemm g{BX, (const bf16*)(ws + WS_WIN), NTOK, ZC, 512}; pg8::AllOrder S; S.init(NTOK / 256, ZC / 256, G, (int)blockIdx.x);
        pg8::EpiBf16<0> E{(bf16*)(ws + WS_Z), ZC, nullptr, ZC, 0, 1.f / (SC_A0 * SC_WIN)};
        pg8::gemm_phase<pg8::EpiBf16<0>, pg8::AllOrder, PG8_ALIGN, true, false, true>(lds, g, S, E);
    } SEAM(2);
    if (IN(3)) REPEAT(3) { FRESH(); phase_norm0(args, lane, wave); hgrn_prep_items(args, lds, tid); } SEAM(3);
    if (IN(4)) REPEAT(4) {
        { pg8::Gemm g{(const bf16*)(ws + WS_CQN), (const bf16*)(ws + WS_WUQ), NTOK, 768, 384}; pg8::LatOrder S; S.init(128, 3, G, (int)blockIdx.x);
          pg8::EpiBf16<0> E{(bf16*)(ws + WS_Q), 768, nullptr, 0, 0, 1.f};
          pg8::gemm_phase<pg8::EpiBf16<0>, pg8::LatOrder, PG8_ALIGN, PG8_SP2>(lds, g, S, E); }
        __syncthreads();
        { pg8::Gemm g{(const bf16*)(ws + WS_CKVN), (const bf16*)(ws + WS_WUKV), NTOK, 1024, 256}; pg8::AllOrder S; S.init(NTOK / 256, 4, G, G - 1 - (int)blockIdx.x);
          pg8::EpiBf16<0> E{(bf16*)(ws + WS_KV), 1024, nullptr, 0, 0, 1.f};
          pg8::gemm_phase<pg8::EpiBf16<0>, pg8::AllOrder, PG8_ALIGN, PG8_SP2>(lds, g, S, E); }
    } SEAM(4);
    if (IN(5)) {
        REPEAT(21) { FRESH();
        for (int u = blockIdx.x; u < 256; u += G) { __syncthreads(); hgrn_unit_mfma(args, (G == 256) ? ((u & 7) * 32 + (u >> 3)) : u, lds, tid); } }
        const bf16* Q = (const bf16*)(ws + WS_Q); const bf16* KV = (const bf16*)(ws + WS_KV); const bf16* KRR = (const bf16*)(ws + WS_KRR);
        const float* rope = (const float*)(ws + WS_ROPE);
        const int cslot = (G == 256) ? ((((int)blockIdx.x & 7) * 2 + (((int)blockIdx.x >> 3) >> 4)) % 5) : 0;
        REPEAT(22) {
        int ai = 0;
        for (int slot = 0; slot < 5; ++slot) {
            if (slot == cslot) { if (rep_ == 0) { FRESH(); __syncthreads(); convert_moe_share(args, lds, lane, wave); } continue; }
            for (int u = (G == 256) ? (int)blockIdx.x + ai * 256 : (int)blockIdx.x; u < ((G == 256) ? (int)blockIdx.x + ai * 256 + 1 : (ai == 0 ? 1024 : 0)); u += G) {
                int b, h, qb; if (G == 256) { const int x = (int)blockIdx.x & 7, j = (int)blockIdx.x >> 3, pr = (u >> 8) * 16 + 2 * x + (j >> 4); b = pr >> 3; h = pr & 7; qb = j & 15; } else { b = u >> 7; h = (u >> 4) & 7; qb = u & 15; }
                const size_t kb = (size_t)b * TPB, q0 = kb + CTXL + (size_t)qb * 256;
                __syncthreads();
                att::attn_unit(Q + q0 * 768 + h * 96, KV + kb * 1024 + h * 64, KRR + kb * 32, BY + q0 * 1024 + h * 64, rope + (size_t)qb * 256 * 32, TPB, (char*)lds_raw);
            }
            ++ai;
        }
        }
    } SEAM(5);
    if (IN(6)) REPEAT(6) { FRESH(); phase_readout(args, lane, wave); } SEAM(6);
    if (IN(7)) REPEAT(7) {
        pg8::Gemm g{BY, (const bf16*)(ws + WS_WOUT), NTOK, 1024, 1024}; pg8::LatOrder S; S.init(128, 4, G, (int)blockIdx.x);
        pg8::EpiRes<false> E{args.in[I_X], nullptr, (bf16*)(ws + WS_PRE), MODV, nullptr, 1.f};
        pg8::gemm_phase<pg8::EpiRes<false>, pg8::LatOrder, PG8_ALIGN, PG8_SP2>(lds, g, S, E);
    } SEAM(7);
    for (int l = 0; l < 2; ++l) {
        if (l == 1) {
            if (IN(13)) REPEAT(13) {
                pg8::Gemm g{BY, (const bf16*)(ws + WS_WPW1), NTOK, 2048, 512}; pg8::LatOrder S; S.init(128, 8, G, (int)blockIdx.x);
                pg8::EpiGate<0> E{BX, (const float*)(ws + WS_PW1B), 8, 1.f / (SC_A1 * SC_WPW), 1.f, lds};
                pg8::gemm_phase<pg8::EpiGate<0>, pg8::LatOrder, PG8_ALIGN, true, false, true>(lds, g, S, E);
            } SEAM(13);
            if (IN(14)) REPEAT(14) { FRESH(); phase_conv(args, lds, tid, lane, wave); } SEAM(14);
            if (IN(15)) REPEAT(15) {
                pg8::Gemm g{BY, (const bf16*)(ws + WS_WPW2), NTOK, 1024, 512}; pg8::LatOrder S; S.init(128, 4, G, (int)blockIdx.x);
                pg8::EpiRes<true> E{nullptr, (const bf16*)(ws + WS_H), (bf16*)(ws + WS_PRE), MODV + 9 * 6144, args.in[I_PW2B], 1.f / (SC_CV * SC_WPW)};
                pg8::gemm_phase<pg8::EpiRes<true>, pg8::LatOrder, PG8_ALIGN, true, false, true>(lds, g, S, E);
            } SEAM(15);
        }
        const int pb = l ? 16 : 8;
        if (IN(pb)) REPEAT(pb) { FRESH(); phase_ln1(args, l, lds, tid, lane, wave); } SEAM(pb);
        if (IN(pb + 2) || IN(pb + 3)) {
            LAS int* tl = (LAS int*)(lds + LDS_TILE_E);
            FRESH();
            __syncthreads();
            if (tid < 32) tl[3 * MAXTILES + 64 + tid] = ld_ctl((const int*)(ws + WS_CURSOR) + l * 32 + tid);
            __syncthreads();
            if (tid == 0) { int ts = 0; for (int e = 0; e < 32; ++e) { tl[3 * MAXTILES + e] = ts; ts += (tl[3 * MAXTILES + 64 + e] + 255) >> 8; } tl[3 * MAXTILES + 32] = ts; }
            __syncthreads();
            const int ntiles = tl[3 * MAXTILES + 32];
            for (int t = tid; t < ntiles && t < MAXTILES; t += NTHR) { int e = 0; while (e < 31 && tl[3 * MAXTILES + e + 1] <= t) ++e; const int j = t - tl[3 * MAXTILES + e], rem = tl[3 * MAXTILES + 64 + e] - 256 * j;
                tl[t] = e; tl[MAXTILES + t] = e * ECAP + 256 * j; tl[2 * MAXTILES + t] = rem < 256 ? rem : 256; }
            __syncthreads();
            if (IN(pb + 2)) REPEAT(pb + 2) {
#if defined(PROBE_STAGGER)
                if (blockIdx.x & 1) { const unsigned long long t0 = __builtin_amdgcn_s_memrealtime(); while (__builtin_amdgcn_s_memrealtime() - t0 < PROBE_STAGGER) __builtin_amdgcn_s_sleep(8); }
#endif
                pg8::Gemm g{BX, (const bf16*)(ws + WS_WGU + (size_t)l * 32 * 2048 * 1024), 0, 0, 512};
                pg8::MoeOrder S; S.init(ntiles, 8, G, (int)blockIdx.x); S.tile_e = tl; S.nper = 8;
                pg8::EpiGate<1, true> E{(bf16*)(ws + WS_ACT), (const float*)(ws + WS_BGU) + (size_t)l * 32 * 2048, 8, 1.f / (SC_X8 * SC_WGU) * PROBE_KSC, SC_ACT, lds};
                pg8::gemm_phase<pg8::EpiGate<1, true>, pg8::MoeOrder, PG8_ALIGN, true, true, true>(lds, g, S, E, (const int*)(ws + WS_ROWS), tl + MAXTILES);
            } SEAM(pb + 2);
            if (IN(pb + 3)) REPEAT(pb + 3) {
                pg8::Gemm g{(const bf16*)(ws + WS_ACT), (const bf16*)(ws + WS_WDN + (size_t)l * 32 * 1024 * 1024), 0, 0, 512};
                pg8::MoeOrder S; S.init(ntiles, 4, G, (int)blockIdx.x); S.tile_e = tl; S.nper = 4;
                pg8::EpiDown E{(bf16*)(ws + WS_YB), args.in[I_BDN] + (size_t)l * 32 * 1024, (const float*)(ws + WS_ROWW), (const int*)(ws + WS_ROWD), 1.f / (SC_ACT * SC_WDN) * PROBE_KSC, tl + MAXTILES, SC_Y, lds};
                pg8::gemm_phase<pg8::EpiDown, pg8::MoeOrder, PG8_ALIGN, true, false, true>(lds, g, S, E);
            } SEAM(pb + 3);
        }
        if (IN(pb + 4)) REPEAT(pb + 4) { FRESH(); phase_ln2(args, l, lane, wave); }
        if (l == 0) SEAM(12);
    }
#undef IN
#undef SEAM
}

extern "C" void kernel_launch(void* const* d_in, const int* in_sizes, int n_in, void* d_out, int out_size, void* d_ws, size_t ws_size, hipStream_t stream) {
    static int grid = 0;
    if (grid == 0) {
        if (n_in != 33 || in_sizes[0] != NB * SEQ * D || out_size != NB * SEQ * D || ws_size < WS_END) {
            fprintf(stderr, "kernel_launch: unexpected shapes: n_in %d in0 %d out %d ws %zu (need %zu)\n", n_in, n_in > 0 ? in_sizes[0] : -1, out_size, ws_size, (size_t)WS_END); grid = -1; return; }
        int dev = 0, cus = 0;
        if (hipGetDevice(&dev) != hipSuccess || hipDeviceGetAttribute(&cus, hipDeviceAttributeMultiprocessorCount, dev) != hipSuccess) { grid = -1; return; }
        if (hipFuncSetAttribute((const void*)fwd_kernel, hipFuncAttributeMaxDynamicSharedMemorySize, LDS_BYTES) != hipSuccess) { fprintf(stderr, "kernel_launch: hipFuncSetAttribute failed\n"); grid = -1; return; }
        int per_cu = 0;
        if (hipOccupancyMaxActiveBlocksPerMultiprocessor(&per_cu, (const void*)fwd_kernel, NTHR, LDS_BYTES) != hipSuccess || per_cu < 1) fprintf(stderr, "kernel_launch: occupancy query reports %d\n", per_cu);
        (void)hipGetLastError();
        grid = cus;
    }
    if (grid < 0) return;
    if (hipMemsetAsync((char*)d_ws + WS_CTL, 0, CTL_ZERO_BYTES, stream) != hipSuccess) return;
    Args a{};
    for (int i = 0; i < 33; ++i) a.in[i] = (const float*)d_in[i];
    a.out = (float*)d_out; a.ws = (unsigned char*)d_ws;
#if MK_ONE_LAUNCH
    a.ph_lo = 0; a.ph_hi = NPHASES;
    hipLaunchKernelGGL(fwd_kernel, dim3(grid), dim3(NTHR), LDS_BYTES, stream, a);
#else
    for (int ph = 0; ph < NPHASES; ++ph) { a.ph_lo = ph; a.ph_hi = ph + 1; hipLaunchKernelGGL(fwd_kernel, dim3(grid), dim3(NTHR), LDS_BYTES, stream, a); }
#endif
    const hipError_t le = hipPeekAtLastError();
    if (le != hipSuccess) fprintf(stderr, "kernel_launch: launch failed: %s\n", hipGetErrorName(le));
}
```

```cpp
#include <hip/hip_runtime.h>
#include <cstdio>
#include <cstdint>

#ifndef PROBE_MASK
#define PROBE_MASK 0u
#endif
#if defined(PROBE_K2)
#define PROBE_KSC 0.5f
#else
#define PROBE_KSC 1.0f
#endif
#ifndef MK_ONE_LAUNCH
#define MK_ONE_LAUNCH 1
#endif

namespace pg8 {
#define PG8_LAS __attribute__((address_space(3)))
typedef unsigned short bf16_t;
typedef short bf16x8 __attribute__((ext_vector_type(8)));
typedef float f32x4 __attribute__((ext_vector_type(4)));
typedef unsigned u32x4 __attribute__((ext_vector_type(4)));
constexpr int BM = 256, BK = 64, HALF = 128, HTB = HALF * BK * 2  , STAGE_BYTES = 8 * HTB, NXCD = 8, WGM = 8;

__host__ __device__ __forceinline__ int lds_byte(int r, int c) { const int st = (r >> 4) * 2 + (c >> 5), rr = r & 15, cc = c & 31, ob = rr * 64 + cc * 2; return st * 1024 + (ob ^ (((ob >> 9) & 1) << 5)); }
__host__ __device__ __forceinline__ void stage_rc(int b, int& R, int& C) { const int st = b / 1024, sb = b % 1024, swz = sb ^ (((sb >> 9) & 1) << 5); R = (st >> 1) * 16 + swz / 64; C = (st & 1) * 32 + (swz % 64) / 2; }
__host__ __device__ __forceinline__ int perm32(int rho) { const int n = rho >> 4, i = rho & 15; return 8 * (i >> 2) + 4 * n + (i & 3); }

struct Unit { int pm, pn; };
struct Gemm { const bf16_t* A; const bf16_t* Bt; int M, N, K; };

struct StaticOrder {
    int nM, nN, nwg, G, c;
    __host__ __device__ void init(int M, int N, int G_, int c_) { nM = M / BM; nN = N / BM; nwg = nM * nN; G = G_; c = c_; }
    __host__ __device__ bool next(int i, Unit& u) const {
        const long L = (long)i * G + c; if (L >= nwg) return false;
        int wgid = (int)L; { const int q = nwg / NXCD, r = nwg % NXCD, xcd = wgid % NXCD, off = wgid / NXCD; wgid = (xcd < r ? xcd * (q + 1) : r * (q + 1) + (xcd - r) * q) + off; }
        const int nig = WGM * nN, gid = wgid / nig, fm = gid * WGM, gsz = (nM - fm) < WGM ? (nM - fm) : WGM;
        u.pm = fm + ((wgid % nig) % gsz); u.pn = (wgid % nig) / gsz; return true;
    }
    __device__ __forceinline__ void a_ready(const Unit&) const {}
    __device__ __forceinline__ void done(const Unit&) const {}
};

__device__ __forceinline__ unsigned cvt_pk_bf16(float lo, float hi) { unsigned r; asm volatile("v_cvt_pk_bf16_f32 %0, %1, %2" : "=v"(r) : "v"(lo), "v"(hi)); return r; }
typedef float f32x2 __attribute__((ext_vector_type(2)));
__device__ __forceinline__ f32x2 gelu_pk(f32x2 v) {
    const f32x2 av = __builtin_elementwise_abs(v), d = av * 0.2316418882f + 1.0f;
    f32x2 t; t.x = __builtin_amdgcn_rcpf(d.x); t.y = __builtin_amdgcn_rcpf(d.y);
    f32x2 q = t * 0.5307027145f + (-0.7265760135f); q = q * t + 0.7107068705f; q = q * t + (-0.142248368f); q = q * t + 0.127414796f; q = q * t;
    const f32x2 s = (v * v) * (-0.72134752044f);
    f32x2 e; e.x = __builtin_amdgcn_exp2f(s.x); e.y = __builtin_amdgcn_exp2f(s.y);
    const f32x2 m = v * (q * e), r = v - m;
    f32x2 o; o.x = v.x < 0.f ? m.x : r.x; o.y = v.y < 0.f ? m.y : r.y; return o;
}

template <int ACT  > struct EpiBf16 {
    static constexpr bool PERM = true, AFTER_DRAIN = false, PREFETCH = false; static_assert(ACT == 0 || ACT == 1, "EpiBf16: ACT is 0 (none) or 1 (gelu_pk)");
    bf16_t* O; int ldc; const float* bias; int split_cols; size_t split_stride; float scale0;
    __device__ __forceinline__ void operator()(const f32x4 (&acc)[2][2][4][2], const Unit& u, int wr, int wc, int fr, int fq) const {
        const int row0 = u.pm * BM + wr * 64 + fr; int colt = u.pn * BM; bf16_t* base = O;
        float sc = 1.f; if (split_cols) { const int t = colt / split_cols; base += (size_t)t * split_stride; colt -= t * split_cols; if (t == 0) sc = scale0; }
        const int col0 = colt + wc * 32 + 8 * fq, bcol0 = u.pn * BM + wc * 32 + 8 * fq;
        f32x4 bv[2][2];
#pragma unroll
        for (int bj = 0; bj < 2; ++bj)
#pragma unroll
            for (int n = 0; n < 2; ++n) bv[bj][n] = bias ? *(const f32x4*)(bias + bcol0 + bj * HALF + 4 * n) : (f32x4){0.f, 0.f, 0.f, 0.f};
#pragma unroll
        for (int ai = 0; ai < 2; ++ai)
#pragma unroll
            for (int m = 0; m < 4; ++m) { bf16_t* rowp = base + (size_t)(row0 + ai * HALF + m * 16) * ldc + col0;
#pragma unroll
                for (int bj = 0; bj < 2; ++bj) { f32x4 v0 = acc[ai][bj][m][0] + bv[bj][0], v1 = acc[ai][bj][m][1] + bv[bj][1];
                    if (ACT == 1) { f32x2 a = gelu_pk((f32x2){v0[0], v0[1]}), b = gelu_pk((f32x2){v0[2], v0[3]}), c = gelu_pk((f32x2){v1[0], v1[1]}), d = gelu_pk((f32x2){v1[2], v1[3]});
                        v0 = (f32x4){a.x, a.y, b.x, b.y}; v1 = (f32x4){c.x, c.y, d.x, d.y}; }
                    v0 = v0 * sc; v1 = v1 * sc; u32x4 w; w.x = cvt_pk_bf16(v0[0], v0[1]); w.y = cvt_pk_bf16(v0[2], v0[3]); w.z = cvt_pk_bf16(v1[0], v1[1]); w.w = cvt_pk_bf16(v1[2], v1[3]);
                    *(u32x4*)(rowp + bj * HALF) = w; } }
    }
};
typedef int v4i_t __attribute__((ext_vector_type(4)));
typedef int v8i_t __attribute__((ext_vector_type(8)));
__device__ __forceinline__ v8i_t cat32(bf16x8 a, bf16x8 b) { const v4i_t x = __builtin_bit_cast(v4i_t, a), y = __builtin_bit_cast(v4i_t, b); return __builtin_shufflevector(x, y, 0, 1, 2, 3, 4, 5, 6, 7); }
template <class Epi, class Sched, bool ALIGN_EPI = false, bool SP2 = false, bool GATHER = false, bool FP8 = false>
__device__ __forceinline__ void gemm_phase(PG8_LAS unsigned char* lds, const Gemm g, const Sched& S, const Epi& E, const int* rowsrc = nullptr, const PG8_LAS int* gtab = nullptr) {
    static_assert(!GATHER || SP2, "GATHER is implemented on the SP2 loop only");
    int tid_l = threadIdx.x; asm volatile("" : "+v"(tid_l));
    const int tid = tid_l, wid = __builtin_amdgcn_readfirstlane(tid >> 6), lane = tid & 63, wr = wid >> 2, wc = wid & 3, fr = lane & 15, fq = lane >> 4;
#if defined(PROBE_K2)
    const int K = g.K, nt0 = K / BK, nt = FP8 ? 2 * nt0 : nt0;
#define PG8_KT(x) (FP8 ? ((x) & (nt0 - 1)) : (x))
#else
    const int K = g.K, nt = K / BK;
#define PG8_KT(x) (x)
#endif
    unsigned voffA[2], voffB[2];
#pragma unroll
    for (int i = 0; i < 2; ++i) { int R, C; stage_rc(tid * 16 + i * 8192, R, C); const int Rb = Epi::PERM ? ((R & ~31) + perm32(R & 31)) : R;
        voffA[i] = (unsigned)(R * K + C) * 2u; voffB[i] = (unsigned)(Rb * K + C) * 2u; }
    unsigned gAc[2][2], gAn[2][2]; int gR[2]; unsigned gC[2];
#pragma unroll
    for (int i = 0; i < 2; ++i) { int R, C; stage_rc(tid * 16 + i * 8192, R, C); gR[i] = R; gC[i] = (unsigned)C * 2u; gAc[0][i] = gAc[1][i] = gAn[0][i] = gAn[1][i] = 0u; }
#define PG8_GATHER(u_, o_) do { const int gtb_ = gtab[(u_).pm], gtc_ = gtab[576 + (u_).pm];     \
        _Pragma("unroll") for (int h_ = 0; h_ < 2; ++h_) _Pragma("unroll") for (int i_ = 0; i_ < 2; ++i_) \
        { const int rl_ = h_ * HALF + gR[i_]; const int src_ = rl_ < gtc_ ? rowsrc[gtb_ + rl_] : 0; o_[h_][i_] = (unsigned)src_ * (unsigned)(K * 2) + gC[i_]; } } while (0)
#define PG8_STAGE_A(bufoff, orig_gbase, NEXTSEL, H, KOFF) do { if constexpr (GATHER) { unsigned vo_[2]; vo_[0] = (NEXTSEL) ? gAn[H][0] : gAc[H][0]; vo_[1] = (NEXTSEL) ? gAn[H][1] : gAc[H][1]; \
        PG8_STAGE(bufoff, (const char*)g.A + (KOFF), vo_); } else { PG8_STAGE(bufoff, orig_gbase, voffA); } } while (0)
    const size_t kstep = (size_t)(BK * 2);
    const size_t hstep = (size_t)HALF * K * 2;
    const size_t tstep = 2 * hstep;
    const unsigned ldsw = (unsigned)wid * 1024u;
    const int aoff = lds_byte(wr * 64 + fr, fq * 8), boff = lds_byte(wc * 32 + fr, fq * 8);
#define PG8_SA(b, h) (((b) * 2 + (h)) * HTB)
#define PG8_SB(b, h) ((4 + (b) * 2 + (h)) * HTB)
#define PG8_STAGE(bufoff, gbase, voff) do { _Pragma("unroll") for (int _i = 0; _i < 2; ++_i) \
        __builtin_amdgcn_global_load_lds((const unsigned*)((const char*)(gbase) + (voff)[_i]), (PG8_LAS unsigned*)(lds + (bufoff) + ldsw + _i * 8192), 16, 0, 0); } while (0)
#define PG8_LD32(var, addr) do { const bf16x8 lo_ = *(const PG8_LAS bf16x8*)(addr); const bf16x8 hi_ = *(const PG8_LAS bf16x8*)((addr) + 1024); var = cat32(lo_, hi_); } while (0)
#define PG8_LDA(dst, b, h) do { if constexpr (FP8) { _Pragma("unroll") for (int m = 0; m < 4; ++m) PG8_LD32(dst##8[m], lds + PG8_SA(b, h) + aoff + m * 2048); } \
        else { _Pragma("unroll") for (int m = 0; m < 4; ++m) _Pragma("unroll") for (int k = 0; k < 2; ++k) dst[m][k] = *(const PG8_LAS bf16x8*)(lds + PG8_SA(b, h) + aoff + m * 2048 + k * 1024); } } while (0)
#define PG8_LDB(dst, b, h) do { if constexpr (FP8) { _Pragma("unroll") for (int n = 0; n < 2; ++n) PG8_LD32(dst##8[n], lds + PG8_SB(b, h) + boff + n * 2048); } \
        else { _Pragma("unroll") for (int n = 0; n < 2; ++n) _Pragma("unroll") for (int k = 0; k < 2; ++k) dst[n][k] = *(const PG8_LAS bf16x8*)(lds + PG8_SB(b, h) + boff + n * 2048 + k * 1024); } } while (0)
#define PG8_MMA(ai, bj, At, Bt) do { __builtin_amdgcn_s_setprio(1); \
        if constexpr (FP8) { _Pragma("unroll") for (int m = 0; m < 4; ++m) _Pragma("unroll") for (int n = 0; n < 2; ++n) \
            asm volatile("v_mfma_scale_f32_16x16x128_f8f6f4 %0, %1, %2, %0, %3, %3 op_sel_hi:[0,0,0]" : "+v"(acc[ai][bj][m][n]) : "v"(Bt##8[n]), "v"(At##8[m]), "v"(sc127)); } \
        else { _Pragma("unroll") for (int m = 0; m < 4; ++m) _Pragma("unroll") for (int n = 0; n < 2; ++n) _Pragma("unroll") for (int k = 0; k < 2; ++k) \
            acc[ai][bj][m][n] = __builtin_amdgcn_mfma_f32_16x16x32_bf16(Bt[n][k], At[m][k], acc[ai][bj][m][n], 0, 0, 0); } \
        __builtin_amdgcn_s_setprio(0); } while (0)
#define PG8_WAIT_V(n) asm volatile("s_waitcnt vmcnt(" #n ")" ::: "memory")
#define PG8_WAIT_L(n) asm volatile("s_waitcnt lgkmcnt(" #n ")" ::: "memory")
#define PG8_BAR __builtin_amdgcn_s_barrier()
#define PG8_SCHED __builtin_amdgcn_sched_barrier(0)
    Unit cur, nxt; int ui = 0;
    if (!S.next(0, cur)) return;
    f32x4 acc[2][2][4][2];
#pragma unroll
    for (int a = 0; a < 2; ++a)
#pragma unroll
        for (int b = 0; b < 2; ++b)
#pragma unroll
            for (int m = 0; m < 4; ++m)
#pragma unroll
                for (int n = 0; n < 2; ++n) acc[a][b][m][n] = (f32x4){0.f, 0.f, 0.f, 0.f};
    int sc127 = 0x7f7f7f7f; asm volatile("" : "+v"(sc127));
    bf16x8 At[4][2], B0[2][2], B1[2][2]; v8i_t At8[4], B08[2], B18[2]; (void)At; (void)B0; (void)B1; (void)At8; (void)B08; (void)B18;
    const char* cA = (const char*)g.A + (size_t)cur.pm * tstep; const char* cB = (const char*)g.Bt + (size_t)cur.pn * tstep;
    S.a_ready(cur);
    if constexpr (GATHER) { PG8_GATHER(cur, gAc); }
    if constexpr (Epi::PREFETCH) E.prefetch(cur, 0, wid, lane);
    if constexpr (SP2) {
        PG8_STAGE(PG8_SB(0, 0), cB, voffB); PG8_STAGE(PG8_SB(0, 1), cB + hstep, voffB); PG8_STAGE_A(PG8_SA(0, 0), cA, false, 0, (size_t)0); PG8_STAGE_A(PG8_SA(0, 1), cA + hstep, false, 1, (size_t)0);
        if (wr == 1) PG8_BAR;
        PG8_WAIT_V(2); PG8_BAR;
        PG8_STAGE(PG8_SB(1, 0), cB + kstep, voffB); PG8_STAGE_A(PG8_SA(1, 0), cA + kstep, false, 0, kstep); PG8_STAGE(PG8_SB(1, 1), cB + hstep + kstep, voffB);
        PG8_WAIT_V(6); PG8_BAR;
    } else {
        PG8_STAGE(PG8_SB(0, 0), cB, voffB); PG8_STAGE(PG8_SA(0, 0), cA, voffA); PG8_STAGE(PG8_SB(0, 1), cB + hstep, voffB); PG8_STAGE(PG8_SA(0, 1), cA + hstep, voffA);
        if (wr == 1) PG8_BAR;
        PG8_WAIT_V(4); PG8_BAR;
        PG8_STAGE(PG8_SB(1, 0), cB + kstep, voffB); PG8_STAGE(PG8_SA(1, 0), cA + kstep, voffA); PG8_STAGE(PG8_SB(1, 1), cB + hstep + kstep, voffB);
        PG8_WAIT_V(6); PG8_BAR;
    }
    for (;;) {
        const bool has_next = S.next(ui + 1, nxt);
        if constexpr (GATHER) { if (has_next) { PG8_GATHER(nxt, gAn); } else { _Pragma("unroll") for (int h_ = 0; h_ < 2; ++h_) _Pragma("unroll") for (int i_ = 0; i_ < 2; ++i_) gAn[h_][i_] = gAc[h_][i_]; } }
        const char* nA = has_next ? (const char*)g.A + (size_t)nxt.pm * tstep : cA; const char* nB = has_next ? (const char*)g.Bt + (size_t)nxt.pn * tstep : cB;
#pragma nounroll
        for (int t = 0; t < nt; t += 2) {
            const bool last = (t == nt - 2);
            const char* a1 = cA + (size_t)PG8_KT(t + 1) * kstep;
            const char* a2 = last ? nA : cA + (size_t)PG8_KT(t + 2) * kstep; const char* b2 = last ? nB : cB + (size_t)PG8_KT(t + 2) * kstep;
            const char* a3 = a2 + kstep; const char* b3 = b2 + kstep;
            const size_t k1 = (size_t)PG8_KT(t + 1) * kstep, k2 = last ? (size_t)0 : (size_t)PG8_KT(t + 2) * kstep, k3 = k2 + kstep; (void)k1; (void)k2; (void)k3;
            if (last && has_next) S.a_ready(nxt);
            if constexpr (SP2) {
            PG8_LDB(B0, 0, 0); PG8_LDB(B1, 0, 1); PG8_SCHED; PG8_LDA(At, 0, 0); PG8_STAGE_A(PG8_SA(1, 1), a1 + hstep, false, 1, k1);
            PG8_WAIT_V(8); PG8_WAIT_L(0); PG8_BAR; PG8_MMA(0, 0, At, B0); PG8_MMA(0, 1, At, B1); PG8_BAR; PG8_SCHED;
            PG8_LDA(At, 0, 1); PG8_STAGE(PG8_SB(0, 0), b2, voffB); PG8_STAGE(PG8_SB(0, 1), b2 + hstep, voffB); PG8_STAGE_A(PG8_SA(0, 0), a2, last, 0, k2);
            PG8_WAIT_V(8); PG8_WAIT_L(0); PG8_BAR; PG8_MMA(1, 0, At, B0); PG8_MMA(1, 1, At, B1); PG8_BAR; PG8_SCHED;
            PG8_LDB(B0, 1, 0); PG8_LDB(B1, 1, 1); PG8_SCHED; PG8_LDA(At, 1, 0); PG8_STAGE_A(PG8_SA(0, 1), a2 + hstep, last, 1, k2);
            PG8_WAIT_V(8); PG8_WAIT_L(0); PG8_BAR; PG8_MMA(0, 0, At, B0); PG8_MMA(0, 1, At, B1); PG8_BAR; PG8_SCHED;
            PG8_LDA(At, 1, 1); PG8_STAGE(PG8_SB(1, 0), b3, voffB); PG8_STAGE(PG8_SB(1, 1), b3 + hstep, voffB); PG8_STAGE_A(PG8_SA(1, 0), a3, last, 0, k3);
            PG8_WAIT_V(8); PG8_WAIT_L(0); PG8_BAR; PG8_MMA(1, 0, At, B0); PG8_MMA(1, 1, At, B1); PG8_BAR; PG8_SCHED;
            } else {
            PG8_LDB(B0, 0, 0); PG8_SCHED; PG8_LDA(At, 0, 0); PG8_STAGE(PG8_SA(1, 1), a1 + hstep, voffA);
            PG8_WAIT_L(8); PG8_BAR; PG8_WAIT_L(0); PG8_MMA(0, 0, At, B0); PG8_BAR; PG8_SCHED;
            PG8_LDB(B1, 0, 1); PG8_STAGE(PG8_SB(0, 0), b2, voffB);
            PG8_BAR; PG8_WAIT_L(0); PG8_MMA(0, 1, At, B1); PG8_BAR;
            PG8_LDA(At, 0, 1); PG8_STAGE(PG8_SA(0, 0), a2, voffA);
            PG8_BAR; PG8_WAIT_L(0); PG8_MMA(1, 0, At, B0); PG8_BAR; PG8_SCHED;
            PG8_STAGE(PG8_SB(0, 1), b2 + hstep, voffB);
            PG8_WAIT_V(6); PG8_BAR; PG8_MMA(1, 1, At, B1); PG8_BAR;
            PG8_LDB(B0, 1, 0); PG8_SCHED; PG8_LDA(At, 1, 0); PG8_STAGE(PG8_SA(0, 1), a2 + hstep, voffA);
            PG8_WAIT_L(8); PG8_BAR; PG8_WAIT_L(0); PG8_MMA(0, 0, At, B0); PG8_BAR; PG8_SCHED;
            PG8_LDB(B1, 1, 1); PG8_STAGE(PG8_SB(1, 0), b3, voffB);
            PG8_BAR; PG8_WAIT_L(0); PG8_MMA(0, 1, At, B1); PG8_BAR;
            PG8_LDA(At, 1, 1); PG8_STAGE(PG8_SA(1, 0), a3, voffA);
            PG8_BAR; PG8_WAIT_L(0); PG8_MMA(1, 0, At, B0); PG8_BAR; PG8_SCHED;
            PG8_STAGE(PG8_SB(1, 1), b3 + hstep, voffB);
            PG8_WAIT_V(6); PG8_BAR; PG8_MMA(1, 1, At, B1); PG8_BAR;
            }
        }
        if constexpr (ALIGN_EPI) { if (wr == 0) PG8_BAR; }
        if constexpr (FP8) { asm volatile("s_nop 15\n\ts_nop 15" ::: "memory"); }
        if constexpr (!Epi::AFTER_DRAIN) { if constexpr (Epi::PREFETCH) E(acc, cur, wr, wc, fr, fq, ui & 1); else E(acc, cur, wr, wc, fr, fq);
#if defined(PROBE_EPI2)
            if constexpr (FP8 == (PROBE_EPI2 == 1)) { if constexpr (Epi::PREFETCH) E(acc, cur, wr, wc, fr, fq, ui & 1); else E(acc, cur, wr, wc, fr, fq); }
#endif
            S.done(cur); }
        if (!has_next) break;
#pragma unroll
        for (int a = 0; a < 2; ++a)
#pragma unroll
            for (int b = 0; b < 2; ++b)
#pragma unroll
                for (int m = 0; m < 4; ++m)
#pragma unroll
                    for (int n = 0; n < 2; ++n) acc[a][b][m][n] = (f32x4){0.f, 0.f, 0.f, 0.f};
        cur = nxt; cA = nA; cB = nB; ++ui;
        if constexpr (Epi::PREFETCH) E.prefetch(cur, ui & 1, wid, lane);
        if constexpr (GATHER) { _Pragma("unroll") for (int h_ = 0; h_ < 2; ++h_) _Pragma("unroll") for (int i_ = 0; i_ < 2; ++i_) gAc[h_][i_] = gAn[h_][i_]; }
        if constexpr (ALIGN_EPI) { if (wr == 1) PG8_BAR; }
    }
    PG8_WAIT_V(0);
    if constexpr (!ALIGN_EPI) { if (wr == 0) PG8_BAR; }
    PG8_BAR;
    if constexpr (Epi::AFTER_DRAIN) { E.fused(acc, cur, wr, wc, fr, fq, lds, wid, lane); S.done(cur); }
#undef PG8_SA
#undef PG8_SB
#undef PG8_STAGE
#undef PG8_STAGE_A
#undef PG8_GATHER
#undef PG8_LDA
#undef PG8_LD32
#undef PG8_LDB
#undef PG8_MMA
#undef PG8_WAIT_V
#undef PG8_WAIT_L
#undef PG8_BAR
#undef PG8_SCHED
}
}

#ifndef PG8_SP2
#define PG8_SP2 true
#endif
#ifndef PG8_ALIGN
#define PG8_ALIGN true
#endif

#define GAS __attribute__((address_space(1)))
#define LAS __attribute__((address_space(3)))
typedef unsigned short bf16;
typedef unsigned v4u __attribute__((ext_vector_type(4)));
typedef unsigned v2u __attribute__((ext_vector_type(2)));
typedef float f32x4 __attribute__((ext_vector_type(4)));
typedef short bf16x8 __attribute__((ext_vector_type(8)));

constexpr int D = 1024, NB = 8, SEQ = 4096, CTXL = 256, TPB = SEQ + CTXL, NTOK = NB * TPB, NLAT = NB * SEQ;
constexpr int ZC = 3328;
constexpr int ZQ = 0, ZKV = 384, ZKR = 640, ZHQ = 672, ZHF = 1184, ZHB = 1696, ZHI = 2208, ZHG = 2720;
constexpr int NEXP = 32;
constexpr float ALPHA = 1.4142135623730951f;
constexpr float LN_EPS = 1e-5f, RMS_EPS = 1e-6f;
constexpr int NWAVES = 8, NTHR = 512;
constexpr float SC_X8 = 16.f, SC_WGU = 64.f, SC_ACT = 8.f, SC_WDN = 128.f, SC_Y = 64.f, SC_A1 = 16.f, SC_WPW = 64.f, SC_CV = 16.f, SC_A0 = 16.f, SC_WIN = 64.f;
constexpr int LDS_BYTES = 163840;
constexpr int LDS_BAR_OFF = LDS_BYTES - 64;
constexpr int LDS_TILE_E = 131072;
constexpr int MAXTILES = 576;
constexpr int LDS_SIDE = 155648, SIDE_BYTES = 3072;
static_assert(LDS_SIDE + 2 * SIDE_BYTES <= LDS_BYTES - 64, "lds side");
constexpr int LDS_EPI_B = 139264;
static_assert(LDS_TILE_E + (3 * MAXTILES + 96) * 4 <= LDS_EPI_B && LDS_EPI_B + 16384 <= LDS_BYTES - 64, "lds map");

constexpr size_t MiB = 1u << 20;
constexpr size_t WS_CTL = 0, CTL_ZERO_BYTES = 16384;
constexpr size_t WS_MODV = 1 * MiB;
constexpr size_t WS_ROPE = 1 * MiB + 512 * 1024;
constexpr size_t WS_BGU = 2 * MiB;
constexpr size_t WS_PW1B = 2 * MiB + 512 * 1024;
constexpr size_t WS_BCNT = WS_PW1B + 64 * 1024;
constexpr size_t WS_TILEE = WS_BCNT + 64 * 1024;
constexpr size_t WS_META = WS_TILEE + 4096;
constexpr size_t WS_TOPI = 3 * MiB, WS_TOPW = 4 * MiB;
constexpr int ECAP = 32768;
constexpr size_t WS_ROWS = 160 * MiB, WS_ROWW = 164 * MiB, WS_ROWD = 168 * MiB;
constexpr size_t WS_CURSOR = 14336;
constexpr size_t WS_WIN = 8 * MiB, WS_WUQ = 15 * MiB, WS_WUKV = 16 * MiB, WS_WOUT = 17 * MiB, WS_WPW1 = 19 * MiB, WS_WPW2 = 23 * MiB;
constexpr size_t WS_WGU = 32 * MiB, WS_WDN = 288 * MiB;
constexpr size_t WS_H = 416 * MiB;
constexpr size_t WS_X = 552 * MiB, WS_Y = 620 * MiB;
constexpr size_t WS_BIG = 688 * MiB;
constexpr size_t WS_Z = WS_BIG, WS_CQN = WS_BIG + 221 * MiB, WS_CKVN = WS_BIG + 247 * MiB, WS_KRR = WS_BIG + 264 * MiB,
                 WS_Q = WS_BIG + 267 * MiB, WS_KV = WS_BIG + 318 * MiB, WS_OF = WS_BIG + 386 * MiB, WS_OB = WS_BIG + 454 * MiB;
constexpr size_t WS_HT = WS_BIG + 528 * MiB;
constexpr size_t WS_PRE = WS_BIG;
constexpr size_t WS_XS = WS_BIG, WS_ACT = WS_BIG + 288 * MiB, WS_YB = WS_BIG + 576 * MiB;
constexpr size_t WS_END = WS_BIG + 848 * MiB;
static_assert((size_t)NTOK * ZC * 2 <= 221 * MiB && (size_t)NTOK * 384 * 2 <= 26 * MiB && (size_t)NTOK * 256 * 2 <= 17 * MiB && (size_t)NTOK * 32 * 2 <= 3 * MiB, "ws map 1");
static_assert((size_t)NTOK * 768 * 2 <= 51 * MiB && (size_t)NTOK * 1024 * 2 <= 68 * MiB && (size_t)NTOK * 512 * 4 <= 68 * MiB, "ws map 2");
static_assert((size_t)64 * 136 * 26624 <= 320 * MiB && (size_t)MAXTILES * 256 * 2048 <= 288 * MiB && (size_t)NLAT * 4 * 2048 <= 272 * MiB && (size_t)NTOK * 1024 * 4 <= 136 * MiB, "ws map 3");

#define LDS_WAIT() asm volatile("s_waitcnt lgkmcnt(0)" ::: "memory")
#define VM_WAIT() asm volatile("s_waitcnt vmcnt(0)" ::: "memory")
__device__ __forceinline__ float bf2f(unsigned short b) { return __uint_as_float(((unsigned)b) << 16); }
__device__ __forceinline__ unsigned pk2(float lo, float hi) { return pg8::cvt_pk_bf16(lo, hi); }
__device__ __forceinline__ float sigm(float x) { return __builtin_amdgcn_rcpf(1.f + __expf(-x)); }
__device__ __forceinline__ float wave_sum(float v) {
#pragma unroll
    for (int o = 1; o < 64; o <<= 1) v += __shfl_xor(v, o);
    return v;
}
__device__ __forceinline__ int ld_ctl(const int* p) { return (int)__hip_atomic_load((const unsigned*)p, __ATOMIC_RELAXED, __HIP_MEMORY_SCOPE_AGENT); }
__device__ __forceinline__ int grow_of(int lr) { return (lr >> 12) * TPB + CTXL + (lr & 4095); }

#define XB_TMO      128
#define XB_XCNT(j)  (256  + 64 * (j))
#define XB_XSUB(j)  (1280 + 64 * (j))
#define XB_XGEN(j)  (2304 + 64 * (j))
#define XB_TOP      3328
#define XB_TOPGEN   3392
#define XCD_BAR_WORDS 3456
#define XB_SPIN_CAP (1u << 21)

__device__ __forceinline__ unsigned xb_ld(unsigned* p)              { return __hip_atomic_load(p, __ATOMIC_RELAXED, __HIP_MEMORY_SCOPE_AGENT); }
__device__ __forceinline__ unsigned xb_add(unsigned* p, unsigned v) { return __hip_atomic_fetch_add(p, v, __ATOMIC_RELAXED, __HIP_MEMORY_SCOPE_AGENT); }
__device__ __forceinline__ unsigned xb_xcc_id() { return (unsigned)__builtin_amdgcn_s_getreg((3 << 11) | 20) & 0xFu; }
#define XB_SPIN(cond, bar) do { unsigned _sp = 0; while (cond) { __builtin_amdgcn_s_sleep(1); \
    if ((++_sp & 255u) == 0u) { if (xb_ld(&(bar)[XB_TMO])) break; if (_sp > XB_SPIN_CAP) { atomicAdd(&(bar)[XB_TMO], 1u); break; } } } } while (0)

struct XcdBarrier { unsigned* bar; unsigned x; volatile LAS unsigned* st; };

__device__ __forceinline__ XcdBarrier xcd_barrier_post(unsigned* bar, volatile LAS unsigned* st) {
    XcdBarrier b; b.bar = bar; b.x = xb_xcc_id(); b.st = st;
    if (threadIdx.x == 0) (void)xb_add(&bar[XB_XCNT(b.x)], 1u);
    return b;
}
__device__ __forceinline__ void xcd_barrier_complete(unsigned* bar, unsigned x, unsigned& nloc, unsigned& nx) {
    const unsigned G = gridDim.x * gridDim.y * gridDim.z;
    unsigned sum, cnt, mine, sp = 0u;
    for (;;) {
        sum = 0u; cnt = 0u; mine = 0u;
#pragma unroll
        for (unsigned j = 0; j < 16; ++j) { const unsigned c = xb_ld(&bar[XB_XCNT(j)]); sum += c; cnt += (c > 0u) ? 1u : 0u; mine = (j == x) ? c : mine; }
        if (sum == G) break;
        __builtin_amdgcn_s_sleep(1);
        if ((++sp & 255u) == 0u) { if (xb_ld(&bar[XB_TMO])) break; if (sp > XB_SPIN_CAP) { atomicAdd(&bar[XB_TMO], 1u); break; } }
    }
    nloc = mine > 0u ? mine : 1u; nx = cnt > 0u ? cnt : 1u;
}
__device__ __forceinline__ void xcd_barrier(const XcdBarrier& b) {
    asm volatile("s_waitcnt vmcnt(0)" ::: "memory");
    __syncthreads();
    if (threadIdx.x == 0) {
        unsigned* bar = b.bar;
        __builtin_amdgcn_s_waitcnt(0);
        unsigned nloc = b.st[0], nx = b.st[1];
        if (nloc == 0u) { xcd_barrier_complete(bar, b.x, nloc, nx); b.st[0] = nloc; b.st[1] = nx; }
        const unsigned old = xb_add(&bar[XB_XSUB(b.x)], 1u);
        const unsigned gen = old / nloc;
        if (old + 1u == (gen + 1u) * nloc) {
            __builtin_amdgcn_fence(__ATOMIC_RELEASE, "agent");
            asm volatile("s_waitcnt vmcnt(0)" ::: "memory");
            const unsigned og = xb_add(&bar[XB_TOP], 1u);
            const unsigned tg = og / nx;
            if (og + 1u == (tg + 1u) * nx) xb_add(&bar[XB_TOPGEN], 1u);
            else XB_SPIN(xb_ld(&bar[XB_TOPGEN]) == tg, bar);
            __builtin_amdgcn_fence(__ATOMIC_ACQUIRE, "agent");
            xb_add(&bar[XB_XGEN(b.x)], 1u);
            asm volatile("s_waitcnt vmcnt(0)" ::: "memory");
        } else {
            XB_SPIN(xb_ld(&bar[XB_XGEN(b.x)]) == gen, bar);
            __builtin_amdgcn_fence(__ATOMIC_ACQUIRE, "agent");
            asm volatile("s_waitcnt vmcnt(0)" ::: "memory");
        }
    }
    __syncthreads();
}

namespace pg8 {
struct TileOrder {
    int nM, nN, nwg, G, c;
    __device__ __forceinline__ void init(int nM_, int nN_, int G_, int c_) { nM = nM_; nN = nN_; nwg = nM * nN; G = G_; c = c_; }
    __device__ __forceinline__ bool logical(int i, int& im, int& in) const {
        const long L = (long)i * G + c; if (L >= nwg) return false;
        int wgid = (int)L; { const int q = nwg / NXCD, r = nwg % NXCD, xcd = wgid % NXCD, off = wgid / NXCD; wgid = (xcd < r ? xcd * (q + 1) : r * (q + 1) + (xcd - r) * q) + off; }
        const int nig = WGM * nN, gid = wgid / nig, fm = gid * WGM, gsz = (nM - fm) < WGM ? (nM - fm) : WGM;
        im = fm + ((wgid % nig) % gsz); in = (wgid % nig) / gsz; return true;
    }
    __device__ __forceinline__ void a_ready(const Unit&) const {}
    __device__ __forceinline__ void done(const Unit&) const {}
};
struct AllOrder : TileOrder { __device__ __forceinline__ bool next(int i, Unit& u) const { int im, in; if (!logical(i, im, in)) return false; u.pm = im; u.pn = in; return true; } };
struct LatOrder : TileOrder {
    __device__ __forceinline__ bool next(int i, Unit& u) const { int im, in; if (!logical(i, im, in)) return false; u.pm = (im >> 4) * 17 + 1 + (im & 15); u.pn = in; return true; } };
struct MoeOrder : TileOrder {
    const PG8_LAS int* tile_e; int nper;
    __device__ __forceinline__ bool next(int i, Unit& u) const { int im, in; if (!logical(i, im, in)) return false; u.pm = im; u.pn = tile_e[im] * nper + in; return true; } };

template <bool HB16> struct EpiRes {
    static constexpr bool PERM = true, AFTER_DRAIN = false, PREFETCH = false;
    const float* xin; const bf16_t* h; bf16_t* pre; const float* modv; const float* bias; float ascale;
    __device__ __forceinline__ void operator()(const f32x4 (&acc)[2][2][4][2], const Unit& u, int wr, int wc, int fr, int fq) const {
        asm volatile("" : "+v"(fr), "+v"(fq));
        const int b = u.pm / 17, j = u.pm % 17;
        const int rl0 = wr * 64 + fr, col0 = u.pn * BM + wc * 32 + 8 * fq;
        const float* gate = modv + (size_t)b * 6144 + 2048;
        f32x4 gv[2][2], bv[2][2];
#pragma unroll
        for (int bj = 0; bj < 2; ++bj)
#pragma unroll
            for (int n = 0; n < 2; ++n) { gv[bj][n] = *(const f32x4*)(gate + col0 + bj * HALF + 4 * n); bv[bj][n] = bias ? *(const f32x4*)(bias + col0 + bj * HALF + 4 * n) : (f32x4){0.f, 0.f, 0.f, 0.f}; }
        if constexpr (HB16) {
#pragma unroll
        for (int ai = 0; ai < 2; ++ai) {
            u32x4 hb[4][2];
#pragma unroll
            for (int m = 0; m < 4; ++m) { const int rl = rl0 + ai * HALF + m * 16; const size_t grow = (size_t)u.pm * BM + rl; const bf16_t* hin = h + grow * 1024 + col0;
#pragma unroll
                for (int bj = 0; bj < 2; ++bj) hb[m][bj] = *(const u32x4*)(hin + bj * HALF); }
            asm volatile("" ::: "memory");
#pragma unroll
            for (int m = 0; m < 4; ++m) { const int rl = rl0 + ai * HALF + m * 16; const size_t grow = (size_t)u.pm * BM + rl; bf16_t* po = pre + grow * 1024 + col0;
#pragma unroll
                for (int bj = 0; bj < 2; ++bj) { const u32x4 q = hb[m][bj];
                    const f32x4 h0 = {__builtin_bit_cast(float, q.x << 16), __builtin_bit_cast(float, q.x & 0xffff0000u), __builtin_bit_cast(float, q.y << 16), __builtin_bit_cast(float, q.y & 0xffff0000u)};
                    const f32x4 h1 = {__builtin_bit_cast(float, q.z << 16), __builtin_bit_cast(float, q.z & 0xffff0000u), __builtin_bit_cast(float, q.w << 16), __builtin_bit_cast(float, q.w & 0xffff0000u)};
                    const f32x4 v0 = h0 * 1.4142135623730951f + gv[bj][0] * (acc[ai][bj][m][0] * ascale + bv[bj][0]), v1 = h1 * 1.4142135623730951f + gv[bj][1] * (acc[ai][bj][m][1] * ascale + bv[bj][1]);
                    u32x4 w; w.x = cvt_pk_bf16(v0[0], v0[1]); w.y = cvt_pk_bf16(v0[2], v0[3]); w.z = cvt_pk_bf16(v1[0], v1[1]); w.w = cvt_pk_bf16(v1[2], v1[3]);
                    *(u32x4*)(po + bj * HALF) = w; } }
            asm volatile("" ::: "memory"); }
        } else {
#pragma unroll
        for (int aim = 0; aim < 4; ++aim) { const int ai = aim >> 1, m0 = (aim & 1) * 2;
            f32x4 hv[2][2][2];
#pragma unroll
            for (int mm = 0; mm < 2; ++mm) { const int rl = rl0 + ai * HALF + (m0 + mm) * 16; const size_t grow = (size_t)u.pm * BM + rl;
                const float* hin = xin + ((size_t)b * 4096 + (size_t)(j - 1) * 256 + rl) * 1024 + col0; (void)grow;
#pragma unroll
                for (int bj = 0; bj < 2; ++bj) { hv[mm][bj][0] = *(const f32x4*)(hin + bj * HALF); hv[mm][bj][1] = *(const f32x4*)(hin + bj * HALF + 4); } }
            asm volatile("" ::: "memory");
#pragma unroll
            for (int mm = 0; mm < 2; ++mm) { const int m = m0 + mm; const int rl = rl0 + ai * HALF + m * 16; const size_t grow = (size_t)u.pm * BM + rl; bf16_t* po = pre + grow * 1024 + col0;
#pragma unroll
                for (int bj = 0; bj < 2; ++bj) {
                    const f32x4 v0 = hv[mm][bj][0] * 1.4142135623730951f + gv[bj][0] * (acc[ai][bj][m][0] * ascale + bv[bj][0]), v1 = hv[mm][bj][1] * 1.4142135623730951f + gv[bj][1] * (acc[ai][bj][m][1] * ascale + bv[bj][1]);
                    u32x4 w; w.x = cvt_pk_bf16(v0[0], v0[1]); w.y = cvt_pk_bf16(v0[2], v0[3]); w.z = cvt_pk_bf16(v1[0], v1[1]); w.w = cvt_pk_bf16(v1[2], v1[3]);
                    *(u32x4*)(po + bj * HALF) = w; } }
            asm volatile("" ::: "memory"); }
        }
    }
};
#define PG8_DMA4(gptr, ldsptr) __builtin_amdgcn_global_load_lds((const unsigned*)(gptr), (PG8_LAS unsigned*)(ldsptr), 4, 0, 0)
template <int MODE, bool OUT8 = false> struct EpiGate {
    static constexpr bool PERM = true, AFTER_DRAIN = false, PREFETCH = true;
    bf16_t* O; const float* bias; int nper; float ascale, oscale; PG8_LAS unsigned char* lds;
    __device__ __forceinline__ void prefetch(const Unit& u, int par, int wid, int lane) const { if (wid < 4) PG8_DMA4(bias + u.pn * BM + 64 * wid + lane, lds + LDS_SIDE + par * SIDE_BYTES + wid * 256); }
    __device__ __forceinline__ void operator()(const f32x4 (&acc)[2][2][4][2], const Unit& u, int wr, int wc, int fr, int fq, int par) const {
        asm volatile("" : "+v"(fr), "+v"(fq));
        const int row0 = u.pm * BM + wr * 64 + fr, pnl = u.pn % nper, ocol0 = pnl * HALF + wc * 32 + 8 * fq, bcol0 = u.pn * BM + wc * 32 + 8 * fq;
        const float s0 = ascale, s1 = MODE == 1 ? ascale * oscale : ascale;
        f32x4 bv[2][2];
#pragma unroll
        for (int n = 0; n < 2; ++n) { const PG8_LAS float* bl = (const PG8_LAS float*)(lds + LDS_SIDE + par * SIDE_BYTES) + wc * 32 + 8 * fq + 4 * n; bv[0][n] = *(const PG8_LAS f32x4*)bl; const f32x4 t = *(const PG8_LAS f32x4*)(bl + HALF); bv[1][n] = MODE == 1 ? (t + 1.0f) * oscale : t; }
        (void)bcol0;
#pragma unroll
        for (int ai = 0; ai < 2; ++ai)
#pragma unroll
            for (int m = 0; m < 4; ++m) { bf16_t* rowp = O + (size_t)(row0 + ai * HALF + m * 16) * 1024 + ocol0;
                unsigned char* rowp8 = (unsigned char*)O + (size_t)(row0 + ai * HALF + m * 16) * 1024 + ocol0;
                float o[8];
#pragma unroll
                for (int n = 0; n < 2; ++n) { const f32x4 a = acc[ai][0][m][n] * s0 + bv[0][n], g = acc[ai][1][m][n] * s1 + bv[1][n];
#pragma unroll
                    for (int e = 0; e < 4; ++e) {
                        if (MODE == 0) { o[4 * n + e] = a[e] * __builtin_amdgcn_rcpf(1.f + __builtin_amdgcn_exp2f(g[e] * -1.4426950408889634f)); }
                        else { const float gt = fminf(a[e], 7.0f), up1 = __builtin_amdgcn_fmed3f(g[e], -6.0f * oscale, 8.0f * oscale);
                            o[4 * n + e] = up1 * (gt * __builtin_amdgcn_rcpf(1.f + __builtin_amdgcn_exp2f(gt * (-1.702f * 1.4426950408889634f)))); } } }
                if constexpr (OUT8) {
                    int w0 = 0, w1 = 0; w0 = __builtin_amdgcn_cvt_pk_fp8_f32(o[0], o[1], w0, false); w0 = __builtin_amdgcn_cvt_pk_fp8_f32(o[2], o[3], w0, true);
                    w1 = __builtin_amdgcn_cvt_pk_fp8_f32(o[4], o[5], w1, false); w1 = __builtin_amdgcn_cvt_pk_fp8_f32(o[6], o[7], w1, true);
                    typedef unsigned u32x2 __attribute__((ext_vector_type(2))); *(u32x2*)rowp8 = (u32x2){(unsigned)w0, (unsigned)w1}; (void)rowp;
                } else { (void)rowp8;
                u32x4 w; w.x = cvt_pk_bf16(o[0], o[1]); w.y = cvt_pk_bf16(o[2], o[3]); w.z = cvt_pk_bf16(o[4], o[5]); w.w = cvt_pk_bf16(o[6], o[7]);
                *(u32x4*)rowp = w; } }
    }
};
struct EpiDown {
    static constexpr bool PERM = true, AFTER_DRAIN = false, PREFETCH = true;
    bf16_t* Y; const float* bias; const float* row_w; const int* row_dst; float ascale; const PG8_LAS int* gtab; float oscale; PG8_LAS unsigned char* lds;
    __device__ __forceinline__ void prefetch(const Unit& u, int par, int wid, int lane) const { PG8_LAS unsigned char* sd = lds + LDS_SIDE + par * SIDE_BYTES; const int tbase = gtab[u.pm];
        if (wid < 4) { PG8_DMA4(bias + u.pn * BM + 64 * wid + lane, sd + wid * 256); PG8_DMA4(row_w + tbase + 64 * wid + lane, sd + 1024 + wid * 256); } else PG8_DMA4(row_dst + tbase + 64 * (wid - 4) + lane, sd + 2048 + (wid - 4) * 256); }
    __device__ __forceinline__ void operator()(const f32x4 (&acc)[2][2][4][2], const Unit& u, int wr, int wc, int fr, int fq, int par) const {
        asm volatile("" : "+v"(fr), "+v"(fq));
        const int tid = (wr * 4 + wc) * 64 + fq * 16 + fr;
        const PG8_LAS unsigned char* sd = lds + LDS_SIDE + par * SIDE_BYTES;
        const int pnl = u.pn & 3; const int tcnt = gtab[576 + u.pm];
        f32x4 bv[2][2];
#pragma unroll
        for (int bj = 0; bj < 2; ++bj)
#pragma unroll
            for (int n = 0; n < 2; ++n) bv[bj][n] = *(const PG8_LAS f32x4*)(sd + (wc * 32 + 8 * fq + bj * HALF + 4 * n) * 4);
        float wv[2][4]; int dstv[2][2];
#pragma unroll
        for (int ai = 0; ai < 2; ++ai) {
#pragma unroll
            for (int m = 0; m < 4; ++m) { const int rl = wr * 64 + fr + ai * HALF + m * 16; wv[ai][m] = *(const PG8_LAS float*)(sd + 1024 + rl * 4); }
#pragma unroll
            for (int k = 0; k < 2; ++k) { const int rl = ai * HALF + (tid >> 3) + 64 * k; dstv[ai][k] = *(const PG8_LAS int*)(sd + 2048 + rl * 4); } }
        PG8_LAS unsigned char* const reg0 = lds + 3 * HTB; PG8_LAS unsigned char* const reg1 = lds + LDS_EPI_B;
        const int wbase = (wr * 64 + fr) * 128 + (((wc * 4 + fq) ^ fr) * 8);
        const int rrow = tid >> 3, rch = tid & 7;
        typedef unsigned u32x2 __attribute__((ext_vector_type(2)));
#pragma unroll
        for (int ai = 0; ai < 2; ++ai) {
#pragma unroll
            for (int m = 0; m < 4; ++m) { const float w8 = wv[ai][m] * oscale;
#pragma unroll
                for (int bj = 0; bj < 2; ++bj) { const f32x4 v0 = (acc[ai][bj][m][0] * ascale + bv[bj][0]) * w8, v1 = (acc[ai][bj][m][1] * ascale + bv[bj][1]) * w8;
                    int w0 = 0, w1 = 0; w0 = __builtin_amdgcn_cvt_pk_fp8_f32(__builtin_amdgcn_fmed3f(v0[0], -448.f, 448.f), __builtin_amdgcn_fmed3f(v0[1], -448.f, 448.f), w0, false); w0 = __builtin_amdgcn_cvt_pk_fp8_f32(__builtin_amdgcn_fmed3f(v0[2], -448.f, 448.f), __builtin_amdgcn_fmed3f(v0[3], -448.f, 448.f), w0, true);
                    w1 = __builtin_amdgcn_cvt_pk_fp8_f32(__builtin_amdgcn_fmed3f(v1[0], -448.f, 448.f), __builtin_amdgcn_fmed3f(v1[1], -448.f, 448.f), w1, false); w1 = __builtin_amdgcn_cvt_pk_fp8_f32(__builtin_amdgcn_fmed3f(v1[2], -448.f, 448.f), __builtin_amdgcn_fmed3f(v1[3], -448.f, 448.f), w1, true);
                    *(PG8_LAS u32x2*)((bj ? reg1 : reg0) + wbase + m * 2048) = (u32x2){(unsigned)w0, (unsigned)w1}; } }
            asm volatile("s_waitcnt lgkmcnt(0)" ::: "memory"); __builtin_amdgcn_s_barrier();
            u32x4 rd[2][2];
#pragma unroll
            for (int bj = 0; bj < 2; ++bj)
#pragma unroll
                for (int k = 0; k < 2; ++k) { const int row = rrow + 64 * k; rd[bj][k] = *(const PG8_LAS u32x4*)((bj ? reg1 : reg0) + row * 128 + ((rch ^ ((row & 15) >> 1)) * 16)); }
            asm volatile("s_waitcnt lgkmcnt(0)" ::: "memory"); __builtin_amdgcn_s_barrier();
#pragma unroll
            for (int k = 0; k < 2; ++k) { const int row = rrow + 64 * k, rl = ai * HALF + row;
                if (rl < tcnt) { unsigned char* rowp = (unsigned char*)Y + (size_t)dstv[ai][k] * 1024 + pnl * BM + rch * 16;
#pragma unroll
                    for (int bj = 0; bj < 2; ++bj) { u32x4 q = rd[bj][k]; if (row & 1) q = (u32x4){q.z, q.w, q.x, q.y}; *(u32x4*)(rowp + bj * HALF) = q; } } }
        }
    }
};
}

namespace att {
using bf16x8 = __attribute__((ext_vector_type(8))) short;
using s16x4  = __attribute__((ext_vector_type(4))) short;
using f32x16 = __attribute__((ext_vector_type(16))) float;
using u32x4  = __attribute__((ext_vector_type(4))) unsigned;
constexpr int NW = 8, QBLK = 32, KVBLK = 64;
constexpr float SCALE = 0.10206207261596575f;
constexpr float THR = 8.f;
constexpr int SHM_V = 16384, SHM_K = 16384, NBUF = 3, SHM_ATTN = NBUF * SHM_V + NBUF * SHM_K + NW * 64 * 4;
#define KSWZ(row, colB) ((row) * 256 + ((colB) ^ (((row) & 7) << 4)))
#define SBAR() __builtin_amdgcn_sched_barrier(0)
__device__ __forceinline__ int crow(int r, int hi) { return (r & 3) + 8 * (r >> 2) + 4 * hi; }
__device__ __forceinline__ unsigned cvtpk(float lo, float hi) { unsigned r; asm volatile("v_cvt_pk_bf16_f32 %0, %1, %2" : "=v"(r) : "v"(lo), "v"(hi)); return r; }

__device__ __forceinline__ void partialSM(f32x16& p0, f32x16& p1, float& m_reg, float& mn, float& alpha) {
  constexpr float C = SCALE * 1.4426950408889634f;
  float pmax = p0[0];
#pragma unroll
  for (int r = 1; r < 16; ++r) pmax = fmaxf(pmax, p0[r]);
#pragma unroll
  for (int r = 0; r < 16; ++r) pmax = fmaxf(pmax, p1[r]);
  { auto rr = __builtin_amdgcn_permlane32_swap(__float_as_uint(pmax), __float_as_uint(pmax), false, false);
    pmax = fmaxf(__uint_as_float(rr[0]), __uint_as_float(rr[1])); }
  if (__builtin_expect(__all(pmax - m_reg <= THR / SCALE), 1)) { mn = m_reg; alpha = 1.f; }
  else { mn = fmaxf(m_reg, pmax); alpha = __builtin_amdgcn_exp2f((m_reg - mn) * C); m_reg = mn; }
  float mnC = -mn * C;
#pragma unroll
  for (int r = 0; r < 16; ++r) p0[r] = fmaf(p0[r], C, mnC);
#pragma unroll
  for (int r = 0; r < 16; ++r) p1[r] = fmaf(p1[r], C, mnC);
#pragma unroll
  for (int r = 0; r < 16; ++r) p0[r] = __builtin_amdgcn_exp2f(p0[r]);
}
__device__ __forceinline__ void finishSM(f32x16& p0, f32x16& p1, float alpha, float& l_reg, bf16x8& pa0, bf16x8& pa1, bf16x8& pa2, bf16x8& pa3) {
#pragma unroll
  for (int r = 0; r < 16; ++r) p1[r] = __builtin_amdgcn_exp2f(p1[r]);
  float ps = 0;
#pragma unroll
  for (int r = 0; r < 16; ++r) ps += p0[r];
#pragma unroll
  for (int r = 0; r < 16; ++r) ps += p1[r];
  { auto rr = __builtin_amdgcn_permlane32_swap(__float_as_uint(ps), __float_as_uint(ps), false, false);
    ps = __uint_as_float(rr[0]) + __uint_as_float(rr[1]); }
  l_reg = l_reg * alpha + ps;
#define PK4(P, BASE, OUT) do { unsigned a0 = cvtpk(P[BASE + 0], P[BASE + 1]), a1 = cvtpk(P[BASE + 2], P[BASE + 3]);   \
    unsigned b0 = cvtpk(P[BASE + 4], P[BASE + 5]), b1 = cvtpk(P[BASE + 6], P[BASE + 7]);                              \
    auto r0 = __builtin_amdgcn_permlane32_swap(a0, b0, false, false); auto r1 = __builtin_amdgcn_permlane32_swap(a1, b1, false, false); \
    u32x4 w = {r0[0], r1[0], r0[1], r1[1]}; OUT = *reinterpret_cast<bf16x8*>(&w); } while (0)
  PK4(p0, 0, pa0); PK4(p0, 8, pa1); PK4(p1, 0, pa2); PK4(p1, 8, pa3);
#undef PK4
}
__device__ __forceinline__ void qkt(f32x16& p0, f32x16& p1, const bf16* Ks, const bf16x8* qr, int r32, int hi) {
  p0 = f32x16{}; p1 = f32x16{};
#pragma unroll
  for (int d0 = 0; d0 < 6; ++d0) { int cb = (d0 * 16 + hi * 8) * 2;
    bf16x8 b0 = *reinterpret_cast<const bf16x8*>((const char*)Ks + KSWZ(r32, cb));
    bf16x8 b1 = *reinterpret_cast<const bf16x8*>((const char*)Ks + KSWZ(32 + r32, cb));
    p0 = __builtin_amdgcn_mfma_f32_32x32x16_bf16(b0, qr[d0], p0, 0, 0, 0);
    p1 = __builtin_amdgcn_mfma_f32_32x32x16_bf16(b1, qr[d0], p1, 0, 0, 0); }
}
__device__ __forceinline__ int v_st(int k, int c) { const int kk = (k & ~0xC) | ((k & 4) << 1) | ((k & 8) >> 1); return ((kk >> 3) * 4 + (c >> 5)) * 512 + ((kk & 7) * 32 + (c & 31)) * 2; }
__device__ __forceinline__ int v_rd_base(int lane) { return ((lane & 3) << 3) | (((lane >> 2) & 3) << 6) | (((lane >> 4) & 1) << 5) | (((lane >> 5) & 1) << 8); }
constexpr int v_rd_off(int d0, int ks, int half) { return d0 * 512 + ks * 4096 + half * 2048; }
template <int OFF> __device__ __forceinline__ s16x4 tr_read(int vb) {
  s16x4 r; asm volatile("ds_read_b64_tr_b16 %0, %1 offset:%2" : "=&v"(r) : "v"(vb), "i"(OFF) : "memory"); return r;
}
template <int D0> __device__ __forceinline__ void pv_one(f32x16& od, int vb, bf16x8 pa0, bf16x8 pa1, bf16x8 pa2, bf16x8 pa3) {
  const s16x4 l0 = tr_read<v_rd_off(D0, 0, 0)>(vb), h0 = tr_read<v_rd_off(D0, 0, 1)>(vb), l1 = tr_read<v_rd_off(D0, 1, 0)>(vb), h1 = tr_read<v_rd_off(D0, 1, 1)>(vb);
  const s16x4 l2 = tr_read<v_rd_off(D0, 2, 0)>(vb), h2 = tr_read<v_rd_off(D0, 2, 1)>(vb), l3 = tr_read<v_rd_off(D0, 3, 0)>(vb), h3 = tr_read<v_rd_off(D0, 3, 1)>(vb);
  asm volatile("s_waitcnt lgkmcnt(0)" ::: "memory"); SBAR();
#define PK(L, H) (bf16x8){L[0], L[1], L[2], L[3], H[0], H[1], H[2], H[3]}
  od = __builtin_amdgcn_mfma_f32_32x32x16_bf16(pa0, PK(l0, h0), od, 0, 0, 0);
  od = __builtin_amdgcn_mfma_f32_32x32x16_bf16(pa1, PK(l1, h1), od, 0, 0, 0);
  od = __builtin_amdgcn_mfma_f32_32x32x16_bf16(pa2, PK(l2, h2), od, 0, 0, 0);
  od = __builtin_amdgcn_mfma_f32_32x32x16_bf16(pa3, PK(l3, h3), od, 0, 0, 0);
#undef PK
}
__device__ __forceinline__ void pv_d0(f32x16* o, int vb, bf16x8 pa0, bf16x8 pa1, bf16x8 pa2, bf16x8 pa3) {
  pv_one<0>(o[0], vb, pa0, pa1, pa2, pa3); pv_one<1>(o[1], vb, pa0, pa1, pa2, pa3);
}
__device__ __forceinline__ bf16x8 rope8(bf16x8 x, const float* tab, int pbase) {
  u32x4 w;
#pragma unroll
  for (int i = 0; i < 4; ++i) { const float x1 = __uint_as_float(((unsigned)(unsigned short)x[2 * i]) << 16), x2 = __uint_as_float(((unsigned)(unsigned short)x[2 * i + 1]) << 16);
    const float cs = tab[pbase + i], sn = tab[16 + pbase + i]; w[i] = cvtpk(x1 * cs - x2 * sn, x1 * sn + x2 * cs); }
  return *reinterpret_cast<bf16x8*>(&w);
}
__device__ __forceinline__ void attn_unit(const bf16* __restrict__ Qb, const bf16* __restrict__ KVb, const bf16* __restrict__ KRb, bf16* __restrict__ Ob,
                                          const float* __restrict__ rope, int seq, char* lds) {
  int tid_l = threadIdx.x; asm volatile("" : "+v"(tid_l));
  const int tid = tid_l, wid = tid >> 6, lane = tid & 63, r32 = lane & 31, hi = lane >> 5;
  bf16* V_lds = (bf16*)lds; bf16* K_lds = (bf16*)(lds + NBUF * SHM_V);
  float* ws = (float*)(lds + NBUF * SHM_V + NBUF * SHM_K) + wid * 64; float* li_l = ws; float* al_l = ws + 32;
  float m_reg = -1e30f, l_reg = 0; f32x16 o[2] = {}; bf16x8 qr[6];
  const bf16* Qw = Qb + (long)(wid * QBLK + r32) * 768 + hi * 8;
#pragma unroll
  for (int d0 = 0; d0 < 6; ++d0) qr[d0] = *reinterpret_cast<const bf16x8*>(Qw + d0 * 16);
  if (rope) { const float* tab = rope + (long)(wid * QBLK + r32) * 32; qr[4] = rope8(qr[4], tab, 4 * hi); qr[5] = rope8(qr[5], tab, 8 + 4 * hi); }
  const int sr = tid >> 4, ch = tid & 15;
  const bf16* kbase = ch < 8 ? KVb + ch * 8 : KRb + ((ch - 8) & 3) * 8; const long kstr = ch < 8 ? 1024 : 32;
  const int vkey = tid >> 3, vc8 = (tid & 7) * 8, vst0 = v_st(vkey, vc8);
  const bf16* vbase = KVb + 512 + vc8;
  const int vb0 = (int)(uintptr_t)V_lds + v_rd_base(lane);
  struct { bf16x8 vs0, ks0, ks1; } sr_[2];
#define SLOAD(i, k0) do { sr_[i].vs0 = *reinterpret_cast<const bf16x8*>(vbase + (long)((k0) + vkey) * 1024); \
    sr_[i].ks0 = *reinterpret_cast<const bf16x8*>(kbase + (long)((k0) + sr) * kstr); sr_[i].ks1 = *reinterpret_cast<const bf16x8*>(kbase + (long)((k0) + 32 + sr) * kstr); } while (0)
#define SWRITE(b, i) do { *(bf16x8*)((char*)V_lds + (b) * SHM_V + vst0) = sr_[i].vs0; int kc = ch * 16;               \
    *(bf16x8*)((char*)K_lds + (b) * SHM_K + KSWZ(sr, kc)) = sr_[i].ks0;                       \
    *(bf16x8*)((char*)K_lds + (b) * SHM_K + KSWZ(32 + sr, kc)) = sr_[i].ks1; } while (0)
#define SWAIT() asm volatile("s_waitcnt vmcnt(3)" ::: "memory")
#define RESC(a) do { if (__any((a) < 1.f)) { if (hi == 0) al_l[r32] = (a); asm volatile("s_waitcnt lgkmcnt(0)" ::: "memory"); \
    _Pragma("unroll") for (int d = 0; d < 2; ++d) _Pragma("unroll") for (int r = 0; r < 16; ++r) o[d][r] *= al_l[crow(r, hi)]; } } while (0)
  f32x16 pA0, pA1, pB0, pB1; float mnA, mnB, alA, alB; bf16x8 pa0, pa1, pa2, pa3; const int NT = seq / KVBLK;
  constexpr int SE = 0, SO = 1;
  SLOAD(SE, 0); asm volatile("s_waitcnt vmcnt(0)" ::: "memory"); SWRITE(0, SE); __syncthreads();
  qkt(pA0, pA1, K_lds, qr, r32, hi); partialSM(pA0, pA1, m_reg, mnA, alA);
  SLOAD(SO, KVBLK); if (2 < NT) SLOAD(SE, 2 * KVBLK);
  SWAIT(); SWRITE(1, SO); __syncthreads();
  int bprev = 0, bcur = 1, bnext = 2;
#define ATT_STEP(PN0, PN1, MNN, ALN, PO0, PO1, ALO, SL_LOAD, SL_WRITE, t) do { \
    SBAR(); qkt(PN0, PN1, (bf16*)((char*)K_lds + bcur * SHM_K), qr, r32, hi); \
    finishSM(PO0, PO1, ALO, l_reg, pa0, pa1, pa2, pa3); SBAR(); \
    SLOAD(SL_LOAD, (((t) + 2 < NT) ? (t) + 2 : NT - 1) * KVBLK); SBAR();     \
    pv_d0(o, vb0 + bprev * (int)SHM_V, pa0, pa1, pa2, pa3); partialSM(PN0, PN1, m_reg, MNN, ALN); \
    SWAIT(); SWRITE(bnext, SL_WRITE); \
    RESC(ALN); __syncthreads(); \
    bprev = bcur; bcur = bnext; bnext = (bnext == 2) ? 0 : bnext + 1; } while (0)
  for (int j = 1; j + 1 < NT; j += 2) {
    ATT_STEP(pB0, pB1, mnB, alB, pA0, pA1, alA, SO, SE, j);
    ATT_STEP(pA0, pA1, mnA, alA, pB0, pB1, alB, SE, SO, j + 1);
  }
#undef ATT_STEP
  SBAR(); qkt(pB0, pB1, (bf16*)((char*)K_lds + bcur * SHM_K), qr, r32, hi);
  finishSM(pA0, pA1, alA, l_reg, pa0, pa1, pa2, pa3); SBAR();
  pv_d0(o, vb0 + bprev * (int)SHM_V, pa0, pa1, pa2, pa3); partialSM(pB0, pB1, m_reg, mnB, alB);
  RESC(alB);
  finishSM(pB0, pB1, alB, l_reg, pa0, pa1, pa2, pa3); SBAR();
  pv_d0(o, vb0 + bcur * (int)SHM_V, pa0, pa1, pa2, pa3);
  if (hi == 0) li_l[r32] = l_reg; asm volatile("s_waitcnt lgkmcnt(0)" ::: "memory");
  float rli[16];
#pragma unroll
  for (int r = 0; r < 16; ++r) rli[r] = __builtin_amdgcn_rcpf(li_l[crow(r, hi)]);
  bf16* Ow = Ob + (long)(wid * QBLK) * 1024;
#pragma unroll
  for (int r = 0; r < 16; ++r) { int orow = crow(r, hi);
#pragma unroll
    for (int d0 = 0; d0 < 2; ++d0) { const float v = o[d0][r] * rli[r]; Ow[(long)orow * 1024 + d0 * 32 + r32] = (bf16)(cvtpk(v, v) & 0xffffu); } }
#undef SLOAD
#undef SWRITE
#undef SWAIT
#undef RESC
}
}

struct Args { const float* in[33]; float* out; unsigned char* ws; int ph_lo, ph_hi; };
enum { I_X = 0, I_C, I_CTX, I_CCTX, I_MODW, I_MODB, I_LN1G, I_LN1B, I_LN2G, I_LN2B, I_WIN, I_QNORM, I_KVNORM, I_WUQ, I_WUK, I_WUV, I_LBL, I_HGNORM, I_WOUT,
       I_PW1W, I_PW1B, I_DWW, I_DWB, I_CLNG, I_CLNB, I_PW2W, I_PW2B, I_RW, I_RB, I_WGU, I_BGU, I_WDN, I_BDN };

__device__ __forceinline__ int dst_row(int n, int mode, int row_off) {
    if (mode == 0) return row_off + n;
    int f, g; if (mode == 1) { f = n >> 1; g = n & 1; } else { g = n >> 10; f = n & 1023; }
    return row_off + 256 * (f >> 7) + 128 * g + (f & 127);
}
__device__ __forceinline__ unsigned pack_fp8x4(float a, float b, float c, float d) { int w = 0; w = __builtin_amdgcn_cvt_pk_fp8_f32(fminf(fmaxf(a, -448.f), 448.f), fminf(fmaxf(b, -448.f), 448.f), w, false);
    w = __builtin_amdgcn_cvt_pk_fp8_f32(fminf(fmaxf(c, -448.f), 448.f), fminf(fmaxf(d, -448.f), 448.f), w, true); return (unsigned)w; }
struct TrItem { const float* W; bf16* WT; int K, N, mode, row_off, item; float f8scale; };
__device__ __forceinline__ void tr_load(const TrItem& d, f32x4 (&v)[16], int lane) {
    const int nblk = (d.N + 31) >> 5, kb = d.item / nblk, nb = d.item - kb * nblk, k0 = 128 * kb + 16 * (lane >> 3), nc = 32 * nb + 4 * (lane & 7);
#pragma unroll
    for (int i = 0; i < 16; ++i) v[i] = (nc < d.N) ? __builtin_nontemporal_load((const f32x4*)(d.W + (size_t)(k0 + i) * d.N + nc)) : (f32x4){0.f, 0.f, 0.f, 0.f};
}
__device__ __forceinline__ void tr_store(const TrItem& d, const f32x4 (&v)[16], int lane) {
    const int nblk = (d.N + 31) >> 5, kb = d.item / nblk, nb = d.item - kb * nblk, k0 = 128 * kb + 16 * (lane >> 3), nc = 32 * nb + 4 * (lane & 7); const int K = d.K;
    if (nc >= d.N) return;
#pragma unroll
    for (int j = 0; j < 4; ++j) { const size_t row = (size_t)dst_row(nc + j, d.mode, d.row_off);
        if (d.f8scale > 0.f) { const float f8 = d.f8scale; v4u o;
            o.x = pack_fp8x4(v[0][j] * f8, v[1][j] * f8, v[2][j] * f8, v[3][j] * f8); o.y = pack_fp8x4(v[4][j] * f8, v[5][j] * f8, v[6][j] * f8, v[7][j] * f8);
            o.z = pack_fp8x4(v[8][j] * f8, v[9][j] * f8, v[10][j] * f8, v[11][j] * f8); o.w = pack_fp8x4(v[12][j] * f8, v[13][j] * f8, v[14][j] * f8, v[15][j] * f8);
            *(v4u*)((unsigned char*)d.WT + row * K + k0) = o; }
        else { v4u o0, o1; o0.x = pk2(v[0][j], v[1][j]); o0.y = pk2(v[2][j], v[3][j]); o0.z = pk2(v[4][j], v[5][j]); o0.w = pk2(v[6][j], v[7][j]);
            o1.x = pk2(v[8][j], v[9][j]); o1.y = pk2(v[10][j], v[11][j]); o1.z = pk2(v[12][j], v[13][j]); o1.w = pk2(v[14][j], v[15][j]);
            bf16* wp = d.WT + row * K + k0; *(v4u*)wp = o0; *(v4u*)(wp + 8) = o1; } }
}
__device__ __forceinline__ void convert_items(const Args& a, unsigned char* ws, LAS float* scr, int lane, int gw, int NGW, int it_lo, int it_hi) {
    constexpr int I0 = 8 * 101, I1 = 6 * 12, I2 = 4 * 8, I3 = 4 * 8, I4 = 256, I5 = 512;
    constexpr int NGU = 64 * 512, NDN = 64 * 256;
    auto decode = [&](int it) -> TrItem {
        TrItem d; int r = it; d.f8scale = 0.f; d.mode = 0; d.row_off = 0;
        if (r < NGU) { const int mi = r >> 9; d.W = a.in[I_WGU] + (size_t)mi * 1024 * 2048; d.K = 1024; d.N = 2048; d.WT = (bf16*)(ws + WS_WGU + (size_t)mi * 2048 * 1024); d.mode = 1; d.item = r & 511; d.f8scale = SC_WGU; return d; } r -= NGU;
        if (r < NDN) { const int mi = r >> 8; d.W = a.in[I_WDN] + (size_t)mi * 1024 * 1024; d.K = 1024; d.N = 1024; d.WT = (bf16*)(ws + WS_WDN + (size_t)mi * 1024 * 1024); d.item = r & 255; d.f8scale = SC_WDN; return d; } r -= NDN;
        if (r < I0) { d.W = a.in[I_WIN]; d.K = 1024; d.N = 3232; d.WT = (bf16*)(ws + WS_WIN); d.item = r; d.f8scale = SC_WIN; return d; } r -= I0;
        if (r < I1) { d.W = a.in[I_WUQ]; d.K = 384; d.N = 768; d.WT = (bf16*)(ws + WS_WUQ); d.item = r; return d; } r -= I1;
        if (r < I2) { d.W = a.in[I_WUK]; d.K = 256; d.N = 512; d.WT = (bf16*)(ws + WS_WUKV); d.item = r; return d; } r -= I2;
        if (r < I3) { d.W = a.in[I_WUV]; d.K = 256; d.N = 512; d.WT = (bf16*)(ws + WS_WUKV); d.row_off = 512; d.item = r; return d; } r -= I3;
        if (r < I4) { d.W = a.in[I_WOUT]; d.K = 1024; d.N = 1024; d.WT = (bf16*)(ws + WS_WOUT); d.item = r; return d; } r -= I4;
        if (r < I5) { d.W = a.in[I_PW1W]; d.K = 1024; d.N = 2048; d.WT = (bf16*)(ws + WS_WPW1); d.mode = 2; d.item = r; d.f8scale = SC_WPW; return d; } r -= I5;
        d.W = a.in[I_PW2W]; d.K = 1024; d.N = 1024; d.WT = (bf16*)(ws + WS_WPW2); d.item = r; d.f8scale = SC_WPW; return d; };
    f32x4 tv0[16], tv1[16];
    int it = it_lo + gw;
    if (it < it_hi) { const TrItem d0 = decode(it); tr_load(d0, tv0, lane); }
    if (it + NGW < it_hi) { const TrItem d1 = decode(it + NGW); tr_load(d1, tv1, lane); }
    for (; it < it_hi; it += 2 * NGW) {
        { const TrItem d = decode(it);
          tr_store(d, tv0, lane);
          if (it + 2 * NGW < it_hi) { const TrItem dn = decode(it + 2 * NGW); tr_load(dn, tv0, lane); } }
        if (it + NGW < it_hi) { const TrItem d = decode(it + NGW);
          tr_store(d, tv1, lane);
          if (it + 3 * NGW < it_hi) { const TrItem dn = decode(it + 3 * NGW); tr_load(dn, tv1, lane); } }
    }
}
__device__ __forceinline__ void phase_prologue(const Args& a, LAS unsigned char* lds, int tid, int lane, int wave) {
    unsigned char* ws = a.ws;
    const int G = gridDim.x, B = blockIdx.x;
    {
        LAS float* sc = (LAS float*)lds;
        LAS float* red = (LAS float*)(lds + 36864);
        float* modv = (float*)(ws + WS_MODV);
        bool have = false;
        for (int it = B; it < 192; it += G) {
            if (!have) { for (int i = tid; i < 9 * 1024; i += NTHR) { const int r = i >> 10, k = i & 1023; const float x = r < 8 ? a.in[I_C][r * 1024 + k] : a.in[I_CCTX][k]; sc[i] = x * sigm(x); } __syncthreads(); have = true; }
            const int l = it / 96, jc = it % 96, kg = tid >> 6, jj = tid & 63, j = jc * 64 + jj;
            float acc[9];
#pragma unroll
            for (int r = 0; r < 9; ++r) acc[r] = 0.f;
            const float* wp = a.in[I_MODW] + ((size_t)l * 1024 + kg * 128) * 6144 + j;
            for (int k0 = 0; k0 < 128; k0 += 16) { float w[16];
#pragma unroll
                for (int kk = 0; kk < 16; ++kk) w[kk] = wp[(size_t)(k0 + kk) * 6144];
#pragma unroll
                for (int kk = 0; kk < 16; ++kk)
#pragma unroll
                    for (int r = 0; r < 9; ++r) acc[r] += sc[r * 1024 + kg * 128 + k0 + kk] * w[kk]; }
#pragma unroll
            for (int r = 0; r < 9; ++r) red[(kg * 9 + r) * 64 + jj] = acc[r];
            __syncthreads();
            for (int i = tid; i < 576; i += NTHR) { const int r = i >> 6, j2 = i & 63; float s = a.in[I_MODB][l * 6144 + jc * 64 + j2];
#pragma unroll
                for (int g = 0; g < 8; ++g) s += red[(g * 9 + r) * 64 + j2];
                modv[((size_t)l * 9 + r) * 6144 + jc * 64 + j2] = s; }
            __syncthreads();
        }
        __syncthreads();
    }
    const int gw = B * NWAVES + wave, NGW = G * NWAVES, gt = B * NTHR + tid, NGT = G * NTHR;
    { float* rope = (float*)(ws + WS_ROPE);
      for (int i = gt; i < 4096 * 16; i += NGT) { const int t = i >> 4, p = i & 15; const float pos = (float)(p < 8 ? (t >> 6) : (t & 63));
          const float inv = __powf(10000.0f, -(float)(p & 7) * 0.125f); const float ang = pos * inv; rope[t * 32 + p] = cosf(ang); rope[t * 32 + 16 + p] = sinf(ang); }
      float* bgu = (float*)(ws + WS_BGU);
      for (int i = gt; i < 2 * 32 * 2048; i += NGT) { const int le = i >> 11, np = i & 2047, q = np >> 8, g = (np >> 7) & 1, r = np & 127, f = 128 * q + r; bgu[i] = a.in[I_BGU][(size_t)le * 2048 + 2 * f + g]; }
      float* pb = (float*)(ws + WS_PW1B);
      for (int i = gt; i < 2048; i += NGT) { const int q = i >> 8, g = (i >> 7) & 1, r = i & 127, f = 128 * q + r; pb[i] = a.in[I_PW1B][g * 1024 + f]; }
      v4u* zp = (v4u*)(ws + WS_WIN + (size_t)3232 * 1024);
      for (int i = gt; i < 96 * 1024 / 16; i += NGT) zp[i] = (v4u){0u, 0u, 0u, 0u};
    }
    LAS float* scr = (LAS float*)(lds + wave * 16640);
    constexpr int I0 = 8 * 101, I1 = 6 * 12, I2 = 4 * 8, I3 = 4 * 8, I4 = 256, I5 = 512, I6 = 256, SMALL = I0 + I1 + I2 + I3 + I4 + I5 + I6;
    constexpr int NGU = 64 * 512, NDN = 64 * 256, NITEMS = SMALL + NGU + NDN;
    convert_items(a, ws, scr, lane, B * NWAVES + wave, G * NWAVES, NGU + NDN, NITEMS);
}
__device__ __forceinline__ void convert_moe_share(const Args& a, LAS unsigned char* lds, int lane, int wave) {
    LAS float* scr = (LAS float*)(lds + wave * 16640);
    constexpr int NGU = 64 * 512, NDN = 64 * 256;
    convert_items(a, a.ws, scr, lane, blockIdx.x * NWAVES + wave, gridDim.x * NWAVES, 0, NGU + NDN);
}

__device__ __forceinline__ void phase_mod0(const Args& a, int lane, int wave) {
    const int gw = blockIdx.x * NWAVES + wave, NGW = gridDim.x * NWAVES;
    const float* modv = (const float*)(a.ws + WS_MODV);
    bf16* X = (bf16*)(a.ws + WS_X);
    f32x4 xv[2][4], xn[2][4];
#define MOD0_LOAD(dst, r0_) do { _Pragma("unroll") for (int q = 0; q < 2; ++q) { const int r = (r0_) + q; const int b = r / TPB, p = r - b * TPB; \
            const float* src = p < CTXL ? a.in[I_CTX] + ((size_t)b * CTXL + p) * 1024 : a.in[I_X] + ((size_t)b * SEQ + (p - CTXL)) * 1024; \
            _Pragma("unroll") for (int j = 0; j < 4; ++j) dst[q][j] = *(const f32x4*)(src + 4 * (lane + 64 * j)); } } while (0)
    if (2 * gw < NTOK) MOD0_LOAD(xv, 2 * gw);
    for (int r0 = 2 * gw; r0 < NTOK; r0 += 2 * NGW) {
        f32x4 shv[2][4], scv[2][4];
#pragma unroll
        for (int q = 0; q < 2; ++q) { const int r = r0 + q; const int b = r / TPB, p = r - b * TPB; const float* mvp = modv + (size_t)(p < CTXL ? 8 : b) * 6144;
#pragma unroll
            for (int j = 0; j < 4; ++j) { const int c = 4 * (lane + 64 * j); shv[q][j] = *(const f32x4*)(mvp + c); scv[q][j] = *(const f32x4*)(mvp + 1024 + c); } }
        if (r0 + 2 * NGW < NTOK) MOD0_LOAD(xn, r0 + 2 * NGW);
#pragma unroll
        for (int q = 0; q < 2; ++q)
#pragma unroll
            for (int j = 0; j < 4; ++j) { const int c = 4 * (lane + 64 * j); const f32x4 sh = shv[q][j], sc = scv[q][j];
                const f32x4 y = (xv[q][j] * (sc + 1.0f) + sh) * SC_A0; *(unsigned*)((unsigned char*)X + (size_t)(r0 + q) * 1024 + c) = pack_fp8x4(y[0], y[1], y[2], y[3]); }
#pragma unroll
        for (int q = 0; q < 2; ++q)
#pragma unroll
            for (int j = 0; j < 4; ++j) xv[q][j] = xn[q][j];
    }
#undef MOD0_LOAD
}

__device__ __forceinline__ void phase_norm0(const Args& a, int lane, int wave) {
    const int gw = blockIdx.x * NWAVES + wave, NGW = gridDim.x * NWAVES;
    const bf16* Z = (const bf16*)(a.ws + WS_Z); bf16* CQN = (bf16*)(a.ws + WS_CQN); bf16* CKVN = (bf16*)(a.ws + WS_CKVN); bf16* KRR = (bf16*)(a.ws + WS_KRR);
    const float* rope = (const float*)(a.ws + WS_ROPE);
    float gq[8], gk[8];
#pragma unroll
    for (int i = 0; i < 8; ++i) { gq[i] = lane < 48 ? a.in[I_QNORM][8 * lane + i] : 0.f; gk[i] = lane < 32 ? a.in[I_KVNORM][8 * lane + i] : 0.f; }
    bf16x8 q8 = {}, k8 = {}, r8 = {}, nq8 = {}, nk8 = {}, nr8 = {};
#define N0_LOAD(dq, dk, dr, r_) do { const bf16* z_ = Z + (size_t)(r_) * ZC; if (lane < 48) dq = *(const bf16x8*)(z_ + ZQ + 8 * lane); if (lane < 32) dk = *(const bf16x8*)(z_ + ZKV + 8 * lane); if (lane < 4) dr = *(const bf16x8*)(z_ + ZKR + 8 * lane); } while (0)
    if (gw < NTOK) N0_LOAD(q8, k8, r8, gw);
    for (int r = gw; r < NTOK; r += NGW, q8 = nq8, k8 = nk8, r8 = nr8) {
        const int p = r % TPB;
        if (r + NGW < NTOK) N0_LOAD(nq8, nk8, nr8, r + NGW);
        float qf[8], kf[8], sq = 0.f, sk = 0.f;
#pragma unroll
        for (int i = 0; i < 8; ++i) { qf[i] = bf2f((unsigned short)q8[i]); kf[i] = bf2f((unsigned short)k8[i]); sq += qf[i] * qf[i]; sk += kf[i] * kf[i]; }
        sq = wave_sum(sq); sk = wave_sum(sk);
        const float rq = rsqrtf(sq * (1.f / 384.f) + RMS_EPS), rk = rsqrtf(sk * (1.f / 256.f) + RMS_EPS);
        if (lane < 48) { v4u o; o.x = pk2(qf[0] * rq * gq[0], qf[1] * rq * gq[1]); o.y = pk2(qf[2] * rq * gq[2], qf[3] * rq * gq[3]); o.z = pk2(qf[4] * rq * gq[4], qf[5] * rq * gq[5]); o.w = pk2(qf[6] * rq * gq[6], qf[7] * rq * gq[7]);
            *(v4u*)(CQN + (size_t)r * 384 + 8 * lane) = o; }
        if (lane < 32) { v4u o; o.x = pk2(kf[0] * rk * gk[0], kf[1] * rk * gk[1]); o.y = pk2(kf[2] * rk * gk[2], kf[3] * rk * gk[3]); o.z = pk2(kf[4] * rk * gk[4], kf[5] * rk * gk[5]); o.w = pk2(kf[6] * rk * gk[6], kf[7] * rk * gk[7]);
            *(v4u*)(CKVN + (size_t)r * 256 + 8 * lane) = o; }
        if (lane < 4) { bf16x8 o8 = r8; if (p >= CTXL) o8 = att::rope8(r8, rope + (size_t)(p - CTXL) * 32, 4 * lane); *(bf16x8*)(KRR + (size_t)r * 32 + 8 * lane) = o8; }
    }
#undef N0_LOAD
}

__device__ __forceinline__ void hgrn_unit(const Args& a, int unit, LAS unsigned char* lds, int tid) {
    const int b = unit >> 5, head = (unit >> 3) & 3, dir = (unit >> 2) & 1, sl = unit & 3;
    const bf16* Z = (const bf16*)(a.ws + WS_Z);
    float* Od = (float*)(a.ws + (dir ? WS_OB : WS_OF));
    LAS float* lbv = (LAS float*)lds;
    constexpr int BUF0 = 1024, BUFSZ = 28672, OFF_Q = 16384, OFF_V = 24576;
    if (tid < 128) { const int c = head * 128 + tid; const float l0 = a.in[I_LBL][c], l1 = a.in[I_LBL][512 + c], l2 = a.in[I_LBL][1024 + c]; const float m = fmaxf(l0, fmaxf(l1, l2));
        const float e0 = __expf(l0 - m), e1 = __expf(l1 - m), e2 = __expf(l2 - m); lbv[tid] = e0 / (e0 + e1 + e2); }
    __syncthreads();
    const int lt = tid >> 4, lcg = tid & 15;
    float lb8[8];
#pragma unroll
    for (int i = 0; i < 8; ++i) lb8[i] = lbv[8 * lcg + i];
    const int fcol = (dir ? ZHB : ZHF) + head * 128 + 8 * lcg, qcol = ZHQ + head * 128 + 8 * lcg;
    const int vt = tid >> 2, vcol = ZHI + head * 128 + sl * 32 + (tid & 3) * 8;
    const int wave = tid >> 6, lane = tid & 63, vv = lane >> 4, cg = lane & 15, vloc = wave * 4 + vv;
    const size_t zb = (size_t)b * TPB;
    bf16x8 rq, rf, rv;
#define TOKP(n) (dir ? ((n) < CTXL ? (CTXL - 1 - (n)) : (TPB + CTXL - 1 - (n))) : (n))
#define HG_LOAD(i) do { const int n_ = 32 * (i) + lt; const bf16* zr_ = Z + (zb + TOKP(n_)) * ZC; rq = *(const bf16x8*)(zr_ + qcol); rf = *(const bf16x8*)(zr_ + fcol); \
        if (tid < 128) { const int n2_ = 32 * (i) + vt; rv = *(const bf16x8*)(Z + (zb + TOKP(n2_)) * ZC + vcol); } } while (0)
#define HG_WRITE(bufi) do { LAS unsigned char* bp_ = lds + BUF0 + (bufi) * BUFSZ; float f_[8]; \
        _Pragma("unroll") for (int i_ = 0; i_ < 8; ++i_) f_[i_] = lb8[i_] + (1.f - lb8[i_]) * sigm(bf2f((unsigned short)rf[i_])); \
        *(LAS f32x4*)(bp_ + ((lt * 128 + lcg * 4) * 4)) = (f32x4){f_[0], f_[1], f_[2], f_[3]}; *(LAS f32x4*)(bp_ + ((lt * 128 + 64 + lcg * 4) * 4)) = (f32x4){f_[4], f_[5], f_[6], f_[7]}; \
        *(LAS bf16x8*)(bp_ + OFF_Q + (lt * 128 + lcg * 8) * 2) = rq; \
        if (tid < 128) { float v_[8]; _Pragma("unroll") for (int i_ = 0; i_ < 8; ++i_) v_[i_] = bf2f((unsigned short)rv[i_]); \
            *(LAS f32x4*)(bp_ + OFF_V + (vt * 32 + (tid & 3) * 8) * 4) = (f32x4){v_[0], v_[1], v_[2], v_[3]}; *(LAS f32x4*)(bp_ + OFF_V + (vt * 32 + (tid & 3) * 8 + 4) * 4) = (f32x4){v_[4], v_[5], v_[6], v_[7]}; } } while (0)
    float S[8];
#pragma unroll
    for (int j = 0; j < 8; ++j) S[j] = 0.f;
    HG_LOAD(0); HG_WRITE(0); __syncthreads();
    const bool b3 = (cg & 8) != 0, b2 = (cg & 4) != 0, b1 = (cg & 2) != 0, b0 = (cg & 1) != 0;
    for (int i = 0; i < TPB / 32; ++i) {
        if (i + 1 < TPB / 32) HG_LOAD(i + 1);
        const LAS unsigned char* bp = lds + BUF0 + (i & 1) * BUFSZ;
#pragma unroll 1
        for (int g = 0; g < 4; ++g) {
            const LAS unsigned char* gp = bp + g * 8 * 512;
            float ot[8];
#pragma unroll
            for (int t = 0; t < 8; ++t) {
                const f32x4 f0 = *(const LAS f32x4*)(gp + ((t * 128 + cg * 4) * 4)), f1 = *(const LAS f32x4*)(gp + ((t * 128 + 64 + cg * 4) * 4));
                const bf16x8 q8 = *(const LAS bf16x8*)(bp + OFF_Q + ((g * 8 + t) * 128 + cg * 8) * 2);
                const float v = *(const LAS float*)(bp + OFF_V + ((g * 8 + t) * 32 + vloc) * 4);
                float acc = 0.f;
#pragma unroll
                for (int j = 0; j < 8; ++j) { const float fj = j < 4 ? f0[j] : f1[j - 4]; const float qj = bf2f((unsigned short)q8[j]);
                    const float kv = fmaf(-fj, v, v); S[j] = fmaf(fj, S[j], kv); acc = fmaf(S[j], qj, acc); }
                ot[t] = acc;
            }
#pragma unroll
            for (int k = 0; k < 4; ++k) { const float snd = b3 ? ot[k] : ot[k + 4]; const float rcv = __shfl_xor(snd, 8); ot[k] = (b3 ? ot[k + 4] : ot[k]) + rcv; }
#pragma unroll
            for (int k = 0; k < 2; ++k) { const float snd = b2 ? ot[k] : ot[k + 2]; const float rcv = __shfl_xor(snd, 4); ot[k] = (b2 ? ot[k + 2] : ot[k]) + rcv; }
            { const float snd = b1 ? ot[0] : ot[1]; const float rcv = __shfl_xor(snd, 2); ot[0] = (b1 ? ot[1] : ot[0]) + rcv; }
            ot[0] += __shfl_xor(ot[0], 1);
            if (!b0) { const int n = 32 * i + 8 * g + (cg >> 1); const int p = TOKP(n); if (p >= CTXL) Od[(zb + p) * 512 + head * 128 + sl * 32 + vloc] = ot[0]; }
        }
        if (i + 1 < TPB / 32) HG_WRITE((i + 1) & 1);
        __syncthreads();
    }
#undef TOKP
#undef HG_LOAD
#undef HG_WRITE
}

__device__ __forceinline__ void phase_readout(const Args& a, int lane, int wave) {
    const int gw = blockIdx.x * NWAVES + wave, NGW = gridDim.x * NWAVES;
    const bf16* OF = (const bf16*)(a.ws + WS_OF); const bf16* OB = (const bf16*)(a.ws + WS_OB);
    const bf16* Z = (const bf16*)(a.ws + WS_Z); bf16* MIX = (bf16*)(a.ws + WS_Y);
    float hn[8];
#pragma unroll
    for (int i = 0; i < 8; ++i) hn[i] = a.in[I_HGNORM][((8 * lane) & 127) + i];
    bf16x8 a8 = {}, c8 = {}, g8 = {}, na8 = {}, nc8 = {}, ng8 = {};
#define RO_LOAD(da, dc, dg, lr_) do { const size_t r_ = (size_t)grow_of(lr_); da = *(const bf16x8*)(OF + r_ * 512 + 8 * lane); dc = *(const bf16x8*)(OB + r_ * 512 + 8 * lane); dg = *(const bf16x8*)(Z + r_ * ZC + ZHG + 8 * lane); } while (0)
    if (gw < NLAT) RO_LOAD(a8, c8, g8, gw);
    for (int lr = gw; lr < NLAT; lr += NGW, a8 = na8, c8 = nc8, g8 = ng8) {
        const size_t r = (size_t)grow_of(lr);
        if (lr + NGW < NLAT) RO_LOAD(na8, nc8, ng8, lr + NGW);
        float o[8]; float ss = 0.f;
#pragma unroll
        for (int i = 0; i < 8; ++i) o[i] = bf2f((unsigned short)a8[i]) + bf2f((unsigned short)c8[i]);
#pragma unroll
        for (int i = 0; i < 8; ++i) ss += o[i] * o[i];
        ss += __shfl_xor(ss, 1); ss += __shfl_xor(ss, 2); ss += __shfl_xor(ss, 4); ss += __shfl_xor(ss, 8);
        const float rs = rsqrtf(ss * (1.f / 128.f) + RMS_EPS);
        float y[8];
#pragma unroll
        for (int i = 0; i < 8; ++i) { const float g = bf2f((unsigned short)g8[i]); y[i] = o[i] * rs * hn[i] * (g * sigm(g)); }
        v4u w; w.x = pk2(y[0], y[1]); w.y = pk2(y[2], y[3]); w.z = pk2(y[4], y[5]); w.w = pk2(y[6], y[7]);
        *(v4u*)(MIX + r * 1024 + 512 + 8 * lane) = w;
    }
#undef RO_LOAD
}

__device__ __forceinline__ int rows_per_block() { const int G = gridDim.x; return (((NLAT + G - 1) / G) + 15) & ~15; }
__device__ __forceinline__ void phase_ln1(const Args& a, int l, LAS unsigned char* lds, int tid, int lane, int wave) {
    typedef short bf16x8s __attribute__((ext_vector_type(8)));
    const int RB = rows_per_block(), lr_base = blockIdx.x * RB;
    const bf16* PRE = (const bf16*)(a.ws + WS_PRE); bf16* XB = (bf16*)(a.ws + WS_X);
    const float* modv = (const float*)(a.ws + WS_MODV) + (size_t)l * 9 * 6144;
    const float* lng = a.in[I_LN1G] + l * 1024; const float* lnb = a.in[I_LN1B] + l * 1024;
    const float* rw = a.in[I_RW] + (size_t)l * 1024 * 32; const float* rb = a.in[I_RB] + l * 32;
    constexpr int XT_LD = 1028, O_PART = 16 * XT_LD * 4, O_LG = O_PART + 8 * 32 * 16 * 4, O_HIST = O_LG + 16 * 33 * 4 + 64, O_CCNT = O_HIST + 256, O_TIL = O_CCNT + 2048, O_TWL = O_TIL + 4096;
    LAS float* XT = (LAS float*)lds; LAS float* PART = (LAS float*)(lds + O_PART); LAS float* LG = (LAS float*)(lds + O_LG);
    LAS int* hist = (LAS int*)(lds + O_HIST);
    LAS int* ccnt = (LAS int*)(lds + O_CCNT);
    LAS int* til = (LAS int*)(lds + O_TIL);
    LAS float* twl = (LAS float*)(lds + O_TWL);
    __syncthreads();
    if (tid < 32) hist[tid] = 0;
    bf16x8s whi[2][4], wlo[2][4];
    { const int e15 = lane & 15, kq = lane >> 4;
#pragma unroll
      for (int t = 0; t < 2; ++t)
#pragma unroll
          for (int sI = 0; sI < 4; ++sI) { float wv[8];
#pragma unroll
              for (int j = 0; j < 8; ++j) wv[j] = rw[(size_t)(128 * wave + 32 * sI + 8 * kq + j) * 32 + 16 * t + e15];
              v4u ph, pl;
#pragma unroll
              for (int j = 0; j < 4; ++j) { const unsigned p = pk2(wv[2 * j], wv[2 * j + 1]); const float h0 = __uint_as_float(p << 16), h1 = __uint_as_float(p & 0xffff0000u); ph[j] = p; pl[j] = pk2(wv[2 * j] - h0, wv[2 * j + 1] - h1); }
              whi[t][sI] = __builtin_bit_cast(bf16x8s, ph); wlo[t][sI] = __builtin_bit_cast(bf16x8s, pl); } }
    const int ngroups = RB / 16;
    f32x4 fP[4], fQ[4]; int fb = -1;
    const float rbias = rb[tid >> 4];
    v2u xr[2][4];
#define LN1_LOAD(g) do { _Pragma("unroll") for (int rr_ = 0; rr_ < 2; ++rr_) { const int lr_ = lr_base + 16 * (g) + 2 * wave + rr_; const size_t r_ = (size_t)grow_of(lr_ < NLAT ? lr_ : NLAT - 1); \
        _Pragma("unroll") for (int j_ = 0; j_ < 4; ++j_) xr[rr_][j_] = *(const v2u*)(PRE + r_ * 1024 + 4 * (lane + 64 * j_)); } } while (0)
#if defined(PROBE_LN1X2)
    for (int rep_ = 0; rep_ < 2; ++rep_) { __syncthreads(); if (tid < 32) hist[tid] = 0; __syncthreads();
#endif
    LN1_LOAD(0);
    for (int g = 0; g < ngroups; ++g) {
#pragma unroll
        for (int rr = 0; rr < 2; ++rr) {
            const int lr = lr_base + 16 * g + 2 * wave + rr; const bool ok = lr < NLAT; const size_t r = (size_t)grow_of(ok ? lr : NLAT - 1); const int b = (ok ? lr : NLAT - 1) >> 12;
            if (b != fb) { const float* mv = modv + (size_t)b * 6144; fb = b;
#pragma unroll
                for (int j = 0; j < 4; ++j) { const int c = 4 * (lane + 64 * j); const f32x4 gg = *(const f32x4*)(lng + c), bb = *(const f32x4*)(lnb + c), sh = *(const f32x4*)(mv + 3 * 1024 + c), sc = *(const f32x4*)(mv + 4 * 1024 + c);
                    fP[j] = gg * (sc + 1.0f); fQ[j] = bb * (sc + 1.0f) + sh; } }
            f32x4 x[4]; float s = 0.f;
#pragma unroll
            for (int j = 0; j < 4; ++j) { const v2u p = xr[rr][j]; x[j] = (f32x4){__uint_as_float(p.x << 16), __uint_as_float(p.x & 0xffff0000u), __uint_as_float(p.y << 16), __uint_as_float(p.y & 0xffff0000u)}; s += (x[j][0] + x[j][1]) + (x[j][2] + x[j][3]); }
            const float mean = wave_sum(s) * (1.f / 1024.f); float s2 = 0.f;
#pragma unroll
            for (int j = 0; j < 4; ++j) { x[j] = x[j] - mean; s2 += (x[j][0] * x[j][0] + x[j][1] * x[j][1]) + (x[j][2] * x[j][2] + x[j][3] * x[j][3]); }
            const float rstd = rsqrtf(wave_sum(s2) * (1.f / 1024.f) + LN_EPS);
#pragma unroll
            for (int j = 0; j < 4; ++j) { const int c = 4 * (lane + 64 * j);
                const f32x4 bm = (x[j] * rstd) * fP[j] + fQ[j];
                if (ok) *(unsigned*)((unsigned char*)XB + r * 1024 + c) = pack_fp8x4(bm[0] * SC_X8, bm[1] * SC_X8, bm[2] * SC_X8, bm[3] * SC_X8);
                *(LAS f32x4*)(XT + (2 * wave + rr) * XT_LD + c) = bm; }
        }
        if (g + 1 < ngroups) LN1_LOAD(g + 1);
        __syncthreads();
        { const int rr = lane & 15, kq = lane >> 4;
          f32x4 acc0 = {0.f, 0.f, 0.f, 0.f}, acc1 = {0.f, 0.f, 0.f, 0.f};
#pragma unroll
          for (int sI = 0; sI < 4; ++sI) { const LAS float* xp = XT + rr * XT_LD + 128 * wave + 32 * sI + 8 * kq; const f32x4 v0 = *(const LAS f32x4*)xp, v1 = *(const LAS f32x4*)(xp + 4);
              const float bv[8] = {v0[0], v0[1], v0[2], v0[3], v1[0], v1[1], v1[2], v1[3]}; v4u ph, pl;
#pragma unroll
              for (int j = 0; j < 4; ++j) { const unsigned p = pk2(bv[2 * j], bv[2 * j + 1]); const float h0 = __uint_as_float(p << 16), h1 = __uint_as_float(p & 0xffff0000u); ph[j] = p; pl[j] = pk2(bv[2 * j] - h0, bv[2 * j + 1] - h1); }
              const bf16x8s bh = __builtin_bit_cast(bf16x8s, ph), bl = __builtin_bit_cast(bf16x8s, pl);
              acc0 = __builtin_amdgcn_mfma_f32_16x16x32_bf16(whi[0][sI], bh, acc0, 0, 0, 0); acc0 = __builtin_amdgcn_mfma_f32_16x16x32_bf16(whi[0][sI], bl, acc0, 0, 0, 0); acc0 = __builtin_amdgcn_mfma_f32_16x16x32_bf16(wlo[0][sI], bh, acc0, 0, 0, 0);
              acc1 = __builtin_amdgcn_mfma_f32_16x16x32_bf16(whi[1][sI], bh, acc1, 0, 0, 0); acc1 = __builtin_amdgcn_mfma_f32_16x16x32_bf16(whi[1][sI], bl, acc1, 0, 0, 0); acc1 = __builtin_amdgcn_mfma_f32_16x16x32_bf16(wlo[1][sI], bh, acc1, 0, 0, 0); }
#pragma unroll
          for (int q = 0; q < 4; ++q) { PART[(wave * 32 + 4 * kq + q) * 16 + rr] = acc0[q]; PART[(wave * 32 + 16 + 4 * kq + q) * 16 + rr] = acc1[q]; } }
        __syncthreads();
        { const int e = tid >> 4, rr = tid & 15; float sacc = rbias;
#pragma unroll
          for (int w = 0; w < 8; ++w) sacc += PART[(w * 32 + e) * 16 + rr];
          LG[rr * 33 + e] = sacc; }
        __syncthreads();
        if (wave == (g & 7) && lane < 16) { const int lr = lr_base + 16 * g + lane;
            if (lr < NLAT) { float lg[32];
#pragma unroll
                for (int e = 0; e < 32; ++e) lg[e] = LG[lane * 33 + e];
                unsigned taken = 0u; float tv[4]; int ti[4];
#pragma unroll
                for (int kk = 0; kk < 4; ++kk) { float best = -3.0e38f; int bi = 0;
#pragma unroll
                    for (int e = 0; e < 32; ++e) { const bool okk = (lg[e] > best) && !((taken >> e) & 1u); best = okk ? lg[e] : best; bi = okk ? e : bi; }
                    taken |= 1u << bi; tv[kk] = best; ti[kk] = bi; }
                const float e1 = __expf(tv[1] - tv[0]), e2 = __expf(tv[2] - tv[0]), e3 = __expf(tv[3] - tv[0]); const float inv = 1.f / (1.f + e1 + e2 + e3);
                const int li = (16 * g + lane) * 4; til[li] = ti[0]; til[li + 1] = ti[1]; til[li + 2] = ti[2]; til[li + 3] = ti[3]; twl[li] = inv; twl[li + 1] = e1 * inv; twl[li + 2] = e2 * inv; twl[li + 3] = e3 * inv;
                __hip_atomic_fetch_add(hist + ti[0], 1, __ATOMIC_RELAXED, __HIP_MEMORY_SCOPE_WORKGROUP); __hip_atomic_fetch_add(hist + ti[1], 1, __ATOMIC_RELAXED, __HIP_MEMORY_SCOPE_WORKGROUP);
                __hip_atomic_fetch_add(hist + ti[2], 1, __ATOMIC_RELAXED, __HIP_MEMORY_SCOPE_WORKGROUP); __hip_atomic_fetch_add(hist + ti[3], 1, __ATOMIC_RELAXED, __HIP_MEMORY_SCOPE_WORKGROUP); } }
    }
#if defined(PROBE_LN1X2)
    }
#endif
#undef LN1_LOAD
    __syncthreads();
    int* cursor = (int*)(a.ws + WS_CURSOR) + l * 32;
    int* rows = (int*)(a.ws + WS_ROWS); float* roww = (float*)(a.ws + WS_ROWW); int* rowd = (int*)(a.ws + WS_ROWD);
    int nrows = NLAT - lr_base; nrows = nrows > RB ? RB : nrows; if (nrows < 0) nrows = 0;
    const int nas = nrows * 4, nchunks = (nas + 63) >> 6;
    int basev = 0; if (tid < 32) basev = (int)__hip_atomic_fetch_add((unsigned*)cursor + tid, (unsigned)hist[tid], __ATOMIC_RELAXED, __HIP_MEMORY_SCOPE_AGENT);
    int myrank[2] = {0, 0}, mye[2] = {-1, -1};
#pragma unroll
    for (int cc = 0; cc < 2; ++cc) { const int c = wave + 8 * cc; if (c < nchunks) { const int idx = c * 64 + lane; const int e = idx < nas ? til[idx] : -1; mye[cc] = e;
        for (int x = 0; x < 32; ++x) { const unsigned long long m = __ballot(e == x); if (e == x) myrank[cc] = __popcll(m & ((1ull << lane) - 1ull)); if (lane == 0) ccnt[c * 32 + x] = __popcll(m); } } }
    __syncthreads();
    if (tid < 32) hist[32 + tid] = basev;
    __syncthreads();
#pragma unroll
    for (int cc = 0; cc < 2; ++cc) { const int c = wave + 8 * cc; const int idx = c * 64 + lane; if (c < nchunks && idx < nas) { const int e = mye[cc]; int pos = hist[32 + e] + myrank[cc]; for (int c2 = 0; c2 < c; ++c2) pos += ccnt[c2 * 32 + e];
        const int lr = lr_base + (idx >> 2); const size_t pi = (size_t)e * ECAP + pos; rows[pi] = grow_of(lr); roww[pi] = twl[idx]; rowd[pi] = lr * 4 + (idx & 3); } }
}

__device__ __forceinline__ void phase_ln2(const Args& a, int l, int lane, int wave) {
    const int gw = blockIdx.x * NWAVES + wave, NGW = gridDim.x * NWAVES;
    float* H = (float*)(a.ws + WS_H); const bf16* PRE = (const bf16*)(a.ws + WS_PRE); const unsigned char* YB = (const unsigned char*)(a.ws + WS_YB); bf16* A1 = (bf16*)(a.ws + WS_Y);
    const float* modv = (const float*)(a.ws + WS_MODV);
    const float* ln1g = a.in[I_LN1G] + l * 1024; const float* ln1b = a.in[I_LN1B] + l * 1024;
    const float* lng = a.in[I_LN2G] + l * 1024; const float* lnb = a.in[I_LN2B] + l * 1024;
    f32x4 P1[4], Q1[4], G2[4], g2v[4], b2v[4], P3[4], Q3[4]; int fb = -1;
    const int rows_w = (((NLAT + NGW - 1) / NGW) + 1) & ~1, lr_lo = gw * rows_w, lr_hi = lr_lo + rows_w < NLAT ? lr_lo + rows_w : NLAT;
    for (int lr0 = lr_lo; lr0 < lr_hi; lr0 += 2) {
        v2u hv[2][4]; unsigned yv[2][4][4];
#pragma unroll
        for (int q = 0; q < 2; ++q) { const int lr = lr0 + q; const size_t r = (size_t)grow_of(lr);
#pragma unroll
            for (int j = 0; j < 4; ++j) { const int c = 4 * (lane + 64 * j); hv[q][j] = *(const v2u*)(PRE + r * 1024 + c);
#pragma unroll
                for (int k = 0; k < 4; ++k) yv[q][j][k] = *(const unsigned*)(YB + ((size_t)lr * 4 + k) * 1024 + c); } }
#pragma unroll
        for (int q = 0; q < 2; ++q) {
            const int lr = lr0 + q; const size_t r = (size_t)grow_of(lr); const int b = lr >> 12;
            if (b != fb) { fb = b; const float* mv = modv + ((size_t)l * 9 + b) * 6144; const float* mv1 = modv + ((size_t)9 + b) * 6144;
#pragma unroll
                for (int j = 0; j < 4; ++j) { const int c = 4 * (lane + 64 * j); const f32x4 g1 = *(const f32x4*)(ln1g + c), b1 = *(const f32x4*)(ln1b + c), gt = *(const f32x4*)(mv + 5 * 1024 + c);
                    P1[j] = g1 * ALPHA; Q1[j] = b1 * ALPHA; G2[j] = gt * (1.f / SC_Y); g2v[j] = *(const f32x4*)(lng + c); b2v[j] = *(const f32x4*)(lnb + c);
                    if (l == 0) { const f32x4 sh = *(const f32x4*)(mv1 + c), sc = *(const f32x4*)(mv1 + 1024 + c); P3[j] = g2v[j] * (sc + 1.0f) * SC_A1; Q3[j] = (b2v[j] * (sc + 1.0f) + sh) * SC_A1; } } }
            f32x4 x[4]; float s = 0.f;
#pragma unroll
            for (int j = 0; j < 4; ++j) { const v2u p = hv[q][j]; x[j] = (f32x4){__uint_as_float(p.x << 16), __uint_as_float(p.x & 0xffff0000u), __uint_as_float(p.y << 16), __uint_as_float(p.y & 0xffff0000u)}; s += (x[j][0] + x[j][1]) + (x[j][2] + x[j][3]); }
            float mean = wave_sum(s) * (1.f / 1024.f), s2 = 0.f;
#pragma unroll
            for (int j = 0; j < 4; ++j) { x[j] = x[j] - mean; s2 += (x[j][0] * x[j][0] + x[j][1] * x[j][1]) + (x[j][2] * x[j][2] + x[j][3] * x[j][3]); }
            float rstd = rsqrtf(wave_sum(s2) * (1.f / 1024.f) + LN_EPS);
            s = 0.f;
#pragma unroll
            for (int j = 0; j < 4; ++j) { f32x4 f = {0.f, 0.f, 0.f, 0.f};
#pragma unroll
                for (int k = 0; k < 4; ++k) { const unsigned y = yv[q][j][k]; const auto lo = __builtin_amdgcn_cvt_pk_f32_fp8((int)y, false), hi = __builtin_amdgcn_cvt_pk_f32_fp8((int)y, true);
                    f[0] += lo[0]; f[1] += lo[1]; f[2] += hi[0]; f[3] += hi[1]; }
                x[j] = (x[j] * rstd) * P1[j] + Q1[j] + G2[j] * f; s += (x[j][0] + x[j][1]) + (x[j][2] + x[j][3]); }
            mean = wave_sum(s) * (1.f / 1024.f); s2 = 0.f;
#pragma unroll
            for (int j = 0; j < 4; ++j) { x[j] = x[j] - mean; s2 += (x[j][0] * x[j][0] + x[j][1] * x[j][1]) + (x[j][2] * x[j][2] + x[j][3] * x[j][3]); }
            rstd = rsqrtf(wave_sum(s2) * (1.f / 1024.f) + LN_EPS);
#pragma unroll
            for (int j = 0; j < 4; ++j) { const int c = 4 * (lane + 64 * j); const f32x4 xh = x[j] * rstd;
                const f32x4 o = xh * g2v[j] + b2v[j];
                if (l == 0) { v2u hw; hw.x = pk2(o[0], o[1]); hw.y = pk2(o[2], o[3]); *(v2u*)((bf16*)H + r * 1024 + c) = hw;
                    const f32x4 am = xh * P3[j] + Q3[j]; *(unsigned*)((unsigned char*)A1 + r * 1024 + c) = pack_fp8x4(am[0], am[1], am[2], am[3]); }
                else *(f32x4*)(a.out + (size_t)lr * 1024 + c) = o; }
        }
    }
}

__device__ __forceinline__ void phase_conv(const Args& a, LAS unsigned char* lds, int tid, int lane, int wave) {
    const bf16* U = (const bf16*)(a.ws + WS_X); bf16* V = (bf16*)(a.ws + WS_Y);
    LAS float* part = (LAS float*)(lds + 126976);
    LAS float* st = part + 512;
    const int c0 = 2 * tid;
    const float db0 = a.in[I_DWB][c0], db1 = a.in[I_DWB][c0 + 1], g0 = a.in[I_CLNG][c0], g1 = a.in[I_CLNG][c0 + 1], be0 = a.in[I_CLNB][c0], be1 = a.in[I_CLNB][c0 + 1];
    for (int tile = blockIdx.x; tile < NLAT / 32; tile += gridDim.x) {
        const int b = tile >> 7, t0 = (tile & 127) * 32;
        const size_t rb0 = (size_t)b * TPB + CTXL;
        __syncthreads();
        for (int i = tid; i < 62 * 128; i += NTHR) { const int row = i >> 7, chk = i & 127, t = t0 - 15 + row;
            v4u val = {0u, 0u, 0u, 0u}; if (t >= 0 && t < SEQ) val = *(const v4u*)(U + (rb0 + t) * 1024 + chk * 8);
            *(LAS v4u*)(lds + row * 2048 + chk * 16) = val; }
        __syncthreads();
        typedef float f32x2_t __attribute__((ext_vector_type(2)));
        f32x2_t w01[31];
#pragma unroll
        for (int j = 0; j < 31; ++j) w01[j] = *(const f32x2_t*)(a.in[I_DWW] + j * 1024 + c0);
#pragma unroll 1
        for (int hh = 0; hh < 2; ++hh) {
            const LAS unsigned char* hp = lds + hh * 16 * 2048;
            f32x2_t acc01[16];
#pragma unroll
            for (int t = 0; t < 16; ++t) acc01[t] = (f32x2_t){db0, db1};
#pragma unroll
            for (int s = 0; s < 46; ++s) { const unsigned pr = *(const LAS unsigned*)(hp + s * 2048 + tid * 4); const f32x2_t x01 = {__uint_as_float(pr << 16), __uint_as_float(pr & 0xffff0000u)};
#pragma unroll
                for (int t = (s > 30 ? s - 30 : 0); t <= (s < 15 ? s : 15); ++t) acc01[t] = __builtin_elementwise_fma(x01, w01[s - t], acc01[t]); }
            float acc0[16], acc1[16];
#pragma unroll
            for (int t = 0; t < 16; ++t) { acc0[t] = acc01[t].x; acc1[t] = acc01[t].y; }
            float rs[32];
#pragma unroll
            for (int t = 0; t < 16; ++t) { rs[2 * t] = acc0[t] + acc1[t]; rs[2 * t + 1] = acc0[t] * acc0[t] + acc1[t] * acc1[t]; }
#define RS_STEP(NKEEP, XORV) { const bool bit_ = (lane & XORV) != 0; _Pragma("unroll") for (int k_ = 0; k_ < NKEEP; ++k_) { const float snd_ = bit_ ? rs[k_] : rs[k_ + NKEEP]; const float rcv_ = __shfl_xor(snd_, XORV); rs[k_] = (bit_ ? rs[k_ + NKEEP] : rs[k_]) + rcv_; } }
            RS_STEP(16, 32) RS_STEP(8, 16) RS_STEP(4, 8) RS_STEP(2, 4) RS_STEP(1, 2)
#undef RS_STEP
            rs[0] += __shfl_xor(rs[0], 1);
            __syncthreads();
            if ((lane & 1) == 0) part[wave * 32 + (lane >> 1)] = rs[0];
            __syncthreads();
            if (tid < 16) { float s1 = 0.f, s2 = 0.f;
#pragma unroll
                for (int w = 0; w < 8; ++w) { s1 += part[w * 32 + 2 * tid]; s2 += part[w * 32 + 2 * tid + 1]; }
                const float mean = s1 * (1.f / 1024.f); const float var = fmaxf(s2 * (1.f / 1024.f) - mean * mean, 0.f); st[2 * tid] = mean; st[2 * tid + 1] = rsqrtf(var + LN_EPS); }
            __syncthreads();
#pragma unroll
            for (int t = 0; t < 16; ++t) { const float mean = st[2 * t], rstd = st[2 * t + 1];
                const float y0 = (acc0[t] - mean) * rstd * g0 + be0, y1 = (acc1[t] - mean) * rstd * g1 + be1;
                const float z0 = fminf(fmaxf(y0 * sigm(y0) * SC_CV, -448.f), 448.f), z1 = fminf(fmaxf(y1 * sigm(y1) * SC_CV, -448.f), 448.f);
                *(unsigned short*)((unsigned char*)V + (rb0 + t0 + hh * 16 + t) * 1024 + c0) = (unsigned short)__builtin_amdgcn_cvt_pk_fp8_f32(z0, z1, 0, false); }
        }
    }
}

namespace hg {
using bf16x8 = __attribute__((ext_vector_type(8))) short;
using s16x4  = __attribute__((ext_vector_type(4))) short;
using f32x16 = __attribute__((ext_vector_type(16))) float;
using u32x4  = __attribute__((ext_vector_type(4))) unsigned;
constexpr int RS = 272;
constexpr int VS = 80;
constexpr int T_Q = 0, T_KO = 32 * RS, T_D = 64 * RS, IMG_BYTES = T_D + 512, T_V = IMG_BYTES, TILE_BYTES = T_V + 32 * VS;
constexpr int OFF_TILES = 1024, NTB = 3, OFF_OPART = OFF_TILES + NTB * TILE_BYTES, OPART_BYTES = 4 * 4096;
static_assert(OFF_OPART + 2 * OPART_BYTES <= 131072 && IMG_BYTES % 16 == 0 && IMG_BYTES / 16 == 1120, "hgrn lds");
constexpr int P_RAW = 1024, R_Q = 0, R_F = 32 * RS, RAW_BYTES = 64 * RS, P_IMG = P_RAW + RAW_BYTES;
constexpr int NCHUNK = TPB / 32, NCHAIN = NB * 4 * 2, NITEM = NCHAIN * NCHUNK;
__device__ __forceinline__ int crow(int r, int hi) { return (r & 3) + 8 * (r >> 2) + 4 * hi; }
__device__ __forceinline__ s16x4 tr_read(unsigned addr) { s16x4 r; asm volatile("ds_read_b64_tr_b16 %0, %1" : "=&v"(r) : "v"(addr) : "memory"); return r; }
__device__ __forceinline__ bf16x8 cat8(s16x4 l, s16x4 h) { return (bf16x8){l[0], l[1], l[2], l[3], h[0], h[1], h[2], h[3]}; }
__device__ __forceinline__ bf16x8 pack8(const f32x16& x, int base) {
    u32x4 w; w[0] = pk2(x[base + 0], x[base + 1]); w[1] = pk2(x[base + 2], x[base + 3]); w[2] = pk2(x[base + 4], x[base + 5]); w[3] = pk2(x[base + 6], x[base + 7]);
    return *reinterpret_cast<bf16x8*>(&w);
}
}


#define HG_TOKP(dir, n) ((dir) ? ((n) < CTXL ? (CTXL - 1 - (n)) : (TPB + CTXL - 1 - (n))) : (n))
#define HG_DPP1(x, ctrl, rmask) __int_as_float(__builtin_amdgcn_update_dpp(0x3f800000, __float_as_int(x), ctrl, rmask, 0xf, false))
#define HG_DPP(x, ctrl, rmask) __int_as_float(__builtin_amdgcn_update_dpp(0, __float_as_int(x), ctrl, rmask, 0xf, false))
__device__ __forceinline__ void hgrn_prep_items(const Args& a, LAS unsigned char* lds, int tid) {
    using namespace hg;
    const bf16* Z = (const bf16*)(a.ws + WS_Z);
    unsigned char* HT = a.ws + WS_HT;
    const int wave = __builtin_amdgcn_readfirstlane(tid >> 6), lane = tid & 63, t = lane & 31, half = lane >> 5;
    const int c0 = 16 * wave + 8 * half;
    const int lr = tid >> 4, lch = tid & 15;
    LAS float* lbt = (LAS float*)lds;
    constexpr int P_RAW2 = 2048, P_IMG2 = P_RAW2 + 2 * RAW_BYTES;
    static_assert(P_IMG2 + 2 * IMG_BYTES <= 131072, "prep lds");
    __syncthreads();
    { const float l0 = a.in[I_LBL][tid], l1 = a.in[I_LBL][512 + tid], l2 = a.in[I_LBL][1024 + tid]; const float m = fmaxf(l0, fmaxf(l1, l2));
      const float e0 = __expf(l0 - m), e1 = __expf(l1 - m), e2 = __expf(l2 - m); lbt[tid] = e0 / (e0 + e1 + e2); }
    bf16x8 gq, gf;
#define HP_LOAD(it) do { const int ch_ = (it) % NCHUNK, cn_ = (it) / NCHUNK, dir_ = cn_ & 1, hd_ = (cn_ >> 1) & 3, b_ = cn_ >> 3; \
        const bf16* zr_ = Z + ((size_t)b_ * TPB + HG_TOKP(dir_, 32 * ch_ + lr)) * ZC; gq = *(const bf16x8*)(zr_ + ZHQ + hd_ * 128 + lch * 8); gf = *(const bf16x8*)(zr_ + (dir_ ? ZHB : ZHF) + hd_ * 128 + lch * 8); } while (0)
#define HP_STASH(bufi) do { LAS unsigned char* rb_ = lds + P_RAW2 + (bufi) * RAW_BYTES; *(LAS bf16x8*)(rb_ + R_Q + lr * RS + lch * 16) = gq; *(LAS bf16x8*)(rb_ + R_F + lr * RS + lch * 16) = gf; } while (0)
#define HP_COPYOUT(item, bufi) do { v4u* dst_ = (v4u*)(HT + (size_t)(item) * IMG_BYTES); const LAS v4u* src_ = (const LAS v4u*)(lds + P_IMG2 + (bufi) * IMG_BYTES); \
        dst_[tid] = src_[tid]; dst_[tid + 512] = src_[tid + 512]; if (tid < 96) dst_[tid + 1024] = src_[tid + 1024]; } while (0)
    const int G = gridDim.x;
    int it = blockIdx.x, par = 0;
    if (it < NITEM) { HP_LOAD(it); HP_STASH(0); }
    if (it + G < NITEM) HP_LOAD(it + G);
    __syncthreads();
    for (; it < NITEM; it += G, par ^= 1) {
        if (it + G < NITEM) HP_STASH(par ^ 1);
        if (it != (int)blockIdx.x) HP_COPYOUT(it - G, par ^ 1);
        if (it + 2 * G < NITEM) HP_LOAD(it + 2 * G);
        const int hd = ((it / NCHUNK) >> 1) & 3;
        {
            const LAS unsigned char* rb_ = lds + P_RAW2 + par * RAW_BYTES;
            const bf16x8 RQ = *(const LAS bf16x8*)(rb_ + R_Q + t * RS + c0 * 2), RF = *(const LAS bf16x8*)(rb_ + R_F + t * RS + c0 * 2);
            const f32x4 lbA = *(const LAS f32x4*)(lbt + hd * 128 + c0), lbB = *(const LAS f32x4*)(lbt + hd * 128 + c0 + 4);
            LAS unsigned char* tb_ = lds + P_IMG2 + par * IMG_BYTES;
            float bb_[8], kk_[8];
#pragma unroll
            for (int i_ = 0; i_ < 8; ++i_) { const float lb_ = i_ < 4 ? lbA[i_] : lbB[i_ - 4]; const float f_ = lb_ + (1.f - lb_) * __builtin_amdgcn_rcpf(1.f + __expf(-bf2f((unsigned short)RF[i_]))); kk_[i_] = 1.f - f_; bb_[i_] = f_; }
#pragma unroll
            for (int i_ = 0; i_ < 8; ++i_) { float x_ = bb_[i_]; x_ *= HG_DPP1(x_, 0x111, 0xf); x_ *= HG_DPP1(x_, 0x112, 0xf); x_ *= HG_DPP1(x_, 0x114, 0xf); x_ *= HG_DPP1(x_, 0x118, 0xf);
                x_ *= HG_DPP1(x_, 0x142, 0xa); bb_[i_] = x_; }
            float qi_[8], ko_[8], dd_[8];
#pragma unroll
            for (int i_ = 0; i_ < 8; ++i_) { const int bi_ = __float_as_int(bb_[i_]); dd_[i_] = __int_as_float(half ? __builtin_amdgcn_readlane(bi_, 63) : __builtin_amdgcn_readlane(bi_, 31));
                const float e_ = bb_[i_]; const float ei_ = __builtin_amdgcn_rcpf(e_);
                qi_[i_] = bf2f((unsigned short)RQ[i_]) * e_; ko_[i_] = kk_[i_] * ei_; }
            *(LAS v4u*)(tb_ + T_Q + t * RS + c0 * 2) = (v4u){pk2(qi_[0], qi_[1]), pk2(qi_[2], qi_[3]), pk2(qi_[4], qi_[5]), pk2(qi_[6], qi_[7])};
            *(LAS v4u*)(tb_ + T_KO + t * RS + c0 * 2) = (v4u){pk2(ko_[0], ko_[1]), pk2(ko_[2], ko_[3]), pk2(ko_[4], ko_[5]), pk2(ko_[6], ko_[7])};
            if (t == 31) { *(LAS f32x4*)(tb_ + T_D + c0 * 4) = (f32x4){dd_[0], dd_[1], dd_[2], dd_[3]}; *(LAS f32x4*)(tb_ + T_D + c0 * 4 + 16) = (f32x4){dd_[4], dd_[5], dd_[6], dd_[7]}; }
            if (tid < 32) *(LAS v4u*)(tb_ + T_Q + tid * RS + 256) = (v4u){0u, 0u, 0u, 0u};
            else if (tid < 64) *(LAS v4u*)(tb_ + T_KO + (tid - 32) * RS + 256) = (v4u){0u, 0u, 0u, 0u};
        }
        __syncthreads();
    }
    if (it - G >= (int)blockIdx.x && it - G < NITEM) HP_COPYOUT(it - G, par ^ 1);
    __syncthreads();
#undef HP_COPYOUT
#undef HP_LOAD
#undef HP_STASH
}

__device__ __forceinline__ void hgrn_unit_mfma(const Args& a, int unit, LAS unsigned char* lds, int tid) {
    using namespace hg;
    const int b = unit >> 5, head = (unit >> 3) & 3, dir = (unit >> 2) & 1, sl = unit & 3;
    const bf16* Z = (const bf16*)(a.ws + WS_Z);
    const unsigned char* HT = a.ws + WS_HT + (size_t)((b * 4 + head) * 2 + dir) * NCHUNK * IMG_BYTES;
    bf16* Od = (bf16*)(a.ws + (dir ? WS_OB : WS_OF));
    const int wave = __builtin_amdgcn_readfirstlane(tid >> 6), lane = tid & 63;
    const size_t zb = (size_t)b * TPB;
    constexpr int NCH = NCHUNK;
    const int vr = (tid >> 2) & 31, vp = tid & 3, lvcol = ZHI + head * 128 + sl * 32 + vp * 8, i3 = 1024 + (tid < 96 ? tid : 0);
    v4u gA0, gA1, gA2, gB0, gB1, gB2; bf16x8 gAv, gBv;
#define HG_LOAD(g0, g1, g2, gv, ch) do { const int c_ = (ch) < NCH ? (ch) : NCH - 1; const v4u* src_ = (const v4u*)(HT + (size_t)c_ * IMG_BYTES); \
        g0 = src_[tid]; g1 = src_[tid + 512]; g2 = src_[i3]; gv = *(const bf16x8*)(Z + (zb + HG_TOKP(dir, 32 * c_ + vr)) * ZC + lvcol); } while (0)
#define HG_STASH(g0, g1, g2, gv, bufi) do { LAS unsigned char* tb_ = lds + OFF_TILES + (bufi) * TILE_BYTES; LAS v4u* d_ = (LAS v4u*)tb_; \
        d_[tid] = g0; d_[tid + 512] = g1; if (tid < 96) d_[tid + 1024] = g2; if (tid < 128) *(LAS bf16x8*)(tb_ + T_V + vr * VS + vp * 16) = gv; } while (0)
    const int r32 = lane & 31, hi = lane >> 5, g1 = (lane >> 4) & 1, q4 = (lane & 15) >> 2, p4 = lane & 3, cb = 32 * wave;
    const unsigned lbase = (unsigned)(uintptr_t)lds;
    f32x16 S = {};
    HG_LOAD(gA0, gA1, gA2, gAv, 0); HG_STASH(gA0, gA1, gA2, gAv, 0); HG_LOAD(gA0, gA1, gA2, gAv, 1); HG_STASH(gA0, gA1, gA2, gAv, 1);
    HG_LOAD(gA0, gA1, gA2, gAv, 2);
    __syncthreads();
#define HG_RD64(dst, addr, OFFS) asm volatile("ds_read_b64 %0, %1 offset:" #OFFS : "=&v"(dst) : "v"(addr) : "memory")
#define HG_MFMA_STAGE(n, bufi) do { \
            const unsigned tb = lbase + OFF_TILES + (bufi) * TILE_BYTES; const LAS unsigned char* tl_ = lds + OFF_TILES + (bufi) * TILE_BYTES; \
            bf16x8 ko[2], qi[2]; s16x4 pvl[2], pvh[2], pql[2], pqh[2], kl[2], kh[2], nvl[2], nvh[2]; f32x4 dsc[4]; \
            _Pragma("unroll") for (int kk = 0; kk < 2; ++kk) { ko[kk] = *(const LAS bf16x8*)(tl_ + T_KO + r32 * RS + (cb + 16 * kk + 8 * hi) * 2); qi[kk] = *(const LAS bf16x8*)(tl_ + T_Q + r32 * RS + (cb + 16 * kk + 8 * hi) * 2); } \
            _Pragma("unroll") for (int sp = 0; sp < 2; ++sp) { \
                const unsigned va = tb + T_V + (16 * sp + 4 * hi + q4) * VS + (16 * g1 + 4 * p4) * 2; pvl[sp] = tr_read(va); pvh[sp] = tr_read(va + 8 * VS);              \
                const unsigned qa = tb + T_Q + r32 * RS + (cb + 16 * sp + 4 * hi) * 2; HG_RD64(pql[sp], qa, 0); HG_RD64(pqh[sp], qa, 16);                                  \
                const unsigned ka = tb + T_KO + (16 * sp + 8 * hi + q4) * RS + (cb + 16 * g1 + 4 * p4) * 2; kl[sp] = tr_read(ka); kh[sp] = tr_read(ka + 4 * RS);        \
                const unsigned vb = tb + T_V + (16 * sp + 8 * hi + q4) * VS + (16 * g1 + 4 * p4) * 2; nvl[sp] = tr_read(vb); nvh[sp] = tr_read(vb + 4 * VS); }            \
            _Pragma("unroll") for (int g = 0; g < 4; ++g) dsc[g] = *(const LAS f32x4*)(tl_ + T_D + (cb + 8 * g + 4 * hi) * 4); \
            asm volatile("s_waitcnt lgkmcnt(0)" ::: "memory"); __builtin_amdgcn_sched_barrier(0); \
            f32x16 X = {}; \
            X = __builtin_amdgcn_mfma_f32_32x32x16_bf16(ko[0], qi[0], X, 0, 0, 0); X = __builtin_amdgcn_mfma_f32_32x32x16_bf16(ko[1], qi[1], X, 0, 0, 0); \
            f32x16 O = {}; \
            O = __builtin_amdgcn_mfma_f32_32x32x16_bf16(cat8(pql[0], pqh[0]), pack8(S, 0), O, 0, 0, 0); O = __builtin_amdgcn_mfma_f32_32x32x16_bf16(cat8(pql[1], pqh[1]), pack8(S, 8), O, 0, 0, 0); \
            S = __builtin_amdgcn_mfma_f32_32x32x16_bf16(cat8(kl[0], kh[0]), cat8(nvl[0], nvh[0]), S, 0, 0, 0); S = __builtin_amdgcn_mfma_f32_32x32x16_bf16(cat8(kl[1], kh[1]), cat8(nvl[1], nvh[1]), S, 0, 0, 0); \
            _Pragma("unroll") for (int i = 0; i < 16; ++i) X[i] = (crow(i, hi) <= r32) ? X[i] : 0.f; \
            O = __builtin_amdgcn_mfma_f32_32x32x16_bf16(pack8(X, 0), cat8(pvl[0], pvh[0]), O, 0, 0, 0); O = __builtin_amdgcn_mfma_f32_32x32x16_bf16(pack8(X, 8), cat8(pvl[1], pvh[1]), O, 0, 0, 0); \
            _Pragma("unroll") for (int i = 0; i < 16; ++i) S[i] *= dsc[i >> 2][i & 3]; \
            LAS float* op = (LAS float*)(lds + OFF_OPART + ((n) & 1) * OPART_BYTES + wave * 4096); \
            _Pragma("unroll") for (int i = 0; i < 16; ++i) op[crow(i, hi) * 32 + r32] = O[i]; } while (0)
#define HG_OUT_STAGE(n) do { \
            const int l2 = tid - 256, tt = l2 >> 3, vq = l2 & 7; \
            const LAS float* op = (const LAS float*)(lds + OFF_OPART + (((n) - 1) & 1) * OPART_BYTES) + tt * 32 + vq * 4; \
            const f32x4 s = (*(const LAS f32x4*)op + *(const LAS f32x4*)(op + 1024)) + (*(const LAS f32x4*)(op + 2048) + *(const LAS f32x4*)(op + 3072)); \
            const int p = HG_TOKP(dir, 32 * ((n) - 1) + tt); \
            if (p >= CTXL) *(v2u*)(Od + (zb + p) * 512 + head * 128 + sl * 32 + vq * 4) = (v2u){pk2(s[0], s[1]), pk2(s[2], s[3])}; } while (0)
#define HG_ITER(n, L0, L1, L2, LV, S0, S1, S2, SV) do { \
        HG_LOAD(L0, L1, L2, LV, (n) + 3); \
        if (wave < 4) { HG_MFMA_STAGE(n, bcur); } else if ((n) > 0) { HG_OUT_STAGE(n); } \
        { const int bst_ = bcur == 0 ? 2 : bcur - 1; HG_STASH(S0, S1, S2, SV, bst_); } \
        bcur = bcur == 2 ? 0 : bcur + 1; \
        __syncthreads(); } while (0)
    int bcur = 0;
    for (int n = 0; n < NCH; n += 2) {
        HG_ITER(n, gB0, gB1, gB2, gBv, gA0, gA1, gA2, gAv);
        HG_ITER(n + 1, gA0, gA1, gA2, gAv, gB0, gB1, gB2, gBv);
    }
    if (wave >= 4) { HG_OUT_STAGE(NCH); }
    __syncthreads();
#undef HG_MFMA_STAGE
#undef HG_OUT_STAGE
#undef HG_ITER
#undef HG_LOAD
#undef HG_STASH
#undef HG_RD64
}

__device__ __forceinline__ bool in_range(int lo, int hi, int k) { asm volatile("" : "+s"(lo), "+s"(hi)); return lo <= k && k < hi; }
constexpr int NPHASES = 21;
__global__ void __launch_bounds__(NTHR, 2) fwd_kernel(Args args) {
    extern __shared__ __attribute__((aligned(16))) unsigned char lds_raw[];
    LAS unsigned char* lds = (LAS unsigned char*)lds_raw;
    const int G = gridDim.x;
#define FRESH() int tid = threadIdx.x; asm volatile("" : "+v"(tid)); const int lane = tid & 63, wave = __builtin_amdgcn_readfirstlane(tid >> 6); (void)lane; (void)wave
    unsigned char* ws = args.ws;
    if (threadIdx.x < 16) ((LAS unsigned*)(lds + LDS_BAR_OFF))[threadIdx.x] = 0u;
    __syncthreads();
    XcdBarrier bar = xcd_barrier_post((unsigned*)(ws + WS_CTL), (volatile LAS unsigned*)(lds + LDS_BAR_OFF));
    const int lo = args.ph_lo, hi = args.ph_hi;
#define IN(k) in_range(lo, hi, (k))
#define NREP(k) (((PROBE_MASK >> (k)) & 1u) ? 2 : 1)
#define REPEAT(k) for (int rep_ = 0; rep_ < NREP(k); ++rep_) if (rep_ == 0 || (xcd_barrier(bar), true))
#define SEAM(k) do { if (IN(k) && IN((k) + 1)) xcd_barrier(bar); } while (0)
    bf16* const BX = (bf16*)(ws + WS_X); bf16* const BY = (bf16*)(ws + WS_Y);
    const float* const MODV = (const float*)(ws + WS_MODV);

#if defined(PROBE_BARS)
    for (int pbi = 0; pbi < PROBE_BARS; ++pbi) xcd_barrier(bar);
#endif
    if (IN(0)) REPEAT(0) { FRESH(); phase_prologue(args, lds, tid, lane, wave); } SEAM(0);
    if (IN(1)) REPEAT(1) { FRESH(); phase_mod0(args, lane, wave); } SEAM(1);
    if (IN(2)) REPEAT(2) {
        pg8::Gemm g{BX, (const bf16*)(ws + WS_WIN), NTOK, ZC, 512}; pg8::AllOrder S; S.init(NTOK / 256, ZC / 256, G, (int)blockIdx.x);
        pg8::EpiBf16<0> E{(bf16*)(ws + WS_Z), ZC, nullptr, ZC, 0, 1.f / (SC_A0 * SC_WIN)};
        pg8::gemm_phase<pg8::EpiBf16<0>, pg8::AllOrder, PG8_ALIGN, true, false, true>(lds, g, S, E);
    } SEAM(2);
    if (IN(3)) REPEAT(3) { FRESH(); phase_norm0(args, lane, wave); hgrn_prep_items(args, lds, tid); } SEAM(3);
    if (IN(4)) REPEAT(4) {
        { pg8::Gemm g{(const bf16*)(ws + WS_CQN), (const bf16*)(ws + WS_WUQ), NTOK, 768, 384}; pg8::LatOrder S; S.init(128, 3, G, (int)blockIdx.x);
          pg8::EpiBf16<0> E{(bf16*)(ws + WS_Q), 768, nullptr, 0, 0, 1.f};
          pg8::gemm_phase<pg8::EpiBf16<0>, pg8::LatOrder, PG8_ALIGN, PG8_SP2>(lds, g, S, E); }
        __syncthreads();
        { pg8::Gemm g{(const bf16*)(ws + WS_CKVN), (const bf16*)(ws + WS_WUKV), NTOK, 1024, 256}; pg8::AllOrder S; S.init(NTOK / 256, 4, G, G - 1 - (int)blockIdx.x);
          pg8::EpiBf16<0> E{(bf16*)(ws + WS_KV), 1024, nullptr, 0, 0, 1.f};
          pg8::gemm_phase<pg8::EpiBf16<0>, pg8::AllOrder, PG8_ALIGN, PG8_SP2>(lds, g, S, E); }
    } SEAM(4);
    if (IN(5)) {
        REPEAT(21) { FRESH();
        for (int u = blockIdx.x; u < 256; u += G) { __syncthreads(); hgrn_unit_mfma(args, (G == 256) ? ((u & 7) * 32 + (u >> 3)) : u, lds, tid); } }
        const bf16* Q = (const bf16*)(ws + WS_Q); const bf16* KV = (const bf16*)(ws + WS_KV); const bf16* KRR = (const bf16*)(ws + WS_KRR);
        const float* rope = (const float*)(ws + WS_ROPE);
        const int cslot = (G == 256) ? ((((int)blockIdx.x & 7) * 2 + (((int)blockIdx.x >> 3) >> 4)) % 5) : 0;
        REPEAT(22) {
        int ai = 0;
        for (int slot = 0; slot < 5; ++slot) {
            if (slot == cslot) { if (rep_ == 0) { FRESH(); __syncthreads(); convert_moe_share(args, lds, lane, wave); } continue; }
            for (int u = (G == 256) ? (int)blockIdx.x + ai * 256 : (int)blockIdx.x; u < ((G == 256) ? (int)blockIdx.x + ai * 256 + 1 : (ai == 0 ? 1024 : 0)); u += G) {
                int b, h, qb; if (G == 256) { const int x = (int)blockIdx.x & 7, j = (int)blockIdx.x >> 3, pr = (u >> 8) * 16 + 2 * x + (j >> 4); b = pr >> 3; h = pr & 7; qb = j & 15; } else { b = u >> 7; h = (u >> 4) & 7; qb = u & 15; }
                const size_t kb = (size_t)b * TPB, q0 = kb + CTXL + (size_t)qb * 256;
                __syncthreads();
                att::attn_unit(Q + q0 * 768 + h * 96, KV + kb * 1024 + h * 64, KRR + kb * 32, BY + q0 * 1024 + h * 64, rope + (size_t)qb * 256 * 32, TPB, (char*)lds_raw);
            }
            ++ai;
        }
        }
    } SEAM(5);
    if (IN(6)) REPEAT(6) { FRESH(); phase_readout(args, lane, wave); } SEAM(6);
    if (IN(7)) REPEAT(7) {
        pg8::Gemm g{BY, (const bf16*)(ws + WS_WOUT), NTOK, 1024, 1024}; pg8::LatOrder S; S.init(128, 4, G, (int)blockIdx.x);
        pg8::EpiRes<false> E{args.in[I_X], nullptr, (bf16*)(ws + WS_PRE), MODV, nullptr, 1.f};
        pg8::gemm_phase<pg8::EpiRes<false>, pg8::LatOrder, PG8_ALIGN, PG8_SP2>(lds, g, S, E);
    } SEAM(7);
    for (int l = 0; l < 2; ++l) {
        if (l == 1) {
            if (IN(13)) REPEAT(13) {
                pg8::Gemm g{BY, (const bf16*)(ws + WS_WPW1), NTOK, 2048, 512}; pg8::LatOrder S; S.init(128, 8, G, (int)blockIdx.x);
                pg8::EpiGate<0> E{BX, (const float*)(ws + WS_PW1B), 8, 1.f / (SC_A1 * SC_WPW), 1.f, lds};
                pg8::gemm_phase<pg8::EpiGate<0>, pg8::LatOrder, PG8_ALIGN, true, false, true>(lds, g, S, E);
            } SEAM(13);
            if (IN(14)) REPEAT(14) { FRESH(); phase_conv(args, lds, tid, lane, wave); } SEAM(14);
            if (IN(15)) REPEAT(15) {
                pg8::Gemm g{BY, (const bf16*)(ws + WS_WPW2), NTOK, 1024, 512}; pg8::LatOrder S; S.init(128, 4, G, (int)blockIdx.x);
                pg8::EpiRes<true> E{nullptr, (const bf16*)(ws + WS_H), (bf16*)(ws + WS_PRE), MODV + 9 * 6144, args.in[I_PW2B], 1.f / (SC_CV * SC_WPW)};
                pg8::gemm_phase<pg8::EpiRes<true>, pg8::LatOrder, PG8_ALIGN, true, false, true>(lds, g, S, E);
            } SEAM(15);
        }
        const int pb = l ? 16 : 8;
        if (IN(pb)) REPEAT(pb) { FRESH(); phase_ln1(args, l, lds, tid, lane, wave); } SEAM(pb);
        if (IN(pb + 2) || IN(pb + 3)) {
            LAS int* tl = (LAS int*)(lds + LDS_TILE_E);
            FRESH();
            __syncthreads();
            if (tid < 32) tl[3 * MAXTILES + 64 + tid] = ld_ctl((const int*)(ws + WS_CURSOR) + l * 32 + tid);
            __syncthreads();
            if (tid == 0) { int ts = 0; for (int e = 0; e < 32; ++e) { tl[3 * MAXTILES + e] = ts; ts += (tl[3 * MAXTILES + 64 + e] + 255) >> 8; } tl[3 * MAXTILES + 32] = ts; }
            __syncthreads();
            const int ntiles = tl[3 * MAXTILES + 32];
            for (int t = tid; t < ntiles && t < MAXTILES; t += NTHR) { int e = 0; while (e < 31 && tl[3 * MAXTILES + e + 1] <= t) ++e; const int j = t - tl[3 * MAXTILES + e], rem = tl[3 * MAXTILES + 64 + e] - 256 * j;
                tl[t] = e; tl[MAXTILES + t] = e * ECAP + 256 * j; tl[2 * MAXTILES + t] = rem < 256 ? rem : 256; }
            __syncthreads();
            if (IN(pb + 2)) REPEAT(pb + 2) {
#if defined(PROBE_STAGGER)
                if (blockIdx.x & 1) { const unsigned long long t0 = __builtin_amdgcn_s_memrealtime(); while (__builtin_amdgcn_s_memrealtime() - t0 < PROBE_STAGGER) __builtin_amdgcn_s_sleep(8); }
#endif
                pg8::Gemm g{BX, (const bf16*)(ws + WS_WGU + (size_t)l * 32 * 2048 * 1024), 0, 0, 512};
                pg8::MoeOrder S; S.init(ntiles, 8, G, (int)blockIdx.x); S.tile_e = tl; S.nper = 8;
                pg8::EpiGate<1, true> E{(bf16*)(ws + WS_ACT), (const float*)(ws + WS_BGU) + (size_t)l * 32 * 2048, 8, 1.f / (SC_X8 * SC_WGU) * PROBE_KSC, SC_ACT, lds};
                pg8::gemm_phase<pg8::EpiGate<1, true>, pg8::MoeOrder, PG8_ALIGN, true, true, true>(lds, g, S, E, (const int*)(ws + WS_ROWS), tl + MAXTILES);
            } SEAM(pb + 2);
            if (IN(pb + 3)) REPEAT(pb + 3) {
                pg8::Gemm g{(const bf16*)(ws + WS_ACT), (const bf16*)(ws + WS_WDN + (size_t)l * 32 * 1024 * 1024), 0, 0, 512};
                pg8::MoeOrder S; S.init(ntiles, 4, G, (int)blockIdx.x); S.tile_e = tl; S.nper = 4;
                pg8::EpiDown E{(bf16*)(ws + WS_YB), args.in[I_BDN] + (size_t)l * 32 * 1024, (const float*)(ws + WS_ROWW), (const int*)(ws + WS_ROWD), 1.f / (SC_ACT * SC_WDN) * PROBE_KSC, tl + MAXTILES, SC_Y, lds};
                pg8::gemm_phase<pg8::EpiDown, pg8::MoeOrder, PG8_ALIGN, true, false, true>(lds, g, S, E);
            } SEAM(pb + 3);
        }
        if (IN(pb + 4)) REPEAT(pb + 4) { FRESH(); phase_ln2(args, l, lane, wave); }
        if (l == 0) SEAM(12);
    }
#undef IN
#undef SEAM
}

extern "C" void kernel_launch(void* const* d_in, const int* in_sizes, int n_in, void* d_out, int out_size, void* d_ws, size_t ws_size, hipStream_t stream) {
    static int grid = 0;
    if (grid == 0) {
        if (n_in != 33 || in_sizes[0] != NB * SEQ * D || out_size != NB * SEQ * D || ws_size < WS_END) {
            fprintf(stderr, "kernel_launch: unexpected shapes: n_in %d in0 %d out %d ws %zu (need %zu)\n", n_in, n_in > 0 ? in_sizes[0] : -1, out_size, ws_size, (size_t)WS_END); grid = -1; return; }
        int dev = 0, cus = 0;
        if (hipGetDevice(&dev) != hipSuccess || hipDeviceGetAttribute(&cus, hipDeviceAttributeMultiprocessorCount, dev) != hipSuccess) { grid = -1; return; }
        if (hipFuncSetAttribute((const void*)fwd_kernel, hipFuncAttributeMaxDynamicSharedMemorySize, LDS_BYTES) != hipSuccess) { fprintf(stderr, "kernel_launch: hipFuncSetAttribute failed\n"); grid = -1; return; }
        int per_cu = 0;
        if (hipOccupancyMaxActiveBlocksPerMultiprocessor(&per_cu, (const void*)fwd_kernel, NTHR, LDS_BYTES) != hipSuccess || per_cu < 1) fprintf(stderr, "kernel_launch: occupancy query reports %d\n", per_cu);
        (void)hipGetLastError();
        grid = cus;
    }
    if (grid < 0) return;
    if (hipMemsetAsync((char*)d_ws + WS_CTL, 0, CTL_ZERO_BYTES, stream) != hipSuccess) return;
    Args a{};
    for (int i = 0; i < 33; ++i) a.in[i] = (const float*)d_in[i];
    a.out = (float*)d_out; a.ws = (unsigned char*)d_ws;
#if MK_ONE_LAUNCH
    a.ph_lo = 0; a.ph_hi = NPHASES;
    hipLaunchKernelGGL(fwd_kernel, dim3(grid), dim3(NTHR), LDS_BYTES, stream, a);
#else
    for (int ph = 0; ph < NPHASES; ++ph) { a.ph_lo = ph; a.ph_hi = ph + 1; hipLaunchKernelGGL(fwd_kernel, dim3(grid), dim3(NTHR), LDS_BYTES, stream, a); }
#endif
    const hipError_t le = hipPeekAtLastError();
    if (le != hipSuccess) fprintf(stderr, "kernel_launch: launch failed: %s\n", hipGetErrorName(le));
}
```

```cpp
#include <hip/hip_runtime.h>
#include <cstdio>
#include <cstdint>

#ifndef PROBE_MASK
#define PROBE_MASK 0u
#endif
#if defined(PROBE_K2)
#define PROBE_KSC 0.5f
#else
#define PROBE_KSC 1.0f
#endif
#ifndef MK_ONE_LAUNCH
#define MK_ONE_LAUNCH 1
#endif

namespace pg8 {
#define PG8_LAS __attribute__((address_space(3)))
typedef unsigned short bf16_t;
typedef short bf16x8 __attribute__((ext_vector_type(8)));
typedef float f32x4 __attribute__((ext_vector_type(4)));
typedef unsigned u32x4 __attribute__((ext_vector_type(4)));
constexpr int BM = 256, BK = 64, HALF = 128, HTB = HALF * BK * 2  , STAGE_BYTES = 8 * HTB, NXCD = 8, WGM = 8;

__host__ __device__ __forceinline__ int lds_byte(int r, int c) { const int st = (r >> 4) * 2 + (c >> 5), rr = r & 15, cc = c & 31, ob = rr * 64 + cc * 2; return st * 1024 + (ob ^ (((ob >> 9) & 1) << 5)); }
__host__ __device__ __forceinline__ void stage_rc(int b, int& R, int& C) { const int st = b / 1024, sb = b % 1024, swz = sb ^ (((sb >> 9) & 1) << 5); R = (st >> 1) * 16 + swz / 64; C = (st & 1) * 32 + (swz % 64) / 2; }
__host__ __device__ __forceinline__ int perm32(int rho) { const int n = rho >> 4, i = rho & 15; return 8 * (i >> 2) + 4 * n + (i & 3); }

struct Unit { int pm, pn; };
struct Gemm { const bf16_t* A; const bf16_t* Bt; int M, N, K; };

struct StaticOrder {
    int nM, nN, nwg, G, c;
    __host__ __device__ void init(int M, int N, int G_, int c_) { nM = M / BM; nN = N / BM; nwg = nM * nN; G = G_; c = c_; }
    __host__ __device__ bool next(int i, Unit& u) const {
        const long L = (long)i * G + c; if (L >= nwg) return false;
        int wgid = (int)L; { const int q = nwg / NXCD, r = nwg % NXCD, xcd = wgid % NXCD, off = wgid / NXCD; wgid = (xcd < r ? xcd * (q + 1) : r * (q + 1) + (xcd - r) * q) + off; }
        const int nig = WGM * nN, gid = wgid / nig, fm = gid * WGM, gsz = (nM - fm) < WGM ? (nM - fm) : WGM;
        u.pm = fm + ((wgid % nig) % gsz); u.pn = (wgid % nig) / gsz; return true;
    }
    __device__ __forceinline__ void a_ready(const Unit&) const {}
    __device__ __forceinline__ void done(const Unit&) const {}
};

__device__ __forceinline__ unsigned cvt_pk_bf16(float lo, float hi) { unsigned r; asm volatile("v_cvt_pk_bf16_f32 %0, %1, %2" : "=v"(r) : "v"(lo), "v"(hi)); return r; }
typedef float f32x2 __attribute__((ext_vector_type(2)));
__device__ __forceinline__ f32x2 gelu_pk(f32x2 v) {
    const f32x2 av = __builtin_elementwise_abs(v), d = av * 0.2316418882f + 1.0f;
    f32x2 t; t.x = __builtin_amdgcn_rcpf(d.x); t.y = __builtin_amdgcn_rcpf(d.y);
    f32x2 q = t * 0.5307027145f + (-0.7265760135f); q = q * t + 0.7107068705f; q = q * t + (-0.142248368f); q = q * t + 0.127414796f; q = q * t;
    const f32x2 s = (v * v) * (-0.72134752044f);
    f32x2 e; e.x = __builtin_amdgcn_exp2f(s.x); e.y = __builtin_amdgcn_exp2f(s.y);
    const f32x2 m = v * (q * e), r = v - m;
    f32x2 o; o.x = v.x < 0.f ? m.x : r.x; o.y = v.y < 0.f ? m.y : r.y; return o;
}

template <int ACT  > struct EpiBf16 {
    static constexpr bool PERM = true, AFTER_DRAIN = false, PREFETCH = false; static_assert(ACT == 0 || ACT == 1, "EpiBf16: ACT is 0 (none) or 1 (gelu_pk)");
    bf16_t* O; int ldc; const float* bias; int split_cols; size_t split_stride; float scale0;
    __device__ __forceinline__ void operator()(const f32x4 (&acc)[2][2][4][2], const Unit& u, int wr, int wc, int fr, int fq) const {
        const int row0 = u.pm * BM + wr * 64 + fr; int colt = u.pn * BM; bf16_t* base = O;
        float sc = 1.f; if (split_cols) { const int t = colt / split_cols; base += (size_t)t * split_stride; colt -= t * split_cols; if (t == 0) sc = scale0; }
        const int col0 = colt + wc * 32 + 8 * fq, bcol0 = u.pn * BM + wc * 32 + 8 * fq;
        f32x4 bv[2][2];
#pragma unroll
        for (int bj = 0; bj < 2; ++bj)
#pragma unroll
            for (int n = 0; n < 2; ++n) bv[bj][n] = bias ? *(const f32x4*)(bias + bcol0 + bj * HALF + 4 * n) : (f32x4){0.f, 0.f, 0.f, 0.f};
#pragma unroll
        for (int ai = 0; ai < 2; ++ai)
#pragma unroll
            for (int m = 0; m < 4; ++m) { bf16_t* rowp = base + (size_t)(row0 + ai * HALF + m * 16) * ldc + col0;
#pragma unroll
                for (int bj = 0; bj < 2; ++bj) { f32x4 v0 = acc[ai][bj][m][0] + bv[bj][0], v1 = acc[ai][bj][m][1] + bv[bj][1];
                    if (ACT == 1) { f32x2 a = gelu_pk((f32x2){v0[0], v0[1]}), b = gelu_pk((f32x2){v0[2], v0[3]}), c = gelu_pk((f32x2){v1[0], v1[1]}), d = gelu_pk((f32x2){v1[2], v1[3]});
                        v0 = (f32x4){a.x, a.y, b.x, b.y}; v1 = (f32x4){c.x, c.y, d.x, d.y}; }
                    v0 = v0 * sc; v1 = v1 * sc; u32x4 w; w.x = cvt_pk_bf16(v0[0], v0[1]); w.y = cvt_pk_bf16(v0[2], v0[3]); w.z = cvt_pk_bf16(v1[0], v1[1]); w.w = cvt_pk_bf16(v1[2], v1[3]);
                    *(u32x4*)(rowp + bj * HALF) = w; } }
    }
};
typedef int v4i_t __attribute__((ext_vector_type(4)));
typedef int v8i_t __attribute__((ext_vector_type(8)));
__device__ __forceinline__ v8i_t cat32(bf16x8 a, bf16x8 b) { const v4i_t x = __builtin_bit_cast(v4i_t, a), y = __builtin_bit_cast(v4i_t, b); return __builtin_shufflevector(x, y, 0, 1, 2, 3, 4, 5, 6, 7); }
template <class Epi, class Sched, bool ALIGN_EPI = false, bool SP2 = false, bool GATHER = false, bool FP8 = false>
__device__ __forceinline__ void gemm_phase(PG8_LAS unsigned char* lds, const Gemm g, const Sched& S, const Epi& E, const int* rowsrc = nullptr, const PG8_LAS int* gtab = nullptr) {
    static_assert(!GATHER || SP2, "GATHER is implemented on the SP2 loop only");
    int tid_l = threadIdx.x; asm volatile("" : "+v"(tid_l));
    const int tid = tid_l, wid = __builtin_amdgcn_readfirstlane(tid >> 6), lane = tid & 63, wr = wid >> 2, wc = wid & 3, fr = lane & 15, fq = lane >> 4;
#if defined(PROBE_K2)
    const int K = g.K, nt0 = K / BK, nt = FP8 ? 2 * nt0 : nt0;
#define PG8_KT(x) (FP8 ? ((x) & (nt0 - 1)) : (x))
#else
    const int K = g.K, nt = K / BK;
#define PG8_KT(x) (x)
#endif
    unsigned voffA[2], voffB[2];
#pragma unroll
    for (int i = 0; i < 2; ++i) { int R, C; stage_rc(tid * 16 + i * 8192, R, C); const int Rb = Epi::PERM ? ((R & ~31) + perm32(R & 31)) : R;
        voffA[i] = (unsigned)(R * K + C) * 2u; voffB[i] = (unsigned)(Rb * K + C) * 2u; }
    unsigned gAc[2][2], gAn[2][2]; int gR[2]; unsigned gC[2];
#pragma unroll
    for (int i = 0; i < 2; ++i) { int R, C; stage_rc(tid * 16 + i * 8192, R, C); gR[i] = R; gC[i] = (unsigned)C * 2u; gAc[0][i] = gAc[1][i] = gAn[0][i] = gAn[1][i] = 0u; }
#define PG8_GATHER(u_, o_) do { const int gtb_ = gtab[(u_).pm], gtc_ = gtab[576 + (u_).pm];     \
        _Pragma("unroll") for (int h_ = 0; h_ < 2; ++h_) _Pragma("unroll") for (int i_ = 0; i_ < 2; ++i_) \
        { const int rl_ = h_ * HALF + gR[i_]; const int src_ = rl_ < gtc_ ? rowsrc[gtb_ + rl_] : 0; o_[h_][i_] = (unsigned)src_ * (unsigned)(K * 2) + gC[i_]; } } while (0)
#define PG8_STAGE_A(bufoff, orig_gbase, NEXTSEL, H, KOFF) do { if constexpr (GATHER) { unsigned vo_[2]; vo_[0] = (NEXTSEL) ? gAn[H][0] : gAc[H][0]; vo_[1] = (NEXTSEL) ? gAn[H][1] : gAc[H][1]; \
        PG8_STAGE(bufoff, (const char*)g.A + (KOFF), vo_); } else { PG8_STAGE(bufoff, orig_gbase, voffA); } } while (0)
    const size_t kstep = (size_t)(BK * 2);
    const size_t hstep = (size_t)HALF * K * 2;
    const size_t tstep = 2 * hstep;
    const unsigned ldsw = (unsigned)wid * 1024u;
    const int aoff = lds_byte(wr * 64 + fr, fq * 8), boff = lds_byte(wc * 32 + fr, fq * 8);
#define PG8_SA(b, h) (((b) * 2 + (h)) * HTB)
#define PG8_SB(b, h) ((4 + (b) * 2 + (h)) * HTB)
#define PG8_STAGE(bufoff, gbase, voff) do { _Pragma("unroll") for (int _i = 0; _i < 2; ++_i) \
        __builtin_amdgcn_global_load_lds((const unsigned*)((const char*)(gbase) + (voff)[_i]), (PG8_LAS unsigned*)(lds + (bufoff) + ldsw + _i * 8192), 16, 0, 0); } while (0)
#define PG8_LD32(var, addr) do { const bf16x8 lo_ = *(const PG8_LAS bf16x8*)(addr); const bf16x8 hi_ = *(const PG8_LAS bf16x8*)((addr) + 1024); var = cat32(lo_, hi_); } while (0)
#define PG8_LDA(dst, b, h) do { if constexpr (FP8) { _Pragma("unroll") for (int m = 0; m < 4; ++m) PG8_LD32(dst##8[m], lds + PG8_SA(b, h) + aoff + m * 2048); } \
        else { _Pragma("unroll") for (int m = 0; m < 4; ++m) _Pragma("unroll") for (int k = 0; k < 2; ++k) dst[m][k] = *(const PG8_LAS bf16x8*)(lds + PG8_SA(b, h) + aoff + m * 2048 + k * 1024); } } while (0)
#define PG8_LDB(dst, b, h) do { if constexpr (FP8) { _Pragma("unroll") for (int n = 0; n < 2; ++n) PG8_LD32(dst##8[n], lds + PG8_SB(b, h) + boff + n * 2048); } \
        else { _Pragma("unroll") for (int n = 0; n < 2; ++n) _Pragma("unroll") for (int k = 0; k < 2; ++k) dst[n][k] = *(const PG8_LAS bf16x8*)(lds + PG8_SB(b, h) + boff + n * 2048 + k * 1024); } } while (0)
#define PG8_MMA(ai, bj, At, Bt) do { __builtin_amdgcn_s_setprio(1); \
        if constexpr (FP8) { _Pragma("unroll") for (int m = 0; m < 4; ++m) _Pragma("unroll") for (int n = 0; n < 2; ++n) \
            asm volatile("v_mfma_scale_f32_16x16x128_f8f6f4 %0, %1, %2, %0, %3, %3 op_sel_hi:[0,0,0]" : "+v"(acc[ai][bj][m][n]) : "v"(Bt##8[n]), "v"(At##8[m]), "v"(sc127)); } \
        else { _Pragma("unroll") for (int m = 0; m < 4; ++m) _Pragma("unroll") for (int n = 0; n < 2; ++n) _Pragma("unroll") for (int k = 0; k < 2; ++k) \
            acc[ai][bj][m][n] = __builtin_amdgcn_mfma_f32_16x16x32_bf16(Bt[n][k], At[m][k], acc[ai][bj][m][n], 0, 0, 0); } \
        __builtin_amdgcn_s_setprio(0); } while (0)
#define PG8_WAIT_V(n) asm volatile("s_waitcnt vmcnt(" #n ")" ::: "memory")
#define PG8_WAIT_L(n) asm volatile("s_waitcnt lgkmcnt(" #n ")" ::: "memory")
#define PG8_BAR __builtin_amdgcn_s_barrier()
#define PG8_SCHED __builtin_amdgcn_sched_barrier(0)
    Unit cur, nxt; int ui = 0;
    if (!S.next(0, cur)) return;
    f32x4 acc[2][2][4][2];
#pragma unroll
    for (int a = 0; a < 2; ++a)
#pragma unroll
        for (int b = 0; b < 2; ++b)
#pragma unroll
            for (int m = 0; m < 4; ++m)
#pragma unroll
                for (int n = 0; n < 2; ++n) acc[a][b][m][n] = (f32x4){0.f, 0.f, 0.f, 0.f};
    int sc127 = 0x7f7f7f7f; asm volatile("" : "+v"(sc127));
    bf16x8 At[4][2], B0[2][2], B1[2][2]; v8i_t At8[4], B08[2], B18[2]; (void)At; (void)B0; (void)B1; (void)At8; (void)B08; (void)B18;
    const char* cA = (const char*)g.A + (size_t)cur.pm * tstep; const char* cB = (const char*)g.Bt + (size_t)cur.pn * tstep;
    S.a_ready(cur);
    if constexpr (GATHER) { PG8_GATHER(cur, gAc); }
    if constexpr (Epi::PREFETCH) E.prefetch(cur, 0, wid, lane);
    if constexpr (SP2) {
        PG8_STAGE(PG8_SB(0, 0), cB, voffB); PG8_STAGE(PG8_SB(0, 1), cB + hstep, voffB); PG8_STAGE_A(PG8_SA(0, 0), cA, false, 0, (size_t)0); PG8_STAGE_A(PG8_SA(0, 1), cA + hstep, false, 1, (size_t)0);
        if (wr == 1) PG8_BAR;
        PG8_WAIT_V(2); PG8_BAR;
        PG8_STAGE(PG8_SB(1, 0), cB + kstep, voffB); PG8_STAGE_A(PG8_SA(1, 0), cA + kstep, false, 0, kstep); PG8_STAGE(PG8_SB(1, 1), cB + hstep + kstep, voffB);
        PG8_WAIT_V(6); PG8_BAR;
    } else {
        PG8_STAGE(PG8_SB(0, 0), cB, voffB); PG8_STAGE(PG8_SA(0, 0), cA, voffA); PG8_STAGE(PG8_SB(0, 1), cB + hstep, voffB); PG8_STAGE(PG8_SA(0, 1), cA + hstep, voffA);
        if (wr == 1) PG8_BAR;
        PG8_WAIT_V(4); PG8_BAR;
        PG8_STAGE(PG8_SB(1, 0), cB + kstep, voffB); PG8_STAGE(PG8_SA(1, 0), cA + kstep, voffA); PG8_STAGE(PG8_SB(1, 1), cB + hstep + kstep, voffB);
        PG8_WAIT_V(6); PG8_BAR;
    }
    for (;;) {
        const bool has_next = S.next(ui + 1, nxt);
        if constexpr (GATHER) { if (has_next) { PG8_GATHER(nxt, gAn); } else { _Pragma("unroll") for (int h_ = 0; h_ < 2; ++h_) _Pragma("unroll") for (int i_ = 0; i_ < 2; ++i_) gAn[h_][i_] = gAc[h_][i_]; } }
        const char* nA = has_next ? (const char*)g.A + (size_t)nxt.pm * tstep : cA; const char* nB = has_next ? (const char*)g.Bt + (size_t)nxt.pn * tstep : cB;
#pragma nounroll
        for (int t = 0; t < nt; t += 2) {
            const bool last = (t == nt - 2);
            const char* a1 = cA + (size_t)PG8_KT(t + 1) * kstep;
            const char* a2 = last ? nA : cA + (size_t)PG8_KT(t + 2) * kstep; const char* b2 = last ? nB : cB + (size_t)PG8_KT(t + 2) * kstep;
            const char* a3 = a2 + kstep; const char* b3 = b2 + kstep;
            const size_t k1 = (size_t)PG8_KT(t + 1) * kstep, k2 = last ? (size_t)0 : (size_t)PG8_KT(t + 2) * kstep, k3 = k2 + kstep; (void)k1; (void)k2; (void)k3;
            if (last && has_next) S.a_ready(nxt);
            if constexpr (SP2) {
            PG8_LDB(B0, 0, 0); PG8_LDB(B1, 0, 1); PG8_SCHED; PG8_LDA(At, 0, 0); PG8_STAGE_A(PG8_SA(1, 1), a1 + hstep, false, 1, k1);
            PG8_WAIT_V(8); PG8_WAIT_L(0); PG8_BAR; PG8_MMA(0, 0, At, B0); PG8_MMA(0, 1, At, B1); PG8_BAR; PG8_SCHED;
            PG8_LDA(At, 0, 1); PG8_STAGE(PG8_SB(0, 0), b2, voffB); PG8_STAGE(PG8_SB(0, 1), b2 + hstep, voffB); PG8_STAGE_A(PG8_SA(0, 0), a2, last, 0, k2);
            PG8_WAIT_V(8); PG8_WAIT_L(0); PG8_BAR; PG8_MMA(1, 0, At, B0); PG8_MMA(1, 1, At, B1); PG8_BAR; PG8_SCHED;
            PG8_LDB(B0, 1, 0); PG8_LDB(B1, 1, 1); PG8_SCHED; PG8_LDA(At, 1, 0); PG8_STAGE_A(PG8_SA(0, 1), a2 + hstep, last, 1, k2);
            PG8_WAIT_V(8); PG8_WAIT_L(0); PG8_BAR; PG8_MMA(0, 0, At, B0); PG8_MMA(0, 1, At, B1); PG8_BAR; PG8_SCHED;
            PG8_LDA(At, 1, 1); PG8_STAGE(PG8_SB(1, 0), b3, voffB); PG8_STAGE(PG8_SB(1, 1), b3 + hstep, voffB); PG8_STAGE_A(PG8_SA(1, 0), a3, last, 0, k3);
            PG8_WAIT_V(8); PG8_WAIT_L(0); PG8_BAR; PG8_MMA(1, 0, At, B0); PG8_MMA(1, 1, At, B1); PG8_BAR; PG8_SCHED;
            } else {
            PG8_LDB(B0, 0, 0); PG8_SCHED; PG8_LDA(At, 0, 0); PG8_STAGE(PG8_SA(1, 1), a1 + hstep, voffA);
            PG8_WAIT_L(8); PG8_BAR; PG8_WAIT_L(0); PG8_MMA(0, 0, At, B0); PG8_BAR; PG8_SCHED;
            PG8_LDB(B1, 0, 1); PG8_STAGE(PG8_SB(0, 0), b2, voffB);
            PG8_BAR; PG8_WAIT_L(0); PG8_MMA(0, 1, At, B1); PG8_BAR;
            PG8_LDA(At, 0, 1); PG8_STAGE(PG8_SA(0, 0), a2, voffA);
            PG8_BAR; PG8_WAIT_L(0); PG8_MMA(1, 0, At, B0); PG8_BAR; PG8_SCHED;
            PG8_STAGE(PG8_SB(0, 1), b2 + hstep, voffB);
            PG8_WAIT_V(6); PG8_BAR; PG8_MMA(1, 1, At, B1); PG8_BAR;
            PG8_LDB(B0, 1, 0); PG8_SCHED; PG8_LDA(At, 1, 0); PG8_STAGE(PG8_SA(0, 1), a2 + hstep, voffA);
            PG8_WAIT_L(8); PG8_BAR; PG8_WAIT_L(0); PG8_MMA(0, 0, At, B0); PG8_BAR; PG8_SCHED;
            PG8_LDB(B1, 1, 1); PG8_STAGE(PG8_SB(1, 0), b3, voffB);
            PG8_BAR; PG8_WAIT_L(0); PG8_MMA(0, 1, At, B1); PG8_BAR;
            PG8_LDA(At, 1, 1); PG8_STAGE(PG8_SA(1, 0), a3, voffA);
            PG8_BAR; PG8_WAIT_L(0); PG8_MMA(1, 0, At, B0); PG8_BAR; PG8_SCHED;
            PG8_STAGE(PG8_SB(1, 1), b3 + hstep, voffB);
            PG8_WAIT_V(6); PG8_BAR; PG8_MMA(1, 1, At, B1); PG8_BAR;
            }
        }
        if constexpr (ALIGN_EPI) { if (wr == 0) PG8_BAR; }
        if constexpr (FP8) { asm volatile("s_nop 15\n\ts_nop 15" ::: "memory"); }
        if constexpr (!Epi::AFTER_DRAIN) { if constexpr (Epi::PREFETCH) E(acc, cur, wr, wc, fr, fq, ui & 1); else E(acc, cur, wr, wc, fr, fq);
#if defined(PROBE_EPI2)
            if constexpr (FP8 == (PROBE_EPI2 == 1)) { if constexpr (Epi::PREFETCH) E(acc, cur, wr, wc, fr, fq, ui & 1); else E(acc, cur, wr, wc, fr, fq); }
#endif
            S.done(cur); }
        if (!has_next) break;
#pragma unroll
        for (int a = 0; a < 2; ++a)
#pragma unroll
            for (int b = 0; b < 2; ++b)
#pragma unroll
                for (int m = 0; m < 4; ++m)
#pragma unroll
                    for (int n = 0; n < 2; ++n) acc[a][b][m][n] = (f32x4){0.f, 0.f, 0.f, 0.f};
        cur = nxt; cA = nA; cB = nB; ++ui;
        if constexpr (Epi::PREFETCH) E.prefetch(cur, ui & 1, wid, lane);
        if constexpr (GATHER) { _Pragma("unroll") for (int h_ = 0; h_ < 2; ++h_) _Pragma("unroll") for (int i_ = 0; i_ < 2; ++i_) gAc[h_][i_] = gAn[h_][i_]; }
        if constexpr (ALIGN_EPI) { if (wr == 1) PG8_BAR; }
    }
    PG8_WAIT_V(0);
    if constexpr (!ALIGN_EPI) { if (wr == 0) PG8_BAR; }
    PG8_BAR;
    if constexpr (Epi::AFTER_DRAIN) { E.fused(acc, cur, wr, wc, fr, fq, lds, wid, lane); S.done(cur); }
#undef PG8_SA
#undef PG8_SB
#undef PG8_STAGE
#undef PG8_STAGE_A
#undef PG8_GATHER
#undef PG8_LDA
#undef PG8_LD32
#undef PG8_LDB
#undef PG8_MMA
#undef PG8_WAIT_V
#undef PG8_WAIT_L
#undef PG8_BAR
#undef PG8_SCHED
}
}

#ifndef PG8_SP2
#define PG8_SP2 true
#endif
#ifndef PG8_ALIGN
#define PG8_ALIGN true
#endif

#define GAS __attribute__((address_space(1)))
#define LAS __attribute__((address_space(3)))
typedef unsigned short bf16;
typedef unsigned v4u __attribute__((ext_vector_type(4)));
typedef unsigned v2u __attribute__((ext_vector_type(2)));
typedef float f32x4 __attribute__((ext_vector_type(4)));
typedef short bf16x8 __attribute__((ext_vector_type(8)));

constexpr int D = 1024, NB = 8, SEQ = 4096, CTXL = 256, TPB = SEQ + CTXL, NTOK = NB * TPB, NLAT = NB * SEQ;
constexpr int ZC = 3328;
constexpr int ZQ = 0, ZKV = 384, ZKR = 640, ZHQ = 672, ZHF = 1184, ZHB = 1696, ZHI = 2208, ZHG = 2720;
constexpr int NEXP = 32;
constexpr float ALPHA = 1.4142135623730951f;
constexpr float LN_EPS = 1e-5f, RMS_EPS = 1e-6f;
constexpr int NWAVES = 8, NTHR = 512;
constexpr float SC_X8 = 16.f, SC_WGU = 64.f, SC_ACT = 8.f, SC_WDN = 128.f, SC_Y = 64.f, SC_A1 = 16.f, SC_WPW = 64.f, SC_CV = 16.f, SC_A0 = 16.f, SC_WIN = 64.f;
constexpr int LDS_BYTES = 163840;
constexpr int LDS_BAR_OFF = LDS_BYTES - 64;
constexpr int LDS_TILE_E = 131072;
constexpr int MAXTILES = 576;
constexpr int LDS_SIDE = 155648, SIDE_BYTES = 3072;
static_assert(LDS_SIDE + 2 * SIDE_BYTES <= LDS_BYTES - 64, "lds side");
constexpr int LDS_EPI_B = 139264;
static_assert(LDS_TILE_E + (3 * MAXTILES + 96) * 4 <= LDS_EPI_B && LDS_EPI_B + 16384 <= LDS_BYTES - 64, "lds map");

constexpr size_t MiB = 1u << 20;
constexpr size_t WS_CTL = 0, CTL_ZERO_BYTES = 16384;
constexpr size_t WS_MODV = 1 * MiB;
constexpr size_t WS_ROPE = 1 * MiB + 512 * 1024;
constexpr size_t WS_BGU = 2 * MiB;
constexpr size_t WS_PW1B = 2 * MiB + 512 * 1024;
constexpr size_t WS_BCNT = WS_PW1B + 64 * 1024;
constexpr size_t WS_TILEE = WS_BCNT + 64 * 1024;
constexpr size_t WS_META = WS_TILEE + 4096;
constexpr size_t WS_TOPI = 3 * MiB, WS_TOPW = 4 * MiB;
constexpr int ECAP = 32768;
constexpr size_t WS_ROWS = 160 * MiB, WS_ROWW = 164 * MiB, WS_ROWD = 168 * MiB;
constexpr size_t WS_CURSOR = 14336;
constexpr size_t WS_WIN = 8 * MiB, WS_WUQ = 15 * MiB, WS_WUKV = 16 * MiB, WS_WOUT = 17 * MiB, WS_WPW1 = 19 * MiB, WS_WPW2 = 23 * MiB;
constexpr size_t WS_WGU = 32 * MiB, WS_WDN = 288 * MiB;
constexpr size_t WS_H = 416 * MiB;
constexpr size_t WS_X = 552 * MiB, WS_Y = 620 * MiB;
constexpr size_t WS_BIG = 688 * MiB;
constexpr size_t WS_Z = WS_BIG, WS_CQN = WS_BIG + 221 * MiB, WS_CKVN = WS_BIG + 247 * MiB, WS_KRR = WS_BIG + 264 * MiB,
                 WS_Q = WS_BIG + 267 * MiB, WS_KV = WS_BIG + 318 * MiB, WS_OF = WS_BIG + 386 * MiB, WS_OB = WS_BIG + 454 * MiB;
constexpr size_t WS_HT = WS_BIG + 528 * MiB;
constexpr size_t WS_PRE = WS_BIG;
constexpr size_t WS_XS = WS_BIG, WS_ACT = WS_BIG + 288 * MiB, WS_YB = WS_BIG + 576 * MiB;
constexpr size_t WS_END = WS_BIG + 848 * MiB;
static_assert((size_t)NTOK * ZC * 2 <= 221 * MiB && (size_t)NTOK * 384 * 2 <= 26 * MiB && (size_t)NTOK * 256 * 2 <= 17 * MiB && (size_t)NTOK * 32 * 2 <= 3 * MiB, "ws map 1");
static_assert((size_t)NTOK * 768 * 2 <= 51 * MiB && (size_t)NTOK * 1024 * 2 <= 68 * MiB && (size_t)NTOK * 512 * 4 <= 68 * MiB, "ws map 2");
static_assert((size_t)64 * 136 * 26624 <= 320 * MiB && (size_t)MAXTILES * 256 * 2048 <= 288 * MiB && (size_t)NLAT * 4 * 2048 <= 272 * MiB && (size_t)NTOK * 1024 * 4 <= 136 * MiB, "ws map 3");

#define LDS_WAIT() asm volatile("s_waitcnt lgkmcnt(0)" ::: "memory")
#define VM_WAIT() asm volatile("s_waitcnt vmcnt(0)" ::: "memory")
__device__ __forceinline__ float bf2f(unsigned short b) { return __uint_as_float(((unsigned)b) << 16); }
__device__ __forceinline__ unsigned pk2(float lo, float hi) { return pg8::cvt_pk_bf16(lo, hi); }
__device__ __forceinline__ float sigm(float x) { return __builtin_amdgcn_rcpf(1.f + __expf(-x)); }
__device__ __forceinline__ float wave_sum(float v) {
#pragma unroll
    for (int o = 1; o < 64; o <<= 1) v += __shfl_xor(v, o);
    return v;
}
__device__ __forceinline__ int ld_ctl(const int* p) { return (int)__hip_atomic_load((const unsigned*)p, __ATOMIC_RELAXED, __HIP_MEMORY_SCOPE_AGENT); }
__device__ __forceinline__ int grow_of(int lr) { return (lr >> 12) * TPB + CTXL + (lr & 4095); }

#define XB_TMO      128
#define XB_XCNT(j)  (256  + 64 * (j))
#define XB_XSUB(j)  (1280 + 64 * (j))
#define XB_XGEN(j)  (2304 + 64 * (j))
#define XB_TOP      3328
#define XB_TOPGEN   3392
#define XCD_BAR_WORDS 3456
#define XB_SPIN_CAP (1u << 21)

__device__ __forceinline__ unsigned xb_ld(unsigned* p)              { return __hip_atomic_load(p, __ATOMIC_RELAXED, __HIP_MEMORY_SCOPE_AGENT); }
__device__ __forceinline__ unsigned xb_add(unsigned* p, unsigned v) { return __hip_atomic_fetch_add(p, v, __ATOMIC_RELAXED, __HIP_MEMORY_SCOPE_AGENT); }
__device__ __forceinline__ unsigned xb_xcc_id() { return (unsigned)__builtin_amdgcn_s_getreg((3 << 11) | 20) & 0xFu; }
#define XB_SPIN(cond, bar) do { unsigned _sp = 0; while (cond) { __builtin_amdgcn_s_sleep(1); \
    if ((++_sp & 255u) == 0u) { if (xb_ld(&(bar)[XB_TMO])) break; if (_sp > XB_SPIN_CAP) { atomicAdd(&(bar)[XB_TMO], 1u); break; } } } } while (0)

struct XcdBarrier { unsigned* bar; unsigned x; volatile LAS unsigned* st; };

__device__ __forceinline__ XcdBarrier xcd_barrier_post(unsigned* bar, volatile LAS unsigned* st) {
    XcdBarrier b; b.bar = bar; b.x = xb_xcc_id(); b.st = st;
    if (threadIdx.x == 0) (void)xb_add(&bar[XB_XCNT(b.x)], 1u);
    return b;
}
__device__ __forceinline__ void xcd_barrier_complete(unsigned* bar, unsigned x, unsigned& nloc, unsigned& nx) {
    const unsigned G = gridDim.x * gridDim.y * gridDim.z;
    unsigned sum, cnt, mine, sp = 0u;
    for (;;) {
        sum = 0u; cnt = 0u; mine = 0u;
#pragma unroll
        for (unsigned j = 0; j < 16; ++j) { const unsigned c = xb_ld(&bar[XB_XCNT(j)]); sum += c; cnt += (c > 0u) ? 1u : 0u; mine = (j == x) ? c : mine; }
        if (sum == G) break;
        __builtin_amdgcn_s_sleep(1);
        if ((++sp & 255u) == 0u) { if (xb_ld(&bar[XB_TMO])) break; if (sp > XB_SPIN_CAP) { atomicAdd(&bar[XB_TMO], 1u); break; } }
    }
    nloc = mine > 0u ? mine : 1u; nx = cnt > 0u ? cnt : 1u;
}
__device__ __forceinline__ void xcd_barrier(const XcdBarrier& b) {
    asm volatile("s_waitcnt vmcnt(0)" ::: "memory");
    __syncthreads();
    if (threadIdx.x == 0) {
        unsigned* bar = b.bar;
        __builtin_amdgcn_s_waitcnt(0);
        unsigned nloc = b.st[0], nx = b.st[1];
        if (nloc == 0u) { xcd_barrier_complete(bar, b.x, nloc, nx); b.st[0] = nloc; b.st[1] = nx; }
        const unsigned old = xb_add(&bar[XB_XSUB(b.x)], 1u);
        const unsigned gen = old / nloc;
        if (old + 1u == (gen + 1u) * nloc) {
            __builtin_amdgcn_fence(__ATOMIC_RELEASE, "agent");
            asm volatile("s_waitcnt vmcnt(0)" ::: "memory");
            const unsigned og = xb_add(&bar[XB_TOP], 1u);
            const unsigned tg = og / nx;
            if (og + 1u == (tg + 1u) * nx) xb_add(&bar[XB_TOPGEN], 1u);
            else XB_SPIN(xb_ld(&bar[XB_TOPGEN]) == tg, bar);
            __builtin_amdgcn_fence(__ATOMIC_ACQUIRE, "agent");
            xb_add(&bar[XB_XGEN(b.x)], 1u);
            asm volatile("s_waitcnt vmcnt(0)" ::: "memory");
        } else {
            XB_SPIN(xb_ld(&bar[XB_XGEN(b.x)]) == gen, bar);
            __builtin_amdgcn_fence(__ATOMIC_ACQUIRE, "agent");
            asm volatile("s_waitcnt vmcnt(0)" ::: "memory");
        }
    }
    __syncthreads();
}

namespace pg8 {
struct TileOrder {
    int nM, nN, nwg, G, c;
    __device__ __forceinline__ void init(int nM_, int nN_, int G_, int c_) { nM = nM_; nN = nN_; nwg = nM * nN; G = G_; c = c_; }
    __device__ __forceinline__ bool logical(int i, int& im, int& in) const {
        const long L = (long)i * G + c; if (L >= nwg) return false;
        int wgid = (int)L; { const int q = nwg / NXCD, r = nwg % NXCD, xcd = wgid % NXCD, off = wgid / NXCD; wgid = (xcd < r ? xcd * (q + 1) : r * (q + 1) + (xcd - r) * q) + off; }
        const int nig = WGM * nN, gid = wgid / nig, fm = gid * WGM, gsz = (nM - fm) < WGM ? (nM - fm) : WGM;
        im = fm + ((wgid % nig) % gsz); in = (wgid % nig) / gsz; return true;
    }
    __device__ __forceinline__ void a_ready(const Unit&) const {}
    __device__ __forceinline__ void done(const Unit&) const {}
};
struct AllOrder : TileOrder { __device__ __forceinline__ bool next(int i, Unit& u) const { int im, in; if (!logical(i, im, in)) return false; u.pm = im; u.pn = in; return true; } };
struct LatOrder : TileOrder {
    __device__ __forceinline__ bool next(int i, Unit& u) const { int im, in; if (!logical(i, im, in)) return false; u.pm = (im >> 4) * 17 + 1 + (im & 15); u.pn = in; return true; } };
struct MoeOrder : TileOrder {
    const PG8_LAS int* tile_e; int nper;
    __device__ __forceinline__ bool next(int i, Unit& u) const { int im, in; if (!logical(i, im, in)) return false; u.pm = im; u.pn = tile_e[im] * nper + in; return true; } };

template <bool HB16> struct EpiRes {
    static constexpr bool PERM = true, AFTER_DRAIN = false, PREFETCH = false;
    const float* xin; const bf16_t* h; bf16_t* pre; const float* modv; const float* bias; float ascale;
    __device__ __forceinline__ void operator()(const f32x4 (&acc)[2][2][4][2], const Unit& u, int wr, int wc, int fr, int fq) const {
        asm volatile("" : "+v"(fr), "+v"(fq));
        const int b = u.pm / 17, j = u.pm % 17;
        const int rl0 = wr * 64 + fr, col0 = u.pn * BM + wc * 32 + 8 * fq;
        const float* gate = modv + (size_t)b * 6144 + 2048;
        f32x4 gv[2][2], bv[2][2];
#pragma unroll
        for (int bj = 0; bj < 2; ++bj)
#pragma unroll
            for (int n = 0; n < 2; ++n) { gv[bj][n] = *(const f32x4*)(gate + col0 + bj * HALF + 4 * n); bv[bj][n] = bias ? *(const f32x4*)(bias + col0 + bj * HALF + 4 * n) : (f32x4){0.f, 0.f, 0.f, 0.f}; }
        if constexpr (HB16) {
#pragma unroll
        for (int ai = 0; ai < 2; ++ai) {
            u32x4 hb[4][2];
#pragma unroll
            for (int m = 0; m < 4; ++m) { const int rl = rl0 + ai * HALF + m * 16; const size_t grow = (size_t)u.pm * BM + rl; const bf16_t* hin = h + grow * 1024 + col0;
#pragma unroll
                for (int bj = 0; bj < 2; ++bj) hb[m][bj] = *(const u32x4*)(hin + bj * HALF); }
            asm volatile("" ::: "memory");
#pragma unroll
            for (int m = 0; m < 4; ++m) { const int rl = rl0 + ai * HALF + m * 16; const size_t grow = (size_t)u.pm * BM + rl; bf16_t* po = pre + grow * 1024 + col0;
#pragma unroll
                for (int bj = 0; bj < 2; ++bj) { const u32x4 q = hb[m][bj];
                    const f32x4 h0 = {__builtin_bit_cast(float, q.x << 16), __builtin_bit_cast(float, q.x & 0xffff0000u), __builtin_bit_cast(float, q.y << 16), __builtin_bit_cast(float, q.y & 0xffff0000u)};
                    const f32x4 h1 = {__builtin_bit_cast(float, q.z << 16), __builtin_bit_cast(float, q.z & 0xffff0000u), __builtin_bit_cast(float, q.w << 16), __builtin_bit_cast(float, q.w & 0xffff0000u)};
                    const f32x4 v0 = h0 * 1.4142135623730951f + gv[bj][0] * (acc[ai][bj][m][0] * ascale + bv[bj][0]), v1 = h1 * 1.4142135623730951f + gv[bj][1] * (acc[ai][bj][m][1] * ascale + bv[bj][1]);
                    u32x4 w; w.x = cvt_pk_bf16(v0[0], v0[1]); w.y = cvt_pk_bf16(v0[2], v0[3]); w.z = cvt_pk_bf16(v1[0], v1[1]); w.w = cvt_pk_bf16(v1[2], v1[3]);
                    *(u32x4*)(po + bj * HALF) = w; } }
            asm volatile("" ::: "memory"); }
        } else {
#pragma unroll
        for (int aim = 0; aim < 4; ++aim) { const int ai = aim >> 1, m0 = (aim & 1) * 2;
            f32x4 hv[2][2][2];
#pragma unroll
            for (int mm = 0; mm < 2; ++mm) { const int rl = rl0 + ai * HALF + (m0 + mm) * 16; const size_t grow = (size_t)u.pm * BM + rl;
                const float* hin = xin + ((size_t)b * 4096 + (size_t)(j - 1) * 256 + rl) * 1024 + col0; (void)grow;
#pragma unroll
                for (int bj = 0; bj < 2; ++bj) { hv[mm][bj][0] = *(const f32x4*)(hin + bj * HALF); hv[mm][bj][1] = *(const f32x4*)(hin + bj * HALF + 4); } }
            asm volatile("" ::: "memory");
#pragma unroll
            for (int mm = 0; mm < 2; ++mm) { const int m = m0 + mm; const int rl = rl0 + ai * HALF + m * 16; const size_t grow = (size_t)u.pm * BM + rl; bf16_t* po = pre + grow * 1024 + col0;
#pragma unroll
                for (int bj = 0; bj < 2; ++bj) {
                    const f32x4 v0 = hv[mm][bj][0] * 1.4142135623730951f + gv[bj][0] * (acc[ai][bj][m][0] * ascale + bv[bj][0]), v1 = hv[mm][bj][1] * 1.4142135623730951f + gv[bj][1] * (acc[ai][bj][m][1] * ascale + bv[bj][1]);
                    u32x4 w; w.x = cvt_pk_bf16(v0[0], v0[1]); w.y = cvt_pk_bf16(v0[2], v0[3]); w.z = cvt_pk_bf16(v1[0], v1[1]); w.w = cvt_pk_bf16(v1[2], v1[3]);
                    *(u32x4*)(po + bj * HALF) = w; } }
            asm volatile("" ::: "memory"); }
        }
    }
};
#define PG8_DMA4(gptr, ldsptr) __builtin_amdgcn_global_load_lds((const unsigned*)(gptr), (PG8_LAS unsigned*)(ldsptr), 4, 0, 0)
template <int MODE, bool OUT8 = false> struct EpiGate {
    static constexpr bool PERM = true, AFTER_DRAIN = false, PREFETCH = true;
    bf16_t* O; const float* bias; int nper; float ascale, oscale; PG8_LAS unsigned char* lds;
    __device__ __forceinline__ void prefetch(const Unit& u, int par, int wid, int lane) const { if (wid < 4) PG8_DMA4(bias + u.pn * BM + 64 * wid + lane, lds + LDS_SIDE + par * SIDE_BYTES + wid * 256); }
    __device__ __forceinline__ void operator()(const f32x4 (&acc)[2][2][4][2], const Unit& u, int wr, int wc, int fr, int fq, int par) const {
        asm volatile("" : "+v"(fr), "+v"(fq));
        const int row0 = u.pm * BM + wr * 64 + fr, pnl = u.pn % nper, ocol0 = pnl * HALF + wc * 32 + 8 * fq, bcol0 = u.pn * BM + wc * 32 + 8 * fq;
        const float s0 = ascale, s1 = MODE == 1 ? ascale * oscale : ascale;
        f32x4 bv[2][2];
#pragma unroll
        for (int n = 0; n < 2; ++n) { const PG8_LAS float* bl = (const PG8_LAS float*)(lds + LDS_SIDE + par * SIDE_BYTES) + wc * 32 + 8 * fq + 4 * n; bv[0][n] = *(const PG8_LAS f32x4*)bl; const f32x4 t = *(const PG8_LAS f32x4*)(bl + HALF); bv[1][n] = MODE == 1 ? (t + 1.0f) * oscale : t; }
        (void)bcol0;
#pragma unroll
        for (int ai = 0; ai < 2; ++ai)
#pragma unroll
            for (int m = 0; m < 4; ++m) { bf16_t* rowp = O + (size_t)(row0 + ai * HALF + m * 16) * 1024 + ocol0;
                unsigned char* rowp8 = (unsigned char*)O + (size_t)(row0 + ai * HALF + m * 16) * 1024 + ocol0;
                float o[8];
#pragma unroll
                for (int n = 0; n < 2; ++n) { const f32x4 a = acc[ai][0][m][n] * s0 + bv[0][n], g = acc[ai][1][m][n] * s1 + bv[1][n];
#pragma unroll
                    for (int e = 0; e < 4; ++e) {
                        if (MODE == 0) { o[4 * n + e] = a[e] * __builtin_amdgcn_rcpf(1.f + __builtin_amdgcn_exp2f(g[e] * -1.4426950408889634f)); }
                        else { const float gt = fminf(a[e], 7.0f), up1 = __builtin_amdgcn_fmed3f(g[e], -6.0f * oscale, 8.0f * oscale);
                            o[4 * n + e] = up1 * (gt * __builtin_amdgcn_rcpf(1.f + __builtin_amdgcn_exp2f(gt * (-1.702f * 1.4426950408889634f)))); } } }
                if constexpr (OUT8) {
                    int w0 = 0, w1 = 0; w0 = __builtin_amdgcn_cvt_pk_fp8_f32(o[0], o[1], w0, false); w0 = __builtin_amdgcn_cvt_pk_fp8_f32(o[2], o[3], w0, true);
                    w1 = __builtin_amdgcn_cvt_pk_fp8_f32(o[4], o[5], w1, false); w1 = __builtin_amdgcn_cvt_pk_fp8_f32(o[6], o[7], w1, true);
                    typedef unsigned u32x2 __attribute__((ext_vector_type(2))); *(u32x2*)rowp8 = (u32x2){(unsigned)w0, (unsigned)w1}; (void)rowp;
                } else { (void)rowp8;
                u32x4 w; w.x = cvt_pk_bf16(o[0], o[1]); w.y = cvt_pk_bf16(o[2], o[3]); w.z = cvt_pk_bf16(o[4], o[5]); w.w = cvt_pk_bf16(o[6], o[7]);
                *(u32x4*)rowp = w; } }
    }
};
struct EpiDown {
    static constexpr bool PERM = true, AFTER_DRAIN = false, PREFETCH = true;
    bf16_t* Y; const float* bias; const float* row_w; const int* row_dst; float ascale; const PG8_LAS int* gtab; float oscale; PG8_LAS unsigned char* lds;
    __device__ __forceinline__ void prefetch(const Unit& u, int par, int wid, int lane) const { PG8_LAS unsigned char* sd = lds + LDS_SIDE + par * SIDE_BYTES; const int tbase = gtab[u.pm];
        if (wid < 4) { PG8_DMA4(bias + u.pn * BM + 64 * wid + lane, sd + wid * 256); PG8_DMA4(row_w + tbase + 64 * wid + lane, sd + 1024 + wid * 256); } else PG8_DMA4(row_dst + tbase + 64 * (wid - 4) + lane, sd + 2048 + (wid - 4) * 256); }
    __device__ __forceinline__ void operator()(const f32x4 (&acc)[2][2][4][2], const Unit& u, int wr, int wc, int fr, int fq, int par) const {
        asm volatile("" : "+v"(fr), "+v"(fq));
        const int tid = (wr * 4 + wc) * 64 + fq * 16 + fr;
        const PG8_LAS unsigned char* sd = lds + LDS_SIDE + par * SIDE_BYTES;
        const int pnl = u.pn & 3; const int tcnt = gtab[576 + u.pm];
        f32x4 bv[2][2];
#pragma unroll
        for (int bj = 0; bj < 2; ++bj)
#pragma unroll
            for (int n = 0; n < 2; ++n) bv[bj][n] = *(const PG8_LAS f32x4*)(sd + (wc * 32 + 8 * fq + bj * HALF + 4 * n) * 4);
        float wv[2][4]; int dstv[2][2];
#pragma unroll
        for (int ai = 0; ai < 2; ++ai) {
#pragma unroll
            for (int m = 0; m < 4; ++m) { const int rl = wr * 64 + fr + ai * HALF + m * 16; wv[ai][m] = *(const PG8_LAS float*)(sd + 1024 + rl * 4); }
#pragma unroll
            for (int k = 0; k < 2; ++k) { const int rl = ai * HALF + (tid >> 3) + 64 * k; dstv[ai][k] = *(const PG8_LAS int*)(sd + 2048 + rl * 4); } }
        PG8_LAS unsigned char* const reg0 = lds + 3 * HTB; PG8_LAS unsigned char* const reg1 = lds + LDS_EPI_B;
        const int wbase = (wr * 64 + fr) * 128 + (((wc * 4 + fq) ^ fr) * 8);
        const int rrow = tid >> 3, rch = tid & 7;
        typedef unsigned u32x2 __attribute__((ext_vector_type(2)));
#pragma unroll
        for (int ai = 0; ai < 2; ++ai) {
#pragma unroll
            for (int m = 0; m < 4; ++m) { const float w8 = wv[ai][m] * oscale;
#pragma unroll
                for (int bj = 0; bj < 2; ++bj) { const f32x4 v0 = (acc[ai][bj][m][0] * ascale + bv[bj][0]) * w8, v1 = (acc[ai][bj][m][1] * ascale + bv[bj][1]) * w8;
                    int w0 = 0, w1 = 0; w0 = __builtin_amdgcn_cvt_pk_fp8_f32(__builtin_amdgcn_fmed3f(v0[0], -448.f, 448.f), __builtin_amdgcn_fmed3f(v0[1], -448.f, 448.f), w0, false); w0 = __builtin_amdgcn_cvt_pk_fp8_f32(__builtin_amdgcn_fmed3f(v0[2], -448.f, 448.f), __builtin_amdgcn_fmed3f(v0[3], -448.f, 448.f), w0, true);
                    w1 = __builtin_amdgcn_cvt_pk_fp8_f32(__builtin_amdgcn_fmed3f(v1[0], -448.f, 448.f), __builtin_amdgcn_fmed3f(v1[1], -448.f, 448.f), w1, false); w1 = __builtin_amdgcn_cvt_pk_fp8_f32(__builtin_amdgcn_fmed3f(v1[2], -448.f, 448.f), __builtin_amdgcn_fmed3f(v1[3], -448.f, 448.f), w1, true);
                    *(PG8_LAS u32x2*)((bj ? reg1 : reg0) + wbase + m * 2048) = (u32x2){(unsigned)w0, (unsigned)w1}; } }
            asm volatile("s_waitcnt lgkmcnt(0)" ::: "memory"); __builtin_amdgcn_s_barrier();
            u32x4 rd[2][2];
#pragma unroll
            for (int bj = 0; bj < 2; ++bj)
#pragma unroll
                for (int k = 0; k < 2; ++k) { const int row = rrow + 64 * k; rd[bj][k] = *(const PG8_LAS u32x4*)((bj ? reg1 : reg0) + row * 128 + ((rch ^ ((row & 15) >> 1)) * 16)); }
            asm volatile("s_waitcnt lgkmcnt(0)" ::: "memory"); __builtin_amdgcn_s_barrier();
#pragma unroll
            for (int k = 0; k < 2; ++k) { const int row = rrow + 64 * k, rl = ai * HALF + row;
                if (rl < tcnt) { unsigned char* rowp = (unsigned char*)Y + (size_t)dstv[ai][k] * 1024 + pnl * BM + rch * 16;
#pragma unroll
                    for (int bj = 0; bj < 2; ++bj) { u32x4 q = rd[bj][k]; if (row & 1) q = (u32x4){q.z, q.w, q.x, q.y}; *(u32x4*)(rowp + bj * HALF) = q; } } }
        }
    }
};
}

namespace att {
using bf16x8 = __attribute__((ext_vector_type(8))) short;
using s16x4  = __attribute__((ext_vector_type(4))) short;
using f32x16 = __attribute__((ext_vector_type(16))) float;
using u32x4  = __attribute__((ext_vector_type(4))) unsigned;
constexpr int NW = 8, QBLK = 32, KVBLK = 64;
constexpr float SCALE = 0.10206207261596575f;
constexpr float THR = 8.f;
constexpr int SHM_V = 16384, SHM_K = 16384, NBUF = 3, SHM_ATTN = NBUF * SHM_V + NBUF * SHM_K + NW * 64 * 4;
#define KSWZ(row, colB) ((row) * 256 + ((colB) ^ (((row) & 7) << 4)))
#define SBAR() __builtin_amdgcn_sched_barrier(0)
__device__ __forceinline__ int crow(int r, int hi) { return (r & 3) + 8 * (r >> 2) + 4 * hi; }
__device__ __forceinline__ unsigned cvtpk(float lo, float hi) { unsigned r; asm volatile("v_cvt_pk_bf16_f32 %0, %1, %2" : "=v"(r) : "v"(lo), "v"(hi)); return r; }

__device__ __forceinline__ void partialSM(f32x16& p0, f32x16& p1, float& m_reg, float& mn, float& alpha) {
  constexpr float C = SCALE * 1.4426950408889634f;
  float pmax = p0[0];
#pragma unroll
  for (int r = 1; r < 16; ++r) pmax = fmaxf(pmax, p0[r]);
#pragma unroll
  for (int r = 0; r < 16; ++r) pmax = fmaxf(pmax, p1[r]);
  { auto rr = __builtin_amdgcn_permlane32_swap(__float_as_uint(pmax), __float_as_uint(pmax), false, false);
    pmax = fmaxf(__uint_as_float(rr[0]), __uint_as_float(rr[1])); }
  if (__builtin_expect(__all(pmax - m_reg <= THR / SCALE), 1)) { mn = m_reg; alpha = 1.f; }
  else { mn = fmaxf(m_reg, pmax); alpha = __builtin_amdgcn_exp2f((m_reg - mn) * C); m_reg = mn; }
  float mnC = -mn * C;
#pragma unroll
  for (int r = 0; r < 16; ++r) p0[r] = fmaf(p0[r], C, mnC);
#pragma unroll
  for (int r = 0; r < 16; ++r) p1[r] = fmaf(p1[r], C, mnC);
#pragma unroll
  for (int r = 0; r < 16; ++r) p0[r] = __builtin_amdgcn_exp2f(p0[r]);
}
__device__ __forceinline__ void finishSM(f32x16& p0, f32x16& p1, float alpha, float& l_reg, bf16x8& pa0, bf16x8& pa1, bf16x8& pa2, bf16x8& pa3) {
#pragma unroll
  for (int r = 0; r < 16; ++r) p1[r] = __builtin_amdgcn_exp2f(p1[r]);
  float ps = 0;
#pragma unroll
  for (int r = 0; r < 16; ++r) ps += p0[r];
#pragma unroll
  for (int r = 0; r < 16; ++r) ps += p1[r];
  { auto rr = __builtin_amdgcn_permlane32_swap(__float_as_uint(ps), __float_as_uint(ps), false, false);
    ps = __uint_as_float(rr[0]) + __uint_as_float(rr[1]); }
  l_reg = l_reg * alpha + ps;
#define PK4(P, BASE, OUT) do { unsigned a0 = cvtpk(P[BASE + 0], P[BASE + 1]), a1 = cvtpk(P[BASE + 2], P[BASE + 3]);   \
    unsigned b0 = cvtpk(P[BASE + 4], P[BASE + 5]), b1 = cvtpk(P[BASE + 6], P[BASE + 7]);                              \
    auto r0 = __builtin_amdgcn_permlane32_swap(a0, b0, false, false); auto r1 = __builtin_amdgcn_permlane32_swap(a1, b1, false, false); \
    u32x4 w = {r0[0], r1[0], r0[1], r1[1]}; OUT = *reinterpret_cast<bf16x8*>(&w); } while (0)
  PK4(p0, 0, pa0); PK4(p0, 8, pa1); PK4(p1, 0, pa2); PK4(p1, 8, pa3);
#undef PK4
}
__device__ __forceinline__ void qkt(f32x16& p0, f32x16& p1, const bf16* Ks, const bf16x8* qr, int r32, int hi) {
  p0 = f32x16{}; p1 = f32x16{};
#pragma unroll
  for (int d0 = 0; d0 < 6; ++d0) { int cb = (d0 * 16 + hi * 8) * 2;
    bf16x8 b0 = *reinterpret_cast<const bf16x8*>((const char*)Ks + KSWZ(r32, cb));
    bf16x8 b1 = *reinterpret_cast<const bf16x8*>((const char*)Ks + KSWZ(32 + r32, cb));
    p0 = __builtin_amdgcn_mfma_f32_32x32x16_bf16(b0, qr[d0], p0, 0, 0, 0);
    p1 = __builtin_amdgcn_mfma_f32_32x32x16_bf16(b1, qr[d0], p1, 0, 0, 0); }
}
__device__ __forceinline__ int v_st(int k, int c) { const int kk = (k & ~0xC) | ((k & 4) << 1) | ((k & 8) >> 1); return ((kk >> 3) * 4 + (c >> 5)) * 512 + ((kk & 7) * 32 + (c & 31)) * 2; }
__device__ __forceinline__ int v_rd_base(int lane) { return ((lane & 3) << 3) | (((lane >> 2) & 3) << 6) | (((lane >> 4) & 1) << 5) | (((lane >> 5) & 1) << 8); }
constexpr int v_rd_off(int d0, int ks, int half) { return d0 * 512 + ks * 4096 + half * 2048; }
template <int OFF> __device__ __forceinline__ s16x4 tr_read(int vb) {
  s16x4 r; asm volatile("ds_read_b64_tr_b16 %0, %1 offset:%2" : "=&v"(r) : "v"(vb), "i"(OFF) : "memory"); return r;
}
template <int D0> __device__ __forceinline__ void pv_one(f32x16& od, int vb, bf16x8 pa0, bf16x8 pa1, bf16x8 pa2, bf16x8 pa3) {
  const s16x4 l0 = tr_read<v_rd_off(D0, 0, 0)>(vb), h0 = tr_read<v_rd_off(D0, 0, 1)>(vb), l1 = tr_read<v_rd_off(D0, 1, 0)>(vb), h1 = tr_read<v_rd_off(D0, 1, 1)>(vb);
  const s16x4 l2 = tr_read<v_rd_off(D0, 2, 0)>(vb), h2 = tr_read<v_rd_off(D0, 2, 1)>(vb), l3 = tr_read<v_rd_off(D0, 3, 0)>(vb), h3 = tr_read<v_rd_off(D0, 3, 1)>(vb);
  asm volatile("s_waitcnt lgkmcnt(0)" ::: "memory"); SBAR();
#define PK(L, H) (bf16x8){L[0], L[1], L[2], L[3], H[0], H[1], H[2], H[3]}
  od = __builtin_amdgcn_mfma_f32_32x32x16_bf16(pa0, PK(l0, h0), od, 0, 0, 0);
  od = __builtin_amdgcn_mfma_f32_32x32x16_bf16(pa1, PK(l1, h1), od, 0, 0, 0);
  od = __builtin_amdgcn_mfma_f32_32x32x16_bf16(pa2, PK(l2, h2), od, 0, 0, 0);
  od = __builtin_amdgcn_mfma_f32_32x32x16_bf16(pa3, PK(l3, h3), od, 0, 0, 0);
#undef PK
}
__device__ __forceinline__ void pv_d0(f32x16* o, int vb, bf16x8 pa0, bf16x8 pa1, bf16x8 pa2, bf16x8 pa3) {
  pv_one<0>(o[0], vb, pa0, pa1, pa2, pa3); pv_one<1>(o[1], vb, pa0, pa1, pa2, pa3);
}
__device__ __forceinline__ bf16x8 rope8(bf16x8 x, const float* tab, int pbase) {
  u32x4 w;
#pragma unroll
  for (int i = 0; i < 4; ++i) { const float x1 = __uint_as_float(((unsigned)(unsigned short)x[2 * i]) << 16), x2 = __uint_as_float(((unsigned)(unsigned short)x[2 * i + 1]) << 16);
    const float cs = tab[pbase + i], sn = tab[16 + pbase + i]; w[i] = cvtpk(x1 * cs - x2 * sn, x1 * sn + x2 * cs); }
  return *reinterpret_cast<bf16x8*>(&w);
}
__device__ __forceinline__ void attn_unit(const bf16* __restrict__ Qb, const bf16* __restrict__ KVb, const bf16* __restrict__ KRb, bf16* __restrict__ Ob,
                                          const float* __restrict__ rope, int seq, char* lds) {
  int tid_l = threadIdx.x; asm volatile("" : "+v"(tid_l));
  const int tid = tid_l, wid = tid >> 6, lane = tid & 63, r32 = lane & 31, hi = lane >> 5;
  bf16* V_lds = (bf16*)lds; bf16* K_lds = (bf16*)(lds + NBUF * SHM_V);
  float* ws = (float*)(lds + NBUF * SHM_V + NBUF * SHM_K) + wid * 64; float* li_l = ws; float* al_l = ws + 32;
  float m_reg = -1e30f, l_reg = 0; f32x16 o[2] = {}; bf16x8 qr[6];
  const bf16* Qw = Qb + (long)(wid * QBLK + r32) * 768 + hi * 8;
#pragma unroll
  for (int d0 = 0; d0 < 6; ++d0) qr[d0] = *reinterpret_cast<const bf16x8*>(Qw + d0 * 16);
  if (rope) { const float* tab = rope + (long)(wid * QBLK + r32) * 32; qr[4] = rope8(qr[4], tab, 4 * hi); qr[5] = rope8(qr[5], tab, 8 + 4 * hi); }
  const int sr = tid >> 4, ch = tid & 15;
  const bf16* kbase = ch < 8 ? KVb + ch * 8 : KRb + ((ch - 8) & 3) * 8; const long kstr = ch < 8 ? 1024 : 32;
  const int vkey = tid >> 3, vc8 = (tid & 7) * 8, vst0 = v_st(vkey, vc8);
  const bf16* vbase = KVb + 512 + vc8;
  const int vb0 = (int)(uintptr_t)V_lds + v_rd_base(lane);
  struct { bf16x8 vs0, ks0, ks1; } sr_[2];
#define SLOAD(i, k0) do { sr_[i].vs0 = *reinterpret_cast<const bf16x8*>(vbase + (long)((k0) + vkey) * 1024); \
    sr_[i].ks0 = *reinterpret_cast<const bf16x8*>(kbase + (long)((k0) + sr) * kstr); sr_[i].ks1 = *reinterpret_cast<const bf16x8*>(kbase + (long)((k0) + 32 + sr) * kstr); } while (0)
#define SWRITE(b, i) do { *(bf16x8*)((char*)V_lds + (b) * SHM_V + vst0) = sr_[i].vs0; int kc = ch * 16;               \
    *(bf16x8*)((char*)K_lds + (b) * SHM_K + KSWZ(sr, kc)) = sr_[i].ks0;                       \
    *(bf16x8*)((char*)K_lds + (b) * SHM_K + KSWZ(32 + sr, kc)) = sr_[i].ks1; } while (0)
#define SWAIT() asm volatile("s_waitcnt vmcnt(3)" ::: "memory")
#define RESC(a) do { if (__any((a) < 1.f)) { if (hi == 0) al_l[r32] = (a); asm volatile("s_waitcnt lgkmcnt(0)" ::: "memory"); \
    _Pragma("unroll") for (int d = 0; d < 2; ++d) _Pragma("unroll") for (int r = 0; r < 16; ++r) o[d][r] *= al_l[crow(r, hi)]; } } while (0)
  f32x16 pA0, pA1, pB0, pB1; float mnA, mnB, alA, alB; bf16x8 pa0, pa1, pa2, pa3; const int NT = seq / KVBLK;
  constexpr int SE = 0, SO = 1;
  SLOAD(SE, 0); asm volatile("s_waitcnt vmcnt(0)" ::: "memory"); SWRITE(0, SE); __syncthreads();
  qkt(pA0, pA1, K_lds, qr, r32, hi); partialSM(pA0, pA1, m_reg, mnA, alA);
  SLOAD(SO, KVBLK); if (2 < NT) SLOAD(SE, 2 * KVBLK);
  SWAIT(); SWRITE(1, SO); __syncthreads();
  int bprev = 0, bcur = 1, bnext = 2;
#define ATT_STEP(PN0, PN1, MNN, ALN, PO0, PO1, ALO, SL_LOAD, SL_WRITE, t) do { \
    SBAR(); qkt(PN0, PN1, (bf16*)((char*)K_lds + bcur * SHM_K), qr, r32, hi); \
    finishSM(PO0, PO1, ALO, l_reg, pa0, pa1, pa2, pa3); SBAR(); \
    SLOAD(SL_LOAD, (((t) + 2 < NT) ? (t) + 2 : NT - 1) * KVBLK); SBAR();     \
    pv_d0(o, vb0 + bprev * (int)SHM_V, pa0, pa1, pa2, pa3); partialSM(PN0, PN1, m_reg, MNN, ALN); \
    SWAIT(); SWRITE(bnext, SL_WRITE); \
    RESC(ALN); __syncthreads(); \
    bprev = bcur; bcur = bnext; bnext = (bnext == 2) ? 0 : bnext + 1; } while (0)
  for (int j = 1; j + 1 < NT; j += 2) {
    ATT_STEP(pB0, pB1, mnB, alB, pA0, pA1, alA, SO, SE, j);
    ATT_STEP(pA0, pA1, mnA, alA, pB0, pB1, alB, SE, SO, j + 1);
  }
#undef ATT_STEP
  SBAR(); qkt(pB0, pB1, (bf16*)((char*)K_lds + bcur * SHM_K), qr, r32, hi);
  finishSM(pA0, pA1, alA, l_reg, pa0, pa1, pa2, pa3); SBAR();
  pv_d0(o, vb0 + bprev * (int)SHM_V, pa0, pa1, pa2, pa3); partialSM(pB0, pB1, m_reg, mnB, alB);
  RESC(alB);
  finishSM(pB0, pB1, alB, l_reg, pa0, pa1, pa2, pa3); SBAR();
  pv_d0(o, vb0 + bcur * (int)SHM_V, pa0, pa1, pa2, pa3);
  if (hi == 0) li_l[r32] = l_reg; asm volatile("s_waitcnt lgkmcnt(0)" ::: "memory");
  float rli[16];
#pragma unroll
  for (int r = 0; r < 16; ++r) rli[r] = __builtin_amdgcn_rcpf(li_l[crow(r, hi)]);
  bf16* Ow = Ob + (long)(wid * QBLK) * 1024;
#pragma unroll
  for (int r = 0; r < 16; ++r) { int orow = crow(r, hi);
#pragma unroll
    for (int d0 = 0; d0 < 2; ++d0) { const float v = o[d0][r] * rli[r]; Ow[(long)orow * 1024 + d0 * 32 + r32] = (bf16)(cvtpk(v, v) & 0xffffu); } }
#undef SLOAD
#undef SWRITE
#undef SWAIT
#undef RESC
}
}

struct Args { const float* in[33]; float* out; unsigned char* ws; int ph_lo, ph_hi; };
enum { I_X = 0, I_C, I_CTX, I_CCTX, I_MODW, I_MODB, I_LN1G, I_LN1B, I_LN2G, I_LN2B, I_WIN, I_QNORM, I_KVNORM, I_WUQ, I_WUK, I_WUV, I_LBL, I_HGNORM, I_WOUT,
       I_PW1W, I_PW1B, I_DWW, I_DWB, I_CLNG, I_CLNB, I_PW2W, I_PW2B, I_RW, I_RB, I_WGU, I_BGU, I_WDN, I_BDN };

__device__ __forceinline__ int dst_row(int n, int mode, int row_off) {
    if (mode == 0) return row_off + n;
    int f, g; if (mode == 1) { f = n >> 1; g = n & 1; } else { g = n >> 10; f = n & 1023; }
    return row_off + 256 * (f >> 7) + 128 * g + (f & 127);
}
__device__ __forceinline__ unsigned pack_fp8x4(float a, float b, float c, float d) { int w = 0; w = __builtin_amdgcn_cvt_pk_fp8_f32(fminf(fmaxf(a, -448.f), 448.f), fminf(fmaxf(b, -448.f), 448.f), w, false);
    w = __builtin_amdgcn_cvt_pk_fp8_f32(fminf(fmaxf(c, -448.f), 448.f), fminf(fmaxf(d, -448.f), 448.f), w, true); return (unsigned)w; }
struct TrItem { const float* W; bf16* WT; int K, N, mode, row_off, item; float f8scale; };
__device__ __forceinline__ void tr_load(const TrItem& d, f32x4 (&v)[16], int lane) {
    const int nblk = (d.N + 31) >> 5, kb = d.item / nblk, nb = d.item - kb * nblk, k0 = 128 * kb + 16 * (lane >> 3), nc = 32 * nb + 4 * (lane & 7);
#pragma unroll
    for (int i = 0; i < 16; ++i) v[i] = (nc < d.N) ? __builtin_nontemporal_load((const f32x4*)(d.W + (size_t)(k0 + i) * d.N + nc)) : (f32x4){0.f, 0.f, 0.f, 0.f};
}
__device__ __forceinline__ void tr_store(const TrItem& d, const f32x4 (&v)[16], int lane) {
    const int nblk = (d.N + 31) >> 5, kb = d.item / nblk, nb = d.item - kb * nblk, k0 = 128 * kb + 16 * (lane >> 3), nc = 32 * nb + 4 * (lane & 7); const int K = d.K;
    if (nc >= d.N) return;
#pragma unroll
    for (int j = 0; j < 4; ++j) { const size_t row = (size_t)dst_row(nc + j, d.mode, d.row_off);
        if (d.f8scale > 0.f) { const float f8 = d.f8scale; v4u o;
            o.x = pack_fp8x4(v[0][j] * f8, v[1][j] * f8, v[2][j] * f8, v[3][j] * f8); o.y = pack_fp8x4(v[4][j] * f8, v[5][j] * f8, v[6][j] * f8, v[7][j] * f8);
            o.z = pack_fp8x4(v[8][j] * f8, v[9][j] * f8, v[10][j] * f8, v[11][j] * f8); o.w = pack_fp8x4(v[12][j] * f8, v[13][j] * f8, v[14][j] * f8, v[15][j] * f8);
            *(v4u*)((unsigned char*)d.WT + row * K + k0) = o; }
        else { v4u o0, o1; o0.x = pk2(v[0][j], v[1][j]); o0.y = pk2(v[2][j], v[3][j]); o0.z = pk2(v[4][j], v[5][j]); o0.w = pk2(v[6][j], v[7][j]);
            o1.x = pk2(v[8][j], v[9][j]); o1.y = pk2(v[10][j], v[11][j]); o1.z = pk2(v[12][j], v[13][j]); o1.w = pk2(v[14][j], v[15][j]);
            bf16* wp = d.WT + row * K + k0; *(v4u*)wp = o0; *(v4u*)(wp + 8) = o1; } }
}
__device__ __forceinline__ void convert_items(const Args& a, unsigned char* ws, LAS float* scr, int lane, int gw, int NGW, int it_lo, int it_hi) {
    constexpr int I0 = 8 * 101, I1 = 6 * 12, I2 = 4 * 8, I3 = 4 * 8, I4 = 256, I5 = 512;
    constexpr int NGU = 64 * 512, NDN = 64 * 256;
    auto decode = [&](int it) -> TrItem {
        TrItem d; int r = it; d.f8scale = 0.f; d.mode = 0; d.row_off = 0;
        if (r < NGU) { const int mi = r >> 9; d.W = a.in[I_WGU] + (size_t)mi * 1024 * 2048; d.K = 1024; d.N = 2048; d.WT = (bf16*)(ws + WS_WGU + (size_t)mi * 2048 * 1024); d.mode = 1; d.item = r & 511; d.f8scale = SC_WGU; return d; } r -= NGU;
        if (r < NDN) { const int mi = r >> 8; d.W = a.in[I_WDN] + (size_t)mi * 1024 * 1024; d.K = 1024; d.N = 1024; d.WT = (bf16*)(ws + WS_WDN + (size_t)mi * 1024 * 1024); d.item = r & 255; d.f8scale = SC_WDN; return d; } r -= NDN;
        if (r < I0) { d.W = a.in[I_WIN]; d.K = 1024; d.N = 3232; d.WT = (bf16*)(ws + WS_WIN); d.item = r; d.f8scale = SC_WIN; return d; } r -= I0;
        if (r < I1) { d.W = a.in[I_WUQ]; d.K = 384; d.N = 768; d.WT = (bf16*)(ws + WS_WUQ); d.item = r; return d; } r -= I1;
        if (r < I2) { d.W = a.in[I_WUK]; d.K = 256; d.N = 512; d.WT = (bf16*)(ws + WS_WUKV); d.item = r; return d; } r -= I2;
        if (r < I3) { d.W = a.in[I_WUV]; d.K = 256; d.N = 512; d.WT = (bf16*)(ws + WS_WUKV); d.row_off = 512; d.item = r; return d; } r -= I3;
        if (r < I4) { d.W = a.in[I_WOUT]; d.K = 1024; d.N = 1024; d.WT = (bf16*)(ws + WS_WOUT); d.item = r; return d; } r -= I4;
        if (r < I5) { d.W = a.in[I_PW1W]; d.K = 1024; d.N = 2048; d.WT = (bf16*)(ws + WS_WPW1); d.mode = 2; d.item = r; d.f8scale = SC_WPW; return d; } r -= I5;
        d.W = a.in[I_PW2W]; d.K = 1024; d.N = 1024; d.WT = (bf16*)(ws + WS_WPW2); d.item = r; d.f8scale = SC_WPW; return d; };
    f32x4 tv0[16], tv1[16];
    int it = it_lo + gw;
    if (it < it_hi) { const TrItem d0 = decode(it); tr_load(d0, tv0, lane); }
    if (it + NGW < it_hi) { const TrItem d1 = decode(it + NGW); tr_load(d1, tv1, lane); }
    for (; it < it_hi; it += 2 * NGW) {
        { const TrItem d = decode(it);
          tr_store(d, tv0, lane);
          if (it + 2 * NGW < it_hi) { const TrItem dn = decode(it + 2 * NGW); tr_load(dn, tv0, lane); } }
        if (it + NGW < it_hi) { const TrItem d = decode(it + NGW);
          tr_store(d, tv1, lane);
          if (it + 3 * NGW < it_hi) { const TrItem dn = decode(it + 3 * NGW); tr_load(dn, tv1, lane); } }
    }
}
__device__ __forceinline__ void phase_prologue(const Args& a, LAS unsigned char* lds, int tid, int lane, int wave) {
    unsigned char* ws = a.ws;
    const int G = gridDim.x, B = blockIdx.x;
    {
        LAS float* sc = (LAS float*)lds;
        LAS float* red = (LAS float*)(lds + 36864);
        float* modv = (float*)(ws + WS_MODV);
        bool have = false;
        for (int it = B; it < 192; it += G) {
            if (!have) { for (int i = tid; i < 9 * 1024; i += NTHR) { const int r = i >> 10, k = i & 1023; const float x = r < 8 ? a.in[I_C][r * 1024 + k] : a.in[I_CCTX][k]; sc[i] = x * sigm(x); } __syncthreads(); have = true; }
            const int l = it / 96, jc = it % 96, kg = tid >> 6, jj = tid & 63, j = jc * 64 + jj;
            float acc[9];
#pragma unroll
            for (int r = 0; r < 9; ++r) acc[r] = 0.f;
            const float* wp = a.in[I_MODW] + ((size_t)l * 1024 + kg * 128) * 6144 + j;
            for (int k0 = 0; k0 < 128; k0 += 16) { float w[16];
#pragma unroll
                for (int kk = 0; kk < 16; ++kk) w[kk] = wp[(size_t)(k0 + kk) * 6144];
#pragma unroll
                for (int kk = 0; kk < 16; ++kk)
#pragma unroll
                    for (int r = 0; r < 9; ++r) acc[r] += sc[r * 1024 + kg * 128 + k0 + kk] * w[kk]; }
#pragma unroll
            for (int r = 0; r < 9; ++r) red[(kg * 9 + r) * 64 + jj] = acc[r];
            __syncthreads();
            for (int i = tid; i < 576; i += NTHR) { const int r = i >> 6, j2 = i & 63; float s = a.in[I_MODB][l * 6144 + jc * 64 + j2];
#pragma unroll
                for (int g = 0; g < 8; ++g) s += red[(g * 9 + r) * 64 + j2];
                modv[((size_t)l * 9 + r) * 6144 + jc * 64 + j2] = s; }
            __syncthreads();
        }
        __syncthreads();
    }
    const int gw = B * NWAVES + wave, NGW = G * NWAVES, gt = B * NTHR + tid, NGT = G * NTHR;
    { float* rope = (float*)(ws + WS_ROPE);
      for (int i = gt; i < 4096 * 16; i += NGT) { const int t = i >> 4, p = i & 15; const float pos = (float)(p < 8 ? (t >> 6) : (t & 63));
          const float inv = __powf(10000.0f, -(float)(p & 7) * 0.125f); const float ang = pos * inv; rope[t * 32 + p] = cosf(ang); rope[t * 32 + 16 + p] = sinf(ang); }
      float* bgu = (float*)(ws + WS_BGU);
      for (int i = gt; i < 2 * 32 * 2048; i += NGT) { const int le = i >> 11, np = i & 2047, q = np >> 8, g = (np >> 7) & 1, r = np & 127, f = 128 * q + r; bgu[i] = a.in[I_BGU][(size_t)le * 2048 + 2 * f + g]; }
      float* pb = (float*)(ws + WS_PW1B);
      for (int i = gt; i < 2048; i += NGT) { const int q = i >> 8, g = (i >> 7) & 1, r = i & 127, f = 128 * q + r; pb[i] = a.in[I_PW1B][g * 1024 + f]; }
      v4u* zp = (v4u*)(ws + WS_WIN + (size_t)3232 * 1024);
      for (int i = gt; i < 96 * 1024 / 16; i += NGT) zp[i] = (v4u){0u, 0u, 0u, 0u};
    }
    LAS float* scr = (LAS float*)(lds + wave * 16640);
    constexpr int I0 = 8 * 101, I1 = 6 * 12, I2 = 4 * 8, I3 = 4 * 8, I4 = 256, I5 = 512, I6 = 256, SMALL = I0 + I1 + I2 + I3 + I4 + I5 + I6;
    constexpr int NGU = 64 * 512, NDN = 64 * 256, NITEMS = SMALL + NGU + NDN;
    convert_items(a, ws, scr, lane, B * NWAVES + wave, G * NWAVES, NGU + NDN, NITEMS);
}
__device__ __forceinline__ void convert_moe_share(const Args& a, LAS unsigned char* lds, int lane, int wave) {
    LAS float* scr = (LAS float*)(lds + wave * 16640);
    constexpr int NGU = 64 * 512, NDN = 64 * 256;
    convert_items(a, a.ws, scr, lane, blockIdx.x * NWAVES + wave, gridDim.x * NWAVES, 0, NGU + NDN);
}

__device__ __forceinline__ void phase_mod0(const Args& a, int lane, int wave) {
    const int gw = blockIdx.x * NWAVES + wave, NGW = gridDim.x * NWAVES;
    const float* modv = (const float*)(a.ws + WS_MODV);
    bf16* X = (bf16*)(a.ws + WS_X);
    f32x4 xv[2][4], xn[2][4];
#define MOD0_LOAD(dst, r0_) do { _Pragma("unroll") for (int q = 0; q < 2; ++q) { const int r = (r0_) + q; const int b = r / TPB, p = r - b * TPB; \
            const float* src = p < CTXL ? a.in[I_CTX] + ((size_t)b * CTXL + p) * 1024 : a.in[I_X] + ((size_t)b * SEQ + (p - CTXL)) * 1024; \
            _Pragma("unroll") for (int j = 0; j < 4; ++j) dst[q][j] = *(const f32x4*)(src + 4 * (lane + 64 * j)); } } while (0)
    if (2 * gw < NTOK) MOD0_LOAD(xv, 2 * gw);
    for (int r0 = 2 * gw; r0 < NTOK; r0 += 2 * NGW) {
        f32x4 shv[2][4], scv[2][4];
#pragma unroll
        for (int q = 0; q < 2; ++q) { const int r = r0 + q; const int b = r / TPB, p = r - b * TPB; const float* mvp = modv + (size_t)(p < CTXL ? 8 : b) * 6144;
#pragma unroll
            for (int j = 0; j < 4; ++j) { const int c = 4 * (lane + 64 * j); shv[q][j] = *(const f32x4*)(mvp + c); scv[q][j] = *(const f32x4*)(mvp + 1024 + c); } }
        if (r0 + 2 * NGW < NTOK) MOD0_LOAD(xn, r0 + 2 * NGW);
#pragma unroll
        for (int q = 0; q < 2; ++q)
#pragma unroll
            for (int j = 0; j < 4; ++j) { const int c = 4 * (lane + 64 * j); const f32x4 sh = shv[q][j], sc = scv[q][j];
                const f32x4 y = (xv[q][j] * (sc + 1.0f) + sh) * SC_A0; *(unsigned*)((unsigned char*)X + (size_t)(r0 + q) * 1024 + c) = pack_fp8x4(y[0], y[1], y[2], y[3]); }
#pragma unroll
        for (int q = 0; q < 2; ++q)
#pragma unroll
            for (int j = 0; j < 4; ++j) xv[q][j] = xn[q][j];
    }
#undef MOD0_LOAD
}

__device__ __forceinline__ void phase_norm0(const Args& a, int lane, int wave) {
    const int gw = blockIdx.x * NWAVES + wave, NGW = gridDim.x * NWAVES;
    const bf16* Z = (const bf16*)(a.ws + WS_Z); bf16* CQN = (bf16*)(a.ws + WS_CQN); bf16* CKVN = (bf16*)(a.ws + WS_CKVN); bf16* KRR = (bf16*)(a.ws + WS_KRR);
    const float* rope = (const float*)(a.ws + WS_ROPE);
    float gq[8], gk[8];
#pragma unroll
    for (int i = 0; i < 8; ++i) { gq[i] = lane < 48 ? a.in[I_QNORM][8 * lane + i] : 0.f; gk[i] = lane < 32 ? a.in[I_KVNORM][8 * lane + i] : 0.f; }
    bf16x8 q8 = {}, k8 = {}, r8 = {}, nq8 = {}, nk8 = {}, nr8 = {};
#define N0_LOAD(dq, dk, dr, r_) do { const bf16* z_ = Z + (size_t)(r_) * ZC; if (lane < 48) dq = *(const bf16x8*)(z_ + ZQ + 8 * lane); if (lane < 32) dk = *(const bf16x8*)(z_ + ZKV + 8 * lane); if (lane < 4) dr = *(const bf16x8*)(z_ + ZKR + 8 * lane); } while (0)
    if (gw < NTOK) N0_LOAD(q8, k8, r8, gw);
    for (int r = gw; r < NTOK; r += NGW, q8 = nq8, k8 = nk8, r8 = nr8) {
        const int p = r % TPB;
        if (r + NGW < NTOK) N0_LOAD(nq8, nk8, nr8, r + NGW);
        float qf[8], kf[8], sq = 0.f, sk = 0.f;
#pragma unroll
        for (int i = 0; i < 8; ++i) { qf[i] = bf2f((unsigned short)q8[i]); kf[i] = bf2f((unsigned short)k8[i]); sq += qf[i] * qf[i]; sk += kf[i] * kf[i]; }
        sq = wave_sum(sq); sk = wave_sum(sk);
        const float rq = rsqrtf(sq * (1.f / 384.f) + RMS_EPS), rk = rsqrtf(sk * (1.f / 256.f) + RMS_EPS);
        if (lane < 48) { v4u o; o.x = pk2(qf[0] * rq * gq[0], qf[1] * rq * gq[1]); o.y = pk2(qf[2] * rq * gq[2], qf[3] * rq * gq[3]); o.z = pk2(qf[4] * rq * gq[4], qf[5] * rq * gq[5]); o.w = pk2(qf[6] * rq * gq[6], qf[7] * rq * gq[7]);
            *(v4u*)(CQN + (size_t)r * 384 + 8 * lane) = o; }
        if (lane < 32) { v4u o; o.x = pk2(kf[0] * rk * gk[0], kf[1] * rk * gk[1]); o.y = pk2(kf[2] * rk * gk[2], kf[3] * rk * gk[3]); o.z = pk2(kf[4] * rk * gk[4], kf[5] * rk * gk[5]); o.w = pk2(kf[6] * rk * gk[6], kf[7] * rk * gk[7]);
            *(v4u*)(CKVN + (size_t)r * 256 + 8 * lane) = o; }
        if (lane < 4) { bf16x8 o8 = r8; if (p >= CTXL) o8 = att::rope8(r8, rope + (size_t)(p - CTXL) * 32, 4 * lane); *(bf16x8*)(KRR + (size_t)r * 32 + 8 * lane) = o8; }
    }
#undef N0_LOAD
}

__device__ __forceinline__ void hgrn_unit(const Args& a, int unit, LAS unsigned char* lds, int tid) {
    const int b = unit >> 5, head = (unit >> 3) & 3, dir = (unit >> 2) & 1, sl = unit & 3;
    const bf16* Z = (const bf16*)(a.ws + WS_Z);
    float* Od = (float*)(a.ws + (dir ? WS_OB : WS_OF));
    LAS float* lbv = (LAS float*)lds;
    constexpr int BUF0 = 1024, BUFSZ = 28672, OFF_Q = 16384, OFF_V = 24576;
    if (tid < 128) { const int c = head * 128 + tid; const float l0 = a.in[I_LBL][c], l1 = a.in[I_LBL][512 + c], l2 = a.in[I_LBL][1024 + c]; const float m = fmaxf(l0, fmaxf(l1, l2));
        const float e0 = __expf(l0 - m), e1 = __expf(l1 - m), e2 = __expf(l2 - m); lbv[tid] = e0 / (e0 + e1 + e2); }
    __syncthreads();
    const int lt = tid >> 4, lcg = tid & 15;
    float lb8[8];
#pragma unroll
    for (int i = 0; i < 8; ++i) lb8[i] = lbv[8 * lcg + i];
    const int fcol = (dir ? ZHB : ZHF) + head * 128 + 8 * lcg, qcol = ZHQ + head * 128 + 8 * lcg;
    const int vt = tid >> 2, vcol = ZHI + head * 128 + sl * 32 + (tid & 3) * 8;
    const int wave = tid >> 6, lane = tid & 63, vv = lane >> 4, cg = lane & 15, vloc = wave * 4 + vv;
    const size_t zb = (size_t)b * TPB;
    bf16x8 rq, rf, rv;
#define TOKP(n) (dir ? ((n) < CTXL ? (CTXL - 1 - (n)) : (TPB + CTXL - 1 - (n))) : (n))
#define HG_LOAD(i) do { const int n_ = 32 * (i) + lt; const bf16* zr_ = Z + (zb + TOKP(n_)) * ZC; rq = *(const bf16x8*)(zr_ + qcol); rf = *(const bf16x8*)(zr_ + fcol); \
        if (tid < 128) { const int n2_ = 32 * (i) + vt; rv = *(const bf16x8*)(Z + (zb + TOKP(n2_)) * ZC + vcol); } } while (0)
#define HG_WRITE(bufi) do { LAS unsigned char* bp_ = lds + BUF0 + (bufi) * BUFSZ; float f_[8]; \
        _Pragma("unroll") for (int i_ = 0; i_ < 8; ++i_) f_[i_] = lb8[i_] + (1.f - lb8[i_]) * sigm(bf2f((unsigned short)rf[i_])); \
        *(LAS f32x4*)(bp_ + ((lt * 128 + lcg * 4) * 4)) = (f32x4){f_[0], f_[1], f_[2], f_[3]}; *(LAS f32x4*)(bp_ + ((lt * 128 + 64 + lcg * 4) * 4)) = (f32x4){f_[4], f_[5], f_[6], f_[7]}; \
        *(LAS bf16x8*)(bp_ + OFF_Q + (lt * 128 + lcg * 8) * 2) = rq; \
        if (tid < 128) { float v_[8]; _Pragma("unroll") for (int i_ = 0; i_ < 8; ++i_) v_[i_] = bf2f((unsigned short)rv[i_]); \
            *(LAS f32x4*)(bp_ + OFF_V + (vt * 32 + (tid & 3) * 8) * 4) = (f32x4){v_[0], v_[1], v_[2], v_[3]}; *(LAS f32x4*)(bp_ + OFF_V + (vt * 32 + (tid & 3) * 8 + 4) * 4) = (f32x4){v_[4], v_[5], v_[6], v_[7]}; } } while (0)
    float S[8];
#pragma unroll
    for (int j = 0; j < 8; ++j) S[j] = 0.f;
    HG_LOAD(0); HG_WRITE(0); __syncthreads();
    const bool b3 = (cg & 8) != 0, b2 = (cg & 4) != 0, b1 = (cg & 2) != 0, b0 = (cg & 1) != 0;
    for (int i = 0; i < TPB / 32; ++i) {
        if (i + 1 < TPB / 32) HG_LOAD(i + 1);
        const LAS unsigned char* bp = lds + BUF0 + (i & 1) * BUFSZ;
#pragma unroll 1
        for (int g = 0; g < 4; ++g) {
            const LAS unsigned char* gp = bp + g * 8 * 512;
            float ot[8];
#pragma unroll
            for (int t = 0; t < 8; ++t) {
                const f32x4 f0 = *(const LAS f32x4*)(gp + ((t * 128 + cg * 4) * 4)), f1 = *(const LAS f32x4*)(gp + ((t * 128 + 64 + cg * 4) * 4));
                const bf16x8 q8 = *(const LAS bf16x8*)(bp + OFF_Q + ((g * 8 + t) * 128 + cg * 8) * 2);
                const float v = *(const LAS float*)(bp + OFF_V + ((g * 8 + t) * 32 + vloc) * 4);
                float acc = 0.f;
#pragma unroll
                for (int j = 0; j < 8; ++j) { const float fj = j < 4 ? f0[j] : f1[j - 4]; const float qj = bf2f((unsigned short)q8[j]);
                    const float kv = fmaf(-fj, v, v); S[j] = fmaf(fj, S[j], kv); acc = fmaf(S[j], qj, acc); }
                ot[t] = acc;
            }
#pragma unroll
            for (int k = 0; k < 4; ++k) { const float snd = b3 ? ot[k] : ot[k + 4]; const float rcv = __shfl_xor(snd, 8); ot[k] = (b3 ? ot[k + 4] : ot[k]) + rcv; }
#pragma unroll
            for (int k = 0; k < 2; ++k) { const float snd = b2 ? ot[k] : ot[k + 2]; const float rcv = __shfl_xor(snd, 4); ot[k] = (b2 ? ot[k + 2] : ot[k]) + rcv; }
            { const float snd = b1 ? ot[0] : ot[1]; const float rcv = __shfl_xor(snd, 2); ot[0] = (b1 ? ot[1] : ot[0]) + rcv; }
            ot[0] += __shfl_xor(ot[0], 1);
            if (!b0) { const int n = 32 * i + 8 * g + (cg >> 1); const int p = TOKP(n); if (p >= CTXL) Od[(zb + p) * 512 + head * 128 + sl * 32 + vloc] = ot[0]; }
        }
        if (i + 1 < TPB / 32) HG_WRITE((i + 1) & 1);
        __syncthreads();
    }
#undef TOKP
#undef HG_LOAD
#undef HG_WRITE
}

__device__ __forceinline__ void phase_readout(const Args& a, int lane, int wave) {
    const int gw = blockIdx.x * NWAVES + wave, NGW = gridDim.x * NWAVES;
    const bf16* OF = (const bf16*)(a.ws + WS_OF); const bf16* OB = (const bf16*)(a.ws + WS_OB);
    const bf16* Z = (const bf16*)(a.ws + WS_Z); bf16* MIX = (bf16*)(a.ws + WS_Y);
    float hn[8];
#pragma unroll
    for (int i = 0; i < 8; ++i) hn[i] = a.in[I_HGNORM][((8 * lane) & 127) + i];
    bf16x8 a8 = {}, c8 = {}, g8 = {}, na8 = {}, nc8 = {}, ng8 = {};
#define RO_LOAD(da, dc, dg, lr_) do { const size_t r_ = (size_t)grow_of(lr_); da = *(const bf16x8*)(OF + r_ * 512 + 8 * lane); dc = *(const bf16x8*)(OB + r_ * 512 + 8 * lane); dg = *(const bf16x8*)(Z + r_ * ZC + ZHG + 8 * lane); } while (0)
    if (gw < NLAT) RO_LOAD(a8, c8, g8, gw);
    for (int lr = gw; lr < NLAT; lr += NGW, a8 = na8, c8 = nc8, g8 = ng8) {
        const size_t r = (size_t)grow_of(lr);
        if (lr + NGW < NLAT) RO_LOAD(na8, nc8, ng8, lr + NGW);
        float o[8]; float ss = 0.f;
#pragma unroll
        for (int i = 0; i < 8; ++i) o[i] = bf2f((unsigned short)a8[i]) + bf2f((unsigned short)c8[i]);
#pragma unroll
        for (int i = 0; i < 8; ++i) ss += o[i] * o[i];
        ss += __shfl_xor(ss, 1); ss += __shfl_xor(ss, 2); ss += __shfl_xor(ss, 4); ss += __shfl_xor(ss, 8);
        const float rs = rsqrtf(ss * (1.f / 128.f) + RMS_EPS);
        float y[8];
#pragma unroll
        for (int i = 0; i < 8; ++i) { const float g = bf2f((unsigned short)g8[i]); y[i] = o[i] * rs * hn[i] * (g * sigm(g)); }
        v4u w; w.x = pk2(y[0], y[1]); w.y = pk2(y[2], y[3]); w.z = pk2(y[4], y[5]); w.w = pk2(y[6], y[7]);
        *(v4u*)(MIX + r * 1024 + 512 + 8 * lane) = w;
    }
#undef RO_LOAD
}

__device__ __forceinline__ int rows_per_block() { const int G = gridDim.x; return (((NLAT + G - 1) / G) + 15) & ~15; }
__device__ __forceinline__ void phase_ln1(const Args& a, int l, LAS unsigned char* lds, int tid, int lane, int wave) {
    typedef short bf16x8s __attribute__((ext_vector_type(8)));
    const int RB = rows_per_block(), lr_base = blockIdx.x * RB;
    const bf16* PRE = (const bf16*)(a.ws + WS_PRE); bf16* XB = (bf16*)(a.ws + WS_X);
    const float* modv = (const float*)(a.ws + WS_MODV) + (size_t)l * 9 * 6144;
    const float* lng = a.in[I_LN1G] + l * 1024; const float* lnb = a.in[I_LN1B] + l * 1024;
    const float* rw = a.in[I_RW] + (size_t)l * 1024 * 32; const float* rb = a.in[I_RB] + l * 32;
    constexpr int XT_LD = 1028, O_PART = 16 * XT_LD * 4, O_LG = O_PART + 8 * 32 * 16 * 4, O_HIST = O_LG + 256 * 33 * 4 + 64, O_CCNT = O_HIST + 256, O_TIL = O_CCNT + 2048, O_TWL = O_TIL + 4096;
    LAS float* XT = (LAS float*)lds; LAS float* PART = (LAS float*)(lds + O_PART); LAS float* LG = (LAS float*)(lds + O_LG);
    LAS int* hist = (LAS int*)(lds + O_HIST);
    LAS int* ccnt = (LAS int*)(lds + O_CCNT);
    LAS int* til = (LAS int*)(lds + O_TIL);
    LAS float* twl = (LAS float*)(lds + O_TWL);
    __syncthreads();
    if (tid < 32) hist[tid] = 0;
    bf16x8s whi[2][4], wlo[2][4];
    { const int e15 = lane & 15, kq = lane >> 4;
#pragma unroll
      for (int t = 0; t < 2; ++t)
#pragma unroll
          for (int sI = 0; sI < 4; ++sI) { float wv[8];
#pragma unroll
              for (int j = 0; j < 8; ++j) wv[j] = rw[(size_t)(128 * wave + 32 * sI + 8 * kq + j) * 32 + 16 * t + e15];
              v4u ph, pl;
#pragma unroll
              for (int j = 0; j < 4; ++j) { const unsigned p = pk2(wv[2 * j], wv[2 * j + 1]); const float h0 = __uint_as_float(p << 16), h1 = __uint_as_float(p & 0xffff0000u); ph[j] = p; pl[j] = pk2(wv[2 * j] - h0, wv[2 * j + 1] - h1); }
              whi[t][sI] = __builtin_bit_cast(bf16x8s, ph); wlo[t][sI] = __builtin_bit_cast(bf16x8s, pl); } }
    const int ngroups = RB / 16;
    f32x4 fP[4], fQ[4]; int fb = -1;
    const float rbias = rb[tid >> 4];
    v2u xr[2][4];
#define LN1_LOAD(g) do { _Pragma("unroll") for (int rr_ = 0; rr_ < 2; ++rr_) { const int lr_ = lr_base + 16 * (g) + 2 * wave + rr_; const size_t r_ = (size_t)grow_of(lr_ < NLAT ? lr_ : NLAT - 1); \
        _Pragma("unroll") for (int j_ = 0; j_ < 4; ++j_) xr[rr_][j_] = *(const v2u*)(PRE + r_ * 1024 + 4 * (lane + 64 * j_)); } } while (0)
#if defined(PROBE_LN1X2)
    for (int rep_ = 0; rep_ < 2; ++rep_) { __syncthreads(); if (tid < 32) hist[tid] = 0; __syncthreads();
#endif
    LN1_LOAD(0);
    for (int g = 0; g < ngroups; ++g) {
#pragma unroll
        for (int rr = 0; rr < 2; ++rr) {
            const int lr = lr_base + 16 * g + 2 * wave + rr; const bool ok = lr < NLAT; const size_t r = (size_t)grow_of(ok ? lr : NLAT - 1); const int b = (ok ? lr : NLAT - 1) >> 12;
            if (b != fb) { const float* mv = modv + (size_t)b * 6144; fb = b;
#pragma unroll
                for (int j = 0; j < 4; ++j) { const int c = 4 * (lane + 64 * j); const f32x4 gg = *(const f32x4*)(lng + c), bb = *(const f32x4*)(lnb + c), sh = *(const f32x4*)(mv + 3 * 1024 + c), sc = *(const f32x4*)(mv + 4 * 1024 + c);
                    fP[j] = gg * (sc + 1.0f); fQ[j] = bb * (sc + 1.0f) + sh; } }
            f32x4 x[4]; float s = 0.f;
#pragma unroll
            for (int j = 0; j < 4; ++j) { const v2u p = xr[rr][j]; x[j] = (f32x4){__uint_as_float(p.x << 16), __uint_as_float(p.x & 0xffff0000u), __uint_as_float(p.y << 16), __uint_as_float(p.y & 0xffff0000u)}; s += (x[j][0] + x[j][1]) + (x[j][2] + x[j][3]); }
            const float mean = wave_sum(s) * (1.f / 1024.f); float s2 = 0.f;
#pragma unroll
            for (int j = 0; j < 4; ++j) { x[j] = x[j] - mean; s2 += (x[j][0] * x[j][0] + x[j][1] * x[j][1]) + (x[j][2] * x[j][2] + x[j][3] * x[j][3]); }
            const float rstd = rsqrtf(wave_sum(s2) * (1.f / 1024.f) + LN_EPS);
#pragma unroll
            for (int j = 0; j < 4; ++j) { const int c = 4 * (lane + 64 * j);
                const f32x4 bm = (x[j] * rstd) * fP[j] + fQ[j];
                if (ok) *(unsigned*)((unsigned char*)XB + r * 1024 + c) = pack_fp8x4(bm[0] * SC_X8, bm[1] * SC_X8, bm[2] * SC_X8, bm[3] * SC_X8);
                *(LAS f32x4*)(XT + (2 * wave + rr) * XT_LD + c) = bm; }
        }
        if (g + 1 < ngroups) LN1_LOAD(g + 1);
        __syncthreads();
        { const int rr = lane & 15, kq = lane >> 4;
          f32x4 acc0 = {0.f, 0.f, 0.f, 0.f}, acc1 = {0.f, 0.f, 0.f, 0.f};
#pragma unroll
          for (int sI = 0; sI < 4; ++sI) { const LAS float* xp = XT + rr * XT_LD + 128 * wave + 32 * sI + 8 * kq; const f32x4 v0 = *(const LAS f32x4*)xp, v1 = *(const LAS f32x4*)(xp + 4);
              const float bv[8] = {v0[0], v0[1], v0[2], v0[3], v1[0], v1[1], v1[2], v1[3]}; v4u ph, pl;
#pragma unroll
              for (int j = 0; j < 4; ++j) { const unsigned p = pk2(bv[2 * j], bv[2 * j + 1]); const float h0 = __uint_as_float(p << 16), h1 = __uint_as_float(p & 0xffff0000u); ph[j] = p; pl[j] = pk2(bv[2 * j] - h0, bv[2 * j + 1] - h1); }
              const bf16x8s bh = __builtin_bit_cast(bf16x8s, ph), bl = __builtin_bit_cast(bf16x8s, pl);
              acc0 = __builtin_amdgcn_mfma_f32_16x16x32_bf16(whi[0][sI], bh, acc0, 0, 0, 0); acc0 = __builtin_amdgcn_mfma_f32_16x16x32_bf16(whi[0][sI], bl, acc0, 0, 0, 0); acc0 = __builtin_amdgcn_mfma_f32_16x16x32_bf16(wlo[0][sI], bh, acc0, 0, 0, 0);
              acc1 = __builtin_amdgcn_mfma_f32_16x16x32_bf16(whi[1][sI], bh, acc1, 0, 0, 0); acc1 = __builtin_amdgcn_mfma_f32_16x16x32_bf16(whi[1][sI], bl, acc1, 0, 0, 0); acc1 = __builtin_amdgcn_mfma_f32_16x16x32_bf16(wlo[1][sI], bh, acc1, 0, 0, 0); }
#pragma unroll
          for (int q = 0; q < 4; ++q) { PART[(wave * 32 + 4 * kq + q) * 16 + rr] = acc0[q]; PART[(wave * 32 + 16 + 4 * kq + q) * 16 + rr] = acc1[q]; } }
        __syncthreads();
        { const int e = tid >> 4, rr = tid & 15; float sacc = rbias;
#pragma unroll
          for (int w = 0; w < 8; ++w) sacc += PART[(w * 32 + e) * 16 + rr];
          LG[(16 * g + rr) * 33 + e] = sacc; }
    }
#if defined(PROBE_LN1X2)
    }
#endif
#undef LN1_LOAD
    __syncthreads();
    { const int lrow = tid; const int lr = lr_base + lrow;
        if (lrow < RB) {
            if (lr < NLAT) { float lg[32];
#pragma unroll
                for (int e = 0; e < 32; ++e) lg[e] = LG[lrow * 33 + e];
                unsigned taken = 0u; float tv[4]; int ti[4];
#pragma unroll
                for (int kk = 0; kk < 4; ++kk) { float best = -3.0e38f; int bi = 0;
#pragma unroll
                    for (int e = 0; e < 32; ++e) { const bool okk = (lg[e] > best) && !((taken >> e) & 1u); best = okk ? lg[e] : best; bi = okk ? e : bi; }
                    taken |= 1u << bi; tv[kk] = best; ti[kk] = bi; }
                const float e1 = __expf(tv[1] - tv[0]), e2 = __expf(tv[2] - tv[0]), e3 = __expf(tv[3] - tv[0]); const float inv = 1.f / (1.f + e1 + e2 + e3);
                const int li = lrow * 4; til[li] = ti[0]; til[li + 1] = ti[1]; til[li + 2] = ti[2]; til[li + 3] = ti[3]; twl[li] = inv; twl[li + 1] = e1 * inv; twl[li + 2] = e2 * inv; twl[li + 3] = e3 * inv;
                __hip_atomic_fetch_add(hist + ti[0], 1, __ATOMIC_RELAXED, __HIP_MEMORY_SCOPE_WORKGROUP); __hip_atomic_fetch_add(hist + ti[1], 1, __ATOMIC_RELAXED, __HIP_MEMORY_SCOPE_WORKGROUP);
                __hip_atomic_fetch_add(hist + ti[2], 1, __ATOMIC_RELAXED, __HIP_MEMORY_SCOPE_WORKGROUP); __hip_atomic_fetch_add(hist + ti[3], 1, __ATOMIC_RELAXED, __HIP_MEMORY_SCOPE_WORKGROUP); } }
    }
    __syncthreads();
    int* cursor = (int*)(a.ws + WS_CURSOR) + l * 32;
    int* rows = (int*)(a.ws + WS_ROWS); float* roww = (float*)(a.ws + WS_ROWW); int* rowd = (int*)(a.ws + WS_ROWD);
    int nrows = NLAT - lr_base; nrows = nrows > RB ? RB : nrows; if (nrows < 0) nrows = 0;
    const int nas = nrows * 4, nchunks = (nas + 63) >> 6;
    int basev = 0; if (tid < 32) basev = (int)__hip_atomic_fetch_add((unsigned*)cursor + tid, (unsigned)hist[tid], __ATOMIC_RELAXED, __HIP_MEMORY_SCOPE_AGENT);
    int myrank[2] = {0, 0}, mye[2] = {-1, -1};
#pragma unroll
    for (int cc = 0; cc < 2; ++cc) { const int c = wave + 8 * cc; if (c < nchunks) { const int idx = c * 64 + lane; const int e = idx < nas ? til[idx] : -1; mye[cc] = e;
        for (int x = 0; x < 32; ++x) { const unsigned long long m = __ballot(e == x); if (e == x) myrank[cc] = __popcll(m & ((1ull << lane) - 1ull)); if (lane == 0) ccnt[c * 32 + x] = __popcll(m); } } }
    __syncthreads();
    if (tid < 32) hist[32 + tid] = basev;
    __syncthreads();
#pragma unroll
    for (int cc = 0; cc < 2; ++cc) { const int c = wave + 8 * cc; const int idx = c * 64 + lane; if (c < nchunks && idx < nas) { const int e = mye[cc]; int pos = hist[32 + e] + myrank[cc]; for (int c2 = 0; c2 < c; ++c2) pos += ccnt[c2 * 32 + e];
        const int lr = lr_base + (idx >> 2); const size_t pi = (size_t)e * ECAP + pos; rows[pi] = grow_of(lr); roww[pi] = twl[idx]; rowd[pi] = lr * 4 + (idx & 3); } }
}

__device__ __forceinline__ void phase_ln2(const Args& a, int l, int lane, int wave) {
    const int gw = blockIdx.x * NWAVES + wave, NGW = gridDim.x * NWAVES;
    float* H = (float*)(a.ws + WS_H); const bf16* PRE = (const bf16*)(a.ws + WS_PRE); const unsigned char* YB = (const unsigned char*)(a.ws + WS_YB); bf16* A1 = (bf16*)(a.ws + WS_Y);
    const float* modv = (const float*)(a.ws + WS_MODV);
    const float* ln1g = a.in[I_LN1G] + l * 1024; const float* ln1b = a.in[I_LN1B] + l * 1024;
    const float* lng = a.in[I_LN2G] + l * 1024; const float* lnb = a.in[I_LN2B] + l * 1024;
    f32x4 P1[4], Q1[4], G2[4], g2v[4], b2v[4], P3[4], Q3[4]; int fb = -1;
    const int rows_w = (((NLAT + NGW - 1) / NGW) + 1) & ~1, lr_lo = gw * rows_w, lr_hi = lr_lo + rows_w < NLAT ? lr_lo + rows_w : NLAT;
    for (int lr0 = lr_lo; lr0 < lr_hi; lr0 += 2) {
        v2u hv[2][4]; unsigned yv[2][4][4];
#pragma unroll
        for (int q = 0; q < 2; ++q) { const int lr = lr0 + q; const size_t r = (size_t)grow_of(lr);
#pragma unroll
            for (int j = 0; j < 4; ++j) { const int c = 4 * (lane + 64 * j); hv[q][j] = *(const v2u*)(PRE + r * 1024 + c);
#pragma unroll
                for (int k = 0; k < 4; ++k) yv[q][j][k] = *(const unsigned*)(YB + ((size_t)lr * 4 + k) * 1024 + c); } }
#pragma unroll
        for (int q = 0; q < 2; ++q) {
            const int lr = lr0 + q; const size_t r = (size_t)grow_of(lr); const int b = lr >> 12;
            if (b != fb) { fb = b; const float* mv = modv + ((size_t)l * 9 + b) * 6144; const float* mv1 = modv + ((size_t)9 + b) * 6144;
#pragma unroll
                for (int j = 0; j < 4; ++j) { const int c = 4 * (lane + 64 * j); const f32x4 g1 = *(const f32x4*)(ln1g + c), b1 = *(const f32x4*)(ln1b + c), gt = *(const f32x4*)(mv + 5 * 1024 + c);
                    P1[j] = g1 * ALPHA; Q1[j] = b1 * ALPHA; G2[j] = gt * (1.f / SC_Y); g2v[j] = *(const f32x4*)(lng + c); b2v[j] = *(const f32x4*)(lnb + c);
                    if (l == 0) { const f32x4 sh = *(const f32x4*)(mv1 + c), sc = *(const f32x4*)(mv1 + 1024 + c); P3[j] = g2v[j] * (sc + 1.0f) * SC_A1; Q3[j] = (b2v[j] * (sc + 1.0f) + sh) * SC_A1; } } }
            f32x4 x[4]; float s = 0.f;
#pragma unroll
            for (int j = 0; j < 4; ++j) { const v2u p = hv[q][j]; x[j] = (f32x4){__uint_as_float(p.x << 16), __uint_as_float(p.x & 0xffff0000u), __uint_as_float(p.y << 16), __uint_as_float(p.y & 0xffff0000u)}; s += (x[j][0] + x[j][1]) + (x[j][2] + x[j][3]); }
            float mean = wave_sum(s) * (1.f / 1024.f), s2 = 0.f;
#pragma unroll
            for (int j = 0; j < 4; ++j) { x[j] = x[j] - mean; s2 += (x[j][0] * x[j][0] + x[j][1] * x[j][1]) + (x[j][2] * x[j][2] + x[j][3] * x[j][3]); }
            float rstd = rsqrtf(wave_sum(s2) * (1.f / 1024.f) + LN_EPS);
            s = 0.f;
#pragma unroll
            for (int j = 0; j < 4; ++j) { f32x4 f = {0.f, 0.f, 0.f, 0.f};
#pragma unroll
                for (int k = 0; k < 4; ++k) { const unsigned y = yv[q][j][k]; const auto lo = __builtin_amdgcn_cvt_pk_f32_fp8((int)y, false), hi = __builtin_amdgcn_cvt_pk_f32_fp8((int)y, true);
                    f[0] += lo[0]; f[1] += lo[1]; f[2] += hi[0]; f[3] += hi[1]; }
                x[j] = (x[j] * rstd) * P1[j] + Q1[j] + G2[j] * f; s += (x[j][0] + x[j][1]) + (x[j][2] + x[j][3]); }
            mean = wave_sum(s) * (1.f / 1024.f); s2 = 0.f;
#pragma unroll
            for (int j = 0; j < 4; ++j) { x[j] = x[j] - mean; s2 += (x[j][0] * x[j][0] + x[j][1] * x[j][1]) + (x[j][2] * x[j][2] + x[j][3] * x[j][3]); }
            rstd = rsqrtf(wave_sum(s2) * (1.f / 1024.f) + LN_EPS);
#pragma unroll
            for (int j = 0; j < 4; ++j) { const int c = 4 * (lane + 64 * j); const f32x4 xh = x[j] * rstd;
                const f32x4 o = xh * g2v[j] + b2v[j];
                if (l == 0) { v2u hw; hw.x = pk2(o[0], o[1]); hw.y = pk2(o[2], o[3]); *(v2u*)((bf16*)H + r * 1024 + c) = hw;
                    const f32x4 am = xh * P3[j] + Q3[j]; *(unsigned*)((unsigned char*)A1 + r * 1024 + c) = pack_fp8x4(am[0], am[1], am[2], am[3]); }
                else *(f32x4*)(a.out + (size_t)lr * 1024 + c) = o; }
        }
    }
}

__device__ __forceinline__ void phase_conv(const Args& a, LAS unsigned char* lds, int tid, int lane, int wave) {
    const bf16* U = (const bf16*)(a.ws + WS_X); bf16* V = (bf16*)(a.ws + WS_Y);
    LAS float* part = (LAS float*)(lds + 126976);
    LAS float* st = part + 512;
    const int c0 = 2 * tid;
    const float db0 = a.in[I_DWB][c0], db1 = a.in[I_DWB][c0 + 1], g0 = a.in[I_CLNG][c0], g1 = a.in[I_CLNG][c0 + 1], be0 = a.in[I_CLNB][c0], be1 = a.in[I_CLNB][c0 + 1];
    for (int tile = blockIdx.x; tile < NLAT / 32; tile += gridDim.x) {
        const int b = tile >> 7, t0 = (tile & 127) * 32;
        const size_t rb0 = (size_t)b * TPB + CTXL;
        __syncthreads();
        for (int i = tid; i < 62 * 128; i += NTHR) { const int row = i >> 7, chk = i & 127, t = t0 - 15 + row;
            v4u val = {0u, 0u, 0u, 0u}; if (t >= 0 && t < SEQ) val = *(const v4u*)(U + (rb0 + t) * 1024 + chk * 8);
            *(LAS v4u*)(lds + row * 2048 + chk * 16) = val; }
        __syncthreads();
        typedef float f32x2_t __attribute__((ext_vector_type(2)));
        f32x2_t w01[31];
#pragma unroll
        for (int j = 0; j < 31; ++j) w01[j] = *(const f32x2_t*)(a.in[I_DWW] + j * 1024 + c0);
#pragma unroll 1
        for (int hh = 0; hh < 2; ++hh) {
            const LAS unsigned char* hp = lds + hh * 16 * 2048;
            f32x2_t acc01[16];
#pragma unroll
            for (int t = 0; t < 16; ++t) acc01[t] = (f32x2_t){db0, db1};
#pragma unroll
            for (int s = 0; s < 46; ++s) { const unsigned pr = *(const LAS unsigned*)(hp + s * 2048 + tid * 4); const f32x2_t x01 = {__uint_as_float(pr << 16), __uint_as_float(pr & 0xffff0000u)};
#pragma unroll
                for (int t = (s > 30 ? s - 30 : 0); t <= (s < 15 ? s : 15); ++t) acc01[t] = __builtin_elementwise_fma(x01, w01[s - t], acc01[t]); }
            float acc0[16], acc1[16];
#pragma unroll
            for (int t = 0; t < 16; ++t) { acc0[t] = acc01[t].x; acc1[t] = acc01[t].y; }
            float rs[32];
#pragma unroll
            for (int t = 0; t < 16; ++t) { rs[2 * t] = acc0[t] + acc1[t]; rs[2 * t + 1] = acc0[t] * acc0[t] + acc1[t] * acc1[t]; }
#define RS_STEP(NKEEP, XORV) { const bool bit_ = (lane & XORV) != 0; _Pragma("unroll") for (int k_ = 0; k_ < NKEEP; ++k_) { const float snd_ = bit_ ? rs[k_] : rs[k_ + NKEEP]; const float rcv_ = __shfl_xor(snd_, XORV); rs[k_] = (bit_ ? rs[k_ + NKEEP] : rs[k_]) + rcv_; } }
            RS_STEP(16, 32) RS_STEP(8, 16) RS_STEP(4, 8) RS_STEP(2, 4) RS_STEP(1, 2)
#undef RS_STEP
            rs[0] += __shfl_xor(rs[0], 1);
            __syncthreads();
            if ((lane & 1) == 0) part[wave * 32 + (lane >> 1)] = rs[0];
            __syncthreads();
            if (tid < 16) { float s1 = 0.f, s2 = 0.f;
#pragma unroll
                for (int w = 0; w < 8; ++w) { s1 += part[w * 32 + 2 * tid]; s2 += part[w * 32 + 2 * tid + 1]; }
                const float mean = s1 * (1.f / 1024.f); const float var = fmaxf(s2 * (1.f / 1024.f) - mean * mean, 0.f); st[2 * tid] = mean; st[2 * tid + 1] = rsqrtf(var + LN_EPS); }
            __syncthreads();
#pragma unroll
            for (int t = 0; t < 16; ++t) { const float mean = st[2 * t], rstd = st[2 * t + 1];
                const float y0 = (acc0[t] - mean) * rstd * g0 + be0, y1 = (acc1[t] - mean) * rstd * g1 + be1;
                const float z0 = fminf(fmaxf(y0 * sigm(y0) * SC_CV, -448.f), 448.f), z1 = fminf(fmaxf(y1 * sigm(y1) * SC_CV, -448.f), 448.f);
                *(unsigned short*)((unsigned char*)V + (rb0 + t0 + hh * 16 + t) * 1024 + c0) = (unsigned short)__builtin_amdgcn_cvt_pk_fp8_f32(z0, z1, 0, false); }
        }
    }
}

namespace hg {
using bf16x8 = __attribute__((ext_vector_type(8))) short;
using s16x4  = __attribute__((ext_vector_type(4))) short;
using f32x16 = __attribute__((ext_vector_type(16))) float;
using u32x4  = __attribute__((ext_vector_type(4))) unsigned;
constexpr int RS = 272;
constexpr int VS = 80;
constexpr int T_Q = 0, T_KO = 32 * RS, T_D = 64 * RS, IMG_BYTES = T_D + 512, T_V = IMG_BYTES, TILE_BYTES = T_V + 32 * VS;
constexpr int OFF_TILES = 1024, NTB = 3, OFF_OPART = OFF_TILES + NTB * TILE_BYTES, OPART_BYTES = 4 * 4096;
static_assert(OFF_OPART + 2 * OPART_BYTES <= 131072 && IMG_BYTES % 16 == 0 && IMG_BYTES / 16 == 1120, "hgrn lds");
constexpr int P_RAW = 1024, R_Q = 0, R_F = 32 * RS, RAW_BYTES = 64 * RS, P_IMG = P_RAW + RAW_BYTES;
constexpr int NCHUNK = TPB / 32, NCHAIN = NB * 4 * 2, NITEM = NCHAIN * NCHUNK;
__device__ __forceinline__ int crow(int r, int hi) { return (r & 3) + 8 * (r >> 2) + 4 * hi; }
__device__ __forceinline__ s16x4 tr_read(unsigned addr) { s16x4 r; asm volatile("ds_read_b64_tr_b16 %0, %1" : "=&v"(r) : "v"(addr) : "memory"); return r; }
__device__ __forceinline__ bf16x8 cat8(s16x4 l, s16x4 h) { return (bf16x8){l[0], l[1], l[2], l[3], h[0], h[1], h[2], h[3]}; }
__device__ __forceinline__ bf16x8 pack8(const f32x16& x, int base) {
    u32x4 w; w[0] = pk2(x[base + 0], x[base + 1]); w[1] = pk2(x[base + 2], x[base + 3]); w[2] = pk2(x[base + 4], x[base + 5]); w[3] = pk2(x[base + 6], x[base + 7]);
    return *reinterpret_cast<bf16x8*>(&w);
}
}


#define HG_TOKP(dir, n) ((dir) ? ((n) < CTXL ? (CTXL - 1 - (n)) : (TPB + CTXL - 1 - (n))) : (n))
#define HG_DPP1(x, ctrl, rmask) __int_as_float(__builtin_amdgcn_update_dpp(0x3f800000, __float_as_int(x), ctrl, rmask, 0xf, false))
#define HG_DPP(x, ctrl, rmask) __int_as_float(__builtin_amdgcn_update_dpp(0, __float_as_int(x), ctrl, rmask, 0xf, false))
__device__ __forceinline__ void hgrn_prep_items(const Args& a, LAS unsigned char* lds, int tid) {
    using namespace hg;
    const bf16* Z = (const bf16*)(a.ws + WS_Z);
    unsigned char* HT = a.ws + WS_HT;
    const int wave = __builtin_amdgcn_readfirstlane(tid >> 6), lane = tid & 63, t = lane & 31, half = lane >> 5;
    const int c0 = 16 * wave + 8 * half;
    const int lr = tid >> 4, lch = tid & 15;
    LAS float* lbt = (LAS float*)lds;
    constexpr int P_RAW2 = 2048, P_IMG2 = P_RAW2 + 2 * RAW_BYTES;
    static_assert(P_IMG2 + 2 * IMG_BYTES <= 131072, "prep lds");
    __syncthreads();
    { const float l0 = a.in[I_LBL][tid], l1 = a.in[I_LBL][512 + tid], l2 = a.in[I_LBL][1024 + tid]; const float m = fmaxf(l0, fmaxf(l1, l2));
      const float e0 = __expf(l0 - m), e1 = __expf(l1 - m), e2 = __expf(l2 - m); lbt[tid] = e0 / (e0 + e1 + e2); }
    bf16x8 gq, gf;
#define HP_LOAD(it) do { const int ch_ = (it) % NCHUNK, cn_ = (it) / NCHUNK, dir_ = cn_ & 1, hd_ = (cn_ >> 1) & 3, b_ = cn_ >> 3; \
        const bf16* zr_ = Z + ((size_t)b_ * TPB + HG_TOKP(dir_, 32 * ch_ + lr)) * ZC; gq = *(const bf16x8*)(zr_ + ZHQ + hd_ * 128 + lch * 8); gf = *(const bf16x8*)(zr_ + (dir_ ? ZHB : ZHF) + hd_ * 128 + lch * 8); } while (0)
#define HP_STASH(bufi) do { LAS unsigned char* rb_ = lds + P_RAW2 + (bufi) * RAW_BYTES; *(LAS bf16x8*)(rb_ + R_Q + lr * RS + lch * 16) = gq; *(LAS bf16x8*)(rb_ + R_F + lr * RS + lch * 16) = gf; } while (0)
#define HP_COPYOUT(item, bufi) do { v4u* dst_ = (v4u*)(HT + (size_t)(item) * IMG_BYTES); const LAS v4u* src_ = (const LAS v4u*)(lds + P_IMG2 + (bufi) * IMG_BYTES); \
        dst_[tid] = src_[tid]; dst_[tid + 512] = src_[tid + 512]; if (tid < 96) dst_[tid + 1024] = src_[tid + 1024]; } while (0)
    const int G = gridDim.x;
    int it = blockIdx.x, par = 0;
    if (it < NITEM) { HP_LOAD(it); HP_STASH(0); }
    if (it + G < NITEM) HP_LOAD(it + G);
    __syncthreads();
    for (; it < NITEM; it += G, par ^= 1) {
        if (it + G < NITEM) HP_STASH(par ^ 1);
        if (it != (int)blockIdx.x) HP_COPYOUT(it - G, par ^ 1);
        if (it + 2 * G < NITEM) HP_LOAD(it + 2 * G);
        const int hd = ((it / NCHUNK) >> 1) & 3;
        {
            const LAS unsigned char* rb_ = lds + P_RAW2 + par * RAW_BYTES;
            const bf16x8 RQ = *(const LAS bf16x8*)(rb_ + R_Q + t * RS + c0 * 2), RF = *(const LAS bf16x8*)(rb_ + R_F + t * RS + c0 * 2);
            const f32x4 lbA = *(const LAS f32x4*)(lbt + hd * 128 + c0), lbB = *(const LAS f32x4*)(lbt + hd * 128 + c0 + 4);
            LAS unsigned char* tb_ = lds + P_IMG2 + par * IMG_BYTES;
            float bb_[8], kk_[8];
#pragma unroll
            for (int i_ = 0; i_ < 8; ++i_) { const float lb_ = i_ < 4 ? lbA[i_] : lbB[i_ - 4]; const float f_ = lb_ + (1.f - lb_) * __builtin_amdgcn_rcpf(1.f + __expf(-bf2f((unsigned short)RF[i_]))); kk_[i_] = 1.f - f_; bb_[i_] = f_; }
#pragma unroll
            for (int i_ = 0; i_ < 8; ++i_) { float x_ = bb_[i_]; x_ *= HG_DPP1(x_, 0x111, 0xf); x_ *= HG_DPP1(x_, 0x112, 0xf); x_ *= HG_DPP1(x_, 0x114, 0xf); x_ *= HG_DPP1(x_, 0x118, 0xf);
                x_ *= HG_DPP1(x_, 0x142, 0xa); bb_[i_] = x_; }
            float qi_[8], ko_[8], dd_[8];
#pragma unroll
            for (int i_ = 0; i_ < 8; ++i_) { const int bi_ = __float_as_int(bb_[i_]); dd_[i_] = __int_as_float(half ? __builtin_amdgcn_readlane(bi_, 63) : __builtin_amdgcn_readlane(bi_, 31));
                const float e_ = bb_[i_]; const float ei_ = __builtin_amdgcn_rcpf(e_);
                qi_[i_] = bf2f((unsigned short)RQ[i_]) * e_; ko_[i_] = kk_[i_] * ei_; }
            *(LAS v4u*)(tb_ + T_Q + t * RS + c0 * 2) = (v4u){pk2(qi_[0], qi_[1]), pk2(qi_[2], qi_[3]), pk2(qi_[4], qi_[5]), pk2(qi_[6], qi_[7])};
            *(LAS v4u*)(tb_ + T_KO + t * RS + c0 * 2) = (v4u){pk2(ko_[0], ko_[1]), pk2(ko_[2], ko_[3]), pk2(ko_[4], ko_[5]), pk2(ko_[6], ko_[7])};
            if (t == 31) { *(LAS f32x4*)(tb_ + T_D + c0 * 4) = (f32x4){dd_[0], dd_[1], dd_[2], dd_[3]}; *(LAS f32x4*)(tb_ + T_D + c0 * 4 + 16) = (f32x4){dd_[4], dd_[5], dd_[6], dd_[7]}; }
            if (tid < 32) *(LAS v4u*)(tb_ + T_Q + tid * RS + 256) = (v4u){0u, 0u, 0u, 0u};
            else if (tid < 64) *(LAS v4u*)(tb_ + T_KO + (tid - 32) * RS + 256) = (v4u){0u, 0u, 0u, 0u};
        }
        __syncthreads();
    }
    if (it - G >= (int)blockIdx.x && it - G < NITEM) HP_COPYOUT(it - G, par ^ 1);
    __syncthreads();
#undef HP_COPYOUT
#undef HP_LOAD
#undef HP_STASH
}

__device__ __forceinline__ void hgrn_unit_mfma(const Args& a, int unit, LAS unsigned char* lds, int tid) {
    using namespace hg;
    const int b = unit >> 5, head = (unit >> 3) & 3, dir = (unit >> 2) & 1, sl = unit & 3;
    const bf16* Z = (const bf16*)(a.ws + WS_Z);
    const unsigned char* HT = a.ws + WS_HT + (size_t)((b * 4 + head) * 2 + dir) * NCHUNK * IMG_BYTES;
    bf16* Od = (bf16*)(a.ws + (dir ? WS_OB : WS_OF));
    const int wave = __builtin_amdgcn_readfirstlane(tid >> 6), lane = tid & 63;
    const size_t zb = (size_t)b * TPB;
    constexpr int NCH = NCHUNK;
    const int vr = (tid >> 2) & 31, vp = tid & 3, lvcol = ZHI + head * 128 + sl * 32 + vp * 8, i3 = 1024 + (tid < 96 ? tid : 0);
    v4u gA0, gA1, gA2, gB0, gB1, gB2; bf16x8 gAv, gBv;
#define HG_LOAD(g0, g1, g2, gv, ch) do { const int c_ = (ch) < NCH ? (ch) : NCH - 1; const v4u* src_ = (const v4u*)(HT + (size_t)c_ * IMG_BYTES); \
        g0 = src_[tid]; g1 = src_[tid + 512]; g2 = src_[i3]; gv = *(const bf16x8*)(Z + (zb + HG_TOKP(dir, 32 * c_ + vr)) * ZC + lvcol); } while (0)
#define HG_STASH(g0, g1, g2, gv, bufi) do { LAS unsigned char* tb_ = lds + OFF_TILES + (bufi) * TILE_BYTES; LAS v4u* d_ = (LAS v4u*)tb_; \
        d_[tid] = g0; d_[tid + 512] = g1; if (tid < 96) d_[tid + 1024] = g2; if (tid < 128) *(LAS bf16x8*)(tb_ + T_V + vr * VS + vp * 16) = gv; } while (0)
    const int r32 = lane & 31, hi = lane >> 5, g1 = (lane >> 4) & 1, q4 = (lane & 15) >> 2, p4 = lane & 3, cb = 32 * wave;
    const unsigned lbase = (unsigned)(uintptr_t)lds;
    f32x16 S = {};
    HG_LOAD(gA0, gA1, gA2, gAv, 0); HG_STASH(gA0, gA1, gA2, gAv, 0); HG_LOAD(gA0, gA1, gA2, gAv, 1); HG_STASH(gA0, gA1, gA2, gAv, 1);
    HG_LOAD(gA0, gA1, gA2, gAv, 2);
    __syncthreads();
#define HG_RD64(dst, addr, OFFS) asm volatile("ds_read_b64 %0, %1 offset:" #OFFS : "=&v"(dst) : "v"(addr) : "memory")
#define HG_MFMA_STAGE(n, bufi) do { \
            const unsigned tb = lbase + OFF_TILES + (bufi) * TILE_BYTES; const LAS unsigned char* tl_ = lds + OFF_TILES + (bufi) * TILE_BYTES; \
            bf16x8 ko[2], qi[2]; s16x4 pvl[2], pvh[2], pql[2], pqh[2], kl[2], kh[2], nvl[2], nvh[2]; f32x4 dsc[4]; \
            _Pragma("unroll") for (int kk = 0; kk < 2; ++kk) { ko[kk] = *(const LAS bf16x8*)(tl_ + T_KO + r32 * RS + (cb + 16 * kk + 8 * hi) * 2); qi[kk] = *(const LAS bf16x8*)(tl_ + T_Q + r32 * RS + (cb + 16 * kk + 8 * hi) * 2); } \
            _Pragma("unroll") for (int sp = 0; sp < 2; ++sp) { \
                const unsigned va = tb + T_V + (16 * sp + 4 * hi + q4) * VS + (16 * g1 + 4 * p4) * 2; pvl[sp] = tr_read(va); pvh[sp] = tr_read(va + 8 * VS);              \
                const unsigned qa = tb + T_Q + r32 * RS + (cb + 16 * sp + 4 * hi) * 2; HG_RD64(pql[sp], qa, 0); HG_RD64(pqh[sp], qa, 16);                                  \
                const unsigned ka = tb + T_KO + (16 * sp + 8 * hi + q4) * RS + (cb + 16 * g1 + 4 * p4) * 2; kl[sp] = tr_read(ka); kh[sp] = tr_read(ka + 4 * RS);        \
                const unsigned vb = tb + T_V + (16 * sp + 8 * hi + q4) * VS + (16 * g1 + 4 * p4) * 2; nvl[sp] = tr_read(vb); nvh[sp] = tr_read(vb + 4 * VS); }            \
            _Pragma("unroll") for (int g = 0; g < 4; ++g) dsc[g] = *(const LAS f32x4*)(tl_ + T_D + (cb + 8 * g + 4 * hi) * 4); \
            asm volatile("s_waitcnt lgkmcnt(0)" ::: "memory"); __builtin_amdgcn_sched_barrier(0); \
            f32x16 X = {}; \
            X = __builtin_amdgcn_mfma_f32_32x32x16_bf16(ko[0], qi[0], X, 0, 0, 0); X = __builtin_amdgcn_mfma_f32_32x32x16_bf16(ko[1], qi[1], X, 0, 0, 0); \
            f32x16 O = {}; \
            O = __builtin_amdgcn_mfma_f32_32x32x16_bf16(cat8(pql[0], pqh[0]), pack8(S, 0), O, 0, 0, 0); O = __builtin_amdgcn_mfma_f32_32x32x16_bf16(cat8(pql[1], pqh[1]), pack8(S, 8), O, 0, 0, 0); \
            S = __builtin_amdgcn_mfma_f32_32x32x16_bf16(cat8(kl[0], kh[0]), cat8(nvl[0], nvh[0]), S, 0, 0, 0); S = __builtin_amdgcn_mfma_f32_32x32x16_bf16(cat8(kl[1], kh[1]), cat8(nvl[1], nvh[1]), S, 0, 0, 0); \
            _Pragma("unroll") for (int i = 0; i < 16; ++i) X[i] = (crow(i, hi) <= r32) ? X[i] : 0.f; \
            O = __builtin_amdgcn_mfma_f32_32x32x16_bf16(pack8(X, 0), cat8(pvl[0], pvh[0]), O, 0, 0, 0); O = __builtin_amdgcn_mfma_f32_32x32x16_bf16(pack8(X, 8), cat8(pvl[1], pvh[1]), O, 0, 0, 0); \
            _Pragma("unroll") for (int i = 0; i < 16; ++i) S[i] *= dsc[i >> 2][i & 3]; \
            LAS float* op = (LAS float*)(lds + OFF_OPART + ((n) & 1) * OPART_BYTES + wave * 4096); \
            _Pragma("unroll") for (int i = 0; i < 16; ++i) op[crow(i, hi) * 32 + r32] = O[i]; } while (0)
#define HG_OUT_STAGE(n) do { \
            const int l2 = tid - 256, tt = l2 >> 3, vq = l2 & 7; \
            const LAS float* op = (const LAS float*)(lds + OFF_OPART + (((n) - 1) & 1) * OPART_BYTES) + tt * 32 + vq * 4; \
            const f32x4 s = (*(const LAS f32x4*)op + *(const LAS f32x4*)(op + 1024)) + (*(const LAS f32x4*)(op + 2048) + *(const LAS f32x4*)(op + 3072)); \
            const int p = HG_TOKP(dir, 32 * ((n) - 1) + tt); \
            if (p >= CTXL) *(v2u*)(Od + (zb + p) * 512 + head * 128 + sl * 32 + vq * 4) = (v2u){pk2(s[0], s[1]), pk2(s[2], s[3])}; } while (0)
#define HG_ITER(n, L0, L1, L2, LV, S0, S1, S2, SV) do { \
        HG_LOAD(L0, L1, L2, LV, (n) + 3); \
        if (wave < 4) { HG_MFMA_STAGE(n, bcur); } else if ((n) > 0) { HG_OUT_STAGE(n); } \
        { const int bst_ = bcur == 0 ? 2 : bcur - 1; HG_STASH(S0, S1, S2, SV, bst_); } \
        bcur = bcur == 2 ? 0 : bcur + 1; \
        __syncthreads(); } while (0)
    int bcur = 0;
    for (int n = 0; n < NCH; n += 2) {
        HG_ITER(n, gB0, gB1, gB2, gBv, gA0, gA1, gA2, gAv);
        HG_ITER(n + 1, gA0, gA1, gA2, gAv, gB0, gB1, gB2, gBv);
    }
    if (wave >= 4) { HG_OUT_STAGE(NCH); }
    __syncthreads();
#undef HG_MFMA_STAGE
#undef HG_OUT_STAGE
#undef HG_ITER
#undef HG_LOAD
#undef HG_STASH
#undef HG_RD64
}

__device__ __forceinline__ bool in_range(int lo, int hi, int k) { asm volatile("" : "+s"(lo), "+s"(hi)); return lo <= k && k < hi; }
constexpr int NPHASES = 21;
__global__ void __launch_bounds__(NTHR, 2) fwd_kernel(Args args) {
    extern __shared__ __attribute__((aligned(16))) unsigned char lds_raw[];
    LAS unsigned char* lds = (LAS unsigned char*)lds_raw;
    const int G = gridDim.x;
#define FRESH() int tid = threadIdx.x; asm volatile("" : "+v"(tid)); const int lane = tid & 63, wave = __builtin_amdgcn_readfirstlane(tid >> 6); (void)lane; (void)wave
    unsigned char* ws = args.ws;
    if (threadIdx.x < 16) ((LAS unsigned*)(lds + LDS_BAR_OFF))[threadIdx.x] = 0u;
    __syncthreads();
    XcdBarrier bar = xcd_barrier_post((unsigned*)(ws + WS_CTL), (volatile LAS unsigned*)(lds + LDS_BAR_OFF));
    const int lo = args.ph_lo, hi = args.ph_hi;
#define IN(k) in_range(lo, hi, (k))
#define NREP(k) (((PROBE_MASK >> (k)) & 1u) ? 2 : 1)
#define REPEAT(k) for (int rep_ = 0; rep_ < NREP(k); ++rep_) if (rep_ == 0 || (xcd_barrier(bar), true))
#define SEAM(k) do { if (IN(k) && IN((k) + 1)) xcd_barrier(bar); } while (0)
    bf16* const BX = (bf16*)(ws + WS_X); bf16* const BY = (bf16*)(ws + WS_Y);
    const float* const MODV = (const float*)(ws + WS_MODV);

#if defined(PROBE_BARS)
    for (int pbi = 0; pbi < PROBE_BARS; ++pbi) xcd_barrier(bar);
#endif
    if (IN(0)) REPEAT(0) { FRESH(); phase_prologue(args, lds, tid, lane, wave); } SEAM(0);
    if (IN(1)) REPEAT(1) { FRESH(); phase_mod0(args, lane, wave); } SEAM(1);
    if (IN(2)) REPEAT(2) {
        pg8::Gemm g{BX, (const bf16*)(ws + WS_WIN), NTOK, ZC, 512}; pg8::AllOrder S; S.init(NTOK / 256, ZC / 256, G, (int)blockIdx.x);
        pg8::EpiBf16<0> E{(bf16*)(ws + WS_Z), ZC, nullptr, ZC, 0, 1.f / (SC_A0 * SC_WIN)};
        pg8::gemm_phase<pg8::EpiBf16<0>, pg8::AllOrder, PG8_ALIGN, true, false, true>(lds, g, S, E);
    } SEAM(2);
    if (IN(3)) REPEAT(3) { FRESH(); phase_norm0(args, lane, wave); hgrn_prep_items(args, lds, tid); } SEAM(3);
    if (IN(4)) REPEAT(4) {
        { pg8::Gemm g{(const bf16*)(ws + WS_CQN), (const bf16*)(ws + WS_WUQ), NTOK, 768, 384}; pg8::LatOrder S; S.init(128, 3, G, (int)blockIdx.x);
          pg8::EpiBf16<0> E{(bf16*)(ws + WS_Q), 768, nullptr, 0, 0, 1.f};
          pg8::gemm_phase<pg8::EpiBf16<0>, pg8::LatOrder, PG8_ALIGN, PG8_SP2>(lds, g, S, E); }
        __syncthreads();
        { pg8::Gemm g{(const bf16*)(ws + WS_CKVN), (const bf16*)(ws + WS_WUKV), NTOK, 1024, 256}; pg8::AllOrder S; S.init(NTOK / 256, 4, G, G - 1 - (int)blockIdx.x);
          pg8::EpiBf16<0> E{(bf16*)(ws + WS_KV), 1024, nullptr, 0, 0, 1.f};
          pg8::gemm_phase<pg8::EpiBf16<0>, pg8::AllOrder, PG8_ALIGN, PG8_SP2>(lds, g, S, E); }
    } SEAM(4);
    if (IN(5)) {
        REPEAT(21) { FRESH();
        for (int u = blockIdx.x; u < 256; u += G) { __syncthreads(); hgrn_unit_mfma(args, (G == 256) ? ((u & 7) * 32 + (u >> 3)) : u, lds, tid); } }
        const bf16* Q = (const bf16*)(ws + WS_Q); const bf16* KV = (const bf16*)(ws + WS_KV); const bf16* KRR = (const bf16*)(ws + WS_KRR);
        const float* rope = (const float*)(ws + WS_ROPE);
        const int cslot = (G == 256) ? ((((int)blockIdx.x & 7) * 2 + (((int)blockIdx.x >> 3) >> 4)) % 5) : 0;
        REPEAT(22) {
        int ai = 0;
        for (int slot = 0; slot < 5; ++slot) {
            if (slot == cslot) { if (rep_ == 0) { FRESH(); __syncthreads(); convert_moe_share(args, lds, lane, wave); } continue; }
            for (int u = (G == 256) ? (int)blockIdx.x + ai * 256 : (int)blockIdx.x; u < ((G == 256) ? (int)blockIdx.x + ai * 256 + 1 : (ai == 0 ? 1024 : 0)); u += G) {
                int b, h, qb; if (G == 256) { const int x = (int)blockIdx.x & 7, j = (int)blockIdx.x >> 3, pr = (u >> 8) * 16 + 2 * x + (j >> 4); b = pr >> 3; h = pr & 7; qb = j & 15; } else { b = u >> 7; h = (u >> 4) & 7; qb = u & 15; }
                const size_t kb = (size_t)b * TPB, q0 = kb + CTXL + (size_t)qb * 256;
                __syncthreads();
                att::attn_unit(Q + q0 * 768 + h * 96, KV + kb * 1024 + h * 64, KRR + kb * 32, BY + q0 * 1024 + h * 64, rope + (size_t)qb * 256 * 32, TPB, (char*)lds_raw);
            }
            ++ai;
        }
        }
    } SEAM(5);
    if (IN(6)) REPEAT(6) { FRESH(); phase_readout(args, lane, wave); } SEAM(6);
    if (IN(7)) REPEAT(7) {
        pg8::Gemm g{BY, (const bf16*)(ws + WS_WOUT), NTOK, 1024, 1024}; pg8::LatOrder S; S.init(128, 4, G, (int)blockIdx.x);
        pg8::EpiRes<false> E{args.in[I_X], nullptr, (bf16*)(ws + WS_PRE), MODV, nullptr, 1.f};
        pg8::gemm_phase<pg8::EpiRes<false>, pg8::LatOrder, PG8_ALIGN, PG8_SP2>(lds, g, S, E);
    } SEAM(7);
    for (int l = 0; l < 2; ++l) {
        if (l == 1) {
            if (IN(13)) REPEAT(13) {
                pg8::Gemm g{BY, (const bf16*)(ws + WS_WPW1), NTOK, 2048, 512}; pg8::LatOrder S; S.init(128, 8, G, (int)blockIdx.x);
                pg8::EpiGate<0> E{BX, (const float*)(ws + WS_PW1B), 8, 1.f / (SC_A1 * SC_WPW), 1.f, lds};
                pg8::gemm_phase<pg8::EpiGate<0>, pg8::LatOrder, PG8_ALIGN, true, false, true>(lds, g, S, E);
            } SEAM(13);
            if (IN(14)) REPEAT(14) { FRESH(); phase_conv(args, lds, tid, lane, wave); } SEAM(14);
            if (IN(15)) REPEAT(15) {
                pg8::Gemm g{BY, (const bf16*)(ws + WS_WPW2), NTOK, 1024, 512}; pg8::LatOrder S; S.init(128, 4, G, (int)blockIdx.x);
                pg8::EpiRes<true> E{nullptr, (const bf16*)(ws + WS_H), (bf16*)(ws + WS_PRE), MODV + 9 * 6144, args.in[I_PW2B], 1.f / (SC_CV * SC_WPW)};
                pg8::gemm_phase<pg8::EpiRes<true>, pg8::LatOrder, PG8_ALIGN, true, false, true>(lds, g, S, E);
            } SEAM(15);
        }
        const int pb = l ? 16 : 8;
        if (IN(pb)) REPEAT(pb) { FRESH(); phase_ln1(args, l, lds, tid, lane, wave); } SEAM(pb);
        if (IN(pb + 2) || IN(pb + 3)) {
            LAS int* tl = (LAS int*)(lds + LDS_TILE_E);
            FRESH();
            __syncthreads();
            if (tid < 32) tl[3 * MAXTILES + 64 + tid] = ld_ctl((const int*)(ws + WS_CURSOR) + l * 32 + tid);
            __syncthreads();
            if (tid == 0) { int ts = 0; for (int e = 0; e < 32; ++e) { tl[3 * MAXTILES + e] = ts; ts += (tl[3 * MAXTILES + 64 + e] + 255) >> 8; } tl[3 * MAXTILES + 32] = ts; }
            __syncthreads();
            const int ntiles = tl[3 * MAXTILES + 32];
            for (int t = tid; t < ntiles && t < MAXTILES; t += NTHR) { int e = 0; while (e < 31 && tl[3 * MAXTILES + e + 1] <= t) ++e; const int j = t - tl[3 * MAXTILES + e], rem = tl[3 * MAXTILES + 64 + e] - 256 * j;
                tl[t] = e; tl[MAXTILES + t] = e * ECAP + 256 * j; tl[2 * MAXTILES + t] = rem < 256 ? rem : 256; }
            __syncthreads();
            if (IN(pb + 2)) REPEAT(pb + 2) {
#if defined(PROBE_STAGGER)
                if (blockIdx.x & 1) { const unsigned long long t0 = __builtin_amdgcn_s_memrealtime(); while (__builtin_amdgcn_s_memrealtime() - t0 < PROBE_STAGGER) __builtin_amdgcn_s_sleep(8); }
#endif
                pg8::Gemm g{BX, (const bf16*)(ws + WS_WGU + (size_t)l * 32 * 2048 * 1024), 0, 0, 512};
                pg8::MoeOrder S; S.init(ntiles, 8, G, (int)blockIdx.x); S.tile_e = tl; S.nper = 8;
                pg8::EpiGate<1, true> E{(bf16*)(ws + WS_ACT), (const float*)(ws + WS_BGU) + (size_t)l * 32 * 2048, 8, 1.f / (SC_X8 * SC_WGU) * PROBE_KSC, SC_ACT, lds};
                pg8::gemm_phase<pg8::EpiGate<1, true>, pg8::MoeOrder, PG8_ALIGN, true, true, true>(lds, g, S, E, (const int*)(ws + WS_ROWS), tl + MAXTILES);
            } SEAM(pb + 2);
            if (IN(pb + 3)) REPEAT(pb + 3) {
                pg8::Gemm g{(const bf16*)(ws + WS_ACT), (const bf16*)(ws + WS_WDN + (size_t)l * 32 * 1024 * 1024), 0, 0, 512};
                pg8::MoeOrder S; S.init(ntiles, 4, G, (int)blockIdx.x); S.tile_e = tl; S.nper = 4;
                pg8::EpiDown E{(bf16*)(ws + WS_YB), args.in[I_BDN] + (size_t)l * 32 * 1024, (const float*)(ws + WS_ROWW), (const int*)(ws + WS_ROWD), 1.f / (SC_ACT * SC_WDN) * PROBE_KSC, tl + MAXTILES, SC_Y, lds};
                pg8::gemm_phase<pg8::EpiDown, pg8::MoeOrder, PG8_ALIGN, true, false, true>(lds, g, S, E);
            } SEAM(pb + 3);
        }
        if (IN(pb + 4)) REPEAT(pb + 4) { FRESH(); phase_ln2(args, l, lane, wave); }
        if (l == 0) SEAM(12);
    }
#undef IN
#undef SEAM
}

extern "C" void kernel_launch(void* const* d_in, const int* in_sizes, int n_in, void* d_out, int out_size, void* d_ws, size_t ws_size, hipStream_t stream) {
    static int grid = 0;
    if (grid == 0) {
        if (n_in != 33 || in_sizes[0] != NB * SEQ * D || out_size != NB * SEQ * D || ws_size < WS_END) {
            fprintf(stderr, "kernel_launch: unexpected shapes: n_in %d in0 %d out %d ws %zu (need %zu)\n", n_in, n_in > 0 ? in_sizes[0] : -1, out_size, ws_size, (size_t)WS_END); grid = -1; return; }
        int dev = 0, cus = 0;
        if (hipGetDevice(&dev) != hipSuccess || hipDeviceGetAttribute(&cus, hipDeviceAttributeMultiprocessorCount, dev) != hipSuccess) { grid = -1; return; }
        if (hipFuncSetAttribute((const void*)fwd_kernel, hipFuncAttributeMaxDynamicSharedMemorySize, LDS_BYTES) != hipSuccess) { fprintf(stderr, "kernel_launch: hipFuncSetAttribute failed\n"); grid = -1; return; }
        int per_cu = 0;
        if (hipOccupancyMaxActiveBlocksPerMultiprocessor(&per_cu, (const void*)fwd_kernel, NTHR, LDS_BYTES) != hipSuccess || per_cu < 1) fprintf(stderr, "kernel_launch: occupancy query reports %d\n", per_cu);
        (void)hipGetLastError();
        grid = cus;
    }
    if (grid < 0) return;
    if (hipMemsetAsync((char*)d_ws + WS_CTL, 0, CTL_ZERO_BYTES, stream) != hipSuccess) return;
    Args a{};
    for (int i = 0; i < 33; ++i) a.in[i] = (const float*)d_in[i];
    a.out = (float*)d_out; a.ws = (unsigned char*)d_ws;
#if MK_ONE_LAUNCH
    a.ph_lo = 0; a.ph_hi = NPHASES;
    hipLaunchKernelGGL(fwd_kernel, dim3(grid), dim3(NTHR), LDS_BYTES, stream, a);
#else
    for (int ph = 0; ph < NPHASES; ++ph) { a.ph_lo = ph; a.ph_hi = ph + 1; hipLaunchKernelGGL(fwd_kernel, dim3(grid), dim3(NTHR), LDS_BYTES, stream, a); }
#endif
    const hipError_t le = hipPeekAtLastError();
    if (le != hipSuccess) fprintf(stderr, "kernel_launch: launch failed: %s\n", hipGetErrorName(le));
}
```
